# Optimizing an MI355X kernel written in HIP

```python
import jax, jax.numpy as jnp
from jax import lax
import numpy as np

D_MODEL = 1024
BATCH = 4
SEQ = 8192
DEPTH = 1

N_META = 16
D_MIX = D_MODEL
D_SC = D_MIX // 2
D_CF = D_MIX - D_SC
N_GROUPS_SC = 8
N_GROUPS_CF = 8
SC_WIDTH = 3
CF_WIDTH = 31
D_IN = 3 * D_SC + 2 * D_CF
PEER_HEADS = 8
PEER_N_KEYS = 128
PEER_N_EXPERTS = PEER_N_KEYS * PEER_N_KEYS
PEER_D_KEY = 256
PEER_D_HALF = PEER_D_KEY // 2
PEER_TOPK = 16
PEER_CHUNK = 256
EPS = 1e-6

kernel_name = "hymba_conv_peer_block"


def rms_norm(x, g):
    xf = x.astype(jnp.float32)
    y = xf * lax.rsqrt(jnp.mean(xf * xf, axis=-1, keepdims=True) + EPS)
    return (y * g.astype(jnp.float32)).astype(x.dtype)


def layer_norm(x, g, b):
    xf = x.astype(jnp.float32)
    mu = jnp.mean(xf, axis=-1, keepdims=True)
    var = jnp.mean(jnp.square(xf - mu), axis=-1, keepdims=True)
    y = (xf - mu) * lax.rsqrt(var + EPS)
    return (y * g.astype(jnp.float32) + b.astype(jnp.float32)).astype(x.dtype)


def causal_depthwise_conv(x, w):
    k, c = w.shape
    return lax.conv_general_dilated(
        x, w[:, None, :].astype(x.dtype), window_strides=(1,), padding=[(k - 1, 0)],
        dimension_numbers=("NWC", "WIO", "NWC"), feature_group_count=c)


def short_conv_mixer(xv, bg, cg, w_conv):
    return bg * causal_depthwise_conv(cg * xv, w_conv)


def conformer_conv_mixer(a, gate, w_dw, b_dw, ln_g, ln_b):
    u = a * jax.nn.sigmoid(gate)
    u = causal_depthwise_conv(u, w_dw) + b_dw
    return jax.nn.silu(layer_norm(u, ln_g, ln_b))


def peer_route(q, sub_keys):
    s1 = jnp.einsum("thd,hnd->thn", q[..., :PEER_D_HALF], sub_keys[:, 0])
    s2 = jnp.einsum("thd,hnd->thn", q[..., PEER_D_HALF:], sub_keys[:, 1])
    v1, i1 = lax.top_k(s1, PEER_TOPK)
    v2, i2 = lax.top_k(s2, PEER_TOPK)
    cand = (v1[..., :, None] + v2[..., None, :]).reshape(q.shape[:-1] + (PEER_TOPK * PEER_TOPK,))
    vals, pos = lax.top_k(cand, PEER_TOPK)
    e1 = jnp.take_along_axis(i1, pos // PEER_TOPK, axis=-1)
    e2 = jnp.take_along_axis(i2, pos % PEER_TOPK, axis=-1)
    idx = e1 * PEER_N_KEYS + e2
    gates = jax.nn.softmax(vals.astype(jnp.float32), axis=-1).astype(q.dtype)
    return idx, gates


def peer_experts(xc, idx, gates, u, v):
    u_sel = jnp.take(u, idx, axis=0)
    act = jax.nn.gelu(jnp.einsum("chkd,cd->chk", u_sel, xc))
    v_sel = jnp.take(v, idx, axis=0)
    return jnp.einsum("chk,chkd->cd", act * gates, v_sel)


def peer_layer(x, w_q, sub_keys, u, v):
    b, t, d = x.shape
    n_tok = b * t
    pad = (-n_tok) % PEER_CHUNK
    xf = jnp.pad(x.reshape(n_tok, d), ((0, pad), (0, 0)))
    q = (xf @ w_q).reshape(n_tok + pad, PEER_HEADS, PEER_D_KEY)
    idx, gates = peer_route(q, sub_keys)
    n_chunks = (n_tok + pad) // PEER_CHUNK
    xc = xf.reshape(n_chunks, PEER_CHUNK, d)
    idxc = idx.reshape(n_chunks, PEER_CHUNK, PEER_HEADS, PEER_TOPK)
    gc = gates.reshape(n_chunks, PEER_CHUNK, PEER_HEADS, PEER_TOPK)
    out = lax.map(lambda args: peer_experts(args[0], args[1], args[2], u, v), (xc, idxc, gc))
    return out.reshape(n_tok + pad, d)[:n_tok].reshape(b, t, d)


def setup_inputs(seed: int = 0) -> dict:
    key = jax.random.key(seed)
    ks = jax.random.split(key, 20)
    f32 = jnp.float32
    nrm = lambda k, shape, s: (jax.random.normal(k, shape, f32) * s)
    gain = lambda k, shape: 1.0 + 0.02 * jax.random.normal(k, shape, f32)
    return {
        "x": nrm(ks[0], (BATCH, SEQ, D_MODEL), 1.0),
        "meta_tokens": nrm(ks[1], (N_META, D_MODEL), 1.0),
        "norm_mix_g": gain(ks[2], (DEPTH, D_MODEL)),
        "w_in": nrm(ks[3], (DEPTH, D_MODEL, D_IN), D_MODEL ** -0.5),
        "sc_conv_w": nrm(ks[4], (DEPTH, SC_WIDTH, D_SC), SC_WIDTH ** -0.5),
        "cf_conv_w": nrm(ks[5], (DEPTH, CF_WIDTH, D_CF), CF_WIDTH ** -0.5),
        "cf_conv_b": nrm(ks[6], (DEPTH, D_CF), 0.02),
        "cf_ln_g": gain(ks[7], (DEPTH, D_CF)),
        "cf_ln_b": nrm(ks[8], (DEPTH, D_CF), 0.02),
        "out_norm_g_sc": gain(ks[9], (DEPTH, D_SC)),
        "out_norm_g_cf": gain(ks[10], (DEPTH, D_CF)),
        "w_out": nrm(ks[11], (DEPTH, D_MIX, D_MODEL), D_MIX ** -0.5),
        "norm_ffn_g": gain(ks[12], (DEPTH, D_MODEL)),
        "peer_w_q": nrm(ks[13], (DEPTH, D_MODEL, PEER_HEADS * PEER_D_KEY), D_MODEL ** -0.5),
        "peer_sub_keys": nrm(ks[14], (DEPTH, PEER_HEADS, 2, PEER_N_KEYS, PEER_D_HALF), PEER_D_HALF ** -0.5),
        "peer_u": nrm(ks[15], (DEPTH, PEER_N_EXPERTS, D_MODEL), D_MODEL ** -0.5),
        "peer_v": nrm(ks[16], (DEPTH, PEER_N_EXPERTS, D_MODEL), PEER_HEADS ** -0.5),
        "final_norm_g": gain(ks[17], (D_MODEL,)),
    }


def reference(x, meta_tokens, norm_mix_g, w_in, sc_conv_w, cf_conv_w, cf_conv_b, cf_ln_g, cf_ln_b,
              out_norm_g_sc, out_norm_g_cf, w_out, norm_ffn_g, peer_w_q, peer_sub_keys, peer_u, peer_v,
              final_norm_g):
    b = x.shape[0]
    meta = jnp.broadcast_to(meta_tokens[None].astype(x.dtype), (b, N_META, x.shape[-1]))
    h = jnp.concatenate([meta, x], axis=1)
    splits = [D_SC, 2 * D_SC, 3 * D_SC, 3 * D_SC + D_CF]
    for l in range(DEPTH):
        hn = rms_norm(h, norm_mix_g[l])
        proj = hn @ w_in[l]
        xv, bg, cg, ga, gg = jnp.split(proj, splits, axis=-1)
        y_sc = short_conv_mixer(xv, bg, cg, sc_conv_w[l])
        y_cf = conformer_conv_mixer(ga, gg, cf_conv_w[l], cf_conv_b[l], cf_ln_g[l], cf_ln_b[l])
        y = jnp.concatenate([rms_norm(y_sc, out_norm_g_sc[l]), rms_norm(y_cf, out_norm_g_cf[l])], axis=-1)
        h = h + y @ w_out[l]
        hn = rms_norm(h, norm_ffn_g[l])
        h = h + peer_layer(hn, peer_w_q[l], peer_sub_keys[l], peer_u[l], peer_v[l])
    h = rms_norm(h, final_norm_g)
    return h[:, N_META:]
```

```cpp
#include <hip/hip_runtime.h>
#include <hip/hip_cooperative_groups.h>
#include <cstdio>
#include <cstdint>
namespace cg = cooperative_groups;

namespace pg8 {
#define PG8_LAS __attribute__((address_space(3)))
typedef unsigned short bf16_t;
typedef short bf16x8 __attribute__((ext_vector_type(8)));
typedef float f32x4 __attribute__((ext_vector_type(4)));
typedef unsigned u32x4 __attribute__((ext_vector_type(4)));
constexpr int BM = 256, BK = 64, HALF = 128, HTB = HALF * BK * 2  , STAGE_BYTES = 8 * HTB, NXCD = 8, WGM = 8;

__host__ __device__ __forceinline__ int lds_byte(int r, int c) { const int st = (r >> 4) * 2 + (c >> 5), rr = r & 15, cc = c & 31, ob = rr * 64 + cc * 2; return st * 1024 + (ob ^ (((ob >> 9) & 1) << 5)); }
__host__ __device__ __forceinline__ void stage_rc(int b, int& R, int& C) { const int st = b / 1024, sb = b % 1024, swz = sb ^ (((sb >> 9) & 1) << 5); R = (st >> 1) * 16 + swz / 64; C = (st & 1) * 32 + (swz % 64) / 2; }
__host__ __device__ __forceinline__ int perm32(int rho) { const int n = rho >> 4, i = rho & 15; return 8 * (i >> 2) + 4 * n + (i & 3); }

struct Unit { int pm, pn; };
struct Gemm { const bf16_t* A; const bf16_t* Bt; int M, N, K; };

struct StaticOrder {
    int nM, nN, nwg, G, c;
    __host__ __device__ void init(int M, int N, int G_, int c_) { nM = M / BM; nN = N / BM; nwg = nM * nN; G = G_; c = c_; }
    __host__ __device__ bool next(int i, Unit& u) const {
        const long L = (long)i * G + c; if (L >= nwg) return false;
        int wgid = (int)L; { const int q = nwg / NXCD, r = nwg % NXCD, xcd = wgid % NXCD, off = wgid / NXCD; wgid = (xcd < r ? xcd * (q + 1) : r * (q + 1) + (xcd - r) * q) + off; }
        const int nig = WGM * nN, gid = wgid / nig, fm = gid * WGM, gsz = (nM - fm) < WGM ? (nM - fm) : WGM;
        u.pm = fm + ((wgid % nig) % gsz); u.pn = (wgid % nig) / gsz; return true;
    }
    __device__ __forceinline__ void a_ready(const Unit&) const {}
    __device__ __forceinline__ void done(const Unit&) const {}
};

template <class Epi, class Sched, bool ALIGN_EPI = false, bool SP2 = false>
__device__ __forceinline__ void gemm_phase(PG8_LAS unsigned char* lds, const Gemm g, const Sched& S, const Epi& E) {
    const int tid = threadIdx.x, wid = __builtin_amdgcn_readfirstlane(tid >> 6), lane = tid & 63, wr = wid >> 2, wc = wid & 3, fr = lane & 15, fq = lane >> 4;
    const int K = g.K, nt = K / BK;
    unsigned voffA[2], voffB[2];
#pragma unroll
    for (int i = 0; i < 2; ++i) { int R, C; stage_rc(tid * 16 + i * 8192, R, C); const int Rb = Epi::PERM ? ((R & ~31) + perm32(R & 31)) : R;
        voffA[i] = (unsigned)(R * K + C) * 2u; voffB[i] = (unsigned)(Rb * K + C) * 2u; }
    const size_t kstep = (size_t)(BK * 2);
    const size_t hstep = (size_t)HALF * K * 2;
    const size_t tstep = 2 * hstep;
    const unsigned ldsw = (unsigned)wid * 1024u;
    const int aoff = lds_byte(wr * 64 + fr, fq * 8), boff = lds_byte(wc * 32 + fr, fq * 8);
#define PG8_SA(b, h) (((b) * 2 + (h)) * HTB)
#define PG8_SB(b, h) ((4 + (b) * 2 + (h)) * HTB)
#define PG8_STAGE(bufoff, gbase, voff) do { _Pragma("unroll") for (int _i = 0; _i < 2; ++_i) \
        __builtin_amdgcn_global_load_lds((const unsigned*)((const char*)(gbase) + (voff)[_i]), (PG8_LAS unsigned*)(lds + (bufoff) + ldsw + _i * 8192), 16, 0, 0); } while (0)
#define PG8_LDA(dst, b, h) do { _Pragma("unroll") for (int m = 0; m < 4; ++m) _Pragma("unroll") for (int k = 0; k < 2; ++k) dst[m][k] = *(const PG8_LAS bf16x8*)(lds + PG8_SA(b, h) + aoff + m * 2048 + k * 1024); } while (0)
#define PG8_LDB(dst, b, h) do { _Pragma("unroll") for (int n = 0; n < 2; ++n) _Pragma("unroll") for (int k = 0; k < 2; ++k) dst[n][k] = *(const PG8_LAS bf16x8*)(lds + PG8_SB(b, h) + boff + n * 2048 + k * 1024); } while (0)
#define PG8_MMA(ai, bj, At, Bt) do { __builtin_amdgcn_s_setprio(1); _Pragma("unroll") for (int m = 0; m < 4; ++m) _Pragma("unroll") for (int n = 0; n < 2; ++n) _Pragma("unroll") for (int k = 0; k < 2; ++k) \
        acc[ai][bj][m][n] = __builtin_amdgcn_mfma_f32_16x16x32_bf16(Bt[n][k], At[m][k], acc[ai][bj][m][n], 0, 0, 0); __builtin_amdgcn_s_setprio(0); } while (0)
#define PG8_WAIT_V(n) asm volatile("s_waitcnt vmcnt(" #n ")" ::: "memory")
#define PG8_WAIT_L(n) asm volatile("s_waitcnt lgkmcnt(" #n ")" ::: "memory")
#define PG8_BAR __builtin_amdgcn_s_barrier()
#define PG8_SCHED __builtin_amdgcn_sched_barrier(0)
    Unit cur, nxt; int ui = 0;
    if (!S.next(0, cur)) return;
    f32x4 acc[2][2][4][2];
#pragma unroll
    for (int a = 0; a < 2; ++a)
#pragma unroll
        for (int b = 0; b < 2; ++b)
#pragma unroll
            for (int m = 0; m < 4; ++m)
#pragma unroll
                for (int n = 0; n < 2; ++n) acc[a][b][m][n] = (f32x4){0.f, 0.f, 0.f, 0.f};
    bf16x8 At[4][2], B0[2][2], B1[2][2];
    const char* cA = (const char*)g.A + (size_t)cur.pm * tstep; const char* cB = (const char*)g.Bt + (size_t)cur.pn * tstep;
    S.a_ready(cur);
    if constexpr (SP2) {
        PG8_STAGE(PG8_SB(0, 0), cB, voffB); PG8_STAGE(PG8_SB(0, 1), cB + hstep, voffB); PG8_STAGE(PG8_SA(0, 0), cA, voffA); PG8_STAGE(PG8_SA(0, 1), cA + hstep, voffA);
        if (wr == 1) PG8_BAR;
        PG8_WAIT_V(2); PG8_BAR;
        PG8_STAGE(PG8_SB(1, 0), cB + kstep, voffB); PG8_STAGE(PG8_SA(1, 0), cA + kstep, voffA); PG8_STAGE(PG8_SB(1, 1), cB + hstep + kstep, voffB);
        PG8_WAIT_V(6); PG8_BAR;
    } else {
        PG8_STAGE(PG8_SB(0, 0), cB, voffB); PG8_STAGE(PG8_SA(0, 0), cA, voffA); PG8_STAGE(PG8_SB(0, 1), cB + hstep, voffB); PG8_STAGE(PG8_SA(0, 1), cA + hstep, voffA);
        if (wr == 1) PG8_BAR;
        PG8_WAIT_V(4); PG8_BAR;
        PG8_STAGE(PG8_SB(1, 0), cB + kstep, voffB); PG8_STAGE(PG8_SA(1, 0), cA + kstep, voffA); PG8_STAGE(PG8_SB(1, 1), cB + hstep + kstep, voffB);
        PG8_WAIT_V(6); PG8_BAR;
    }
    for (;;) {
        const bool has_next = S.next(ui + 1, nxt);
        const char* nA = has_next ? (const char*)g.A + (size_t)nxt.pm * tstep : cA; const char* nB = has_next ? (const char*)g.Bt + (size_t)nxt.pn * tstep : cB;
        for (int t = 0; t < nt; t += 2) {
            const bool last = (t == nt - 2);
            const char* a1 = cA + (size_t)(t + 1) * kstep;
            const char* a2 = last ? nA : cA + (size_t)(t + 2) * kstep; const char* b2 = last ? nB : cB + (size_t)(t + 2) * kstep;
            const char* a3 = a2 + kstep; const char* b3 = b2 + kstep;
            if (last && has_next) S.a_ready(nxt);
            if constexpr (SP2) {
            PG8_LDB(B0, 0, 0); PG8_LDB(B1, 0, 1); PG8_SCHED; PG8_LDA(At, 0, 0); PG8_STAGE(PG8_SA(1, 1), a1 + hstep, voffA);
            PG8_WAIT_V(8); PG8_WAIT_L(0); PG8_BAR; PG8_MMA(0, 0, At, B0); PG8_MMA(0, 1, At, B1); PG8_BAR; PG8_SCHED;
            PG8_LDA(At, 0, 1); PG8_STAGE(PG8_SB(0, 0), b2, voffB); PG8_STAGE(PG8_SB(0, 1), b2 + hstep, voffB); PG8_STAGE(PG8_SA(0, 0), a2, voffA);
            PG8_WAIT_V(8); PG8_WAIT_L(0); PG8_BAR; PG8_MMA(1, 0, At, B0); PG8_MMA(1, 1, At, B1); PG8_BAR; PG8_SCHED;
            PG8_LDB(B0, 1, 0); PG8_LDB(B1, 1, 1); PG8_SCHED; PG8_LDA(At, 1, 0); PG8_STAGE(PG8_SA(0, 1), a2 + hstep, voffA);
            PG8_WAIT_V(8); PG8_WAIT_L(0); PG8_BAR; PG8_MMA(0, 0, At, B0); PG8_MMA(0, 1, At, B1); PG8_BAR; PG8_SCHED;
            PG8_LDA(At, 1, 1); PG8_STAGE(PG8_SB(1, 0), b3, voffB); PG8_STAGE(PG8_SB(1, 1), b3 + hstep, voffB); PG8_STAGE(PG8_SA(1, 0), a3, voffA);
            PG8_WAIT_V(8); PG8_WAIT_L(0); PG8_BAR; PG8_MMA(1, 0, At, B0); PG8_MMA(1, 1, At, B1); PG8_BAR; PG8_SCHED;
            } else {
            PG8_LDB(B0, 0, 0); PG8_SCHED; PG8_LDA(At, 0, 0); PG8_STAGE(PG8_SA(1, 1), a1 + hstep, voffA);
            PG8_WAIT_L(8); PG8_BAR; PG8_WAIT_L(0); PG8_MMA(0, 0, At, B0); PG8_BAR; PG8_SCHED;
            PG8_LDB(B1, 0, 1); PG8_STAGE(PG8_SB(0, 0), b2, voffB);
            PG8_BAR; PG8_WAIT_L(0); PG8_MMA(0, 1, At, B1); PG8_BAR;
            PG8_LDA(At, 0, 1); PG8_STAGE(PG8_SA(0, 0), a2, voffA);
            PG8_BAR; PG8_WAIT_L(0); PG8_MMA(1, 0, At, B0); PG8_BAR; PG8_SCHED;
            PG8_STAGE(PG8_SB(0, 1), b2 + hstep, voffB);
            PG8_WAIT_V(6); PG8_BAR; PG8_MMA(1, 1, At, B1); PG8_BAR;
            PG8_LDB(B0, 1, 0); PG8_SCHED; PG8_LDA(At, 1, 0); PG8_STAGE(PG8_SA(0, 1), a2 + hstep, voffA);
            PG8_WAIT_L(8); PG8_BAR; PG8_WAIT_L(0); PG8_MMA(0, 0, At, B0); PG8_BAR; PG8_SCHED;
            PG8_LDB(B1, 1, 1); PG8_STAGE(PG8_SB(1, 0), b3, voffB);
            PG8_BAR; PG8_WAIT_L(0); PG8_MMA(0, 1, At, B1); PG8_BAR;
            PG8_LDA(At, 1, 1); PG8_STAGE(PG8_SA(1, 0), a3, voffA);
            PG8_BAR; PG8_WAIT_L(0); PG8_MMA(1, 0, At, B0); PG8_BAR; PG8_SCHED;
            PG8_STAGE(PG8_SB(1, 1), b3 + hstep, voffB);
            PG8_WAIT_V(6); PG8_BAR; PG8_MMA(1, 1, At, B1); PG8_BAR;
            }
        }
        if constexpr (ALIGN_EPI) { if (wr == 0) PG8_BAR; }
        if constexpr (!Epi::AFTER_DRAIN) { E(acc, cur, wr, wc, fr, fq); S.done(cur); }
        if (!has_next) break;
#pragma unroll
        for (int a = 0; a < 2; ++a)
#pragma unroll
            for (int b = 0; b < 2; ++b)
#pragma unroll
                for (int m = 0; m < 4; ++m)
#pragma unroll
                    for (int n = 0; n < 2; ++n) acc[a][b][m][n] = (f32x4){0.f, 0.f, 0.f, 0.f};
        cur = nxt; cA = nA; cB = nB; ++ui;
        if constexpr (ALIGN_EPI) { if (wr == 1) PG8_BAR; }
    }
    PG8_WAIT_V(0);
    if constexpr (!ALIGN_EPI) { if (wr == 0) PG8_BAR; }
    PG8_BAR;
    if constexpr (Epi::AFTER_DRAIN) { E.fused(acc, cur, wr, wc, fr, fq, lds, wid, lane); S.done(cur); }
#undef PG8_SA
#undef PG8_SB
#undef PG8_STAGE
#undef PG8_LDA
#undef PG8_LDB
#undef PG8_MMA
#undef PG8_WAIT_V
#undef PG8_WAIT_L
#undef PG8_BAR
#undef PG8_SCHED
}
}

#define LAS __attribute__((address_space(3)))
typedef unsigned short bf16;
typedef float f32x2 __attribute__((ext_vector_type(2)));
typedef float f32x4 __attribute__((ext_vector_type(4)));
typedef unsigned u32x2 __attribute__((ext_vector_type(2)));
typedef unsigned u32x4 __attribute__((ext_vector_type(4)));

constexpr int NTOK = 32768, DM = 1024, DIN = 2560, SEQ = 8192, NBATCH = 4, NMETA = 16;
constexpr int NHEAD = 8, NKEYS = 128, TOPK = 16, NSEL = NHEAD * TOPK;
constexpr float EPS = 1e-6f;
constexpr float U_SCALE = 64.f, V_SCALE = 16.f;
constexpr int NWAVES = 8, NTHREADS = 512;
constexpr int LDS_BYTES = 147456;

constexpr size_t MiB = 1u << 20;
constexpr size_t WS_CTL = 0, WS_WIN_T = 1 * MiB, WS_WOUT_T = 6 * MiB, WS_WQ_T = 8 * MiB, WS_KEYS = 12 * MiB, WS_METAPART = 13 * MiB,
                 WS_METARSTD = 14 * MiB + 512 * 1024, WS_METAPROJ = 14 * MiB + 576 * 1024, WS_RSTD1 = 15 * MiB, WS_SSQ = 16 * MiB, WS_U8 = 32 * MiB, WS_V8 = 48 * MiB,
                 WS_IDX = 64 * MiB, WS_GATE = 80 * MiB, WS_H0B = 96 * MiB, WS_H2B = 96 * MiB, WS_Y = 160 * MiB, WS_PROJ = 224 * MiB,
                 WS_Q = 224 * MiB, WS_END = 384 * MiB;

struct Params {
    const float* x; const float* meta; const float* g_mix; const float* w_in; const float* sc_w; const float* cf_w; const float* cf_b;
    const float* ln_g; const float* ln_b; const float* g_sc; const float* g_cf; const float* w_out; const float* g_ffn; const float* w_q;
    const float* keys; const float* pu; const float* pv; const float* g_fin;
    float* out; unsigned char* ws;
    int ph_lo, ph_hi, coop, pad;
};

__device__ __forceinline__ unsigned f2bf(float f) { unsigned u = __builtin_bit_cast(unsigned, f); return (u + 0x7fffu + ((u >> 16) & 1u)) >> 16; }
__device__ __forceinline__ unsigned pk2(float lo, float hi) { return f2bf(lo) | (f2bf(hi) << 16); }
__device__ __forceinline__ float bf2f(unsigned b) { return __builtin_bit_cast(float, b << 16); }
__device__ __forceinline__ float bflo(unsigned w) { return __builtin_bit_cast(float, w << 16); }
__device__ __forceinline__ float bfhi(unsigned w) { return __builtin_bit_cast(float, w & 0xffff0000u); }
__device__ __forceinline__ float wave_sum(float v) {
#pragma unroll
    for (int o = 1; o < 64; o <<= 1) v += __shfl_xor(v, o);
    return v;
}
__device__ __forceinline__ float sigmoid_f(float x) { return 1.f / (1.f + __expf(-x)); }
__device__ __forceinline__ float gelu_tanh_f(float x) {
    const float t = 0.7978845608028654f * (x + 0.044715f * x * x * x);
    const float e = __expf(2.f * t);
    const float th = 1.f - 2.f / (e + 1.f);
    return 0.5f * x * (1.f + th);
}

__device__ __forceinline__ unsigned cvt_pk_bf16(float lo, float hi) { unsigned r; asm volatile("v_cvt_pk_bf16_f32 %0, %1, %2" : "=v"(r) : "v"(lo), "v"(hi)); return r; }

template <int MODE> struct EpiRowScale {
    static constexpr bool PERM = true, AFTER_DRAIN = false;
    bf16* O; int ldc; const float* rs;
    __device__ __forceinline__ void operator()(const pg8::f32x4 (&acc)[2][2][4][2], const pg8::Unit& u, int wr, int wc, int fr, int fq) const {
        const int row0 = u.pm * 256 + wr * 64 + fr, col0 = u.pn * 256 + wc * 32 + 8 * fq;
#pragma unroll
        for (int ai = 0; ai < 2; ++ai)
#pragma unroll
            for (int m = 0; m < 4; ++m) {
                const int row = row0 + ai * 128 + m * 16;
                float s;
                if (MODE == 0) s = rs[row];
                else { const f32x4* p = (const f32x4*)(rs + (size_t)row * 16); const f32x4 a = p[0], b = p[1], c = p[2], d = p[3];
                       const float t = ((a.x + a.y) + (a.z + a.w)) + ((b.x + b.y) + (b.z + b.w)) + ((c.x + c.y) + (c.z + c.w)) + ((d.x + d.y) + (d.z + d.w));
                       s = rsqrtf(t * (1.f / 1024.f) + EPS); }
                bf16* rowp = O + (size_t)row * ldc + col0;
#pragma unroll
                for (int bj = 0; bj < 2; ++bj) { const pg8::f32x4 v0 = acc[ai][bj][m][0] * s, v1 = acc[ai][bj][m][1] * s;
                    u32x4 w; w.x = cvt_pk_bf16(v0[0], v0[1]); w.y = cvt_pk_bf16(v0[2], v0[3]); w.z = cvt_pk_bf16(v1[0], v1[1]); w.w = cvt_pk_bf16(v1[2], v1[3]);
                    *(u32x4*)(rowp + bj * 128) = w; }
            }
    }
};
struct EpiResidual {
    static constexpr bool PERM = true, AFTER_DRAIN = false;
    bf16* O; const float* X; float* ssq;
    __device__ __forceinline__ void operator()(const pg8::f32x4 (&acc)[2][2][4][2], const pg8::Unit& u, int wr, int wc, int fr, int fq) const {
        const int row0 = u.pm * 256 + wr * 64 + fr, col0 = u.pn * 256 + wc * 32 + 8 * fq;
#pragma unroll
        for (int ai = 0; ai < 2; ++ai)
#pragma unroll
            for (int m = 0; m < 4; ++m) {
                const int row = row0 + ai * 128 + m * 16;
                const float* xr = X + (size_t)row * DM + col0; bf16* rowp = O + (size_t)row * DM + col0;
                float q = 0.f;
#pragma unroll
                for (int bj = 0; bj < 2; ++bj) { const f32x4 x0 = *(const f32x4*)(xr + bj * 128), x1 = *(const f32x4*)(xr + bj * 128 + 4);
                    const pg8::f32x4 v0 = acc[ai][bj][m][0] + x0, v1 = acc[ai][bj][m][1] + x1;
                    q += (v0[0] * v0[0] + v0[1] * v0[1]) + (v0[2] * v0[2] + v0[3] * v0[3]) + (v1[0] * v1[0] + v1[1] * v1[1]) + (v1[2] * v1[2] + v1[3] * v1[3]);
                    u32x4 w; w.x = cvt_pk_bf16(v0[0], v0[1]); w.y = cvt_pk_bf16(v0[2], v0[3]); w.z = cvt_pk_bf16(v1[0], v1[1]); w.w = cvt_pk_bf16(v1[2], v1[3]);
                    *(u32x4*)(rowp + bj * 128) = w; }
                q += __shfl_xor(q, 16); q += __shfl_xor(q, 32);
                if (fq == 0) ssq[(size_t)row * 16 + u.pn * 4 + wc] = q;
            }
    }
};

__device__ __forceinline__ void p0_transpose_item(const float* W, int K, int N, bf16* WT, LAS float* scr, int item, int lane,
                                                  const float* g_lo, const float* g_hi, int split) {
    const int nblk = N / 32, kb = item / nblk, nb = item % nblk, k0 = 64 * kb, n0 = 32 * nb;
#pragma unroll 8
    for (int i = 0; i < 32; ++i) { const int kk = 2 * i + (lane >> 5); const int k = k0 + kk;
        const float g = (k < split) ? g_lo[k] : g_hi[k - split];
        scr[kk * 33 + (lane & 31)] = W[(size_t)k * N + n0 + (lane & 31)] * g; }
    asm volatile("s_waitcnt lgkmcnt(0)" ::: "memory");
    const int c = lane & 7;
#pragma unroll
    for (int j = 0; j < 4; ++j) { const int n = (lane >> 3) + 8 * j; const LAS float* s = scr + (8 * c) * 33 + n;
        u32x4 o; o.x = pk2(s[0 * 33], s[1 * 33]); o.y = pk2(s[2 * 33], s[3 * 33]); o.z = pk2(s[4 * 33], s[5 * 33]); o.w = pk2(s[6 * 33], s[7 * 33]);
        *(u32x4*)(WT + (size_t)(n0 + n) * K + k0 + 8 * c) = o; }
    asm volatile("s_waitcnt lgkmcnt(0)" ::: "memory");
}

__device__ __forceinline__ void phase_prep(const Params& P, LAS unsigned char* lds) {
    const int tid = threadIdx.x, lane = tid & 63, wave = __builtin_amdgcn_readfirstlane(tid >> 6);
    const int gw = blockIdx.x * NWAVES + wave, NGW = gridDim.x * NWAVES;
    unsigned char* ws = P.ws;
    LAS float* scr = (LAS float*)(lds + wave * 16384);
    constexpr int I_IN = (DM / 64) * (DIN / 32), I_OUT = (DM / 64) * (DM / 32), I_Q = (DM / 64) * (2048 / 32);
    for (int it = gw; it < I_IN + I_OUT + I_Q; it += NGW) {
        int r = it;
        if (r < I_IN) { p0_transpose_item(P.w_in, DM, DIN, (bf16*)(ws + WS_WIN_T), scr, r, lane, P.g_mix, P.g_mix, DM); continue; } r -= I_IN;
        if (r < I_OUT) { p0_transpose_item(P.w_out, DM, DM, (bf16*)(ws + WS_WOUT_T), scr, r, lane, P.g_sc, P.g_cf, 512); continue; } r -= I_OUT;
        p0_transpose_item(P.w_q, DM, 2048, (bf16*)(ws + WS_WQ_T), scr, r, lane, P.g_ffn, P.g_ffn, DM);
    }
    {
        bf16* H0B = (bf16*)(ws + WS_H0B); float* RSTD1 = (float*)(ws + WS_RSTD1);
        for (int t = gw; t < NTOK; t += NGW) {
            const f32x4* xr = (const f32x4*)(P.x + (size_t)t * DM) + lane;
            f32x4 v[4]; float s = 0.f;
#pragma unroll
            for (int j = 0; j < 4; ++j) { v[j] = xr[64 * j]; s += (v[j].x * v[j].x + v[j].y * v[j].y) + (v[j].z * v[j].z + v[j].w * v[j].w); }
            s = wave_sum(s);
            if (lane == 0) RSTD1[t] = rsqrtf(s * (1.f / DM) + EPS);
            u32x2* o = (u32x2*)(H0B + (size_t)t * DM) + lane;
#pragma unroll
            for (int j = 0; j < 4; ++j) { u32x2 w; w.x = pk2(v[j].x, v[j].y); w.y = pk2(v[j].z, v[j].w); o[64 * j] = w; }
        }
    }
    {
        unsigned char* U8 = ws + WS_U8; unsigned char* V8 = ws + WS_V8;
        f32x4 gf[4];
#pragma unroll
        for (int j = 0; j < 4; ++j) gf[j] = ((const f32x4*)P.g_ffn)[64 * j + lane] * U_SCALE;
        for (int e = gw; e < 2 * 16384; e += NGW) {
            const bool isv = e >= 16384; const int ee = isv ? e - 16384 : e;
            const f32x4* src = (const f32x4*)((isv ? P.pv : P.pu) + (size_t)ee * DM) + lane;
            u32x4 o; unsigned ow[4];
#pragma unroll
            for (int j = 0; j < 4; ++j) { f32x4 v = src[64 * j]; if (isv) v = v * V_SCALE; else v = v * gf[j];
                int p = __builtin_amdgcn_cvt_pk_fp8_f32(v.x, v.y, 0, false); p = __builtin_amdgcn_cvt_pk_fp8_f32(v.z, v.w, p, true); ow[j] = (unsigned)p; }
            o.x = ow[0]; o.y = ow[1]; o.z = ow[2]; o.w = ow[3];
            *(u32x4*)((isv ? V8 : U8) + (size_t)ee * DM + 16 * lane) = o;
        }
    }
    {
        bf16* KB = (bf16*)(ws + WS_KEYS);
        const int gt = blockIdx.x * NTHREADS + tid, NGT = gridDim.x * NTHREADS;
        for (int i = gt; i < 8 * 2 * 128 * 128 / 4; i += NGT) { const f32x4 v = ((const f32x4*)P.keys)[i]; u32x2 w; w.x = pk2(v.x, v.y); w.y = pk2(v.z, v.w); ((u32x2*)KB)[i] = w; }
    }
    {
        float* MP = (float*)(ws + WS_METAPART); float* MR = (float*)(ws + WS_METARSTD);
        for (int r = gw; r < NMETA; r += NGW) {
            float s = 0.f;
            for (int k = lane; k < DM; k += 64) { const float v = P.meta[r * DM + k]; s += v * v; }
            s = wave_sum(s);
            if (lane == 0) MR[r] = rsqrtf(s * (1.f / DM) + EPS);
        }
        for (int it = gw; it < 8 * 40; it += NGW) {
            const int kc = it / 40, nb = it % 40, n = nb * 64 + lane;
            float acc[NMETA];
#pragma unroll
            for (int r = 0; r < NMETA; ++r) acc[r] = 0.f;
            for (int k = kc * 128; k < kc * 128 + 128; ++k) {
                const float w = P.w_in[(size_t)k * DIN + n] * P.g_mix[k];
#pragma unroll
                for (int r = 0; r < NMETA; ++r) acc[r] += P.meta[r * DM + k] * w;
            }
#pragma unroll
            for (int r = 0; r < NMETA; ++r) MP[(size_t)(kc * 16 + r) * DIN + n] = acc[r];
        }
    }
}

__device__ __forceinline__ void phase_metaproj(const Params& P) {
    const float* MP = (const float*)(P.ws + WS_METAPART); const float* MR = (const float*)(P.ws + WS_METARSTD); float* MJ = (float*)(P.ws + WS_METAPROJ);
    const int gt = blockIdx.x * NTHREADS + threadIdx.x;
    if (gt < NMETA * DIN) { const int p = gt / DIN, col = gt % DIN; float s = 0.f;
#pragma unroll
        for (int kc = 0; kc < 8; ++kc) s += MP[(size_t)(kc * 16 + p) * DIN + col];
        MJ[gt] = s * MR[p]; }
}
__device__ __forceinline__ float meta_val(const float* MJ, const float*, int p, int col) { return MJ[p * DIN + col]; }
__device__ __forceinline__ float proj_at(const bf16* PROJ, const float* MP, const float* MR, int b, int pos, int col) {
    if (pos < 0) return 0.f;
    if (pos < NMETA) return meta_val(MP, MR, pos, col);
    return bf2f(PROJ[(size_t)(b * SEQ + pos - NMETA) * DIN + col]);
}
__device__ __forceinline__ void proj8_at(const bf16* PROJ, const float* MP, const float* MR, int b, int pos, int col, float (&v)[8]) {
    if (pos < 0) {
#pragma unroll
        for (int i = 0; i < 8; ++i) v[i] = 0.f;
    } else if (pos < NMETA) {
        const f32x4 a = *(const f32x4*)(MP + pos * DIN + col), bq = *(const f32x4*)(MP + pos * DIN + col + 4);
        v[0] = a.x; v[1] = a.y; v[2] = a.z; v[3] = a.w; v[4] = bq.x; v[5] = bq.y; v[6] = bq.z; v[7] = bq.w;
    } else {
        const u32x4 w = *(const u32x4*)(PROJ + (size_t)(b * SEQ + pos - NMETA) * DIN + col);
        v[0] = bflo(w.x); v[1] = bfhi(w.x); v[2] = bflo(w.y); v[3] = bfhi(w.y); v[4] = bflo(w.z); v[5] = bfhi(w.z); v[6] = bflo(w.w); v[7] = bfhi(w.w);
    }
}

__device__ __forceinline__ void phase_conv(const Params& P, LAS unsigned char* lds) {
    const int tid = threadIdx.x, lane = tid & 63, wave = __builtin_amdgcn_readfirstlane(tid >> 6);
    unsigned char* ws = P.ws;
    const bf16* PROJ = (const bf16*)(ws + WS_PROJ); const float* MP = (const float*)(ws + WS_METAPROJ); const float* MR = nullptr;
    bf16* Y = (bf16*)(ws + WS_Y);
    LAS float* U = (LAS float*)lds;
    constexpr int TT = 32, NTILE = NTOK / TT;
    const int c = tid;
    float wcf[31];
#pragma unroll
    for (int j = 0; j < 31; ++j) wcf[j] = P.cf_w[j * 512 + c];
    const float bcf = P.cf_b[c];
    float lng[8], lnb[8], wsc[3][8];
#pragma unroll
    for (int i = 0; i < 8; ++i) { lng[i] = P.ln_g[8 * lane + i]; lnb[i] = P.ln_b[8 * lane + i];
#pragma unroll
        for (int j = 0; j < 3; ++j) wsc[j][i] = P.sc_w[j * 512 + 8 * lane + i]; }
    for (int tile = blockIdx.x; tile < NTILE; tile += gridDim.x) {
        const int b = tile / (SEQ / TT), s0 = (tile % (SEQ / TT)) * TT;
#pragma unroll 2
        for (int r = 0; r < TT + 30; ++r) {
            const int pos = NMETA + s0 - 30 + r;
            const float ga = proj_at(PROJ, MP, MR, b, pos, 1536 + c), gg = proj_at(PROJ, MP, MR, b, pos, 2048 + c);
            U[r * 512 + c] = ga * sigmoid_f(gg);
        }
#pragma unroll 1
        for (int ii = 0; ii < TT; ++ii) {
            float o = bcf;
#pragma unroll
            for (int j = 0; j < 31; ++j) o += wcf[j] * U[(ii + j) * 512 + c];
            U[ii * 512 + c] = o;
        }
        __syncthreads();
#pragma unroll 1
        for (int q = 0; q < 4; ++q) {
            const int ii = 4 * wave + q, s = s0 + ii; const size_t t = (size_t)b * SEQ + s;
            float o[8];
            { const f32x4 a = *(const LAS f32x4*)(U + ii * 512 + 8 * lane), bq = *(const LAS f32x4*)(U + ii * 512 + 8 * lane + 4);
              o[0] = a.x; o[1] = a.y; o[2] = a.z; o[3] = a.w; o[4] = bq.x; o[5] = bq.y; o[6] = bq.z; o[7] = bq.w; }
            float s1 = 0.f;
#pragma unroll
            for (int i = 0; i < 8; ++i) s1 += o[i];
            const float mean = wave_sum(s1) * (1.f / 512.f);
            float s2 = 0.f;
#pragma unroll
            for (int i = 0; i < 8; ++i) { o[i] -= mean; s2 += o[i] * o[i]; }
            const float rs = rsqrtf(wave_sum(s2) * (1.f / 512.f) + EPS);
            float s3 = 0.f;
#pragma unroll
            for (int i = 0; i < 8; ++i) { float y = o[i] * rs * lng[i] + lnb[i]; y = y * sigmoid_f(y); o[i] = y; s3 += y * y; }
            const float r2 = rsqrtf(wave_sum(s3) * (1.f / 512.f) + EPS);
            u32x4 wv; wv.x = pk2(o[0] * r2, o[1] * r2); wv.y = pk2(o[2] * r2, o[3] * r2); wv.z = pk2(o[4] * r2, o[5] * r2); wv.w = pk2(o[6] * r2, o[7] * r2);
            *(u32x4*)(Y + t * DM + 512 + 8 * lane) = wv;
            float accs[8];
#pragma unroll
            for (int i = 0; i < 8; ++i) accs[i] = 0.f;
#pragma unroll
            for (int j = 0; j < 3; ++j) {
                const int pos = NMETA + s - 2 + j; float xv[8], cgv[8];
                proj8_at(PROJ, MP, MR, b, pos, 8 * lane, xv); proj8_at(PROJ, MP, MR, b, pos, 1024 + 8 * lane, cgv);
#pragma unroll
                for (int i = 0; i < 8; ++i) accs[i] += wsc[j][i] * (xv[i] * cgv[i]);
            }
            float bgv[8]; proj8_at(PROJ, MP, MR, b, NMETA + s, 512 + 8 * lane, bgv);
            float s4 = 0.f;
#pragma unroll
            for (int i = 0; i < 8; ++i) { accs[i] *= bgv[i]; s4 += accs[i] * accs[i]; }
            const float r4 = rsqrtf(wave_sum(s4) * (1.f / 512.f) + EPS);
            u32x4 wz; wz.x = pk2(accs[0] * r4, accs[1] * r4); wz.y = pk2(accs[2] * r4, accs[3] * r4); wz.z = pk2(accs[4] * r4, accs[5] * r4); wz.w = pk2(accs[6] * r4, accs[7] * r4);
            *(u32x4*)(Y + t * DM + 8 * lane) = wz;
        }
        __syncthreads();
    }
}

__device__ __forceinline__ int ord_i(float s) { int k = __builtin_bit_cast(int, s); k ^= (k >> 31) & 0x7fffffff; return k; }
__device__ __forceinline__ float unord_f(int k) { k ^= (k >> 31) & 0x7fffffff; return __builtin_bit_cast(float, k); }
#define TOP_INSERT(L, x_) do { int _x = (x_); _Pragma("unroll") for (int _i = 0; _i < 16; ++_i) { const int _hi = max(L[_i], _x); _x = min(L[_i], _x); L[_i] = _hi; } } while (0)

__device__ __forceinline__ void phase_route(const Params& P, LAS unsigned char* lds) {
    const int tid = threadIdx.x;
    unsigned char* ws = P.ws;
    const bf16* KEYS = (const bf16*)(ws + WS_KEYS); const bf16* Q = (const bf16*)(ws + WS_Q);
    int* IDX = (int*)(ws + WS_IDX); float* GATE = (float*)(ws + WS_GATE);
    LAS u32x4* KL = (LAS u32x4*)lds;
    for (int unit = blockIdx.x; unit < (NTOK / NTHREADS) * NHEAD; unit += gridDim.x) {
        const int tb = unit / NHEAD, h = unit % NHEAD;
        __syncthreads();
        for (int i = tid; i < 4096; i += NTHREADS) KL[i] = ((const u32x4*)(KEYS + (size_t)h * 32768))[i];
        __syncthreads();
        const size_t t = (size_t)tb * NTHREADS + tid;
        int Lh[2][16];
#pragma unroll
        for (int half = 0; half < 2; ++half) {
            float qh[128];
            const u32x4* qp = (const u32x4*)(Q + t * 2048 + h * 256 + half * 128);
#pragma unroll
            for (int d8 = 0; d8 < 16; ++d8) { const u32x4 w = qp[d8];
                qh[8 * d8 + 0] = bflo(w.x); qh[8 * d8 + 1] = bfhi(w.x); qh[8 * d8 + 2] = bflo(w.y); qh[8 * d8 + 3] = bfhi(w.y);
                qh[8 * d8 + 4] = bflo(w.z); qh[8 * d8 + 5] = bfhi(w.z); qh[8 * d8 + 6] = bflo(w.w); qh[8 * d8 + 7] = bfhi(w.w); }
#pragma unroll
            for (int i = 0; i < 16; ++i) Lh[half][i] = (int)0x80000000;
            for (int n = 0; n < NKEYS; ++n) {
                float s = 0.f;
#pragma unroll
                for (int d8 = 0; d8 < 16; ++d8) { const u32x4 w = KL[(half * 128 + n) * 16 + d8];
                    s += qh[8 * d8 + 0] * bflo(w.x) + qh[8 * d8 + 1] * bfhi(w.x) + qh[8 * d8 + 2] * bflo(w.y) + qh[8 * d8 + 3] * bfhi(w.y)
                       + qh[8 * d8 + 4] * bflo(w.z) + qh[8 * d8 + 5] * bfhi(w.z) + qh[8 * d8 + 6] * bflo(w.w) + qh[8 * d8 + 7] * bfhi(w.w); }
                const int key = (ord_i(s) & ~127) | (127 - n);
                TOP_INSERT(Lh[half], key);
            }
        }
        float v1[16], v2[16]; int n1[16], n2[16];
#pragma unroll
        for (int i = 0; i < 16; ++i) { n1[i] = 127 - (Lh[0][i] & 127); v1[i] = unord_f(Lh[0][i] & ~127); n2[i] = 127 - (Lh[1][i] & 127); v2[i] = unord_f(Lh[1][i] & ~127); }
        int M[16];
#pragma unroll
        for (int i = 0; i < 16; ++i) M[i] = (int)0x80000000;
#pragma unroll
        for (int i = 0; i < 16; ++i)
#pragma unroll
            for (int j = 0; j < 16; ++j)
                if ((i + 1) * (j + 1) <= 16) { const int key = (ord_i(v1[i] + v2[j]) & ~255) | (255 - (i * 16 + j)); TOP_INSERT(M, key); }
        float val[16]; int ex[16];
#pragma unroll
        for (int k = 0; k < 16; ++k) {
            const int pos = 255 - (M[k] & 255), pi = pos >> 4, pj = pos & 15;
            val[k] = unord_f(M[k] & ~255);
            int e1 = n1[0], e2 = n2[0];
#pragma unroll
            for (int a = 1; a < 16; ++a) { e1 = (pi == a) ? n1[a] : e1; e2 = (pj == a) ? n2[a] : e2; }
            ex[k] = e1 * NKEYS + e2;
        }
        float sum = 0.f; const float vmax = val[0];
#pragma unroll
        for (int k = 0; k < 16; ++k) { val[k] = __expf(val[k] - vmax); sum += val[k]; }
        const float inv = 1.f / sum;
        int* ip = IDX + t * NSEL + h * TOPK; float* gp = GATE + t * NSEL + h * TOPK;
#pragma unroll
        for (int k4 = 0; k4 < 4; ++k4) {
            *(int4*)(ip + 4 * k4) = make_int4(ex[4 * k4], ex[4 * k4 + 1], ex[4 * k4 + 2], ex[4 * k4 + 3]);
            *(f32x4*)(gp + 4 * k4) = (f32x4){val[4 * k4] * inv, val[4 * k4 + 1] * inv, val[4 * k4 + 2] * inv, val[4 * k4 + 3] * inv};
        }
    }
}

__device__ __forceinline__ float dot16_fp8(const u32x4 r, const f32x4 (&xs)[4]) {
    float p = 0.f;
    const unsigned rw[4] = {r.x, r.y, r.z, r.w};
#pragma unroll
    for (int j = 0; j < 4; ++j) { const f32x2 lo = __builtin_amdgcn_cvt_pk_f32_fp8((int)rw[j], false), hi = __builtin_amdgcn_cvt_pk_f32_fp8((int)rw[j], true);
        p += (lo.x * xs[j].x + lo.y * xs[j].y) + (hi.x * xs[j].z + hi.y * xs[j].w); }
    return p;
}
__device__ __forceinline__ void axpy16_fp8(const u32x4 r, float w, f32x4 (&o)[4]) {
    const unsigned rw[4] = {r.x, r.y, r.z, r.w};
#pragma unroll
    for (int j = 0; j < 4; ++j) { const f32x2 lo = __builtin_amdgcn_cvt_pk_f32_fp8((int)rw[j], false), hi = __builtin_amdgcn_cvt_pk_f32_fp8((int)rw[j], true);
        o[j].x += w * lo.x; o[j].y += w * lo.y; o[j].z += w * hi.x; o[j].w += w * hi.y; }
}
__device__ __forceinline__ void phase_gather(const Params& P, LAS unsigned char* lds) {
    const int tid = threadIdx.x, lane = tid & 63, wave = __builtin_amdgcn_readfirstlane(tid >> 6);
    const int gw = blockIdx.x * NWAVES + wave, NGW = gridDim.x * NWAVES;
    unsigned char* ws = P.ws;
    const int* IDX = (const int*)(ws + WS_IDX); const float* GATE = (const float*)(ws + WS_GATE);
    const unsigned char* U8 = ws + WS_U8; const unsigned char* V8 = ws + WS_V8;
    const bf16* H2B = (const bf16*)(ws + WS_H2B); const float* SSQ = (const float*)(ws + WS_SSQ);
    f32x4 gfin[4];
#pragma unroll
    for (int j = 0; j < 4; ++j) gfin[j] = ((const f32x4*)P.g_fin)[64 * j + lane];
    for (int t = gw; t < NTOK; t += NGW) {
        const int idx0 = IDX[(size_t)t * NSEL + lane], idx1 = IDX[(size_t)t * NSEL + 64 + lane];
        const float g0 = GATE[(size_t)t * NSEL + lane], g1 = GATE[(size_t)t * NSEL + 64 + lane];
        float sq = (lane < 16) ? SSQ[(size_t)t * 16 + lane] : 0.f; sq = wave_sum(sq);
        const float rstd2 = rsqrtf(sq * (1.f / DM) + EPS);
        f32x4 xs[4];
#pragma unroll
        for (int j = 0; j < 4; ++j) { const u32x2 w = ((const u32x2*)(H2B + (size_t)t * DM))[64 * j + lane]; xs[j] = (f32x4){bflo(w.x), bfhi(w.x), bflo(w.y), bfhi(w.y)}; }
        float z0 = 0.f, z1 = 0.f;
#pragma unroll 8
        for (int k = 0; k < 64; ++k) { const int e = __builtin_amdgcn_readlane(idx0, k);
            const u32x4 r = *(const u32x4*)(U8 + (size_t)e * DM + 16 * lane);
            const float p = wave_sum(dot16_fp8(r, xs)); z0 = (lane == k) ? p : z0; }
#pragma unroll 8
        for (int k = 0; k < 64; ++k) { const int e = __builtin_amdgcn_readlane(idx1, k);
            const u32x4 r = *(const u32x4*)(U8 + (size_t)e * DM + 16 * lane);
            const float p = wave_sum(dot16_fp8(r, xs)); z1 = (lane == k) ? p : z1; }
        const float zs = rstd2 * (1.f / U_SCALE);
        const float a0 = gelu_tanh_f(z0 * zs) * g0, a1 = gelu_tanh_f(z1 * zs) * g1;
        f32x4 o[4];
#pragma unroll
        for (int j = 0; j < 4; ++j) o[j] = (f32x4){0.f, 0.f, 0.f, 0.f};
#pragma unroll 8
        for (int k = 0; k < 64; ++k) { const int e = __builtin_amdgcn_readlane(idx0, k);
            const float w = __builtin_bit_cast(float, __builtin_amdgcn_readlane(__builtin_bit_cast(int, a0), k));
            const u32x4 r = *(const u32x4*)(V8 + (size_t)e * DM + 16 * lane); axpy16_fp8(r, w, o); }
#pragma unroll 8
        for (int k = 0; k < 64; ++k) { const int e = __builtin_amdgcn_readlane(idx1, k);
            const float w = __builtin_bit_cast(float, __builtin_amdgcn_readlane(__builtin_bit_cast(int, a1), k));
            const u32x4 r = *(const u32x4*)(V8 + (size_t)e * DM + 16 * lane); axpy16_fp8(r, w, o); }
        float ss = 0.f;
#pragma unroll
        for (int j = 0; j < 4; ++j) { o[j] = xs[j] + o[j] * (1.f / V_SCALE); ss += (o[j].x * o[j].x + o[j].y * o[j].y) + (o[j].z * o[j].z + o[j].w * o[j].w); }
        ss = wave_sum(ss);
        const float r3 = rsqrtf(ss * (1.f / DM) + EPS);
        f32x4* op = (f32x4*)(P.out + (size_t)t * DM) + lane;
#pragma unroll
        for (int j = 0; j < 4; ++j) op[64 * j] = o[j] * r3 * gfin[j];
    }
}

__device__ __forceinline__ void phase_gather_f32(const Params& P, LAS unsigned char* lds) {
    const int tid = threadIdx.x, lane = tid & 63, wave = __builtin_amdgcn_readfirstlane(tid >> 6);
    const int gw = blockIdx.x * NWAVES + wave, NGW = gridDim.x * NWAVES;
    unsigned char* ws = P.ws;
    const int* IDX = (const int*)(ws + WS_IDX); const float* GATE = (const float*)(ws + WS_GATE);
    const unsigned char* U8 = ws + WS_U8; const unsigned char* V8 = ws + WS_V8;
    const bf16* H2B = (const bf16*)(ws + WS_H2B); const float* SSQ = (const float*)(ws + WS_SSQ);
    f32x4 gfin[4], gff[4];
#pragma unroll
    for (int j = 0; j < 4; ++j) gff[j] = ((const f32x4*)P.g_ffn)[64 * j + lane];
#pragma unroll
    for (int j = 0; j < 4; ++j) gfin[j] = ((const f32x4*)P.g_fin)[64 * j + lane];
    for (int t = gw; t < NTOK; t += NGW) {
        const int idx0 = IDX[(size_t)t * NSEL + lane], idx1 = IDX[(size_t)t * NSEL + 64 + lane];
        const float g0 = GATE[(size_t)t * NSEL + lane], g1 = GATE[(size_t)t * NSEL + 64 + lane];
        float sq = (lane < 16) ? SSQ[(size_t)t * 16 + lane] : 0.f; sq = wave_sum(sq);
        const float rstd2 = rsqrtf(sq * (1.f / DM) + EPS);
        f32x4 xs[4];
#pragma unroll
        for (int j = 0; j < 4; ++j) { const u32x2 w = ((const u32x2*)(H2B + (size_t)t * DM))[64 * j + lane]; xs[j] = (f32x4){bflo(w.x), bfhi(w.x), bflo(w.y), bfhi(w.y)}; }
        float z0 = 0.f, z1 = 0.f;
#pragma unroll 8
        for (int k = 0; k < 64; ++k) { const int e = __builtin_amdgcn_readlane(idx0, k);
            const f32x4* ur = (const f32x4*)(P.pu + (size_t)e * DM) + lane; float pp = 0.f;
            for (int j = 0; j < 4; ++j) { const f32x4 uu = ur[64 * j] * gff[j]; pp += (uu.x * xs[j].x + uu.y * xs[j].y) + (uu.z * xs[j].z + uu.w * xs[j].w); }
            const float p = wave_sum(pp); z0 = (lane == k) ? p : z0; }
#pragma unroll 8
        for (int k = 0; k < 64; ++k) { const int e = __builtin_amdgcn_readlane(idx1, k);
            const f32x4* ur = (const f32x4*)(P.pu + (size_t)e * DM) + lane; float pp = 0.f;
            for (int j = 0; j < 4; ++j) { const f32x4 uu = ur[64 * j] * gff[j]; pp += (uu.x * xs[j].x + uu.y * xs[j].y) + (uu.z * xs[j].z + uu.w * xs[j].w); }
            const float p = wave_sum(pp); z1 = (lane == k) ? p : z1; }
        const float zs = rstd2;
        const float a0 = gelu_tanh_f(z0 * zs) * g0, a1 = gelu_tanh_f(z1 * zs) * g1;
        f32x4 o[4];
#pragma unroll
        for (int j = 0; j < 4; ++j) o[j] = (f32x4){0.f, 0.f, 0.f, 0.f};
#pragma unroll 8
        for (int k = 0; k < 64; ++k) { const int e = __builtin_amdgcn_readlane(idx0, k);
            const float w = __builtin_bit_cast(float, __builtin_amdgcn_readlane(__builtin_bit_cast(int, a0), k));
            const f32x4* vr = (const f32x4*)(P.pv + (size_t)e * DM) + lane;
            for (int j = 0; j < 4; ++j) o[j] += vr[64 * j] * w; }
#pragma unroll 8
        for (int k = 0; k < 64; ++k) { const int e = __builtin_amdgcn_readlane(idx1, k);
            const float w = __builtin_bit_cast(float, __builtin_amdgcn_readlane(__builtin_bit_cast(int, a1), k));
            const f32x4* vr = (const f32x4*)(P.pv + (size_t)e * DM) + lane;
            for (int j = 0; j < 4; ++j) o[j] += vr[64 * j] * w; }
        float ss = 0.f;
#pragma unroll
        for (int j = 0; j < 4; ++j) { o[j] = xs[j] + o[j]; ss += (o[j].x * o[j].x + o[j].y * o[j].y) + (o[j].z * o[j].z + o[j].w * o[j].w); }
        ss = wave_sum(ss);
        const float r3 = rsqrtf(ss * (1.f / DM) + EPS);
        f32x4* op = (f32x4*)(P.out + (size_t)t * DM) + lane;
#pragma unroll
        for (int j = 0; j < 4; ++j) op[64 * j] = o[j] * r3 * gfin[j];
    }
}

#ifndef MK_MULTI
#define MK_MULTI 0
#endif
constexpr int NPHASE = 7;
__global__ void __launch_bounds__(NTHREADS, 2) mk_fwd(Params P) {
    extern __shared__ __attribute__((aligned(16))) unsigned char lds_raw[];
    LAS unsigned char* lds = (LAS unsigned char*)lds_raw;
    cg::grid_group grid = cg::this_grid();
    unsigned char* ws = P.ws;
    const int lo = P.ph_lo, hi = P.ph_hi;
#define IN(k) (lo <= (k) && (k) < hi)
#define SEAM(k) do { if (IN(k) && IN((k) + 1)) grid.sync(); } while (0)
#ifndef SKIP0
    if (IN(0)) phase_prep(P, lds);
#endif
    SEAM(0);
#ifndef SKIP1
    if (IN(1)) {
        phase_metaproj(P);
        pg8::Gemm g{(const bf16*)(ws + WS_H0B), (const bf16*)(ws + WS_WIN_T), NTOK, DIN, DM}; pg8::StaticOrder S; S.init(NTOK, DIN, (int)gridDim.x, (int)blockIdx.x);
        EpiRowScale<0> E{(bf16*)(ws + WS_PROJ), DIN, (const float*)(ws + WS_RSTD1)};
        pg8::gemm_phase<EpiRowScale<0>, pg8::StaticOrder, true, true>(lds, g, S, E);
    }
#endif
    SEAM(1);
#ifndef SKIP2
    if (IN(2)) phase_conv(P, lds);
#endif
    SEAM(2);
#ifndef SKIP3
    if (IN(3)) {
        pg8::Gemm g{(const bf16*)(ws + WS_Y), (const bf16*)(ws + WS_WOUT_T), NTOK, DM, DM}; pg8::StaticOrder S; S.init(NTOK, DM, (int)gridDim.x, (int)blockIdx.x);
        EpiResidual E{(bf16*)(ws + WS_H2B), P.x, (float*)(ws + WS_SSQ)};
        pg8::gemm_phase<EpiResidual, pg8::StaticOrder, true, true>(lds, g, S, E);
    }
#endif
    SEAM(3);
#ifndef SKIP4
    if (IN(4)) {
        pg8::Gemm g{(const bf16*)(ws + WS_H2B), (const bf16*)(ws + WS_WQ_T), NTOK, 2048, DM}; pg8::StaticOrder S; S.init(NTOK, 2048, (int)gridDim.x, (int)blockIdx.x);
        EpiRowScale<1> E{(bf16*)(ws + WS_Q), 2048, (const float*)(ws + WS_SSQ)};
        pg8::gemm_phase<EpiRowScale<1>, pg8::StaticOrder, true, true>(lds, g, S, E);
    }
#endif
    SEAM(4);
#ifndef SKIP5
    if (IN(5)) phase_route(P, lds);
#endif
    SEAM(5);
#ifndef SKIP6
#ifdef GATHER_F32
    if (IN(6)) phase_gather_f32(P, lds);
#else
    if (IN(6)) phase_gather(P, lds);
#endif
#endif
#undef IN
#undef SEAM
}

extern "C" void kernel_launch(void* const* d_in, const int* in_sizes, int n_in, void* d_out, int out_size, void* d_ws, size_t ws_size, hipStream_t stream) {
    static int grid = 0;
    if (grid == 0) {
        if (n_in != 18 || in_sizes[0] != NTOK * DM || out_size != NTOK * DM || ws_size < WS_END) {
            fprintf(stderr, "kernel_launch: unexpected shapes (n_in %d in0 %d out %d ws %zu)\n", n_in, n_in > 0 ? in_sizes[0] : -1, out_size, ws_size); grid = -1; return; }
        int dev = 0, cus = 0, per_cu = 0;
        (void)hipGetDevice(&dev); (void)hipDeviceGetAttribute(&cus, hipDeviceAttributeMultiprocessorCount, dev);
        if (hipFuncSetAttribute((const void*)mk_fwd, hipFuncAttributeMaxDynamicSharedMemorySize, LDS_BYTES) != hipSuccess) { fprintf(stderr, "kernel_launch: hipFuncSetAttribute failed\n"); grid = -1; return; }
        if (hipOccupancyMaxActiveBlocksPerMultiprocessor(&per_cu, (const void*)mk_fwd, NTHREADS, LDS_BYTES) != hipSuccess || per_cu < 1) { fprintf(stderr, "kernel_launch: occupancy query failed (%d)\n", per_cu); (void)hipGetLastError(); per_cu = 1; }
        if (per_cu > 1) per_cu = 1;
        grid = cus * per_cu;
        if (grid <= 0) grid = 256;
    }
    if (grid < 0) return;
    Params p{};
    p.x = (const float*)d_in[0]; p.meta = (const float*)d_in[1]; p.g_mix = (const float*)d_in[2]; p.w_in = (const float*)d_in[3]; p.sc_w = (const float*)d_in[4];
    p.cf_w = (const float*)d_in[5]; p.cf_b = (const float*)d_in[6]; p.ln_g = (const float*)d_in[7]; p.ln_b = (const float*)d_in[8]; p.g_sc = (const float*)d_in[9];
    p.g_cf = (const float*)d_in[10]; p.w_out = (const float*)d_in[11]; p.g_ffn = (const float*)d_in[12]; p.w_q = (const float*)d_in[13]; p.keys = (const float*)d_in[14];
    p.pu = (const float*)d_in[15]; p.pv = (const float*)d_in[16]; p.g_fin = (const float*)d_in[17];
    p.out = (float*)d_out; p.ws = (unsigned char*)d_ws;
#if MK_MULTI
    for (int ph = 0; ph < NPHASE; ++ph) { p.ph_lo = ph; p.ph_hi = ph + 1; p.coop = 0; p.pad = 0;
        hipLaunchKernelGGL(mk_fwd, dim3(grid), dim3(NTHREADS), LDS_BYTES, stream, p); }
#else
    p.ph_lo = 0; p.ph_hi = NPHASE; p.coop = 1; p.pad = 0;
    void* args[] = {&p};
    hipError_t e = hipLaunchCooperativeKernel((const void*)mk_fwd, dim3(grid), dim3(NTHREADS), args, LDS_BYTES, stream);
    if (e != hipSuccess) fprintf(stderr, "cooperative launch failed: %s (grid %d)\n", hipGetErrorString(e), grid);
#endif
}
```

```cpp
#include <hip/hip_runtime.h>
#include <hip/hip_cooperative_groups.h>
#include <cstdio>
#include <cstdint>
namespace cg = cooperative_groups;

namespace pg8 {
#define PG8_LAS __attribute__((address_space(3)))
typedef unsigned short bf16_t;
typedef short bf16x8 __attribute__((ext_vector_type(8)));
typedef float f32x4 __attribute__((ext_vector_type(4)));
typedef unsigned u32x4 __attribute__((ext_vector_type(4)));
constexpr int BM = 256, BK = 64, HALF = 128, HTB = HALF * BK * 2  , STAGE_BYTES = 8 * HTB, NXCD = 8, WGM = 8;

__host__ __device__ __forceinline__ int lds_byte(int r, int c) { const int st = (r >> 4) * 2 + (c >> 5), rr = r & 15, cc = c & 31, ob = rr * 64 + cc * 2; return st * 1024 + (ob ^ (((ob >> 9) & 1) << 5)); }
__host__ __device__ __forceinline__ void stage_rc(int b, int& R, int& C) { const int st = b / 1024, sb = b % 1024, swz = sb ^ (((sb >> 9) & 1) << 5); R = (st >> 1) * 16 + swz / 64; C = (st & 1) * 32 + (swz % 64) / 2; }
__host__ __device__ __forceinline__ int perm32(int rho) { const int n = rho >> 4, i = rho & 15; return 8 * (i >> 2) + 4 * n + (i & 3); }

struct Unit { int pm, pn; };
struct Gemm { const bf16_t* A; const bf16_t* Bt; int M, N, K; };

struct StaticOrder {
    int nM, nN, nwg, G, c;
    __host__ __device__ void init(int M, int N, int G_, int c_) { nM = M / BM; nN = N / BM; nwg = nM * nN; G = G_; c = c_; }
    __host__ __device__ bool next(int i, Unit& u) const {
        const long L = (long)i * G + c; if (L >= nwg) return false;
        int wgid = (int)L; { const int q = nwg / NXCD, r = nwg % NXCD, xcd = wgid % NXCD, off = wgid / NXCD; wgid = (xcd < r ? xcd * (q + 1) : r * (q + 1) + (xcd - r) * q) + off; }
        const int nig = WGM * nN, gid = wgid / nig, fm = gid * WGM, gsz = (nM - fm) < WGM ? (nM - fm) : WGM;
        u.pm = fm + ((wgid % nig) % gsz); u.pn = (wgid % nig) / gsz; return true;
    }
    __device__ __forceinline__ void a_ready(const Unit&) const {}
    __device__ __forceinline__ void done(const Unit&) const {}
};

template <class Epi, class Sched, bool ALIGN_EPI = false, bool SP2 = false>
__device__ __forceinline__ void gemm_phase(PG8_LAS unsigned char* lds, const Gemm g, const Sched& S, const Epi& E) {
    const int tid = threadIdx.x, wid = __builtin_amdgcn_readfirstlane(tid >> 6), lane = tid & 63, wr = wid >> 2, wc = wid & 3, fr = lane & 15, fq = lane >> 4;
    const int K = g.K, nt = K / BK;
    unsigned voffA[2], voffB[2];
#pragma unroll
    for (int i = 0; i < 2; ++i) { int R, C; stage_rc(tid * 16 + i * 8192, R, C); const int Rb = Epi::PERM ? ((R & ~31) + perm32(R & 31)) : R;
        voffA[i] = (unsigned)(R * K + C) * 2u; voffB[i] = (unsigned)(Rb * K + C) * 2u; }
    const size_t kstep = (size_t)(BK * 2);
    const size_t hstep = (size_t)HALF * K * 2;
    const size_t tstep = 2 * hstep;
    const unsigned ldsw = (unsigned)wid * 1024u;
    const int aoff = lds_byte(wr * 64 + fr, fq * 8), boff = lds_byte(wc * 32 + fr, fq * 8);
#define PG8_SA(b, h) (((b) * 2 + (h)) * HTB)
#define PG8_SB(b, h) ((4 + (b) * 2 + (h)) * HTB)
#define PG8_STAGE(bufoff, gbase, voff) do { _Pragma("unroll") for (int _i = 0; _i < 2; ++_i) \
        __builtin_amdgcn_global_load_lds((const unsigned*)((const char*)(gbase) + (voff)[_i]), (PG8_LAS unsigned*)(lds + (bufoff) + ldsw + _i * 8192), 16, 0, 0); } while (0)
#define PG8_LDA(dst, b, h) do { _Pragma("unroll") for (int m = 0; m < 4; ++m) _Pragma("unroll") for (int k = 0; k < 2; ++k) dst[m][k] = *(const PG8_LAS bf16x8*)(lds + PG8_SA(b, h) + aoff + m * 2048 + k * 1024); } while (0)
#define PG8_LDB(dst, b, h) do { _Pragma("unroll") for (int n = 0; n < 2; ++n) _Pragma("unroll") for (int k = 0; k < 2; ++k) dst[n][k] = *(const PG8_LAS bf16x8*)(lds + PG8_SB(b, h) + boff + n * 2048 + k * 1024); } while (0)
#define PG8_MMA(ai, bj, At, Bt) do { __builtin_amdgcn_s_setprio(1); _Pragma("unroll") for (int m = 0; m < 4; ++m) _Pragma("unroll") for (int n = 0; n < 2; ++n) _Pragma("unroll") for (int k = 0; k < 2; ++k) \
        acc[ai][bj][m][n] = __builtin_amdgcn_mfma_f32_16x16x32_bf16(Bt[n][k], At[m][k], acc[ai][bj][m][n], 0, 0, 0); __builtin_amdgcn_s_setprio(0); } while (0)
#define PG8_WAIT_V(n) asm volatile("s_waitcnt vmcnt(" #n ")" ::: "memory")
#define PG8_WAIT_L(n) asm volatile("s_waitcnt lgkmcnt(" #n ")" ::: "memory")
#define PG8_BAR __builtin_amdgcn_s_barrier()
#define PG8_SCHED __builtin_amdgcn_sched_barrier(0)
    Unit cur, nxt; int ui = 0;
    if (!S.next(0, cur)) return;
    f32x4 acc[2][2][4][2];
#pragma unroll
    for (int a = 0; a < 2; ++a)
#pragma unroll
        for (int b = 0; b < 2; ++b)
#pragma unroll
            for (int m = 0; m < 4; ++m)
#pragma unroll
                for (int n = 0; n < 2; ++n) acc[a][b][m][n] = (f32x4){0.f, 0.f, 0.f, 0.f};
    bf16x8 At[4][2], B0[2][2], B1[2][2];
    const char* cA = (const char*)g.A + (size_t)cur.pm * tstep; const char* cB = (const char*)g.Bt + (size_t)cur.pn * tstep;
    S.a_ready(cur);
    if constexpr (SP2) {
        PG8_STAGE(PG8_SB(0, 0), cB, voffB); PG8_STAGE(PG8_SB(0, 1), cB + hstep, voffB); PG8_STAGE(PG8_SA(0, 0), cA, voffA); PG8_STAGE(PG8_SA(0, 1), cA + hstep, voffA);
        if (wr == 1) PG8_BAR;
        PG8_WAIT_V(2); PG8_BAR;
        PG8_STAGE(PG8_SB(1, 0), cB + kstep, voffB); PG8_STAGE(PG8_SA(1, 0), cA + kstep, voffA); PG8_STAGE(PG8_SB(1, 1), cB + hstep + kstep, voffB);
        PG8_WAIT_V(6); PG8_BAR;
    } else {
        PG8_STAGE(PG8_SB(0, 0), cB, voffB); PG8_STAGE(PG8_SA(0, 0), cA, voffA); PG8_STAGE(PG8_SB(0, 1), cB + hstep, voffB); PG8_STAGE(PG8_SA(0, 1), cA + hstep, voffA);
        if (wr == 1) PG8_BAR;
        PG8_WAIT_V(4); PG8_BAR;
        PG8_STAGE(PG8_SB(1, 0), cB + kstep, voffB); PG8_STAGE(PG8_SA(1, 0), cA + kstep, voffA); PG8_STAGE(PG8_SB(1, 1), cB + hstep + kstep, voffB);
        PG8_WAIT_V(6); PG8_BAR;
    }
    for (;;) {
        const bool has_next = S.next(ui + 1, nxt);
        const char* nA = has_next ? (const char*)g.A + (size_t)nxt.pm * tstep : cA; const char* nB = has_next ? (const char*)g.Bt + (size_t)nxt.pn * tstep : cB;
        for (int t = 0; t < nt; t += 2) {
            const bool last = (t == nt - 2);
            const char* a1 = cA + (size_t)(t + 1) * kstep;
            const char* a2 = last ? nA : cA + (size_t)(t + 2) * kstep; const char* b2 = last ? nB : cB + (size_t)(t + 2) * kstep;
            const char* a3 = a2 + kstep; const char* b3 = b2 + kstep;
            if (last && has_next) S.a_ready(nxt);
            if constexpr (SP2) {
            PG8_LDB(B0, 0, 0); PG8_LDB(B1, 0, 1); PG8_SCHED; PG8_LDA(At, 0, 0); PG8_STAGE(PG8_SA(1, 1), a1 + hstep, voffA);
            PG8_WAIT_V(8); PG8_WAIT_L(0); PG8_BAR; PG8_MMA(0, 0, At, B0); PG8_MMA(0, 1, At, B1); PG8_BAR; PG8_SCHED;
            PG8_LDA(At, 0, 1); PG8_STAGE(PG8_SB(0, 0), b2, voffB); PG8_STAGE(PG8_SB(0, 1), b2 + hstep, voffB); PG8_STAGE(PG8_SA(0, 0), a2, voffA);
            PG8_WAIT_V(8); PG8_WAIT_L(0); PG8_BAR; PG8_MMA(1, 0, At, B0); PG8_MMA(1, 1, At, B1); PG8_BAR; PG8_SCHED;
            PG8_LDB(B0, 1, 0); PG8_LDB(B1, 1, 1); PG8_SCHED; PG8_LDA(At, 1, 0); PG8_STAGE(PG8_SA(0, 1), a2 + hstep, voffA);
            PG8_WAIT_V(8); PG8_WAIT_L(0); PG8_BAR; PG8_MMA(0, 0, At, B0); PG8_MMA(0, 1, At, B1); PG8_BAR; PG8_SCHED;
            PG8_LDA(At, 1, 1); PG8_STAGE(PG8_SB(1, 0), b3, voffB); PG8_STAGE(PG8_SB(1, 1), b3 + hstep, voffB); PG8_STAGE(PG8_SA(1, 0), a3, voffA);
            PG8_WAIT_V(8); PG8_WAIT_L(0); PG8_BAR; PG8_MMA(1, 0, At, B0); PG8_MMA(1, 1, At, B1); PG8_BAR; PG8_SCHED;
            } else {
            PG8_LDB(B0, 0, 0); PG8_SCHED; PG8_LDA(At, 0, 0); PG8_STAGE(PG8_SA(1, 1), a1 + hstep, voffA);
            PG8_WAIT_L(8); PG8_BAR; PG8_WAIT_L(0); PG8_MMA(0, 0, At, B0); PG8_BAR; PG8_SCHED;
            PG8_LDB(B1, 0, 1); PG8_STAGE(PG8_SB(0, 0), b2, voffB);
            PG8_BAR; PG8_WAIT_L(0); PG8_MMA(0, 1, At, B1); PG8_BAR;
            PG8_LDA(At, 0, 1); PG8_STAGE(PG8_SA(0, 0), a2, voffA);
            PG8_BAR; PG8_WAIT_L(0); PG8_MMA(1, 0, At, B0); PG8_BAR; PG8_SCHED;
            PG8_STAGE(PG8_SB(0, 1), b2 + hstep, voffB);
            PG8_WAIT_V(6); PG8_BAR; PG8_MMA(1, 1, At, B1); PG8_BAR;
            PG8_LDB(B0, 1, 0); PG8_SCHED; PG8_LDA(At, 1, 0); PG8_STAGE(PG8_SA(0, 1), a2 + hstep, voffA);
            PG8_WAIT_L(8); PG8_BAR; PG8_WAIT_L(0); PG8_MMA(0, 0, At, B0); PG8_BAR; PG8_SCHED;
            PG8_LDB(B1, 1, 1); PG8_STAGE(PG8_SB(1, 0), b3, voffB);
            PG8_BAR; PG8_WAIT_L(0); PG8_MMA(0, 1, At, B1); PG8_BAR;
            PG8_LDA(At, 1, 1); PG8_STAGE(PG8_SA(1, 0), a3, voffA);
            PG8_BAR; PG8_WAIT_L(0); PG8_MMA(1, 0, At, B0); PG8_BAR; PG8_SCHED;
            PG8_STAGE(PG8_SB(1, 1), b3 + hstep, voffB);
            PG8_WAIT_V(6); PG8_BAR; PG8_MMA(1, 1, At, B1); PG8_BAR;
            }
        }
        if constexpr (ALIGN_EPI) { if (wr == 0) PG8_BAR; }
        if constexpr (!Epi::AFTER_DRAIN) { E(acc, cur, wr, wc, fr, fq); S.done(cur); }
        if (!has_next) break;
#pragma unroll
        for (int a = 0; a < 2; ++a)
#pragma unroll
            for (int b = 0; b < 2; ++b)
#pragma unroll
                for (int m = 0; m < 4; ++m)
#pragma unroll
                    for (int n = 0; n < 2; ++n) acc[a][b][m][n] = (f32x4){0.f, 0.f, 0.f, 0.f};
        cur = nxt; cA = nA; cB = nB; ++ui;
        if constexpr (ALIGN_EPI) { if (wr == 1) PG8_BAR; }
    }
    PG8_WAIT_V(0);
    if constexpr (!ALIGN_EPI) { if (wr == 0) PG8_BAR; }
    PG8_BAR;
    if constexpr (Epi::AFTER_DRAIN) { E.fused(acc, cur, wr, wc, fr, fq, lds, wid, lane); S.done(cur); }
#undef PG8_SA
#undef PG8_SB
#undef PG8_STAGE
#undef PG8_LDA
#undef PG8_LDB
#undef PG8_MMA
#undef PG8_WAIT_V
#undef PG8_WAIT_L
#undef PG8_BAR
#undef PG8_SCHED
}
}

#define LAS __attribute__((address_space(3)))
typedef unsigned short bf16;
typedef float f32x2 __attribute__((ext_vector_type(2)));
typedef float f32x4 __attribute__((ext_vector_type(4)));
typedef unsigned u32x2 __attribute__((ext_vector_type(2)));
typedef unsigned u32x4 __attribute__((ext_vector_type(4)));

constexpr int NTOK = 32768, DM = 1024, DIN = 2560, SEQ = 8192, NBATCH = 4, NMETA = 16;
constexpr int NHEAD = 8, NKEYS = 128, TOPK = 16, NSEL = NHEAD * TOPK;
constexpr float EPS = 1e-6f;
constexpr float U_SCALE = 64.f, V_SCALE = 16.f;
constexpr int NWAVES = 8, NTHREADS = 512;
constexpr int LDS_BYTES = 147456;

constexpr size_t MiB = 1u << 20;
constexpr size_t WS_CTL = 0, WS_WIN_T = 1 * MiB, WS_WOUT_T = 6 * MiB, WS_WQ_T = 8 * MiB, WS_KEYS = 12 * MiB, WS_METAPART = 13 * MiB,
                 WS_METARSTD = 14 * MiB + 512 * 1024, WS_METAPROJ = 14 * MiB + 576 * 1024, WS_RSTD1 = 15 * MiB, WS_SSQ = 16 * MiB, WS_U8 = 32 * MiB, WS_V8 = 48 * MiB,
                 WS_IDX = 64 * MiB, WS_GATE = 80 * MiB, WS_H0B = 96 * MiB, WS_H2B = 96 * MiB, WS_Y = 160 * MiB, WS_PROJ = 224 * MiB,
                 WS_Q = 224 * MiB, WS_END = 384 * MiB;

struct Params {
    const float* x; const float* meta; const float* g_mix; const float* w_in; const float* sc_w; const float* cf_w; const float* cf_b;
    const float* ln_g; const float* ln_b; const float* g_sc; const float* g_cf; const float* w_out; const float* g_ffn; const float* w_q;
    const float* keys; const float* pu; const float* pv; const float* g_fin;
    float* out; unsigned char* ws;
    int ph_lo, ph_hi, coop, pad;
};

__device__ __forceinline__ unsigned f2bf(float f) { unsigned u = __builtin_bit_cast(unsigned, f); return (u + 0x7fffu + ((u >> 16) & 1u)) >> 16; }
__device__ __forceinline__ unsigned pk2(float lo, float hi) { return f2bf(lo) | (f2bf(hi) << 16); }
__device__ __forceinline__ float bf2f(unsigned b) { return __builtin_bit_cast(float, b << 16); }
__device__ __forceinline__ float bflo(unsigned w) { return __builtin_bit_cast(float, w << 16); }
__device__ __forceinline__ float bfhi(unsigned w) { return __builtin_bit_cast(float, w & 0xffff0000u); }
__device__ __forceinline__ float wave_sum(float v) {
#pragma unroll
    for (int o = 1; o < 64; o <<= 1) v += __shfl_xor(v, o);
    return v;
}
__device__ __forceinline__ float sigmoid_f(float x) { return 1.f / (1.f + __expf(-x)); }
__device__ __forceinline__ float gelu_tanh_f(float x) {
    const float t = 0.7978845608028654f * (x + 0.044715f * x * x * x);
    const float e = __expf(2.f * t);
    const float th = 1.f - 2.f / (e + 1.f);
    return 0.5f * x * (1.f + th);
}

__device__ __forceinline__ unsigned cvt_pk_bf16(float lo, float hi) { unsigned r; asm volatile("v_cvt_pk_bf16_f32 %0, %1, %2" : "=v"(r) : "v"(lo), "v"(hi)); return r; }

template <int MODE> struct EpiRowScale {
    static constexpr bool PERM = true, AFTER_DRAIN = false;
    bf16* O; int ldc; const float* rs;
    __device__ __forceinline__ void operator()(const pg8::f32x4 (&acc)[2][2][4][2], const pg8::Unit& u, int wr, int wc, int fr, int fq) const {
        const int row0 = u.pm * 256 + wr * 64 + fr, col0 = u.pn * 256 + wc * 32 + 8 * fq;
#pragma unroll
        for (int ai = 0; ai < 2; ++ai)
#pragma unroll
            for (int m = 0; m < 4; ++m) {
                const int row = row0 + ai * 128 + m * 16;
                float s;
                if (MODE == 0) s = rs[row];
                else { const f32x4* p = (const f32x4*)(rs + (size_t)row * 16); const f32x4 a = p[0], b = p[1], c = p[2], d = p[3];
                       const float t = ((a.x + a.y) + (a.z + a.w)) + ((b.x + b.y) + (b.z + b.w)) + ((c.x + c.y) + (c.z + c.w)) + ((d.x + d.y) + (d.z + d.w));
                       s = rsqrtf(t * (1.f / 1024.f) + EPS); }
                bf16* rowp = O + (size_t)row * ldc + col0;
#pragma unroll
                for (int bj = 0; bj < 2; ++bj) { const pg8::f32x4 v0 = acc[ai][bj][m][0] * s, v1 = acc[ai][bj][m][1] * s;
                    u32x4 w; w.x = cvt_pk_bf16(v0[0], v0[1]); w.y = cvt_pk_bf16(v0[2], v0[3]); w.z = cvt_pk_bf16(v1[0], v1[1]); w.w = cvt_pk_bf16(v1[2], v1[3]);
                    *(u32x4*)(rowp + bj * 128) = w; }
            }
    }
};
struct EpiResidual {
    static constexpr bool PERM = true, AFTER_DRAIN = false;
    bf16* O; const float* X; float* ssq;
    __device__ __forceinline__ void operator()(const pg8::f32x4 (&acc)[2][2][4][2], const pg8::Unit& u, int wr, int wc, int fr, int fq) const {
        const int row0 = u.pm * 256 + wr * 64 + fr, col0 = u.pn * 256 + wc * 32 + 8 * fq;
#pragma unroll
        for (int ai = 0; ai < 2; ++ai)
#pragma unroll
            for (int m = 0; m < 4; ++m) {
                const int row = row0 + ai * 128 + m * 16;
                const float* xr = X + (size_t)row * DM + col0; bf16* rowp = O + (size_t)row * DM + col0;
                float q = 0.f;
#pragma unroll
                for (int bj = 0; bj < 2; ++bj) { const f32x4 x0 = *(const f32x4*)(xr + bj * 128), x1 = *(const f32x4*)(xr + bj * 128 + 4);
                    const pg8::f32x4 v0 = acc[ai][bj][m][0] + x0, v1 = acc[ai][bj][m][1] + x1;
                    q += (v0[0] * v0[0] + v0[1] * v0[1]) + (v0[2] * v0[2] + v0[3] * v0[3]) + (v1[0] * v1[0] + v1[1] * v1[1]) + (v1[2] * v1[2] + v1[3] * v1[3]);
                    u32x4 w; w.x = cvt_pk_bf16(v0[0], v0[1]); w.y = cvt_pk_bf16(v0[2], v0[3]); w.z = cvt_pk_bf16(v1[0], v1[1]); w.w = cvt_pk_bf16(v1[2], v1[3]);
                    *(u32x4*)(rowp + bj * 128) = w; }
                q += __shfl_xor(q, 16); q += __shfl_xor(q, 32);
                if (fq == 0) ssq[(size_t)row * 16 + u.pn * 4 + wc] = q;
            }
    }
};

__device__ __forceinline__ void p0_transpose_item(const float* W, int K, int N, bf16* WT, LAS float* scr, int item, int lane,
                                                  const float* g_lo, const float* g_hi, int split) {
    const int nblk = N / 32, kb = item / nblk, nb = item % nblk, k0 = 64 * kb, n0 = 32 * nb;
#pragma unroll 8
    for (int i = 0; i < 32; ++i) { const int kk = 2 * i + (lane >> 5); const int k = k0 + kk;
        const float g = (k < split) ? g_lo[k] : g_hi[k - split];
        scr[kk * 33 + (lane & 31)] = W[(size_t)k * N + n0 + (lane & 31)] * g; }
    asm volatile("s_waitcnt lgkmcnt(0)" ::: "memory");
    const int c = lane & 7;
#pragma unroll
    for (int j = 0; j < 4; ++j) { const int n = (lane >> 3) + 8 * j; const LAS float* s = scr + (8 * c) * 33 + n;
        u32x4 o; o.x = pk2(s[0 * 33], s[1 * 33]); o.y = pk2(s[2 * 33], s[3 * 33]); o.z = pk2(s[4 * 33], s[5 * 33]); o.w = pk2(s[6 * 33], s[7 * 33]);
        *(u32x4*)(WT + (size_t)(n0 + n) * K + k0 + 8 * c) = o; }
    asm volatile("s_waitcnt lgkmcnt(0)" ::: "memory");
}

__device__ __forceinline__ void phase_prep(const Params& P, LAS unsigned char* lds) {
    const int tid = threadIdx.x, lane = tid & 63, wave = __builtin_amdgcn_readfirstlane(tid >> 6);
    const int gw = blockIdx.x * NWAVES + wave, NGW = gridDim.x * NWAVES;
    unsigned char* ws = P.ws;
    LAS float* scr = (LAS float*)(lds + wave * 16384);
    constexpr int I_IN = (DM / 64) * (DIN / 32), I_OUT = (DM / 64) * (DM / 32), I_Q = (DM / 64) * (2048 / 32);
    for (int it = gw; it < I_IN + I_OUT + I_Q; it += NGW) {
        int r = it;
        if (r < I_IN) { p0_transpose_item(P.w_in, DM, DIN, (bf16*)(ws + WS_WIN_T), scr, r, lane, P.g_mix, P.g_mix, DM); continue; } r -= I_IN;
        if (r < I_OUT) { p0_transpose_item(P.w_out, DM, DM, (bf16*)(ws + WS_WOUT_T), scr, r, lane, P.g_sc, P.g_cf, 512); continue; } r -= I_OUT;
        p0_transpose_item(P.w_q, DM, 2048, (bf16*)(ws + WS_WQ_T), scr, r, lane, P.g_ffn, P.g_ffn, DM);
    }
    {
        bf16* H0B = (bf16*)(ws + WS_H0B); float* RSTD1 = (float*)(ws + WS_RSTD1);
        for (int t = gw; t < NTOK; t += NGW) {
            const f32x4* xr = (const f32x4*)(P.x + (size_t)t * DM) + lane;
            f32x4 v[4]; float s = 0.f;
#pragma unroll
            for (int j = 0; j < 4; ++j) { v[j] = xr[64 * j]; s += (v[j].x * v[j].x + v[j].y * v[j].y) + (v[j].z * v[j].z + v[j].w * v[j].w); }
            s = wave_sum(s);
            if (lane == 0) RSTD1[t] = rsqrtf(s * (1.f / DM) + EPS);
            u32x2* o = (u32x2*)(H0B + (size_t)t * DM) + lane;
#pragma unroll
            for (int j = 0; j < 4; ++j) { u32x2 w; w.x = pk2(v[j].x, v[j].y); w.y = pk2(v[j].z, v[j].w); o[64 * j] = w; }
        }
    }
    {
        unsigned char* U8 = ws + WS_U8; unsigned char* V8 = ws + WS_V8;
        f32x4 gf[4];
#pragma unroll
        for (int j = 0; j < 4; ++j) gf[j] = ((const f32x4*)P.g_ffn)[64 * j + lane] * U_SCALE;
        for (int e = gw; e < 2 * 16384; e += NGW) {
            const bool isv = e >= 16384; const int ee = isv ? e - 16384 : e;
            const f32x4* src = (const f32x4*)((isv ? P.pv : P.pu) + (size_t)ee * DM) + lane;
            u32x4 o; unsigned ow[4];
#pragma unroll
            for (int j = 0; j < 4; ++j) { f32x4 v = src[64 * j]; if (isv) v = v * V_SCALE; else v = v * gf[j];
                int p = __builtin_amdgcn_cvt_pk_fp8_f32(v.x, v.y, 0, false); p = __builtin_amdgcn_cvt_pk_fp8_f32(v.z, v.w, p, true); ow[j] = (unsigned)p; }
            o.x = ow[0]; o.y = ow[1]; o.z = ow[2]; o.w = ow[3];
            *(u32x4*)((isv ? V8 : U8) + (size_t)ee * DM + 16 * lane) = o;
        }
    }
    {
        bf16* KB = (bf16*)(ws + WS_KEYS);
        const int gt = blockIdx.x * NTHREADS + tid, NGT = gridDim.x * NTHREADS;
        for (int i = gt; i < 8 * 2 * 128 * 128 / 4; i += NGT) { const f32x4 v = ((const f32x4*)P.keys)[i]; u32x2 w; w.x = pk2(v.x, v.y); w.y = pk2(v.z, v.w); ((u32x2*)KB)[i] = w; }
    }
    {
        float* MP = (float*)(ws + WS_METAPART); float* MR = (float*)(ws + WS_METARSTD);
        for (int r = gw; r < NMETA; r += NGW) {
            float s = 0.f;
            for (int k = lane; k < DM; k += 64) { const float v = P.meta[r * DM + k]; s += v * v; }
            s = wave_sum(s);
            if (lane == 0) MR[r] = rsqrtf(s * (1.f / DM) + EPS);
        }
        for (int it = gw; it < 8 * 40; it += NGW) {
            const int kc = it / 40, nb = it % 40, n = nb * 64 + lane;
            float acc[NMETA];
#pragma unroll
            for (int r = 0; r < NMETA; ++r) acc[r] = 0.f;
            for (int k = kc * 128; k < kc * 128 + 128; ++k) {
                const float w = P.w_in[(size_t)k * DIN + n] * P.g_mix[k];
#pragma unroll
                for (int r = 0; r < NMETA; ++r) acc[r] += P.meta[r * DM + k] * w;
            }
#pragma unroll
            for (int r = 0; r < NMETA; ++r) MP[(size_t)(kc * 16 + r) * DIN + n] = acc[r];
        }
    }
}

__device__ __forceinline__ void phase_metaproj(const Params& P) {
    const float* MP = (const float*)(P.ws + WS_METAPART); const float* MR = (const float*)(P.ws + WS_METARSTD); float* MJ = (float*)(P.ws + WS_METAPROJ);
    const int gt = blockIdx.x * NTHREADS + threadIdx.x;
    if (gt < NMETA * DIN) { const int p = gt / DIN, col = gt % DIN; float s = 0.f;
#pragma unroll
        for (int kc = 0; kc < 8; ++kc) s += MP[(size_t)(kc * 16 + p) * DIN + col];
        MJ[gt] = s * MR[p]; }
}
__device__ __forceinline__ float meta_val(const float* MJ, const float*, int p, int col) { return MJ[p * DIN + col]; }
__device__ __forceinline__ float proj_at(const bf16* PROJ, const float* MP, const float* MR, int b, int pos, int col) {
    if (pos < 0) return 0.f;
    if (pos < NMETA) return meta_val(MP, MR, pos, col);
    return bf2f(PROJ[(size_t)(b * SEQ + pos - NMETA) * DIN + col]);
}
__device__ __forceinline__ void proj8_at(const bf16* PROJ, const float* MP, const float* MR, int b, int pos, int col, float (&v)[8]) {
    if (pos < 0) {
#pragma unroll
        for (int i = 0; i < 8; ++i) v[i] = 0.f;
    } else if (pos < NMETA) {
        const f32x4 a = *(const f32x4*)(MP + pos * DIN + col), bq = *(const f32x4*)(MP + pos * DIN + col + 4);
        v[0] = a.x; v[1] = a.y; v[2] = a.z; v[3] = a.w; v[4] = bq.x; v[5] = bq.y; v[6] = bq.z; v[7] = bq.w;
    } else {
        const u32x4 w = *(const u32x4*)(PROJ + (size_t)(b * SEQ + pos - NMETA) * DIN + col);
        v[0] = bflo(w.x); v[1] = bfhi(w.x); v[2] = bflo(w.y); v[3] = bfhi(w.y); v[4] = bflo(w.z); v[5] = bfhi(w.z); v[6] = bflo(w.w); v[7] = bfhi(w.w);
    }
}

__device__ __forceinline__ void phase_conv(const Params& P, LAS unsigned char* lds) {
    const int tid = threadIdx.x, lane = tid & 63, wave = __builtin_amdgcn_readfirstlane(tid >> 6);
    unsigned char* ws = P.ws;
    const bf16* PROJ = (const bf16*)(ws + WS_PROJ); const float* MP = (const float*)(ws + WS_METAPROJ); const float* MR = nullptr;
    bf16* Y = (bf16*)(ws + WS_Y);
    LAS float* U = (LAS float*)lds;
    constexpr int TT = 32, NTILE = NTOK / TT;
    const int c = tid;
    float wcf[31];
#pragma unroll
    for (int j = 0; j < 31; ++j) wcf[j] = P.cf_w[j * 512 + c];
    const float bcf = P.cf_b[c];
    float lng[8], lnb[8], wsc[3][8];
#pragma unroll
    for (int i = 0; i < 8; ++i) { lng[i] = P.ln_g[8 * lane + i]; lnb[i] = P.ln_b[8 * lane + i];
#pragma unroll
        for (int j = 0; j < 3; ++j) wsc[j][i] = P.sc_w[j * 512 + 8 * lane + i]; }
    for (int tile = blockIdx.x; tile < NTILE; tile += gridDim.x) {
        const int b = tile / (SEQ / TT), s0 = (tile % (SEQ / TT)) * TT;
#pragma unroll 2
        for (int r = 0; r < TT + 30; ++r) {
            const int pos = NMETA + s0 - 30 + r;
            const float ga = proj_at(PROJ, MP, MR, b, pos, 1536 + c), gg = proj_at(PROJ, MP, MR, b, pos, 2048 + c);
            U[r * 512 + c] = ga * sigmoid_f(gg);
        }
#pragma unroll 1
        for (int ii = 0; ii < TT; ++ii) {
            float o = bcf;
#pragma unroll
            for (int j = 0; j < 31; ++j) o += wcf[j] * U[(ii + j) * 512 + c];
            U[ii * 512 + c] = o;
        }
        __syncthreads();
#pragma unroll 1
        for (int q = 0; q < 4; ++q) {
            const int ii = 4 * wave + q, s = s0 + ii; const size_t t = (size_t)b * SEQ + s;
            float o[8];
            { const f32x4 a = *(const LAS f32x4*)(U + ii * 512 + 8 * lane), bq = *(const LAS f32x4*)(U + ii * 512 + 8 * lane + 4);
              o[0] = a.x; o[1] = a.y; o[2] = a.z; o[3] = a.w; o[4] = bq.x; o[5] = bq.y; o[6] = bq.z; o[7] = bq.w; }
            float s1 = 0.f;
#pragma unroll
            for (int i = 0; i < 8; ++i) s1 += o[i];
            const float mean = wave_sum(s1) * (1.f / 512.f);
            float s2 = 0.f;
#pragma unroll
            for (int i = 0; i < 8; ++i) { o[i] -= mean; s2 += o[i] * o[i]; }
            const float rs = rsqrtf(wave_sum(s2) * (1.f / 512.f) + EPS);
            float s3 = 0.f;
#pragma unroll
            for (int i = 0; i < 8; ++i) { float y = o[i] * rs * lng[i] + lnb[i]; y = y * sigmoid_f(y); o[i] = y; s3 += y * y; }
            const float r2 = rsqrtf(wave_sum(s3) * (1.f / 512.f) + EPS);
            u32x4 wv; wv.x = pk2(o[0] * r2, o[1] * r2); wv.y = pk2(o[2] * r2, o[3] * r2); wv.z = pk2(o[4] * r2, o[5] * r2); wv.w = pk2(o[6] * r2, o[7] * r2);
            *(u32x4*)(Y + t * DM + 512 + 8 * lane) = wv;
            float accs[8];
#pragma unroll
            for (int i = 0; i < 8; ++i) accs[i] = 0.f;
#pragma unroll
            for (int j = 0; j < 3; ++j) {
                const int pos = NMETA + s - 2 + j; float xv[8], cgv[8];
                proj8_at(PROJ, MP, MR, b, pos, 8 * lane, xv); proj8_at(PROJ, MP, MR, b, pos, 1024 + 8 * lane, cgv);
#pragma unroll
                for (int i = 0; i < 8; ++i) accs[i] += wsc[j][i] * (xv[i] * cgv[i]);
            }
            float bgv[8]; proj8_at(PROJ, MP, MR, b, NMETA + s, 512 + 8 * lane, bgv);
            float s4 = 0.f;
#pragma unroll
            for (int i = 0; i < 8; ++i) { accs[i] *= bgv[i]; s4 += accs[i] * accs[i]; }
            const float r4 = rsqrtf(wave_sum(s4) * (1.f / 512.f) + EPS);
            u32x4 wz; wz.x = pk2(accs[0] * r4, accs[1] * r4); wz.y = pk2(accs[2] * r4, accs[3] * r4); wz.z = pk2(accs[4] * r4, accs[5] * r4); wz.w = pk2(accs[6] * r4, accs[7] * r4);
            *(u32x4*)(Y + t * DM + 8 * lane) = wz;
        }
        __syncthreads();
    }
}

__device__ __forceinline__ int ord_i(float s) { int k = __builtin_bit_cast(int, s); k ^= (k >> 31) & 0x7fffffff; return k; }
__device__ __forceinline__ float unord_f(int k) { k ^= (k >> 31) & 0x7fffffff; return __builtin_bit_cast(float, k); }
#define TOP_INSERT(L, x_) do { int _x = (x_); _Pragma("unroll") for (int _i = 0; _i < 16; ++_i) { const int _hi = max(L[_i], _x); _x = min(L[_i], _x); L[_i] = _hi; } } while (0)

typedef short bf16x8 __attribute__((ext_vector_type(8)));
typedef float f32x16 __attribute__((ext_vector_type(16)));
template <bool DESC> __device__ __forceinline__ void ce_i(int& a, int& b) { const int hi = max(a, b), lo = min(a, b); if (DESC) { a = hi; b = lo; } else { a = lo; b = hi; } }
__device__ __forceinline__ void bitonic_sort16(int (&a)[16]) {
#pragma unroll
    for (int k = 2; k <= 16; k <<= 1)
#pragma unroll
        for (int j = k >> 1; j > 0; j >>= 1)
#pragma unroll
            for (int i = 0; i < 16; ++i) { const int l = i ^ j; if (l > i) { if ((i & k) == 0) ce_i<true>(a[i], a[l]); else ce_i<false>(a[i], a[l]); } }
}
__device__ __forceinline__ void bitonic_merge16(int (&a)[16]) {
#pragma unroll
    for (int j = 8; j > 0; j >>= 1)
#pragma unroll
        for (int i = 0; i < 16; ++i) { const int l = i ^ j; if (l > i) ce_i<true>(a[i], a[l]); }
}
__device__ __forceinline__ void merge_top16(int (&a)[16], const int (&b)[16]) {
#pragma unroll
    for (int i = 0; i < 16; ++i) a[i] = max(a[i], b[15 - i]);
    bitonic_merge16(a);
}
__device__ __forceinline__ int lut16(const unsigned (&T)[4], int i) {
    const unsigned sel = (unsigned)(i & 7) | 0x0c0c0c00u;
    const unsigned lo = __builtin_amdgcn_perm(T[1], T[0], sel), hi = __builtin_amdgcn_perm(T[3], T[2], sel);
    return (int)((i & 8) ? hi : lo);
}
constexpr int KROW = 272;
constexpr float SCORE_BIAS = 8.0f;

__device__ __forceinline__ void route_half(const LAS unsigned char* kl, const bf16* qrow, int nl, int hb, int (&L)[16]) {
    bf16x8 qf[8];
#pragma unroll
    for (int ks = 0; ks < 8; ++ks) qf[ks] = *(const bf16x8*)(qrow + 64 * hb + 8 * ks);
    f32x16 acc[4];
#pragma unroll
    for (int nt = 0; nt < 4; ++nt)
#pragma unroll
        for (int r = 0; r < 16; ++r) acc[nt][r] = SCORE_BIAS;
#pragma unroll
    for (int ks = 0; ks < 8; ++ks)
#pragma unroll
        for (int nt = 0; nt < 4; ++nt) {
            const bf16x8 a = *(const LAS bf16x8*)(kl + (32 * nt + nl) * KROW + (64 * hb + 8 * ks) * 2);
            acc[nt] = __builtin_amdgcn_mfma_f32_32x32x16_bf16(a, qf[ks], acc[nt], 0, 0, 0);
        }
    const int hb4 = 4 * hb;
    int T[4][16];
#pragma unroll
    for (int nt = 0; nt < 4; ++nt)
#pragma unroll
        for (int r = 0; r < 16; ++r) { const int n0 = 32 * nt + (r & 3) + 8 * (r >> 2); const float sc = acc[nt][r];
            T[nt][r] = (__float_as_int(sc) & ~127) | ((127 - n0) - hb4); }
    bitonic_sort16(T[0]); bitonic_sort16(T[1]); bitonic_sort16(T[2]); bitonic_sort16(T[3]);
    merge_top16(T[0], T[1]); merge_top16(T[2], T[3]); merge_top16(T[0], T[2]);
#pragma unroll
    for (int i = 0; i < 16; ++i) { const unsigned v = (unsigned)T[0][15 - i]; auto r = __builtin_amdgcn_permlane32_swap(v, v, false, false);
        const unsigned r0 = r[0], r1 = r[1]; const int partner = (int)(hb ? r0 : r1); L[i] = max(T[0][i], partner); }
    bitonic_merge16(L);
}

__device__ __forceinline__ void phase_route(const Params& P, LAS unsigned char* lds) {
    const int tid = threadIdx.x, lane = tid & 63, wave = __builtin_amdgcn_readfirstlane(tid >> 6);
    const int nl = lane & 31, hb = lane >> 5;
    unsigned char* ws = P.ws;
    const bf16* KEYS = (const bf16*)(ws + WS_KEYS); const bf16* Q = (const bf16*)(ws + WS_Q);
    int* IDX = (int*)(ws + WS_IDX); float* GATE = (float*)(ws + WS_GATE);
    int last_h = -1;
    for (int unit = blockIdx.x; unit < (NTOK / 256) * NHEAD; unit += gridDim.x) {
        const int h = unit & 7, tb = unit >> 3;
        if (h != last_h) {
            __syncthreads();
            for (int c = tid; c < 4096; c += NTHREADS) { const u32x4 v = ((const u32x4*)(KEYS + (size_t)h * 32768))[c];
                *(LAS u32x4*)(lds + (c >> 4) * KROW + (c & 15) * 16) = v; }
            __syncthreads();
            last_h = h;
        }
        const size_t t = (size_t)tb * 256 + wave * 32 + nl;
        int L1[16], L2[16];
        route_half(lds, Q + t * 2048 + h * 256, nl, hb, L1);
        route_half(lds + 128 * KROW, Q + t * 2048 + h * 256 + 128, nl, hb, L2);
        float v1[16], v2[16];
#pragma unroll
        for (int i = 0; i < 16; ++i) { v1[i] = __int_as_float(L1[i] & ~127); v2[i] = __int_as_float(L2[i] & ~127); }
#define CAND(i, j) ((__float_as_int(v1[i] + v2[j]) & ~255) | (255 - (16 * (i) + (j))))
        int A[16], B[16], C[16];
#pragma unroll
        for (int j = 0; j < 16; ++j) A[j] = CAND(0, j);
#pragma unroll
        for (int j = 0; j < 8; ++j) { B[j] = CAND(1, j); B[8 + j] = CAND(15 - j, 0); }
        bitonic_merge16(B);
        C[0] = CAND(2, 0); C[1] = CAND(2, 1); C[2] = CAND(2, 2); C[3] = CAND(2, 3); C[4] = CAND(2, 4);
        C[5] = CAND(3, 0); C[6] = CAND(3, 1); C[7] = CAND(3, 2); C[8] = CAND(3, 3);
        C[9] = CAND(4, 0); C[10] = CAND(4, 1); C[11] = CAND(4, 2);
        C[12] = CAND(5, 0); C[13] = CAND(5, 1); C[14] = CAND(6, 0); C[15] = CAND(6, 1);
        bitonic_sort16(C);
        { const int d0 = CAND(7, 0), d1 = CAND(7, 1); C[14] = max(C[14], d1); C[15] = max(C[15], d0); bitonic_merge16(C); }
#undef CAND
        merge_top16(A, B); merge_top16(A, C);
        unsigned T1[4], T2[4];
#pragma unroll
        for (int q = 0; q < 4; ++q) {
            T1[q] = (unsigned)(127 - (L1[4 * q] & 127)) | ((unsigned)(127 - (L1[4 * q + 1] & 127)) << 8) | ((unsigned)(127 - (L1[4 * q + 2] & 127)) << 16) | ((unsigned)(127 - (L1[4 * q + 3] & 127)) << 24);
            T2[q] = (unsigned)(127 - (L2[4 * q] & 127)) | ((unsigned)(127 - (L2[4 * q + 1] & 127)) << 8) | ((unsigned)(127 - (L2[4 * q + 2] & 127)) << 16) | ((unsigned)(127 - (L2[4 * q + 3] & 127)) << 24); }
        float val[16]; int ex[16];
#pragma unroll
        for (int k = 0; k < 16; ++k) { const int pos = 255 - (A[k] & 255); val[k] = __int_as_float(A[k] & ~255);
            ex[k] = lut16(T1, pos >> 4) * NKEYS + lut16(T2, pos & 15); }
        float sum = 0.f; const float vmax = val[0];
#pragma unroll
        for (int k = 0; k < 16; ++k) { val[k] = __expf(val[k] - vmax); sum += val[k]; }
        const float inv = 1.f / sum;
        if (hb == 0) {
            int* ip = IDX + t * NSEL + h * TOPK; float* gp = GATE + t * NSEL + h * TOPK;
#pragma unroll
            for (int k4 = 0; k4 < 4; ++k4) {
                *(int4*)(ip + 4 * k4) = make_int4(ex[4 * k4], ex[4 * k4 + 1], ex[4 * k4 + 2], ex[4 * k4 + 3]);
                *(f32x4*)(gp + 4 * k4) = (f32x4){val[4 * k4] * inv, val[4 * k4 + 1] * inv, val[4 * k4 + 2] * inv, val[4 * k4 + 3] * inv};
            }
        }
    }
}

__device__ __forceinline__ float dot16_fp8(const u32x4 r, const f32x4 (&xs)[4]) {
    float p = 0.f;
    const unsigned rw[4] = {r.x, r.y, r.z, r.w};
#pragma unroll
    for (int j = 0; j < 4; ++j) { const f32x2 lo = __builtin_amdgcn_cvt_pk_f32_fp8((int)rw[j], false), hi = __builtin_amdgcn_cvt_pk_f32_fp8((int)rw[j], true);
        p += (lo.x * xs[j].x + lo.y * xs[j].y) + (hi.x * xs[j].z + hi.y * xs[j].w); }
    return p;
}
__device__ __forceinline__ void axpy16_fp8(const u32x4 r, float w, f32x4 (&o)[4]) {
    const unsigned rw[4] = {r.x, r.y, r.z, r.w};
#pragma unroll
    for (int j = 0; j < 4; ++j) { const f32x2 lo = __builtin_amdgcn_cvt_pk_f32_fp8((int)rw[j], false), hi = __builtin_amdgcn_cvt_pk_f32_fp8((int)rw[j], true);
        o[j].x += w * lo.x; o[j].y += w * lo.y; o[j].z += w * hi.x; o[j].w += w * hi.y; }
}
__device__ __forceinline__ void phase_gather(const Params& P, LAS unsigned char* lds) {
    const int tid = threadIdx.x, lane = tid & 63, wave = __builtin_amdgcn_readfirstlane(tid >> 6);
    const int gw = blockIdx.x * NWAVES + wave, NGW = gridDim.x * NWAVES;
    unsigned char* ws = P.ws;
    const int* IDX = (const int*)(ws + WS_IDX); const float* GATE = (const float*)(ws + WS_GATE);
    const unsigned char* U8 = ws + WS_U8; const unsigned char* V8 = ws + WS_V8;
    const bf16* H2B = (const bf16*)(ws + WS_H2B); const float* SSQ = (const float*)(ws + WS_SSQ);
    f32x4 gfin[4];
#pragma unroll
    for (int j = 0; j < 4; ++j) gfin[j] = ((const f32x4*)P.g_fin)[64 * j + lane];
    for (int t = gw; t < NTOK; t += NGW) {
        const int idx0 = IDX[(size_t)t * NSEL + lane], idx1 = IDX[(size_t)t * NSEL + 64 + lane];
        const float g0 = GATE[(size_t)t * NSEL + lane], g1 = GATE[(size_t)t * NSEL + 64 + lane];
        float sq = (lane < 16) ? SSQ[(size_t)t * 16 + lane] : 0.f; sq = wave_sum(sq);
        const float rstd2 = rsqrtf(sq * (1.f / DM) + EPS);
        f32x4 xs[4];
#pragma unroll
        for (int j = 0; j < 4; ++j) { const u32x2 w = ((const u32x2*)(H2B + (size_t)t * DM))[64 * j + lane]; xs[j] = (f32x4){bflo(w.x), bfhi(w.x), bflo(w.y), bfhi(w.y)}; }
        float z0 = 0.f, z1 = 0.f;
#pragma unroll 8
        for (int k = 0; k < 64; ++k) { const int e = __builtin_amdgcn_readlane(idx0, k);
            const u32x4 r = *(const u32x4*)(U8 + (size_t)e * DM + 16 * lane);
            const float p = wave_sum(dot16_fp8(r, xs)); z0 = (lane == k) ? p : z0; }
#pragma unroll 8
        for (int k = 0; k < 64; ++k) { const int e = __builtin_amdgcn_readlane(idx1, k);
            const u32x4 r = *(const u32x4*)(U8 + (size_t)e * DM + 16 * lane);
            const float p = wave_sum(dot16_fp8(r, xs)); z1 = (lane == k) ? p : z1; }
        const float zs = rstd2 * (1.f / U_SCALE);
        const float a0 = gelu_tanh_f(z0 * zs) * g0, a1 = gelu_tanh_f(z1 * zs) * g1;
        f32x4 o[4];
#pragma unroll
        for (int j = 0; j < 4; ++j) o[j] = (f32x4){0.f, 0.f, 0.f, 0.f};
#pragma unroll 8
        for (int k = 0; k < 64; ++k) { const int e = __builtin_amdgcn_readlane(idx0, k);
            const float w = __builtin_bit_cast(float, __builtin_amdgcn_readlane(__builtin_bit_cast(int, a0), k));
            const u32x4 r = *(const u32x4*)(V8 + (size_t)e * DM + 16 * lane); axpy16_fp8(r, w, o); }
#pragma unroll 8
        for (int k = 0; k < 64; ++k) { const int e = __builtin_amdgcn_readlane(idx1, k);
            const float w = __builtin_bit_cast(float, __builtin_amdgcn_readlane(__builtin_bit_cast(int, a1), k));
            const u32x4 r = *(const u32x4*)(V8 + (size_t)e * DM + 16 * lane); axpy16_fp8(r, w, o); }
        float ss = 0.f;
#pragma unroll
        for (int j = 0; j < 4; ++j) { o[j] = xs[j] + o[j] * (1.f / V_SCALE); ss += (o[j].x * o[j].x + o[j].y * o[j].y) + (o[j].z * o[j].z + o[j].w * o[j].w); }
        ss = wave_sum(ss);
        const float r3 = rsqrtf(ss * (1.f / DM) + EPS);
        f32x4* op = (f32x4*)(P.out + (size_t)t * DM) + lane;
#pragma unroll
        for (int j = 0; j < 4; ++j) op[64 * j] = o[j] * r3 * gfin[j];
    }
}

__device__ __forceinline__ void phase_gather_f32(const Params& P, LAS unsigned char* lds) {
    const int tid = threadIdx.x, lane = tid & 63, wave = __builtin_amdgcn_readfirstlane(tid >> 6);
    const int gw = blockIdx.x * NWAVES + wave, NGW = gridDim.x * NWAVES;
    unsigned char* ws = P.ws;
    const int* IDX = (const int*)(ws + WS_IDX); const float* GATE = (const float*)(ws + WS_GATE);
    const unsigned char* U8 = ws + WS_U8; const unsigned char* V8 = ws + WS_V8;
    const bf16* H2B = (const bf16*)(ws + WS_H2B); const float* SSQ = (const float*)(ws + WS_SSQ);
    f32x4 gfin[4], gff[4];
#pragma unroll
    for (int j = 0; j < 4; ++j) gff[j] = ((const f32x4*)P.g_ffn)[64 * j + lane];
#pragma unroll
    for (int j = 0; j < 4; ++j) gfin[j] = ((const f32x4*)P.g_fin)[64 * j + lane];
    for (int t = gw; t < NTOK; t += NGW) {
        const int idx0 = IDX[(size_t)t * NSEL + lane], idx1 = IDX[(size_t)t * NSEL + 64 + lane];
        const float g0 = GATE[(size_t)t * NSEL + lane], g1 = GATE[(size_t)t * NSEL + 64 + lane];
        float sq = (lane < 16) ? SSQ[(size_t)t * 16 + lane] : 0.f; sq = wave_sum(sq);
        const float rstd2 = rsqrtf(sq * (1.f / DM) + EPS);
        f32x4 xs[4];
#pragma unroll
        for (int j = 0; j < 4; ++j) { const u32x2 w = ((const u32x2*)(H2B + (size_t)t * DM))[64 * j + lane]; xs[j] = (f32x4){bflo(w.x), bfhi(w.x), bflo(w.y), bfhi(w.y)}; }
        float z0 = 0.f, z1 = 0.f;
#pragma unroll 8
        for (int k = 0; k < 64; ++k) { const int e = __builtin_amdgcn_readlane(idx0, k);
            const f32x4* ur = (const f32x4*)(P.pu + (size_t)e * DM) + lane; float pp = 0.f;
            for (int j = 0; j < 4; ++j) { const f32x4 uu = ur[64 * j] * gff[j]; pp += (uu.x * xs[j].x + uu.y * xs[j].y) + (uu.z * xs[j].z + uu.w * xs[j].w); }
            const float p = wave_sum(pp); z0 = (lane == k) ? p : z0; }
#pragma unroll 8
        for (int k = 0; k < 64; ++k) { const int e = __builtin_amdgcn_readlane(idx1, k);
            const f32x4* ur = (const f32x4*)(P.pu + (size_t)e * DM) + lane; float pp = 0.f;
            for (int j = 0; j < 4; ++j) { const f32x4 uu = ur[64 * j] * gff[j]; pp += (uu.x * xs[j].x + uu.y * xs[j].y) + (uu.z * xs[j].z + uu.w * xs[j].w); }
            const float p = wave_sum(pp); z1 = (lane == k) ? p : z1; }
        const float zs = rstd2;
        const float a0 = gelu_tanh_f(z0 * zs) * g0, a1 = gelu_tanh_f(z1 * zs) * g1;
        f32x4 o[4];
#pragma unroll
        for (int j = 0; j < 4; ++j) o[j] = (f32x4){0.f, 0.f, 0.f, 0.f};
#pragma unroll 8
        for (int k = 0; k < 64; ++k) { const int e = __builtin_amdgcn_readlane(idx0, k);
            const float w = __builtin_bit_cast(float, __builtin_amdgcn_readlane(__builtin_bit_cast(int, a0), k));
            const f32x4* vr = (const f32x4*)(P.pv + (size_t)e * DM) + lane;
            for (int j = 0; j < 4; ++j) o[j] += vr[64 * j] * w; }
#pragma unroll 8
        for (int k = 0; k < 64; ++k) { const int e = __builtin_amdgcn_readlane(idx1, k);
            const float w = __builtin_bit_cast(float, __builtin_amdgcn_readlane(__builtin_bit_cast(int, a1), k));
            const f32x4* vr = (const f32x4*)(P.pv + (size_t)e * DM) + lane;
            for (int j = 0; j < 4; ++j) o[j] += vr[64 * j] * w; }
        float ss = 0.f;
#pragma unroll
        for (int j = 0; j < 4; ++j) { o[j] = xs[j] + o[j]; ss += (o[j].x * o[j].x + o[j].y * o[j].y) + (o[j].z * o[j].z + o[j].w * o[j].w); }
        ss = wave_sum(ss);
        const float r3 = rsqrtf(ss * (1.f / DM) + EPS);
        f32x4* op = (f32x4*)(P.out + (size_t)t * DM) + lane;
#pragma unroll
        for (int j = 0; j < 4; ++j) op[64 * j] = o[j] * r3 * gfin[j];
    }
}

#ifndef MK_MULTI
#define MK_MULTI 0
#endif
constexpr int NPHASE = 7;
#ifndef REP5
#define REP5 1
#endif
#ifndef REP6
#define REP6 1
#endif
__global__ void __launch_bounds__(NTHREADS, 2) mk_fwd(Params P) {
    extern __shared__ __attribute__((aligned(16))) unsigned char lds_raw[];
    LAS unsigned char* lds = (LAS unsigned char*)lds_raw;
    cg::grid_group grid = cg::this_grid();
    unsigned char* ws = P.ws;
    const int lo = P.ph_lo, hi = P.ph_hi;
#define IN(k) (lo <= (k) && (k) < hi)
#define SEAM(k) do { if (IN(k) && IN((k) + 1)) grid.sync(); } while (0)
#ifndef SKIP0
    if (IN(0)) phase_prep(P, lds);
#endif
    SEAM(0);
#ifndef SKIP1
    if (IN(1)) {
        phase_metaproj(P);
        pg8::Gemm g{(const bf16*)(ws + WS_H0B), (const bf16*)(ws + WS_WIN_T), NTOK, DIN, DM}; pg8::StaticOrder S; S.init(NTOK, DIN, (int)gridDim.x, (int)blockIdx.x);
        EpiRowScale<0> E{(bf16*)(ws + WS_PROJ), DIN, (const float*)(ws + WS_RSTD1)};
        pg8::gemm_phase<EpiRowScale<0>, pg8::StaticOrder, true, true>(lds, g, S, E);
    }
#endif
    SEAM(1);
#ifndef SKIP2
    if (IN(2)) phase_conv(P, lds);
#endif
    SEAM(2);
#ifndef SKIP3
    if (IN(3)) {
        pg8::Gemm g{(const bf16*)(ws + WS_Y), (const bf16*)(ws + WS_WOUT_T), NTOK, DM, DM}; pg8::StaticOrder S; S.init(NTOK, DM, (int)gridDim.x, (int)blockIdx.x);
        EpiResidual E{(bf16*)(ws + WS_H2B), P.x, (float*)(ws + WS_SSQ)};
        pg8::gemm_phase<EpiResidual, pg8::StaticOrder, true, true>(lds, g, S, E);
    }
#endif
    SEAM(3);
#ifndef SKIP4
    if (IN(4)) {
        pg8::Gemm g{(const bf16*)(ws + WS_H2B), (const bf16*)(ws + WS_WQ_T), NTOK, 2048, DM}; pg8::StaticOrder S; S.init(NTOK, 2048, (int)gridDim.x, (int)blockIdx.x);
        EpiRowScale<1> E{(bf16*)(ws + WS_Q), 2048, (const float*)(ws + WS_SSQ)};
        pg8::gemm_phase<EpiRowScale<1>, pg8::StaticOrder, true, true>(lds, g, S, E);
    }
#endif
    SEAM(4);
#ifndef SKIP5
    if (IN(5)) for (int rep = 0; rep < REP5; ++rep) phase_route(P, lds);
#endif
    SEAM(5);
#ifndef SKIP6
#ifdef GATHER_F32
    if (IN(6)) phase_gather_f32(P, lds);
#else
    if (IN(6)) for (int rep = 0; rep < REP6; ++rep) phase_gather(P, lds);
#endif
#endif
#undef IN
#undef SEAM
}

extern "C" void kernel_launch(void* const* d_in, const int* in_sizes, int n_in, void* d_out, int out_size, void* d_ws, size_t ws_size, hipStream_t stream) {
    static int grid = 0;
    if (grid == 0) {
        if (n_in != 18 || in_sizes[0] != NTOK * DM || out_size != NTOK * DM || ws_size < WS_END) {
            fprintf(stderr, "kernel_launch: unexpected shapes (n_in %d in0 %d out %d ws %zu)\n", n_in, n_in > 0 ? in_sizes[0] : -1, out_size, ws_size); grid = -1; return; }
        int dev = 0, cus = 0, per_cu = 0;
        (void)hipGetDevice(&dev); (void)hipDeviceGetAttribute(&cus, hipDeviceAttributeMultiprocessorCount, dev);
        if (hipFuncSetAttribute((const void*)mk_fwd, hipFuncAttributeMaxDynamicSharedMemorySize, LDS_BYTES) != hipSuccess) { fprintf(stderr, "kernel_launch: hipFuncSetAttribute failed\n"); grid = -1; return; }
        if (hipOccupancyMaxActiveBlocksPerMultiprocessor(&per_cu, (const void*)mk_fwd, NTHREADS, LDS_BYTES) != hipSuccess || per_cu < 1) { fprintf(stderr, "kernel_launch: occupancy query failed (%d)\n", per_cu); (void)hipGetLastError(); per_cu = 1; }
        if (per_cu > 1) per_cu = 1;
        grid = cus * per_cu;
        if (grid <= 0) grid = 256;
    }
    if (grid < 0) return;
    Params p{};
    p.x = (const float*)d_in[0]; p.meta = (const float*)d_in[1]; p.g_mix = (const float*)d_in[2]; p.w_in = (const float*)d_in[3]; p.sc_w = (const float*)d_in[4];
    p.cf_w = (const float*)d_in[5]; p.cf_b = (const float*)d_in[6]; p.ln_g = (const float*)d_in[7]; p.ln_b = (const float*)d_in[8]; p.g_sc = (const float*)d_in[9];
    p.g_cf = (const float*)d_in[10]; p.w_out = (const float*)d_in[11]; p.g_ffn = (const float*)d_in[12]; p.w_q = (const float*)d_in[13]; p.keys = (const float*)d_in[14];
    p.pu = (const float*)d_in[15]; p.pv = (const float*)d_in[16]; p.g_fin = (const float*)d_in[17];
    p.out = (float*)d_out; p.ws = (unsigned char*)d_ws;
#if MK_MULTI
    for (int ph = 0; ph < NPHASE; ++ph) { p.ph_lo = ph; p.ph_hi = ph + 1; p.coop = 0; p.pad = 0;
        hipLaunchKernelGGL(mk_fwd, dim3(grid), dim3(NTHREADS), LDS_BYTES, stream, p); }
#else
    p.ph_lo = 0; p.ph_hi = NPHASE; p.coop = 1; p.pad = 0;
    void* args[] = {&p};
    hipError_t e = hipLaunchCooperativeKernel((const void*)mk_fwd, dim3(grid), dim3(NTHREADS), args, LDS_BYTES, stream);
    if (e != hipSuccess) fprintf(stderr, "cooperative launch failed: %s (grid %d)\n", hipGetErrorString(e), grid);
#endif
}
```

```cpp
#include <hip/hip_runtime.h>
#include <hip/hip_cooperative_groups.h>
#include <cstdio>
#include <cstdint>
namespace cg = cooperative_groups;

namespace pg8 {
#define PG8_LAS __attribute__((address_space(3)))
typedef unsigned short bf16_t;
typedef short bf16x8 __attribute__((ext_vector_type(8)));
typedef float f32x4 __attribute__((ext_vector_type(4)));
typedef unsigned u32x4 __attribute__((ext_vector_type(4)));
constexpr int BM = 256, BK = 64, HALF = 128, HTB = HALF * BK * 2  , STAGE_BYTES = 8 * HTB, NXCD = 8, WGM = 8;

__host__ __device__ __forceinline__ int lds_byte(int r, int c) { const int st = (r >> 4) * 2 + (c >> 5), rr = r & 15, cc = c & 31, ob = rr * 64 + cc * 2; return st * 1024 + (ob ^ (((ob >> 9) & 1) << 5)); }
__host__ __device__ __forceinline__ void stage_rc(int b, int& R, int& C) { const int st = b / 1024, sb = b % 1024, swz = sb ^ (((sb >> 9) & 1) << 5); R = (st >> 1) * 16 + swz / 64; C = (st & 1) * 32 + (swz % 64) / 2; }
__host__ __device__ __forceinline__ int perm32(int rho) { const int n = rho >> 4, i = rho & 15; return 8 * (i >> 2) + 4 * n + (i & 3); }

struct Unit { int pm, pn; };
struct Gemm { const bf16_t* A; const bf16_t* Bt; int M, N, K; };

struct StaticOrder {
    int nM, nN, nwg, G, c;
    __host__ __device__ void init(int M, int N, int G_, int c_) { nM = M / BM; nN = N / BM; nwg = nM * nN; G = G_; c = c_; }
    __host__ __device__ bool next(int i, Unit& u) const {
        const long L = (long)i * G + c; if (L >= nwg) return false;
        int wgid = (int)L; { const int q = nwg / NXCD, r = nwg % NXCD, xcd = wgid % NXCD, off = wgid / NXCD; wgid = (xcd < r ? xcd * (q + 1) : r * (q + 1) + (xcd - r) * q) + off; }
        const int nig = WGM * nN, gid = wgid / nig, fm = gid * WGM, gsz = (nM - fm) < WGM ? (nM - fm) : WGM;
        u.pm = fm + ((wgid % nig) % gsz); u.pn = (wgid % nig) / gsz; return true;
    }
    __device__ __forceinline__ void a_ready(const Unit&) const {}
    __device__ __forceinline__ void done(const Unit&) const {}
};

template <class Epi, class Sched, bool ALIGN_EPI = false, bool SP2 = false>
__device__ __forceinline__ void gemm_phase(PG8_LAS unsigned char* lds, const Gemm g, const Sched& S, const Epi& E) {
    const int tid = threadIdx.x, wid = __builtin_amdgcn_readfirstlane(tid >> 6), lane = tid & 63, wr = wid >> 2, wc = wid & 3, fr = lane & 15, fq = lane >> 4;
    const int K = g.K, nt = K / BK;
    unsigned voffA[2], voffB[2];
#pragma unroll
    for (int i = 0; i < 2; ++i) { int R, C; stage_rc(tid * 16 + i * 8192, R, C); const int Rb = Epi::PERM ? ((R & ~31) + perm32(R & 31)) : R;
        voffA[i] = (unsigned)(R * K + C) * 2u; voffB[i] = (unsigned)(Rb * K + C) * 2u; }
    const size_t kstep = (size_t)(BK * 2);
    const size_t hstep = (size_t)HALF * K * 2;
    const size_t tstep = 2 * hstep;
    const unsigned ldsw = (unsigned)wid * 1024u;
    const int aoff = lds_byte(wr * 64 + fr, fq * 8), boff = lds_byte(wc * 32 + fr, fq * 8);
#define PG8_SA(b, h) (((b) * 2 + (h)) * HTB)
#define PG8_SB(b, h) ((4 + (b) * 2 + (h)) * HTB)
#define PG8_STAGE(bufoff, gbase, voff) do { _Pragma("unroll") for (int _i = 0; _i < 2; ++_i) \
        __builtin_amdgcn_global_load_lds((const unsigned*)((const char*)(gbase) + (voff)[_i]), (PG8_LAS unsigned*)(lds + (bufoff) + ldsw + _i * 8192), 16, 0, 0); } while (0)
#define PG8_LDA(dst, b, h) do { _Pragma("unroll") for (int m = 0; m < 4; ++m) _Pragma("unroll") for (int k = 0; k < 2; ++k) dst[m][k] = *(const PG8_LAS bf16x8*)(lds + PG8_SA(b, h) + aoff + m * 2048 + k * 1024); } while (0)
#define PG8_LDB(dst, b, h) do { _Pragma("unroll") for (int n = 0; n < 2; ++n) _Pragma("unroll") for (int k = 0; k < 2; ++k) dst[n][k] = *(const PG8_LAS bf16x8*)(lds + PG8_SB(b, h) + boff + n * 2048 + k * 1024); } while (0)
#define PG8_MMA(ai, bj, At, Bt) do { __builtin_amdgcn_s_setprio(1); _Pragma("unroll") for (int m = 0; m < 4; ++m) _Pragma("unroll") for (int n = 0; n < 2; ++n) _Pragma("unroll") for (int k = 0; k < 2; ++k) \
        acc[ai][bj][m][n] = __builtin_amdgcn_mfma_f32_16x16x32_bf16(Bt[n][k], At[m][k], acc[ai][bj][m][n], 0, 0, 0); __builtin_amdgcn_s_setprio(0); } while (0)
#define PG8_WAIT_V(n) asm volatile("s_waitcnt vmcnt(" #n ")" ::: "memory")
#define PG8_WAIT_L(n) asm volatile("s_waitcnt lgkmcnt(" #n ")" ::: "memory")
#define PG8_BAR __builtin_amdgcn_s_barrier()
#define PG8_SCHED __builtin_amdgcn_sched_barrier(0)
    Unit cur, nxt; int ui = 0;
    if (!S.next(0, cur)) return;
    f32x4 acc[2][2][4][2];
#pragma unroll
    for (int a = 0; a < 2; ++a)
#pragma unroll
        for (int b = 0; b < 2; ++b)
#pragma unroll
            for (int m = 0; m < 4; ++m)
#pragma unroll
                for (int n = 0; n < 2; ++n) acc[a][b][m][n] = (f32x4){0.f, 0.f, 0.f, 0.f};
    bf16x8 At[4][2], B0[2][2], B1[2][2];
    const char* cA = (const char*)g.A + (size_t)cur.pm * tstep; const char* cB = (const char*)g.Bt + (size_t)cur.pn * tstep;
    S.a_ready(cur);
    if constexpr (SP2) {
        PG8_STAGE(PG8_SB(0, 0), cB, voffB); PG8_STAGE(PG8_SB(0, 1), cB + hstep, voffB); PG8_STAGE(PG8_SA(0, 0), cA, voffA); PG8_STAGE(PG8_SA(0, 1), cA + hstep, voffA);
        if (wr == 1) PG8_BAR;
        PG8_WAIT_V(2); PG8_BAR;
        PG8_STAGE(PG8_SB(1, 0), cB + kstep, voffB); PG8_STAGE(PG8_SA(1, 0), cA + kstep, voffA); PG8_STAGE(PG8_SB(1, 1), cB + hstep + kstep, voffB);
        PG8_WAIT_V(6); PG8_BAR;
    } else {
        PG8_STAGE(PG8_SB(0, 0), cB, voffB); PG8_STAGE(PG8_SA(0, 0), cA, voffA); PG8_STAGE(PG8_SB(0, 1), cB + hstep, voffB); PG8_STAGE(PG8_SA(0, 1), cA + hstep, voffA);
        if (wr == 1) PG8_BAR;
        PG8_WAIT_V(4); PG8_BAR;
        PG8_STAGE(PG8_SB(1, 0), cB + kstep, voffB); PG8_STAGE(PG8_SA(1, 0), cA + kstep, voffA); PG8_STAGE(PG8_SB(1, 1), cB + hstep + kstep, voffB);
        PG8_WAIT_V(6); PG8_BAR;
    }
    for (;;) {
        const bool has_next = S.next(ui + 1, nxt);
        const char* nA = has_next ? (const char*)g.A + (size_t)nxt.pm * tstep : cA; const char* nB = has_next ? (const char*)g.Bt + (size_t)nxt.pn * tstep : cB;
        for (int t = 0; t < nt; t += 2) {
            const bool last = (t == nt - 2);
            const char* a1 = cA + (size_t)(t + 1) * kstep;
            const char* a2 = last ? nA : cA + (size_t)(t + 2) * kstep; const char* b2 = last ? nB : cB + (size_t)(t + 2) * kstep;
            const char* a3 = a2 + kstep; const char* b3 = b2 + kstep;
            if (last && has_next) S.a_ready(nxt);
            if constexpr (SP2) {
            PG8_LDB(B0, 0, 0); PG8_LDB(B1, 0, 1); PG8_SCHED; PG8_LDA(At, 0, 0); PG8_STAGE(PG8_SA(1, 1), a1 + hstep, voffA);
            PG8_WAIT_V(8); PG8_WAIT_L(0); PG8_BAR; PG8_MMA(0, 0, At, B0); PG8_MMA(0, 1, At, B1); PG8_BAR; PG8_SCHED;
            PG8_LDA(At, 0, 1); PG8_STAGE(PG8_SB(0, 0), b2, voffB); PG8_STAGE(PG8_SB(0, 1), b2 + hstep, voffB); PG8_STAGE(PG8_SA(0, 0), a2, voffA);
            PG8_WAIT_V(8); PG8_WAIT_L(0); PG8_BAR; PG8_MMA(1, 0, At, B0); PG8_MMA(1, 1, At, B1); PG8_BAR; PG8_SCHED;
            PG8_LDB(B0, 1, 0); PG8_LDB(B1, 1, 1); PG8_SCHED; PG8_LDA(At, 1, 0); PG8_STAGE(PG8_SA(0, 1), a2 + hstep, voffA);
            PG8_WAIT_V(8); PG8_WAIT_L(0); PG8_BAR; PG8_MMA(0, 0, At, B0); PG8_MMA(0, 1, At, B1); PG8_BAR; PG8_SCHED;
            PG8_LDA(At, 1, 1); PG8_STAGE(PG8_SB(1, 0), b3, voffB); PG8_STAGE(PG8_SB(1, 1), b3 + hstep, voffB); PG8_STAGE(PG8_SA(1, 0), a3, voffA);
            PG8_WAIT_V(8); PG8_WAIT_L(0); PG8_BAR; PG8_MMA(1, 0, At, B0); PG8_MMA(1, 1, At, B1); PG8_BAR; PG8_SCHED;
            } else {
            PG8_LDB(B0, 0, 0); PG8_SCHED; PG8_LDA(At, 0, 0); PG8_STAGE(PG8_SA(1, 1), a1 + hstep, voffA);
            PG8_WAIT_L(8); PG8_BAR; PG8_WAIT_L(0); PG8_MMA(0, 0, At, B0); PG8_BAR; PG8_SCHED;
            PG8_LDB(B1, 0, 1); PG8_STAGE(PG8_SB(0, 0), b2, voffB);
            PG8_BAR; PG8_WAIT_L(0); PG8_MMA(0, 1, At, B1); PG8_BAR;
            PG8_LDA(At, 0, 1); PG8_STAGE(PG8_SA(0, 0), a2, voffA);
            PG8_BAR; PG8_WAIT_L(0); PG8_MMA(1, 0, At, B0); PG8_BAR; PG8_SCHED;
            PG8_STAGE(PG8_SB(0, 1), b2 + hstep, voffB);
            PG8_WAIT_V(6); PG8_BAR; PG8_MMA(1, 1, At, B1); PG8_BAR;
            PG8_LDB(B0, 1, 0); PG8_SCHED; PG8_LDA(At, 1, 0); PG8_STAGE(PG8_SA(0, 1), a2 + hstep, voffA);
            PG8_WAIT_L(8); PG8_BAR; PG8_WAIT_L(0); PG8_MMA(0, 0, At, B0); PG8_BAR; PG8_SCHED;
            PG8_LDB(B1, 1, 1); PG8_STAGE(PG8_SB(1, 0), b3, voffB);
            PG8_BAR; PG8_WAIT_L(0); PG8_MMA(0, 1, At, B1); PG8_BAR;
            PG8_LDA(At, 1, 1); PG8_STAGE(PG8_SA(1, 0), a3, voffA);
            PG8_BAR; PG8_WAIT_L(0); PG8_MMA(1, 0, At, B0); PG8_BAR; PG8_SCHED;
            PG8_STAGE(PG8_SB(1, 1), b3 + hstep, voffB);
            PG8_WAIT_V(6); PG8_BAR; PG8_MMA(1, 1, At, B1); PG8_BAR;
            }
        }
        if constexpr (ALIGN_EPI) { if (wr == 0) PG8_BAR; }
        if constexpr (!Epi::AFTER_DRAIN) { E(acc, cur, wr, wc, fr, fq); S.done(cur); }
        if (!has_next) break;
#pragma unroll
        for (int a = 0; a < 2; ++a)
#pragma unroll
            for (int b = 0; b < 2; ++b)
#pragma unroll
                for (int m = 0; m < 4; ++m)
#pragma unroll
                    for (int n = 0; n < 2; ++n) acc[a][b][m][n] = (f32x4){0.f, 0.f, 0.f, 0.f};
        cur = nxt; cA = nA; cB = nB; ++ui;
        if constexpr (ALIGN_EPI) { if (wr == 1) PG8_BAR; }
    }
    PG8_WAIT_V(0);
    if constexpr (!ALIGN_EPI) { if (wr == 0) PG8_BAR; }
    PG8_BAR;
    if constexpr (Epi::AFTER_DRAIN) { E.fused(acc, cur, wr, wc, fr, fq, lds, wid, lane); S.done(cur); }
#undef PG8_SA
#undef PG8_SB
#undef PG8_STAGE
#undef PG8_LDA
#undef PG8_LDB
#undef PG8_MMA
#undef PG8_WAIT_V
#undef PG8_WAIT_L
#undef PG8_BAR
#undef PG8_SCHED
}
}

#define LAS __attribute__((address_space(3)))
typedef unsigned short bf16;
typedef float f32x2 __attribute__((ext_vector_type(2)));
typedef float f32x4 __attribute__((ext_vector_type(4)));
typedef unsigned u32x2 __attribute__((ext_vector_type(2)));
typedef unsigned u32x4 __attribute__((ext_vector_type(4)));

constexpr int NTOK = 32768, DM = 1024, DIN = 2560, SEQ = 8192, NBATCH = 4, NMETA = 16;
constexpr int NHEAD = 8, NKEYS = 128, TOPK = 16, NSEL = NHEAD * TOPK;
constexpr float EPS = 1e-6f;
constexpr float U_SCALE = 64.f, V_SCALE = 16.f;
constexpr int NWAVES = 8, NTHREADS = 512;
constexpr int LDS_BYTES = 147456;

constexpr size_t MiB = 1u << 20;
constexpr size_t WS_CTL = 0, WS_WIN_T = 1 * MiB, WS_WOUT_T = 6 * MiB, WS_WQ_T = 8 * MiB, WS_KEYS = 12 * MiB, WS_METAPART = 13 * MiB,
                 WS_METARSTD = 14 * MiB + 512 * 1024, WS_METAPROJ = 14 * MiB + 576 * 1024, WS_RSTD1 = 15 * MiB, WS_SSQ = 16 * MiB, WS_U8 = 32 * MiB, WS_V8 = 48 * MiB,
                 WS_IDX = 64 * MiB, WS_GATE = 80 * MiB, WS_H0B = 96 * MiB, WS_H2B = 96 * MiB, WS_Y = 160 * MiB, WS_PROJ = 224 * MiB,
                 WS_Q = 224 * MiB, WS_END = 384 * MiB;

struct Params {
    const float* x; const float* meta; const float* g_mix; const float* w_in; const float* sc_w; const float* cf_w; const float* cf_b;
    const float* ln_g; const float* ln_b; const float* g_sc; const float* g_cf; const float* w_out; const float* g_ffn; const float* w_q;
    const float* keys; const float* pu; const float* pv; const float* g_fin;
    float* out; unsigned char* ws;
    int ph_lo, ph_hi, coop, pad;
};

__device__ __forceinline__ unsigned f2bf(float f) { unsigned u = __builtin_bit_cast(unsigned, f); return (u + 0x7fffu + ((u >> 16) & 1u)) >> 16; }
__device__ __forceinline__ unsigned pk2(float lo, float hi) { return f2bf(lo) | (f2bf(hi) << 16); }
__device__ __forceinline__ float bf2f(unsigned b) { return __builtin_bit_cast(float, b << 16); }
__device__ __forceinline__ float bflo(unsigned w) { return __builtin_bit_cast(float, w << 16); }
__device__ __forceinline__ float bfhi(unsigned w) { return __builtin_bit_cast(float, w & 0xffff0000u); }
__device__ __forceinline__ float wave_sum(float v) {
#pragma unroll
    for (int o = 1; o < 64; o <<= 1) v += __shfl_xor(v, o);
    return v;
}
__device__ __forceinline__ float sigmoid_f(float x) { return 1.f / (1.f + __expf(-x)); }
__device__ __forceinline__ float gelu_tanh_f(float x) {
    const float t = 0.7978845608028654f * (x + 0.044715f * x * x * x);
    const float e = __expf(2.f * t);
    const float th = 1.f - 2.f / (e + 1.f);
    return 0.5f * x * (1.f + th);
}

__device__ __forceinline__ unsigned cvt_pk_bf16(float lo, float hi) { unsigned r; asm volatile("v_cvt_pk_bf16_f32 %0, %1, %2" : "=v"(r) : "v"(lo), "v"(hi)); return r; }

template <int MODE> struct EpiRowScale {
    static constexpr bool PERM = true, AFTER_DRAIN = false;
    bf16* O; int ldc; const float* rs;
    __device__ __forceinline__ void operator()(const pg8::f32x4 (&acc)[2][2][4][2], const pg8::Unit& u, int wr, int wc, int fr, int fq) const {
        const int row0 = u.pm * 256 + wr * 64 + fr, col0 = u.pn * 256 + wc * 32 + 8 * fq;
#pragma unroll
        for (int ai = 0; ai < 2; ++ai)
#pragma unroll
            for (int m = 0; m < 4; ++m) {
                const int row = row0 + ai * 128 + m * 16;
                float s;
                if (MODE == 0) s = rs[row];
                else { const f32x4* p = (const f32x4*)(rs + (size_t)row * 16); const f32x4 a = p[0], b = p[1], c = p[2], d = p[3];
                       const float t = ((a.x + a.y) + (a.z + a.w)) + ((b.x + b.y) + (b.z + b.w)) + ((c.x + c.y) + (c.z + c.w)) + ((d.x + d.y) + (d.z + d.w));
                       s = rsqrtf(t * (1.f / 1024.f) + EPS); }
                bf16* rowp = O + (size_t)row * ldc + col0;
#pragma unroll
                for (int bj = 0; bj < 2; ++bj) { const pg8::f32x4 v0 = acc[ai][bj][m][0] * s, v1 = acc[ai][bj][m][1] * s;
                    u32x4 w; w.x = cvt_pk_bf16(v0[0], v0[1]); w.y = cvt_pk_bf16(v0[2], v0[3]); w.z = cvt_pk_bf16(v1[0], v1[1]); w.w = cvt_pk_bf16(v1[2], v1[3]);
                    *(u32x4*)(rowp + bj * 128) = w; }
            }
    }
};
struct EpiResidual {
    static constexpr bool PERM = true, AFTER_DRAIN = false;
    bf16* O; const float* X; float* ssq;
    __device__ __forceinline__ void operator()(const pg8::f32x4 (&acc)[2][2][4][2], const pg8::Unit& u, int wr, int wc, int fr, int fq) const {
        const int row0 = u.pm * 256 + wr * 64 + fr, col0 = u.pn * 256 + wc * 32 + 8 * fq;
#pragma unroll
        for (int ai = 0; ai < 2; ++ai)
#pragma unroll
            for (int m = 0; m < 4; ++m) {
                const int row = row0 + ai * 128 + m * 16;
                const float* xr = X + (size_t)row * DM + col0; bf16* rowp = O + (size_t)row * DM + col0;
                float q = 0.f;
#pragma unroll
                for (int bj = 0; bj < 2; ++bj) { const f32x4 x0 = *(const f32x4*)(xr + bj * 128), x1 = *(const f32x4*)(xr + bj * 128 + 4);
                    const pg8::f32x4 v0 = acc[ai][bj][m][0] + x0, v1 = acc[ai][bj][m][1] + x1;
                    q += (v0[0] * v0[0] + v0[1] * v0[1]) + (v0[2] * v0[2] + v0[3] * v0[3]) + (v1[0] * v1[0] + v1[1] * v1[1]) + (v1[2] * v1[2] + v1[3] * v1[3]);
                    u32x4 w; w.x = cvt_pk_bf16(v0[0], v0[1]); w.y = cvt_pk_bf16(v0[2], v0[3]); w.z = cvt_pk_bf16(v1[0], v1[1]); w.w = cvt_pk_bf16(v1[2], v1[3]);
                    *(u32x4*)(rowp + bj * 128) = w; }
                q += __shfl_xor(q, 16); q += __shfl_xor(q, 32);
                if (fq == 0) ssq[(size_t)row * 16 + u.pn * 4 + wc] = q;
            }
    }
};

__device__ __forceinline__ void p0_transpose_item(const float* W, int K, int N, bf16* WT, LAS float* scr, int item, int lane,
                                                  const float* g_lo, const float* g_hi, int split) {
    const int nblk = N / 32, kb = item / nblk, nb = item % nblk, k0 = 64 * kb, n0 = 32 * nb;
#pragma unroll 8
    for (int i = 0; i < 32; ++i) { const int kk = 2 * i + (lane >> 5); const int k = k0 + kk;
        const float g = (k < split) ? g_lo[k] : g_hi[k - split];
        scr[kk * 33 + (lane & 31)] = W[(size_t)k * N + n0 + (lane & 31)] * g; }
    asm volatile("s_waitcnt lgkmcnt(0)" ::: "memory");
    const int c = lane & 7;
#pragma unroll
    for (int j = 0; j < 4; ++j) { const int n = (lane >> 3) + 8 * j; const LAS float* s = scr + (8 * c) * 33 + n;
        u32x4 o; o.x = pk2(s[0 * 33], s[1 * 33]); o.y = pk2(s[2 * 33], s[3 * 33]); o.z = pk2(s[4 * 33], s[5 * 33]); o.w = pk2(s[6 * 33], s[7 * 33]);
        *(u32x4*)(WT + (size_t)(n0 + n) * K + k0 + 8 * c) = o; }
    asm volatile("s_waitcnt lgkmcnt(0)" ::: "memory");
}

__device__ __forceinline__ void phase_prep(const Params& P, LAS unsigned char* lds) {
    const int tid = threadIdx.x, lane = tid & 63, wave = __builtin_amdgcn_readfirstlane(tid >> 6);
    const int gw = blockIdx.x * NWAVES + wave, NGW = gridDim.x * NWAVES;
    unsigned char* ws = P.ws;
    LAS float* scr = (LAS float*)(lds + wave * 16384);
    constexpr int I_IN = (DM / 64) * (DIN / 32), I_OUT = (DM / 64) * (DM / 32), I_Q = (DM / 64) * (2048 / 32);
    for (int it = gw; it < I_IN + I_OUT + I_Q; it += NGW) {
        int r = it;
        if (r < I_IN) { p0_transpose_item(P.w_in, DM, DIN, (bf16*)(ws + WS_WIN_T), scr, r, lane, P.g_mix, P.g_mix, DM); continue; } r -= I_IN;
        if (r < I_OUT) { p0_transpose_item(P.w_out, DM, DM, (bf16*)(ws + WS_WOUT_T), scr, r, lane, P.g_sc, P.g_cf, 512); continue; } r -= I_OUT;
        p0_transpose_item(P.w_q, DM, 2048, (bf16*)(ws + WS_WQ_T), scr, r, lane, P.g_ffn, P.g_ffn, DM);
    }
    {
        bf16* H0B = (bf16*)(ws + WS_H0B); float* RSTD1 = (float*)(ws + WS_RSTD1);
        for (int t = gw; t < NTOK; t += NGW) {
            const f32x4* xr = (const f32x4*)(P.x + (size_t)t * DM) + lane;
            f32x4 v[4]; float s = 0.f;
#pragma unroll
            for (int j = 0; j < 4; ++j) { v[j] = xr[64 * j]; s += (v[j].x * v[j].x + v[j].y * v[j].y) + (v[j].z * v[j].z + v[j].w * v[j].w); }
            s = wave_sum(s);
            if (lane == 0) RSTD1[t] = rsqrtf(s * (1.f / DM) + EPS);
            u32x2* o = (u32x2*)(H0B + (size_t)t * DM) + lane;
#pragma unroll
            for (int j = 0; j < 4; ++j) { u32x2 w; w.x = pk2(v[j].x, v[j].y); w.y = pk2(v[j].z, v[j].w); o[64 * j] = w; }
        }
    }
    {
        unsigned char* U8 = ws + WS_U8; unsigned char* V8 = ws + WS_V8;
        f32x4 gf[4];
#pragma unroll
        for (int j = 0; j < 4; ++j) gf[j] = ((const f32x4*)P.g_ffn)[64 * j + lane] * U_SCALE;
        for (int e = gw; e < 2 * 16384; e += NGW) {
            const bool isv = e >= 16384; const int ee = isv ? e - 16384 : e;
            const f32x4* src = (const f32x4*)((isv ? P.pv : P.pu) + (size_t)ee * DM) + lane;
            u32x4 o; unsigned ow[4];
#pragma unroll
            for (int j = 0; j < 4; ++j) { f32x4 v = src[64 * j]; if (isv) v = v * V_SCALE; else v = v * gf[j];
                int p = __builtin_amdgcn_cvt_pk_fp8_f32(v.x, v.y, 0, false); p = __builtin_amdgcn_cvt_pk_fp8_f32(v.z, v.w, p, true); ow[j] = (unsigned)p; }
            o.x = ow[0]; o.y = ow[1]; o.z = ow[2]; o.w = ow[3];
            *(u32x4*)((isv ? V8 : U8) + (size_t)ee * DM + 16 * lane) = o;
        }
    }
    {
        bf16* KB = (bf16*)(ws + WS_KEYS);
        const int gt = blockIdx.x * NTHREADS + tid, NGT = gridDim.x * NTHREADS;
        for (int i = gt; i < 8 * 2 * 128 * 128 / 4; i += NGT) { const f32x4 v = ((const f32x4*)P.keys)[i]; u32x2 w; w.x = pk2(v.x, v.y); w.y = pk2(v.z, v.w); ((u32x2*)KB)[i] = w; }
    }
    {
        float* MP = (float*)(ws + WS_METAPART); float* MR = (float*)(ws + WS_METARSTD);
        for (int r = gw; r < NMETA; r += NGW) {
            float s = 0.f;
            for (int k = lane; k < DM; k += 64) { const float v = P.meta[r * DM + k]; s += v * v; }
            s = wave_sum(s);
            if (lane == 0) MR[r] = rsqrtf(s * (1.f / DM) + EPS);
        }
        for (int it = gw; it < 8 * 40; it += NGW) {
            const int kc = it / 40, nb = it % 40, n = nb * 64 + lane;
            float acc[NMETA];
#pragma unroll
            for (int r = 0; r < NMETA; ++r) acc[r] = 0.f;
            for (int k = kc * 128; k < kc * 128 + 128; ++k) {
                const float w = P.w_in[(size_t)k * DIN + n] * P.g_mix[k];
#pragma unroll
                for (int r = 0; r < NMETA; ++r) acc[r] += P.meta[r * DM + k] * w;
            }
#pragma unroll
            for (int r = 0; r < NMETA; ++r) MP[(size_t)(kc * 16 + r) * DIN + n] = acc[r];
        }
    }
}

__device__ __forceinline__ void phase_metaproj(const Params& P) {
    const float* MP = (const float*)(P.ws + WS_METAPART); const float* MR = (const float*)(P.ws + WS_METARSTD); float* MJ = (float*)(P.ws + WS_METAPROJ);
    const int gt = blockIdx.x * NTHREADS + threadIdx.x;
    if (gt < NMETA * DIN) { const int p = gt / DIN, col = gt % DIN; float s = 0.f;
#pragma unroll
        for (int kc = 0; kc < 8; ++kc) s += MP[(size_t)(kc * 16 + p) * DIN + col];
        MJ[gt] = s * MR[p]; }
}
__device__ __forceinline__ float meta_val(const float* MJ, const float*, int p, int col) { return MJ[p * DIN + col]; }
__device__ __forceinline__ float proj_at(const bf16* PROJ, const float* MP, const float* MR, int b, int pos, int col) {
    if (pos < 0) return 0.f;
    if (pos < NMETA) return meta_val(MP, MR, pos, col);
    return bf2f(PROJ[(size_t)(b * SEQ + pos - NMETA) * DIN + col]);
}
__device__ __forceinline__ void proj8_at(const bf16* PROJ, const float* MP, const float* MR, int b, int pos, int col, float (&v)[8]) {
    if (pos < 0) {
#pragma unroll
        for (int i = 0; i < 8; ++i) v[i] = 0.f;
    } else if (pos < NMETA) {
        const f32x4 a = *(const f32x4*)(MP + pos * DIN + col), bq = *(const f32x4*)(MP + pos * DIN + col + 4);
        v[0] = a.x; v[1] = a.y; v[2] = a.z; v[3] = a.w; v[4] = bq.x; v[5] = bq.y; v[6] = bq.z; v[7] = bq.w;
    } else {
        const u32x4 w = *(const u32x4*)(PROJ + (size_t)(b * SEQ + pos - NMETA) * DIN + col);
        v[0] = bflo(w.x); v[1] = bfhi(w.x); v[2] = bflo(w.y); v[3] = bfhi(w.y); v[4] = bflo(w.z); v[5] = bfhi(w.z); v[6] = bflo(w.w); v[7] = bfhi(w.w);
    }
}

template <int CTRL> __device__ __forceinline__ float dpp_f(float v) { return __builtin_bit_cast(float, __builtin_amdgcn_update_dpp(0, __builtin_bit_cast(int, v), CTRL, 0xf, 0xf, true)); }
__device__ __forceinline__ float wave_sum_fast(float v) {
    v += dpp_f<0xB1>(v); v += dpp_f<0x4E>(v); v += dpp_f<0x141>(v); v += dpp_f<0x140>(v);
    { auto r = __builtin_amdgcn_permlane16_swap(__float_as_uint(v), __float_as_uint(v), false, false); v = __uint_as_float(r[0]) + __uint_as_float(r[1]); }
    { auto r = __builtin_amdgcn_permlane32_swap(__float_as_uint(v), __float_as_uint(v), false, false); v = __uint_as_float(r[0]) + __uint_as_float(r[1]); }
    return v;
}
template <int R> __device__ __forceinline__ void conv_rows(const LAS unsigned char* ubase, const f32x2 (&wcf)[31], f32x2 (&acc)[32]) {
    if constexpr (R < 62) {
        const unsigned uw = *(const LAS unsigned*)(ubase + R * 1024);
        const f32x2 x = (f32x2){bflo(uw), bfhi(uw)};
        constexpr int lo = R > 30 ? R - 30 : 0, hi = R < 31 ? R : 31;
#pragma unroll
        for (int ii = lo; ii <= hi; ++ii) acc[ii] += wcf[R - ii] * x;
        conv_rows<R + 1>(ubase, wcf, acc);
    }
}
__device__ __forceinline__ void phase_conv(const Params& P, LAS unsigned char* lds) {
    const int tid = threadIdx.x, lane = tid & 63, wave = __builtin_amdgcn_readfirstlane(tid >> 6);
    unsigned char* ws = P.ws;
    const bf16* PROJ = (const bf16*)(ws + WS_PROJ); const float* MP = (const float*)(ws + WS_METAPROJ); const float* MR = nullptr;
    bf16* Y = (bf16*)(ws + WS_Y);
    constexpr int TT = 64, NTILE = NTOK / TT, UROWS = TT + 30;
    const int cgp = wave & 3, th = wave >> 2, ch2 = cgp * 128 + 2 * lane;
    f32x2 wcf[31];
#pragma unroll
    for (int j = 0; j < 31; ++j) wcf[j] = *(const f32x2*)(P.cf_w + j * 512 + ch2);
    const f32x2 bcf = *(const f32x2*)(P.cf_b + ch2);
    for (int tile = blockIdx.x; tile < NTILE; tile += gridDim.x) {
        const int b = tile / (SEQ / TT), s0 = (tile % (SEQ / TT)) * TT;
#pragma unroll 4
        for (int p = 0; p < (UROWS + 7) / 8; ++p) {
            const int r = p * 8 + wave;
            if (r < UROWS) {
                const int pos = NMETA + s0 - 30 + r;
                float ga[8], gg[8];
                proj8_at(PROJ, MP, MR, b, pos, 1536 + 8 * lane, ga); proj8_at(PROJ, MP, MR, b, pos, 2048 + 8 * lane, gg);
                u32x4 w;
                w.x = pk2(ga[0] * sigmoid_f(gg[0]), ga[1] * sigmoid_f(gg[1])); w.y = pk2(ga[2] * sigmoid_f(gg[2]), ga[3] * sigmoid_f(gg[3]));
                w.z = pk2(ga[4] * sigmoid_f(gg[4]), ga[5] * sigmoid_f(gg[5])); w.w = pk2(ga[6] * sigmoid_f(gg[6]), ga[7] * sigmoid_f(gg[7]));
                *(LAS u32x4*)(lds + r * 1024 + lane * 16) = w;
            }
        }
        __syncthreads();
        f32x2 acc[32];
#pragma unroll
        for (int ii = 0; ii < 32; ++ii) acc[ii] = bcf;
        conv_rows<0>(lds + (32 * th) * 1024 + ch2 * 2, wcf, acc);
        __syncthreads();
#pragma unroll
        for (int ii = 0; ii < 32; ++ii) *(LAS f32x2*)(lds + (32 * th + ii) * 2048 + ch2 * 4) = acc[ii];
        __syncthreads();
        {
            float lng[8], lnb[8];
            { const f32x4 a = *(const f32x4*)(P.ln_g + 8 * lane), c = *(const f32x4*)(P.ln_g + 8 * lane + 4), d = *(const f32x4*)(P.ln_b + 8 * lane), e = *(const f32x4*)(P.ln_b + 8 * lane + 4);
              lng[0] = a.x; lng[1] = a.y; lng[2] = a.z; lng[3] = a.w; lng[4] = c.x; lng[5] = c.y; lng[6] = c.z; lng[7] = c.w;
              lnb[0] = d.x; lnb[1] = d.y; lnb[2] = d.z; lnb[3] = d.w; lnb[4] = e.x; lnb[5] = e.y; lnb[6] = e.z; lnb[7] = e.w; }
            float wsc[3][8];
#pragma unroll
            for (int j = 0; j < 3; ++j) { const f32x4 a = *(const f32x4*)(P.sc_w + j * 512 + 8 * lane), c = *(const f32x4*)(P.sc_w + j * 512 + 8 * lane + 4);
                wsc[j][0] = a.x; wsc[j][1] = a.y; wsc[j][2] = a.z; wsc[j][3] = a.w; wsc[j][4] = c.x; wsc[j][5] = c.y; wsc[j][6] = c.z; wsc[j][7] = c.w; }
            float cxa[8], cxb[8];
            { float xv[8], cgv[8]; const int pos = NMETA + s0 + 8 * wave - 2;
              proj8_at(PROJ, MP, MR, b, pos, 8 * lane, xv); proj8_at(PROJ, MP, MR, b, pos, 1024 + 8 * lane, cgv);
#pragma unroll
              for (int i = 0; i < 8; ++i) cxa[i] = xv[i] * cgv[i];
              proj8_at(PROJ, MP, MR, b, pos + 1, 8 * lane, xv); proj8_at(PROJ, MP, MR, b, pos + 1, 1024 + 8 * lane, cgv);
#pragma unroll
              for (int i = 0; i < 8; ++i) cxb[i] = xv[i] * cgv[i]; }
#pragma unroll 2
            for (int q = 0; q < 8; ++q) {
                const int ii = 8 * wave + q, s = s0 + ii; const size_t t = (size_t)b * SEQ + s;
                float o[8];
                { const f32x4 a = *(const LAS f32x4*)(lds + ii * 2048 + lane * 32), c = *(const LAS f32x4*)(lds + ii * 2048 + lane * 32 + 16);
                  o[0] = a.x; o[1] = a.y; o[2] = a.z; o[3] = a.w; o[4] = c.x; o[5] = c.y; o[6] = c.z; o[7] = c.w; }
                float s1 = 0.f;
#pragma unroll
                for (int i = 0; i < 8; ++i) s1 += o[i];
                const float mean = wave_sum_fast(s1) * (1.f / 512.f);
                float s2 = 0.f;
#pragma unroll
                for (int i = 0; i < 8; ++i) { o[i] -= mean; s2 += o[i] * o[i]; }
                const float rs = rsqrtf(wave_sum_fast(s2) * (1.f / 512.f) + EPS);
                float s3 = 0.f;
#pragma unroll
                for (int i = 0; i < 8; ++i) { float y = o[i] * rs * lng[i] + lnb[i]; y = y * sigmoid_f(y); o[i] = y; s3 += y * y; }
                const float r2 = rsqrtf(wave_sum_fast(s3) * (1.f / 512.f) + EPS);
                u32x4 wv; wv.x = pk2(o[0] * r2, o[1] * r2); wv.y = pk2(o[2] * r2, o[3] * r2); wv.z = pk2(o[4] * r2, o[5] * r2); wv.w = pk2(o[6] * r2, o[7] * r2);
                *(u32x4*)(Y + t * DM + 512 + 8 * lane) = wv;
                float xv[8], cgv[8], bgv[8], cxc[8], accs[8];
                proj8_at(PROJ, MP, MR, b, NMETA + s, 8 * lane, xv); proj8_at(PROJ, MP, MR, b, NMETA + s, 1024 + 8 * lane, cgv); proj8_at(PROJ, MP, MR, b, NMETA + s, 512 + 8 * lane, bgv);
                float s4 = 0.f;
#pragma unroll
                for (int i = 0; i < 8; ++i) { cxc[i] = xv[i] * cgv[i]; accs[i] = bgv[i] * (wsc[0][i] * cxa[i] + wsc[1][i] * cxb[i] + wsc[2][i] * cxc[i]); s4 += accs[i] * accs[i]; cxa[i] = cxb[i]; cxb[i] = cxc[i]; }
                const float r4 = rsqrtf(wave_sum_fast(s4) * (1.f / 512.f) + EPS);
                u32x4 wz; wz.x = pk2(accs[0] * r4, accs[1] * r4); wz.y = pk2(accs[2] * r4, accs[3] * r4); wz.z = pk2(accs[4] * r4, accs[5] * r4); wz.w = pk2(accs[6] * r4, accs[7] * r4);
                *(u32x4*)(Y + t * DM + 8 * lane) = wz;
            }
        }
        __syncthreads();
    }
}

__device__ __forceinline__ int ord_i(float s) { int k = __builtin_bit_cast(int, s); k ^= (k >> 31) & 0x7fffffff; return k; }
__device__ __forceinline__ float unord_f(int k) { k ^= (k >> 31) & 0x7fffffff; return __builtin_bit_cast(float, k); }
#define TOP_INSERT(L, x_) do { int _x = (x_); _Pragma("unroll") for (int _i = 0; _i < 16; ++_i) { const int _hi = max(L[_i], _x); _x = min(L[_i], _x); L[_i] = _hi; } } while (0)

typedef short bf16x8 __attribute__((ext_vector_type(8)));
typedef float f32x16 __attribute__((ext_vector_type(16)));
template <bool DESC> __device__ __forceinline__ void ce_i(int& a, int& b) { const int hi = max(a, b), lo = min(a, b); if (DESC) { a = hi; b = lo; } else { a = lo; b = hi; } }
__device__ __forceinline__ void bitonic_sort16(int (&a)[16]) {
#pragma unroll
    for (int k = 2; k <= 16; k <<= 1)
#pragma unroll
        for (int j = k >> 1; j > 0; j >>= 1)
#pragma unroll
            for (int i = 0; i < 16; ++i) { const int l = i ^ j; if (l > i) { if ((i & k) == 0) ce_i<true>(a[i], a[l]); else ce_i<false>(a[i], a[l]); } }
}
__device__ __forceinline__ void bitonic_merge16(int (&a)[16]) {
#pragma unroll
    for (int j = 8; j > 0; j >>= 1)
#pragma unroll
        for (int i = 0; i < 16; ++i) { const int l = i ^ j; if (l > i) ce_i<true>(a[i], a[l]); }
}
__device__ __forceinline__ void merge_top16(int (&a)[16], const int (&b)[16]) {
#pragma unroll
    for (int i = 0; i < 16; ++i) a[i] = max(a[i], b[15 - i]);
    bitonic_merge16(a);
}
__device__ __forceinline__ int lut16(const unsigned (&T)[4], int i) {
    const unsigned sel = (unsigned)(i & 7) | 0x0c0c0c00u;
    const unsigned lo = __builtin_amdgcn_perm(T[1], T[0], sel), hi = __builtin_amdgcn_perm(T[3], T[2], sel);
    return (int)((i & 8) ? hi : lo);
}
constexpr int KROW = 272;
constexpr float SCORE_BIAS = 8.0f;

__device__ __forceinline__ void route_half(const LAS unsigned char* kl, const bf16* qrow, int nl, int hb, int (&L)[16]) {
    bf16x8 qf[8];
#pragma unroll
    for (int ks = 0; ks < 8; ++ks) qf[ks] = *(const bf16x8*)(qrow + 64 * hb + 8 * ks);
    f32x16 acc[4];
#pragma unroll
    for (int nt = 0; nt < 4; ++nt)
#pragma unroll
        for (int r = 0; r < 16; ++r) acc[nt][r] = SCORE_BIAS;
#pragma unroll
    for (int ks = 0; ks < 8; ++ks)
#pragma unroll
        for (int nt = 0; nt < 4; ++nt) {
            const bf16x8 a = *(const LAS bf16x8*)(kl + (32 * nt + nl) * KROW + (64 * hb + 8 * ks) * 2);
            acc[nt] = __builtin_amdgcn_mfma_f32_32x32x16_bf16(a, qf[ks], acc[nt], 0, 0, 0);
        }
    const int hb4 = 4 * hb;
    int T[4][16];
#pragma unroll
    for (int nt = 0; nt < 4; ++nt)
#pragma unroll
        for (int r = 0; r < 16; ++r) { const int n0 = 32 * nt + (r & 3) + 8 * (r >> 2); const float sc = acc[nt][r];
            T[nt][r] = (__float_as_int(sc) & ~127) | ((127 - n0) - hb4); }
    bitonic_sort16(T[0]); bitonic_sort16(T[1]); bitonic_sort16(T[2]); bitonic_sort16(T[3]);
    merge_top16(T[0], T[1]); merge_top16(T[2], T[3]); merge_top16(T[0], T[2]);
#pragma unroll
    for (int i = 0; i < 16; ++i) { const unsigned v = (unsigned)T[0][15 - i]; auto r = __builtin_amdgcn_permlane32_swap(v, v, false, false);
        const unsigned r0 = r[0], r1 = r[1]; const int partner = (int)(hb ? r0 : r1); L[i] = max(T[0][i], partner); }
    bitonic_merge16(L);
}

__device__ __forceinline__ void phase_route(const Params& P, LAS unsigned char* lds) {
    const int tid = threadIdx.x, lane = tid & 63, wave = __builtin_amdgcn_readfirstlane(tid >> 6);
    const int nl = lane & 31, hb = lane >> 5;
    unsigned char* ws = P.ws;
    const bf16* KEYS = (const bf16*)(ws + WS_KEYS); const bf16* Q = (const bf16*)(ws + WS_Q);
    int* IDX = (int*)(ws + WS_IDX); float* GATE = (float*)(ws + WS_GATE);
    int last_h = -1;
    for (int unit = blockIdx.x; unit < (NTOK / 256) * NHEAD; unit += gridDim.x) {
        const int h = unit & 7, tb = unit >> 3;
        if (h != last_h) {
            __syncthreads();
            for (int c = tid; c < 4096; c += NTHREADS) { const u32x4 v = ((const u32x4*)(KEYS + (size_t)h * 32768))[c];
                *(LAS u32x4*)(lds + (c >> 4) * KROW + (c & 15) * 16) = v; }
            __syncthreads();
            last_h = h;
        }
        const size_t t = (size_t)tb * 256 + wave * 32 + nl;
        int L1[16], L2[16];
        route_half(lds, Q + t * 2048 + h * 256, nl, hb, L1);
        route_half(lds + 128 * KROW, Q + t * 2048 + h * 256 + 128, nl, hb, L2);
        float v1[16], v2[16];
#pragma unroll
        for (int i = 0; i < 16; ++i) { v1[i] = __int_as_float(L1[i] & ~127); v2[i] = __int_as_float(L2[i] & ~127); }
#define CAND(i, j) ((__float_as_int(v1[i] + v2[j]) & ~255) | (255 - (16 * (i) + (j))))
        int A[16], B[16], C[16];
#pragma unroll
        for (int j = 0; j < 16; ++j) A[j] = CAND(0, j);
#pragma unroll
        for (int j = 0; j < 8; ++j) { B[j] = CAND(1, j); B[8 + j] = CAND(15 - j, 0); }
        bitonic_merge16(B);
        C[0] = CAND(2, 0); C[1] = CAND(2, 1); C[2] = CAND(2, 2); C[3] = CAND(2, 3); C[4] = CAND(2, 4);
        C[5] = CAND(3, 0); C[6] = CAND(3, 1); C[7] = CAND(3, 2); C[8] = CAND(3, 3);
        C[9] = CAND(4, 0); C[10] = CAND(4, 1); C[11] = CAND(4, 2);
        C[12] = CAND(5, 0); C[13] = CAND(5, 1); C[14] = CAND(6, 0); C[15] = CAND(6, 1);
        bitonic_sort16(C);
        { const int d0 = CAND(7, 0), d1 = CAND(7, 1); C[14] = max(C[14], d1); C[15] = max(C[15], d0); bitonic_merge16(C); }
#undef CAND
        merge_top16(A, B); merge_top16(A, C);
        unsigned T1[4], T2[4];
#pragma unroll
        for (int q = 0; q < 4; ++q) {
            T1[q] = (unsigned)(127 - (L1[4 * q] & 127)) | ((unsigned)(127 - (L1[4 * q + 1] & 127)) << 8) | ((unsigned)(127 - (L1[4 * q + 2] & 127)) << 16) | ((unsigned)(127 - (L1[4 * q + 3] & 127)) << 24);
            T2[q] = (unsigned)(127 - (L2[4 * q] & 127)) | ((unsigned)(127 - (L2[4 * q + 1] & 127)) << 8) | ((unsigned)(127 - (L2[4 * q + 2] & 127)) << 16) | ((unsigned)(127 - (L2[4 * q + 3] & 127)) << 24); }
        float val[16]; int ex[16];
#pragma unroll
        for (int k = 0; k < 16; ++k) { const int pos = 255 - (A[k] & 255); val[k] = __int_as_float(A[k] & ~255);
            ex[k] = lut16(T1, pos >> 4) * NKEYS + lut16(T2, pos & 15); }
        float sum = 0.f; const float vmax = val[0];
#pragma unroll
        for (int k = 0; k < 16; ++k) { val[k] = __expf(val[k] - vmax); sum += val[k]; }
        const float inv = 1.f / sum;
        if (hb == 0) {
            int* ip = IDX + t * NSEL + h * TOPK; float* gp = GATE + t * NSEL + h * TOPK;
#pragma unroll
            for (int k4 = 0; k4 < 4; ++k4) {
                *(int4*)(ip + 4 * k4) = make_int4(ex[4 * k4], ex[4 * k4 + 1], ex[4 * k4 + 2], ex[4 * k4 + 3]);
                *(f32x4*)(gp + 4 * k4) = (f32x4){val[4 * k4] * inv, val[4 * k4 + 1] * inv, val[4 * k4 + 2] * inv, val[4 * k4 + 3] * inv};
            }
        }
    }
}

__device__ __forceinline__ float dot16_fp8(const u32x4 r, const f32x4 (&xs)[4]) {
    float p = 0.f;
    const unsigned rw[4] = {r.x, r.y, r.z, r.w};
#pragma unroll
    for (int j = 0; j < 4; ++j) { const f32x2 lo = __builtin_amdgcn_cvt_pk_f32_fp8((int)rw[j], false), hi = __builtin_amdgcn_cvt_pk_f32_fp8((int)rw[j], true);
        p += (lo.x * xs[j].x + lo.y * xs[j].y) + (hi.x * xs[j].z + hi.y * xs[j].w); }
    return p;
}
__device__ __forceinline__ void axpy16_fp8(const u32x4 r, float w, f32x4 (&o)[4]) {
    const unsigned rw[4] = {r.x, r.y, r.z, r.w};
#pragma unroll
    for (int j = 0; j < 4; ++j) { const f32x2 lo = __builtin_amdgcn_cvt_pk_f32_fp8((int)rw[j], false), hi = __builtin_amdgcn_cvt_pk_f32_fp8((int)rw[j], true);
        o[j].x += w * lo.x; o[j].y += w * lo.y; o[j].z += w * hi.x; o[j].w += w * hi.y; }
}
__device__ __forceinline__ void phase_gather(const Params& P, LAS unsigned char* lds) {
    const int tid = threadIdx.x, lane = tid & 63, wave = __builtin_amdgcn_readfirstlane(tid >> 6);
    const int gw = blockIdx.x * NWAVES + wave, NGW = gridDim.x * NWAVES;
    unsigned char* ws = P.ws;
    const int* IDX = (const int*)(ws + WS_IDX); const float* GATE = (const float*)(ws + WS_GATE);
    const unsigned char* U8 = ws + WS_U8; const unsigned char* V8 = ws + WS_V8;
    const bf16* H2B = (const bf16*)(ws + WS_H2B); const float* SSQ = (const float*)(ws + WS_SSQ);
    f32x4 gfin[4];
#pragma unroll
    for (int j = 0; j < 4; ++j) gfin[j] = ((const f32x4*)P.g_fin)[64 * j + lane];
    for (int t = gw; t < NTOK; t += NGW) {
        const int idx0 = IDX[(size_t)t * NSEL + lane], idx1 = IDX[(size_t)t * NSEL + 64 + lane];
        const float g0 = GATE[(size_t)t * NSEL + lane], g1 = GATE[(size_t)t * NSEL + 64 + lane];
        float sq = (lane < 16) ? SSQ[(size_t)t * 16 + lane] : 0.f; sq = wave_sum(sq);
        const float rstd2 = rsqrtf(sq * (1.f / DM) + EPS);
        f32x4 xs[4];
#pragma unroll
        for (int j = 0; j < 4; ++j) { const u32x2 w = ((const u32x2*)(H2B + (size_t)t * DM))[64 * j + lane]; xs[j] = (f32x4){bflo(w.x), bfhi(w.x), bflo(w.y), bfhi(w.y)}; }
        float z0 = 0.f, z1 = 0.f;
#pragma unroll 8
        for (int k = 0; k < 64; ++k) { const int e = __builtin_amdgcn_readlane(idx0, k);
            const u32x4 r = *(const u32x4*)(U8 + (size_t)e * DM + 16 * lane);
            const float p = wave_sum(dot16_fp8(r, xs)); z0 = (lane == k) ? p : z0; }
#pragma unroll 8
        for (int k = 0; k < 64; ++k) { const int e = __builtin_amdgcn_readlane(idx1, k);
            const u32x4 r = *(const u32x4*)(U8 + (size_t)e * DM + 16 * lane);
            const float p = wave_sum(dot16_fp8(r, xs)); z1 = (lane == k) ? p : z1; }
        const float zs = rstd2 * (1.f / U_SCALE);
        const float a0 = gelu_tanh_f(z0 * zs) * g0, a1 = gelu_tanh_f(z1 * zs) * g1;
        f32x4 o[4];
#pragma unroll
        for (int j = 0; j < 4; ++j) o[j] = (f32x4){0.f, 0.f, 0.f, 0.f};
#pragma unroll 8
        for (int k = 0; k < 64; ++k) { const int e = __builtin_amdgcn_readlane(idx0, k);
            const float w = __builtin_bit_cast(float, __builtin_amdgcn_readlane(__builtin_bit_cast(int, a0), k));
            const u32x4 r = *(const u32x4*)(V8 + (size_t)e * DM + 16 * lane); axpy16_fp8(r, w, o); }
#pragma unroll 8
        for (int k = 0; k < 64; ++k) { const int e = __builtin_amdgcn_readlane(idx1, k);
            const float w = __builtin_bit_cast(float, __builtin_amdgcn_readlane(__builtin_bit_cast(int, a1), k));
            const u32x4 r = *(const u32x4*)(V8 + (size_t)e * DM + 16 * lane); axpy16_fp8(r, w, o); }
        float ss = 0.f;
#pragma unroll
        for (int j = 0; j < 4; ++j) { o[j] = xs[j] + o[j] * (1.f / V_SCALE); ss += (o[j].x * o[j].x + o[j].y * o[j].y) + (o[j].z * o[j].z + o[j].w * o[j].w); }
        ss = wave_sum(ss);
        const float r3 = rsqrtf(ss * (1.f / DM) + EPS);
        f32x4* op = (f32x4*)(P.out + (size_t)t * DM) + lane;
#pragma unroll
        for (int j = 0; j < 4; ++j) op[64 * j] = o[j] * r3 * gfin[j];
    }
}

__device__ __forceinline__ void phase_gather_f32(const Params& P, LAS unsigned char* lds) {
    const int tid = threadIdx.x, lane = tid & 63, wave = __builtin_amdgcn_readfirstlane(tid >> 6);
    const int gw = blockIdx.x * NWAVES + wave, NGW = gridDim.x * NWAVES;
    unsigned char* ws = P.ws;
    const int* IDX = (const int*)(ws + WS_IDX); const float* GATE = (const float*)(ws + WS_GATE);
    const unsigned char* U8 = ws + WS_U8; const unsigned char* V8 = ws + WS_V8;
    const bf16* H2B = (const bf16*)(ws + WS_H2B); const float* SSQ = (const float*)(ws + WS_SSQ);
    f32x4 gfin[4], gff[4];
#pragma unroll
    for (int j = 0; j < 4; ++j) gff[j] = ((const f32x4*)P.g_ffn)[64 * j + lane];
#pragma unroll
    for (int j = 0; j < 4; ++j) gfin[j] = ((const f32x4*)P.g_fin)[64 * j + lane];
    for (int t = gw; t < NTOK; t += NGW) {
        const int idx0 = IDX[(size_t)t * NSEL + lane], idx1 = IDX[(size_t)t * NSEL + 64 + lane];
        const float g0 = GATE[(size_t)t * NSEL + lane], g1 = GATE[(size_t)t * NSEL + 64 + lane];
        float sq = (lane < 16) ? SSQ[(size_t)t * 16 + lane] : 0.f; sq = wave_sum(sq);
        const float rstd2 = rsqrtf(sq * (1.f / DM) + EPS);
        f32x4 xs[4];
#pragma unroll
        for (int j = 0; j < 4; ++j) { const u32x2 w = ((const u32x2*)(H2B + (size_t)t * DM))[64 * j + lane]; xs[j] = (f32x4){bflo(w.x), bfhi(w.x), bflo(w.y), bfhi(w.y)}; }
        float z0 = 0.f, z1 = 0.f;
#pragma unroll 8
        for (int k = 0; k < 64; ++k) { const int e = __builtin_amdgcn_readlane(idx0, k);
            const f32x4* ur = (const f32x4*)(P.pu + (size_t)e * DM) + lane; float pp = 0.f;
            for (int j = 0; j < 4; ++j) { const f32x4 uu = ur[64 * j] * gff[j]; pp += (uu.x * xs[j].x + uu.y * xs[j].y) + (uu.z * xs[j].z + uu.w * xs[j].w); }
            const float p = wave_sum(pp); z0 = (lane == k) ? p : z0; }
#pragma unroll 8
        for (int k = 0; k < 64; ++k) { const int e = __builtin_amdgcn_readlane(idx1, k);
            const f32x4* ur = (const f32x4*)(P.pu + (size_t)e * DM) + lane; float pp = 0.f;
            for (int j = 0; j < 4; ++j) { const f32x4 uu = ur[64 * j] * gff[j]; pp += (uu.x * xs[j].x + uu.y * xs[j].y) + (uu.z * xs[j].z + uu.w * xs[j].w); }
            const float p = wave_sum(pp); z1 = (lane == k) ? p : z1; }
        const float zs = rstd2;
        const float a0 = gelu_tanh_f(z0 * zs) * g0, a1 = gelu_tanh_f(z1 * zs) * g1;
        f32x4 o[4];
#pragma unroll
        for (int j = 0; j < 4; ++j) o[j] = (f32x4){0.f, 0.f, 0.f, 0.f};
#pragma unroll 8
        for (int k = 0; k < 64; ++k) { const int e = __builtin_amdgcn_readlane(idx0, k);
            const float w = __builtin_bit_cast(float, __builtin_amdgcn_readlane(__builtin_bit_cast(int, a0), k));
            const f32x4* vr = (const f32x4*)(P.pv + (size_t)e * DM) + lane;
            for (int j = 0; j < 4; ++j) o[j] += vr[64 * j] * w; }
#pragma unroll 8
        for (int k = 0; k < 64; ++k) { const int e = __builtin_amdgcn_readlane(idx1, k);
            const float w = __builtin_bit_cast(float, __builtin_amdgcn_readlane(__builtin_bit_cast(int, a1), k));
            const f32x4* vr = (const f32x4*)(P.pv + (size_t)e * DM) + lane;
            for (int j = 0; j < 4; ++j) o[j] += vr[64 * j] * w; }
        float ss = 0.f;
#pragma unroll
        for (int j = 0; j < 4; ++j) { o[j] = xs[j] + o[j]; ss += (o[j].x * o[j].x + o[j].y * o[j].y) + (o[j].z * o[j].z + o[j].w * o[j].w); }
        ss = wave_sum(ss);
        const float r3 = rsqrtf(ss * (1.f / DM) + EPS);
        f32x4* op = (f32x4*)(P.out + (size_t)t * DM) + lane;
#pragma unroll
        for (int j = 0; j < 4; ++j) op[64 * j] = o[j] * r3 * gfin[j];
    }
}

#define XB_TMO      128
#define XB_XCNT(j)  (256  + 64 * (j))
#define XB_XSUB(j)  (1280 + 64 * (j))
#define XB_XGEN(j)  (2304 + 64 * (j))
#define XB_TOP      3328
#define XB_TOPGEN   3392
#define XCD_BAR_WORDS 3456
#define XB_SPIN_CAP (1u << 18)

__device__ __forceinline__ unsigned xb_ld(unsigned* p)              { return __hip_atomic_load(p, __ATOMIC_RELAXED, __HIP_MEMORY_SCOPE_AGENT); }
__device__ __forceinline__ unsigned xb_add(unsigned* p, unsigned v) { return __hip_atomic_fetch_add(p, v, __ATOMIC_RELAXED, __HIP_MEMORY_SCOPE_AGENT); }
__device__ __forceinline__ unsigned xb_xcc_id() { return (unsigned)__builtin_amdgcn_s_getreg((3 << 11) | 20) & 0xFu; }
#define XB_SPIN(cond, bar) do { unsigned _sp = 0; while (cond) { __builtin_amdgcn_s_sleep(1); \
    if ((++_sp & 255u) == 0u) { if (xb_ld(&(bar)[XB_TMO])) break; if (_sp > XB_SPIN_CAP) { atomicAdd(&(bar)[XB_TMO], 1u); break; } } } } while (0)

struct XcdBarrier {
    unsigned* bar; unsigned x;
    volatile LAS unsigned* st;
};

__device__ __forceinline__ XcdBarrier xcd_barrier_post(unsigned* bar, volatile LAS unsigned* st) {
    XcdBarrier b; b.bar = bar; b.x = xb_xcc_id(); b.st = st;
    if (threadIdx.x == 0) (void)xb_add(&bar[XB_XCNT(b.x)], 1u);
    return b;
}
__device__ __forceinline__ void xcd_barrier_complete(unsigned* bar, unsigned x, unsigned& nloc, unsigned& nx) {
    const unsigned G = gridDim.x * gridDim.y * gridDim.z;
    unsigned sum, cnt, mine, sp = 0u;
    for (;;) {
        sum = 0u; cnt = 0u; mine = 0u;
#pragma unroll
        for (unsigned j = 0; j < 16; ++j) { const unsigned c = xb_ld(&bar[XB_XCNT(j)]); sum += c; cnt += (c > 0u) ? 1u : 0u; mine = (j == x) ? c : mine; }
        if (sum == G) break;
        __builtin_amdgcn_s_sleep(1);
        if ((++sp & 255u) == 0u) { if (xb_ld(&bar[XB_TMO])) break; if (sp > XB_SPIN_CAP) { atomicAdd(&bar[XB_TMO], 1u); break; } }
    }
    nloc = mine > 0u ? mine : 1u; nx = cnt > 0u ? cnt : 1u;
}

__device__ __forceinline__ void xcd_barrier(const XcdBarrier& b) {
    asm volatile("s_waitcnt vmcnt(0)" ::: "memory");
    __syncthreads();
    if (threadIdx.x == 0) {
        unsigned* bar = b.bar;
        __builtin_amdgcn_s_waitcnt(0);
        unsigned nloc = b.st[0], nx = b.st[1];
        if (nloc == 0u) { xcd_barrier_complete(bar, b.x, nloc, nx); b.st[0] = nloc; b.st[1] = nx; }
        const unsigned old = xb_add(&bar[XB_XSUB(b.x)], 1u);
        const unsigned gen = old / nloc;
        if (old + 1u == (gen + 1u) * nloc) {
            __builtin_amdgcn_fence(__ATOMIC_RELEASE, "agent");
            asm volatile("s_waitcnt vmcnt(0)" ::: "memory");
            const unsigned og = xb_add(&bar[XB_TOP], 1u);
            const unsigned tg = og / nx;
            if (og + 1u == (tg + 1u) * nx) xb_add(&bar[XB_TOPGEN], 1u);
            else XB_SPIN(xb_ld(&bar[XB_TOPGEN]) == tg, bar);
            __builtin_amdgcn_fence(__ATOMIC_ACQUIRE, "agent");
            xb_add(&bar[XB_XGEN(b.x)], 1u);
            asm volatile("s_waitcnt vmcnt(0)" ::: "memory");
        } else {
            XB_SPIN(xb_ld(&bar[XB_XGEN(b.x)]) == gen, bar);
            __builtin_amdgcn_fence(__ATOMIC_ACQUIRE, "agent");
            asm volatile("s_waitcnt vmcnt(0)" ::: "memory");
        }
    }
    __syncthreads();
}


#ifndef MK_MULTI
#define MK_MULTI 0
#endif
constexpr int NPHASE = 7;
#ifndef REP5
#define REP5 1
#endif
#ifndef REP6
#define REP6 1
#endif
__global__ void __launch_bounds__(NTHREADS, 2) mk_fwd(Params P) {
    extern __shared__ __attribute__((aligned(16))) unsigned char lds_raw[];
    LAS unsigned char* lds = (LAS unsigned char*)lds_raw;
    cg::grid_group grid = cg::this_grid();
    unsigned char* ws = P.ws;
    const int lo = P.ph_lo, hi = P.ph_hi;
    volatile LAS unsigned* bst = (volatile LAS unsigned*)(lds + 131072 + 64);
    if (threadIdx.x < 2) bst[threadIdx.x] = 0u;
    __syncthreads();
    XcdBarrier xbar = xcd_barrier_post((unsigned*)(ws + WS_CTL), bst);
#define IN(k) (lo <= (k) && (k) < hi)
#define SEAM(k) do { if (IN(k) && IN((k) + 1)) { if ((k) == 0) grid.sync(); else xcd_barrier(xbar); } } while (0)
#ifndef SKIP0
    if (IN(0)) phase_prep(P, lds);
#endif
    SEAM(0);
#ifndef SKIP1
    if (IN(1)) {
        phase_metaproj(P);
        pg8::Gemm g{(const bf16*)(ws + WS_H0B), (const bf16*)(ws + WS_WIN_T), NTOK, DIN, DM}; pg8::StaticOrder S; S.init(NTOK, DIN, (int)gridDim.x, (int)blockIdx.x);
        EpiRowScale<0> E{(bf16*)(ws + WS_PROJ), DIN, (const float*)(ws + WS_RSTD1)};
        pg8::gemm_phase<EpiRowScale<0>, pg8::StaticOrder, true, true>(lds, g, S, E);
    }
#endif
    SEAM(1);
#ifndef SKIP2
    if (IN(2)) phase_conv(P, lds);
#endif
    SEAM(2);
#ifndef SKIP3
    if (IN(3)) {
        pg8::Gemm g{(const bf16*)(ws + WS_Y), (const bf16*)(ws + WS_WOUT_T), NTOK, DM, DM}; pg8::StaticOrder S; S.init(NTOK, DM, (int)gridDim.x, (int)blockIdx.x);
        EpiResidual E{(bf16*)(ws + WS_H2B), P.x, (float*)(ws + WS_SSQ)};
        pg8::gemm_phase<EpiResidual, pg8::StaticOrder, true, true>(lds, g, S, E);
    }
#endif
    SEAM(3);
#ifndef SKIP4
    if (IN(4)) {
        pg8::Gemm g{(const bf16*)(ws + WS_H2B), (const bf16*)(ws + WS_WQ_T), NTOK, 2048, DM}; pg8::StaticOrder S; S.init(NTOK, 2048, (int)gridDim.x, (int)blockIdx.x);
        EpiRowScale<1> E{(bf16*)(ws + WS_Q), 2048, (const float*)(ws + WS_SSQ)};
        pg8::gemm_phase<EpiRowScale<1>, pg8::StaticOrder, true, true>(lds, g, S, E);
    }
#endif
    SEAM(4);
#ifndef SKIP5
    if (IN(5)) for (int rep = 0; rep < REP5; ++rep) phase_route(P, lds);
#endif
    SEAM(5);
#ifndef SKIP6
#ifdef GATHER_F32
    if (IN(6)) phase_gather_f32(P, lds);
#else
    if (IN(6)) for (int rep = 0; rep < REP6; ++rep) phase_gather(P, lds);
#endif
#endif
#undef IN
#undef SEAM
}

extern "C" void kernel_launch(void* const* d_in, const int* in_sizes, int n_in, void* d_out, int out_size, void* d_ws, size_t ws_size, hipStream_t stream) {
    static int grid = 0;
    if (grid == 0) {
        if (n_in != 18 || in_sizes[0] != NTOK * DM || out_size != NTOK * DM || ws_size < WS_END) {
            fprintf(stderr, "kernel_launch: unexpected shapes (n_in %d in0 %d out %d ws %zu)\n", n_in, n_in > 0 ? in_sizes[0] : -1, out_size, ws_size); grid = -1; return; }
        int dev = 0, cus = 0, per_cu = 0;
        (void)hipGetDevice(&dev); (void)hipDeviceGetAttribute(&cus, hipDeviceAttributeMultiprocessorCount, dev);
        if (hipFuncSetAttribute((const void*)mk_fwd, hipFuncAttributeMaxDynamicSharedMemorySize, LDS_BYTES) != hipSuccess) { fprintf(stderr, "kernel_launch: hipFuncSetAttribute failed\n"); grid = -1; return; }
        if (hipOccupancyMaxActiveBlocksPerMultiprocessor(&per_cu, (const void*)mk_fwd, NTHREADS, LDS_BYTES) != hipSuccess || per_cu < 1) { fprintf(stderr, "kernel_launch: occupancy query failed (%d)\n", per_cu); (void)hipGetLastError(); per_cu = 1; }
        if (per_cu > 1) per_cu = 1;
        grid = cus * per_cu;
        if (grid <= 0) grid = 256;
    }
    if (grid < 0) return;
    Params p{};
    p.x = (const float*)d_in[0]; p.meta = (const float*)d_in[1]; p.g_mix = (const float*)d_in[2]; p.w_in = (const float*)d_in[3]; p.sc_w = (const float*)d_in[4];
    p.cf_w = (const float*)d_in[5]; p.cf_b = (const float*)d_in[6]; p.ln_g = (const float*)d_in[7]; p.ln_b = (const float*)d_in[8]; p.g_sc = (const float*)d_in[9];
    p.g_cf = (const float*)d_in[10]; p.w_out = (const float*)d_in[11]; p.g_ffn = (const float*)d_in[12]; p.w_q = (const float*)d_in[13]; p.keys = (const float*)d_in[14];
    p.pu = (const float*)d_in[15]; p.pv = (const float*)d_in[16]; p.g_fin = (const float*)d_in[17];
    p.out = (float*)d_out; p.ws = (unsigned char*)d_ws;
    (void)hipMemsetAsync((char*)d_ws + WS_CTL, 0, 16384, stream);
#if MK_MULTI
    for (int ph = 0; ph < NPHASE; ++ph) { p.ph_lo = ph; p.ph_hi = ph + 1; p.coop = 0; p.pad = 0;
        hipLaunchKernelGGL(mk_fwd, dim3(grid), dim3(NTHREADS), LDS_BYTES, stream, p); }
#else
    p.ph_lo = 0; p.ph_hi = NPHASE; p.coop = 1; p.pad = 0;
    void* args[] = {&p};
    hipError_t e = hipLaunchCooperativeKernel((const void*)mk_fwd, dim3(grid), dim3(NTHREADS), args, LDS_BYTES, stream);
    if (e != hipSuccess) fprintf(stderr, "cooperative launch failed: %s (grid %d)\n", hipGetErrorString(e), grid);
#endif
}
```

```cpp
#include <hip/hip_runtime.h>
#include <hip/hip_cooperative_groups.h>
#include <cstdio>
#include <cstdint>
namespace cg = cooperative_groups;

namespace pg8 {
#define PG8_LAS __attribute__((address_space(3)))
typedef unsigned short bf16_t;
typedef short bf16x8 __attribute__((ext_vector_type(8)));
typedef float f32x4 __attribute__((ext_vector_type(4)));
typedef unsigned u32x4 __attribute__((ext_vector_type(4)));
constexpr int BM = 256, BK = 64, HALF = 128, HTB = HALF * BK * 2  , STAGE_BYTES = 8 * HTB, NXCD = 8, WGM = 8;

__host__ __device__ __forceinline__ int lds_byte(int r, int c) { const int st = (r >> 4) * 2 + (c >> 5), rr = r & 15, cc = c & 31, ob = rr * 64 + cc * 2; return st * 1024 + (ob ^ (((ob >> 9) & 1) << 5)); }
__host__ __device__ __forceinline__ void stage_rc(int b, int& R, int& C) { const int st = b / 1024, sb = b % 1024, swz = sb ^ (((sb >> 9) & 1) << 5); R = (st >> 1) * 16 + swz / 64; C = (st & 1) * 32 + (swz % 64) / 2; }
__host__ __device__ __forceinline__ int perm32(int rho) { const int n = rho >> 4, i = rho & 15; return 8 * (i >> 2) + 4 * n + (i & 3); }

struct Unit { int pm, pn; };
struct Gemm { const bf16_t* A; const bf16_t* Bt; int M, N, K; };

struct StaticOrder {
    int nM, nN, nwg, G, c;
    __host__ __device__ void init(int M, int N, int G_, int c_) { nM = M / BM; nN = N / BM; nwg = nM * nN; G = G_; c = c_; }
    __host__ __device__ bool next(int i, Unit& u) const {
        const long L = (long)i * G + c; if (L >= nwg) return false;
        int wgid = (int)L; { const int q = nwg / NXCD, r = nwg % NXCD, xcd = wgid % NXCD, off = wgid / NXCD; wgid = (xcd < r ? xcd * (q + 1) : r * (q + 1) + (xcd - r) * q) + off; }
        const int nig = WGM * nN, gid = wgid / nig, fm = gid * WGM, gsz = (nM - fm) < WGM ? (nM - fm) : WGM;
        u.pm = fm + ((wgid % nig) % gsz); u.pn = (wgid % nig) / gsz; return true;
    }
    __device__ __forceinline__ void a_ready(const Unit&) const {}
    __device__ __forceinline__ void done(const Unit&) const {}
};

template <class Epi, class Sched, bool ALIGN_EPI = false, bool SP2 = false>
__device__ __forceinline__ void gemm_phase(PG8_LAS unsigned char* lds, const Gemm g, const Sched& S, const Epi& E) {
    const int tid = threadIdx.x, wid = __builtin_amdgcn_readfirstlane(tid >> 6), lane = tid & 63, wr = wid >> 2, wc = wid & 3, fr = lane & 15, fq = lane >> 4;
    const int K = g.K, nt = K / BK;
    unsigned voffA[2], voffB[2];
#pragma unroll
    for (int i = 0; i < 2; ++i) { int R, C; stage_rc(tid * 16 + i * 8192, R, C); const int Rb = Epi::PERM ? ((R & ~31) + perm32(R & 31)) : R;
        voffA[i] = (unsigned)(R * K + C) * 2u; voffB[i] = (unsigned)(Rb * K + C) * 2u; }
    const size_t kstep = (size_t)(BK * 2);
    const size_t hstep = (size_t)HALF * K * 2;
    const size_t tstep = 2 * hstep;
    const unsigned ldsw = (unsigned)wid * 1024u;
    const int aoff = lds_byte(wr * 64 + fr, fq * 8), boff = lds_byte(wc * 32 + fr, fq * 8);
#define PG8_SA(b, h) (((b) * 2 + (h)) * HTB)
#define PG8_SB(b, h) ((4 + (b) * 2 + (h)) * HTB)
#define PG8_STAGE(bufoff, gbase, voff) do { _Pragma("unroll") for (int _i = 0; _i < 2; ++_i) \
        __builtin_amdgcn_global_load_lds((const unsigned*)((const char*)(gbase) + (voff)[_i]), (PG8_LAS unsigned*)(lds + (bufoff) + ldsw + _i * 8192), 16, 0, 0); } while (0)
#define PG8_LDA(dst, b, h) do { _Pragma("unroll") for (int m = 0; m < 4; ++m) _Pragma("unroll") for (int k = 0; k < 2; ++k) dst[m][k] = *(const PG8_LAS bf16x8*)(lds + PG8_SA(b, h) + aoff + m * 2048 + k * 1024); } while (0)
#define PG8_LDB(dst, b, h) do { _Pragma("unroll") for (int n = 0; n < 2; ++n) _Pragma("unroll") for (int k = 0; k < 2; ++k) dst[n][k] = *(const PG8_LAS bf16x8*)(lds + PG8_SB(b, h) + boff + n * 2048 + k * 1024); } while (0)
#define PG8_MMA(ai, bj, At, Bt) do { __builtin_amdgcn_s_setprio(1); _Pragma("unroll") for (int m = 0; m < 4; ++m) _Pragma("unroll") for (int n = 0; n < 2; ++n) _Pragma("unroll") for (int k = 0; k < 2; ++k) \
        acc[ai][bj][m][n] = __builtin_amdgcn_mfma_f32_16x16x32_bf16(Bt[n][k], At[m][k], acc[ai][bj][m][n], 0, 0, 0); __builtin_amdgcn_s_setprio(0); } while (0)
#define PG8_WAIT_V(n) asm volatile("s_waitcnt vmcnt(" #n ")" ::: "memory")
#define PG8_WAIT_L(n) asm volatile("s_waitcnt lgkmcnt(" #n ")" ::: "memory")
#define PG8_BAR __builtin_amdgcn_s_barrier()
#define PG8_SCHED __builtin_amdgcn_sched_barrier(0)
    Unit cur, nxt; int ui = 0;
    if (!S.next(0, cur)) return;
    f32x4 acc[2][2][4][2];
#pragma unroll
    for (int a = 0; a < 2; ++a)
#pragma unroll
        for (int b = 0; b < 2; ++b)
#pragma unroll
            for (int m = 0; m < 4; ++m)
#pragma unroll
                for (int n = 0; n < 2; ++n) acc[a][b][m][n] = (f32x4){0.f, 0.f, 0.f, 0.f};
    bf16x8 At[4][2], B0[2][2], B1[2][2];
    const char* cA = (const char*)g.A + (size_t)cur.pm * tstep; const char* cB = (const char*)g.Bt + (size_t)cur.pn * tstep;
    S.a_ready(cur);
    if constexpr (SP2) {
        PG8_STAGE(PG8_SB(0, 0), cB, voffB); PG8_STAGE(PG8_SB(0, 1), cB + hstep, voffB); PG8_STAGE(PG8_SA(0, 0), cA, voffA); PG8_STAGE(PG8_SA(0, 1), cA + hstep, voffA);
        if (wr == 1) PG8_BAR;
        PG8_WAIT_V(2); PG8_BAR;
        PG8_STAGE(PG8_SB(1, 0), cB + kstep, voffB); PG8_STAGE(PG8_SA(1, 0), cA + kstep, voffA); PG8_STAGE(PG8_SB(1, 1), cB + hstep + kstep, voffB);
        PG8_WAIT_V(6); PG8_BAR;
    } else {
        PG8_STAGE(PG8_SB(0, 0), cB, voffB); PG8_STAGE(PG8_SA(0, 0), cA, voffA); PG8_STAGE(PG8_SB(0, 1), cB + hstep, voffB); PG8_STAGE(PG8_SA(0, 1), cA + hstep, voffA);
        if (wr == 1) PG8_BAR;
        PG8_WAIT_V(4); PG8_BAR;
        PG8_STAGE(PG8_SB(1, 0), cB + kstep, voffB); PG8_STAGE(PG8_SA(1, 0), cA + kstep, voffA); PG8_STAGE(PG8_SB(1, 1), cB + hstep + kstep, voffB);
        PG8_WAIT_V(6); PG8_BAR;
    }
    for (;;) {
        const bool has_next = S.next(ui + 1, nxt);
        const char* nA = has_next ? (const char*)g.A + (size_t)nxt.pm * tstep : cA; const char* nB = has_next ? (const char*)g.Bt + (size_t)nxt.pn * tstep : cB;
        for (int t = 0; t < nt; t += 2) {
            const bool last = (t == nt - 2);
            const char* a1 = cA + (size_t)(t + 1) * kstep;
            const char* a2 = last ? nA : cA + (size_t)(t + 2) * kstep; const char* b2 = last ? nB : cB + (size_t)(t + 2) * kstep;
            const char* a3 = a2 + kstep; const char* b3 = b2 + kstep;
            if (last && has_next) S.a_ready(nxt);
            if constexpr (SP2) {
            PG8_LDB(B0, 0, 0); PG8_LDB(B1, 0, 1); PG8_SCHED; PG8_LDA(At, 0, 0); PG8_STAGE(PG8_SA(1, 1), a1 + hstep, voffA);
            PG8_WAIT_V(8); PG8_WAIT_L(0); PG8_BAR; PG8_MMA(0, 0, At, B0); PG8_MMA(0, 1, At, B1); PG8_BAR; PG8_SCHED;
            PG8_LDA(At, 0, 1); PG8_STAGE(PG8_SB(0, 0), b2, voffB); PG8_STAGE(PG8_SB(0, 1), b2 + hstep, voffB); PG8_STAGE(PG8_SA(0, 0), a2, voffA);
            PG8_WAIT_V(8); PG8_WAIT_L(0); PG8_BAR; PG8_MMA(1, 0, At, B0); PG8_MMA(1, 1, At, B1); PG8_BAR; PG8_SCHED;
            PG8_LDB(B0, 1, 0); PG8_LDB(B1, 1, 1); PG8_SCHED; PG8_LDA(At, 1, 0); PG8_STAGE(PG8_SA(0, 1), a2 + hstep, voffA);
            PG8_WAIT_V(8); PG8_WAIT_L(0); PG8_BAR; PG8_MMA(0, 0, At, B0); PG8_MMA(0, 1, At, B1); PG8_BAR; PG8_SCHED;
            PG8_LDA(At, 1, 1); PG8_STAGE(PG8_SB(1, 0), b3, voffB); PG8_STAGE(PG8_SB(1, 1), b3 + hstep, voffB); PG8_STAGE(PG8_SA(1, 0), a3, voffA);
            PG8_WAIT_V(8); PG8_WAIT_L(0); PG8_BAR; PG8_MMA(1, 0, At, B0); PG8_MMA(1, 1, At, B1); PG8_BAR; PG8_SCHED;
            } else {
            PG8_LDB(B0, 0, 0); PG8_SCHED; PG8_LDA(At, 0, 0); PG8_STAGE(PG8_SA(1, 1), a1 + hstep, voffA);
            PG8_WAIT_L(8); PG8_BAR; PG8_WAIT_L(0); PG8_MMA(0, 0, At, B0); PG8_BAR; PG8_SCHED;
            PG8_LDB(B1, 0, 1); PG8_STAGE(PG8_SB(0, 0), b2, voffB);
            PG8_BAR; PG8_WAIT_L(0); PG8_MMA(0, 1, At, B1); PG8_BAR;
            PG8_LDA(At, 0, 1); PG8_STAGE(PG8_SA(0, 0), a2, voffA);
            PG8_BAR; PG8_WAIT_L(0); PG8_MMA(1, 0, At, B0); PG8_BAR; PG8_SCHED;
            PG8_STAGE(PG8_SB(0, 1), b2 + hstep, voffB);
            PG8_WAIT_V(6); PG8_BAR; PG8_MMA(1, 1, At, B1); PG8_BAR;
            PG8_LDB(B0, 1, 0); PG8_SCHED; PG8_LDA(At, 1, 0); PG8_STAGE(PG8_SA(0, 1), a2 + hstep, voffA);
            PG8_WAIT_L(8); PG8_BAR; PG8_WAIT_L(0); PG8_MMA(0, 0, At, B0); PG8_BAR; PG8_SCHED;
            PG8_LDB(B1, 1, 1); PG8_STAGE(PG8_SB(1, 0), b3, voffB);
            PG8_BAR; PG8_WAIT_L(0); PG8_MMA(0, 1, At, B1); PG8_BAR;
            PG8_LDA(At, 1, 1); PG8_STAGE(PG8_SA(1, 0), a3, voffA);
            PG8_BAR; PG8_WAIT_L(0); PG8_MMA(1, 0, At, B0); PG8_BAR; PG8_SCHED;
            PG8_STAGE(PG8_SB(1, 1), b3 + hstep, voffB);
            PG8_WAIT_V(6); PG8_BAR; PG8_MMA(1, 1, At, B1); PG8_BAR;
            }
        }
        if constexpr (ALIGN_EPI) { if (wr == 0) PG8_BAR; }
        if constexpr (!Epi::AFTER_DRAIN) { E(acc, cur, wr, wc, fr, fq); S.done(cur); }
        if (!has_next) break;
#pragma unroll
        for (int a = 0; a < 2; ++a)
#pragma unroll
            for (int b = 0; b < 2; ++b)
#pragma unroll
                for (int m = 0; m < 4; ++m)
#pragma unroll
                    for (int n = 0; n < 2; ++n) acc[a][b][m][n] = (f32x4){0.f, 0.f, 0.f, 0.f};
        cur = nxt; cA = nA; cB = nB; ++ui;
        if constexpr (ALIGN_EPI) { if (wr == 1) PG8_BAR; }
    }
    PG8_WAIT_V(0);
    if constexpr (!ALIGN_EPI) { if (wr == 0) PG8_BAR; }
    PG8_BAR;
    if constexpr (Epi::AFTER_DRAIN) { E.fused(acc, cur, wr, wc, fr, fq, lds, wid, lane); S.done(cur); }
#undef PG8_SA
#undef PG8_SB
#undef PG8_STAGE
#undef PG8_LDA
#undef PG8_LDB
#undef PG8_MMA
#undef PG8_WAIT_V
#undef PG8_WAIT_L
#undef PG8_BAR
#undef PG8_SCHED
}
}

#define LAS __attribute__((address_space(3)))
typedef unsigned short bf16;
typedef float f32x2 __attribute__((ext_vector_type(2)));
typedef float f32x4 __attribute__((ext_vector_type(4)));
typedef unsigned u32x2 __attribute__((ext_vector_type(2)));
typedef unsigned u32x4 __attribute__((ext_vector_type(4)));

constexpr int NTOK = 32768, DM = 1024, DIN = 2560, SEQ = 8192, NBATCH = 4, NMETA = 16;
constexpr int NHEAD = 8, NKEYS = 128, TOPK = 16, NSEL = NHEAD * TOPK;
constexpr float EPS = 1e-6f;
constexpr float U_SCALE = 64.f, V_SCALE = 16.f;
constexpr int NWAVES = 8, NTHREADS = 512;
constexpr int LDS_BYTES = 147456;

constexpr size_t MiB = 1u << 20;
constexpr size_t WS_CTL = 0, WS_WIN_T = 1 * MiB, WS_WOUT_T = 6 * MiB, WS_WQ_T = 8 * MiB, WS_KEYS = 12 * MiB, WS_METAPART = 13 * MiB,
                 WS_METARSTD = 14 * MiB + 512 * 1024, WS_METAPROJ = 14 * MiB + 576 * 1024, WS_RSTD1 = 15 * MiB, WS_SSQ = 16 * MiB, WS_U8 = 32 * MiB, WS_V8 = 48 * MiB,
                 WS_IDX = 64 * MiB, WS_GATE = 80 * MiB, WS_H0B = 96 * MiB, WS_H2B = 96 * MiB, WS_Y = 160 * MiB, WS_PROJ = 224 * MiB,
                 WS_Q = 224 * MiB, WS_ESCALE = 18 * MiB, WS_END = 384 * MiB;

struct Params {
    const float* x; const float* meta; const float* g_mix; const float* w_in; const float* sc_w; const float* cf_w; const float* cf_b;
    const float* ln_g; const float* ln_b; const float* g_sc; const float* g_cf; const float* w_out; const float* g_ffn; const float* w_q;
    const float* keys; const float* pu; const float* pv; const float* g_fin;
    float* out; unsigned char* ws;
    int ph_lo, ph_hi, coop, pad;
};

__device__ __forceinline__ unsigned f2bf(float f) { unsigned u = __builtin_bit_cast(unsigned, f); return (u + 0x7fffu + ((u >> 16) & 1u)) >> 16; }
__device__ __forceinline__ unsigned pk2(float lo, float hi) { return f2bf(lo) | (f2bf(hi) << 16); }
__device__ __forceinline__ float bf2f(unsigned b) { return __builtin_bit_cast(float, b << 16); }
__device__ __forceinline__ float bflo(unsigned w) { return __builtin_bit_cast(float, w << 16); }
__device__ __forceinline__ float bfhi(unsigned w) { return __builtin_bit_cast(float, w & 0xffff0000u); }
__device__ __forceinline__ float wave_sum(float v) {
#pragma unroll
    for (int o = 1; o < 64; o <<= 1) v += __shfl_xor(v, o);
    return v;
}
__device__ __forceinline__ float sigmoid_f(float x) { return 1.f / (1.f + __expf(-x)); }
__device__ __forceinline__ float gelu_tanh_f(float x) {
    const float t = 0.7978845608028654f * (x + 0.044715f * x * x * x);
    const float e = __expf(2.f * t);
    const float th = 1.f - 2.f / (e + 1.f);
    return 0.5f * x * (1.f + th);
}

__device__ __forceinline__ unsigned cvt_pk_bf16(float lo, float hi) { unsigned r; asm volatile("v_cvt_pk_bf16_f32 %0, %1, %2" : "=v"(r) : "v"(lo), "v"(hi)); return r; }

template <int MODE> struct EpiRowScale {
    static constexpr bool PERM = true, AFTER_DRAIN = false;
    bf16* O; int ldc; const float* rs;
    __device__ __forceinline__ void operator()(const pg8::f32x4 (&acc)[2][2][4][2], const pg8::Unit& u, int wr, int wc, int fr, int fq) const {
        const int row0 = u.pm * 256 + wr * 64 + fr, col0 = u.pn * 256 + wc * 32 + 8 * fq;
#pragma unroll
        for (int ai = 0; ai < 2; ++ai)
#pragma unroll
            for (int m = 0; m < 4; ++m) {
                const int row = row0 + ai * 128 + m * 16;
                float s;
                if (MODE == 0) s = rs[row];
                else { const f32x4* p = (const f32x4*)(rs + (size_t)row * 16); const f32x4 a = p[0], b = p[1], c = p[2], d = p[3];
                       const float t = ((a.x + a.y) + (a.z + a.w)) + ((b.x + b.y) + (b.z + b.w)) + ((c.x + c.y) + (c.z + c.w)) + ((d.x + d.y) + (d.z + d.w));
                       s = rsqrtf(t * (1.f / 1024.f) + EPS); }
                bf16* rowp = O + (size_t)row * ldc + col0;
#pragma unroll
                for (int bj = 0; bj < 2; ++bj) { const pg8::f32x4 v0 = acc[ai][bj][m][0] * s, v1 = acc[ai][bj][m][1] * s;
                    u32x4 w; w.x = cvt_pk_bf16(v0[0], v0[1]); w.y = cvt_pk_bf16(v0[2], v0[3]); w.z = cvt_pk_bf16(v1[0], v1[1]); w.w = cvt_pk_bf16(v1[2], v1[3]);
                    *(u32x4*)(rowp + bj * 128) = w; }
            }
    }
};
struct EpiResidual {
    static constexpr bool PERM = true, AFTER_DRAIN = false;
    bf16* O; const float* X; float* ssq;
    __device__ __forceinline__ void operator()(const pg8::f32x4 (&acc)[2][2][4][2], const pg8::Unit& u, int wr, int wc, int fr, int fq) const {
        const int row0 = u.pm * 256 + wr * 64 + fr, col0 = u.pn * 256 + wc * 32 + 8 * fq;
#pragma unroll
        for (int ai = 0; ai < 2; ++ai)
#pragma unroll
            for (int m = 0; m < 4; ++m) {
                const int row = row0 + ai * 128 + m * 16;
                const float* xr = X + (size_t)row * DM + col0; bf16* rowp = O + (size_t)row * DM + col0;
                float q = 0.f;
#pragma unroll
                for (int bj = 0; bj < 2; ++bj) { const f32x4 x0 = *(const f32x4*)(xr + bj * 128), x1 = *(const f32x4*)(xr + bj * 128 + 4);
                    const pg8::f32x4 v0 = acc[ai][bj][m][0] + x0, v1 = acc[ai][bj][m][1] + x1;
                    q += (v0[0] * v0[0] + v0[1] * v0[1]) + (v0[2] * v0[2] + v0[3] * v0[3]) + (v1[0] * v1[0] + v1[1] * v1[1]) + (v1[2] * v1[2] + v1[3] * v1[3]);
                    u32x4 w; w.x = cvt_pk_bf16(v0[0], v0[1]); w.y = cvt_pk_bf16(v0[2], v0[3]); w.z = cvt_pk_bf16(v1[0], v1[1]); w.w = cvt_pk_bf16(v1[2], v1[3]);
                    *(u32x4*)(rowp + bj * 128) = w; }
                q += __shfl_xor(q, 16); q += __shfl_xor(q, 32);
                if (fq == 0) ssq[(size_t)row * 16 + u.pn * 4 + wc] = q;
            }
    }
};

__device__ __forceinline__ void p0_transpose_item(const float* W, int K, int N, bf16* WT, LAS float* scr, int item, int lane,
                                                  const float* g_lo, const float* g_hi, int split) {
    const int nblk = N / 32, kb = item / nblk, nb = item % nblk, k0 = 64 * kb, n0 = 32 * nb;
#pragma unroll 8
    for (int i = 0; i < 32; ++i) { const int kk = 2 * i + (lane >> 5); const int k = k0 + kk;
        const float g = (k < split) ? g_lo[k] : g_hi[k - split];
        scr[kk * 33 + (lane & 31)] = W[(size_t)k * N + n0 + (lane & 31)] * g; }
    asm volatile("s_waitcnt lgkmcnt(0)" ::: "memory");
    const int c = lane & 7;
#pragma unroll
    for (int j = 0; j < 4; ++j) { const int n = (lane >> 3) + 8 * j; const LAS float* s = scr + (8 * c) * 33 + n;
        u32x4 o; o.x = pk2(s[0 * 33], s[1 * 33]); o.y = pk2(s[2 * 33], s[3 * 33]); o.z = pk2(s[4 * 33], s[5 * 33]); o.w = pk2(s[6 * 33], s[7 * 33]);
        *(u32x4*)(WT + (size_t)(n0 + n) * K + k0 + 8 * c) = o; }
    asm volatile("s_waitcnt lgkmcnt(0)" ::: "memory");
}

__device__ __forceinline__ float q4(float x, float inv_s) {
    const float a = fabsf(x) * inv_s; float r;
    if (a < 2.f) r = rintf(a * 2.f) * 0.5f; else if (a < 4.f) r = rintf(a); else r = fminf(6.f, rintf(a * 0.5f) * 2.f);
    return copysignf(r, x);
}
__device__ __forceinline__ void phase_prep(const Params& P, LAS unsigned char* lds) {
    const int tid = threadIdx.x, lane = tid & 63, wave = __builtin_amdgcn_readfirstlane(tid >> 6);
    const int gw = blockIdx.x * NWAVES + wave, NGW = gridDim.x * NWAVES;
    unsigned char* ws = P.ws;
    LAS float* scr = (LAS float*)(lds + wave * 16384);
    constexpr int I_IN = (DM / 64) * (DIN / 32), I_OUT = (DM / 64) * (DM / 32), I_Q = (DM / 64) * (2048 / 32);
    for (int it = gw; it < I_IN + I_OUT + I_Q; it += NGW) {
        int r = it;
        if (r < I_IN) { p0_transpose_item(P.w_in, DM, DIN, (bf16*)(ws + WS_WIN_T), scr, r, lane, P.g_mix, P.g_mix, DM); continue; } r -= I_IN;
        if (r < I_OUT) { p0_transpose_item(P.w_out, DM, DM, (bf16*)(ws + WS_WOUT_T), scr, r, lane, P.g_sc, P.g_cf, 512); continue; } r -= I_OUT;
        p0_transpose_item(P.w_q, DM, 2048, (bf16*)(ws + WS_WQ_T), scr, r, lane, P.g_ffn, P.g_ffn, DM);
    }
    {
        bf16* H0B = (bf16*)(ws + WS_H0B); float* RSTD1 = (float*)(ws + WS_RSTD1);
        for (int t = gw; t < NTOK; t += NGW) {
            const f32x4* xr = (const f32x4*)(P.x + (size_t)t * DM) + lane;
            f32x4 v[4]; float s = 0.f;
#pragma unroll
            for (int j = 0; j < 4; ++j) { v[j] = xr[64 * j]; s += (v[j].x * v[j].x + v[j].y * v[j].y) + (v[j].z * v[j].z + v[j].w * v[j].w); }
            s = wave_sum(s);
            if (lane == 0) RSTD1[t] = rsqrtf(s * (1.f / DM) + EPS);
            u32x2* o = (u32x2*)(H0B + (size_t)t * DM) + lane;
#pragma unroll
            for (int j = 0; j < 4; ++j) { u32x2 w; w.x = pk2(v[j].x, v[j].y); w.y = pk2(v[j].z, v[j].w); o[64 * j] = w; }
        }
    }
    {
        unsigned char* U8 = ws + WS_U8; unsigned char* V8 = ws + WS_V8;
        f32x4 gf[4];
#pragma unroll
        for (int j = 0; j < 4; ++j) gf[j] = ((const f32x4*)P.g_ffn)[64 * j + lane];
        float* ESC = (float*)(ws + WS_ESCALE);
        for (int e = gw; e < 2 * 16384; e += NGW) {
            const bool isv = e >= 16384; const int ee = isv ? e - 16384 : e;
            const f32x4* src = (const f32x4*)((isv ? P.pv : P.pu) + (size_t)ee * DM) + lane;
            f32x4 v[4]; float mx = 0.f;
#pragma unroll
            for (int j = 0; j < 4; ++j) { v[j] = src[64 * j]; if (!isv) v[j] = v[j] * gf[j];
                mx = fmaxf(mx, fmaxf(fmaxf(fabsf(v[j].x), fabsf(v[j].y)), fmaxf(fabsf(v[j].z), fabsf(v[j].w)))); }
#pragma unroll
            for (int o = 1; o < 64; o <<= 1) mx = fmaxf(mx, __shfl_xor(mx, o));
            const float sc = fmaxf(mx, 1e-30f) * (1.f / 6.f), inv = 1.f / sc;
            if (lane == 0) ESC[e] = sc;
            unsigned w0 = 0u, w1 = 0u;
            w0 = __builtin_amdgcn_cvt_scalef32_pk_fp4_f32(w0, v[0].x * inv, v[0].y * inv, 1.0f, 0); w0 = __builtin_amdgcn_cvt_scalef32_pk_fp4_f32(w0, v[0].z * inv, v[0].w * inv, 1.0f, 1);
            w0 = __builtin_amdgcn_cvt_scalef32_pk_fp4_f32(w0, v[1].x * inv, v[1].y * inv, 1.0f, 2); w0 = __builtin_amdgcn_cvt_scalef32_pk_fp4_f32(w0, v[1].z * inv, v[1].w * inv, 1.0f, 3);
            w1 = __builtin_amdgcn_cvt_scalef32_pk_fp4_f32(w1, v[2].x * inv, v[2].y * inv, 1.0f, 0); w1 = __builtin_amdgcn_cvt_scalef32_pk_fp4_f32(w1, v[2].z * inv, v[2].w * inv, 1.0f, 1);
            w1 = __builtin_amdgcn_cvt_scalef32_pk_fp4_f32(w1, v[3].x * inv, v[3].y * inv, 1.0f, 2); w1 = __builtin_amdgcn_cvt_scalef32_pk_fp4_f32(w1, v[3].z * inv, v[3].w * inv, 1.0f, 3);
            u32x2 o; o.x = w0; o.y = w1;
            *(u32x2*)((isv ? V8 : U8) + (size_t)ee * 512 + 8 * lane) = o;
        }
    }
    {
        bf16* KB = (bf16*)(ws + WS_KEYS);
        const int gt = blockIdx.x * NTHREADS + tid, NGT = gridDim.x * NTHREADS;
        for (int i = gt; i < 8 * 2 * 128 * 128 / 4; i += NGT) { const f32x4 v = ((const f32x4*)P.keys)[i]; u32x2 w; w.x = pk2(v.x, v.y); w.y = pk2(v.z, v.w); ((u32x2*)KB)[i] = w; }
    }
    {
        float* MP = (float*)(ws + WS_METAPART); float* MR = (float*)(ws + WS_METARSTD);
        for (int r = gw; r < NMETA; r += NGW) {
            float s = 0.f;
            for (int k = lane; k < DM; k += 64) { const float v = P.meta[r * DM + k]; s += v * v; }
            s = wave_sum(s);
            if (lane == 0) MR[r] = rsqrtf(s * (1.f / DM) + EPS);
        }
        for (int it = gw; it < 8 * 40; it += NGW) {
            const int kc = it / 40, nb = it % 40, n = nb * 64 + lane;
            float acc[NMETA];
#pragma unroll
            for (int r = 0; r < NMETA; ++r) acc[r] = 0.f;
            for (int k = kc * 128; k < kc * 128 + 128; ++k) {
                const float w = P.w_in[(size_t)k * DIN + n] * P.g_mix[k];
#pragma unroll
                for (int r = 0; r < NMETA; ++r) acc[r] += P.meta[r * DM + k] * w;
            }
#pragma unroll
            for (int r = 0; r < NMETA; ++r) MP[(size_t)(kc * 16 + r) * DIN + n] = acc[r];
        }
    }
}

__device__ __forceinline__ void phase_metaproj(const Params& P) {
    const float* MP = (const float*)(P.ws + WS_METAPART); const float* MR = (const float*)(P.ws + WS_METARSTD); float* MJ = (float*)(P.ws + WS_METAPROJ);
    const int gt = blockIdx.x * NTHREADS + threadIdx.x;
    if (gt < NMETA * DIN) { const int p = gt / DIN, col = gt % DIN; float s = 0.f;
#pragma unroll
        for (int kc = 0; kc < 8; ++kc) s += MP[(size_t)(kc * 16 + p) * DIN + col];
        MJ[gt] = s * MR[p]; }
}
__device__ __forceinline__ float meta_val(const float* MJ, const float*, int p, int col) { return MJ[p * DIN + col]; }
__device__ __forceinline__ float proj_at(const bf16* PROJ, const float* MP, const float* MR, int b, int pos, int col) {
    if (pos < 0) return 0.f;
    if (pos < NMETA) return meta_val(MP, MR, pos, col);
    return bf2f(PROJ[(size_t)(b * SEQ + pos - NMETA) * DIN + col]);
}
__device__ __forceinline__ void proj8_at(const bf16* PROJ, const float* MP, const float* MR, int b, int pos, int col, float (&v)[8]) {
    if (pos < 0) {
#pragma unroll
        for (int i = 0; i < 8; ++i) v[i] = 0.f;
    } else if (pos < NMETA) {
        const f32x4 a = *(const f32x4*)(MP + pos * DIN + col), bq = *(const f32x4*)(MP + pos * DIN + col + 4);
        v[0] = a.x; v[1] = a.y; v[2] = a.z; v[3] = a.w; v[4] = bq.x; v[5] = bq.y; v[6] = bq.z; v[7] = bq.w;
    } else {
        const u32x4 w = *(const u32x4*)(PROJ + (size_t)(b * SEQ + pos - NMETA) * DIN + col);
        v[0] = bflo(w.x); v[1] = bfhi(w.x); v[2] = bflo(w.y); v[3] = bfhi(w.y); v[4] = bflo(w.z); v[5] = bfhi(w.z); v[6] = bflo(w.w); v[7] = bfhi(w.w);
    }
}

template <int CTRL> __device__ __forceinline__ float dpp_f(float v) { return __builtin_bit_cast(float, __builtin_amdgcn_update_dpp(0, __builtin_bit_cast(int, v), CTRL, 0xf, 0xf, true)); }
__device__ __forceinline__ float wave_sum_fast(float v) {
    v += dpp_f<0xB1>(v); v += dpp_f<0x4E>(v); v += dpp_f<0x141>(v); v += dpp_f<0x140>(v);
    { auto r = __builtin_amdgcn_permlane16_swap(__float_as_uint(v), __float_as_uint(v), false, false); v = __uint_as_float(r[0]) + __uint_as_float(r[1]); }
    { auto r = __builtin_amdgcn_permlane32_swap(__float_as_uint(v), __float_as_uint(v), false, false); v = __uint_as_float(r[0]) + __uint_as_float(r[1]); }
    return v;
}
template <int R> __device__ __forceinline__ void conv_rows(const LAS unsigned char* ubase, const f32x2 (&wcf)[31], f32x2 (&acc)[32]) {
    if constexpr (R < 62) {
        const unsigned uw = *(const LAS unsigned*)(ubase + R * 1024);
        const f32x2 x = (f32x2){bflo(uw), bfhi(uw)};
        constexpr int lo = R > 30 ? R - 30 : 0, hi = R < 31 ? R : 31;
#pragma unroll
        for (int ii = lo; ii <= hi; ++ii) acc[ii] += wcf[R - ii] * x;
        conv_rows<R + 1>(ubase, wcf, acc);
    }
}
__device__ __forceinline__ void phase_conv(const Params& P, LAS unsigned char* lds) {
    const int tid = threadIdx.x, lane = tid & 63, wave = __builtin_amdgcn_readfirstlane(tid >> 6);
    unsigned char* ws = P.ws;
    const bf16* PROJ = (const bf16*)(ws + WS_PROJ); const float* MP = (const float*)(ws + WS_METAPROJ); const float* MR = nullptr;
    bf16* Y = (bf16*)(ws + WS_Y);
    constexpr int TT = 64, NTILE = NTOK / TT, UROWS = TT + 30;
    const int cgp = wave & 3, th = wave >> 2, ch2 = cgp * 128 + 2 * lane;
    f32x2 wcf[31];
#pragma unroll
    for (int j = 0; j < 31; ++j) wcf[j] = *(const f32x2*)(P.cf_w + j * 512 + ch2);
    const f32x2 bcf = *(const f32x2*)(P.cf_b + ch2);
    for (int tile = blockIdx.x; tile < NTILE; tile += gridDim.x) {
        const int b = tile / (SEQ / TT), s0 = (tile % (SEQ / TT)) * TT;
#pragma unroll 4
        for (int p = 0; p < (UROWS + 7) / 8; ++p) {
            const int r = p * 8 + wave;
            if (r < UROWS) {
                const int pos = NMETA + s0 - 30 + r;
                float ga[8], gg[8];
                proj8_at(PROJ, MP, MR, b, pos, 1536 + 8 * lane, ga); proj8_at(PROJ, MP, MR, b, pos, 2048 + 8 * lane, gg);
                u32x4 w;
                w.x = pk2(ga[0] * sigmoid_f(gg[0]), ga[1] * sigmoid_f(gg[1])); w.y = pk2(ga[2] * sigmoid_f(gg[2]), ga[3] * sigmoid_f(gg[3]));
                w.z = pk2(ga[4] * sigmoid_f(gg[4]), ga[5] * sigmoid_f(gg[5])); w.w = pk2(ga[6] * sigmoid_f(gg[6]), ga[7] * sigmoid_f(gg[7]));
                *(LAS u32x4*)(lds + r * 1024 + lane * 16) = w;
            }
        }
        __syncthreads();
        f32x2 acc[32];
#pragma unroll
        for (int ii = 0; ii < 32; ++ii) acc[ii] = bcf;
        conv_rows<0>(lds + (32 * th) * 1024 + ch2 * 2, wcf, acc);
        __syncthreads();
#pragma unroll
        for (int ii = 0; ii < 32; ++ii) *(LAS f32x2*)(lds + (32 * th + ii) * 2048 + ch2 * 4) = acc[ii];
        __syncthreads();
        {
            float lng[8], lnb[8];
            { const f32x4 a = *(const f32x4*)(P.ln_g + 8 * lane), c = *(const f32x4*)(P.ln_g + 8 * lane + 4), d = *(const f32x4*)(P.ln_b + 8 * lane), e = *(const f32x4*)(P.ln_b + 8 * lane + 4);
              lng[0] = a.x; lng[1] = a.y; lng[2] = a.z; lng[3] = a.w; lng[4] = c.x; lng[5] = c.y; lng[6] = c.z; lng[7] = c.w;
              lnb[0] = d.x; lnb[1] = d.y; lnb[2] = d.z; lnb[3] = d.w; lnb[4] = e.x; lnb[5] = e.y; lnb[6] = e.z; lnb[7] = e.w; }
            float wsc[3][8];
#pragma unroll
            for (int j = 0; j < 3; ++j) { const f32x4 a = *(const f32x4*)(P.sc_w + j * 512 + 8 * lane), c = *(const f32x4*)(P.sc_w + j * 512 + 8 * lane + 4);
                wsc[j][0] = a.x; wsc[j][1] = a.y; wsc[j][2] = a.z; wsc[j][3] = a.w; wsc[j][4] = c.x; wsc[j][5] = c.y; wsc[j][6] = c.z; wsc[j][7] = c.w; }
            float cxa[8], cxb[8];
            { float xv[8], cgv[8]; const int pos = NMETA + s0 + 8 * wave - 2;
              proj8_at(PROJ, MP, MR, b, pos, 8 * lane, xv); proj8_at(PROJ, MP, MR, b, pos, 1024 + 8 * lane, cgv);
#pragma unroll
              for (int i = 0; i < 8; ++i) cxa[i] = xv[i] * cgv[i];
              proj8_at(PROJ, MP, MR, b, pos + 1, 8 * lane, xv); proj8_at(PROJ, MP, MR, b, pos + 1, 1024 + 8 * lane, cgv);
#pragma unroll
              for (int i = 0; i < 8; ++i) cxb[i] = xv[i] * cgv[i]; }
#pragma unroll 2
            for (int q = 0; q < 8; ++q) {
                const int ii = 8 * wave + q, s = s0 + ii; const size_t t = (size_t)b * SEQ + s;
                float o[8];
                { const f32x4 a = *(const LAS f32x4*)(lds + ii * 2048 + lane * 32), c = *(const LAS f32x4*)(lds + ii * 2048 + lane * 32 + 16);
                  o[0] = a.x; o[1] = a.y; o[2] = a.z; o[3] = a.w; o[4] = c.x; o[5] = c.y; o[6] = c.z; o[7] = c.w; }
                float s1 = 0.f;
#pragma unroll
                for (int i = 0; i < 8; ++i) s1 += o[i];
                const float mean = wave_sum_fast(s1) * (1.f / 512.f);
                float s2 = 0.f;
#pragma unroll
                for (int i = 0; i < 8; ++i) { o[i] -= mean; s2 += o[i] * o[i]; }
                const float rs = rsqrtf(wave_sum_fast(s2) * (1.f / 512.f) + EPS);
                float s3 = 0.f;
#pragma unroll
                for (int i = 0; i < 8; ++i) { float y = o[i] * rs * lng[i] + lnb[i]; y = y * sigmoid_f(y); o[i] = y; s3 += y * y; }
                const float r2 = rsqrtf(wave_sum_fast(s3) * (1.f / 512.f) + EPS);
                u32x4 wv; wv.x = pk2(o[0] * r2, o[1] * r2); wv.y = pk2(o[2] * r2, o[3] * r2); wv.z = pk2(o[4] * r2, o[5] * r2); wv.w = pk2(o[6] * r2, o[7] * r2);
                *(u32x4*)(Y + t * DM + 512 + 8 * lane) = wv;
                float xv[8], cgv[8], bgv[8], cxc[8], accs[8];
                proj8_at(PROJ, MP, MR, b, NMETA + s, 8 * lane, xv); proj8_at(PROJ, MP, MR, b, NMETA + s, 1024 + 8 * lane, cgv); proj8_at(PROJ, MP, MR, b, NMETA + s, 512 + 8 * lane, bgv);
                float s4 = 0.f;
#pragma unroll
                for (int i = 0; i < 8; ++i) { cxc[i] = xv[i] * cgv[i]; accs[i] = bgv[i] * (wsc[0][i] * cxa[i] + wsc[1][i] * cxb[i] + wsc[2][i] * cxc[i]); s4 += accs[i] * accs[i]; cxa[i] = cxb[i]; cxb[i] = cxc[i]; }
                const float r4 = rsqrtf(wave_sum_fast(s4) * (1.f / 512.f) + EPS);
                u32x4 wz; wz.x = pk2(accs[0] * r4, accs[1] * r4); wz.y = pk2(accs[2] * r4, accs[3] * r4); wz.z = pk2(accs[4] * r4, accs[5] * r4); wz.w = pk2(accs[6] * r4, accs[7] * r4);
                *(u32x4*)(Y + t * DM + 8 * lane) = wz;
            }
        }
        __syncthreads();
    }
}

__device__ __forceinline__ int ord_i(float s) { int k = __builtin_bit_cast(int, s); k ^= (k >> 31) & 0x7fffffff; return k; }
__device__ __forceinline__ float unord_f(int k) { k ^= (k >> 31) & 0x7fffffff; return __builtin_bit_cast(float, k); }
#define TOP_INSERT(L, x_) do { int _x = (x_); _Pragma("unroll") for (int _i = 0; _i < 16; ++_i) { const int _hi = max(L[_i], _x); _x = min(L[_i], _x); L[_i] = _hi; } } while (0)

typedef short bf16x8 __attribute__((ext_vector_type(8)));
typedef float f32x16 __attribute__((ext_vector_type(16)));
template <bool DESC> __device__ __forceinline__ void ce_i(int& a, int& b) { const int hi = max(a, b), lo = min(a, b); if (DESC) { a = hi; b = lo; } else { a = lo; b = hi; } }
__device__ __forceinline__ void bitonic_sort16(int (&a)[16]) {
#pragma unroll
    for (int k = 2; k <= 16; k <<= 1)
#pragma unroll
        for (int j = k >> 1; j > 0; j >>= 1)
#pragma unroll
            for (int i = 0; i < 16; ++i) { const int l = i ^ j; if (l > i) { if ((i & k) == 0) ce_i<true>(a[i], a[l]); else ce_i<false>(a[i], a[l]); } }
}
__device__ __forceinline__ void bitonic_merge16(int (&a)[16]) {
#pragma unroll
    for (int j = 8; j > 0; j >>= 1)
#pragma unroll
        for (int i = 0; i < 16; ++i) { const int l = i ^ j; if (l > i) ce_i<true>(a[i], a[l]); }
}
__device__ __forceinline__ void merge_top16(int (&a)[16], const int (&b)[16]) {
#pragma unroll
    for (int i = 0; i < 16; ++i) a[i] = max(a[i], b[15 - i]);
    bitonic_merge16(a);
}
__device__ __forceinline__ int lut16(const unsigned (&T)[4], int i) {
    const unsigned sel = (unsigned)(i & 7) | 0x0c0c0c00u;
    const unsigned lo = __builtin_amdgcn_perm(T[1], T[0], sel), hi = __builtin_amdgcn_perm(T[3], T[2], sel);
    return (int)((i & 8) ? hi : lo);
}
constexpr int KROW = 272;
constexpr float SCORE_BIAS = 8.0f;

__device__ __forceinline__ void route_half(const LAS unsigned char* kl, const bf16* qrow, int nl, int hb, int (&L)[16]) {
    bf16x8 qf[8];
#pragma unroll
    for (int ks = 0; ks < 8; ++ks) qf[ks] = *(const bf16x8*)(qrow + 64 * hb + 8 * ks);
    f32x16 acc[4];
#pragma unroll
    for (int nt = 0; nt < 4; ++nt)
#pragma unroll
        for (int r = 0; r < 16; ++r) acc[nt][r] = SCORE_BIAS;
#pragma unroll
    for (int ks = 0; ks < 8; ++ks)
#pragma unroll
        for (int nt = 0; nt < 4; ++nt) {
            const bf16x8 a = *(const LAS bf16x8*)(kl + (32 * nt + nl) * KROW + (64 * hb + 8 * ks) * 2);
            acc[nt] = __builtin_amdgcn_mfma_f32_32x32x16_bf16(a, qf[ks], acc[nt], 0, 0, 0);
        }
    const int hb4 = 4 * hb;
    int T[4][16];
#pragma unroll
    for (int nt = 0; nt < 4; ++nt)
#pragma unroll
        for (int r = 0; r < 16; ++r) { const int n0 = 32 * nt + (r & 3) + 8 * (r >> 2); const float sc = acc[nt][r];
            T[nt][r] = (__float_as_int(sc) & ~127) | ((127 - n0) - hb4); }
    bitonic_sort16(T[0]); bitonic_sort16(T[1]); bitonic_sort16(T[2]); bitonic_sort16(T[3]);
    merge_top16(T[0], T[1]); merge_top16(T[2], T[3]); merge_top16(T[0], T[2]);
#pragma unroll
    for (int i = 0; i < 16; ++i) { const unsigned v = (unsigned)T[0][15 - i]; auto r = __builtin_amdgcn_permlane32_swap(v, v, false, false);
        const unsigned r0 = r[0], r1 = r[1]; const int partner = (int)(hb ? r0 : r1); L[i] = max(T[0][i], partner); }
    bitonic_merge16(L);
}

__device__ __forceinline__ void phase_route(const Params& P, LAS unsigned char* lds) {
    const int tid = threadIdx.x, lane = tid & 63, wave = __builtin_amdgcn_readfirstlane(tid >> 6);
    const int nl = lane & 31, hb = lane >> 5;
    unsigned char* ws = P.ws;
    const bf16* KEYS = (const bf16*)(ws + WS_KEYS); const bf16* Q = (const bf16*)(ws + WS_Q);
    int* IDX = (int*)(ws + WS_IDX); float* GATE = (float*)(ws + WS_GATE);
    int last_h = -1;
    for (int unit = blockIdx.x; unit < (NTOK / 256) * NHEAD; unit += gridDim.x) {
        const int h = unit & 7, tb = unit >> 3;
        if (h != last_h) {
            __syncthreads();
            for (int c = tid; c < 4096; c += NTHREADS) { const u32x4 v = ((const u32x4*)(KEYS + (size_t)h * 32768))[c];
                *(LAS u32x4*)(lds + (c >> 4) * KROW + (c & 15) * 16) = v; }
            __syncthreads();
            last_h = h;
        }
        const size_t t = (size_t)tb * 256 + wave * 32 + nl;
        int L1[16], L2[16];
        route_half(lds, Q + t * 2048 + h * 256, nl, hb, L1);
        route_half(lds + 128 * KROW, Q + t * 2048 + h * 256 + 128, nl, hb, L2);
        float v1[16], v2[16];
#pragma unroll
        for (int i = 0; i < 16; ++i) { v1[i] = __int_as_float(L1[i] & ~127); v2[i] = __int_as_float(L2[i] & ~127); }
#define CAND(i, j) ((__float_as_int(v1[i] + v2[j]) & ~255) | (255 - (16 * (i) + (j))))
        int A[16], B[16], C[16];
#pragma unroll
        for (int j = 0; j < 16; ++j) A[j] = CAND(0, j);
#pragma unroll
        for (int j = 0; j < 8; ++j) { B[j] = CAND(1, j); B[8 + j] = CAND(15 - j, 0); }
        bitonic_merge16(B);
        C[0] = CAND(2, 0); C[1] = CAND(2, 1); C[2] = CAND(2, 2); C[3] = CAND(2, 3); C[4] = CAND(2, 4);
        C[5] = CAND(3, 0); C[6] = CAND(3, 1); C[7] = CAND(3, 2); C[8] = CAND(3, 3);
        C[9] = CAND(4, 0); C[10] = CAND(4, 1); C[11] = CAND(4, 2);
        C[12] = CAND(5, 0); C[13] = CAND(5, 1); C[14] = CAND(6, 0); C[15] = CAND(6, 1);
        bitonic_sort16(C);
        { const int d0 = CAND(7, 0), d1 = CAND(7, 1); C[14] = max(C[14], d1); C[15] = max(C[15], d0); bitonic_merge16(C); }
#undef CAND
        merge_top16(A, B); merge_top16(A, C);
        unsigned T1[4], T2[4];
#pragma unroll
        for (int q = 0; q < 4; ++q) {
            T1[q] = (unsigned)(127 - (L1[4 * q] & 127)) | ((unsigned)(127 - (L1[4 * q + 1] & 127)) << 8) | ((unsigned)(127 - (L1[4 * q + 2] & 127)) << 16) | ((unsigned)(127 - (L1[4 * q + 3] & 127)) << 24);
            T2[q] = (unsigned)(127 - (L2[4 * q] & 127)) | ((unsigned)(127 - (L2[4 * q + 1] & 127)) << 8) | ((unsigned)(127 - (L2[4 * q + 2] & 127)) << 16) | ((unsigned)(127 - (L2[4 * q + 3] & 127)) << 24); }
        float val[16]; int ex[16];
#pragma unroll
        for (int k = 0; k < 16; ++k) { const int pos = 255 - (A[k] & 255); val[k] = __int_as_float(A[k] & ~255);
            ex[k] = lut16(T1, pos >> 4) * NKEYS + lut16(T2, pos & 15); }
        float sum = 0.f; const float vmax = val[0];
#pragma unroll
        for (int k = 0; k < 16; ++k) { val[k] = __expf(val[k] - vmax); sum += val[k]; }
        const float inv = 1.f / sum;
        if (hb == 0) {
            int* ip = IDX + t * NSEL + h * TOPK; float* gp = GATE + t * NSEL + h * TOPK;
#pragma unroll
            for (int k4 = 0; k4 < 4; ++k4) {
                *(int4*)(ip + 4 * k4) = make_int4(ex[4 * k4], ex[4 * k4 + 1], ex[4 * k4 + 2], ex[4 * k4 + 3]);
                *(f32x4*)(gp + 4 * k4) = (f32x4){val[4 * k4] * inv, val[4 * k4 + 1] * inv, val[4 * k4 + 2] * inv, val[4 * k4 + 3] * inv};
            }
        }
    }
}

#define FP4X2(w, sel) __builtin_amdgcn_cvt_scalef32_pk_f32_fp4((w), 1.0f, (sel))
__device__ __forceinline__ float dot16_fp4(const u32x2 r, const f32x4 (&xs)[4]) {
    float p = 0.f;
    { const f32x2 a = FP4X2(r.x, 0), b = FP4X2(r.x, 1), c = FP4X2(r.x, 2), d = FP4X2(r.x, 3);
      p += (a.x * xs[0].x + a.y * xs[0].y) + (b.x * xs[0].z + b.y * xs[0].w); p += (c.x * xs[1].x + c.y * xs[1].y) + (d.x * xs[1].z + d.y * xs[1].w); }
    { const f32x2 a = FP4X2(r.y, 0), b = FP4X2(r.y, 1), c = FP4X2(r.y, 2), d = FP4X2(r.y, 3);
      p += (a.x * xs[2].x + a.y * xs[2].y) + (b.x * xs[2].z + b.y * xs[2].w); p += (c.x * xs[3].x + c.y * xs[3].y) + (d.x * xs[3].z + d.y * xs[3].w); }
    return p;
}
__device__ __forceinline__ void axpy16_fp4(const u32x2 r, float w, f32x4 (&o)[4]) {
    { const f32x2 a = FP4X2(r.x, 0), b = FP4X2(r.x, 1), c = FP4X2(r.x, 2), d = FP4X2(r.x, 3);
      o[0].x += w * a.x; o[0].y += w * a.y; o[0].z += w * b.x; o[0].w += w * b.y; o[1].x += w * c.x; o[1].y += w * c.y; o[1].z += w * d.x; o[1].w += w * d.y; }
    { const f32x2 a = FP4X2(r.y, 0), b = FP4X2(r.y, 1), c = FP4X2(r.y, 2), d = FP4X2(r.y, 3);
      o[2].x += w * a.x; o[2].y += w * a.y; o[2].z += w * b.x; o[2].w += w * b.y; o[3].x += w * c.x; o[3].y += w * c.y; o[3].z += w * d.x; o[3].w += w * d.y; }
}
__device__ __forceinline__ float swap32_add(float a, float b) { auto r = __builtin_amdgcn_permlane32_swap(__float_as_uint(a), __float_as_uint(b), false, false); return __uint_as_float(r[0]) + __uint_as_float(r[1]); }
__device__ __forceinline__ float swap16_add(float a, float b) { auto r = __builtin_amdgcn_permlane16_swap(__float_as_uint(a), __float_as_uint(b), false, false); return __uint_as_float(r[0]) + __uint_as_float(r[1]); }
__device__ __forceinline__ float row_sum16(float v) { v += dpp_f<0xB1>(v); v += dpp_f<0x4E>(v); v += dpp_f<0x141>(v); v += dpp_f<0x140>(v); return v; }
constexpr int GB = 32;
__device__ __forceinline__ void phase_gather(const Params& P, LAS unsigned char* lds) {
    const int tid = threadIdx.x, lane = tid & 63, wave = __builtin_amdgcn_readfirstlane(tid >> 6);
    const int gw = blockIdx.x * NWAVES + wave, NGW = gridDim.x * NWAVES;
    unsigned char* ws = P.ws;
    const int* IDX = (const int*)(ws + WS_IDX); const float* GATE = (const float*)(ws + WS_GATE); const float* ESC = (const float*)(ws + WS_ESCALE);
    const unsigned char* U4 = ws + WS_U8; const unsigned char* V4 = ws + WS_V8;
    const bf16* H2B = (const bf16*)(ws + WS_H2B); const float* SSQ = (const float*)(ws + WS_SSQ);
    const int hh = lane >> 5, rr = (lane >> 4) & 1, i16 = lane & 15, gsel = 4 * i16 + 2 * rr + hh;
    for (int t = gw; t < NTOK; t += NGW) {
        int idx0, idx1; u32x2 hraw[4]; float sqv, g0, g1;
        { const int* ip = IDX + (size_t)t * NSEL; idx0 = ip[lane]; idx1 = ip[64 + lane];
          const u32x2* hp = (const u32x2*)(H2B + (size_t)t * DM);
#pragma unroll
          for (int j = 0; j < 4; ++j) hraw[j] = hp[64 * j + lane];
          sqv = (lane < 16) ? (SSQ + (size_t)t * 16)[lane] : 0.f;
          const float* gp = GATE + (size_t)t * NSEL; g0 = gp[lane]; g1 = gp[64 + lane]; }
        const float su0 = ESC[idx0], su1 = ESC[idx1], sv0 = ESC[16384 + idx0], sv1 = ESC[16384 + idx1];
        const float rstd2 = rsqrtf(wave_sum_fast(sqv) * (1.f / DM) + EPS);
        f32x4 xs[4];
#pragma unroll
        for (int j = 0; j < 4; ++j) xs[j] = (f32x4){bflo(hraw[j].x), bfhi(hraw[j].x), bflo(hraw[j].y), bfhi(hraw[j].y)};
        float zlo = 0.f, zhi = 0.f;
#pragma unroll 1
        for (int bb = 0; bb < 4; ++bb) {
            const int idxr = (bb < 2) ? idx0 : idx1, lb = 32 * (bb & 1);
            u32x2 rows[GB];
#pragma unroll
            for (int j = 0; j < GB; ++j) { const int e = __builtin_amdgcn_readlane(idxr, lb + j); rows[j] = *(const u32x2*)(U4 + (size_t)e * 512 + 8 * lane); }
#pragma unroll
            for (int hf = 0; hf < 2; ++hf) {
                float p[16];
#pragma unroll
                for (int j = 0; j < 16; ++j) p[j] = dot16_fp4(rows[16 * hf + j], xs);
                float s1[8], s2[4];
#pragma unroll
                for (int m = 0; m < 8; ++m) s1[m] = swap32_add(p[2 * m], p[2 * m + 1]);
#pragma unroll
                for (int n = 0; n < 4; ++n) s2[n] = swap16_add(s1[2 * n], s1[2 * n + 1]);
#pragma unroll
                for (int r = 0; r < 4; ++r) { const float z = row_sum16(s2[r]); const bool mine = i16 == ((8 * bb + 4 * hf + r) & 15);
                    zlo = (mine && bb < 2) ? z : zlo; zhi = (mine && bb >= 2) ? z : zhi; }
            }
        }
        const float glo = __shfl(g0, gsel), ghi = __shfl(g1, gsel), sulo = __shfl(su0, gsel), suhi = __shfl(su1, gsel), svlo = __shfl(sv0, gsel), svhi = __shfl(sv1, gsel);
        const float alo = gelu_tanh_f(zlo * rstd2 * sulo) * glo * svlo, ahi = gelu_tanh_f(zhi * rstd2 * suhi) * ghi * svhi;
        f32x4 o[4];
#pragma unroll
        for (int j = 0; j < 4; ++j) o[j] = (f32x4){0.f, 0.f, 0.f, 0.f};
#pragma unroll 1
        for (int bb = 0; bb < 4; ++bb) {
            const int idxr = (bb < 2) ? idx0 : idx1, lb = 32 * (bb & 1), sb = 8 * (bb & 1);
            const int areg = __builtin_bit_cast(int, (bb < 2) ? alo : ahi);
            u32x2 rows[GB];
#pragma unroll
            for (int j = 0; j < GB; ++j) { const int e = __builtin_amdgcn_readlane(idxr, lb + j); rows[j] = *(const u32x2*)(V4 + (size_t)e * 512 + 8 * lane); }
#pragma unroll
            for (int j = 0; j < GB; ++j) { const int src = 32 * (j & 1) + 16 * ((j >> 1) & 1) + (j >> 2) + sb;
                const float w = __builtin_bit_cast(float, __builtin_amdgcn_readlane(areg, src));
                axpy16_fp4(rows[j], w, o); }
        }
        float ss = 0.f;
#pragma unroll
        for (int j = 0; j < 4; ++j) { o[j] = xs[j] + o[j]; ss += (o[j].x * o[j].x + o[j].y * o[j].y) + (o[j].z * o[j].z + o[j].w * o[j].w); }
        ss = wave_sum_fast(ss);
        const float r3 = rsqrtf(ss * (1.f / DM) + EPS);
        f32x4* op = (f32x4*)(P.out + (size_t)t * DM);
        const f32x4* gfp = (const f32x4*)P.g_fin;
#pragma unroll
        for (int j = 0; j < 4; ++j) op[64 * j + lane] = o[j] * r3 * gfp[64 * j + lane];
    }
}

#define XB_TMO      128
#define XB_XCNT(j)  (256  + 64 * (j))
#define XB_XSUB(j)  (1280 + 64 * (j))
#define XB_XGEN(j)  (2304 + 64 * (j))
#define XB_TOP      3328
#define XB_TOPGEN   3392
#define XCD_BAR_WORDS 3456
#define XB_SPIN_CAP (1u << 18)

__device__ __forceinline__ unsigned xb_ld(unsigned* p)              { return __hip_atomic_load(p, __ATOMIC_RELAXED, __HIP_MEMORY_SCOPE_AGENT); }
__device__ __forceinline__ unsigned xb_add(unsigned* p, unsigned v) { return __hip_atomic_fetch_add(p, v, __ATOMIC_RELAXED, __HIP_MEMORY_SCOPE_AGENT); }
__device__ __forceinline__ unsigned xb_xcc_id() { return (unsigned)__builtin_amdgcn_s_getreg((3 << 11) | 20) & 0xFu; }
#define XB_SPIN(cond, bar) do { unsigned _sp = 0; while (cond) { __builtin_amdgcn_s_sleep(1); \
    if ((++_sp & 255u) == 0u) { if (xb_ld(&(bar)[XB_TMO])) break; if (_sp > XB_SPIN_CAP) { atomicAdd(&(bar)[XB_TMO], 1u); break; } } } } while (0)

struct XcdBarrier {
    unsigned* bar; unsigned x;
    volatile LAS unsigned* st;
};

__device__ __forceinline__ XcdBarrier xcd_barrier_post(unsigned* bar, volatile LAS unsigned* st) {
    XcdBarrier b; b.bar = bar; b.x = xb_xcc_id(); b.st = st;
    if (threadIdx.x == 0) (void)xb_add(&bar[XB_XCNT(b.x)], 1u);
    return b;
}
__device__ __forceinline__ void xcd_barrier_complete(unsigned* bar, unsigned x, unsigned& nloc, unsigned& nx) {
    const unsigned G = gridDim.x * gridDim.y * gridDim.z;
    unsigned sum, cnt, mine, sp = 0u;
    for (;;) {
        sum = 0u; cnt = 0u; mine = 0u;
#pragma unroll
        for (unsigned j = 0; j < 16; ++j) { const unsigned c = xb_ld(&bar[XB_XCNT(j)]); sum += c; cnt += (c > 0u) ? 1u : 0u; mine = (j == x) ? c : mine; }
        if (sum == G) break;
        __builtin_amdgcn_s_sleep(1);
        if ((++sp & 255u) == 0u) { if (xb_ld(&bar[XB_TMO])) break; if (sp > XB_SPIN_CAP) { atomicAdd(&bar[XB_TMO], 1u); break; } }
    }
    nloc = mine > 0u ? mine : 1u; nx = cnt > 0u ? cnt : 1u;
}

__device__ __forceinline__ void xcd_barrier(const XcdBarrier& b) {
    asm volatile("s_waitcnt vmcnt(0)" ::: "memory");
    __syncthreads();
    if (threadIdx.x == 0) {
        unsigned* bar = b.bar;
        __builtin_amdgcn_s_waitcnt(0);
        unsigned nloc = b.st[0], nx = b.st[1];
        if (nloc == 0u) { xcd_barrier_complete(bar, b.x, nloc, nx); b.st[0] = nloc; b.st[1] = nx; }
        const unsigned old = xb_add(&bar[XB_XSUB(b.x)], 1u);
        const unsigned gen = old / nloc;
        if (old + 1u == (gen + 1u) * nloc) {
            __builtin_amdgcn_fence(__ATOMIC_RELEASE, "agent");
            asm volatile("s_waitcnt vmcnt(0)" ::: "memory");
            const unsigned og = xb_add(&bar[XB_TOP], 1u);
            const unsigned tg = og / nx;
            if (og + 1u == (tg + 1u) * nx) xb_add(&bar[XB_TOPGEN], 1u);
            else XB_SPIN(xb_ld(&bar[XB_TOPGEN]) == tg, bar);
            __builtin_amdgcn_fence(__ATOMIC_ACQUIRE, "agent");
            xb_add(&bar[XB_XGEN(b.x)], 1u);
            asm volatile("s_waitcnt vmcnt(0)" ::: "memory");
        } else {
            XB_SPIN(xb_ld(&bar[XB_XGEN(b.x)]) == gen, bar);
            __builtin_amdgcn_fence(__ATOMIC_ACQUIRE, "agent");
            asm volatile("s_waitcnt vmcnt(0)" ::: "memory");
        }
    }
    __syncthreads();
}


#ifndef MK_MULTI
#define MK_MULTI 0
#endif
constexpr int NPHASE = 7;
#ifndef REP5
#define REP5 1
#endif
#ifndef REP6
#define REP6 1
#endif
__global__ void __launch_bounds__(NTHREADS, 2) mk_fwd(Params P) {
    extern __shared__ __attribute__((aligned(16))) unsigned char lds_raw[];
    LAS unsigned char* lds = (LAS unsigned char*)lds_raw;
    cg::grid_group grid = cg::this_grid();
    unsigned char* ws = P.ws;
    const int lo = P.ph_lo, hi = P.ph_hi;
    volatile LAS unsigned* bst = (volatile LAS unsigned*)(lds + 131072 + 64);
    if (threadIdx.x < 2) bst[threadIdx.x] = 0u;
    __syncthreads();
    XcdBarrier xbar = xcd_barrier_post((unsigned*)(ws + WS_CTL), bst);
#define IN(k) (lo <= (k) && (k) < hi)
#define SEAM(k) do { if (IN(k) && IN((k) + 1)) { if ((k) == 0) grid.sync(); else xcd_barrier(xbar); } } while (0)
#ifndef SKIP0
    if (IN(0)) phase_prep(P, lds);
#endif
    SEAM(0);
#ifndef SKIP1
    if (IN(1)) {
        phase_metaproj(P);
        pg8::Gemm g{(const bf16*)(ws + WS_H0B), (const bf16*)(ws + WS_WIN_T), NTOK, DIN, DM}; pg8::StaticOrder S; S.init(NTOK, DIN, (int)gridDim.x, (int)blockIdx.x);
        EpiRowScale<0> E{(bf16*)(ws + WS_PROJ), DIN, (const float*)(ws + WS_RSTD1)};
        pg8::gemm_phase<EpiRowScale<0>, pg8::StaticOrder, true, true>(lds, g, S, E);
    }
#endif
    SEAM(1);
#ifndef SKIP2
    if (IN(2)) phase_conv(P, lds);
#endif
    SEAM(2);
#ifndef SKIP3
    if (IN(3)) {
        pg8::Gemm g{(const bf16*)(ws + WS_Y), (const bf16*)(ws + WS_WOUT_T), NTOK, DM, DM}; pg8::StaticOrder S; S.init(NTOK, DM, (int)gridDim.x, (int)blockIdx.x);
        EpiResidual E{(bf16*)(ws + WS_H2B), P.x, (float*)(ws + WS_SSQ)};
        pg8::gemm_phase<EpiResidual, pg8::StaticOrder, true, true>(lds, g, S, E);
    }
#endif
    SEAM(3);
#ifndef SKIP4
    if (IN(4)) {
        pg8::Gemm g{(const bf16*)(ws + WS_H2B), (const bf16*)(ws + WS_WQ_T), NTOK, 2048, DM}; pg8::StaticOrder S; S.init(NTOK, 2048, (int)gridDim.x, (int)blockIdx.x);
        EpiRowScale<1> E{(bf16*)(ws + WS_Q), 2048, (const float*)(ws + WS_SSQ)};
        pg8::gemm_phase<EpiRowScale<1>, pg8::StaticOrder, true, true>(lds, g, S, E);
    }
#endif
    SEAM(4);
#ifndef SKIP5
    if (IN(5)) for (int rep = 0; rep < REP5; ++rep) phase_route(P, lds);
#endif
    SEAM(5);
    if (IN(6)) phase_gather(P, lds);
#undef IN
#undef SEAM
}

extern "C" void kernel_launch(void* const* d_in, const int* in_sizes, int n_in, void* d_out, int out_size, void* d_ws, size_t ws_size, hipStream_t stream) {
    static int grid = 0;
    if (grid == 0) {
        if (n_in != 18 || in_sizes[0] != NTOK * DM || out_size != NTOK * DM || ws_size < WS_END) {
            fprintf(stderr, "kernel_launch: unexpected shapes (n_in %d in0 %d out %d ws %zu)\n", n_in, n_in > 0 ? in_sizes[0] : -1, out_size, ws_size); grid = -1; return; }
        int dev = 0, cus = 0, per_cu = 0;
        (void)hipGetDevice(&dev); (void)hipDeviceGetAttribute(&cus, hipDeviceAttributeMultiprocessorCount, dev);
        if (hipFuncSetAttribute((const void*)mk_fwd, hipFuncAttributeMaxDynamicSharedMemorySize, LDS_BYTES) != hipSuccess) { fprintf(stderr, "kernel_launch: hipFuncSetAttribute failed\n"); grid = -1; return; }
        if (hipOccupancyMaxActiveBlocksPerMultiprocessor(&per_cu, (const void*)mk_fwd, NTHREADS, LDS_BYTES) != hipSuccess || per_cu < 1) { fprintf(stderr, "kernel_launch: occupancy query failed (%d)\n", per_cu); (void)hipGetLastError(); per_cu = 1; }
        if (per_cu > 1) per_cu = 1;
        grid = cus * per_cu;
        if (grid <= 0) grid = 256;
    }
    if (grid < 0) return;
    Params p{};
    p.x = (const float*)d_in[0]; p.meta = (const float*)d_in[1]; p.g_mix = (const float*)d_in[2]; p.w_in = (const float*)d_in[3]; p.sc_w = (const float*)d_in[4];
    p.cf_w = (const float*)d_in[5]; p.cf_b = (const float*)d_in[6]; p.ln_g = (const float*)d_in[7]; p.ln_b = (const float*)d_in[8]; p.g_sc = (const float*)d_in[9];
    p.g_cf = (const float*)d_in[10]; p.w_out = (const float*)d_in[11]; p.g_ffn = (const float*)d_in[12]; p.w_q = (const float*)d_in[13]; p.keys = (const float*)d_in[14];
    p.pu = (const float*)d_in[15]; p.pv = (const float*)d_in[16]; p.g_fin = (const float*)d_in[17];
    p.out = (float*)d_out; p.ws = (unsigned char*)d_ws;
    (void)hipMemsetAsync((char*)d_ws + WS_CTL, 0, 16384, stream);
#if MK_MULTI
    for (int ph = 0; ph < NPHASE; ++ph) { p.ph_lo = ph; p.ph_hi = ph + 1; p.coop = 0; p.pad = 0;
        hipLaunchKernelGGL(mk_fwd, dim3(grid), dim3(NTHREADS), LDS_BYTES, stream, p); }
#else
    p.ph_lo = 0; p.ph_hi = NPHASE; p.coop = 1; p.pad = 0;
    void* args[] = {&p};
    hipError_t e = hipLaunchCooperativeKernel((const void*)mk_fwd, dim3(grid), dim3(NTHREADS), args, LDS_BYTES, stream);
    if (e != hipSuccess) fprintf(stderr, "cooperative launch failed: %s (grid %d)\n", hipGetErrorString(e), grid);
#endif
}
```

```cpp
#include <hip/hip_runtime.h>
#include <hip/hip_cooperative_groups.h>
#include <cstdio>
#include <cstdint>
namespace cg = cooperative_groups;

namespace pg8 {
#define PG8_LAS __attribute__((address_space(3)))
typedef unsigned short bf16_t;
typedef short bf16x8 __attribute__((ext_vector_type(8)));
typedef float f32x4 __attribute__((ext_vector_type(4)));
typedef unsigned u32x4 __attribute__((ext_vector_type(4)));
constexpr int BM = 256, BK = 64, HALF = 128, HTB = HALF * BK * 2  , STAGE_BYTES = 8 * HTB, NXCD = 8, WGM = 8;

__host__ __device__ __forceinline__ int lds_byte(int r, int c) { const int st = (r >> 4) * 2 + (c >> 5), rr = r & 15, cc = c & 31, ob = rr * 64 + cc * 2; return st * 1024 + (ob ^ (((ob >> 9) & 1) << 5)); }
__host__ __device__ __forceinline__ void stage_rc(int b, int& R, int& C) { const int st = b / 1024, sb = b % 1024, swz = sb ^ (((sb >> 9) & 1) << 5); R = (st >> 1) * 16 + swz / 64; C = (st & 1) * 32 + (swz % 64) / 2; }
__host__ __device__ __forceinline__ int perm32(int rho) { const int n = rho >> 4, i = rho & 15; return 8 * (i >> 2) + 4 * n + (i & 3); }

struct Unit { int pm, pn; };
struct Gemm { const bf16_t* A; const bf16_t* Bt; int M, N, K; };

struct StaticOrder {
    int nM, nN, nwg, G, c;
    __host__ __device__ void init(int M, int N, int G_, int c_) { nM = M / BM; nN = N / BM; nwg = nM * nN; G = G_; c = c_; }
    __host__ __device__ bool next(int i, Unit& u) const {
        const long L = (long)i * G + c; if (L >= nwg) return false;
        int wgid = (int)L; { const int q = nwg / NXCD, r = nwg % NXCD, xcd = wgid % NXCD, off = wgid / NXCD; wgid = (xcd < r ? xcd * (q + 1) : r * (q + 1) + (xcd - r) * q) + off; }
        const int nig = WGM * nN, gid = wgid / nig, fm = gid * WGM, gsz = (nM - fm) < WGM ? (nM - fm) : WGM;
        u.pm = fm + ((wgid % nig) % gsz); u.pn = (wgid % nig) / gsz; return true;
    }
    __device__ __forceinline__ void a_ready(const Unit&) const {}
    __device__ __forceinline__ void done(const Unit&) const {}
};

template <class Epi, class Sched, bool ALIGN_EPI = false, bool SP2 = false>
__device__ __forceinline__ void gemm_phase(PG8_LAS unsigned char* lds, const Gemm g, const Sched& S, const Epi& E) {
    const int tid = threadIdx.x, wid = __builtin_amdgcn_readfirstlane(tid >> 6), lane = tid & 63, wr = wid >> 2, wc = wid & 3, fr = lane & 15, fq = lane >> 4;
    const int K = g.K, nt = K / BK;
    unsigned voffA[2], voffB[2];
#pragma unroll
    for (int i = 0; i < 2; ++i) { int R, C; stage_rc(tid * 16 + i * 8192, R, C); const int Rb = Epi::PERM ? ((R & ~31) + perm32(R & 31)) : R;
        voffA[i] = (unsigned)(R * K + C) * 2u; voffB[i] = (unsigned)(Rb * K + C) * 2u; }
    const size_t kstep = (size_t)(BK * 2);
    const size_t hstep = (size_t)HALF * K * 2;
    const size_t tstep = 2 * hstep;
    const unsigned ldsw = (unsigned)wid * 1024u;
    const int aoff = lds_byte(wr * 64 + fr, fq * 8), boff = lds_byte(wc * 32 + fr, fq * 8);
#define PG8_SA(b, h) (((b) * 2 + (h)) * HTB)
#define PG8_SB(b, h) ((4 + (b) * 2 + (h)) * HTB)
#define PG8_STAGE(bufoff, gbase, voff) do { _Pragma("unroll") for (int _i = 0; _i < 2; ++_i) \
        __builtin_amdgcn_global_load_lds((const unsigned*)((const char*)(gbase) + (voff)[_i]), (PG8_LAS unsigned*)(lds + (bufoff) + ldsw + _i * 8192), 16, 0, 0); } while (0)
#define PG8_LDA(dst, b, h) do { _Pragma("unroll") for (int m = 0; m < 4; ++m) _Pragma("unroll") for (int k = 0; k < 2; ++k) dst[m][k] = *(const PG8_LAS bf16x8*)(lds + PG8_SA(b, h) + aoff + m * 2048 + k * 1024); } while (0)
#define PG8_LDB(dst, b, h) do { _Pragma("unroll") for (int n = 0; n < 2; ++n) _Pragma("unroll") for (int k = 0; k < 2; ++k) dst[n][k] = *(const PG8_LAS bf16x8*)(lds + PG8_SB(b, h) + boff + n * 2048 + k * 1024); } while (0)
#define PG8_MMA(ai, bj, At, Bt) do { __builtin_amdgcn_s_setprio(1); _Pragma("unroll") for (int m = 0; m < 4; ++m) _Pragma("unroll") for (int n = 0; n < 2; ++n) _Pragma("unroll") for (int k = 0; k < 2; ++k) \
        acc[ai][bj][m][n] = __builtin_amdgcn_mfma_f32_16x16x32_bf16(Bt[n][k], At[m][k], acc[ai][bj][m][n], 0, 0, 0); __builtin_amdgcn_s_setprio(0); } while (0)
#define PG8_WAIT_V(n) asm volatile("s_waitcnt vmcnt(" #n ")" ::: "memory")
#define PG8_WAIT_L(n) asm volatile("s_waitcnt lgkmcnt(" #n ")" ::: "memory")
#define PG8_BAR __builtin_amdgcn_s_barrier()
#define PG8_SCHED __builtin_amdgcn_sched_barrier(0)
    Unit cur, nxt; int ui = 0;
    if (!S.next(0, cur)) return;
    f32x4 acc[2][2][4][2];
#pragma unroll
    for (int a = 0; a < 2; ++a)
#pragma unroll
        for (int b = 0; b < 2; ++b)
#pragma unroll
            for (int m = 0; m < 4; ++m)
#pragma unroll
                for (int n = 0; n < 2; ++n) acc[a][b][m][n] = (f32x4){0.f, 0.f, 0.f, 0.f};
    bf16x8 At[4][2], B0[2][2], B1[2][2];
    const char* cA = (const char*)g.A + (size_t)cur.pm * tstep; const char* cB = (const char*)g.Bt + (size_t)cur.pn * tstep;
    S.a_ready(cur);
    if constexpr (SP2) {
        PG8_STAGE(PG8_SB(0, 0), cB, voffB); PG8_STAGE(PG8_SB(0, 1), cB + hstep, voffB); PG8_STAGE(PG8_SA(0, 0), cA, voffA); PG8_STAGE(PG8_SA(0, 1), cA + hstep, voffA);
        if (wr == 1) PG8_BAR;
        PG8_WAIT_V(2); PG8_BAR;
        PG8_STAGE(PG8_SB(1, 0), cB + kstep, voffB); PG8_STAGE(PG8_SA(1, 0), cA + kstep, voffA); PG8_STAGE(PG8_SB(1, 1), cB + hstep + kstep, voffB);
        PG8_WAIT_V(6); PG8_BAR;
    } else {
        PG8_STAGE(PG8_SB(0, 0), cB, voffB); PG8_STAGE(PG8_SA(0, 0), cA, voffA); PG8_STAGE(PG8_SB(0, 1), cB + hstep, voffB); PG8_STAGE(PG8_SA(0, 1), cA + hstep, voffA);
        if (wr == 1) PG8_BAR;
        PG8_WAIT_V(4); PG8_BAR;
        PG8_STAGE(PG8_SB(1, 0), cB + kstep, voffB); PG8_STAGE(PG8_SA(1, 0), cA + kstep, voffA); PG8_STAGE(PG8_SB(1, 1), cB + hstep + kstep, voffB);
        PG8_WAIT_V(6); PG8_BAR;
    }
    for (;;) {
        const bool has_next = S.next(ui + 1, nxt);
        const char* nA = has_next ? (const char*)g.A + (size_t)nxt.pm * tstep : cA; const char* nB = has_next ? (const char*)g.Bt + (size_t)nxt.pn * tstep : cB;
        for (int t = 0; t < nt; t += 2) {
            const bool last = (t == nt - 2);
            const char* a1 = cA + (size_t)(t + 1) * kstep;
            const char* a2 = last ? nA : cA + (size_t)(t + 2) * kstep; const char* b2 = last ? nB : cB + (size_t)(t + 2) * kstep;
            const char* a3 = a2 + kstep; const char* b3 = b2 + kstep;
            if (last && has_next) S.a_ready(nxt);
            if constexpr (SP2) {
            PG8_LDB(B0, 0, 0); PG8_LDB(B1, 0, 1); PG8_SCHED; PG8_LDA(At, 0, 0); PG8_STAGE(PG8_SA(1, 1), a1 + hstep, voffA);
            PG8_WAIT_V(8); PG8_WAIT_L(0); PG8_BAR; PG8_MMA(0, 0, At, B0); PG8_MMA(0, 1, At, B1); PG8_BAR; PG8_SCHED;
            PG8_LDA(At, 0, 1); PG8_STAGE(PG8_SB(0, 0), b2, voffB); PG8_STAGE(PG8_SB(0, 1), b2 + hstep, voffB); PG8_STAGE(PG8_SA(0, 0), a2, voffA);
            PG8_WAIT_V(8); PG8_WAIT_L(0); PG8_BAR; PG8_MMA(1, 0, At, B0); PG8_MMA(1, 1, At, B1); PG8_BAR; PG8_SCHED;
            PG8_LDB(B0, 1, 0); PG8_LDB(B1, 1, 1); PG8_SCHED; PG8_LDA(At, 1, 0); PG8_STAGE(PG8_SA(0, 1), a2 + hstep, voffA);
            PG8_WAIT_V(8); PG8_WAIT_L(0); PG8_BAR; PG8_MMA(0, 0, At, B0); PG8_MMA(0, 1, At, B1); PG8_BAR; PG8_SCHED;
            PG8_LDA(At, 1, 1); PG8_STAGE(PG8_SB(1, 0), b3, voffB); PG8_STAGE(PG8_SB(1, 1), b3 + hstep, voffB); PG8_STAGE(PG8_SA(1, 0), a3, voffA);
            PG8_WAIT_V(8); PG8_WAIT_L(0); PG8_BAR; PG8_MMA(1, 0, At, B0); PG8_MMA(1, 1, At, B1); PG8_BAR; PG8_SCHED;
            } else {
            PG8_LDB(B0, 0, 0); PG8_SCHED; PG8_LDA(At, 0, 0); PG8_STAGE(PG8_SA(1, 1), a1 + hstep, voffA);
            PG8_WAIT_L(8); PG8_BAR; PG8_WAIT_L(0); PG8_MMA(0, 0, At, B0); PG8_BAR; PG8_SCHED;
            PG8_LDB(B1, 0, 1); PG8_STAGE(PG8_SB(0, 0), b2, voffB);
            PG8_BAR; PG8_WAIT_L(0); PG8_MMA(0, 1, At, B1); PG8_BAR;
            PG8_LDA(At, 0, 1); PG8_STAGE(PG8_SA(0, 0), a2, voffA);
            PG8_BAR; PG8_WAIT_L(0); PG8_MMA(1, 0, At, B0); PG8_BAR; PG8_SCHED;
            PG8_STAGE(PG8_SB(0, 1), b2 + hstep, voffB);
            PG8_WAIT_V(6); PG8_BAR; PG8_MMA(1, 1, At, B1); PG8_BAR;
            PG8_LDB(B0, 1, 0); PG8_SCHED; PG8_LDA(At, 1, 0); PG8_STAGE(PG8_SA(0, 1), a2 + hstep, voffA);
            PG8_WAIT_L(8); PG8_BAR; PG8_WAIT_L(0); PG8_MMA(0, 0, At, B0); PG8_BAR; PG8_SCHED;
            PG8_LDB(B1, 1, 1); PG8_STAGE(PG8_SB(1, 0), b3, voffB);
            PG8_BAR; PG8_WAIT_L(0); PG8_MMA(0, 1, At, B1); PG8_BAR;
            PG8_LDA(At, 1, 1); PG8_STAGE(PG8_SA(1, 0), a3, voffA);
            PG8_BAR; PG8_WAIT_L(0); PG8_MMA(1, 0, At, B0); PG8_BAR; PG8_SCHED;
            PG8_STAGE(PG8_SB(1, 1), b3 + hstep, voffB);
            PG8_WAIT_V(6); PG8_BAR; PG8_MMA(1, 1, At, B1); PG8_BAR;
            }
        }
        if constexpr (ALIGN_EPI) { if (wr == 0) PG8_BAR; }
        if constexpr (!Epi::AFTER_DRAIN) { E(acc, cur, wr, wc, fr, fq); S.done(cur); }
        if (!has_next) break;
#pragma unroll
        for (int a = 0; a < 2; ++a)
#pragma unroll
            for (int b = 0; b < 2; ++b)
#pragma unroll
                for (int m = 0; m < 4; ++m)
#pragma unroll
                    for (int n = 0; n < 2; ++n) acc[a][b][m][n] = (f32x4){0.f, 0.f, 0.f, 0.f};
        cur = nxt; cA = nA; cB = nB; ++ui;
        if constexpr (ALIGN_EPI) { if (wr == 1) PG8_BAR; }
    }
    PG8_WAIT_V(0);
    if constexpr (!ALIGN_EPI) { if (wr == 0) PG8_BAR; }
    PG8_BAR;
    if constexpr (Epi::AFTER_DRAIN) { E.fused(acc, cur, wr, wc, fr, fq, lds, wid, lane); S.done(cur); }
#undef PG8_SA
#undef PG8_SB
#undef PG8_STAGE
#undef PG8_LDA
#undef PG8_LDB
#undef PG8_MMA
#undef PG8_WAIT_V
#undef PG8_WAIT_L
#undef PG8_BAR
#undef PG8_SCHED
}
}

#define LAS __attribute__((address_space(3)))
typedef unsigned short bf16;
typedef float f32x2 __attribute__((ext_vector_type(2)));
typedef float f32x4 __attribute__((ext_vector_type(4)));
typedef unsigned u32x2 __attribute__((ext_vector_type(2)));
typedef unsigned u32x4 __attribute__((ext_vector_type(4)));

constexpr int NTOK = 32768, DM = 1024, DIN = 2560, SEQ = 8192, NBATCH = 4, NMETA = 16;
constexpr int NHEAD = 8, NKEYS = 128, TOPK = 16, NSEL = NHEAD * TOPK;
constexpr float EPS = 1e-6f;
constexpr float U_SCALE = 64.f, V_SCALE = 16.f;
constexpr int NWAVES = 8, NTHREADS = 512;
constexpr int MKC = 32;
constexpr int LDS_BYTES = 147456;

constexpr size_t MiB = 1u << 20;
constexpr size_t WS_CTL = 0, WS_WIN_T = 1 * MiB, WS_WOUT_T = 6 * MiB, WS_WQ_T = 8 * MiB, WS_KEYS = 12 * MiB, WS_METAPART = 160 * MiB  ,
                 WS_METARSTD = 14 * MiB + 512 * 1024, WS_METAPROJ = 14 * MiB + 576 * 1024, WS_RSTD1 = 15 * MiB, WS_SSQ = 16 * MiB, WS_U8 = 32 * MiB, WS_V8 = 48 * MiB,
                 WS_IDX = 64 * MiB, WS_GATE = 80 * MiB, WS_H0B = 96 * MiB, WS_H2B = 96 * MiB, WS_Y = 160 * MiB, WS_PROJ = 224 * MiB,
                 WS_Q = 224 * MiB, WS_ESCALE = 18 * MiB, WS_END = 384 * MiB;

struct Params {
    const float* x; const float* meta; const float* g_mix; const float* w_in; const float* sc_w; const float* cf_w; const float* cf_b;
    const float* ln_g; const float* ln_b; const float* g_sc; const float* g_cf; const float* w_out; const float* g_ffn; const float* w_q;
    const float* keys; const float* pu; const float* pv; const float* g_fin;
    float* out; unsigned char* ws;
    int ph_lo, ph_hi, coop, pad;
};

__device__ __forceinline__ unsigned f2bf(float f) { unsigned u = __builtin_bit_cast(unsigned, f); return (u + 0x7fffu + ((u >> 16) & 1u)) >> 16; }
__device__ __forceinline__ unsigned pk2(float lo, float hi) { return f2bf(lo) | (f2bf(hi) << 16); }
__device__ __forceinline__ float bf2f(unsigned b) { return __builtin_bit_cast(float, b << 16); }
__device__ __forceinline__ float bflo(unsigned w) { return __builtin_bit_cast(float, w << 16); }
__device__ __forceinline__ float bfhi(unsigned w) { return __builtin_bit_cast(float, w & 0xffff0000u); }
__device__ __forceinline__ float wave_sum(float v) {
#pragma unroll
    for (int o = 1; o < 64; o <<= 1) v += __shfl_xor(v, o);
    return v;
}
template <int CTRL> __device__ __forceinline__ float dpp_f(float v) { return __builtin_bit_cast(float, __builtin_amdgcn_update_dpp(0, __builtin_bit_cast(int, v), CTRL, 0xf, 0xf, true)); }
__device__ __forceinline__ float wave_sum_fast(float v) {
    v += dpp_f<0xB1>(v); v += dpp_f<0x4E>(v); v += dpp_f<0x141>(v); v += dpp_f<0x140>(v);
    { auto r = __builtin_amdgcn_permlane16_swap(__float_as_uint(v), __float_as_uint(v), false, false); v = __uint_as_float(r[0]) + __uint_as_float(r[1]); }
    { auto r = __builtin_amdgcn_permlane32_swap(__float_as_uint(v), __float_as_uint(v), false, false); v = __uint_as_float(r[0]) + __uint_as_float(r[1]); }
    return v;
}
__device__ __forceinline__ float sigmoid_f(float x) { return 1.f / (1.f + __expf(-x)); }
__device__ __forceinline__ float gelu_tanh_f(float x) {
    const float t = 0.7978845608028654f * (x + 0.044715f * x * x * x);
    const float e = __expf(2.f * t);
    const float th = 1.f - 2.f / (e + 1.f);
    return 0.5f * x * (1.f + th);
}

__device__ __forceinline__ unsigned cvt_pk_bf16(float lo, float hi) { unsigned r; asm volatile("v_cvt_pk_bf16_f32 %0, %1, %2" : "=v"(r) : "v"(lo), "v"(hi)); return r; }

template <int MODE> struct EpiRowScale {
    static constexpr bool PERM = true, AFTER_DRAIN = false;
    bf16* O; int ldc; const float* rs;
    __device__ __forceinline__ void operator()(const pg8::f32x4 (&acc)[2][2][4][2], const pg8::Unit& u, int wr, int wc, int fr, int fq) const {
        const int row0 = u.pm * 256 + wr * 64 + fr, col0 = u.pn * 256 + wc * 32 + 8 * fq;
#pragma unroll
        for (int ai = 0; ai < 2; ++ai)
#pragma unroll
            for (int m = 0; m < 4; ++m) {
                const int row = row0 + ai * 128 + m * 16;
                float s;
                if (MODE == 0) s = rs[row];
                else { const f32x4* p = (const f32x4*)(rs + (size_t)row * 16); const f32x4 a = p[0], b = p[1], c = p[2], d = p[3];
                       const float t = ((a.x + a.y) + (a.z + a.w)) + ((b.x + b.y) + (b.z + b.w)) + ((c.x + c.y) + (c.z + c.w)) + ((d.x + d.y) + (d.z + d.w));
                       s = rsqrtf(t * (1.f / 1024.f) + EPS); }
                bf16* rowp = O + (size_t)row * ldc + col0;
#pragma unroll
                for (int bj = 0; bj < 2; ++bj) { const pg8::f32x4 v0 = acc[ai][bj][m][0] * s, v1 = acc[ai][bj][m][1] * s;
                    u32x4 w; w.x = cvt_pk_bf16(v0[0], v0[1]); w.y = cvt_pk_bf16(v0[2], v0[3]); w.z = cvt_pk_bf16(v1[0], v1[1]); w.w = cvt_pk_bf16(v1[2], v1[3]);
                    *(u32x4*)(rowp + bj * 128) = w; }
            }
    }
};
struct EpiResidual {
    static constexpr bool PERM = true, AFTER_DRAIN = false;
    bf16* O; const float* X; float* ssq;
    __device__ __forceinline__ void operator()(const pg8::f32x4 (&acc)[2][2][4][2], const pg8::Unit& u, int wr, int wc, int fr, int fq) const {
        const int row0 = u.pm * 256 + wr * 64 + fr, col0 = u.pn * 256 + wc * 32 + 8 * fq;
#pragma unroll
        for (int ai = 0; ai < 2; ++ai)
#pragma unroll
            for (int m = 0; m < 4; ++m) {
                const int row = row0 + ai * 128 + m * 16;
                const float* xr = X + (size_t)row * DM + col0; bf16* rowp = O + (size_t)row * DM + col0;
                float q = 0.f;
#pragma unroll
                for (int bj = 0; bj < 2; ++bj) { const f32x4 x0 = *(const f32x4*)(xr + bj * 128), x1 = *(const f32x4*)(xr + bj * 128 + 4);
                    const pg8::f32x4 v0 = acc[ai][bj][m][0] + x0, v1 = acc[ai][bj][m][1] + x1;
                    q += (v0[0] * v0[0] + v0[1] * v0[1]) + (v0[2] * v0[2] + v0[3] * v0[3]) + (v1[0] * v1[0] + v1[1] * v1[1]) + (v1[2] * v1[2] + v1[3] * v1[3]);
                    u32x4 w; w.x = cvt_pk_bf16(v0[0], v0[1]); w.y = cvt_pk_bf16(v0[2], v0[3]); w.z = cvt_pk_bf16(v1[0], v1[1]); w.w = cvt_pk_bf16(v1[2], v1[3]);
                    *(u32x4*)(rowp + bj * 128) = w; }
                q += __shfl_xor(q, 16); q += __shfl_xor(q, 32);
                if (fq == 0) ssq[(size_t)row * 16 + u.pn * 4 + wc] = q;
            }
    }
};

__device__ __forceinline__ void p0_transpose_item(const float* W, int K, int N, bf16* WT, LAS float* scr, int item, int lane,
                                                  const float* g_lo, const float* g_hi, int split) {
    const int nblk = N / 32, kb = item / nblk, nb = item % nblk, k0 = 64 * kb, n0 = 32 * nb;
#pragma unroll 8
    for (int i = 0; i < 32; ++i) { const int kk = 2 * i + (lane >> 5); const int k = k0 + kk;
        const float g = (k < split) ? g_lo[k] : g_hi[k - split];
        scr[kk * 33 + (lane & 31)] = W[(size_t)k * N + n0 + (lane & 31)] * g; }
    asm volatile("s_waitcnt lgkmcnt(0)" ::: "memory");
    const int c = lane & 7;
#pragma unroll
    for (int j = 0; j < 4; ++j) { const int n = (lane >> 3) + 8 * j; const LAS float* s = scr + (8 * c) * 33 + n;
        u32x4 o; o.x = pk2(s[0 * 33], s[1 * 33]); o.y = pk2(s[2 * 33], s[3 * 33]); o.z = pk2(s[4 * 33], s[5 * 33]); o.w = pk2(s[6 * 33], s[7 * 33]);
        *(u32x4*)(WT + (size_t)(n0 + n) * K + k0 + 8 * c) = o; }
    asm volatile("s_waitcnt lgkmcnt(0)" ::: "memory");
}

__device__ __forceinline__ float q4(float x, float inv_s) {
    const float a = fabsf(x) * inv_s; float r;
    if (a < 2.f) r = rintf(a * 2.f) * 0.5f; else if (a < 4.f) r = rintf(a); else r = fminf(6.f, rintf(a * 0.5f) * 2.f);
    return copysignf(r, x);
}
__device__ __forceinline__ void phase_prep(const Params& P, LAS unsigned char* lds) {
    const int tid = threadIdx.x, lane = tid & 63, wave = __builtin_amdgcn_readfirstlane(tid >> 6);
    const int gw = blockIdx.x * NWAVES + wave, NGW = gridDim.x * NWAVES;
    unsigned char* ws = P.ws;
    LAS float* scr = (LAS float*)(lds + wave * 16384);
    constexpr int I_IN = (DM / 64) * (DIN / 32), I_OUT = (DM / 64) * (DM / 32), I_Q = (DM / 64) * (2048 / 32);
    for (int it = gw; it < I_IN + I_OUT + I_Q; it += NGW) {
        int r = it;
        if (r < I_IN) { p0_transpose_item(P.w_in, DM, DIN, (bf16*)(ws + WS_WIN_T), scr, r, lane, P.g_mix, P.g_mix, DM); continue; } r -= I_IN;
        if (r < I_OUT) { p0_transpose_item(P.w_out, DM, DM, (bf16*)(ws + WS_WOUT_T), scr, r, lane, P.g_sc, P.g_cf, 512); continue; } r -= I_OUT;
        p0_transpose_item(P.w_q, DM, 2048, (bf16*)(ws + WS_WQ_T), scr, r, lane, P.g_ffn, P.g_ffn, DM);
    }
    {
        bf16* H0B = (bf16*)(ws + WS_H0B); float* RSTD1 = (float*)(ws + WS_RSTD1);
        for (int t0 = gw * 4; t0 < NTOK; t0 += NGW * 4) {
            f32x4 v[4][4];
#pragma unroll
            for (int q = 0; q < 4; ++q) { const f32x4* xr = (const f32x4*)(P.x + (size_t)(t0 + q) * DM) + lane;
#pragma unroll
                for (int j = 0; j < 4; ++j) v[q][j] = xr[64 * j]; }
#pragma unroll
            for (int q = 0; q < 4; ++q) { float sq = 0.f;
#pragma unroll
                for (int j = 0; j < 4; ++j) sq += (v[q][j].x * v[q][j].x + v[q][j].y * v[q][j].y) + (v[q][j].z * v[q][j].z + v[q][j].w * v[q][j].w);
                sq = wave_sum_fast(sq);
                if (lane == 0) RSTD1[t0 + q] = rsqrtf(sq * (1.f / DM) + EPS);
                u32x2* o = (u32x2*)(H0B + (size_t)(t0 + q) * DM) + lane;
#pragma unroll
                for (int j = 0; j < 4; ++j) { u32x2 w; w.x = pk2(v[q][j].x, v[q][j].y); w.y = pk2(v[q][j].z, v[q][j].w); o[64 * j] = w; } }
        }
    }
    {
        unsigned char* U8 = ws + WS_U8; unsigned char* V8 = ws + WS_V8;
        f32x4 gf[4];
#pragma unroll
        for (int j = 0; j < 4; ++j) gf[j] = ((const f32x4*)P.g_ffn)[64 * j + lane];
        float* ESC = (float*)(ws + WS_ESCALE);
        for (int e0 = gw * 2; e0 < 2 * 16384; e0 += NGW * 2) {
            const bool isv = e0 >= 16384; const int ee0 = isv ? e0 - 16384 : e0;
            f32x4 v[2][4];
#pragma unroll
            for (int q = 0; q < 2; ++q) { const f32x4* src = (const f32x4*)((isv ? P.pv : P.pu) + (size_t)(ee0 + q) * DM) + lane;
#pragma unroll
                for (int j = 0; j < 4; ++j) v[q][j] = src[64 * j]; }
#pragma unroll
            for (int q = 0; q < 2; ++q) {
                float mx = 0.f;
#pragma unroll
                for (int j = 0; j < 4; ++j) { if (!isv) v[q][j] = v[q][j] * gf[j];
                    mx = fmaxf(mx, fmaxf(fmaxf(fabsf(v[q][j].x), fabsf(v[q][j].y)), fmaxf(fabsf(v[q][j].z), fabsf(v[q][j].w)))); }
#pragma unroll
                for (int o = 1; o < 64; o <<= 1) mx = fmaxf(mx, __shfl_xor(mx, o));
                const float sc = fmaxf(mx, 1e-30f) * (1.f / 6.f), inv = 1.f / sc;
                if (lane == 0) ESC[e0 + q] = sc;
                unsigned w0 = 0u, w1 = 0u;
                w0 = __builtin_amdgcn_cvt_scalef32_pk_fp4_f32(w0, v[q][0].x * inv, v[q][0].y * inv, 1.0f, 0); w0 = __builtin_amdgcn_cvt_scalef32_pk_fp4_f32(w0, v[q][0].z * inv, v[q][0].w * inv, 1.0f, 1);
                w0 = __builtin_amdgcn_cvt_scalef32_pk_fp4_f32(w0, v[q][1].x * inv, v[q][1].y * inv, 1.0f, 2); w0 = __builtin_amdgcn_cvt_scalef32_pk_fp4_f32(w0, v[q][1].z * inv, v[q][1].w * inv, 1.0f, 3);
                w1 = __builtin_amdgcn_cvt_scalef32_pk_fp4_f32(w1, v[q][2].x * inv, v[q][2].y * inv, 1.0f, 0); w1 = __builtin_amdgcn_cvt_scalef32_pk_fp4_f32(w1, v[q][2].z * inv, v[q][2].w * inv, 1.0f, 1);
                w1 = __builtin_amdgcn_cvt_scalef32_pk_fp4_f32(w1, v[q][3].x * inv, v[q][3].y * inv, 1.0f, 2); w1 = __builtin_amdgcn_cvt_scalef32_pk_fp4_f32(w1, v[q][3].z * inv, v[q][3].w * inv, 1.0f, 3);
                u32x2 o; o.x = w0; o.y = w1;
                *(u32x2*)((isv ? V8 : U8) + (size_t)(ee0 + q) * 512 + 8 * lane) = o;
            }
        }
    }
    {
        bf16* KB = (bf16*)(ws + WS_KEYS);
        const int gt = blockIdx.x * NTHREADS + tid, NGT = gridDim.x * NTHREADS;
        for (int i = gt; i < 8 * 2 * 128 * 128 / 4; i += NGT) { const f32x4 v = ((const f32x4*)P.keys)[i]; u32x2 w; w.x = pk2(v.x, v.y); w.y = pk2(v.z, v.w); ((u32x2*)KB)[i] = w; }
    }
    {
        float* MP = (float*)(ws + WS_METAPART); float* MR = (float*)(ws + WS_METARSTD);
        for (int r = gw; r < NMETA; r += NGW) {
            float s = 0.f;
            for (int k = lane; k < DM; k += 64) { const float v = P.meta[r * DM + k]; s += v * v; }
            s = wave_sum(s);
            if (lane == 0) MR[r] = rsqrtf(s * (1.f / DM) + EPS);
        }
        for (int it = gw; it < MKC * 40; it += NGW) {
            const int kc = it / 40, nb = it % 40, n = nb * 64 + lane;
            float acc[NMETA];
#pragma unroll
            for (int r = 0; r < NMETA; ++r) acc[r] = 0.f;
            for (int k = kc * (DM / MKC); k < (kc + 1) * (DM / MKC); ++k) {
                const float w = P.w_in[(size_t)k * DIN + n] * P.g_mix[k];
#pragma unroll
                for (int r = 0; r < NMETA; ++r) acc[r] += P.meta[r * DM + k] * w;
            }
#pragma unroll
            for (int r = 0; r < NMETA; ++r) MP[(size_t)(kc * 16 + r) * DIN + n] = acc[r];
        }
    }
}

__device__ __forceinline__ void phase_metaproj(const Params& P) {
    const float* MP = (const float*)(P.ws + WS_METAPART); const float* MR = (const float*)(P.ws + WS_METARSTD); float* MJ = (float*)(P.ws + WS_METAPROJ);
    const int gt = blockIdx.x * NTHREADS + threadIdx.x;
    if (gt < NMETA * DIN) { const int p = gt / DIN, col = gt % DIN; float s = 0.f;
#pragma unroll
        for (int kc = 0; kc < MKC; ++kc) s += MP[(size_t)(kc * 16 + p) * DIN + col];
        MJ[gt] = s * MR[p]; }
}
__device__ __forceinline__ float meta_val(const float* MJ, const float*, int p, int col) { return MJ[p * DIN + col]; }
__device__ __forceinline__ float proj_at(const bf16* PROJ, const float* MP, const float* MR, int b, int pos, int col) {
    if (pos < 0) return 0.f;
    if (pos < NMETA) return meta_val(MP, MR, pos, col);
    return bf2f(PROJ[(size_t)(b * SEQ + pos - NMETA) * DIN + col]);
}
__device__ __forceinline__ void proj8_at(const bf16* PROJ, const float* MP, const float* MR, int b, int pos, int col, float (&v)[8]) {
    if (pos < 0) {
#pragma unroll
        for (int i = 0; i < 8; ++i) v[i] = 0.f;
    } else if (pos < NMETA) {
        const f32x4 a = *(const f32x4*)(MP + pos * DIN + col), bq = *(const f32x4*)(MP + pos * DIN + col + 4);
        v[0] = a.x; v[1] = a.y; v[2] = a.z; v[3] = a.w; v[4] = bq.x; v[5] = bq.y; v[6] = bq.z; v[7] = bq.w;
    } else {
        const u32x4 w = *(const u32x4*)(PROJ + (size_t)(b * SEQ + pos - NMETA) * DIN + col);
        v[0] = bflo(w.x); v[1] = bfhi(w.x); v[2] = bflo(w.y); v[3] = bfhi(w.y); v[4] = bflo(w.z); v[5] = bfhi(w.z); v[6] = bflo(w.w); v[7] = bfhi(w.w);
    }
}

template <int R> __device__ __forceinline__ void conv_rows(const LAS unsigned char* ubase, const f32x2 (&wcf)[31], f32x2 (&acc)[32]) {
    if constexpr (R < 62) {
        const unsigned uw = *(const LAS unsigned*)(ubase + R * 1024);
        const f32x2 x = (f32x2){bflo(uw), bfhi(uw)};
        constexpr int lo = R > 30 ? R - 30 : 0, hi = R < 31 ? R : 31;
#pragma unroll
        for (int ii = lo; ii <= hi; ++ii) acc[ii] += wcf[R - ii] * x;
        conv_rows<R + 1>(ubase, wcf, acc);
    }
}
__device__ __forceinline__ void phase_conv(const Params& P, LAS unsigned char* lds) {
    const int tid = threadIdx.x, lane = tid & 63, wave = __builtin_amdgcn_readfirstlane(tid >> 6);
    unsigned char* ws = P.ws;
    const bf16* PROJ = (const bf16*)(ws + WS_PROJ); const float* MP = (const float*)(ws + WS_METAPROJ); const float* MR = nullptr;
    bf16* Y = (bf16*)(ws + WS_Y);
    constexpr int TT = 64, NTILE = NTOK / TT, UROWS = TT + 30;
    const int cgp = wave & 3, th = wave >> 2, ch2 = cgp * 128 + 2 * lane;
    f32x2 wcf[31];
#pragma unroll
    for (int j = 0; j < 31; ++j) wcf[j] = *(const f32x2*)(P.cf_w + j * 512 + ch2);
    const f32x2 bcf = *(const f32x2*)(P.cf_b + ch2);
    for (int tile = blockIdx.x; tile < NTILE; tile += gridDim.x) {
        const int b = tile / (SEQ / TT), s0 = (tile % (SEQ / TT)) * TT;
#pragma unroll 4
        for (int p = 0; p < (UROWS + 7) / 8; ++p) {
            const int r = p * 8 + wave;
            if (r < UROWS) {
                const int pos = NMETA + s0 - 30 + r;
                float ga[8], gg[8];
                proj8_at(PROJ, MP, MR, b, pos, 1536 + 8 * lane, ga); proj8_at(PROJ, MP, MR, b, pos, 2048 + 8 * lane, gg);
                u32x4 w;
                w.x = pk2(ga[0] * sigmoid_f(gg[0]), ga[1] * sigmoid_f(gg[1])); w.y = pk2(ga[2] * sigmoid_f(gg[2]), ga[3] * sigmoid_f(gg[3]));
                w.z = pk2(ga[4] * sigmoid_f(gg[4]), ga[5] * sigmoid_f(gg[5])); w.w = pk2(ga[6] * sigmoid_f(gg[6]), ga[7] * sigmoid_f(gg[7]));
                *(LAS u32x4*)(lds + r * 1024 + lane * 16) = w;
            }
        }
        __syncthreads();
        f32x2 acc[32];
#pragma unroll
        for (int ii = 0; ii < 32; ++ii) acc[ii] = bcf;
        conv_rows<0>(lds + (32 * th) * 1024 + ch2 * 2, wcf, acc);
        __syncthreads();
#pragma unroll
        for (int ii = 0; ii < 32; ++ii) *(LAS f32x2*)(lds + (32 * th + ii) * 2048 + ch2 * 4) = acc[ii];
        __syncthreads();
        {
            float lng[8], lnb[8];
            { const f32x4 a = *(const f32x4*)(P.ln_g + 8 * lane), c = *(const f32x4*)(P.ln_g + 8 * lane + 4), d = *(const f32x4*)(P.ln_b + 8 * lane), e = *(const f32x4*)(P.ln_b + 8 * lane + 4);
              lng[0] = a.x; lng[1] = a.y; lng[2] = a.z; lng[3] = a.w; lng[4] = c.x; lng[5] = c.y; lng[6] = c.z; lng[7] = c.w;
              lnb[0] = d.x; lnb[1] = d.y; lnb[2] = d.z; lnb[3] = d.w; lnb[4] = e.x; lnb[5] = e.y; lnb[6] = e.z; lnb[7] = e.w; }
            float wsc[3][8];
#pragma unroll
            for (int j = 0; j < 3; ++j) { const f32x4 a = *(const f32x4*)(P.sc_w + j * 512 + 8 * lane), c = *(const f32x4*)(P.sc_w + j * 512 + 8 * lane + 4);
                wsc[j][0] = a.x; wsc[j][1] = a.y; wsc[j][2] = a.z; wsc[j][3] = a.w; wsc[j][4] = c.x; wsc[j][5] = c.y; wsc[j][6] = c.z; wsc[j][7] = c.w; }
            float cxa[8], cxb[8];
            { float xv[8], cgv[8]; const int pos = NMETA + s0 + 8 * wave - 2;
              proj8_at(PROJ, MP, MR, b, pos, 8 * lane, xv); proj8_at(PROJ, MP, MR, b, pos, 1024 + 8 * lane, cgv);
#pragma unroll
              for (int i = 0; i < 8; ++i) cxa[i] = xv[i] * cgv[i];
              proj8_at(PROJ, MP, MR, b, pos + 1, 8 * lane, xv); proj8_at(PROJ, MP, MR, b, pos + 1, 1024 + 8 * lane, cgv);
#pragma unroll
              for (int i = 0; i < 8; ++i) cxb[i] = xv[i] * cgv[i]; }
#pragma unroll 2
            for (int q = 0; q < 8; ++q) {
                const int ii = 8 * wave + q, s = s0 + ii; const size_t t = (size_t)b * SEQ + s;
                float o[8];
                { const f32x4 a = *(const LAS f32x4*)(lds + ii * 2048 + lane * 32), c = *(const LAS f32x4*)(lds + ii * 2048 + lane * 32 + 16);
                  o[0] = a.x; o[1] = a.y; o[2] = a.z; o[3] = a.w; o[4] = c.x; o[5] = c.y; o[6] = c.z; o[7] = c.w; }
                float s1 = 0.f;
#pragma unroll
                for (int i = 0; i < 8; ++i) s1 += o[i];
                const float mean = wave_sum_fast(s1) * (1.f / 512.f);
                float s2 = 0.f;
#pragma unroll
                for (int i = 0; i < 8; ++i) { o[i] -= mean; s2 += o[i] * o[i]; }
                const float rs = rsqrtf(wave_sum_fast(s2) * (1.f / 512.f) + EPS);
                float s3 = 0.f;
#pragma unroll
                for (int i = 0; i < 8; ++i) { float y = o[i] * rs * lng[i] + lnb[i]; y = y * sigmoid_f(y); o[i] = y; s3 += y * y; }
                const float r2 = rsqrtf(wave_sum_fast(s3) * (1.f / 512.f) + EPS);
                u32x4 wv; wv.x = pk2(o[0] * r2, o[1] * r2); wv.y = pk2(o[2] * r2, o[3] * r2); wv.z = pk2(o[4] * r2, o[5] * r2); wv.w = pk2(o[6] * r2, o[7] * r2);
                *(u32x4*)(Y + t * DM + 512 + 8 * lane) = wv;
                float xv[8], cgv[8], bgv[8], cxc[8], accs[8];
                proj8_at(PROJ, MP, MR, b, NMETA + s, 8 * lane, xv); proj8_at(PROJ, MP, MR, b, NMETA + s, 1024 + 8 * lane, cgv); proj8_at(PROJ, MP, MR, b, NMETA + s, 512 + 8 * lane, bgv);
                float s4 = 0.f;
#pragma unroll
                for (int i = 0; i < 8; ++i) { cxc[i] = xv[i] * cgv[i]; accs[i] = bgv[i] * (wsc[0][i] * cxa[i] + wsc[1][i] * cxb[i] + wsc[2][i] * cxc[i]); s4 += accs[i] * accs[i]; cxa[i] = cxb[i]; cxb[i] = cxc[i]; }
                const float r4 = rsqrtf(wave_sum_fast(s4) * (1.f / 512.f) + EPS);
                u32x4 wz; wz.x = pk2(accs[0] * r4, accs[1] * r4); wz.y = pk2(accs[2] * r4, accs[3] * r4); wz.z = pk2(accs[4] * r4, accs[5] * r4); wz.w = pk2(accs[6] * r4, accs[7] * r4);
                *(u32x4*)(Y + t * DM + 8 * lane) = wz;
            }
        }
        __syncthreads();
    }
}

__device__ __forceinline__ int ord_i(float s) { int k = __builtin_bit_cast(int, s); k ^= (k >> 31) & 0x7fffffff; return k; }
__device__ __forceinline__ float unord_f(int k) { k ^= (k >> 31) & 0x7fffffff; return __builtin_bit_cast(float, k); }
#define TOP_INSERT(L, x_) do { int _x = (x_); _Pragma("unroll") for (int _i = 0; _i < 16; ++_i) { const int _hi = max(L[_i], _x); _x = min(L[_i], _x); L[_i] = _hi; } } while (0)

typedef short bf16x8 __attribute__((ext_vector_type(8)));
typedef float f32x16 __attribute__((ext_vector_type(16)));
template <bool DESC> __device__ __forceinline__ void ce_i(int& a, int& b) { const int hi = max(a, b), lo = min(a, b); if (DESC) { a = hi; b = lo; } else { a = lo; b = hi; } }
__device__ __forceinline__ void bitonic_sort16(int (&a)[16]) {
#pragma unroll
    for (int k = 2; k <= 16; k <<= 1)
#pragma unroll
        for (int j = k >> 1; j > 0; j >>= 1)
#pragma unroll
            for (int i = 0; i < 16; ++i) { const int l = i ^ j; if (l > i) { if ((i & k) == 0) ce_i<true>(a[i], a[l]); else ce_i<false>(a[i], a[l]); } }
}
__device__ __forceinline__ void bitonic_merge16(int (&a)[16]) {
#pragma unroll
    for (int j = 8; j > 0; j >>= 1)
#pragma unroll
        for (int i = 0; i < 16; ++i) { const int l = i ^ j; if (l > i) ce_i<true>(a[i], a[l]); }
}
__device__ __forceinline__ void merge_top16(int (&a)[16], const int (&b)[16]) {
#pragma unroll
    for (int i = 0; i < 16; ++i) a[i] = max(a[i], b[15 - i]);
    bitonic_merge16(a);
}
__device__ __forceinline__ int lut16(const unsigned (&T)[4], int i) {
    const unsigned sel = (unsigned)(i & 7) | 0x0c0c0c00u;
    const unsigned lo = __builtin_amdgcn_perm(T[1], T[0], sel), hi = __builtin_amdgcn_perm(T[3], T[2], sel);
    return (int)((i & 8) ? hi : lo);
}
constexpr int KROW = 272;
constexpr float SCORE_BIAS = 8.0f;

__device__ __forceinline__ void route_half(const LAS unsigned char* kl, const bf16* qrow, int nl, int hb, int (&L)[16]) {
    bf16x8 qf[8];
#pragma unroll
    for (int ks = 0; ks < 8; ++ks) qf[ks] = *(const bf16x8*)(qrow + 64 * hb + 8 * ks);
    f32x16 acc[4];
#pragma unroll
    for (int nt = 0; nt < 4; ++nt)
#pragma unroll
        for (int r = 0; r < 16; ++r) acc[nt][r] = SCORE_BIAS;
#pragma unroll
    for (int ks = 0; ks < 8; ++ks)
#pragma unroll
        for (int nt = 0; nt < 4; ++nt) {
            const bf16x8 a = *(const LAS bf16x8*)(kl + (32 * nt + nl) * KROW + (64 * hb + 8 * ks) * 2);
            acc[nt] = __builtin_amdgcn_mfma_f32_32x32x16_bf16(a, qf[ks], acc[nt], 0, 0, 0);
        }
    const int hb4 = 4 * hb;
    int T[4][16];
#pragma unroll
    for (int nt = 0; nt < 4; ++nt)
#pragma unroll
        for (int r = 0; r < 16; ++r) { const int n0 = 32 * nt + (r & 3) + 8 * (r >> 2); const float sc = acc[nt][r];
            T[nt][r] = (__float_as_int(sc) & ~127) | ((127 - n0) - hb4); }
    bitonic_sort16(T[0]); bitonic_sort16(T[1]); bitonic_sort16(T[2]); bitonic_sort16(T[3]);
    merge_top16(T[0], T[1]); merge_top16(T[2], T[3]); merge_top16(T[0], T[2]);
#pragma unroll
    for (int i = 0; i < 16; ++i) { const unsigned v = (unsigned)T[0][15 - i]; auto r = __builtin_amdgcn_permlane32_swap(v, v, false, false);
        const unsigned r0 = r[0], r1 = r[1]; const int partner = (int)(hb ? r0 : r1); L[i] = max(T[0][i], partner); }
    bitonic_merge16(L);
}

__device__ __forceinline__ void phase_route(const Params& P, LAS unsigned char* lds) {
    const int tid = threadIdx.x, lane = tid & 63, wave = __builtin_amdgcn_readfirstlane(tid >> 6);
    const int nl = lane & 31, hb = lane >> 5;
    unsigned char* ws = P.ws;
    const bf16* KEYS = (const bf16*)(ws + WS_KEYS); const bf16* Q = (const bf16*)(ws + WS_Q);
    int* IDX = (int*)(ws + WS_IDX); float* GATE = (float*)(ws + WS_GATE);
    int last_h = -1;
    for (int unit = blockIdx.x; unit < (NTOK / 256) * NHEAD; unit += gridDim.x) {
        const int h = unit & 7, tb = unit >> 3;
        if (h != last_h) {
            __syncthreads();
            for (int c = tid; c < 4096; c += NTHREADS) { const u32x4 v = ((const u32x4*)(KEYS + (size_t)h * 32768))[c];
                *(LAS u32x4*)(lds + (c >> 4) * KROW + (c & 15) * 16) = v; }
            __syncthreads();
            last_h = h;
        }
        const size_t t = (size_t)tb * 256 + wave * 32 + nl;
        int L1[16], L2[16];
        route_half(lds, Q + t * 2048 + h * 256, nl, hb, L1);
        route_half(lds + 128 * KROW, Q + t * 2048 + h * 256 + 128, nl, hb, L2);
        float v1[16], v2[16];
#pragma unroll
        for (int i = 0; i < 16; ++i) { v1[i] = __int_as_float(L1[i] & ~127); v2[i] = __int_as_float(L2[i] & ~127); }
#define CAND(i, j) ((__float_as_int(v1[i] + v2[j]) & ~255) | (255 - (16 * (i) + (j))))
        int A[16], B[16], C[16];
#pragma unroll
        for (int j = 0; j < 16; ++j) A[j] = CAND(0, j);
#pragma unroll
        for (int j = 0; j < 8; ++j) { B[j] = CAND(1, j); B[8 + j] = CAND(15 - j, 0); }
        bitonic_merge16(B);
        C[0] = CAND(2, 0); C[1] = CAND(2, 1); C[2] = CAND(2, 2); C[3] = CAND(2, 3); C[4] = CAND(2, 4);
        C[5] = CAND(3, 0); C[6] = CAND(3, 1); C[7] = CAND(3, 2); C[8] = CAND(3, 3);
        C[9] = CAND(4, 0); C[10] = CAND(4, 1); C[11] = CAND(4, 2);
        C[12] = CAND(5, 0); C[13] = CAND(5, 1); C[14] = CAND(6, 0); C[15] = CAND(6, 1);
        bitonic_sort16(C);
        { const int d0 = CAND(7, 0), d1 = CAND(7, 1); C[14] = max(C[14], d1); C[15] = max(C[15], d0); bitonic_merge16(C); }
#undef CAND
        merge_top16(A, B); merge_top16(A, C);
        unsigned T1[4], T2[4];
#pragma unroll
        for (int q = 0; q < 4; ++q) {
            T1[q] = (unsigned)(127 - (L1[4 * q] & 127)) | ((unsigned)(127 - (L1[4 * q + 1] & 127)) << 8) | ((unsigned)(127 - (L1[4 * q + 2] & 127)) << 16) | ((unsigned)(127 - (L1[4 * q + 3] & 127)) << 24);
            T2[q] = (unsigned)(127 - (L2[4 * q] & 127)) | ((unsigned)(127 - (L2[4 * q + 1] & 127)) << 8) | ((unsigned)(127 - (L2[4 * q + 2] & 127)) << 16) | ((unsigned)(127 - (L2[4 * q + 3] & 127)) << 24); }
        float val[16]; int ex[16];
#pragma unroll
        for (int k = 0; k < 16; ++k) { const int pos = 255 - (A[k] & 255); val[k] = __int_as_float(A[k] & ~255);
            ex[k] = lut16(T1, pos >> 4) * NKEYS + lut16(T2, pos & 15); }
        float sum = 0.f; const float vmax = val[0];
#pragma unroll
        for (int k = 0; k < 16; ++k) { val[k] = __expf(val[k] - vmax); sum += val[k]; }
        const float inv = 1.f / sum;
        if (hb == 0) {
            int* ip = IDX + t * NSEL + h * TOPK; float* gp = GATE + t * NSEL + h * TOPK;
#pragma unroll
            for (int k4 = 0; k4 < 4; ++k4) {
                *(int4*)(ip + 4 * k4) = make_int4(ex[4 * k4], ex[4 * k4 + 1], ex[4 * k4 + 2], ex[4 * k4 + 3]);
                *(f32x4*)(gp + 4 * k4) = (f32x4){val[4 * k4] * inv, val[4 * k4 + 1] * inv, val[4 * k4 + 2] * inv, val[4 * k4 + 3] * inv};
            }
        }
    }
}

#define FP4X2(w, sel) __builtin_amdgcn_cvt_scalef32_pk_f32_fp4((w), 1.0f, (sel))
__device__ __forceinline__ float dot16_fp4(const u32x2 r, const f32x4 (&xs)[4]) {
    float p = 0.f;
    { const f32x2 a = FP4X2(r.x, 0), b = FP4X2(r.x, 1), c = FP4X2(r.x, 2), d = FP4X2(r.x, 3);
      p += (a.x * xs[0].x + a.y * xs[0].y) + (b.x * xs[0].z + b.y * xs[0].w); p += (c.x * xs[1].x + c.y * xs[1].y) + (d.x * xs[1].z + d.y * xs[1].w); }
    { const f32x2 a = FP4X2(r.y, 0), b = FP4X2(r.y, 1), c = FP4X2(r.y, 2), d = FP4X2(r.y, 3);
      p += (a.x * xs[2].x + a.y * xs[2].y) + (b.x * xs[2].z + b.y * xs[2].w); p += (c.x * xs[3].x + c.y * xs[3].y) + (d.x * xs[3].z + d.y * xs[3].w); }
    return p;
}
__device__ __forceinline__ void axpy16_fp4(const u32x2 r, float w, f32x4 (&o)[4]) {
    { const f32x2 a = FP4X2(r.x, 0), b = FP4X2(r.x, 1), c = FP4X2(r.x, 2), d = FP4X2(r.x, 3);
      o[0].x += w * a.x; o[0].y += w * a.y; o[0].z += w * b.x; o[0].w += w * b.y; o[1].x += w * c.x; o[1].y += w * c.y; o[1].z += w * d.x; o[1].w += w * d.y; }
    { const f32x2 a = FP4X2(r.y, 0), b = FP4X2(r.y, 1), c = FP4X2(r.y, 2), d = FP4X2(r.y, 3);
      o[2].x += w * a.x; o[2].y += w * a.y; o[2].z += w * b.x; o[2].w += w * b.y; o[3].x += w * c.x; o[3].y += w * c.y; o[3].z += w * d.x; o[3].w += w * d.y; }
}
__device__ __forceinline__ float swap32_add(float a, float b) { auto r = __builtin_amdgcn_permlane32_swap(__float_as_uint(a), __float_as_uint(b), false, false); return __uint_as_float(r[0]) + __uint_as_float(r[1]); }
__device__ __forceinline__ float swap16_add(float a, float b) { auto r = __builtin_amdgcn_permlane16_swap(__float_as_uint(a), __float_as_uint(b), false, false); return __uint_as_float(r[0]) + __uint_as_float(r[1]); }
__device__ __forceinline__ float row_sum16(float v) { v += dpp_f<0xB1>(v); v += dpp_f<0x4E>(v); v += dpp_f<0x141>(v); v += dpp_f<0x140>(v); return v; }
constexpr int GB = 16;
typedef __attribute__((address_space(8))) void* rsrc_t;
__device__ __forceinline__ void g_issue(u32x2 (&buf)[GB], __amdgpu_buffer_rsrc_t rs, int idxr, int lb, int voff) {
#pragma unroll
    for (int j = 0; j < GB; ++j) { const int e = __builtin_amdgcn_readlane(idxr, lb + j); buf[j] = __builtin_amdgcn_raw_buffer_load_b64(rs, voff, e * 512, 0); }
}
__device__ __forceinline__ float dot16_fp4p(const u32x2 r, const f32x2 (&xp)[8]) {
    f32x2 a = FP4X2(r.x, 0) * xp[0];
    a += FP4X2(r.x, 1) * xp[1]; a += FP4X2(r.x, 2) * xp[2]; a += FP4X2(r.x, 3) * xp[3];
    a += FP4X2(r.y, 0) * xp[4]; a += FP4X2(r.y, 1) * xp[5]; a += FP4X2(r.y, 2) * xp[6]; a += FP4X2(r.y, 3) * xp[7];
    return a.x + a.y;
}
__device__ __forceinline__ void axpy16_fp4p(const u32x2 r, float w, f32x2 (&o)[8]) {
    const f32x2 ww = (f32x2){w, w};
    o[0] += FP4X2(r.x, 0) * ww; o[1] += FP4X2(r.x, 1) * ww; o[2] += FP4X2(r.x, 2) * ww; o[3] += FP4X2(r.x, 3) * ww;
    o[4] += FP4X2(r.y, 0) * ww; o[5] += FP4X2(r.y, 1) * ww; o[6] += FP4X2(r.y, 2) * ww; o[7] += FP4X2(r.y, 3) * ww;
}
__device__ __forceinline__ void g_compute_u(const u32x2 (&buf)[GB], int q, int i16, const f32x2 (&xp)[8], float& zlo, float& zhi) {
    float p[16];
#pragma unroll
    for (int j = 0; j < 16; ++j) p[j] = dot16_fp4p(buf[j], xp);
    float s1[8], s2[4];
#pragma unroll
    for (int m = 0; m < 8; ++m) s1[m] = swap32_add(p[2 * m], p[2 * m + 1]);
#pragma unroll
    for (int n = 0; n < 4; ++n) s2[n] = swap16_add(s1[2 * n], s1[2 * n + 1]);
#pragma unroll
    for (int r = 0; r < 4; ++r) { const float z = row_sum16(s2[r]); const bool mine = i16 == ((4 * q + r) & 15);
        zlo = (mine && q < 4) ? z : zlo; zhi = (mine && q >= 4) ? z : zhi; }
}
__device__ __forceinline__ void g_compute_v(const u32x2 (&buf)[GB], int q, float alo, float ahi, f32x2 (&o)[8]) {
    const int areg = __builtin_bit_cast(int, (q < 4) ? alo : ahi), sb = 4 * (q & 3);
#pragma unroll
    for (int j = 0; j < 16; ++j) { const int src = 32 * (j & 1) + 16 * ((j >> 1) & 1) + (j >> 2) + sb;
        const float w = __builtin_bit_cast(float, __builtin_amdgcn_readlane(areg, src));
        axpy16_fp4p(buf[j], w, o); }
}
__device__ __forceinline__ void phase_gather(const Params& P, LAS unsigned char* lds) {
    const int tid = threadIdx.x, lane = tid & 63, wave = __builtin_amdgcn_readfirstlane(tid >> 6);
    const int gw = blockIdx.x * NWAVES + wave, NGW = gridDim.x * NWAVES;
    unsigned char* ws = P.ws;
    const int* IDX = (const int*)(ws + WS_IDX); const float* GATE = (const float*)(ws + WS_GATE); const float* ESC = (const float*)(ws + WS_ESCALE);
    const __amdgpu_buffer_rsrc_t rsU = __builtin_amdgcn_make_buffer_rsrc((void*)(ws + WS_U8), 0, 16384 * 512, 0x00020000);
    const __amdgpu_buffer_rsrc_t rsV = __builtin_amdgcn_make_buffer_rsrc((void*)(ws + WS_V8), 0, 16384 * 512, 0x00020000);
    const bf16* H2B = (const bf16*)(ws + WS_H2B); const float* SSQ = (const float*)(ws + WS_SSQ);
    const int hh = lane >> 5, rr = (lane >> 4) & 1, i16 = lane & 15, gsel = 4 * i16 + 2 * rr + hh;
    const int voff = 8 * lane;
    int t = gw;
    if (t < NTOK) {
        int idx0, idx1; u32x2 hraw[4]; float sqv;
        { const int* ip = IDX + (size_t)t * NSEL; idx0 = ip[lane]; idx1 = ip[64 + lane];
          const u32x2* hp = (const u32x2*)(H2B + (size_t)t * DM);
#pragma unroll
          for (int j = 0; j < 4; ++j) hraw[j] = hp[64 * j + lane];
          sqv = (lane < 16) ? (SSQ + (size_t)t * 16)[lane] : 0.f; }
        u32x2 bufA[GB], bufB[GB];
        g_issue(bufA, rsU, idx0, 0, voff);
        for (;;) {
            const int tn = t + NGW; const bool has_next = tn < NTOK; const int tl = has_next ? tn : t;
            int idx0n, idx1n; u32x2 hrawn[4]; float sqn, g0, g1;
            { const int* ip = IDX + (size_t)tl * NSEL; idx0n = ip[lane]; idx1n = ip[64 + lane];
              const u32x2* hp = (const u32x2*)(H2B + (size_t)tl * DM);
#pragma unroll
              for (int j = 0; j < 4; ++j) hrawn[j] = hp[64 * j + lane];
              sqn = (lane < 16) ? (SSQ + (size_t)tl * 16)[lane] : 0.f;
              const float* gp = GATE + (size_t)t * NSEL; g0 = gp[lane]; g1 = gp[64 + lane]; }
            const float su0 = ESC[idx0], su1 = ESC[idx1], sv0 = ESC[16384 + idx0], sv1 = ESC[16384 + idx1];
            const float rstd2 = rsqrtf(wave_sum_fast(sqv) * (1.f / DM) + EPS);
            f32x2 xp[8];
#pragma unroll
            for (int j = 0; j < 4; ++j) { xp[2 * j] = (f32x2){bflo(hraw[j].x), bfhi(hraw[j].x)}; xp[2 * j + 1] = (f32x2){bflo(hraw[j].y), bfhi(hraw[j].y)}; }
            float zlo = 0.f, zhi = 0.f;
#pragma unroll 1
            for (int q = 0; q < 8; q += 2) {
                g_issue(bufB, rsU, (q + 1 < 4) ? idx0 : idx1, 16 * ((q + 1) & 3), voff);
                g_compute_u(bufA, q, i16, xp, zlo, zhi);
                if (q + 2 < 8) g_issue(bufA, rsU, (q + 2 < 4) ? idx0 : idx1, 16 * ((q + 2) & 3), voff); else g_issue(bufA, rsV, idx0, 0, voff);
                g_compute_u(bufB, q + 1, i16, xp, zlo, zhi);
            }
            const float glo = __shfl(g0, gsel), ghi = __shfl(g1, gsel), sulo = __shfl(su0, gsel), suhi = __shfl(su1, gsel), svlo = __shfl(sv0, gsel), svhi = __shfl(sv1, gsel);
            const float alo = gelu_tanh_f(zlo * rstd2 * sulo) * glo * svlo, ahi = gelu_tanh_f(zhi * rstd2 * suhi) * ghi * svhi;
            f32x2 o[8];
#pragma unroll
            for (int j = 0; j < 8; ++j) o[j] = (f32x2){0.f, 0.f};
#pragma unroll 1
            for (int q = 0; q < 8; q += 2) {
                g_issue(bufB, rsV, (q + 1 < 4) ? idx0 : idx1, 16 * ((q + 1) & 3), voff);
                g_compute_v(bufA, q, alo, ahi, o);
                if (q + 2 < 8) g_issue(bufA, rsV, (q + 2 < 4) ? idx0 : idx1, 16 * ((q + 2) & 3), voff); else if (has_next) g_issue(bufA, rsU, idx0n, 0, voff);
                g_compute_v(bufB, q + 1, alo, ahi, o);
            }
            float ss = 0.f;
#pragma unroll
            for (int j = 0; j < 8; ++j) { o[j] += xp[j]; ss += o[j].x * o[j].x + o[j].y * o[j].y; }
            ss = wave_sum_fast(ss);
            const float r3 = rsqrtf(ss * (1.f / DM) + EPS);
            f32x4* op = (f32x4*)(P.out + (size_t)t * DM);
            const f32x4* gfp = (const f32x4*)P.g_fin;
#pragma unroll
            for (int j = 0; j < 4; ++j) { const f32x4 gv = gfp[64 * j + lane]; op[64 * j + lane] = (f32x4){o[2 * j].x * r3 * gv.x, o[2 * j].y * r3 * gv.y, o[2 * j + 1].x * r3 * gv.z, o[2 * j + 1].y * r3 * gv.w}; }
            if (!has_next) break;
            t = tn; idx0 = idx0n; idx1 = idx1n; sqv = sqn;
#pragma unroll
            for (int j = 0; j < 4; ++j) hraw[j] = hrawn[j];
        }
    }
}

#define XB_TMO      128
#define XB_XCNT(j)  (256  + 64 * (j))
#define XB_XSUB(j)  (1280 + 64 * (j))
#define XB_XGEN(j)  (2304 + 64 * (j))
#define XB_TOP      3328
#define XB_TOPGEN   3392
#define XCD_BAR_WORDS 3456
#define XB_SPIN_CAP (1u << 18)

__device__ __forceinline__ unsigned xb_ld(unsigned* p)              { return __hip_atomic_load(p, __ATOMIC_RELAXED, __HIP_MEMORY_SCOPE_AGENT); }
__device__ __forceinline__ unsigned xb_add(unsigned* p, unsigned v) { return __hip_atomic_fetch_add(p, v, __ATOMIC_RELAXED, __HIP_MEMORY_SCOPE_AGENT); }
__device__ __forceinline__ unsigned xb_xcc_id() { return (unsigned)__builtin_amdgcn_s_getreg((3 << 11) | 20) & 0xFu; }
#define XB_SPIN(cond, bar) do { unsigned _sp = 0; while (cond) { __builtin_amdgcn_s_sleep(1); \
    if ((++_sp & 255u) == 0u) { if (xb_ld(&(bar)[XB_TMO])) break; if (_sp > XB_SPIN_CAP) { atomicAdd(&(bar)[XB_TMO], 1u); break; } } } } while (0)

struct XcdBarrier {
    unsigned* bar; unsigned x;
    volatile LAS unsigned* st;
};

__device__ __forceinline__ XcdBarrier xcd_barrier_post(unsigned* bar, volatile LAS unsigned* st) {
    XcdBarrier b; b.bar = bar; b.x = xb_xcc_id(); b.st = st;
    if (threadIdx.x == 0) (void)xb_add(&bar[XB_XCNT(b.x)], 1u);
    return b;
}
__device__ __forceinline__ void xcd_barrier_complete(unsigned* bar, unsigned x, unsigned& nloc, unsigned& nx) {
    const unsigned G = gridDim.x * gridDim.y * gridDim.z;
    unsigned sum, cnt, mine, sp = 0u;
    for (;;) {
        sum = 0u; cnt = 0u; mine = 0u;
#pragma unroll
        for (unsigned j = 0; j < 16; ++j) { const unsigned c = xb_ld(&bar[XB_XCNT(j)]); sum += c; cnt += (c > 0u) ? 1u : 0u; mine = (j == x) ? c : mine; }
        if (sum == G) break;
        __builtin_amdgcn_s_sleep(1);
        if ((++sp & 255u) == 0u) { if (xb_ld(&bar[XB_TMO])) break; if (sp > XB_SPIN_CAP) { atomicAdd(&bar[XB_TMO], 1u); break; } }
    }
    nloc = mine > 0u ? mine : 1u; nx = cnt > 0u ? cnt : 1u;
}

__device__ __forceinline__ void xcd_barrier(const XcdBarrier& b) {
    asm volatile("s_waitcnt vmcnt(0)" ::: "memory");
    __syncthreads();
    if (threadIdx.x == 0) {
        unsigned* bar = b.bar;
        __builtin_amdgcn_s_waitcnt(0);
        unsigned nloc = b.st[0], nx = b.st[1];
        if (nloc == 0u) { xcd_barrier_complete(bar, b.x, nloc, nx); b.st[0] = nloc; b.st[1] = nx; }
        const unsigned old = xb_add(&bar[XB_XSUB(b.x)], 1u);
        const unsigned gen = old / nloc;
        if (old + 1u == (gen + 1u) * nloc) {
            __builtin_amdgcn_fence(__ATOMIC_RELEASE, "agent");
            asm volatile("s_waitcnt vmcnt(0)" ::: "memory");
            const unsigned og = xb_add(&bar[XB_TOP], 1u);
            const unsigned tg = og / nx;
            if (og + 1u == (tg + 1u) * nx) xb_add(&bar[XB_TOPGEN], 1u);
            else XB_SPIN(xb_ld(&bar[XB_TOPGEN]) == tg, bar);
            __builtin_amdgcn_fence(__ATOMIC_ACQUIRE, "agent");
            xb_add(&bar[XB_XGEN(b.x)], 1u);
            asm volatile("s_waitcnt vmcnt(0)" ::: "memory");
        } else {
            XB_SPIN(xb_ld(&bar[XB_XGEN(b.x)]) == gen, bar);
            __builtin_amdgcn_fence(__ATOMIC_ACQUIRE, "agent");
            asm volatile("s_waitcnt vmcnt(0)" ::: "memory");
        }
    }
    __syncthreads();
}


#ifndef MK_MULTI
#define MK_MULTI 0
#endif
constexpr int NPHASE = 7;
#ifndef REP5
#define REP5 1
#endif
#ifndef REP6
#define REP6 1
#endif
__global__ void __launch_bounds__(NTHREADS, 2) mk_fwd(Params P) {
    extern __shared__ __attribute__((aligned(16))) unsigned char lds_raw[];
    LAS unsigned char* lds = (LAS unsigned char*)lds_raw;
    cg::grid_group grid = cg::this_grid();
    unsigned char* ws = P.ws;
    const int lo = P.ph_lo, hi = P.ph_hi;
    volatile LAS unsigned* bst = (volatile LAS unsigned*)(lds + 131072 + 64);
    if (threadIdx.x < 2) bst[threadIdx.x] = 0u;
    __syncthreads();
    XcdBarrier xbar = xcd_barrier_post((unsigned*)(ws + WS_CTL), bst);
#define IN(k) (lo <= (k) && (k) < hi)
#define SEAM(k) do { if (IN(k) && IN((k) + 1)) { if ((k) == 0) grid.sync(); else xcd_barrier(xbar); } } while (0)
#ifndef SKIP0
    if (IN(0)) phase_prep(P, lds);
#endif
    SEAM(0);
#ifndef SKIP1
    if (IN(1)) {
        phase_metaproj(P);
        pg8::Gemm g{(const bf16*)(ws + WS_H0B), (const bf16*)(ws + WS_WIN_T), NTOK, DIN, DM}; pg8::StaticOrder S; S.init(NTOK, DIN, (int)gridDim.x, (int)blockIdx.x);
        EpiRowScale<0> E{(bf16*)(ws + WS_PROJ), DIN, (const float*)(ws + WS_RSTD1)};
        pg8::gemm_phase<EpiRowScale<0>, pg8::StaticOrder, true, true>(lds, g, S, E);
    }
#endif
    SEAM(1);
#ifndef SKIP2
    if (IN(2)) phase_conv(P, lds);
#endif
    SEAM(2);
#ifndef SKIP3
    if (IN(3)) {
        pg8::Gemm g{(const bf16*)(ws + WS_Y), (const bf16*)(ws + WS_WOUT_T), NTOK, DM, DM}; pg8::StaticOrder S; S.init(NTOK, DM, (int)gridDim.x, (int)blockIdx.x);
        EpiResidual E{(bf16*)(ws + WS_H2B), P.x, (float*)(ws + WS_SSQ)};
        pg8::gemm_phase<EpiResidual, pg8::StaticOrder, true, true>(lds, g, S, E);
    }
#endif
    SEAM(3);
#ifndef SKIP4
    if (IN(4)) {
        pg8::Gemm g{(const bf16*)(ws + WS_H2B), (const bf16*)(ws + WS_WQ_T), NTOK, 2048, DM}; pg8::StaticOrder S; S.init(NTOK, 2048, (int)gridDim.x, (int)blockIdx.x);
        EpiRowScale<1> E{(bf16*)(ws + WS_Q), 2048, (const float*)(ws + WS_SSQ)};
        pg8::gemm_phase<EpiRowScale<1>, pg8::StaticOrder, true, true>(lds, g, S, E);
    }
#endif
    SEAM(4);
#ifndef SKIP5
    if (IN(5)) for (int rep = 0; rep < REP5; ++rep) phase_route(P, lds);
#endif
    SEAM(5);
    if (IN(6)) phase_gather(P, lds);
#undef IN
#undef SEAM
}

extern "C" void kernel_launch(void* const* d_in, const int* in_sizes, int n_in, void* d_out, int out_size, void* d_ws, size_t ws_size, hipStream_t stream) {
    static int grid = 0;
    if (grid == 0) {
        if (n_in != 18 || in_sizes[0] != NTOK * DM || out_size != NTOK * DM || ws_size < WS_END) {
            fprintf(stderr, "kernel_launch: unexpected shapes (n_in %d in0 %d out %d ws %zu)\n", n_in, n_in > 0 ? in_sizes[0] : -1, out_size, ws_size); grid = -1; return; }
        int dev = 0, cus = 0, per_cu = 0;
        (void)hipGetDevice(&dev); (void)hipDeviceGetAttribute(&cus, hipDeviceAttributeMultiprocessorCount, dev);
        if (hipFuncSetAttribute((const void*)mk_fwd, hipFuncAttributeMaxDynamicSharedMemorySize, LDS_BYTES) != hipSuccess) { fprintf(stderr, "kernel_launch: hipFuncSetAttribute failed\n"); grid = -1; return; }
        if (hipOccupancyMaxActiveBlocksPerMultiprocessor(&per_cu, (const void*)mk_fwd, NTHREADS, LDS_BYTES) != hipSuccess || per_cu < 1) { fprintf(stderr, "kernel_launch: occupancy query failed (%d)\n", per_cu); (void)hipGetLastError(); per_cu = 1; }
        if (per_cu > 1) per_cu = 1;
        grid = cus * per_cu;
        if (grid <= 0) grid = 256;
    }
    if (grid < 0) return;
    Params p{};
    p.x = (const float*)d_in[0]; p.meta = (const float*)d_in[1]; p.g_mix = (const float*)d_in[2]; p.w_in = (const float*)d_in[3]; p.sc_w = (const float*)d_in[4];
    p.cf_w = (const float*)d_in[5]; p.cf_b = (const float*)d_in[6]; p.ln_g = (const float*)d_in[7]; p.ln_b = (const float*)d_in[8]; p.g_sc = (const float*)d_in[9];
    p.g_cf = (const float*)d_in[10]; p.w_out = (const float*)d_in[11]; p.g_ffn = (const float*)d_in[12]; p.w_q = (const float*)d_in[13]; p.keys = (const float*)d_in[14];
    p.pu = (const float*)d_in[15]; p.pv = (const float*)d_in[16]; p.g_fin = (const float*)d_in[17];
    p.out = (float*)d_out; p.ws = (unsigned char*)d_ws;
    (void)hipMemsetAsync((char*)d_ws + WS_CTL, 0, 16384, stream);
#if MK_MULTI
    for (int ph = 0; ph < NPHASE; ++ph) { p.ph_lo = ph; p.ph_hi = ph + 1; p.coop = 0; p.pad = 0;
        hipLaunchKernelGGL(mk_fwd, dim3(grid), dim3(NTHREADS), LDS_BYTES, stream, p); }
#else
    p.ph_lo = 0; p.ph_hi = NPHASE; p.coop = 1; p.pad = 0;
    void* args[] = {&p};
    hipError_t e = hipLaunchCooperativeKernel((const void*)mk_fwd, dim3(grid), dim3(NTHREADS), args, LDS_BYTES, stream);
    if (e != hipSuccess) fprintf(stderr, "cooperative launch failed: %s (grid %d)\n", hipGetErrorString(e), grid);
#endif
}
```

```cpp
#include <hip/hip_runtime.h>
#include <hip/hip_cooperative_groups.h>
#include <cstdio>
#include <cstdint>
namespace cg = cooperative_groups;

namespace pg8 {
#define PG8_LAS __attribute__((address_space(3)))
typedef unsigned short bf16_t;
typedef short bf16x8 __attribute__((ext_vector_type(8)));
typedef float f32x4 __attribute__((ext_vector_type(4)));
typedef unsigned u32x4 __attribute__((ext_vector_type(4)));
constexpr int BM = 256, BK = 64, HALF = 128, HTB = HALF * BK * 2  , STAGE_BYTES = 8 * HTB, NXCD = 8, WGM = 8;

__host__ __device__ __forceinline__ int lds_byte(int r, int c) { const int st = (r >> 4) * 2 + (c >> 5), rr = r & 15, cc = c & 31, ob = rr * 64 + cc * 2; return st * 1024 + (ob ^ (((ob >> 9) & 1) << 5)); }
__host__ __device__ __forceinline__ void stage_rc(int b, int& R, int& C) { const int st = b / 1024, sb = b % 1024, swz = sb ^ (((sb >> 9) & 1) << 5); R = (st >> 1) * 16 + swz / 64; C = (st & 1) * 32 + (swz % 64) / 2; }
__host__ __device__ __forceinline__ int perm32(int rho) { const int n = rho >> 4, i = rho & 15; return 8 * (i >> 2) + 4 * n + (i & 3); }

struct Unit { int pm, pn; };
struct Gemm { const bf16_t* A; const bf16_t* Bt; int M, N, K; };

struct StaticOrder {
    int nM, nN, nwg, G, c;
    __host__ __device__ void init(int M, int N, int G_, int c_) { nM = M / BM; nN = N / BM; nwg = nM * nN; G = G_; c = c_; }
    __host__ __device__ bool next(int i, Unit& u) const {
        const long L = (long)i * G + c; if (L >= nwg) return false;
        int wgid = (int)L; { const int q = nwg / NXCD, r = nwg % NXCD, xcd = wgid % NXCD, off = wgid / NXCD; wgid = (xcd < r ? xcd * (q + 1) : r * (q + 1) + (xcd - r) * q) + off; }
        const int nig = WGM * nN, gid = wgid / nig, fm = gid * WGM, gsz = (nM - fm) < WGM ? (nM - fm) : WGM;
        u.pm = fm + ((wgid % nig) % gsz); u.pn = (wgid % nig) / gsz; return true;
    }
    __device__ __forceinline__ void a_ready(const Unit&) const {}
    __device__ __forceinline__ void done(const Unit&) const {}
};

template <class Epi, class Sched, bool ALIGN_EPI = false, bool SP2 = false>
__device__ __forceinline__ void gemm_phase(PG8_LAS unsigned char* lds, const Gemm g, const Sched& S, const Epi& E) {
    const int tid = threadIdx.x, wid = __builtin_amdgcn_readfirstlane(tid >> 6), lane = tid & 63, wr = wid >> 2, wc = wid & 3, fr = lane & 15, fq = lane >> 4;
    const int K = g.K, nt = K / BK;
    unsigned voffA[2], voffB[2];
#pragma unroll
    for (int i = 0; i < 2; ++i) { int R, C; stage_rc(tid * 16 + i * 8192, R, C); const int Rb = Epi::PERM ? ((R & ~31) + perm32(R & 31)) : R;
        voffA[i] = (unsigned)(R * K + C) * 2u; voffB[i] = (unsigned)(Rb * K + C) * 2u; }
    const size_t kstep = (size_t)(BK * 2);
    const size_t hstep = (size_t)HALF * K * 2;
    const size_t tstep = 2 * hstep;
    const unsigned ldsw = (unsigned)wid * 1024u;
    const int aoff = lds_byte(wr * 64 + fr, fq * 8), boff = lds_byte(wc * 32 + fr, fq * 8);
#define PG8_SA(b, h) (((b) * 2 + (h)) * HTB)
#define PG8_SB(b, h) ((4 + (b) * 2 + (h)) * HTB)
#define PG8_STAGE(bufoff, gbase, voff) do { _Pragma("unroll") for (int _i = 0; _i < 2; ++_i) \
        __builtin_amdgcn_global_load_lds((const unsigned*)((const char*)(gbase) + (voff)[_i]), (PG8_LAS unsigned*)(lds + (bufoff) + ldsw + _i * 8192), 16, 0, 0); } while (0)
#define PG8_LDA(dst, b, h) do { _Pragma("unroll") for (int m = 0; m < 4; ++m) _Pragma("unroll") for (int k = 0; k < 2; ++k) dst[m][k] = *(const PG8_LAS bf16x8*)(lds + PG8_SA(b, h) + aoff + m * 2048 + k * 1024); } while (0)
#define PG8_LDB(dst, b, h) do { _Pragma("unroll") for (int n = 0; n < 2; ++n) _Pragma("unroll") for (int k = 0; k < 2; ++k) dst[n][k] = *(const PG8_LAS bf16x8*)(lds + PG8_SB(b, h) + boff + n * 2048 + k * 1024); } while (0)
#define PG8_MMA(ai, bj, At, Bt) do { __builtin_amdgcn_s_setprio(1); _Pragma("unroll") for (int m = 0; m < 4; ++m) _Pragma("unroll") for (int n = 0; n < 2; ++n) _Pragma("unroll") for (int k = 0; k < 2; ++k) \
        acc[ai][bj][m][n] = __builtin_amdgcn_mfma_f32_16x16x32_bf16(Bt[n][k], At[m][k], acc[ai][bj][m][n], 0, 0, 0); __builtin_amdgcn_s_setprio(0); } while (0)
#define PG8_WAIT_V(n) asm volatile("s_waitcnt vmcnt(" #n ")" ::: "memory")
#define PG8_WAIT_L(n) asm volatile("s_waitcnt lgkmcnt(" #n ")" ::: "memory")
#define PG8_BAR __builtin_amdgcn_s_barrier()
#define PG8_SCHED __builtin_amdgcn_sched_barrier(0)
    Unit cur, nxt; int ui = 0;
    if (!S.next(0, cur)) return;
    f32x4 acc[2][2][4][2];
#pragma unroll
    for (int a = 0; a < 2; ++a)
#pragma unroll
        for (int b = 0; b < 2; ++b)
#pragma unroll
            for (int m = 0; m < 4; ++m)
#pragma unroll
                for (int n = 0; n < 2; ++n) acc[a][b][m][n] = (f32x4){0.f, 0.f, 0.f, 0.f};
    bf16x8 At[4][2], B0[2][2], B1[2][2];
    const char* cA = (const char*)g.A + (size_t)cur.pm * tstep; const char* cB = (const char*)g.Bt + (size_t)cur.pn * tstep;
    S.a_ready(cur);
    if constexpr (SP2) {
        PG8_STAGE(PG8_SB(0, 0), cB, voffB); PG8_STAGE(PG8_SB(0, 1), cB + hstep, voffB); PG8_STAGE(PG8_SA(0, 0), cA, voffA); PG8_STAGE(PG8_SA(0, 1), cA + hstep, voffA);
        if (wr == 1) PG8_BAR;
        PG8_WAIT_V(2); PG8_BAR;
        PG8_STAGE(PG8_SB(1, 0), cB + kstep, voffB); PG8_STAGE(PG8_SA(1, 0), cA + kstep, voffA); PG8_STAGE(PG8_SB(1, 1), cB + hstep + kstep, voffB);
        PG8_WAIT_V(6); PG8_BAR;
    } else {
        PG8_STAGE(PG8_SB(0, 0), cB, voffB); PG8_STAGE(PG8_SA(0, 0), cA, voffA); PG8_STAGE(PG8_SB(0, 1), cB + hstep, voffB); PG8_STAGE(PG8_SA(0, 1), cA + hstep, voffA);
        if (wr == 1) PG8_BAR;
        PG8_WAIT_V(4); PG8_BAR;
        PG8_STAGE(PG8_SB(1, 0), cB + kstep, voffB); PG8_STAGE(PG8_SA(1, 0), cA + kstep, voffA); PG8_STAGE(PG8_SB(1, 1), cB + hstep + kstep, voffB);
        PG8_WAIT_V(6); PG8_BAR;
    }
    for (;;) {
        const bool has_next = S.next(ui + 1, nxt);
        const char* nA = has_next ? (const char*)g.A + (size_t)nxt.pm * tstep : cA; const char* nB = has_next ? (const char*)g.Bt + (size_t)nxt.pn * tstep : cB;
        for (int t = 0; t < nt; t += 2) {
            const bool last = (t == nt - 2);
            const char* a1 = cA + (size_t)(t + 1) * kstep;
            const char* a2 = last ? nA : cA + (size_t)(t + 2) * kstep; const char* b2 = last ? nB : cB + (size_t)(t + 2) * kstep;
            const char* a3 = a2 + kstep; const char* b3 = b2 + kstep;
            if (last && has_next) S.a_ready(nxt);
            if constexpr (SP2) {
            PG8_LDB(B0, 0, 0); PG8_LDB(B1, 0, 1); PG8_SCHED; PG8_LDA(At, 0, 0); PG8_STAGE(PG8_SA(1, 1), a1 + hstep, voffA);
            PG8_WAIT_V(8); PG8_WAIT_L(0); PG8_BAR; PG8_MMA(0, 0, At, B0); PG8_MMA(0, 1, At, B1); PG8_BAR; PG8_SCHED;
            PG8_LDA(At, 0, 1); PG8_STAGE(PG8_SB(0, 0), b2, voffB); PG8_STAGE(PG8_SB(0, 1), b2 + hstep, voffB); PG8_STAGE(PG8_SA(0, 0), a2, voffA);
            PG8_WAIT_V(8); PG8_WAIT_L(0); PG8_BAR; PG8_MMA(1, 0, At, B0); PG8_MMA(1, 1, At, B1); PG8_BAR; PG8_SCHED;
            PG8_LDB(B0, 1, 0); PG8_LDB(B1, 1, 1); PG8_SCHED; PG8_LDA(At, 1, 0); PG8_STAGE(PG8_SA(0, 1), a2 + hstep, voffA);
            PG8_WAIT_V(8); PG8_WAIT_L(0); PG8_BAR; PG8_MMA(0, 0, At, B0); PG8_MMA(0, 1, At, B1); PG8_BAR; PG8_SCHED;
            PG8_LDA(At, 1, 1); PG8_STAGE(PG8_SB(1, 0), b3, voffB); PG8_STAGE(PG8_SB(1, 1), b3 + hstep, voffB); PG8_STAGE(PG8_SA(1, 0), a3, voffA);
            PG8_WAIT_V(8); PG8_WAIT_L(0); PG8_BAR; PG8_MMA(1, 0, At, B0); PG8_MMA(1, 1, At, B1); PG8_BAR; PG8_SCHED;
            } else {
            PG8_LDB(B0, 0, 0); PG8_SCHED; PG8_LDA(At, 0, 0); PG8_STAGE(PG8_SA(1, 1), a1 + hstep, voffA);
            PG8_WAIT_L(8); PG8_BAR; PG8_WAIT_L(0); PG8_MMA(0, 0, At, B0); PG8_BAR; PG8_SCHED;
            PG8_LDB(B1, 0, 1); PG8_STAGE(PG8_SB(0, 0), b2, voffB);
            PG8_BAR; PG8_WAIT_L(0); PG8_MMA(0, 1, At, B1); PG8_BAR;
            PG8_LDA(At, 0, 1); PG8_STAGE(PG8_SA(0, 0), a2, voffA);
            PG8_BAR; PG8_WAIT_L(0); PG8_MMA(1, 0, At, B0); PG8_BAR; PG8_SCHED;
            PG8_STAGE(PG8_SB(0, 1), b2 + hstep, voffB);
            PG8_WAIT_V(6); PG8_BAR; PG8_MMA(1, 1, At, B1); PG8_BAR;
            PG8_LDB(B0, 1, 0); PG8_SCHED; PG8_LDA(At, 1, 0); PG8_STAGE(PG8_SA(0, 1), a2 + hstep, voffA);
            PG8_WAIT_L(8); PG8_BAR; PG8_WAIT_L(0); PG8_MMA(0, 0, At, B0); PG8_BAR; PG8_SCHED;
            PG8_LDB(B1, 1, 1); PG8_STAGE(PG8_SB(1, 0), b3, voffB);
            PG8_BAR; PG8_WAIT_L(0); PG8_MMA(0, 1, At, B1); PG8_BAR;
            PG8_LDA(At, 1, 1); PG8_STAGE(PG8_SA(1, 0), a3, voffA);
            PG8_BAR; PG8_WAIT_L(0); PG8_MMA(1, 0, At, B0); PG8_BAR; PG8_SCHED;
            PG8_STAGE(PG8_SB(1, 1), b3 + hstep, voffB);
            PG8_WAIT_V(6); PG8_BAR; PG8_MMA(1, 1, At, B1); PG8_BAR;
            }
        }
        if constexpr (ALIGN_EPI) { if (wr == 0) PG8_BAR; }
        if constexpr (!Epi::AFTER_DRAIN) { E(acc, cur, wr, wc, fr, fq); S.done(cur); }
        if (!has_next) break;
#pragma unroll
        for (int a = 0; a < 2; ++a)
#pragma unroll
            for (int b = 0; b < 2; ++b)
#pragma unroll
                for (int m = 0; m < 4; ++m)
#pragma unroll
                    for (int n = 0; n < 2; ++n) acc[a][b][m][n] = (f32x4){0.f, 0.f, 0.f, 0.f};
        cur = nxt; cA = nA; cB = nB; ++ui;
        if constexpr (ALIGN_EPI) { if (wr == 1) PG8_BAR; }
    }
    PG8_WAIT_V(0);
    if constexpr (!ALIGN_EPI) { if (wr == 0) PG8_BAR; }
    PG8_BAR;
    if constexpr (Epi::AFTER_DRAIN) { E.fused(acc, cur, wr, wc, fr, fq, lds, wid, lane); S.done(cur); }
#undef PG8_SA
#undef PG8_SB
#undef PG8_STAGE
#undef PG8_LDA
#undef PG8_LDB
#undef PG8_MMA
#undef PG8_WAIT_V
#undef PG8_WAIT_L
#undef PG8_BAR
#undef PG8_SCHED
}
}

#define LAS __attribute__((address_space(3)))
typedef unsigned short bf16;
typedef float f32x2 __attribute__((ext_vector_type(2)));
typedef float f32x4 __attribute__((ext_vector_type(4)));
typedef unsigned u32x2 __attribute__((ext_vector_type(2)));
typedef unsigned u32x4 __attribute__((ext_vector_type(4)));

constexpr int NTOK = 32768, DM = 1024, DIN = 2560, SEQ = 8192, NBATCH = 4, NMETA = 16;
constexpr int NHEAD = 8, NKEYS = 128, TOPK = 16, NSEL = NHEAD * TOPK;
constexpr float EPS = 1e-6f;
constexpr float U_SCALE = 64.f, V_SCALE = 16.f;
constexpr int NWAVES = 8, NTHREADS = 512;
constexpr int MKC = 32;
constexpr int LDS_BYTES = 147456;

constexpr size_t MiB = 1u << 20;
constexpr size_t WS_CTL = 0, WS_WIN_T = 1 * MiB, WS_WOUT_T = 6 * MiB, WS_WQ_T = 8 * MiB, WS_KEYS = 12 * MiB, WS_METAPART = 160 * MiB  ,
                 WS_METARSTD = 14 * MiB + 512 * 1024, WS_METAPROJ = 14 * MiB + 576 * 1024, WS_RSTD1 = 15 * MiB, WS_SSQ = 16 * MiB, WS_U8 = 32 * MiB, WS_V8 = 48 * MiB,
                 WS_IDX = 64 * MiB, WS_GATE = 80 * MiB, WS_H0B = 96 * MiB, WS_H2B = 96 * MiB, WS_Y = 160 * MiB, WS_PROJ = 224 * MiB,
                 WS_Q = 224 * MiB, WS_ESCALE = 18 * MiB, WS_END = 384 * MiB;

struct Params {
    const float* x; const float* meta; const float* g_mix; const float* w_in; const float* sc_w; const float* cf_w; const float* cf_b;
    const float* ln_g; const float* ln_b; const float* g_sc; const float* g_cf; const float* w_out; const float* g_ffn; const float* w_q;
    const float* keys; const float* pu; const float* pv; const float* g_fin;
    float* out; unsigned char* ws;
    int ph_lo, ph_hi, coop, pad;
};

__device__ __forceinline__ unsigned f2bf(float f) { unsigned u = __builtin_bit_cast(unsigned, f); return (u + 0x7fffu + ((u >> 16) & 1u)) >> 16; }
__device__ __forceinline__ unsigned pk2(float lo, float hi) { return f2bf(lo) | (f2bf(hi) << 16); }
__device__ __forceinline__ float bf2f(unsigned b) { return __builtin_bit_cast(float, b << 16); }
__device__ __forceinline__ float bflo(unsigned w) { return __builtin_bit_cast(float, w << 16); }
__device__ __forceinline__ float bfhi(unsigned w) { return __builtin_bit_cast(float, w & 0xffff0000u); }
__device__ __forceinline__ float wave_sum(float v) {
#pragma unroll
    for (int o = 1; o < 64; o <<= 1) v += __shfl_xor(v, o);
    return v;
}
template <int CTRL> __device__ __forceinline__ float dpp_f(float v) { return __builtin_bit_cast(float, __builtin_amdgcn_update_dpp(0, __builtin_bit_cast(int, v), CTRL, 0xf, 0xf, true)); }
__device__ __forceinline__ float wave_sum_fast(float v) {
    v += dpp_f<0xB1>(v); v += dpp_f<0x4E>(v); v += dpp_f<0x141>(v); v += dpp_f<0x140>(v);
    { auto r = __builtin_amdgcn_permlane16_swap(__float_as_uint(v), __float_as_uint(v), false, false); v = __uint_as_float(r[0]) + __uint_as_float(r[1]); }
    { auto r = __builtin_amdgcn_permlane32_swap(__float_as_uint(v), __float_as_uint(v), false, false); v = __uint_as_float(r[0]) + __uint_as_float(r[1]); }
    return v;
}
__device__ __forceinline__ float sigmoid_f(float x) { return 1.f / (1.f + __expf(-x)); }
__device__ __forceinline__ float gelu_tanh_f(float x) {
    const float t = 0.7978845608028654f * (x + 0.044715f * x * x * x);
    const float e = __expf(2.f * t);
    const float th = 1.f - 2.f / (e + 1.f);
    return 0.5f * x * (1.f + th);
}

__device__ __forceinline__ unsigned cvt_pk_bf16(float lo, float hi) { unsigned r; asm volatile("v_cvt_pk_bf16_f32 %0, %1, %2" : "=v"(r) : "v"(lo), "v"(hi)); return r; }

template <int MODE> struct EpiRowScale {
    static constexpr bool PERM = true, AFTER_DRAIN = false;
    bf16* O; int ldc; const float* rs;
    __device__ __forceinline__ void operator()(const pg8::f32x4 (&acc)[2][2][4][2], const pg8::Unit& u, int wr, int wc, int fr, int fq) const {
        const int row0 = u.pm * 256 + wr * 64 + fr, col0 = u.pn * 256 + wc * 32 + 8 * fq;
#pragma unroll
        for (int ai = 0; ai < 2; ++ai)
#pragma unroll
            for (int m = 0; m < 4; ++m) {
                const int row = row0 + ai * 128 + m * 16;
                float s;
                if (MODE == 0) s = rs[row];
                else { const f32x4* p = (const f32x4*)(rs + (size_t)row * 16); const f32x4 a = p[0], b = p[1], c = p[2], d = p[3];
                       const float t = ((a.x + a.y) + (a.z + a.w)) + ((b.x + b.y) + (b.z + b.w)) + ((c.x + c.y) + (c.z + c.w)) + ((d.x + d.y) + (d.z + d.w));
                       s = rsqrtf(t * (1.f / 1024.f) + EPS); }
                bf16* rowp = O + (size_t)row * ldc + col0;
#pragma unroll
                for (int bj = 0; bj < 2; ++bj) { const pg8::f32x4 v0 = acc[ai][bj][m][0] * s, v1 = acc[ai][bj][m][1] * s;
                    u32x4 w; w.x = cvt_pk_bf16(v0[0], v0[1]); w.y = cvt_pk_bf16(v0[2], v0[3]); w.z = cvt_pk_bf16(v1[0], v1[1]); w.w = cvt_pk_bf16(v1[2], v1[3]);
                    *(u32x4*)(rowp + bj * 128) = w; }
            }
    }
};
struct EpiResidual {
    static constexpr bool PERM = true, AFTER_DRAIN = false;
    bf16* O; const bf16* XB; float* ssq;
    __device__ __forceinline__ void operator()(const pg8::f32x4 (&acc)[2][2][4][2], const pg8::Unit& u, int wr, int wc, int fr, int fq) const {
        const int row0 = u.pm * 256 + wr * 64 + fr, col0 = u.pn * 256 + wc * 32 + 8 * fq;
#pragma unroll
        for (int ai = 0; ai < 2; ++ai)
#pragma unroll
            for (int m = 0; m < 4; ++m) {
                const int row = row0 + ai * 128 + m * 16;
                const bf16* xr = XB + (size_t)row * DM + col0; bf16* rowp = O + (size_t)row * DM + col0;
                float q = 0.f;
                u32x4 xw[2];
#pragma unroll
                for (int bj = 0; bj < 2; ++bj) xw[bj] = *(const u32x4*)(xr + bj * 128);
#pragma unroll
                for (int bj = 0; bj < 2; ++bj) { const f32x4 x0 = (f32x4){bflo(xw[bj].x), bfhi(xw[bj].x), bflo(xw[bj].y), bfhi(xw[bj].y)}, x1 = (f32x4){bflo(xw[bj].z), bfhi(xw[bj].z), bflo(xw[bj].w), bfhi(xw[bj].w)};
                    const pg8::f32x4 v0 = acc[ai][bj][m][0] + x0, v1 = acc[ai][bj][m][1] + x1;
                    q += (v0[0] * v0[0] + v0[1] * v0[1]) + (v0[2] * v0[2] + v0[3] * v0[3]) + (v1[0] * v1[0] + v1[1] * v1[1]) + (v1[2] * v1[2] + v1[3] * v1[3]);
                    u32x4 w; w.x = cvt_pk_bf16(v0[0], v0[1]); w.y = cvt_pk_bf16(v0[2], v0[3]); w.z = cvt_pk_bf16(v1[0], v1[1]); w.w = cvt_pk_bf16(v1[2], v1[3]);
                    *(u32x4*)(rowp + bj * 128) = w; }
                q += __shfl_xor(q, 16); q += __shfl_xor(q, 32);
                if (fq == 0) ssq[(size_t)row * 16 + u.pn * 4 + wc] = q;
            }
    }
};

__device__ __forceinline__ void p0_transpose_item(const float* W, int K, int N, bf16* WT, LAS float* scr, int item, int lane,
                                                  const float* g_lo, const float* g_hi, int split) {
    const int nblk = N / 32, kb = item / nblk, nb = item % nblk, k0 = 64 * kb, n0 = 32 * nb;
#pragma unroll 8
    for (int i = 0; i < 32; ++i) { const int kk = 2 * i + (lane >> 5); const int k = k0 + kk;
        const float g = (k < split) ? g_lo[k] : g_hi[k - split];
        scr[kk * 33 + (lane & 31)] = W[(size_t)k * N + n0 + (lane & 31)] * g; }
    asm volatile("s_waitcnt lgkmcnt(0)" ::: "memory");
    const int c = lane & 7;
#pragma unroll
    for (int j = 0; j < 4; ++j) { const int n = (lane >> 3) + 8 * j; const LAS float* s = scr + (8 * c) * 33 + n;
        u32x4 o; o.x = pk2(s[0 * 33], s[1 * 33]); o.y = pk2(s[2 * 33], s[3 * 33]); o.z = pk2(s[4 * 33], s[5 * 33]); o.w = pk2(s[6 * 33], s[7 * 33]);
        *(u32x4*)(WT + (size_t)(n0 + n) * K + k0 + 8 * c) = o; }
    asm volatile("s_waitcnt lgkmcnt(0)" ::: "memory");
}

__device__ __forceinline__ float q4(float x, float inv_s) {
    const float a = fabsf(x) * inv_s; float r;
    if (a < 2.f) r = rintf(a * 2.f) * 0.5f; else if (a < 4.f) r = rintf(a); else r = fminf(6.f, rintf(a * 0.5f) * 2.f);
    return copysignf(r, x);
}
__device__ __forceinline__ void phase_prep(const Params& P, LAS unsigned char* lds) {
    const int tid = threadIdx.x, lane = tid & 63, wave = __builtin_amdgcn_readfirstlane(tid >> 6);
    const int gw = blockIdx.x * NWAVES + wave, NGW = gridDim.x * NWAVES;
    unsigned char* ws = P.ws;
    LAS float* scr = (LAS float*)(lds + wave * 16384);
    constexpr int I_IN = (DM / 64) * (DIN / 32), I_OUT = (DM / 64) * (DM / 32), I_Q = (DM / 64) * (2048 / 32);
    for (int it = gw; it < I_IN + I_OUT + I_Q; it += NGW) {
        int r = it;
        if (r < I_IN) { p0_transpose_item(P.w_in, DM, DIN, (bf16*)(ws + WS_WIN_T), scr, r, lane, P.g_mix, P.g_mix, DM); continue; } r -= I_IN;
        if (r < I_OUT) { p0_transpose_item(P.w_out, DM, DM, (bf16*)(ws + WS_WOUT_T), scr, r, lane, P.g_sc, P.g_cf, 512); continue; } r -= I_OUT;
        p0_transpose_item(P.w_q, DM, 2048, (bf16*)(ws + WS_WQ_T), scr, r, lane, P.g_ffn, P.g_ffn, DM);
    }
    {
        bf16* H0B = (bf16*)(ws + WS_H0B); float* RSTD1 = (float*)(ws + WS_RSTD1);
        for (int t0 = gw * 4; t0 < NTOK; t0 += NGW * 4) {
            f32x4 v[4][4];
#pragma unroll
            for (int q = 0; q < 4; ++q) { const f32x4* xr = (const f32x4*)(P.x + (size_t)(t0 + q) * DM) + lane;
#pragma unroll
                for (int j = 0; j < 4; ++j) v[q][j] = xr[64 * j]; }
#pragma unroll
            for (int q = 0; q < 4; ++q) { float sq = 0.f;
#pragma unroll
                for (int j = 0; j < 4; ++j) sq += (v[q][j].x * v[q][j].x + v[q][j].y * v[q][j].y) + (v[q][j].z * v[q][j].z + v[q][j].w * v[q][j].w);
                sq = wave_sum_fast(sq);
                if (lane == 0) RSTD1[t0 + q] = rsqrtf(sq * (1.f / DM) + EPS);
                u32x2* o = (u32x2*)(H0B + (size_t)(t0 + q) * DM) + lane;
#pragma unroll
                for (int j = 0; j < 4; ++j) { u32x2 w; w.x = pk2(v[q][j].x, v[q][j].y); w.y = pk2(v[q][j].z, v[q][j].w); o[64 * j] = w; } }
        }
    }
    {
        unsigned char* U8 = ws + WS_U8; unsigned char* V8 = ws + WS_V8;
        f32x4 gf[4];
#pragma unroll
        for (int j = 0; j < 4; ++j) gf[j] = ((const f32x4*)P.g_ffn)[64 * j + lane];
        float* ESC = (float*)(ws + WS_ESCALE);
        for (int e0 = gw * 2; e0 < 2 * 16384; e0 += NGW * 2) {
            const bool isv = e0 >= 16384; const int ee0 = isv ? e0 - 16384 : e0;
            f32x4 v[2][4];
#pragma unroll
            for (int q = 0; q < 2; ++q) { const f32x4* src = (const f32x4*)((isv ? P.pv : P.pu) + (size_t)(ee0 + q) * DM) + lane;
#pragma unroll
                for (int j = 0; j < 4; ++j) v[q][j] = src[64 * j]; }
#pragma unroll
            for (int q = 0; q < 2; ++q) {
                float mx = 0.f;
#pragma unroll
                for (int j = 0; j < 4; ++j) { if (!isv) v[q][j] = v[q][j] * gf[j];
                    mx = fmaxf(mx, fmaxf(fmaxf(fabsf(v[q][j].x), fabsf(v[q][j].y)), fmaxf(fabsf(v[q][j].z), fabsf(v[q][j].w)))); }
#pragma unroll
                for (int o = 1; o < 64; o <<= 1) mx = fmaxf(mx, __shfl_xor(mx, o));
                const float sc = fmaxf(mx, 1e-30f) * (1.f / 6.f), inv = 1.f / sc;
                if (lane == 0) ESC[e0 + q] = sc;
                unsigned w0 = 0u, w1 = 0u;
                w0 = __builtin_amdgcn_cvt_scalef32_pk_fp4_f32(w0, v[q][0].x * inv, v[q][0].y * inv, 1.0f, 0); w0 = __builtin_amdgcn_cvt_scalef32_pk_fp4_f32(w0, v[q][0].z * inv, v[q][0].w * inv, 1.0f, 1);
                w0 = __builtin_amdgcn_cvt_scalef32_pk_fp4_f32(w0, v[q][1].x * inv, v[q][1].y * inv, 1.0f, 2); w0 = __builtin_amdgcn_cvt_scalef32_pk_fp4_f32(w0, v[q][1].z * inv, v[q][1].w * inv, 1.0f, 3);
                w1 = __builtin_amdgcn_cvt_scalef32_pk_fp4_f32(w1, v[q][2].x * inv, v[q][2].y * inv, 1.0f, 0); w1 = __builtin_amdgcn_cvt_scalef32_pk_fp4_f32(w1, v[q][2].z * inv, v[q][2].w * inv, 1.0f, 1);
                w1 = __builtin_amdgcn_cvt_scalef32_pk_fp4_f32(w1, v[q][3].x * inv, v[q][3].y * inv, 1.0f, 2); w1 = __builtin_amdgcn_cvt_scalef32_pk_fp4_f32(w1, v[q][3].z * inv, v[q][3].w * inv, 1.0f, 3);
                u32x2 o; o.x = w0; o.y = w1;
                *(u32x2*)((isv ? V8 : U8) + (size_t)(ee0 + q) * 512 + 8 * lane) = o;
            }
        }
    }
    {
        bf16* KB = (bf16*)(ws + WS_KEYS);
        const int gt = blockIdx.x * NTHREADS + tid, NGT = gridDim.x * NTHREADS;
        for (int i = gt; i < 8 * 2 * 128 * 128 / 4; i += NGT) { const f32x4 v = ((const f32x4*)P.keys)[i]; u32x2 w; w.x = pk2(v.x, v.y); w.y = pk2(v.z, v.w); ((u32x2*)KB)[i] = w; }
    }
    {
        float* MP = (float*)(ws + WS_METAPART); float* MR = (float*)(ws + WS_METARSTD);
        for (int r = gw; r < NMETA; r += NGW) {
            float s = 0.f;
            for (int k = lane; k < DM; k += 64) { const float v = P.meta[r * DM + k]; s += v * v; }
            s = wave_sum(s);
            if (lane == 0) MR[r] = rsqrtf(s * (1.f / DM) + EPS);
        }
        for (int it = gw; it < MKC * 40; it += NGW) {
            const int kc = it / 40, nb = it % 40, n = nb * 64 + lane;
            float acc[NMETA];
#pragma unroll
            for (int r = 0; r < NMETA; ++r) acc[r] = 0.f;
            for (int k = kc * (DM / MKC); k < (kc + 1) * (DM / MKC); ++k) {
                const float w = P.w_in[(size_t)k * DIN + n] * P.g_mix[k];
#pragma unroll
                for (int r = 0; r < NMETA; ++r) acc[r] += P.meta[r * DM + k] * w;
            }
#pragma unroll
            for (int r = 0; r < NMETA; ++r) MP[(size_t)(kc * 16 + r) * DIN + n] = acc[r];
        }
    }
}

__device__ __forceinline__ void phase_metaproj(const Params& P) {
    const float* MP = (const float*)(P.ws + WS_METAPART); const float* MR = (const float*)(P.ws + WS_METARSTD); float* MJ = (float*)(P.ws + WS_METAPROJ);
    const int gt = blockIdx.x * NTHREADS + threadIdx.x;
    if (gt < NMETA * DIN) { const int p = gt / DIN, col = gt % DIN; float s = 0.f;
#pragma unroll
        for (int kc = 0; kc < MKC; ++kc) s += MP[(size_t)(kc * 16 + p) * DIN + col];
        MJ[gt] = s * MR[p]; }
}
__device__ __forceinline__ float meta_val(const float* MJ, const float*, int p, int col) { return MJ[p * DIN + col]; }
__device__ __forceinline__ float proj_at(const bf16* PROJ, const float* MP, const float* MR, int b, int pos, int col) {
    if (pos < 0) return 0.f;
    if (pos < NMETA) return meta_val(MP, MR, pos, col);
    return bf2f(PROJ[(size_t)(b * SEQ + pos - NMETA) * DIN + col]);
}
__device__ __forceinline__ void proj8_at(const bf16* PROJ, const float* MP, const float* MR, int b, int pos, int col, float (&v)[8]) {
    if (pos < 0) {
#pragma unroll
        for (int i = 0; i < 8; ++i) v[i] = 0.f;
    } else if (pos < NMETA) {
        const f32x4 a = *(const f32x4*)(MP + pos * DIN + col), bq = *(const f32x4*)(MP + pos * DIN + col + 4);
        v[0] = a.x; v[1] = a.y; v[2] = a.z; v[3] = a.w; v[4] = bq.x; v[5] = bq.y; v[6] = bq.z; v[7] = bq.w;
    } else {
        const u32x4 w = *(const u32x4*)(PROJ + (size_t)(b * SEQ + pos - NMETA) * DIN + col);
        v[0] = bflo(w.x); v[1] = bfhi(w.x); v[2] = bflo(w.y); v[3] = bfhi(w.y); v[4] = bflo(w.z); v[5] = bfhi(w.z); v[6] = bflo(w.w); v[7] = bfhi(w.w);
    }
}

template <int R> __device__ __forceinline__ void conv_rows(const LAS unsigned char* ubase, const f32x2 (&wcf)[31], f32x2 (&acc)[32]) {
    if constexpr (R < 62) {
        const unsigned uw = *(const LAS unsigned*)(ubase + R * 1024);
        const f32x2 x = (f32x2){bflo(uw), bfhi(uw)};
        constexpr int lo = R > 30 ? R - 30 : 0, hi = R < 31 ? R : 31;
#pragma unroll
        for (int ii = lo; ii <= hi; ++ii) acc[ii] += wcf[R - ii] * x;
        conv_rows<R + 1>(ubase, wcf, acc);
    }
}
__device__ __forceinline__ void phase_conv(const Params& P, LAS unsigned char* lds) {
    const int tid = threadIdx.x, lane = tid & 63, wave = __builtin_amdgcn_readfirstlane(tid >> 6);
    unsigned char* ws = P.ws;
    const bf16* PROJ = (const bf16*)(ws + WS_PROJ); const float* MP = (const float*)(ws + WS_METAPROJ); const float* MR = nullptr;
    bf16* Y = (bf16*)(ws + WS_Y);
    constexpr int TT = 64, NTILE = NTOK / TT, UROWS = TT + 30;
    const int cgp = wave & 3, th = wave >> 2, ch2 = cgp * 128 + 2 * lane;
    f32x2 wcf[31];
#pragma unroll
    for (int j = 0; j < 31; ++j) wcf[j] = *(const f32x2*)(P.cf_w + j * 512 + ch2);
    const f32x2 bcf = *(const f32x2*)(P.cf_b + ch2);
    for (int tile = blockIdx.x; tile < NTILE; tile += gridDim.x) {
        const int b = tile / (SEQ / TT), s0 = (tile % (SEQ / TT)) * TT;
#pragma unroll 4
        for (int p = 0; p < (UROWS + 7) / 8; ++p) {
            const int r = p * 8 + wave;
            if (r < UROWS) {
                const int pos = NMETA + s0 - 30 + r;
                float ga[8], gg[8];
                proj8_at(PROJ, MP, MR, b, pos, 1536 + 8 * lane, ga); proj8_at(PROJ, MP, MR, b, pos, 2048 + 8 * lane, gg);
                u32x4 w;
                w.x = pk2(ga[0] * sigmoid_f(gg[0]), ga[1] * sigmoid_f(gg[1])); w.y = pk2(ga[2] * sigmoid_f(gg[2]), ga[3] * sigmoid_f(gg[3]));
                w.z = pk2(ga[4] * sigmoid_f(gg[4]), ga[5] * sigmoid_f(gg[5])); w.w = pk2(ga[6] * sigmoid_f(gg[6]), ga[7] * sigmoid_f(gg[7]));
                *(LAS u32x4*)(lds + r * 1024 + lane * 16) = w;
            }
        }
        __syncthreads();
        f32x2 acc[32];
#pragma unroll
        for (int ii = 0; ii < 32; ++ii) acc[ii] = bcf;
        conv_rows<0>(lds + (32 * th) * 1024 + ch2 * 2, wcf, acc);
        __syncthreads();
#pragma unroll
        for (int ii = 0; ii < 32; ++ii) *(LAS f32x2*)(lds + (32 * th + ii) * 2048 + ch2 * 4) = acc[ii];
        __syncthreads();
        {
            float lng[8], lnb[8];
            { const f32x4 a = *(const f32x4*)(P.ln_g + 8 * lane), c = *(const f32x4*)(P.ln_g + 8 * lane + 4), d = *(const f32x4*)(P.ln_b + 8 * lane), e = *(const f32x4*)(P.ln_b + 8 * lane + 4);
              lng[0] = a.x; lng[1] = a.y; lng[2] = a.z; lng[3] = a.w; lng[4] = c.x; lng[5] = c.y; lng[6] = c.z; lng[7] = c.w;
              lnb[0] = d.x; lnb[1] = d.y; lnb[2] = d.z; lnb[3] = d.w; lnb[4] = e.x; lnb[5] = e.y; lnb[6] = e.z; lnb[7] = e.w; }
            float wsc[3][8];
#pragma unroll
            for (int j = 0; j < 3; ++j) { const f32x4 a = *(const f32x4*)(P.sc_w + j * 512 + 8 * lane), c = *(const f32x4*)(P.sc_w + j * 512 + 8 * lane + 4);
                wsc[j][0] = a.x; wsc[j][1] = a.y; wsc[j][2] = a.z; wsc[j][3] = a.w; wsc[j][4] = c.x; wsc[j][5] = c.y; wsc[j][6] = c.z; wsc[j][7] = c.w; }
            float cxa[8], cxb[8];
            { float xv[8], cgv[8]; const int pos = NMETA + s0 + 8 * wave - 2;
              proj8_at(PROJ, MP, MR, b, pos, 8 * lane, xv); proj8_at(PROJ, MP, MR, b, pos, 1024 + 8 * lane, cgv);
#pragma unroll
              for (int i = 0; i < 8; ++i) cxa[i] = xv[i] * cgv[i];
              proj8_at(PROJ, MP, MR, b, pos + 1, 8 * lane, xv); proj8_at(PROJ, MP, MR, b, pos + 1, 1024 + 8 * lane, cgv);
#pragma unroll
              for (int i = 0; i < 8; ++i) cxb[i] = xv[i] * cgv[i]; }
#pragma unroll 2
            for (int q = 0; q < 8; ++q) {
                const int ii = 8 * wave + q, s = s0 + ii; const size_t t = (size_t)b * SEQ + s;
                float o[8];
                { const f32x4 a = *(const LAS f32x4*)(lds + ii * 2048 + lane * 32), c = *(const LAS f32x4*)(lds + ii * 2048 + lane * 32 + 16);
                  o[0] = a.x; o[1] = a.y; o[2] = a.z; o[3] = a.w; o[4] = c.x; o[5] = c.y; o[6] = c.z; o[7] = c.w; }
                float s1 = 0.f;
#pragma unroll
                for (int i = 0; i < 8; ++i) s1 += o[i];
                const float mean = wave_sum_fast(s1) * (1.f / 512.f);
                float s2 = 0.f;
#pragma unroll
                for (int i = 0; i < 8; ++i) { o[i] -= mean; s2 += o[i] * o[i]; }
                const float rs = rsqrtf(wave_sum_fast(s2) * (1.f / 512.f) + EPS);
                float s3 = 0.f;
#pragma unroll
                for (int i = 0; i < 8; ++i) { float y = o[i] * rs * lng[i] + lnb[i]; y = y * sigmoid_f(y); o[i] = y; s3 += y * y; }
                const float r2 = rsqrtf(wave_sum_fast(s3) * (1.f / 512.f) + EPS);
                u32x4 wv; wv.x = pk2(o[0] * r2, o[1] * r2); wv.y = pk2(o[2] * r2, o[3] * r2); wv.z = pk2(o[4] * r2, o[5] * r2); wv.w = pk2(o[6] * r2, o[7] * r2);
                *(u32x4*)(Y + t * DM + 512 + 8 * lane) = wv;
                float xv[8], cgv[8], bgv[8], cxc[8], accs[8];
                proj8_at(PROJ, MP, MR, b, NMETA + s, 8 * lane, xv); proj8_at(PROJ, MP, MR, b, NMETA + s, 1024 + 8 * lane, cgv); proj8_at(PROJ, MP, MR, b, NMETA + s, 512 + 8 * lane, bgv);
                float s4 = 0.f;
#pragma unroll
                for (int i = 0; i < 8; ++i) { cxc[i] = xv[i] * cgv[i]; accs[i] = bgv[i] * (wsc[0][i] * cxa[i] + wsc[1][i] * cxb[i] + wsc[2][i] * cxc[i]); s4 += accs[i] * accs[i]; cxa[i] = cxb[i]; cxb[i] = cxc[i]; }
                const float r4 = rsqrtf(wave_sum_fast(s4) * (1.f / 512.f) + EPS);
                u32x4 wz; wz.x = pk2(accs[0] * r4, accs[1] * r4); wz.y = pk2(accs[2] * r4, accs[3] * r4); wz.z = pk2(accs[4] * r4, accs[5] * r4); wz.w = pk2(accs[6] * r4, accs[7] * r4);
                *(u32x4*)(Y + t * DM + 8 * lane) = wz;
            }
        }
        __syncthreads();
    }
}

__device__ __forceinline__ int ord_i(float s) { int k = __builtin_bit_cast(int, s); k ^= (k >> 31) & 0x7fffffff; return k; }
__device__ __forceinline__ float unord_f(int k) { k ^= (k >> 31) & 0x7fffffff; return __builtin_bit_cast(float, k); }
#define TOP_INSERT(L, x_) do { int _x = (x_); _Pragma("unroll") for (int _i = 0; _i < 16; ++_i) { const int _hi = max(L[_i], _x); _x = min(L[_i], _x); L[_i] = _hi; } } while (0)

typedef short bf16x8 __attribute__((ext_vector_type(8)));
typedef float f32x16 __attribute__((ext_vector_type(16)));
template <bool DESC> __device__ __forceinline__ void ce_i(int& a, int& b) { const int hi = max(a, b), lo = min(a, b); if (DESC) { a = hi; b = lo; } else { a = lo; b = hi; } }
__device__ __forceinline__ void bitonic_sort16(int (&a)[16]) {
#pragma unroll
    for (int k = 2; k <= 16; k <<= 1)
#pragma unroll
        for (int j = k >> 1; j > 0; j >>= 1)
#pragma unroll
            for (int i = 0; i < 16; ++i) { const int l = i ^ j; if (l > i) { if ((i & k) == 0) ce_i<true>(a[i], a[l]); else ce_i<false>(a[i], a[l]); } }
}
__device__ __forceinline__ void bitonic_merge16(int (&a)[16]) {
#pragma unroll
    for (int j = 8; j > 0; j >>= 1)
#pragma unroll
        for (int i = 0; i < 16; ++i) { const int l = i ^ j; if (l > i) ce_i<true>(a[i], a[l]); }
}
__device__ __forceinline__ void merge_top16(int (&a)[16], const int (&b)[16]) {
#pragma unroll
    for (int i = 0; i < 16; ++i) a[i] = max(a[i], b[15 - i]);
    bitonic_merge16(a);
}
__device__ __forceinline__ int lut16(const unsigned (&T)[4], int i) {
    const unsigned sel = (unsigned)(i & 7) | 0x0c0c0c00u;
    const unsigned lo = __builtin_amdgcn_perm(T[1], T[0], sel), hi = __builtin_amdgcn_perm(T[3], T[2], sel);
    return (int)((i & 8) ? hi : lo);
}
constexpr int KROW = 272;
constexpr float SCORE_BIAS = 8.0f;

__device__ __forceinline__ void route_half(const LAS unsigned char* kl, const bf16* qrow, int nl, int hb, int (&L)[16]) {
    bf16x8 qf[8];
#pragma unroll
    for (int ks = 0; ks < 8; ++ks) qf[ks] = *(const bf16x8*)(qrow + 64 * hb + 8 * ks);
    f32x16 acc[4];
#pragma unroll
    for (int nt = 0; nt < 4; ++nt)
#pragma unroll
        for (int r = 0; r < 16; ++r) acc[nt][r] = SCORE_BIAS;
#pragma unroll
    for (int ks = 0; ks < 8; ++ks)
#pragma unroll
        for (int nt = 0; nt < 4; ++nt) {
            const bf16x8 a = *(const LAS bf16x8*)(kl + (32 * nt + nl) * KROW + (64 * hb + 8 * ks) * 2);
            acc[nt] = __builtin_amdgcn_mfma_f32_32x32x16_bf16(a, qf[ks], acc[nt], 0, 0, 0);
        }
    const int hb4 = 4 * hb;
    int T[4][16];
#pragma unroll
    for (int nt = 0; nt < 4; ++nt)
#pragma unroll
        for (int r = 0; r < 16; ++r) { const int n0 = 32 * nt + (r & 3) + 8 * (r >> 2); const float sc = acc[nt][r];
            T[nt][r] = (__float_as_int(sc) & ~127) | ((127 - n0) - hb4); }
    bitonic_sort16(T[0]); bitonic_sort16(T[1]); bitonic_sort16(T[2]); bitonic_sort16(T[3]);
    merge_top16(T[0], T[1]); merge_top16(T[2], T[3]); merge_top16(T[0], T[2]);
#pragma unroll
    for (int i = 0; i < 16; ++i) { const unsigned v = (unsigned)T[0][15 - i]; auto r = __builtin_amdgcn_permlane32_swap(v, v, false, false);
        const unsigned r0 = r[0], r1 = r[1]; const int partner = (int)(hb ? r0 : r1); L[i] = max(T[0][i], partner); }
    bitonic_merge16(L);
}

__device__ __forceinline__ void phase_route(const Params& P, LAS unsigned char* lds) {
    const int tid = threadIdx.x, lane = tid & 63, wave = __builtin_amdgcn_readfirstlane(tid >> 6);
    const int nl = lane & 31, hb = lane >> 5;
    unsigned char* ws = P.ws;
    const bf16* KEYS = (const bf16*)(ws + WS_KEYS); const bf16* Q = (const bf16*)(ws + WS_Q);
    int* IDX = (int*)(ws + WS_IDX); float* GATE = (float*)(ws + WS_GATE);
    int last_h = -1;
    for (int unit = blockIdx.x; unit < (NTOK / 256) * NHEAD; unit += gridDim.x) {
        const int h = unit & 7, tb = unit >> 3;
        if (h != last_h) {
            __syncthreads();
            for (int c = tid; c < 4096; c += NTHREADS) { const u32x4 v = ((const u32x4*)(KEYS + (size_t)h * 32768))[c];
                *(LAS u32x4*)(lds + (c >> 4) * KROW + (c & 15) * 16) = v; }
            __syncthreads();
            last_h = h;
        }
        const size_t t = (size_t)tb * 256 + wave * 32 + nl;
        int L1[16], L2[16];
        route_half(lds, Q + t * 2048 + h * 256, nl, hb, L1);
        route_half(lds + 128 * KROW, Q + t * 2048 + h * 256 + 128, nl, hb, L2);
        float v1[16], v2[16];
#pragma unroll
        for (int i = 0; i < 16; ++i) { v1[i] = __int_as_float(L1[i] & ~127); v2[i] = __int_as_float(L2[i] & ~127); }
#define CAND(i, j) ((__float_as_int(v1[i] + v2[j]) & ~255) | (255 - (16 * (i) + (j))))
        int A[16], B[16], C[16];
#pragma unroll
        for (int j = 0; j < 16; ++j) A[j] = CAND(0, j);
#pragma unroll
        for (int j = 0; j < 8; ++j) { B[j] = CAND(1, j); B[8 + j] = CAND(15 - j, 0); }
        bitonic_merge16(B);
        C[0] = CAND(2, 0); C[1] = CAND(2, 1); C[2] = CAND(2, 2); C[3] = CAND(2, 3); C[4] = CAND(2, 4);
        C[5] = CAND(3, 0); C[6] = CAND(3, 1); C[7] = CAND(3, 2); C[8] = CAND(3, 3);
        C[9] = CAND(4, 0); C[10] = CAND(4, 1); C[11] = CAND(4, 2);
        C[12] = CAND(5, 0); C[13] = CAND(5, 1); C[14] = CAND(6, 0); C[15] = CAND(6, 1);
        bitonic_sort16(C);
        { const int d0 = CAND(7, 0), d1 = CAND(7, 1); C[14] = max(C[14], d1); C[15] = max(C[15], d0); bitonic_merge16(C); }
#undef CAND
        merge_top16(A, B); merge_top16(A, C);
        unsigned T1[4], T2[4];
#pragma unroll
        for (int q = 0; q < 4; ++q) {
            T1[q] = (unsigned)(127 - (L1[4 * q] & 127)) | ((unsigned)(127 - (L1[4 * q + 1] & 127)) << 8) | ((unsigned)(127 - (L1[4 * q + 2] & 127)) << 16) | ((unsigned)(127 - (L1[4 * q + 3] & 127)) << 24);
            T2[q] = (unsigned)(127 - (L2[4 * q] & 127)) | ((unsigned)(127 - (L2[4 * q + 1] & 127)) << 8) | ((unsigned)(127 - (L2[4 * q + 2] & 127)) << 16) | ((unsigned)(127 - (L2[4 * q + 3] & 127)) << 24); }
        float val[16]; int ex[16];
#pragma unroll
        for (int k = 0; k < 16; ++k) { const int pos = 255 - (A[k] & 255); val[k] = __int_as_float(A[k] & ~255);
            ex[k] = lut16(T1, pos >> 4) * NKEYS + lut16(T2, pos & 15); }
        float sum = 0.f; const float vmax = val[0];
#pragma unroll
        for (int k = 0; k < 16; ++k) { val[k] = __expf(val[k] - vmax); sum += val[k]; }
        const float inv = 1.f / sum;
        if (hb == 0) {
            int* ip = IDX + t * NSEL + h * TOPK; float* gp = GATE + t * NSEL + h * TOPK;
#pragma unroll
            for (int k4 = 0; k4 < 4; ++k4) {
                *(int4*)(ip + 4 * k4) = make_int4(ex[4 * k4], ex[4 * k4 + 1], ex[4 * k4 + 2], ex[4 * k4 + 3]);
                *(f32x4*)(gp + 4 * k4) = (f32x4){val[4 * k4] * inv, val[4 * k4 + 1] * inv, val[4 * k4 + 2] * inv, val[4 * k4 + 3] * inv};
            }
        }
    }
}

#define FP4X2(w, sel) __builtin_amdgcn_cvt_scalef32_pk_f32_fp4((w), 1.0f, (sel))
__device__ __forceinline__ float dot16_fp4(const u32x2 r, const f32x4 (&xs)[4]) {
    float p = 0.f;
    { const f32x2 a = FP4X2(r.x, 0), b = FP4X2(r.x, 1), c = FP4X2(r.x, 2), d = FP4X2(r.x, 3);
      p += (a.x * xs[0].x + a.y * xs[0].y) + (b.x * xs[0].z + b.y * xs[0].w); p += (c.x * xs[1].x + c.y * xs[1].y) + (d.x * xs[1].z + d.y * xs[1].w); }
    { const f32x2 a = FP4X2(r.y, 0), b = FP4X2(r.y, 1), c = FP4X2(r.y, 2), d = FP4X2(r.y, 3);
      p += (a.x * xs[2].x + a.y * xs[2].y) + (b.x * xs[2].z + b.y * xs[2].w); p += (c.x * xs[3].x + c.y * xs[3].y) + (d.x * xs[3].z + d.y * xs[3].w); }
    return p;
}
__device__ __forceinline__ void axpy16_fp4(const u32x2 r, float w, f32x4 (&o)[4]) {
    { const f32x2 a = FP4X2(r.x, 0), b = FP4X2(r.x, 1), c = FP4X2(r.x, 2), d = FP4X2(r.x, 3);
      o[0].x += w * a.x; o[0].y += w * a.y; o[0].z += w * b.x; o[0].w += w * b.y; o[1].x += w * c.x; o[1].y += w * c.y; o[1].z += w * d.x; o[1].w += w * d.y; }
    { const f32x2 a = FP4X2(r.y, 0), b = FP4X2(r.y, 1), c = FP4X2(r.y, 2), d = FP4X2(r.y, 3);
      o[2].x += w * a.x; o[2].y += w * a.y; o[2].z += w * b.x; o[2].w += w * b.y; o[3].x += w * c.x; o[3].y += w * c.y; o[3].z += w * d.x; o[3].w += w * d.y; }
}
__device__ __forceinline__ float swap32_add(float a, float b) { auto r = __builtin_amdgcn_permlane32_swap(__float_as_uint(a), __float_as_uint(b), false, false); return __uint_as_float(r[0]) + __uint_as_float(r[1]); }
__device__ __forceinline__ float swap16_add(float a, float b) { auto r = __builtin_amdgcn_permlane16_swap(__float_as_uint(a), __float_as_uint(b), false, false); return __uint_as_float(r[0]) + __uint_as_float(r[1]); }
__device__ __forceinline__ float row_sum16(float v) { v += dpp_f<0xB1>(v); v += dpp_f<0x4E>(v); v += dpp_f<0x141>(v); v += dpp_f<0x140>(v); return v; }
constexpr int GB = 16;
typedef __attribute__((address_space(8))) void* rsrc_t;
__device__ __forceinline__ void g_issue(u32x2 (&buf)[GB], __amdgpu_buffer_rsrc_t rs, int idxr, int lb, int voff) {
#pragma unroll
    for (int j = 0; j < GB; ++j) { const int e = __builtin_amdgcn_readlane(idxr, lb + j); buf[j] = __builtin_amdgcn_raw_buffer_load_b64(rs, voff, e * 512, 0); }
}
__device__ __forceinline__ float dot16_fp4p(const u32x2 r, const f32x2 (&xp)[8]) {
    f32x2 a = FP4X2(r.x, 0) * xp[0];
    a += FP4X2(r.x, 1) * xp[1]; a += FP4X2(r.x, 2) * xp[2]; a += FP4X2(r.x, 3) * xp[3];
    a += FP4X2(r.y, 0) * xp[4]; a += FP4X2(r.y, 1) * xp[5]; a += FP4X2(r.y, 2) * xp[6]; a += FP4X2(r.y, 3) * xp[7];
    return a.x + a.y;
}
__device__ __forceinline__ void axpy16_fp4p(const u32x2 r, float w, f32x2 (&o)[8]) {
    const f32x2 ww = (f32x2){w, w};
    o[0] += FP4X2(r.x, 0) * ww; o[1] += FP4X2(r.x, 1) * ww; o[2] += FP4X2(r.x, 2) * ww; o[3] += FP4X2(r.x, 3) * ww;
    o[4] += FP4X2(r.y, 0) * ww; o[5] += FP4X2(r.y, 1) * ww; o[6] += FP4X2(r.y, 2) * ww; o[7] += FP4X2(r.y, 3) * ww;
}
__device__ __forceinline__ void g_compute_u(const u32x2 (&buf)[GB], int q, int i16, const f32x2 (&xp)[8], float& zlo, float& zhi) {
    float p[16];
#pragma unroll
    for (int j = 0; j < 16; ++j) p[j] = dot16_fp4p(buf[j], xp);
    float s1[8], s2[4];
#pragma unroll
    for (int m = 0; m < 8; ++m) s1[m] = swap32_add(p[2 * m], p[2 * m + 1]);
#pragma unroll
    for (int n = 0; n < 4; ++n) s2[n] = swap16_add(s1[2 * n], s1[2 * n + 1]);
#pragma unroll
    for (int r = 0; r < 4; ++r) { const float z = row_sum16(s2[r]); const bool mine = i16 == ((4 * q + r) & 15);
        zlo = (mine && q < 4) ? z : zlo; zhi = (mine && q >= 4) ? z : zhi; }
}
__device__ __forceinline__ void g_compute_v(const u32x2 (&buf)[GB], int q, float alo, float ahi, f32x2 (&o)[8]) {
    const int areg = __builtin_bit_cast(int, (q < 4) ? alo : ahi), sb = 4 * (q & 3);
#pragma unroll
    for (int j = 0; j < 16; ++j) { const int src = 32 * (j & 1) + 16 * ((j >> 1) & 1) + (j >> 2) + sb;
        const float w = __builtin_bit_cast(float, __builtin_amdgcn_readlane(areg, src));
        axpy16_fp4p(buf[j], w, o); }
}
__device__ __forceinline__ void phase_gather(const Params& P, LAS unsigned char* lds) {
    const int tid = threadIdx.x, lane = tid & 63, wave = __builtin_amdgcn_readfirstlane(tid >> 6);
    const int gw = blockIdx.x * NWAVES + wave, NGW = gridDim.x * NWAVES;
    unsigned char* ws = P.ws;
    const int* IDX = (const int*)(ws + WS_IDX); const float* GATE = (const float*)(ws + WS_GATE); const float* ESC = (const float*)(ws + WS_ESCALE);
    const __amdgpu_buffer_rsrc_t rsU = __builtin_amdgcn_make_buffer_rsrc((void*)(ws + WS_U8), 0, 16384 * 512, 0x00020000);
    const __amdgpu_buffer_rsrc_t rsV = __builtin_amdgcn_make_buffer_rsrc((void*)(ws + WS_V8), 0, 16384 * 512, 0x00020000);
    const bf16* H2B = (const bf16*)(ws + WS_H2B); const float* SSQ = (const float*)(ws + WS_SSQ);
    const int hh = lane >> 5, rr = (lane >> 4) & 1, i16 = lane & 15, gsel = 4 * i16 + 2 * rr + hh;
    const int voff = 8 * lane;
    int t = gw;
    if (t < NTOK) {
        int idx0, idx1; u32x2 hraw[4]; float sqv;
        { const int* ip = IDX + (size_t)t * NSEL; idx0 = ip[lane]; idx1 = ip[64 + lane];
          const u32x2* hp = (const u32x2*)(H2B + (size_t)t * DM);
#pragma unroll
          for (int j = 0; j < 4; ++j) hraw[j] = hp[64 * j + lane];
          sqv = (lane < 16) ? (SSQ + (size_t)t * 16)[lane] : 0.f; }
        u32x2 bufA[GB], bufB[GB];
        g_issue(bufA, rsU, idx0, 0, voff);
        for (;;) {
            const int tn = t + NGW; const bool has_next = tn < NTOK; const int tl = has_next ? tn : t;
            int idx0n, idx1n; u32x2 hrawn[4]; float sqn, g0, g1;
            { const int* ip = IDX + (size_t)tl * NSEL; idx0n = ip[lane]; idx1n = ip[64 + lane];
              const u32x2* hp = (const u32x2*)(H2B + (size_t)tl * DM);
#pragma unroll
              for (int j = 0; j < 4; ++j) hrawn[j] = hp[64 * j + lane];
              sqn = (lane < 16) ? (SSQ + (size_t)tl * 16)[lane] : 0.f;
              const float* gp = GATE + (size_t)t * NSEL; g0 = gp[lane]; g1 = gp[64 + lane]; }
            const float su0 = ESC[idx0], su1 = ESC[idx1], sv0 = ESC[16384 + idx0], sv1 = ESC[16384 + idx1];
            const float rstd2 = rsqrtf(wave_sum_fast(sqv) * (1.f / DM) + EPS);
            f32x2 xp[8];
#pragma unroll
            for (int j = 0; j < 4; ++j) { xp[2 * j] = (f32x2){bflo(hraw[j].x), bfhi(hraw[j].x)}; xp[2 * j + 1] = (f32x2){bflo(hraw[j].y), bfhi(hraw[j].y)}; }
            float zlo = 0.f, zhi = 0.f;
#pragma unroll 1
            for (int q = 0; q < 8; q += 2) {
                g_issue(bufB, rsU, (q + 1 < 4) ? idx0 : idx1, 16 * ((q + 1) & 3), voff);
                g_compute_u(bufA, q, i16, xp, zlo, zhi);
                if (q + 2 < 8) g_issue(bufA, rsU, (q + 2 < 4) ? idx0 : idx1, 16 * ((q + 2) & 3), voff); else g_issue(bufA, rsV, idx0, 0, voff);
                g_compute_u(bufB, q + 1, i16, xp, zlo, zhi);
            }
            const float glo = __shfl(g0, gsel), ghi = __shfl(g1, gsel), sulo = __shfl(su0, gsel), suhi = __shfl(su1, gsel), svlo = __shfl(sv0, gsel), svhi = __shfl(sv1, gsel);
            const float alo = gelu_tanh_f(zlo * rstd2 * sulo) * glo * svlo, ahi = gelu_tanh_f(zhi * rstd2 * suhi) * ghi * svhi;
            f32x2 o[8];
#pragma unroll
            for (int j = 0; j < 8; ++j) o[j] = (f32x2){0.f, 0.f};
#pragma unroll 1
            for (int q = 0; q < 8; q += 2) {
                g_issue(bufB, rsV, (q + 1 < 4) ? idx0 : idx1, 16 * ((q + 1) & 3), voff);
                g_compute_v(bufA, q, alo, ahi, o);
                if (q + 2 < 8) g_issue(bufA, rsV, (q + 2 < 4) ? idx0 : idx1, 16 * ((q + 2) & 3), voff); else if (has_next) g_issue(bufA, rsU, idx0n, 0, voff);
                g_compute_v(bufB, q + 1, alo, ahi, o);
            }
            float ss = 0.f;
#pragma unroll
            for (int j = 0; j < 8; ++j) { o[j] += xp[j]; ss += o[j].x * o[j].x + o[j].y * o[j].y; }
            ss = wave_sum_fast(ss);
            const float r3 = rsqrtf(ss * (1.f / DM) + EPS);
            f32x4* op = (f32x4*)(P.out + (size_t)t * DM);
            const f32x4* gfp = (const f32x4*)P.g_fin;
#pragma unroll
            for (int j = 0; j < 4; ++j) { const f32x4 gv = gfp[64 * j + lane]; op[64 * j + lane] = (f32x4){o[2 * j].x * r3 * gv.x, o[2 * j].y * r3 * gv.y, o[2 * j + 1].x * r3 * gv.z, o[2 * j + 1].y * r3 * gv.w}; }
            if (!has_next) break;
            t = tn; idx0 = idx0n; idx1 = idx1n; sqv = sqn;
#pragma unroll
            for (int j = 0; j < 4; ++j) hraw[j] = hrawn[j];
        }
    }
}

#define XB_TMO      128
#define XB_XCNT(j)  (256  + 64 * (j))
#define XB_XSUB(j)  (1280 + 64 * (j))
#define XB_XGEN(j)  (2304 + 64 * (j))
#define XB_TOP      3328
#define XB_TOPGEN   3392
#define XCD_BAR_WORDS 3456
#define XB_SPIN_CAP (1u << 18)

__device__ __forceinline__ unsigned xb_ld(unsigned* p)              { return __hip_atomic_load(p, __ATOMIC_RELAXED, __HIP_MEMORY_SCOPE_AGENT); }
__device__ __forceinline__ unsigned xb_add(unsigned* p, unsigned v) { return __hip_atomic_fetch_add(p, v, __ATOMIC_RELAXED, __HIP_MEMORY_SCOPE_AGENT); }
__device__ __forceinline__ unsigned xb_xcc_id() { return (unsigned)__builtin_amdgcn_s_getreg((3 << 11) | 20) & 0xFu; }
#define XB_SPIN(cond, bar) do { unsigned _sp = 0; while (cond) { __builtin_amdgcn_s_sleep(1); \
    if ((++_sp & 255u) == 0u) { if (xb_ld(&(bar)[XB_TMO])) break; if (_sp > XB_SPIN_CAP) { atomicAdd(&(bar)[XB_TMO], 1u); break; } } } } while (0)

struct XcdBarrier {
    unsigned* bar; unsigned x;
    volatile LAS unsigned* st;
};

__device__ __forceinline__ XcdBarrier xcd_barrier_post(unsigned* bar, volatile LAS unsigned* st) {
    XcdBarrier b; b.bar = bar; b.x = xb_xcc_id(); b.st = st;
    if (threadIdx.x == 0) (void)xb_add(&bar[XB_XCNT(b.x)], 1u);
    return b;
}
__device__ __forceinline__ void xcd_barrier_complete(unsigned* bar, unsigned x, unsigned& nloc, unsigned& nx) {
    const unsigned G = gridDim.x * gridDim.y * gridDim.z;
    unsigned sum, cnt, mine, sp = 0u;
    for (;;) {
        sum = 0u; cnt = 0u; mine = 0u;
#pragma unroll
        for (unsigned j = 0; j < 16; ++j) { const unsigned c = xb_ld(&bar[XB_XCNT(j)]); sum += c; cnt += (c > 0u) ? 1u : 0u; mine = (j == x) ? c : mine; }
        if (sum == G) break;
        __builtin_amdgcn_s_sleep(1);
        if ((++sp & 255u) == 0u) { if (xb_ld(&bar[XB_TMO])) break; if (sp > XB_SPIN_CAP) { atomicAdd(&bar[XB_TMO], 1u); break; } }
    }
    nloc = mine > 0u ? mine : 1u; nx = cnt > 0u ? cnt : 1u;
}

__device__ __forceinline__ void xcd_barrier(const XcdBarrier& b) {
    asm volatile("s_waitcnt vmcnt(0)" ::: "memory");
    __syncthreads();
    if (threadIdx.x == 0) {
        unsigned* bar = b.bar;
        __builtin_amdgcn_s_waitcnt(0);
        unsigned nloc = b.st[0], nx = b.st[1];
        if (nloc == 0u) { xcd_barrier_complete(bar, b.x, nloc, nx); b.st[0] = nloc; b.st[1] = nx; }
        const unsigned old = xb_add(&bar[XB_XSUB(b.x)], 1u);
        const unsigned gen = old / nloc;
        if (old + 1u == (gen + 1u) * nloc) {
            __builtin_amdgcn_fence(__ATOMIC_RELEASE, "agent");
            asm volatile("s_waitcnt vmcnt(0)" ::: "memory");
            const unsigned og = xb_add(&bar[XB_TOP], 1u);
            const unsigned tg = og / nx;
            if (og + 1u == (tg + 1u) * nx) xb_add(&bar[XB_TOPGEN], 1u);
            else XB_SPIN(xb_ld(&bar[XB_TOPGEN]) == tg, bar);
            __builtin_amdgcn_fence(__ATOMIC_ACQUIRE, "agent");
            xb_add(&bar[XB_XGEN(b.x)], 1u);
            asm volatile("s_waitcnt vmcnt(0)" ::: "memory");
        } else {
            XB_SPIN(xb_ld(&bar[XB_XGEN(b.x)]) == gen, bar);
            __builtin_amdgcn_fence(__ATOMIC_ACQUIRE, "agent");
            asm volatile("s_waitcnt vmcnt(0)" ::: "memory");
        }
    }
    __syncthreads();
}


#ifndef MK_MULTI
#define MK_MULTI 0
#endif
constexpr int NPHASE = 7;
#ifndef REP5
#define REP5 1
#endif
#ifndef REP6
#define REP6 1
#endif
__global__ void __launch_bounds__(NTHREADS, 2) mk_fwd(Params P) {
    extern __shared__ __attribute__((aligned(16))) unsigned char lds_raw[];
    LAS unsigned char* lds = (LAS unsigned char*)lds_raw;
    cg::grid_group grid = cg::this_grid();
    unsigned char* ws = P.ws;
    const int lo = P.ph_lo, hi = P.ph_hi;
    volatile LAS unsigned* bst = (volatile LAS unsigned*)(lds + 131072 + 64);
    if (threadIdx.x < 2) bst[threadIdx.x] = 0u;
    __syncthreads();
    XcdBarrier xbar = xcd_barrier_post((unsigned*)(ws + WS_CTL), bst);
#define IN(k) (lo <= (k) && (k) < hi)
#define SEAM(k) do { if (IN(k) && IN((k) + 1)) { xcd_barrier(xbar); } } while (0)
#ifndef SKIP0
    if (IN(0)) phase_prep(P, lds);
#endif
    SEAM(0);
#ifndef SKIP1
    if (IN(1)) {
        phase_metaproj(P);
        pg8::Gemm g{(const bf16*)(ws + WS_H0B), (const bf16*)(ws + WS_WIN_T), NTOK, DIN, DM}; pg8::StaticOrder S; S.init(NTOK, DIN, (int)gridDim.x, (int)blockIdx.x);
        EpiRowScale<0> E{(bf16*)(ws + WS_PROJ), DIN, (const float*)(ws + WS_RSTD1)};
        pg8::gemm_phase<EpiRowScale<0>, pg8::StaticOrder, true, true>(lds, g, S, E);
    }
#endif
    SEAM(1);
#ifndef SKIP2
    if (IN(2)) phase_conv(P, lds);
#endif
    SEAM(2);
#ifndef SKIP3
    if (IN(3)) {
        pg8::Gemm g{(const bf16*)(ws + WS_Y), (const bf16*)(ws + WS_WOUT_T), NTOK, DM, DM}; pg8::StaticOrder S; S.init(NTOK, DM, (int)gridDim.x, (int)blockIdx.x);
        EpiResidual E{(bf16*)(ws + WS_H2B), (const bf16*)(ws + WS_H0B), (float*)(ws + WS_SSQ)};
        pg8::gemm_phase<EpiResidual, pg8::StaticOrder, true, true>(lds, g, S, E);
    }
#endif
    SEAM(3);
#ifndef SKIP4
    if (IN(4)) {
        pg8::Gemm g{(const bf16*)(ws + WS_H2B), (const bf16*)(ws + WS_WQ_T), NTOK, 2048, DM}; pg8::StaticOrder S; S.init(NTOK, 2048, (int)gridDim.x, (int)blockIdx.x);
        EpiRowScale<1> E{(bf16*)(ws + WS_Q), 2048, (const float*)(ws + WS_SSQ)};
        pg8::gemm_phase<EpiRowScale<1>, pg8::StaticOrder, true, true>(lds, g, S, E);
    }
#endif
    SEAM(4);
#ifndef SKIP5
    if (IN(5)) for (int rep = 0; rep < REP5; ++rep) phase_route(P, lds);
#endif
    SEAM(5);
    if (IN(6)) phase_gather(P, lds);
#undef IN
#undef SEAM
}

extern "C" void kernel_launch(void* const* d_in, const int* in_sizes, int n_in, void* d_out, int out_size, void* d_ws, size_t ws_size, hipStream_t stream) {
    static int grid = 0;
    if (grid == 0) {
        if (n_in != 18 || in_sizes[0] != NTOK * DM || out_size != NTOK * DM || ws_size < WS_END) {
            fprintf(stderr, "kernel_launch: unexpected shapes (n_in %d in0 %d out %d ws %zu)\n", n_in, n_in > 0 ? in_sizes[0] : -1, out_size, ws_size); grid = -1; return; }
        int dev = 0, cus = 0, per_cu = 0;
        (void)hipGetDevice(&dev); (void)hipDeviceGetAttribute(&cus, hipDeviceAttributeMultiprocessorCount, dev);
        if (hipFuncSetAttribute((const void*)mk_fwd, hipFuncAttributeMaxDynamicSharedMemorySize, LDS_BYTES) != hipSuccess) { fprintf(stderr, "kernel_launch: hipFuncSetAttribute failed\n"); grid = -1; return; }
        if (hipOccupancyMaxActiveBlocksPerMultiprocessor(&per_cu, (const void*)mk_fwd, NTHREADS, LDS_BYTES) != hipSuccess || per_cu < 1) { fprintf(stderr, "kernel_launch: occupancy query failed (%d)\n", per_cu); (void)hipGetLastError(); per_cu = 1; }
        if (per_cu > 1) per_cu = 1;
        grid = cus * per_cu;
        if (grid <= 0) grid = 256;
    }
    if (grid < 0) return;
    Params p{};
    p.x = (const float*)d_in[0]; p.meta = (const float*)d_in[1]; p.g_mix = (const float*)d_in[2]; p.w_in = (const float*)d_in[3]; p.sc_w = (const float*)d_in[4];
    p.cf_w = (const float*)d_in[5]; p.cf_b = (const float*)d_in[6]; p.ln_g = (const float*)d_in[7]; p.ln_b = (const float*)d_in[8]; p.g_sc = (const float*)d_in[9];
    p.g_cf = (const float*)d_in[10]; p.w_out = (const float*)d_in[11]; p.g_ffn = (const float*)d_in[12]; p.w_q = (const float*)d_in[13]; p.keys = (const float*)d_in[14];
    p.pu = (const float*)d_in[15]; p.pv = (const float*)d_in[16]; p.g_fin = (const float*)d_in[17];
    p.out = (float*)d_out; p.ws = (unsigned char*)d_ws;
    (void)hipMemsetAsync((char*)d_ws + WS_CTL, 0, 16384, stream);
#if MK_MULTI
    for (int ph = 0; ph < NPHASE; ++ph) { p.ph_lo = ph; p.ph_hi = ph + 1; p.coop = 0; p.pad = 0;
        hipLaunchKernelGGL(mk_fwd, dim3(grid), dim3(NTHREADS), LDS_BYTES, stream, p); }
#else
    p.ph_lo = 0; p.ph_hi = NPHASE; p.coop = 1; p.pad = 0;
    void* args[] = {&p};
    hipError_t e = hipLaunchCooperativeKernel((const void*)mk_fwd, dim3(grid), dim3(NTHREADS), args, LDS_BYTES, stream);
    if (e != hipSuccess) fprintf(stderr, "cooperative launch failed: %s (grid %d)\n", hipGetErrorString(e), grid);
#endif
}
```

```cpp
#include <hip/hip_runtime.h>
#include <hip/hip_cooperative_groups.h>
#include <cstdio>
#include <cstdint>
namespace cg = cooperative_groups;

namespace pg8 {
#define PG8_LAS __attribute__((address_space(3)))
typedef unsigned short bf16_t;
typedef short bf16x8 __attribute__((ext_vector_type(8)));
typedef float f32x4 __attribute__((ext_vector_type(4)));
typedef unsigned u32x4 __attribute__((ext_vector_type(4)));
constexpr int BM = 256, BK = 64, HALF = 128, HTB = HALF * BK * 2  , STAGE_BYTES = 8 * HTB, NXCD = 8, WGM = 8;

__host__ __device__ __forceinline__ int lds_byte(int r, int c) { const int st = (r >> 4) * 2 + (c >> 5), rr = r & 15, cc = c & 31, ob = rr * 64 + cc * 2; return st * 1024 + (ob ^ (((ob >> 9) & 1) << 5)); }
__host__ __device__ __forceinline__ void stage_rc(int b, int& R, int& C) { const int st = b / 1024, sb = b % 1024, swz = sb ^ (((sb >> 9) & 1) << 5); R = (st >> 1) * 16 + swz / 64; C = (st & 1) * 32 + (swz % 64) / 2; }
__host__ __device__ __forceinline__ int perm32(int rho) { const int n = rho >> 4, i = rho & 15; return 8 * (i >> 2) + 4 * n + (i & 3); }

struct Unit { int pm, pn; };
struct Gemm { const bf16_t* A; const bf16_t* Bt; int M, N, K; };

struct StaticOrder {
    int nM, nN, nwg, G, c;
    __host__ __device__ void init(int M, int N, int G_, int c_) { nM = M / BM; nN = N / BM; nwg = nM * nN; G = G_; c = c_; }
    __host__ __device__ bool next(int i, Unit& u) const {
        const long L = (long)i * G + c; if (L >= nwg) return false;
        int wgid = (int)L; { const int q = nwg / NXCD, r = nwg % NXCD, xcd = wgid % NXCD, off = wgid / NXCD; wgid = (xcd < r ? xcd * (q + 1) : r * (q + 1) + (xcd - r) * q) + off; }
        const int nig = WGM * nN, gid = wgid / nig, fm = gid * WGM, gsz = (nM - fm) < WGM ? (nM - fm) : WGM;
        u.pm = fm + ((wgid % nig) % gsz); u.pn = (wgid % nig) / gsz; return true;
    }
    __device__ __forceinline__ void a_ready(const Unit&) const {}
    __device__ __forceinline__ void done(const Unit&) const {}
};

template <class Epi, class Sched, bool ALIGN_EPI = false, bool SP2 = false>
__device__ __forceinline__ void gemm_phase(PG8_LAS unsigned char* lds, const Gemm g, const Sched& S, const Epi& E) {
    const int tid = threadIdx.x, wid = __builtin_amdgcn_readfirstlane(tid >> 6), lane = tid & 63, wr = wid >> 2, wc = wid & 3, fr = lane & 15, fq = lane >> 4;
    const int K = g.K, nt = K / BK;
    unsigned voffA[2], voffB[2];
#pragma unroll
    for (int i = 0; i < 2; ++i) { int R, C; stage_rc(tid * 16 + i * 8192, R, C); const int Rb = Epi::PERM ? ((R & ~31) + perm32(R & 31)) : R;
        voffA[i] = (unsigned)(R * K + C) * 2u; voffB[i] = (unsigned)(Rb * K + C) * 2u; }
    const size_t kstep = (size_t)(BK * 2);
    const size_t hstep = (size_t)HALF * K * 2;
    const size_t tstep = 2 * hstep;
    const unsigned ldsw = (unsigned)wid * 1024u;
    const int aoff = lds_byte(wr * 64 + fr, fq * 8), boff = lds_byte(wc * 32 + fr, fq * 8);
#define PG8_SA(b, h) (((b) * 2 + (h)) * HTB)
#define PG8_SB(b, h) ((4 + (b) * 2 + (h)) * HTB)
#define PG8_STAGE(bufoff, gbase, voff) do { _Pragma("unroll") for (int _i = 0; _i < 2; ++_i) \
        __builtin_amdgcn_global_load_lds((const unsigned*)((const char*)(gbase) + (voff)[_i]), (PG8_LAS unsigned*)(lds + (bufoff) + ldsw + _i * 8192), 16, 0, 0); } while (0)
#define PG8_LDA(dst, b, h) do { _Pragma("unroll") for (int m = 0; m < 4; ++m) _Pragma("unroll") for (int k = 0; k < 2; ++k) dst[m][k] = *(const PG8_LAS bf16x8*)(lds + PG8_SA(b, h) + aoff + m * 2048 + k * 1024); } while (0)
#define PG8_LDB(dst, b, h) do { _Pragma("unroll") for (int n = 0; n < 2; ++n) _Pragma("unroll") for (int k = 0; k < 2; ++k) dst[n][k] = *(const PG8_LAS bf16x8*)(lds + PG8_SB(b, h) + boff + n * 2048 + k * 1024); } while (0)
#define PG8_MMA(ai, bj, At, Bt) do { __builtin_amdgcn_s_setprio(1); _Pragma("unroll") for (int m = 0; m < 4; ++m) _Pragma("unroll") for (int n = 0; n < 2; ++n) _Pragma("unroll") for (int k = 0; k < 2; ++k) \
        acc[ai][bj][m][n] = __builtin_amdgcn_mfma_f32_16x16x32_bf16(Bt[n][k], At[m][k], acc[ai][bj][m][n], 0, 0, 0); __builtin_amdgcn_s_setprio(0); } while (0)
#define PG8_WAIT_V(n) asm volatile("s_waitcnt vmcnt(" #n ")" ::: "memory")
#define PG8_WAIT_L(n) asm volatile("s_waitcnt lgkmcnt(" #n ")" ::: "memory")
#define PG8_BAR __builtin_amdgcn_s_barrier()
#define PG8_SCHED __builtin_amdgcn_sched_barrier(0)
    Unit cur, nxt; int ui = 0;
    if (!S.next(0, cur)) return;
    f32x4 acc[2][2][4][2];
#pragma unroll
    for (int a = 0; a < 2; ++a)
#pragma unroll
        for (int b = 0; b < 2; ++b)
#pragma unroll
            for (int m = 0; m < 4; ++m)
#pragma unroll
                for (int n = 0; n < 2; ++n) acc[a][b][m][n] = (f32x4){0.f, 0.f, 0.f, 0.f};
    bf16x8 At[4][2], B0[2][2], B1[2][2];
    const char* cA = (const char*)g.A + (size_t)cur.pm * tstep; const char* cB = (const char*)g.Bt + (size_t)cur.pn * tstep;
    S.a_ready(cur);
    if constexpr (SP2) {
        PG8_STAGE(PG8_SB(0, 0), cB, voffB); PG8_STAGE(PG8_SB(0, 1), cB + hstep, voffB); PG8_STAGE(PG8_SA(0, 0), cA, voffA); PG8_STAGE(PG8_SA(0, 1), cA + hstep, voffA);
        if (wr == 1) PG8_BAR;
        PG8_WAIT_V(2); PG8_BAR;
        PG8_STAGE(PG8_SB(1, 0), cB + kstep, voffB); PG8_STAGE(PG8_SA(1, 0), cA + kstep, voffA); PG8_STAGE(PG8_SB(1, 1), cB + hstep + kstep, voffB);
        PG8_WAIT_V(6); PG8_BAR;
    } else {
        PG8_STAGE(PG8_SB(0, 0), cB, voffB); PG8_STAGE(PG8_SA(0, 0), cA, voffA); PG8_STAGE(PG8_SB(0, 1), cB + hstep, voffB); PG8_STAGE(PG8_SA(0, 1), cA + hstep, voffA);
        if (wr == 1) PG8_BAR;
        PG8_WAIT_V(4); PG8_BAR;
        PG8_STAGE(PG8_SB(1, 0), cB + kstep, voffB); PG8_STAGE(PG8_SA(1, 0), cA + kstep, voffA); PG8_STAGE(PG8_SB(1, 1), cB + hstep + kstep, voffB);
        PG8_WAIT_V(6); PG8_BAR;
    }
    for (;;) {
        const bool has_next = S.next(ui + 1, nxt);
        const char* nA = has_next ? (const char*)g.A + (size_t)nxt.pm * tstep : cA; const char* nB = has_next ? (const char*)g.Bt + (size_t)nxt.pn * tstep : cB;
        for (int t = 0; t < nt; t += 2) {
            const bool last = (t == nt - 2);
            const char* a1 = cA + (size_t)(t + 1) * kstep;
            const char* a2 = last ? nA : cA + (size_t)(t + 2) * kstep; const char* b2 = last ? nB : cB + (size_t)(t + 2) * kstep;
            const char* a3 = a2 + kstep; const char* b3 = b2 + kstep;
            if (last && has_next) S.a_ready(nxt);
            if constexpr (SP2) {
            PG8_LDB(B0, 0, 0); PG8_LDB(B1, 0, 1); PG8_SCHED; PG8_LDA(At, 0, 0); PG8_STAGE(PG8_SA(1, 1), a1 + hstep, voffA);
            PG8_WAIT_V(8); PG8_WAIT_L(0); PG8_BAR; PG8_MMA(0, 0, At, B0); PG8_MMA(0, 1, At, B1); PG8_BAR; PG8_SCHED;
            PG8_LDA(At, 0, 1); PG8_STAGE(PG8_SB(0, 0), b2, voffB); PG8_STAGE(PG8_SB(0, 1), b2 + hstep, voffB); PG8_STAGE(PG8_SA(0, 0), a2, voffA);
            PG8_WAIT_V(8); PG8_WAIT_L(0); PG8_BAR; PG8_MMA(1, 0, At, B0); PG8_MMA(1, 1, At, B1); PG8_BAR; PG8_SCHED;
            PG8_LDB(B0, 1, 0); PG8_LDB(B1, 1, 1); PG8_SCHED; PG8_LDA(At, 1, 0); PG8_STAGE(PG8_SA(0, 1), a2 + hstep, voffA);
            PG8_WAIT_V(8); PG8_WAIT_L(0); PG8_BAR; PG8_MMA(0, 0, At, B0); PG8_MMA(0, 1, At, B1); PG8_BAR; PG8_SCHED;
            PG8_LDA(At, 1, 1); PG8_STAGE(PG8_SB(1, 0), b3, voffB); PG8_STAGE(PG8_SB(1, 1), b3 + hstep, voffB); PG8_STAGE(PG8_SA(1, 0), a3, voffA);
            PG8_WAIT_V(8); PG8_WAIT_L(0); PG8_BAR; PG8_MMA(1, 0, At, B0); PG8_MMA(1, 1, At, B1); PG8_BAR; PG8_SCHED;
            } else {
            PG8_LDB(B0, 0, 0); PG8_SCHED; PG8_LDA(At, 0, 0); PG8_STAGE(PG8_SA(1, 1), a1 + hstep, voffA);
            PG8_WAIT_L(8); PG8_BAR; PG8_WAIT_L(0); PG8_MMA(0, 0, At, B0); PG8_BAR; PG8_SCHED;
            PG8_LDB(B1, 0, 1); PG8_STAGE(PG8_SB(0, 0), b2, voffB);
            PG8_BAR; PG8_WAIT_L(0); PG8_MMA(0, 1, At, B1); PG8_BAR;
            PG8_LDA(At, 0, 1); PG8_STAGE(PG8_SA(0, 0), a2, voffA);
            PG8_BAR; PG8_WAIT_L(0); PG8_MMA(1, 0, At, B0); PG8_BAR; PG8_SCHED;
            PG8_STAGE(PG8_SB(0, 1), b2 + hstep, voffB);
            PG8_WAIT_V(6); PG8_BAR; PG8_MMA(1, 1, At, B1); PG8_BAR;
            PG8_LDB(B0, 1, 0); PG8_SCHED; PG8_LDA(At, 1, 0); PG8_STAGE(PG8_SA(0, 1), a2 + hstep, voffA);
            PG8_WAIT_L(8); PG8_BAR; PG8_WAIT_L(0); PG8_MMA(0, 0, At, B0); PG8_BAR; PG8_SCHED;
            PG8_LDB(B1, 1, 1); PG8_STAGE(PG8_SB(1, 0), b3, voffB);
            PG8_BAR; PG8_WAIT_L(0); PG8_MMA(0, 1, At, B1); PG8_BAR;
            PG8_LDA(At, 1, 1); PG8_STAGE(PG8_SA(1, 0), a3, voffA);
            PG8_BAR; PG8_WAIT_L(0); PG8_MMA(1, 0, At, B0); PG8_BAR; PG8_SCHED;
            PG8_STAGE(PG8_SB(1, 1), b3 + hstep, voffB);
            PG8_WAIT_V(6); PG8_BAR; PG8_MMA(1, 1, At, B1); PG8_BAR;
            }
        }
        if constexpr (ALIGN_EPI) { if (wr == 0) PG8_BAR; }
        if constexpr (!Epi::AFTER_DRAIN) { E(acc, cur, wr, wc, fr, fq); S.done(cur); }
        if (!has_next) break;
#pragma unroll
        for (int a = 0; a < 2; ++a)
#pragma unroll
            for (int b = 0; b < 2; ++b)
#pragma unroll
                for (int m = 0; m < 4; ++m)
#pragma unroll
                    for (int n = 0; n < 2; ++n) acc[a][b][m][n] = (f32x4){0.f, 0.f, 0.f, 0.f};
        cur = nxt; cA = nA; cB = nB; ++ui;
        if constexpr (ALIGN_EPI) { if (wr == 1) PG8_BAR; }
    }
    PG8_WAIT_V(0);
    if constexpr (!ALIGN_EPI) { if (wr == 0) PG8_BAR; }
    PG8_BAR;
    if constexpr (Epi::AFTER_DRAIN) { E.fused(acc, cur, wr, wc, fr, fq, lds, wid, lane); S.done(cur); }
#undef PG8_SA
#undef PG8_SB
#undef PG8_STAGE
#undef PG8_LDA
#undef PG8_LDB
#undef PG8_MMA
#undef PG8_WAIT_V
#undef PG8_WAIT_L
#undef PG8_BAR
#undef PG8_SCHED
}
}

#define LAS __attribute__((address_space(3)))
typedef unsigned short bf16;
typedef float f32x2 __attribute__((ext_vector_type(2)));
typedef float f32x4 __attribute__((ext_vector_type(4)));
typedef unsigned u32x2 __attribute__((ext_vector_type(2)));
typedef unsigned u32x4 __attribute__((ext_vector_type(4)));

constexpr int PDIM = 1536;
constexpr int NTOK = 32768, DM = 1024, DIN = 2560, SEQ = 8192, NBATCH = 4, NMETA = 16;
constexpr int NHEAD = 8, NKEYS = 128, TOPK = 16, NSEL = NHEAD * TOPK;
constexpr float EPS = 1e-6f;
constexpr float U_SCALE = 64.f, V_SCALE = 16.f;
constexpr int NWAVES = 8, NTHREADS = 512;
constexpr int MKC = 32;
constexpr int LDS_BYTES = 147456;

constexpr size_t MiB = 1u << 20;
constexpr size_t WS_CTL = 0, WS_WIN_T = 1 * MiB, WS_WOUT_T = 6 * MiB, WS_WQ_T = 8 * MiB, WS_KEYS = 12 * MiB, WS_METAPART = 160 * MiB  ,
                 WS_METARSTD = 14 * MiB + 512 * 1024, WS_METAPROJ = 14 * MiB + 576 * 1024, WS_RSTD1 = 15 * MiB, WS_SSQ = 16 * MiB, WS_U8 = 32 * MiB, WS_V8 = 48 * MiB,
                 WS_IDX = 64 * MiB, WS_GATE = 80 * MiB, WS_H0B = 96 * MiB, WS_H2B = 96 * MiB, WS_Y = 160 * MiB, WS_PROJ = 224 * MiB,
                 WS_Q = 224 * MiB, WS_ESCALE = 18 * MiB, WS_END = 384 * MiB;

struct Params {
    const float* x; const float* meta; const float* g_mix; const float* w_in; const float* sc_w; const float* cf_w; const float* cf_b;
    const float* ln_g; const float* ln_b; const float* g_sc; const float* g_cf; const float* w_out; const float* g_ffn; const float* w_q;
    const float* keys; const float* pu; const float* pv; const float* g_fin;
    float* out; unsigned char* ws;
    int ph_lo, ph_hi, coop, pad;
};

__device__ __forceinline__ unsigned f2bf(float f) { unsigned u = __builtin_bit_cast(unsigned, f); return (u + 0x7fffu + ((u >> 16) & 1u)) >> 16; }
__device__ __forceinline__ unsigned pk2(float lo, float hi) { return f2bf(lo) | (f2bf(hi) << 16); }
__device__ __forceinline__ float bf2f(unsigned b) { return __builtin_bit_cast(float, b << 16); }
__device__ __forceinline__ float bflo(unsigned w) { return __builtin_bit_cast(float, w << 16); }
__device__ __forceinline__ float bfhi(unsigned w) { return __builtin_bit_cast(float, w & 0xffff0000u); }
__device__ __forceinline__ float wave_sum(float v) {
#pragma unroll
    for (int o = 1; o < 64; o <<= 1) v += __shfl_xor(v, o);
    return v;
}
template <int CTRL> __device__ __forceinline__ float dpp_f(float v) { return __builtin_bit_cast(float, __builtin_amdgcn_update_dpp(0, __builtin_bit_cast(int, v), CTRL, 0xf, 0xf, true)); }
__device__ __forceinline__ float wave_sum_fast(float v) {
    v += dpp_f<0xB1>(v); v += dpp_f<0x4E>(v); v += dpp_f<0x141>(v); v += dpp_f<0x140>(v);
    { auto r = __builtin_amdgcn_permlane16_swap(__float_as_uint(v), __float_as_uint(v), false, false); v = __uint_as_float(r[0]) + __uint_as_float(r[1]); }
    { auto r = __builtin_amdgcn_permlane32_swap(__float_as_uint(v), __float_as_uint(v), false, false); v = __uint_as_float(r[0]) + __uint_as_float(r[1]); }
    return v;
}
__device__ __forceinline__ float sigmoid_f(float x) { return 1.f / (1.f + __expf(-x)); }
__device__ __forceinline__ float gelu_tanh_f(float x) {
    const float t = 0.7978845608028654f * (x + 0.044715f * x * x * x);
    const float e = __expf(2.f * t);
    const float th = 1.f - 2.f / (e + 1.f);
    return 0.5f * x * (1.f + th);
}

__device__ __forceinline__ unsigned cvt_pk_bf16(float lo, float hi) { unsigned r; asm volatile("v_cvt_pk_bf16_f32 %0, %1, %2" : "=v"(r) : "v"(lo), "v"(hi)); return r; }

template <int MODE> struct EpiRowScale {
    static constexpr bool PERM = true, AFTER_DRAIN = false;
    bf16* O; int ldc; const float* rs;
    __device__ __forceinline__ void operator()(const pg8::f32x4 (&acc)[2][2][4][2], const pg8::Unit& u, int wr, int wc, int fr, int fq) const {
        const int row0 = u.pm * 256 + wr * 64 + fr, col0 = u.pn * 256 + wc * 32 + 8 * fq;
#pragma unroll
        for (int ai = 0; ai < 2; ++ai)
#pragma unroll
            for (int m = 0; m < 4; ++m) {
                const int row = row0 + ai * 128 + m * 16;
                float s;
                if (MODE == 0) s = rs[row];
                else { const f32x4* p = (const f32x4*)(rs + (size_t)row * 16); const f32x4 a = p[0], b = p[1], c = p[2], d = p[3];
                       const float t = ((a.x + a.y) + (a.z + a.w)) + ((b.x + b.y) + (b.z + b.w)) + ((c.x + c.y) + (c.z + c.w)) + ((d.x + d.y) + (d.z + d.w));
                       s = rsqrtf(t * (1.f / 1024.f) + EPS); }
                bf16* rowp = O + (size_t)row * ldc + col0;
#pragma unroll
                for (int bj = 0; bj < 2; ++bj) { const pg8::f32x4 v0 = acc[ai][bj][m][0] * s, v1 = acc[ai][bj][m][1] * s;
                    u32x4 w; w.x = cvt_pk_bf16(v0[0], v0[1]); w.y = cvt_pk_bf16(v0[2], v0[3]); w.z = cvt_pk_bf16(v1[0], v1[1]); w.w = cvt_pk_bf16(v1[2], v1[3]);
                    *(u32x4*)(rowp + bj * 128) = w; }
            }
    }
};
struct EpiProj {
    static constexpr bool PERM = true, AFTER_DRAIN = false;
    bf16* O; const float* rs;
    __device__ __forceinline__ void operator()(const pg8::f32x4 (&acc)[2][2][4][2], const pg8::Unit& u, int wr, int wc, int fr, int fq) const {
        const int row0 = u.pm * 256 + wr * 64 + fr, cin = wc * 32 + 8 * fq, pn = u.pn;
#pragma unroll
        for (int ai = 0; ai < 2; ++ai)
#pragma unroll
            for (int m = 0; m < 4; ++m) {
                const int row = row0 + ai * 128 + m * 16; const float sc = rs[row];
                float a[8], b[8];
#pragma unroll
                for (int i = 0; i < 4; ++i) { a[i] = acc[ai][0][m][0][i] * sc; a[4 + i] = acc[ai][0][m][1][i] * sc; b[i] = acc[ai][1][m][0][i] * sc; b[4 + i] = acc[ai][1][m][1][i] * sc; }
                bf16* rowp = O + (size_t)row * PDIM;
                if (pn >= 4 && pn < 6) {
                    u32x4 w0, w1; w0.x = cvt_pk_bf16(a[0], a[1]); w0.y = cvt_pk_bf16(a[2], a[3]); w0.z = cvt_pk_bf16(a[4], a[5]); w0.w = cvt_pk_bf16(a[6], a[7]);
                    w1.x = cvt_pk_bf16(b[0], b[1]); w1.y = cvt_pk_bf16(b[2], b[3]); w1.z = cvt_pk_bf16(b[4], b[5]); w1.w = cvt_pk_bf16(b[6], b[7]);
                    *(u32x4*)(rowp + 512 + 256 * (pn - 4) + cin) = w0; *(u32x4*)(rowp + 512 + 256 * (pn - 4) + 128 + cin) = w1;
                } else {
                    float o[8];
                    if (pn < 4) {
#pragma unroll
                        for (int i = 0; i < 8; ++i) o[i] = a[i] * b[i];
                    } else {
#pragma unroll
                        for (int i = 0; i < 8; ++i) o[i] = a[i] * sigmoid_f(b[i]);
                    }
                    u32x4 w; w.x = cvt_pk_bf16(o[0], o[1]); w.y = cvt_pk_bf16(o[2], o[3]); w.z = cvt_pk_bf16(o[4], o[5]); w.w = cvt_pk_bf16(o[6], o[7]);
                    *(u32x4*)(rowp + (pn < 4 ? 128 * pn : 1024 + 128 * (pn - 6)) + cin) = w;
                }
            }
    }
};
__host__ __device__ __forceinline__ int win_src_col(int n) {
    const int t = n >> 8, j = n & 255;
    if (t < 4) return (j < 128) ? 128 * t + j : 1024 + 128 * t + (j - 128);
    if (t < 6) return 512 + 256 * (t - 4) + j;
    return (j < 128) ? 1536 + 128 * (t - 6) + j : 2048 + 128 * (t - 6) + (j - 128);
}
struct EpiResidual {
    static constexpr bool PERM = true, AFTER_DRAIN = false;
    bf16* O; const bf16* XB; float* ssq;
    __device__ __forceinline__ void operator()(const pg8::f32x4 (&acc)[2][2][4][2], const pg8::Unit& u, int wr, int wc, int fr, int fq) const {
        const int row0 = u.pm * 256 + wr * 64 + fr, col0 = u.pn * 256 + wc * 32 + 8 * fq;
#pragma unroll
        for (int ai = 0; ai < 2; ++ai)
#pragma unroll
            for (int m = 0; m < 4; ++m) {
                const int row = row0 + ai * 128 + m * 16;
                const bf16* xr = XB + (size_t)row * DM + col0; bf16* rowp = O + (size_t)row * DM + col0;
                float q = 0.f;
                u32x4 xw[2];
#pragma unroll
                for (int bj = 0; bj < 2; ++bj) xw[bj] = *(const u32x4*)(xr + bj * 128);
#pragma unroll
                for (int bj = 0; bj < 2; ++bj) { const f32x4 x0 = (f32x4){bflo(xw[bj].x), bfhi(xw[bj].x), bflo(xw[bj].y), bfhi(xw[bj].y)}, x1 = (f32x4){bflo(xw[bj].z), bfhi(xw[bj].z), bflo(xw[bj].w), bfhi(xw[bj].w)};
                    const pg8::f32x4 v0 = acc[ai][bj][m][0] + x0, v1 = acc[ai][bj][m][1] + x1;
                    q += (v0[0] * v0[0] + v0[1] * v0[1]) + (v0[2] * v0[2] + v0[3] * v0[3]) + (v1[0] * v1[0] + v1[1] * v1[1]) + (v1[2] * v1[2] + v1[3] * v1[3]);
                    u32x4 w; w.x = cvt_pk_bf16(v0[0], v0[1]); w.y = cvt_pk_bf16(v0[2], v0[3]); w.z = cvt_pk_bf16(v1[0], v1[1]); w.w = cvt_pk_bf16(v1[2], v1[3]);
                    *(u32x4*)(rowp + bj * 128) = w; }
                q += __shfl_xor(q, 16); q += __shfl_xor(q, 32);
                if (fq == 0) ssq[(size_t)row * 16 + u.pn * 4 + wc] = q;
            }
    }
};

template <bool MAPIN> __device__ __forceinline__ void p0_transpose_item(const float* W, int K, int N, bf16* WT, LAS float* scr, int item, int lane,
                                                  const float* g_lo, const float* g_hi, int split) {
    const int nblk = N / 32, kb = item / nblk, nb = item % nblk, k0 = 64 * kb, n0 = 32 * nb;
#pragma unroll 8
    for (int i = 0; i < 32; ++i) { const int kk = 2 * i + (lane >> 5); const int k = k0 + kk;
        const float g = (k < split) ? g_lo[k] : g_hi[k - split];
        scr[kk * 33 + (lane & 31)] = W[(size_t)k * N + (MAPIN ? win_src_col(n0) : n0) + (lane & 31)] * g; }
    asm volatile("s_waitcnt lgkmcnt(0)" ::: "memory");
    const int c = lane & 7;
#pragma unroll
    for (int j = 0; j < 4; ++j) { const int n = (lane >> 3) + 8 * j; const LAS float* s = scr + (8 * c) * 33 + n;
        u32x4 o; o.x = pk2(s[0 * 33], s[1 * 33]); o.y = pk2(s[2 * 33], s[3 * 33]); o.z = pk2(s[4 * 33], s[5 * 33]); o.w = pk2(s[6 * 33], s[7 * 33]);
        *(u32x4*)(WT + (size_t)(n0 + n) * K + k0 + 8 * c) = o; }
    asm volatile("s_waitcnt lgkmcnt(0)" ::: "memory");
}

__device__ __forceinline__ float q4(float x, float inv_s) {
    const float a = fabsf(x) * inv_s; float r;
    if (a < 2.f) r = rintf(a * 2.f) * 0.5f; else if (a < 4.f) r = rintf(a); else r = fminf(6.f, rintf(a * 0.5f) * 2.f);
    return copysignf(r, x);
}
__device__ __forceinline__ void phase_prep(const Params& P, LAS unsigned char* lds) {
    const int tid = threadIdx.x, lane = tid & 63, wave = __builtin_amdgcn_readfirstlane(tid >> 6);
    const int gw = blockIdx.x * NWAVES + wave, NGW = gridDim.x * NWAVES;
    unsigned char* ws = P.ws;
    LAS float* scr = (LAS float*)(lds + wave * 16384);
    constexpr int I_IN = (DM / 64) * (DIN / 32), I_OUT = (DM / 64) * (DM / 32), I_Q = (DM / 64) * (2048 / 32);
    for (int it = gw; it < I_IN + I_OUT + I_Q; it += NGW) {
        int r = it;
        if (r < I_IN) { p0_transpose_item<true>(P.w_in, DM, DIN, (bf16*)(ws + WS_WIN_T), scr, r, lane, P.g_mix, P.g_mix, DM); continue; } r -= I_IN;
        if (r < I_OUT) { p0_transpose_item<false>(P.w_out, DM, DM, (bf16*)(ws + WS_WOUT_T), scr, r, lane, P.g_sc, P.g_cf, 512); continue; } r -= I_OUT;
        p0_transpose_item<false>(P.w_q, DM, 2048, (bf16*)(ws + WS_WQ_T), scr, r, lane, P.g_ffn, P.g_ffn, DM);
    }
    {
        bf16* H0B = (bf16*)(ws + WS_H0B); float* RSTD1 = (float*)(ws + WS_RSTD1);
        for (int t0 = gw * 4; t0 < NTOK; t0 += NGW * 4) {
            f32x4 v[4][4];
#pragma unroll
            for (int q = 0; q < 4; ++q) { const f32x4* xr = (const f32x4*)(P.x + (size_t)(t0 + q) * DM) + lane;
#pragma unroll
                for (int j = 0; j < 4; ++j) v[q][j] = xr[64 * j]; }
#pragma unroll
            for (int q = 0; q < 4; ++q) { float sq = 0.f;
#pragma unroll
                for (int j = 0; j < 4; ++j) sq += (v[q][j].x * v[q][j].x + v[q][j].y * v[q][j].y) + (v[q][j].z * v[q][j].z + v[q][j].w * v[q][j].w);
                sq = wave_sum_fast(sq);
                if (lane == 0) RSTD1[t0 + q] = rsqrtf(sq * (1.f / DM) + EPS);
                u32x2* o = (u32x2*)(H0B + (size_t)(t0 + q) * DM) + lane;
#pragma unroll
                for (int j = 0; j < 4; ++j) { u32x2 w; w.x = pk2(v[q][j].x, v[q][j].y); w.y = pk2(v[q][j].z, v[q][j].w); o[64 * j] = w; } }
        }
    }
    {
        unsigned char* U8 = ws + WS_U8; unsigned char* V8 = ws + WS_V8;
        f32x4 gf[4];
#pragma unroll
        for (int j = 0; j < 4; ++j) gf[j] = ((const f32x4*)P.g_ffn)[64 * j + lane];
        float* ESC = (float*)(ws + WS_ESCALE);
        for (int e0 = gw * 2; e0 < 2 * 16384; e0 += NGW * 2) {
            const bool isv = e0 >= 16384; const int ee0 = isv ? e0 - 16384 : e0;
            f32x4 v[2][4];
#pragma unroll
            for (int q = 0; q < 2; ++q) { const f32x4* src = (const f32x4*)((isv ? P.pv : P.pu) + (size_t)(ee0 + q) * DM) + lane;
#pragma unroll
                for (int j = 0; j < 4; ++j) v[q][j] = src[64 * j]; }
#pragma unroll
            for (int q = 0; q < 2; ++q) {
                float mx = 0.f;
#pragma unroll
                for (int j = 0; j < 4; ++j) { if (!isv) v[q][j] = v[q][j] * gf[j];
                    mx = fmaxf(mx, fmaxf(fmaxf(fabsf(v[q][j].x), fabsf(v[q][j].y)), fmaxf(fabsf(v[q][j].z), fabsf(v[q][j].w)))); }
#pragma unroll
                for (int o = 1; o < 64; o <<= 1) mx = fmaxf(mx, __shfl_xor(mx, o));
                const float sc = fmaxf(mx, 1e-30f) * (1.f / 6.f), inv = 1.f / sc;
                if (lane == 0) ESC[e0 + q] = sc;
                unsigned w0 = 0u, w1 = 0u;
                w0 = __builtin_amdgcn_cvt_scalef32_pk_fp4_f32(w0, v[q][0].x * inv, v[q][0].y * inv, 1.0f, 0); w0 = __builtin_amdgcn_cvt_scalef32_pk_fp4_f32(w0, v[q][0].z * inv, v[q][0].w * inv, 1.0f, 1);
                w0 = __builtin_amdgcn_cvt_scalef32_pk_fp4_f32(w0, v[q][1].x * inv, v[q][1].y * inv, 1.0f, 2); w0 = __builtin_amdgcn_cvt_scalef32_pk_fp4_f32(w0, v[q][1].z * inv, v[q][1].w * inv, 1.0f, 3);
                w1 = __builtin_amdgcn_cvt_scalef32_pk_fp4_f32(w1, v[q][2].x * inv, v[q][2].y * inv, 1.0f, 0); w1 = __builtin_amdgcn_cvt_scalef32_pk_fp4_f32(w1, v[q][2].z * inv, v[q][2].w * inv, 1.0f, 1);
                w1 = __builtin_amdgcn_cvt_scalef32_pk_fp4_f32(w1, v[q][3].x * inv, v[q][3].y * inv, 1.0f, 2); w1 = __builtin_amdgcn_cvt_scalef32_pk_fp4_f32(w1, v[q][3].z * inv, v[q][3].w * inv, 1.0f, 3);
                u32x2 o; o.x = w0; o.y = w1;
                *(u32x2*)((isv ? V8 : U8) + (size_t)(ee0 + q) * 512 + 8 * lane) = o;
            }
        }
    }
    {
        bf16* KB = (bf16*)(ws + WS_KEYS);
        const int gt = blockIdx.x * NTHREADS + tid, NGT = gridDim.x * NTHREADS;
        for (int i = gt; i < 8 * 2 * 128 * 128 / 4; i += NGT) { const f32x4 v = ((const f32x4*)P.keys)[i]; u32x2 w; w.x = pk2(v.x, v.y); w.y = pk2(v.z, v.w); ((u32x2*)KB)[i] = w; }
    }
    {
        float* MP = (float*)(ws + WS_METAPART); float* MR = (float*)(ws + WS_METARSTD);
        for (int r = gw; r < NMETA; r += NGW) {
            float s = 0.f;
            for (int k = lane; k < DM; k += 64) { const float v = P.meta[r * DM + k]; s += v * v; }
            s = wave_sum(s);
            if (lane == 0) MR[r] = rsqrtf(s * (1.f / DM) + EPS);
        }
        for (int it = gw; it < MKC * 40; it += NGW) {
            const int kc = it / 40, nb = it % 40, n = nb * 64 + lane;
            float acc[NMETA];
#pragma unroll
            for (int r = 0; r < NMETA; ++r) acc[r] = 0.f;
            for (int k = kc * (DM / MKC); k < (kc + 1) * (DM / MKC); ++k) {
                const float w = P.w_in[(size_t)k * DIN + n] * P.g_mix[k];
#pragma unroll
                for (int r = 0; r < NMETA; ++r) acc[r] += P.meta[r * DM + k] * w;
            }
#pragma unroll
            for (int r = 0; r < NMETA; ++r) MP[(size_t)(kc * 16 + r) * DIN + n] = acc[r];
        }
    }
}

__device__ __forceinline__ float metaraw(const float* MP, const float* MR, int p, int col) { float s = 0.f;
#pragma unroll 8
    for (int kc = 0; kc < MKC; ++kc) s += MP[(size_t)(kc * 16 + p) * DIN + col];
    return s * MR[p]; }
__device__ __forceinline__ void phase_metaproj(const Params& P) {
    const float* MP = (const float*)(P.ws + WS_METAPART); const float* MR = (const float*)(P.ws + WS_METARSTD); float* MJ = (float*)(P.ws + WS_METAPROJ);
    for (int gt = blockIdx.x * NTHREADS + threadIdx.x; gt < NMETA * PDIM; gt += gridDim.x * NTHREADS) { const int p = gt / PDIM, c = gt % PDIM; float v;
        if (c < 512) v = metaraw(MP, MR, p, c) * metaraw(MP, MR, p, 1024 + c);
        else if (c < 1024) v = metaraw(MP, MR, p, c);
        else v = metaraw(MP, MR, p, 1536 + (c - 1024)) * sigmoid_f(metaraw(MP, MR, p, 2048 + (c - 1024)));
        MJ[gt] = v; }
}
__device__ __forceinline__ float meta_val(const float* MJ, const float*, int p, int col) { return MJ[p * PDIM + col]; }
__device__ __forceinline__ float proj_at(const bf16* PROJ, const float* MP, const float* MR, int b, int pos, int col) {
    if (pos < 0) return 0.f;
    if (pos < NMETA) return meta_val(MP, MR, pos, col);
    return bf2f(PROJ[(size_t)(b * SEQ + pos - NMETA) * PDIM + col]);
}
__device__ __forceinline__ void proj8_at(const bf16* PROJ, const float* MP, const float* MR, int b, int pos, int col, float (&v)[8]) {
    if (pos < 0) {
#pragma unroll
        for (int i = 0; i < 8; ++i) v[i] = 0.f;
    } else if (pos < NMETA) {
        const f32x4 a = *(const f32x4*)(MP + pos * PDIM + col), bq = *(const f32x4*)(MP + pos * PDIM + col + 4);
        v[0] = a.x; v[1] = a.y; v[2] = a.z; v[3] = a.w; v[4] = bq.x; v[5] = bq.y; v[6] = bq.z; v[7] = bq.w;
    } else {
        const u32x4 w = *(const u32x4*)(PROJ + (size_t)(b * SEQ + pos - NMETA) * PDIM + col);
        v[0] = bflo(w.x); v[1] = bfhi(w.x); v[2] = bflo(w.y); v[3] = bfhi(w.y); v[4] = bflo(w.z); v[5] = bfhi(w.z); v[6] = bflo(w.w); v[7] = bfhi(w.w);
    }
}

template <int R> __device__ __forceinline__ void conv_rows(const LAS unsigned char* ubase, const f32x2 (&wcf)[31], f32x2 (&acc)[32]) {
    if constexpr (R < 62) {
        const unsigned uw = *(const LAS unsigned*)(ubase + R * 1024);
        const f32x2 x = (f32x2){bflo(uw), bfhi(uw)};
        constexpr int lo = R > 30 ? R - 30 : 0, hi = R < 31 ? R : 31;
#pragma unroll
        for (int ii = lo; ii <= hi; ++ii) acc[ii] += wcf[R - ii] * x;
        conv_rows<R + 1>(ubase, wcf, acc);
    }
}
__device__ __forceinline__ void phase_conv(const Params& P, LAS unsigned char* lds) {
    const int tid = threadIdx.x, lane = tid & 63, wave = __builtin_amdgcn_readfirstlane(tid >> 6);
    unsigned char* ws = P.ws;
    const bf16* PROJ = (const bf16*)(ws + WS_PROJ); const float* MP = (const float*)(ws + WS_METAPROJ); const float* MR = nullptr;
    bf16* Y = (bf16*)(ws + WS_Y);
    constexpr int TT = 64, NTILE = NTOK / TT, UROWS = TT + 30;
    const int cgp = wave & 3, th = wave >> 2, ch2 = cgp * 128 + 2 * lane;
    f32x2 wcf[31];
#pragma unroll
    for (int j = 0; j < 31; ++j) wcf[j] = *(const f32x2*)(P.cf_w + j * 512 + ch2);
    const f32x2 bcf = *(const f32x2*)(P.cf_b + ch2);
    for (int tile = blockIdx.x; tile < NTILE; tile += gridDim.x) {
        const int b = tile / (SEQ / TT), s0 = (tile % (SEQ / TT)) * TT;
#pragma unroll 4
        for (int p = 0; p < (UROWS + 7) / 8; ++p) {
            const int r = p * 8 + wave;
            if (r < UROWS) {
                const int pos = NMETA + s0 - 30 + r;
                float uu[8];
                proj8_at(PROJ, MP, MR, b, pos, 1024 + 8 * lane, uu);
                u32x4 w; w.x = pk2(uu[0], uu[1]); w.y = pk2(uu[2], uu[3]); w.z = pk2(uu[4], uu[5]); w.w = pk2(uu[6], uu[7]);
                *(LAS u32x4*)(lds + r * 1024 + lane * 16) = w;
            }
        }
        __syncthreads();
        f32x2 acc[32];
#pragma unroll
        for (int ii = 0; ii < 32; ++ii) acc[ii] = bcf;
        conv_rows<0>(lds + (32 * th) * 1024 + ch2 * 2, wcf, acc);
        __syncthreads();
#pragma unroll
        for (int ii = 0; ii < 32; ++ii) *(LAS f32x2*)(lds + (32 * th + ii) * 2048 + ch2 * 4) = acc[ii];
        __syncthreads();
        {
            float lng[8], lnb[8];
            { const f32x4 a = *(const f32x4*)(P.ln_g + 8 * lane), c = *(const f32x4*)(P.ln_g + 8 * lane + 4), d = *(const f32x4*)(P.ln_b + 8 * lane), e = *(const f32x4*)(P.ln_b + 8 * lane + 4);
              lng[0] = a.x; lng[1] = a.y; lng[2] = a.z; lng[3] = a.w; lng[4] = c.x; lng[5] = c.y; lng[6] = c.z; lng[7] = c.w;
              lnb[0] = d.x; lnb[1] = d.y; lnb[2] = d.z; lnb[3] = d.w; lnb[4] = e.x; lnb[5] = e.y; lnb[6] = e.z; lnb[7] = e.w; }
            float wsc[3][8];
#pragma unroll
            for (int j = 0; j < 3; ++j) { const f32x4 a = *(const f32x4*)(P.sc_w + j * 512 + 8 * lane), c = *(const f32x4*)(P.sc_w + j * 512 + 8 * lane + 4);
                wsc[j][0] = a.x; wsc[j][1] = a.y; wsc[j][2] = a.z; wsc[j][3] = a.w; wsc[j][4] = c.x; wsc[j][5] = c.y; wsc[j][6] = c.z; wsc[j][7] = c.w; }
            float cxa[8], cxb[8];
            { const int pos = NMETA + s0 + 8 * wave - 2;
              proj8_at(PROJ, MP, MR, b, pos, 8 * lane, cxa); proj8_at(PROJ, MP, MR, b, pos + 1, 8 * lane, cxb); }
#pragma unroll 2
            for (int q = 0; q < 8; ++q) {
                const int ii = 8 * wave + q, s = s0 + ii; const size_t t = (size_t)b * SEQ + s;
                float o[8];
                { const f32x4 a = *(const LAS f32x4*)(lds + ii * 2048 + lane * 32), c = *(const LAS f32x4*)(lds + ii * 2048 + lane * 32 + 16);
                  o[0] = a.x; o[1] = a.y; o[2] = a.z; o[3] = a.w; o[4] = c.x; o[5] = c.y; o[6] = c.z; o[7] = c.w; }
                float s1 = 0.f;
#pragma unroll
                for (int i = 0; i < 8; ++i) s1 += o[i];
                const float mean = wave_sum_fast(s1) * (1.f / 512.f);
                float s2 = 0.f;
#pragma unroll
                for (int i = 0; i < 8; ++i) { o[i] -= mean; s2 += o[i] * o[i]; }
                const float rs = rsqrtf(wave_sum_fast(s2) * (1.f / 512.f) + EPS);
                float s3 = 0.f;
#pragma unroll
                for (int i = 0; i < 8; ++i) { float y = o[i] * rs * lng[i] + lnb[i]; y = y * sigmoid_f(y); o[i] = y; s3 += y * y; }
                const float r2 = rsqrtf(wave_sum_fast(s3) * (1.f / 512.f) + EPS);
                u32x4 wv; wv.x = pk2(o[0] * r2, o[1] * r2); wv.y = pk2(o[2] * r2, o[3] * r2); wv.z = pk2(o[4] * r2, o[5] * r2); wv.w = pk2(o[6] * r2, o[7] * r2);
                *(u32x4*)(Y + t * DM + 512 + 8 * lane) = wv;
                float bgv[8], cxc[8], accs[8];
                proj8_at(PROJ, MP, MR, b, NMETA + s, 8 * lane, cxc); proj8_at(PROJ, MP, MR, b, NMETA + s, 512 + 8 * lane, bgv);
                float s4 = 0.f;
#pragma unroll
                for (int i = 0; i < 8; ++i) { accs[i] = bgv[i] * (wsc[0][i] * cxa[i] + wsc[1][i] * cxb[i] + wsc[2][i] * cxc[i]); s4 += accs[i] * accs[i]; cxa[i] = cxb[i]; cxb[i] = cxc[i]; }
                const float r4 = rsqrtf(wave_sum_fast(s4) * (1.f / 512.f) + EPS);
                u32x4 wz; wz.x = pk2(accs[0] * r4, accs[1] * r4); wz.y = pk2(accs[2] * r4, accs[3] * r4); wz.z = pk2(accs[4] * r4, accs[5] * r4); wz.w = pk2(accs[6] * r4, accs[7] * r4);
                *(u32x4*)(Y + t * DM + 8 * lane) = wz;
            }
        }
        __syncthreads();
    }
}

__device__ __forceinline__ int ord_i(float s) { int k = __builtin_bit_cast(int, s); k ^= (k >> 31) & 0x7fffffff; return k; }
__device__ __forceinline__ float unord_f(int k) { k ^= (k >> 31) & 0x7fffffff; return __builtin_bit_cast(float, k); }
#define TOP_INSERT(L, x_) do { int _x = (x_); _Pragma("unroll") for (int _i = 0; _i < 16; ++_i) { const int _hi = max(L[_i], _x); _x = min(L[_i], _x); L[_i] = _hi; } } while (0)

typedef short bf16x8 __attribute__((ext_vector_type(8)));
typedef float f32x16 __attribute__((ext_vector_type(16)));
template <bool DESC> __device__ __forceinline__ void ce_i(int& a, int& b) { const int hi = max(a, b), lo = min(a, b); if (DESC) { a = hi; b = lo; } else { a = lo; b = hi; } }
__device__ __forceinline__ void bitonic_sort16(int (&a)[16]) {
#pragma unroll
    for (int k = 2; k <= 16; k <<= 1)
#pragma unroll
        for (int j = k >> 1; j > 0; j >>= 1)
#pragma unroll
            for (int i = 0; i < 16; ++i) { const int l = i ^ j; if (l > i) { if ((i & k) == 0) ce_i<true>(a[i], a[l]); else ce_i<false>(a[i], a[l]); } }
}
__device__ __forceinline__ void bitonic_merge16(int (&a)[16]) {
#pragma unroll
    for (int j = 8; j > 0; j >>= 1)
#pragma unroll
        for (int i = 0; i < 16; ++i) { const int l = i ^ j; if (l > i) ce_i<true>(a[i], a[l]); }
}
__device__ __forceinline__ void merge_top16(int (&a)[16], const int (&b)[16]) {
#pragma unroll
    for (int i = 0; i < 16; ++i) a[i] = max(a[i], b[15 - i]);
    bitonic_merge16(a);
}
__device__ __forceinline__ int lut16(const unsigned (&T)[4], int i) {
    const unsigned sel = (unsigned)(i & 7) | 0x0c0c0c00u;
    const unsigned lo = __builtin_amdgcn_perm(T[1], T[0], sel), hi = __builtin_amdgcn_perm(T[3], T[2], sel);
    return (int)((i & 8) ? hi : lo);
}
constexpr int KROW = 272;
constexpr float SCORE_BIAS = 8.0f;

__device__ __forceinline__ void route_half(const LAS unsigned char* kl, const bf16* qrow, int nl, int hb, int (&L)[16]) {
    bf16x8 qf[8];
#pragma unroll
    for (int ks = 0; ks < 8; ++ks) qf[ks] = *(const bf16x8*)(qrow + 64 * hb + 8 * ks);
    f32x16 acc[4];
#pragma unroll
    for (int nt = 0; nt < 4; ++nt)
#pragma unroll
        for (int r = 0; r < 16; ++r) acc[nt][r] = SCORE_BIAS;
#pragma unroll
    for (int ks = 0; ks < 8; ++ks)
#pragma unroll
        for (int nt = 0; nt < 4; ++nt) {
            const bf16x8 a = *(const LAS bf16x8*)(kl + (32 * nt + nl) * KROW + (64 * hb + 8 * ks) * 2);
            acc[nt] = __builtin_amdgcn_mfma_f32_32x32x16_bf16(a, qf[ks], acc[nt], 0, 0, 0);
        }
    const int hb4 = 4 * hb;
    int T[4][16];
#pragma unroll
    for (int nt = 0; nt < 4; ++nt)
#pragma unroll
        for (int r = 0; r < 16; ++r) { const int n0 = 32 * nt + (r & 3) + 8 * (r >> 2); const float sc = acc[nt][r];
            T[nt][r] = (__float_as_int(sc) & ~127) | ((127 - n0) - hb4); }
    bitonic_sort16(T[0]); bitonic_sort16(T[1]); bitonic_sort16(T[2]); bitonic_sort16(T[3]);
    merge_top16(T[0], T[1]); merge_top16(T[2], T[3]); merge_top16(T[0], T[2]);
#pragma unroll
    for (int i = 0; i < 16; ++i) { const unsigned v = (unsigned)T[0][15 - i]; auto r = __builtin_amdgcn_permlane32_swap(v, v, false, false);
        const unsigned r0 = r[0], r1 = r[1]; const int partner = (int)(hb ? r0 : r1); L[i] = max(T[0][i], partner); }
    bitonic_merge16(L);
}

__device__ __forceinline__ void phase_route(const Params& P, LAS unsigned char* lds) {
    const int tid = threadIdx.x, lane = tid & 63, wave = __builtin_amdgcn_readfirstlane(tid >> 6);
    const int nl = lane & 31, hb = lane >> 5;
    unsigned char* ws = P.ws;
    const bf16* KEYS = (const bf16*)(ws + WS_KEYS); const bf16* Q = (const bf16*)(ws + WS_Q);
    int* IDX = (int*)(ws + WS_IDX); float* GATE = (float*)(ws + WS_GATE);
    int last_h = -1;
    for (int unit = blockIdx.x; unit < (NTOK / 256) * NHEAD; unit += gridDim.x) {
        const int h = unit & 7, tb = unit >> 3;
        if (h != last_h) {
            __syncthreads();
            for (int c = tid; c < 4096; c += NTHREADS) { const u32x4 v = ((const u32x4*)(KEYS + (size_t)h * 32768))[c];
                *(LAS u32x4*)(lds + (c >> 4) * KROW + (c & 15) * 16) = v; }
            __syncthreads();
            last_h = h;
        }
        const size_t t = (size_t)tb * 256 + wave * 32 + nl;
        int L1[16], L2[16];
        route_half(lds, Q + t * 2048 + h * 256, nl, hb, L1);
        route_half(lds + 128 * KROW, Q + t * 2048 + h * 256 + 128, nl, hb, L2);
        float v1[16], v2[16];
#pragma unroll
        for (int i = 0; i < 16; ++i) { v1[i] = __int_as_float(L1[i] & ~127); v2[i] = __int_as_float(L2[i] & ~127); }
#define CAND(i, j) ((__float_as_int(v1[i] + v2[j]) & ~255) | (255 - (16 * (i) + (j))))
        int A[16], B[16], C[16];
#pragma unroll
        for (int j = 0; j < 16; ++j) A[j] = CAND(0, j);
#pragma unroll
        for (int j = 0; j < 8; ++j) { B[j] = CAND(1, j); B[8 + j] = CAND(15 - j, 0); }
        bitonic_merge16(B);
        C[0] = CAND(2, 0); C[1] = CAND(2, 1); C[2] = CAND(2, 2); C[3] = CAND(2, 3); C[4] = CAND(2, 4);
        C[5] = CAND(3, 0); C[6] = CAND(3, 1); C[7] = CAND(3, 2); C[8] = CAND(3, 3);
        C[9] = CAND(4, 0); C[10] = CAND(4, 1); C[11] = CAND(4, 2);
        C[12] = CAND(5, 0); C[13] = CAND(5, 1); C[14] = CAND(6, 0); C[15] = CAND(6, 1);
        bitonic_sort16(C);
        { const int d0 = CAND(7, 0), d1 = CAND(7, 1); C[14] = max(C[14], d1); C[15] = max(C[15], d0); bitonic_merge16(C); }
#undef CAND
        merge_top16(A, B); merge_top16(A, C);
        unsigned T1[4], T2[4];
#pragma unroll
        for (int q = 0; q < 4; ++q) {
            T1[q] = (unsigned)(127 - (L1[4 * q] & 127)) | ((unsigned)(127 - (L1[4 * q + 1] & 127)) << 8) | ((unsigned)(127 - (L1[4 * q + 2] & 127)) << 16) | ((unsigned)(127 - (L1[4 * q + 3] & 127)) << 24);
            T2[q] = (unsigned)(127 - (L2[4 * q] & 127)) | ((unsigned)(127 - (L2[4 * q + 1] & 127)) << 8) | ((unsigned)(127 - (L2[4 * q + 2] & 127)) << 16) | ((unsigned)(127 - (L2[4 * q + 3] & 127)) << 24); }
        float val[16]; int ex[16];
#pragma unroll
        for (int k = 0; k < 16; ++k) { const int pos = 255 - (A[k] & 255); val[k] = __int_as_float(A[k] & ~255);
            ex[k] = lut16(T1, pos >> 4) * NKEYS + lut16(T2, pos & 15); }
        float sum = 0.f; const float vmax = val[0];
#pragma unroll
        for (int k = 0; k < 16; ++k) { val[k] = __expf(val[k] - vmax); sum += val[k]; }
        const float inv = 1.f / sum;
        if (hb == 0) {
            int* ip = IDX + t * NSEL + h * TOPK; float* gp = GATE + t * NSEL + h * TOPK;
#pragma unroll
            for (int k4 = 0; k4 < 4; ++k4) {
                *(int4*)(ip + 4 * k4) = make_int4(ex[4 * k4], ex[4 * k4 + 1], ex[4 * k4 + 2], ex[4 * k4 + 3]);
                *(f32x4*)(gp + 4 * k4) = (f32x4){val[4 * k4] * inv, val[4 * k4 + 1] * inv, val[4 * k4 + 2] * inv, val[4 * k4 + 3] * inv};
            }
        }
    }
}

#define FP4X2(w, sel) __builtin_amdgcn_cvt_scalef32_pk_f32_fp4((w), 1.0f, (sel))
__device__ __forceinline__ float dot16_fp4(const u32x2 r, const f32x4 (&xs)[4]) {
    float p = 0.f;
    { const f32x2 a = FP4X2(r.x, 0), b = FP4X2(r.x, 1), c = FP4X2(r.x, 2), d = FP4X2(r.x, 3);
      p += (a.x * xs[0].x + a.y * xs[0].y) + (b.x * xs[0].z + b.y * xs[0].w); p += (c.x * xs[1].x + c.y * xs[1].y) + (d.x * xs[1].z + d.y * xs[1].w); }
    { const f32x2 a = FP4X2(r.y, 0), b = FP4X2(r.y, 1), c = FP4X2(r.y, 2), d = FP4X2(r.y, 3);
      p += (a.x * xs[2].x + a.y * xs[2].y) + (b.x * xs[2].z + b.y * xs[2].w); p += (c.x * xs[3].x + c.y * xs[3].y) + (d.x * xs[3].z + d.y * xs[3].w); }
    return p;
}
__device__ __forceinline__ void axpy16_fp4(const u32x2 r, float w, f32x4 (&o)[4]) {
    { const f32x2 a = FP4X2(r.x, 0), b = FP4X2(r.x, 1), c = FP4X2(r.x, 2), d = FP4X2(r.x, 3);
      o[0].x += w * a.x; o[0].y += w * a.y; o[0].z += w * b.x; o[0].w += w * b.y; o[1].x += w * c.x; o[1].y += w * c.y; o[1].z += w * d.x; o[1].w += w * d.y; }
    { const f32x2 a = FP4X2(r.y, 0), b = FP4X2(r.y, 1), c = FP4X2(r.y, 2), d = FP4X2(r.y, 3);
      o[2].x += w * a.x; o[2].y += w * a.y; o[2].z += w * b.x; o[2].w += w * b.y; o[3].x += w * c.x; o[3].y += w * c.y; o[3].z += w * d.x; o[3].w += w * d.y; }
}
__device__ __forceinline__ float swap32_add(float a, float b) { auto r = __builtin_amdgcn_permlane32_swap(__float_as_uint(a), __float_as_uint(b), false, false); return __uint_as_float(r[0]) + __uint_as_float(r[1]); }
__device__ __forceinline__ float swap16_add(float a, float b) { auto r = __builtin_amdgcn_permlane16_swap(__float_as_uint(a), __float_as_uint(b), false, false); return __uint_as_float(r[0]) + __uint_as_float(r[1]); }
__device__ __forceinline__ float row_sum16(float v) { v += dpp_f<0xB1>(v); v += dpp_f<0x4E>(v); v += dpp_f<0x141>(v); v += dpp_f<0x140>(v); return v; }
constexpr int GB = 16;
typedef __attribute__((address_space(8))) void* rsrc_t;
__device__ __forceinline__ void g_issue(u32x2 (&buf)[GB], __amdgpu_buffer_rsrc_t rs, int idxr, int lb, int voff) {
#pragma unroll
    for (int j = 0; j < GB; ++j) { const int e = __builtin_amdgcn_readlane(idxr, lb + j); buf[j] = __builtin_amdgcn_raw_buffer_load_b64(rs, voff, e * 512, 0); }
}
__device__ __forceinline__ float dot16_fp4p(const u32x2 r, const f32x2 (&xp)[8]) {
    f32x2 a = FP4X2(r.x, 0) * xp[0];
    a += FP4X2(r.x, 1) * xp[1]; a += FP4X2(r.x, 2) * xp[2]; a += FP4X2(r.x, 3) * xp[3];
    a += FP4X2(r.y, 0) * xp[4]; a += FP4X2(r.y, 1) * xp[5]; a += FP4X2(r.y, 2) * xp[6]; a += FP4X2(r.y, 3) * xp[7];
    return a.x + a.y;
}
__device__ __forceinline__ void axpy16_fp4p(const u32x2 r, float w, f32x2 (&o)[8]) {
    const f32x2 ww = (f32x2){w, w};
    o[0] += FP4X2(r.x, 0) * ww; o[1] += FP4X2(r.x, 1) * ww; o[2] += FP4X2(r.x, 2) * ww; o[3] += FP4X2(r.x, 3) * ww;
    o[4] += FP4X2(r.y, 0) * ww; o[5] += FP4X2(r.y, 1) * ww; o[6] += FP4X2(r.y, 2) * ww; o[7] += FP4X2(r.y, 3) * ww;
}
__device__ __forceinline__ void g_compute_u(const u32x2 (&buf)[GB], int q, int i16, const f32x2 (&xp)[8], float& zlo, float& zhi) {
    float p[16];
#pragma unroll
    for (int j = 0; j < 16; ++j) p[j] = dot16_fp4p(buf[j], xp);
    float s1[8], s2[4];
#pragma unroll
    for (int m = 0; m < 8; ++m) s1[m] = swap32_add(p[2 * m], p[2 * m + 1]);
#pragma unroll
    for (int n = 0; n < 4; ++n) s2[n] = swap16_add(s1[2 * n], s1[2 * n + 1]);
#pragma unroll
    for (int r = 0; r < 4; ++r) { const float z = row_sum16(s2[r]); const bool mine = i16 == ((4 * q + r) & 15);
        zlo = (mine && q < 4) ? z : zlo; zhi = (mine && q >= 4) ? z : zhi; }
}
__device__ __forceinline__ void g_compute_v(const u32x2 (&buf)[GB], int q, float alo, float ahi, f32x2 (&o)[8]) {
    const int areg = __builtin_bit_cast(int, (q < 4) ? alo : ahi), sb = 4 * (q & 3);
#pragma unroll
    for (int j = 0; j < 16; ++j) { const int src = 32 * (j & 1) + 16 * ((j >> 1) & 1) + (j >> 2) + sb;
        const float w = __builtin_bit_cast(float, __builtin_amdgcn_readlane(areg, src));
        axpy16_fp4p(buf[j], w, o); }
}
__device__ __forceinline__ void phase_gather(const Params& P, LAS unsigned char* lds) {
    const int tid = threadIdx.x, lane = tid & 63, wave = __builtin_amdgcn_readfirstlane(tid >> 6);
    const int gw = blockIdx.x * NWAVES + wave, NGW = gridDim.x * NWAVES;
    unsigned char* ws = P.ws;
    const int* IDX = (const int*)(ws + WS_IDX); const float* GATE = (const float*)(ws + WS_GATE); const float* ESC = (const float*)(ws + WS_ESCALE);
    const __amdgpu_buffer_rsrc_t rsU = __builtin_amdgcn_make_buffer_rsrc((void*)(ws + WS_U8), 0, 16384 * 512, 0x00020000);
    const __amdgpu_buffer_rsrc_t rsV = __builtin_amdgcn_make_buffer_rsrc((void*)(ws + WS_V8), 0, 16384 * 512, 0x00020000);
    const bf16* H2B = (const bf16*)(ws + WS_H2B); const float* SSQ = (const float*)(ws + WS_SSQ);
    const int hh = lane >> 5, rr = (lane >> 4) & 1, i16 = lane & 15, gsel = 4 * i16 + 2 * rr + hh;
    const int voff = 8 * lane;
    int t = gw;
    if (t < NTOK) {
        int idx0, idx1; u32x2 hraw[4]; float sqv;
        { const int* ip = IDX + (size_t)t * NSEL; idx0 = ip[lane]; idx1 = ip[64 + lane];
          const u32x2* hp = (const u32x2*)(H2B + (size_t)t * DM);
#pragma unroll
          for (int j = 0; j < 4; ++j) hraw[j] = hp[64 * j + lane];
          sqv = (lane < 16) ? (SSQ + (size_t)t * 16)[lane] : 0.f; }
        u32x2 bufA[GB], bufB[GB];
        g_issue(bufA, rsU, idx0, 0, voff);
        for (;;) {
            const int tn = t + NGW; const bool has_next = tn < NTOK; const int tl = has_next ? tn : t;
            int idx0n, idx1n; u32x2 hrawn[4]; float sqn, g0, g1;
            { const int* ip = IDX + (size_t)tl * NSEL; idx0n = ip[lane]; idx1n = ip[64 + lane];
              const u32x2* hp = (const u32x2*)(H2B + (size_t)tl * DM);
#pragma unroll
              for (int j = 0; j < 4; ++j) hrawn[j] = hp[64 * j + lane];
              sqn = (lane < 16) ? (SSQ + (size_t)tl * 16)[lane] : 0.f;
              const float* gp = GATE + (size_t)t * NSEL; g0 = gp[lane]; g1 = gp[64 + lane]; }
            const float su0 = ESC[idx0], su1 = ESC[idx1], sv0 = ESC[16384 + idx0], sv1 = ESC[16384 + idx1];
            const float rstd2 = rsqrtf(wave_sum_fast(sqv) * (1.f / DM) + EPS);
            f32x2 xp[8];
#pragma unroll
            for (int j = 0; j < 4; ++j) { xp[2 * j] = (f32x2){bflo(hraw[j].x), bfhi(hraw[j].x)}; xp[2 * j + 1] = (f32x2){bflo(hraw[j].y), bfhi(hraw[j].y)}; }
            float zlo = 0.f, zhi = 0.f;
#pragma unroll 1
            for (int q = 0; q < 8; q += 2) {
                g_issue(bufB, rsU, (q + 1 < 4) ? idx0 : idx1, 16 * ((q + 1) & 3), voff);
                g_compute_u(bufA, q, i16, xp, zlo, zhi);
                if (q + 2 < 8) g_issue(bufA, rsU, (q + 2 < 4) ? idx0 : idx1, 16 * ((q + 2) & 3), voff); else g_issue(bufA, rsV, idx0, 0, voff);
                g_compute_u(bufB, q + 1, i16, xp, zlo, zhi);
            }
            const float glo = __shfl(g0, gsel), ghi = __shfl(g1, gsel), sulo = __shfl(su0, gsel), suhi = __shfl(su1, gsel), svlo = __shfl(sv0, gsel), svhi = __shfl(sv1, gsel);
            const float alo = gelu_tanh_f(zlo * rstd2 * sulo) * glo * svlo, ahi = gelu_tanh_f(zhi * rstd2 * suhi) * ghi * svhi;
            f32x2 o[8];
#pragma unroll
            for (int j = 0; j < 8; ++j) o[j] = (f32x2){0.f, 0.f};
#pragma unroll 1
            for (int q = 0; q < 8; q += 2) {
                g_issue(bufB, rsV, (q + 1 < 4) ? idx0 : idx1, 16 * ((q + 1) & 3), voff);
                g_compute_v(bufA, q, alo, ahi, o);
                if (q + 2 < 8) g_issue(bufA, rsV, (q + 2 < 4) ? idx0 : idx1, 16 * ((q + 2) & 3), voff); else if (has_next) g_issue(bufA, rsU, idx0n, 0, voff);
                g_compute_v(bufB, q + 1, alo, ahi, o);
            }
            float ss = 0.f;
#pragma unroll
            for (int j = 0; j < 8; ++j) { o[j] += xp[j]; ss += o[j].x * o[j].x + o[j].y * o[j].y; }
            ss = wave_sum_fast(ss);
            const float r3 = rsqrtf(ss * (1.f / DM) + EPS);
            f32x4* op = (f32x4*)(P.out + (size_t)t * DM);
            const f32x4* gfp = (const f32x4*)P.g_fin;
#pragma unroll
            for (int j = 0; j < 4; ++j) { const f32x4 gv = gfp[64 * j + lane]; op[64 * j + lane] = (f32x4){o[2 * j].x * r3 * gv.x, o[2 * j].y * r3 * gv.y, o[2 * j + 1].x * r3 * gv.z, o[2 * j + 1].y * r3 * gv.w}; }
            if (!has_next) break;
            t = tn; idx0 = idx0n; idx1 = idx1n; sqv = sqn;
#pragma unroll
            for (int j = 0; j < 4; ++j) hraw[j] = hrawn[j];
        }
    }
}

#define XB_TMO      128
#define XB_XCNT(j)  (256  + 64 * (j))
#define XB_XSUB(j)  (1280 + 64 * (j))
#define XB_XGEN(j)  (2304 + 64 * (j))
#define XB_TOP      3328
#define XB_TOPGEN   3392
#define XCD_BAR_WORDS 3456
#define XB_SPIN_CAP (1u << 18)

__device__ __forceinline__ unsigned xb_ld(unsigned* p)              { return __hip_atomic_load(p, __ATOMIC_RELAXED, __HIP_MEMORY_SCOPE_AGENT); }
__device__ __forceinline__ unsigned xb_add(unsigned* p, unsigned v) { return __hip_atomic_fetch_add(p, v, __ATOMIC_RELAXED, __HIP_MEMORY_SCOPE_AGENT); }
__device__ __forceinline__ unsigned xb_xcc_id() { return (unsigned)__builtin_amdgcn_s_getreg((3 << 11) | 20) & 0xFu; }
#define XB_SPIN(cond, bar) do { unsigned _sp = 0; while (cond) { __builtin_amdgcn_s_sleep(1); \
    if ((++_sp & 255u) == 0u) { if (xb_ld(&(bar)[XB_TMO])) break; if (_sp > XB_SPIN_CAP) { atomicAdd(&(bar)[XB_TMO], 1u); break; } } } } while (0)

struct XcdBarrier {
    unsigned* bar; unsigned x;
    volatile LAS unsigned* st;
};

__device__ __forceinline__ XcdBarrier xcd_barrier_post(unsigned* bar, volatile LAS unsigned* st) {
    XcdBarrier b; b.bar = bar; b.x = xb_xcc_id(); b.st = st;
    if (threadIdx.x == 0) (void)xb_add(&bar[XB_XCNT(b.x)], 1u);
    return b;
}
__device__ __forceinline__ void xcd_barrier_complete(unsigned* bar, unsigned x, unsigned& nloc, unsigned& nx) {
    const unsigned G = gridDim.x * gridDim.y * gridDim.z;
    unsigned sum, cnt, mine, sp = 0u;
    for (;;) {
        sum = 0u; cnt = 0u; mine = 0u;
#pragma unroll
        for (unsigned j = 0; j < 16; ++j) { const unsigned c = xb_ld(&bar[XB_XCNT(j)]); sum += c; cnt += (c > 0u) ? 1u : 0u; mine = (j == x) ? c : mine; }
        if (sum == G) break;
        __builtin_amdgcn_s_sleep(1);
        if ((++sp & 255u) == 0u) { if (xb_ld(&bar[XB_TMO])) break; if (sp > XB_SPIN_CAP) { atomicAdd(&bar[XB_TMO], 1u); break; } }
    }
    nloc = mine > 0u ? mine : 1u; nx = cnt > 0u ? cnt : 1u;
}

__device__ __forceinline__ void xcd_barrier(const XcdBarrier& b) {
    asm volatile("s_waitcnt vmcnt(0)" ::: "memory");
    __syncthreads();
    if (threadIdx.x == 0) {
        unsigned* bar = b.bar;
        __builtin_amdgcn_s_waitcnt(0);
        unsigned nloc = b.st[0], nx = b.st[1];
        if (nloc == 0u) { xcd_barrier_complete(bar, b.x, nloc, nx); b.st[0] = nloc; b.st[1] = nx; }
        const unsigned old = xb_add(&bar[XB_XSUB(b.x)], 1u);
        const unsigned gen = old / nloc;
        if (old + 1u == (gen + 1u) * nloc) {
            __builtin_amdgcn_fence(__ATOMIC_RELEASE, "agent");
            asm volatile("s_waitcnt vmcnt(0)" ::: "memory");
            const unsigned og = xb_add(&bar[XB_TOP], 1u);
            const unsigned tg = og / nx;
            if (og + 1u == (tg + 1u) * nx) xb_add(&bar[XB_TOPGEN], 1u);
            else XB_SPIN(xb_ld(&bar[XB_TOPGEN]) == tg, bar);
            __builtin_amdgcn_fence(__ATOMIC_ACQUIRE, "agent");
            xb_add(&bar[XB_XGEN(b.x)], 1u);
            asm volatile("s_waitcnt vmcnt(0)" ::: "memory");
        } else {
            XB_SPIN(xb_ld(&bar[XB_XGEN(b.x)]) == gen, bar);
            __builtin_amdgcn_fence(__ATOMIC_ACQUIRE, "agent");
            asm volatile("s_waitcnt vmcnt(0)" ::: "memory");
        }
    }
    __syncthreads();
}


#ifndef MK_MULTI
#define MK_MULTI 0
#endif
constexpr int NPHASE = 7;
#ifndef REP5
#define REP5 1
#endif
#ifndef REP6
#define REP6 1
#endif
__global__ void __launch_bounds__(NTHREADS, 2) mk_fwd(Params P) {
    extern __shared__ __attribute__((aligned(16))) unsigned char lds_raw[];
    LAS unsigned char* lds = (LAS unsigned char*)lds_raw;
    cg::grid_group grid = cg::this_grid();
    unsigned char* ws = P.ws;
    const int lo = P.ph_lo, hi = P.ph_hi;
    volatile LAS unsigned* bst = (volatile LAS unsigned*)(lds + 131072 + 64);
    if (threadIdx.x < 2) bst[threadIdx.x] = 0u;
    __syncthreads();
    XcdBarrier xbar = xcd_barrier_post((unsigned*)(ws + WS_CTL), bst);
#define IN(k) (lo <= (k) && (k) < hi)
#define SEAM(k) do { if (IN(k) && IN((k) + 1)) { xcd_barrier(xbar); } } while (0)
#ifndef SKIP0
    if (IN(0)) phase_prep(P, lds);
#endif
    SEAM(0);
#ifndef SKIP1
    if (IN(1)) {
        phase_metaproj(P);
        pg8::Gemm g{(const bf16*)(ws + WS_H0B), (const bf16*)(ws + WS_WIN_T), NTOK, DIN, DM}; pg8::StaticOrder S; S.init(NTOK, DIN, (int)gridDim.x, (int)blockIdx.x);
        EpiProj E{(bf16*)(ws + WS_PROJ), (const float*)(ws + WS_RSTD1)};
        pg8::gemm_phase<EpiProj, pg8::StaticOrder, true, true>(lds, g, S, E);
    }
#endif
    SEAM(1);
#ifndef SKIP2
    if (IN(2)) phase_conv(P, lds);
#endif
    SEAM(2);
#ifndef SKIP3
    if (IN(3)) {
        pg8::Gemm g{(const bf16*)(ws + WS_Y), (const bf16*)(ws + WS_WOUT_T), NTOK, DM, DM}; pg8::StaticOrder S; S.init(NTOK, DM, (int)gridDim.x, (int)blockIdx.x);
        EpiResidual E{(bf16*)(ws + WS_H2B), (const bf16*)(ws + WS_H0B), (float*)(ws + WS_SSQ)};
        pg8::gemm_phase<EpiResidual, pg8::StaticOrder, true, true>(lds, g, S, E);
    }
#endif
    SEAM(3);
#ifndef SKIP4
    if (IN(4)) {
        pg8::Gemm g{(const bf16*)(ws + WS_H2B), (const bf16*)(ws + WS_WQ_T), NTOK, 2048, DM}; pg8::StaticOrder S; S.init(NTOK, 2048, (int)gridDim.x, (int)blockIdx.x);
        EpiRowScale<1> E{(bf16*)(ws + WS_Q), 2048, (const float*)(ws + WS_SSQ)};
        pg8::gemm_phase<EpiRowScale<1>, pg8::StaticOrder, true, true>(lds, g, S, E);
    }
#endif
    SEAM(4);
#ifndef SKIP5
    if (IN(5)) for (int rep = 0; rep < REP5; ++rep) phase_route(P, lds);
#endif
    SEAM(5);
    if (IN(6)) phase_gather(P, lds);
#undef IN
#undef SEAM
}

extern "C" void kernel_launch(void* const* d_in, const int* in_sizes, int n_in, void* d_out, int out_size, void* d_ws, size_t ws_size, hipStream_t stream) {
    static int grid = 0;
    if (grid == 0) {
        if (n_in != 18 || in_sizes[0] != NTOK * DM || out_size != NTOK * DM || ws_size < WS_END) {
            fprintf(stderr, "kernel_launch: unexpected shapes (n_in %d in0 %d out %d ws %zu)\n", n_in, n_in > 0 ? in_sizes[0] : -1, out_size, ws_size); grid = -1; return; }
        int dev = 0, cus = 0, per_cu = 0;
        (void)hipGetDevice(&dev); (void)hipDeviceGetAttribute(&cus, hipDeviceAttributeMultiprocessorCount, dev);
        if (hipFuncSetAttribute((const void*)mk_fwd, hipFuncAttributeMaxDynamicSharedMemorySize, LDS_BYTES) != hipSuccess) { fprintf(stderr, "kernel_launch: hipFuncSetAttribute failed\n"); grid = -1; return; }
        if (hipOccupancyMaxActiveBlocksPerMultiprocessor(&per_cu, (const void*)mk_fwd, NTHREADS, LDS_BYTES) != hipSuccess || per_cu < 1) { fprintf(stderr, "kernel_launch: occupancy query failed (%d)\n", per_cu); (void)hipGetLastError(); per_cu = 1; }
        if (per_cu > 1) per_cu = 1;
        grid = cus * per_cu;
        if (grid <= 0) grid = 256;
    }
    if (grid < 0) return;
    Params p{};
    p.x = (const float*)d_in[0]; p.meta = (const float*)d_in[1]; p.g_mix = (const float*)d_in[2]; p.w_in = (const float*)d_in[3]; p.sc_w = (const float*)d_in[4];
    p.cf_w = (const float*)d_in[5]; p.cf_b = (const float*)d_in[6]; p.ln_g = (const float*)d_in[7]; p.ln_b = (const float*)d_in[8]; p.g_sc = (const float*)d_in[9];
    p.g_cf = (const float*)d_in[10]; p.w_out = (const float*)d_in[11]; p.g_ffn = (const float*)d_in[12]; p.w_q = (const float*)d_in[13]; p.keys = (const float*)d_in[14];
    p.pu = (const float*)d_in[15]; p.pv = (const float*)d_in[16]; p.g_fin = (const float*)d_in[17];
    p.out = (float*)d_out; p.ws = (unsigned char*)d_ws;
    (void)hipMemsetAsync((char*)d_ws + WS_CTL, 0, 16384, stream);
#if MK_MULTI
    for (int ph = 0; ph < NPHASE; ++ph) { p.ph_lo = ph; p.ph_hi = ph + 1; p.coop = 0; p.pad = 0;
        hipLaunchKernelGGL(mk_fwd, dim3(grid), dim3(NTHREADS), LDS_BYTES, stream, p); }
#else
    p.ph_lo = 0; p.ph_hi = NPHASE; p.coop = 1; p.pad = 0;
    void* args[] = {&p};
    hipError_t e = hipLaunchCooperativeKernel((const void*)mk_fwd, dim3(grid), dim3(NTHREADS), args, LDS_BYTES, stream);
    if (e != hipSuccess) fprintf(stderr, "cooperative launch failed: %s (grid %d)\n", hipGetErrorString(e), grid);
#endif
}
```

```cpp
#include <hip/hip_runtime.h>
#include <hip/hip_cooperative_groups.h>
#include <cstdio>
#include <cstdint>
namespace cg = cooperative_groups;

namespace pg8 {
#define PG8_LAS __attribute__((address_space(3)))
typedef unsigned short bf16_t;
typedef short bf16x8 __attribute__((ext_vector_type(8)));
typedef float f32x4 __attribute__((ext_vector_type(4)));
typedef unsigned u32x4 __attribute__((ext_vector_type(4)));
constexpr int BM = 256, BK = 64, HALF = 128, HTB = HALF * BK * 2  , STAGE_BYTES = 8 * HTB, NXCD = 8, WGM = 8;

__host__ __device__ __forceinline__ int lds_byte(int r, int c) { const int st = (r >> 4) * 2 + (c >> 5), rr = r & 15, cc = c & 31, ob = rr * 64 + cc * 2; return st * 1024 + (ob ^ (((ob >> 9) & 1) << 5)); }
__host__ __device__ __forceinline__ void stage_rc(int b, int& R, int& C) { const int st = b / 1024, sb = b % 1024, swz = sb ^ (((sb >> 9) & 1) << 5); R = (st >> 1) * 16 + swz / 64; C = (st & 1) * 32 + (swz % 64) / 2; }
__host__ __device__ __forceinline__ int perm32(int rho) { const int n = rho >> 4, i = rho & 15; return 8 * (i >> 2) + 4 * n + (i & 3); }

struct Unit { int pm, pn; };
struct Gemm { const bf16_t* A; const bf16_t* Bt; int M, N, K; };

struct StaticOrder {
    int nM, nN, nwg, G, c;
    __host__ __device__ void init(int M, int N, int G_, int c_) { nM = M / BM; nN = N / BM; nwg = nM * nN; G = G_; c = c_; }
    __host__ __device__ bool next(int i, Unit& u) const {
        const long L = (long)i * G + c; if (L >= nwg) return false;
        int wgid = (int)L; { const int q = nwg / NXCD, r = nwg % NXCD, xcd = wgid % NXCD, off = wgid / NXCD; wgid = (xcd < r ? xcd * (q + 1) : r * (q + 1) + (xcd - r) * q) + off; }
        const int nig = WGM * nN, gid = wgid / nig, fm = gid * WGM, gsz = (nM - fm) < WGM ? (nM - fm) : WGM;
        u.pm = fm + ((wgid % nig) % gsz); u.pn = (wgid % nig) / gsz; return true;
    }
    __device__ __forceinline__ void a_ready(const Unit&) const {}
    __device__ __forceinline__ void done(const Unit&) const {}
};

template <class Epi, class Sched, bool ALIGN_EPI = false, bool SP2 = false>
__device__ __forceinline__ void gemm_phase(PG8_LAS unsigned char* lds, const Gemm g, const Sched& S, const Epi& E) {
    const int tid = threadIdx.x, wid = __builtin_amdgcn_readfirstlane(tid >> 6), lane = tid & 63, wr = wid >> 2, wc = wid & 3, fr = lane & 15, fq = lane >> 4;
    const int K = g.K, nt = K / BK;
    unsigned voffA[2], voffB[2];
#pragma unroll
    for (int i = 0; i < 2; ++i) { int R, C; stage_rc(tid * 16 + i * 8192, R, C); const int Rb = Epi::PERM ? ((R & ~31) + perm32(R & 31)) : R;
        voffA[i] = (unsigned)(R * K + C) * 2u; voffB[i] = (unsigned)(Rb * K + C) * 2u; }
    const size_t kstep = (size_t)(BK * 2);
    const size_t hstep = (size_t)HALF * K * 2;
    const size_t tstep = 2 * hstep;
    const unsigned ldsw = (unsigned)wid * 1024u;
    const int aoff = lds_byte(wr * 64 + fr, fq * 8), boff = lds_byte(wc * 32 + fr, fq * 8);
#define PG8_SA(b, h) (((b) * 2 + (h)) * HTB)
#define PG8_SB(b, h) ((4 + (b) * 2 + (h)) * HTB)
#define PG8_STAGE(bufoff, gbase, voff) do { _Pragma("unroll") for (int _i = 0; _i < 2; ++_i) \
        __builtin_amdgcn_global_load_lds((const unsigned*)((const char*)(gbase) + (voff)[_i]), (PG8_LAS unsigned*)(lds + (bufoff) + ldsw + _i * 8192), 16, 0, 0); } while (0)
#define PG8_LDA(dst, b, h) do { _Pragma("unroll") for (int m = 0; m < 4; ++m) _Pragma("unroll") for (int k = 0; k < 2; ++k) dst[m][k] = *(const PG8_LAS bf16x8*)(lds + PG8_SA(b, h) + aoff + m * 2048 + k * 1024); } while (0)
#define PG8_LDB(dst, b, h) do { _Pragma("unroll") for (int n = 0; n < 2; ++n) _Pragma("unroll") for (int k = 0; k < 2; ++k) dst[n][k] = *(const PG8_LAS bf16x8*)(lds + PG8_SB(b, h) + boff + n * 2048 + k * 1024); } while (0)
#define PG8_MMA(ai, bj, At, Bt) do { __builtin_amdgcn_s_setprio(1); _Pragma("unroll") for (int m = 0; m < 4; ++m) _Pragma("unroll") for (int n = 0; n < 2; ++n) _Pragma("unroll") for (int k = 0; k < 2; ++k) \
        acc[ai][bj][m][n] = __builtin_amdgcn_mfma_f32_16x16x32_bf16(Bt[n][k], At[m][k], acc[ai][bj][m][n], 0, 0, 0); __builtin_amdgcn_s_setprio(0); } while (0)
#define PG8_WAIT_V(n) asm volatile("s_waitcnt vmcnt(" #n ")" ::: "memory")
#define PG8_WAIT_L(n) asm volatile("s_waitcnt lgkmcnt(" #n ")" ::: "memory")
#define PG8_BAR __builtin_amdgcn_s_barrier()
#define PG8_SCHED __builtin_amdgcn_sched_barrier(0)
    Unit cur, nxt; int ui = 0;
    if (!S.next(0, cur)) return;
    f32x4 acc[2][2][4][2];
#pragma unroll
    for (int a = 0; a < 2; ++a)
#pragma unroll
        for (int b = 0; b < 2; ++b)
#pragma unroll
            for (int m = 0; m < 4; ++m)
#pragma unroll
                for (int n = 0; n < 2; ++n) acc[a][b][m][n] = (f32x4){0.f, 0.f, 0.f, 0.f};
    bf16x8 At[4][2], B0[2][2], B1[2][2];
    const char* cA = (const char*)g.A + (size_t)cur.pm * tstep; const char* cB = (const char*)g.Bt + (size_t)cur.pn * tstep;
    S.a_ready(cur);
    if constexpr (SP2) {
        PG8_STAGE(PG8_SB(0, 0), cB, voffB); PG8_STAGE(PG8_SB(0, 1), cB + hstep, voffB); PG8_STAGE(PG8_SA(0, 0), cA, voffA); PG8_STAGE(PG8_SA(0, 1), cA + hstep, voffA);
        if (wr == 1) PG8_BAR;
        PG8_WAIT_V(2); PG8_BAR;
        PG8_STAGE(PG8_SB(1, 0), cB + kstep, voffB); PG8_STAGE(PG8_SA(1, 0), cA + kstep, voffA); PG8_STAGE(PG8_SB(1, 1), cB + hstep + kstep, voffB);
        PG8_WAIT_V(6); PG8_BAR;
    } else {
        PG8_STAGE(PG8_SB(0, 0), cB, voffB); PG8_STAGE(PG8_SA(0, 0), cA, voffA); PG8_STAGE(PG8_SB(0, 1), cB + hstep, voffB); PG8_STAGE(PG8_SA(0, 1), cA + hstep, voffA);
        if (wr == 1) PG8_BAR;
        PG8_WAIT_V(4); PG8_BAR;
        PG8_STAGE(PG8_SB(1, 0), cB + kstep, voffB); PG8_STAGE(PG8_SA(1, 0), cA + kstep, voffA); PG8_STAGE(PG8_SB(1, 1), cB + hstep + kstep, voffB);
        PG8_WAIT_V(6); PG8_BAR;
    }
    for (;;) {
        const bool has_next = S.next(ui + 1, nxt);
        const char* nA = has_next ? (const char*)g.A + (size_t)nxt.pm * tstep : cA; const char* nB = has_next ? (const char*)g.Bt + (size_t)nxt.pn * tstep : cB;
        for (int t = 0; t < nt; t += 2) {
            const bool last = (t == nt - 2);
            const char* a1 = cA + (size_t)(t + 1) * kstep;
            const char* a2 = last ? nA : cA + (size_t)(t + 2) * kstep; const char* b2 = last ? nB : cB + (size_t)(t + 2) * kstep;
            const char* a3 = a2 + kstep; const char* b3 = b2 + kstep;
            if (last && has_next) S.a_ready(nxt);
            if constexpr (SP2) {
            PG8_LDB(B0, 0, 0); PG8_LDB(B1, 0, 1); PG8_SCHED; PG8_LDA(At, 0, 0); PG8_STAGE(PG8_SA(1, 1), a1 + hstep, voffA);
            PG8_WAIT_V(8); PG8_WAIT_L(0); PG8_BAR; PG8_MMA(0, 0, At, B0); PG8_MMA(0, 1, At, B1); PG8_BAR; PG8_SCHED;
            PG8_LDA(At, 0, 1); PG8_STAGE(PG8_SB(0, 0), b2, voffB); PG8_STAGE(PG8_SB(0, 1), b2 + hstep, voffB); PG8_STAGE(PG8_SA(0, 0), a2, voffA);
            PG8_WAIT_V(8); PG8_WAIT_L(0); PG8_BAR; PG8_MMA(1, 0, At, B0); PG8_MMA(1, 1, At, B1); PG8_BAR; PG8_SCHED;
            PG8_LDB(B0, 1, 0); PG8_LDB(B1, 1, 1); PG8_SCHED; PG8_LDA(At, 1, 0); PG8_STAGE(PG8_SA(0, 1), a2 + hstep, voffA);
            PG8_WAIT_V(8); PG8_WAIT_L(0); PG8_BAR; PG8_MMA(0, 0, At, B0); PG8_MMA(0, 1, At, B1); PG8_BAR; PG8_SCHED;
            PG8_LDA(At, 1, 1); PG8_STAGE(PG8_SB(1, 0), b3, voffB); PG8_STAGE(PG8_SB(1, 1), b3 + hstep, voffB); PG8_STAGE(PG8_SA(1, 0), a3, voffA);
            PG8_WAIT_V(8); PG8_WAIT_L(0); PG8_BAR; PG8_MMA(1, 0, At, B0); PG8_MMA(1, 1, At, B1); PG8_BAR; PG8_SCHED;
            } else {
            PG8_LDB(B0, 0, 0); PG8_SCHED; PG8_LDA(At, 0, 0); PG8_STAGE(PG8_SA(1, 1), a1 + hstep, voffA);
            PG8_WAIT_L(8); PG8_BAR; PG8_WAIT_L(0); PG8_MMA(0, 0, At, B0); PG8_BAR; PG8_SCHED;
            PG8_LDB(B1, 0, 1); PG8_STAGE(PG8_SB(0, 0), b2, voffB);
            PG8_BAR; PG8_WAIT_L(0); PG8_MMA(0, 1, At, B1); PG8_BAR;
            PG8_LDA(At, 0, 1); PG8_STAGE(PG8_SA(0, 0), a2, voffA);
            PG8_BAR; PG8_WAIT_L(0); PG8_MMA(1, 0, At, B0); PG8_BAR; PG8_SCHED;
            PG8_STAGE(PG8_SB(0, 1), b2 + hstep, voffB);
            PG8_WAIT_V(6); PG8_BAR; PG8_MMA(1, 1, At, B1); PG8_BAR;
            PG8_LDB(B0, 1, 0); PG8_SCHED; PG8_LDA(At, 1, 0); PG8_STAGE(PG8_SA(0, 1), a2 + hstep, voffA);
            PG8_WAIT_L(8); PG8_BAR; PG8_WAIT_L(0); PG8_MMA(0, 0, At, B0); PG8_BAR; PG8_SCHED;
            PG8_LDB(B1, 1, 1); PG8_STAGE(PG8_SB(1, 0), b3, voffB);
            PG8_BAR; PG8_WAIT_L(0); PG8_MMA(0, 1, At, B1); PG8_BAR;
            PG8_LDA(At, 1, 1); PG8_STAGE(PG8_SA(1, 0), a3, voffA);
            PG8_BAR; PG8_WAIT_L(0); PG8_MMA(1, 0, At, B0); PG8_BAR; PG8_SCHED;
            PG8_STAGE(PG8_SB(1, 1), b3 + hstep, voffB);
            PG8_WAIT_V(6); PG8_BAR; PG8_MMA(1, 1, At, B1); PG8_BAR;
            }
        }
        if constexpr (ALIGN_EPI) { if (wr == 0) PG8_BAR; }
        if constexpr (!Epi::AFTER_DRAIN) { E(acc, cur, wr, wc, fr, fq); S.done(cur); }
        if (!has_next) break;
#pragma unroll
        for (int a = 0; a < 2; ++a)
#pragma unroll
            for (int b = 0; b < 2; ++b)
#pragma unroll
                for (int m = 0; m < 4; ++m)
#pragma unroll
                    for (int n = 0; n < 2; ++n) acc[a][b][m][n] = (f32x4){0.f, 0.f, 0.f, 0.f};
        cur = nxt; cA = nA; cB = nB; ++ui;
        if constexpr (ALIGN_EPI) { if (wr == 1) PG8_BAR; }
    }
    PG8_WAIT_V(0);
    if constexpr (!ALIGN_EPI) { if (wr == 0) PG8_BAR; }
    PG8_BAR;
    if constexpr (Epi::AFTER_DRAIN) { E.fused(acc, cur, wr, wc, fr, fq, lds, wid, lane); S.done(cur); }
#undef PG8_SA
#undef PG8_SB
#undef PG8_STAGE
#undef PG8_LDA
#undef PG8_LDB
#undef PG8_MMA
#undef PG8_WAIT_V
#undef PG8_WAIT_L
#undef PG8_BAR
#undef PG8_SCHED
}
}

#define LAS __attribute__((address_space(3)))
typedef unsigned short bf16;
typedef float f32x2 __attribute__((ext_vector_type(2)));
typedef float f32x4 __attribute__((ext_vector_type(4)));
typedef unsigned u32x2 __attribute__((ext_vector_type(2)));
typedef unsigned u32x4 __attribute__((ext_vector_type(4)));

constexpr int PDIM = 1536;
constexpr int NTOK = 32768, DM = 1024, DIN = 2560, SEQ = 8192, NBATCH = 4, NMETA = 16;
constexpr int NHEAD = 8, NKEYS = 128, TOPK = 16, NSEL = NHEAD * TOPK;
constexpr float EPS = 1e-6f;
constexpr float U_SCALE = 64.f, V_SCALE = 16.f;
constexpr int NWAVES = 8, NTHREADS = 512;
constexpr int MKC = 32;
constexpr int LDS_BYTES = 147456;

constexpr size_t MiB = 1u << 20;
constexpr size_t WS_CTL = 0, WS_WIN_T = 1 * MiB, WS_WOUT_T = 6 * MiB, WS_WQ_T = 8 * MiB, WS_KEYS = 12 * MiB, WS_METAPART = 160 * MiB  ,
                 WS_METARSTD = 14 * MiB + 512 * 1024, WS_METAPROJ = 14 * MiB + 576 * 1024, WS_RSTD1 = 15 * MiB, WS_SSQ = 16 * MiB, WS_U8 = 32 * MiB, WS_V8 = 48 * MiB,
                 WS_IDX = 64 * MiB, WS_GATE = 80 * MiB, WS_H0B = 96 * MiB, WS_H2B = 96 * MiB, WS_Y = 160 * MiB, WS_PROJ = 224 * MiB,
                 WS_Q = 224 * MiB, WS_ESCALE = 18 * MiB, WS_AW = 160 * MiB  , WS_END = 384 * MiB;

struct Params {
    const float* x; const float* meta; const float* g_mix; const float* w_in; const float* sc_w; const float* cf_w; const float* cf_b;
    const float* ln_g; const float* ln_b; const float* g_sc; const float* g_cf; const float* w_out; const float* g_ffn; const float* w_q;
    const float* keys; const float* pu; const float* pv; const float* g_fin;
    float* out; unsigned char* ws;
    int ph_lo, ph_hi, coop, pad;
};

__device__ __forceinline__ unsigned f2bf(float f) { unsigned u = __builtin_bit_cast(unsigned, f); return (u + 0x7fffu + ((u >> 16) & 1u)) >> 16; }
__device__ __forceinline__ unsigned pk2(float lo, float hi) { return f2bf(lo) | (f2bf(hi) << 16); }
__device__ __forceinline__ float bf2f(unsigned b) { return __builtin_bit_cast(float, b << 16); }
__device__ __forceinline__ float bflo(unsigned w) { return __builtin_bit_cast(float, w << 16); }
__device__ __forceinline__ float bfhi(unsigned w) { return __builtin_bit_cast(float, w & 0xffff0000u); }
__device__ __forceinline__ float wave_sum(float v) {
#pragma unroll
    for (int o = 1; o < 64; o <<= 1) v += __shfl_xor(v, o);
    return v;
}
template <int CTRL> __device__ __forceinline__ float dpp_f(float v) { return __builtin_bit_cast(float, __builtin_amdgcn_update_dpp(0, __builtin_bit_cast(int, v), CTRL, 0xf, 0xf, true)); }
__device__ __forceinline__ float wave_sum_fast(float v) {
    v += dpp_f<0xB1>(v); v += dpp_f<0x4E>(v); v += dpp_f<0x141>(v); v += dpp_f<0x140>(v);
    { auto r = __builtin_amdgcn_permlane16_swap(__float_as_uint(v), __float_as_uint(v), false, false); v = __uint_as_float(r[0]) + __uint_as_float(r[1]); }
    { auto r = __builtin_amdgcn_permlane32_swap(__float_as_uint(v), __float_as_uint(v), false, false); v = __uint_as_float(r[0]) + __uint_as_float(r[1]); }
    return v;
}
__device__ __forceinline__ float sigmoid_f(float x) { return 1.f / (1.f + __expf(-x)); }
__device__ __forceinline__ float gelu_tanh_f(float x) {
    const float t = 0.7978845608028654f * (x + 0.044715f * x * x * x);
    const float e = __expf(2.f * t);
    const float th = 1.f - 2.f / (e + 1.f);
    return 0.5f * x * (1.f + th);
}

__device__ __forceinline__ unsigned cvt_pk_bf16(float lo, float hi) { unsigned r; asm volatile("v_cvt_pk_bf16_f32 %0, %1, %2" : "=v"(r) : "v"(lo), "v"(hi)); return r; }

template <int MODE> struct EpiRowScale {
    static constexpr bool PERM = true, AFTER_DRAIN = false;
    bf16* O; int ldc; const float* rs;
    __device__ __forceinline__ void operator()(const pg8::f32x4 (&acc)[2][2][4][2], const pg8::Unit& u, int wr, int wc, int fr, int fq) const {
        const int row0 = u.pm * 256 + wr * 64 + fr, col0 = u.pn * 256 + wc * 32 + 8 * fq;
#pragma unroll
        for (int ai = 0; ai < 2; ++ai)
#pragma unroll
            for (int m = 0; m < 4; ++m) {
                const int row = row0 + ai * 128 + m * 16;
                float s;
                if (MODE == 0) s = rs[row];
                else { const f32x4* p = (const f32x4*)(rs + (size_t)row * 16); const f32x4 a = p[0], b = p[1], c = p[2], d = p[3];
                       const float t = ((a.x + a.y) + (a.z + a.w)) + ((b.x + b.y) + (b.z + b.w)) + ((c.x + c.y) + (c.z + c.w)) + ((d.x + d.y) + (d.z + d.w));
                       s = rsqrtf(t * (1.f / 1024.f) + EPS); }
                bf16* rowp = O + (size_t)row * ldc + col0;
#pragma unroll
                for (int bj = 0; bj < 2; ++bj) { const pg8::f32x4 v0 = acc[ai][bj][m][0] * s, v1 = acc[ai][bj][m][1] * s;
                    u32x4 w; w.x = cvt_pk_bf16(v0[0], v0[1]); w.y = cvt_pk_bf16(v0[2], v0[3]); w.z = cvt_pk_bf16(v1[0], v1[1]); w.w = cvt_pk_bf16(v1[2], v1[3]);
                    *(u32x4*)(rowp + bj * 128) = w; }
            }
    }
};
struct EpiProj {
    static constexpr bool PERM = true, AFTER_DRAIN = false;
    bf16* O; const float* rs;
    __device__ __forceinline__ void operator()(const pg8::f32x4 (&acc)[2][2][4][2], const pg8::Unit& u, int wr, int wc, int fr, int fq) const {
        const int row0 = u.pm * 256 + wr * 64 + fr, cin = wc * 32 + 8 * fq, pn = u.pn;
#pragma unroll
        for (int ai = 0; ai < 2; ++ai)
#pragma unroll
            for (int m = 0; m < 4; ++m) {
                const int row = row0 + ai * 128 + m * 16; const float sc = rs[row];
                float a[8], b[8];
#pragma unroll
                for (int i = 0; i < 4; ++i) { a[i] = acc[ai][0][m][0][i] * sc; a[4 + i] = acc[ai][0][m][1][i] * sc; b[i] = acc[ai][1][m][0][i] * sc; b[4 + i] = acc[ai][1][m][1][i] * sc; }
                bf16* rowp = O + (size_t)row * PDIM;
                if (pn >= 4 && pn < 6) {
                    u32x4 w0, w1; w0.x = cvt_pk_bf16(a[0], a[1]); w0.y = cvt_pk_bf16(a[2], a[3]); w0.z = cvt_pk_bf16(a[4], a[5]); w0.w = cvt_pk_bf16(a[6], a[7]);
                    w1.x = cvt_pk_bf16(b[0], b[1]); w1.y = cvt_pk_bf16(b[2], b[3]); w1.z = cvt_pk_bf16(b[4], b[5]); w1.w = cvt_pk_bf16(b[6], b[7]);
                    *(u32x4*)(rowp + 512 + 256 * (pn - 4) + cin) = w0; *(u32x4*)(rowp + 512 + 256 * (pn - 4) + 128 + cin) = w1;
                } else {
                    float o[8];
                    if (pn < 4) {
#pragma unroll
                        for (int i = 0; i < 8; ++i) o[i] = a[i] * b[i];
                    } else {
#pragma unroll
                        for (int i = 0; i < 8; ++i) o[i] = a[i] * sigmoid_f(b[i]);
                    }
                    u32x4 w; w.x = cvt_pk_bf16(o[0], o[1]); w.y = cvt_pk_bf16(o[2], o[3]); w.z = cvt_pk_bf16(o[4], o[5]); w.w = cvt_pk_bf16(o[6], o[7]);
                    *(u32x4*)(rowp + (pn < 4 ? 128 * pn : 1024 + 128 * (pn - 6)) + cin) = w;
                }
            }
    }
};
__host__ __device__ __forceinline__ int win_src_col(int n) {
    const int t = n >> 8, j = n & 255;
    if (t < 4) return (j < 128) ? 128 * t + j : 1024 + 128 * t + (j - 128);
    if (t < 6) return 512 + 256 * (t - 4) + j;
    return (j < 128) ? 1536 + 128 * (t - 6) + j : 2048 + 128 * (t - 6) + (j - 128);
}
struct EpiResidual {
    static constexpr bool PERM = true, AFTER_DRAIN = false;
    bf16* O; const bf16* XB; float* ssq;
    __device__ __forceinline__ void operator()(const pg8::f32x4 (&acc)[2][2][4][2], const pg8::Unit& u, int wr, int wc, int fr, int fq) const {
        const int row0 = u.pm * 256 + wr * 64 + fr, col0 = u.pn * 256 + wc * 32 + 8 * fq;
#pragma unroll
        for (int ai = 0; ai < 2; ++ai)
#pragma unroll
            for (int m = 0; m < 4; ++m) {
                const int row = row0 + ai * 128 + m * 16;
                const bf16* xr = XB + (size_t)row * DM + col0; bf16* rowp = O + (size_t)row * DM + col0;
                float q = 0.f;
                u32x4 xw[2];
#pragma unroll
                for (int bj = 0; bj < 2; ++bj) xw[bj] = *(const u32x4*)(xr + bj * 128);
#pragma unroll
                for (int bj = 0; bj < 2; ++bj) { const f32x4 x0 = (f32x4){bflo(xw[bj].x), bfhi(xw[bj].x), bflo(xw[bj].y), bfhi(xw[bj].y)}, x1 = (f32x4){bflo(xw[bj].z), bfhi(xw[bj].z), bflo(xw[bj].w), bfhi(xw[bj].w)};
                    const pg8::f32x4 v0 = acc[ai][bj][m][0] + x0, v1 = acc[ai][bj][m][1] + x1;
                    q += (v0[0] * v0[0] + v0[1] * v0[1]) + (v0[2] * v0[2] + v0[3] * v0[3]) + (v1[0] * v1[0] + v1[1] * v1[1]) + (v1[2] * v1[2] + v1[3] * v1[3]);
                    u32x4 w; w.x = cvt_pk_bf16(v0[0], v0[1]); w.y = cvt_pk_bf16(v0[2], v0[3]); w.z = cvt_pk_bf16(v1[0], v1[1]); w.w = cvt_pk_bf16(v1[2], v1[3]);
                    *(u32x4*)(rowp + bj * 128) = w; }
                q += __shfl_xor(q, 16); q += __shfl_xor(q, 32);
                if (fq == 0) ssq[(size_t)row * 16 + u.pn * 4 + wc] = q;
            }
    }
};

template <bool MAPIN> __device__ __forceinline__ void p0_transpose_item(const float* W, int K, int N, bf16* WT, LAS float* scr, int item, int lane,
                                                  const float* g_lo, const float* g_hi, int split) {
    const int nblk = N / 32, kb = item / nblk, nb = item % nblk, k0 = 64 * kb, n0 = 32 * nb;
#pragma unroll 8
    for (int i = 0; i < 32; ++i) { const int kk = 2 * i + (lane >> 5); const int k = k0 + kk;
        const float g = (k < split) ? g_lo[k] : g_hi[k - split];
        scr[kk * 33 + (lane & 31)] = W[(size_t)k * N + (MAPIN ? win_src_col(n0) : n0) + (lane & 31)] * g; }
    asm volatile("s_waitcnt lgkmcnt(0)" ::: "memory");
    const int c = lane & 7;
#pragma unroll
    for (int j = 0; j < 4; ++j) { const int n = (lane >> 3) + 8 * j; const LAS float* s = scr + (8 * c) * 33 + n;
        u32x4 o; o.x = pk2(s[0 * 33], s[1 * 33]); o.y = pk2(s[2 * 33], s[3 * 33]); o.z = pk2(s[4 * 33], s[5 * 33]); o.w = pk2(s[6 * 33], s[7 * 33]);
        *(u32x4*)(WT + (size_t)(n0 + n) * K + k0 + 8 * c) = o; }
    asm volatile("s_waitcnt lgkmcnt(0)" ::: "memory");
}

__device__ __forceinline__ float q4(float x, float inv_s) {
    const float a = fabsf(x) * inv_s; float r;
    if (a < 2.f) r = rintf(a * 2.f) * 0.5f; else if (a < 4.f) r = rintf(a); else r = fminf(6.f, rintf(a * 0.5f) * 2.f);
    return copysignf(r, x);
}
__device__ __forceinline__ void phase_prep(const Params& P, LAS unsigned char* lds) {
    const int tid = threadIdx.x, lane = tid & 63, wave = __builtin_amdgcn_readfirstlane(tid >> 6);
    const int gw = blockIdx.x * NWAVES + wave, NGW = gridDim.x * NWAVES;
    unsigned char* ws = P.ws;
    LAS float* scr = (LAS float*)(lds + wave * 16384);
    constexpr int I_IN = (DM / 64) * (DIN / 32), I_OUT = (DM / 64) * (DM / 32), I_Q = (DM / 64) * (2048 / 32);
    for (int it = gw; it < I_IN + I_OUT + I_Q; it += NGW) {
        int r = it;
        if (r < I_IN) { p0_transpose_item<true>(P.w_in, DM, DIN, (bf16*)(ws + WS_WIN_T), scr, r, lane, P.g_mix, P.g_mix, DM); continue; } r -= I_IN;
        if (r < I_OUT) { p0_transpose_item<false>(P.w_out, DM, DM, (bf16*)(ws + WS_WOUT_T), scr, r, lane, P.g_sc, P.g_cf, 512); continue; } r -= I_OUT;
        p0_transpose_item<false>(P.w_q, DM, 2048, (bf16*)(ws + WS_WQ_T), scr, r, lane, P.g_ffn, P.g_ffn, DM);
    }
    {
        bf16* H0B = (bf16*)(ws + WS_H0B); float* RSTD1 = (float*)(ws + WS_RSTD1);
        for (int t0 = gw * 4; t0 < NTOK; t0 += NGW * 4) {
            f32x4 v[4][4];
#pragma unroll
            for (int q = 0; q < 4; ++q) { const f32x4* xr = (const f32x4*)(P.x + (size_t)(t0 + q) * DM) + lane;
#pragma unroll
                for (int j = 0; j < 4; ++j) v[q][j] = xr[64 * j]; }
#pragma unroll
            for (int q = 0; q < 4; ++q) { float sq = 0.f;
#pragma unroll
                for (int j = 0; j < 4; ++j) sq += (v[q][j].x * v[q][j].x + v[q][j].y * v[q][j].y) + (v[q][j].z * v[q][j].z + v[q][j].w * v[q][j].w);
                sq = wave_sum_fast(sq);
                if (lane == 0) RSTD1[t0 + q] = rsqrtf(sq * (1.f / DM) + EPS);
                u32x2* o = (u32x2*)(H0B + (size_t)(t0 + q) * DM) + lane;
#pragma unroll
                for (int j = 0; j < 4; ++j) { u32x2 w; w.x = pk2(v[q][j].x, v[q][j].y); w.y = pk2(v[q][j].z, v[q][j].w); o[64 * j] = w; } }
        }
    }
    {
        unsigned char* U8 = ws + WS_U8; unsigned char* V8 = ws + WS_V8;
        f32x4 gf[4];
#pragma unroll
        for (int j = 0; j < 4; ++j) gf[j] = ((const f32x4*)P.g_ffn)[64 * j + lane];
        float* ESC = (float*)(ws + WS_ESCALE);
        for (int e0 = gw * 2; e0 < 2 * 16384; e0 += NGW * 2) {
            const bool isv = e0 >= 16384; const int ee0 = isv ? e0 - 16384 : e0;
            f32x4 v[2][4];
#pragma unroll
            for (int q = 0; q < 2; ++q) { const f32x4* src = (const f32x4*)((isv ? P.pv : P.pu) + (size_t)(ee0 + q) * DM) + lane;
#pragma unroll
                for (int j = 0; j < 4; ++j) v[q][j] = src[64 * j]; }
#pragma unroll
            for (int q = 0; q < 2; ++q) {
                float mx = 0.f;
#pragma unroll
                for (int j = 0; j < 4; ++j) { if (!isv) v[q][j] = v[q][j] * gf[j];
                    mx = fmaxf(mx, fmaxf(fmaxf(fabsf(v[q][j].x), fabsf(v[q][j].y)), fmaxf(fabsf(v[q][j].z), fabsf(v[q][j].w)))); }
#pragma unroll
                for (int o = 1; o < 64; o <<= 1) mx = fmaxf(mx, __shfl_xor(mx, o));
                const float sc = fmaxf(mx, 1e-30f) * (1.f / 6.f), inv = 1.f / sc;
                if (lane == 0) ESC[e0 + q] = sc;
                unsigned w0 = 0u, w1 = 0u;
                w0 = __builtin_amdgcn_cvt_scalef32_pk_fp4_f32(w0, v[q][0].x * inv, v[q][0].y * inv, 1.0f, 0); w0 = __builtin_amdgcn_cvt_scalef32_pk_fp4_f32(w0, v[q][0].z * inv, v[q][0].w * inv, 1.0f, 1);
                w0 = __builtin_amdgcn_cvt_scalef32_pk_fp4_f32(w0, v[q][1].x * inv, v[q][1].y * inv, 1.0f, 2); w0 = __builtin_amdgcn_cvt_scalef32_pk_fp4_f32(w0, v[q][1].z * inv, v[q][1].w * inv, 1.0f, 3);
                w1 = __builtin_amdgcn_cvt_scalef32_pk_fp4_f32(w1, v[q][2].x * inv, v[q][2].y * inv, 1.0f, 0); w1 = __builtin_amdgcn_cvt_scalef32_pk_fp4_f32(w1, v[q][2].z * inv, v[q][2].w * inv, 1.0f, 1);
                w1 = __builtin_amdgcn_cvt_scalef32_pk_fp4_f32(w1, v[q][3].x * inv, v[q][3].y * inv, 1.0f, 2); w1 = __builtin_amdgcn_cvt_scalef32_pk_fp4_f32(w1, v[q][3].z * inv, v[q][3].w * inv, 1.0f, 3);
                u32x2 o; o.x = w0; o.y = w1;
                *(u32x2*)((isv ? V8 : U8) + (size_t)(ee0 + q) * 512 + 8 * lane) = o;
            }
        }
    }
    {
        bf16* KB = (bf16*)(ws + WS_KEYS);
        const int gt = blockIdx.x * NTHREADS + tid, NGT = gridDim.x * NTHREADS;
        for (int i = gt; i < 8 * 2 * 128 * 128 / 4; i += NGT) { const f32x4 v = ((const f32x4*)P.keys)[i]; u32x2 w; w.x = pk2(v.x, v.y); w.y = pk2(v.z, v.w); ((u32x2*)KB)[i] = w; }
    }
    {
        float* MP = (float*)(ws + WS_METAPART); float* MR = (float*)(ws + WS_METARSTD);
        for (int r = gw; r < NMETA; r += NGW) {
            float s = 0.f;
            for (int k = lane; k < DM; k += 64) { const float v = P.meta[r * DM + k]; s += v * v; }
            s = wave_sum(s);
            if (lane == 0) MR[r] = rsqrtf(s * (1.f / DM) + EPS);
        }
        for (int it = gw; it < MKC * 40; it += NGW) {
            const int kc = it / 40, nb = it % 40, n = nb * 64 + lane;
            float acc[NMETA];
#pragma unroll
            for (int r = 0; r < NMETA; ++r) acc[r] = 0.f;
            for (int k = kc * (DM / MKC); k < (kc + 1) * (DM / MKC); ++k) {
                const float w = P.w_in[(size_t)k * DIN + n] * P.g_mix[k];
#pragma unroll
                for (int r = 0; r < NMETA; ++r) acc[r] += P.meta[r * DM + k] * w;
            }
#pragma unroll
            for (int r = 0; r < NMETA; ++r) MP[(size_t)(kc * 16 + r) * DIN + n] = acc[r];
        }
    }
}

__device__ __forceinline__ float metaraw(const float* MP, const float* MR, int p, int col) { float s = 0.f;
#pragma unroll 8
    for (int kc = 0; kc < MKC; ++kc) s += MP[(size_t)(kc * 16 + p) * DIN + col];
    return s * MR[p]; }
__device__ __forceinline__ void phase_metaproj(const Params& P) {
    const float* MP = (const float*)(P.ws + WS_METAPART); const float* MR = (const float*)(P.ws + WS_METARSTD); float* MJ = (float*)(P.ws + WS_METAPROJ);
    for (int gt = blockIdx.x * NTHREADS + threadIdx.x; gt < NMETA * PDIM; gt += gridDim.x * NTHREADS) { const int p = gt / PDIM, c = gt % PDIM; float v;
        if (c < 512) v = metaraw(MP, MR, p, c) * metaraw(MP, MR, p, 1024 + c);
        else if (c < 1024) v = metaraw(MP, MR, p, c);
        else v = metaraw(MP, MR, p, 1536 + (c - 1024)) * sigmoid_f(metaraw(MP, MR, p, 2048 + (c - 1024)));
        MJ[gt] = v; }
}
__device__ __forceinline__ float meta_val(const float* MJ, const float*, int p, int col) { return MJ[p * PDIM + col]; }
__device__ __forceinline__ float proj_at(const bf16* PROJ, const float* MP, const float* MR, int b, int pos, int col) {
    if (pos < 0) return 0.f;
    if (pos < NMETA) return meta_val(MP, MR, pos, col);
    return bf2f(PROJ[(size_t)(b * SEQ + pos - NMETA) * PDIM + col]);
}
__device__ __forceinline__ void proj8_at(const bf16* PROJ, const float* MP, const float* MR, int b, int pos, int col, float (&v)[8]) {
    if (pos < 0) {
#pragma unroll
        for (int i = 0; i < 8; ++i) v[i] = 0.f;
    } else if (pos < NMETA) {
        const f32x4 a = *(const f32x4*)(MP + pos * PDIM + col), bq = *(const f32x4*)(MP + pos * PDIM + col + 4);
        v[0] = a.x; v[1] = a.y; v[2] = a.z; v[3] = a.w; v[4] = bq.x; v[5] = bq.y; v[6] = bq.z; v[7] = bq.w;
    } else {
        const u32x4 w = *(const u32x4*)(PROJ + (size_t)(b * SEQ + pos - NMETA) * PDIM + col);
        v[0] = bflo(w.x); v[1] = bfhi(w.x); v[2] = bflo(w.y); v[3] = bfhi(w.y); v[4] = bflo(w.z); v[5] = bfhi(w.z); v[6] = bflo(w.w); v[7] = bfhi(w.w);
    }
}

template <int R> __device__ __forceinline__ void conv_rows(const LAS unsigned char* ubase, const f32x2 (&wcf)[31], f32x2 (&acc)[32]) {
    if constexpr (R < 62) {
        const unsigned uw = *(const LAS unsigned*)(ubase + R * 1024);
        const f32x2 x = (f32x2){bflo(uw), bfhi(uw)};
        constexpr int lo = R > 30 ? R - 30 : 0, hi = R < 31 ? R : 31;
#pragma unroll
        for (int ii = lo; ii <= hi; ++ii) acc[ii] += wcf[R - ii] * x;
        conv_rows<R + 1>(ubase, wcf, acc);
    }
}
__device__ __forceinline__ void phase_conv(const Params& P, LAS unsigned char* lds) {
    const int tid = threadIdx.x, lane = tid & 63, wave = __builtin_amdgcn_readfirstlane(tid >> 6);
    unsigned char* ws = P.ws;
    const bf16* PROJ = (const bf16*)(ws + WS_PROJ); const float* MP = (const float*)(ws + WS_METAPROJ); const float* MR = nullptr;
    bf16* Y = (bf16*)(ws + WS_Y);
    constexpr int TT = 64, NTILE = NTOK / TT, UROWS = TT + 30;
    const int cgp = wave & 3, th = wave >> 2, ch2 = cgp * 128 + 2 * lane;
    f32x2 wcf[31];
#pragma unroll
    for (int j = 0; j < 31; ++j) wcf[j] = *(const f32x2*)(P.cf_w + j * 512 + ch2);
    const f32x2 bcf = *(const f32x2*)(P.cf_b + ch2);
    for (int tile = blockIdx.x; tile < NTILE; tile += gridDim.x) {
        const int b = tile / (SEQ / TT), s0 = (tile % (SEQ / TT)) * TT;
#pragma unroll 4
        for (int p = 0; p < (UROWS + 7) / 8; ++p) {
            const int r = p * 8 + wave;
            if (r < UROWS) {
                const int pos = NMETA + s0 - 30 + r;
                float uu[8];
                proj8_at(PROJ, MP, MR, b, pos, 1024 + 8 * lane, uu);
                u32x4 w; w.x = pk2(uu[0], uu[1]); w.y = pk2(uu[2], uu[3]); w.z = pk2(uu[4], uu[5]); w.w = pk2(uu[6], uu[7]);
                *(LAS u32x4*)(lds + r * 1024 + lane * 16) = w;
            }
        }
        __syncthreads();
        f32x2 acc[32];
#pragma unroll
        for (int ii = 0; ii < 32; ++ii) acc[ii] = bcf;
        conv_rows<0>(lds + (32 * th) * 1024 + ch2 * 2, wcf, acc);
        __syncthreads();
#pragma unroll
        for (int ii = 0; ii < 32; ++ii) *(LAS f32x2*)(lds + (32 * th + ii) * 2048 + ch2 * 4) = acc[ii];
        __syncthreads();
        {
            float lng[8], lnb[8];
            { const f32x4 a = *(const f32x4*)(P.ln_g + 8 * lane), c = *(const f32x4*)(P.ln_g + 8 * lane + 4), d = *(const f32x4*)(P.ln_b + 8 * lane), e = *(const f32x4*)(P.ln_b + 8 * lane + 4);
              lng[0] = a.x; lng[1] = a.y; lng[2] = a.z; lng[3] = a.w; lng[4] = c.x; lng[5] = c.y; lng[6] = c.z; lng[7] = c.w;
              lnb[0] = d.x; lnb[1] = d.y; lnb[2] = d.z; lnb[3] = d.w; lnb[4] = e.x; lnb[5] = e.y; lnb[6] = e.z; lnb[7] = e.w; }
            float wsc[3][8];
#pragma unroll
            for (int j = 0; j < 3; ++j) { const f32x4 a = *(const f32x4*)(P.sc_w + j * 512 + 8 * lane), c = *(const f32x4*)(P.sc_w + j * 512 + 8 * lane + 4);
                wsc[j][0] = a.x; wsc[j][1] = a.y; wsc[j][2] = a.z; wsc[j][3] = a.w; wsc[j][4] = c.x; wsc[j][5] = c.y; wsc[j][6] = c.z; wsc[j][7] = c.w; }
            float cxa[8], cxb[8];
            { const int pos = NMETA + s0 + 8 * wave - 2;
              proj8_at(PROJ, MP, MR, b, pos, 8 * lane, cxa); proj8_at(PROJ, MP, MR, b, pos + 1, 8 * lane, cxb); }
#pragma unroll 2
            for (int q = 0; q < 8; ++q) {
                const int ii = 8 * wave + q, s = s0 + ii; const size_t t = (size_t)b * SEQ + s;
                float o[8];
                { const f32x4 a = *(const LAS f32x4*)(lds + ii * 2048 + lane * 32), c = *(const LAS f32x4*)(lds + ii * 2048 + lane * 32 + 16);
                  o[0] = a.x; o[1] = a.y; o[2] = a.z; o[3] = a.w; o[4] = c.x; o[5] = c.y; o[6] = c.z; o[7] = c.w; }
                float s1 = 0.f;
#pragma unroll
                for (int i = 0; i < 8; ++i) s1 += o[i];
                const float mean = wave_sum_fast(s1) * (1.f / 512.f);
                float s2 = 0.f;
#pragma unroll
                for (int i = 0; i < 8; ++i) { o[i] -= mean; s2 += o[i] * o[i]; }
                const float rs = rsqrtf(wave_sum_fast(s2) * (1.f / 512.f) + EPS);
                float s3 = 0.f;
#pragma unroll
                for (int i = 0; i < 8; ++i) { float y = o[i] * rs * lng[i] + lnb[i]; y = y * sigmoid_f(y); o[i] = y; s3 += y * y; }
                const float r2 = rsqrtf(wave_sum_fast(s3) * (1.f / 512.f) + EPS);
                u32x4 wv; wv.x = pk2(o[0] * r2, o[1] * r2); wv.y = pk2(o[2] * r2, o[3] * r2); wv.z = pk2(o[4] * r2, o[5] * r2); wv.w = pk2(o[6] * r2, o[7] * r2);
                *(u32x4*)(Y + t * DM + 512 + 8 * lane) = wv;
                float bgv[8], cxc[8], accs[8];
                proj8_at(PROJ, MP, MR, b, NMETA + s, 8 * lane, cxc); proj8_at(PROJ, MP, MR, b, NMETA + s, 512 + 8 * lane, bgv);
                float s4 = 0.f;
#pragma unroll
                for (int i = 0; i < 8; ++i) { accs[i] = bgv[i] * (wsc[0][i] * cxa[i] + wsc[1][i] * cxb[i] + wsc[2][i] * cxc[i]); s4 += accs[i] * accs[i]; cxa[i] = cxb[i]; cxb[i] = cxc[i]; }
                const float r4 = rsqrtf(wave_sum_fast(s4) * (1.f / 512.f) + EPS);
                u32x4 wz; wz.x = pk2(accs[0] * r4, accs[1] * r4); wz.y = pk2(accs[2] * r4, accs[3] * r4); wz.z = pk2(accs[4] * r4, accs[5] * r4); wz.w = pk2(accs[6] * r4, accs[7] * r4);
                *(u32x4*)(Y + t * DM + 8 * lane) = wz;
            }
        }
        __syncthreads();
    }
}

__device__ __forceinline__ int ord_i(float s) { int k = __builtin_bit_cast(int, s); k ^= (k >> 31) & 0x7fffffff; return k; }
__device__ __forceinline__ float unord_f(int k) { k ^= (k >> 31) & 0x7fffffff; return __builtin_bit_cast(float, k); }
#define TOP_INSERT(L, x_) do { int _x = (x_); _Pragma("unroll") for (int _i = 0; _i < 16; ++_i) { const int _hi = max(L[_i], _x); _x = min(L[_i], _x); L[_i] = _hi; } } while (0)

typedef short bf16x8 __attribute__((ext_vector_type(8)));
typedef float f32x16 __attribute__((ext_vector_type(16)));
template <bool DESC> __device__ __forceinline__ void ce_i(int& a, int& b) { const int hi = max(a, b), lo = min(a, b); if (DESC) { a = hi; b = lo; } else { a = lo; b = hi; } }
__device__ __forceinline__ void bitonic_sort16(int (&a)[16]) {
#pragma unroll
    for (int k = 2; k <= 16; k <<= 1)
#pragma unroll
        for (int j = k >> 1; j > 0; j >>= 1)
#pragma unroll
            for (int i = 0; i < 16; ++i) { const int l = i ^ j; if (l > i) { if ((i & k) == 0) ce_i<true>(a[i], a[l]); else ce_i<false>(a[i], a[l]); } }
}
__device__ __forceinline__ void bitonic_merge16(int (&a)[16]) {
#pragma unroll
    for (int j = 8; j > 0; j >>= 1)
#pragma unroll
        for (int i = 0; i < 16; ++i) { const int l = i ^ j; if (l > i) ce_i<true>(a[i], a[l]); }
}
__device__ __forceinline__ void merge_top16(int (&a)[16], const int (&b)[16]) {
#pragma unroll
    for (int i = 0; i < 16; ++i) a[i] = max(a[i], b[15 - i]);
    bitonic_merge16(a);
}
__device__ __forceinline__ int lut16(const unsigned (&T)[4], int i) {
    const unsigned sel = (unsigned)(i & 7) | 0x0c0c0c00u;
    const unsigned lo = __builtin_amdgcn_perm(T[1], T[0], sel), hi = __builtin_amdgcn_perm(T[3], T[2], sel);
    return (int)((i & 8) ? hi : lo);
}
constexpr int KROW = 272;
constexpr float SCORE_BIAS = 8.0f;

__device__ __forceinline__ void route_half(const LAS unsigned char* kl, const bf16* qrow, int nl, int hb, int (&L)[16]) {
    bf16x8 qf[8];
#pragma unroll
    for (int ks = 0; ks < 8; ++ks) qf[ks] = *(const bf16x8*)(qrow + 64 * hb + 8 * ks);
    f32x16 acc[4];
#pragma unroll
    for (int nt = 0; nt < 4; ++nt)
#pragma unroll
        for (int r = 0; r < 16; ++r) acc[nt][r] = SCORE_BIAS;
#pragma unroll
    for (int ks = 0; ks < 8; ++ks)
#pragma unroll
        for (int nt = 0; nt < 4; ++nt) {
            const bf16x8 a = *(const LAS bf16x8*)(kl + (32 * nt + nl) * KROW + (64 * hb + 8 * ks) * 2);
            acc[nt] = __builtin_amdgcn_mfma_f32_32x32x16_bf16(a, qf[ks], acc[nt], 0, 0, 0);
        }
    const int hb4 = 4 * hb;
    int T[4][16];
#pragma unroll
    for (int nt = 0; nt < 4; ++nt)
#pragma unroll
        for (int r = 0; r < 16; ++r) { const int n0 = 32 * nt + (r & 3) + 8 * (r >> 2); const float sc = acc[nt][r];
            T[nt][r] = (__float_as_int(sc) & ~127) | ((127 - n0) - hb4); }
    bitonic_sort16(T[0]); bitonic_sort16(T[1]); bitonic_sort16(T[2]); bitonic_sort16(T[3]);
    merge_top16(T[0], T[1]); merge_top16(T[2], T[3]); merge_top16(T[0], T[2]);
#pragma unroll
    for (int i = 0; i < 16; ++i) { const unsigned v = (unsigned)T[0][15 - i]; auto r = __builtin_amdgcn_permlane32_swap(v, v, false, false);
        const unsigned r0 = r[0], r1 = r[1]; const int partner = (int)(hb ? r0 : r1); L[i] = max(T[0][i], partner); }
    bitonic_merge16(L);
}

__device__ __forceinline__ void phase_route(const Params& P, LAS unsigned char* lds) {
    const int tid = threadIdx.x, lane = tid & 63, wave = __builtin_amdgcn_readfirstlane(tid >> 6);
    const int nl = lane & 31, hb = lane >> 5;
    unsigned char* ws = P.ws;
    const bf16* KEYS = (const bf16*)(ws + WS_KEYS); const bf16* Q = (const bf16*)(ws + WS_Q);
    int* IDX = (int*)(ws + WS_IDX); float* GATE = (float*)(ws + WS_GATE);
    int last_h = -1;
    for (int unit = blockIdx.x; unit < (NTOK / 256) * NHEAD; unit += gridDim.x) {
        const int h = unit & 7, tb = unit >> 3;
        if (h != last_h) {
            __syncthreads();
            for (int c = tid; c < 4096; c += NTHREADS) { const u32x4 v = ((const u32x4*)(KEYS + (size_t)h * 32768))[c];
                *(LAS u32x4*)(lds + (c >> 4) * KROW + (c & 15) * 16) = v; }
            __syncthreads();
            last_h = h;
        }
        const size_t t = (size_t)tb * 256 + wave * 32 + nl;
        int L1[16], L2[16];
        route_half(lds, Q + t * 2048 + h * 256, nl, hb, L1);
        route_half(lds + 128 * KROW, Q + t * 2048 + h * 256 + 128, nl, hb, L2);
        float v1[16], v2[16];
#pragma unroll
        for (int i = 0; i < 16; ++i) { v1[i] = __int_as_float(L1[i] & ~127); v2[i] = __int_as_float(L2[i] & ~127); }
#define CAND(i, j) ((__float_as_int(v1[i] + v2[j]) & ~255) | (255 - (16 * (i) + (j))))
        int A[16], B[16], C[16];
#pragma unroll
        for (int j = 0; j < 16; ++j) A[j] = CAND(0, j);
#pragma unroll
        for (int j = 0; j < 8; ++j) { B[j] = CAND(1, j); B[8 + j] = CAND(15 - j, 0); }
        bitonic_merge16(B);
        C[0] = CAND(2, 0); C[1] = CAND(2, 1); C[2] = CAND(2, 2); C[3] = CAND(2, 3); C[4] = CAND(2, 4);
        C[5] = CAND(3, 0); C[6] = CAND(3, 1); C[7] = CAND(3, 2); C[8] = CAND(3, 3);
        C[9] = CAND(4, 0); C[10] = CAND(4, 1); C[11] = CAND(4, 2);
        C[12] = CAND(5, 0); C[13] = CAND(5, 1); C[14] = CAND(6, 0); C[15] = CAND(6, 1);
        bitonic_sort16(C);
        { const int d0 = CAND(7, 0), d1 = CAND(7, 1); C[14] = max(C[14], d1); C[15] = max(C[15], d0); bitonic_merge16(C); }
#undef CAND
        merge_top16(A, B); merge_top16(A, C);
        unsigned T1[4], T2[4];
#pragma unroll
        for (int q = 0; q < 4; ++q) {
            T1[q] = (unsigned)(127 - (L1[4 * q] & 127)) | ((unsigned)(127 - (L1[4 * q + 1] & 127)) << 8) | ((unsigned)(127 - (L1[4 * q + 2] & 127)) << 16) | ((unsigned)(127 - (L1[4 * q + 3] & 127)) << 24);
            T2[q] = (unsigned)(127 - (L2[4 * q] & 127)) | ((unsigned)(127 - (L2[4 * q + 1] & 127)) << 8) | ((unsigned)(127 - (L2[4 * q + 2] & 127)) << 16) | ((unsigned)(127 - (L2[4 * q + 3] & 127)) << 24); }
        float val[16]; int ex[16];
#pragma unroll
        for (int k = 0; k < 16; ++k) { const int pos = 255 - (A[k] & 255); val[k] = __int_as_float(A[k] & ~255);
            ex[k] = lut16(T1, pos >> 4) * NKEYS + lut16(T2, pos & 15); }
        float sum = 0.f; const float vmax = val[0];
#pragma unroll
        for (int k = 0; k < 16; ++k) { val[k] = __expf(val[k] - vmax); sum += val[k]; }
        const float inv = 1.f / sum;
        if (hb == 0) {
            int* ip = IDX + t * NSEL + h * TOPK; float* gp = GATE + t * NSEL + h * TOPK;
#pragma unroll
            for (int k4 = 0; k4 < 4; ++k4) {
                *(int4*)(ip + 4 * k4) = make_int4(ex[4 * k4], ex[4 * k4 + 1], ex[4 * k4 + 2], ex[4 * k4 + 3]);
                *(f32x4*)(gp + 4 * k4) = (f32x4){val[4 * k4] * inv, val[4 * k4 + 1] * inv, val[4 * k4 + 2] * inv, val[4 * k4 + 3] * inv};
            }
        }
    }
}

#define FP4X2(w, sel) __builtin_amdgcn_cvt_scalef32_pk_f32_fp4((w), 1.0f, (sel))
__device__ __forceinline__ float dot16_fp4(const u32x2 r, const f32x4 (&xs)[4]) {
    float p = 0.f;
    { const f32x2 a = FP4X2(r.x, 0), b = FP4X2(r.x, 1), c = FP4X2(r.x, 2), d = FP4X2(r.x, 3);
      p += (a.x * xs[0].x + a.y * xs[0].y) + (b.x * xs[0].z + b.y * xs[0].w); p += (c.x * xs[1].x + c.y * xs[1].y) + (d.x * xs[1].z + d.y * xs[1].w); }
    { const f32x2 a = FP4X2(r.y, 0), b = FP4X2(r.y, 1), c = FP4X2(r.y, 2), d = FP4X2(r.y, 3);
      p += (a.x * xs[2].x + a.y * xs[2].y) + (b.x * xs[2].z + b.y * xs[2].w); p += (c.x * xs[3].x + c.y * xs[3].y) + (d.x * xs[3].z + d.y * xs[3].w); }
    return p;
}
__device__ __forceinline__ void axpy16_fp4(const u32x2 r, float w, f32x4 (&o)[4]) {
    { const f32x2 a = FP4X2(r.x, 0), b = FP4X2(r.x, 1), c = FP4X2(r.x, 2), d = FP4X2(r.x, 3);
      o[0].x += w * a.x; o[0].y += w * a.y; o[0].z += w * b.x; o[0].w += w * b.y; o[1].x += w * c.x; o[1].y += w * c.y; o[1].z += w * d.x; o[1].w += w * d.y; }
    { const f32x2 a = FP4X2(r.y, 0), b = FP4X2(r.y, 1), c = FP4X2(r.y, 2), d = FP4X2(r.y, 3);
      o[2].x += w * a.x; o[2].y += w * a.y; o[2].z += w * b.x; o[2].w += w * b.y; o[3].x += w * c.x; o[3].y += w * c.y; o[3].z += w * d.x; o[3].w += w * d.y; }
}
__device__ __forceinline__ float swap32_add(float a, float b) { auto r = __builtin_amdgcn_permlane32_swap(__float_as_uint(a), __float_as_uint(b), false, false); return __uint_as_float(r[0]) + __uint_as_float(r[1]); }
__device__ __forceinline__ float swap16_add(float a, float b) { auto r = __builtin_amdgcn_permlane16_swap(__float_as_uint(a), __float_as_uint(b), false, false); return __uint_as_float(r[0]) + __uint_as_float(r[1]); }
__device__ __forceinline__ float row_sum16(float v) { v += dpp_f<0xB1>(v); v += dpp_f<0x4E>(v); v += dpp_f<0x141>(v); v += dpp_f<0x140>(v); return v; }
constexpr int GB = 32;
typedef __attribute__((address_space(8))) void* rsrc_t;
__device__ __forceinline__ void g_issue(u32x2 (&buf)[GB], __amdgpu_buffer_rsrc_t rs, int idxr, int lb, int voff) {
#pragma unroll
    for (int j = 0; j < GB; ++j) { const int e = __builtin_amdgcn_readlane(idxr, lb + j); buf[j] = __builtin_amdgcn_raw_buffer_load_b64(rs, voff, e * 512, 0); }
}
__device__ __forceinline__ float dot16_fp4p(const u32x2 r, const f32x2 (&xp)[8]) {
    f32x2 a = FP4X2(r.x, 0) * xp[0];
    a += FP4X2(r.x, 1) * xp[1]; a += FP4X2(r.x, 2) * xp[2]; a += FP4X2(r.x, 3) * xp[3];
    a += FP4X2(r.y, 0) * xp[4]; a += FP4X2(r.y, 1) * xp[5]; a += FP4X2(r.y, 2) * xp[6]; a += FP4X2(r.y, 3) * xp[7];
    return a.x + a.y;
}
__device__ __forceinline__ void axpy16_fp4p(const u32x2 r, float w, f32x2 (&o)[8]) {
    const f32x2 ww = (f32x2){w, w};
    o[0] += FP4X2(r.x, 0) * ww; o[1] += FP4X2(r.x, 1) * ww; o[2] += FP4X2(r.x, 2) * ww; o[3] += FP4X2(r.x, 3) * ww;
    o[4] += FP4X2(r.y, 0) * ww; o[5] += FP4X2(r.y, 1) * ww; o[6] += FP4X2(r.y, 2) * ww; o[7] += FP4X2(r.y, 3) * ww;
}
template <int H> __device__ __forceinline__ void g_compute_u(const u32x2 (&buf)[GB], int q, int i16, const f32x2 (&xp)[8], float& zlo, float& zhi) {
    float p[16];
#pragma unroll
    for (int j = 0; j < 16; ++j) p[j] = dot16_fp4p(buf[16 * H + j], xp);
    float s1[8], s2[4];
#pragma unroll
    for (int m = 0; m < 8; ++m) s1[m] = swap32_add(p[2 * m], p[2 * m + 1]);
#pragma unroll
    for (int n = 0; n < 4; ++n) s2[n] = swap16_add(s1[2 * n], s1[2 * n + 1]);
#pragma unroll
    for (int r = 0; r < 4; ++r) { const float z = row_sum16(s2[r]); const bool mine = i16 == ((4 * q + r) & 15);
        zlo = (mine && q < 4) ? z : zlo; zhi = (mine && q >= 4) ? z : zhi; }
}
template <int H> __device__ __forceinline__ void g_compute_v(const u32x2 (&buf)[GB], int q, float alo, float ahi, f32x2 (&o)[8]) {
    const int areg = __builtin_bit_cast(int, (q < 4) ? alo : ahi), sb = 4 * (q & 3);
#pragma unroll
    for (int j = 0; j < 16; ++j) { const int src = 32 * (j & 1) + 16 * ((j >> 1) & 1) + (j >> 2) + sb;
        const float w = __builtin_bit_cast(float, __builtin_amdgcn_readlane(areg, src));
        axpy16_fp4p(buf[16 * H + j], w, o); }
}
__device__ __forceinline__ void phase_gather_u(const Params& P) {
    const int tid = threadIdx.x, lane = tid & 63, wave = __builtin_amdgcn_readfirstlane(tid >> 6);
    const int gw = blockIdx.x * NWAVES + wave, NGW = gridDim.x * NWAVES;
    unsigned char* ws = P.ws;
    const int* IDX = (const int*)(ws + WS_IDX); const float* GATE = (const float*)(ws + WS_GATE); const float* ESC = (const float*)(ws + WS_ESCALE); float* AW = (float*)(ws + WS_AW);
    const __amdgpu_buffer_rsrc_t rsU = __builtin_amdgcn_make_buffer_rsrc((void*)(ws + WS_U8), 0, 16384 * 512, 0x00020000);
    const bf16* H2B = (const bf16*)(ws + WS_H2B); const float* SSQ = (const float*)(ws + WS_SSQ);
    const int hh = lane >> 5, rr = (lane >> 4) & 1, i16 = lane & 15, gsel = 4 * i16 + 2 * rr + hh;
    const int voff = 8 * lane;
    int t = gw;
    if (t < NTOK) {
        int idx0, idx1; u32x2 hraw[4]; float sqv;
        { const int* ip = IDX + (size_t)t * NSEL; idx0 = ip[lane]; idx1 = ip[64 + lane];
          const u32x2* hp = (const u32x2*)(H2B + (size_t)t * DM);
#pragma unroll
          for (int j = 0; j < 4; ++j) hraw[j] = hp[64 * j + lane];
          sqv = (lane < 16) ? (SSQ + (size_t)t * 16)[lane] : 0.f; }
        u32x2 bufA[GB], bufB[GB];
        g_issue(bufA, rsU, idx0, 0, voff);
        for (;;) {
            const int tn = t + NGW; const bool has_next = tn < NTOK; const int tl = has_next ? tn : t;
            int idx0n, idx1n; u32x2 hrawn[4]; float sqn, g0, g1;
            { const int* ip = IDX + (size_t)tl * NSEL; idx0n = ip[lane]; idx1n = ip[64 + lane];
              const u32x2* hp = (const u32x2*)(H2B + (size_t)tl * DM);
#pragma unroll
              for (int j = 0; j < 4; ++j) hrawn[j] = hp[64 * j + lane];
              sqn = (lane < 16) ? (SSQ + (size_t)tl * 16)[lane] : 0.f;
              const float* gp = GATE + (size_t)t * NSEL; g0 = gp[lane]; g1 = gp[64 + lane]; }
            const float su0 = ESC[idx0], su1 = ESC[idx1], sv0 = ESC[16384 + idx0], sv1 = ESC[16384 + idx1];
            const float rstd2 = rsqrtf(wave_sum_fast(sqv) * (1.f / DM) + EPS);
            f32x2 xp[8];
#pragma unroll
            for (int j = 0; j < 4; ++j) { xp[2 * j] = (f32x2){bflo(hraw[j].x), bfhi(hraw[j].x)}; xp[2 * j + 1] = (f32x2){bflo(hraw[j].y), bfhi(hraw[j].y)}; }
            float zlo = 0.f, zhi = 0.f;
#pragma unroll 1
            for (int i = 0; i < 2; ++i) {
                const int idxr = i ? idx1 : idx0, idxnx = i ? idx0n : idx1;
                g_issue(bufB, rsU, idxr, 32, voff);
                g_compute_u<0>(bufA, 4 * i, i16, xp, zlo, zhi); g_compute_u<1>(bufA, 4 * i + 1, i16, xp, zlo, zhi);
                if (i == 0 || has_next) g_issue(bufA, rsU, idxnx, 0, voff);
                g_compute_u<0>(bufB, 4 * i + 2, i16, xp, zlo, zhi); g_compute_u<1>(bufB, 4 * i + 3, i16, xp, zlo, zhi);
            }
            const float glo = __shfl(g0, gsel), ghi = __shfl(g1, gsel), sulo = __shfl(su0, gsel), suhi = __shfl(su1, gsel), svlo = __shfl(sv0, gsel), svhi = __shfl(sv1, gsel);
            float* ap = AW + (size_t)t * NSEL;
            ap[lane] = gelu_tanh_f(zlo * rstd2 * sulo) * glo * svlo; ap[64 + lane] = gelu_tanh_f(zhi * rstd2 * suhi) * ghi * svhi;
            if (!has_next) break;
            t = tn; idx0 = idx0n; idx1 = idx1n; sqv = sqn;
#pragma unroll
            for (int j = 0; j < 4; ++j) hraw[j] = hrawn[j];
        }
    }
}
__device__ __forceinline__ void phase_gather_v(const Params& P) {
    const int tid = threadIdx.x, lane = tid & 63, wave = __builtin_amdgcn_readfirstlane(tid >> 6);
    const int gw = blockIdx.x * NWAVES + wave, NGW = gridDim.x * NWAVES;
    unsigned char* ws = P.ws;
    const int* IDX = (const int*)(ws + WS_IDX); const float* AW = (const float*)(ws + WS_AW);
    const __amdgpu_buffer_rsrc_t rsV = __builtin_amdgcn_make_buffer_rsrc((void*)(ws + WS_V8), 0, 16384 * 512, 0x00020000);
    const bf16* H2B = (const bf16*)(ws + WS_H2B);
    const int voff = 8 * lane;
    int t = gw;
    if (t < NTOK) {
        int idx0, idx1; u32x2 hraw[4]; float alo, ahi;
        { const int* ip = IDX + (size_t)t * NSEL; idx0 = ip[lane]; idx1 = ip[64 + lane];
          const u32x2* hp = (const u32x2*)(H2B + (size_t)t * DM);
#pragma unroll
          for (int j = 0; j < 4; ++j) hraw[j] = hp[64 * j + lane];
          const float* ap = AW + (size_t)t * NSEL; alo = ap[lane]; ahi = ap[64 + lane]; }
        u32x2 bufA[GB], bufB[GB];
        g_issue(bufA, rsV, idx0, 0, voff);
        for (;;) {
            const int tn = t + NGW; const bool has_next = tn < NTOK; const int tl = has_next ? tn : t;
            int idx0n, idx1n; u32x2 hrawn[4]; float alon, ahin;
            { const int* ip = IDX + (size_t)tl * NSEL; idx0n = ip[lane]; idx1n = ip[64 + lane];
              const u32x2* hp = (const u32x2*)(H2B + (size_t)tl * DM);
#pragma unroll
              for (int j = 0; j < 4; ++j) hrawn[j] = hp[64 * j + lane];
              const float* ap = AW + (size_t)tl * NSEL; alon = ap[lane]; ahin = ap[64 + lane]; }
            f32x2 o[8];
#pragma unroll
            for (int j = 0; j < 8; ++j) o[j] = (f32x2){0.f, 0.f};
#pragma unroll 1
            for (int i = 0; i < 2; ++i) {
                const int idxr = i ? idx1 : idx0, idxnx = i ? idx0n : idx1;
                g_issue(bufB, rsV, idxr, 32, voff);
                g_compute_v<0>(bufA, 4 * i, alo, ahi, o); g_compute_v<1>(bufA, 4 * i + 1, alo, ahi, o);
                if (i == 0 || has_next) g_issue(bufA, rsV, idxnx, 0, voff);
                g_compute_v<0>(bufB, 4 * i + 2, alo, ahi, o); g_compute_v<1>(bufB, 4 * i + 3, alo, ahi, o);
            }
            float ss = 0.f;
#pragma unroll
            for (int j = 0; j < 4; ++j) { o[2 * j] += (f32x2){bflo(hraw[j].x), bfhi(hraw[j].x)}; o[2 * j + 1] += (f32x2){bflo(hraw[j].y), bfhi(hraw[j].y)}; }
#pragma unroll
            for (int j = 0; j < 8; ++j) ss += o[j].x * o[j].x + o[j].y * o[j].y;
            ss = wave_sum_fast(ss);
            const float r3 = rsqrtf(ss * (1.f / DM) + EPS);
            f32x4* op = (f32x4*)(P.out + (size_t)t * DM);
            const f32x4* gfp = (const f32x4*)P.g_fin;
#pragma unroll
            for (int j = 0; j < 4; ++j) { const f32x4 gv = gfp[64 * j + lane]; op[64 * j + lane] = (f32x4){o[2 * j].x * r3 * gv.x, o[2 * j].y * r3 * gv.y, o[2 * j + 1].x * r3 * gv.z, o[2 * j + 1].y * r3 * gv.w}; }
            if (!has_next) break;
            t = tn; idx0 = idx0n; idx1 = idx1n; alo = alon; ahi = ahin;
#pragma unroll
            for (int j = 0; j < 4; ++j) hraw[j] = hrawn[j];
        }
    }
}

#define XB_TMO      128
#define XB_XCNT(j)  (256  + 64 * (j))
#define XB_XSUB(j)  (1280 + 64 * (j))
#define XB_XGEN(j)  (2304 + 64 * (j))
#define XB_TOP      3328
#define XB_TOPGEN   3392
#define XCD_BAR_WORDS 3456
#define XB_SPIN_CAP (1u << 18)

__device__ __forceinline__ unsigned xb_ld(unsigned* p)              { return __hip_atomic_load(p, __ATOMIC_RELAXED, __HIP_MEMORY_SCOPE_AGENT); }
__device__ __forceinline__ unsigned xb_add(unsigned* p, unsigned v) { return __hip_atomic_fetch_add(p, v, __ATOMIC_RELAXED, __HIP_MEMORY_SCOPE_AGENT); }
__device__ __forceinline__ unsigned xb_xcc_id() { return (unsigned)__builtin_amdgcn_s_getreg((3 << 11) | 20) & 0xFu; }
#define XB_SPIN(cond, bar) do { unsigned _sp = 0; while (cond) { __builtin_amdgcn_s_sleep(1); \
    if ((++_sp & 255u) == 0u) { if (xb_ld(&(bar)[XB_TMO])) break; if (_sp > XB_SPIN_CAP) { atomicAdd(&(bar)[XB_TMO], 1u); break; } } } } while (0)

struct XcdBarrier {
    unsigned* bar; unsigned x;
    volatile LAS unsigned* st;
};

__device__ __forceinline__ XcdBarrier xcd_barrier_post(unsigned* bar, volatile LAS unsigned* st) {
    XcdBarrier b; b.bar = bar; b.x = xb_xcc_id(); b.st = st;
    if (threadIdx.x == 0) (void)xb_add(&bar[XB_XCNT(b.x)], 1u);
    return b;
}
__device__ __forceinline__ void xcd_barrier_complete(unsigned* bar, unsigned x, unsigned& nloc, unsigned& nx) {
    const unsigned G = gridDim.x * gridDim.y * gridDim.z;
    unsigned sum, cnt, mine, sp = 0u;
    for (;;) {
        sum = 0u; cnt = 0u; mine = 0u;
#pragma unroll
        for (unsigned j = 0; j < 16; ++j) { const unsigned c = xb_ld(&bar[XB_XCNT(j)]); sum += c; cnt += (c > 0u) ? 1u : 0u; mine = (j == x) ? c : mine; }
        if (sum == G) break;
        __builtin_amdgcn_s_sleep(1);
        if ((++sp & 255u) == 0u) { if (xb_ld(&bar[XB_TMO])) break; if (sp > XB_SPIN_CAP) { atomicAdd(&bar[XB_TMO], 1u); break; } }
    }
    nloc = mine > 0u ? mine : 1u; nx = cnt > 0u ? cnt : 1u;
}

__device__ __forceinline__ void xcd_barrier(const XcdBarrier& b) {
    asm volatile("s_waitcnt vmcnt(0)" ::: "memory");
    __syncthreads();
    if (threadIdx.x == 0) {
        unsigned* bar = b.bar;
        __builtin_amdgcn_s_waitcnt(0);
        unsigned nloc = b.st[0], nx = b.st[1];
        if (nloc == 0u) { xcd_barrier_complete(bar, b.x, nloc, nx); b.st[0] = nloc; b.st[1] = nx; }
        const unsigned old = xb_add(&bar[XB_XSUB(b.x)], 1u);
        const unsigned gen = old / nloc;
        if (old + 1u == (gen + 1u) * nloc) {
            __builtin_amdgcn_fence(__ATOMIC_RELEASE, "agent");
            asm volatile("s_waitcnt vmcnt(0)" ::: "memory");
            const unsigned og = xb_add(&bar[XB_TOP], 1u);
            const unsigned tg = og / nx;
            if (og + 1u == (tg + 1u) * nx) xb_add(&bar[XB_TOPGEN], 1u);
            else XB_SPIN(xb_ld(&bar[XB_TOPGEN]) == tg, bar);
            __builtin_amdgcn_fence(__ATOMIC_ACQUIRE, "agent");
            xb_add(&bar[XB_XGEN(b.x)], 1u);
            asm volatile("s_waitcnt vmcnt(0)" ::: "memory");
        } else {
            XB_SPIN(xb_ld(&bar[XB_XGEN(b.x)]) == gen, bar);
            __builtin_amdgcn_fence(__ATOMIC_ACQUIRE, "agent");
            asm volatile("s_waitcnt vmcnt(0)" ::: "memory");
        }
    }
    __syncthreads();
}


#ifndef MK_MULTI
#define MK_MULTI 0
#endif
constexpr int NPHASE = 8;
#ifndef REP5
#define REP5 1
#endif
#ifndef REP6
#define REP6 1
#endif
__global__ void __launch_bounds__(NTHREADS, 2) mk_fwd(Params P) {
    extern __shared__ __attribute__((aligned(16))) unsigned char lds_raw[];
    LAS unsigned char* lds = (LAS unsigned char*)lds_raw;
    cg::grid_group grid = cg::this_grid();
    unsigned char* ws = P.ws;
    const int lo = P.ph_lo, hi = P.ph_hi;
    volatile LAS unsigned* bst = (volatile LAS unsigned*)(lds + 131072 + 64);
    if (threadIdx.x < 2) bst[threadIdx.x] = 0u;
    __syncthreads();
    XcdBarrier xbar = xcd_barrier_post((unsigned*)(ws + WS_CTL), bst);
#define IN(k) (lo <= (k) && (k) < hi)
#define SEAM(k) do { if (IN(k) && IN((k) + 1)) { xcd_barrier(xbar); } } while (0)
#ifndef SKIP0
    if (IN(0)) phase_prep(P, lds);
#endif
    SEAM(0);
#ifndef SKIP1
    if (IN(1)) {
        phase_metaproj(P);
        pg8::Gemm g{(const bf16*)(ws + WS_H0B), (const bf16*)(ws + WS_WIN_T), NTOK, DIN, DM}; pg8::StaticOrder S; S.init(NTOK, DIN, (int)gridDim.x, (int)blockIdx.x);
        EpiProj E{(bf16*)(ws + WS_PROJ), (const float*)(ws + WS_RSTD1)};
        pg8::gemm_phase<EpiProj, pg8::StaticOrder, true, true>(lds, g, S, E);
    }
#endif
    SEAM(1);
#ifndef SKIP2
    if (IN(2)) phase_conv(P, lds);
#endif
    SEAM(2);
#ifndef SKIP3
    if (IN(3)) {
        pg8::Gemm g{(const bf16*)(ws + WS_Y), (const bf16*)(ws + WS_WOUT_T), NTOK, DM, DM}; pg8::StaticOrder S; S.init(NTOK, DM, (int)gridDim.x, (int)blockIdx.x);
        EpiResidual E{(bf16*)(ws + WS_H2B), (const bf16*)(ws + WS_H0B), (float*)(ws + WS_SSQ)};
        pg8::gemm_phase<EpiResidual, pg8::StaticOrder, true, true>(lds, g, S, E);
    }
#endif
    SEAM(3);
#ifndef SKIP4
    if (IN(4)) {
        pg8::Gemm g{(const bf16*)(ws + WS_H2B), (const bf16*)(ws + WS_WQ_T), NTOK, 2048, DM}; pg8::StaticOrder S; S.init(NTOK, 2048, (int)gridDim.x, (int)blockIdx.x);
        EpiRowScale<1> E{(bf16*)(ws + WS_Q), 2048, (const float*)(ws + WS_SSQ)};
        pg8::gemm_phase<EpiRowScale<1>, pg8::StaticOrder, true, true>(lds, g, S, E);
    }
#endif
    SEAM(4);
#ifndef SKIP5
    if (IN(5)) for (int rep = 0; rep < REP5; ++rep) phase_route(P, lds);
#endif
    SEAM(5);
    if (IN(6)) phase_gather_u(P);
    SEAM(6);
    if (IN(7)) phase_gather_v(P);
#undef IN
#undef SEAM
}

extern "C" void kernel_launch(void* const* d_in, const int* in_sizes, int n_in, void* d_out, int out_size, void* d_ws, size_t ws_size, hipStream_t stream) {
    static int grid = 0;
    if (grid == 0) {
        if (n_in != 18 || in_sizes[0] != NTOK * DM || out_size != NTOK * DM || ws_size < WS_END) {
            fprintf(stderr, "kernel_launch: unexpected shapes (n_in %d in0 %d out %d ws %zu)\n", n_in, n_in > 0 ? in_sizes[0] : -1, out_size, ws_size); grid = -1; return; }
        int dev = 0, cus = 0, per_cu = 0;
        (void)hipGetDevice(&dev); (void)hipDeviceGetAttribute(&cus, hipDeviceAttributeMultiprocessorCount, dev);
        if (hipFuncSetAttribute((const void*)mk_fwd, hipFuncAttributeMaxDynamicSharedMemorySize, LDS_BYTES) != hipSuccess) { fprintf(stderr, "kernel_launch: hipFuncSetAttribute failed\n"); grid = -1; return; }
        if (hipOccupancyMaxActiveBlocksPerMultiprocessor(&per_cu, (const void*)mk_fwd, NTHREADS, LDS_BYTES) != hipSuccess || per_cu < 1) { fprintf(stderr, "kernel_launch: occupancy query failed (%d)\n", per_cu); (void)hipGetLastError(); per_cu = 1; }
        if (per_cu > 1) per_cu = 1;
        grid = cus * per_cu;
        if (grid <= 0) grid = 256;
    }
    if (grid < 0) return;
    Params p{};
    p.x = (const float*)d_in[0]; p.meta = (const float*)d_in[1]; p.g_mix = (const float*)d_in[2]; p.w_in = (const float*)d_in[3]; p.sc_w = (const float*)d_in[4];
    p.cf_w = (const float*)d_in[5]; p.cf_b = (const float*)d_in[6]; p.ln_g = (const float*)d_in[7]; p.ln_b = (const float*)d_in[8]; p.g_sc = (const float*)d_in[9];
    p.g_cf = (const float*)d_in[10]; p.w_out = (const float*)d_in[11]; p.g_ffn = (const float*)d_in[12]; p.w_q = (const float*)d_in[13]; p.keys = (const float*)d_in[14];
    p.pu = (const float*)d_in[15]; p.pv = (const float*)d_in[16]; p.g_fin = (const float*)d_in[17];
    p.out = (float*)d_out; p.ws = (unsigned char*)d_ws;
    (void)hipMemsetAsync((char*)d_ws + WS_CTL, 0, 16384, stream);
#if MK_MULTI
    for (int ph = 0; ph < NPHASE; ++ph) { p.ph_lo = ph; p.ph_hi = ph + 1; p.coop = 0; p.pad = 0;
        hipLaunchKernelGGL(mk_fwd, dim3(grid), dim3(NTHREADS), LDS_BYTES, stream, p); }
#else
    p.ph_lo = 0; p.ph_hi = NPHASE; p.coop = 1; p.pad = 0;
    void* args[] = {&p};
    hipError_t e = hipLaunchCooperativeKernel((const void*)mk_fwd, dim3(grid), dim3(NTHREADS), args, LDS_BYTES, stream);
    if (e != hipSuccess) fprintf(stderr, "cooperative launch failed: %s (grid %d)\n", hipGetErrorString(e), grid);
#endif
}
```

```cpp
#include <hip/hip_runtime.h>
#include <hip/hip_cooperative_groups.h>
#include <cstdio>
#include <cstdint>
namespace cg = cooperative_groups;

namespace pg8 {
#define PG8_LAS __attribute__((address_space(3)))
typedef unsigned short bf16_t;
typedef short bf16x8 __attribute__((ext_vector_type(8)));
typedef float f32x4 __attribute__((ext_vector_type(4)));
typedef unsigned u32x4 __attribute__((ext_vector_type(4)));
constexpr int BM = 256, BK = 64, HALF = 128, HTB = HALF * BK * 2  , STAGE_BYTES = 8 * HTB, NXCD = 8, WGM = 8;

__host__ __device__ __forceinline__ int lds_byte(int r, int c) { const int st = (r >> 4) * 2 + (c >> 5), rr = r & 15, cc = c & 31, ob = rr * 64 + cc * 2; return st * 1024 + (ob ^ (((ob >> 9) & 1) << 5)); }
__host__ __device__ __forceinline__ void stage_rc(int b, int& R, int& C) { const int st = b / 1024, sb = b % 1024, swz = sb ^ (((sb >> 9) & 1) << 5); R = (st >> 1) * 16 + swz / 64; C = (st & 1) * 32 + (swz % 64) / 2; }
__host__ __device__ __forceinline__ int perm32(int rho) { const int n = rho >> 4, i = rho & 15; return 8 * (i >> 2) + 4 * n + (i & 3); }

struct Unit { int pm, pn; };
struct Gemm { const bf16_t* A; const bf16_t* Bt; int M, N, K; };

struct StaticOrder {
    int nM, nN, nwg, G, c;
    __host__ __device__ void init(int M, int N, int G_, int c_) { nM = M / BM; nN = N / BM; nwg = nM * nN; G = G_; c = c_; }
    __host__ __device__ bool next(int i, Unit& u) const {
        const long L = (long)i * G + c; if (L >= nwg) return false;
        int wgid = (int)L; { const int q = nwg / NXCD, r = nwg % NXCD, xcd = wgid % NXCD, off = wgid / NXCD; wgid = (xcd < r ? xcd * (q + 1) : r * (q + 1) + (xcd - r) * q) + off; }
        const int nig = WGM * nN, gid = wgid / nig, fm = gid * WGM, gsz = (nM - fm) < WGM ? (nM - fm) : WGM;
        u.pm = fm + ((wgid % nig) % gsz); u.pn = (wgid % nig) / gsz; return true;
    }
    __device__ __forceinline__ void a_ready(const Unit&) const {}
    __device__ __forceinline__ void done(const Unit&) const {}
};

template <class Epi, class Sched, bool ALIGN_EPI = false, bool SP2 = false>
__device__ __forceinline__ void gemm_phase(PG8_LAS unsigned char* lds, const Gemm g, const Sched& S, const Epi& E) {
    const int tid = threadIdx.x, wid = __builtin_amdgcn_readfirstlane(tid >> 6), lane = tid & 63, wr = wid >> 2, wc = wid & 3, fr = lane & 15, fq = lane >> 4;
    const int K = g.K, nt = K / BK;
    unsigned voffA[2], voffB[2];
#pragma unroll
    for (int i = 0; i < 2; ++i) { int R, C; stage_rc(tid * 16 + i * 8192, R, C); const int Rb = Epi::PERM ? ((R & ~31) + perm32(R & 31)) : R;
        voffA[i] = (unsigned)(R * K + C) * 2u; voffB[i] = (unsigned)(Rb * K + C) * 2u; }
    const size_t kstep = (size_t)(BK * 2);
    const size_t hstep = (size_t)HALF * K * 2;
    const size_t tstep = 2 * hstep;
    const unsigned ldsw = (unsigned)wid * 1024u;
    const int aoff = lds_byte(wr * 64 + fr, fq * 8), boff = lds_byte(wc * 32 + fr, fq * 8);
#define PG8_SA(b, h) (((b) * 2 + (h)) * HTB)
#define PG8_SB(b, h) ((4 + (b) * 2 + (h)) * HTB)
#define PG8_STAGE(bufoff, gbase, voff) do { _Pragma("unroll") for (int _i = 0; _i < 2; ++_i) \
        __builtin_amdgcn_global_load_lds((const unsigned*)((const char*)(gbase) + (voff)[_i]), (PG8_LAS unsigned*)(lds + (bufoff) + ldsw + _i * 8192), 16, 0, 0); } while (0)
#define PG8_LDA(dst, b, h) do { _Pragma("unroll") for (int m = 0; m < 4; ++m) _Pragma("unroll") for (int k = 0; k < 2; ++k) dst[m][k] = *(const PG8_LAS bf16x8*)(lds + PG8_SA(b, h) + aoff + m * 2048 + k * 1024); } while (0)
#define PG8_LDB(dst, b, h) do { _Pragma("unroll") for (int n = 0; n < 2; ++n) _Pragma("unroll") for (int k = 0; k < 2; ++k) dst[n][k] = *(const PG8_LAS bf16x8*)(lds + PG8_SB(b, h) + boff + n * 2048 + k * 1024); } while (0)
#define PG8_MMA(ai, bj, At, Bt) do { __builtin_amdgcn_s_setprio(1); _Pragma("unroll") for (int m = 0; m < 4; ++m) _Pragma("unroll") for (int n = 0; n < 2; ++n) _Pragma("unroll") for (int k = 0; k < 2; ++k) \
        acc[ai][bj][m][n] = __builtin_amdgcn_mfma_f32_16x16x32_bf16(Bt[n][k], At[m][k], acc[ai][bj][m][n], 0, 0, 0); __builtin_amdgcn_s_setprio(0); } while (0)
#define PG8_WAIT_V(n) asm volatile("s_waitcnt vmcnt(" #n ")" ::: "memory")
#define PG8_WAIT_L(n) asm volatile("s_waitcnt lgkmcnt(" #n ")" ::: "memory")
#define PG8_BAR __builtin_amdgcn_s_barrier()
#define PG8_SCHED __builtin_amdgcn_sched_barrier(0)
    Unit cur, nxt; int ui = 0;
    if (!S.next(0, cur)) return;
    f32x4 acc[2][2][4][2];
#pragma unroll
    for (int a = 0; a < 2; ++a)
#pragma unroll
        for (int b = 0; b < 2; ++b)
#pragma unroll
            for (int m = 0; m < 4; ++m)
#pragma unroll
                for (int n = 0; n < 2; ++n) acc[a][b][m][n] = (f32x4){0.f, 0.f, 0.f, 0.f};
    bf16x8 At[4][2], B0[2][2], B1[2][2];
    const char* cA = (const char*)g.A + (size_t)cur.pm * tstep; const char* cB = (const char*)g.Bt + (size_t)cur.pn * tstep;
    S.a_ready(cur);
    if constexpr (SP2) {
        PG8_STAGE(PG8_SB(0, 0), cB, voffB); PG8_STAGE(PG8_SB(0, 1), cB + hstep, voffB); PG8_STAGE(PG8_SA(0, 0), cA, voffA); PG8_STAGE(PG8_SA(0, 1), cA + hstep, voffA);
        if (wr == 1) PG8_BAR;
        PG8_WAIT_V(2); PG8_BAR;
        PG8_STAGE(PG8_SB(1, 0), cB + kstep, voffB); PG8_STAGE(PG8_SA(1, 0), cA + kstep, voffA); PG8_STAGE(PG8_SB(1, 1), cB + hstep + kstep, voffB);
        PG8_WAIT_V(6); PG8_BAR;
    } else {
        PG8_STAGE(PG8_SB(0, 0), cB, voffB); PG8_STAGE(PG8_SA(0, 0), cA, voffA); PG8_STAGE(PG8_SB(0, 1), cB + hstep, voffB); PG8_STAGE(PG8_SA(0, 1), cA + hstep, voffA);
        if (wr == 1) PG8_BAR;
        PG8_WAIT_V(4); PG8_BAR;
        PG8_STAGE(PG8_SB(1, 0), cB + kstep, voffB); PG8_STAGE(PG8_SA(1, 0), cA + kstep, voffA); PG8_STAGE(PG8_SB(1, 1), cB + hstep + kstep, voffB);
        PG8_WAIT_V(6); PG8_BAR;
    }
    for (;;) {
        const bool has_next = S.next(ui + 1, nxt);
        const char* nA = has_next ? (const char*)g.A + (size_t)nxt.pm * tstep : cA; const char* nB = has_next ? (const char*)g.Bt + (size_t)nxt.pn * tstep : cB;
        for (int t = 0; t < nt; t += 2) {
            const bool last = (t == nt - 2);
            const char* a1 = cA + (size_t)(t + 1) * kstep;
            const char* a2 = last ? nA : cA + (size_t)(t + 2) * kstep; const char* b2 = last ? nB : cB + (size_t)(t + 2) * kstep;
            const char* a3 = a2 + kstep; const char* b3 = b2 + kstep;
            if (last && has_next) S.a_ready(nxt);
            if constexpr (SP2) {
            PG8_LDB(B0, 0, 0); PG8_LDB(B1, 0, 1); PG8_SCHED; PG8_LDA(At, 0, 0); PG8_STAGE(PG8_SA(1, 1), a1 + hstep, voffA);
            PG8_WAIT_V(8); PG8_WAIT_L(0); PG8_BAR; PG8_MMA(0, 0, At, B0); PG8_MMA(0, 1, At, B1); PG8_BAR; PG8_SCHED;
            PG8_LDA(At, 0, 1); PG8_STAGE(PG8_SB(0, 0), b2, voffB); PG8_STAGE(PG8_SB(0, 1), b2 + hstep, voffB); PG8_STAGE(PG8_SA(0, 0), a2, voffA);
            PG8_WAIT_V(8); PG8_WAIT_L(0); PG8_BAR; PG8_MMA(1, 0, At, B0); PG8_MMA(1, 1, At, B1); PG8_BAR; PG8_SCHED;
            PG8_LDB(B0, 1, 0); PG8_LDB(B1, 1, 1); PG8_SCHED; PG8_LDA(At, 1, 0); PG8_STAGE(PG8_SA(0, 1), a2 + hstep, voffA);
            PG8_WAIT_V(8); PG8_WAIT_L(0); PG8_BAR; PG8_MMA(0, 0, At, B0); PG8_MMA(0, 1, At, B1); PG8_BAR; PG8_SCHED;
            PG8_LDA(At, 1, 1); PG8_STAGE(PG8_SB(1, 0), b3, voffB); PG8_STAGE(PG8_SB(1, 1), b3 + hstep, voffB); PG8_STAGE(PG8_SA(1, 0), a3, voffA);
            PG8_WAIT_V(8); PG8_WAIT_L(0); PG8_BAR; PG8_MMA(1, 0, At, B0); PG8_MMA(1, 1, At, B1); PG8_BAR; PG8_SCHED;
            } else {
            PG8_LDB(B0, 0, 0); PG8_SCHED; PG8_LDA(At, 0, 0); PG8_STAGE(PG8_SA(1, 1), a1 + hstep, voffA);
            PG8_WAIT_L(8); PG8_BAR; PG8_WAIT_L(0); PG8_MMA(0, 0, At, B0); PG8_BAR; PG8_SCHED;
            PG8_LDB(B1, 0, 1); PG8_STAGE(PG8_SB(0, 0), b2, voffB);
            PG8_BAR; PG8_WAIT_L(0); PG8_MMA(0, 1, At, B1); PG8_BAR;
            PG8_LDA(At, 0, 1); PG8_STAGE(PG8_SA(0, 0), a2, voffA);
            PG8_BAR; PG8_WAIT_L(0); PG8_MMA(1, 0, At, B0); PG8_BAR; PG8_SCHED;
            PG8_STAGE(PG8_SB(0, 1), b2 + hstep, voffB);
            PG8_WAIT_V(6); PG8_BAR; PG8_MMA(1, 1, At, B1); PG8_BAR;
            PG8_LDB(B0, 1, 0); PG8_SCHED; PG8_LDA(At, 1, 0); PG8_STAGE(PG8_SA(0, 1), a2 + hstep, voffA);
            PG8_WAIT_L(8); PG8_BAR; PG8_WAIT_L(0); PG8_MMA(0, 0, At, B0); PG8_BAR; PG8_SCHED;
            PG8_LDB(B1, 1, 1); PG8_STAGE(PG8_SB(1, 0), b3, voffB);
            PG8_BAR; PG8_WAIT_L(0); PG8_MMA(0, 1, At, B1); PG8_BAR;
            PG8_LDA(At, 1, 1); PG8_STAGE(PG8_SA(1, 0), a3, voffA);
            PG8_BAR; PG8_WAIT_L(0); PG8_MMA(1, 0, At, B0); PG8_BAR; PG8_SCHED;
            PG8_STAGE(PG8_SB(1, 1), b3 + hstep, voffB);
            PG8_WAIT_V(6); PG8_BAR; PG8_MMA(1, 1, At, B1); PG8_BAR;
            }
        }
        if constexpr (ALIGN_EPI) { if (wr == 0) PG8_BAR; }
        if constexpr (!Epi::AFTER_DRAIN) { E(acc, cur, wr, wc, fr, fq); S.done(cur); }
        if (!has_next) break;
#pragma unroll
        for (int a = 0; a < 2; ++a)
#pragma unroll
            for (int b = 0; b < 2; ++b)
#pragma unroll
                for (int m = 0; m < 4; ++m)
#pragma unroll
                    for (int n = 0; n < 2; ++n) acc[a][b][m][n] = (f32x4){0.f, 0.f, 0.f, 0.f};
        cur = nxt; cA = nA; cB = nB; ++ui;
        if constexpr (ALIGN_EPI) { if (wr == 1) PG8_BAR; }
    }
    PG8_WAIT_V(0);
    if constexpr (!ALIGN_EPI) { if (wr == 0) PG8_BAR; }
    PG8_BAR;
    if constexpr (Epi::AFTER_DRAIN) { E.fused(acc, cur, wr, wc, fr, fq, lds, wid, lane); S.done(cur); }
#undef PG8_SA
#undef PG8_SB
#undef PG8_STAGE
#undef PG8_LDA
#undef PG8_LDB
#undef PG8_MMA
#undef PG8_WAIT_V
#undef PG8_WAIT_L
#undef PG8_BAR
#undef PG8_SCHED
}
}

#define LAS __attribute__((address_space(3)))
typedef unsigned short bf16;
typedef float f32x2 __attribute__((ext_vector_type(2)));
typedef float f32x4 __attribute__((ext_vector_type(4)));
typedef unsigned u32x2 __attribute__((ext_vector_type(2)));
typedef unsigned u32x4 __attribute__((ext_vector_type(4)));

constexpr int PDIM = 1536;
constexpr int NTOK = 32768, DM = 1024, DIN = 2560, SEQ = 8192, NBATCH = 4, NMETA = 16;
constexpr int NHEAD = 8, NKEYS = 128, TOPK = 16, NSEL = NHEAD * TOPK;
constexpr float EPS = 1e-6f;
constexpr float U_SCALE = 64.f, V_SCALE = 16.f;
constexpr int NWAVES = 8, NTHREADS = 512;
constexpr int MKC = 32;
constexpr int LDS_BYTES = 147456;

constexpr size_t MiB = 1u << 20;
constexpr size_t WS_CTL = 0, WS_WIN_T = 1 * MiB, WS_WOUT_T = 6 * MiB, WS_WQ_T = 8 * MiB, WS_KEYS = 12 * MiB, WS_METAPART = 160 * MiB  ,
                 WS_METARSTD = 14 * MiB + 512 * 1024, WS_METAPROJ = 14 * MiB + 576 * 1024, WS_RSTD1 = 15 * MiB, WS_SSQ = 16 * MiB, WS_U8 = 32 * MiB, WS_V8 = 48 * MiB,
                 WS_IDX = 64 * MiB, WS_GATE = 80 * MiB, WS_H0B = 96 * MiB, WS_H2B = 96 * MiB, WS_Y = 160 * MiB, WS_PROJ = 224 * MiB,
                 WS_Q = 224 * MiB, WS_ESCALE = 18 * MiB, WS_AW = 160 * MiB  , WS_END = 384 * MiB;

struct Params {
    const float* x; const float* meta; const float* g_mix; const float* w_in; const float* sc_w; const float* cf_w; const float* cf_b;
    const float* ln_g; const float* ln_b; const float* g_sc; const float* g_cf; const float* w_out; const float* g_ffn; const float* w_q;
    const float* keys; const float* pu; const float* pv; const float* g_fin;
    float* out; unsigned char* ws;
    int ph_lo, ph_hi, coop, pad;
};

__device__ __forceinline__ unsigned f2bf(float f) { unsigned u = __builtin_bit_cast(unsigned, f); return (u + 0x7fffu + ((u >> 16) & 1u)) >> 16; }
__device__ __forceinline__ unsigned pk2(float lo, float hi) { return f2bf(lo) | (f2bf(hi) << 16); }
__device__ __forceinline__ float bf2f(unsigned b) { return __builtin_bit_cast(float, b << 16); }
__device__ __forceinline__ float bflo(unsigned w) { return __builtin_bit_cast(float, w << 16); }
__device__ __forceinline__ float bfhi(unsigned w) { return __builtin_bit_cast(float, w & 0xffff0000u); }
__device__ __forceinline__ float wave_sum(float v) {
#pragma unroll
    for (int o = 1; o < 64; o <<= 1) v += __shfl_xor(v, o);
    return v;
}
template <int CTRL> __device__ __forceinline__ float dpp_f(float v) { return __builtin_bit_cast(float, __builtin_amdgcn_update_dpp(0, __builtin_bit_cast(int, v), CTRL, 0xf, 0xf, true)); }
__device__ __forceinline__ float wave_sum_fast(float v) {
    v += dpp_f<0xB1>(v); v += dpp_f<0x4E>(v); v += dpp_f<0x141>(v); v += dpp_f<0x140>(v);
    { auto r = __builtin_amdgcn_permlane16_swap(__float_as_uint(v), __float_as_uint(v), false, false); v = __uint_as_float(r[0]) + __uint_as_float(r[1]); }
    { auto r = __builtin_amdgcn_permlane32_swap(__float_as_uint(v), __float_as_uint(v), false, false); v = __uint_as_float(r[0]) + __uint_as_float(r[1]); }
    return v;
}
__device__ __forceinline__ float sigmoid_f(float x) { return 1.f / (1.f + __expf(-x)); }
__device__ __forceinline__ float gelu_tanh_f(float x) {
    const float t = 0.7978845608028654f * (x + 0.044715f * x * x * x);
    const float e = __expf(2.f * t);
    const float th = 1.f - 2.f / (e + 1.f);
    return 0.5f * x * (1.f + th);
}

__device__ __forceinline__ unsigned cvt_pk_bf16(float lo, float hi) { unsigned r; asm volatile("v_cvt_pk_bf16_f32 %0, %1, %2" : "=v"(r) : "v"(lo), "v"(hi)); return r; }

template <int MODE> struct EpiRowScale {
    static constexpr bool PERM = true, AFTER_DRAIN = false;
    bf16* O; int ldc; const float* rs;
    __device__ __forceinline__ void operator()(const pg8::f32x4 (&acc)[2][2][4][2], const pg8::Unit& u, int wr, int wc, int fr, int fq) const {
        const int row0 = u.pm * 256 + wr * 64 + fr, col0 = u.pn * 256 + wc * 32 + 8 * fq;
#pragma unroll
        for (int ai = 0; ai < 2; ++ai)
#pragma unroll
            for (int m = 0; m < 4; ++m) {
                const int row = row0 + ai * 128 + m * 16;
                float s;
                if (MODE == 0) s = rs[row];
                else { const f32x4* p = (const f32x4*)(rs + (size_t)row * 16); const f32x4 a = p[0], b = p[1], c = p[2], d = p[3];
                       const float t = ((a.x + a.y) + (a.z + a.w)) + ((b.x + b.y) + (b.z + b.w)) + ((c.x + c.y) + (c.z + c.w)) + ((d.x + d.y) + (d.z + d.w));
                       s = rsqrtf(t * (1.f / 1024.f) + EPS); }
                bf16* rowp = O + (size_t)row * ldc + col0;
#pragma unroll
                for (int bj = 0; bj < 2; ++bj) { const pg8::f32x4 v0 = acc[ai][bj][m][0] * s, v1 = acc[ai][bj][m][1] * s;
                    u32x4 w; w.x = cvt_pk_bf16(v0[0], v0[1]); w.y = cvt_pk_bf16(v0[2], v0[3]); w.z = cvt_pk_bf16(v1[0], v1[1]); w.w = cvt_pk_bf16(v1[2], v1[3]);
                    *(u32x4*)(rowp + bj * 128) = w; }
            }
    }
};
struct EpiProj {
    static constexpr bool PERM = true, AFTER_DRAIN = false;
    bf16* O; const float* rs;
    __device__ __forceinline__ void operator()(const pg8::f32x4 (&acc)[2][2][4][2], const pg8::Unit& u, int wr, int wc, int fr, int fq) const {
        const int row0 = u.pm * 256 + wr * 64 + fr, cin = wc * 32 + 8 * fq, pn = u.pn;
#pragma unroll
        for (int ai = 0; ai < 2; ++ai)
#pragma unroll
            for (int m = 0; m < 4; ++m) {
                const int row = row0 + ai * 128 + m * 16; const float sc = rs[row];
                float a[8], b[8];
#pragma unroll
                for (int i = 0; i < 4; ++i) { a[i] = acc[ai][0][m][0][i] * sc; a[4 + i] = acc[ai][0][m][1][i] * sc; b[i] = acc[ai][1][m][0][i] * sc; b[4 + i] = acc[ai][1][m][1][i] * sc; }
                bf16* rowp = O + (size_t)row * PDIM;
                if (pn >= 4 && pn < 6) {
                    u32x4 w0, w1; w0.x = cvt_pk_bf16(a[0], a[1]); w0.y = cvt_pk_bf16(a[2], a[3]); w0.z = cvt_pk_bf16(a[4], a[5]); w0.w = cvt_pk_bf16(a[6], a[7]);
                    w1.x = cvt_pk_bf16(b[0], b[1]); w1.y = cvt_pk_bf16(b[2], b[3]); w1.z = cvt_pk_bf16(b[4], b[5]); w1.w = cvt_pk_bf16(b[6], b[7]);
                    *(u32x4*)(rowp + 512 + 256 * (pn - 4) + cin) = w0; *(u32x4*)(rowp + 512 + 256 * (pn - 4) + 128 + cin) = w1;
                } else {
                    float o[8];
                    if (pn < 4) {
#pragma unroll
                        for (int i = 0; i < 8; ++i) o[i] = a[i] * b[i];
                    } else {
#pragma unroll
                        for (int i = 0; i < 8; ++i) o[i] = a[i] * sigmoid_f(b[i]);
                    }
                    u32x4 w; w.x = cvt_pk_bf16(o[0], o[1]); w.y = cvt_pk_bf16(o[2], o[3]); w.z = cvt_pk_bf16(o[4], o[5]); w.w = cvt_pk_bf16(o[6], o[7]);
                    *(u32x4*)(rowp + (pn < 4 ? 128 * pn : 1024 + 128 * (pn - 6)) + cin) = w;
                }
            }
    }
};
__host__ __device__ __forceinline__ int win_src_col(int n) {
    const int t = n >> 8, j = n & 255;
    if (t < 4) return (j < 128) ? 128 * t + j : 1024 + 128 * t + (j - 128);
    if (t < 6) return 512 + 256 * (t - 4) + j;
    return (j < 128) ? 1536 + 128 * (t - 6) + j : 2048 + 128 * (t - 6) + (j - 128);
}
struct EpiResidual {
    static constexpr bool PERM = true, AFTER_DRAIN = false;
    bf16* O; const bf16* XB; float* ssq;
    __device__ __forceinline__ void operator()(const pg8::f32x4 (&acc)[2][2][4][2], const pg8::Unit& u, int wr, int wc, int fr, int fq) const {
        const int row0 = u.pm * 256 + wr * 64 + fr, col0 = u.pn * 256 + wc * 32 + 8 * fq;
#pragma unroll
        for (int ai = 0; ai < 2; ++ai)
#pragma unroll
            for (int m = 0; m < 4; ++m) {
                const int row = row0 + ai * 128 + m * 16;
                const bf16* xr = XB + (size_t)row * DM + col0; bf16* rowp = O + (size_t)row * DM + col0;
                float q = 0.f;
                u32x4 xw[2];
#pragma unroll
                for (int bj = 0; bj < 2; ++bj) xw[bj] = *(const u32x4*)(xr + bj * 128);
#pragma unroll
                for (int bj = 0; bj < 2; ++bj) { const f32x4 x0 = (f32x4){bflo(xw[bj].x), bfhi(xw[bj].x), bflo(xw[bj].y), bfhi(xw[bj].y)}, x1 = (f32x4){bflo(xw[bj].z), bfhi(xw[bj].z), bflo(xw[bj].w), bfhi(xw[bj].w)};
                    const pg8::f32x4 v0 = acc[ai][bj][m][0] + x0, v1 = acc[ai][bj][m][1] + x1;
                    q += (v0[0] * v0[0] + v0[1] * v0[1]) + (v0[2] * v0[2] + v0[3] * v0[3]) + (v1[0] * v1[0] + v1[1] * v1[1]) + (v1[2] * v1[2] + v1[3] * v1[3]);
                    u32x4 w; w.x = cvt_pk_bf16(v0[0], v0[1]); w.y = cvt_pk_bf16(v0[2], v0[3]); w.z = cvt_pk_bf16(v1[0], v1[1]); w.w = cvt_pk_bf16(v1[2], v1[3]);
                    *(u32x4*)(rowp + bj * 128) = w; }
                q += __shfl_xor(q, 16); q += __shfl_xor(q, 32);
                if (fq == 0) ssq[(size_t)row * 16 + u.pn * 4 + wc] = q;
            }
    }
};

template <bool MAPIN> __device__ __forceinline__ void p0_transpose_item(const float* W, int K, int N, bf16* WT, LAS float* scr, int item, int lane,
                                                  const float* g_lo, const float* g_hi, int split) {
    const int nblk = N / 32, kb = item / nblk, nb = item % nblk, k0 = 64 * kb, n0 = 32 * nb;
#pragma unroll 8
    for (int i = 0; i < 32; ++i) { const int kk = 2 * i + (lane >> 5); const int k = k0 + kk;
        const float g = (k < split) ? g_lo[k] : g_hi[k - split];
        scr[kk * 33 + (lane & 31)] = W[(size_t)k * N + (MAPIN ? win_src_col(n0) : n0) + (lane & 31)] * g; }
    asm volatile("s_waitcnt lgkmcnt(0)" ::: "memory");
    const int c = lane & 7;
#pragma unroll
    for (int j = 0; j < 4; ++j) { const int n = (lane >> 3) + 8 * j; const LAS float* s = scr + (8 * c) * 33 + n;
        u32x4 o; o.x = pk2(s[0 * 33], s[1 * 33]); o.y = pk2(s[2 * 33], s[3 * 33]); o.z = pk2(s[4 * 33], s[5 * 33]); o.w = pk2(s[6 * 33], s[7 * 33]);
        *(u32x4*)(WT + (size_t)(n0 + n) * K + k0 + 8 * c) = o; }
    asm volatile("s_waitcnt lgkmcnt(0)" ::: "memory");
}

__device__ __forceinline__ float q4(float x, float inv_s) {
    const float a = fabsf(x) * inv_s; float r;
    if (a < 2.f) r = rintf(a * 2.f) * 0.5f; else if (a < 4.f) r = rintf(a); else r = fminf(6.f, rintf(a * 0.5f) * 2.f);
    return copysignf(r, x);
}
__device__ __forceinline__ void phase_prep(const Params& P, LAS unsigned char* lds) {
    const int tid = threadIdx.x, lane = tid & 63, wave = __builtin_amdgcn_readfirstlane(tid >> 6);
    const int gw = blockIdx.x * NWAVES + wave, NGW = gridDim.x * NWAVES;
    unsigned char* ws = P.ws;
    LAS float* scr = (LAS float*)(lds + wave * 16384);
    constexpr int I_IN = (DM / 64) * (DIN / 32), I_OUT = (DM / 64) * (DM / 32), I_Q = (DM / 64) * (2048 / 32);
    for (int it = gw; it < I_IN + I_OUT + I_Q; it += NGW) {
        int r = it;
        if (r < I_IN) { p0_transpose_item<true>(P.w_in, DM, DIN, (bf16*)(ws + WS_WIN_T), scr, r, lane, P.g_mix, P.g_mix, DM); continue; } r -= I_IN;
        if (r < I_OUT) { p0_transpose_item<false>(P.w_out, DM, DM, (bf16*)(ws + WS_WOUT_T), scr, r, lane, P.g_sc, P.g_cf, 512); continue; } r -= I_OUT;
        p0_transpose_item<false>(P.w_q, DM, 2048, (bf16*)(ws + WS_WQ_T), scr, r, lane, P.g_ffn, P.g_ffn, DM);
    }
    {
        bf16* H0B = (bf16*)(ws + WS_H0B); float* RSTD1 = (float*)(ws + WS_RSTD1);
        for (int t0 = gw * 4; t0 < NTOK; t0 += NGW * 4) {
            f32x4 v[4][4];
#pragma unroll
            for (int q = 0; q < 4; ++q) { const f32x4* xr = (const f32x4*)(P.x + (size_t)(t0 + q) * DM) + lane;
#pragma unroll
                for (int j = 0; j < 4; ++j) v[q][j] = xr[64 * j]; }
#pragma unroll
            for (int q = 0; q < 4; ++q) { float sq = 0.f;
#pragma unroll
                for (int j = 0; j < 4; ++j) sq += (v[q][j].x * v[q][j].x + v[q][j].y * v[q][j].y) + (v[q][j].z * v[q][j].z + v[q][j].w * v[q][j].w);
                sq = wave_sum_fast(sq);
                if (lane == 0) RSTD1[t0 + q] = rsqrtf(sq * (1.f / DM) + EPS);
                u32x2* o = (u32x2*)(H0B + (size_t)(t0 + q) * DM) + lane;
#pragma unroll
                for (int j = 0; j < 4; ++j) { u32x2 w; w.x = pk2(v[q][j].x, v[q][j].y); w.y = pk2(v[q][j].z, v[q][j].w); o[64 * j] = w; } }
        }
    }
    {
        unsigned char* U8 = ws + WS_U8; unsigned char* V8 = ws + WS_V8;
        f32x4 gf[4];
#pragma unroll
        for (int j = 0; j < 4; ++j) gf[j] = ((const f32x4*)P.g_ffn)[64 * j + lane];
        float* ESC = (float*)(ws + WS_ESCALE);
        for (int e0 = gw * 2; e0 < 2 * 16384; e0 += NGW * 2) {
            const bool isv = e0 >= 16384; const int ee0 = isv ? e0 - 16384 : e0;
            f32x4 v[2][4];
#pragma unroll
            for (int q = 0; q < 2; ++q) { const f32x4* src = (const f32x4*)((isv ? P.pv : P.pu) + (size_t)(ee0 + q) * DM) + lane;
#pragma unroll
                for (int j = 0; j < 4; ++j) v[q][j] = src[64 * j]; }
#pragma unroll
            for (int q = 0; q < 2; ++q) {
                float mx = 0.f;
#pragma unroll
                for (int j = 0; j < 4; ++j) { if (!isv) v[q][j] = v[q][j] * gf[j];
                    mx = fmaxf(mx, fmaxf(fmaxf(fabsf(v[q][j].x), fabsf(v[q][j].y)), fmaxf(fabsf(v[q][j].z), fabsf(v[q][j].w)))); }
#pragma unroll
                for (int o = 1; o < 64; o <<= 1) mx = fmaxf(mx, __shfl_xor(mx, o));
                const float sc = fmaxf(mx, 1e-30f) * (1.f / 6.f), inv = 1.f / sc;
                if (lane == 0) ESC[e0 + q] = sc;
                unsigned w0 = 0u, w1 = 0u;
                w0 = __builtin_amdgcn_cvt_scalef32_pk_fp4_f32(w0, v[q][0].x * inv, v[q][0].y * inv, 1.0f, 0); w0 = __builtin_amdgcn_cvt_scalef32_pk_fp4_f32(w0, v[q][0].z * inv, v[q][0].w * inv, 1.0f, 1);
                w0 = __builtin_amdgcn_cvt_scalef32_pk_fp4_f32(w0, v[q][1].x * inv, v[q][1].y * inv, 1.0f, 2); w0 = __builtin_amdgcn_cvt_scalef32_pk_fp4_f32(w0, v[q][1].z * inv, v[q][1].w * inv, 1.0f, 3);
                w1 = __builtin_amdgcn_cvt_scalef32_pk_fp4_f32(w1, v[q][2].x * inv, v[q][2].y * inv, 1.0f, 0); w1 = __builtin_amdgcn_cvt_scalef32_pk_fp4_f32(w1, v[q][2].z * inv, v[q][2].w * inv, 1.0f, 1);
                w1 = __builtin_amdgcn_cvt_scalef32_pk_fp4_f32(w1, v[q][3].x * inv, v[q][3].y * inv, 1.0f, 2); w1 = __builtin_amdgcn_cvt_scalef32_pk_fp4_f32(w1, v[q][3].z * inv, v[q][3].w * inv, 1.0f, 3);
                u32x2 o; o.x = w0; o.y = w1;
                *(u32x2*)((isv ? V8 : U8) + (size_t)(ee0 + q) * 512 + 8 * lane) = o;
            }
        }
    }
    {
        bf16* KB = (bf16*)(ws + WS_KEYS);
        const int gt = blockIdx.x * NTHREADS + tid, NGT = gridDim.x * NTHREADS;
        for (int i = gt; i < 8 * 2 * 128 * 128 / 4; i += NGT) { const f32x4 v = ((const f32x4*)P.keys)[i]; u32x2 w; w.x = pk2(v.x, v.y); w.y = pk2(v.z, v.w); ((u32x2*)KB)[i] = w; }
    }
    {
        float* MP = (float*)(ws + WS_METAPART); float* MR = (float*)(ws + WS_METARSTD);
        for (int r = gw; r < NMETA; r += NGW) {
            float s = 0.f;
            for (int k = lane; k < DM; k += 64) { const float v = P.meta[r * DM + k]; s += v * v; }
            s = wave_sum(s);
            if (lane == 0) MR[r] = rsqrtf(s * (1.f / DM) + EPS);
        }
        for (int it = gw; it < MKC * 40; it += NGW) {
            const int kc = it / 40, nb = it % 40, n = nb * 64 + lane;
            float acc[NMETA];
#pragma unroll
            for (int r = 0; r < NMETA; ++r) acc[r] = 0.f;
            for (int k = kc * (DM / MKC); k < (kc + 1) * (DM / MKC); ++k) {
                const float w = P.w_in[(size_t)k * DIN + n] * P.g_mix[k];
#pragma unroll
                for (int r = 0; r < NMETA; ++r) acc[r] += P.meta[r * DM + k] * w;
            }
#pragma unroll
            for (int r = 0; r < NMETA; ++r) MP[(size_t)(kc * 16 + r) * DIN + n] = acc[r];
        }
    }
}

__device__ __forceinline__ float metaraw(const float* MP, const float* MR, int p, int col) { float s = 0.f;
#pragma unroll 8
    for (int kc = 0; kc < MKC; ++kc) s += MP[(size_t)(kc * 16 + p) * DIN + col];
    return s * MR[p]; }
__device__ __forceinline__ void phase_metaproj(const Params& P) {
    const float* MP = (const float*)(P.ws + WS_METAPART); const float* MR = (const float*)(P.ws + WS_METARSTD); float* MJ = (float*)(P.ws + WS_METAPROJ);
    for (int gt = blockIdx.x * NTHREADS + threadIdx.x; gt < NMETA * PDIM; gt += gridDim.x * NTHREADS) { const int p = gt / PDIM, c = gt % PDIM; float v;
        if (c < 512) v = metaraw(MP, MR, p, c) * metaraw(MP, MR, p, 1024 + c);
        else if (c < 1024) v = metaraw(MP, MR, p, c);
        else v = metaraw(MP, MR, p, 1536 + (c - 1024)) * sigmoid_f(metaraw(MP, MR, p, 2048 + (c - 1024)));
        MJ[gt] = v; }
}
__device__ __forceinline__ float meta_val(const float* MJ, const float*, int p, int col) { return MJ[p * PDIM + col]; }
__device__ __forceinline__ float proj_at(const bf16* PROJ, const float* MP, const float* MR, int b, int pos, int col) {
    if (pos < 0) return 0.f;
    if (pos < NMETA) return meta_val(MP, MR, pos, col);
    return bf2f(PROJ[(size_t)(b * SEQ + pos - NMETA) * PDIM + col]);
}
__device__ __forceinline__ void proj8_at(const bf16* PROJ, const float* MP, const float* MR, int b, int pos, int col, float (&v)[8]) {
    if (pos < 0) {
#pragma unroll
        for (int i = 0; i < 8; ++i) v[i] = 0.f;
    } else if (pos < NMETA) {
        const f32x4 a = *(const f32x4*)(MP + pos * PDIM + col), bq = *(const f32x4*)(MP + pos * PDIM + col + 4);
        v[0] = a.x; v[1] = a.y; v[2] = a.z; v[3] = a.w; v[4] = bq.x; v[5] = bq.y; v[6] = bq.z; v[7] = bq.w;
    } else {
        const u32x4 w = *(const u32x4*)(PROJ + (size_t)(b * SEQ + pos - NMETA) * PDIM + col);
        v[0] = bflo(w.x); v[1] = bfhi(w.x); v[2] = bflo(w.y); v[3] = bfhi(w.y); v[4] = bflo(w.z); v[5] = bfhi(w.z); v[6] = bflo(w.w); v[7] = bfhi(w.w);
    }
}

template <int R> __device__ __forceinline__ void conv_rows(const LAS unsigned char* ubase, const f32x2 (&wcf)[31], f32x2 (&acc)[32]) {
    if constexpr (R < 62) {
        const unsigned uw = *(const LAS unsigned*)(ubase + R * 1024);
        const f32x2 x = (f32x2){bflo(uw), bfhi(uw)};
        constexpr int lo = R > 30 ? R - 30 : 0, hi = R < 31 ? R : 31;
#pragma unroll
        for (int ii = lo; ii <= hi; ++ii) acc[ii] += wcf[R - ii] * x;
        conv_rows<R + 1>(ubase, wcf, acc);
    }
}
__device__ __forceinline__ void phase_conv(const Params& P, LAS unsigned char* lds) {
    const int tid = threadIdx.x, lane = tid & 63, wave = __builtin_amdgcn_readfirstlane(tid >> 6);
    unsigned char* ws = P.ws;
    const bf16* PROJ = (const bf16*)(ws + WS_PROJ); const float* MP = (const float*)(ws + WS_METAPROJ); const float* MR = nullptr;
    bf16* Y = (bf16*)(ws + WS_Y);
    constexpr int TT = 64, NTILE = NTOK / TT, UROWS = TT + 30;
    const int cgp = wave & 3, th = wave >> 2, ch2 = cgp * 128 + 2 * lane;
    f32x2 wcf[31];
#pragma unroll
    for (int j = 0; j < 31; ++j) wcf[j] = *(const f32x2*)(P.cf_w + j * 512 + ch2);
    const f32x2 bcf = *(const f32x2*)(P.cf_b + ch2);
    for (int tile = blockIdx.x; tile < NTILE; tile += gridDim.x) {
        const int b = tile / (SEQ / TT), s0 = (tile % (SEQ / TT)) * TT;
#pragma unroll 4
        for (int p = 0; p < (UROWS + 7) / 8; ++p) {
            const int r = p * 8 + wave;
            if (r < UROWS) {
                const int pos = NMETA + s0 - 30 + r;
                float uu[8];
                proj8_at(PROJ, MP, MR, b, pos, 1024 + 8 * lane, uu);
                u32x4 w; w.x = pk2(uu[0], uu[1]); w.y = pk2(uu[2], uu[3]); w.z = pk2(uu[4], uu[5]); w.w = pk2(uu[6], uu[7]);
                *(LAS u32x4*)(lds + r * 1024 + lane * 16) = w;
            }
        }
        __syncthreads();
        f32x2 acc[32];
#pragma unroll
        for (int ii = 0; ii < 32; ++ii) acc[ii] = bcf;
        conv_rows<0>(lds + (32 * th) * 1024 + ch2 * 2, wcf, acc);
        __syncthreads();
#pragma unroll
        for (int ii = 0; ii < 32; ++ii) *(LAS f32x2*)(lds + (32 * th + ii) * 2048 + ch2 * 4) = acc[ii];
        __syncthreads();
        {
            float lng[8], lnb[8];
            { const f32x4 a = *(const f32x4*)(P.ln_g + 8 * lane), c = *(const f32x4*)(P.ln_g + 8 * lane + 4), d = *(const f32x4*)(P.ln_b + 8 * lane), e = *(const f32x4*)(P.ln_b + 8 * lane + 4);
              lng[0] = a.x; lng[1] = a.y; lng[2] = a.z; lng[3] = a.w; lng[4] = c.x; lng[5] = c.y; lng[6] = c.z; lng[7] = c.w;
              lnb[0] = d.x; lnb[1] = d.y; lnb[2] = d.z; lnb[3] = d.w; lnb[4] = e.x; lnb[5] = e.y; lnb[6] = e.z; lnb[7] = e.w; }
            float wsc[3][8];
#pragma unroll
            for (int j = 0; j < 3; ++j) { const f32x4 a = *(const f32x4*)(P.sc_w + j * 512 + 8 * lane), c = *(const f32x4*)(P.sc_w + j * 512 + 8 * lane + 4);
                wsc[j][0] = a.x; wsc[j][1] = a.y; wsc[j][2] = a.z; wsc[j][3] = a.w; wsc[j][4] = c.x; wsc[j][5] = c.y; wsc[j][6] = c.z; wsc[j][7] = c.w; }
            float cxa[8], cxb[8];
            { const int pos = NMETA + s0 + 8 * wave - 2;
              proj8_at(PROJ, MP, MR, b, pos, 8 * lane, cxa); proj8_at(PROJ, MP, MR, b, pos + 1, 8 * lane, cxb); }
#pragma unroll 2
            for (int q = 0; q < 8; ++q) {
                const int ii = 8 * wave + q, s = s0 + ii; const size_t t = (size_t)b * SEQ + s;
                float o[8];
                { const f32x4 a = *(const LAS f32x4*)(lds + ii * 2048 + lane * 32), c = *(const LAS f32x4*)(lds + ii * 2048 + lane * 32 + 16);
                  o[0] = a.x; o[1] = a.y; o[2] = a.z; o[3] = a.w; o[4] = c.x; o[5] = c.y; o[6] = c.z; o[7] = c.w; }
                float s1 = 0.f;
#pragma unroll
                for (int i = 0; i < 8; ++i) s1 += o[i];
                const float mean = wave_sum_fast(s1) * (1.f / 512.f);
                float s2 = 0.f;
#pragma unroll
                for (int i = 0; i < 8; ++i) { o[i] -= mean; s2 += o[i] * o[i]; }
                const float rs = rsqrtf(wave_sum_fast(s2) * (1.f / 512.f) + EPS);
                float s3 = 0.f;
#pragma unroll
                for (int i = 0; i < 8; ++i) { float y = o[i] * rs * lng[i] + lnb[i]; y = y * sigmoid_f(y); o[i] = y; s3 += y * y; }
                const float r2 = rsqrtf(wave_sum_fast(s3) * (1.f / 512.f) + EPS);
                u32x4 wv; wv.x = pk2(o[0] * r2, o[1] * r2); wv.y = pk2(o[2] * r2, o[3] * r2); wv.z = pk2(o[4] * r2, o[5] * r2); wv.w = pk2(o[6] * r2, o[7] * r2);
                *(u32x4*)(Y + t * DM + 512 + 8 * lane) = wv;
                float bgv[8], cxc[8], accs[8];
                proj8_at(PROJ, MP, MR, b, NMETA + s, 8 * lane, cxc); proj8_at(PROJ, MP, MR, b, NMETA + s, 512 + 8 * lane, bgv);
                float s4 = 0.f;
#pragma unroll
                for (int i = 0; i < 8; ++i) { accs[i] = bgv[i] * (wsc[0][i] * cxa[i] + wsc[1][i] * cxb[i] + wsc[2][i] * cxc[i]); s4 += accs[i] * accs[i]; cxa[i] = cxb[i]; cxb[i] = cxc[i]; }
                const float r4 = rsqrtf(wave_sum_fast(s4) * (1.f / 512.f) + EPS);
                u32x4 wz; wz.x = pk2(accs[0] * r4, accs[1] * r4); wz.y = pk2(accs[2] * r4, accs[3] * r4); wz.z = pk2(accs[4] * r4, accs[5] * r4); wz.w = pk2(accs[6] * r4, accs[7] * r4);
                *(u32x4*)(Y + t * DM + 8 * lane) = wz;
            }
        }
        __syncthreads();
    }
}

__device__ __forceinline__ int ord_i(float s) { int k = __builtin_bit_cast(int, s); k ^= (k >> 31) & 0x7fffffff; return k; }
__device__ __forceinline__ float unord_f(int k) { k ^= (k >> 31) & 0x7fffffff; return __builtin_bit_cast(float, k); }
#define TOP_INSERT(L, x_) do { int _x = (x_); _Pragma("unroll") for (int _i = 0; _i < 16; ++_i) { const int _hi = max(L[_i], _x); _x = min(L[_i], _x); L[_i] = _hi; } } while (0)

typedef short bf16x8 __attribute__((ext_vector_type(8)));
typedef float f32x16 __attribute__((ext_vector_type(16)));
template <bool DESC> __device__ __forceinline__ void ce_i(int& a, int& b) { const int hi = max(a, b), lo = min(a, b); if (DESC) { a = hi; b = lo; } else { a = lo; b = hi; } }
__device__ __forceinline__ void bitonic_sort16(int (&a)[16]) {
#pragma unroll
    for (int k = 2; k <= 16; k <<= 1)
#pragma unroll
        for (int j = k >> 1; j > 0; j >>= 1)
#pragma unroll
            for (int i = 0; i < 16; ++i) { const int l = i ^ j; if (l > i) { if ((i & k) == 0) ce_i<true>(a[i], a[l]); else ce_i<false>(a[i], a[l]); } }
}
__device__ __forceinline__ void bitonic_merge16(int (&a)[16]) {
#pragma unroll
    for (int j = 8; j > 0; j >>= 1)
#pragma unroll
        for (int i = 0; i < 16; ++i) { const int l = i ^ j; if (l > i) ce_i<true>(a[i], a[l]); }
}
__device__ __forceinline__ void merge_top16(int (&a)[16], const int (&b)[16]) {
#pragma unroll
    for (int i = 0; i < 16; ++i) a[i] = max(a[i], b[15 - i]);
    bitonic_merge16(a);
}
__device__ __forceinline__ int lut16(const unsigned (&T)[4], int i) {
    const unsigned sel = (unsigned)(i & 7) | 0x0c0c0c00u;
    const unsigned lo = __builtin_amdgcn_perm(T[1], T[0], sel), hi = __builtin_amdgcn_perm(T[3], T[2], sel);
    return (int)((i & 8) ? hi : lo);
}
constexpr int KROW = 272;
constexpr float SCORE_BIAS = 8.0f;

__device__ __forceinline__ void route_load_q(bf16x8 (&qf)[8], const bf16* qrow, int hb) {
#pragma unroll
    for (int ks = 0; ks < 8; ++ks) qf[ks] = *(const bf16x8*)(qrow + 64 * hb + 8 * ks);
}
__device__ __forceinline__ void route_half(const LAS unsigned char* kl, const bf16x8 (&qf)[8], int nl, int hb, int (&L)[16]) {
    f32x16 acc[4];
#pragma unroll
    for (int nt = 0; nt < 4; ++nt)
#pragma unroll
        for (int r = 0; r < 16; ++r) acc[nt][r] = SCORE_BIAS;
#pragma unroll
    for (int ks = 0; ks < 8; ++ks)
#pragma unroll
        for (int nt = 0; nt < 4; ++nt) {
            const bf16x8 a = *(const LAS bf16x8*)(kl + (32 * nt + nl) * KROW + (64 * hb + 8 * ks) * 2);
            acc[nt] = __builtin_amdgcn_mfma_f32_32x32x16_bf16(a, qf[ks], acc[nt], 0, 0, 0);
        }
    const int hb4 = 4 * hb;
    int T[4][16];
#pragma unroll
    for (int nt = 0; nt < 4; ++nt)
#pragma unroll
        for (int r = 0; r < 16; ++r) { const int n0 = 32 * nt + (r & 3) + 8 * (r >> 2); const float sc = acc[nt][r];
            T[nt][r] = (__float_as_int(sc) & ~127) | ((127 - n0) - hb4); }
    bitonic_sort16(T[0]); bitonic_sort16(T[1]); bitonic_sort16(T[2]); bitonic_sort16(T[3]);
    merge_top16(T[0], T[1]); merge_top16(T[2], T[3]); merge_top16(T[0], T[2]);
#pragma unroll
    for (int i = 0; i < 16; ++i) { const unsigned v = (unsigned)T[0][15 - i]; auto r = __builtin_amdgcn_permlane32_swap(v, v, false, false);
        const unsigned r0 = r[0], r1 = r[1]; const int partner = (int)(hb ? r0 : r1); L[i] = max(T[0][i], partner); }
    bitonic_merge16(L);
}

__device__ __forceinline__ void phase_route(const Params& P, LAS unsigned char* lds) {
    const int tid = threadIdx.x, lane = tid & 63, wave = __builtin_amdgcn_readfirstlane(tid >> 6);
    const int nl = lane & 31, hb = lane >> 5;
    unsigned char* ws = P.ws;
    const bf16* KEYS = (const bf16*)(ws + WS_KEYS); const bf16* Q = (const bf16*)(ws + WS_Q);
    int* IDX = (int*)(ws + WS_IDX); float* GATE = (float*)(ws + WS_GATE);
    int last_h = -1;
    const int nunits = (NTOK / 256) * NHEAD;
    bf16x8 qfA[8], qfB[8];
    if ((int)blockIdx.x < nunits) { const int h = blockIdx.x & 7, tb = blockIdx.x >> 3; route_load_q(qfA, Q + ((size_t)tb * 256 + wave * 32 + nl) * 2048 + h * 256, hb); }
    for (int unit = blockIdx.x; unit < nunits; unit += gridDim.x) {
        const int h = unit & 7, tb = unit >> 3;
        if (h != last_h) {
            __syncthreads();
            for (int c = tid; c < 4096; c += NTHREADS) { const u32x4 v = ((const u32x4*)(KEYS + (size_t)h * 32768))[c];
                *(LAS u32x4*)(lds + (c >> 4) * KROW + (c & 15) * 16) = v; }
            __syncthreads();
            last_h = h;
        }
        const size_t t = (size_t)tb * 256 + wave * 32 + nl;
        int L1[16], L2[16];
        route_load_q(qfB, Q + t * 2048 + h * 256 + 128, hb);
        route_half(lds, qfA, nl, hb, L1);
        { const int un = unit + gridDim.x; if (un < nunits) { const int hn = un & 7, tbn = un >> 3; route_load_q(qfA, Q + ((size_t)tbn * 256 + wave * 32 + nl) * 2048 + hn * 256, hb); } }
        route_half(lds + 128 * KROW, qfB, nl, hb, L2);
        float v1[16], v2[16];
#pragma unroll
        for (int i = 0; i < 16; ++i) { v1[i] = __int_as_float(L1[i] & ~127); v2[i] = __int_as_float(L2[i] & ~127); }
#define CAND(i, j) ((__float_as_int(v1[i] + v2[j]) & ~255) | (255 - (16 * (i) + (j))))
        int A[16], B[16], C[16];
#pragma unroll
        for (int j = 0; j < 16; ++j) A[j] = CAND(0, j);
#pragma unroll
        for (int j = 0; j < 8; ++j) { B[j] = CAND(1, j); B[8 + j] = CAND(15 - j, 0); }
        bitonic_merge16(B);
        C[0] = CAND(2, 0); C[1] = CAND(2, 1); C[2] = CAND(2, 2); C[3] = CAND(2, 3); C[4] = CAND(2, 4);
        C[5] = CAND(3, 0); C[6] = CAND(3, 1); C[7] = CAND(3, 2); C[8] = CAND(3, 3);
        C[9] = CAND(4, 0); C[10] = CAND(4, 1); C[11] = CAND(4, 2);
        C[12] = CAND(5, 0); C[13] = CAND(5, 1); C[14] = CAND(6, 0); C[15] = CAND(6, 1);
        bitonic_sort16(C);
        { const int d0 = CAND(7, 0), d1 = CAND(7, 1); C[14] = max(C[14], d1); C[15] = max(C[15], d0); bitonic_merge16(C); }
#undef CAND
        merge_top16(A, B); merge_top16(A, C);
        unsigned T1[4], T2[4];
#pragma unroll
        for (int q = 0; q < 4; ++q) {
            T1[q] = (unsigned)(127 - (L1[4 * q] & 127)) | ((unsigned)(127 - (L1[4 * q + 1] & 127)) << 8) | ((unsigned)(127 - (L1[4 * q + 2] & 127)) << 16) | ((unsigned)(127 - (L1[4 * q + 3] & 127)) << 24);
            T2[q] = (unsigned)(127 - (L2[4 * q] & 127)) | ((unsigned)(127 - (L2[4 * q + 1] & 127)) << 8) | ((unsigned)(127 - (L2[4 * q + 2] & 127)) << 16) | ((unsigned)(127 - (L2[4 * q + 3] & 127)) << 24); }
        float val[16]; int ex[16];
#pragma unroll
        for (int k = 0; k < 16; ++k) { const int pos = 255 - (A[k] & 255); val[k] = __int_as_float(A[k] & ~255);
            ex[k] = lut16(T1, pos >> 4) * NKEYS + lut16(T2, pos & 15); }
        float sum = 0.f; const float vmax = val[0];
#pragma unroll
        for (int k = 0; k < 16; ++k) { val[k] = __expf(val[k] - vmax); sum += val[k]; }
        const float inv = 1.f / sum;
        if (hb == 0) {
            int* ip = IDX + t * NSEL + h * TOPK; float* gp = GATE + t * NSEL + h * TOPK;
#pragma unroll
            for (int k4 = 0; k4 < 4; ++k4) {
                *(int4*)(ip + 4 * k4) = make_int4(ex[4 * k4], ex[4 * k4 + 1], ex[4 * k4 + 2], ex[4 * k4 + 3]);
                *(f32x4*)(gp + 4 * k4) = (f32x4){val[4 * k4] * inv, val[4 * k4 + 1] * inv, val[4 * k4 + 2] * inv, val[4 * k4 + 3] * inv};
            }
        }
    }
}

#define FP4X2(w, sel) __builtin_amdgcn_cvt_scalef32_pk_f32_fp4((w), 1.0f, (sel))
__device__ __forceinline__ float dot16_fp4(const u32x2 r, const f32x4 (&xs)[4]) {
    float p = 0.f;
    { const f32x2 a = FP4X2(r.x, 0), b = FP4X2(r.x, 1), c = FP4X2(r.x, 2), d = FP4X2(r.x, 3);
      p += (a.x * xs[0].x + a.y * xs[0].y) + (b.x * xs[0].z + b.y * xs[0].w); p += (c.x * xs[1].x + c.y * xs[1].y) + (d.x * xs[1].z + d.y * xs[1].w); }
    { const f32x2 a = FP4X2(r.y, 0), b = FP4X2(r.y, 1), c = FP4X2(r.y, 2), d = FP4X2(r.y, 3);
      p += (a.x * xs[2].x + a.y * xs[2].y) + (b.x * xs[2].z + b.y * xs[2].w); p += (c.x * xs[3].x + c.y * xs[3].y) + (d.x * xs[3].z + d.y * xs[3].w); }
    return p;
}
__device__ __forceinline__ void axpy16_fp4(const u32x2 r, float w, f32x4 (&o)[4]) {
    { const f32x2 a = FP4X2(r.x, 0), b = FP4X2(r.x, 1), c = FP4X2(r.x, 2), d = FP4X2(r.x, 3);
      o[0].x += w * a.x; o[0].y += w * a.y; o[0].z += w * b.x; o[0].w += w * b.y; o[1].x += w * c.x; o[1].y += w * c.y; o[1].z += w * d.x; o[1].w += w * d.y; }
    { const f32x2 a = FP4X2(r.y, 0), b = FP4X2(r.y, 1), c = FP4X2(r.y, 2), d = FP4X2(r.y, 3);
      o[2].x += w * a.x; o[2].y += w * a.y; o[2].z += w * b.x; o[2].w += w * b.y; o[3].x += w * c.x; o[3].y += w * c.y; o[3].z += w * d.x; o[3].w += w * d.y; }
}
__device__ __forceinline__ float swap32_add(float a, float b) { auto r = __builtin_amdgcn_permlane32_swap(__float_as_uint(a), __float_as_uint(b), false, false); return __uint_as_float(r[0]) + __uint_as_float(r[1]); }
__device__ __forceinline__ float swap16_add(float a, float b) { auto r = __builtin_amdgcn_permlane16_swap(__float_as_uint(a), __float_as_uint(b), false, false); return __uint_as_float(r[0]) + __uint_as_float(r[1]); }
__device__ __forceinline__ float row_sum16(float v) { v += dpp_f<0xB1>(v); v += dpp_f<0x4E>(v); v += dpp_f<0x141>(v); v += dpp_f<0x140>(v); return v; }
constexpr int GB = 32;
typedef __attribute__((address_space(8))) void* rsrc_t;
__device__ __forceinline__ void g_issue(u32x2 (&buf)[GB], __amdgpu_buffer_rsrc_t rs, int idxr, int lb, int voff) {
#pragma unroll
    for (int j = 0; j < GB; ++j) { const int e = __builtin_amdgcn_readlane(idxr, lb + j); buf[j] = __builtin_amdgcn_raw_buffer_load_b64(rs, voff, e * 512, 0); }
}
__device__ __forceinline__ float dot16_fp4p(const u32x2 r, const f32x2 (&xp)[8]) {
    f32x2 a = FP4X2(r.x, 0) * xp[0];
    a += FP4X2(r.x, 1) * xp[1]; a += FP4X2(r.x, 2) * xp[2]; a += FP4X2(r.x, 3) * xp[3];
    a += FP4X2(r.y, 0) * xp[4]; a += FP4X2(r.y, 1) * xp[5]; a += FP4X2(r.y, 2) * xp[6]; a += FP4X2(r.y, 3) * xp[7];
    return a.x + a.y;
}
__device__ __forceinline__ void axpy16_fp4p(const u32x2 r, float w, f32x2 (&o)[8]) {
    const f32x2 ww = (f32x2){w, w};
    o[0] += FP4X2(r.x, 0) * ww; o[1] += FP4X2(r.x, 1) * ww; o[2] += FP4X2(r.x, 2) * ww; o[3] += FP4X2(r.x, 3) * ww;
    o[4] += FP4X2(r.y, 0) * ww; o[5] += FP4X2(r.y, 1) * ww; o[6] += FP4X2(r.y, 2) * ww; o[7] += FP4X2(r.y, 3) * ww;
}
template <int H> __device__ __forceinline__ void g_compute_u(const u32x2 (&buf)[GB], int q, int i16, const f32x2 (&xp)[8], float& zlo, float& zhi) {
    float p[16];
#pragma unroll
    for (int j = 0; j < 16; ++j) p[j] = dot16_fp4p(buf[16 * H + j], xp);
    float s1[8], s2[4];
#pragma unroll
    for (int m = 0; m < 8; ++m) s1[m] = swap32_add(p[2 * m], p[2 * m + 1]);
#pragma unroll
    for (int n = 0; n < 4; ++n) s2[n] = swap16_add(s1[2 * n], s1[2 * n + 1]);
#pragma unroll
    for (int r = 0; r < 4; ++r) { const float z = row_sum16(s2[r]); const bool mine = i16 == ((4 * q + r) & 15);
        zlo = (mine && q < 4) ? z : zlo; zhi = (mine && q >= 4) ? z : zhi; }
}
template <int H> __device__ __forceinline__ void g_compute_v(const u32x2 (&buf)[GB], int q, float alo, float ahi, f32x2 (&o)[8]) {
    const int areg = __builtin_bit_cast(int, (q < 4) ? alo : ahi), sb = 4 * (q & 3);
#pragma unroll
    for (int j = 0; j < 16; ++j) { const int src = 32 * (j & 1) + 16 * ((j >> 1) & 1) + (j >> 2) + sb;
        const float w = __builtin_bit_cast(float, __builtin_amdgcn_readlane(areg, src));
        axpy16_fp4p(buf[16 * H + j], w, o); }
}
__device__ __forceinline__ void phase_gather_u(const Params& P) {
    const int tid = threadIdx.x, lane = tid & 63, wave = __builtin_amdgcn_readfirstlane(tid >> 6);
    const int gw = blockIdx.x * NWAVES + wave, NGW = gridDim.x * NWAVES;
    unsigned char* ws = P.ws;
    const int* IDX = (const int*)(ws + WS_IDX); const float* GATE = (const float*)(ws + WS_GATE); const float* ESC = (const float*)(ws + WS_ESCALE); float* AW = (float*)(ws + WS_AW);
    const __amdgpu_buffer_rsrc_t rsU = __builtin_amdgcn_make_buffer_rsrc((void*)(ws + WS_U8), 0, 16384 * 512, 0x00020000);
    const bf16* H2B = (const bf16*)(ws + WS_H2B); const float* SSQ = (const float*)(ws + WS_SSQ);
    const int hh = lane >> 5, rr = (lane >> 4) & 1, i16 = lane & 15, gsel = 4 * i16 + 2 * rr + hh;
    const int voff = 8 * lane;
    int t = gw;
    if (t < NTOK) {
        int idx0, idx1; u32x2 hraw[4]; float sqv;
        { const int* ip = IDX + (size_t)t * NSEL; idx0 = ip[lane]; idx1 = ip[64 + lane];
          const u32x2* hp = (const u32x2*)(H2B + (size_t)t * DM);
#pragma unroll
          for (int j = 0; j < 4; ++j) hraw[j] = hp[64 * j + lane];
          sqv = (lane < 16) ? (SSQ + (size_t)t * 16)[lane] : 0.f; }
        u32x2 bufA[GB], bufB[GB];
        g_issue(bufA, rsU, idx0, 0, voff);
        for (;;) {
            const int tn = t + NGW; const bool has_next = tn < NTOK; const int tl = has_next ? tn : t;
            int idx0n, idx1n; u32x2 hrawn[4]; float sqn, g0, g1;
            { const int* ip = IDX + (size_t)tl * NSEL; idx0n = ip[lane]; idx1n = ip[64 + lane];
              const u32x2* hp = (const u32x2*)(H2B + (size_t)tl * DM);
#pragma unroll
              for (int j = 0; j < 4; ++j) hrawn[j] = hp[64 * j + lane];
              sqn = (lane < 16) ? (SSQ + (size_t)tl * 16)[lane] : 0.f;
              const float* gp = GATE + (size_t)t * NSEL; g0 = gp[lane]; g1 = gp[64 + lane]; }
            const float su0 = ESC[idx0], su1 = ESC[idx1], sv0 = ESC[16384 + idx0], sv1 = ESC[16384 + idx1];
            const float rstd2 = rsqrtf(wave_sum_fast(sqv) * (1.f / DM) + EPS);
            f32x2 xp[8];
#pragma unroll
            for (int j = 0; j < 4; ++j) { xp[2 * j] = (f32x2){bflo(hraw[j].x), bfhi(hraw[j].x)}; xp[2 * j + 1] = (f32x2){bflo(hraw[j].y), bfhi(hraw[j].y)}; }
            float zlo = 0.f, zhi = 0.f;
#pragma unroll 1
            for (int i = 0; i < 2; ++i) {
                const int idxr = i ? idx1 : idx0, idxnx = i ? idx0n : idx1;
                g_issue(bufB, rsU, idxr, 32, voff);
                g_compute_u<0>(bufA, 4 * i, i16, xp, zlo, zhi); g_compute_u<1>(bufA, 4 * i + 1, i16, xp, zlo, zhi);
                if (i == 0 || has_next) g_issue(bufA, rsU, idxnx, 0, voff);
                g_compute_u<0>(bufB, 4 * i + 2, i16, xp, zlo, zhi); g_compute_u<1>(bufB, 4 * i + 3, i16, xp, zlo, zhi);
            }
            const float glo = __shfl(g0, gsel), ghi = __shfl(g1, gsel), sulo = __shfl(su0, gsel), suhi = __shfl(su1, gsel), svlo = __shfl(sv0, gsel), svhi = __shfl(sv1, gsel);
            float* ap = AW + (size_t)t * NSEL;
            ap[lane] = gelu_tanh_f(zlo * rstd2 * sulo) * glo * svlo; ap[64 + lane] = gelu_tanh_f(zhi * rstd2 * suhi) * ghi * svhi;
            if (!has_next) break;
            t = tn; idx0 = idx0n; idx1 = idx1n; sqv = sqn;
#pragma unroll
            for (int j = 0; j < 4; ++j) hraw[j] = hrawn[j];
        }
    }
}
__device__ __forceinline__ void phase_gather_v(const Params& P) {
    const int tid = threadIdx.x, lane = tid & 63, wave = __builtin_amdgcn_readfirstlane(tid >> 6);
    const int gw = blockIdx.x * NWAVES + wave, NGW = gridDim.x * NWAVES;
    unsigned char* ws = P.ws;
    const int* IDX = (const int*)(ws + WS_IDX); const float* AW = (const float*)(ws + WS_AW);
    const __amdgpu_buffer_rsrc_t rsV = __builtin_amdgcn_make_buffer_rsrc((void*)(ws + WS_V8), 0, 16384 * 512, 0x00020000);
    const bf16* H2B = (const bf16*)(ws + WS_H2B);
    const int voff = 8 * lane;
    int t = gw;
    if (t < NTOK) {
        int idx0, idx1; u32x2 hraw[4]; float alo, ahi;
        { const int* ip = IDX + (size_t)t * NSEL; idx0 = ip[lane]; idx1 = ip[64 + lane];
          const u32x2* hp = (const u32x2*)(H2B + (size_t)t * DM);
#pragma unroll
          for (int j = 0; j < 4; ++j) hraw[j] = hp[64 * j + lane];
          const float* ap = AW + (size_t)t * NSEL; alo = ap[lane]; ahi = ap[64 + lane]; }
        u32x2 bufA[GB], bufB[GB];
        g_issue(bufA, rsV, idx0, 0, voff);
        for (;;) {
            const int tn = t + NGW; const bool has_next = tn < NTOK; const int tl = has_next ? tn : t;
            int idx0n, idx1n; u32x2 hrawn[4]; float alon, ahin;
            { const int* ip = IDX + (size_t)tl * NSEL; idx0n = ip[lane]; idx1n = ip[64 + lane];
              const u32x2* hp = (const u32x2*)(H2B + (size_t)tl * DM);
#pragma unroll
              for (int j = 0; j < 4; ++j) hrawn[j] = hp[64 * j + lane];
              const float* ap = AW + (size_t)tl * NSEL; alon = ap[lane]; ahin = ap[64 + lane]; }
            f32x2 o[8];
#pragma unroll
            for (int j = 0; j < 8; ++j) o[j] = (f32x2){0.f, 0.f};
#pragma unroll 1
            for (int i = 0; i < 2; ++i) {
                const int idxr = i ? idx1 : idx0, idxnx = i ? idx0n : idx1;
                g_issue(bufB, rsV, idxr, 32, voff);
                g_compute_v<0>(bufA, 4 * i, alo, ahi, o); g_compute_v<1>(bufA, 4 * i + 1, alo, ahi, o);
                if (i == 0 || has_next) g_issue(bufA, rsV, idxnx, 0, voff);
                g_compute_v<0>(bufB, 4 * i + 2, alo, ahi, o); g_compute_v<1>(bufB, 4 * i + 3, alo, ahi, o);
            }
            float ss = 0.f;
#pragma unroll
            for (int j = 0; j < 4; ++j) { o[2 * j] += (f32x2){bflo(hraw[j].x), bfhi(hraw[j].x)}; o[2 * j + 1] += (f32x2){bflo(hraw[j].y), bfhi(hraw[j].y)}; }
#pragma unroll
            for (int j = 0; j < 8; ++j) ss += o[j].x * o[j].x + o[j].y * o[j].y;
            ss = wave_sum_fast(ss);
            const float r3 = rsqrtf(ss * (1.f / DM) + EPS);
            f32x4* op = (f32x4*)(P.out + (size_t)t * DM);
            const f32x4* gfp = (const f32x4*)P.g_fin;
#pragma unroll
            for (int j = 0; j < 4; ++j) { const f32x4 gv = gfp[64 * j + lane]; op[64 * j + lane] = (f32x4){o[2 * j].x * r3 * gv.x, o[2 * j].y * r3 * gv.y, o[2 * j + 1].x * r3 * gv.z, o[2 * j + 1].y * r3 * gv.w}; }
            if (!has_next) break;
            t = tn; idx0 = idx0n; idx1 = idx1n; alo = alon; ahi = ahin;
#pragma unroll
            for (int j = 0; j < 4; ++j) hraw[j] = hrawn[j];
        }
    }
}

#define XB_TMO      128
#define XB_XCNT(j)  (256  + 64 * (j))
#define XB_XSUB(j)  (1280 + 64 * (j))
#define XB_XGEN(j)  (2304 + 64 * (j))
#define XB_TOP      3328
#define XB_TOPGEN   3392
#define XCD_BAR_WORDS 3456
#define XB_SPIN_CAP (1u << 18)

__device__ __forceinline__ unsigned xb_ld(unsigned* p)              { return __hip_atomic_load(p, __ATOMIC_RELAXED, __HIP_MEMORY_SCOPE_AGENT); }
__device__ __forceinline__ unsigned xb_add(unsigned* p, unsigned v) { return __hip_atomic_fetch_add(p, v, __ATOMIC_RELAXED, __HIP_MEMORY_SCOPE_AGENT); }
__device__ __forceinline__ unsigned xb_xcc_id() { return (unsigned)__builtin_amdgcn_s_getreg((3 << 11) | 20) & 0xFu; }
#define XB_SPIN(cond, bar) do { unsigned _sp = 0; while (cond) { __builtin_amdgcn_s_sleep(1); \
    if ((++_sp & 255u) == 0u) { if (xb_ld(&(bar)[XB_TMO])) break; if (_sp > XB_SPIN_CAP) { atomicAdd(&(bar)[XB_TMO], 1u); break; } } } } while (0)

struct XcdBarrier {
    unsigned* bar; unsigned x;
    volatile LAS unsigned* st;
};

__device__ __forceinline__ XcdBarrier xcd_barrier_post(unsigned* bar, volatile LAS unsigned* st) {
    XcdBarrier b; b.bar = bar; b.x = xb_xcc_id(); b.st = st;
    if (threadIdx.x == 0) (void)xb_add(&bar[XB_XCNT(b.x)], 1u);
    return b;
}
__device__ __forceinline__ void xcd_barrier_complete(unsigned* bar, unsigned x, unsigned& nloc, unsigned& nx) {
    const unsigned G = gridDim.x * gridDim.y * gridDim.z;
    unsigned sum, cnt, mine, sp = 0u;
    for (;;) {
        sum = 0u; cnt = 0u; mine = 0u;
#pragma unroll
        for (unsigned j = 0; j < 16; ++j) { const unsigned c = xb_ld(&bar[XB_XCNT(j)]); sum += c; cnt += (c > 0u) ? 1u : 0u; mine = (j == x) ? c : mine; }
        if (sum == G) break;
        __builtin_amdgcn_s_sleep(1);
        if ((++sp & 255u) == 0u) { if (xb_ld(&bar[XB_TMO])) break; if (sp > XB_SPIN_CAP) { atomicAdd(&bar[XB_TMO], 1u); break; } }
    }
    nloc = mine > 0u ? mine : 1u; nx = cnt > 0u ? cnt : 1u;
}

__device__ __forceinline__ void xcd_barrier(const XcdBarrier& b) {
    asm volatile("s_waitcnt vmcnt(0)" ::: "memory");
    __syncthreads();
    if (threadIdx.x == 0) {
        unsigned* bar = b.bar;
        __builtin_amdgcn_s_waitcnt(0);
        unsigned nloc = b.st[0], nx = b.st[1];
        if (nloc == 0u) { xcd_barrier_complete(bar, b.x, nloc, nx); b.st[0] = nloc; b.st[1] = nx; }
        const unsigned old = xb_add(&bar[XB_XSUB(b.x)], 1u);
        const unsigned gen = old / nloc;
        if (old + 1u == (gen + 1u) * nloc) {
            __builtin_amdgcn_fence(__ATOMIC_RELEASE, "agent");
            asm volatile("s_waitcnt vmcnt(0)" ::: "memory");
            const unsigned og = xb_add(&bar[XB_TOP], 1u);
            const unsigned tg = og / nx;
            if (og + 1u == (tg + 1u) * nx) xb_add(&bar[XB_TOPGEN], 1u);
            else XB_SPIN(xb_ld(&bar[XB_TOPGEN]) == tg, bar);
            __builtin_amdgcn_fence(__ATOMIC_ACQUIRE, "agent");
            xb_add(&bar[XB_XGEN(b.x)], 1u);
            asm volatile("s_waitcnt vmcnt(0)" ::: "memory");
        } else {
            XB_SPIN(xb_ld(&bar[XB_XGEN(b.x)]) == gen, bar);
            __builtin_amdgcn_fence(__ATOMIC_ACQUIRE, "agent");
            asm volatile("s_waitcnt vmcnt(0)" ::: "memory");
        }
    }
    __syncthreads();
}


#ifndef MK_MULTI
#define MK_MULTI 0
#endif
constexpr int NPHASE = 8;
#ifndef REP5
#define REP5 1
#endif
#ifndef REP6
#define REP6 1
#endif
__global__ void __launch_bounds__(NTHREADS, 2) mk_fwd(Params P) {
    extern __shared__ __attribute__((aligned(16))) unsigned char lds_raw[];
    LAS unsigned char* lds = (LAS unsigned char*)lds_raw;
    cg::grid_group grid = cg::this_grid();
    unsigned char* ws = P.ws;
    const int lo = P.ph_lo, hi = P.ph_hi;
    volatile LAS unsigned* bst = (volatile LAS unsigned*)(lds + 131072 + 64);
    if (threadIdx.x < 2) bst[threadIdx.x] = 0u;
    __syncthreads();
    XcdBarrier xbar = xcd_barrier_post((unsigned*)(ws + WS_CTL), bst);
#define IN(k) (lo <= (k) && (k) < hi)
#define SEAM(k) do { if (IN(k) && IN((k) + 1)) { xcd_barrier(xbar); } } while (0)
#ifndef SKIP0
    if (IN(0)) phase_prep(P, lds);
#endif
    SEAM(0);
#ifndef SKIP1
    if (IN(1)) {
        phase_metaproj(P);
        pg8::Gemm g{(const bf16*)(ws + WS_H0B), (const bf16*)(ws + WS_WIN_T), NTOK, DIN, DM}; pg8::StaticOrder S; S.init(NTOK, DIN, (int)gridDim.x, (int)blockIdx.x);
        EpiProj E{(bf16*)(ws + WS_PROJ), (const float*)(ws + WS_RSTD1)};
        pg8::gemm_phase<EpiProj, pg8::StaticOrder, true, true>(lds, g, S, E);
    }
#endif
    SEAM(1);
#ifndef SKIP2
    if (IN(2)) phase_conv(P, lds);
#endif
    SEAM(2);
#ifndef SKIP3
    if (IN(3)) {
        pg8::Gemm g{(const bf16*)(ws + WS_Y), (const bf16*)(ws + WS_WOUT_T), NTOK, DM, DM}; pg8::StaticOrder S; S.init(NTOK, DM, (int)gridDim.x, (int)blockIdx.x);
        EpiResidual E{(bf16*)(ws + WS_H2B), (const bf16*)(ws + WS_H0B), (float*)(ws + WS_SSQ)};
        pg8::gemm_phase<EpiResidual, pg8::StaticOrder, true, true>(lds, g, S, E);
    }
#endif
    SEAM(3);
#ifndef SKIP4
    if (IN(4)) {
        pg8::Gemm g{(const bf16*)(ws + WS_H2B), (const bf16*)(ws + WS_WQ_T), NTOK, 2048, DM}; pg8::StaticOrder S; S.init(NTOK, 2048, (int)gridDim.x, (int)blockIdx.x);
        EpiRowScale<1> E{(bf16*)(ws + WS_Q), 2048, (const float*)(ws + WS_SSQ)};
        pg8::gemm_phase<EpiRowScale<1>, pg8::StaticOrder, true, true>(lds, g, S, E);
    }
#endif
    SEAM(4);
#ifndef SKIP5
    if (IN(5)) for (int rep = 0; rep < REP5; ++rep) phase_route(P, lds);
#endif
    SEAM(5);
    if (IN(6)) phase_gather_u(P);
    SEAM(6);
    if (IN(7)) phase_gather_v(P);
#undef IN
#undef SEAM
}

extern "C" void kernel_launch(void* const* d_in, const int* in_sizes, int n_in, void* d_out, int out_size, void* d_ws, size_t ws_size, hipStream_t stream) {
    static int grid = 0;
    if (grid == 0) {
        if (n_in != 18 || in_sizes[0] != NTOK * DM || out_size != NTOK * DM || ws_size < WS_END) {
            fprintf(stderr, "kernel_launch: unexpected shapes (n_in %d in0 %d out %d ws %zu)\n", n_in, n_in > 0 ? in_sizes[0] : -1, out_size, ws_size); grid = -1; return; }
        int dev = 0, cus = 0, per_cu = 0;
        (void)hipGetDevice(&dev); (void)hipDeviceGetAttribute(&cus, hipDeviceAttributeMultiprocessorCount, dev);
        if (hipFuncSetAttribute((const void*)mk_fwd, hipFuncAttributeMaxDynamicSharedMemorySize, LDS_BYTES) != hipSuccess) { fprintf(stderr, "kernel_launch: hipFuncSetAttribute failed\n"); grid = -1; return; }
        if (hipOccupancyMaxActiveBlocksPerMultiprocessor(&per_cu, (const void*)mk_fwd, NTHREADS, LDS_BYTES) != hipSuccess || per_cu < 1) { fprintf(stderr, "kernel_launch: occupancy query failed (%d)\n", per_cu); (void)hipGetLastError(); per_cu = 1; }
        if (per_cu > 1) per_cu = 1;
        grid = cus * per_cu;
        if (grid <= 0) grid = 256;
    }
    if (grid < 0) return;
    Params p{};
    p.x = (const float*)d_in[0]; p.meta = (const float*)d_in[1]; p.g_mix = (const float*)d_in[2]; p.w_in = (const float*)d_in[3]; p.sc_w = (const float*)d_in[4];
    p.cf_w = (const float*)d_in[5]; p.cf_b = (const float*)d_in[6]; p.ln_g = (const float*)d_in[7]; p.ln_b = (const float*)d_in[8]; p.g_sc = (const float*)d_in[9];
    p.g_cf = (const float*)d_in[10]; p.w_out = (const float*)d_in[11]; p.g_ffn = (const float*)d_in[12]; p.w_q = (const float*)d_in[13]; p.keys = (const float*)d_in[14];
    p.pu = (const float*)d_in[15]; p.pv = (const float*)d_in[16]; p.g_fin = (const float*)d_in[17];
    p.out = (float*)d_out; p.ws = (unsigned char*)d_ws;
    (void)hipMemsetAsync((char*)d_ws + WS_CTL, 0, 16384, stream);
#if MK_MULTI
    for (int ph = 0; ph < NPHASE; ++ph) { p.ph_lo = ph; p.ph_hi = ph + 1; p.coop = 0; p.pad = 0;
        hipLaunchKernelGGL(mk_fwd, dim3(grid), dim3(NTHREADS), LDS_BYTES, stream, p); }
#else
    p.ph_lo = 0; p.ph_hi = NPHASE; p.coop = 1; p.pad = 0;
    void* args[] = {&p};
    hipError_t e = hipLaunchCooperativeKernel((const void*)mk_fwd, dim3(grid), dim3(NTHREADS), args, LDS_BYTES, stream);
    if (e != hipSuccess) fprintf(stderr, "cooperative launch failed: %s (grid %d)\n", hipGetErrorString(e), grid);
#endif
}
```

```cpp
#include <hip/hip_runtime.h>
#include <hip/hip_cooperative_groups.h>
#include <cstdio>
#include <cstdint>
namespace cg = cooperative_groups;

namespace pg8 {
#define PG8_LAS __attribute__((address_space(3)))
typedef unsigned short bf16_t;
typedef short bf16x8 __attribute__((ext_vector_type(8)));
typedef float f32x4 __attribute__((ext_vector_type(4)));
typedef unsigned u32x4 __attribute__((ext_vector_type(4)));
constexpr int BM = 256, BK = 64, HALF = 128, HTB = HALF * BK * 2  , STAGE_BYTES = 8 * HTB, NXCD = 8, WGM = 8;

__host__ __device__ __forceinline__ int lds_byte(int r, int c) { const int st = (r >> 4) * 2 + (c >> 5), rr = r & 15, cc = c & 31, ob = rr * 64 + cc * 2; return st * 1024 + (ob ^ (((ob >> 9) & 1) << 5)); }
__host__ __device__ __forceinline__ void stage_rc(int b, int& R, int& C) { const int st = b / 1024, sb = b % 1024, swz = sb ^ (((sb >> 9) & 1) << 5); R = (st >> 1) * 16 + swz / 64; C = (st & 1) * 32 + (swz % 64) / 2; }
__host__ __device__ __forceinline__ int perm32(int rho) { const int n = rho >> 4, i = rho & 15; return 8 * (i >> 2) + 4 * n + (i & 3); }

struct Unit { int pm, pn; };
struct Gemm { const bf16_t* A; const bf16_t* Bt; int M, N, K; };

struct StaticOrder {
    int nM, nN, nwg, G, c;
    __host__ __device__ void init(int M, int N, int G_, int c_) { nM = M / BM; nN = N / BM; nwg = nM * nN; G = G_; c = c_; }
    __host__ __device__ bool next(int i, Unit& u) const {
        const long L = (long)i * G + c; if (L >= nwg) return false;
        int wgid = (int)L; { const int q = nwg / NXCD, r = nwg % NXCD, xcd = wgid % NXCD, off = wgid / NXCD; wgid = (xcd < r ? xcd * (q + 1) : r * (q + 1) + (xcd - r) * q) + off; }
        const int nig = WGM * nN, gid = wgid / nig, fm = gid * WGM, gsz = (nM - fm) < WGM ? (nM - fm) : WGM;
        u.pm = fm + ((wgid % nig) % gsz); u.pn = (wgid % nig) / gsz; return true;
    }
    __device__ __forceinline__ void a_ready(const Unit&) const {}
    __device__ __forceinline__ void done(const Unit&) const {}
};

template <class Epi, class Sched, bool ALIGN_EPI = false, bool SP2 = false>
__device__ __forceinline__ void gemm_phase(PG8_LAS unsigned char* lds, const Gemm g, const Sched& S, const Epi& E) {
    const int tid = threadIdx.x, wid = __builtin_amdgcn_readfirstlane(tid >> 6), lane = tid & 63, wr = wid >> 2, wc = wid & 3, fr = lane & 15, fq = lane >> 4;
    const int K = g.K, nt = K / BK;
    unsigned voffA[2], voffB[2];
#pragma unroll
    for (int i = 0; i < 2; ++i) { int R, C; stage_rc(tid * 16 + i * 8192, R, C); const int Rb = Epi::PERM ? ((R & ~31) + perm32(R & 31)) : R;
        voffA[i] = (unsigned)(R * K + C) * 2u; voffB[i] = (unsigned)(Rb * K + C) * 2u; }
    const size_t kstep = (size_t)(BK * 2);
    const size_t hstep = (size_t)HALF * K * 2;
    const size_t tstep = 2 * hstep;
    const unsigned ldsw = (unsigned)wid * 1024u;
    const int aoff = lds_byte(wr * 64 + fr, fq * 8), boff = lds_byte(wc * 32 + fr, fq * 8);
#define PG8_SA(b, h) (((b) * 2 + (h)) * HTB)
#define PG8_SB(b, h) ((4 + (b) * 2 + (h)) * HTB)
#define PG8_STAGE(bufoff, gbase, voff) do { _Pragma("unroll") for (int _i = 0; _i < 2; ++_i) \
        __builtin_amdgcn_global_load_lds((const unsigned*)((const char*)(gbase) + (voff)[_i]), (PG8_LAS unsigned*)(lds + (bufoff) + ldsw + _i * 8192), 16, 0, 0); } while (0)
#define PG8_LDA(dst, b, h) do { _Pragma("unroll") for (int m = 0; m < 4; ++m) _Pragma("unroll") for (int k = 0; k < 2; ++k) dst[m][k] = *(const PG8_LAS bf16x8*)(lds + PG8_SA(b, h) + aoff + m * 2048 + k * 1024); } while (0)
#define PG8_LDB(dst, b, h) do { _Pragma("unroll") for (int n = 0; n < 2; ++n) _Pragma("unroll") for (int k = 0; k < 2; ++k) dst[n][k] = *(const PG8_LAS bf16x8*)(lds + PG8_SB(b, h) + boff + n * 2048 + k * 1024); } while (0)
#define PG8_MMA(ai, bj, At, Bt) do { __builtin_amdgcn_s_setprio(1); _Pragma("unroll") for (int m = 0; m < 4; ++m) _Pragma("unroll") for (int n = 0; n < 2; ++n) _Pragma("unroll") for (int k = 0; k < 2; ++k) \
        acc[ai][bj][m][n] = __builtin_amdgcn_mfma_f32_16x16x32_bf16(Bt[n][k], At[m][k], acc[ai][bj][m][n], 0, 0, 0); __builtin_amdgcn_s_setprio(0); } while (0)
#define PG8_WAIT_V(n) asm volatile("s_waitcnt vmcnt(" #n ")" ::: "memory")
#define PG8_WAIT_L(n) asm volatile("s_waitcnt lgkmcnt(" #n ")" ::: "memory")
#define PG8_BAR __builtin_amdgcn_s_barrier()
#define PG8_SCHED __builtin_amdgcn_sched_barrier(0)
    Unit cur, nxt; int ui = 0;
    if (!S.next(0, cur)) return;
    f32x4 acc[2][2][4][2];
#pragma unroll
    for (int a = 0; a < 2; ++a)
#pragma unroll
        for (int b = 0; b < 2; ++b)
#pragma unroll
            for (int m = 0; m < 4; ++m)
#pragma unroll
                for (int n = 0; n < 2; ++n) acc[a][b][m][n] = (f32x4){0.f, 0.f, 0.f, 0.f};
    bf16x8 At[4][2], B0[2][2], B1[2][2];
    const char* cA = (const char*)g.A + (size_t)cur.pm * tstep; const char* cB = (const char*)g.Bt + (size_t)cur.pn * tstep;
    S.a_ready(cur);
    if constexpr (SP2) {
        PG8_STAGE(PG8_SB(0, 0), cB, voffB); PG8_STAGE(PG8_SB(0, 1), cB + hstep, voffB); PG8_STAGE(PG8_SA(0, 0), cA, voffA); PG8_STAGE(PG8_SA(0, 1), cA + hstep, voffA);
        if (wr == 1) PG8_BAR;
        PG8_WAIT_V(2); PG8_BAR;
        PG8_STAGE(PG8_SB(1, 0), cB + kstep, voffB); PG8_STAGE(PG8_SA(1, 0), cA + kstep, voffA); PG8_STAGE(PG8_SB(1, 1), cB + hstep + kstep, voffB);
        PG8_WAIT_V(6); PG8_BAR;
    } else {
        PG8_STAGE(PG8_SB(0, 0), cB, voffB); PG8_STAGE(PG8_SA(0, 0), cA, voffA); PG8_STAGE(PG8_SB(0, 1), cB + hstep, voffB); PG8_STAGE(PG8_SA(0, 1), cA + hstep, voffA);
        if (wr == 1) PG8_BAR;
        PG8_WAIT_V(4); PG8_BAR;
        PG8_STAGE(PG8_SB(1, 0), cB + kstep, voffB); PG8_STAGE(PG8_SA(1, 0), cA + kstep, voffA); PG8_STAGE(PG8_SB(1, 1), cB + hstep + kstep, voffB);
        PG8_WAIT_V(6); PG8_BAR;
    }
    for (;;) {
        const bool has_next = S.next(ui + 1, nxt);
        const char* nA = has_next ? (const char*)g.A + (size_t)nxt.pm * tstep : cA; const char* nB = has_next ? (const char*)g.Bt + (size_t)nxt.pn * tstep : cB;
        for (int t = 0; t < nt; t += 2) {
            const bool last = (t == nt - 2);
            const char* a1 = cA + (size_t)(t + 1) * kstep;
            const char* a2 = last ? nA : cA + (size_t)(t + 2) * kstep; const char* b2 = last ? nB : cB + (size_t)(t + 2) * kstep;
            const char* a3 = a2 + kstep; const char* b3 = b2 + kstep;
            if (last && has_next) S.a_ready(nxt);
            if constexpr (SP2) {
            PG8_LDB(B0, 0, 0); PG8_LDB(B1, 0, 1); PG8_SCHED; PG8_LDA(At, 0, 0); PG8_STAGE(PG8_SA(1, 1), a1 + hstep, voffA);
            PG8_WAIT_V(8); PG8_WAIT_L(0); PG8_BAR; PG8_MMA(0, 0, At, B0); PG8_MMA(0, 1, At, B1); PG8_BAR; PG8_SCHED;
            PG8_LDA(At, 0, 1); PG8_STAGE(PG8_SB(0, 0), b2, voffB); PG8_STAGE(PG8_SB(0, 1), b2 + hstep, voffB); PG8_STAGE(PG8_SA(0, 0), a2, voffA);
            PG8_WAIT_V(8); PG8_WAIT_L(0); PG8_BAR; PG8_MMA(1, 0, At, B0); PG8_MMA(1, 1, At, B1); PG8_BAR; PG8_SCHED;
            PG8_LDB(B0, 1, 0); PG8_LDB(B1, 1, 1); PG8_SCHED; PG8_LDA(At, 1, 0); PG8_STAGE(PG8_SA(0, 1), a2 + hstep, voffA);
            PG8_WAIT_V(8); PG8_WAIT_L(0); PG8_BAR; PG8_MMA(0, 0, At, B0); PG8_MMA(0, 1, At, B1); PG8_BAR; PG8_SCHED;
            PG8_LDA(At, 1, 1); PG8_STAGE(PG8_SB(1, 0), b3, voffB); PG8_STAGE(PG8_SB(1, 1), b3 + hstep, voffB); PG8_STAGE(PG8_SA(1, 0), a3, voffA);
            PG8_WAIT_V(8); PG8_WAIT_L(0); PG8_BAR; PG8_MMA(1, 0, At, B0); PG8_MMA(1, 1, At, B1); PG8_BAR; PG8_SCHED;
            } else {
            PG8_LDB(B0, 0, 0); PG8_SCHED; PG8_LDA(At, 0, 0); PG8_STAGE(PG8_SA(1, 1), a1 + hstep, voffA);
            PG8_WAIT_L(8); PG8_BAR; PG8_WAIT_L(0); PG8_MMA(0, 0, At, B0); PG8_BAR; PG8_SCHED;
            PG8_LDB(B1, 0, 1); PG8_STAGE(PG8_SB(0, 0), b2, voffB);
            PG8_BAR; PG8_WAIT_L(0); PG8_MMA(0, 1, At, B1); PG8_BAR;
            PG8_LDA(At, 0, 1); PG8_STAGE(PG8_SA(0, 0), a2, voffA);
            PG8_BAR; PG8_WAIT_L(0); PG8_MMA(1, 0, At, B0); PG8_BAR; PG8_SCHED;
            PG8_STAGE(PG8_SB(0, 1), b2 + hstep, voffB);
            PG8_WAIT_V(6); PG8_BAR; PG8_MMA(1, 1, At, B1); PG8_BAR;
            PG8_LDB(B0, 1, 0); PG8_SCHED; PG8_LDA(At, 1, 0); PG8_STAGE(PG8_SA(0, 1), a2 + hstep, voffA);
            PG8_WAIT_L(8); PG8_BAR; PG8_WAIT_L(0); PG8_MMA(0, 0, At, B0); PG8_BAR; PG8_SCHED;
            PG8_LDB(B1, 1, 1); PG8_STAGE(PG8_SB(1, 0), b3, voffB);
            PG8_BAR; PG8_WAIT_L(0); PG8_MMA(0, 1, At, B1); PG8_BAR;
            PG8_LDA(At, 1, 1); PG8_STAGE(PG8_SA(1, 0), a3, voffA);
            PG8_BAR; PG8_WAIT_L(0); PG8_MMA(1, 0, At, B0); PG8_BAR; PG8_SCHED;
            PG8_STAGE(PG8_SB(1, 1), b3 + hstep, voffB);
            PG8_WAIT_V(6); PG8_BAR; PG8_MMA(1, 1, At, B1); PG8_BAR;
            }
        }
        if constexpr (ALIGN_EPI) { if (wr == 0) PG8_BAR; }
        if constexpr (!Epi::AFTER_DRAIN) { E(acc, cur, wr, wc, fr, fq); S.done(cur); }
        if (!has_next) break;
#pragma unroll
        for (int a = 0; a < 2; ++a)
#pragma unroll
            for (int b = 0; b < 2; ++b)
#pragma unroll
                for (int m = 0; m < 4; ++m)
#pragma unroll
                    for (int n = 0; n < 2; ++n) acc[a][b][m][n] = (f32x4){0.f, 0.f, 0.f, 0.f};
        cur = nxt; cA = nA; cB = nB; ++ui;
        if constexpr (ALIGN_EPI) { if (wr == 1) PG8_BAR; }
    }
    PG8_WAIT_V(0);
    if constexpr (!ALIGN_EPI) { if (wr == 0) PG8_BAR; }
    PG8_BAR;
    if constexpr (Epi::AFTER_DRAIN) { E.fused(acc, cur, wr, wc, fr, fq, lds, wid, lane); S.done(cur); }
#undef PG8_SA
#undef PG8_SB
#undef PG8_STAGE
#undef PG8_LDA
#undef PG8_LDB
#undef PG8_MMA
#undef PG8_WAIT_V
#undef PG8_WAIT_L
#undef PG8_BAR
#undef PG8_SCHED
}
}

#define LAS __attribute__((address_space(3)))
typedef unsigned short bf16;
typedef float f32x2 __attribute__((ext_vector_type(2)));
typedef float f32x4 __attribute__((ext_vector_type(4)));
typedef unsigned u32x2 __attribute__((ext_vector_type(2)));
typedef unsigned u32x4 __attribute__((ext_vector_type(4)));

constexpr int PDIM = 1536;
constexpr int NTOK = 32768, DM = 1024, DIN = 2560, SEQ = 8192, NBATCH = 4, NMETA = 16;
constexpr int NHEAD = 8, NKEYS = 128, TOPK = 16, NSEL = NHEAD * TOPK;
constexpr float EPS = 1e-6f;
constexpr float U_SCALE = 64.f, V_SCALE = 16.f;
constexpr int NWAVES = 8, NTHREADS = 512;
constexpr int MKC = 32;
constexpr int LDS_BYTES = 147456;

constexpr size_t MiB = 1u << 20;
constexpr size_t WS_CTL = 0, WS_WIN_T = 1 * MiB, WS_WOUT_T = 6 * MiB, WS_WQ_T = 8 * MiB, WS_KEYS = 12 * MiB, WS_METAPART = 160 * MiB  ,
                 WS_METARSTD = 14 * MiB + 512 * 1024, WS_METAPROJ = 14 * MiB + 576 * 1024, WS_RSTD1 = 15 * MiB, WS_SSQ = 16 * MiB, WS_U8 = 32 * MiB, WS_V8 = 48 * MiB,
                 WS_IDX = 64 * MiB, WS_GATE = 80 * MiB, WS_H0B = 96 * MiB, WS_H2B = 96 * MiB, WS_Y = 160 * MiB, WS_PROJ = 224 * MiB,
                 WS_Q = 224 * MiB, WS_ESCALE = 18 * MiB, WS_AW = 160 * MiB  , WS_END = 384 * MiB;

struct Params {
    const float* x; const float* meta; const float* g_mix; const float* w_in; const float* sc_w; const float* cf_w; const float* cf_b;
    const float* ln_g; const float* ln_b; const float* g_sc; const float* g_cf; const float* w_out; const float* g_ffn; const float* w_q;
    const float* keys; const float* pu; const float* pv; const float* g_fin;
    float* out; unsigned char* ws;
    int ph_lo, ph_hi, coop, pad;
};

__device__ __forceinline__ unsigned f2bf(float f) { unsigned u = __builtin_bit_cast(unsigned, f); return (u + 0x7fffu + ((u >> 16) & 1u)) >> 16; }
__device__ __forceinline__ unsigned pk2(float lo, float hi) { return f2bf(lo) | (f2bf(hi) << 16); }
__device__ __forceinline__ float bf2f(unsigned b) { return __builtin_bit_cast(float, b << 16); }
__device__ __forceinline__ float bflo(unsigned w) { return __builtin_bit_cast(float, w << 16); }
__device__ __forceinline__ float bfhi(unsigned w) { return __builtin_bit_cast(float, w & 0xffff0000u); }
__device__ __forceinline__ float wave_sum(float v) {
#pragma unroll
    for (int o = 1; o < 64; o <<= 1) v += __shfl_xor(v, o);
    return v;
}
template <int CTRL> __device__ __forceinline__ float dpp_f(float v) { return __builtin_bit_cast(float, __builtin_amdgcn_update_dpp(0, __builtin_bit_cast(int, v), CTRL, 0xf, 0xf, true)); }
__device__ __forceinline__ float wave_sum_fast(float v) {
    v += dpp_f<0xB1>(v); v += dpp_f<0x4E>(v); v += dpp_f<0x141>(v); v += dpp_f<0x140>(v);
    { auto r = __builtin_amdgcn_permlane16_swap(__float_as_uint(v), __float_as_uint(v), false, false); v = __uint_as_float(r[0]) + __uint_as_float(r[1]); }
    { auto r = __builtin_amdgcn_permlane32_swap(__float_as_uint(v), __float_as_uint(v), false, false); v = __uint_as_float(r[0]) + __uint_as_float(r[1]); }
    return v;
}
__device__ __forceinline__ float sigmoid_f(float x) { return 1.f / (1.f + __expf(-x)); }
__device__ __forceinline__ float gelu_tanh_f(float x) {
    const float t = 0.7978845608028654f * (x + 0.044715f * x * x * x);
    const float e = __expf(2.f * t);
    const float th = 1.f - 2.f / (e + 1.f);
    return 0.5f * x * (1.f + th);
}

__device__ __forceinline__ unsigned cvt_pk_bf16(float lo, float hi) { unsigned r; asm volatile("v_cvt_pk_bf16_f32 %0, %1, %2" : "=v"(r) : "v"(lo), "v"(hi)); return r; }

template <int MODE> struct EpiRowScale {
    static constexpr bool PERM = true, AFTER_DRAIN = false;
    bf16* O; int ldc; const float* rs;
    __device__ __forceinline__ void operator()(const pg8::f32x4 (&acc)[2][2][4][2], const pg8::Unit& u, int wr, int wc, int fr, int fq) const {
        const int row0 = u.pm * 256 + wr * 64 + fr, col0 = u.pn * 256 + wc * 32 + 8 * fq;
#pragma unroll
        for (int ai = 0; ai < 2; ++ai)
#pragma unroll
            for (int m = 0; m < 4; ++m) {
                const int row = row0 + ai * 128 + m * 16;
                float s;
                if (MODE == 0) s = rs[row];
                else { const f32x4* p = (const f32x4*)(rs + (size_t)row * 16); const f32x4 a = p[0], b = p[1], c = p[2], d = p[3];
                       const float t = ((a.x + a.y) + (a.z + a.w)) + ((b.x + b.y) + (b.z + b.w)) + ((c.x + c.y) + (c.z + c.w)) + ((d.x + d.y) + (d.z + d.w));
                       s = rsqrtf(t * (1.f / 1024.f) + EPS); }
                bf16* rowp = O + (size_t)row * ldc + col0;
#pragma unroll
                for (int bj = 0; bj < 2; ++bj) { const pg8::f32x4 v0 = acc[ai][bj][m][0] * s, v1 = acc[ai][bj][m][1] * s;
                    u32x4 w; w.x = cvt_pk_bf16(v0[0], v0[1]); w.y = cvt_pk_bf16(v0[2], v0[3]); w.z = cvt_pk_bf16(v1[0], v1[1]); w.w = cvt_pk_bf16(v1[2], v1[3]);
                    *(u32x4*)(rowp + bj * 128) = w; }
            }
    }
};
struct EpiProj {
    static constexpr bool PERM = true, AFTER_DRAIN = false;
    bf16* O; const float* rs;
    __device__ __forceinline__ void operator()(const pg8::f32x4 (&acc)[2][2][4][2], const pg8::Unit& u, int wr, int wc, int fr, int fq) const {
        const int row0 = u.pm * 256 + wr * 64 + fr, cin = wc * 32 + 8 * fq, pn = u.pn;
#pragma unroll
        for (int ai = 0; ai < 2; ++ai)
#pragma unroll
            for (int m = 0; m < 4; ++m) {
                const int row = row0 + ai * 128 + m * 16; const float sc = rs[row];
                float a[8], b[8];
#pragma unroll
                for (int i = 0; i < 4; ++i) { a[i] = acc[ai][0][m][0][i] * sc; a[4 + i] = acc[ai][0][m][1][i] * sc; b[i] = acc[ai][1][m][0][i] * sc; b[4 + i] = acc[ai][1][m][1][i] * sc; }
                bf16* rowp = O + (size_t)row * PDIM;
                if (pn >= 4 && pn < 6) {
                    u32x4 w0, w1; w0.x = cvt_pk_bf16(a[0], a[1]); w0.y = cvt_pk_bf16(a[2], a[3]); w0.z = cvt_pk_bf16(a[4], a[5]); w0.w = cvt_pk_bf16(a[6], a[7]);
                    w1.x = cvt_pk_bf16(b[0], b[1]); w1.y = cvt_pk_bf16(b[2], b[3]); w1.z = cvt_pk_bf16(b[4], b[5]); w1.w = cvt_pk_bf16(b[6], b[7]);
                    *(u32x4*)(rowp + 512 + 256 * (pn - 4) + cin) = w0; *(u32x4*)(rowp + 512 + 256 * (pn - 4) + 128 + cin) = w1;
                } else {
                    float o[8];
                    if (pn < 4) {
#pragma unroll
                        for (int i = 0; i < 8; ++i) o[i] = a[i] * b[i];
                    } else {
#pragma unroll
                        for (int i = 0; i < 8; ++i) o[i] = a[i] * sigmoid_f(b[i]);
                    }
                    u32x4 w; w.x = cvt_pk_bf16(o[0], o[1]); w.y = cvt_pk_bf16(o[2], o[3]); w.z = cvt_pk_bf16(o[4], o[5]); w.w = cvt_pk_bf16(o[6], o[7]);
                    *(u32x4*)(rowp + (pn < 4 ? 128 * pn : 1024 + 128 * (pn - 6)) + cin) = w;
                }
            }
    }
};
__host__ __device__ __forceinline__ int win_src_col(int n) {
    const int t = n >> 8, j = n & 255;
    if (t < 4) return (j < 128) ? 128 * t + j : 1024 + 128 * t + (j - 128);
    if (t < 6) return 512 + 256 * (t - 4) + j;
    return (j < 128) ? 1536 + 128 * (t - 6) + j : 2048 + 128 * (t - 6) + (j - 128);
}
struct EpiResidual {
    static constexpr bool PERM = true, AFTER_DRAIN = false;
    bf16* O; const bf16* XB; float* ssq;
    __device__ __forceinline__ void operator()(const pg8::f32x4 (&acc)[2][2][4][2], const pg8::Unit& u, int wr, int wc, int fr, int fq) const {
        const int row0 = u.pm * 256 + wr * 64 + fr, col0 = u.pn * 256 + wc * 32 + 8 * fq;
#pragma unroll
        for (int ai = 0; ai < 2; ++ai)
#pragma unroll
            for (int m = 0; m < 4; ++m) {
                const int row = row0 + ai * 128 + m * 16;
                const bf16* xr = XB + (size_t)row * DM + col0; bf16* rowp = O + (size_t)row * DM + col0;
                float q = 0.f;
                u32x4 xw[2];
#pragma unroll
                for (int bj = 0; bj < 2; ++bj) xw[bj] = *(const u32x4*)(xr + bj * 128);
#pragma unroll
                for (int bj = 0; bj < 2; ++bj) { const f32x4 x0 = (f32x4){bflo(xw[bj].x), bfhi(xw[bj].x), bflo(xw[bj].y), bfhi(xw[bj].y)}, x1 = (f32x4){bflo(xw[bj].z), bfhi(xw[bj].z), bflo(xw[bj].w), bfhi(xw[bj].w)};
                    const pg8::f32x4 v0 = acc[ai][bj][m][0] + x0, v1 = acc[ai][bj][m][1] + x1;
                    q += (v0[0] * v0[0] + v0[1] * v0[1]) + (v0[2] * v0[2] + v0[3] * v0[3]) + (v1[0] * v1[0] + v1[1] * v1[1]) + (v1[2] * v1[2] + v1[3] * v1[3]);
                    u32x4 w; w.x = cvt_pk_bf16(v0[0], v0[1]); w.y = cvt_pk_bf16(v0[2], v0[3]); w.z = cvt_pk_bf16(v1[0], v1[1]); w.w = cvt_pk_bf16(v1[2], v1[3]);
                    *(u32x4*)(rowp + bj * 128) = w; }
                q += __shfl_xor(q, 16); q += __shfl_xor(q, 32);
                if (fq == 0) ssq[(size_t)row * 16 + u.pn * 4 + wc] = q;
            }
    }
};

template <bool MAPIN> __device__ __forceinline__ void p0_transpose_item(const float* W, int K, int N, bf16* WT, LAS float* scr, int item, int lane,
                                                  const float* g_lo, const float* g_hi, int split) {
    const int nblk = N / 32, kb = item / nblk, nb = item % nblk, k0 = 64 * kb, n0 = 32 * nb;
#pragma unroll 8
    for (int i = 0; i < 32; ++i) { const int kk = 2 * i + (lane >> 5); const int k = k0 + kk;
        const float g = (k < split) ? g_lo[k] : g_hi[k - split];
        scr[kk * 33 + (lane & 31)] = W[(size_t)k * N + (MAPIN ? win_src_col(n0) : n0) + (lane & 31)] * g; }
    asm volatile("s_waitcnt lgkmcnt(0)" ::: "memory");
    const int c = lane & 7;
#pragma unroll
    for (int j = 0; j < 4; ++j) { const int n = (lane >> 3) + 8 * j; const LAS float* s = scr + (8 * c) * 33 + n;
        u32x4 o; o.x = pk2(s[0 * 33], s[1 * 33]); o.y = pk2(s[2 * 33], s[3 * 33]); o.z = pk2(s[4 * 33], s[5 * 33]); o.w = pk2(s[6 * 33], s[7 * 33]);
        *(u32x4*)(WT + (size_t)(n0 + n) * K + k0 + 8 * c) = o; }
    asm volatile("s_waitcnt lgkmcnt(0)" ::: "memory");
}

__device__ __forceinline__ float q4(float x, float inv_s) {
    const float a = fabsf(x) * inv_s; float r;
    if (a < 2.f) r = rintf(a * 2.f) * 0.5f; else if (a < 4.f) r = rintf(a); else r = fminf(6.f, rintf(a * 0.5f) * 2.f);
    return copysignf(r, x);
}
__device__ __forceinline__ void phase_prep(const Params& P, LAS unsigned char* lds) {
    const int tid = threadIdx.x, lane = tid & 63, wave = __builtin_amdgcn_readfirstlane(tid >> 6);
    const int gw = blockIdx.x * NWAVES + wave, NGW = gridDim.x * NWAVES;
    unsigned char* ws = P.ws;
    LAS float* scr = (LAS float*)(lds + wave * 16384);
    constexpr int I_IN = (DM / 64) * (DIN / 32), I_OUT = (DM / 64) * (DM / 32), I_Q = (DM / 64) * (2048 / 32);
    for (int it = gw; it < I_IN + I_OUT + I_Q; it += NGW) {
        int r = it;
        if (r < I_IN) { p0_transpose_item<true>(P.w_in, DM, DIN, (bf16*)(ws + WS_WIN_T), scr, r, lane, P.g_mix, P.g_mix, DM); continue; } r -= I_IN;
        if (r < I_OUT) { p0_transpose_item<false>(P.w_out, DM, DM, (bf16*)(ws + WS_WOUT_T), scr, r, lane, P.g_sc, P.g_cf, 512); continue; } r -= I_OUT;
        p0_transpose_item<false>(P.w_q, DM, 2048, (bf16*)(ws + WS_WQ_T), scr, r, lane, P.g_ffn, P.g_ffn, DM);
    }
    {
        bf16* H0B = (bf16*)(ws + WS_H0B); float* RSTD1 = (float*)(ws + WS_RSTD1);
        for (int t0 = gw * 4; t0 < NTOK; t0 += NGW * 4) {
            f32x4 v[4][4];
#pragma unroll
            for (int q = 0; q < 4; ++q) { const f32x4* xr = (const f32x4*)(P.x + (size_t)(t0 + q) * DM) + lane;
#pragma unroll
                for (int j = 0; j < 4; ++j) v[q][j] = xr[64 * j]; }
#pragma unroll
            for (int q = 0; q < 4; ++q) { float sq = 0.f;
#pragma unroll
                for (int j = 0; j < 4; ++j) sq += (v[q][j].x * v[q][j].x + v[q][j].y * v[q][j].y) + (v[q][j].z * v[q][j].z + v[q][j].w * v[q][j].w);
                sq = wave_sum_fast(sq);
                if (lane == 0) RSTD1[t0 + q] = rsqrtf(sq * (1.f / DM) + EPS);
                u32x2* o = (u32x2*)(H0B + (size_t)(t0 + q) * DM) + lane;
#pragma unroll
                for (int j = 0; j < 4; ++j) { u32x2 w; w.x = pk2(v[q][j].x, v[q][j].y); w.y = pk2(v[q][j].z, v[q][j].w); o[64 * j] = w; } }
        }
    }
    {
        unsigned char* U8 = ws + WS_U8; unsigned char* V8 = ws + WS_V8;
        f32x4 gf[4];
#pragma unroll
        for (int j = 0; j < 4; ++j) gf[j] = ((const f32x4*)P.g_ffn)[64 * j + lane];
        float* ESC = (float*)(ws + WS_ESCALE);
        for (int e0 = gw * 2; e0 < 2 * 16384; e0 += NGW * 2) {
            const bool isv = e0 >= 16384; const int ee0 = isv ? e0 - 16384 : e0;
            f32x4 v[2][4];
#pragma unroll
            for (int q = 0; q < 2; ++q) { const f32x4* src = (const f32x4*)((isv ? P.pv : P.pu) + (size_t)(ee0 + q) * DM) + lane;
#pragma unroll
                for (int j = 0; j < 4; ++j) v[q][j] = src[64 * j]; }
#pragma unroll
            for (int q = 0; q < 2; ++q) {
                float mx = 0.f;
#pragma unroll
                for (int j = 0; j < 4; ++j) { if (!isv) v[q][j] = v[q][j] * gf[j];
                    mx = fmaxf(mx, fmaxf(fmaxf(fabsf(v[q][j].x), fabsf(v[q][j].y)), fmaxf(fabsf(v[q][j].z), fabsf(v[q][j].w)))); }
#pragma unroll
                for (int o = 1; o < 64; o <<= 1) mx = fmaxf(mx, __shfl_xor(mx, o));
                const float sc = fmaxf(mx, 1e-30f) * (1.f / 6.f), inv = 1.f / sc;
                if (lane == 0) ESC[e0 + q] = sc;
                unsigned w0 = 0u, w1 = 0u;
                w0 = __builtin_amdgcn_cvt_scalef32_pk_fp4_f32(w0, v[q][0].x * inv, v[q][0].y * inv, 1.0f, 0); w0 = __builtin_amdgcn_cvt_scalef32_pk_fp4_f32(w0, v[q][0].z * inv, v[q][0].w * inv, 1.0f, 1);
                w0 = __builtin_amdgcn_cvt_scalef32_pk_fp4_f32(w0, v[q][1].x * inv, v[q][1].y * inv, 1.0f, 2); w0 = __builtin_amdgcn_cvt_scalef32_pk_fp4_f32(w0, v[q][1].z * inv, v[q][1].w * inv, 1.0f, 3);
                w1 = __builtin_amdgcn_cvt_scalef32_pk_fp4_f32(w1, v[q][2].x * inv, v[q][2].y * inv, 1.0f, 0); w1 = __builtin_amdgcn_cvt_scalef32_pk_fp4_f32(w1, v[q][2].z * inv, v[q][2].w * inv, 1.0f, 1);
                w1 = __builtin_amdgcn_cvt_scalef32_pk_fp4_f32(w1, v[q][3].x * inv, v[q][3].y * inv, 1.0f, 2); w1 = __builtin_amdgcn_cvt_scalef32_pk_fp4_f32(w1, v[q][3].z * inv, v[q][3].w * inv, 1.0f, 3);
                u32x2 o; o.x = w0; o.y = w1;
                *(u32x2*)((isv ? V8 : U8) + (size_t)(ee0 + q) * 512 + 8 * lane) = o;
            }
        }
    }
    {
        bf16* KB = (bf16*)(ws + WS_KEYS);
        const int gt = blockIdx.x * NTHREADS + tid, NGT = gridDim.x * NTHREADS;
        for (int i = gt; i < 8 * 2 * 128 * 128 / 4; i += NGT) { const f32x4 v = ((const f32x4*)P.keys)[i]; u32x2 w; w.x = pk2(v.x, v.y); w.y = pk2(v.z, v.w); ((u32x2*)KB)[i] = w; }
    }
    {
        float* MP = (float*)(ws + WS_METAPART); float* MR = (float*)(ws + WS_METARSTD);
        for (int r = gw; r < NMETA; r += NGW) {
            float s = 0.f;
            for (int k = lane; k < DM; k += 64) { const float v = P.meta[r * DM + k]; s += v * v; }
            s = wave_sum(s);
            if (lane == 0) MR[r] = rsqrtf(s * (1.f / DM) + EPS);
        }
        for (int it = gw; it < MKC * 40; it += NGW) {
            const int kc = it / 40, nb = it % 40, n = nb * 64 + lane;
            float acc[NMETA];
#pragma unroll
            for (int r = 0; r < NMETA; ++r) acc[r] = 0.f;
            for (int k = kc * (DM / MKC); k < (kc + 1) * (DM / MKC); ++k) {
                const float w = P.w_in[(size_t)k * DIN + n] * P.g_mix[k];
#pragma unroll
                for (int r = 0; r < NMETA; ++r) acc[r] += P.meta[r * DM + k] * w;
            }
#pragma unroll
            for (int r = 0; r < NMETA; ++r) MP[(size_t)(kc * 16 + r) * DIN + n] = acc[r];
        }
    }
}

__device__ __forceinline__ float metaraw(const float* MP, const float* MR, int p, int col) { float s = 0.f;
#pragma unroll 8
    for (int kc = 0; kc < MKC; ++kc) s += MP[(size_t)(kc * 16 + p) * DIN + col];
    return s * MR[p]; }
__device__ __forceinline__ void phase_metaproj(const Params& P) {
    const float* MP = (const float*)(P.ws + WS_METAPART); const float* MR = (const float*)(P.ws + WS_METARSTD); float* MJ = (float*)(P.ws + WS_METAPROJ);
    for (int gt = blockIdx.x * NTHREADS + threadIdx.x; gt < NMETA * PDIM; gt += gridDim.x * NTHREADS) { const int p = gt / PDIM, c = gt % PDIM; float v;
        if (c < 512) v = metaraw(MP, MR, p, c) * metaraw(MP, MR, p, 1024 + c);
        else if (c < 1024) v = metaraw(MP, MR, p, c);
        else v = metaraw(MP, MR, p, 1536 + (c - 1024)) * sigmoid_f(metaraw(MP, MR, p, 2048 + (c - 1024)));
        MJ[gt] = v; }
}
__device__ __forceinline__ float meta_val(const float* MJ, const float*, int p, int col) { return MJ[p * PDIM + col]; }
__device__ __forceinline__ float proj_at(const bf16* PROJ, const float* MP, const float* MR, int b, int pos, int col) {
    if (pos < 0) return 0.f;
    if (pos < NMETA) return meta_val(MP, MR, pos, col);
    return bf2f(PROJ[(size_t)(b * SEQ + pos - NMETA) * PDIM + col]);
}
__device__ __forceinline__ void proj8_at(const bf16* PROJ, const float* MP, const float* MR, int b, int pos, int col, float (&v)[8]) {
    if (pos < 0) {
#pragma unroll
        for (int i = 0; i < 8; ++i) v[i] = 0.f;
    } else if (pos < NMETA) {
        const f32x4 a = *(const f32x4*)(MP + pos * PDIM + col), bq = *(const f32x4*)(MP + pos * PDIM + col + 4);
        v[0] = a.x; v[1] = a.y; v[2] = a.z; v[3] = a.w; v[4] = bq.x; v[5] = bq.y; v[6] = bq.z; v[7] = bq.w;
    } else {
        const u32x4 w = *(const u32x4*)(PROJ + (size_t)(b * SEQ + pos - NMETA) * PDIM + col);
        v[0] = bflo(w.x); v[1] = bfhi(w.x); v[2] = bflo(w.y); v[3] = bfhi(w.y); v[4] = bflo(w.z); v[5] = bfhi(w.z); v[6] = bflo(w.w); v[7] = bfhi(w.w);
    }
}

template <int R> __device__ __forceinline__ void conv_rows(const LAS unsigned char* ubase, const f32x2 (&wcf)[31], f32x2 (&acc)[32]) {
    if constexpr (R < 62) {
        const unsigned uw = *(const LAS unsigned*)(ubase + R * 1024);
        const f32x2 x = (f32x2){bflo(uw), bfhi(uw)};
        constexpr int lo = R > 30 ? R - 30 : 0, hi = R < 31 ? R : 31;
#pragma unroll
        for (int ii = lo; ii <= hi; ++ii) acc[ii] += wcf[R - ii] * x;
        conv_rows<R + 1>(ubase, wcf, acc);
    }
}
__device__ __forceinline__ void phase_conv(const Params& P, LAS unsigned char* lds) {
    const int tid = threadIdx.x, lane = tid & 63, wave = __builtin_amdgcn_readfirstlane(tid >> 6);
    unsigned char* ws = P.ws;
    const bf16* PROJ = (const bf16*)(ws + WS_PROJ); const float* MP = (const float*)(ws + WS_METAPROJ); const float* MR = nullptr;
    bf16* Y = (bf16*)(ws + WS_Y);
    constexpr int TT = 64, NTILE = NTOK / TT, UROWS = TT + 30;
    const int cgp = wave & 3, th = wave >> 2, ch2 = cgp * 128 + 2 * lane;
    f32x2 wcf[31];
#pragma unroll
    for (int j = 0; j < 31; ++j) wcf[j] = *(const f32x2*)(P.cf_w + j * 512 + ch2);
    const f32x2 bcf = *(const f32x2*)(P.cf_b + ch2);
    for (int tile = blockIdx.x; tile < NTILE; tile += gridDim.x) {
        const int b = tile / (SEQ / TT), s0 = (tile % (SEQ / TT)) * TT;
#pragma unroll 4
        for (int p = 0; p < (UROWS + 7) / 8; ++p) {
            const int r = p * 8 + wave;
            if (r < UROWS) {
                const int pos = NMETA + s0 - 30 + r;
                float uu[8];
                proj8_at(PROJ, MP, MR, b, pos, 1024 + 8 * lane, uu);
                u32x4 w; w.x = pk2(uu[0], uu[1]); w.y = pk2(uu[2], uu[3]); w.z = pk2(uu[4], uu[5]); w.w = pk2(uu[6], uu[7]);
                *(LAS u32x4*)(lds + r * 1024 + lane * 16) = w;
            }
        }
        __syncthreads();
        f32x2 acc[32];
#pragma unroll
        for (int ii = 0; ii < 32; ++ii) acc[ii] = bcf;
        conv_rows<0>(lds + (32 * th) * 1024 + ch2 * 2, wcf, acc);
        __syncthreads();
#pragma unroll
        for (int ii = 0; ii < 32; ++ii) *(LAS f32x2*)(lds + (32 * th + ii) * 2048 + ch2 * 4) = acc[ii];
        __syncthreads();
        {
            float lng[8], lnb[8];
            { const f32x4 a = *(const f32x4*)(P.ln_g + 8 * lane), c = *(const f32x4*)(P.ln_g + 8 * lane + 4), d = *(const f32x4*)(P.ln_b + 8 * lane), e = *(const f32x4*)(P.ln_b + 8 * lane + 4);
              lng[0] = a.x; lng[1] = a.y; lng[2] = a.z; lng[3] = a.w; lng[4] = c.x; lng[5] = c.y; lng[6] = c.z; lng[7] = c.w;
              lnb[0] = d.x; lnb[1] = d.y; lnb[2] = d.z; lnb[3] = d.w; lnb[4] = e.x; lnb[5] = e.y; lnb[6] = e.z; lnb[7] = e.w; }
            float wsc[3][8];
#pragma unroll
            for (int j = 0; j < 3; ++j) { const f32x4 a = *(const f32x4*)(P.sc_w + j * 512 + 8 * lane), c = *(const f32x4*)(P.sc_w + j * 512 + 8 * lane + 4);
                wsc[j][0] = a.x; wsc[j][1] = a.y; wsc[j][2] = a.z; wsc[j][3] = a.w; wsc[j][4] = c.x; wsc[j][5] = c.y; wsc[j][6] = c.z; wsc[j][7] = c.w; }
            float cxa[8], cxb[8];
            { const int pos = NMETA + s0 + 8 * wave - 2;
              proj8_at(PROJ, MP, MR, b, pos, 8 * lane, cxa); proj8_at(PROJ, MP, MR, b, pos + 1, 8 * lane, cxb); }
#pragma unroll 2
            for (int q = 0; q < 8; ++q) {
                const int ii = 8 * wave + q, s = s0 + ii; const size_t t = (size_t)b * SEQ + s;
                float o[8];
                { const f32x4 a = *(const LAS f32x4*)(lds + ii * 2048 + lane * 32), c = *(const LAS f32x4*)(lds + ii * 2048 + lane * 32 + 16);
                  o[0] = a.x; o[1] = a.y; o[2] = a.z; o[3] = a.w; o[4] = c.x; o[5] = c.y; o[6] = c.z; o[7] = c.w; }
                float s1 = 0.f;
#pragma unroll
                for (int i = 0; i < 8; ++i) s1 += o[i];
                const float mean = wave_sum_fast(s1) * (1.f / 512.f);
                float s2 = 0.f;
#pragma unroll
                for (int i = 0; i < 8; ++i) { o[i] -= mean; s2 += o[i] * o[i]; }
                const float rs = rsqrtf(wave_sum_fast(s2) * (1.f / 512.f) + EPS);
                float s3 = 0.f;
#pragma unroll
                for (int i = 0; i < 8; ++i) { float y = o[i] * rs * lng[i] + lnb[i]; y = y * sigmoid_f(y); o[i] = y; s3 += y * y; }
                const float r2 = rsqrtf(wave_sum_fast(s3) * (1.f / 512.f) + EPS);
                u32x4 wv; wv.x = pk2(o[0] * r2, o[1] * r2); wv.y = pk2(o[2] * r2, o[3] * r2); wv.z = pk2(o[4] * r2, o[5] * r2); wv.w = pk2(o[6] * r2, o[7] * r2);
                *(u32x4*)(Y + t * DM + 512 + 8 * lane) = wv;
                float bgv[8], cxc[8], accs[8];
                proj8_at(PROJ, MP, MR, b, NMETA + s, 8 * lane, cxc); proj8_at(PROJ, MP, MR, b, NMETA + s, 512 + 8 * lane, bgv);
                float s4 = 0.f;
#pragma unroll
                for (int i = 0; i < 8; ++i) { accs[i] = bgv[i] * (wsc[0][i] * cxa[i] + wsc[1][i] * cxb[i] + wsc[2][i] * cxc[i]); s4 += accs[i] * accs[i]; cxa[i] = cxb[i]; cxb[i] = cxc[i]; }
                const float r4 = rsqrtf(wave_sum_fast(s4) * (1.f / 512.f) + EPS);
                u32x4 wz; wz.x = pk2(accs[0] * r4, accs[1] * r4); wz.y = pk2(accs[2] * r4, accs[3] * r4); wz.z = pk2(accs[4] * r4, accs[5] * r4); wz.w = pk2(accs[6] * r4, accs[7] * r4);
                *(u32x4*)(Y + t * DM + 8 * lane) = wz;
            }
        }
        __syncthreads();
    }
}

__device__ __forceinline__ int ord_i(float s) { int k = __builtin_bit_cast(int, s); k ^= (k >> 31) & 0x7fffffff; return k; }
__device__ __forceinline__ float unord_f(int k) { k ^= (k >> 31) & 0x7fffffff; return __builtin_bit_cast(float, k); }
#define TOP_INSERT(L, x_) do { int _x = (x_); _Pragma("unroll") for (int _i = 0; _i < 16; ++_i) { const int _hi = max(L[_i], _x); _x = min(L[_i], _x); L[_i] = _hi; } } while (0)

typedef short bf16x8 __attribute__((ext_vector_type(8)));
typedef float f32x16 __attribute__((ext_vector_type(16)));
template <bool DESC> __device__ __forceinline__ void ce_i(int& a, int& b) { const int hi = max(a, b), lo = min(a, b); if (DESC) { a = hi; b = lo; } else { a = lo; b = hi; } }
__device__ __forceinline__ void bitonic_sort16(int (&a)[16]) {
#pragma unroll
    for (int k = 2; k <= 16; k <<= 1)
#pragma unroll
        for (int j = k >> 1; j > 0; j >>= 1)
#pragma unroll
            for (int i = 0; i < 16; ++i) { const int l = i ^ j; if (l > i) { if ((i & k) == 0) ce_i<true>(a[i], a[l]); else ce_i<false>(a[i], a[l]); } }
}
__device__ __forceinline__ void bitonic_merge16(int (&a)[16]) {
#pragma unroll
    for (int j = 8; j > 0; j >>= 1)
#pragma unroll
        for (int i = 0; i < 16; ++i) { const int l = i ^ j; if (l > i) ce_i<true>(a[i], a[l]); }
}
__device__ __forceinline__ void merge_top16(int (&a)[16], const int (&b)[16]) {
#pragma unroll
    for (int i = 0; i < 16; ++i) a[i] = max(a[i], b[15 - i]);
    bitonic_merge16(a);
}
__device__ __forceinline__ int lut16(const unsigned (&T)[4], int i) {
    const unsigned sel = (unsigned)(i & 7) | 0x0c0c0c00u;
    const unsigned lo = __builtin_amdgcn_perm(T[1], T[0], sel), hi = __builtin_amdgcn_perm(T[3], T[2], sel);
    return (int)((i & 8) ? hi : lo);
}
constexpr int KROW = 272;
constexpr float SCORE_BIAS = 8.0f;

__device__ __forceinline__ void route_load_q(bf16x8 (&qf)[8], const bf16* qrow, int hb) {
#pragma unroll
    for (int ks = 0; ks < 8; ++ks) qf[ks] = *(const bf16x8*)(qrow + 64 * hb + 8 * ks);
}
__device__ __forceinline__ void route_half(const LAS unsigned char* kl, const bf16x8 (&qf)[8], int nl, int hb, int (&L)[16]) {
    f32x16 acc[4];
#pragma unroll
    for (int nt = 0; nt < 4; ++nt)
#pragma unroll
        for (int r = 0; r < 16; ++r) acc[nt][r] = SCORE_BIAS;
#pragma unroll
    for (int ks = 0; ks < 8; ++ks)
#pragma unroll
        for (int nt = 0; nt < 4; ++nt) {
            const bf16x8 a = *(const LAS bf16x8*)(kl + (32 * nt + nl) * KROW + (64 * hb + 8 * ks) * 2);
            acc[nt] = __builtin_amdgcn_mfma_f32_32x32x16_bf16(a, qf[ks], acc[nt], 0, 0, 0);
        }
    const int hb4 = 4 * hb;
    int T[4][16];
#pragma unroll
    for (int nt = 0; nt < 4; ++nt)
#pragma unroll
        for (int r = 0; r < 16; ++r) { const int n0 = 32 * nt + (r & 3) + 8 * (r >> 2); const float sc = acc[nt][r];
            T[nt][r] = (__float_as_int(sc) & ~127) | ((127 - n0) - hb4); }
    bitonic_sort16(T[0]); bitonic_sort16(T[1]); bitonic_sort16(T[2]); bitonic_sort16(T[3]);
    merge_top16(T[0], T[1]); merge_top16(T[2], T[3]); merge_top16(T[0], T[2]);
#pragma unroll
    for (int i = 0; i < 16; ++i) { const unsigned v = (unsigned)T[0][15 - i]; auto r = __builtin_amdgcn_permlane32_swap(v, v, false, false);
        const unsigned r0 = r[0], r1 = r[1]; const int partner = (int)(hb ? r0 : r1); L[i] = max(T[0][i], partner); }
    bitonic_merge16(L);
}

__device__ __forceinline__ void phase_route(const Params& P, LAS unsigned char* lds) {
    const int tid = threadIdx.x, lane = tid & 63, wave = __builtin_amdgcn_readfirstlane(tid >> 6);
    const int nl = lane & 31, hb = lane >> 5;
    unsigned char* ws = P.ws;
    const bf16* KEYS = (const bf16*)(ws + WS_KEYS); const bf16* Q = (const bf16*)(ws + WS_Q);
    int* IDX = (int*)(ws + WS_IDX); float* GATE = (float*)(ws + WS_GATE);
    int last_h = -1;
    const int nunits = (NTOK / 256) * NHEAD;
    bf16x8 qfA[8], qfB[8];
    if ((int)blockIdx.x < nunits) { const int h = blockIdx.x & 7, tb = blockIdx.x >> 3; route_load_q(qfA, Q + ((size_t)tb * 256 + wave * 32 + nl) * 2048 + h * 256, hb); }
    for (int unit = blockIdx.x; unit < nunits; unit += gridDim.x) {
        const int h = unit & 7, tb = unit >> 3;
        if (h != last_h) {
            __syncthreads();
            for (int c = tid; c < 4096; c += NTHREADS) { const u32x4 v = ((const u32x4*)(KEYS + (size_t)h * 32768))[c];
                *(LAS u32x4*)(lds + (c >> 4) * KROW + (c & 15) * 16) = v; }
            __syncthreads();
            last_h = h;
        }
        const size_t t = (size_t)tb * 256 + wave * 32 + nl;
        int L1[16], L2[16];
        route_load_q(qfB, Q + t * 2048 + h * 256 + 128, hb);
        route_half(lds, qfA, nl, hb, L1);
        { const int un = unit + gridDim.x; if (un < nunits) { const int hn = un & 7, tbn = un >> 3; route_load_q(qfA, Q + ((size_t)tbn * 256 + wave * 32 + nl) * 2048 + hn * 256, hb); } }
        route_half(lds + 128 * KROW, qfB, nl, hb, L2);
        float v1[16], v2[16];
#pragma unroll
        for (int i = 0; i < 16; ++i) { v1[i] = __int_as_float(L1[i] & ~127); v2[i] = __int_as_float(L2[i] & ~127); }
#define CAND(i, j) ((__float_as_int(v1[i] + v2[j]) & ~255) | (255 - (16 * (i) + (j))))
        int A[16], B[16], C[16];
#pragma unroll
        for (int j = 0; j < 16; ++j) A[j] = CAND(0, j);
#pragma unroll
        for (int j = 0; j < 8; ++j) { B[j] = CAND(1, j); B[8 + j] = CAND(15 - j, 0); }
        bitonic_merge16(B);
        C[0] = CAND(2, 0); C[1] = CAND(2, 1); C[2] = CAND(2, 2); C[3] = CAND(2, 3); C[4] = CAND(2, 4);
        C[5] = CAND(3, 0); C[6] = CAND(3, 1); C[7] = CAND(3, 2); C[8] = CAND(3, 3);
        C[9] = CAND(4, 0); C[10] = CAND(4, 1); C[11] = CAND(4, 2);
        C[12] = CAND(5, 0); C[13] = CAND(5, 1); C[14] = CAND(6, 0); C[15] = CAND(6, 1);
        bitonic_sort16(C);
        { const int d0 = CAND(7, 0), d1 = CAND(7, 1); C[14] = max(C[14], d1); C[15] = max(C[15], d0); bitonic_merge16(C); }
#undef CAND
        merge_top16(A, B); merge_top16(A, C);
        unsigned T1[4], T2[4];
#pragma unroll
        for (int q = 0; q < 4; ++q) {
            T1[q] = (unsigned)(127 - (L1[4 * q] & 127)) | ((unsigned)(127 - (L1[4 * q + 1] & 127)) << 8) | ((unsigned)(127 - (L1[4 * q + 2] & 127)) << 16) | ((unsigned)(127 - (L1[4 * q + 3] & 127)) << 24);
            T2[q] = (unsigned)(127 - (L2[4 * q] & 127)) | ((unsigned)(127 - (L2[4 * q + 1] & 127)) << 8) | ((unsigned)(127 - (L2[4 * q + 2] & 127)) << 16) | ((unsigned)(127 - (L2[4 * q + 3] & 127)) << 24); }
        float val[16]; int ex[16];
#pragma unroll
        for (int k = 0; k < 16; ++k) { const int pos = 255 - (A[k] & 255); val[k] = __int_as_float(A[k] & ~255);
            ex[k] = lut16(T1, pos >> 4) * NKEYS + lut16(T2, pos & 15); }
        float sum = 0.f; const float vmax = val[0];
#pragma unroll
        for (int k = 0; k < 16; ++k) { val[k] = __expf(val[k] - vmax); sum += val[k]; }
        const float inv = 1.f / sum;
        if (hb == 0) {
            int* ip = IDX + t * NSEL + h * TOPK; float* gp = GATE + t * NSEL + h * TOPK;
#pragma unroll
            for (int k4 = 0; k4 < 4; ++k4) {
                *(int4*)(ip + 4 * k4) = make_int4(ex[4 * k4], ex[4 * k4 + 1], ex[4 * k4 + 2], ex[4 * k4 + 3]);
                *(f32x4*)(gp + 4 * k4) = (f32x4){val[4 * k4] * inv, val[4 * k4 + 1] * inv, val[4 * k4 + 2] * inv, val[4 * k4 + 3] * inv};
            }
        }
    }
}

#define FP4X2(w, sel) __builtin_amdgcn_cvt_scalef32_pk_f32_fp4((w), 1.0f, (sel))
__device__ __forceinline__ float dot16_fp4(const u32x2 r, const f32x4 (&xs)[4]) {
    float p = 0.f;
    { const f32x2 a = FP4X2(r.x, 0), b = FP4X2(r.x, 1), c = FP4X2(r.x, 2), d = FP4X2(r.x, 3);
      p += (a.x * xs[0].x + a.y * xs[0].y) + (b.x * xs[0].z + b.y * xs[0].w); p += (c.x * xs[1].x + c.y * xs[1].y) + (d.x * xs[1].z + d.y * xs[1].w); }
    { const f32x2 a = FP4X2(r.y, 0), b = FP4X2(r.y, 1), c = FP4X2(r.y, 2), d = FP4X2(r.y, 3);
      p += (a.x * xs[2].x + a.y * xs[2].y) + (b.x * xs[2].z + b.y * xs[2].w); p += (c.x * xs[3].x + c.y * xs[3].y) + (d.x * xs[3].z + d.y * xs[3].w); }
    return p;
}
__device__ __forceinline__ void axpy16_fp4(const u32x2 r, float w, f32x4 (&o)[4]) {
    { const f32x2 a = FP4X2(r.x, 0), b = FP4X2(r.x, 1), c = FP4X2(r.x, 2), d = FP4X2(r.x, 3);
      o[0].x += w * a.x; o[0].y += w * a.y; o[0].z += w * b.x; o[0].w += w * b.y; o[1].x += w * c.x; o[1].y += w * c.y; o[1].z += w * d.x; o[1].w += w * d.y; }
    { const f32x2 a = FP4X2(r.y, 0), b = FP4X2(r.y, 1), c = FP4X2(r.y, 2), d = FP4X2(r.y, 3);
      o[2].x += w * a.x; o[2].y += w * a.y; o[2].z += w * b.x; o[2].w += w * b.y; o[3].x += w * c.x; o[3].y += w * c.y; o[3].z += w * d.x; o[3].w += w * d.y; }
}
__device__ __forceinline__ float swap32_add(float a, float b) { auto r = __builtin_amdgcn_permlane32_swap(__float_as_uint(a), __float_as_uint(b), false, false); return __uint_as_float(r[0]) + __uint_as_float(r[1]); }
__device__ __forceinline__ float swap16_add(float a, float b) { auto r = __builtin_amdgcn_permlane16_swap(__float_as_uint(a), __float_as_uint(b), false, false); return __uint_as_float(r[0]) + __uint_as_float(r[1]); }
__device__ __forceinline__ float row_sum16(float v) { v += dpp_f<0xB1>(v); v += dpp_f<0x4E>(v); v += dpp_f<0x141>(v); v += dpp_f<0x140>(v); return v; }
constexpr int GB = 32;
typedef __attribute__((address_space(8))) void* rsrc_t;
__device__ __forceinline__ void g_issue(u32x2 (&buf)[GB], __amdgpu_buffer_rsrc_t rs, int idxr, int lb, int voff) {
#pragma unroll
    for (int j = 0; j < GB; ++j) { const int e = __builtin_amdgcn_readlane(idxr, lb + j); buf[j] = __builtin_amdgcn_raw_buffer_load_b64(rs, voff, e * 512, 0); }
}
__device__ __forceinline__ float dot16_fp4p(const u32x2 r, const f32x2 (&xp)[8]) {
    f32x2 a = FP4X2(r.x, 0) * xp[0];
    a += FP4X2(r.x, 1) * xp[1]; a += FP4X2(r.x, 2) * xp[2]; a += FP4X2(r.x, 3) * xp[3];
    a += FP4X2(r.y, 0) * xp[4]; a += FP4X2(r.y, 1) * xp[5]; a += FP4X2(r.y, 2) * xp[6]; a += FP4X2(r.y, 3) * xp[7];
    return a.x + a.y;
}
__device__ __forceinline__ void axpy16_fp4p(const u32x2 r, float w, f32x2 (&o)[8]) {
    const f32x2 ww = (f32x2){w, w};
    o[0] += FP4X2(r.x, 0) * ww; o[1] += FP4X2(r.x, 1) * ww; o[2] += FP4X2(r.x, 2) * ww; o[3] += FP4X2(r.x, 3) * ww;
    o[4] += FP4X2(r.y, 0) * ww; o[5] += FP4X2(r.y, 1) * ww; o[6] += FP4X2(r.y, 2) * ww; o[7] += FP4X2(r.y, 3) * ww;
}
template <int H> __device__ __forceinline__ void g_compute_u(const u32x2 (&buf)[GB], int q, int i16, const f32x2 (&xp)[8], float& zlo, float& zhi) {
    float p[16];
#pragma unroll
    for (int j = 0; j < 16; ++j) p[j] = dot16_fp4p(buf[16 * H + j], xp);
    float s1[8], s2[4];
#pragma unroll
    for (int m = 0; m < 8; ++m) s1[m] = swap32_add(p[2 * m], p[2 * m + 1]);
#pragma unroll
    for (int n = 0; n < 4; ++n) s2[n] = swap16_add(s1[2 * n], s1[2 * n + 1]);
#pragma unroll
    for (int r = 0; r < 4; ++r) { const float z = row_sum16(s2[r]); const bool mine = i16 == ((4 * q + r) & 15);
        zlo = (mine && q < 4) ? z : zlo; zhi = (mine && q >= 4) ? z : zhi; }
}
template <int H> __device__ __forceinline__ void g_compute_v(const u32x2 (&buf)[GB], int q, float alo, float ahi, f32x2 (&o)[8]) {
    const int areg = __builtin_bit_cast(int, (q < 4) ? alo : ahi), sb = 4 * (q & 3);
#pragma unroll
    for (int j = 0; j < 16; ++j) { const int src = 32 * (j & 1) + 16 * ((j >> 1) & 1) + (j >> 2) + sb;
        const float w = __builtin_bit_cast(float, __builtin_amdgcn_readlane(areg, src));
        axpy16_fp4p(buf[16 * H + j], w, o); }
}
__device__ __forceinline__ void q_issue(u32x2 (&buf)[16], __amdgpu_buffer_rsrc_t rs, int ixr  , int lb, int voff) {
#pragma unroll
    for (int j = 0; j < 16; ++j) { const int e9 = __builtin_amdgcn_readlane(ixr, lb + j); buf[j] = __builtin_amdgcn_raw_buffer_load_b64(rs, voff, e9, 0); }
}
__device__ __forceinline__ void q_compute_u(const u32x2 (&buf)[16], int q, int i16, const f32x2 (&xp)[8], float& zlo, float& zhi) {
    float p[16];
#pragma unroll
    for (int j = 0; j < 16; ++j) p[j] = dot16_fp4p(buf[j], xp);
    float s1[8], s2[4];
#pragma unroll
    for (int m = 0; m < 8; ++m) s1[m] = swap32_add(p[2 * m], p[2 * m + 1]);
#pragma unroll
    for (int n = 0; n < 4; ++n) s2[n] = swap16_add(s1[2 * n], s1[2 * n + 1]);
#pragma unroll
    for (int r = 0; r < 4; ++r) { const float z = row_sum16(s2[r]); const bool mine = i16 == ((4 * q + r) & 15);
        zlo = (mine && q < 4) ? z : zlo; zhi = (mine && q >= 4) ? z : zhi; }
}
__device__ __forceinline__ void q_compute_v(const u32x2 (&buf)[16], int q, float alo, float ahi, f32x2 (&o)[8]) {
    const int areg = __builtin_bit_cast(int, (q < 4) ? alo : ahi), sb = 4 * (q & 3);
#pragma unroll
    for (int j = 0; j < 16; ++j) { const int src = 32 * (j & 1) + 16 * ((j >> 1) & 1) + (j >> 2) + sb;
        const float w = __builtin_bit_cast(float, __builtin_amdgcn_readlane(areg, src));
        axpy16_fp4p(buf[j], w, o); }
}
__device__ __forceinline__ void phase_gather_u(const Params& P) {
    const int tid = threadIdx.x, lane = tid & 63, wave = __builtin_amdgcn_readfirstlane(tid >> 6);
    const int gw = blockIdx.x * NWAVES + wave, NGW = gridDim.x * NWAVES;
    unsigned char* ws = P.ws;
    const int* IDX = (const int*)(ws + WS_IDX); const float* GATE = (const float*)(ws + WS_GATE); const float* ESC = (const float*)(ws + WS_ESCALE); float* AW = (float*)(ws + WS_AW);
    const __amdgpu_buffer_rsrc_t rsU = __builtin_amdgcn_make_buffer_rsrc((void*)(ws + WS_U8), 0, 16384 * 512, 0x00020000);
    const bf16* H2B = (const bf16*)(ws + WS_H2B); const float* SSQ = (const float*)(ws + WS_SSQ);
    const int hh = lane >> 5, rr = (lane >> 4) & 1, i16 = lane & 15, gsel = 4 * i16 + 2 * rr + hh;
    const int voff = 8 * lane;
    const unsigned ul = (unsigned)lane;
    int t = gw;
    if (t < NTOK) {
        int idx0, idx1; u32x2 hraw[4]; float sqv;
        { const int* ip = IDX + (size_t)t * NSEL; idx0 = ip[ul]; idx1 = ip[64u + ul];
          const u32x2* hp = (const u32x2*)(H2B + (size_t)t * DM);
#pragma unroll
          for (int j = 0; j < 4; ++j) hraw[j] = hp[64u * j + ul];
          sqv = (SSQ + (size_t)t * 16)[ul & 15u]; }
        u32x2 R0[16], R1[16], R2[16], R3[16];
        { const int ix0 = idx0 << 9; q_issue(R0, rsU, ix0, 0, voff); q_issue(R1, rsU, ix0, 16, voff); q_issue(R2, rsU, ix0, 32, voff); }
        for (;;) {
            const int tn = t + NGW; const bool has_next = tn < NTOK; const int tl = has_next ? tn : t;
            int idx0n, idx1n; u32x2 hrawn[4]; float sqn, g0, g1;
            { const int* ip = IDX + (size_t)tl * NSEL; idx0n = ip[ul]; idx1n = ip[64u + ul];
              const u32x2* hp = (const u32x2*)(H2B + (size_t)tl * DM);
#pragma unroll
              for (int j = 0; j < 4; ++j) hrawn[j] = hp[64u * j + ul];
              sqn = (SSQ + (size_t)tl * 16)[ul & 15u];
              const float* gp = GATE + (size_t)t * NSEL; g0 = gp[ul]; g1 = gp[64u + ul]; }
            const float su0 = ESC[idx0], su1 = ESC[idx1], sv0 = ESC[16384 + idx0], sv1 = ESC[16384 + idx1];
            const float rstd2 = rsqrtf(row_sum16(sqv) * (1.f / DM) + EPS);
            f32x2 xp[8];
#pragma unroll
            for (int j = 0; j < 4; ++j) { xp[2 * j] = (f32x2){bflo(hraw[j].x), bfhi(hraw[j].x)}; xp[2 * j + 1] = (f32x2){bflo(hraw[j].y), bfhi(hraw[j].y)}; }
            float zlo = 0.f, zhi = 0.f;
            const int ix0 = idx0 << 9, ix1 = idx1 << 9;
#pragma unroll 1
            for (int qq = 0; qq < 8; qq += 4) {
                const int ixn = qq ? (idx0n << 9) : ix1;
                q_issue(R3, rsU, qq ? ix1 : ix0, 48, voff);
                q_compute_u(R0, qq, i16, xp, zlo, zhi);
                q_issue(R0, rsU, ixn, 0, voff);
                q_compute_u(R1, qq + 1, i16, xp, zlo, zhi);
                q_issue(R1, rsU, ixn, 16, voff);
                q_compute_u(R2, qq + 2, i16, xp, zlo, zhi);
                q_issue(R2, rsU, ixn, 32, voff);
                q_compute_u(R3, qq + 3, i16, xp, zlo, zhi);
            }
            const float glo = __shfl(g0, gsel), ghi = __shfl(g1, gsel), sulo = __shfl(su0, gsel), suhi = __shfl(su1, gsel), svlo = __shfl(sv0, gsel), svhi = __shfl(sv1, gsel);
            float* ap = AW + (size_t)t * NSEL;
            ap[ul] = gelu_tanh_f(zlo * rstd2 * sulo) * glo * svlo; ap[64u + ul] = gelu_tanh_f(zhi * rstd2 * suhi) * ghi * svhi;
            if (!has_next) break;
            t = tn; idx0 = idx0n; idx1 = idx1n; sqv = sqn;
#pragma unroll
            for (int j = 0; j < 4; ++j) hraw[j] = hrawn[j];
        }
    }
}
__device__ __forceinline__ void phase_gather_v(const Params& P) {
    const int tid = threadIdx.x, lane = tid & 63, wave = __builtin_amdgcn_readfirstlane(tid >> 6);
    const int gw = blockIdx.x * NWAVES + wave, NGW = gridDim.x * NWAVES;
    unsigned char* ws = P.ws;
    const int* IDX = (const int*)(ws + WS_IDX); const float* AW = (const float*)(ws + WS_AW);
    const __amdgpu_buffer_rsrc_t rsV = __builtin_amdgcn_make_buffer_rsrc((void*)(ws + WS_V8), 0, 16384 * 512, 0x00020000);
    const bf16* H2B = (const bf16*)(ws + WS_H2B);
    const int voff = 8 * lane;
    const unsigned ul = (unsigned)lane;
    int t = gw;
    if (t < NTOK) {
        int idx0, idx1; u32x2 hraw[4]; float alo, ahi;
        { const int* ip = IDX + (size_t)t * NSEL; idx0 = ip[ul]; idx1 = ip[64u + ul];
          const u32x2* hp = (const u32x2*)(H2B + (size_t)t * DM);
#pragma unroll
          for (int j = 0; j < 4; ++j) hraw[j] = hp[64u * j + ul];
          const float* ap = AW + (size_t)t * NSEL; alo = ap[ul]; ahi = ap[64u + ul]; }
        u32x2 R0[16], R1[16], R2[16], R3[16];
        { const int ix0 = idx0 << 9; q_issue(R0, rsV, ix0, 0, voff); q_issue(R1, rsV, ix0, 16, voff); q_issue(R2, rsV, ix0, 32, voff); }
        for (;;) {
            const int tn = t + NGW; const bool has_next = tn < NTOK; const int tl = has_next ? tn : t;
            int idx0n, idx1n; u32x2 hrawn[4]; float alon, ahin;
            { const int* ip = IDX + (size_t)tl * NSEL; idx0n = ip[ul]; idx1n = ip[64u + ul];
              const u32x2* hp = (const u32x2*)(H2B + (size_t)tl * DM);
#pragma unroll
              for (int j = 0; j < 4; ++j) hrawn[j] = hp[64u * j + ul];
              const float* ap = AW + (size_t)tl * NSEL; alon = ap[ul]; ahin = ap[64u + ul]; }
            f32x2 o[8];
#pragma unroll
            for (int j = 0; j < 8; ++j) o[j] = (f32x2){0.f, 0.f};
            const int ix0 = idx0 << 9, ix1 = idx1 << 9;
#pragma unroll 1
            for (int qq = 0; qq < 8; qq += 4) {
                const int ixn = qq ? (idx0n << 9) : ix1;
                q_issue(R3, rsV, qq ? ix1 : ix0, 48, voff);
                q_compute_v(R0, qq, alo, ahi, o);
                q_issue(R0, rsV, ixn, 0, voff);
                q_compute_v(R1, qq + 1, alo, ahi, o);
                q_issue(R1, rsV, ixn, 16, voff);
                q_compute_v(R2, qq + 2, alo, ahi, o);
                q_issue(R2, rsV, ixn, 32, voff);
                q_compute_v(R3, qq + 3, alo, ahi, o);
            }
            float ss = 0.f;
#pragma unroll
            for (int j = 0; j < 4; ++j) { o[2 * j] += (f32x2){bflo(hraw[j].x), bfhi(hraw[j].x)}; o[2 * j + 1] += (f32x2){bflo(hraw[j].y), bfhi(hraw[j].y)}; }
#pragma unroll
            for (int j = 0; j < 8; ++j) ss += o[j].x * o[j].x + o[j].y * o[j].y;
            ss = wave_sum_fast(ss);
            const float r3 = rsqrtf(ss * (1.f / DM) + EPS);
            f32x4* op = (f32x4*)(P.out + (size_t)t * DM);
            const f32x4* gfp = (const f32x4*)P.g_fin;
#pragma unroll
            for (int j = 0; j < 4; ++j) { const f32x4 gv = gfp[64u * j + ul]; op[64u * j + ul] = (f32x4){o[2 * j].x * r3 * gv.x, o[2 * j].y * r3 * gv.y, o[2 * j + 1].x * r3 * gv.z, o[2 * j + 1].y * r3 * gv.w}; }
            if (!has_next) break;
            t = tn; idx0 = idx0n; idx1 = idx1n; alo = alon; ahi = ahin;
#pragma unroll
            for (int j = 0; j < 4; ++j) hraw[j] = hrawn[j];
        }
    }
}

#define XB_TMO      128
#define XB_XCNT(j)  (256  + 64 * (j))
#define XB_XSUB(j)  (1280 + 64 * (j))
#define XB_XGEN(j)  (2304 + 64 * (j))
#define XB_TOP      3328
#define XB_TOPGEN   3392
#define XCD_BAR_WORDS 3456
#define XB_SPIN_CAP (1u << 18)

__device__ __forceinline__ unsigned xb_ld(unsigned* p)              { return __hip_atomic_load(p, __ATOMIC_RELAXED, __HIP_MEMORY_SCOPE_AGENT); }
__device__ __forceinline__ unsigned xb_add(unsigned* p, unsigned v) { return __hip_atomic_fetch_add(p, v, __ATOMIC_RELAXED, __HIP_MEMORY_SCOPE_AGENT); }
__device__ __forceinline__ unsigned xb_xcc_id() { return (unsigned)__builtin_amdgcn_s_getreg((3 << 11) | 20) & 0xFu; }
#define XB_SPIN(cond, bar) do { unsigned _sp = 0; while (cond) { __builtin_amdgcn_s_sleep(1); \
    if ((++_sp & 255u) == 0u) { if (xb_ld(&(bar)[XB_TMO])) break; if (_sp > XB_SPIN_CAP) { atomicAdd(&(bar)[XB_TMO], 1u); break; } } } } while (0)

struct XcdBarrier {
    unsigned* bar; unsigned x;
    volatile LAS unsigned* st;
};

__device__ __forceinline__ XcdBarrier xcd_barrier_post(unsigned* bar, volatile LAS unsigned* st) {
    XcdBarrier b; b.bar = bar; b.x = xb_xcc_id(); b.st = st;
    if (threadIdx.x == 0) (void)xb_add(&bar[XB_XCNT(b.x)], 1u);
    return b;
}
__device__ __forceinline__ void xcd_barrier_complete(unsigned* bar, unsigned x, unsigned& nloc, unsigned& nx) {
    const unsigned G = gridDim.x * gridDim.y * gridDim.z;
    unsigned sum, cnt, mine, sp = 0u;
    for (;;) {
        sum = 0u; cnt = 0u; mine = 0u;
#pragma unroll
        for (unsigned j = 0; j < 16; ++j) { const unsigned c = xb_ld(&bar[XB_XCNT(j)]); sum += c; cnt += (c > 0u) ? 1u : 0u; mine = (j == x) ? c : mine; }
        if (sum == G) break;
        __builtin_amdgcn_s_sleep(1);
        if ((++sp & 255u) == 0u) { if (xb_ld(&bar[XB_TMO])) break; if (sp > XB_SPIN_CAP) { atomicAdd(&bar[XB_TMO], 1u); break; } }
    }
    nloc = mine > 0u ? mine : 1u; nx = cnt > 0u ? cnt : 1u;
}

__device__ __forceinline__ void xcd_barrier(const XcdBarrier& b) {
    asm volatile("s_waitcnt vmcnt(0)" ::: "memory");
    __syncthreads();
    if (threadIdx.x == 0) {
        unsigned* bar = b.bar;
        __builtin_amdgcn_s_waitcnt(0);
        unsigned nloc = b.st[0], nx = b.st[1];
        if (nloc == 0u) { xcd_barrier_complete(bar, b.x, nloc, nx); b.st[0] = nloc; b.st[1] = nx; }
        const unsigned old = xb_add(&bar[XB_XSUB(b.x)], 1u);
        const unsigned gen = old / nloc;
        if (old + 1u == (gen + 1u) * nloc) {
            __builtin_amdgcn_fence(__ATOMIC_RELEASE, "agent");
            asm volatile("s_waitcnt vmcnt(0)" ::: "memory");
            const unsigned og = xb_add(&bar[XB_TOP], 1u);
            const unsigned tg = og / nx;
            if (og + 1u == (tg + 1u) * nx) xb_add(&bar[XB_TOPGEN], 1u);
            else XB_SPIN(xb_ld(&bar[XB_TOPGEN]) == tg, bar);
            __builtin_amdgcn_fence(__ATOMIC_ACQUIRE, "agent");
            xb_add(&bar[XB_XGEN(b.x)], 1u);
            asm volatile("s_waitcnt vmcnt(0)" ::: "memory");
        } else {
            XB_SPIN(xb_ld(&bar[XB_XGEN(b.x)]) == gen, bar);
            __builtin_amdgcn_fence(__ATOMIC_ACQUIRE, "agent");
            asm volatile("s_waitcnt vmcnt(0)" ::: "memory");
        }
    }
    __syncthreads();
}


#ifndef MK_MULTI
#define MK_MULTI 0
#endif
constexpr int NPHASE = 8;
#ifndef REP5
#define REP5 1
#endif
#ifndef REP6
#define REP6 1
#endif
__global__ void __launch_bounds__(NTHREADS, 2) mk_fwd(Params P) {
    extern __shared__ __attribute__((aligned(16))) unsigned char lds_raw[];
    LAS unsigned char* lds = (LAS unsigned char*)lds_raw;
    cg::grid_group grid = cg::this_grid();
    unsigned char* ws = P.ws;
    const int lo = P.ph_lo, hi = P.ph_hi;
    volatile LAS unsigned* bst = (volatile LAS unsigned*)(lds + 131072 + 64);
    if (threadIdx.x < 2) bst[threadIdx.x] = 0u;
    __syncthreads();
    XcdBarrier xbar = xcd_barrier_post((unsigned*)(ws + WS_CTL), bst);
#define IN(k) (lo <= (k) && (k) < hi)
#define SEAM(k) do { if (IN(k) && IN((k) + 1)) { xcd_barrier(xbar); } } while (0)
#ifndef SKIP0
    if (IN(0)) phase_prep(P, lds);
#endif
    SEAM(0);
#ifndef SKIP1
    if (IN(1)) {
        phase_metaproj(P);
        pg8::Gemm g{(const bf16*)(ws + WS_H0B), (const bf16*)(ws + WS_WIN_T), NTOK, DIN, DM}; pg8::StaticOrder S; S.init(NTOK, DIN, (int)gridDim.x, (int)blockIdx.x);
        EpiProj E{(bf16*)(ws + WS_PROJ), (const float*)(ws + WS_RSTD1)};
        pg8::gemm_phase<EpiProj, pg8::StaticOrder, true, true>(lds, g, S, E);
    }
#endif
    SEAM(1);
#ifndef SKIP2
    if (IN(2)) phase_conv(P, lds);
#endif
    SEAM(2);
#ifndef SKIP3
    if (IN(3)) {
        pg8::Gemm g{(const bf16*)(ws + WS_Y), (const bf16*)(ws + WS_WOUT_T), NTOK, DM, DM}; pg8::StaticOrder S; S.init(NTOK, DM, (int)gridDim.x, (int)blockIdx.x);
        EpiResidual E{(bf16*)(ws + WS_H2B), (const bf16*)(ws + WS_H0B), (float*)(ws + WS_SSQ)};
        pg8::gemm_phase<EpiResidual, pg8::StaticOrder, true, true>(lds, g, S, E);
    }
#endif
    SEAM(3);
#ifndef SKIP4
    if (IN(4)) {
        pg8::Gemm g{(const bf16*)(ws + WS_H2B), (const bf16*)(ws + WS_WQ_T), NTOK, 2048, DM}; pg8::StaticOrder S; S.init(NTOK, 2048, (int)gridDim.x, (int)blockIdx.x);
        EpiRowScale<1> E{(bf16*)(ws + WS_Q), 2048, (const float*)(ws + WS_SSQ)};
        pg8::gemm_phase<EpiRowScale<1>, pg8::StaticOrder, true, true>(lds, g, S, E);
    }
#endif
    SEAM(4);
#ifndef SKIP5
    if (IN(5)) for (int rep = 0; rep < REP5; ++rep) phase_route(P, lds);
#endif
    SEAM(5);
    if (IN(6)) phase_gather_u(P);
    SEAM(6);
    if (IN(7)) phase_gather_v(P);
#undef IN
#undef SEAM
}

extern "C" void kernel_launch(void* const* d_in, const int* in_sizes, int n_in, void* d_out, int out_size, void* d_ws, size_t ws_size, hipStream_t stream) {
    static int grid = 0;
    if (grid == 0) {
        if (n_in != 18 || in_sizes[0] != NTOK * DM || out_size != NTOK * DM || ws_size < WS_END) {
            fprintf(stderr, "kernel_launch: unexpected shapes (n_in %d in0 %d out %d ws %zu)\n", n_in, n_in > 0 ? in_sizes[0] : -1, out_size, ws_size); grid = -1; return; }
        int dev = 0, cus = 0, per_cu = 0;
        (void)hipGetDevice(&dev); (void)hipDeviceGetAttribute(&cus, hipDeviceAttributeMultiprocessorCount, dev);
        if (hipFuncSetAttribute((const void*)mk_fwd, hipFuncAttributeMaxDynamicSharedMemorySize, LDS_BYTES) != hipSuccess) { fprintf(stderr, "kernel_launch: hipFuncSetAttribute failed\n"); grid = -1; return; }
        if (hipOccupancyMaxActiveBlocksPerMultiprocessor(&per_cu, (const void*)mk_fwd, NTHREADS, LDS_BYTES) != hipSuccess || per_cu < 1) { fprintf(stderr, "kernel_launch: occupancy query failed (%d)\n", per_cu); (void)hipGetLastError(); per_cu = 1; }
        if (per_cu > 1) per_cu = 1;
        grid = cus * per_cu;
        if (grid <= 0) grid = 256;
    }
    if (grid < 0) return;
    Params p{};
    p.x = (const float*)d_in[0]; p.meta = (const float*)d_in[1]; p.g_mix = (const float*)d_in[2]; p.w_in = (const float*)d_in[3]; p.sc_w = (const float*)d_in[4];
    p.cf_w = (const float*)d_in[5]; p.cf_b = (const float*)d_in[6]; p.ln_g = (const float*)d_in[7]; p.ln_b = (const float*)d_in[8]; p.g_sc = (const float*)d_in[9];
    p.g_cf = (const float*)d_in[10]; p.w_out = (const float*)d_in[11]; p.g_ffn = (const float*)d_in[12]; p.w_q = (const float*)d_in[13]; p.keys = (const float*)d_in[14];
    p.pu = (const float*)d_in[15]; p.pv = (const float*)d_in[16]; p.g_fin = (const float*)d_in[17];
    p.out = (float*)d_out; p.ws = (unsigned char*)d_ws;
    (void)hipMemsetAsync((char*)d_ws + WS_CTL, 0, 16384, stream);
#if MK_MULTI
    for (int ph = 0; ph < NPHASE; ++ph) { p.ph_lo = ph; p.ph_hi = ph + 1; p.coop = 0; p.pad = 0;
        hipLaunchKernelGGL(mk_fwd, dim3(grid), dim3(NTHREADS), LDS_BYTES, stream, p); }
#else
    p.ph_lo = 0; p.ph_hi = NPHASE; p.coop = 1; p.pad = 0;
    void* args[] = {&p};
    hipError_t e = hipLaunchCooperativeKernel((const void*)mk_fwd, dim3(grid), dim3(NTHREADS), args, LDS_BYTES, stream);
    if (e != hipSuccess) fprintf(stderr, "cooperative launch failed: %s (grid %d)\n", hipGetErrorString(e), grid);
#endif
}
```

```cpp
#include <hip/hip_runtime.h>
#include <hip/hip_cooperative_groups.h>
#include <cstdio>
#include <cstdint>
namespace cg = cooperative_groups;

namespace pg8 {
#define PG8_LAS __attribute__((address_space(3)))
typedef unsigned short bf16_t;
typedef short bf16x8 __attribute__((ext_vector_type(8)));
typedef float f32x4 __attribute__((ext_vector_type(4)));
typedef unsigned u32x4 __attribute__((ext_vector_type(4)));
constexpr int BM = 256, BK = 64, HALF = 128, HTB = HALF * BK * 2  , STAGE_BYTES = 8 * HTB, NXCD = 8, WGM = 8;

__host__ __device__ __forceinline__ int lds_byte(int r, int c) { const int st = (r >> 4) * 2 + (c >> 5), rr = r & 15, cc = c & 31, ob = rr * 64 + cc * 2; return st * 1024 + (ob ^ (((ob >> 9) & 1) << 5)); }
__host__ __device__ __forceinline__ void stage_rc(int b, int& R, int& C) { const int st = b / 1024, sb = b % 1024, swz = sb ^ (((sb >> 9) & 1) << 5); R = (st >> 1) * 16 + swz / 64; C = (st & 1) * 32 + (swz % 64) / 2; }
__host__ __device__ __forceinline__ int perm32(int rho) { const int n = rho >> 4, i = rho & 15; return 8 * (i >> 2) + 4 * n + (i & 3); }

struct Unit { int pm, pn; };
struct Gemm { const bf16_t* A; const bf16_t* Bt; int M, N, K; };

struct StaticOrder {
    int nM, nN, nwg, G, c;
    __host__ __device__ void init(int M, int N, int G_, int c_) { nM = M / BM; nN = N / BM; nwg = nM * nN; G = G_; c = c_; }
    __host__ __device__ bool next(int i, Unit& u) const {
        const long L = (long)i * G + c; if (L >= nwg) return false;
        int wgid = (int)L; { const int q = nwg / NXCD, r = nwg % NXCD, xcd = wgid % NXCD, off = wgid / NXCD; wgid = (xcd < r ? xcd * (q + 1) : r * (q + 1) + (xcd - r) * q) + off; }
        const int nig = WGM * nN, gid = wgid / nig, fm = gid * WGM, gsz = (nM - fm) < WGM ? (nM - fm) : WGM;
        u.pm = fm + ((wgid % nig) % gsz); u.pn = (wgid % nig) / gsz; return true;
    }
    __device__ __forceinline__ void a_ready(const Unit&) const {}
    __device__ __forceinline__ void done(const Unit&) const {}
};

template <class Epi, class Sched, bool ALIGN_EPI = false, bool SP2 = false>
__device__ __forceinline__ void gemm_phase(PG8_LAS unsigned char* lds, const Gemm g, const Sched& S, const Epi& E) {
    const int tid = threadIdx.x, wid = __builtin_amdgcn_readfirstlane(tid >> 6), lane = tid & 63, wr = wid >> 2, wc = wid & 3, fr = lane & 15, fq = lane >> 4;
    const int K = g.K, nt = K / BK;
    unsigned voffA[2], voffB[2];
#pragma unroll
    for (int i = 0; i < 2; ++i) { int R, C; stage_rc(tid * 16 + i * 8192, R, C); const int Rb = Epi::PERM ? ((R & ~31) + perm32(R & 31)) : R;
        voffA[i] = (unsigned)(R * K + C) * 2u; voffB[i] = (unsigned)(Rb * K + C) * 2u; }
    const size_t kstep = (size_t)(BK * 2);
    const size_t hstep = (size_t)HALF * K * 2;
    const size_t tstep = 2 * hstep;
    const unsigned ldsw = (unsigned)wid * 1024u;
    const int aoff = lds_byte(wr * 64 + fr, fq * 8), boff = lds_byte(wc * 32 + fr, fq * 8);
#define PG8_SA(b, h) (((b) * 2 + (h)) * HTB)
#define PG8_SB(b, h) ((4 + (b) * 2 + (h)) * HTB)
#define PG8_STAGE(bufoff, gbase, voff) do { _Pragma("unroll") for (int _i = 0; _i < 2; ++_i) \
        __builtin_amdgcn_global_load_lds((const unsigned*)((const char*)(gbase) + (voff)[_i]), (PG8_LAS unsigned*)(lds + (bufoff) + ldsw + _i * 8192), 16, 0, 0); } while (0)
#define PG8_LDA(dst, b, h) do { _Pragma("unroll") for (int m = 0; m < 4; ++m) _Pragma("unroll") for (int k = 0; k < 2; ++k) dst[m][k] = *(const PG8_LAS bf16x8*)(lds + PG8_SA(b, h) + aoff + m * 2048 + k * 1024); } while (0)
#define PG8_LDB(dst, b, h) do { _Pragma("unroll") for (int n = 0; n < 2; ++n) _Pragma("unroll") for (int k = 0; k < 2; ++k) dst[n][k] = *(const PG8_LAS bf16x8*)(lds + PG8_SB(b, h) + boff + n * 2048 + k * 1024); } while (0)
#define PG8_MMA(ai, bj, At, Bt) do { __builtin_amdgcn_s_setprio(1); _Pragma("unroll") for (int m = 0; m < 4; ++m) _Pragma("unroll") for (int n = 0; n < 2; ++n) _Pragma("unroll") for (int k = 0; k < 2; ++k) \
        acc[ai][bj][m][n] = __builtin_amdgcn_mfma_f32_16x16x32_bf16(Bt[n][k], At[m][k], acc[ai][bj][m][n], 0, 0, 0); __builtin_amdgcn_s_setprio(0); } while (0)
#define PG8_WAIT_V(n) asm volatile("s_waitcnt vmcnt(" #n ")" ::: "memory")
#define PG8_WAIT_L(n) asm volatile("s_waitcnt lgkmcnt(" #n ")" ::: "memory")
#define PG8_BAR __builtin_amdgcn_s_barrier()
#define PG8_SCHED __builtin_amdgcn_sched_barrier(0)
    Unit cur, nxt; int ui = 0;
    if (!S.next(0, cur)) return;
    f32x4 acc[2][2][4][2];
#pragma unroll
    for (int a = 0; a < 2; ++a)
#pragma unroll
        for (int b = 0; b < 2; ++b)
#pragma unroll
            for (int m = 0; m < 4; ++m)
#pragma unroll
                for (int n = 0; n < 2; ++n) acc[a][b][m][n] = (f32x4){0.f, 0.f, 0.f, 0.f};
    bf16x8 At[4][2], B0[2][2], B1[2][2];
    const char* cA = (const char*)g.A + (size_t)cur.pm * tstep; const char* cB = (const char*)g.Bt + (size_t)cur.pn * tstep;
    S.a_ready(cur);
    if constexpr (SP2) {
        PG8_STAGE(PG8_SB(0, 0), cB, voffB); PG8_STAGE(PG8_SB(0, 1), cB + hstep, voffB); PG8_STAGE(PG8_SA(0, 0), cA, voffA); PG8_STAGE(PG8_SA(0, 1), cA + hstep, voffA);
        if (wr == 1) PG8_BAR;
        PG8_WAIT_V(2); PG8_BAR;
        PG8_STAGE(PG8_SB(1, 0), cB + kstep, voffB); PG8_STAGE(PG8_SA(1, 0), cA + kstep, voffA); PG8_STAGE(PG8_SB(1, 1), cB + hstep + kstep, voffB);
        PG8_WAIT_V(6); PG8_BAR;
    } else {
        PG8_STAGE(PG8_SB(0, 0), cB, voffB); PG8_STAGE(PG8_SA(0, 0), cA, voffA); PG8_STAGE(PG8_SB(0, 1), cB + hstep, voffB); PG8_STAGE(PG8_SA(0, 1), cA + hstep, voffA);
        if (wr == 1) PG8_BAR;
        PG8_WAIT_V(4); PG8_BAR;
        PG8_STAGE(PG8_SB(1, 0), cB + kstep, voffB); PG8_STAGE(PG8_SA(1, 0), cA + kstep, voffA); PG8_STAGE(PG8_SB(1, 1), cB + hstep + kstep, voffB);
        PG8_WAIT_V(6); PG8_BAR;
    }
    for (;;) {
        const bool has_next = S.next(ui + 1, nxt);
        const char* nA = has_next ? (const char*)g.A + (size_t)nxt.pm * tstep : cA; const char* nB = has_next ? (const char*)g.Bt + (size_t)nxt.pn * tstep : cB;
        for (int t = 0; t < nt; t += 2) {
            const bool last = (t == nt - 2);
            const char* a1 = cA + (size_t)(t + 1) * kstep;
            const char* a2 = last ? nA : cA + (size_t)(t + 2) * kstep; const char* b2 = last ? nB : cB + (size_t)(t + 2) * kstep;
            const char* a3 = a2 + kstep; const char* b3 = b2 + kstep;
            if (last && has_next) S.a_ready(nxt);
            if constexpr (SP2) {
            PG8_LDB(B0, 0, 0); PG8_LDB(B1, 0, 1); PG8_SCHED; PG8_LDA(At, 0, 0); PG8_STAGE(PG8_SA(1, 1), a1 + hstep, voffA);
            PG8_WAIT_V(8); PG8_WAIT_L(0); PG8_BAR; PG8_MMA(0, 0, At, B0); PG8_MMA(0, 1, At, B1); PG8_BAR; PG8_SCHED;
            PG8_LDA(At, 0, 1); PG8_STAGE(PG8_SB(0, 0), b2, voffB); PG8_STAGE(PG8_SB(0, 1), b2 + hstep, voffB); PG8_STAGE(PG8_SA(0, 0), a2, voffA);
            PG8_WAIT_V(8); PG8_WAIT_L(0); PG8_BAR; PG8_MMA(1, 0, At, B0); PG8_MMA(1, 1, At, B1); PG8_BAR; PG8_SCHED;
            PG8_LDB(B0, 1, 0); PG8_LDB(B1, 1, 1); PG8_SCHED; PG8_LDA(At, 1, 0); PG8_STAGE(PG8_SA(0, 1), a2 + hstep, voffA);
            PG8_WAIT_V(8); PG8_WAIT_L(0); PG8_BAR; PG8_MMA(0, 0, At, B0); PG8_MMA(0, 1, At, B1); PG8_BAR; PG8_SCHED;
            PG8_LDA(At, 1, 1); PG8_STAGE(PG8_SB(1, 0), b3, voffB); PG8_STAGE(PG8_SB(1, 1), b3 + hstep, voffB); PG8_STAGE(PG8_SA(1, 0), a3, voffA);
            PG8_WAIT_V(8); PG8_WAIT_L(0); PG8_BAR; PG8_MMA(1, 0, At, B0); PG8_MMA(1, 1, At, B1); PG8_BAR; PG8_SCHED;
            } else {
            PG8_LDB(B0, 0, 0); PG8_SCHED; PG8_LDA(At, 0, 0); PG8_STAGE(PG8_SA(1, 1), a1 + hstep, voffA);
            PG8_WAIT_L(8); PG8_BAR; PG8_WAIT_L(0); PG8_MMA(0, 0, At, B0); PG8_BAR; PG8_SCHED;
            PG8_LDB(B1, 0, 1); PG8_STAGE(PG8_SB(0, 0), b2, voffB);
            PG8_BAR; PG8_WAIT_L(0); PG8_MMA(0, 1, At, B1); PG8_BAR;
            PG8_LDA(At, 0, 1); PG8_STAGE(PG8_SA(0, 0), a2, voffA);
            PG8_BAR; PG8_WAIT_L(0); PG8_MMA(1, 0, At, B0); PG8_BAR; PG8_SCHED;
            PG8_STAGE(PG8_SB(0, 1), b2 + hstep, voffB);
            PG8_WAIT_V(6); PG8_BAR; PG8_MMA(1, 1, At, B1); PG8_BAR;
            PG8_LDB(B0, 1, 0); PG8_SCHED; PG8_LDA(At, 1, 0); PG8_STAGE(PG8_SA(0, 1), a2 + hstep, voffA);
            PG8_WAIT_L(8); PG8_BAR; PG8_WAIT_L(0); PG8_MMA(0, 0, At, B0); PG8_BAR; PG8_SCHED;
            PG8_LDB(B1, 1, 1); PG8_STAGE(PG8_SB(1, 0), b3, voffB);
            PG8_BAR; PG8_WAIT_L(0); PG8_MMA(0, 1, At, B1); PG8_BAR;
            PG8_LDA(At, 1, 1); PG8_STAGE(PG8_SA(1, 0), a3, voffA);
            PG8_BAR; PG8_WAIT_L(0); PG8_MMA(1, 0, At, B0); PG8_BAR; PG8_SCHED;
            PG8_STAGE(PG8_SB(1, 1), b3 + hstep, voffB);
            PG8_WAIT_V(6); PG8_BAR; PG8_MMA(1, 1, At, B1); PG8_BAR;
            }
        }
        if constexpr (ALIGN_EPI) { if (wr == 0) PG8_BAR; }
        if constexpr (!Epi::AFTER_DRAIN) { E(acc, cur, wr, wc, fr, fq); S.done(cur); }
        if (!has_next) break;
#pragma unroll
        for (int a = 0; a < 2; ++a)
#pragma unroll
            for (int b = 0; b < 2; ++b)
#pragma unroll
                for (int m = 0; m < 4; ++m)
#pragma unroll
                    for (int n = 0; n < 2; ++n) acc[a][b][m][n] = (f32x4){0.f, 0.f, 0.f, 0.f};
        cur = nxt; cA = nA; cB = nB; ++ui;
        if constexpr (ALIGN_EPI) { if (wr == 1) PG8_BAR; }
    }
    PG8_WAIT_V(0);
    if constexpr (!ALIGN_EPI) { if (wr == 0) PG8_BAR; }
    PG8_BAR;
    if constexpr (Epi::AFTER_DRAIN) { E.fused(acc, cur, wr, wc, fr, fq, lds, wid, lane); S.done(cur); }
#undef PG8_SA
#undef PG8_SB
#undef PG8_STAGE
#undef PG8_LDA
#undef PG8_LDB
#undef PG8_MMA
#undef PG8_WAIT_V
#undef PG8_WAIT_L
#undef PG8_BAR
#undef PG8_SCHED
}
}

#define LAS __attribute__((address_space(3)))
typedef unsigned short bf16;
typedef float f32x2 __attribute__((ext_vector_type(2)));
typedef float f32x4 __attribute__((ext_vector_type(4)));
typedef unsigned u32x2 __attribute__((ext_vector_type(2)));
typedef unsigned u32x4 __attribute__((ext_vector_type(4)));

constexpr int PDIM = 1536;
constexpr int NTOK = 32768, DM = 1024, DIN = 2560, SEQ = 8192, NBATCH = 4, NMETA = 16;
constexpr int NHEAD = 8, NKEYS = 128, TOPK = 16, NSEL = NHEAD * TOPK;
constexpr float EPS = 1e-6f;
constexpr float U_SCALE = 64.f, V_SCALE = 16.f;
constexpr int NWAVES = 8, NTHREADS = 512;
constexpr int MKC = 32;
constexpr int LDS_BYTES = 147456;

constexpr size_t MiB = 1u << 20;
constexpr size_t WS_CTL = 0, WS_WIN_T = 1 * MiB, WS_WOUT_T = 6 * MiB, WS_WQ_T = 8 * MiB, WS_KEYS = 12 * MiB, WS_METAPART = 160 * MiB  ,
                 WS_METARSTD = 14 * MiB + 512 * 1024, WS_METAPROJ = 14 * MiB + 576 * 1024, WS_RSTD1 = 15 * MiB, WS_SSQ = 16 * MiB, WS_U8 = 32 * MiB, WS_V8 = 48 * MiB,
                 WS_IDX = 64 * MiB, WS_GATE = 80 * MiB, WS_H0B = 96 * MiB, WS_H2B = 96 * MiB, WS_Y = 160 * MiB, WS_PROJ = 224 * MiB,
                 WS_Q = 224 * MiB, WS_ESCALE = 18 * MiB, WS_AW = 160 * MiB  , WS_END = 384 * MiB;

struct Params {
    const float* x; const float* meta; const float* g_mix; const float* w_in; const float* sc_w; const float* cf_w; const float* cf_b;
    const float* ln_g; const float* ln_b; const float* g_sc; const float* g_cf; const float* w_out; const float* g_ffn; const float* w_q;
    const float* keys; const float* pu; const float* pv; const float* g_fin;
    float* out; unsigned char* ws;
    int ph_lo, ph_hi, coop, pad;
};

__device__ __forceinline__ unsigned f2bf(float f) { unsigned u = __builtin_bit_cast(unsigned, f); return (u + 0x7fffu + ((u >> 16) & 1u)) >> 16; }
__device__ __forceinline__ unsigned pk2(float lo, float hi) { return f2bf(lo) | (f2bf(hi) << 16); }
__device__ __forceinline__ float bf2f(unsigned b) { return __builtin_bit_cast(float, b << 16); }
__device__ __forceinline__ float bflo(unsigned w) { return __builtin_bit_cast(float, w << 16); }
__device__ __forceinline__ float bfhi(unsigned w) { return __builtin_bit_cast(float, w & 0xffff0000u); }
__device__ __forceinline__ float wave_sum(float v) {
#pragma unroll
    for (int o = 1; o < 64; o <<= 1) v += __shfl_xor(v, o);
    return v;
}
template <int CTRL> __device__ __forceinline__ float dpp_f(float v) { return __builtin_bit_cast(float, __builtin_amdgcn_update_dpp(0, __builtin_bit_cast(int, v), CTRL, 0xf, 0xf, true)); }
__device__ __forceinline__ float wave_sum_fast(float v) {
    v += dpp_f<0xB1>(v); v += dpp_f<0x4E>(v); v += dpp_f<0x141>(v); v += dpp_f<0x140>(v);
    { auto r = __builtin_amdgcn_permlane16_swap(__float_as_uint(v), __float_as_uint(v), false, false); v = __uint_as_float(r[0]) + __uint_as_float(r[1]); }
    { auto r = __builtin_amdgcn_permlane32_swap(__float_as_uint(v), __float_as_uint(v), false, false); v = __uint_as_float(r[0]) + __uint_as_float(r[1]); }
    return v;
}
__device__ __forceinline__ float sigmoid_f(float x) { return 1.f / (1.f + __expf(-x)); }
__device__ __forceinline__ float gelu_tanh_f(float x) {
    const float t = 0.7978845608028654f * (x + 0.044715f * x * x * x);
    const float e = __expf(2.f * t);
    const float th = 1.f - 2.f / (e + 1.f);
    return 0.5f * x * (1.f + th);
}

__device__ __forceinline__ unsigned cvt_pk_bf16(float lo, float hi) { unsigned r; asm volatile("v_cvt_pk_bf16_f32 %0, %1, %2" : "=v"(r) : "v"(lo), "v"(hi)); return r; }

template <int MODE> struct EpiRowScale {
    static constexpr bool PERM = true, AFTER_DRAIN = false;
    bf16* O; int ldc; const float* rs;
    __device__ __forceinline__ void operator()(const pg8::f32x4 (&acc)[2][2][4][2], const pg8::Unit& u, int wr, int wc, int fr, int fq) const {
        const int row0 = u.pm * 256 + wr * 64 + fr, col0 = u.pn * 256 + wc * 32 + 8 * fq;
#pragma unroll
        for (int ai = 0; ai < 2; ++ai)
#pragma unroll
            for (int m = 0; m < 4; ++m) {
                const int row = row0 + ai * 128 + m * 16;
                float s;
                if (MODE == 0) s = rs[row];
                else { const f32x4* p = (const f32x4*)(rs + (size_t)row * 16); const f32x4 a = p[0], b = p[1], c = p[2], d = p[3];
                       const float t = ((a.x + a.y) + (a.z + a.w)) + ((b.x + b.y) + (b.z + b.w)) + ((c.x + c.y) + (c.z + c.w)) + ((d.x + d.y) + (d.z + d.w));
                       s = rsqrtf(t * (1.f / 1024.f) + EPS); }
                bf16* rowp = O + (size_t)row * ldc + col0;
#pragma unroll
                for (int bj = 0; bj < 2; ++bj) { const pg8::f32x4 v0 = acc[ai][bj][m][0] * s, v1 = acc[ai][bj][m][1] * s;
                    u32x4 w; w.x = cvt_pk_bf16(v0[0], v0[1]); w.y = cvt_pk_bf16(v0[2], v0[3]); w.z = cvt_pk_bf16(v1[0], v1[1]); w.w = cvt_pk_bf16(v1[2], v1[3]);
                    *(u32x4*)(rowp + bj * 128) = w; }
            }
    }
};
struct EpiProj {
    static constexpr bool PERM = true, AFTER_DRAIN = false;
    bf16* O; const float* rs;
    __device__ __forceinline__ void operator()(const pg8::f32x4 (&acc)[2][2][4][2], const pg8::Unit& u, int wr, int wc, int fr, int fq) const {
        const int row0 = u.pm * 256 + wr * 64 + fr, cin = wc * 32 + 8 * fq, pn = u.pn;
#pragma unroll
        for (int ai = 0; ai < 2; ++ai)
#pragma unroll
            for (int m = 0; m < 4; ++m) {
                const int row = row0 + ai * 128 + m * 16; const float sc = rs[row];
                float a[8], b[8];
#pragma unroll
                for (int i = 0; i < 4; ++i) { a[i] = acc[ai][0][m][0][i] * sc; a[4 + i] = acc[ai][0][m][1][i] * sc; b[i] = acc[ai][1][m][0][i] * sc; b[4 + i] = acc[ai][1][m][1][i] * sc; }
                bf16* rowp = O + (size_t)row * PDIM;
                if (pn >= 4 && pn < 6) {
                    u32x4 w0, w1; w0.x = cvt_pk_bf16(a[0], a[1]); w0.y = cvt_pk_bf16(a[2], a[3]); w0.z = cvt_pk_bf16(a[4], a[5]); w0.w = cvt_pk_bf16(a[6], a[7]);
                    w1.x = cvt_pk_bf16(b[0], b[1]); w1.y = cvt_pk_bf16(b[2], b[3]); w1.z = cvt_pk_bf16(b[4], b[5]); w1.w = cvt_pk_bf16(b[6], b[7]);
                    *(u32x4*)(rowp + 512 + 256 * (pn - 4) + cin) = w0; *(u32x4*)(rowp + 512 + 256 * (pn - 4) + 128 + cin) = w1;
                } else {
                    float o[8];
                    if (pn < 4) {
#pragma unroll
                        for (int i = 0; i < 8; ++i) o[i] = a[i] * b[i];
                    } else {
#pragma unroll
                        for (int i = 0; i < 8; ++i) o[i] = a[i] * sigmoid_f(b[i]);
                    }
                    u32x4 w; w.x = cvt_pk_bf16(o[0], o[1]); w.y = cvt_pk_bf16(o[2], o[3]); w.z = cvt_pk_bf16(o[4], o[5]); w.w = cvt_pk_bf16(o[6], o[7]);
                    *(u32x4*)(rowp + (pn < 4 ? 128 * pn : 1024 + 128 * (pn - 6)) + cin) = w;
                }
            }
    }
};
__host__ __device__ __forceinline__ int win_src_col(int n) {
    const int t = n >> 8, j = n & 255;
    if (t < 4) return (j < 128) ? 128 * t + j : 1024 + 128 * t + (j - 128);
    if (t < 6) return 512 + 256 * (t - 4) + j;
    return (j < 128) ? 1536 + 128 * (t - 6) + j : 2048 + 128 * (t - 6) + (j - 128);
}
struct EpiResidual {
    static constexpr bool PERM = true, AFTER_DRAIN = false;
    bf16* O; const bf16* XB; float* ssq;
    __device__ __forceinline__ void operator()(const pg8::f32x4 (&acc)[2][2][4][2], const pg8::Unit& u, int wr, int wc, int fr, int fq) const {
        const int row0 = u.pm * 256 + wr * 64 + fr, col0 = u.pn * 256 + wc * 32 + 8 * fq;
#pragma unroll
        for (int ai = 0; ai < 2; ++ai)
#pragma unroll
            for (int m = 0; m < 4; ++m) {
                const int row = row0 + ai * 128 + m * 16;
                const bf16* xr = XB + (size_t)row * DM + col0; bf16* rowp = O + (size_t)row * DM + col0;
                float q = 0.f;
                u32x4 xw[2];
#pragma unroll
                for (int bj = 0; bj < 2; ++bj) xw[bj] = *(const u32x4*)(xr + bj * 128);
#pragma unroll
                for (int bj = 0; bj < 2; ++bj) { const f32x4 x0 = (f32x4){bflo(xw[bj].x), bfhi(xw[bj].x), bflo(xw[bj].y), bfhi(xw[bj].y)}, x1 = (f32x4){bflo(xw[bj].z), bfhi(xw[bj].z), bflo(xw[bj].w), bfhi(xw[bj].w)};
                    const pg8::f32x4 v0 = acc[ai][bj][m][0] + x0, v1 = acc[ai][bj][m][1] + x1;
                    q += (v0[0] * v0[0] + v0[1] * v0[1]) + (v0[2] * v0[2] + v0[3] * v0[3]) + (v1[0] * v1[0] + v1[1] * v1[1]) + (v1[2] * v1[2] + v1[3] * v1[3]);
                    u32x4 w; w.x = cvt_pk_bf16(v0[0], v0[1]); w.y = cvt_pk_bf16(v0[2], v0[3]); w.z = cvt_pk_bf16(v1[0], v1[1]); w.w = cvt_pk_bf16(v1[2], v1[3]);
                    *(u32x4*)(rowp + bj * 128) = w; }
                q += __shfl_xor(q, 16); q += __shfl_xor(q, 32);
                if (fq == 0) ssq[(size_t)row * 16 + u.pn * 4 + wc] = q;
            }
    }
};

template <bool MAPIN> __device__ __forceinline__ void p0_transpose_item(const float* W, int K, int N, bf16* WT, LAS float* scr, int item, int lane,
                                                  const float* g_lo, const float* g_hi, int split) {
    const int nblk = N / 32, kb = item / nblk, nb = item % nblk, k0 = 64 * kb, n0 = 32 * nb;
#pragma unroll 8
    for (int i = 0; i < 32; ++i) { const int kk = 2 * i + (lane >> 5); const int k = k0 + kk;
        const float g = (k < split) ? g_lo[k] : g_hi[k - split];
        scr[kk * 33 + (lane & 31)] = W[(size_t)k * N + (MAPIN ? win_src_col(n0) : n0) + (lane & 31)] * g; }
    asm volatile("s_waitcnt lgkmcnt(0)" ::: "memory");
    const int c = lane & 7;
#pragma unroll
    for (int j = 0; j < 4; ++j) { const int n = (lane >> 3) + 8 * j; const LAS float* s = scr + (8 * c) * 33 + n;
        u32x4 o; o.x = pk2(s[0 * 33], s[1 * 33]); o.y = pk2(s[2 * 33], s[3 * 33]); o.z = pk2(s[4 * 33], s[5 * 33]); o.w = pk2(s[6 * 33], s[7 * 33]);
        *(u32x4*)(WT + (size_t)(n0 + n) * K + k0 + 8 * c) = o; }
    asm volatile("s_waitcnt lgkmcnt(0)" ::: "memory");
}

__device__ __forceinline__ float q4(float x, float inv_s) {
    const float a = fabsf(x) * inv_s; float r;
    if (a < 2.f) r = rintf(a * 2.f) * 0.5f; else if (a < 4.f) r = rintf(a); else r = fminf(6.f, rintf(a * 0.5f) * 2.f);
    return copysignf(r, x);
}
__device__ __forceinline__ void phase_prep(const Params& P, LAS unsigned char* lds) {
    const int tid = threadIdx.x, lane = tid & 63, wave = __builtin_amdgcn_readfirstlane(tid >> 6);
    const int gw = blockIdx.x * NWAVES + wave, NGW = gridDim.x * NWAVES;
    unsigned char* ws = P.ws;
    LAS float* scr = (LAS float*)(lds + wave * 16384);
    constexpr int I_IN = (DM / 64) * (DIN / 32), I_OUT = (DM / 64) * (DM / 32), I_Q = (DM / 64) * (2048 / 32);
    for (int it = gw; it < I_IN + I_OUT + I_Q; it += NGW) {
        int r = it;
        if (r < I_IN) { p0_transpose_item<true>(P.w_in, DM, DIN, (bf16*)(ws + WS_WIN_T), scr, r, lane, P.g_mix, P.g_mix, DM); continue; } r -= I_IN;
        if (r < I_OUT) { p0_transpose_item<false>(P.w_out, DM, DM, (bf16*)(ws + WS_WOUT_T), scr, r, lane, P.g_sc, P.g_cf, 512); continue; } r -= I_OUT;
        p0_transpose_item<false>(P.w_q, DM, 2048, (bf16*)(ws + WS_WQ_T), scr, r, lane, P.g_ffn, P.g_ffn, DM);
    }
    {
        bf16* H0B = (bf16*)(ws + WS_H0B); float* RSTD1 = (float*)(ws + WS_RSTD1);
        for (int t0 = gw * 4; t0 < NTOK; t0 += NGW * 4) {
            f32x4 v[4][4];
#pragma unroll
            for (int q = 0; q < 4; ++q) { const f32x4* xr = (const f32x4*)(P.x + (size_t)(t0 + q) * DM) + lane;
#pragma unroll
                for (int j = 0; j < 4; ++j) v[q][j] = xr[64 * j]; }
#pragma unroll
            for (int q = 0; q < 4; ++q) { float sq = 0.f;
#pragma unroll
                for (int j = 0; j < 4; ++j) sq += (v[q][j].x * v[q][j].x + v[q][j].y * v[q][j].y) + (v[q][j].z * v[q][j].z + v[q][j].w * v[q][j].w);
                sq = wave_sum_fast(sq);
                if (lane == 0) RSTD1[t0 + q] = rsqrtf(sq * (1.f / DM) + EPS);
                u32x2* o = (u32x2*)(H0B + (size_t)(t0 + q) * DM) + lane;
#pragma unroll
                for (int j = 0; j < 4; ++j) { u32x2 w; w.x = pk2(v[q][j].x, v[q][j].y); w.y = pk2(v[q][j].z, v[q][j].w); o[64 * j] = w; } }
        }
    }
    {
        unsigned char* U8 = ws + WS_U8; unsigned char* V8 = ws + WS_V8;
        f32x4 gf[4];
#pragma unroll
        for (int j = 0; j < 4; ++j) gf[j] = ((const f32x4*)P.g_ffn)[64 * j + lane];
        float* ESC = (float*)(ws + WS_ESCALE);
        for (int e0 = gw * 2; e0 < 2 * 16384; e0 += NGW * 2) {
            const bool isv = e0 >= 16384; const int ee0 = isv ? e0 - 16384 : e0;
            f32x4 v[2][4];
#pragma unroll
            for (int q = 0; q < 2; ++q) { const f32x4* src = (const f32x4*)((isv ? P.pv : P.pu) + (size_t)(ee0 + q) * DM) + lane;
#pragma unroll
                for (int j = 0; j < 4; ++j) v[q][j] = src[64 * j]; }
#pragma unroll
            for (int q = 0; q < 2; ++q) {
                float mx = 0.f;
#pragma unroll
                for (int j = 0; j < 4; ++j) { if (!isv) v[q][j] = v[q][j] * gf[j];
                    mx = fmaxf(mx, fmaxf(fmaxf(fabsf(v[q][j].x), fabsf(v[q][j].y)), fmaxf(fabsf(v[q][j].z), fabsf(v[q][j].w)))); }
#pragma unroll
                for (int o = 1; o < 64; o <<= 1) mx = fmaxf(mx, __shfl_xor(mx, o));
                const float sc = fmaxf(mx, 1e-30f) * (1.f / 6.f), inv = 1.f / sc;
                if (lane == 0) ESC[e0 + q] = sc;
                unsigned w0 = 0u, w1 = 0u;
                w0 = __builtin_amdgcn_cvt_scalef32_pk_fp4_f32(w0, v[q][0].x * inv, v[q][0].y * inv, 1.0f, 0); w0 = __builtin_amdgcn_cvt_scalef32_pk_fp4_f32(w0, v[q][0].z * inv, v[q][0].w * inv, 1.0f, 1);
                w0 = __builtin_amdgcn_cvt_scalef32_pk_fp4_f32(w0, v[q][1].x * inv, v[q][1].y * inv, 1.0f, 2); w0 = __builtin_amdgcn_cvt_scalef32_pk_fp4_f32(w0, v[q][1].z * inv, v[q][1].w * inv, 1.0f, 3);
                w1 = __builtin_amdgcn_cvt_scalef32_pk_fp4_f32(w1, v[q][2].x * inv, v[q][2].y * inv, 1.0f, 0); w1 = __builtin_amdgcn_cvt_scalef32_pk_fp4_f32(w1, v[q][2].z * inv, v[q][2].w * inv, 1.0f, 1);
                w1 = __builtin_amdgcn_cvt_scalef32_pk_fp4_f32(w1, v[q][3].x * inv, v[q][3].y * inv, 1.0f, 2); w1 = __builtin_amdgcn_cvt_scalef32_pk_fp4_f32(w1, v[q][3].z * inv, v[q][3].w * inv, 1.0f, 3);
                u32x2 o; o.x = w0; o.y = w1;
                *(u32x2*)((isv ? V8 : U8) + (size_t)(ee0 + q) * 512 + 8 * lane) = o;
            }
        }
    }
    {
        bf16* KB = (bf16*)(ws + WS_KEYS);
        const int gt = blockIdx.x * NTHREADS + tid, NGT = gridDim.x * NTHREADS;
        for (int i = gt; i < 8 * 2 * 128 * 128 / 4; i += NGT) { const f32x4 v = ((const f32x4*)P.keys)[i]; u32x2 w; w.x = pk2(v.x, v.y); w.y = pk2(v.z, v.w); ((u32x2*)KB)[i] = w; }
    }
    {
        float* MP = (float*)(ws + WS_METAPART); float* MR = (float*)(ws + WS_METARSTD);
        for (int r = gw; r < NMETA; r += NGW) {
            float s = 0.f;
            for (int k = lane; k < DM; k += 64) { const float v = P.meta[r * DM + k]; s += v * v; }
            s = wave_sum(s);
            if (lane == 0) MR[r] = rsqrtf(s * (1.f / DM) + EPS);
        }
        for (int it = gw; it < MKC * 40; it += NGW) {
            const int kc = it / 40, nb = it % 40, n = nb * 64 + lane;
            float acc[NMETA];
#pragma unroll
            for (int r = 0; r < NMETA; ++r) acc[r] = 0.f;
            for (int k = kc * (DM / MKC); k < (kc + 1) * (DM / MKC); ++k) {
                const float w = P.w_in[(size_t)k * DIN + n] * P.g_mix[k];
#pragma unroll
                for (int r = 0; r < NMETA; ++r) acc[r] += P.meta[r * DM + k] * w;
            }
#pragma unroll
            for (int r = 0; r < NMETA; ++r) MP[(size_t)(kc * 16 + r) * DIN + n] = acc[r];
        }
    }
}

__device__ __forceinline__ float metaraw(const float* MP, const float* MR, int p, int col) { float s = 0.f;
#pragma unroll 8
    for (int kc = 0; kc < MKC; ++kc) s += MP[(size_t)(kc * 16 + p) * DIN + col];
    return s * MR[p]; }
__device__ __forceinline__ void phase_metaproj(const Params& P) {
    const float* MP = (const float*)(P.ws + WS_METAPART); const float* MR = (const float*)(P.ws + WS_METARSTD); float* MJ = (float*)(P.ws + WS_METAPROJ);
    for (int gt = blockIdx.x * NTHREADS + threadIdx.x; gt < NMETA * PDIM; gt += gridDim.x * NTHREADS) { const int p = gt / PDIM, c = gt % PDIM; float v;
        if (c < 512) v = metaraw(MP, MR, p, c) * metaraw(MP, MR, p, 1024 + c);
        else if (c < 1024) v = metaraw(MP, MR, p, c);
        else v = metaraw(MP, MR, p, 1536 + (c - 1024)) * sigmoid_f(metaraw(MP, MR, p, 2048 + (c - 1024)));
        MJ[gt] = v; }
}
__device__ __forceinline__ float meta_val(const float* MJ, const float*, int p, int col) { return MJ[p * PDIM + col]; }
__device__ __forceinline__ float proj_at(const bf16* PROJ, const float* MP, const float* MR, int b, int pos, int col) {
    if (pos < 0) return 0.f;
    if (pos < NMETA) return meta_val(MP, MR, pos, col);
    return bf2f(PROJ[(size_t)(b * SEQ + pos - NMETA) * PDIM + col]);
}
__device__ __forceinline__ void proj8_at(const bf16* PROJ, const float* MP, const float* MR, int b, int pos, int col, float (&v)[8]) {
    if (pos < 0) {
#pragma unroll
        for (int i = 0; i < 8; ++i) v[i] = 0.f;
    } else if (pos < NMETA) {
        const f32x4 a = *(const f32x4*)(MP + pos * PDIM + col), bq = *(const f32x4*)(MP + pos * PDIM + col + 4);
        v[0] = a.x; v[1] = a.y; v[2] = a.z; v[3] = a.w; v[4] = bq.x; v[5] = bq.y; v[6] = bq.z; v[7] = bq.w;
    } else {
        const u32x4 w = *(const u32x4*)(PROJ + (size_t)(b * SEQ + pos - NMETA) * PDIM + col);
        v[0] = bflo(w.x); v[1] = bfhi(w.x); v[2] = bflo(w.y); v[3] = bfhi(w.y); v[4] = bflo(w.z); v[5] = bfhi(w.z); v[6] = bflo(w.w); v[7] = bfhi(w.w);
    }
}

template <int R> __device__ __forceinline__ void conv_rows(const LAS unsigned char* ubase, const f32x2 (&wcf)[31], f32x2 (&acc)[32]) {
    if constexpr (R < 62) {
        const unsigned uw = *(const LAS unsigned*)(ubase + R * 1024);
        const f32x2 x = (f32x2){bflo(uw), bfhi(uw)};
        constexpr int lo = R > 30 ? R - 30 : 0, hi = R < 31 ? R : 31;
#pragma unroll
        for (int ii = lo; ii <= hi; ++ii) acc[ii] += wcf[R - ii] * x;
        conv_rows<R + 1>(ubase, wcf, acc);
    }
}
__device__ __forceinline__ void phase_conv(const Params& P, LAS unsigned char* lds) {
    const int tid = threadIdx.x, lane = tid & 63, wave = __builtin_amdgcn_readfirstlane(tid >> 6);
    unsigned char* ws = P.ws;
    const bf16* PROJ = (const bf16*)(ws + WS_PROJ); const float* MP = (const float*)(ws + WS_METAPROJ); const float* MR = nullptr;
    bf16* Y = (bf16*)(ws + WS_Y);
    constexpr int TT = 64, NTILE = NTOK / TT, UROWS = TT + 30;
    const int cgp = wave & 3, th = wave >> 2, ch2 = cgp * 128 + 2 * lane;
    f32x2 wcf[31];
#pragma unroll
    for (int j = 0; j < 31; ++j) wcf[j] = *(const f32x2*)(P.cf_w + j * 512 + ch2);
    const f32x2 bcf = *(const f32x2*)(P.cf_b + ch2);
    for (int tile = blockIdx.x; tile < NTILE; tile += gridDim.x) {
        const int b = tile / (SEQ / TT), s0 = (tile % (SEQ / TT)) * TT;
#pragma unroll 4
        for (int p = 0; p < (UROWS + 7) / 8; ++p) {
            const int r = p * 8 + wave;
            if (r < UROWS) {
                const int pos = NMETA + s0 - 30 + r;
                float uu[8];
                proj8_at(PROJ, MP, MR, b, pos, 1024 + 8 * lane, uu);
                u32x4 w; w.x = pk2(uu[0], uu[1]); w.y = pk2(uu[2], uu[3]); w.z = pk2(uu[4], uu[5]); w.w = pk2(uu[6], uu[7]);
                *(LAS u32x4*)(lds + r * 1024 + lane * 16) = w;
            }
        }
        __syncthreads();
        f32x2 acc[32];
#pragma unroll
        for (int ii = 0; ii < 32; ++ii) acc[ii] = bcf;
        conv_rows<0>(lds + (32 * th) * 1024 + ch2 * 2, wcf, acc);
        __syncthreads();
#pragma unroll
        for (int ii = 0; ii < 32; ++ii) *(LAS f32x2*)(lds + (32 * th + ii) * 2048 + ch2 * 4) = acc[ii];
        __syncthreads();
        {
            float lng[8], lnb[8];
            { const f32x4 a = *(const f32x4*)(P.ln_g + 8 * lane), c = *(const f32x4*)(P.ln_g + 8 * lane + 4), d = *(const f32x4*)(P.ln_b + 8 * lane), e = *(const f32x4*)(P.ln_b + 8 * lane + 4);
              lng[0] = a.x; lng[1] = a.y; lng[2] = a.z; lng[3] = a.w; lng[4] = c.x; lng[5] = c.y; lng[6] = c.z; lng[7] = c.w;
              lnb[0] = d.x; lnb[1] = d.y; lnb[2] = d.z; lnb[3] = d.w; lnb[4] = e.x; lnb[5] = e.y; lnb[6] = e.z; lnb[7] = e.w; }
            float wsc[3][8];
#pragma unroll
            for (int j = 0; j < 3; ++j) { const f32x4 a = *(const f32x4*)(P.sc_w + j * 512 + 8 * lane), c = *(const f32x4*)(P.sc_w + j * 512 + 8 * lane + 4);
                wsc[j][0] = a.x; wsc[j][1] = a.y; wsc[j][2] = a.z; wsc[j][3] = a.w; wsc[j][4] = c.x; wsc[j][5] = c.y; wsc[j][6] = c.z; wsc[j][7] = c.w; }
            float cxa[8], cxb[8];
            { const int pos = NMETA + s0 + 8 * wave - 2;
              proj8_at(PROJ, MP, MR, b, pos, 8 * lane, cxa); proj8_at(PROJ, MP, MR, b, pos + 1, 8 * lane, cxb); }
#pragma unroll 2
            for (int q = 0; q < 8; ++q) {
                const int ii = 8 * wave + q, s = s0 + ii; const size_t t = (size_t)b * SEQ + s;
                float o[8];
                { const f32x4 a = *(const LAS f32x4*)(lds + ii * 2048 + lane * 32), c = *(const LAS f32x4*)(lds + ii * 2048 + lane * 32 + 16);
                  o[0] = a.x; o[1] = a.y; o[2] = a.z; o[3] = a.w; o[4] = c.x; o[5] = c.y; o[6] = c.z; o[7] = c.w; }
                float s1 = 0.f;
#pragma unroll
                for (int i = 0; i < 8; ++i) s1 += o[i];
                const float mean = wave_sum_fast(s1) * (1.f / 512.f);
                float s2 = 0.f;
#pragma unroll
                for (int i = 0; i < 8; ++i) { o[i] -= mean; s2 += o[i] * o[i]; }
                const float rs = rsqrtf(wave_sum_fast(s2) * (1.f / 512.f) + EPS);
                float s3 = 0.f;
#pragma unroll
                for (int i = 0; i < 8; ++i) { float y = o[i] * rs * lng[i] + lnb[i]; y = y * sigmoid_f(y); o[i] = y; s3 += y * y; }
                const float r2 = rsqrtf(wave_sum_fast(s3) * (1.f / 512.f) + EPS);
                u32x4 wv; wv.x = pk2(o[0] * r2, o[1] * r2); wv.y = pk2(o[2] * r2, o[3] * r2); wv.z = pk2(o[4] * r2, o[5] * r2); wv.w = pk2(o[6] * r2, o[7] * r2);
                *(u32x4*)(Y + t * DM + 512 + 8 * lane) = wv;
                float bgv[8], cxc[8], accs[8];
                proj8_at(PROJ, MP, MR, b, NMETA + s, 8 * lane, cxc); proj8_at(PROJ, MP, MR, b, NMETA + s, 512 + 8 * lane, bgv);
                float s4 = 0.f;
#pragma unroll
                for (int i = 0; i < 8; ++i) { accs[i] = bgv[i] * (wsc[0][i] * cxa[i] + wsc[1][i] * cxb[i] + wsc[2][i] * cxc[i]); s4 += accs[i] * accs[i]; cxa[i] = cxb[i]; cxb[i] = cxc[i]; }
                const float r4 = rsqrtf(wave_sum_fast(s4) * (1.f / 512.f) + EPS);
                u32x4 wz; wz.x = pk2(accs[0] * r4, accs[1] * r4); wz.y = pk2(accs[2] * r4, accs[3] * r4); wz.z = pk2(accs[4] * r4, accs[5] * r4); wz.w = pk2(accs[6] * r4, accs[7] * r4);
                *(u32x4*)(Y + t * DM + 8 * lane) = wz;
            }
        }
        __syncthreads();
    }
}

__device__ __forceinline__ int ord_i(float s) { int k = __builtin_bit_cast(int, s); k ^= (k >> 31) & 0x7fffffff; return k; }
__device__ __forceinline__ float unord_f(int k) { k ^= (k >> 31) & 0x7fffffff; return __builtin_bit_cast(float, k); }
#define TOP_INSERT(L, x_) do { int _x = (x_); _Pragma("unroll") for (int _i = 0; _i < 16; ++_i) { const int _hi = max(L[_i], _x); _x = min(L[_i], _x); L[_i] = _hi; } } while (0)

typedef short bf16x8 __attribute__((ext_vector_type(8)));
typedef float f32x16 __attribute__((ext_vector_type(16)));
template <bool DESC> __device__ __forceinline__ void ce_i(int& a, int& b) { const int hi = max(a, b), lo = min(a, b); if (DESC) { a = hi; b = lo; } else { a = lo; b = hi; } }
__device__ __forceinline__ void bitonic_sort16(int (&a)[16]) {
#pragma unroll
    for (int k = 2; k <= 16; k <<= 1)
#pragma unroll
        for (int j = k >> 1; j > 0; j >>= 1)
#pragma unroll
            for (int i = 0; i < 16; ++i) { const int l = i ^ j; if (l > i) { if ((i & k) == 0) ce_i<true>(a[i], a[l]); else ce_i<false>(a[i], a[l]); } }
}
__device__ __forceinline__ void bitonic_merge16(int (&a)[16]) {
#pragma unroll
    for (int j = 8; j > 0; j >>= 1)
#pragma unroll
        for (int i = 0; i < 16; ++i) { const int l = i ^ j; if (l > i) ce_i<true>(a[i], a[l]); }
}
__device__ __forceinline__ void merge_top16(int (&a)[16], const int (&b)[16]) {
#pragma unroll
    for (int i = 0; i < 16; ++i) a[i] = max(a[i], b[15 - i]);
    bitonic_merge16(a);
}
__device__ __forceinline__ int lut16(const unsigned (&T)[4], int i) {
    const unsigned sel = (unsigned)(i & 7) | 0x0c0c0c00u;
    const unsigned lo = __builtin_amdgcn_perm(T[1], T[0], sel), hi = __builtin_amdgcn_perm(T[3], T[2], sel);
    return (int)((i & 8) ? hi : lo);
}
constexpr int KROW = 272;
constexpr float SCORE_BIAS = 8.0f;

__device__ __forceinline__ void route_load_q(bf16x8 (&qf)[8], const bf16* qrow, int hb) {
#pragma unroll
    for (int ks = 0; ks < 8; ++ks) qf[ks] = *(const bf16x8*)(qrow + 64 * hb + 8 * ks);
}
__device__ __forceinline__ void route_half(const LAS unsigned char* kl, const bf16x8 (&qf)[8], int nl, int hb, int (&L)[16]) {
    f32x16 acc[4];
#pragma unroll
    for (int nt = 0; nt < 4; ++nt)
#pragma unroll
        for (int r = 0; r < 16; ++r) acc[nt][r] = SCORE_BIAS;
#pragma unroll
    for (int ks = 0; ks < 8; ++ks)
#pragma unroll
        for (int nt = 0; nt < 4; ++nt) {
            const bf16x8 a = *(const LAS bf16x8*)(kl + (32 * nt + nl) * KROW + (64 * hb + 8 * ks) * 2);
            acc[nt] = __builtin_amdgcn_mfma_f32_32x32x16_bf16(a, qf[ks], acc[nt], 0, 0, 0);
        }
    const int hb4 = 4 * hb;
    int T[4][16];
#pragma unroll
    for (int nt = 0; nt < 4; ++nt)
#pragma unroll
        for (int r = 0; r < 16; ++r) { const int n0 = 32 * nt + (r & 3) + 8 * (r >> 2); const float sc = acc[nt][r];
            T[nt][r] = (__float_as_int(sc) & ~127) | ((127 - n0) - hb4); }
    bitonic_sort16(T[0]); bitonic_sort16(T[1]); bitonic_sort16(T[2]); bitonic_sort16(T[3]);
    merge_top16(T[0], T[1]); merge_top16(T[2], T[3]); merge_top16(T[0], T[2]);
#pragma unroll
    for (int i = 0; i < 16; ++i) { const unsigned v = (unsigned)T[0][15 - i]; auto r = __builtin_amdgcn_permlane32_swap(v, v, false, false);
        const unsigned r0 = r[0], r1 = r[1]; const int partner = (int)(hb ? r0 : r1); L[i] = max(T[0][i], partner); }
    bitonic_merge16(L);
}

__device__ __forceinline__ void phase_route(const Params& P, LAS unsigned char* lds) {
    const int tid = threadIdx.x, lane = tid & 63, wave = __builtin_amdgcn_readfirstlane(tid >> 6);
    const int nl = lane & 31, hb = lane >> 5;
    unsigned char* ws = P.ws;
    const bf16* KEYS = (const bf16*)(ws + WS_KEYS); const bf16* Q = (const bf16*)(ws + WS_Q);
    int* IDX = (int*)(ws + WS_IDX); float* GATE = (float*)(ws + WS_GATE);
    int last_h = -1;
    pg8::StaticOrder S; S.init(NTOK, 2048, (int)gridDim.x, (int)blockIdx.x);
    pg8::Unit ucur, unxt;
    bool have = S.next(0, ucur);
    bf16x8 qfA[8], qfB[8];
    if (have) route_load_q(qfA, Q + ((size_t)ucur.pm * 256 + wave * 32 + nl) * 2048 + ucur.pn * 256, hb);
    for (int ui = 0; have; ++ui) {
        const int h = ucur.pn, tb = ucur.pm;
        const bool have_next = S.next(ui + 1, unxt);
        if (h != last_h) {
            __syncthreads();
            for (int c = tid; c < 4096; c += NTHREADS) { const u32x4 v = ((const u32x4*)(KEYS + (size_t)h * 32768))[c];
                *(LAS u32x4*)(lds + (c >> 4) * KROW + (c & 15) * 16) = v; }
            __syncthreads();
            last_h = h;
        }
        const size_t t = (size_t)tb * 256 + wave * 32 + nl;
        int L1[16], L2[16];
        route_load_q(qfB, Q + t * 2048 + h * 256 + 128, hb);
        route_half(lds, qfA, nl, hb, L1);
        if (have_next) route_load_q(qfA, Q + ((size_t)unxt.pm * 256 + wave * 32 + nl) * 2048 + unxt.pn * 256, hb);
        route_half(lds + 128 * KROW, qfB, nl, hb, L2);
        float v1[16], v2[16];
#pragma unroll
        for (int i = 0; i < 16; ++i) { v1[i] = __int_as_float(L1[i] & ~127); v2[i] = __int_as_float(L2[i] & ~127); }
#define CAND(i, j) ((__float_as_int(v1[i] + v2[j]) & ~255) | (255 - (16 * (i) + (j))))
        int A[16], B[16], C[16];
#pragma unroll
        for (int j = 0; j < 16; ++j) A[j] = CAND(0, j);
#pragma unroll
        for (int j = 0; j < 8; ++j) { B[j] = CAND(1, j); B[8 + j] = CAND(15 - j, 0); }
        bitonic_merge16(B);
        C[0] = CAND(2, 0); C[1] = CAND(2, 1); C[2] = CAND(2, 2); C[3] = CAND(2, 3); C[4] = CAND(2, 4);
        C[5] = CAND(3, 0); C[6] = CAND(3, 1); C[7] = CAND(3, 2); C[8] = CAND(3, 3);
        C[9] = CAND(4, 0); C[10] = CAND(4, 1); C[11] = CAND(4, 2);
        C[12] = CAND(5, 0); C[13] = CAND(5, 1); C[14] = CAND(6, 0); C[15] = CAND(6, 1);
        bitonic_sort16(C);
        { const int d0 = CAND(7, 0), d1 = CAND(7, 1); C[14] = max(C[14], d1); C[15] = max(C[15], d0); bitonic_merge16(C); }
#undef CAND
        merge_top16(A, B); merge_top16(A, C);
        unsigned T1[4], T2[4];
#pragma unroll
        for (int q = 0; q < 4; ++q) {
            T1[q] = (unsigned)(127 - (L1[4 * q] & 127)) | ((unsigned)(127 - (L1[4 * q + 1] & 127)) << 8) | ((unsigned)(127 - (L1[4 * q + 2] & 127)) << 16) | ((unsigned)(127 - (L1[4 * q + 3] & 127)) << 24);
            T2[q] = (unsigned)(127 - (L2[4 * q] & 127)) | ((unsigned)(127 - (L2[4 * q + 1] & 127)) << 8) | ((unsigned)(127 - (L2[4 * q + 2] & 127)) << 16) | ((unsigned)(127 - (L2[4 * q + 3] & 127)) << 24); }
        float val[16]; int ex[16];
#pragma unroll
        for (int k = 0; k < 16; ++k) { const int pos = 255 - (A[k] & 255); val[k] = __int_as_float(A[k] & ~255);
            ex[k] = lut16(T1, pos >> 4) * NKEYS + lut16(T2, pos & 15); }
        float sum = 0.f; const float vmax = val[0];
#pragma unroll
        for (int k = 0; k < 16; ++k) { val[k] = __expf(val[k] - vmax); sum += val[k]; }
        const float inv = 1.f / sum;
        if (hb == 0) {
            int* ip = IDX + t * NSEL + h * TOPK; float* gp = GATE + t * NSEL + h * TOPK;
#pragma unroll
            for (int k4 = 0; k4 < 4; ++k4) {
                *(int4*)(ip + 4 * k4) = make_int4(ex[4 * k4], ex[4 * k4 + 1], ex[4 * k4 + 2], ex[4 * k4 + 3]);
                *(f32x4*)(gp + 4 * k4) = (f32x4){val[4 * k4] * inv, val[4 * k4 + 1] * inv, val[4 * k4 + 2] * inv, val[4 * k4 + 3] * inv};
            }
        }
        ucur = unxt; have = have_next;
    }
}

#define FP4X2(w, sel) __builtin_amdgcn_cvt_scalef32_pk_f32_fp4((w), 1.0f, (sel))
__device__ __forceinline__ float dot16_fp4(const u32x2 r, const f32x4 (&xs)[4]) {
    float p = 0.f;
    { const f32x2 a = FP4X2(r.x, 0), b = FP4X2(r.x, 1), c = FP4X2(r.x, 2), d = FP4X2(r.x, 3);
      p += (a.x * xs[0].x + a.y * xs[0].y) + (b.x * xs[0].z + b.y * xs[0].w); p += (c.x * xs[1].x + c.y * xs[1].y) + (d.x * xs[1].z + d.y * xs[1].w); }
    { const f32x2 a = FP4X2(r.y, 0), b = FP4X2(r.y, 1), c = FP4X2(r.y, 2), d = FP4X2(r.y, 3);
      p += (a.x * xs[2].x + a.y * xs[2].y) + (b.x * xs[2].z + b.y * xs[2].w); p += (c.x * xs[3].x + c.y * xs[3].y) + (d.x * xs[3].z + d.y * xs[3].w); }
    return p;
}
__device__ __forceinline__ void axpy16_fp4(const u32x2 r, float w, f32x4 (&o)[4]) {
    { const f32x2 a = FP4X2(r.x, 0), b = FP4X2(r.x, 1), c = FP4X2(r.x, 2), d = FP4X2(r.x, 3);
      o[0].x += w * a.x; o[0].y += w * a.y; o[0].z += w * b.x; o[0].w += w * b.y; o[1].x += w * c.x; o[1].y += w * c.y; o[1].z += w * d.x; o[1].w += w * d.y; }
    { const f32x2 a = FP4X2(r.y, 0), b = FP4X2(r.y, 1), c = FP4X2(r.y, 2), d = FP4X2(r.y, 3);
      o[2].x += w * a.x; o[2].y += w * a.y; o[2].z += w * b.x; o[2].w += w * b.y; o[3].x += w * c.x; o[3].y += w * c.y; o[3].z += w * d.x; o[3].w += w * d.y; }
}
__device__ __forceinline__ float swap32_add(float a, float b) { auto r = __builtin_amdgcn_permlane32_swap(__float_as_uint(a), __float_as_uint(b), false, false); return __uint_as_float(r[0]) + __uint_as_float(r[1]); }
__device__ __forceinline__ float swap16_add(float a, float b) { auto r = __builtin_amdgcn_permlane16_swap(__float_as_uint(a), __float_as_uint(b), false, false); return __uint_as_float(r[0]) + __uint_as_float(r[1]); }
__device__ __forceinline__ float row_sum16(float v) { v += dpp_f<0xB1>(v); v += dpp_f<0x4E>(v); v += dpp_f<0x141>(v); v += dpp_f<0x140>(v); return v; }
constexpr int GB = 32;
typedef __attribute__((address_space(8))) void* rsrc_t;
__device__ __forceinline__ void g_issue(u32x2 (&buf)[GB], __amdgpu_buffer_rsrc_t rs, int idxr, int lb, int voff) {
#pragma unroll
    for (int j = 0; j < GB; ++j) { const int e = __builtin_amdgcn_readlane(idxr, lb + j); buf[j] = __builtin_amdgcn_raw_buffer_load_b64(rs, voff, e * 512, 0); }
}
__device__ __forceinline__ float dot16_fp4p(const u32x2 r, const f32x2 (&xp)[8]) {
    f32x2 a = FP4X2(r.x, 0) * xp[0];
    a += FP4X2(r.x, 1) * xp[1]; a += FP4X2(r.x, 2) * xp[2]; a += FP4X2(r.x, 3) * xp[3];
    a += FP4X2(r.y, 0) * xp[4]; a += FP4X2(r.y, 1) * xp[5]; a += FP4X2(r.y, 2) * xp[6]; a += FP4X2(r.y, 3) * xp[7];
    return a.x + a.y;
}
__device__ __forceinline__ void axpy16_fp4p(const u32x2 r, float w, f32x2 (&o)[8]) {
    const f32x2 ww = (f32x2){w, w};
    o[0] += FP4X2(r.x, 0) * ww; o[1] += FP4X2(r.x, 1) * ww; o[2] += FP4X2(r.x, 2) * ww; o[3] += FP4X2(r.x, 3) * ww;
    o[4] += FP4X2(r.y, 0) * ww; o[5] += FP4X2(r.y, 1) * ww; o[6] += FP4X2(r.y, 2) * ww; o[7] += FP4X2(r.y, 3) * ww;
}
template <int H> __device__ __forceinline__ void g_compute_u(const u32x2 (&buf)[GB], int q, int i16, const f32x2 (&xp)[8], float& zlo, float& zhi) {
    float p[16];
#pragma unroll
    for (int j = 0; j < 16; ++j) p[j] = dot16_fp4p(buf[16 * H + j], xp);
    float s1[8], s2[4];
#pragma unroll
    for (int m = 0; m < 8; ++m) s1[m] = swap32_add(p[2 * m], p[2 * m + 1]);
#pragma unroll
    for (int n = 0; n < 4; ++n) s2[n] = swap16_add(s1[2 * n], s1[2 * n + 1]);
#pragma unroll
    for (int r = 0; r < 4; ++r) { const float z = row_sum16(s2[r]); const bool mine = i16 == ((4 * q + r) & 15);
        zlo = (mine && q < 4) ? z : zlo; zhi = (mine && q >= 4) ? z : zhi; }
}
template <int H> __device__ __forceinline__ void g_compute_v(const u32x2 (&buf)[GB], int q, float alo, float ahi, f32x2 (&o)[8]) {
    const int areg = __builtin_bit_cast(int, (q < 4) ? alo : ahi), sb = 4 * (q & 3);
#pragma unroll
    for (int j = 0; j < 16; ++j) { const int src = 32 * (j & 1) + 16 * ((j >> 1) & 1) + (j >> 2) + sb;
        const float w = __builtin_bit_cast(float, __builtin_amdgcn_readlane(areg, src));
        axpy16_fp4p(buf[16 * H + j], w, o); }
}
__device__ __forceinline__ void q_issue(u32x2 (&buf)[16], __amdgpu_buffer_rsrc_t rs, int ixr  , int lb, int voff) {
#pragma unroll
    for (int j = 0; j < 16; ++j) { const int e9 = __builtin_amdgcn_readlane(ixr, lb + j); buf[j] = __builtin_amdgcn_raw_buffer_load_b64(rs, voff, e9, 0); }
}
__device__ __forceinline__ void q_compute_u(const u32x2 (&buf)[16], int q, int i16, const f32x2 (&xp)[8], float& zlo, float& zhi) {
    float p[16];
#pragma unroll
    for (int j = 0; j < 16; ++j) p[j] = dot16_fp4p(buf[j], xp);
    float s1[8], s2[4];
#pragma unroll
    for (int m = 0; m < 8; ++m) s1[m] = swap32_add(p[2 * m], p[2 * m + 1]);
#pragma unroll
    for (int n = 0; n < 4; ++n) s2[n] = swap16_add(s1[2 * n], s1[2 * n + 1]);
#pragma unroll
    for (int r = 0; r < 4; ++r) { const float z = row_sum16(s2[r]); const bool mine = i16 == ((4 * q + r) & 15);
        zlo = (mine && q < 4) ? z : zlo; zhi = (mine && q >= 4) ? z : zhi; }
}
__device__ __forceinline__ void q_compute_v(const u32x2 (&buf)[16], int q, float alo, float ahi, f32x2 (&o)[8]) {
    const int areg = __builtin_bit_cast(int, (q < 4) ? alo : ahi), sb = 4 * (q & 3);
#pragma unroll
    for (int j = 0; j < 16; ++j) { const int src = 32 * (j & 1) + 16 * ((j >> 1) & 1) + (j >> 2) + sb;
        const float w = __builtin_bit_cast(float, __builtin_amdgcn_readlane(areg, src));
        axpy16_fp4p(buf[j], w, o); }
}
__device__ __forceinline__ void phase_gather_u(const Params& P) {
    const int tid = threadIdx.x, lane = tid & 63, wave = __builtin_amdgcn_readfirstlane(tid >> 6);
    const int gw = blockIdx.x * NWAVES + wave, NGW = gridDim.x * NWAVES;
    unsigned char* ws = P.ws;
    const int* IDX = (const int*)(ws + WS_IDX); const float* GATE = (const float*)(ws + WS_GATE); const float* ESC = (const float*)(ws + WS_ESCALE); float* AW = (float*)(ws + WS_AW);
    const __amdgpu_buffer_rsrc_t rsU = __builtin_amdgcn_make_buffer_rsrc((void*)(ws + WS_U8), 0, 16384 * 512, 0x00020000);
    const bf16* H2B = (const bf16*)(ws + WS_H2B); const float* SSQ = (const float*)(ws + WS_SSQ);
    const int hh = lane >> 5, rr = (lane >> 4) & 1, i16 = lane & 15, gsel = 4 * i16 + 2 * rr + hh;
    const int voff = 8 * lane;
    const unsigned ul = (unsigned)lane;
    int t = gw;
    if (t < NTOK) {
        int idx0, idx1; u32x2 hraw[4]; float sqv;
        { const int* ip = IDX + (size_t)t * NSEL; idx0 = ip[ul]; idx1 = ip[64u + ul];
          const u32x2* hp = (const u32x2*)(H2B + (size_t)t * DM);
#pragma unroll
          for (int j = 0; j < 4; ++j) hraw[j] = hp[64u * j + ul];
          sqv = (SSQ + (size_t)t * 16)[ul & 15u]; }
        u32x2 R0[16], R1[16], R2[16], R3[16];
        { const int ix0 = idx0 << 9; q_issue(R0, rsU, ix0, 0, voff); q_issue(R1, rsU, ix0, 16, voff); q_issue(R2, rsU, ix0, 32, voff); }
        for (;;) {
            const int tn = t + NGW; const bool has_next = tn < NTOK; const int tl = has_next ? tn : t;
            int idx0n, idx1n; u32x2 hrawn[4]; float sqn, g0, g1;
            { const int* ip = IDX + (size_t)tl * NSEL; idx0n = ip[ul]; idx1n = ip[64u + ul];
              const u32x2* hp = (const u32x2*)(H2B + (size_t)tl * DM);
#pragma unroll
              for (int j = 0; j < 4; ++j) hrawn[j] = hp[64u * j + ul];
              sqn = (SSQ + (size_t)tl * 16)[ul & 15u];
              const float* gp = GATE + (size_t)t * NSEL; g0 = gp[ul]; g1 = gp[64u + ul]; }
            const float su0 = ESC[idx0], su1 = ESC[idx1], sv0 = ESC[16384 + idx0], sv1 = ESC[16384 + idx1];
            const float rstd2 = rsqrtf(row_sum16(sqv) * (1.f / DM) + EPS);
            f32x2 xp[8];
#pragma unroll
            for (int j = 0; j < 4; ++j) { xp[2 * j] = (f32x2){bflo(hraw[j].x), bfhi(hraw[j].x)}; xp[2 * j + 1] = (f32x2){bflo(hraw[j].y), bfhi(hraw[j].y)}; }
            float zlo = 0.f, zhi = 0.f;
            const int ix0 = idx0 << 9, ix1 = idx1 << 9;
#pragma unroll 1
            for (int qq = 0; qq < 8; qq += 4) {
                const int ixn = qq ? (idx0n << 9) : ix1;
                q_issue(R3, rsU, qq ? ix1 : ix0, 48, voff);
                q_compute_u(R0, qq, i16, xp, zlo, zhi);
                q_issue(R0, rsU, ixn, 0, voff);
                q_compute_u(R1, qq + 1, i16, xp, zlo, zhi);
                q_issue(R1, rsU, ixn, 16, voff);
                q_compute_u(R2, qq + 2, i16, xp, zlo, zhi);
                q_issue(R2, rsU, ixn, 32, voff);
                q_compute_u(R3, qq + 3, i16, xp, zlo, zhi);
            }
            const float glo = __shfl(g0, gsel), ghi = __shfl(g1, gsel), sulo = __shfl(su0, gsel), suhi = __shfl(su1, gsel), svlo = __shfl(sv0, gsel), svhi = __shfl(sv1, gsel);
            float* ap = AW + (size_t)t * NSEL;
            ap[ul] = gelu_tanh_f(zlo * rstd2 * sulo) * glo * svlo; ap[64u + ul] = gelu_tanh_f(zhi * rstd2 * suhi) * ghi * svhi;
            if (!has_next) break;
            t = tn; idx0 = idx0n; idx1 = idx1n; sqv = sqn;
#pragma unroll
            for (int j = 0; j < 4; ++j) hraw[j] = hrawn[j];
        }
    }
}
__device__ __forceinline__ void phase_gather_v(const Params& P) {
    const int tid = threadIdx.x, lane = tid & 63, wave = __builtin_amdgcn_readfirstlane(tid >> 6);
    const int gw = blockIdx.x * NWAVES + wave, NGW = gridDim.x * NWAVES;
    unsigned char* ws = P.ws;
    const int* IDX = (const int*)(ws + WS_IDX); const float* AW = (const float*)(ws + WS_AW);
    const __amdgpu_buffer_rsrc_t rsV = __builtin_amdgcn_make_buffer_rsrc((void*)(ws + WS_V8), 0, 16384 * 512, 0x00020000);
    const bf16* H2B = (const bf16*)(ws + WS_H2B);
    const int voff = 8 * lane;
    const unsigned ul = (unsigned)lane;
    int t = gw;
    if (t < NTOK) {
        int idx0, idx1; u32x2 hraw[4]; float alo, ahi;
        { const int* ip = IDX + (size_t)t * NSEL; idx0 = ip[ul]; idx1 = ip[64u + ul];
          const u32x2* hp = (const u32x2*)(H2B + (size_t)t * DM);
#pragma unroll
          for (int j = 0; j < 4; ++j) hraw[j] = hp[64u * j + ul];
          const float* ap = AW + (size_t)t * NSEL; alo = ap[ul]; ahi = ap[64u + ul]; }
        u32x2 R0[16], R1[16], R2[16], R3[16];
        { const int ix0 = idx0 << 9; q_issue(R0, rsV, ix0, 0, voff); q_issue(R1, rsV, ix0, 16, voff); q_issue(R2, rsV, ix0, 32, voff); }
        for (;;) {
            const int tn = t + NGW; const bool has_next = tn < NTOK; const int tl = has_next ? tn : t;
            int idx0n, idx1n; u32x2 hrawn[4]; float alon, ahin;
            { const int* ip = IDX + (size_t)tl * NSEL; idx0n = ip[ul]; idx1n = ip[64u + ul];
              const u32x2* hp = (const u32x2*)(H2B + (size_t)tl * DM);
#pragma unroll
              for (int j = 0; j < 4; ++j) hrawn[j] = hp[64u * j + ul];
              const float* ap = AW + (size_t)tl * NSEL; alon = ap[ul]; ahin = ap[64u + ul]; }
            f32x2 o[8];
#pragma unroll
            for (int j = 0; j < 8; ++j) o[j] = (f32x2){0.f, 0.f};
            const int ix0 = idx0 << 9, ix1 = idx1 << 9;
#pragma unroll 1
            for (int qq = 0; qq < 8; qq += 4) {
                const int ixn = qq ? (idx0n << 9) : ix1;
                q_issue(R3, rsV, qq ? ix1 : ix0, 48, voff);
                q_compute_v(R0, qq, alo, ahi, o);
                q_issue(R0, rsV, ixn, 0, voff);
                q_compute_v(R1, qq + 1, alo, ahi, o);
                q_issue(R1, rsV, ixn, 16, voff);
                q_compute_v(R2, qq + 2, alo, ahi, o);
                q_issue(R2, rsV, ixn, 32, voff);
                q_compute_v(R3, qq + 3, alo, ahi, o);
            }
            float ss = 0.f;
#pragma unroll
            for (int j = 0; j < 4; ++j) { o[2 * j] += (f32x2){bflo(hraw[j].x), bfhi(hraw[j].x)}; o[2 * j + 1] += (f32x2){bflo(hraw[j].y), bfhi(hraw[j].y)}; }
#pragma unroll
            for (int j = 0; j < 8; ++j) ss += o[j].x * o[j].x + o[j].y * o[j].y;
            ss = wave_sum_fast(ss);
            const float r3 = rsqrtf(ss * (1.f / DM) + EPS);
            f32x4* op = (f32x4*)(P.out + (size_t)t * DM);
            const f32x4* gfp = (const f32x4*)P.g_fin;
#pragma unroll
            for (int j = 0; j < 4; ++j) { const f32x4 gv = gfp[64u * j + ul]; op[64u * j + ul] = (f32x4){o[2 * j].x * r3 * gv.x, o[2 * j].y * r3 * gv.y, o[2 * j + 1].x * r3 * gv.z, o[2 * j + 1].y * r3 * gv.w}; }
            if (!has_next) break;
            t = tn; idx0 = idx0n; idx1 = idx1n; alo = alon; ahi = ahin;
#pragma unroll
            for (int j = 0; j < 4; ++j) hraw[j] = hrawn[j];
        }
    }
}

#define XB_TMO      128
#define XB_XCNT(j)  (256  + 64 * (j))
#define XB_XSUB(j)  (1280 + 64 * (j))
#define XB_XGEN(j)  (2304 + 64 * (j))
#define XB_TOP      3328
#define XB_TOPGEN   3392
#define XCD_BAR_WORDS 3456
#define XB_SPIN_CAP (1u << 18)

__device__ __forceinline__ unsigned xb_ld(unsigned* p)              { return __hip_atomic_load(p, __ATOMIC_RELAXED, __HIP_MEMORY_SCOPE_AGENT); }
__device__ __forceinline__ unsigned xb_add(unsigned* p, unsigned v) { return __hip_atomic_fetch_add(p, v, __ATOMIC_RELAXED, __HIP_MEMORY_SCOPE_AGENT); }
__device__ __forceinline__ unsigned xb_xcc_id() { return (unsigned)__builtin_amdgcn_s_getreg((3 << 11) | 20) & 0xFu; }
#define XB_SPIN(cond, bar) do { unsigned _sp = 0; while (cond) { __builtin_amdgcn_s_sleep(1); \
    if ((++_sp & 255u) == 0u) { if (xb_ld(&(bar)[XB_TMO])) break; if (_sp > XB_SPIN_CAP) { atomicAdd(&(bar)[XB_TMO], 1u); break; } } } } while (0)

struct XcdBarrier {
    unsigned* bar; unsigned x;
    volatile LAS unsigned* st;
};

__device__ __forceinline__ XcdBarrier xcd_barrier_post(unsigned* bar, volatile LAS unsigned* st) {
    XcdBarrier b; b.bar = bar; b.x = xb_xcc_id(); b.st = st;
    if (threadIdx.x == 0) (void)xb_add(&bar[XB_XCNT(b.x)], 1u);
    return b;
}
__device__ __forceinline__ void xcd_barrier_complete(unsigned* bar, unsigned x, unsigned& nloc, unsigned& nx) {
    const unsigned G = gridDim.x * gridDim.y * gridDim.z;
    unsigned sum, cnt, mine, sp = 0u;
    for (;;) {
        sum = 0u; cnt = 0u; mine = 0u;
#pragma unroll
        for (unsigned j = 0; j < 16; ++j) { const unsigned c = xb_ld(&bar[XB_XCNT(j)]); sum += c; cnt += (c > 0u) ? 1u : 0u; mine = (j == x) ? c : mine; }
        if (sum == G) break;
        __builtin_amdgcn_s_sleep(1);
        if ((++sp & 255u) == 0u) { if (xb_ld(&bar[XB_TMO])) break; if (sp > XB_SPIN_CAP) { atomicAdd(&bar[XB_TMO], 1u); break; } }
    }
    nloc = mine > 0u ? mine : 1u; nx = cnt > 0u ? cnt : 1u;
}

__device__ __forceinline__ void xcd_barrier(const XcdBarrier& b) {
    asm volatile("s_waitcnt vmcnt(0)" ::: "memory");
    __syncthreads();
    if (threadIdx.x == 0) {
        unsigned* bar = b.bar;
        __builtin_amdgcn_s_waitcnt(0);
        unsigned nloc = b.st[0], nx = b.st[1];
        if (nloc == 0u) { xcd_barrier_complete(bar, b.x, nloc, nx); b.st[0] = nloc; b.st[1] = nx; }
        const unsigned old = xb_add(&bar[XB_XSUB(b.x)], 1u);
        const unsigned gen = old / nloc;
        if (old + 1u == (gen + 1u) * nloc) {
            __builtin_amdgcn_fence(__ATOMIC_RELEASE, "agent");
            asm volatile("s_waitcnt vmcnt(0)" ::: "memory");
            const unsigned og = xb_add(&bar[XB_TOP], 1u);
            const unsigned tg = og / nx;
            if (og + 1u == (tg + 1u) * nx) xb_add(&bar[XB_TOPGEN], 1u);
            else XB_SPIN(xb_ld(&bar[XB_TOPGEN]) == tg, bar);
            __builtin_amdgcn_fence(__ATOMIC_ACQUIRE, "agent");
            xb_add(&bar[XB_XGEN(b.x)], 1u);
            asm volatile("s_waitcnt vmcnt(0)" ::: "memory");
        } else {
            XB_SPIN(xb_ld(&bar[XB_XGEN(b.x)]) == gen, bar);
            __builtin_amdgcn_fence(__ATOMIC_ACQUIRE, "agent");
            asm volatile("s_waitcnt vmcnt(0)" ::: "memory");
        }
    }
    __syncthreads();
}


#ifndef MK_MULTI
#define MK_MULTI 0
#endif
constexpr int NPHASE = 8;
#ifndef REP5
#define REP5 1
#endif
#ifndef REP6
#define REP6 1
#endif
__global__ void __launch_bounds__(NTHREADS, 2) mk_fwd(Params P) {
    extern __shared__ __attribute__((aligned(16))) unsigned char lds_raw[];
    LAS unsigned char* lds = (LAS unsigned char*)lds_raw;
    cg::grid_group grid = cg::this_grid();
    unsigned char* ws = P.ws;
    const int lo = P.ph_lo, hi = P.ph_hi;
    volatile LAS unsigned* bst = (volatile LAS unsigned*)(lds + 131072 + 64);
    if (threadIdx.x < 2) bst[threadIdx.x] = 0u;
    __syncthreads();
    XcdBarrier xbar = xcd_barrier_post((unsigned*)(ws + WS_CTL), bst);
#define IN(k) (lo <= (k) && (k) < hi)
#define SEAM(k) do { if (IN(k) && IN((k) + 1)) { xcd_barrier(xbar); } } while (0)
#ifndef SKIP0
    if (IN(0)) phase_prep(P, lds);
#endif
    SEAM(0);
#ifndef SKIP1
    if (IN(1)) {
        phase_metaproj(P);
        pg8::Gemm g{(const bf16*)(ws + WS_H0B), (const bf16*)(ws + WS_WIN_T), NTOK, DIN, DM}; pg8::StaticOrder S; S.init(NTOK, DIN, (int)gridDim.x, (int)blockIdx.x);
        EpiProj E{(bf16*)(ws + WS_PROJ), (const float*)(ws + WS_RSTD1)};
        pg8::gemm_phase<EpiProj, pg8::StaticOrder, true, true>(lds, g, S, E);
    }
#endif
    SEAM(1);
#ifndef SKIP2
    if (IN(2)) phase_conv(P, lds);
#endif
    SEAM(2);
#ifndef SKIP3
    if (IN(3)) {
        pg8::Gemm g{(const bf16*)(ws + WS_Y), (const bf16*)(ws + WS_WOUT_T), NTOK, DM, DM}; pg8::StaticOrder S; S.init(NTOK, DM, (int)gridDim.x, (int)blockIdx.x);
        EpiResidual E{(bf16*)(ws + WS_H2B), (const bf16*)(ws + WS_H0B), (float*)(ws + WS_SSQ)};
        pg8::gemm_phase<EpiResidual, pg8::StaticOrder, true, true>(lds, g, S, E);
    }
#endif
    SEAM(3);
#ifndef SKIP4
    if (IN(4)) {
        pg8::Gemm g{(const bf16*)(ws + WS_H2B), (const bf16*)(ws + WS_WQ_T), NTOK, 2048, DM}; pg8::StaticOrder S; S.init(NTOK, 2048, (int)gridDim.x, (int)blockIdx.x);
        EpiRowScale<1> E{(bf16*)(ws + WS_Q), 2048, (const float*)(ws + WS_SSQ)};
        pg8::gemm_phase<EpiRowScale<1>, pg8::StaticOrder, true, true>(lds, g, S, E);
    }
#endif
    if (IN(4) && IN(5)) { asm volatile("s_waitcnt vmcnt(0)" ::: "memory"); __syncthreads(); }
#ifndef SKIP5
    if (IN(5)) for (int rep = 0; rep < REP5; ++rep) phase_route(P, lds);
#endif
    SEAM(5);
    if (IN(6)) phase_gather_u(P);
    SEAM(6);
    if (IN(7)) phase_gather_v(P);
#undef IN
#undef SEAM
}

extern "C" void kernel_launch(void* const* d_in, const int* in_sizes, int n_in, void* d_out, int out_size, void* d_ws, size_t ws_size, hipStream_t stream) {
    static int grid = 0;
    if (grid == 0) {
        if (n_in != 18 || in_sizes[0] != NTOK * DM || out_size != NTOK * DM || ws_size < WS_END) {
            fprintf(stderr, "kernel_launch: unexpected shapes (n_in %d in0 %d out %d ws %zu)\n", n_in, n_in > 0 ? in_sizes[0] : -1, out_size, ws_size); grid = -1; return; }
        int dev = 0, cus = 0, per_cu = 0;
        (void)hipGetDevice(&dev); (void)hipDeviceGetAttribute(&cus, hipDeviceAttributeMultiprocessorCount, dev);
        if (hipFuncSetAttribute((const void*)mk_fwd, hipFuncAttributeMaxDynamicSharedMemorySize, LDS_BYTES) != hipSuccess) { fprintf(stderr, "kernel_launch: hipFuncSetAttribute failed\n"); grid = -1; return; }
        if (hipOccupancyMaxActiveBlocksPerMultiprocessor(&per_cu, (const void*)mk_fwd, NTHREADS, LDS_BYTES) != hipSuccess || per_cu < 1) { fprintf(stderr, "kernel_launch: occupancy query failed (%d)\n", per_cu); (void)hipGetLastError(); per_cu = 1; }
        if (per_cu > 1) per_cu = 1;
        grid = cus * per_cu;
        if (grid <= 0) grid = 256;
    }
    if (grid < 0) return;
    Params p{};
    p.x = (const float*)d_in[0]; p.meta = (const float*)d_in[1]; p.g_mix = (const float*)d_in[2]; p.w_in = (const float*)d_in[3]; p.sc_w = (const float*)d_in[4];
    p.cf_w = (const float*)d_in[5]; p.cf_b = (const float*)d_in[6]; p.ln_g = (const float*)d_in[7]; p.ln_b = (const float*)d_in[8]; p.g_sc = (const float*)d_in[9];
    p.g_cf = (const float*)d_in[10]; p.w_out = (const float*)d_in[11]; p.g_ffn = (const float*)d_in[12]; p.w_q = (const float*)d_in[13]; p.keys = (const float*)d_in[14];
    p.pu = (const float*)d_in[15]; p.pv = (const float*)d_in[16]; p.g_fin = (const float*)d_in[17];
    p.out = (float*)d_out; p.ws = (unsigned char*)d_ws;
    (void)hipMemsetAsync((char*)d_ws + WS_CTL, 0, 16384, stream);
#if MK_MULTI
    for (int ph = 0; ph < NPHASE; ++ph) { p.ph_lo = ph; p.ph_hi = ph + 1; p.coop = 0; p.pad = 0;
        hipLaunchKernelGGL(mk_fwd, dim3(grid), dim3(NTHREADS), LDS_BYTES, stream, p); }
#else
    p.ph_lo = 0; p.ph_hi = NPHASE; p.coop = 1; p.pad = 0;
    void* args[] = {&p};
    hipError_t e = hipLaunchCooperativeKernel((const void*)mk_fwd, dim3(grid), dim3(NTHREADS), args, LDS_BYTES, stream);
    if (e != hipSuccess) fprintf(stderr, "cooperative launch failed: %s (grid %d)\n", hipGetErrorString(e), grid);
#endif
}
```

```cpp
#include <hip/hip_runtime.h>
#include <hip/hip_cooperative_groups.h>
#include <cstdio>
#include <cstdint>
namespace cg = cooperative_groups;

namespace pg8 {
#define PG8_LAS __attribute__((address_space(3)))
typedef unsigned short bf16_t;
typedef short bf16x8 __attribute__((ext_vector_type(8)));
typedef float f32x4 __attribute__((ext_vector_type(4)));
typedef unsigned u32x4 __attribute__((ext_vector_type(4)));
constexpr int BM = 256, BK = 64, HALF = 128, HTB = HALF * BK * 2  , STAGE_BYTES = 8 * HTB, NXCD = 8, WGM = 8;

__host__ __device__ __forceinline__ int lds_byte(int r, int c) { const int st = (r >> 4) * 2 + (c >> 5), rr = r & 15, cc = c & 31, ob = rr * 64 + cc * 2; return st * 1024 + (ob ^ (((ob >> 9) & 1) << 5)); }
__host__ __device__ __forceinline__ void stage_rc(int b, int& R, int& C) { const int st = b / 1024, sb = b % 1024, swz = sb ^ (((sb >> 9) & 1) << 5); R = (st >> 1) * 16 + swz / 64; C = (st & 1) * 32 + (swz % 64) / 2; }
__host__ __device__ __forceinline__ int perm32(int rho) { const int n = rho >> 4, i = rho & 15; return 8 * (i >> 2) + 4 * n + (i & 3); }

struct Unit { int pm, pn; };
struct Gemm { const bf16_t* A; const bf16_t* Bt; int M, N, K; };

struct StaticOrder {
    int nM, nN, nwg, G, c;
    __host__ __device__ void init(int M, int N, int G_, int c_) { nM = M / BM; nN = N / BM; nwg = nM * nN; G = G_; c = c_; }
    __host__ __device__ bool next(int i, Unit& u) const {
        const long L = (long)i * G + c; if (L >= nwg) return false;
        int wgid = (int)L; { const int q = nwg / NXCD, r = nwg % NXCD, xcd = wgid % NXCD, off = wgid / NXCD; wgid = (xcd < r ? xcd * (q + 1) : r * (q + 1) + (xcd - r) * q) + off; }
        const int nig = WGM * nN, gid = wgid / nig, fm = gid * WGM, gsz = (nM - fm) < WGM ? (nM - fm) : WGM;
        u.pm = fm + ((wgid % nig) % gsz); u.pn = (wgid % nig) / gsz; return true;
    }
    __device__ __forceinline__ void a_ready(const Unit&) const {}
    __device__ __forceinline__ void done(const Unit&) const {}
};

template <class Epi, class Sched, bool ALIGN_EPI = false, bool SP2 = false>
__device__ __forceinline__ void gemm_phase(PG8_LAS unsigned char* lds, const Gemm g, const Sched& S, const Epi& E) {
    const int tid = threadIdx.x, wid = __builtin_amdgcn_readfirstlane(tid >> 6), lane = tid & 63, wr = wid >> 2, wc = wid & 3, fr = lane & 15, fq = lane >> 4;
    const int K = g.K, nt = K / BK;
    unsigned voffA[2], voffB[2];
#pragma unroll
    for (int i = 0; i < 2; ++i) { int R, C; stage_rc(tid * 16 + i * 8192, R, C); const int Rb = Epi::PERM ? ((R & ~31) + perm32(R & 31)) : R;
        voffA[i] = (unsigned)(R * K + C) * 2u; voffB[i] = (unsigned)(Rb * K + C) * 2u; }
    const size_t kstep = (size_t)(BK * 2);
    const size_t hstep = (size_t)HALF * K * 2;
    const size_t tstep = 2 * hstep;
    const unsigned ldsw = (unsigned)wid * 1024u;
    const int aoff = lds_byte(wr * 64 + fr, fq * 8), boff = lds_byte(wc * 32 + fr, fq * 8);
#define PG8_SA(b, h) (((b) * 2 + (h)) * HTB)
#define PG8_SB(b, h) ((4 + (b) * 2 + (h)) * HTB)
#define PG8_STAGE(bufoff, gbase, voff) do { _Pragma("unroll") for (int _i = 0; _i < 2; ++_i) \
        __builtin_amdgcn_global_load_lds((const unsigned*)((const char*)(gbase) + (voff)[_i]), (PG8_LAS unsigned*)(lds + (bufoff) + ldsw + _i * 8192), 16, 0, 0); } while (0)
#define PG8_LDA(dst, b, h) do { _Pragma("unroll") for (int m = 0; m < 4; ++m) _Pragma("unroll") for (int k = 0; k < 2; ++k) dst[m][k] = *(const PG8_LAS bf16x8*)(lds + PG8_SA(b, h) + aoff + m * 2048 + k * 1024); } while (0)
#define PG8_LDB(dst, b, h) do { _Pragma("unroll") for (int n = 0; n < 2; ++n) _Pragma("unroll") for (int k = 0; k < 2; ++k) dst[n][k] = *(const PG8_LAS bf16x8*)(lds + PG8_SB(b, h) + boff + n * 2048 + k * 1024); } while (0)
#define PG8_MMA(ai, bj, At, Bt) do { __builtin_amdgcn_s_setprio(1); _Pragma("unroll") for (int m = 0; m < 4; ++m) _Pragma("unroll") for (int n = 0; n < 2; ++n) _Pragma("unroll") for (int k = 0; k < 2; ++k) \
        acc[ai][bj][m][n] = __builtin_amdgcn_mfma_f32_16x16x32_bf16(Bt[n][k], At[m][k], acc[ai][bj][m][n], 0, 0, 0); __builtin_amdgcn_s_setprio(0); } while (0)
#define PG8_WAIT_V(n) asm volatile("s_waitcnt vmcnt(" #n ")" ::: "memory")
#define PG8_WAIT_L(n) asm volatile("s_waitcnt lgkmcnt(" #n ")" ::: "memory")
#define PG8_BAR __builtin_amdgcn_s_barrier()
#define PG8_SCHED __builtin_amdgcn_sched_barrier(0)
    Unit cur, nxt; int ui = 0;
    if (!S.next(0, cur)) return;
    f32x4 acc[2][2][4][2];
#pragma unroll
    for (int a = 0; a < 2; ++a)
#pragma unroll
        for (int b = 0; b < 2; ++b)
#pragma unroll
            for (int m = 0; m < 4; ++m)
#pragma unroll
                for (int n = 0; n < 2; ++n) acc[a][b][m][n] = (f32x4){0.f, 0.f, 0.f, 0.f};
    bf16x8 At[4][2], B0[2][2], B1[2][2];
    const char* cA = (const char*)g.A + (size_t)cur.pm * tstep; const char* cB = (const char*)g.Bt + (size_t)cur.pn * tstep;
    S.a_ready(cur);
    if constexpr (SP2) {
        PG8_STAGE(PG8_SB(0, 0), cB, voffB); PG8_STAGE(PG8_SB(0, 1), cB + hstep, voffB); PG8_STAGE(PG8_SA(0, 0), cA, voffA); PG8_STAGE(PG8_SA(0, 1), cA + hstep, voffA);
        if (wr == 1) PG8_BAR;
        PG8_WAIT_V(2); PG8_BAR;
        PG8_STAGE(PG8_SB(1, 0), cB + kstep, voffB); PG8_STAGE(PG8_SA(1, 0), cA + kstep, voffA); PG8_STAGE(PG8_SB(1, 1), cB + hstep + kstep, voffB);
        PG8_WAIT_V(6); PG8_BAR;
    } else {
        PG8_STAGE(PG8_SB(0, 0), cB, voffB); PG8_STAGE(PG8_SA(0, 0), cA, voffA); PG8_STAGE(PG8_SB(0, 1), cB + hstep, voffB); PG8_STAGE(PG8_SA(0, 1), cA + hstep, voffA);
        if (wr == 1) PG8_BAR;
        PG8_WAIT_V(4); PG8_BAR;
        PG8_STAGE(PG8_SB(1, 0), cB + kstep, voffB); PG8_STAGE(PG8_SA(1, 0), cA + kstep, voffA); PG8_STAGE(PG8_SB(1, 1), cB + hstep + kstep, voffB);
        PG8_WAIT_V(6); PG8_BAR;
    }
    for (;;) {
        const bool has_next = S.next(ui + 1, nxt);
        const char* nA = has_next ? (const char*)g.A + (size_t)nxt.pm * tstep : cA; const char* nB = has_next ? (const char*)g.Bt + (size_t)nxt.pn * tstep : cB;
        for (int t = 0; t < nt; t += 2) {
            const bool last = (t == nt - 2);
            const char* a1 = cA + (size_t)(t + 1) * kstep;
            const char* a2 = last ? nA : cA + (size_t)(t + 2) * kstep; const char* b2 = last ? nB : cB + (size_t)(t + 2) * kstep;
            const char* a3 = a2 + kstep; const char* b3 = b2 + kstep;
            if (last && has_next) S.a_ready(nxt);
            if constexpr (SP2) {
            PG8_LDB(B0, 0, 0); PG8_LDB(B1, 0, 1); PG8_SCHED; PG8_LDA(At, 0, 0); PG8_STAGE(PG8_SA(1, 1), a1 + hstep, voffA);
            PG8_WAIT_V(8); PG8_WAIT_L(0); PG8_BAR; PG8_MMA(0, 0, At, B0); PG8_MMA(0, 1, At, B1); PG8_BAR; PG8_SCHED;
            PG8_LDA(At, 0, 1); PG8_STAGE(PG8_SB(0, 0), b2, voffB); PG8_STAGE(PG8_SB(0, 1), b2 + hstep, voffB); PG8_STAGE(PG8_SA(0, 0), a2, voffA);
            PG8_WAIT_V(8); PG8_WAIT_L(0); PG8_BAR; PG8_MMA(1, 0, At, B0); PG8_MMA(1, 1, At, B1); PG8_BAR; PG8_SCHED;
            PG8_LDB(B0, 1, 0); PG8_LDB(B1, 1, 1); PG8_SCHED; PG8_LDA(At, 1, 0); PG8_STAGE(PG8_SA(0, 1), a2 + hstep, voffA);
            PG8_WAIT_V(8); PG8_WAIT_L(0); PG8_BAR; PG8_MMA(0, 0, At, B0); PG8_MMA(0, 1, At, B1); PG8_BAR; PG8_SCHED;
            PG8_LDA(At, 1, 1); PG8_STAGE(PG8_SB(1, 0), b3, voffB); PG8_STAGE(PG8_SB(1, 1), b3 + hstep, voffB); PG8_STAGE(PG8_SA(1, 0), a3, voffA);
            PG8_WAIT_V(8); PG8_WAIT_L(0); PG8_BAR; PG8_MMA(1, 0, At, B0); PG8_MMA(1, 1, At, B1); PG8_BAR; PG8_SCHED;
            } else {
            PG8_LDB(B0, 0, 0); PG8_SCHED; PG8_LDA(At, 0, 0); PG8_STAGE(PG8_SA(1, 1), a1 + hstep, voffA);
            PG8_WAIT_L(8); PG8_BAR; PG8_WAIT_L(0); PG8_MMA(0, 0, At, B0); PG8_BAR; PG8_SCHED;
            PG8_LDB(B1, 0, 1); PG8_STAGE(PG8_SB(0, 0), b2, voffB);
            PG8_BAR; PG8_WAIT_L(0); PG8_MMA(0, 1, At, B1); PG8_BAR;
            PG8_LDA(At, 0, 1); PG8_STAGE(PG8_SA(0, 0), a2, voffA);
            PG8_BAR; PG8_WAIT_L(0); PG8_MMA(1, 0, At, B0); PG8_BAR; PG8_SCHED;
            PG8_STAGE(PG8_SB(0, 1), b2 + hstep, voffB);
            PG8_WAIT_V(6); PG8_BAR; PG8_MMA(1, 1, At, B1); PG8_BAR;
            PG8_LDB(B0, 1, 0); PG8_SCHED; PG8_LDA(At, 1, 0); PG8_STAGE(PG8_SA(0, 1), a2 + hstep, voffA);
            PG8_WAIT_L(8); PG8_BAR; PG8_WAIT_L(0); PG8_MMA(0, 0, At, B0); PG8_BAR; PG8_SCHED;
            PG8_LDB(B1, 1, 1); PG8_STAGE(PG8_SB(1, 0), b3, voffB);
            PG8_BAR; PG8_WAIT_L(0); PG8_MMA(0, 1, At, B1); PG8_BAR;
            PG8_LDA(At, 1, 1); PG8_STAGE(PG8_SA(1, 0), a3, voffA);
            PG8_BAR; PG8_WAIT_L(0); PG8_MMA(1, 0, At, B0); PG8_BAR; PG8_SCHED;
            PG8_STAGE(PG8_SB(1, 1), b3 + hstep, voffB);
            PG8_WAIT_V(6); PG8_BAR; PG8_MMA(1, 1, At, B1); PG8_BAR;
            }
        }
        if constexpr (ALIGN_EPI) { if (wr == 0) PG8_BAR; }
        if constexpr (!Epi::AFTER_DRAIN) { E(acc, cur, wr, wc, fr, fq); S.done(cur); }
        if (!has_next) break;
#pragma unroll
        for (int a = 0; a < 2; ++a)
#pragma unroll
            for (int b = 0; b < 2; ++b)
#pragma unroll
                for (int m = 0; m < 4; ++m)
#pragma unroll
                    for (int n = 0; n < 2; ++n) acc[a][b][m][n] = (f32x4){0.f, 0.f, 0.f, 0.f};
        cur = nxt; cA = nA; cB = nB; ++ui;
        if constexpr (ALIGN_EPI) { if (wr == 1) PG8_BAR; }
    }
    PG8_WAIT_V(0);
    if constexpr (!ALIGN_EPI) { if (wr == 0) PG8_BAR; }
    PG8_BAR;
    if constexpr (Epi::AFTER_DRAIN) { E.fused(acc, cur, wr, wc, fr, fq, lds, wid, lane); S.done(cur); }
#undef PG8_SA
#undef PG8_SB
#undef PG8_STAGE
#undef PG8_LDA
#undef PG8_LDB
#undef PG8_MMA
#undef PG8_WAIT_V
#undef PG8_WAIT_L
#undef PG8_BAR
#undef PG8_SCHED
}
}

#define LAS __attribute__((address_space(3)))
typedef unsigned short bf16;
typedef float f32x2 __attribute__((ext_vector_type(2)));
typedef float f32x4 __attribute__((ext_vector_type(4)));
typedef unsigned u32x2 __attribute__((ext_vector_type(2)));
typedef unsigned u32x4 __attribute__((ext_vector_type(4)));

constexpr int PDIM = 1536;
constexpr int NTOK = 32768, DM = 1024, DIN = 2560, SEQ = 8192, NBATCH = 4, NMETA = 16;
constexpr int NHEAD = 8, NKEYS = 128, TOPK = 16, NSEL = NHEAD * TOPK;
constexpr float EPS = 1e-6f;
constexpr float U_SCALE = 64.f, V_SCALE = 16.f;
constexpr float U4_CLIP = 2.6f;
constexpr int NWAVES = 8, NTHREADS = 512;
constexpr int MKC = 32;
constexpr int LDS_BYTES = 147456;

constexpr size_t MiB = 1u << 20;
constexpr size_t WS_CTL = 0, WS_WIN_T = 1 * MiB, WS_WOUT_T = 6 * MiB, WS_WQ_T = 8 * MiB, WS_KEYS = 12 * MiB, WS_METAPART = 160 * MiB  ,
                 WS_METARSTD = 14 * MiB + 512 * 1024, WS_METAPROJ = 14 * MiB + 576 * 1024, WS_RSTD1 = 15 * MiB, WS_SSQ = 16 * MiB, WS_U8 = 32 * MiB, WS_V8 = 48 * MiB,
                 WS_IDX = 64 * MiB, WS_GATE = 80 * MiB, WS_H0B = 96 * MiB, WS_H2B = 96 * MiB, WS_Y = 160 * MiB, WS_PROJ = 224 * MiB,
                 WS_Q = 224 * MiB, WS_ESCALE = 18 * MiB, WS_SUMQ = 19 * MiB, WS_AW = 160 * MiB  , WS_END = 384 * MiB;

struct Params {
    const float* x; const float* meta; const float* g_mix; const float* w_in; const float* sc_w; const float* cf_w; const float* cf_b;
    const float* ln_g; const float* ln_b; const float* g_sc; const float* g_cf; const float* w_out; const float* g_ffn; const float* w_q;
    const float* keys; const float* pu; const float* pv; const float* g_fin;
    float* out; unsigned char* ws;
    int ph_lo, ph_hi, coop, pad;
};

__device__ __forceinline__ unsigned f2bf(float f) { unsigned u = __builtin_bit_cast(unsigned, f); return (u + 0x7fffu + ((u >> 16) & 1u)) >> 16; }
__device__ __forceinline__ unsigned pk2(float lo, float hi) { return f2bf(lo) | (f2bf(hi) << 16); }
__device__ __forceinline__ float bf2f(unsigned b) { return __builtin_bit_cast(float, b << 16); }
__device__ __forceinline__ float bflo(unsigned w) { return __builtin_bit_cast(float, w << 16); }
__device__ __forceinline__ float bfhi(unsigned w) { return __builtin_bit_cast(float, w & 0xffff0000u); }
__device__ __forceinline__ float wave_sum(float v) {
#pragma unroll
    for (int o = 1; o < 64; o <<= 1) v += __shfl_xor(v, o);
    return v;
}
template <int CTRL> __device__ __forceinline__ float dpp_f(float v) { return __builtin_bit_cast(float, __builtin_amdgcn_update_dpp(0, __builtin_bit_cast(int, v), CTRL, 0xf, 0xf, true)); }
__device__ __forceinline__ float wave_sum_fast(float v) {
    v += dpp_f<0xB1>(v); v += dpp_f<0x4E>(v); v += dpp_f<0x141>(v); v += dpp_f<0x140>(v);
    { auto r = __builtin_amdgcn_permlane16_swap(__float_as_uint(v), __float_as_uint(v), false, false); v = __uint_as_float(r[0]) + __uint_as_float(r[1]); }
    { auto r = __builtin_amdgcn_permlane32_swap(__float_as_uint(v), __float_as_uint(v), false, false); v = __uint_as_float(r[0]) + __uint_as_float(r[1]); }
    return v;
}
__device__ __forceinline__ float sigmoid_f(float x) { return 1.f / (1.f + __expf(-x)); }
__device__ __forceinline__ float gelu_tanh_f(float x) {
    const float t = 0.7978845608028654f * (x + 0.044715f * x * x * x);
    const float e = __expf(2.f * t);
    const float th = 1.f - 2.f / (e + 1.f);
    return 0.5f * x * (1.f + th);
}

__device__ __forceinline__ unsigned cvt_pk_bf16(float lo, float hi) { unsigned r; asm volatile("v_cvt_pk_bf16_f32 %0, %1, %2" : "=v"(r) : "v"(lo), "v"(hi)); return r; }

template <int MODE> struct EpiRowScale {
    static constexpr bool PERM = true, AFTER_DRAIN = false;
    bf16* O; int ldc; const float* rs;
    __device__ __forceinline__ void operator()(const pg8::f32x4 (&acc)[2][2][4][2], const pg8::Unit& u, int wr, int wc, int fr, int fq) const {
        const int row0 = u.pm * 256 + wr * 64 + fr, col0 = u.pn * 256 + wc * 32 + 8 * fq;
#pragma unroll
        for (int ai = 0; ai < 2; ++ai)
#pragma unroll
            for (int m = 0; m < 4; ++m) {
                const int row = row0 + ai * 128 + m * 16;
                float s;
                if (MODE == 0) s = rs[row];
                else { const f32x4* p = (const f32x4*)(rs + (size_t)row * 16); const f32x4 a = p[0], b = p[1], c = p[2], d = p[3];
                       const float t = ((a.x + a.y) + (a.z + a.w)) + ((b.x + b.y) + (b.z + b.w)) + ((c.x + c.y) + (c.z + c.w)) + ((d.x + d.y) + (d.z + d.w));
                       s = rsqrtf(t * (1.f / 1024.f) + EPS); }
                bf16* rowp = O + (size_t)row * ldc + col0;
#pragma unroll
                for (int bj = 0; bj < 2; ++bj) { const pg8::f32x4 v0 = acc[ai][bj][m][0] * s, v1 = acc[ai][bj][m][1] * s;
                    u32x4 w; w.x = cvt_pk_bf16(v0[0], v0[1]); w.y = cvt_pk_bf16(v0[2], v0[3]); w.z = cvt_pk_bf16(v1[0], v1[1]); w.w = cvt_pk_bf16(v1[2], v1[3]);
                    *(u32x4*)(rowp + bj * 128) = w; }
            }
    }
};
struct EpiProj {
    static constexpr bool PERM = true, AFTER_DRAIN = false;
    bf16* O; const float* rs;
    __device__ __forceinline__ void operator()(const pg8::f32x4 (&acc)[2][2][4][2], const pg8::Unit& u, int wr, int wc, int fr, int fq) const {
        const int row0 = u.pm * 256 + wr * 64 + fr, cin = wc * 32 + 8 * fq, pn = u.pn;
#pragma unroll
        for (int ai = 0; ai < 2; ++ai)
#pragma unroll
            for (int m = 0; m < 4; ++m) {
                const int row = row0 + ai * 128 + m * 16; const float sc = rs[row];
                float a[8], b[8];
#pragma unroll
                for (int i = 0; i < 4; ++i) { a[i] = acc[ai][0][m][0][i] * sc; a[4 + i] = acc[ai][0][m][1][i] * sc; b[i] = acc[ai][1][m][0][i] * sc; b[4 + i] = acc[ai][1][m][1][i] * sc; }
                bf16* rowp = O + (size_t)row * PDIM;
                if (pn >= 4 && pn < 6) {
                    u32x4 w0, w1; w0.x = cvt_pk_bf16(a[0], a[1]); w0.y = cvt_pk_bf16(a[2], a[3]); w0.z = cvt_pk_bf16(a[4], a[5]); w0.w = cvt_pk_bf16(a[6], a[7]);
                    w1.x = cvt_pk_bf16(b[0], b[1]); w1.y = cvt_pk_bf16(b[2], b[3]); w1.z = cvt_pk_bf16(b[4], b[5]); w1.w = cvt_pk_bf16(b[6], b[7]);
                    *(u32x4*)(rowp + 512 + 256 * (pn - 4) + cin) = w0; *(u32x4*)(rowp + 512 + 256 * (pn - 4) + 128 + cin) = w1;
                } else {
                    float o[8];
                    if (pn < 4) {
#pragma unroll
                        for (int i = 0; i < 8; ++i) o[i] = a[i] * b[i];
                    } else {
#pragma unroll
                        for (int i = 0; i < 8; ++i) o[i] = a[i] * sigmoid_f(b[i]);
                    }
                    u32x4 w; w.x = cvt_pk_bf16(o[0], o[1]); w.y = cvt_pk_bf16(o[2], o[3]); w.z = cvt_pk_bf16(o[4], o[5]); w.w = cvt_pk_bf16(o[6], o[7]);
                    *(u32x4*)(rowp + (pn < 4 ? 128 * pn : 1024 + 128 * (pn - 6)) + cin) = w;
                }
            }
    }
};
__host__ __device__ __forceinline__ int win_src_col(int n) {
    const int t = n >> 8, j = n & 255;
    if (t < 4) return (j < 128) ? 128 * t + j : 1024 + 128 * t + (j - 128);
    if (t < 6) return 512 + 256 * (t - 4) + j;
    return (j < 128) ? 1536 + 128 * (t - 6) + j : 2048 + 128 * (t - 6) + (j - 128);
}
struct EpiResidual {
    static constexpr bool PERM = true, AFTER_DRAIN = false;
    bf16* O; const bf16* XB; float* ssq;
    __device__ __forceinline__ void operator()(const pg8::f32x4 (&acc)[2][2][4][2], const pg8::Unit& u, int wr, int wc, int fr, int fq) const {
        const int row0 = u.pm * 256 + wr * 64 + fr, col0 = u.pn * 256 + wc * 32 + 8 * fq;
#pragma unroll
        for (int ai = 0; ai < 2; ++ai)
#pragma unroll
            for (int m = 0; m < 4; ++m) {
                const int row = row0 + ai * 128 + m * 16;
                const bf16* xr = XB + (size_t)row * DM + col0; bf16* rowp = O + (size_t)row * DM + col0;
                float q = 0.f;
                u32x4 xw[2];
#pragma unroll
                for (int bj = 0; bj < 2; ++bj) xw[bj] = *(const u32x4*)(xr + bj * 128);
#pragma unroll
                for (int bj = 0; bj < 2; ++bj) { const f32x4 x0 = (f32x4){bflo(xw[bj].x), bfhi(xw[bj].x), bflo(xw[bj].y), bfhi(xw[bj].y)}, x1 = (f32x4){bflo(xw[bj].z), bfhi(xw[bj].z), bflo(xw[bj].w), bfhi(xw[bj].w)};
                    const pg8::f32x4 v0 = acc[ai][bj][m][0] + x0, v1 = acc[ai][bj][m][1] + x1;
                    q += (v0[0] * v0[0] + v0[1] * v0[1]) + (v0[2] * v0[2] + v0[3] * v0[3]) + (v1[0] * v1[0] + v1[1] * v1[1]) + (v1[2] * v1[2] + v1[3] * v1[3]);
                    u32x4 w; w.x = cvt_pk_bf16(v0[0], v0[1]); w.y = cvt_pk_bf16(v0[2], v0[3]); w.z = cvt_pk_bf16(v1[0], v1[1]); w.w = cvt_pk_bf16(v1[2], v1[3]);
                    *(u32x4*)(rowp + bj * 128) = w; }
                q += __shfl_xor(q, 16); q += __shfl_xor(q, 32);
                if (fq == 0) ssq[(size_t)row * 16 + u.pn * 4 + wc] = q;
            }
    }
};

template <bool MAPIN> __device__ __forceinline__ void p0_transpose_item(const float* W, int K, int N, bf16* WT, LAS float* scr, int item, int lane,
                                                  const float* g_lo, const float* g_hi, int split) {
    const int nblk = N / 32, kb = item / nblk, nb = item % nblk, k0 = 64 * kb, n0 = 32 * nb;
#pragma unroll 8
    for (int i = 0; i < 32; ++i) { const int kk = 2 * i + (lane >> 5); const int k = k0 + kk;
        const float g = (k < split) ? g_lo[k] : g_hi[k - split];
        scr[kk * 33 + (lane & 31)] = W[(size_t)k * N + (MAPIN ? win_src_col(n0) : n0) + (lane & 31)] * g; }
    asm volatile("s_waitcnt lgkmcnt(0)" ::: "memory");
    const int c = lane & 7;
#pragma unroll
    for (int j = 0; j < 4; ++j) { const int n = (lane >> 3) + 8 * j; const LAS float* s = scr + (8 * c) * 33 + n;
        u32x4 o; o.x = pk2(s[0 * 33], s[1 * 33]); o.y = pk2(s[2 * 33], s[3 * 33]); o.z = pk2(s[4 * 33], s[5 * 33]); o.w = pk2(s[6 * 33], s[7 * 33]);
        *(u32x4*)(WT + (size_t)(n0 + n) * K + k0 + 8 * c) = o; }
    asm volatile("s_waitcnt lgkmcnt(0)" ::: "memory");
}

__device__ __forceinline__ float q4(float x, float inv_s) {
    const float a = fabsf(x) * inv_s; float r;
    if (a < 2.f) r = rintf(a * 2.f) * 0.5f; else if (a < 4.f) r = rintf(a); else r = fminf(6.f, rintf(a * 0.5f) * 2.f);
    return copysignf(r, x);
}
__device__ __forceinline__ void phase_prep(const Params& P, LAS unsigned char* lds) {
    const int tid = threadIdx.x, lane = tid & 63, wave = __builtin_amdgcn_readfirstlane(tid >> 6);
    const int gw = blockIdx.x * NWAVES + wave, NGW = gridDim.x * NWAVES;
    unsigned char* ws = P.ws;
    LAS float* scr = (LAS float*)(lds + wave * 16384);
    constexpr int I_IN = (DM / 64) * (DIN / 32), I_OUT = (DM / 64) * (DM / 32), I_Q = (DM / 64) * (2048 / 32);
    for (int it = gw; it < I_IN + I_OUT + I_Q; it += NGW) {
        int r = it;
        if (r < I_IN) { p0_transpose_item<true>(P.w_in, DM, DIN, (bf16*)(ws + WS_WIN_T), scr, r, lane, P.g_mix, P.g_mix, DM); continue; } r -= I_IN;
        if (r < I_OUT) { p0_transpose_item<false>(P.w_out, DM, DM, (bf16*)(ws + WS_WOUT_T), scr, r, lane, P.g_sc, P.g_cf, 512); continue; } r -= I_OUT;
        p0_transpose_item<false>(P.w_q, DM, 2048, (bf16*)(ws + WS_WQ_T), scr, r, lane, P.g_ffn, P.g_ffn, DM);
    }
    {
        bf16* H0B = (bf16*)(ws + WS_H0B); float* RSTD1 = (float*)(ws + WS_RSTD1);
        for (int t0 = gw * 4; t0 < NTOK; t0 += NGW * 4) {
            f32x4 v[4][4];
#pragma unroll
            for (int q = 0; q < 4; ++q) { const f32x4* xr = (const f32x4*)(P.x + (size_t)(t0 + q) * DM) + lane;
#pragma unroll
                for (int j = 0; j < 4; ++j) v[q][j] = xr[64 * j]; }
#pragma unroll
            for (int q = 0; q < 4; ++q) { float sq = 0.f;
#pragma unroll
                for (int j = 0; j < 4; ++j) sq += (v[q][j].x * v[q][j].x + v[q][j].y * v[q][j].y) + (v[q][j].z * v[q][j].z + v[q][j].w * v[q][j].w);
                sq = wave_sum_fast(sq);
                if (lane == 0) RSTD1[t0 + q] = rsqrtf(sq * (1.f / DM) + EPS);
                u32x2* o = (u32x2*)(H0B + (size_t)(t0 + q) * DM) + lane;
#pragma unroll
                for (int j = 0; j < 4; ++j) { u32x2 w; w.x = pk2(v[q][j].x, v[q][j].y); w.y = pk2(v[q][j].z, v[q][j].w); o[64 * j] = w; } }
        }
    }
    {
        unsigned char* U8 = ws + WS_U8; unsigned char* V8 = ws + WS_V8;
        f32x4 gf[4];
#pragma unroll
        for (int j = 0; j < 4; ++j) gf[j] = ((const f32x4*)P.g_ffn)[64 * j + lane];
        float* ESC = (float*)(ws + WS_ESCALE);
        for (int e0 = gw * 2; e0 < 2 * 16384; e0 += NGW * 2) {
            const bool isv = e0 >= 16384; const int ee0 = isv ? e0 - 16384 : e0;
            f32x4 v[2][4];
#pragma unroll
            for (int q = 0; q < 2; ++q) { const f32x4* src = (const f32x4*)((isv ? P.pv : P.pu) + (size_t)(ee0 + q) * DM) + lane;
#pragma unroll
                for (int j = 0; j < 4; ++j) v[q][j] = src[64 * j]; }
#pragma unroll
            for (int q = 0; q < 2; ++q) {
                float mx = 0.f;
#pragma unroll
                for (int j = 0; j < 4; ++j) { if (!isv) v[q][j] = v[q][j] * gf[j];
                    mx = fmaxf(mx, fmaxf(fmaxf(fabsf(v[q][j].x), fabsf(v[q][j].y)), fmaxf(fabsf(v[q][j].z), fabsf(v[q][j].w)))); }
#pragma unroll
                for (int o = 1; o < 64; o <<= 1) mx = fmaxf(mx, __shfl_xor(mx, o));
                if (!isv) {
                    float sq2 = 0.f;
#pragma unroll
                    for (int j = 0; j < 4; ++j) sq2 += (v[q][j].x * v[q][j].x + v[q][j].y * v[q][j].y) + (v[q][j].z * v[q][j].z + v[q][j].w * v[q][j].w);
                    const float rms = sqrtf(wave_sum_fast(sq2) * (1.f / DM));
                    const float su = fmaxf(fminf(mx, U4_CLIP * rms), 1e-30f) * (1.f / 7.f), inv = 1.f / su;
                    unsigned wq[2] = {0u, 0u}; int csum = 0;
#pragma unroll
                    for (int j = 0; j < 4; ++j) { const float e4[4] = {v[q][j].x, v[q][j].y, v[q][j].z, v[q][j].w};
#pragma unroll
                        for (int i = 0; i < 4; ++i) { int c = (int)rintf(fminf(fmaxf(e4[i] * inv, -7.f), 7.f)); csum += c;
                            wq[j >> 1] |= ((unsigned)c & 15u) << (16 * (j & 1) + 4 * i); } }
                    const float cs = wave_sum_fast((float)csum);
                    if (lane == 0) { ESC[e0 + q] = su; ((float*)(ws + WS_SUMQ))[e0 + q] = cs; }
                    u32x2 o; o.x = wq[0]; o.y = wq[1];
                    *(u32x2*)(U8 + (size_t)(ee0 + q) * 512 + 8 * lane) = o;
                    continue;
                }
                const float sc = fmaxf(mx, 1e-30f) * (1.f / 6.f), inv = 1.f / sc;
                if (lane == 0) ESC[e0 + q] = sc;
                unsigned w0 = 0u, w1 = 0u;
                w0 = __builtin_amdgcn_cvt_scalef32_pk_fp4_f32(w0, v[q][0].x * inv, v[q][0].y * inv, 1.0f, 0); w0 = __builtin_amdgcn_cvt_scalef32_pk_fp4_f32(w0, v[q][0].z * inv, v[q][0].w * inv, 1.0f, 1);
                w0 = __builtin_amdgcn_cvt_scalef32_pk_fp4_f32(w0, v[q][1].x * inv, v[q][1].y * inv, 1.0f, 2); w0 = __builtin_amdgcn_cvt_scalef32_pk_fp4_f32(w0, v[q][1].z * inv, v[q][1].w * inv, 1.0f, 3);
                w1 = __builtin_amdgcn_cvt_scalef32_pk_fp4_f32(w1, v[q][2].x * inv, v[q][2].y * inv, 1.0f, 0); w1 = __builtin_amdgcn_cvt_scalef32_pk_fp4_f32(w1, v[q][2].z * inv, v[q][2].w * inv, 1.0f, 1);
                w1 = __builtin_amdgcn_cvt_scalef32_pk_fp4_f32(w1, v[q][3].x * inv, v[q][3].y * inv, 1.0f, 2); w1 = __builtin_amdgcn_cvt_scalef32_pk_fp4_f32(w1, v[q][3].z * inv, v[q][3].w * inv, 1.0f, 3);
                u32x2 o; o.x = w0; o.y = w1;
                *(u32x2*)((isv ? V8 : U8) + (size_t)(ee0 + q) * 512 + 8 * lane) = o;
            }
        }
    }
    {
        bf16* KB = (bf16*)(ws + WS_KEYS);
        const int gt = blockIdx.x * NTHREADS + tid, NGT = gridDim.x * NTHREADS;
        for (int i = gt; i < 8 * 2 * 128 * 128 / 4; i += NGT) { const f32x4 v = ((const f32x4*)P.keys)[i]; u32x2 w; w.x = pk2(v.x, v.y); w.y = pk2(v.z, v.w); ((u32x2*)KB)[i] = w; }
    }
    {
        float* MP = (float*)(ws + WS_METAPART); float* MR = (float*)(ws + WS_METARSTD);
        for (int r = gw; r < NMETA; r += NGW) {
            float s = 0.f;
            for (int k = lane; k < DM; k += 64) { const float v = P.meta[r * DM + k]; s += v * v; }
            s = wave_sum(s);
            if (lane == 0) MR[r] = rsqrtf(s * (1.f / DM) + EPS);
        }
        for (int it = gw; it < MKC * 40; it += NGW) {
            const int kc = it / 40, nb = it % 40, n = nb * 64 + lane;
            float acc[NMETA];
#pragma unroll
            for (int r = 0; r < NMETA; ++r) acc[r] = 0.f;
            for (int k = kc * (DM / MKC); k < (kc + 1) * (DM / MKC); ++k) {
                const float w = P.w_in[(size_t)k * DIN + n] * P.g_mix[k];
#pragma unroll
                for (int r = 0; r < NMETA; ++r) acc[r] += P.meta[r * DM + k] * w;
            }
#pragma unroll
            for (int r = 0; r < NMETA; ++r) MP[(size_t)(kc * 16 + r) * DIN + n] = acc[r];
        }
    }
}

__device__ __forceinline__ float metaraw(const float* MP, const float* MR, int p, int col) { float s = 0.f;
#pragma unroll 8
    for (int kc = 0; kc < MKC; ++kc) s += MP[(size_t)(kc * 16 + p) * DIN + col];
    return s * MR[p]; }
__device__ __forceinline__ void phase_metaproj(const Params& P) {
    const float* MP = (const float*)(P.ws + WS_METAPART); const float* MR = (const float*)(P.ws + WS_METARSTD); float* MJ = (float*)(P.ws + WS_METAPROJ);
    for (int gt = blockIdx.x * NTHREADS + threadIdx.x; gt < NMETA * PDIM; gt += gridDim.x * NTHREADS) { const int p = gt / PDIM, c = gt % PDIM; float v;
        if (c < 512) v = metaraw(MP, MR, p, c) * metaraw(MP, MR, p, 1024 + c);
        else if (c < 1024) v = metaraw(MP, MR, p, c);
        else v = metaraw(MP, MR, p, 1536 + (c - 1024)) * sigmoid_f(metaraw(MP, MR, p, 2048 + (c - 1024)));
        MJ[gt] = v; }
}
__device__ __forceinline__ float meta_val(const float* MJ, const float*, int p, int col) { return MJ[p * PDIM + col]; }
__device__ __forceinline__ float proj_at(const bf16* PROJ, const float* MP, const float* MR, int b, int pos, int col) {
    if (pos < 0) return 0.f;
    if (pos < NMETA) return meta_val(MP, MR, pos, col);
    return bf2f(PROJ[(size_t)(b * SEQ + pos - NMETA) * PDIM + col]);
}
__device__ __forceinline__ void proj8_at(const bf16* PROJ, const float* MP, const float* MR, int b, int pos, int col, float (&v)[8]) {
    if (pos < 0) {
#pragma unroll
        for (int i = 0; i < 8; ++i) v[i] = 0.f;
    } else if (pos < NMETA) {
        const f32x4 a = *(const f32x4*)(MP + pos * PDIM + col), bq = *(const f32x4*)(MP + pos * PDIM + col + 4);
        v[0] = a.x; v[1] = a.y; v[2] = a.z; v[3] = a.w; v[4] = bq.x; v[5] = bq.y; v[6] = bq.z; v[7] = bq.w;
    } else {
        const u32x4 w = *(const u32x4*)(PROJ + (size_t)(b * SEQ + pos - NMETA) * PDIM + col);
        v[0] = bflo(w.x); v[1] = bfhi(w.x); v[2] = bflo(w.y); v[3] = bfhi(w.y); v[4] = bflo(w.z); v[5] = bfhi(w.z); v[6] = bflo(w.w); v[7] = bfhi(w.w);
    }
}

template <int R> __device__ __forceinline__ void conv_rows(const LAS unsigned char* ubase, const f32x2 (&wcf)[31], f32x2 (&acc)[32]) {
    if constexpr (R < 62) {
        const unsigned uw = *(const LAS unsigned*)(ubase + R * 1024);
        const f32x2 x = (f32x2){bflo(uw), bfhi(uw)};
        constexpr int lo = R > 30 ? R - 30 : 0, hi = R < 31 ? R : 31;
#pragma unroll
        for (int ii = lo; ii <= hi; ++ii) acc[ii] += wcf[R - ii] * x;
        conv_rows<R + 1>(ubase, wcf, acc);
    }
}
__device__ __forceinline__ void phase_conv(const Params& P, LAS unsigned char* lds) {
    const int tid = threadIdx.x, lane = tid & 63, wave = __builtin_amdgcn_readfirstlane(tid >> 6);
    unsigned char* ws = P.ws;
    const bf16* PROJ = (const bf16*)(ws + WS_PROJ); const float* MP = (const float*)(ws + WS_METAPROJ); const float* MR = nullptr;
    bf16* Y = (bf16*)(ws + WS_Y);
    constexpr int TT = 64, NTILE = NTOK / TT, UROWS = TT + 30;
    const int cgp = wave & 3, th = wave >> 2, ch2 = cgp * 128 + 2 * lane;
    f32x2 wcf[31];
#pragma unroll
    for (int j = 0; j < 31; ++j) wcf[j] = *(const f32x2*)(P.cf_w + j * 512 + ch2);
    const f32x2 bcf = *(const f32x2*)(P.cf_b + ch2);
    for (int tile = blockIdx.x; tile < NTILE; tile += gridDim.x) {
        const int b = tile / (SEQ / TT), s0 = (tile % (SEQ / TT)) * TT;
#pragma unroll 4
        for (int p = 0; p < (UROWS + 7) / 8; ++p) {
            const int r = p * 8 + wave;
            if (r < UROWS) {
                const int pos = NMETA + s0 - 30 + r;
                float uu[8];
                proj8_at(PROJ, MP, MR, b, pos, 1024 + 8 * lane, uu);
                u32x4 w; w.x = pk2(uu[0], uu[1]); w.y = pk2(uu[2], uu[3]); w.z = pk2(uu[4], uu[5]); w.w = pk2(uu[6], uu[7]);
                *(LAS u32x4*)(lds + r * 1024 + lane * 16) = w;
            }
        }
        __syncthreads();
        f32x2 acc[32];
#pragma unroll
        for (int ii = 0; ii < 32; ++ii) acc[ii] = bcf;
        conv_rows<0>(lds + (32 * th) * 1024 + ch2 * 2, wcf, acc);
        __syncthreads();
#pragma unroll
        for (int ii = 0; ii < 32; ++ii) *(LAS f32x2*)(lds + (32 * th + ii) * 2048 + ch2 * 4) = acc[ii];
        __syncthreads();
        {
            float lng[8], lnb[8];
            { const f32x4 a = *(const f32x4*)(P.ln_g + 8 * lane), c = *(const f32x4*)(P.ln_g + 8 * lane + 4), d = *(const f32x4*)(P.ln_b + 8 * lane), e = *(const f32x4*)(P.ln_b + 8 * lane + 4);
              lng[0] = a.x; lng[1] = a.y; lng[2] = a.z; lng[3] = a.w; lng[4] = c.x; lng[5] = c.y; lng[6] = c.z; lng[7] = c.w;
              lnb[0] = d.x; lnb[1] = d.y; lnb[2] = d.z; lnb[3] = d.w; lnb[4] = e.x; lnb[5] = e.y; lnb[6] = e.z; lnb[7] = e.w; }
            float wsc[3][8];
#pragma unroll
            for (int j = 0; j < 3; ++j) { const f32x4 a = *(const f32x4*)(P.sc_w + j * 512 + 8 * lane), c = *(const f32x4*)(P.sc_w + j * 512 + 8 * lane + 4);
                wsc[j][0] = a.x; wsc[j][1] = a.y; wsc[j][2] = a.z; wsc[j][3] = a.w; wsc[j][4] = c.x; wsc[j][5] = c.y; wsc[j][6] = c.z; wsc[j][7] = c.w; }
            float cxa[8], cxb[8];
            { const int pos = NMETA + s0 + 8 * wave - 2;
              proj8_at(PROJ, MP, MR, b, pos, 8 * lane, cxa); proj8_at(PROJ, MP, MR, b, pos + 1, 8 * lane, cxb); }
#pragma unroll 2
            for (int q = 0; q < 8; ++q) {
                const int ii = 8 * wave + q, s = s0 + ii; const size_t t = (size_t)b * SEQ + s;
                float o[8];
                { const f32x4 a = *(const LAS f32x4*)(lds + ii * 2048 + lane * 32), c = *(const LAS f32x4*)(lds + ii * 2048 + lane * 32 + 16);
                  o[0] = a.x; o[1] = a.y; o[2] = a.z; o[3] = a.w; o[4] = c.x; o[5] = c.y; o[6] = c.z; o[7] = c.w; }
                float s1 = 0.f;
#pragma unroll
                for (int i = 0; i < 8; ++i) s1 += o[i];
                const float mean = wave_sum_fast(s1) * (1.f / 512.f);
                float s2 = 0.f;
#pragma unroll
                for (int i = 0; i < 8; ++i) { o[i] -= mean; s2 += o[i] * o[i]; }
                const float rs = rsqrtf(wave_sum_fast(s2) * (1.f / 512.f) + EPS);
                float s3 = 0.f;
#pragma unroll
                for (int i = 0; i < 8; ++i) { float y = o[i] * rs * lng[i] + lnb[i]; y = y * sigmoid_f(y); o[i] = y; s3 += y * y; }
                const float r2 = rsqrtf(wave_sum_fast(s3) * (1.f / 512.f) + EPS);
                u32x4 wv; wv.x = pk2(o[0] * r2, o[1] * r2); wv.y = pk2(o[2] * r2, o[3] * r2); wv.z = pk2(o[4] * r2, o[5] * r2); wv.w = pk2(o[6] * r2, o[7] * r2);
                *(u32x4*)(Y + t * DM + 512 + 8 * lane) = wv;
                float bgv[8], cxc[8], accs[8];
                proj8_at(PROJ, MP, MR, b, NMETA + s, 8 * lane, cxc); proj8_at(PROJ, MP, MR, b, NMETA + s, 512 + 8 * lane, bgv);
                float s4 = 0.f;
#pragma unroll
                for (int i = 0; i < 8; ++i) { accs[i] = bgv[i] * (wsc[0][i] * cxa[i] + wsc[1][i] * cxb[i] + wsc[2][i] * cxc[i]); s4 += accs[i] * accs[i]; cxa[i] = cxb[i]; cxb[i] = cxc[i]; }
                const float r4 = rsqrtf(wave_sum_fast(s4) * (1.f / 512.f) + EPS);
                u32x4 wz; wz.x = pk2(accs[0] * r4, accs[1] * r4); wz.y = pk2(accs[2] * r4, accs[3] * r4); wz.z = pk2(accs[4] * r4, accs[5] * r4); wz.w = pk2(accs[6] * r4, accs[7] * r4);
                *(u32x4*)(Y + t * DM + 8 * lane) = wz;
            }
        }
        __syncthreads();
    }
}

__device__ __forceinline__ int ord_i(float s) { int k = __builtin_bit_cast(int, s); k ^= (k >> 31) & 0x7fffffff; return k; }
__device__ __forceinline__ float unord_f(int k) { k ^= (k >> 31) & 0x7fffffff; return __builtin_bit_cast(float, k); }
#define TOP_INSERT(L, x_) do { int _x = (x_); _Pragma("unroll") for (int _i = 0; _i < 16; ++_i) { const int _hi = max(L[_i], _x); _x = min(L[_i], _x); L[_i] = _hi; } } while (0)

typedef short bf16x8 __attribute__((ext_vector_type(8)));
typedef float f32x16 __attribute__((ext_vector_type(16)));
template <bool DESC> __device__ __forceinline__ void ce_i(int& a, int& b) { const int hi = max(a, b), lo = min(a, b); if (DESC) { a = hi; b = lo; } else { a = lo; b = hi; } }
__device__ __forceinline__ void bitonic_sort16(int (&a)[16]) {
#pragma unroll
    for (int k = 2; k <= 16; k <<= 1)
#pragma unroll
        for (int j = k >> 1; j > 0; j >>= 1)
#pragma unroll
            for (int i = 0; i < 16; ++i) { const int l = i ^ j; if (l > i) { if ((i & k) == 0) ce_i<true>(a[i], a[l]); else ce_i<false>(a[i], a[l]); } }
}
__device__ __forceinline__ void bitonic_merge16(int (&a)[16]) {
#pragma unroll
    for (int j = 8; j > 0; j >>= 1)
#pragma unroll
        for (int i = 0; i < 16; ++i) { const int l = i ^ j; if (l > i) ce_i<true>(a[i], a[l]); }
}
__device__ __forceinline__ void merge_top16(int (&a)[16], const int (&b)[16]) {
#pragma unroll
    for (int i = 0; i < 16; ++i) a[i] = max(a[i], b[15 - i]);
    bitonic_merge16(a);
}
__device__ __forceinline__ int lut16(const unsigned (&T)[4], int i) {
    const unsigned sel = (unsigned)(i & 7) | 0x0c0c0c00u;
    const unsigned lo = __builtin_amdgcn_perm(T[1], T[0], sel), hi = __builtin_amdgcn_perm(T[3], T[2], sel);
    return (int)((i & 8) ? hi : lo);
}
constexpr int KROW = 272;
constexpr float SCORE_BIAS = 8.0f;

__device__ __forceinline__ void route_load_q(bf16x8 (&qf)[8], const bf16* qrow, int hb) {
#pragma unroll
    for (int ks = 0; ks < 8; ++ks) qf[ks] = *(const bf16x8*)(qrow + 64 * hb + 8 * ks);
}
__device__ __forceinline__ void route_half(const LAS unsigned char* kl, const bf16x8 (&qf)[8], int nl, int hb, int (&L)[16]) {
    f32x16 acc[4];
#pragma unroll
    for (int nt = 0; nt < 4; ++nt)
#pragma unroll
        for (int r = 0; r < 16; ++r) acc[nt][r] = SCORE_BIAS;
#pragma unroll
    for (int ks = 0; ks < 8; ++ks)
#pragma unroll
        for (int nt = 0; nt < 4; ++nt) {
            const bf16x8 a = *(const LAS bf16x8*)(kl + (32 * nt + nl) * KROW + (64 * hb + 8 * ks) * 2);
            acc[nt] = __builtin_amdgcn_mfma_f32_32x32x16_bf16(a, qf[ks], acc[nt], 0, 0, 0);
        }
    const int hb4 = 4 * hb;
    int T[4][16];
#pragma unroll
    for (int nt = 0; nt < 4; ++nt)
#pragma unroll
        for (int r = 0; r < 16; ++r) { const int n0 = 32 * nt + (r & 3) + 8 * (r >> 2); const float sc = acc[nt][r];
            T[nt][r] = (__float_as_int(sc) & ~127) | ((127 - n0) - hb4); }
    bitonic_sort16(T[0]); bitonic_sort16(T[1]); bitonic_sort16(T[2]); bitonic_sort16(T[3]);
    merge_top16(T[0], T[1]); merge_top16(T[2], T[3]); merge_top16(T[0], T[2]);
#pragma unroll
    for (int i = 0; i < 16; ++i) { const unsigned v = (unsigned)T[0][15 - i]; auto r = __builtin_amdgcn_permlane32_swap(v, v, false, false);
        const unsigned r0 = r[0], r1 = r[1]; const int partner = (int)(hb ? r0 : r1); L[i] = max(T[0][i], partner); }
    bitonic_merge16(L);
}

__device__ __forceinline__ void phase_route(const Params& P, LAS unsigned char* lds) {
    const int tid = threadIdx.x, lane = tid & 63, wave = __builtin_amdgcn_readfirstlane(tid >> 6);
    const int nl = lane & 31, hb = lane >> 5;
    unsigned char* ws = P.ws;
    const bf16* KEYS = (const bf16*)(ws + WS_KEYS); const bf16* Q = (const bf16*)(ws + WS_Q);
    int* IDX = (int*)(ws + WS_IDX); float* GATE = (float*)(ws + WS_GATE);
    int last_h = -1;
    pg8::StaticOrder S; S.init(NTOK, 2048, (int)gridDim.x, (int)blockIdx.x);
    pg8::Unit ucur, unxt;
    bool have = S.next(0, ucur);
    bf16x8 qfA[8], qfB[8];
    if (have) route_load_q(qfA, Q + ((size_t)ucur.pm * 256 + wave * 32 + nl) * 2048 + ucur.pn * 256, hb);
    for (int ui = 0; have; ++ui) {
        const int h = ucur.pn, tb = ucur.pm;
        const bool have_next = S.next(ui + 1, unxt);
        if (h != last_h) {
            __syncthreads();
            for (int c = tid; c < 4096; c += NTHREADS) { const u32x4 v = ((const u32x4*)(KEYS + (size_t)h * 32768))[c];
                *(LAS u32x4*)(lds + (c >> 4) * KROW + (c & 15) * 16) = v; }
            __syncthreads();
            last_h = h;
        }
        const size_t t = (size_t)tb * 256 + wave * 32 + nl;
        int L1[16], L2[16];
        route_load_q(qfB, Q + t * 2048 + h * 256 + 128, hb);
        route_half(lds, qfA, nl, hb, L1);
        if (have_next) route_load_q(qfA, Q + ((size_t)unxt.pm * 256 + wave * 32 + nl) * 2048 + unxt.pn * 256, hb);
        route_half(lds + 128 * KROW, qfB, nl, hb, L2);
        float v1[16], v2[16];
#pragma unroll
        for (int i = 0; i < 16; ++i) { v1[i] = __int_as_float(L1[i] & ~127); v2[i] = __int_as_float(L2[i] & ~127); }
#define CAND(i, j) ((__float_as_int(v1[i] + v2[j]) & ~255) | (255 - (16 * (i) + (j))))
        int A[16], B[16], C[16];
#pragma unroll
        for (int j = 0; j < 16; ++j) A[j] = CAND(0, j);
#pragma unroll
        for (int j = 0; j < 8; ++j) { B[j] = CAND(1, j); B[8 + j] = CAND(15 - j, 0); }
        bitonic_merge16(B);
        C[0] = CAND(2, 0); C[1] = CAND(2, 1); C[2] = CAND(2, 2); C[3] = CAND(2, 3); C[4] = CAND(2, 4);
        C[5] = CAND(3, 0); C[6] = CAND(3, 1); C[7] = CAND(3, 2); C[8] = CAND(3, 3);
        C[9] = CAND(4, 0); C[10] = CAND(4, 1); C[11] = CAND(4, 2);
        C[12] = CAND(5, 0); C[13] = CAND(5, 1); C[14] = CAND(6, 0); C[15] = CAND(6, 1);
        bitonic_sort16(C);
        { const int d0 = CAND(7, 0), d1 = CAND(7, 1); C[14] = max(C[14], d1); C[15] = max(C[15], d0); bitonic_merge16(C); }
#undef CAND
        merge_top16(A, B); merge_top16(A, C);
        unsigned T1[4], T2[4];
#pragma unroll
        for (int q = 0; q < 4; ++q) {
            T1[q] = (unsigned)(127 - (L1[4 * q] & 127)) | ((unsigned)(127 - (L1[4 * q + 1] & 127)) << 8) | ((unsigned)(127 - (L1[4 * q + 2] & 127)) << 16) | ((unsigned)(127 - (L1[4 * q + 3] & 127)) << 24);
            T2[q] = (unsigned)(127 - (L2[4 * q] & 127)) | ((unsigned)(127 - (L2[4 * q + 1] & 127)) << 8) | ((unsigned)(127 - (L2[4 * q + 2] & 127)) << 16) | ((unsigned)(127 - (L2[4 * q + 3] & 127)) << 24); }
        float val[16]; int ex[16];
#pragma unroll
        for (int k = 0; k < 16; ++k) { const int pos = 255 - (A[k] & 255); val[k] = __int_as_float(A[k] & ~255);
            ex[k] = lut16(T1, pos >> 4) * NKEYS + lut16(T2, pos & 15); }
        float sum = 0.f; const float vmax = val[0];
#pragma unroll
        for (int k = 0; k < 16; ++k) { val[k] = __expf(val[k] - vmax); sum += val[k]; }
        const float inv = 1.f / sum;
        if (hb == 0) {
            int* ip = IDX + t * NSEL + h * TOPK; float* gp = GATE + t * NSEL + h * TOPK;
#pragma unroll
            for (int k4 = 0; k4 < 4; ++k4) {
                *(int4*)(ip + 4 * k4) = make_int4(ex[4 * k4], ex[4 * k4 + 1], ex[4 * k4 + 2], ex[4 * k4 + 3]);
                *(f32x4*)(gp + 4 * k4) = (f32x4){val[4 * k4] * inv, val[4 * k4 + 1] * inv, val[4 * k4 + 2] * inv, val[4 * k4 + 3] * inv};
            }
        }
        ucur = unxt; have = have_next;
    }
}

#define FP4X2(w, sel) __builtin_amdgcn_cvt_scalef32_pk_f32_fp4((w), 1.0f, (sel))
__device__ __forceinline__ float dot16_fp4(const u32x2 r, const f32x4 (&xs)[4]) {
    float p = 0.f;
    { const f32x2 a = FP4X2(r.x, 0), b = FP4X2(r.x, 1), c = FP4X2(r.x, 2), d = FP4X2(r.x, 3);
      p += (a.x * xs[0].x + a.y * xs[0].y) + (b.x * xs[0].z + b.y * xs[0].w); p += (c.x * xs[1].x + c.y * xs[1].y) + (d.x * xs[1].z + d.y * xs[1].w); }
    { const f32x2 a = FP4X2(r.y, 0), b = FP4X2(r.y, 1), c = FP4X2(r.y, 2), d = FP4X2(r.y, 3);
      p += (a.x * xs[2].x + a.y * xs[2].y) + (b.x * xs[2].z + b.y * xs[2].w); p += (c.x * xs[3].x + c.y * xs[3].y) + (d.x * xs[3].z + d.y * xs[3].w); }
    return p;
}
__device__ __forceinline__ void axpy16_fp4(const u32x2 r, float w, f32x4 (&o)[4]) {
    { const f32x2 a = FP4X2(r.x, 0), b = FP4X2(r.x, 1), c = FP4X2(r.x, 2), d = FP4X2(r.x, 3);
      o[0].x += w * a.x; o[0].y += w * a.y; o[0].z += w * b.x; o[0].w += w * b.y; o[1].x += w * c.x; o[1].y += w * c.y; o[1].z += w * d.x; o[1].w += w * d.y; }
    { const f32x2 a = FP4X2(r.y, 0), b = FP4X2(r.y, 1), c = FP4X2(r.y, 2), d = FP4X2(r.y, 3);
      o[2].x += w * a.x; o[2].y += w * a.y; o[2].z += w * b.x; o[2].w += w * b.y; o[3].x += w * c.x; o[3].y += w * c.y; o[3].z += w * d.x; o[3].w += w * d.y; }
}
__device__ __forceinline__ float swap32_add(float a, float b) { auto r = __builtin_amdgcn_permlane32_swap(__float_as_uint(a), __float_as_uint(b), false, false); return __uint_as_float(r[0]) + __uint_as_float(r[1]); }
__device__ __forceinline__ float swap16_add(float a, float b) { auto r = __builtin_amdgcn_permlane16_swap(__float_as_uint(a), __float_as_uint(b), false, false); return __uint_as_float(r[0]) + __uint_as_float(r[1]); }
__device__ __forceinline__ float row_sum16(float v) { v += dpp_f<0xB1>(v); v += dpp_f<0x4E>(v); v += dpp_f<0x141>(v); v += dpp_f<0x140>(v); return v; }
constexpr int GB = 32;
typedef __attribute__((address_space(8))) void* rsrc_t;
__device__ __forceinline__ void g_issue(u32x2 (&buf)[GB], __amdgpu_buffer_rsrc_t rs, int idxr, int lb, int voff) {
#pragma unroll
    for (int j = 0; j < GB; ++j) { const int e = __builtin_amdgcn_readlane(idxr, lb + j); buf[j] = __builtin_amdgcn_raw_buffer_load_b64(rs, voff, e * 512, 0); }
}
__device__ __forceinline__ float dot16_fp4p(const u32x2 r, const f32x2 (&xp)[8]) {
    f32x2 a = FP4X2(r.x, 0) * xp[0];
    a += FP4X2(r.x, 1) * xp[1]; a += FP4X2(r.x, 2) * xp[2]; a += FP4X2(r.x, 3) * xp[3];
    a += FP4X2(r.y, 0) * xp[4]; a += FP4X2(r.y, 1) * xp[5]; a += FP4X2(r.y, 2) * xp[6]; a += FP4X2(r.y, 3) * xp[7];
    return a.x + a.y;
}
__device__ __forceinline__ void axpy16_fp4p(const u32x2 r, float w, f32x2 (&o)[8]) {
    const f32x2 ww = (f32x2){w, w};
    o[0] += FP4X2(r.x, 0) * ww; o[1] += FP4X2(r.x, 1) * ww; o[2] += FP4X2(r.x, 2) * ww; o[3] += FP4X2(r.x, 3) * ww;
    o[4] += FP4X2(r.y, 0) * ww; o[5] += FP4X2(r.y, 1) * ww; o[6] += FP4X2(r.y, 2) * ww; o[7] += FP4X2(r.y, 3) * ww;
}
template <int H> __device__ __forceinline__ void g_compute_u(const u32x2 (&buf)[GB], int q, int i16, const f32x2 (&xp)[8], float& zlo, float& zhi) {
    float p[16];
#pragma unroll
    for (int j = 0; j < 16; ++j) p[j] = dot16_fp4p(buf[16 * H + j], xp);
    float s1[8], s2[4];
#pragma unroll
    for (int m = 0; m < 8; ++m) s1[m] = swap32_add(p[2 * m], p[2 * m + 1]);
#pragma unroll
    for (int n = 0; n < 4; ++n) s2[n] = swap16_add(s1[2 * n], s1[2 * n + 1]);
#pragma unroll
    for (int r = 0; r < 4; ++r) { const float z = row_sum16(s2[r]); const bool mine = i16 == ((4 * q + r) & 15);
        zlo = (mine && q < 4) ? z : zlo; zhi = (mine && q >= 4) ? z : zhi; }
}
template <int H> __device__ __forceinline__ void g_compute_v(const u32x2 (&buf)[GB], int q, float alo, float ahi, f32x2 (&o)[8]) {
    const int areg = __builtin_bit_cast(int, (q < 4) ? alo : ahi), sb = 4 * (q & 3);
#pragma unroll
    for (int j = 0; j < 16; ++j) { const int src = 32 * (j & 1) + 16 * ((j >> 1) & 1) + (j >> 2) + sb;
        const float w = __builtin_bit_cast(float, __builtin_amdgcn_readlane(areg, src));
        axpy16_fp4p(buf[16 * H + j], w, o); }
}
__device__ __forceinline__ void q_issue(u32x2 (&buf)[16], __amdgpu_buffer_rsrc_t rs, int ixr  , int lb, int voff) {
#pragma unroll
    for (int j = 0; j < 16; ++j) { const int e9 = __builtin_amdgcn_readlane(ixr, lb + j); buf[j] = __builtin_amdgcn_raw_buffer_load_b64(rs, voff, e9, 0); }
}
__device__ __forceinline__ void q_compute_u(const u32x2 (&buf)[16], int q, int i16, const f32x2 (&xp)[8], float& zlo, float& zhi) {
    float p[16];
#pragma unroll
    for (int j = 0; j < 16; ++j) p[j] = dot16_fp4p(buf[j], xp);
    float s1[8], s2[4];
#pragma unroll
    for (int m = 0; m < 8; ++m) s1[m] = swap32_add(p[2 * m], p[2 * m + 1]);
#pragma unroll
    for (int n = 0; n < 4; ++n) s2[n] = swap16_add(s1[2 * n], s1[2 * n + 1]);
#pragma unroll
    for (int r = 0; r < 4; ++r) { const float z = row_sum16(s2[r]); const bool mine = i16 == ((4 * q + r) & 15);
        zlo = (mine && q < 4) ? z : zlo; zhi = (mine && q >= 4) ? z : zhi; }
}
__device__ __forceinline__ void q_compute_v(const u32x2 (&buf)[16], int q, float alo, float ahi, f32x2 (&o)[8]) {
    const int areg = __builtin_bit_cast(int, (q < 4) ? alo : ahi), sb = 4 * (q & 3);
#pragma unroll
    for (int j = 0; j < 16; ++j) { const int src = 32 * (j & 1) + 16 * ((j >> 1) & 1) + (j >> 2) + sb;
        const float w = __builtin_bit_cast(float, __builtin_amdgcn_readlane(areg, src));
        axpy16_fp4p(buf[j], w, o); }
}
__device__ __forceinline__ int swap32_addi(int a, int b) { auto r = __builtin_amdgcn_permlane32_swap((unsigned)a, (unsigned)b, false, false); const unsigned r0 = r[0], r1 = r[1]; return (int)(r0 + r1); }
__device__ __forceinline__ int swap16_addi(int a, int b) { auto r = __builtin_amdgcn_permlane16_swap((unsigned)a, (unsigned)b, false, false); const unsigned r0 = r[0], r1 = r[1]; return (int)(r0 + r1); }
template <int CTRL> __device__ __forceinline__ int dpp_i(int v) { return __builtin_amdgcn_update_dpp(0, v, CTRL, 0xf, 0xf, true); }
__device__ __forceinline__ int row_sum16i(int v) { v += dpp_i<0xB1>(v); v += dpp_i<0x4E>(v); v += dpp_i<0x141>(v); v += dpp_i<0x140>(v); return v; }
__device__ __forceinline__ void q_compute_ui(const u32x2 (&buf)[16], int q, int i16, int xh0, int xh1, int xl0, int xl1, int& zlo, int& zhi) {
    int p[16];
#pragma unroll
    for (int j = 0; j < 16; ++j) { const int d1 = __builtin_amdgcn_sdot8((int)buf[j].x, xh0, __builtin_amdgcn_sdot8((int)buf[j].y, xh1, 0, false), false);
        const int d2 = __builtin_amdgcn_sdot8((int)buf[j].x, xl0, __builtin_amdgcn_sdot8((int)buf[j].y, xl1, 0, false), false);
        p[j] = (d1 << 4) + d2; }
    int s1[8], s2[4];
#pragma unroll
    for (int m = 0; m < 8; ++m) s1[m] = swap32_addi(p[2 * m], p[2 * m + 1]);
#pragma unroll
    for (int n = 0; n < 4; ++n) s2[n] = swap16_addi(s1[2 * n], s1[2 * n + 1]);
#pragma unroll
    for (int r = 0; r < 4; ++r) { const int z = row_sum16i(s2[r]); const bool mine = i16 == ((4 * q + r) & 15);
        zlo = (mine && q < 4) ? z : zlo; zhi = (mine && q >= 4) ? z : zhi; }
}
__device__ __forceinline__ float wave_max_fast(float v) {
    v = fmaxf(v, dpp_f<0xB1>(v)); v = fmaxf(v, dpp_f<0x4E>(v)); v = fmaxf(v, dpp_f<0x141>(v)); v = fmaxf(v, dpp_f<0x140>(v));
    { auto r = __builtin_amdgcn_permlane16_swap(__float_as_uint(v), __float_as_uint(v), false, false); v = fmaxf(__uint_as_float(r[0]), __uint_as_float(r[1])); }
    { auto r = __builtin_amdgcn_permlane32_swap(__float_as_uint(v), __float_as_uint(v), false, false); v = fmaxf(__uint_as_float(r[0]), __uint_as_float(r[1])); }
    return v;
}
__device__ __forceinline__ void phase_gather_u(const Params& P) {
    const int tid = threadIdx.x, lane = tid & 63, wave = __builtin_amdgcn_readfirstlane(tid >> 6);
    const int gw = blockIdx.x * NWAVES + wave, NGW = gridDim.x * NWAVES;
    unsigned char* ws = P.ws;
    const int* IDX = (const int*)(ws + WS_IDX); const float* GATE = (const float*)(ws + WS_GATE); const float* ESC = (const float*)(ws + WS_ESCALE); float* AW = (float*)(ws + WS_AW);
    const __amdgpu_buffer_rsrc_t rsU = __builtin_amdgcn_make_buffer_rsrc((void*)(ws + WS_U8), 0, 16384 * 512, 0x00020000);
    const bf16* H2B = (const bf16*)(ws + WS_H2B); const float* SSQ = (const float*)(ws + WS_SSQ);
    const int hh = lane >> 5, rr = (lane >> 4) & 1, i16 = lane & 15, gsel = 4 * i16 + 2 * rr + hh;
    const int voff = 8 * lane;
    const unsigned ul = (unsigned)lane;
    int t = gw;
    if (t < NTOK) {
        int idx0, idx1; u32x2 hraw[4]; float sqv;
        { const int* ip = IDX + (size_t)t * NSEL; idx0 = ip[ul]; idx1 = ip[64u + ul];
          const u32x2* hp = (const u32x2*)(H2B + (size_t)t * DM);
#pragma unroll
          for (int j = 0; j < 4; ++j) hraw[j] = hp[64u * j + ul];
          sqv = (SSQ + (size_t)t * 16)[ul & 15u]; }
        u32x2 R0[16], R1[16], R2[16], R3[16];
        { const int ix0 = idx0 << 9; q_issue(R0, rsU, ix0, 0, voff); q_issue(R1, rsU, ix0, 16, voff); q_issue(R2, rsU, ix0, 32, voff); }
        for (;;) {
            const int tn = t + NGW; const bool has_next = tn < NTOK; const int tl = has_next ? tn : t;
            int idx0n, idx1n; u32x2 hrawn[4]; float sqn, g0, g1;
            { const int* ip = IDX + (size_t)tl * NSEL; idx0n = ip[ul]; idx1n = ip[64u + ul];
              const u32x2* hp = (const u32x2*)(H2B + (size_t)tl * DM);
#pragma unroll
              for (int j = 0; j < 4; ++j) hrawn[j] = hp[64u * j + ul];
              sqn = (SSQ + (size_t)tl * 16)[ul & 15u];
              const float* gp = GATE + (size_t)t * NSEL; g0 = gp[ul]; g1 = gp[64u + ul]; }
            const float su0 = ESC[idx0], su1 = ESC[idx1], sv0 = ESC[16384 + idx0], sv1 = ESC[16384 + idx1];
            const float cq0 = ((const float*)(ws + WS_SUMQ))[idx0], cq1 = ((const float*)(ws + WS_SUMQ))[idx1];
            const float rstd2 = rsqrtf(row_sum16(sqv) * (1.f / DM) + EPS);
            float xf[16];
#pragma unroll
            for (int j = 0; j < 4; ++j) { xf[4 * j] = bflo(hraw[j].x); xf[4 * j + 1] = bfhi(hraw[j].x); xf[4 * j + 2] = bflo(hraw[j].y); xf[4 * j + 3] = bfhi(hraw[j].y); }
            float am = 0.f;
#pragma unroll
            for (int e = 0; e < 16; ++e) am = fmaxf(am, fabsf(xf[e]));
            am = fmaxf(wave_max_fast(am), 1e-30f);
            const float xinv = 127.f / am, xscale = am * (1.f / 127.f);
            unsigned xh[2] = {0u, 0u}, xl[2] = {0u, 0u};
#pragma unroll
            for (int j = 0; j < 4; ++j)
#pragma unroll
                for (int i = 0; i < 4; ++i) { const int xi = (int)rintf(xf[4 * j + i] * xinv); const int sh = 16 * (j & 1) + 4 * i;
                    xh[j >> 1] |= ((unsigned)(xi >> 4) & 15u) << sh; xl[j >> 1] |= ((unsigned)((xi & 15) - 8) & 15u) << sh; }
            int zlo = 0, zhi = 0;
            const int ix0 = idx0 << 9, ix1 = idx1 << 9;
#pragma unroll 1
            for (int qq = 0; qq < 8; qq += 4) {
                const int ixn = qq ? (idx0n << 9) : ix1;
                q_issue(R3, rsU, qq ? ix1 : ix0, 48, voff);
                q_compute_ui(R0, qq, i16, (int)xh[0], (int)xh[1], (int)xl[0], (int)xl[1], zlo, zhi);
                q_issue(R0, rsU, ixn, 0, voff);
                q_compute_ui(R1, qq + 1, i16, (int)xh[0], (int)xh[1], (int)xl[0], (int)xl[1], zlo, zhi);
                q_issue(R1, rsU, ixn, 16, voff);
                q_compute_ui(R2, qq + 2, i16, (int)xh[0], (int)xh[1], (int)xl[0], (int)xl[1], zlo, zhi);
                q_issue(R2, rsU, ixn, 32, voff);
                q_compute_ui(R3, qq + 3, i16, (int)xh[0], (int)xh[1], (int)xl[0], (int)xl[1], zlo, zhi);
            }
            const float glo = __shfl(g0, gsel), ghi = __shfl(g1, gsel), sulo = __shfl(su0, gsel), suhi = __shfl(su1, gsel), svlo = __shfl(sv0, gsel), svhi = __shfl(sv1, gsel);
            const float cqlo = __shfl(cq0, gsel), cqhi = __shfl(cq1, gsel);
            const float zfl = ((float)zlo + 8.f * cqlo) * (sulo * xscale * rstd2), zfh = ((float)zhi + 8.f * cqhi) * (suhi * xscale * rstd2);
            float* ap = AW + (size_t)t * NSEL;
            ap[lane] = gelu_tanh_f(zfl) * glo * svlo; ap[64 + lane] = gelu_tanh_f(zfh) * ghi * svhi;
            if (!has_next) break;
            t = tn; idx0 = idx0n; idx1 = idx1n; sqv = sqn;
#pragma unroll
            for (int j = 0; j < 4; ++j) hraw[j] = hrawn[j];
        }
    }
}
__device__ __forceinline__ void phase_gather_v(const Params& P) {
    const int tid = threadIdx.x, lane = tid & 63, wave = __builtin_amdgcn_readfirstlane(tid >> 6);
    const int gw = blockIdx.x * NWAVES + wave, NGW = gridDim.x * NWAVES;
    unsigned char* ws = P.ws;
    const int* IDX = (const int*)(ws + WS_IDX); const float* AW = (const float*)(ws + WS_AW);
    const __amdgpu_buffer_rsrc_t rsV = __builtin_amdgcn_make_buffer_rsrc((void*)(ws + WS_V8), 0, 16384 * 512, 0x00020000);
    const bf16* H2B = (const bf16*)(ws + WS_H2B);
    const int voff = 8 * lane;
    const unsigned ul = (unsigned)lane;
    int t = gw;
    if (t < NTOK) {
        int idx0, idx1; u32x2 hraw[4]; float alo, ahi;
        { const int* ip = IDX + (size_t)t * NSEL; idx0 = ip[ul]; idx1 = ip[64u + ul];
          const u32x2* hp = (const u32x2*)(H2B + (size_t)t * DM);
#pragma unroll
          for (int j = 0; j < 4; ++j) hraw[j] = hp[64u * j + ul];
          const float* ap = AW + (size_t)t * NSEL; alo = ap[ul]; ahi = ap[64u + ul]; }
        u32x2 R0[16], R1[16], R2[16], R3[16];
        { const int ix0 = idx0 << 9; q_issue(R0, rsV, ix0, 0, voff); q_issue(R1, rsV, ix0, 16, voff); q_issue(R2, rsV, ix0, 32, voff); }
        for (;;) {
            const int tn = t + NGW; const bool has_next = tn < NTOK; const int tl = has_next ? tn : t;
            int idx0n, idx1n; u32x2 hrawn[4]; float alon, ahin;
            { const int* ip = IDX + (size_t)tl * NSEL; idx0n = ip[ul]; idx1n = ip[64u + ul];
              const u32x2* hp = (const u32x2*)(H2B + (size_t)tl * DM);
#pragma unroll
              for (int j = 0; j < 4; ++j) hrawn[j] = hp[64u * j + ul];
              const float* ap = AW + (size_t)tl * NSEL; alon = ap[ul]; ahin = ap[64u + ul]; }
            f32x2 o[8];
#pragma unroll
            for (int j = 0; j < 8; ++j) o[j] = (f32x2){0.f, 0.f};
            const int ix0 = idx0 << 9, ix1 = idx1 << 9;
#pragma unroll 1
            for (int qq = 0; qq < 8; qq += 4) {
                const int ixn = qq ? (idx0n << 9) : ix1;
                q_issue(R3, rsV, qq ? ix1 : ix0, 48, voff);
                q_compute_v(R0, qq, alo, ahi, o);
                q_issue(R0, rsV, ixn, 0, voff);
                q_compute_v(R1, qq + 1, alo, ahi, o);
                q_issue(R1, rsV, ixn, 16, voff);
                q_compute_v(R2, qq + 2, alo, ahi, o);
                q_issue(R2, rsV, ixn, 32, voff);
                q_compute_v(R3, qq + 3, alo, ahi, o);
            }
            float ss = 0.f;
#pragma unroll
            for (int j = 0; j < 4; ++j) { o[2 * j] += (f32x2){bflo(hraw[j].x), bfhi(hraw[j].x)}; o[2 * j + 1] += (f32x2){bflo(hraw[j].y), bfhi(hraw[j].y)}; }
#pragma unroll
            for (int j = 0; j < 8; ++j) ss += o[j].x * o[j].x + o[j].y * o[j].y;
            ss = wave_sum_fast(ss);
            const float r3 = rsqrtf(ss * (1.f / DM) + EPS);
            f32x4* op = (f32x4*)(P.out + (size_t)t * DM);
            const f32x4* gfp = (const f32x4*)P.g_fin;
#pragma unroll
            for (int j = 0; j < 4; ++j) { const f32x4 gv = gfp[64u * j + ul]; op[64u * j + ul] = (f32x4){o[2 * j].x * r3 * gv.x, o[2 * j].y * r3 * gv.y, o[2 * j + 1].x * r3 * gv.z, o[2 * j + 1].y * r3 * gv.w}; }
            if (!has_next) break;
            t = tn; idx0 = idx0n; idx1 = idx1n; alo = alon; ahi = ahin;
#pragma unroll
            for (int j = 0; j < 4; ++j) hraw[j] = hrawn[j];
        }
    }
}

#define XB_TMO      128
#define XB_XCNT(j)  (256  + 64 * (j))
#define XB_XSUB(j)  (1280 + 64 * (j))
#define XB_XGEN(j)  (2304 + 64 * (j))
#define XB_TOP      3328
#define XB_TOPGEN   3392
#define XCD_BAR_WORDS 3456
#define XB_SPIN_CAP (1u << 18)

__device__ __forceinline__ unsigned xb_ld(unsigned* p)              { return __hip_atomic_load(p, __ATOMIC_RELAXED, __HIP_MEMORY_SCOPE_AGENT); }
__device__ __forceinline__ unsigned xb_add(unsigned* p, unsigned v) { return __hip_atomic_fetch_add(p, v, __ATOMIC_RELAXED, __HIP_MEMORY_SCOPE_AGENT); }
__device__ __forceinline__ unsigned xb_xcc_id() { return (unsigned)__builtin_amdgcn_s_getreg((3 << 11) | 20) & 0xFu; }
#define XB_SPIN(cond, bar) do { unsigned _sp = 0; while (cond) { __builtin_amdgcn_s_sleep(1); \
    if ((++_sp & 255u) == 0u) { if (xb_ld(&(bar)[XB_TMO])) break; if (_sp > XB_SPIN_CAP) { atomicAdd(&(bar)[XB_TMO], 1u); break; } } } } while (0)

struct XcdBarrier {
    unsigned* bar; unsigned x;
    volatile LAS unsigned* st;
};

__device__ __forceinline__ XcdBarrier xcd_barrier_post(unsigned* bar, volatile LAS unsigned* st) {
    XcdBarrier b; b.bar = bar; b.x = xb_xcc_id(); b.st = st;
    if (threadIdx.x == 0) (void)xb_add(&bar[XB_XCNT(b.x)], 1u);
    return b;
}
__device__ __forceinline__ void xcd_barrier_complete(unsigned* bar, unsigned x, unsigned& nloc, unsigned& nx) {
    const unsigned G = gridDim.x * gridDim.y * gridDim.z;
    unsigned sum, cnt, mine, sp = 0u;
    for (;;) {
        sum = 0u; cnt = 0u; mine = 0u;
#pragma unroll
        for (unsigned j = 0; j < 16; ++j) { const unsigned c = xb_ld(&bar[XB_XCNT(j)]); sum += c; cnt += (c > 0u) ? 1u : 0u; mine = (j == x) ? c : mine; }
        if (sum == G) break;
        __builtin_amdgcn_s_sleep(1);
        if ((++sp & 255u) == 0u) { if (xb_ld(&bar[XB_TMO])) break; if (sp > XB_SPIN_CAP) { atomicAdd(&bar[XB_TMO], 1u); break; } }
    }
    nloc = mine > 0u ? mine : 1u; nx = cnt > 0u ? cnt : 1u;
}

__device__ __forceinline__ void xcd_barrier(const XcdBarrier& b) {
    asm volatile("s_waitcnt vmcnt(0)" ::: "memory");
    __syncthreads();
    if (threadIdx.x == 0) {
        unsigned* bar = b.bar;
        __builtin_amdgcn_s_waitcnt(0);
        unsigned nloc = b.st[0], nx = b.st[1];
        if (nloc == 0u) { xcd_barrier_complete(bar, b.x, nloc, nx); b.st[0] = nloc; b.st[1] = nx; }
        const unsigned old = xb_add(&bar[XB_XSUB(b.x)], 1u);
        const unsigned gen = old / nloc;
        if (old + 1u == (gen + 1u) * nloc) {
            __builtin_amdgcn_fence(__ATOMIC_RELEASE, "agent");
            asm volatile("s_waitcnt vmcnt(0)" ::: "memory");
            const unsigned og = xb_add(&bar[XB_TOP], 1u);
            const unsigned tg = og / nx;
            if (og + 1u == (tg + 1u) * nx) xb_add(&bar[XB_TOPGEN], 1u);
            else XB_SPIN(xb_ld(&bar[XB_TOPGEN]) == tg, bar);
            __builtin_amdgcn_fence(__ATOMIC_ACQUIRE, "agent");
            xb_add(&bar[XB_XGEN(b.x)], 1u);
            asm volatile("s_waitcnt vmcnt(0)" ::: "memory");
        } else {
            XB_SPIN(xb_ld(&bar[XB_XGEN(b.x)]) == gen, bar);
            __builtin_amdgcn_fence(__ATOMIC_ACQUIRE, "agent");
            asm volatile("s_waitcnt vmcnt(0)" ::: "memory");
        }
    }
    __syncthreads();
}


#ifndef MK_MULTI
#define MK_MULTI 0
#endif
constexpr int NPHASE = 8;
#ifndef REP5
#define REP5 1
#endif
#ifndef REP6
#define REP6 1
#endif
__global__ void __launch_bounds__(NTHREADS, 2) mk_fwd(Params P) {
    extern __shared__ __attribute__((aligned(16))) unsigned char lds_raw[];
    LAS unsigned char* lds = (LAS unsigned char*)lds_raw;
    cg::grid_group grid = cg::this_grid();
    unsigned char* ws = P.ws;
    const int lo = P.ph_lo, hi = P.ph_hi;
    volatile LAS unsigned* bst = (volatile LAS unsigned*)(lds + 131072 + 64);
    if (threadIdx.x < 2) bst[threadIdx.x] = 0u;
    __syncthreads();
    XcdBarrier xbar = xcd_barrier_post((unsigned*)(ws + WS_CTL), bst);
#define IN(k) (lo <= (k) && (k) < hi)
#define SEAM(k) do { if (IN(k) && IN((k) + 1)) { xcd_barrier(xbar); } } while (0)
#ifndef SKIP0
    if (IN(0)) phase_prep(P, lds);
#endif
    SEAM(0);
#ifndef SKIP1
    if (IN(1)) {
        phase_metaproj(P);
        pg8::Gemm g{(const bf16*)(ws + WS_H0B), (const bf16*)(ws + WS_WIN_T), NTOK, DIN, DM}; pg8::StaticOrder S; S.init(NTOK, DIN, (int)gridDim.x, (int)blockIdx.x);
        EpiProj E{(bf16*)(ws + WS_PROJ), (const float*)(ws + WS_RSTD1)};
        pg8::gemm_phase<EpiProj, pg8::StaticOrder, true, true>(lds, g, S, E);
    }
#endif
    SEAM(1);
#ifndef SKIP2
    if (IN(2)) phase_conv(P, lds);
#endif
    SEAM(2);
#ifndef SKIP3
    if (IN(3)) {
        pg8::Gemm g{(const bf16*)(ws + WS_Y), (const bf16*)(ws + WS_WOUT_T), NTOK, DM, DM}; pg8::StaticOrder S; S.init(NTOK, DM, (int)gridDim.x, (int)blockIdx.x);
        EpiResidual E{(bf16*)(ws + WS_H2B), (const bf16*)(ws + WS_H0B), (float*)(ws + WS_SSQ)};
        pg8::gemm_phase<EpiResidual, pg8::StaticOrder, true, true>(lds, g, S, E);
    }
#endif
    SEAM(3);
#ifndef SKIP4
    if (IN(4)) {
        pg8::Gemm g{(const bf16*)(ws + WS_H2B), (const bf16*)(ws + WS_WQ_T), NTOK, 2048, DM}; pg8::StaticOrder S; S.init(NTOK, 2048, (int)gridDim.x, (int)blockIdx.x);
        EpiRowScale<1> E{(bf16*)(ws + WS_Q), 2048, (const float*)(ws + WS_SSQ)};
        pg8::gemm_phase<EpiRowScale<1>, pg8::StaticOrder, true, true>(lds, g, S, E);
    }
#endif
    if (IN(4) && IN(5)) { asm volatile("s_waitcnt vmcnt(0)" ::: "memory"); __syncthreads(); }
#ifndef SKIP5
    if (IN(5)) for (int rep = 0; rep < REP5; ++rep) phase_route(P, lds);
#endif
    SEAM(5);
    if (IN(6)) phase_gather_u(P);
    SEAM(6);
    if (IN(7)) phase_gather_v(P);
#undef IN
#undef SEAM
}

extern "C" void kernel_launch(void* const* d_in, const int* in_sizes, int n_in, void* d_out, int out_size, void* d_ws, size_t ws_size, hipStream_t stream) {
    static int grid = 0;
    if (grid == 0) {
        if (n_in != 18 || in_sizes[0] != NTOK * DM || out_size != NTOK * DM || ws_size < WS_END) {
            fprintf(stderr, "kernel_launch: unexpected shapes (n_in %d in0 %d out %d ws %zu)\n", n_in, n_in > 0 ? in_sizes[0] : -1, out_size, ws_size); grid = -1; return; }
        int dev = 0, cus = 0, per_cu = 0;
        (void)hipGetDevice(&dev); (void)hipDeviceGetAttribute(&cus, hipDeviceAttributeMultiprocessorCount, dev);
        if (hipFuncSetAttribute((const void*)mk_fwd, hipFuncAttributeMaxDynamicSharedMemorySize, LDS_BYTES) != hipSuccess) { fprintf(stderr, "kernel_launch: hipFuncSetAttribute failed\n"); grid = -1; return; }
        if (hipOccupancyMaxActiveBlocksPerMultiprocessor(&per_cu, (const void*)mk_fwd, NTHREADS, LDS_BYTES) != hipSuccess || per_cu < 1) { fprintf(stderr, "kernel_launch: occupancy query failed (%d)\n", per_cu); (void)hipGetLastError(); per_cu = 1; }
        if (per_cu > 1) per_cu = 1;
        grid = cus * per_cu;
        if (grid <= 0) grid = 256;
    }
    if (grid < 0) return;
    Params p{};
    p.x = (const float*)d_in[0]; p.meta = (const float*)d_in[1]; p.g_mix = (const float*)d_in[2]; p.w_in = (const float*)d_in[3]; p.sc_w = (const float*)d_in[4];
    p.cf_w = (const float*)d_in[5]; p.cf_b = (const float*)d_in[6]; p.ln_g = (const float*)d_in[7]; p.ln_b = (const float*)d_in[8]; p.g_sc = (const float*)d_in[9];
    p.g_cf = (const float*)d_in[10]; p.w_out = (const float*)d_in[11]; p.g_ffn = (const float*)d_in[12]; p.w_q = (const float*)d_in[13]; p.keys = (const float*)d_in[14];
    p.pu = (const float*)d_in[15]; p.pv = (const float*)d_in[16]; p.g_fin = (const float*)d_in[17];
    p.out = (float*)d_out; p.ws = (unsigned char*)d_ws;
    (void)hipMemsetAsync((char*)d_ws + WS_CTL, 0, 16384, stream);
#if MK_MULTI
    for (int ph = 0; ph < NPHASE; ++ph) { p.ph_lo = ph; p.ph_hi = ph + 1; p.coop = 0; p.pad = 0;
        hipLaunchKernelGGL(mk_fwd, dim3(grid), dim3(NTHREADS), LDS_BYTES, stream, p); }
#else
    p.ph_lo = 0; p.ph_hi = NPHASE; p.coop = 1; p.pad = 0;
    void* args[] = {&p};
    hipError_t e = hipLaunchCooperativeKernel((const void*)mk_fwd, dim3(grid), dim3(NTHREADS), args, LDS_BYTES, stream);
    if (e != hipSuccess) fprintf(stderr, "cooperative launch failed: %s (grid %d)\n", hipGetErrorString(e), grid);
#endif
}
```

```cpp
#include <hip/hip_runtime.h>
#include <hip/hip_cooperative_groups.h>
#include <cstdio>
#include <cstdint>
namespace cg = cooperative_groups;

namespace pg8 {
#define PG8_LAS __attribute__((address_space(3)))
typedef unsigned short bf16_t;
typedef short bf16x8 __attribute__((ext_vector_type(8)));
typedef float f32x4 __attribute__((ext_vector_type(4)));
typedef unsigned u32x4 __attribute__((ext_vector_type(4)));
typedef int i32x4 __attribute__((ext_vector_type(4)));
constexpr int BM = 256, BK = 64, HALF = 128, HTB = HALF * BK * 2  , STAGE_BYTES = 8 * HTB, NXCD = 8, WGM = 8;

__host__ __device__ __forceinline__ int lds_byte(int r, int c) { const int st = (r >> 4) * 2 + (c >> 5), rr = r & 15, cc = c & 31, ob = rr * 64 + cc * 2; return st * 1024 + (ob ^ (((ob >> 9) & 1) << 5)); }
__host__ __device__ __forceinline__ void stage_rc(int b, int& R, int& C) { const int st = b / 1024, sb = b % 1024, swz = sb ^ (((sb >> 9) & 1) << 5); R = (st >> 1) * 16 + swz / 64; C = (st & 1) * 32 + (swz % 64) / 2; }
__host__ __device__ __forceinline__ int perm32(int rho) { const int n = rho >> 4, i = rho & 15; return 8 * (i >> 2) + 4 * n + (i & 3); }

struct Unit { int pm, pn; };
struct Gemm { const bf16_t* A; const bf16_t* Bt; int M, N, K; };

struct StaticOrder {
    int nM, nN, nwg, G, c;
    __host__ __device__ void init(int M, int N, int G_, int c_) { nM = M / BM; nN = N / BM; nwg = nM * nN; G = G_; c = c_; }
    __host__ __device__ bool next(int i, Unit& u) const {
        const long L = (long)i * G + c; if (L >= nwg) return false;
        int wgid = (int)L; { const int q = nwg / NXCD, r = nwg % NXCD, xcd = wgid % NXCD, off = wgid / NXCD; wgid = (xcd < r ? xcd * (q + 1) : r * (q + 1) + (xcd - r) * q) + off; }
        const int nig = WGM * nN, gid = wgid / nig, fm = gid * WGM, gsz = (nM - fm) < WGM ? (nM - fm) : WGM;
        u.pm = fm + ((wgid % nig) % gsz); u.pn = (wgid % nig) / gsz; return true;
    }
    __device__ __forceinline__ void a_ready(const Unit&) const {}
    __device__ __forceinline__ void done(const Unit&) const {}
};

template <class Epi, class Sched, bool ALIGN_EPI = false, bool SP2 = false>
__device__ __forceinline__ void gemm_phase(PG8_LAS unsigned char* lds, const Gemm g, const Sched& S, const Epi& E) {
    const int tid = threadIdx.x, wid = __builtin_amdgcn_readfirstlane(tid >> 6), lane = tid & 63, wr = wid >> 2, wc = wid & 3, fr = lane & 15, fq = lane >> 4;
    const int K = g.K, nt = K / BK;
    unsigned voffA[2], voffB[2];
#pragma unroll
    for (int i = 0; i < 2; ++i) { int R, C; stage_rc(tid * 16 + i * 8192, R, C); const int Rb = Epi::PERM ? ((R & ~31) + perm32(R & 31)) : R;
        voffA[i] = (unsigned)(R * K + C) * 2u; voffB[i] = (unsigned)(Rb * K + C) * 2u; }
    const size_t kstep = (size_t)(BK * 2);
    const size_t hstep = (size_t)HALF * K * 2;
    const size_t tstep = 2 * hstep;
    const unsigned ldsw = (unsigned)wid * 1024u;
    const int aoff = lds_byte(wr * 64 + fr, fq * 8), boff = lds_byte(wc * 32 + fr, fq * 8);
#define PG8_SA(b, h) (((b) * 2 + (h)) * HTB)
#define PG8_SB(b, h) ((4 + (b) * 2 + (h)) * HTB)
#define PG8_STAGE(bufoff, gbase, voff) do { _Pragma("unroll") for (int _i = 0; _i < 2; ++_i) \
        __builtin_amdgcn_global_load_lds((const unsigned*)((const char*)(gbase) + (voff)[_i]), (PG8_LAS unsigned*)(lds + (bufoff) + ldsw + _i * 8192), 16, 0, 0); } while (0)
#define PG8_LDA(dst, b, h) do { _Pragma("unroll") for (int m = 0; m < 4; ++m) _Pragma("unroll") for (int k = 0; k < 2; ++k) dst[m][k] = *(const PG8_LAS bf16x8*)(lds + PG8_SA(b, h) + aoff + m * 2048 + k * 1024); } while (0)
#define PG8_LDB(dst, b, h) do { _Pragma("unroll") for (int n = 0; n < 2; ++n) _Pragma("unroll") for (int k = 0; k < 2; ++k) dst[n][k] = *(const PG8_LAS bf16x8*)(lds + PG8_SB(b, h) + boff + n * 2048 + k * 1024); } while (0)
#define PG8_MMA(ai, bj, At, Bt) do { __builtin_amdgcn_s_setprio(1); _Pragma("unroll") for (int m = 0; m < 4; ++m) _Pragma("unroll") for (int n = 0; n < 2; ++n) _Pragma("unroll") for (int k = 0; k < 2; ++k) \
        acc[ai][bj][m][n] = __builtin_amdgcn_mfma_f32_16x16x32_bf16(Bt[n][k], At[m][k], acc[ai][bj][m][n], 0, 0, 0); __builtin_amdgcn_s_setprio(0); } while (0)
#define PG8_WAIT_V(n) asm volatile("s_waitcnt vmcnt(" #n ")" ::: "memory")
#define PG8_WAIT_L(n) asm volatile("s_waitcnt lgkmcnt(" #n ")" ::: "memory")
#define PG8_BAR __builtin_amdgcn_s_barrier()
#define PG8_SCHED __builtin_amdgcn_sched_barrier(0)
    Unit cur, nxt; int ui = 0;
    if (!S.next(0, cur)) return;
    f32x4 acc[2][2][4][2];
#pragma unroll
    for (int a = 0; a < 2; ++a)
#pragma unroll
        for (int b = 0; b < 2; ++b)
#pragma unroll
            for (int m = 0; m < 4; ++m)
#pragma unroll
                for (int n = 0; n < 2; ++n) acc[a][b][m][n] = (f32x4){0.f, 0.f, 0.f, 0.f};
    bf16x8 At[4][2], B0[2][2], B1[2][2];
    const char* cA = (const char*)g.A + (size_t)cur.pm * tstep; const char* cB = (const char*)g.Bt + (size_t)cur.pn * tstep;
    S.a_ready(cur);
    if constexpr (SP2) {
        PG8_STAGE(PG8_SB(0, 0), cB, voffB); PG8_STAGE(PG8_SB(0, 1), cB + hstep, voffB); PG8_STAGE(PG8_SA(0, 0), cA, voffA); PG8_STAGE(PG8_SA(0, 1), cA + hstep, voffA);
        if (wr == 1) PG8_BAR;
        PG8_WAIT_V(2); PG8_BAR;
        PG8_STAGE(PG8_SB(1, 0), cB + kstep, voffB); PG8_STAGE(PG8_SA(1, 0), cA + kstep, voffA); PG8_STAGE(PG8_SB(1, 1), cB + hstep + kstep, voffB);
        PG8_WAIT_V(6); PG8_BAR;
    } else {
        PG8_STAGE(PG8_SB(0, 0), cB, voffB); PG8_STAGE(PG8_SA(0, 0), cA, voffA); PG8_STAGE(PG8_SB(0, 1), cB + hstep, voffB); PG8_STAGE(PG8_SA(0, 1), cA + hstep, voffA);
        if (wr == 1) PG8_BAR;
        PG8_WAIT_V(4); PG8_BAR;
        PG8_STAGE(PG8_SB(1, 0), cB + kstep, voffB); PG8_STAGE(PG8_SA(1, 0), cA + kstep, voffA); PG8_STAGE(PG8_SB(1, 1), cB + hstep + kstep, voffB);
        PG8_WAIT_V(6); PG8_BAR;
    }
    for (;;) {
        const bool has_next = S.next(ui + 1, nxt);
        const char* nA = has_next ? (const char*)g.A + (size_t)nxt.pm * tstep : cA; const char* nB = has_next ? (const char*)g.Bt + (size_t)nxt.pn * tstep : cB;
        for (int t = 0; t < nt; t += 2) {
            const bool last = (t == nt - 2);
            const char* a1 = cA + (size_t)(t + 1) * kstep;
            const char* a2 = last ? nA : cA + (size_t)(t + 2) * kstep; const char* b2 = last ? nB : cB + (size_t)(t + 2) * kstep;
            const char* a3 = a2 + kstep; const char* b3 = b2 + kstep;
            if (last && has_next) S.a_ready(nxt);
            if constexpr (SP2) {
            PG8_LDB(B0, 0, 0); PG8_LDB(B1, 0, 1); PG8_SCHED; PG8_LDA(At, 0, 0); PG8_STAGE(PG8_SA(1, 1), a1 + hstep, voffA);
            PG8_WAIT_V(8); PG8_WAIT_L(0); PG8_BAR; PG8_MMA(0, 0, At, B0); PG8_MMA(0, 1, At, B1); PG8_BAR; PG8_SCHED;
            PG8_LDA(At, 0, 1); PG8_STAGE(PG8_SB(0, 0), b2, voffB); PG8_STAGE(PG8_SB(0, 1), b2 + hstep, voffB); PG8_STAGE(PG8_SA(0, 0), a2, voffA);
            PG8_WAIT_V(8); PG8_WAIT_L(0); PG8_BAR; PG8_MMA(1, 0, At, B0); PG8_MMA(1, 1, At, B1); PG8_BAR; PG8_SCHED;
            PG8_LDB(B0, 1, 0); PG8_LDB(B1, 1, 1); PG8_SCHED; PG8_LDA(At, 1, 0); PG8_STAGE(PG8_SA(0, 1), a2 + hstep, voffA);
            PG8_WAIT_V(8); PG8_WAIT_L(0); PG8_BAR; PG8_MMA(0, 0, At, B0); PG8_MMA(0, 1, At, B1); PG8_BAR; PG8_SCHED;
            PG8_LDA(At, 1, 1); PG8_STAGE(PG8_SB(1, 0), b3, voffB); PG8_STAGE(PG8_SB(1, 1), b3 + hstep, voffB); PG8_STAGE(PG8_SA(1, 0), a3, voffA);
            PG8_WAIT_V(8); PG8_WAIT_L(0); PG8_BAR; PG8_MMA(1, 0, At, B0); PG8_MMA(1, 1, At, B1); PG8_BAR; PG8_SCHED;
            } else {
            PG8_LDB(B0, 0, 0); PG8_SCHED; PG8_LDA(At, 0, 0); PG8_STAGE(PG8_SA(1, 1), a1 + hstep, voffA);
            PG8_WAIT_L(8); PG8_BAR; PG8_WAIT_L(0); PG8_MMA(0, 0, At, B0); PG8_BAR; PG8_SCHED;
            PG8_LDB(B1, 0, 1); PG8_STAGE(PG8_SB(0, 0), b2, voffB);
            PG8_BAR; PG8_WAIT_L(0); PG8_MMA(0, 1, At, B1); PG8_BAR;
            PG8_LDA(At, 0, 1); PG8_STAGE(PG8_SA(0, 0), a2, voffA);
            PG8_BAR; PG8_WAIT_L(0); PG8_MMA(1, 0, At, B0); PG8_BAR; PG8_SCHED;
            PG8_STAGE(PG8_SB(0, 1), b2 + hstep, voffB);
            PG8_WAIT_V(6); PG8_BAR; PG8_MMA(1, 1, At, B1); PG8_BAR;
            PG8_LDB(B0, 1, 0); PG8_SCHED; PG8_LDA(At, 1, 0); PG8_STAGE(PG8_SA(0, 1), a2 + hstep, voffA);
            PG8_WAIT_L(8); PG8_BAR; PG8_WAIT_L(0); PG8_MMA(0, 0, At, B0); PG8_BAR; PG8_SCHED;
            PG8_LDB(B1, 1, 1); PG8_STAGE(PG8_SB(1, 0), b3, voffB);
            PG8_BAR; PG8_WAIT_L(0); PG8_MMA(0, 1, At, B1); PG8_BAR;
            PG8_LDA(At, 1, 1); PG8_STAGE(PG8_SA(1, 0), a3, voffA);
            PG8_BAR; PG8_WAIT_L(0); PG8_MMA(1, 0, At, B0); PG8_BAR; PG8_SCHED;
            PG8_STAGE(PG8_SB(1, 1), b3 + hstep, voffB);
            PG8_WAIT_V(6); PG8_BAR; PG8_MMA(1, 1, At, B1); PG8_BAR;
            }
        }
        if constexpr (ALIGN_EPI) { if (wr == 0) PG8_BAR; }
        if constexpr (!Epi::AFTER_DRAIN) { E(acc, cur, wr, wc, fr, fq); S.done(cur); }
        if (!has_next) break;
#pragma unroll
        for (int a = 0; a < 2; ++a)
#pragma unroll
            for (int b = 0; b < 2; ++b)
#pragma unroll
                for (int m = 0; m < 4; ++m)
#pragma unroll
                    for (int n = 0; n < 2; ++n) acc[a][b][m][n] = (f32x4){0.f, 0.f, 0.f, 0.f};
        cur = nxt; cA = nA; cB = nB; ++ui;
        if constexpr (ALIGN_EPI) { if (wr == 1) PG8_BAR; }
    }
    PG8_WAIT_V(0);
    if constexpr (!ALIGN_EPI) { if (wr == 0) PG8_BAR; }
    PG8_BAR;
    if constexpr (Epi::AFTER_DRAIN) { E.fused(acc, cur, wr, wc, fr, fq, lds, wid, lane); S.done(cur); }
#undef PG8_SA
#undef PG8_SB
#undef PG8_STAGE
#undef PG8_LDA
#undef PG8_LDB
#undef PG8_MMA
#undef PG8_WAIT_V
#undef PG8_WAIT_L
#undef PG8_BAR
#undef PG8_SCHED
}
template <class Epi, class Sched, bool ALIGN_EPI = false, bool SP2 = false>
__device__ __forceinline__ void gemm_phase_i8(PG8_LAS unsigned char* lds, const Gemm g, const Sched& S, const Epi& E) {
    const int tid = threadIdx.x, wid = __builtin_amdgcn_readfirstlane(tid >> 6), lane = tid & 63, wr = wid >> 2, wc = wid & 3, fr = lane & 15, fq = lane >> 4;
    const int K = g.K, nt = K / BK;
    unsigned voffA[2], voffB[2];
#pragma unroll
    for (int i = 0; i < 2; ++i) { int R, C; stage_rc(tid * 16 + i * 8192, R, C); const int Rb = Epi::PERM ? ((R & ~31) + perm32(R & 31)) : R;
        voffA[i] = (unsigned)(R * K + C) * 2u; voffB[i] = (unsigned)(Rb * K + C) * 2u; }
    const size_t kstep = (size_t)(BK * 2);
    const size_t hstep = (size_t)HALF * K * 2;
    const size_t tstep = 2 * hstep;
    const unsigned ldsw = (unsigned)wid * 1024u;
    const int aoff = lds_byte(wr * 64 + fr, fq * 8), boff = lds_byte(wc * 32 + fr, fq * 8);
#define PG8_SA(b, h) (((b) * 2 + (h)) * HTB)
#define PG8_SB(b, h) ((4 + (b) * 2 + (h)) * HTB)
#define PG8_STAGE(bufoff, gbase, voff) do { _Pragma("unroll") for (int _i = 0; _i < 2; ++_i) \
        __builtin_amdgcn_global_load_lds((const unsigned*)((const char*)(gbase) + (voff)[_i]), (PG8_LAS unsigned*)(lds + (bufoff) + ldsw + _i * 8192), 16, 0, 0); } while (0)
#define PG8_LDA(dst, b, h) do { _Pragma("unroll") for (int m = 0; m < 4; ++m) _Pragma("unroll") for (int k = 0; k < 2; ++k) dst[m][k] = *(const PG8_LAS bf16x8*)(lds + PG8_SA(b, h) + aoff + m * 2048 + k * 1024); } while (0)
#define PG8_LDB(dst, b, h) do { _Pragma("unroll") for (int n = 0; n < 2; ++n) _Pragma("unroll") for (int k = 0; k < 2; ++k) dst[n][k] = *(const PG8_LAS bf16x8*)(lds + PG8_SB(b, h) + boff + n * 2048 + k * 1024); } while (0)
#define PG8_MMA(ai, bj, At, Bt) do { __builtin_amdgcn_s_setprio(1); _Pragma("unroll") for (int m = 0; m < 4; ++m) _Pragma("unroll") for (int n = 0; n < 2; ++n) _Pragma("unroll") for (int k = 0; k < 2; ++k) \
        acc[ai][bj][m][n] = __builtin_amdgcn_mfma_i32_16x16x64_i8(__builtin_bit_cast(i32x4, Bt[n][k]), __builtin_bit_cast(i32x4, At[m][k]), acc[ai][bj][m][n], 0, 0, 0); __builtin_amdgcn_s_setprio(0); } while (0)
#define PG8_WAIT_V(n) asm volatile("s_waitcnt vmcnt(" #n ")" ::: "memory")
#define PG8_WAIT_L(n) asm volatile("s_waitcnt lgkmcnt(" #n ")" ::: "memory")
#define PG8_BAR __builtin_amdgcn_s_barrier()
#define PG8_SCHED __builtin_amdgcn_sched_barrier(0)
    Unit cur, nxt; int ui = 0;
    if (!S.next(0, cur)) return;
    i32x4 acc[2][2][4][2];
#pragma unroll
    for (int a = 0; a < 2; ++a)
#pragma unroll
        for (int b = 0; b < 2; ++b)
#pragma unroll
            for (int m = 0; m < 4; ++m)
#pragma unroll
                for (int n = 0; n < 2; ++n) acc[a][b][m][n] = (i32x4){0, 0, 0, 0};
    bf16x8 At[4][2], B0[2][2], B1[2][2];
    const char* cA = (const char*)g.A + (size_t)cur.pm * tstep; const char* cB = (const char*)g.Bt + (size_t)cur.pn * tstep;
    S.a_ready(cur);
    if constexpr (SP2) {
        PG8_STAGE(PG8_SB(0, 0), cB, voffB); PG8_STAGE(PG8_SB(0, 1), cB + hstep, voffB); PG8_STAGE(PG8_SA(0, 0), cA, voffA); PG8_STAGE(PG8_SA(0, 1), cA + hstep, voffA);
        if (wr == 1) PG8_BAR;
        PG8_WAIT_V(2); PG8_BAR;
        PG8_STAGE(PG8_SB(1, 0), cB + kstep, voffB); PG8_STAGE(PG8_SA(1, 0), cA + kstep, voffA); PG8_STAGE(PG8_SB(1, 1), cB + hstep + kstep, voffB);
        PG8_WAIT_V(6); PG8_BAR;
    } else {
        PG8_STAGE(PG8_SB(0, 0), cB, voffB); PG8_STAGE(PG8_SA(0, 0), cA, voffA); PG8_STAGE(PG8_SB(0, 1), cB + hstep, voffB); PG8_STAGE(PG8_SA(0, 1), cA + hstep, voffA);
        if (wr == 1) PG8_BAR;
        PG8_WAIT_V(4); PG8_BAR;
        PG8_STAGE(PG8_SB(1, 0), cB + kstep, voffB); PG8_STAGE(PG8_SA(1, 0), cA + kstep, voffA); PG8_STAGE(PG8_SB(1, 1), cB + hstep + kstep, voffB);
        PG8_WAIT_V(6); PG8_BAR;
    }
    for (;;) {
        const bool has_next = S.next(ui + 1, nxt);
        const char* nA = has_next ? (const char*)g.A + (size_t)nxt.pm * tstep : cA; const char* nB = has_next ? (const char*)g.Bt + (size_t)nxt.pn * tstep : cB;
        for (int t = 0; t < nt; t += 2) {
            const bool last = (t == nt - 2);
            const char* a1 = cA + (size_t)(t + 1) * kstep;
            const char* a2 = last ? nA : cA + (size_t)(t + 2) * kstep; const char* b2 = last ? nB : cB + (size_t)(t + 2) * kstep;
            const char* a3 = a2 + kstep; const char* b3 = b2 + kstep;
            if (last && has_next) S.a_ready(nxt);
            if constexpr (SP2) {
            PG8_LDB(B0, 0, 0); PG8_LDB(B1, 0, 1); PG8_SCHED; PG8_LDA(At, 0, 0); PG8_STAGE(PG8_SA(1, 1), a1 + hstep, voffA);
            PG8_WAIT_V(8); PG8_WAIT_L(0); PG8_BAR; PG8_MMA(0, 0, At, B0); PG8_MMA(0, 1, At, B1); PG8_BAR; PG8_SCHED;
            PG8_LDA(At, 0, 1); PG8_STAGE(PG8_SB(0, 0), b2, voffB); PG8_STAGE(PG8_SB(0, 1), b2 + hstep, voffB); PG8_STAGE(PG8_SA(0, 0), a2, voffA);
            PG8_WAIT_V(8); PG8_WAIT_L(0); PG8_BAR; PG8_MMA(1, 0, At, B0); PG8_MMA(1, 1, At, B1); PG8_BAR; PG8_SCHED;
            PG8_LDB(B0, 1, 0); PG8_LDB(B1, 1, 1); PG8_SCHED; PG8_LDA(At, 1, 0); PG8_STAGE(PG8_SA(0, 1), a2 + hstep, voffA);
            PG8_WAIT_V(8); PG8_WAIT_L(0); PG8_BAR; PG8_MMA(0, 0, At, B0); PG8_MMA(0, 1, At, B1); PG8_BAR; PG8_SCHED;
            PG8_LDA(At, 1, 1); PG8_STAGE(PG8_SB(1, 0), b3, voffB); PG8_STAGE(PG8_SB(1, 1), b3 + hstep, voffB); PG8_STAGE(PG8_SA(1, 0), a3, voffA);
            PG8_WAIT_V(8); PG8_WAIT_L(0); PG8_BAR; PG8_MMA(1, 0, At, B0); PG8_MMA(1, 1, At, B1); PG8_BAR; PG8_SCHED;
            } else {
            PG8_LDB(B0, 0, 0); PG8_SCHED; PG8_LDA(At, 0, 0); PG8_STAGE(PG8_SA(1, 1), a1 + hstep, voffA);
            PG8_WAIT_L(8); PG8_BAR; PG8_WAIT_L(0); PG8_MMA(0, 0, At, B0); PG8_BAR; PG8_SCHED;
            PG8_LDB(B1, 0, 1); PG8_STAGE(PG8_SB(0, 0), b2, voffB);
            PG8_BAR; PG8_WAIT_L(0); PG8_MMA(0, 1, At, B1); PG8_BAR;
            PG8_LDA(At, 0, 1); PG8_STAGE(PG8_SA(0, 0), a2, voffA);
            PG8_BAR; PG8_WAIT_L(0); PG8_MMA(1, 0, At, B0); PG8_BAR; PG8_SCHED;
            PG8_STAGE(PG8_SB(0, 1), b2 + hstep, voffB);
            PG8_WAIT_V(6); PG8_BAR; PG8_MMA(1, 1, At, B1); PG8_BAR;
            PG8_LDB(B0, 1, 0); PG8_SCHED; PG8_LDA(At, 1, 0); PG8_STAGE(PG8_SA(0, 1), a2 + hstep, voffA);
            PG8_WAIT_L(8); PG8_BAR; PG8_WAIT_L(0); PG8_MMA(0, 0, At, B0); PG8_BAR; PG8_SCHED;
            PG8_LDB(B1, 1, 1); PG8_STAGE(PG8_SB(1, 0), b3, voffB);
            PG8_BAR; PG8_WAIT_L(0); PG8_MMA(0, 1, At, B1); PG8_BAR;
            PG8_LDA(At, 1, 1); PG8_STAGE(PG8_SA(1, 0), a3, voffA);
            PG8_BAR; PG8_WAIT_L(0); PG8_MMA(1, 0, At, B0); PG8_BAR; PG8_SCHED;
            PG8_STAGE(PG8_SB(1, 1), b3 + hstep, voffB);
            PG8_WAIT_V(6); PG8_BAR; PG8_MMA(1, 1, At, B1); PG8_BAR;
            }
        }
        if constexpr (ALIGN_EPI) { if (wr == 0) PG8_BAR; }
        if constexpr (!Epi::AFTER_DRAIN) { E(acc, cur, wr, wc, fr, fq); S.done(cur); }
        if (!has_next) break;
#pragma unroll
        for (int a = 0; a < 2; ++a)
#pragma unroll
            for (int b = 0; b < 2; ++b)
#pragma unroll
                for (int m = 0; m < 4; ++m)
#pragma unroll
                    for (int n = 0; n < 2; ++n) acc[a][b][m][n] = (i32x4){0, 0, 0, 0};
        cur = nxt; cA = nA; cB = nB; ++ui;
        if constexpr (ALIGN_EPI) { if (wr == 1) PG8_BAR; }
    }
    PG8_WAIT_V(0);
    if constexpr (!ALIGN_EPI) { if (wr == 0) PG8_BAR; }
    PG8_BAR;
    if constexpr (Epi::AFTER_DRAIN) { E.fused(acc, cur, wr, wc, fr, fq, lds, wid, lane); S.done(cur); }
#undef PG8_SA
#undef PG8_SB
#undef PG8_STAGE
#undef PG8_LDA
#undef PG8_LDB
#undef PG8_MMA
#undef PG8_WAIT_V
#undef PG8_WAIT_L
#undef PG8_BAR
#undef PG8_SCHED
}
}

#define LAS __attribute__((address_space(3)))
typedef unsigned short bf16;
typedef float f32x2 __attribute__((ext_vector_type(2)));
typedef float f32x4 __attribute__((ext_vector_type(4)));
typedef unsigned u32x2 __attribute__((ext_vector_type(2)));
typedef unsigned u32x4 __attribute__((ext_vector_type(4)));

constexpr int PDIM = 1536;
constexpr int NTOK = 32768, DM = 1024, DIN = 2560, SEQ = 8192, NBATCH = 4, NMETA = 16;
constexpr int NHEAD = 8, NKEYS = 128, TOPK = 16, NSEL = NHEAD * TOPK;
constexpr float EPS = 1e-6f;
constexpr float U_SCALE = 64.f, V_SCALE = 16.f;
constexpr float U4_CLIP = 2.6f;
constexpr int NWAVES = 8, NTHREADS = 512;
constexpr int MKC = 32;
constexpr int LDS_BYTES = 147456;

constexpr size_t MiB = 1u << 20;
constexpr size_t WS_CTL = 0, WS_WIN_T = 1 * MiB, WS_WOUT_T = 6 * MiB, WS_WQ_T = 8 * MiB, WS_KEYS = 12 * MiB, WS_METAPART = 160 * MiB  ,
                 WS_METARSTD = 14 * MiB + 512 * 1024, WS_METAPROJ = 14 * MiB + 576 * 1024, WS_RSTD1 = 15 * MiB, WS_SSQ = 16 * MiB, WS_U8 = 32 * MiB, WS_V8 = 48 * MiB,
                 WS_IDX = 64 * MiB, WS_GATE = 80 * MiB, WS_H0B = 96 * MiB, WS_H2B = 96 * MiB, WS_Y = 160 * MiB, WS_PROJ = 224 * MiB,
                 WS_Q = 224 * MiB, WS_ESCALE = 18 * MiB, WS_SUMQ = 19 * MiB, WS_SX = 20 * MiB, WS_SW = 21 * MiB, WS_H0I8 = 384 * MiB, WS_AW = 160 * MiB  , WS_END = 416 * MiB;

struct Params {
    const float* x; const float* meta; const float* g_mix; const float* w_in; const float* sc_w; const float* cf_w; const float* cf_b;
    const float* ln_g; const float* ln_b; const float* g_sc; const float* g_cf; const float* w_out; const float* g_ffn; const float* w_q;
    const float* keys; const float* pu; const float* pv; const float* g_fin;
    float* out; unsigned char* ws;
    int ph_lo, ph_hi, coop, pad;
};

__device__ __forceinline__ unsigned f2bf(float f) { unsigned u = __builtin_bit_cast(unsigned, f); return (u + 0x7fffu + ((u >> 16) & 1u)) >> 16; }
__device__ __forceinline__ unsigned pk2(float lo, float hi) { return f2bf(lo) | (f2bf(hi) << 16); }
__device__ __forceinline__ float bf2f(unsigned b) { return __builtin_bit_cast(float, b << 16); }
__device__ __forceinline__ float bflo(unsigned w) { return __builtin_bit_cast(float, w << 16); }
__device__ __forceinline__ float bfhi(unsigned w) { return __builtin_bit_cast(float, w & 0xffff0000u); }
__device__ __forceinline__ float wave_sum(float v) {
#pragma unroll
    for (int o = 1; o < 64; o <<= 1) v += __shfl_xor(v, o);
    return v;
}
template <int CTRL> __device__ __forceinline__ float dpp_f(float v) { return __builtin_bit_cast(float, __builtin_amdgcn_update_dpp(0, __builtin_bit_cast(int, v), CTRL, 0xf, 0xf, true)); }
__device__ __forceinline__ float wave_sum_fast(float v) {
    v += dpp_f<0xB1>(v); v += dpp_f<0x4E>(v); v += dpp_f<0x141>(v); v += dpp_f<0x140>(v);
    { auto r = __builtin_amdgcn_permlane16_swap(__float_as_uint(v), __float_as_uint(v), false, false); v = __uint_as_float(r[0]) + __uint_as_float(r[1]); }
    { auto r = __builtin_amdgcn_permlane32_swap(__float_as_uint(v), __float_as_uint(v), false, false); v = __uint_as_float(r[0]) + __uint_as_float(r[1]); }
    return v;
}
__device__ __forceinline__ float wave_max_fast(float v) {
    v = fmaxf(v, dpp_f<0xB1>(v)); v = fmaxf(v, dpp_f<0x4E>(v)); v = fmaxf(v, dpp_f<0x141>(v)); v = fmaxf(v, dpp_f<0x140>(v));
    { auto r = __builtin_amdgcn_permlane16_swap(__float_as_uint(v), __float_as_uint(v), false, false); v = fmaxf(__uint_as_float(r[0]), __uint_as_float(r[1])); }
    { auto r = __builtin_amdgcn_permlane32_swap(__float_as_uint(v), __float_as_uint(v), false, false); v = fmaxf(__uint_as_float(r[0]), __uint_as_float(r[1])); }
    return v;
}
__device__ __forceinline__ float sigmoid_f(float x) { return 1.f / (1.f + __expf(-x)); }
__device__ __forceinline__ float gelu_tanh_f(float x) {
    const float t = 0.7978845608028654f * (x + 0.044715f * x * x * x);
    const float e = __expf(2.f * t);
    const float th = 1.f - 2.f / (e + 1.f);
    return 0.5f * x * (1.f + th);
}

__device__ __forceinline__ unsigned cvt_pk_bf16(float lo, float hi) { unsigned r; asm volatile("v_cvt_pk_bf16_f32 %0, %1, %2" : "=v"(r) : "v"(lo), "v"(hi)); return r; }

template <int MODE> struct EpiRowScale {
    static constexpr bool PERM = true, AFTER_DRAIN = false;
    bf16* O; int ldc; const float* rs;
    __device__ __forceinline__ void operator()(const pg8::f32x4 (&acc)[2][2][4][2], const pg8::Unit& u, int wr, int wc, int fr, int fq) const {
        const int row0 = u.pm * 256 + wr * 64 + fr, col0 = u.pn * 256 + wc * 32 + 8 * fq;
#pragma unroll
        for (int ai = 0; ai < 2; ++ai)
#pragma unroll
            for (int m = 0; m < 4; ++m) {
                const int row = row0 + ai * 128 + m * 16;
                float s;
                if (MODE == 0) s = rs[row];
                else { const f32x4* p = (const f32x4*)(rs + (size_t)row * 16); const f32x4 a = p[0], b = p[1], c = p[2], d = p[3];
                       const float t = ((a.x + a.y) + (a.z + a.w)) + ((b.x + b.y) + (b.z + b.w)) + ((c.x + c.y) + (c.z + c.w)) + ((d.x + d.y) + (d.z + d.w));
                       s = rsqrtf(t * (1.f / 1024.f) + EPS); }
                bf16* rowp = O + (size_t)row * ldc + col0;
#pragma unroll
                for (int bj = 0; bj < 2; ++bj) { const pg8::f32x4 v0 = acc[ai][bj][m][0] * s, v1 = acc[ai][bj][m][1] * s;
                    u32x4 w; w.x = cvt_pk_bf16(v0[0], v0[1]); w.y = cvt_pk_bf16(v0[2], v0[3]); w.z = cvt_pk_bf16(v1[0], v1[1]); w.w = cvt_pk_bf16(v1[2], v1[3]);
                    *(u32x4*)(rowp + bj * 128) = w; }
            }
    }
};
struct EpiProj {
    static constexpr bool PERM = true, AFTER_DRAIN = false;
    bf16* O; const float* rs;
    __device__ __forceinline__ void operator()(const pg8::f32x4 (&acc)[2][2][4][2], const pg8::Unit& u, int wr, int wc, int fr, int fq) const {
        const int row0 = u.pm * 256 + wr * 64 + fr, cin = wc * 32 + 8 * fq, pn = u.pn;
#pragma unroll
        for (int ai = 0; ai < 2; ++ai)
#pragma unroll
            for (int m = 0; m < 4; ++m) {
                const int row = row0 + ai * 128 + m * 16; const float sc = rs[row];
                float a[8], b[8];
#pragma unroll
                for (int i = 0; i < 4; ++i) { a[i] = acc[ai][0][m][0][i] * sc; a[4 + i] = acc[ai][0][m][1][i] * sc; b[i] = acc[ai][1][m][0][i] * sc; b[4 + i] = acc[ai][1][m][1][i] * sc; }
                bf16* rowp = O + (size_t)row * PDIM;
                if (pn >= 4 && pn < 6) {
                    u32x4 w0, w1; w0.x = cvt_pk_bf16(a[0], a[1]); w0.y = cvt_pk_bf16(a[2], a[3]); w0.z = cvt_pk_bf16(a[4], a[5]); w0.w = cvt_pk_bf16(a[6], a[7]);
                    w1.x = cvt_pk_bf16(b[0], b[1]); w1.y = cvt_pk_bf16(b[2], b[3]); w1.z = cvt_pk_bf16(b[4], b[5]); w1.w = cvt_pk_bf16(b[6], b[7]);
                    *(u32x4*)(rowp + 512 + 256 * (pn - 4) + cin) = w0; *(u32x4*)(rowp + 512 + 256 * (pn - 4) + 128 + cin) = w1;
                } else {
                    float o[8];
                    if (pn < 4) {
#pragma unroll
                        for (int i = 0; i < 8; ++i) o[i] = a[i] * b[i];
                    } else {
#pragma unroll
                        for (int i = 0; i < 8; ++i) o[i] = a[i] * sigmoid_f(b[i]);
                    }
                    u32x4 w; w.x = cvt_pk_bf16(o[0], o[1]); w.y = cvt_pk_bf16(o[2], o[3]); w.z = cvt_pk_bf16(o[4], o[5]); w.w = cvt_pk_bf16(o[6], o[7]);
                    *(u32x4*)(rowp + (pn < 4 ? 128 * pn : 1024 + 128 * (pn - 6)) + cin) = w;
                }
            }
    }
};
struct EpiProjI8 {
    static constexpr bool PERM = true, AFTER_DRAIN = false;
    bf16* O; const float* rs; const float* sw;
    __device__ __forceinline__ void operator()(const pg8::i32x4 (&acc)[2][2][4][2], const pg8::Unit& u, int wr, int wc, int fr, int fq) const {
        const int row0 = u.pm * 256 + wr * 64 + fr, cin = wc * 32 + 8 * fq, pn = u.pn;
        float swa[8], swb[8];
        { const f32x4 a0 = *(const f32x4*)(sw + 256 * pn + cin), a1 = *(const f32x4*)(sw + 256 * pn + cin + 4), b0 = *(const f32x4*)(sw + 256 * pn + 128 + cin), b1 = *(const f32x4*)(sw + 256 * pn + 128 + cin + 4);
          swa[0] = a0.x; swa[1] = a0.y; swa[2] = a0.z; swa[3] = a0.w; swa[4] = a1.x; swa[5] = a1.y; swa[6] = a1.z; swa[7] = a1.w;
          swb[0] = b0.x; swb[1] = b0.y; swb[2] = b0.z; swb[3] = b0.w; swb[4] = b1.x; swb[5] = b1.y; swb[6] = b1.z; swb[7] = b1.w; }
#pragma unroll
        for (int ai = 0; ai < 2; ++ai)
#pragma unroll
            for (int m = 0; m < 4; ++m) {
                const int row = row0 + ai * 128 + m * 16; const float sc = rs[row];
                float a[8], b[8];
#pragma unroll
                for (int i = 0; i < 4; ++i) { a[i] = (float)acc[ai][0][m][0][i] * (sc * swa[i]); a[4 + i] = (float)acc[ai][0][m][1][i] * (sc * swa[4 + i]);
                    b[i] = (float)acc[ai][1][m][0][i] * (sc * swb[i]); b[4 + i] = (float)acc[ai][1][m][1][i] * (sc * swb[4 + i]); }
                bf16* rowp = O + (size_t)row * PDIM;
                if (pn >= 4 && pn < 6) {
                    u32x4 w0, w1; w0.x = cvt_pk_bf16(a[0], a[1]); w0.y = cvt_pk_bf16(a[2], a[3]); w0.z = cvt_pk_bf16(a[4], a[5]); w0.w = cvt_pk_bf16(a[6], a[7]);
                    w1.x = cvt_pk_bf16(b[0], b[1]); w1.y = cvt_pk_bf16(b[2], b[3]); w1.z = cvt_pk_bf16(b[4], b[5]); w1.w = cvt_pk_bf16(b[6], b[7]);
                    *(u32x4*)(rowp + 512 + 256 * (pn - 4) + cin) = w0; *(u32x4*)(rowp + 512 + 256 * (pn - 4) + 128 + cin) = w1;
                } else {
                    float o[8];
                    if (pn < 4) {
#pragma unroll
                        for (int i = 0; i < 8; ++i) o[i] = a[i] * b[i];
                    } else {
#pragma unroll
                        for (int i = 0; i < 8; ++i) o[i] = a[i] * sigmoid_f(b[i]);
                    }
                    u32x4 w; w.x = cvt_pk_bf16(o[0], o[1]); w.y = cvt_pk_bf16(o[2], o[3]); w.z = cvt_pk_bf16(o[4], o[5]); w.w = cvt_pk_bf16(o[6], o[7]);
                    *(u32x4*)(rowp + (pn < 4 ? 128 * pn : 1024 + 128 * (pn - 6)) + cin) = w;
                }
            }
    }
};
__host__ __device__ __forceinline__ int win_src_col(int n) {
    const int t = n >> 8, j = n & 255;
    if (t < 4) return (j < 128) ? 128 * t + j : 1024 + 128 * t + (j - 128);
    if (t < 6) return 512 + 256 * (t - 4) + j;
    return (j < 128) ? 1536 + 128 * (t - 6) + j : 2048 + 128 * (t - 6) + (j - 128);
}
struct EpiResidual {
    static constexpr bool PERM = true, AFTER_DRAIN = false;
    bf16* O; const signed char* XB; const float* SX; float* ssq;
    __device__ __forceinline__ void operator()(const pg8::f32x4 (&acc)[2][2][4][2], const pg8::Unit& u, int wr, int wc, int fr, int fq) const {
        const int row0 = u.pm * 256 + wr * 64 + fr, col0 = u.pn * 256 + wc * 32 + 8 * fq;
#pragma unroll
        for (int ai = 0; ai < 2; ++ai)
#pragma unroll
            for (int m = 0; m < 4; ++m) {
                const int row = row0 + ai * 128 + m * 16;
                const signed char* xr = XB + (size_t)row * DM + col0; bf16* rowp = O + (size_t)row * DM + col0;
                float q = 0.f;
                u32x2 xw[2]; const float sxr = SX[row];
#pragma unroll
                for (int bj = 0; bj < 2; ++bj) xw[bj] = *(const u32x2*)(xr + bj * 128);
#pragma unroll
                for (int bj = 0; bj < 2; ++bj) {
                    const f32x4 x0 = (f32x4){(float)(signed char)(xw[bj].x), (float)(signed char)(xw[bj].x >> 8), (float)(signed char)(xw[bj].x >> 16), (float)((int)xw[bj].x >> 24)} * sxr,
                                x1 = (f32x4){(float)(signed char)(xw[bj].y), (float)(signed char)(xw[bj].y >> 8), (float)(signed char)(xw[bj].y >> 16), (float)((int)xw[bj].y >> 24)} * sxr;
                    const pg8::f32x4 v0 = acc[ai][bj][m][0] + x0, v1 = acc[ai][bj][m][1] + x1;
                    q += (v0[0] * v0[0] + v0[1] * v0[1]) + (v0[2] * v0[2] + v0[3] * v0[3]) + (v1[0] * v1[0] + v1[1] * v1[1]) + (v1[2] * v1[2] + v1[3] * v1[3]);
                    u32x4 w; w.x = cvt_pk_bf16(v0[0], v0[1]); w.y = cvt_pk_bf16(v0[2], v0[3]); w.z = cvt_pk_bf16(v1[0], v1[1]); w.w = cvt_pk_bf16(v1[2], v1[3]);
                    *(u32x4*)(rowp + bj * 128) = w; }
                q += __shfl_xor(q, 16); q += __shfl_xor(q, 32);
                if (fq == 0) ssq[(size_t)row * 16 + u.pn * 4 + wc] = q;
            }
    }
};

template <bool MAPIN> __device__ __forceinline__ void p0_transpose_item(const float* W, int K, int N, bf16* WT, LAS float* scr, int item, int lane,
                                                  const float* g_lo, const float* g_hi, int split) {
    const int nblk = N / 32, kb = item / nblk, nb = item % nblk, k0 = 64 * kb, n0 = 32 * nb;
#pragma unroll 8
    for (int i = 0; i < 32; ++i) { const int kk = 2 * i + (lane >> 5); const int k = k0 + kk;
        const float g = (k < split) ? g_lo[k] : g_hi[k - split];
        scr[kk * 33 + (lane & 31)] = W[(size_t)k * N + (MAPIN ? win_src_col(n0) : n0) + (lane & 31)] * g; }
    asm volatile("s_waitcnt lgkmcnt(0)" ::: "memory");
    const int c = lane & 7;
#pragma unroll
    for (int j = 0; j < 4; ++j) { const int n = (lane >> 3) + 8 * j; const LAS float* s = scr + (8 * c) * 33 + n;
        u32x4 o; o.x = pk2(s[0 * 33], s[1 * 33]); o.y = pk2(s[2 * 33], s[3 * 33]); o.z = pk2(s[4 * 33], s[5 * 33]); o.w = pk2(s[6 * 33], s[7 * 33]);
        *(u32x4*)(WT + (size_t)(n0 + n) * K + k0 + 8 * c) = o; }
    asm volatile("s_waitcnt lgkmcnt(0)" ::: "memory");
}

constexpr int CW_COLMAX = 5120;
__device__ __forceinline__ void p0_colmax_item(const float* W, int N, unsigned* colmax, int item, int lane, const float* g) {
    const int nblk = N / 32, kb = item / nblk, nb = item % nblk, k0 = 64 * kb, n0 = 32 * nb;
    float mx = 0.f;
#pragma unroll
    for (int i = 0; i < 32; ++i) { const int k = k0 + 2 * i + (lane >> 5); mx = fmaxf(mx, fabsf(W[(size_t)k * N + n0 + (lane & 31)] * g[k])); }
    mx = fmaxf(mx, __shfl_xor(mx, 32));
    if (lane < 32) atomicMax(colmax + n0 + lane, __float_as_uint(mx));
}
__device__ __forceinline__ void p1_quant_item(const float* W, int K, int N, signed char* WT8, float* swout, const unsigned* colmax, LAS float* scr, int item, int lane, const float* g) {
    const int nblk = N / 32, kb = item / nblk, nb = item % nblk, k0 = 64 * kb, n0 = 32 * nb, s0 = win_src_col(n0);
    const float cm = fmaxf(__uint_as_float(colmax[s0 + (lane & 31)]), 1e-30f), inv = 127.f / cm;
    if (kb == 0 && lane < 32) swout[n0 + lane] = cm * (1.f / 127.f);
#pragma unroll
    for (int i = 0; i < 32; ++i) { const int kk = 2 * i + (lane >> 5); const int k = k0 + kk;
        scr[kk * 33 + (lane & 31)] = W[(size_t)k * N + s0 + (lane & 31)] * g[k] * inv; }
    asm volatile("s_waitcnt lgkmcnt(0)" ::: "memory");
    const int c = lane & 7;
#pragma unroll
    for (int j = 0; j < 4; ++j) { const int n = (lane >> 3) + 8 * j; const LAS float* sp = scr + (8 * c) * 33 + n;
        unsigned w0 = 0u, w1 = 0u;
#pragma unroll
        for (int i = 0; i < 4; ++i) { w0 |= ((unsigned)(int)rintf(sp[i * 33]) & 255u) << (8 * i); w1 |= ((unsigned)(int)rintf(sp[(4 + i) * 33]) & 255u) << (8 * i); }
        u32x2 o; o.x = w0; o.y = w1;
        *(u32x2*)(WT8 + (size_t)(n0 + n) * K + k0 + 8 * c) = o; }
    asm volatile("s_waitcnt lgkmcnt(0)" ::: "memory");
}
__device__ __forceinline__ void phase_winq(const Params& P, LAS unsigned char* lds) {
    const int tid = threadIdx.x, lane = tid & 63, wave = __builtin_amdgcn_readfirstlane(tid >> 6);
    const int gw = blockIdx.x * NWAVES + wave, NGW = gridDim.x * NWAVES;
    LAS float* scr = (LAS float*)(lds + wave * 16384);
    for (int it = gw; it < (DM / 64) * (DIN / 32); it += NGW)
        p1_quant_item(P.w_in, DM, DIN, (signed char*)(P.ws + WS_WIN_T), (float*)(P.ws + WS_SW), (const unsigned*)(P.ws + WS_CTL) + CW_COLMAX, scr, it, lane, P.g_mix);
}
__device__ __forceinline__ float q4(float x, float inv_s) {
    const float a = fabsf(x) * inv_s; float r;
    if (a < 2.f) r = rintf(a * 2.f) * 0.5f; else if (a < 4.f) r = rintf(a); else r = fminf(6.f, rintf(a * 0.5f) * 2.f);
    return copysignf(r, x);
}
__device__ __forceinline__ void phase_prep(const Params& P, LAS unsigned char* lds) {
    const int tid = threadIdx.x, lane = tid & 63, wave = __builtin_amdgcn_readfirstlane(tid >> 6);
    const int gw = blockIdx.x * NWAVES + wave, NGW = gridDim.x * NWAVES;
    unsigned char* ws = P.ws;
    LAS float* scr = (LAS float*)(lds + wave * 16384);
    constexpr int I_IN = (DM / 64) * (DIN / 32), I_OUT = (DM / 64) * (DM / 32), I_Q = (DM / 64) * (2048 / 32);
    for (int it = gw; it < I_IN + I_OUT + I_Q; it += NGW) {
        int r = it;
        if (r < I_IN) { p0_colmax_item(P.w_in, DIN, (unsigned*)(ws + WS_CTL) + CW_COLMAX, r, lane, P.g_mix); continue; } r -= I_IN;
        if (r < I_OUT) { p0_transpose_item<false>(P.w_out, DM, DM, (bf16*)(ws + WS_WOUT_T), scr, r, lane, P.g_sc, P.g_cf, 512); continue; } r -= I_OUT;
        p0_transpose_item<false>(P.w_q, DM, 2048, (bf16*)(ws + WS_WQ_T), scr, r, lane, P.g_ffn, P.g_ffn, DM);
    }
    {
        unsigned* H0I8 = (unsigned*)(ws + WS_H0I8); float* RS1 = (float*)(ws + WS_RSTD1); float* SXp = (float*)(ws + WS_SX);
        for (int t0 = gw * 4; t0 < NTOK; t0 += NGW * 4) {
            f32x4 v[4][4];
#pragma unroll
            for (int q = 0; q < 4; ++q) { const f32x4* xr = (const f32x4*)(P.x + (size_t)(t0 + q) * DM) + lane;
#pragma unroll
                for (int j = 0; j < 4; ++j) v[q][j] = xr[64 * j]; }
#pragma unroll
            for (int q = 0; q < 4; ++q) { float sq = 0.f, mx = 0.f;
#pragma unroll
                for (int j = 0; j < 4; ++j) { sq += (v[q][j].x * v[q][j].x + v[q][j].y * v[q][j].y) + (v[q][j].z * v[q][j].z + v[q][j].w * v[q][j].w);
                    mx = fmaxf(mx, fmaxf(fmaxf(fabsf(v[q][j].x), fabsf(v[q][j].y)), fmaxf(fabsf(v[q][j].z), fabsf(v[q][j].w)))); }
                sq = wave_sum_fast(sq); mx = fmaxf(wave_max_fast(mx), 1e-30f);
                const float sx = mx * (1.f / 127.f), inv = 127.f / mx;
                if (lane == 0) { RS1[t0 + q] = sx * rsqrtf(sq * (1.f / DM) + EPS); SXp[t0 + q] = sx; }
                unsigned* o = H0I8 + (size_t)(t0 + q) * (DM / 4) + lane;
#pragma unroll
                for (int j = 0; j < 4; ++j) { const int a = (int)rintf(v[q][j].x * inv), b = (int)rintf(v[q][j].y * inv), c = (int)rintf(v[q][j].z * inv), d = (int)rintf(v[q][j].w * inv);
                    o[64 * j] = ((unsigned)a & 255u) | (((unsigned)b & 255u) << 8) | (((unsigned)c & 255u) << 16) | ((unsigned)d << 24); } }
        }
    }
    {
        unsigned char* U8 = ws + WS_U8; unsigned char* V8 = ws + WS_V8;
        f32x4 gf[4];
#pragma unroll
        for (int j = 0; j < 4; ++j) gf[j] = ((const f32x4*)P.g_ffn)[64 * j + lane];
        float* ESC = (float*)(ws + WS_ESCALE);
        for (int e0 = gw * 2; e0 < 2 * 16384; e0 += NGW * 2) {
            const bool isv = e0 >= 16384; const int ee0 = isv ? e0 - 16384 : e0;
            f32x4 v[2][4];
#pragma unroll
            for (int q = 0; q < 2; ++q) { const f32x4* src = (const f32x4*)((isv ? P.pv : P.pu) + (size_t)(ee0 + q) * DM) + lane;
#pragma unroll
                for (int j = 0; j < 4; ++j) v[q][j] = src[64 * j]; }
#pragma unroll
            for (int q = 0; q < 2; ++q) {
                float mx = 0.f;
#pragma unroll
                for (int j = 0; j < 4; ++j) { if (!isv) v[q][j] = v[q][j] * gf[j];
                    mx = fmaxf(mx, fmaxf(fmaxf(fabsf(v[q][j].x), fabsf(v[q][j].y)), fmaxf(fabsf(v[q][j].z), fabsf(v[q][j].w)))); }
#pragma unroll
                for (int o = 1; o < 64; o <<= 1) mx = fmaxf(mx, __shfl_xor(mx, o));
                if (!isv) {
                    float sq2 = 0.f;
#pragma unroll
                    for (int j = 0; j < 4; ++j) sq2 += (v[q][j].x * v[q][j].x + v[q][j].y * v[q][j].y) + (v[q][j].z * v[q][j].z + v[q][j].w * v[q][j].w);
                    const float rms = sqrtf(wave_sum_fast(sq2) * (1.f / DM));
                    const float su = fmaxf(fminf(mx, U4_CLIP * rms), 1e-30f) * (1.f / 7.f), inv = 1.f / su;
                    unsigned wq[2] = {0u, 0u}; int csum = 0;
#pragma unroll
                    for (int j = 0; j < 4; ++j) { const float e4[4] = {v[q][j].x, v[q][j].y, v[q][j].z, v[q][j].w};
#pragma unroll
                        for (int i = 0; i < 4; ++i) { int c = (int)rintf(fminf(fmaxf(e4[i] * inv, -7.f), 7.f)); csum += c;
                            wq[j >> 1] |= ((unsigned)c & 15u) << (16 * (j & 1) + 4 * i); } }
                    const float cs = wave_sum_fast((float)csum);
                    if (lane == 0) { ESC[e0 + q] = su; ((float*)(ws + WS_SUMQ))[e0 + q] = cs; }
                    u32x2 o; o.x = wq[0]; o.y = wq[1];
                    *(u32x2*)(U8 + (size_t)(ee0 + q) * 512 + 8 * lane) = o;
                    continue;
                }
                const float sc = fmaxf(mx, 1e-30f) * (1.f / 6.f), inv = 1.f / sc;
                if (lane == 0) ESC[e0 + q] = sc;
                unsigned w0 = 0u, w1 = 0u;
                w0 = __builtin_amdgcn_cvt_scalef32_pk_fp4_f32(w0, v[q][0].x * inv, v[q][0].y * inv, 1.0f, 0); w0 = __builtin_amdgcn_cvt_scalef32_pk_fp4_f32(w0, v[q][0].z * inv, v[q][0].w * inv, 1.0f, 1);
                w0 = __builtin_amdgcn_cvt_scalef32_pk_fp4_f32(w0, v[q][1].x * inv, v[q][1].y * inv, 1.0f, 2); w0 = __builtin_amdgcn_cvt_scalef32_pk_fp4_f32(w0, v[q][1].z * inv, v[q][1].w * inv, 1.0f, 3);
                w1 = __builtin_amdgcn_cvt_scalef32_pk_fp4_f32(w1, v[q][2].x * inv, v[q][2].y * inv, 1.0f, 0); w1 = __builtin_amdgcn_cvt_scalef32_pk_fp4_f32(w1, v[q][2].z * inv, v[q][2].w * inv, 1.0f, 1);
                w1 = __builtin_amdgcn_cvt_scalef32_pk_fp4_f32(w1, v[q][3].x * inv, v[q][3].y * inv, 1.0f, 2); w1 = __builtin_amdgcn_cvt_scalef32_pk_fp4_f32(w1, v[q][3].z * inv, v[q][3].w * inv, 1.0f, 3);
                u32x2 o; o.x = w0; o.y = w1;
                *(u32x2*)((isv ? V8 : U8) + (size_t)(ee0 + q) * 512 + 8 * lane) = o;
            }
        }
    }
    {
        bf16* KB = (bf16*)(ws + WS_KEYS);
        const int gt = blockIdx.x * NTHREADS + tid, NGT = gridDim.x * NTHREADS;
        for (int i = gt; i < 8 * 2 * 128 * 128 / 4; i += NGT) { const f32x4 v = ((const f32x4*)P.keys)[i]; u32x2 w; w.x = pk2(v.x, v.y); w.y = pk2(v.z, v.w); ((u32x2*)KB)[i] = w; }
    }
    {
        float* MP = (float*)(ws + WS_METAPART); float* MR = (float*)(ws + WS_METARSTD);
        for (int r = gw; r < NMETA; r += NGW) {
            float s = 0.f;
            for (int k = lane; k < DM; k += 64) { const float v = P.meta[r * DM + k]; s += v * v; }
            s = wave_sum(s);
            if (lane == 0) MR[r] = rsqrtf(s * (1.f / DM) + EPS);
        }
        for (int it = gw; it < MKC * 40; it += NGW) {
            const int kc = it / 40, nb = it % 40, n = nb * 64 + lane;
            float acc[NMETA];
#pragma unroll
            for (int r = 0; r < NMETA; ++r) acc[r] = 0.f;
            for (int k = kc * (DM / MKC); k < (kc + 1) * (DM / MKC); ++k) {
                const float w = P.w_in[(size_t)k * DIN + n] * P.g_mix[k];
#pragma unroll
                for (int r = 0; r < NMETA; ++r) acc[r] += P.meta[r * DM + k] * w;
            }
#pragma unroll
            for (int r = 0; r < NMETA; ++r) MP[(size_t)(kc * 16 + r) * DIN + n] = acc[r];
        }
    }
}

__device__ __forceinline__ float metaraw(const float* MP, const float* MR, int p, int col) { float s = 0.f;
#pragma unroll 8
    for (int kc = 0; kc < MKC; ++kc) s += MP[(size_t)(kc * 16 + p) * DIN + col];
    return s * MR[p]; }
__device__ __forceinline__ void phase_metaproj(const Params& P) {
    const float* MP = (const float*)(P.ws + WS_METAPART); const float* MR = (const float*)(P.ws + WS_METARSTD); float* MJ = (float*)(P.ws + WS_METAPROJ);
    for (int gt = blockIdx.x * NTHREADS + threadIdx.x; gt < NMETA * PDIM; gt += gridDim.x * NTHREADS) { const int p = gt / PDIM, c = gt % PDIM; float v;
        if (c < 512) v = metaraw(MP, MR, p, c) * metaraw(MP, MR, p, 1024 + c);
        else if (c < 1024) v = metaraw(MP, MR, p, c);
        else v = metaraw(MP, MR, p, 1536 + (c - 1024)) * sigmoid_f(metaraw(MP, MR, p, 2048 + (c - 1024)));
        MJ[gt] = v; }
}
__device__ __forceinline__ float meta_val(const float* MJ, const float*, int p, int col) { return MJ[p * PDIM + col]; }
__device__ __forceinline__ float proj_at(const bf16* PROJ, const float* MP, const float* MR, int b, int pos, int col) {
    if (pos < 0) return 0.f;
    if (pos < NMETA) return meta_val(MP, MR, pos, col);
    return bf2f(PROJ[(size_t)(b * SEQ + pos - NMETA) * PDIM + col]);
}
__device__ __forceinline__ void proj8_at(const bf16* PROJ, const float* MP, const float* MR, int b, int pos, int col, float (&v)[8]) {
    if (pos < 0) {
#pragma unroll
        for (int i = 0; i < 8; ++i) v[i] = 0.f;
    } else if (pos < NMETA) {
        const f32x4 a = *(const f32x4*)(MP + pos * PDIM + col), bq = *(const f32x4*)(MP + pos * PDIM + col + 4);
        v[0] = a.x; v[1] = a.y; v[2] = a.z; v[3] = a.w; v[4] = bq.x; v[5] = bq.y; v[6] = bq.z; v[7] = bq.w;
    } else {
        const u32x4 w = *(const u32x4*)(PROJ + (size_t)(b * SEQ + pos - NMETA) * PDIM + col);
        v[0] = bflo(w.x); v[1] = bfhi(w.x); v[2] = bflo(w.y); v[3] = bfhi(w.y); v[4] = bflo(w.z); v[5] = bfhi(w.z); v[6] = bflo(w.w); v[7] = bfhi(w.w);
    }
}

template <int R> __device__ __forceinline__ void conv_rows(const LAS unsigned char* ubase, const f32x2 (&wcf)[31], f32x2 (&acc)[32]) {
    if constexpr (R < 62) {
        const unsigned uw = *(const LAS unsigned*)(ubase + R * 1024);
        const f32x2 x = (f32x2){bflo(uw), bfhi(uw)};
        constexpr int lo = R > 30 ? R - 30 : 0, hi = R < 31 ? R : 31;
#pragma unroll
        for (int ii = lo; ii <= hi; ++ii) acc[ii] += wcf[R - ii] * x;
        conv_rows<R + 1>(ubase, wcf, acc);
    }
}
__device__ __forceinline__ void phase_conv(const Params& P, LAS unsigned char* lds) {
    const int tid = threadIdx.x, lane = tid & 63, wave = __builtin_amdgcn_readfirstlane(tid >> 6);
    unsigned char* ws = P.ws;
    const bf16* PROJ = (const bf16*)(ws + WS_PROJ); const float* MP = (const float*)(ws + WS_METAPROJ); const float* MR = nullptr;
    bf16* Y = (bf16*)(ws + WS_Y);
    constexpr int TT = 64, NTILE = NTOK / TT, UROWS = TT + 30;
    const int cgp = wave & 3, th = wave >> 2, ch2 = cgp * 128 + 2 * lane;
    f32x2 wcf[31];
#pragma unroll
    for (int j = 0; j < 31; ++j) wcf[j] = *(const f32x2*)(P.cf_w + j * 512 + ch2);
    const f32x2 bcf = *(const f32x2*)(P.cf_b + ch2);
    for (int tile = blockIdx.x; tile < NTILE; tile += gridDim.x) {
        const int b = tile / (SEQ / TT), s0 = (tile % (SEQ / TT)) * TT;
#pragma unroll 4
        for (int p = 0; p < (UROWS + 7) / 8; ++p) {
            const int r = p * 8 + wave;
            if (r < UROWS) {
                const int pos = NMETA + s0 - 30 + r;
                float uu[8];
                proj8_at(PROJ, MP, MR, b, pos, 1024 + 8 * lane, uu);
                u32x4 w; w.x = pk2(uu[0], uu[1]); w.y = pk2(uu[2], uu[3]); w.z = pk2(uu[4], uu[5]); w.w = pk2(uu[6], uu[7]);
                *(LAS u32x4*)(lds + r * 1024 + lane * 16) = w;
            }
        }
        __syncthreads();
        f32x2 acc[32];
#pragma unroll
        for (int ii = 0; ii < 32; ++ii) acc[ii] = bcf;
        conv_rows<0>(lds + (32 * th) * 1024 + ch2 * 2, wcf, acc);
        __syncthreads();
#pragma unroll
        for (int ii = 0; ii < 32; ++ii) *(LAS f32x2*)(lds + (32 * th + ii) * 2048 + ch2 * 4) = acc[ii];
        __syncthreads();
        {
            float lng[8], lnb[8];
            { const f32x4 a = *(const f32x4*)(P.ln_g + 8 * lane), c = *(const f32x4*)(P.ln_g + 8 * lane + 4), d = *(const f32x4*)(P.ln_b + 8 * lane), e = *(const f32x4*)(P.ln_b + 8 * lane + 4);
              lng[0] = a.x; lng[1] = a.y; lng[2] = a.z; lng[3] = a.w; lng[4] = c.x; lng[5] = c.y; lng[6] = c.z; lng[7] = c.w;
              lnb[0] = d.x; lnb[1] = d.y; lnb[2] = d.z; lnb[3] = d.w; lnb[4] = e.x; lnb[5] = e.y; lnb[6] = e.z; lnb[7] = e.w; }
            float wsc[3][8];
#pragma unroll
            for (int j = 0; j < 3; ++j) { const f32x4 a = *(const f32x4*)(P.sc_w + j * 512 + 8 * lane), c = *(const f32x4*)(P.sc_w + j * 512 + 8 * lane + 4);
                wsc[j][0] = a.x; wsc[j][1] = a.y; wsc[j][2] = a.z; wsc[j][3] = a.w; wsc[j][4] = c.x; wsc[j][5] = c.y; wsc[j][6] = c.z; wsc[j][7] = c.w; }
            float cxa[8], cxb[8];
            { const int pos = NMETA + s0 + 8 * wave - 2;
              proj8_at(PROJ, MP, MR, b, pos, 8 * lane, cxa); proj8_at(PROJ, MP, MR, b, pos + 1, 8 * lane, cxb); }
#pragma unroll 2
            for (int q = 0; q < 8; ++q) {
                const int ii = 8 * wave + q, s = s0 + ii; const size_t t = (size_t)b * SEQ + s;
                float o[8];
                { const f32x4 a = *(const LAS f32x4*)(lds + ii * 2048 + lane * 32), c = *(const LAS f32x4*)(lds + ii * 2048 + lane * 32 + 16);
                  o[0] = a.x; o[1] = a.y; o[2] = a.z; o[3] = a.w; o[4] = c.x; o[5] = c.y; o[6] = c.z; o[7] = c.w; }
                float s1 = 0.f;
#pragma unroll
                for (int i = 0; i < 8; ++i) s1 += o[i];
                const float mean = wave_sum_fast(s1) * (1.f / 512.f);
                float s2 = 0.f;
#pragma unroll
                for (int i = 0; i < 8; ++i) { o[i] -= mean; s2 += o[i] * o[i]; }
                const float rs = rsqrtf(wave_sum_fast(s2) * (1.f / 512.f) + EPS);
                float s3 = 0.f;
#pragma unroll
                for (int i = 0; i < 8; ++i) { float y = o[i] * rs * lng[i] + lnb[i]; y = y * sigmoid_f(y); o[i] = y; s3 += y * y; }
                const float r2 = rsqrtf(wave_sum_fast(s3) * (1.f / 512.f) + EPS);
                u32x4 wv; wv.x = pk2(o[0] * r2, o[1] * r2); wv.y = pk2(o[2] * r2, o[3] * r2); wv.z = pk2(o[4] * r2, o[5] * r2); wv.w = pk2(o[6] * r2, o[7] * r2);
                *(u32x4*)(Y + t * DM + 512 + 8 * lane) = wv;
                float bgv[8], cxc[8], accs[8];
                proj8_at(PROJ, MP, MR, b, NMETA + s, 8 * lane, cxc); proj8_at(PROJ, MP, MR, b, NMETA + s, 512 + 8 * lane, bgv);
                float s4 = 0.f;
#pragma unroll
                for (int i = 0; i < 8; ++i) { accs[i] = bgv[i] * (wsc[0][i] * cxa[i] + wsc[1][i] * cxb[i] + wsc[2][i] * cxc[i]); s4 += accs[i] * accs[i]; cxa[i] = cxb[i]; cxb[i] = cxc[i]; }
                const float r4 = rsqrtf(wave_sum_fast(s4) * (1.f / 512.f) + EPS);
                u32x4 wz; wz.x = pk2(accs[0] * r4, accs[1] * r4); wz.y = pk2(accs[2] * r4, accs[3] * r4); wz.z = pk2(accs[4] * r4, accs[5] * r4); wz.w = pk2(accs[6] * r4, accs[7] * r4);
                *(u32x4*)(Y + t * DM + 8 * lane) = wz;
            }
        }
        __syncthreads();
    }
}

__device__ __forceinline__ int ord_i(float s) { int k = __builtin_bit_cast(int, s); k ^= (k >> 31) & 0x7fffffff; return k; }
__device__ __forceinline__ float unord_f(int k) { k ^= (k >> 31) & 0x7fffffff; return __builtin_bit_cast(float, k); }
#define TOP_INSERT(L, x_) do { int _x = (x_); _Pragma("unroll") for (int _i = 0; _i < 16; ++_i) { const int _hi = max(L[_i], _x); _x = min(L[_i], _x); L[_i] = _hi; } } while (0)

typedef short bf16x8 __attribute__((ext_vector_type(8)));
typedef float f32x16 __attribute__((ext_vector_type(16)));
template <bool DESC> __device__ __forceinline__ void ce_i(int& a, int& b) { const int hi = max(a, b), lo = min(a, b); if (DESC) { a = hi; b = lo; } else { a = lo; b = hi; } }
__device__ __forceinline__ void bitonic_sort16(int (&a)[16]) {
#pragma unroll
    for (int k = 2; k <= 16; k <<= 1)
#pragma unroll
        for (int j = k >> 1; j > 0; j >>= 1)
#pragma unroll
            for (int i = 0; i < 16; ++i) { const int l = i ^ j; if (l > i) { if ((i & k) == 0) ce_i<true>(a[i], a[l]); else ce_i<false>(a[i], a[l]); } }
}
__device__ __forceinline__ void bitonic_merge16(int (&a)[16]) {
#pragma unroll
    for (int j = 8; j > 0; j >>= 1)
#pragma unroll
        for (int i = 0; i < 16; ++i) { const int l = i ^ j; if (l > i) ce_i<true>(a[i], a[l]); }
}
__device__ __forceinline__ void merge_top16(int (&a)[16], const int (&b)[16]) {
#pragma unroll
    for (int i = 0; i < 16; ++i) a[i] = max(a[i], b[15 - i]);
    bitonic_merge16(a);
}
__device__ __forceinline__ int lut16(const unsigned (&T)[4], int i) {
    const unsigned sel = (unsigned)(i & 7) | 0x0c0c0c00u;
    const unsigned lo = __builtin_amdgcn_perm(T[1], T[0], sel), hi = __builtin_amdgcn_perm(T[3], T[2], sel);
    return (int)((i & 8) ? hi : lo);
}
constexpr int KROW = 272;
constexpr float SCORE_BIAS = 8.0f;

__device__ __forceinline__ void route_load_q(bf16x8 (&qf)[8], const bf16* qrow, int hb) {
#pragma unroll
    for (int ks = 0; ks < 8; ++ks) qf[ks] = *(const bf16x8*)(qrow + 64 * hb + 8 * ks);
}
__device__ __forceinline__ void route_half(const LAS unsigned char* kl, const bf16x8 (&qf)[8], int nl, int hb, int (&L)[16]) {
    f32x16 acc[4];
#pragma unroll
    for (int nt = 0; nt < 4; ++nt)
#pragma unroll
        for (int r = 0; r < 16; ++r) acc[nt][r] = SCORE_BIAS;
#pragma unroll
    for (int ks = 0; ks < 8; ++ks)
#pragma unroll
        for (int nt = 0; nt < 4; ++nt) {
            const bf16x8 a = *(const LAS bf16x8*)(kl + (32 * nt + nl) * KROW + (64 * hb + 8 * ks) * 2);
            acc[nt] = __builtin_amdgcn_mfma_f32_32x32x16_bf16(a, qf[ks], acc[nt], 0, 0, 0);
        }
    const int hb4 = 4 * hb;
    int T[4][16];
#pragma unroll
    for (int nt = 0; nt < 4; ++nt)
#pragma unroll
        for (int r = 0; r < 16; ++r) { const int n0 = 32 * nt + (r & 3) + 8 * (r >> 2); const float sc = acc[nt][r];
            T[nt][r] = (__float_as_int(sc) & ~127) | ((127 - n0) - hb4); }
    bitonic_sort16(T[0]); bitonic_sort16(T[1]); bitonic_sort16(T[2]); bitonic_sort16(T[3]);
    merge_top16(T[0], T[1]); merge_top16(T[2], T[3]); merge_top16(T[0], T[2]);
#pragma unroll
    for (int i = 0; i < 16; ++i) { const unsigned v = (unsigned)T[0][15 - i]; auto r = __builtin_amdgcn_permlane32_swap(v, v, false, false);
        const unsigned r0 = r[0], r1 = r[1]; const int partner = (int)(hb ? r0 : r1); L[i] = max(T[0][i], partner); }
    bitonic_merge16(L);
}

__device__ __forceinline__ void phase_route(const Params& P, LAS unsigned char* lds) {
    const int tid = threadIdx.x, lane = tid & 63, wave = __builtin_amdgcn_readfirstlane(tid >> 6);
    const int nl = lane & 31, hb = lane >> 5;
    unsigned char* ws = P.ws;
    const bf16* KEYS = (const bf16*)(ws + WS_KEYS); const bf16* Q = (const bf16*)(ws + WS_Q);
    int* IDX = (int*)(ws + WS_IDX); float* GATE = (float*)(ws + WS_GATE);
    int last_h = -1;
    pg8::StaticOrder S; S.init(NTOK, 2048, (int)gridDim.x, (int)blockIdx.x);
    pg8::Unit ucur, unxt;
    bool have = S.next(0, ucur);
    bf16x8 qfA[8], qfB[8];
    if (have) route_load_q(qfA, Q + ((size_t)ucur.pm * 256 + wave * 32 + nl) * 2048 + ucur.pn * 256, hb);
    for (int ui = 0; have; ++ui) {
        const int h = ucur.pn, tb = ucur.pm;
        const bool have_next = S.next(ui + 1, unxt);
        if (h != last_h) {
            __syncthreads();
            for (int c = tid; c < 4096; c += NTHREADS) { const u32x4 v = ((const u32x4*)(KEYS + (size_t)h * 32768))[c];
                *(LAS u32x4*)(lds + (c >> 4) * KROW + (c & 15) * 16) = v; }
            __syncthreads();
            last_h = h;
        }
        const size_t t = (size_t)tb * 256 + wave * 32 + nl;
        int L1[16], L2[16];
        route_load_q(qfB, Q + t * 2048 + h * 256 + 128, hb);
        route_half(lds, qfA, nl, hb, L1);
        if (have_next) route_load_q(qfA, Q + ((size_t)unxt.pm * 256 + wave * 32 + nl) * 2048 + unxt.pn * 256, hb);
        route_half(lds + 128 * KROW, qfB, nl, hb, L2);
        float v1[16], v2[16];
#pragma unroll
        for (int i = 0; i < 16; ++i) { v1[i] = __int_as_float(L1[i] & ~127); v2[i] = __int_as_float(L2[i] & ~127); }
#define CAND(i, j) ((__float_as_int(v1[i] + v2[j]) & ~255) | (255 - (16 * (i) + (j))))
        int A[16], B[16], C[16];
#pragma unroll
        for (int j = 0; j < 16; ++j) A[j] = CAND(0, j);
#pragma unroll
        for (int j = 0; j < 8; ++j) { B[j] = CAND(1, j); B[8 + j] = CAND(15 - j, 0); }
        bitonic_merge16(B);
        C[0] = CAND(2, 0); C[1] = CAND(2, 1); C[2] = CAND(2, 2); C[3] = CAND(2, 3); C[4] = CAND(2, 4);
        C[5] = CAND(3, 0); C[6] = CAND(3, 1); C[7] = CAND(3, 2); C[8] = CAND(3, 3);
        C[9] = CAND(4, 0); C[10] = CAND(4, 1); C[11] = CAND(4, 2);
        C[12] = CAND(5, 0); C[13] = CAND(5, 1); C[14] = CAND(6, 0); C[15] = CAND(6, 1);
        bitonic_sort16(C);
        { const int d0 = CAND(7, 0), d1 = CAND(7, 1); C[14] = max(C[14], d1); C[15] = max(C[15], d0); bitonic_merge16(C); }
#undef CAND
        merge_top16(A, B); merge_top16(A, C);
        unsigned T1[4], T2[4];
#pragma unroll
        for (int q = 0; q < 4; ++q) {
            T1[q] = (unsigned)(127 - (L1[4 * q] & 127)) | ((unsigned)(127 - (L1[4 * q + 1] & 127)) << 8) | ((unsigned)(127 - (L1[4 * q + 2] & 127)) << 16) | ((unsigned)(127 - (L1[4 * q + 3] & 127)) << 24);
            T2[q] = (unsigned)(127 - (L2[4 * q] & 127)) | ((unsigned)(127 - (L2[4 * q + 1] & 127)) << 8) | ((unsigned)(127 - (L2[4 * q + 2] & 127)) << 16) | ((unsigned)(127 - (L2[4 * q + 3] & 127)) << 24); }
        float val[16]; int ex[16];
#pragma unroll
        for (int k = 0; k < 16; ++k) { const int pos = 255 - (A[k] & 255); val[k] = __int_as_float(A[k] & ~255);
            ex[k] = lut16(T1, pos >> 4) * NKEYS + lut16(T2, pos & 15); }
        float sum = 0.f; const float vmax = val[0];
#pragma unroll
        for (int k = 0; k < 16; ++k) { val[k] = __expf(val[k] - vmax); sum += val[k]; }
        const float inv = 1.f / sum;
        if (hb == 0) {
            int* ip = IDX + t * NSEL + h * TOPK; float* gp = GATE + t * NSEL + h * TOPK;
#pragma unroll
            for (int k4 = 0; k4 < 4; ++k4) {
                *(int4*)(ip + 4 * k4) = make_int4(ex[4 * k4], ex[4 * k4 + 1], ex[4 * k4 + 2], ex[4 * k4 + 3]);
                *(f32x4*)(gp + 4 * k4) = (f32x4){val[4 * k4] * inv, val[4 * k4 + 1] * inv, val[4 * k4 + 2] * inv, val[4 * k4 + 3] * inv};
            }
        }
        ucur = unxt; have = have_next;
    }
}

#define FP4X2(w, sel) __builtin_amdgcn_cvt_scalef32_pk_f32_fp4((w), 1.0f, (sel))
__device__ __forceinline__ float dot16_fp4(const u32x2 r, const f32x4 (&xs)[4]) {
    float p = 0.f;
    { const f32x2 a = FP4X2(r.x, 0), b = FP4X2(r.x, 1), c = FP4X2(r.x, 2), d = FP4X2(r.x, 3);
      p += (a.x * xs[0].x + a.y * xs[0].y) + (b.x * xs[0].z + b.y * xs[0].w); p += (c.x * xs[1].x + c.y * xs[1].y) + (d.x * xs[1].z + d.y * xs[1].w); }
    { const f32x2 a = FP4X2(r.y, 0), b = FP4X2(r.y, 1), c = FP4X2(r.y, 2), d = FP4X2(r.y, 3);
      p += (a.x * xs[2].x + a.y * xs[2].y) + (b.x * xs[2].z + b.y * xs[2].w); p += (c.x * xs[3].x + c.y * xs[3].y) + (d.x * xs[3].z + d.y * xs[3].w); }
    return p;
}
__device__ __forceinline__ void axpy16_fp4(const u32x2 r, float w, f32x4 (&o)[4]) {
    { const f32x2 a = FP4X2(r.x, 0), b = FP4X2(r.x, 1), c = FP4X2(r.x, 2), d = FP4X2(r.x, 3);
      o[0].x += w * a.x; o[0].y += w * a.y; o[0].z += w * b.x; o[0].w += w * b.y; o[1].x += w * c.x; o[1].y += w * c.y; o[1].z += w * d.x; o[1].w += w * d.y; }
    { const f32x2 a = FP4X2(r.y, 0), b = FP4X2(r.y, 1), c = FP4X2(r.y, 2), d = FP4X2(r.y, 3);
      o[2].x += w * a.x; o[2].y += w * a.y; o[2].z += w * b.x; o[2].w += w * b.y; o[3].x += w * c.x; o[3].y += w * c.y; o[3].z += w * d.x; o[3].w += w * d.y; }
}
__device__ __forceinline__ float swap32_add(float a, float b) { auto r = __builtin_amdgcn_permlane32_swap(__float_as_uint(a), __float_as_uint(b), false, false); return __uint_as_float(r[0]) + __uint_as_float(r[1]); }
__device__ __forceinline__ float swap16_add(float a, float b) { auto r = __builtin_amdgcn_permlane16_swap(__float_as_uint(a), __float_as_uint(b), false, false); return __uint_as_float(r[0]) + __uint_as_float(r[1]); }
__device__ __forceinline__ float row_sum16(float v) { v += dpp_f<0xB1>(v); v += dpp_f<0x4E>(v); v += dpp_f<0x141>(v); v += dpp_f<0x140>(v); return v; }
constexpr int GB = 32;
typedef __attribute__((address_space(8))) void* rsrc_t;
__device__ __forceinline__ void g_issue(u32x2 (&buf)[GB], __amdgpu_buffer_rsrc_t rs, int idxr, int lb, int voff) {
#pragma unroll
    for (int j = 0; j < GB; ++j) { const int e = __builtin_amdgcn_readlane(idxr, lb + j); buf[j] = __builtin_amdgcn_raw_buffer_load_b64(rs, voff, e * 512, 0); }
}
__device__ __forceinline__ float dot16_fp4p(const u32x2 r, const f32x2 (&xp)[8]) {
    f32x2 a = FP4X2(r.x, 0) * xp[0];
    a += FP4X2(r.x, 1) * xp[1]; a += FP4X2(r.x, 2) * xp[2]; a += FP4X2(r.x, 3) * xp[3];
    a += FP4X2(r.y, 0) * xp[4]; a += FP4X2(r.y, 1) * xp[5]; a += FP4X2(r.y, 2) * xp[6]; a += FP4X2(r.y, 3) * xp[7];
    return a.x + a.y;
}
__device__ __forceinline__ void axpy16_fp4p(const u32x2 r, float w, f32x2 (&o)[8]) {
    const f32x2 ww = (f32x2){w, w};
    o[0] += FP4X2(r.x, 0) * ww; o[1] += FP4X2(r.x, 1) * ww; o[2] += FP4X2(r.x, 2) * ww; o[3] += FP4X2(r.x, 3) * ww;
    o[4] += FP4X2(r.y, 0) * ww; o[5] += FP4X2(r.y, 1) * ww; o[6] += FP4X2(r.y, 2) * ww; o[7] += FP4X2(r.y, 3) * ww;
}
template <int H> __device__ __forceinline__ void g_compute_u(const u32x2 (&buf)[GB], int q, int i16, const f32x2 (&xp)[8], float& zlo, float& zhi) {
    float p[16];
#pragma unroll
    for (int j = 0; j < 16; ++j) p[j] = dot16_fp4p(buf[16 * H + j], xp);
    float s1[8], s2[4];
#pragma unroll
    for (int m = 0; m < 8; ++m) s1[m] = swap32_add(p[2 * m], p[2 * m + 1]);
#pragma unroll
    for (int n = 0; n < 4; ++n) s2[n] = swap16_add(s1[2 * n], s1[2 * n + 1]);
#pragma unroll
    for (int r = 0; r < 4; ++r) { const float z = row_sum16(s2[r]); const bool mine = i16 == ((4 * q + r) & 15);
        zlo = (mine && q < 4) ? z : zlo; zhi = (mine && q >= 4) ? z : zhi; }
}
template <int H> __device__ __forceinline__ void g_compute_v(const u32x2 (&buf)[GB], int q, float alo, float ahi, f32x2 (&o)[8]) {
    const int areg = __builtin_bit_cast(int, (q < 4) ? alo : ahi), sb = 4 * (q & 3);
#pragma unroll
    for (int j = 0; j < 16; ++j) { const int src = 32 * (j & 1) + 16 * ((j >> 1) & 1) + (j >> 2) + sb;
        const float w = __builtin_bit_cast(float, __builtin_amdgcn_readlane(areg, src));
        axpy16_fp4p(buf[16 * H + j], w, o); }
}
__device__ __forceinline__ void q_issue(u32x2 (&buf)[16], __amdgpu_buffer_rsrc_t rs, int ixr  , int lb, int voff) {
#pragma unroll
    for (int j = 0; j < 16; ++j) { const int e9 = __builtin_amdgcn_readlane(ixr, lb + j); buf[j] = __builtin_amdgcn_raw_buffer_load_b64(rs, voff, e9, 0); }
}
__device__ __forceinline__ void q_compute_u(const u32x2 (&buf)[16], int q, int i16, const f32x2 (&xp)[8], float& zlo, float& zhi) {
    float p[16];
#pragma unroll
    for (int j = 0; j < 16; ++j) p[j] = dot16_fp4p(buf[j], xp);
    float s1[8], s2[4];
#pragma unroll
    for (int m = 0; m < 8; ++m) s1[m] = swap32_add(p[2 * m], p[2 * m + 1]);
#pragma unroll
    for (int n = 0; n < 4; ++n) s2[n] = swap16_add(s1[2 * n], s1[2 * n + 1]);
#pragma unroll
    for (int r = 0; r < 4; ++r) { const float z = row_sum16(s2[r]); const bool mine = i16 == ((4 * q + r) & 15);
        zlo = (mine && q < 4) ? z : zlo; zhi = (mine && q >= 4) ? z : zhi; }
}
__device__ __forceinline__ void q_compute_v(const u32x2 (&buf)[16], int q, float alo, float ahi, f32x2 (&o)[8]) {
    const int areg = __builtin_bit_cast(int, (q < 4) ? alo : ahi), sb = 4 * (q & 3);
#pragma unroll
    for (int j = 0; j < 16; ++j) { const int src = 32 * (j & 1) + 16 * ((j >> 1) & 1) + (j >> 2) + sb;
        const float w = __builtin_bit_cast(float, __builtin_amdgcn_readlane(areg, src));
        axpy16_fp4p(buf[j], w, o); }
}
__device__ __forceinline__ int swap32_addi(int a, int b) { auto r = __builtin_amdgcn_permlane32_swap((unsigned)a, (unsigned)b, false, false); const unsigned r0 = r[0], r1 = r[1]; return (int)(r0 + r1); }
__device__ __forceinline__ int swap16_addi(int a, int b) { auto r = __builtin_amdgcn_permlane16_swap((unsigned)a, (unsigned)b, false, false); const unsigned r0 = r[0], r1 = r[1]; return (int)(r0 + r1); }
template <int CTRL> __device__ __forceinline__ int dpp_i(int v) { return __builtin_amdgcn_update_dpp(0, v, CTRL, 0xf, 0xf, true); }
__device__ __forceinline__ int row_sum16i(int v) { v += dpp_i<0xB1>(v); v += dpp_i<0x4E>(v); v += dpp_i<0x141>(v); v += dpp_i<0x140>(v); return v; }
__device__ __forceinline__ void q_compute_ui(const u32x2 (&buf)[16], int q, int i16, int xh0, int xh1, int xl0, int xl1, int& zlo, int& zhi) {
    int p[16];
#pragma unroll
    for (int j = 0; j < 16; ++j) { const int d1 = __builtin_amdgcn_sdot8((int)buf[j].x, xh0, __builtin_amdgcn_sdot8((int)buf[j].y, xh1, 0, false), false);
        const int d2 = __builtin_amdgcn_sdot8((int)buf[j].x, xl0, __builtin_amdgcn_sdot8((int)buf[j].y, xl1, 0, false), false);
        p[j] = (d1 << 4) + d2; }
    int s1[8], s2[4];
#pragma unroll
    for (int m = 0; m < 8; ++m) s1[m] = swap32_addi(p[2 * m], p[2 * m + 1]);
#pragma unroll
    for (int n = 0; n < 4; ++n) s2[n] = swap16_addi(s1[2 * n], s1[2 * n + 1]);
#pragma unroll
    for (int r = 0; r < 4; ++r) { const int z = row_sum16i(s2[r]); const bool mine = i16 == ((4 * q + r) & 15);
        zlo = (mine && q < 4) ? z : zlo; zhi = (mine && q >= 4) ? z : zhi; }
}
__device__ __forceinline__ void phase_gather_u(const Params& P) {
    const int tid = threadIdx.x, lane = tid & 63, wave = __builtin_amdgcn_readfirstlane(tid >> 6);
    const int gw = blockIdx.x * NWAVES + wave, NGW = gridDim.x * NWAVES;
    unsigned char* ws = P.ws;
    const int* IDX = (const int*)(ws + WS_IDX); const float* GATE = (const float*)(ws + WS_GATE); const float* ESC = (const float*)(ws + WS_ESCALE); float* AW = (float*)(ws + WS_AW);
    const __amdgpu_buffer_rsrc_t rsU = __builtin_amdgcn_make_buffer_rsrc((void*)(ws + WS_U8), 0, 16384 * 512, 0x00020000);
    const bf16* H2B = (const bf16*)(ws + WS_H2B); const float* SSQ = (const float*)(ws + WS_SSQ);
    const int hh = lane >> 5, rr = (lane >> 4) & 1, i16 = lane & 15, gsel = 4 * i16 + 2 * rr + hh;
    const int voff = 8 * lane;
    const unsigned ul = (unsigned)lane;
    int t = gw;
    if (t < NTOK) {
        int idx0, idx1; u32x2 hraw[4]; float sqv;
        { const int* ip = IDX + (size_t)t * NSEL; idx0 = ip[ul]; idx1 = ip[64u + ul];
          const u32x2* hp = (const u32x2*)(H2B + (size_t)t * DM);
#pragma unroll
          for (int j = 0; j < 4; ++j) hraw[j] = hp[64u * j + ul];
          sqv = (SSQ + (size_t)t * 16)[ul & 15u]; }
        u32x2 R0[16], R1[16], R2[16], R3[16];
        { const int ix0 = idx0 << 9; q_issue(R0, rsU, ix0, 0, voff); q_issue(R1, rsU, ix0, 16, voff); q_issue(R2, rsU, ix0, 32, voff); }
        for (;;) {
            const int tn = t + NGW; const bool has_next = tn < NTOK; const int tl = has_next ? tn : t;
            int idx0n, idx1n; u32x2 hrawn[4]; float sqn, g0, g1;
            { const int* ip = IDX + (size_t)tl * NSEL; idx0n = ip[ul]; idx1n = ip[64u + ul];
              const u32x2* hp = (const u32x2*)(H2B + (size_t)tl * DM);
#pragma unroll
              for (int j = 0; j < 4; ++j) hrawn[j] = hp[64u * j + ul];
              sqn = (SSQ + (size_t)tl * 16)[ul & 15u];
              const float* gp = GATE + (size_t)t * NSEL; g0 = gp[ul]; g1 = gp[64u + ul]; }
            const float su0 = ESC[idx0], su1 = ESC[idx1], sv0 = ESC[16384 + idx0], sv1 = ESC[16384 + idx1];
            const float cq0 = ((const float*)(ws + WS_SUMQ))[idx0], cq1 = ((const float*)(ws + WS_SUMQ))[idx1];
            const float rstd2 = rsqrtf(row_sum16(sqv) * (1.f / DM) + EPS);
            float xf[16];
#pragma unroll
            for (int j = 0; j < 4; ++j) { xf[4 * j] = bflo(hraw[j].x); xf[4 * j + 1] = bfhi(hraw[j].x); xf[4 * j + 2] = bflo(hraw[j].y); xf[4 * j + 3] = bfhi(hraw[j].y); }
            float am = 0.f;
#pragma unroll
            for (int e = 0; e < 16; ++e) am = fmaxf(am, fabsf(xf[e]));
            am = fmaxf(wave_max_fast(am), 1e-30f);
            const float xinv = 127.f / am, xscale = am * (1.f / 127.f);
            unsigned xh[2] = {0u, 0u}, xl[2] = {0u, 0u};
#pragma unroll
            for (int j = 0; j < 4; ++j)
#pragma unroll
                for (int i = 0; i < 4; ++i) { const int xi = (int)rintf(xf[4 * j + i] * xinv); const int sh = 16 * (j & 1) + 4 * i;
                    xh[j >> 1] |= ((unsigned)(xi >> 4) & 15u) << sh; xl[j >> 1] |= ((unsigned)((xi & 15) - 8) & 15u) << sh; }
            int zlo = 0, zhi = 0;
            const int ix0 = idx0 << 9, ix1 = idx1 << 9;
#pragma unroll 1
            for (int qq = 0; qq < 8; qq += 4) {
                const int ixn = qq ? (idx0n << 9) : ix1;
                q_issue(R3, rsU, qq ? ix1 : ix0, 48, voff);
                q_compute_ui(R0, qq, i16, (int)xh[0], (int)xh[1], (int)xl[0], (int)xl[1], zlo, zhi);
                q_issue(R0, rsU, ixn, 0, voff);
                q_compute_ui(R1, qq + 1, i16, (int)xh[0], (int)xh[1], (int)xl[0], (int)xl[1], zlo, zhi);
                q_issue(R1, rsU, ixn, 16, voff);
                q_compute_ui(R2, qq + 2, i16, (int)xh[0], (int)xh[1], (int)xl[0], (int)xl[1], zlo, zhi);
                q_issue(R2, rsU, ixn, 32, voff);
                q_compute_ui(R3, qq + 3, i16, (int)xh[0], (int)xh[1], (int)xl[0], (int)xl[1], zlo, zhi);
            }
            const float glo = __shfl(g0, gsel), ghi = __shfl(g1, gsel), sulo = __shfl(su0, gsel), suhi = __shfl(su1, gsel), svlo = __shfl(sv0, gsel), svhi = __shfl(sv1, gsel);
            const float cqlo = __shfl(cq0, gsel), cqhi = __shfl(cq1, gsel);
            const float zfl = ((float)zlo + 8.f * cqlo) * (sulo * xscale * rstd2), zfh = ((float)zhi + 8.f * cqhi) * (suhi * xscale * rstd2);
            float* ap = AW + (size_t)t * NSEL;
            ap[lane] = gelu_tanh_f(zfl) * glo * svlo; ap[64 + lane] = gelu_tanh_f(zfh) * ghi * svhi;
            if (!has_next) break;
            t = tn; idx0 = idx0n; idx1 = idx1n; sqv = sqn;
#pragma unroll
            for (int j = 0; j < 4; ++j) hraw[j] = hrawn[j];
        }
    }
}
__device__ __forceinline__ void phase_gather_v(const Params& P) {
    const int tid = threadIdx.x, lane = tid & 63, wave = __builtin_amdgcn_readfirstlane(tid >> 6);
    const int gw = blockIdx.x * NWAVES + wave, NGW = gridDim.x * NWAVES;
    unsigned char* ws = P.ws;
    const int* IDX = (const int*)(ws + WS_IDX); const float* AW = (const float*)(ws + WS_AW);
    const __amdgpu_buffer_rsrc_t rsV = __builtin_amdgcn_make_buffer_rsrc((void*)(ws + WS_V8), 0, 16384 * 512, 0x00020000);
    const bf16* H2B = (const bf16*)(ws + WS_H2B);
    const int voff = 8 * lane;
    const unsigned ul = (unsigned)lane;
    int t = gw;
    if (t < NTOK) {
        int idx0, idx1; u32x2 hraw[4]; float alo, ahi;
        { const int* ip = IDX + (size_t)t * NSEL; idx0 = ip[ul]; idx1 = ip[64u + ul];
          const u32x2* hp = (const u32x2*)(H2B + (size_t)t * DM);
#pragma unroll
          for (int j = 0; j < 4; ++j) hraw[j] = hp[64u * j + ul];
          const float* ap = AW + (size_t)t * NSEL; alo = ap[ul]; ahi = ap[64u + ul]; }
        u32x2 R0[16], R1[16], R2[16], R3[16];
        { const int ix0 = idx0 << 9; q_issue(R0, rsV, ix0, 0, voff); q_issue(R1, rsV, ix0, 16, voff); q_issue(R2, rsV, ix0, 32, voff); }
        for (;;) {
            const int tn = t + NGW; const bool has_next = tn < NTOK; const int tl = has_next ? tn : t;
            int idx0n, idx1n; u32x2 hrawn[4]; float alon, ahin;
            { const int* ip = IDX + (size_t)tl * NSEL; idx0n = ip[ul]; idx1n = ip[64u + ul];
              const u32x2* hp = (const u32x2*)(H2B + (size_t)tl * DM);
#pragma unroll
              for (int j = 0; j < 4; ++j) hrawn[j] = hp[64u * j + ul];
              const float* ap = AW + (size_t)tl * NSEL; alon = ap[ul]; ahin = ap[64u + ul]; }
            f32x2 o[8];
#pragma unroll
            for (int j = 0; j < 8; ++j) o[j] = (f32x2){0.f, 0.f};
            const int ix0 = idx0 << 9, ix1 = idx1 << 9;
#pragma unroll 1
            for (int qq = 0; qq < 8; qq += 4) {
                const int ixn = qq ? (idx0n << 9) : ix1;
                q_issue(R3, rsV, qq ? ix1 : ix0, 48, voff);
                q_compute_v(R0, qq, alo, ahi, o);
                q_issue(R0, rsV, ixn, 0, voff);
                q_compute_v(R1, qq + 1, alo, ahi, o);
                q_issue(R1, rsV, ixn, 16, voff);
                q_compute_v(R2, qq + 2, alo, ahi, o);
                q_issue(R2, rsV, ixn, 32, voff);
                q_compute_v(R3, qq + 3, alo, ahi, o);
            }
            float ss = 0.f;
#pragma unroll
            for (int j = 0; j < 4; ++j) { o[2 * j] += (f32x2){bflo(hraw[j].x), bfhi(hraw[j].x)}; o[2 * j + 1] += (f32x2){bflo(hraw[j].y), bfhi(hraw[j].y)}; }
#pragma unroll
            for (int j = 0; j < 8; ++j) ss += o[j].x * o[j].x + o[j].y * o[j].y;
            ss = wave_sum_fast(ss);
            const float r3 = rsqrtf(ss * (1.f / DM) + EPS);
            f32x4* op = (f32x4*)(P.out + (size_t)t * DM);
            const f32x4* gfp = (const f32x4*)P.g_fin;
#pragma unroll
            for (int j = 0; j < 4; ++j) { const f32x4 gv = gfp[64u * j + ul]; op[64u * j + ul] = (f32x4){o[2 * j].x * r3 * gv.x, o[2 * j].y * r3 * gv.y, o[2 * j + 1].x * r3 * gv.z, o[2 * j + 1].y * r3 * gv.w}; }
            if (!has_next) break;
            t = tn; idx0 = idx0n; idx1 = idx1n; alo = alon; ahi = ahin;
#pragma unroll
            for (int j = 0; j < 4; ++j) hraw[j] = hrawn[j];
        }
    }
}

#define XB_TMO      128
#define XB_XCNT(j)  (256  + 64 * (j))
#define XB_XSUB(j)  (1280 + 64 * (j))
#define XB_XGEN(j)  (2304 + 64 * (j))
#define XB_TOP      3328
#define XB_TOPGEN   3392
#define XCD_BAR_WORDS 3456
#define XB_SPIN_CAP (1u << 18)

__device__ __forceinline__ unsigned xb_ld(unsigned* p)              { return __hip_atomic_load(p, __ATOMIC_RELAXED, __HIP_MEMORY_SCOPE_AGENT); }
__device__ __forceinline__ unsigned xb_add(unsigned* p, unsigned v) { return __hip_atomic_fetch_add(p, v, __ATOMIC_RELAXED, __HIP_MEMORY_SCOPE_AGENT); }
__device__ __forceinline__ unsigned xb_xcc_id() { return (unsigned)__builtin_amdgcn_s_getreg((3 << 11) | 20) & 0xFu; }
#define XB_SPIN(cond, bar) do { unsigned _sp = 0; while (cond) { __builtin_amdgcn_s_sleep(1); \
    if ((++_sp & 255u) == 0u) { if (xb_ld(&(bar)[XB_TMO])) break; if (_sp > XB_SPIN_CAP) { atomicAdd(&(bar)[XB_TMO], 1u); break; } } } } while (0)

struct XcdBarrier {
    unsigned* bar; unsigned x;
    volatile LAS unsigned* st;
};

__device__ __forceinline__ XcdBarrier xcd_barrier_post(unsigned* bar, volatile LAS unsigned* st) {
    XcdBarrier b; b.bar = bar; b.x = xb_xcc_id(); b.st = st;
    if (threadIdx.x == 0) (void)xb_add(&bar[XB_XCNT(b.x)], 1u);
    return b;
}
__device__ __forceinline__ void xcd_barrier_complete(unsigned* bar, unsigned x, unsigned& nloc, unsigned& nx) {
    const unsigned G = gridDim.x * gridDim.y * gridDim.z;
    unsigned sum, cnt, mine, sp = 0u;
    for (;;) {
        sum = 0u; cnt = 0u; mine = 0u;
#pragma unroll
        for (unsigned j = 0; j < 16; ++j) { const unsigned c = xb_ld(&bar[XB_XCNT(j)]); sum += c; cnt += (c > 0u) ? 1u : 0u; mine = (j == x) ? c : mine; }
        if (sum == G) break;
        __builtin_amdgcn_s_sleep(1);
        if ((++sp & 255u) == 0u) { if (xb_ld(&bar[XB_TMO])) break; if (sp > XB_SPIN_CAP) { atomicAdd(&bar[XB_TMO], 1u); break; } }
    }
    nloc = mine > 0u ? mine : 1u; nx = cnt > 0u ? cnt : 1u;
}

__device__ __forceinline__ void xcd_barrier(const XcdBarrier& b) {
    asm volatile("s_waitcnt vmcnt(0)" ::: "memory");
    __syncthreads();
    if (threadIdx.x == 0) {
        unsigned* bar = b.bar;
        __builtin_amdgcn_s_waitcnt(0);
        unsigned nloc = b.st[0], nx = b.st[1];
        if (nloc == 0u) { xcd_barrier_complete(bar, b.x, nloc, nx); b.st[0] = nloc; b.st[1] = nx; }
        const unsigned old = xb_add(&bar[XB_XSUB(b.x)], 1u);
        const unsigned gen = old / nloc;
        if (old + 1u == (gen + 1u) * nloc) {
            __builtin_amdgcn_fence(__ATOMIC_RELEASE, "agent");
            asm volatile("s_waitcnt vmcnt(0)" ::: "memory");
            const unsigned og = xb_add(&bar[XB_TOP], 1u);
            const unsigned tg = og / nx;
            if (og + 1u == (tg + 1u) * nx) xb_add(&bar[XB_TOPGEN], 1u);
            else XB_SPIN(xb_ld(&bar[XB_TOPGEN]) == tg, bar);
            __builtin_amdgcn_fence(__ATOMIC_ACQUIRE, "agent");
            xb_add(&bar[XB_XGEN(b.x)], 1u);
            asm volatile("s_waitcnt vmcnt(0)" ::: "memory");
        } else {
            XB_SPIN(xb_ld(&bar[XB_XGEN(b.x)]) == gen, bar);
            __builtin_amdgcn_fence(__ATOMIC_ACQUIRE, "agent");
            asm volatile("s_waitcnt vmcnt(0)" ::: "memory");
        }
    }
    __syncthreads();
}


#ifndef MK_MULTI
#define MK_MULTI 0
#endif
constexpr int NPHASE = 9;
#ifndef REP5
#define REP5 1
#endif
#ifndef REP6
#define REP6 1
#endif
__global__ void __launch_bounds__(NTHREADS, 2) mk_fwd(Params P) {
    extern __shared__ __attribute__((aligned(16))) unsigned char lds_raw[];
    LAS unsigned char* lds = (LAS unsigned char*)lds_raw;
    cg::grid_group grid = cg::this_grid();
    unsigned char* ws = P.ws;
    const int lo = P.ph_lo, hi = P.ph_hi;
    volatile LAS unsigned* bst = (volatile LAS unsigned*)(lds + 131072 + 64);
    if (threadIdx.x < 2) bst[threadIdx.x] = 0u;
    __syncthreads();
    XcdBarrier xbar = xcd_barrier_post((unsigned*)(ws + WS_CTL), bst);
#define IN(k) (lo <= (k) && (k) < hi)
#define SEAM(k) do { if (IN(k) && IN((k) + 1)) { xcd_barrier(xbar); } } while (0)
    if (IN(0)) phase_prep(P, lds);
    SEAM(0);
    if (IN(1)) { phase_metaproj(P); phase_winq(P, lds); }
    SEAM(1);
    if (IN(2)) {
        pg8::Gemm g{(const bf16*)(ws + WS_H0I8), (const bf16*)(ws + WS_WIN_T), NTOK, DIN, DM / 2}; pg8::StaticOrder S; S.init(NTOK, DIN, (int)gridDim.x, (int)blockIdx.x);
        EpiProjI8 E{(bf16*)(ws + WS_PROJ), (const float*)(ws + WS_RSTD1), (const float*)(ws + WS_SW)};
        pg8::gemm_phase_i8<EpiProjI8, pg8::StaticOrder, true, true>(lds, g, S, E);
    }
    SEAM(2);
    if (IN(3)) phase_conv(P, lds);
    SEAM(3);
    if (IN(4)) {
        pg8::Gemm g{(const bf16*)(ws + WS_Y), (const bf16*)(ws + WS_WOUT_T), NTOK, DM, DM}; pg8::StaticOrder S; S.init(NTOK, DM, (int)gridDim.x, (int)blockIdx.x);
        EpiResidual E{(bf16*)(ws + WS_H2B), (const signed char*)(ws + WS_H0I8), (const float*)(ws + WS_SX), (float*)(ws + WS_SSQ)};
        pg8::gemm_phase<EpiResidual, pg8::StaticOrder, true, true>(lds, g, S, E);
    }
    SEAM(4);
    if (IN(5)) {
        pg8::Gemm g{(const bf16*)(ws + WS_H2B), (const bf16*)(ws + WS_WQ_T), NTOK, 2048, DM}; pg8::StaticOrder S; S.init(NTOK, 2048, (int)gridDim.x, (int)blockIdx.x);
        EpiRowScale<1> E{(bf16*)(ws + WS_Q), 2048, (const float*)(ws + WS_SSQ)};
        pg8::gemm_phase<EpiRowScale<1>, pg8::StaticOrder, true, true>(lds, g, S, E);
    }
    if (IN(5) && IN(6)) { asm volatile("s_waitcnt vmcnt(0)" ::: "memory"); __syncthreads(); }
    if (IN(6)) phase_route(P, lds);
    SEAM(6);
    if (IN(7)) phase_gather_u(P);
    SEAM(7);
    if (IN(8)) phase_gather_v(P);
#undef IN
#undef SEAM
}

extern "C" void kernel_launch(void* const* d_in, const int* in_sizes, int n_in, void* d_out, int out_size, void* d_ws, size_t ws_size, hipStream_t stream) {
    static int grid = 0;
    if (grid == 0) {
        if (n_in != 18 || in_sizes[0] != NTOK * DM || out_size != NTOK * DM || ws_size < WS_END) {
            fprintf(stderr, "kernel_launch: unexpected shapes (n_in %d in0 %d out %d ws %zu)\n", n_in, n_in > 0 ? in_sizes[0] : -1, out_size, ws_size); grid = -1; return; }
        int dev = 0, cus = 0, per_cu = 0;
        (void)hipGetDevice(&dev); (void)hipDeviceGetAttribute(&cus, hipDeviceAttributeMultiprocessorCount, dev);
        if (hipFuncSetAttribute((const void*)mk_fwd, hipFuncAttributeMaxDynamicSharedMemorySize, LDS_BYTES) != hipSuccess) { fprintf(stderr, "kernel_launch: hipFuncSetAttribute failed\n"); grid = -1; return; }
        if (hipOccupancyMaxActiveBlocksPerMultiprocessor(&per_cu, (const void*)mk_fwd, NTHREADS, LDS_BYTES) != hipSuccess || per_cu < 1) { fprintf(stderr, "kernel_launch: occupancy query failed (%d)\n", per_cu); (void)hipGetLastError(); per_cu = 1; }
        if (per_cu > 1) per_cu = 1;
        grid = cus * per_cu;
        if (grid <= 0) grid = 256;
    }
    if (grid < 0) return;
    Params p{};
    p.x = (const float*)d_in[0]; p.meta = (const float*)d_in[1]; p.g_mix = (const float*)d_in[2]; p.w_in = (const float*)d_in[3]; p.sc_w = (const float*)d_in[4];
    p.cf_w = (const float*)d_in[5]; p.cf_b = (const float*)d_in[6]; p.ln_g = (const float*)d_in[7]; p.ln_b = (const float*)d_in[8]; p.g_sc = (const float*)d_in[9];
    p.g_cf = (const float*)d_in[10]; p.w_out = (const float*)d_in[11]; p.g_ffn = (const float*)d_in[12]; p.w_q = (const float*)d_in[13]; p.keys = (const float*)d_in[14];
    p.pu = (const float*)d_in[15]; p.pv = (const float*)d_in[16]; p.g_fin = (const float*)d_in[17];
    p.out = (float*)d_out; p.ws = (unsigned char*)d_ws;
    (void)hipMemsetAsync((char*)d_ws + WS_CTL, 0, 32768, stream);
#if MK_MULTI
    for (int ph = 0; ph < NPHASE; ++ph) { p.ph_lo = ph; p.ph_hi = ph + 1; p.coop = 0; p.pad = 0;
        hipLaunchKernelGGL(mk_fwd, dim3(grid), dim3(NTHREADS), LDS_BYTES, stream, p); }
#else
    p.ph_lo = 0; p.ph_hi = NPHASE; p.coop = 1; p.pad = 0;
    void* args[] = {&p};
    hipError_t e = hipLaunchCooperativeKernel((const void*)mk_fwd, dim3(grid), dim3(NTHREADS), args, LDS_BYTES, stream);
    if (e != hipSuccess) fprintf(stderr, "cooperative launch failed: %s (grid %d)\n", hipGetErrorString(e), grid);
#endif
}
```

```cpp
#include <hip/hip_runtime.h>
#include <hip/hip_cooperative_groups.h>
#include <cstdio>
#include <cstdint>
namespace cg = cooperative_groups;

namespace pg8 {
#define PG8_LAS __attribute__((address_space(3)))
typedef unsigned short bf16_t;
typedef short bf16x8 __attribute__((ext_vector_type(8)));
typedef float f32x4 __attribute__((ext_vector_type(4)));
typedef unsigned u32x4 __attribute__((ext_vector_type(4)));
typedef int i32x4 __attribute__((ext_vector_type(4)));
constexpr int BM = 256, BK = 64, HALF = 128, HTB = HALF * BK * 2  , STAGE_BYTES = 8 * HTB, NXCD = 8, WGM = 8;

__host__ __device__ __forceinline__ int lds_byte(int r, int c) { const int st = (r >> 4) * 2 + (c >> 5), rr = r & 15, cc = c & 31, ob = rr * 64 + cc * 2; return st * 1024 + (ob ^ (((ob >> 9) & 1) << 5)); }
__host__ __device__ __forceinline__ void stage_rc(int b, int& R, int& C) { const int st = b / 1024, sb = b % 1024, swz = sb ^ (((sb >> 9) & 1) << 5); R = (st >> 1) * 16 + swz / 64; C = (st & 1) * 32 + (swz % 64) / 2; }
__host__ __device__ __forceinline__ int perm32(int rho) { const int n = rho >> 4, i = rho & 15; return 8 * (i >> 2) + 4 * n + (i & 3); }

struct Unit { int pm, pn; };
struct Gemm { const bf16_t* A; const bf16_t* Bt; int M, N, K; };

struct StaticOrder {
    int nM, nN, nwg, G, c;
    __host__ __device__ void init(int M, int N, int G_, int c_) { nM = M / BM; nN = N / BM; nwg = nM * nN; G = G_; c = c_; }
    __host__ __device__ bool next(int i, Unit& u) const {
        const long L = (long)i * G + c; if (L >= nwg) return false;
        int wgid = (int)L; { const int q = nwg / NXCD, r = nwg % NXCD, xcd = wgid % NXCD, off = wgid / NXCD; wgid = (xcd < r ? xcd * (q + 1) : r * (q + 1) + (xcd - r) * q) + off; }
        const int nig = WGM * nN, gid = wgid / nig, fm = gid * WGM, gsz = (nM - fm) < WGM ? (nM - fm) : WGM;
        u.pm = fm + ((wgid % nig) % gsz); u.pn = (wgid % nig) / gsz; return true;
    }
    __device__ __forceinline__ void a_ready(const Unit&) const {}
    __device__ __forceinline__ void done(const Unit&) const {}
};

template <class Epi, class Sched, bool ALIGN_EPI = false, bool SP2 = false>
__device__ __forceinline__ void gemm_phase(PG8_LAS unsigned char* lds, const Gemm g, const Sched& S, const Epi& E) {
    const int tid = threadIdx.x, wid = __builtin_amdgcn_readfirstlane(tid >> 6), lane = tid & 63, wr = wid >> 2, wc = wid & 3, fr = lane & 15, fq = lane >> 4;
    const int K = g.K, nt = K / BK;
    unsigned voffA[2], voffB[2];
#pragma unroll
    for (int i = 0; i < 2; ++i) { int R, C; stage_rc(tid * 16 + i * 8192, R, C); const int Rb = Epi::PERM ? ((R & ~31) + perm32(R & 31)) : R;
        voffA[i] = (unsigned)(R * K + C) * 2u; voffB[i] = (unsigned)(Rb * K + C) * 2u; }
    const size_t kstep = (size_t)(BK * 2);
    const size_t hstep = (size_t)HALF * K * 2;
    const size_t tstep = 2 * hstep;
    const unsigned ldsw = (unsigned)wid * 1024u;
    const int aoff = lds_byte(wr * 64 + fr, fq * 8), boff = lds_byte(wc * 32 + fr, fq * 8);
#define PG8_SA(b, h) (((b) * 2 + (h)) * HTB)
#define PG8_SB(b, h) ((4 + (b) * 2 + (h)) * HTB)
#define PG8_STAGE(bufoff, gbase, voff) do { _Pragma("unroll") for (int _i = 0; _i < 2; ++_i) \
        __builtin_amdgcn_global_load_lds((const unsigned*)((const char*)(gbase) + (voff)[_i]), (PG8_LAS unsigned*)(lds + (bufoff) + ldsw + _i * 8192), 16, 0, 0); } while (0)
#define PG8_LDA(dst, b, h) do { _Pragma("unroll") for (int m = 0; m < 4; ++m) _Pragma("unroll") for (int k = 0; k < 2; ++k) dst[m][k] = *(const PG8_LAS bf16x8*)(lds + PG8_SA(b, h) + aoff + m * 2048 + k * 1024); } while (0)
#define PG8_LDB(dst, b, h) do { _Pragma("unroll") for (int n = 0; n < 2; ++n) _Pragma("unroll") for (int k = 0; k < 2; ++k) dst[n][k] = *(const PG8_LAS bf16x8*)(lds + PG8_SB(b, h) + boff + n * 2048 + k * 1024); } while (0)
#define PG8_MMA(ai, bj, At, Bt) do { __builtin_amdgcn_s_setprio(1); _Pragma("unroll") for (int m = 0; m < 4; ++m) _Pragma("unroll") for (int n = 0; n < 2; ++n) _Pragma("unroll") for (int k = 0; k < 2; ++k) \
        acc[ai][bj][m][n] = __builtin_amdgcn_mfma_f32_16x16x32_bf16(Bt[n][k], At[m][k], acc[ai][bj][m][n], 0, 0, 0); __builtin_amdgcn_s_setprio(0); } while (0)
#define PG8_WAIT_V(n) asm volatile("s_waitcnt vmcnt(" #n ")" ::: "memory")
#define PG8_WAIT_L(n) asm volatile("s_waitcnt lgkmcnt(" #n ")" ::: "memory")
#define PG8_BAR __builtin_amdgcn_s_barrier()
#define PG8_SCHED __builtin_amdgcn_sched_barrier(0)
    Unit cur, nxt; int ui = 0;
    if (!S.next(0, cur)) return;
    f32x4 acc[2][2][4][2];
#pragma unroll
    for (int a = 0; a < 2; ++a)
#pragma unroll
        for (int b = 0; b < 2; ++b)
#pragma unroll
            for (int m = 0; m < 4; ++m)
#pragma unroll
                for (int n = 0; n < 2; ++n) acc[a][b][m][n] = (f32x4){0.f, 0.f, 0.f, 0.f};
    bf16x8 At[4][2], B0[2][2], B1[2][2];
    const char* cA = (const char*)g.A + (size_t)cur.pm * tstep; const char* cB = (const char*)g.Bt + (size_t)cur.pn * tstep;
    S.a_ready(cur);
    if constexpr (SP2) {
        PG8_STAGE(PG8_SB(0, 0), cB, voffB); PG8_STAGE(PG8_SB(0, 1), cB + hstep, voffB); PG8_STAGE(PG8_SA(0, 0), cA, voffA); PG8_STAGE(PG8_SA(0, 1), cA + hstep, voffA);
        if (wr == 1) PG8_BAR;
        PG8_WAIT_V(2); PG8_BAR;
        PG8_STAGE(PG8_SB(1, 0), cB + kstep, voffB); PG8_STAGE(PG8_SA(1, 0), cA + kstep, voffA); PG8_STAGE(PG8_SB(1, 1), cB + hstep + kstep, voffB);
        PG8_WAIT_V(6); PG8_BAR;
    } else {
        PG8_STAGE(PG8_SB(0, 0), cB, voffB); PG8_STAGE(PG8_SA(0, 0), cA, voffA); PG8_STAGE(PG8_SB(0, 1), cB + hstep, voffB); PG8_STAGE(PG8_SA(0, 1), cA + hstep, voffA);
        if (wr == 1) PG8_BAR;
        PG8_WAIT_V(4); PG8_BAR;
        PG8_STAGE(PG8_SB(1, 0), cB + kstep, voffB); PG8_STAGE(PG8_SA(1, 0), cA + kstep, voffA); PG8_STAGE(PG8_SB(1, 1), cB + hstep + kstep, voffB);
        PG8_WAIT_V(6); PG8_BAR;
    }
    for (;;) {
        const bool has_next = S.next(ui + 1, nxt);
        const char* nA = has_next ? (const char*)g.A + (size_t)nxt.pm * tstep : cA; const char* nB = has_next ? (const char*)g.Bt + (size_t)nxt.pn * tstep : cB;
        for (int t = 0; t < nt; t += 2) {
            const bool last = (t == nt - 2);
            const char* a1 = cA + (size_t)(t + 1) * kstep;
            const char* a2 = last ? nA : cA + (size_t)(t + 2) * kstep; const char* b2 = last ? nB : cB + (size_t)(t + 2) * kstep;
            const char* a3 = a2 + kstep; const char* b3 = b2 + kstep;
            if (last && has_next) S.a_ready(nxt);
            if constexpr (SP2) {
            PG8_LDB(B0, 0, 0); PG8_LDB(B1, 0, 1); PG8_SCHED; PG8_LDA(At, 0, 0); PG8_STAGE(PG8_SA(1, 1), a1 + hstep, voffA);
            PG8_WAIT_V(8); PG8_WAIT_L(0); PG8_BAR; PG8_MMA(0, 0, At, B0); PG8_MMA(0, 1, At, B1); PG8_BAR; PG8_SCHED;
            PG8_LDA(At, 0, 1); PG8_STAGE(PG8_SB(0, 0), b2, voffB); PG8_STAGE(PG8_SB(0, 1), b2 + hstep, voffB); PG8_STAGE(PG8_SA(0, 0), a2, voffA);
            PG8_WAIT_V(8); PG8_WAIT_L(0); PG8_BAR; PG8_MMA(1, 0, At, B0); PG8_MMA(1, 1, At, B1); PG8_BAR; PG8_SCHED;
            PG8_LDB(B0, 1, 0); PG8_LDB(B1, 1, 1); PG8_SCHED; PG8_LDA(At, 1, 0); PG8_STAGE(PG8_SA(0, 1), a2 + hstep, voffA);
            PG8_WAIT_V(8); PG8_WAIT_L(0); PG8_BAR; PG8_MMA(0, 0, At, B0); PG8_MMA(0, 1, At, B1); PG8_BAR; PG8_SCHED;
            PG8_LDA(At, 1, 1); PG8_STAGE(PG8_SB(1, 0), b3, voffB); PG8_STAGE(PG8_SB(1, 1), b3 + hstep, voffB); PG8_STAGE(PG8_SA(1, 0), a3, voffA);
            PG8_WAIT_V(8); PG8_WAIT_L(0); PG8_BAR; PG8_MMA(1, 0, At, B0); PG8_MMA(1, 1, At, B1); PG8_BAR; PG8_SCHED;
            } else {
            PG8_LDB(B0, 0, 0); PG8_SCHED; PG8_LDA(At, 0, 0); PG8_STAGE(PG8_SA(1, 1), a1 + hstep, voffA);
            PG8_WAIT_L(8); PG8_BAR; PG8_WAIT_L(0); PG8_MMA(0, 0, At, B0); PG8_BAR; PG8_SCHED;
            PG8_LDB(B1, 0, 1); PG8_STAGE(PG8_SB(0, 0), b2, voffB);
            PG8_BAR; PG8_WAIT_L(0); PG8_MMA(0, 1, At, B1); PG8_BAR;
            PG8_LDA(At, 0, 1); PG8_STAGE(PG8_SA(0, 0), a2, voffA);
            PG8_BAR; PG8_WAIT_L(0); PG8_MMA(1, 0, At, B0); PG8_BAR; PG8_SCHED;
            PG8_STAGE(PG8_SB(0, 1), b2 + hstep, voffB);
            PG8_WAIT_V(6); PG8_BAR; PG8_MMA(1, 1, At, B1); PG8_BAR;
            PG8_LDB(B0, 1, 0); PG8_SCHED; PG8_LDA(At, 1, 0); PG8_STAGE(PG8_SA(0, 1), a2 + hstep, voffA);
            PG8_WAIT_L(8); PG8_BAR; PG8_WAIT_L(0); PG8_MMA(0, 0, At, B0); PG8_BAR; PG8_SCHED;
            PG8_LDB(B1, 1, 1); PG8_STAGE(PG8_SB(1, 0), b3, voffB);
            PG8_BAR; PG8_WAIT_L(0); PG8_MMA(0, 1, At, B1); PG8_BAR;
            PG8_LDA(At, 1, 1); PG8_STAGE(PG8_SA(1, 0), a3, voffA);
            PG8_BAR; PG8_WAIT_L(0); PG8_MMA(1, 0, At, B0); PG8_BAR; PG8_SCHED;
            PG8_STAGE(PG8_SB(1, 1), b3 + hstep, voffB);
            PG8_WAIT_V(6); PG8_BAR; PG8_MMA(1, 1, At, B1); PG8_BAR;
            }
        }
        if constexpr (ALIGN_EPI) { if (wr == 0) PG8_BAR; }
        if constexpr (!Epi::AFTER_DRAIN) { E(acc, cur, wr, wc, fr, fq); S.done(cur); }
        if (!has_next) break;
#pragma unroll
        for (int a = 0; a < 2; ++a)
#pragma unroll
            for (int b = 0; b < 2; ++b)
#pragma unroll
                for (int m = 0; m < 4; ++m)
#pragma unroll
                    for (int n = 0; n < 2; ++n) acc[a][b][m][n] = (f32x4){0.f, 0.f, 0.f, 0.f};
        cur = nxt; cA = nA; cB = nB; ++ui;
        if constexpr (ALIGN_EPI) { if (wr == 1) PG8_BAR; }
    }
    PG8_WAIT_V(0);
    if constexpr (!ALIGN_EPI) { if (wr == 0) PG8_BAR; }
    PG8_BAR;
    if constexpr (Epi::AFTER_DRAIN) { E.fused(acc, cur, wr, wc, fr, fq, lds, wid, lane); S.done(cur); }
#undef PG8_SA
#undef PG8_SB
#undef PG8_STAGE
#undef PG8_LDA
#undef PG8_LDB
#undef PG8_MMA
#undef PG8_WAIT_V
#undef PG8_WAIT_L
#undef PG8_BAR
#undef PG8_SCHED
}
template <class Epi, class Sched, bool ALIGN_EPI = false, bool SP2 = false>
__device__ __forceinline__ void gemm_phase_i8(PG8_LAS unsigned char* lds, const Gemm g, const Sched& S, const Epi& E) {
    const int tid = threadIdx.x, wid = __builtin_amdgcn_readfirstlane(tid >> 6), lane = tid & 63, wr = wid >> 2, wc = wid & 3, fr = lane & 15, fq = lane >> 4;
    const int K = g.K, nt = K / BK;
    unsigned voffA[2], voffB[2];
#pragma unroll
    for (int i = 0; i < 2; ++i) { int R, C; stage_rc(tid * 16 + i * 8192, R, C); const int Rb = Epi::PERM ? ((R & ~31) + perm32(R & 31)) : R;
        voffA[i] = (unsigned)(R * K + C) * 2u; voffB[i] = (unsigned)(Rb * K + C) * 2u; }
    const size_t kstep = (size_t)(BK * 2);
    const size_t hstep = (size_t)HALF * K * 2;
    const size_t tstep = 2 * hstep;
    const unsigned ldsw = (unsigned)wid * 1024u;
    const int aoff = lds_byte(wr * 64 + fr, fq * 8), boff = lds_byte(wc * 32 + fr, fq * 8);
#define PG8_SA(b, h) (((b) * 2 + (h)) * HTB)
#define PG8_SB(b, h) ((4 + (b) * 2 + (h)) * HTB)
#define PG8_STAGE(bufoff, gbase, voff) do { _Pragma("unroll") for (int _i = 0; _i < 2; ++_i) \
        __builtin_amdgcn_global_load_lds((const unsigned*)((const char*)(gbase) + (voff)[_i]), (PG8_LAS unsigned*)(lds + (bufoff) + ldsw + _i * 8192), 16, 0, 0); } while (0)
#define PG8_LDA(dst, b, h) do { _Pragma("unroll") for (int m = 0; m < 4; ++m) _Pragma("unroll") for (int k = 0; k < 2; ++k) dst[m][k] = *(const PG8_LAS bf16x8*)(lds + PG8_SA(b, h) + aoff + m * 2048 + k * 1024); } while (0)
#define PG8_LDB(dst, b, h) do { _Pragma("unroll") for (int n = 0; n < 2; ++n) _Pragma("unroll") for (int k = 0; k < 2; ++k) dst[n][k] = *(const PG8_LAS bf16x8*)(lds + PG8_SB(b, h) + boff + n * 2048 + k * 1024); } while (0)
#define PG8_MMA(ai, bj, At, Bt) do { __builtin_amdgcn_s_setprio(1); _Pragma("unroll") for (int m = 0; m < 4; ++m) _Pragma("unroll") for (int n = 0; n < 2; ++n) _Pragma("unroll") for (int k = 0; k < 2; ++k) \
        acc[ai][bj][m][n] = __builtin_amdgcn_mfma_i32_16x16x64_i8(__builtin_bit_cast(i32x4, Bt[n][k]), __builtin_bit_cast(i32x4, At[m][k]), acc[ai][bj][m][n], 0, 0, 0); __builtin_amdgcn_s_setprio(0); } while (0)
#define PG8_WAIT_V(n) asm volatile("s_waitcnt vmcnt(" #n ")" ::: "memory")
#define PG8_WAIT_L(n) asm volatile("s_waitcnt lgkmcnt(" #n ")" ::: "memory")
#define PG8_BAR __builtin_amdgcn_s_barrier()
#define PG8_SCHED __builtin_amdgcn_sched_barrier(0)
    Unit cur, nxt; int ui = 0;
    if (!S.next(0, cur)) return;
    i32x4 acc[2][2][4][2];
#pragma unroll
    for (int a = 0; a < 2; ++a)
#pragma unroll
        for (int b = 0; b < 2; ++b)
#pragma unroll
            for (int m = 0; m < 4; ++m)
#pragma unroll
                for (int n = 0; n < 2; ++n) acc[a][b][m][n] = (i32x4){0, 0, 0, 0};
    bf16x8 At[4][2], B0[2][2], B1[2][2];
    const char* cA = (const char*)g.A + (size_t)cur.pm * tstep; const char* cB = (const char*)g.Bt + (size_t)cur.pn * tstep;
    S.a_ready(cur);
    if constexpr (SP2) {
        PG8_STAGE(PG8_SB(0, 0), cB, voffB); PG8_STAGE(PG8_SB(0, 1), cB + hstep, voffB); PG8_STAGE(PG8_SA(0, 0), cA, voffA); PG8_STAGE(PG8_SA(0, 1), cA + hstep, voffA);
        if (wr == 1) PG8_BAR;
        PG8_WAIT_V(2); PG8_BAR;
        PG8_STAGE(PG8_SB(1, 0), cB + kstep, voffB); PG8_STAGE(PG8_SA(1, 0), cA + kstep, voffA); PG8_STAGE(PG8_SB(1, 1), cB + hstep + kstep, voffB);
        PG8_WAIT_V(6); PG8_BAR;
    } else {
        PG8_STAGE(PG8_SB(0, 0), cB, voffB); PG8_STAGE(PG8_SA(0, 0), cA, voffA); PG8_STAGE(PG8_SB(0, 1), cB + hstep, voffB); PG8_STAGE(PG8_SA(0, 1), cA + hstep, voffA);
        if (wr == 1) PG8_BAR;
        PG8_WAIT_V(4); PG8_BAR;
        PG8_STAGE(PG8_SB(1, 0), cB + kstep, voffB); PG8_STAGE(PG8_SA(1, 0), cA + kstep, voffA); PG8_STAGE(PG8_SB(1, 1), cB + hstep + kstep, voffB);
        PG8_WAIT_V(6); PG8_BAR;
    }
    for (;;) {
        const bool has_next = S.next(ui + 1, nxt);
        const char* nA = has_next ? (const char*)g.A + (size_t)nxt.pm * tstep : cA; const char* nB = has_next ? (const char*)g.Bt + (size_t)nxt.pn * tstep : cB;
        for (int t = 0; t < nt; t += 2) {
            const bool last = (t == nt - 2);
            const char* a1 = cA + (size_t)(t + 1) * kstep;
            const char* a2 = last ? nA : cA + (size_t)(t + 2) * kstep; const char* b2 = last ? nB : cB + (size_t)(t + 2) * kstep;
            const char* a3 = a2 + kstep; const char* b3 = b2 + kstep;
            if (last && has_next) S.a_ready(nxt);
            if constexpr (SP2) {
            PG8_LDB(B0, 0, 0); PG8_LDB(B1, 0, 1); PG8_SCHED; PG8_LDA(At, 0, 0); PG8_STAGE(PG8_SA(1, 1), a1 + hstep, voffA);
            PG8_WAIT_V(8); PG8_WAIT_L(0); PG8_BAR; PG8_MMA(0, 0, At, B0); PG8_MMA(0, 1, At, B1); PG8_BAR; PG8_SCHED;
            PG8_LDA(At, 0, 1); PG8_STAGE(PG8_SB(0, 0), b2, voffB); PG8_STAGE(PG8_SB(0, 1), b2 + hstep, voffB); PG8_STAGE(PG8_SA(0, 0), a2, voffA);
            PG8_WAIT_V(8); PG8_WAIT_L(0); PG8_BAR; PG8_MMA(1, 0, At, B0); PG8_MMA(1, 1, At, B1); PG8_BAR; PG8_SCHED;
            PG8_LDB(B0, 1, 0); PG8_LDB(B1, 1, 1); PG8_SCHED; PG8_LDA(At, 1, 0); PG8_STAGE(PG8_SA(0, 1), a2 + hstep, voffA);
            PG8_WAIT_V(8); PG8_WAIT_L(0); PG8_BAR; PG8_MMA(0, 0, At, B0); PG8_MMA(0, 1, At, B1); PG8_BAR; PG8_SCHED;
            PG8_LDA(At, 1, 1); PG8_STAGE(PG8_SB(1, 0), b3, voffB); PG8_STAGE(PG8_SB(1, 1), b3 + hstep, voffB); PG8_STAGE(PG8_SA(1, 0), a3, voffA);
            PG8_WAIT_V(8); PG8_WAIT_L(0); PG8_BAR; PG8_MMA(1, 0, At, B0); PG8_MMA(1, 1, At, B1); PG8_BAR; PG8_SCHED;
            } else {
            PG8_LDB(B0, 0, 0); PG8_SCHED; PG8_LDA(At, 0, 0); PG8_STAGE(PG8_SA(1, 1), a1 + hstep, voffA);
            PG8_WAIT_L(8); PG8_BAR; PG8_WAIT_L(0); PG8_MMA(0, 0, At, B0); PG8_BAR; PG8_SCHED;
            PG8_LDB(B1, 0, 1); PG8_STAGE(PG8_SB(0, 0), b2, voffB);
            PG8_BAR; PG8_WAIT_L(0); PG8_MMA(0, 1, At, B1); PG8_BAR;
            PG8_LDA(At, 0, 1); PG8_STAGE(PG8_SA(0, 0), a2, voffA);
            PG8_BAR; PG8_WAIT_L(0); PG8_MMA(1, 0, At, B0); PG8_BAR; PG8_SCHED;
            PG8_STAGE(PG8_SB(0, 1), b2 + hstep, voffB);
            PG8_WAIT_V(6); PG8_BAR; PG8_MMA(1, 1, At, B1); PG8_BAR;
            PG8_LDB(B0, 1, 0); PG8_SCHED; PG8_LDA(At, 1, 0); PG8_STAGE(PG8_SA(0, 1), a2 + hstep, voffA);
            PG8_WAIT_L(8); PG8_BAR; PG8_WAIT_L(0); PG8_MMA(0, 0, At, B0); PG8_BAR; PG8_SCHED;
            PG8_LDB(B1, 1, 1); PG8_STAGE(PG8_SB(1, 0), b3, voffB);
            PG8_BAR; PG8_WAIT_L(0); PG8_MMA(0, 1, At, B1); PG8_BAR;
            PG8_LDA(At, 1, 1); PG8_STAGE(PG8_SA(1, 0), a3, voffA);
            PG8_BAR; PG8_WAIT_L(0); PG8_MMA(1, 0, At, B0); PG8_BAR; PG8_SCHED;
            PG8_STAGE(PG8_SB(1, 1), b3 + hstep, voffB);
            PG8_WAIT_V(6); PG8_BAR; PG8_MMA(1, 1, At, B1); PG8_BAR;
            }
        }
        if constexpr (ALIGN_EPI) { if (wr == 0) PG8_BAR; }
        if constexpr (!Epi::AFTER_DRAIN) { E(acc, cur, wr, wc, fr, fq); S.done(cur); }
        if (!has_next) break;
#pragma unroll
        for (int a = 0; a < 2; ++a)
#pragma unroll
            for (int b = 0; b < 2; ++b)
#pragma unroll
                for (int m = 0; m < 4; ++m)
#pragma unroll
                    for (int n = 0; n < 2; ++n) acc[a][b][m][n] = (i32x4){0, 0, 0, 0};
        cur = nxt; cA = nA; cB = nB; ++ui;
        if constexpr (ALIGN_EPI) { if (wr == 1) PG8_BAR; }
    }
    PG8_WAIT_V(0);
    if constexpr (!ALIGN_EPI) { if (wr == 0) PG8_BAR; }
    PG8_BAR;
    if constexpr (Epi::AFTER_DRAIN) { E.fused(acc, cur, wr, wc, fr, fq, lds, wid, lane); S.done(cur); }
#undef PG8_SA
#undef PG8_SB
#undef PG8_STAGE
#undef PG8_LDA
#undef PG8_LDB
#undef PG8_MMA
#undef PG8_WAIT_V
#undef PG8_WAIT_L
#undef PG8_BAR
#undef PG8_SCHED
}
}

#define LAS __attribute__((address_space(3)))
typedef unsigned short bf16;
typedef float f32x2 __attribute__((ext_vector_type(2)));
typedef float f32x4 __attribute__((ext_vector_type(4)));
typedef unsigned u32x2 __attribute__((ext_vector_type(2)));
typedef unsigned u32x4 __attribute__((ext_vector_type(4)));

constexpr int PDIM = 1536;
constexpr int NTOK = 32768, DM = 1024, DIN = 2560, SEQ = 8192, NBATCH = 4, NMETA = 16;
constexpr int NHEAD = 8, NKEYS = 128, TOPK = 16, NSEL = NHEAD * TOPK;
constexpr float EPS = 1e-6f;
constexpr float U_SCALE = 64.f, V_SCALE = 16.f;
constexpr float U4_CLIP = 2.6f;
constexpr int NWAVES = 8, NTHREADS = 512;
constexpr int MKC = 32;
constexpr int LDS_BYTES = 147456;

constexpr size_t MiB = 1u << 20;
constexpr size_t WS_CTL = 0, WS_WIN_T = 1 * MiB, WS_WOUT_T = 6 * MiB, WS_WQ_T = 8 * MiB, WS_KEYS = 12 * MiB, WS_METAPART = 160 * MiB  ,
                 WS_METARSTD = 14 * MiB + 512 * 1024, WS_METAPROJ = 14 * MiB + 576 * 1024, WS_RSTD1 = 15 * MiB, WS_SSQ = 16 * MiB, WS_U8 = 32 * MiB, WS_V8 = 48 * MiB,
                 WS_IDX = 64 * MiB, WS_GATE = 80 * MiB, WS_H0B = 96 * MiB, WS_H2B = 96 * MiB, WS_Y = 160 * MiB, WS_PROJ = 224 * MiB,
                 WS_Q = 224 * MiB, WS_ESCALE = 18 * MiB, WS_SUMQ = 19 * MiB, WS_SX = 20 * MiB, WS_SW = 21 * MiB, WS_SY = 22 * MiB, WS_SWO = 23 * MiB, WS_H0I8 = 384 * MiB, WS_AW = 160 * MiB  , WS_END = 416 * MiB;

struct Params {
    const float* x; const float* meta; const float* g_mix; const float* w_in; const float* sc_w; const float* cf_w; const float* cf_b;
    const float* ln_g; const float* ln_b; const float* g_sc; const float* g_cf; const float* w_out; const float* g_ffn; const float* w_q;
    const float* keys; const float* pu; const float* pv; const float* g_fin;
    float* out; unsigned char* ws;
    int ph_lo, ph_hi, coop, pad;
};

__device__ __forceinline__ unsigned f2bf(float f) { unsigned u = __builtin_bit_cast(unsigned, f); return (u + 0x7fffu + ((u >> 16) & 1u)) >> 16; }
__device__ __forceinline__ unsigned pk2(float lo, float hi) { return f2bf(lo) | (f2bf(hi) << 16); }
__device__ __forceinline__ float bf2f(unsigned b) { return __builtin_bit_cast(float, b << 16); }
__device__ __forceinline__ float bflo(unsigned w) { return __builtin_bit_cast(float, w << 16); }
__device__ __forceinline__ float bfhi(unsigned w) { return __builtin_bit_cast(float, w & 0xffff0000u); }
__device__ __forceinline__ float wave_sum(float v) {
#pragma unroll
    for (int o = 1; o < 64; o <<= 1) v += __shfl_xor(v, o);
    return v;
}
template <int CTRL> __device__ __forceinline__ float dpp_f(float v) { return __builtin_bit_cast(float, __builtin_amdgcn_update_dpp(0, __builtin_bit_cast(int, v), CTRL, 0xf, 0xf, true)); }
__device__ __forceinline__ float wave_sum_fast(float v) {
    v += dpp_f<0xB1>(v); v += dpp_f<0x4E>(v); v += dpp_f<0x141>(v); v += dpp_f<0x140>(v);
    { auto r = __builtin_amdgcn_permlane16_swap(__float_as_uint(v), __float_as_uint(v), false, false); v = __uint_as_float(r[0]) + __uint_as_float(r[1]); }
    { auto r = __builtin_amdgcn_permlane32_swap(__float_as_uint(v), __float_as_uint(v), false, false); v = __uint_as_float(r[0]) + __uint_as_float(r[1]); }
    return v;
}
__device__ __forceinline__ float wave_max_fast(float v) {
    v = fmaxf(v, dpp_f<0xB1>(v)); v = fmaxf(v, dpp_f<0x4E>(v)); v = fmaxf(v, dpp_f<0x141>(v)); v = fmaxf(v, dpp_f<0x140>(v));
    { auto r = __builtin_amdgcn_permlane16_swap(__float_as_uint(v), __float_as_uint(v), false, false); v = fmaxf(__uint_as_float(r[0]), __uint_as_float(r[1])); }
    { auto r = __builtin_amdgcn_permlane32_swap(__float_as_uint(v), __float_as_uint(v), false, false); v = fmaxf(__uint_as_float(r[0]), __uint_as_float(r[1])); }
    return v;
}
__device__ __forceinline__ float sigmoid_f(float x) { return 1.f / (1.f + __expf(-x)); }
__device__ __forceinline__ float gelu_tanh_f(float x) {
    const float t = 0.7978845608028654f * (x + 0.044715f * x * x * x);
    const float e = __expf(2.f * t);
    const float th = 1.f - 2.f / (e + 1.f);
    return 0.5f * x * (1.f + th);
}

__device__ __forceinline__ unsigned cvt_pk_bf16(float lo, float hi) { unsigned r; asm volatile("v_cvt_pk_bf16_f32 %0, %1, %2" : "=v"(r) : "v"(lo), "v"(hi)); return r; }

template <int MODE> struct EpiRowScale {
    static constexpr bool PERM = true, AFTER_DRAIN = false;
    bf16* O; int ldc; const float* rs;
    __device__ __forceinline__ void operator()(const pg8::f32x4 (&acc)[2][2][4][2], const pg8::Unit& u, int wr, int wc, int fr, int fq) const {
        const int row0 = u.pm * 256 + wr * 64 + fr, col0 = u.pn * 256 + wc * 32 + 8 * fq;
#pragma unroll
        for (int ai = 0; ai < 2; ++ai)
#pragma unroll
            for (int m = 0; m < 4; ++m) {
                const int row = row0 + ai * 128 + m * 16;
                float s;
                if (MODE == 0) s = rs[row];
                else { const f32x4* p = (const f32x4*)(rs + (size_t)row * 16); const f32x4 a = p[0], b = p[1], c = p[2], d = p[3];
                       const float t = ((a.x + a.y) + (a.z + a.w)) + ((b.x + b.y) + (b.z + b.w)) + ((c.x + c.y) + (c.z + c.w)) + ((d.x + d.y) + (d.z + d.w));
                       s = rsqrtf(t * (1.f / 1024.f) + EPS); }
                bf16* rowp = O + (size_t)row * ldc + col0;
#pragma unroll
                for (int bj = 0; bj < 2; ++bj) { const pg8::f32x4 v0 = acc[ai][bj][m][0] * s, v1 = acc[ai][bj][m][1] * s;
                    u32x4 w; w.x = cvt_pk_bf16(v0[0], v0[1]); w.y = cvt_pk_bf16(v0[2], v0[3]); w.z = cvt_pk_bf16(v1[0], v1[1]); w.w = cvt_pk_bf16(v1[2], v1[3]);
                    *(u32x4*)(rowp + bj * 128) = w; }
            }
    }
};
struct EpiProj {
    static constexpr bool PERM = true, AFTER_DRAIN = false;
    bf16* O; const float* rs;
    __device__ __forceinline__ void operator()(const pg8::f32x4 (&acc)[2][2][4][2], const pg8::Unit& u, int wr, int wc, int fr, int fq) const {
        const int row0 = u.pm * 256 + wr * 64 + fr, cin = wc * 32 + 8 * fq, pn = u.pn;
#pragma unroll
        for (int ai = 0; ai < 2; ++ai)
#pragma unroll
            for (int m = 0; m < 4; ++m) {
                const int row = row0 + ai * 128 + m * 16; const float sc = rs[row];
                float a[8], b[8];
#pragma unroll
                for (int i = 0; i < 4; ++i) { a[i] = acc[ai][0][m][0][i] * sc; a[4 + i] = acc[ai][0][m][1][i] * sc; b[i] = acc[ai][1][m][0][i] * sc; b[4 + i] = acc[ai][1][m][1][i] * sc; }
                bf16* rowp = O + (size_t)row * PDIM;
                if (pn >= 4 && pn < 6) {
                    u32x4 w0, w1; w0.x = cvt_pk_bf16(a[0], a[1]); w0.y = cvt_pk_bf16(a[2], a[3]); w0.z = cvt_pk_bf16(a[4], a[5]); w0.w = cvt_pk_bf16(a[6], a[7]);
                    w1.x = cvt_pk_bf16(b[0], b[1]); w1.y = cvt_pk_bf16(b[2], b[3]); w1.z = cvt_pk_bf16(b[4], b[5]); w1.w = cvt_pk_bf16(b[6], b[7]);
                    *(u32x4*)(rowp + 512 + 256 * (pn - 4) + cin) = w0; *(u32x4*)(rowp + 512 + 256 * (pn - 4) + 128 + cin) = w1;
                } else {
                    float o[8];
                    if (pn < 4) {
#pragma unroll
                        for (int i = 0; i < 8; ++i) o[i] = a[i] * b[i];
                    } else {
#pragma unroll
                        for (int i = 0; i < 8; ++i) o[i] = a[i] * sigmoid_f(b[i]);
                    }
                    u32x4 w; w.x = cvt_pk_bf16(o[0], o[1]); w.y = cvt_pk_bf16(o[2], o[3]); w.z = cvt_pk_bf16(o[4], o[5]); w.w = cvt_pk_bf16(o[6], o[7]);
                    *(u32x4*)(rowp + (pn < 4 ? 128 * pn : 1024 + 128 * (pn - 6)) + cin) = w;
                }
            }
    }
};
struct EpiProjI8 {
    static constexpr bool PERM = true, AFTER_DRAIN = false;
    bf16* O; const float* rs; const float* sw;
    __device__ __forceinline__ void operator()(const pg8::i32x4 (&acc)[2][2][4][2], const pg8::Unit& u, int wr, int wc, int fr, int fq) const {
        const int row0 = u.pm * 256 + wr * 64 + fr, cin = wc * 32 + 8 * fq, pn = u.pn;
        float swa[8], swb[8];
        { const f32x4 a0 = *(const f32x4*)(sw + 256 * pn + cin), a1 = *(const f32x4*)(sw + 256 * pn + cin + 4), b0 = *(const f32x4*)(sw + 256 * pn + 128 + cin), b1 = *(const f32x4*)(sw + 256 * pn + 128 + cin + 4);
          swa[0] = a0.x; swa[1] = a0.y; swa[2] = a0.z; swa[3] = a0.w; swa[4] = a1.x; swa[5] = a1.y; swa[6] = a1.z; swa[7] = a1.w;
          swb[0] = b0.x; swb[1] = b0.y; swb[2] = b0.z; swb[3] = b0.w; swb[4] = b1.x; swb[5] = b1.y; swb[6] = b1.z; swb[7] = b1.w; }
#pragma unroll
        for (int ai = 0; ai < 2; ++ai)
#pragma unroll
            for (int m = 0; m < 4; ++m) {
                const int row = row0 + ai * 128 + m * 16; const float sc = rs[row];
                float a[8], b[8];
#pragma unroll
                for (int i = 0; i < 4; ++i) { a[i] = (float)acc[ai][0][m][0][i] * (sc * swa[i]); a[4 + i] = (float)acc[ai][0][m][1][i] * (sc * swa[4 + i]);
                    b[i] = (float)acc[ai][1][m][0][i] * (sc * swb[i]); b[4 + i] = (float)acc[ai][1][m][1][i] * (sc * swb[4 + i]); }
                bf16* rowp = O + (size_t)row * PDIM;
                if (pn >= 4 && pn < 6) {
                    u32x4 w0, w1; w0.x = cvt_pk_bf16(a[0], a[1]); w0.y = cvt_pk_bf16(a[2], a[3]); w0.z = cvt_pk_bf16(a[4], a[5]); w0.w = cvt_pk_bf16(a[6], a[7]);
                    w1.x = cvt_pk_bf16(b[0], b[1]); w1.y = cvt_pk_bf16(b[2], b[3]); w1.z = cvt_pk_bf16(b[4], b[5]); w1.w = cvt_pk_bf16(b[6], b[7]);
                    *(u32x4*)(rowp + 512 + 256 * (pn - 4) + cin) = w0; *(u32x4*)(rowp + 512 + 256 * (pn - 4) + 128 + cin) = w1;
                } else {
                    float o[8];
                    if (pn < 4) {
#pragma unroll
                        for (int i = 0; i < 8; ++i) o[i] = a[i] * b[i];
                    } else {
#pragma unroll
                        for (int i = 0; i < 8; ++i) o[i] = a[i] * sigmoid_f(b[i]);
                    }
                    u32x4 w; w.x = cvt_pk_bf16(o[0], o[1]); w.y = cvt_pk_bf16(o[2], o[3]); w.z = cvt_pk_bf16(o[4], o[5]); w.w = cvt_pk_bf16(o[6], o[7]);
                    *(u32x4*)(rowp + (pn < 4 ? 128 * pn : 1024 + 128 * (pn - 6)) + cin) = w;
                }
            }
    }
};
__host__ __device__ __forceinline__ int win_src_col(int n) {
    const int t = n >> 8, j = n & 255;
    if (t < 4) return (j < 128) ? 128 * t + j : 1024 + 128 * t + (j - 128);
    if (t < 6) return 512 + 256 * (t - 4) + j;
    return (j < 128) ? 1536 + 128 * (t - 6) + j : 2048 + 128 * (t - 6) + (j - 128);
}
struct EpiResidual {
    static constexpr bool PERM = true, AFTER_DRAIN = false;
    bf16* O; const signed char* XB; const float* SX; float* ssq;
    __device__ __forceinline__ void operator()(const pg8::f32x4 (&acc)[2][2][4][2], const pg8::Unit& u, int wr, int wc, int fr, int fq) const {
        const int row0 = u.pm * 256 + wr * 64 + fr, col0 = u.pn * 256 + wc * 32 + 8 * fq;
#pragma unroll
        for (int ai = 0; ai < 2; ++ai)
#pragma unroll
            for (int m = 0; m < 4; ++m) {
                const int row = row0 + ai * 128 + m * 16;
                const signed char* xr = XB + (size_t)row * DM + col0; bf16* rowp = O + (size_t)row * DM + col0;
                float q = 0.f;
                u32x2 xw[2]; const float sxr = SX[row];
#pragma unroll
                for (int bj = 0; bj < 2; ++bj) xw[bj] = *(const u32x2*)(xr + bj * 128);
#pragma unroll
                for (int bj = 0; bj < 2; ++bj) {
                    const f32x4 x0 = (f32x4){(float)(signed char)(xw[bj].x), (float)(signed char)(xw[bj].x >> 8), (float)(signed char)(xw[bj].x >> 16), (float)((int)xw[bj].x >> 24)} * sxr,
                                x1 = (f32x4){(float)(signed char)(xw[bj].y), (float)(signed char)(xw[bj].y >> 8), (float)(signed char)(xw[bj].y >> 16), (float)((int)xw[bj].y >> 24)} * sxr;
                    const pg8::f32x4 v0 = acc[ai][bj][m][0] + x0, v1 = acc[ai][bj][m][1] + x1;
                    q += (v0[0] * v0[0] + v0[1] * v0[1]) + (v0[2] * v0[2] + v0[3] * v0[3]) + (v1[0] * v1[0] + v1[1] * v1[1]) + (v1[2] * v1[2] + v1[3] * v1[3]);
                    u32x4 w; w.x = cvt_pk_bf16(v0[0], v0[1]); w.y = cvt_pk_bf16(v0[2], v0[3]); w.z = cvt_pk_bf16(v1[0], v1[1]); w.w = cvt_pk_bf16(v1[2], v1[3]);
                    *(u32x4*)(rowp + bj * 128) = w; }
                q += __shfl_xor(q, 16); q += __shfl_xor(q, 32);
                if (fq == 0) ssq[(size_t)row * 16 + u.pn * 4 + wc] = q;
            }
    }
};

struct EpiResidualI8 {
    static constexpr bool PERM = true, AFTER_DRAIN = false;
    bf16* O; const signed char* XB; const float* SX; const float* SY; const float* SWO; float* ssq;
    __device__ __forceinline__ void operator()(const pg8::i32x4 (&acc)[2][2][4][2], const pg8::Unit& u, int wr, int wc, int fr, int fq) const {
        const int row0 = u.pm * 256 + wr * 64 + fr, col0 = u.pn * 256 + wc * 32 + 8 * fq;
        f32x4 sw[2][2];
#pragma unroll
        for (int bj = 0; bj < 2; ++bj) { sw[bj][0] = *(const f32x4*)(SWO + col0 + bj * 128); sw[bj][1] = *(const f32x4*)(SWO + col0 + bj * 128 + 4); }
#pragma unroll
        for (int ai = 0; ai < 2; ++ai)
#pragma unroll
            for (int m = 0; m < 4; ++m) {
                const int row = row0 + ai * 128 + m * 16;
                const signed char* xr = XB + (size_t)row * DM + col0; bf16* rowp = O + (size_t)row * DM + col0;
                float q = 0.f;
                u32x2 xw[2]; const float sxr = SX[row], syr = SY[row];
#pragma unroll
                for (int bj = 0; bj < 2; ++bj) xw[bj] = *(const u32x2*)(xr + bj * 128);
#pragma unroll
                for (int bj = 0; bj < 2; ++bj) {
                    const f32x4 x0 = (f32x4){(float)(signed char)(xw[bj].x), (float)(signed char)(xw[bj].x >> 8), (float)(signed char)(xw[bj].x >> 16), (float)((int)xw[bj].x >> 24)} * sxr,
                                x1 = (f32x4){(float)(signed char)(xw[bj].y), (float)(signed char)(xw[bj].y >> 8), (float)(signed char)(xw[bj].y >> 16), (float)((int)xw[bj].y >> 24)} * sxr;
                    const pg8::i32x4 a0 = acc[ai][bj][m][0], a1 = acc[ai][bj][m][1];
                    const f32x4 v0 = (f32x4){(float)a0[0], (float)a0[1], (float)a0[2], (float)a0[3]} * (sw[bj][0] * syr) + x0, v1 = (f32x4){(float)a1[0], (float)a1[1], (float)a1[2], (float)a1[3]} * (sw[bj][1] * syr) + x1;
                    q += (v0[0] * v0[0] + v0[1] * v0[1]) + (v0[2] * v0[2] + v0[3] * v0[3]) + (v1[0] * v1[0] + v1[1] * v1[1]) + (v1[2] * v1[2] + v1[3] * v1[3]);
                    u32x4 w; w.x = cvt_pk_bf16(v0[0], v0[1]); w.y = cvt_pk_bf16(v0[2], v0[3]); w.z = cvt_pk_bf16(v1[0], v1[1]); w.w = cvt_pk_bf16(v1[2], v1[3]);
                    *(u32x4*)(rowp + bj * 128) = w; }
                q += __shfl_xor(q, 16); q += __shfl_xor(q, 32);
                if (fq == 0) ssq[(size_t)row * 16 + u.pn * 4 + wc] = q;
            }
    }
};
template <bool MAPIN> __device__ __forceinline__ void p0_transpose_item(const float* W, int K, int N, bf16* WT, LAS float* scr, int item, int lane,
                                                  const float* g_lo, const float* g_hi, int split) {
    const int nblk = N / 32, kb = item / nblk, nb = item % nblk, k0 = 64 * kb, n0 = 32 * nb;
#pragma unroll 8
    for (int i = 0; i < 32; ++i) { const int kk = 2 * i + (lane >> 5); const int k = k0 + kk;
        const float g = (k < split) ? g_lo[k] : g_hi[k - split];
        scr[kk * 33 + (lane & 31)] = W[(size_t)k * N + (MAPIN ? win_src_col(n0) : n0) + (lane & 31)] * g; }
    asm volatile("s_waitcnt lgkmcnt(0)" ::: "memory");
    const int c = lane & 7;
#pragma unroll
    for (int j = 0; j < 4; ++j) { const int n = (lane >> 3) + 8 * j; const LAS float* s = scr + (8 * c) * 33 + n;
        u32x4 o; o.x = pk2(s[0 * 33], s[1 * 33]); o.y = pk2(s[2 * 33], s[3 * 33]); o.z = pk2(s[4 * 33], s[5 * 33]); o.w = pk2(s[6 * 33], s[7 * 33]);
        *(u32x4*)(WT + (size_t)(n0 + n) * K + k0 + 8 * c) = o; }
    asm volatile("s_waitcnt lgkmcnt(0)" ::: "memory");
}

constexpr int CW_COLMAX = 5120;
__device__ __forceinline__ void p0_colmax_item(const float* W, int N, unsigned* colmax, int item, int lane, const float* g) {
    const int nblk = N / 32, kb = item / nblk, nb = item % nblk, k0 = 64 * kb, n0 = 32 * nb;
    float mx = 0.f;
#pragma unroll
    for (int i = 0; i < 32; ++i) { const int k = k0 + 2 * i + (lane >> 5); mx = fmaxf(mx, fabsf(W[(size_t)k * N + n0 + (lane & 31)] * g[k])); }
    mx = fmaxf(mx, __shfl_xor(mx, 32));
    if (lane < 32) atomicMax(colmax + n0 + lane, __float_as_uint(mx));
}
__device__ __forceinline__ void p1_quant_item(const float* W, int K, int N, signed char* WT8, float* swout, const unsigned* colmax, LAS float* scr, int item, int lane, const float* g) {
    const int nblk = N / 32, kb = item / nblk, nb = item % nblk, k0 = 64 * kb, n0 = 32 * nb, s0 = win_src_col(n0);
    const float cm = fmaxf(__uint_as_float(colmax[s0 + (lane & 31)]), 1e-30f), inv = 127.f / cm;
    if (kb == 0 && lane < 32) swout[n0 + lane] = cm * (1.f / 127.f);
#pragma unroll
    for (int i = 0; i < 32; ++i) { const int kk = 2 * i + (lane >> 5); const int k = k0 + kk;
        scr[kk * 33 + (lane & 31)] = W[(size_t)k * N + s0 + (lane & 31)] * g[k] * inv; }
    asm volatile("s_waitcnt lgkmcnt(0)" ::: "memory");
    const int c = lane & 7;
#pragma unroll
    for (int j = 0; j < 4; ++j) { const int n = (lane >> 3) + 8 * j; const LAS float* sp = scr + (8 * c) * 33 + n;
        unsigned w0 = 0u, w1 = 0u;
#pragma unroll
        for (int i = 0; i < 4; ++i) { w0 |= ((unsigned)(int)rintf(sp[i * 33]) & 255u) << (8 * i); w1 |= ((unsigned)(int)rintf(sp[(4 + i) * 33]) & 255u) << (8 * i); }
        u32x2 o; o.x = w0; o.y = w1;
        *(u32x2*)(WT8 + (size_t)(n0 + n) * K + k0 + 8 * c) = o; }
    asm volatile("s_waitcnt lgkmcnt(0)" ::: "memory");
}
constexpr int CW_COLMAX2 = 7680;
__device__ __forceinline__ void p0_colmax_item2(const float* W, int N, unsigned* colmax, int item, int lane, const float* g_lo, const float* g_hi, int split) {
    const int nblk = N / 32, kb = item / nblk, nb = item % nblk, k0 = 64 * kb, n0 = 32 * nb;
    float mx = 0.f;
#pragma unroll
    for (int i = 0; i < 32; ++i) { const int k = k0 + 2 * i + (lane >> 5); const float g = (k < split) ? g_lo[k] : g_hi[k - split]; mx = fmaxf(mx, fabsf(W[(size_t)k * N + n0 + (lane & 31)] * g)); }
    mx = fmaxf(mx, __shfl_xor(mx, 32));
    if (lane < 32) atomicMax(colmax + n0 + lane, __float_as_uint(mx));
}
__device__ __forceinline__ void p1_quant_item2(const float* W, int K, int N, signed char* WT8, float* swout, const unsigned* colmax, LAS float* scr, int item, int lane, const float* g_lo, const float* g_hi, int split) {
    const int nblk = N / 32, kb = item / nblk, nb = item % nblk, k0 = 64 * kb, n0 = 32 * nb;
    const float cm = fmaxf(__uint_as_float(colmax[n0 + (lane & 31)]), 1e-30f), inv = 127.f / cm;
    if (kb == 0 && lane < 32) swout[n0 + lane] = cm * (1.f / 127.f);
#pragma unroll
    for (int i = 0; i < 32; ++i) { const int kk = 2 * i + (lane >> 5); const int k = k0 + kk; const float g = (k < split) ? g_lo[k] : g_hi[k - split];
        scr[kk * 33 + (lane & 31)] = W[(size_t)k * N + n0 + (lane & 31)] * g * inv; }
    asm volatile("s_waitcnt lgkmcnt(0)" ::: "memory");
    const int c = lane & 7;
#pragma unroll
    for (int j = 0; j < 4; ++j) { const int n = (lane >> 3) + 8 * j; const LAS float* sp = scr + (8 * c) * 33 + n;
        unsigned w0 = 0u, w1 = 0u;
#pragma unroll
        for (int i = 0; i < 4; ++i) { w0 |= ((unsigned)(int)rintf(sp[i * 33]) & 255u) << (8 * i); w1 |= ((unsigned)(int)rintf(sp[(4 + i) * 33]) & 255u) << (8 * i); }
        u32x2 o; o.x = w0; o.y = w1;
        *(u32x2*)(WT8 + (size_t)(n0 + n) * K + k0 + 8 * c) = o; }
    asm volatile("s_waitcnt lgkmcnt(0)" ::: "memory");
}
__device__ __forceinline__ void phase_winq(const Params& P, LAS unsigned char* lds) {
    const int tid = threadIdx.x, lane = tid & 63, wave = __builtin_amdgcn_readfirstlane(tid >> 6);
    const int gw = blockIdx.x * NWAVES + wave, NGW = gridDim.x * NWAVES;
    LAS float* scr = (LAS float*)(lds + wave * 16384);
    constexpr int NI1 = (DM / 64) * (DIN / 32), NI2 = (DM / 64) * (DM / 32);
    for (int it = gw; it < NI1 + NI2; it += NGW) {
        if (it < NI1) p1_quant_item(P.w_in, DM, DIN, (signed char*)(P.ws + WS_WIN_T), (float*)(P.ws + WS_SW), (const unsigned*)(P.ws + WS_CTL) + CW_COLMAX, scr, it, lane, P.g_mix);
        else p1_quant_item2(P.w_out, DM, DM, (signed char*)(P.ws + WS_WOUT_T), (float*)(P.ws + WS_SWO), (const unsigned*)(P.ws + WS_CTL) + CW_COLMAX2, scr, it - NI1, lane, P.g_sc, P.g_cf, 512);
    }
}
__device__ __forceinline__ float q4(float x, float inv_s) {
    const float a = fabsf(x) * inv_s; float r;
    if (a < 2.f) r = rintf(a * 2.f) * 0.5f; else if (a < 4.f) r = rintf(a); else r = fminf(6.f, rintf(a * 0.5f) * 2.f);
    return copysignf(r, x);
}
__device__ __forceinline__ void phase_prep(const Params& P, LAS unsigned char* lds) {
    const int tid = threadIdx.x, lane = tid & 63, wave = __builtin_amdgcn_readfirstlane(tid >> 6);
    const int gw = blockIdx.x * NWAVES + wave, NGW = gridDim.x * NWAVES;
    unsigned char* ws = P.ws;
    LAS float* scr = (LAS float*)(lds + wave * 16384);
    constexpr int I_IN = (DM / 64) * (DIN / 32), I_OUT = (DM / 64) * (DM / 32), I_Q = (DM / 64) * (2048 / 32);
    for (int it = gw; it < I_IN + I_OUT + I_Q; it += NGW) {
        int r = it;
        if (r < I_IN) { p0_colmax_item(P.w_in, DIN, (unsigned*)(ws + WS_CTL) + CW_COLMAX, r, lane, P.g_mix); continue; } r -= I_IN;
        if (r < I_OUT) { p0_colmax_item2(P.w_out, DM, (unsigned*)(ws + WS_CTL) + CW_COLMAX2, r, lane, P.g_sc, P.g_cf, 512); continue; } r -= I_OUT;
        p0_transpose_item<false>(P.w_q, DM, 2048, (bf16*)(ws + WS_WQ_T), scr, r, lane, P.g_ffn, P.g_ffn, DM);
    }
    {
        unsigned* H0I8 = (unsigned*)(ws + WS_H0I8); float* RS1 = (float*)(ws + WS_RSTD1); float* SXp = (float*)(ws + WS_SX);
        for (int t0 = gw * 4; t0 < NTOK; t0 += NGW * 4) {
            f32x4 v[4][4];
#pragma unroll
            for (int q = 0; q < 4; ++q) { const f32x4* xr = (const f32x4*)(P.x + (size_t)(t0 + q) * DM) + lane;
#pragma unroll
                for (int j = 0; j < 4; ++j) v[q][j] = xr[64 * j]; }
#pragma unroll
            for (int q = 0; q < 4; ++q) { float sq = 0.f, mx = 0.f;
#pragma unroll
                for (int j = 0; j < 4; ++j) { sq += (v[q][j].x * v[q][j].x + v[q][j].y * v[q][j].y) + (v[q][j].z * v[q][j].z + v[q][j].w * v[q][j].w);
                    mx = fmaxf(mx, fmaxf(fmaxf(fabsf(v[q][j].x), fabsf(v[q][j].y)), fmaxf(fabsf(v[q][j].z), fabsf(v[q][j].w)))); }
                sq = wave_sum_fast(sq); mx = fmaxf(wave_max_fast(mx), 1e-30f);
                const float sx = mx * (1.f / 127.f), inv = 127.f / mx;
                if (lane == 0) { RS1[t0 + q] = sx * rsqrtf(sq * (1.f / DM) + EPS); SXp[t0 + q] = sx; }
                unsigned* o = H0I8 + (size_t)(t0 + q) * (DM / 4) + lane;
#pragma unroll
                for (int j = 0; j < 4; ++j) { const int a = (int)rintf(v[q][j].x * inv), b = (int)rintf(v[q][j].y * inv), c = (int)rintf(v[q][j].z * inv), d = (int)rintf(v[q][j].w * inv);
                    o[64 * j] = ((unsigned)a & 255u) | (((unsigned)b & 255u) << 8) | (((unsigned)c & 255u) << 16) | ((unsigned)d << 24); } }
        }
    }
    {
        unsigned char* U8 = ws + WS_U8; unsigned char* V8 = ws + WS_V8;
        f32x4 gf[4];
#pragma unroll
        for (int j = 0; j < 4; ++j) gf[j] = ((const f32x4*)P.g_ffn)[64 * j + lane];
        float* ESC = (float*)(ws + WS_ESCALE);
        for (int e0 = gw * 2; e0 < 2 * 16384; e0 += NGW * 2) {
            const bool isv = e0 >= 16384; const int ee0 = isv ? e0 - 16384 : e0;
            f32x4 v[2][4];
#pragma unroll
            for (int q = 0; q < 2; ++q) { const f32x4* src = (const f32x4*)((isv ? P.pv : P.pu) + (size_t)(ee0 + q) * DM) + lane;
#pragma unroll
                for (int j = 0; j < 4; ++j) v[q][j] = src[64 * j]; }
#pragma unroll
            for (int q = 0; q < 2; ++q) {
                float mx = 0.f;
#pragma unroll
                for (int j = 0; j < 4; ++j) { if (!isv) v[q][j] = v[q][j] * gf[j];
                    mx = fmaxf(mx, fmaxf(fmaxf(fabsf(v[q][j].x), fabsf(v[q][j].y)), fmaxf(fabsf(v[q][j].z), fabsf(v[q][j].w)))); }
#pragma unroll
                for (int o = 1; o < 64; o <<= 1) mx = fmaxf(mx, __shfl_xor(mx, o));
                if (!isv) {
                    float sq2 = 0.f;
#pragma unroll
                    for (int j = 0; j < 4; ++j) sq2 += (v[q][j].x * v[q][j].x + v[q][j].y * v[q][j].y) + (v[q][j].z * v[q][j].z + v[q][j].w * v[q][j].w);
                    const float rms = sqrtf(wave_sum_fast(sq2) * (1.f / DM));
                    const float su = fmaxf(fminf(mx, U4_CLIP * rms), 1e-30f) * (1.f / 7.f), inv = 1.f / su;
                    unsigned wq[2] = {0u, 0u}; int csum = 0;
#pragma unroll
                    for (int j = 0; j < 4; ++j) { const float e4[4] = {v[q][j].x, v[q][j].y, v[q][j].z, v[q][j].w};
#pragma unroll
                        for (int i = 0; i < 4; ++i) { int c = (int)rintf(fminf(fmaxf(e4[i] * inv, -7.f), 7.f)); csum += c;
                            wq[j >> 1] |= ((unsigned)c & 15u) << (16 * (j & 1) + 4 * i); } }
                    const float cs = wave_sum_fast((float)csum);
                    if (lane == 0) { ESC[e0 + q] = su; ((float*)(ws + WS_SUMQ))[e0 + q] = cs; }
                    u32x2 o; o.x = wq[0]; o.y = wq[1];
                    *(u32x2*)(U8 + (size_t)(ee0 + q) * 512 + 8 * lane) = o;
                    continue;
                }
                const float sc = fmaxf(mx, 1e-30f) * (1.f / 6.f), inv = 1.f / sc;
                if (lane == 0) ESC[e0 + q] = sc;
                unsigned w0 = 0u, w1 = 0u;
                w0 = __builtin_amdgcn_cvt_scalef32_pk_fp4_f32(w0, v[q][0].x * inv, v[q][0].y * inv, 1.0f, 0); w0 = __builtin_amdgcn_cvt_scalef32_pk_fp4_f32(w0, v[q][0].z * inv, v[q][0].w * inv, 1.0f, 1);
                w0 = __builtin_amdgcn_cvt_scalef32_pk_fp4_f32(w0, v[q][1].x * inv, v[q][1].y * inv, 1.0f, 2); w0 = __builtin_amdgcn_cvt_scalef32_pk_fp4_f32(w0, v[q][1].z * inv, v[q][1].w * inv, 1.0f, 3);
                w1 = __builtin_amdgcn_cvt_scalef32_pk_fp4_f32(w1, v[q][2].x * inv, v[q][2].y * inv, 1.0f, 0); w1 = __builtin_amdgcn_cvt_scalef32_pk_fp4_f32(w1, v[q][2].z * inv, v[q][2].w * inv, 1.0f, 1);
                w1 = __builtin_amdgcn_cvt_scalef32_pk_fp4_f32(w1, v[q][3].x * inv, v[q][3].y * inv, 1.0f, 2); w1 = __builtin_amdgcn_cvt_scalef32_pk_fp4_f32(w1, v[q][3].z * inv, v[q][3].w * inv, 1.0f, 3);
                u32x2 o; o.x = w0; o.y = w1;
                *(u32x2*)((isv ? V8 : U8) + (size_t)(ee0 + q) * 512 + 8 * lane) = o;
            }
        }
    }
    {
        bf16* KB = (bf16*)(ws + WS_KEYS);
        const int gt = blockIdx.x * NTHREADS + tid, NGT = gridDim.x * NTHREADS;
        for (int i = gt; i < 8 * 2 * 128 * 128 / 4; i += NGT) { const f32x4 v = ((const f32x4*)P.keys)[i]; u32x2 w; w.x = pk2(v.x, v.y); w.y = pk2(v.z, v.w); ((u32x2*)KB)[i] = w; }
    }
    {
        float* MP = (float*)(ws + WS_METAPART); float* MR = (float*)(ws + WS_METARSTD);
        for (int r = gw; r < NMETA; r += NGW) {
            float s = 0.f;
            for (int k = lane; k < DM; k += 64) { const float v = P.meta[r * DM + k]; s += v * v; }
            s = wave_sum(s);
            if (lane == 0) MR[r] = rsqrtf(s * (1.f / DM) + EPS);
        }
        for (int it = gw; it < MKC * 40; it += NGW) {
            const int kc = it / 40, nb = it % 40, n = nb * 64 + lane;
            float acc[NMETA];
#pragma unroll
            for (int r = 0; r < NMETA; ++r) acc[r] = 0.f;
            for (int k = kc * (DM / MKC); k < (kc + 1) * (DM / MKC); ++k) {
                const float w = P.w_in[(size_t)k * DIN + n] * P.g_mix[k];
#pragma unroll
                for (int r = 0; r < NMETA; ++r) acc[r] += P.meta[r * DM + k] * w;
            }
#pragma unroll
            for (int r = 0; r < NMETA; ++r) MP[(size_t)(kc * 16 + r) * DIN + n] = acc[r];
        }
    }
}

__device__ __forceinline__ float metaraw(const float* MP, const float* MR, int p, int col) { float s = 0.f;
#pragma unroll 8
    for (int kc = 0; kc < MKC; ++kc) s += MP[(size_t)(kc * 16 + p) * DIN + col];
    return s * MR[p]; }
__device__ __forceinline__ void phase_metaproj(const Params& P) {
    const float* MP = (const float*)(P.ws + WS_METAPART); const float* MR = (const float*)(P.ws + WS_METARSTD); float* MJ = (float*)(P.ws + WS_METAPROJ);
    for (int gt = blockIdx.x * NTHREADS + threadIdx.x; gt < NMETA * PDIM; gt += gridDim.x * NTHREADS) { const int p = gt / PDIM, c = gt % PDIM; float v;
        if (c < 512) v = metaraw(MP, MR, p, c) * metaraw(MP, MR, p, 1024 + c);
        else if (c < 1024) v = metaraw(MP, MR, p, c);
        else v = metaraw(MP, MR, p, 1536 + (c - 1024)) * sigmoid_f(metaraw(MP, MR, p, 2048 + (c - 1024)));
        MJ[gt] = v; }
}
__device__ __forceinline__ float meta_val(const float* MJ, const float*, int p, int col) { return MJ[p * PDIM + col]; }
__device__ __forceinline__ float proj_at(const bf16* PROJ, const float* MP, const float* MR, int b, int pos, int col) {
    if (pos < 0) return 0.f;
    if (pos < NMETA) return meta_val(MP, MR, pos, col);
    return bf2f(PROJ[(size_t)(b * SEQ + pos - NMETA) * PDIM + col]);
}
__device__ __forceinline__ void proj8_at(const bf16* PROJ, const float* MP, const float* MR, int b, int pos, int col, float (&v)[8]) {
    if (pos < 0) {
#pragma unroll
        for (int i = 0; i < 8; ++i) v[i] = 0.f;
    } else if (pos < NMETA) {
        const f32x4 a = *(const f32x4*)(MP + pos * PDIM + col), bq = *(const f32x4*)(MP + pos * PDIM + col + 4);
        v[0] = a.x; v[1] = a.y; v[2] = a.z; v[3] = a.w; v[4] = bq.x; v[5] = bq.y; v[6] = bq.z; v[7] = bq.w;
    } else {
        const u32x4 w = *(const u32x4*)(PROJ + (size_t)(b * SEQ + pos - NMETA) * PDIM + col);
        v[0] = bflo(w.x); v[1] = bfhi(w.x); v[2] = bflo(w.y); v[3] = bfhi(w.y); v[4] = bflo(w.z); v[5] = bfhi(w.z); v[6] = bflo(w.w); v[7] = bfhi(w.w);
    }
}

template <int R> __device__ __forceinline__ void conv_rows(const LAS unsigned char* ubase, const f32x2 (&wcf)[31], f32x2 (&acc)[32]) {
    if constexpr (R < 62) {
        const unsigned uw = *(const LAS unsigned*)(ubase + R * 1024);
        const f32x2 x = (f32x2){bflo(uw), bfhi(uw)};
        constexpr int lo = R > 30 ? R - 30 : 0, hi = R < 31 ? R : 31;
#pragma unroll
        for (int ii = lo; ii <= hi; ++ii) acc[ii] += wcf[R - ii] * x;
        conv_rows<R + 1>(ubase, wcf, acc);
    }
}
__device__ __forceinline__ void phase_conv(const Params& P, LAS unsigned char* lds) {
    const int tid = threadIdx.x, lane = tid & 63, wave = __builtin_amdgcn_readfirstlane(tid >> 6);
    unsigned char* ws = P.ws;
    const bf16* PROJ = (const bf16*)(ws + WS_PROJ); const float* MP = (const float*)(ws + WS_METAPROJ); const float* MR = nullptr;
    bf16* Y = (bf16*)(ws + WS_Y);
    constexpr int TT = 64, NTILE = NTOK / TT, UROWS = TT + 30;
    const int cgp = wave & 3, th = wave >> 2, ch2 = cgp * 128 + 2 * lane;
    f32x2 wcf[31];
#pragma unroll
    for (int j = 0; j < 31; ++j) wcf[j] = *(const f32x2*)(P.cf_w + j * 512 + ch2);
    const f32x2 bcf = *(const f32x2*)(P.cf_b + ch2);
    for (int tile = blockIdx.x; tile < NTILE; tile += gridDim.x) {
        const int b = tile / (SEQ / TT), s0 = (tile % (SEQ / TT)) * TT;
#pragma unroll 4
        for (int p = 0; p < (UROWS + 7) / 8; ++p) {
            const int r = p * 8 + wave;
            if (r < UROWS) {
                const int pos = NMETA + s0 - 30 + r;
                float uu[8];
                proj8_at(PROJ, MP, MR, b, pos, 1024 + 8 * lane, uu);
                u32x4 w; w.x = pk2(uu[0], uu[1]); w.y = pk2(uu[2], uu[3]); w.z = pk2(uu[4], uu[5]); w.w = pk2(uu[6], uu[7]);
                *(LAS u32x4*)(lds + r * 1024 + lane * 16) = w;
            }
        }
        __syncthreads();
        f32x2 acc[32];
#pragma unroll
        for (int ii = 0; ii < 32; ++ii) acc[ii] = bcf;
        conv_rows<0>(lds + (32 * th) * 1024 + ch2 * 2, wcf, acc);
        __syncthreads();
#pragma unroll
        for (int ii = 0; ii < 32; ++ii) *(LAS f32x2*)(lds + (32 * th + ii) * 2048 + ch2 * 4) = acc[ii];
        __syncthreads();
        {
            float lng[8], lnb[8];
            { const f32x4 a = *(const f32x4*)(P.ln_g + 8 * lane), c = *(const f32x4*)(P.ln_g + 8 * lane + 4), d = *(const f32x4*)(P.ln_b + 8 * lane), e = *(const f32x4*)(P.ln_b + 8 * lane + 4);
              lng[0] = a.x; lng[1] = a.y; lng[2] = a.z; lng[3] = a.w; lng[4] = c.x; lng[5] = c.y; lng[6] = c.z; lng[7] = c.w;
              lnb[0] = d.x; lnb[1] = d.y; lnb[2] = d.z; lnb[3] = d.w; lnb[4] = e.x; lnb[5] = e.y; lnb[6] = e.z; lnb[7] = e.w; }
            float wsc[3][8];
#pragma unroll
            for (int j = 0; j < 3; ++j) { const f32x4 a = *(const f32x4*)(P.sc_w + j * 512 + 8 * lane), c = *(const f32x4*)(P.sc_w + j * 512 + 8 * lane + 4);
                wsc[j][0] = a.x; wsc[j][1] = a.y; wsc[j][2] = a.z; wsc[j][3] = a.w; wsc[j][4] = c.x; wsc[j][5] = c.y; wsc[j][6] = c.z; wsc[j][7] = c.w; }
            float cxa[8], cxb[8];
            { const int pos = NMETA + s0 + 8 * wave - 2;
              proj8_at(PROJ, MP, MR, b, pos, 8 * lane, cxa); proj8_at(PROJ, MP, MR, b, pos + 1, 8 * lane, cxb); }
#pragma unroll 2
            for (int q = 0; q < 8; ++q) {
                const int ii = 8 * wave + q, s = s0 + ii; const size_t t = (size_t)b * SEQ + s;
                float o[8];
                { const f32x4 a = *(const LAS f32x4*)(lds + ii * 2048 + lane * 32), c = *(const LAS f32x4*)(lds + ii * 2048 + lane * 32 + 16);
                  o[0] = a.x; o[1] = a.y; o[2] = a.z; o[3] = a.w; o[4] = c.x; o[5] = c.y; o[6] = c.z; o[7] = c.w; }
                float s1 = 0.f;
#pragma unroll
                for (int i = 0; i < 8; ++i) s1 += o[i];
                const float mean = wave_sum_fast(s1) * (1.f / 512.f);
                float s2 = 0.f;
#pragma unroll
                for (int i = 0; i < 8; ++i) { o[i] -= mean; s2 += o[i] * o[i]; }
                const float rs = rsqrtf(wave_sum_fast(s2) * (1.f / 512.f) + EPS);
                float s3 = 0.f;
#pragma unroll
                for (int i = 0; i < 8; ++i) { float y = o[i] * rs * lng[i] + lnb[i]; y = y * sigmoid_f(y); o[i] = y; s3 += y * y; }
                const float r2 = rsqrtf(wave_sum_fast(s3) * (1.f / 512.f) + EPS);
                float bgv[8], cxc[8], accs[8];
                proj8_at(PROJ, MP, MR, b, NMETA + s, 8 * lane, cxc); proj8_at(PROJ, MP, MR, b, NMETA + s, 512 + 8 * lane, bgv);
                float s4 = 0.f;
#pragma unroll
                for (int i = 0; i < 8; ++i) { accs[i] = bgv[i] * (wsc[0][i] * cxa[i] + wsc[1][i] * cxb[i] + wsc[2][i] * cxc[i]); s4 += accs[i] * accs[i]; cxa[i] = cxb[i]; cxb[i] = cxc[i]; }
                const float r4 = rsqrtf(wave_sum_fast(s4) * (1.f / 512.f) + EPS);
                float ym = 0.f;
#pragma unroll
                for (int i = 0; i < 8; ++i) { o[i] *= r2; accs[i] *= r4; ym = fmaxf(ym, fmaxf(fabsf(o[i]), fabsf(accs[i]))); }
                ym = fmaxf(wave_max_fast(ym), 1e-30f);
                const float yinv = 127.f / ym;
                if (lane == 0) ((float*)(ws + WS_SY))[t] = ym * (1.f / 127.f);
                u32x2 wz, wv;
                wz.x = ((unsigned)(int)rintf(accs[0] * yinv) & 255u) | (((unsigned)(int)rintf(accs[1] * yinv) & 255u) << 8) | (((unsigned)(int)rintf(accs[2] * yinv) & 255u) << 16) | ((unsigned)(int)rintf(accs[3] * yinv) << 24);
                wz.y = ((unsigned)(int)rintf(accs[4] * yinv) & 255u) | (((unsigned)(int)rintf(accs[5] * yinv) & 255u) << 8) | (((unsigned)(int)rintf(accs[6] * yinv) & 255u) << 16) | ((unsigned)(int)rintf(accs[7] * yinv) << 24);
                wv.x = ((unsigned)(int)rintf(o[0] * yinv) & 255u) | (((unsigned)(int)rintf(o[1] * yinv) & 255u) << 8) | (((unsigned)(int)rintf(o[2] * yinv) & 255u) << 16) | ((unsigned)(int)rintf(o[3] * yinv) << 24);
                wv.y = ((unsigned)(int)rintf(o[4] * yinv) & 255u) | (((unsigned)(int)rintf(o[5] * yinv) & 255u) << 8) | (((unsigned)(int)rintf(o[6] * yinv) & 255u) << 16) | ((unsigned)(int)rintf(o[7] * yinv) << 24);
                *(u32x2*)(ws + WS_Y + t * DM + 8 * lane) = wz;
                *(u32x2*)(ws + WS_Y + t * DM + 512 + 8 * lane) = wv;
            }
        }
        __syncthreads();
    }
}

__device__ __forceinline__ int ord_i(float s) { int k = __builtin_bit_cast(int, s); k ^= (k >> 31) & 0x7fffffff; return k; }
__device__ __forceinline__ float unord_f(int k) { k ^= (k >> 31) & 0x7fffffff; return __builtin_bit_cast(float, k); }
#define TOP_INSERT(L, x_) do { int _x = (x_); _Pragma("unroll") for (int _i = 0; _i < 16; ++_i) { const int _hi = max(L[_i], _x); _x = min(L[_i], _x); L[_i] = _hi; } } while (0)

typedef short bf16x8 __attribute__((ext_vector_type(8)));
typedef float f32x16 __attribute__((ext_vector_type(16)));
template <bool DESC> __device__ __forceinline__ void ce_i(int& a, int& b) { const int hi = max(a, b), lo = min(a, b); if (DESC) { a = hi; b = lo; } else { a = lo; b = hi; } }
__device__ __forceinline__ void bitonic_sort16(int (&a)[16]) {
#pragma unroll
    for (int k = 2; k <= 16; k <<= 1)
#pragma unroll
        for (int j = k >> 1; j > 0; j >>= 1)
#pragma unroll
            for (int i = 0; i < 16; ++i) { const int l = i ^ j; if (l > i) { if ((i & k) == 0) ce_i<true>(a[i], a[l]); else ce_i<false>(a[i], a[l]); } }
}
__device__ __forceinline__ void bitonic_merge16(int (&a)[16]) {
#pragma unroll
    for (int j = 8; j > 0; j >>= 1)
#pragma unroll
        for (int i = 0; i < 16; ++i) { const int l = i ^ j; if (l > i) ce_i<true>(a[i], a[l]); }
}
__device__ __forceinline__ void merge_top16(int (&a)[16], const int (&b)[16]) {
#pragma unroll
    for (int i = 0; i < 16; ++i) a[i] = max(a[i], b[15 - i]);
    bitonic_merge16(a);
}
__device__ __forceinline__ int lut16(const unsigned (&T)[4], int i) {
    const unsigned sel = (unsigned)(i & 7) | 0x0c0c0c00u;
    const unsigned lo = __builtin_amdgcn_perm(T[1], T[0], sel), hi = __builtin_amdgcn_perm(T[3], T[2], sel);
    return (int)((i & 8) ? hi : lo);
}
constexpr int KROW = 272;
constexpr float SCORE_BIAS = 8.0f;

__device__ __forceinline__ void route_load_q(bf16x8 (&qf)[8], const bf16* qrow, int hb) {
#pragma unroll
    for (int ks = 0; ks < 8; ++ks) qf[ks] = *(const bf16x8*)(qrow + 64 * hb + 8 * ks);
}
__device__ __forceinline__ void route_half(const LAS unsigned char* kl, const bf16x8 (&qf)[8], int nl, int hb, int (&L)[16]) {
    f32x16 acc[4];
#pragma unroll
    for (int nt = 0; nt < 4; ++nt)
#pragma unroll
        for (int r = 0; r < 16; ++r) acc[nt][r] = SCORE_BIAS;
#pragma unroll
    for (int ks = 0; ks < 8; ++ks)
#pragma unroll
        for (int nt = 0; nt < 4; ++nt) {
            const bf16x8 a = *(const LAS bf16x8*)(kl + (32 * nt + nl) * KROW + (64 * hb + 8 * ks) * 2);
            acc[nt] = __builtin_amdgcn_mfma_f32_32x32x16_bf16(a, qf[ks], acc[nt], 0, 0, 0);
        }
    const int hb4 = 4 * hb;
    int T[4][16];
#pragma unroll
    for (int nt = 0; nt < 4; ++nt)
#pragma unroll
        for (int r = 0; r < 16; ++r) { const int n0 = 32 * nt + (r & 3) + 8 * (r >> 2); const float sc = acc[nt][r];
            T[nt][r] = (__float_as_int(sc) & ~127) | ((127 - n0) - hb4); }
    bitonic_sort16(T[0]); bitonic_sort16(T[1]); bitonic_sort16(T[2]); bitonic_sort16(T[3]);
    merge_top16(T[0], T[1]); merge_top16(T[2], T[3]); merge_top16(T[0], T[2]);
#pragma unroll
    for (int i = 0; i < 16; ++i) { const unsigned v = (unsigned)T[0][15 - i]; auto r = __builtin_amdgcn_permlane32_swap(v, v, false, false);
        const unsigned r0 = r[0], r1 = r[1]; const int partner = (int)(hb ? r0 : r1); L[i] = max(T[0][i], partner); }
    bitonic_merge16(L);
}

__device__ __forceinline__ void phase_route(const Params& P, LAS unsigned char* lds) {
    const int tid = threadIdx.x, lane = tid & 63, wave = __builtin_amdgcn_readfirstlane(tid >> 6);
    const int nl = lane & 31, hb = lane >> 5;
    unsigned char* ws = P.ws;
    const bf16* KEYS = (const bf16*)(ws + WS_KEYS); const bf16* Q = (const bf16*)(ws + WS_Q);
    int* IDX = (int*)(ws + WS_IDX); float* GATE = (float*)(ws + WS_GATE);
    int last_h = -1;
    pg8::StaticOrder S; S.init(NTOK, 2048, (int)gridDim.x, (int)blockIdx.x);
    pg8::Unit ucur, unxt;
    bool have = S.next(0, ucur);
    bf16x8 qfA[8], qfB[8];
    if (have) route_load_q(qfA, Q + ((size_t)ucur.pm * 256 + wave * 32 + nl) * 2048 + ucur.pn * 256, hb);
    for (int ui = 0; have; ++ui) {
        const int h = ucur.pn, tb = ucur.pm;
        const bool have_next = S.next(ui + 1, unxt);
        if (h != last_h) {
            __syncthreads();
            for (int c = tid; c < 4096; c += NTHREADS) { const u32x4 v = ((const u32x4*)(KEYS + (size_t)h * 32768))[c];
                *(LAS u32x4*)(lds + (c >> 4) * KROW + (c & 15) * 16) = v; }
            __syncthreads();
            last_h = h;
        }
        const size_t t = (size_t)tb * 256 + wave * 32 + nl;
        int L1[16], L2[16];
        route_load_q(qfB, Q + t * 2048 + h * 256 + 128, hb);
        route_half(lds, qfA, nl, hb, L1);
        if (have_next) route_load_q(qfA, Q + ((size_t)unxt.pm * 256 + wave * 32 + nl) * 2048 + unxt.pn * 256, hb);
        route_half(lds + 128 * KROW, qfB, nl, hb, L2);
        float v1[16], v2[16];
#pragma unroll
        for (int i = 0; i < 16; ++i) { v1[i] = __int_as_float(L1[i] & ~127); v2[i] = __int_as_float(L2[i] & ~127); }
#define CAND(i, j) ((__float_as_int(v1[i] + v2[j]) & ~255) | (255 - (16 * (i) + (j))))
        int A[16], B[16], C[16];
#pragma unroll
        for (int j = 0; j < 16; ++j) A[j] = CAND(0, j);
#pragma unroll
        for (int j = 0; j < 8; ++j) { B[j] = CAND(1, j); B[8 + j] = CAND(15 - j, 0); }
        bitonic_merge16(B);
        C[0] = CAND(2, 0); C[1] = CAND(2, 1); C[2] = CAND(2, 2); C[3] = CAND(2, 3); C[4] = CAND(2, 4);
        C[5] = CAND(3, 0); C[6] = CAND(3, 1); C[7] = CAND(3, 2); C[8] = CAND(3, 3);
        C[9] = CAND(4, 0); C[10] = CAND(4, 1); C[11] = CAND(4, 2);
        C[12] = CAND(5, 0); C[13] = CAND(5, 1); C[14] = CAND(6, 0); C[15] = CAND(6, 1);
        bitonic_sort16(C);
        { const int d0 = CAND(7, 0), d1 = CAND(7, 1); C[14] = max(C[14], d1); C[15] = max(C[15], d0); bitonic_merge16(C); }
#undef CAND
        merge_top16(A, B); merge_top16(A, C);
        unsigned T1[4], T2[4];
#pragma unroll
        for (int q = 0; q < 4; ++q) {
            T1[q] = (unsigned)(127 - (L1[4 * q] & 127)) | ((unsigned)(127 - (L1[4 * q + 1] & 127)) << 8) | ((unsigned)(127 - (L1[4 * q + 2] & 127)) << 16) | ((unsigned)(127 - (L1[4 * q + 3] & 127)) << 24);
            T2[q] = (unsigned)(127 - (L2[4 * q] & 127)) | ((unsigned)(127 - (L2[4 * q + 1] & 127)) << 8) | ((unsigned)(127 - (L2[4 * q + 2] & 127)) << 16) | ((unsigned)(127 - (L2[4 * q + 3] & 127)) << 24); }
        float val[16]; int ex[16];
#pragma unroll
        for (int k = 0; k < 16; ++k) { const int pos = 255 - (A[k] & 255); val[k] = __int_as_float(A[k] & ~255);
            ex[k] = lut16(T1, pos >> 4) * NKEYS + lut16(T2, pos & 15); }
        float sum = 0.f; const float vmax = val[0];
#pragma unroll
        for (int k = 0; k < 16; ++k) { val[k] = __expf(val[k] - vmax); sum += val[k]; }
        const float inv = 1.f / sum;
        if (hb == 0) {
            int* ip = IDX + t * NSEL + h * TOPK; float* gp = GATE + t * NSEL + h * TOPK;
#pragma unroll
            for (int k4 = 0; k4 < 4; ++k4) {
                *(int4*)(ip + 4 * k4) = make_int4(ex[4 * k4], ex[4 * k4 + 1], ex[4 * k4 + 2], ex[4 * k4 + 3]);
                *(f32x4*)(gp + 4 * k4) = (f32x4){val[4 * k4] * inv, val[4 * k4 + 1] * inv, val[4 * k4 + 2] * inv, val[4 * k4 + 3] * inv};
            }
        }
        ucur = unxt; have = have_next;
    }
}

#define FP4X2(w, sel) __builtin_amdgcn_cvt_scalef32_pk_f32_fp4((w), 1.0f, (sel))
__device__ __forceinline__ float dot16_fp4(const u32x2 r, const f32x4 (&xs)[4]) {
    float p = 0.f;
    { const f32x2 a = FP4X2(r.x, 0), b = FP4X2(r.x, 1), c = FP4X2(r.x, 2), d = FP4X2(r.x, 3);
      p += (a.x * xs[0].x + a.y * xs[0].y) + (b.x * xs[0].z + b.y * xs[0].w); p += (c.x * xs[1].x + c.y * xs[1].y) + (d.x * xs[1].z + d.y * xs[1].w); }
    { const f32x2 a = FP4X2(r.y, 0), b = FP4X2(r.y, 1), c = FP4X2(r.y, 2), d = FP4X2(r.y, 3);
      p += (a.x * xs[2].x + a.y * xs[2].y) + (b.x * xs[2].z + b.y * xs[2].w); p += (c.x * xs[3].x + c.y * xs[3].y) + (d.x * xs[3].z + d.y * xs[3].w); }
    return p;
}
__device__ __forceinline__ void axpy16_fp4(const u32x2 r, float w, f32x4 (&o)[4]) {
    { const f32x2 a = FP4X2(r.x, 0), b = FP4X2(r.x, 1), c = FP4X2(r.x, 2), d = FP4X2(r.x, 3);
      o[0].x += w * a.x; o[0].y += w * a.y; o[0].z += w * b.x; o[0].w += w * b.y; o[1].x += w * c.x; o[1].y += w * c.y; o[1].z += w * d.x; o[1].w += w * d.y; }
    { const f32x2 a = FP4X2(r.y, 0), b = FP4X2(r.y, 1), c = FP4X2(r.y, 2), d = FP4X2(r.y, 3);
      o[2].x += w * a.x; o[2].y += w * a.y; o[2].z += w * b.x; o[2].w += w * b.y; o[3].x += w * c.x; o[3].y += w * c.y; o[3].z += w * d.x; o[3].w += w * d.y; }
}
__device__ __forceinline__ float swap32_add(float a, float b) { auto r = __builtin_amdgcn_permlane32_swap(__float_as_uint(a), __float_as_uint(b), false, false); return __uint_as_float(r[0]) + __uint_as_float(r[1]); }
__device__ __forceinline__ float swap16_add(float a, float b) { auto r = __builtin_amdgcn_permlane16_swap(__float_as_uint(a), __float_as_uint(b), false, false); return __uint_as_float(r[0]) + __uint_as_float(r[1]); }
__device__ __forceinline__ float row_sum16(float v) { v += dpp_f<0xB1>(v); v += dpp_f<0x4E>(v); v += dpp_f<0x141>(v); v += dpp_f<0x140>(v); return v; }
constexpr int GB = 32;
typedef __attribute__((address_space(8))) void* rsrc_t;
__device__ __forceinline__ void g_issue(u32x2 (&buf)[GB], __amdgpu_buffer_rsrc_t rs, int idxr, int lb, int voff) {
#pragma unroll
    for (int j = 0; j < GB; ++j) { const int e = __builtin_amdgcn_readlane(idxr, lb + j); buf[j] = __builtin_amdgcn_raw_buffer_load_b64(rs, voff, e * 512, 0); }
}
__device__ __forceinline__ float dot16_fp4p(const u32x2 r, const f32x2 (&xp)[8]) {
    f32x2 a = FP4X2(r.x, 0) * xp[0];
    a += FP4X2(r.x, 1) * xp[1]; a += FP4X2(r.x, 2) * xp[2]; a += FP4X2(r.x, 3) * xp[3];
    a += FP4X2(r.y, 0) * xp[4]; a += FP4X2(r.y, 1) * xp[5]; a += FP4X2(r.y, 2) * xp[6]; a += FP4X2(r.y, 3) * xp[7];
    return a.x + a.y;
}
__device__ __forceinline__ void axpy16_fp4p(const u32x2 r, float w, f32x2 (&o)[8]) {
    const f32x2 ww = (f32x2){w, w};
    o[0] += FP4X2(r.x, 0) * ww; o[1] += FP4X2(r.x, 1) * ww; o[2] += FP4X2(r.x, 2) * ww; o[3] += FP4X2(r.x, 3) * ww;
    o[4] += FP4X2(r.y, 0) * ww; o[5] += FP4X2(r.y, 1) * ww; o[6] += FP4X2(r.y, 2) * ww; o[7] += FP4X2(r.y, 3) * ww;
}
template <int H> __device__ __forceinline__ void g_compute_u(const u32x2 (&buf)[GB], int q, int i16, const f32x2 (&xp)[8], float& zlo, float& zhi) {
    float p[16];
#pragma unroll
    for (int j = 0; j < 16; ++j) p[j] = dot16_fp4p(buf[16 * H + j], xp);
    float s1[8], s2[4];
#pragma unroll
    for (int m = 0; m < 8; ++m) s1[m] = swap32_add(p[2 * m], p[2 * m + 1]);
#pragma unroll
    for (int n = 0; n < 4; ++n) s2[n] = swap16_add(s1[2 * n], s1[2 * n + 1]);
#pragma unroll
    for (int r = 0; r < 4; ++r) { const float z = row_sum16(s2[r]); const bool mine = i16 == ((4 * q + r) & 15);
        zlo = (mine && q < 4) ? z : zlo; zhi = (mine && q >= 4) ? z : zhi; }
}
template <int H> __device__ __forceinline__ void g_compute_v(const u32x2 (&buf)[GB], int q, float alo, float ahi, f32x2 (&o)[8]) {
    const int areg = __builtin_bit_cast(int, (q < 4) ? alo : ahi), sb = 4 * (q & 3);
#pragma unroll
    for (int j = 0; j < 16; ++j) { const int src = 32 * (j & 1) + 16 * ((j >> 1) & 1) + (j >> 2) + sb;
        const float w = __builtin_bit_cast(float, __builtin_amdgcn_readlane(areg, src));
        axpy16_fp4p(buf[16 * H + j], w, o); }
}
__device__ __forceinline__ void q_issue(u32x2 (&buf)[16], __amdgpu_buffer_rsrc_t rs, int ixr  , int lb, int voff) {
#pragma unroll
    for (int j = 0; j < 16; ++j) { const int e9 = __builtin_amdgcn_readlane(ixr, lb + j); buf[j] = __builtin_amdgcn_raw_buffer_load_b64(rs, voff, e9, 0); }
}
__device__ __forceinline__ void q_compute_u(const u32x2 (&buf)[16], int q, int i16, const f32x2 (&xp)[8], float& zlo, float& zhi) {
    float p[16];
#pragma unroll
    for (int j = 0; j < 16; ++j) p[j] = dot16_fp4p(buf[j], xp);
    float s1[8], s2[4];
#pragma unroll
    for (int m = 0; m < 8; ++m) s1[m] = swap32_add(p[2 * m], p[2 * m + 1]);
#pragma unroll
    for (int n = 0; n < 4; ++n) s2[n] = swap16_add(s1[2 * n], s1[2 * n + 1]);
#pragma unroll
    for (int r = 0; r < 4; ++r) { const float z = row_sum16(s2[r]); const bool mine = i16 == ((4 * q + r) & 15);
        zlo = (mine && q < 4) ? z : zlo; zhi = (mine && q >= 4) ? z : zhi; }
}
__device__ __forceinline__ void q_compute_v(const u32x2 (&buf)[16], int q, float alo, float ahi, f32x2 (&o)[8]) {
    const int areg = __builtin_bit_cast(int, (q < 4) ? alo : ahi), sb = 4 * (q & 3);
#pragma unroll
    for (int j = 0; j < 16; ++j) { const int src = 32 * (j & 1) + 16 * ((j >> 1) & 1) + (j >> 2) + sb;
        const float w = __builtin_bit_cast(float, __builtin_amdgcn_readlane(areg, src));
        axpy16_fp4p(buf[j], w, o); }
}
__device__ __forceinline__ int swap32_addi(int a, int b) { auto r = __builtin_amdgcn_permlane32_swap((unsigned)a, (unsigned)b, false, false); const unsigned r0 = r[0], r1 = r[1]; return (int)(r0 + r1); }
__device__ __forceinline__ int swap16_addi(int a, int b) { auto r = __builtin_amdgcn_permlane16_swap((unsigned)a, (unsigned)b, false, false); const unsigned r0 = r[0], r1 = r[1]; return (int)(r0 + r1); }
template <int CTRL> __device__ __forceinline__ int dpp_i(int v) { return __builtin_amdgcn_update_dpp(0, v, CTRL, 0xf, 0xf, true); }
__device__ __forceinline__ int row_sum16i(int v) { v += dpp_i<0xB1>(v); v += dpp_i<0x4E>(v); v += dpp_i<0x141>(v); v += dpp_i<0x140>(v); return v; }
__device__ __forceinline__ void q_compute_ui(const u32x2 (&buf)[16], int q, int i16, int xh0, int xh1, int xl0, int xl1, int& zlo, int& zhi) {
    int p[16];
#pragma unroll
    for (int j = 0; j < 16; ++j) { const int d1 = __builtin_amdgcn_sdot8((int)buf[j].x, xh0, __builtin_amdgcn_sdot8((int)buf[j].y, xh1, 0, false), false);
        const int d2 = __builtin_amdgcn_sdot8((int)buf[j].x, xl0, __builtin_amdgcn_sdot8((int)buf[j].y, xl1, 0, false), false);
        p[j] = (d1 << 4) + d2; }
    int s1[8], s2[4];
#pragma unroll
    for (int m = 0; m < 8; ++m) s1[m] = swap32_addi(p[2 * m], p[2 * m + 1]);
#pragma unroll
    for (int n = 0; n < 4; ++n) s2[n] = swap16_addi(s1[2 * n], s1[2 * n + 1]);
#pragma unroll
    for (int r = 0; r < 4; ++r) { const int z = row_sum16i(s2[r]); const bool mine = i16 == ((4 * q + r) & 15);
        zlo = (mine && q < 4) ? z : zlo; zhi = (mine && q >= 4) ? z : zhi; }
}
__device__ __forceinline__ void phase_gather_u(const Params& P) {
    const int tid = threadIdx.x, lane = tid & 63, wave = __builtin_amdgcn_readfirstlane(tid >> 6);
    const int gw = blockIdx.x * NWAVES + wave, NGW = gridDim.x * NWAVES;
    unsigned char* ws = P.ws;
    const int* IDX = (const int*)(ws + WS_IDX); const float* GATE = (const float*)(ws + WS_GATE); const float* ESC = (const float*)(ws + WS_ESCALE); float* AW = (float*)(ws + WS_AW);
    const __amdgpu_buffer_rsrc_t rsU = __builtin_amdgcn_make_buffer_rsrc((void*)(ws + WS_U8), 0, 16384 * 512, 0x00020000);
    const bf16* H2B = (const bf16*)(ws + WS_H2B); const float* SSQ = (const float*)(ws + WS_SSQ);
    const int hh = lane >> 5, rr = (lane >> 4) & 1, i16 = lane & 15, gsel = 4 * i16 + 2 * rr + hh;
    const int voff = 8 * lane;
    const unsigned ul = (unsigned)lane;
    int t = gw;
    if (t < NTOK) {
        int idx0, idx1; u32x2 hraw[4]; float sqv;
        { const int* ip = IDX + (size_t)t * NSEL; idx0 = ip[ul]; idx1 = ip[64u + ul];
          const u32x2* hp = (const u32x2*)(H2B + (size_t)t * DM);
#pragma unroll
          for (int j = 0; j < 4; ++j) hraw[j] = hp[64u * j + ul];
          sqv = (SSQ + (size_t)t * 16)[ul & 15u]; }
        u32x2 R0[16], R1[16], R2[16], R3[16];
        { const int ix0 = idx0 << 9; q_issue(R0, rsU, ix0, 0, voff); q_issue(R1, rsU, ix0, 16, voff); q_issue(R2, rsU, ix0, 32, voff); }
        for (;;) {
            const int tn = t + NGW; const bool has_next = tn < NTOK; const int tl = has_next ? tn : t;
            int idx0n, idx1n; u32x2 hrawn[4]; float sqn, g0, g1;
            { const int* ip = IDX + (size_t)tl * NSEL; idx0n = ip[ul]; idx1n = ip[64u + ul];
              const u32x2* hp = (const u32x2*)(H2B + (size_t)tl * DM);
#pragma unroll
              for (int j = 0; j < 4; ++j) hrawn[j] = hp[64u * j + ul];
              sqn = (SSQ + (size_t)tl * 16)[ul & 15u];
              const float* gp = GATE + (size_t)t * NSEL; g0 = gp[ul]; g1 = gp[64u + ul]; }
            const float su0 = ESC[idx0], su1 = ESC[idx1], sv0 = ESC[16384 + idx0], sv1 = ESC[16384 + idx1];
            const float cq0 = ((const float*)(ws + WS_SUMQ))[idx0], cq1 = ((const float*)(ws + WS_SUMQ))[idx1];
            const float rstd2 = rsqrtf(row_sum16(sqv) * (1.f / DM) + EPS);
            float xf[16];
#pragma unroll
            for (int j = 0; j < 4; ++j) { xf[4 * j] = bflo(hraw[j].x); xf[4 * j + 1] = bfhi(hraw[j].x); xf[4 * j + 2] = bflo(hraw[j].y); xf[4 * j + 3] = bfhi(hraw[j].y); }
            float am = 0.f;
#pragma unroll
            for (int e = 0; e < 16; ++e) am = fmaxf(am, fabsf(xf[e]));
            am = fmaxf(wave_max_fast(am), 1e-30f);
            const float xinv = 127.f / am, xscale = am * (1.f / 127.f);
            unsigned xh[2] = {0u, 0u}, xl[2] = {0u, 0u};
#pragma unroll
            for (int j = 0; j < 4; ++j)
#pragma unroll
                for (int i = 0; i < 4; ++i) { const int xi = (int)rintf(xf[4 * j + i] * xinv); const int sh = 16 * (j & 1) + 4 * i;
                    xh[j >> 1] |= ((unsigned)(xi >> 4) & 15u) << sh; xl[j >> 1] |= ((unsigned)((xi & 15) - 8) & 15u) << sh; }
            int zlo = 0, zhi = 0;
            const int ix0 = idx0 << 9, ix1 = idx1 << 9;
#pragma unroll 1
            for (int qq = 0; qq < 8; qq += 4) {
                const int ixn = qq ? (idx0n << 9) : ix1;
                q_issue(R3, rsU, qq ? ix1 : ix0, 48, voff);
                q_compute_ui(R0, qq, i16, (int)xh[0], (int)xh[1], (int)xl[0], (int)xl[1], zlo, zhi);
                q_issue(R0, rsU, ixn, 0, voff);
                q_compute_ui(R1, qq + 1, i16, (int)xh[0], (int)xh[1], (int)xl[0], (int)xl[1], zlo, zhi);
                q_issue(R1, rsU, ixn, 16, voff);
                q_compute_ui(R2, qq + 2, i16, (int)xh[0], (int)xh[1], (int)xl[0], (int)xl[1], zlo, zhi);
                q_issue(R2, rsU, ixn, 32, voff);
                q_compute_ui(R3, qq + 3, i16, (int)xh[0], (int)xh[1], (int)xl[0], (int)xl[1], zlo, zhi);
            }
            const float glo = __shfl(g0, gsel), ghi = __shfl(g1, gsel), sulo = __shfl(su0, gsel), suhi = __shfl(su1, gsel), svlo = __shfl(sv0, gsel), svhi = __shfl(sv1, gsel);
            const float cqlo = __shfl(cq0, gsel), cqhi = __shfl(cq1, gsel);
            const float zfl = ((float)zlo + 8.f * cqlo) * (sulo * xscale * rstd2), zfh = ((float)zhi + 8.f * cqhi) * (suhi * xscale * rstd2);
            float* ap = AW + (size_t)t * NSEL;
            ap[lane] = gelu_tanh_f(zfl) * glo * svlo; ap[64 + lane] = gelu_tanh_f(zfh) * ghi * svhi;
            if (!has_next) break;
            t = tn; idx0 = idx0n; idx1 = idx1n; sqv = sqn;
#pragma unroll
            for (int j = 0; j < 4; ++j) hraw[j] = hrawn[j];
        }
    }
}
__device__ __forceinline__ void phase_gather_v(const Params& P) {
    const int tid = threadIdx.x, lane = tid & 63, wave = __builtin_amdgcn_readfirstlane(tid >> 6);
    const int gw = blockIdx.x * NWAVES + wave, NGW = gridDim.x * NWAVES;
    unsigned char* ws = P.ws;
    const int* IDX = (const int*)(ws + WS_IDX); const float* AW = (const float*)(ws + WS_AW);
    const __amdgpu_buffer_rsrc_t rsV = __builtin_amdgcn_make_buffer_rsrc((void*)(ws + WS_V8), 0, 16384 * 512, 0x00020000);
    const bf16* H2B = (const bf16*)(ws + WS_H2B);
    const int voff = 8 * lane;
    const unsigned ul = (unsigned)lane;
    int t = gw;
    if (t < NTOK) {
        int idx0, idx1; u32x2 hraw[4]; float alo, ahi;
        { const int* ip = IDX + (size_t)t * NSEL; idx0 = ip[ul]; idx1 = ip[64u + ul];
          const u32x2* hp = (const u32x2*)(H2B + (size_t)t * DM);
#pragma unroll
          for (int j = 0; j < 4; ++j) hraw[j] = hp[64u * j + ul];
          const float* ap = AW + (size_t)t * NSEL; alo = ap[ul]; ahi = ap[64u + ul]; }
        u32x2 R0[16], R1[16], R2[16], R3[16];
        { const int ix0 = idx0 << 9; q_issue(R0, rsV, ix0, 0, voff); q_issue(R1, rsV, ix0, 16, voff); q_issue(R2, rsV, ix0, 32, voff); }
        for (;;) {
            const int tn = t + NGW; const bool has_next = tn < NTOK; const int tl = has_next ? tn : t;
            int idx0n, idx1n; u32x2 hrawn[4]; float alon, ahin;
            { const int* ip = IDX + (size_t)tl * NSEL; idx0n = ip[ul]; idx1n = ip[64u + ul];
              const u32x2* hp = (const u32x2*)(H2B + (size_t)tl * DM);
#pragma unroll
              for (int j = 0; j < 4; ++j) hrawn[j] = hp[64u * j + ul];
              const float* ap = AW + (size_t)tl * NSEL; alon = ap[ul]; ahin = ap[64u + ul]; }
            f32x2 o[8];
#pragma unroll
            for (int j = 0; j < 8; ++j) o[j] = (f32x2){0.f, 0.f};
            const int ix0 = idx0 << 9, ix1 = idx1 << 9;
#pragma unroll 1
            for (int qq = 0; qq < 8; qq += 4) {
                const int ixn = qq ? (idx0n << 9) : ix1;
                q_issue(R3, rsV, qq ? ix1 : ix0, 48, voff);
                q_compute_v(R0, qq, alo, ahi, o);
                q_issue(R0, rsV, ixn, 0, voff);
                q_compute_v(R1, qq + 1, alo, ahi, o);
                q_issue(R1, rsV, ixn, 16, voff);
                q_compute_v(R2, qq + 2, alo, ahi, o);
                q_issue(R2, rsV, ixn, 32, voff);
                q_compute_v(R3, qq + 3, alo, ahi, o);
            }
            float ss = 0.f;
#pragma unroll
            for (int j = 0; j < 4; ++j) { o[2 * j] += (f32x2){bflo(hraw[j].x), bfhi(hraw[j].x)}; o[2 * j + 1] += (f32x2){bflo(hraw[j].y), bfhi(hraw[j].y)}; }
#pragma unroll
            for (int j = 0; j < 8; ++j) ss += o[j].x * o[j].x + o[j].y * o[j].y;
            ss = wave_sum_fast(ss);
            const float r3 = rsqrtf(ss * (1.f / DM) + EPS);
            f32x4* op = (f32x4*)(P.out + (size_t)t * DM);
            const f32x4* gfp = (const f32x4*)P.g_fin;
#pragma unroll
            for (int j = 0; j < 4; ++j) { const f32x4 gv = gfp[64u * j + ul]; op[64u * j + ul] = (f32x4){o[2 * j].x * r3 * gv.x, o[2 * j].y * r3 * gv.y, o[2 * j + 1].x * r3 * gv.z, o[2 * j + 1].y * r3 * gv.w}; }
            if (!has_next) break;
            t = tn; idx0 = idx0n; idx1 = idx1n; alo = alon; ahi = ahin;
#pragma unroll
            for (int j = 0; j < 4; ++j) hraw[j] = hrawn[j];
        }
    }
}

#define XB_TMO      128
#define XB_XCNT(j)  (256  + 64 * (j))
#define XB_XSUB(j)  (1280 + 64 * (j))
#define XB_XGEN(j)  (2304 + 64 * (j))
#define XB_TOP      3328
#define XB_TOPGEN   3392
#define XCD_BAR_WORDS 3456
#define XB_SPIN_CAP (1u << 18)

__device__ __forceinline__ unsigned xb_ld(unsigned* p)              { return __hip_atomic_load(p, __ATOMIC_RELAXED, __HIP_MEMORY_SCOPE_AGENT); }
__device__ __forceinline__ unsigned xb_add(unsigned* p, unsigned v) { return __hip_atomic_fetch_add(p, v, __ATOMIC_RELAXED, __HIP_MEMORY_SCOPE_AGENT); }
__device__ __forceinline__ unsigned xb_xcc_id() { return (unsigned)__builtin_amdgcn_s_getreg((3 << 11) | 20) & 0xFu; }
#define XB_SPIN(cond, bar) do { unsigned _sp = 0; while (cond) { __builtin_amdgcn_s_sleep(1); \
    if ((++_sp & 255u) == 0u) { if (xb_ld(&(bar)[XB_TMO])) break; if (_sp > XB_SPIN_CAP) { atomicAdd(&(bar)[XB_TMO], 1u); break; } } } } while (0)

struct XcdBarrier {
    unsigned* bar; unsigned x;
    volatile LAS unsigned* st;
};

__device__ __forceinline__ XcdBarrier xcd_barrier_post(unsigned* bar, volatile LAS unsigned* st) {
    XcdBarrier b; b.bar = bar; b.x = xb_xcc_id(); b.st = st;
    if (threadIdx.x == 0) (void)xb_add(&bar[XB_XCNT(b.x)], 1u);
    return b;
}
__device__ __forceinline__ void xcd_barrier_complete(unsigned* bar, unsigned x, unsigned& nloc, unsigned& nx) {
    const unsigned G = gridDim.x * gridDim.y * gridDim.z;
    unsigned sum, cnt, mine, sp = 0u;
    for (;;) {
        sum = 0u; cnt = 0u; mine = 0u;
#pragma unroll
        for (unsigned j = 0; j < 16; ++j) { const unsigned c = xb_ld(&bar[XB_XCNT(j)]); sum += c; cnt += (c > 0u) ? 1u : 0u; mine = (j == x) ? c : mine; }
        if (sum == G) break;
        __builtin_amdgcn_s_sleep(1);
        if ((++sp & 255u) == 0u) { if (xb_ld(&bar[XB_TMO])) break; if (sp > XB_SPIN_CAP) { atomicAdd(&bar[XB_TMO], 1u); break; } }
    }
    nloc = mine > 0u ? mine : 1u; nx = cnt > 0u ? cnt : 1u;
}

__device__ __forceinline__ void xcd_barrier(const XcdBarrier& b) {
    asm volatile("s_waitcnt vmcnt(0)" ::: "memory");
    __syncthreads();
    if (threadIdx.x == 0) {
        unsigned* bar = b.bar;
        __builtin_amdgcn_s_waitcnt(0);
        unsigned nloc = b.st[0], nx = b.st[1];
        if (nloc == 0u) { xcd_barrier_complete(bar, b.x, nloc, nx); b.st[0] = nloc; b.st[1] = nx; }
        const unsigned old = xb_add(&bar[XB_XSUB(b.x)], 1u);
        const unsigned gen = old / nloc;
        if (old + 1u == (gen + 1u) * nloc) {
            __builtin_amdgcn_fence(__ATOMIC_RELEASE, "agent");
            asm volatile("s_waitcnt vmcnt(0)" ::: "memory");
            const unsigned og = xb_add(&bar[XB_TOP], 1u);
            const unsigned tg = og / nx;
            if (og + 1u == (tg + 1u) * nx) xb_add(&bar[XB_TOPGEN], 1u);
            else XB_SPIN(xb_ld(&bar[XB_TOPGEN]) == tg, bar);
            __builtin_amdgcn_fence(__ATOMIC_ACQUIRE, "agent");
            xb_add(&bar[XB_XGEN(b.x)], 1u);
            asm volatile("s_waitcnt vmcnt(0)" ::: "memory");
        } else {
            XB_SPIN(xb_ld(&bar[XB_XGEN(b.x)]) == gen, bar);
            __builtin_amdgcn_fence(__ATOMIC_ACQUIRE, "agent");
            asm volatile("s_waitcnt vmcnt(0)" ::: "memory");
        }
    }
    __syncthreads();
}


#ifndef MK_MULTI
#define MK_MULTI 0
#endif
constexpr int NPHASE = 9;
#ifndef REP5
#define REP5 1
#endif
#ifndef REP6
#define REP6 1
#endif
__global__ void __launch_bounds__(NTHREADS, 2) mk_fwd(Params P) {
    extern __shared__ __attribute__((aligned(16))) unsigned char lds_raw[];
    LAS unsigned char* lds = (LAS unsigned char*)lds_raw;
    cg::grid_group grid = cg::this_grid();
    unsigned char* ws = P.ws;
    const int lo = P.ph_lo, hi = P.ph_hi;
    volatile LAS unsigned* bst = (volatile LAS unsigned*)(lds + 131072 + 64);
    if (threadIdx.x < 2) bst[threadIdx.x] = 0u;
    __syncthreads();
    XcdBarrier xbar = xcd_barrier_post((unsigned*)(ws + WS_CTL), bst);
#define IN(k) (lo <= (k) && (k) < hi)
#define SEAM(k) do { if (IN(k) && IN((k) + 1)) { xcd_barrier(xbar); } } while (0)
    if (IN(0)) phase_prep(P, lds);
    SEAM(0);
    if (IN(1)) { phase_metaproj(P); phase_winq(P, lds); }
    SEAM(1);
    if (IN(2)) {
        pg8::Gemm g{(const bf16*)(ws + WS_H0I8), (const bf16*)(ws + WS_WIN_T), NTOK, DIN, DM / 2}; pg8::StaticOrder S; S.init(NTOK, DIN, (int)gridDim.x, (int)blockIdx.x);
        EpiProjI8 E{(bf16*)(ws + WS_PROJ), (const float*)(ws + WS_RSTD1), (const float*)(ws + WS_SW)};
        pg8::gemm_phase_i8<EpiProjI8, pg8::StaticOrder, true, true>(lds, g, S, E);
    }
    SEAM(2);
    if (IN(3)) phase_conv(P, lds);
    SEAM(3);
    if (IN(4)) {
        pg8::Gemm g{(const bf16*)(ws + WS_Y), (const bf16*)(ws + WS_WOUT_T), NTOK, DM, DM / 2}; pg8::StaticOrder S; S.init(NTOK, DM, (int)gridDim.x, (int)blockIdx.x);
        EpiResidualI8 E{(bf16*)(ws + WS_H2B), (const signed char*)(ws + WS_H0I8), (const float*)(ws + WS_SX), (const float*)(ws + WS_SY), (const float*)(ws + WS_SWO), (float*)(ws + WS_SSQ)};
        pg8::gemm_phase_i8<EpiResidualI8, pg8::StaticOrder, true, true>(lds, g, S, E);
    }
    SEAM(4);
    if (IN(5)) {
        pg8::Gemm g{(const bf16*)(ws + WS_H2B), (const bf16*)(ws + WS_WQ_T), NTOK, 2048, DM}; pg8::StaticOrder S; S.init(NTOK, 2048, (int)gridDim.x, (int)blockIdx.x);
        EpiRowScale<1> E{(bf16*)(ws + WS_Q), 2048, (const float*)(ws + WS_SSQ)};
        pg8::gemm_phase<EpiRowScale<1>, pg8::StaticOrder, true, true>(lds, g, S, E);
    }
    if (IN(5) && IN(6)) { asm volatile("s_waitcnt vmcnt(0)" ::: "memory"); __syncthreads(); }
    if (IN(6)) phase_route(P, lds);
    SEAM(6);
    if (IN(7)) phase_gather_u(P);
    SEAM(7);
    if (IN(8)) phase_gather_v(P);
#undef IN
#undef SEAM
}

extern "C" void kernel_launch(void* const* d_in, const int* in_sizes, int n_in, void* d_out, int out_size, void* d_ws, size_t ws_size, hipStream_t stream) {
    static int grid = 0;
    if (grid == 0) {
        if (n_in != 18 || in_sizes[0] != NTOK * DM || out_size != NTOK * DM || ws_size < WS_END) {
            fprintf(stderr, "kernel_launch: unexpected shapes (n_in %d in0 %d out %d ws %zu)\n", n_in, n_in > 0 ? in_sizes[0] : -1, out_size, ws_size); grid = -1; return; }
        int dev = 0, cus = 0, per_cu = 0;
        (void)hipGetDevice(&dev); (void)hipDeviceGetAttribute(&cus, hipDeviceAttributeMultiprocessorCount, dev);
        if (hipFuncSetAttribute((const void*)mk_fwd, hipFuncAttributeMaxDynamicSharedMemorySize, LDS_BYTES) != hipSuccess) { fprintf(stderr, "kernel_launch: hipFuncSetAttribute failed\n"); grid = -1; return; }
        if (hipOccupancyMaxActiveBlocksPerMultiprocessor(&per_cu, (const void*)mk_fwd, NTHREADS, LDS_BYTES) != hipSuccess || per_cu < 1) { fprintf(stderr, "kernel_launch: occupancy query failed (%d)\n", per_cu); (void)hipGetLastError(); per_cu = 1; }
        if (per_cu > 1) per_cu = 1;
        grid = cus * per_cu;
        if (grid <= 0) grid = 256;
    }
    if (grid < 0) return;
    Params p{};
    p.x = (const float*)d_in[0]; p.meta = (const float*)d_in[1]; p.g_mix = (const float*)d_in[2]; p.w_in = (const float*)d_in[3]; p.sc_w = (const float*)d_in[4];
    p.cf_w = (const float*)d_in[5]; p.cf_b = (const float*)d_in[6]; p.ln_g = (const float*)d_in[7]; p.ln_b = (const float*)d_in[8]; p.g_sc = (const float*)d_in[9];
    p.g_cf = (const float*)d_in[10]; p.w_out = (const float*)d_in[11]; p.g_ffn = (const float*)d_in[12]; p.w_q = (const float*)d_in[13]; p.keys = (const float*)d_in[14];
    p.pu = (const float*)d_in[15]; p.pv = (const float*)d_in[16]; p.g_fin = (const float*)d_in[17];
    p.out = (float*)d_out; p.ws = (unsigned char*)d_ws;
    (void)hipMemsetAsync((char*)d_ws + WS_CTL, 0, 40960, stream);
#if MK_MULTI
    for (int ph = 0; ph < NPHASE; ++ph) { p.ph_lo = ph; p.ph_hi = ph + 1; p.coop = 0; p.pad = 0;
        hipLaunchKernelGGL(mk_fwd, dim3(grid), dim3(NTHREADS), LDS_BYTES, stream, p); }
#else
    p.ph_lo = 0; p.ph_hi = NPHASE; p.coop = 1; p.pad = 0;
    void* args[] = {&p};
    hipError_t e = hipLaunchCooperativeKernel((const void*)mk_fwd, dim3(grid), dim3(NTHREADS), args, LDS_BYTES, stream);
    if (e != hipSuccess) fprintf(stderr, "cooperative launch failed: %s (grid %d)\n", hipGetErrorString(e), grid);
#endif
}
```

```cpp
#include <hip/hip_runtime.h>
#include <hip/hip_cooperative_groups.h>
#include <cstdio>
#include <cstdint>
namespace cg = cooperative_groups;

namespace pg8 {
#define PG8_LAS __attribute__((address_space(3)))
typedef unsigned short bf16_t;
typedef short bf16x8 __attribute__((ext_vector_type(8)));
typedef float f32x4 __attribute__((ext_vector_type(4)));
typedef unsigned u32x4 __attribute__((ext_vector_type(4)));
typedef int i32x4 __attribute__((ext_vector_type(4)));
constexpr int BM = 256, BK = 64, HALF = 128, HTB = HALF * BK * 2  , STAGE_BYTES = 8 * HTB, NXCD = 8, WGM = 8;

__host__ __device__ __forceinline__ int lds_byte(int r, int c) { const int st = (r >> 4) * 2 + (c >> 5), rr = r & 15, cc = c & 31, ob = rr * 64 + cc * 2; return st * 1024 + (ob ^ (((ob >> 9) & 1) << 5)); }
__host__ __device__ __forceinline__ void stage_rc(int b, int& R, int& C) { const int st = b / 1024, sb = b % 1024, swz = sb ^ (((sb >> 9) & 1) << 5); R = (st >> 1) * 16 + swz / 64; C = (st & 1) * 32 + (swz % 64) / 2; }
__host__ __device__ __forceinline__ int perm32(int rho) { const int n = rho >> 4, i = rho & 15; return 8 * (i >> 2) + 4 * n + (i & 3); }

struct Unit { int pm, pn; };
struct Gemm { const bf16_t* A; const bf16_t* Bt; int M, N, K; };

struct StaticOrder {
    int nM, nN, nwg, G, c;
    __host__ __device__ void init(int M, int N, int G_, int c_) { nM = M / BM; nN = N / BM; nwg = nM * nN; G = G_; c = c_; }
    __host__ __device__ bool next(int i, Unit& u) const {
        const long L = (long)i * G + c; if (L >= nwg) return false;
        int wgid = (int)L; { const int q = nwg / NXCD, r = nwg % NXCD, xcd = wgid % NXCD, off = wgid / NXCD; wgid = (xcd < r ? xcd * (q + 1) : r * (q + 1) + (xcd - r) * q) + off; }
        const int nig = WGM * nN, gid = wgid / nig, fm = gid * WGM, gsz = (nM - fm) < WGM ? (nM - fm) : WGM;
        u.pm = fm + ((wgid % nig) % gsz); u.pn = (wgid % nig) / gsz; return true;
    }
    __device__ __forceinline__ void a_ready(const Unit&) const {}
    __device__ __forceinline__ void done(const Unit&) const {}
};

template <class Epi, class Sched, bool ALIGN_EPI = false, bool SP2 = false>
__device__ __forceinline__ void gemm_phase(PG8_LAS unsigned char* lds, const Gemm g, const Sched& S, const Epi& E) {
    const int tid = threadIdx.x, wid = __builtin_amdgcn_readfirstlane(tid >> 6), lane = tid & 63, wr = wid >> 2, wc = wid & 3, fr = lane & 15, fq = lane >> 4;
    const int K = g.K, nt = K / BK;
    unsigned voffA[2], voffB[2];
#pragma unroll
    for (int i = 0; i < 2; ++i) { int R, C; stage_rc(tid * 16 + i * 8192, R, C); const int Rb = Epi::PERM ? ((R & ~31) + perm32(R & 31)) : R;
        voffA[i] = (unsigned)(R * K + C) * 2u; voffB[i] = (unsigned)(Rb * K + C) * 2u; }
    const size_t kstep = (size_t)(BK * 2);
    const size_t hstep = (size_t)HALF * K * 2;
    const size_t tstep = 2 * hstep;
    const unsigned ldsw = (unsigned)wid * 1024u;
    const int aoff = lds_byte(wr * 64 + fr, fq * 8), boff = lds_byte(wc * 32 + fr, fq * 8);
#define PG8_SA(b, h) (((b) * 2 + (h)) * HTB)
#define PG8_SB(b, h) ((4 + (b) * 2 + (h)) * HTB)
#define PG8_STAGE(bufoff, gbase, voff) do { _Pragma("unroll") for (int _i = 0; _i < 2; ++_i) \
        __builtin_amdgcn_global_load_lds((const unsigned*)((const char*)(gbase) + (voff)[_i]), (PG8_LAS unsigned*)(lds + (bufoff) + ldsw + _i * 8192), 16, 0, 0); } while (0)
#define PG8_LDA(dst, b, h) do { _Pragma("unroll") for (int m = 0; m < 4; ++m) _Pragma("unroll") for (int k = 0; k < 2; ++k) dst[m][k] = *(const PG8_LAS bf16x8*)(lds + PG8_SA(b, h) + aoff + m * 2048 + k * 1024); } while (0)
#define PG8_LDB(dst, b, h) do { _Pragma("unroll") for (int n = 0; n < 2; ++n) _Pragma("unroll") for (int k = 0; k < 2; ++k) dst[n][k] = *(const PG8_LAS bf16x8*)(lds + PG8_SB(b, h) + boff + n * 2048 + k * 1024); } while (0)
#define PG8_MMA(ai, bj, At, Bt) do { __builtin_amdgcn_s_setprio(1); _Pragma("unroll") for (int m = 0; m < 4; ++m) _Pragma("unroll") for (int n = 0; n < 2; ++n) _Pragma("unroll") for (int k = 0; k < 2; ++k) \
        acc[ai][bj][m][n] = __builtin_amdgcn_mfma_f32_16x16x32_bf16(Bt[n][k], At[m][k], acc[ai][bj][m][n], 0, 0, 0); __builtin_amdgcn_s_setprio(0); } while (0)
#define PG8_WAIT_V(n) asm volatile("s_waitcnt vmcnt(" #n ")" ::: "memory")
#define PG8_WAIT_L(n) asm volatile("s_waitcnt lgkmcnt(" #n ")" ::: "memory")
#define PG8_BAR __builtin_amdgcn_s_barrier()
#define PG8_SCHED __builtin_amdgcn_sched_barrier(0)
    Unit cur, nxt; int ui = 0;
    if (!S.next(0, cur)) return;
    f32x4 acc[2][2][4][2];
#pragma unroll
    for (int a = 0; a < 2; ++a)
#pragma unroll
        for (int b = 0; b < 2; ++b)
#pragma unroll
            for (int m = 0; m < 4; ++m)
#pragma unroll
                for (int n = 0; n < 2; ++n) acc[a][b][m][n] = (f32x4){0.f, 0.f, 0.f, 0.f};
    bf16x8 At[4][2], B0[2][2], B1[2][2];
    const char* cA = (const char*)g.A + (size_t)cur.pm * tstep; const char* cB = (const char*)g.Bt + (size_t)cur.pn * tstep;
    S.a_ready(cur);
    if constexpr (SP2) {
        PG8_STAGE(PG8_SB(0, 0), cB, voffB); PG8_STAGE(PG8_SB(0, 1), cB + hstep, voffB); PG8_STAGE(PG8_SA(0, 0), cA, voffA); PG8_STAGE(PG8_SA(0, 1), cA + hstep, voffA);
        if (wr == 1) PG8_BAR;
        PG8_WAIT_V(2); PG8_BAR;
        PG8_STAGE(PG8_SB(1, 0), cB + kstep, voffB); PG8_STAGE(PG8_SA(1, 0), cA + kstep, voffA); PG8_STAGE(PG8_SB(1, 1), cB + hstep + kstep, voffB);
        PG8_WAIT_V(6); PG8_BAR;
    } else {
        PG8_STAGE(PG8_SB(0, 0), cB, voffB); PG8_STAGE(PG8_SA(0, 0), cA, voffA); PG8_STAGE(PG8_SB(0, 1), cB + hstep, voffB); PG8_STAGE(PG8_SA(0, 1), cA + hstep, voffA);
        if (wr == 1) PG8_BAR;
        PG8_WAIT_V(4); PG8_BAR;
        PG8_STAGE(PG8_SB(1, 0), cB + kstep, voffB); PG8_STAGE(PG8_SA(1, 0), cA + kstep, voffA); PG8_STAGE(PG8_SB(1, 1), cB + hstep + kstep, voffB);
        PG8_WAIT_V(6); PG8_BAR;
    }
    for (;;) {
        const bool has_next = S.next(ui + 1, nxt);
        const char* nA = has_next ? (const char*)g.A + (size_t)nxt.pm * tstep : cA; const char* nB = has_next ? (const char*)g.Bt + (size_t)nxt.pn * tstep : cB;
        for (int t = 0; t < nt; t += 2) {
            const bool last = (t == nt - 2);
            const char* a1 = cA + (size_t)(t + 1) * kstep;
            const char* a2 = last ? nA : cA + (size_t)(t + 2) * kstep; const char* b2 = last ? nB : cB + (size_t)(t + 2) * kstep;
            const char* a3 = a2 + kstep; const char* b3 = b2 + kstep;
            if (last && has_next) S.a_ready(nxt);
            if constexpr (SP2) {
            PG8_LDB(B0, 0, 0); PG8_LDB(B1, 0, 1); PG8_SCHED; PG8_LDA(At, 0, 0); PG8_STAGE(PG8_SA(1, 1), a1 + hstep, voffA);
            PG8_WAIT_V(8); PG8_WAIT_L(0); PG8_BAR; PG8_MMA(0, 0, At, B0); PG8_MMA(0, 1, At, B1); PG8_BAR; PG8_SCHED;
            PG8_LDA(At, 0, 1); PG8_STAGE(PG8_SB(0, 0), b2, voffB); PG8_STAGE(PG8_SB(0, 1), b2 + hstep, voffB); PG8_STAGE(PG8_SA(0, 0), a2, voffA);
            PG8_WAIT_V(8); PG8_WAIT_L(0); PG8_BAR; PG8_MMA(1, 0, At, B0); PG8_MMA(1, 1, At, B1); PG8_BAR; PG8_SCHED;
            PG8_LDB(B0, 1, 0); PG8_LDB(B1, 1, 1); PG8_SCHED; PG8_LDA(At, 1, 0); PG8_STAGE(PG8_SA(0, 1), a2 + hstep, voffA);
            PG8_WAIT_V(8); PG8_WAIT_L(0); PG8_BAR; PG8_MMA(0, 0, At, B0); PG8_MMA(0, 1, At, B1); PG8_BAR; PG8_SCHED;
            PG8_LDA(At, 1, 1); PG8_STAGE(PG8_SB(1, 0), b3, voffB); PG8_STAGE(PG8_SB(1, 1), b3 + hstep, voffB); PG8_STAGE(PG8_SA(1, 0), a3, voffA);
            PG8_WAIT_V(8); PG8_WAIT_L(0); PG8_BAR; PG8_MMA(1, 0, At, B0); PG8_MMA(1, 1, At, B1); PG8_BAR; PG8_SCHED;
            } else {
            PG8_LDB(B0, 0, 0); PG8_SCHED; PG8_LDA(At, 0, 0); PG8_STAGE(PG8_SA(1, 1), a1 + hstep, voffA);
            PG8_WAIT_L(8); PG8_BAR; PG8_WAIT_L(0); PG8_MMA(0, 0, At, B0); PG8_BAR; PG8_SCHED;
            PG8_LDB(B1, 0, 1); PG8_STAGE(PG8_SB(0, 0), b2, voffB);
            PG8_BAR; PG8_WAIT_L(0); PG8_MMA(0, 1, At, B1); PG8_BAR;
            PG8_LDA(At, 0, 1); PG8_STAGE(PG8_SA(0, 0), a2, voffA);
            PG8_BAR; PG8_WAIT_L(0); PG8_MMA(1, 0, At, B0); PG8_BAR; PG8_SCHED;
            PG8_STAGE(PG8_SB(0, 1), b2 + hstep, voffB);
            PG8_WAIT_V(6); PG8_BAR; PG8_MMA(1, 1, At, B1); PG8_BAR;
            PG8_LDB(B0, 1, 0); PG8_SCHED; PG8_LDA(At, 1, 0); PG8_STAGE(PG8_SA(0, 1), a2 + hstep, voffA);
            PG8_WAIT_L(8); PG8_BAR; PG8_WAIT_L(0); PG8_MMA(0, 0, At, B0); PG8_BAR; PG8_SCHED;
            PG8_LDB(B1, 1, 1); PG8_STAGE(PG8_SB(1, 0), b3, voffB);
            PG8_BAR; PG8_WAIT_L(0); PG8_MMA(0, 1, At, B1); PG8_BAR;
            PG8_LDA(At, 1, 1); PG8_STAGE(PG8_SA(1, 0), a3, voffA);
            PG8_BAR; PG8_WAIT_L(0); PG8_MMA(1, 0, At, B0); PG8_BAR; PG8_SCHED;
            PG8_STAGE(PG8_SB(1, 1), b3 + hstep, voffB);
            PG8_WAIT_V(6); PG8_BAR; PG8_MMA(1, 1, At, B1); PG8_BAR;
            }
        }
        if constexpr (ALIGN_EPI) { if (wr == 0) PG8_BAR; }
        if constexpr (!Epi::AFTER_DRAIN) { E(acc, cur, wr, wc, fr, fq); S.done(cur); }
        if (!has_next) break;
#pragma unroll
        for (int a = 0; a < 2; ++a)
#pragma unroll
            for (int b = 0; b < 2; ++b)
#pragma unroll
                for (int m = 0; m < 4; ++m)
#pragma unroll
                    for (int n = 0; n < 2; ++n) acc[a][b][m][n] = (f32x4){0.f, 0.f, 0.f, 0.f};
        cur = nxt; cA = nA; cB = nB; ++ui;
        if constexpr (ALIGN_EPI) { if (wr == 1) PG8_BAR; }
    }
    PG8_WAIT_V(0);
    if constexpr (!ALIGN_EPI) { if (wr == 0) PG8_BAR; }
    PG8_BAR;
    if constexpr (Epi::AFTER_DRAIN) { E.fused(acc, cur, wr, wc, fr, fq, lds, wid, lane); S.done(cur); }
#undef PG8_SA
#undef PG8_SB
#undef PG8_STAGE
#undef PG8_LDA
#undef PG8_LDB
#undef PG8_MMA
#undef PG8_WAIT_V
#undef PG8_WAIT_L
#undef PG8_BAR
#undef PG8_SCHED
}
template <class Epi, class Sched, bool ALIGN_EPI = false, bool SP2 = false>
__device__ __forceinline__ void gemm_phase_i8(PG8_LAS unsigned char* lds, const Gemm g, const Sched& S, const Epi& E) {
    const int tid = threadIdx.x, wid = __builtin_amdgcn_readfirstlane(tid >> 6), lane = tid & 63, wr = wid >> 2, wc = wid & 3, fr = lane & 15, fq = lane >> 4;
    const int K = g.K, nt = K / BK;
    unsigned voffA[2], voffB[2];
#pragma unroll
    for (int i = 0; i < 2; ++i) { int R, C; stage_rc(tid * 16 + i * 8192, R, C); const int Rb = Epi::PERM ? ((R & ~31) + perm32(R & 31)) : R;
        voffA[i] = (unsigned)(R * K + C) * 2u; voffB[i] = (unsigned)(Rb * K + C) * 2u; }
    const size_t kstep = (size_t)(BK * 2);
    const size_t hstep = (size_t)HALF * K * 2;
    const size_t tstep = 2 * hstep;
    const unsigned ldsw = (unsigned)wid * 1024u;
    const int aoff = lds_byte(wr * 64 + fr, fq * 8), boff = lds_byte(wc * 32 + fr, fq * 8);
#define PG8_SA(b, h) (((b) * 2 + (h)) * HTB)
#define PG8_SB(b, h) ((4 + (b) * 2 + (h)) * HTB)
#define PG8_STAGE(bufoff, gbase, voff) do { _Pragma("unroll") for (int _i = 0; _i < 2; ++_i) \
        __builtin_amdgcn_global_load_lds((const unsigned*)((const char*)(gbase) + (voff)[_i]), (PG8_LAS unsigned*)(lds + (bufoff) + ldsw + _i * 8192), 16, 0, 0); } while (0)
#define PG8_LDA(dst, b, h) do { _Pragma("unroll") for (int m = 0; m < 4; ++m) _Pragma("unroll") for (int k = 0; k < 2; ++k) dst[m][k] = *(const PG8_LAS bf16x8*)(lds + PG8_SA(b, h) + aoff + m * 2048 + k * 1024); } while (0)
#define PG8_LDB(dst, b, h) do { _Pragma("unroll") for (int n = 0; n < 2; ++n) _Pragma("unroll") for (int k = 0; k < 2; ++k) dst[n][k] = *(const PG8_LAS bf16x8*)(lds + PG8_SB(b, h) + boff + n * 2048 + k * 1024); } while (0)
#define PG8_MMA(ai, bj, At, Bt) do { __builtin_amdgcn_s_setprio(1); _Pragma("unroll") for (int m = 0; m < 4; ++m) _Pragma("unroll") for (int n = 0; n < 2; ++n) _Pragma("unroll") for (int k = 0; k < 2; ++k) \
        acc[ai][bj][m][n] = __builtin_amdgcn_mfma_i32_16x16x64_i8(__builtin_bit_cast(i32x4, Bt[n][k]), __builtin_bit_cast(i32x4, At[m][k]), acc[ai][bj][m][n], 0, 0, 0); __builtin_amdgcn_s_setprio(0); } while (0)
#define PG8_WAIT_V(n) asm volatile("s_waitcnt vmcnt(" #n ")" ::: "memory")
#define PG8_WAIT_L(n) asm volatile("s_waitcnt lgkmcnt(" #n ")" ::: "memory")
#define PG8_BAR __builtin_amdgcn_s_barrier()
#define PG8_SCHED __builtin_amdgcn_sched_barrier(0)
    Unit cur, nxt; int ui = 0;
    if (!S.next(0, cur)) return;
    i32x4 acc[2][2][4][2];
#pragma unroll
    for (int a = 0; a < 2; ++a)
#pragma unroll
        for (int b = 0; b < 2; ++b)
#pragma unroll
            for (int m = 0; m < 4; ++m)
#pragma unroll
                for (int n = 0; n < 2; ++n) acc[a][b][m][n] = (i32x4){0, 0, 0, 0};
    bf16x8 At[4][2], B0[2][2], B1[2][2];
    const char* cA = (const char*)g.A + (size_t)cur.pm * tstep; const char* cB = (const char*)g.Bt + (size_t)cur.pn * tstep;
    S.a_ready(cur);
    if constexpr (SP2) {
        PG8_STAGE(PG8_SB(0, 0), cB, voffB); PG8_STAGE(PG8_SB(0, 1), cB + hstep, voffB); PG8_STAGE(PG8_SA(0, 0), cA, voffA); PG8_STAGE(PG8_SA(0, 1), cA + hstep, voffA);
        if (wr == 1) PG8_BAR;
        PG8_WAIT_V(2); PG8_BAR;
        PG8_STAGE(PG8_SB(1, 0), cB + kstep, voffB); PG8_STAGE(PG8_SA(1, 0), cA + kstep, voffA); PG8_STAGE(PG8_SB(1, 1), cB + hstep + kstep, voffB);
        PG8_WAIT_V(6); PG8_BAR;
    } else {
        PG8_STAGE(PG8_SB(0, 0), cB, voffB); PG8_STAGE(PG8_SA(0, 0), cA, voffA); PG8_STAGE(PG8_SB(0, 1), cB + hstep, voffB); PG8_STAGE(PG8_SA(0, 1), cA + hstep, voffA);
        if (wr == 1) PG8_BAR;
        PG8_WAIT_V(4); PG8_BAR;
        PG8_STAGE(PG8_SB(1, 0), cB + kstep, voffB); PG8_STAGE(PG8_SA(1, 0), cA + kstep, voffA); PG8_STAGE(PG8_SB(1, 1), cB + hstep + kstep, voffB);
        PG8_WAIT_V(6); PG8_BAR;
    }
    for (;;) {
        const bool has_next = S.next(ui + 1, nxt);
        const char* nA = has_next ? (const char*)g.A + (size_t)nxt.pm * tstep : cA; const char* nB = has_next ? (const char*)g.Bt + (size_t)nxt.pn * tstep : cB;
        for (int t = 0; t < nt; t += 2) {
            const bool last = (t == nt - 2);
            const char* a1 = cA + (size_t)(t + 1) * kstep;
            const char* a2 = last ? nA : cA + (size_t)(t + 2) * kstep; const char* b2 = last ? nB : cB + (size_t)(t + 2) * kstep;
            const char* a3 = a2 + kstep; const char* b3 = b2 + kstep;
            if (last && has_next) S.a_ready(nxt);
            if constexpr (SP2) {
            PG8_LDB(B0, 0, 0); PG8_LDB(B1, 0, 1); PG8_SCHED; PG8_LDA(At, 0, 0); PG8_STAGE(PG8_SA(1, 1), a1 + hstep, voffA);
            PG8_WAIT_V(8); PG8_WAIT_L(0); PG8_BAR; PG8_MMA(0, 0, At, B0); PG8_MMA(0, 1, At, B1); PG8_BAR; PG8_SCHED;
            PG8_LDA(At, 0, 1); PG8_STAGE(PG8_SB(0, 0), b2, voffB); PG8_STAGE(PG8_SB(0, 1), b2 + hstep, voffB); PG8_STAGE(PG8_SA(0, 0), a2, voffA);
            PG8_WAIT_V(8); PG8_WAIT_L(0); PG8_BAR; PG8_MMA(1, 0, At, B0); PG8_MMA(1, 1, At, B1); PG8_BAR; PG8_SCHED;
            PG8_LDB(B0, 1, 0); PG8_LDB(B1, 1, 1); PG8_SCHED; PG8_LDA(At, 1, 0); PG8_STAGE(PG8_SA(0, 1), a2 + hstep, voffA);
            PG8_WAIT_V(8); PG8_WAIT_L(0); PG8_BAR; PG8_MMA(0, 0, At, B0); PG8_MMA(0, 1, At, B1); PG8_BAR; PG8_SCHED;
            PG8_LDA(At, 1, 1); PG8_STAGE(PG8_SB(1, 0), b3, voffB); PG8_STAGE(PG8_SB(1, 1), b3 + hstep, voffB); PG8_STAGE(PG8_SA(1, 0), a3, voffA);
            PG8_WAIT_V(8); PG8_WAIT_L(0); PG8_BAR; PG8_MMA(1, 0, At, B0); PG8_MMA(1, 1, At, B1); PG8_BAR; PG8_SCHED;
            } else {
            PG8_LDB(B0, 0, 0); PG8_SCHED; PG8_LDA(At, 0, 0); PG8_STAGE(PG8_SA(1, 1), a1 + hstep, voffA);
            PG8_WAIT_L(8); PG8_BAR; PG8_WAIT_L(0); PG8_MMA(0, 0, At, B0); PG8_BAR; PG8_SCHED;
            PG8_LDB(B1, 0, 1); PG8_STAGE(PG8_SB(0, 0), b2, voffB);
            PG8_BAR; PG8_WAIT_L(0); PG8_MMA(0, 1, At, B1); PG8_BAR;
            PG8_LDA(At, 0, 1); PG8_STAGE(PG8_SA(0, 0), a2, voffA);
            PG8_BAR; PG8_WAIT_L(0); PG8_MMA(1, 0, At, B0); PG8_BAR; PG8_SCHED;
            PG8_STAGE(PG8_SB(0, 1), b2 + hstep, voffB);
            PG8_WAIT_V(6); PG8_BAR; PG8_MMA(1, 1, At, B1); PG8_BAR;
            PG8_LDB(B0, 1, 0); PG8_SCHED; PG8_LDA(At, 1, 0); PG8_STAGE(PG8_SA(0, 1), a2 + hstep, voffA);
            PG8_WAIT_L(8); PG8_BAR; PG8_WAIT_L(0); PG8_MMA(0, 0, At, B0); PG8_BAR; PG8_SCHED;
            PG8_LDB(B1, 1, 1); PG8_STAGE(PG8_SB(1, 0), b3, voffB);
            PG8_BAR; PG8_WAIT_L(0); PG8_MMA(0, 1, At, B1); PG8_BAR;
            PG8_LDA(At, 1, 1); PG8_STAGE(PG8_SA(1, 0), a3, voffA);
            PG8_BAR; PG8_WAIT_L(0); PG8_MMA(1, 0, At, B0); PG8_BAR; PG8_SCHED;
            PG8_STAGE(PG8_SB(1, 1), b3 + hstep, voffB);
            PG8_WAIT_V(6); PG8_BAR; PG8_MMA(1, 1, At, B1); PG8_BAR;
            }
        }
        if constexpr (ALIGN_EPI) { if (wr == 0) PG8_BAR; }
        if constexpr (!Epi::AFTER_DRAIN) { E(acc, cur, wr, wc, fr, fq); S.done(cur); }
        if (!has_next) break;
#pragma unroll
        for (int a = 0; a < 2; ++a)
#pragma unroll
            for (int b = 0; b < 2; ++b)
#pragma unroll
                for (int m = 0; m < 4; ++m)
#pragma unroll
                    for (int n = 0; n < 2; ++n) acc[a][b][m][n] = (i32x4){0, 0, 0, 0};
        cur = nxt; cA = nA; cB = nB; ++ui;
        if constexpr (ALIGN_EPI) { if (wr == 1) PG8_BAR; }
    }
    PG8_WAIT_V(0);
    if constexpr (!ALIGN_EPI) { if (wr == 0) PG8_BAR; }
    PG8_BAR;
    if constexpr (Epi::AFTER_DRAIN) { E.fused(acc, cur, wr, wc, fr, fq, lds, wid, lane); S.done(cur); }
#undef PG8_SA
#undef PG8_SB
#undef PG8_STAGE
#undef PG8_LDA
#undef PG8_LDB
#undef PG8_MMA
#undef PG8_WAIT_V
#undef PG8_WAIT_L
#undef PG8_BAR
#undef PG8_SCHED
}
}

#define LAS __attribute__((address_space(3)))
typedef unsigned short bf16;
typedef float f32x2 __attribute__((ext_vector_type(2)));
typedef float f32x4 __attribute__((ext_vector_type(4)));
typedef unsigned u32x2 __attribute__((ext_vector_type(2)));
typedef unsigned u32x4 __attribute__((ext_vector_type(4)));

constexpr int PDIM = 1536;
constexpr int NTOK = 32768, DM = 1024, DIN = 2560, SEQ = 8192, NBATCH = 4, NMETA = 16;
constexpr int NHEAD = 8, NKEYS = 128, TOPK = 16, NSEL = NHEAD * TOPK;
constexpr float EPS = 1e-6f;
constexpr float U_SCALE = 64.f, V_SCALE = 16.f;
constexpr float U4_CLIP = 2.6f;
constexpr int NWAVES = 8, NTHREADS = 512;
constexpr int MKC = 32;
constexpr int LDS_BYTES = 147456;

constexpr size_t MiB = 1u << 20;
constexpr size_t WS_CTL = 0, WS_WIN_T = 1 * MiB, WS_WOUT_T = 6 * MiB, WS_WQ_T = 8 * MiB, WS_KEYS = 12 * MiB, WS_METAPART = 160 * MiB  ,
                 WS_METARSTD = 14 * MiB + 512 * 1024, WS_METAPROJ = 14 * MiB + 576 * 1024, WS_RSTD1 = 15 * MiB, WS_SSQ = 16 * MiB, WS_U8 = 32 * MiB, WS_V8 = 48 * MiB,
                 WS_IDX = 64 * MiB, WS_GATE = 80 * MiB, WS_H0B = 96 * MiB, WS_H2B = 96 * MiB, WS_Y = 160 * MiB, WS_PROJ = 224 * MiB,
                 WS_Q = 224 * MiB, WS_ESCALE = 18 * MiB, WS_SUMQ = 19 * MiB, WS_SX = 20 * MiB, WS_SW = 21 * MiB, WS_SY = 22 * MiB, WS_SWO = 23 * MiB, WS_H0I8 = 384 * MiB, WS_AW = 160 * MiB  , WS_END = 416 * MiB;

struct Params {
    const float* x; const float* meta; const float* g_mix; const float* w_in; const float* sc_w; const float* cf_w; const float* cf_b;
    const float* ln_g; const float* ln_b; const float* g_sc; const float* g_cf; const float* w_out; const float* g_ffn; const float* w_q;
    const float* keys; const float* pu; const float* pv; const float* g_fin;
    float* out; unsigned char* ws;
    int ph_lo, ph_hi, coop, pad;
};

__device__ __forceinline__ unsigned f2bf(float f) { unsigned u = __builtin_bit_cast(unsigned, f); return (u + 0x7fffu + ((u >> 16) & 1u)) >> 16; }
__device__ __forceinline__ unsigned pk2(float lo, float hi) { return f2bf(lo) | (f2bf(hi) << 16); }
__device__ __forceinline__ float bf2f(unsigned b) { return __builtin_bit_cast(float, b << 16); }
__device__ __forceinline__ float bflo(unsigned w) { return __builtin_bit_cast(float, w << 16); }
__device__ __forceinline__ float bfhi(unsigned w) { return __builtin_bit_cast(float, w & 0xffff0000u); }
__device__ __forceinline__ float wave_sum(float v) {
#pragma unroll
    for (int o = 1; o < 64; o <<= 1) v += __shfl_xor(v, o);
    return v;
}
template <int CTRL> __device__ __forceinline__ float dpp_f(float v) { return __builtin_bit_cast(float, __builtin_amdgcn_update_dpp(0, __builtin_bit_cast(int, v), CTRL, 0xf, 0xf, true)); }
__device__ __forceinline__ float wave_sum_fast(float v) {
    v += dpp_f<0xB1>(v); v += dpp_f<0x4E>(v); v += dpp_f<0x141>(v); v += dpp_f<0x140>(v);
    { auto r = __builtin_amdgcn_permlane16_swap(__float_as_uint(v), __float_as_uint(v), false, false); v = __uint_as_float(r[0]) + __uint_as_float(r[1]); }
    { auto r = __builtin_amdgcn_permlane32_swap(__float_as_uint(v), __float_as_uint(v), false, false); v = __uint_as_float(r[0]) + __uint_as_float(r[1]); }
    return v;
}
__device__ __forceinline__ float wave_max_fast(float v) {
    v = fmaxf(v, dpp_f<0xB1>(v)); v = fmaxf(v, dpp_f<0x4E>(v)); v = fmaxf(v, dpp_f<0x141>(v)); v = fmaxf(v, dpp_f<0x140>(v));
    { auto r = __builtin_amdgcn_permlane16_swap(__float_as_uint(v), __float_as_uint(v), false, false); v = fmaxf(__uint_as_float(r[0]), __uint_as_float(r[1])); }
    { auto r = __builtin_amdgcn_permlane32_swap(__float_as_uint(v), __float_as_uint(v), false, false); v = fmaxf(__uint_as_float(r[0]), __uint_as_float(r[1])); }
    return v;
}
__device__ __forceinline__ float sigmoid_f(float x) { return 1.f / (1.f + __expf(-x)); }
__device__ __forceinline__ float gelu_tanh_f(float x) {
    const float t = 0.7978845608028654f * (x + 0.044715f * x * x * x);
    const float e = __expf(2.f * t);
    const float th = 1.f - 2.f / (e + 1.f);
    return 0.5f * x * (1.f + th);
}

__device__ __forceinline__ unsigned cvt_pk_bf16(float lo, float hi) { unsigned r; asm volatile("v_cvt_pk_bf16_f32 %0, %1, %2" : "=v"(r) : "v"(lo), "v"(hi)); return r; }

template <int MODE> struct EpiRowScale {
    static constexpr bool PERM = true, AFTER_DRAIN = false;
    bf16* O; int ldc; const float* rs;
    __device__ __forceinline__ void operator()(const pg8::f32x4 (&acc)[2][2][4][2], const pg8::Unit& u, int wr, int wc, int fr, int fq) const {
        const int row0 = u.pm * 256 + wr * 64 + fr, col0 = u.pn * 256 + wc * 32 + 8 * fq;
#pragma unroll
        for (int ai = 0; ai < 2; ++ai)
#pragma unroll
            for (int m = 0; m < 4; ++m) {
                const int row = row0 + ai * 128 + m * 16;
                float s;
                if (MODE == 0) s = rs[row];
                else { const f32x4* p = (const f32x4*)(rs + (size_t)row * 16); const f32x4 a = p[0], b = p[1], c = p[2], d = p[3];
                       const float t = ((a.x + a.y) + (a.z + a.w)) + ((b.x + b.y) + (b.z + b.w)) + ((c.x + c.y) + (c.z + c.w)) + ((d.x + d.y) + (d.z + d.w));
                       s = rsqrtf(t * (1.f / 1024.f) + EPS); }
                bf16* rowp = O + (size_t)row * ldc + col0;
#pragma unroll
                for (int bj = 0; bj < 2; ++bj) { const pg8::f32x4 v0 = acc[ai][bj][m][0] * s, v1 = acc[ai][bj][m][1] * s;
                    u32x4 w; w.x = cvt_pk_bf16(v0[0], v0[1]); w.y = cvt_pk_bf16(v0[2], v0[3]); w.z = cvt_pk_bf16(v1[0], v1[1]); w.w = cvt_pk_bf16(v1[2], v1[3]);
                    *(u32x4*)(rowp + bj * 128) = w; }
            }
    }
};
struct EpiProj {
    static constexpr bool PERM = true, AFTER_DRAIN = false;
    bf16* O; const float* rs;
    __device__ __forceinline__ void operator()(const pg8::f32x4 (&acc)[2][2][4][2], const pg8::Unit& u, int wr, int wc, int fr, int fq) const {
        const int row0 = u.pm * 256 + wr * 64 + fr, cin = wc * 32 + 8 * fq, pn = u.pn;
#pragma unroll
        for (int ai = 0; ai < 2; ++ai)
#pragma unroll
            for (int m = 0; m < 4; ++m) {
                const int row = row0 + ai * 128 + m * 16; const float sc = rs[row];
                float a[8], b[8];
#pragma unroll
                for (int i = 0; i < 4; ++i) { a[i] = acc[ai][0][m][0][i] * sc; a[4 + i] = acc[ai][0][m][1][i] * sc; b[i] = acc[ai][1][m][0][i] * sc; b[4 + i] = acc[ai][1][m][1][i] * sc; }
                bf16* rowp = O + (size_t)row * PDIM;
                if (pn >= 4 && pn < 6) {
                    u32x4 w0, w1; w0.x = cvt_pk_bf16(a[0], a[1]); w0.y = cvt_pk_bf16(a[2], a[3]); w0.z = cvt_pk_bf16(a[4], a[5]); w0.w = cvt_pk_bf16(a[6], a[7]);
                    w1.x = cvt_pk_bf16(b[0], b[1]); w1.y = cvt_pk_bf16(b[2], b[3]); w1.z = cvt_pk_bf16(b[4], b[5]); w1.w = cvt_pk_bf16(b[6], b[7]);
                    *(u32x4*)(rowp + 512 + 256 * (pn - 4) + cin) = w0; *(u32x4*)(rowp + 512 + 256 * (pn - 4) + 128 + cin) = w1;
                } else {
                    float o[8];
                    if (pn < 4) {
#pragma unroll
                        for (int i = 0; i < 8; ++i) o[i] = a[i] * b[i];
                    } else {
#pragma unroll
                        for (int i = 0; i < 8; ++i) o[i] = a[i] * sigmoid_f(b[i]);
                    }
                    u32x4 w; w.x = cvt_pk_bf16(o[0], o[1]); w.y = cvt_pk_bf16(o[2], o[3]); w.z = cvt_pk_bf16(o[4], o[5]); w.w = cvt_pk_bf16(o[6], o[7]);
                    *(u32x4*)(rowp + (pn < 4 ? 128 * pn : 1024 + 128 * (pn - 6)) + cin) = w;
                }
            }
    }
};
struct EpiProjI8 {
    static constexpr bool PERM = true, AFTER_DRAIN = false;
    bf16* O; const float* rs; const float* sw;
    __device__ __forceinline__ void operator()(const pg8::i32x4 (&acc)[2][2][4][2], const pg8::Unit& u, int wr, int wc, int fr, int fq) const {
        const int row0 = u.pm * 256 + wr * 64 + fr, cin = wc * 32 + 8 * fq, pn = u.pn;
        float swa[8], swb[8];
        { const f32x4 a0 = *(const f32x4*)(sw + 256 * pn + cin), a1 = *(const f32x4*)(sw + 256 * pn + cin + 4), b0 = *(const f32x4*)(sw + 256 * pn + 128 + cin), b1 = *(const f32x4*)(sw + 256 * pn + 128 + cin + 4);
          swa[0] = a0.x; swa[1] = a0.y; swa[2] = a0.z; swa[3] = a0.w; swa[4] = a1.x; swa[5] = a1.y; swa[6] = a1.z; swa[7] = a1.w;
          swb[0] = b0.x; swb[1] = b0.y; swb[2] = b0.z; swb[3] = b0.w; swb[4] = b1.x; swb[5] = b1.y; swb[6] = b1.z; swb[7] = b1.w; }
#pragma unroll
        for (int ai = 0; ai < 2; ++ai)
#pragma unroll
            for (int m = 0; m < 4; ++m) {
                const int row = row0 + ai * 128 + m * 16; const float sc = rs[row];
                float a[8], b[8];
#pragma unroll
                for (int i = 0; i < 4; ++i) { a[i] = (float)acc[ai][0][m][0][i] * (sc * swa[i]); a[4 + i] = (float)acc[ai][0][m][1][i] * (sc * swa[4 + i]);
                    b[i] = (float)acc[ai][1][m][0][i] * (sc * swb[i]); b[4 + i] = (float)acc[ai][1][m][1][i] * (sc * swb[4 + i]); }
                bf16* rowp = O + (size_t)row * PDIM;
                if (pn >= 4 && pn < 6) {
                    u32x4 w0, w1; w0.x = cvt_pk_bf16(a[0], a[1]); w0.y = cvt_pk_bf16(a[2], a[3]); w0.z = cvt_pk_bf16(a[4], a[5]); w0.w = cvt_pk_bf16(a[6], a[7]);
                    w1.x = cvt_pk_bf16(b[0], b[1]); w1.y = cvt_pk_bf16(b[2], b[3]); w1.z = cvt_pk_bf16(b[4], b[5]); w1.w = cvt_pk_bf16(b[6], b[7]);
                    *(u32x4*)(rowp + 512 + 256 * (pn - 4) + cin) = w0; *(u32x4*)(rowp + 512 + 256 * (pn - 4) + 128 + cin) = w1;
                } else {
                    float o[8];
                    if (pn < 4) {
#pragma unroll
                        for (int i = 0; i < 8; ++i) o[i] = a[i] * b[i];
                    } else {
#pragma unroll
                        for (int i = 0; i < 8; ++i) o[i] = a[i] * sigmoid_f(b[i]);
                    }
                    u32x4 w; w.x = cvt_pk_bf16(o[0], o[1]); w.y = cvt_pk_bf16(o[2], o[3]); w.z = cvt_pk_bf16(o[4], o[5]); w.w = cvt_pk_bf16(o[6], o[7]);
                    *(u32x4*)(rowp + (pn < 4 ? 128 * pn : 1024 + 128 * (pn - 6)) + cin) = w;
                }
            }
    }
};
__host__ __device__ __forceinline__ int win_src_col(int n) {
    const int t = n >> 8, j = n & 255;
    if (t < 4) return (j < 128) ? 128 * t + j : 1024 + 128 * t + (j - 128);
    if (t < 6) return 512 + 256 * (t - 4) + j;
    return (j < 128) ? 1536 + 128 * (t - 6) + j : 2048 + 128 * (t - 6) + (j - 128);
}
struct EpiResidual {
    static constexpr bool PERM = true, AFTER_DRAIN = false;
    bf16* O; const signed char* XB; const float* SX; float* ssq;
    __device__ __forceinline__ void operator()(const pg8::f32x4 (&acc)[2][2][4][2], const pg8::Unit& u, int wr, int wc, int fr, int fq) const {
        const int row0 = u.pm * 256 + wr * 64 + fr, col0 = u.pn * 256 + wc * 32 + 8 * fq;
#pragma unroll
        for (int ai = 0; ai < 2; ++ai)
#pragma unroll
            for (int m = 0; m < 4; ++m) {
                const int row = row0 + ai * 128 + m * 16;
                const signed char* xr = XB + (size_t)row * DM + col0; bf16* rowp = O + (size_t)row * DM + col0;
                float q = 0.f;
                u32x2 xw[2]; const float sxr = SX[row];
#pragma unroll
                for (int bj = 0; bj < 2; ++bj) xw[bj] = *(const u32x2*)(xr + bj * 128);
#pragma unroll
                for (int bj = 0; bj < 2; ++bj) {
                    const f32x4 x0 = (f32x4){(float)(signed char)(xw[bj].x), (float)(signed char)(xw[bj].x >> 8), (float)(signed char)(xw[bj].x >> 16), (float)((int)xw[bj].x >> 24)} * sxr,
                                x1 = (f32x4){(float)(signed char)(xw[bj].y), (float)(signed char)(xw[bj].y >> 8), (float)(signed char)(xw[bj].y >> 16), (float)((int)xw[bj].y >> 24)} * sxr;
                    const pg8::f32x4 v0 = acc[ai][bj][m][0] + x0, v1 = acc[ai][bj][m][1] + x1;
                    q += (v0[0] * v0[0] + v0[1] * v0[1]) + (v0[2] * v0[2] + v0[3] * v0[3]) + (v1[0] * v1[0] + v1[1] * v1[1]) + (v1[2] * v1[2] + v1[3] * v1[3]);
                    u32x4 w; w.x = cvt_pk_bf16(v0[0], v0[1]); w.y = cvt_pk_bf16(v0[2], v0[3]); w.z = cvt_pk_bf16(v1[0], v1[1]); w.w = cvt_pk_bf16(v1[2], v1[3]);
                    *(u32x4*)(rowp + bj * 128) = w; }
                q += __shfl_xor(q, 16); q += __shfl_xor(q, 32);
                if (fq == 0) ssq[(size_t)row * 16 + u.pn * 4 + wc] = q;
            }
    }
};

struct EpiResidualI8 {
    static constexpr bool PERM = true, AFTER_DRAIN = false;
    bf16* O; const signed char* XB; const float* SX; const float* SY; const float* SWO; float* ssq;
    __device__ __forceinline__ void operator()(const pg8::i32x4 (&acc)[2][2][4][2], const pg8::Unit& u, int wr, int wc, int fr, int fq) const {
        const int row0 = u.pm * 256 + wr * 64 + fr, col0 = u.pn * 256 + wc * 32 + 8 * fq;
        f32x4 sw[2][2];
#pragma unroll
        for (int bj = 0; bj < 2; ++bj) { sw[bj][0] = *(const f32x4*)(SWO + col0 + bj * 128); sw[bj][1] = *(const f32x4*)(SWO + col0 + bj * 128 + 4); }
#pragma unroll
        for (int ai = 0; ai < 2; ++ai)
#pragma unroll
            for (int m = 0; m < 4; ++m) {
                const int row = row0 + ai * 128 + m * 16;
                const signed char* xr = XB + (size_t)row * DM + col0; bf16* rowp = O + (size_t)row * DM + col0;
                float q = 0.f;
                u32x2 xw[2]; const float sxr = SX[row], syr = SY[row];
#pragma unroll
                for (int bj = 0; bj < 2; ++bj) xw[bj] = *(const u32x2*)(xr + bj * 128);
#pragma unroll
                for (int bj = 0; bj < 2; ++bj) {
                    const f32x4 x0 = (f32x4){(float)(signed char)(xw[bj].x), (float)(signed char)(xw[bj].x >> 8), (float)(signed char)(xw[bj].x >> 16), (float)((int)xw[bj].x >> 24)} * sxr,
                                x1 = (f32x4){(float)(signed char)(xw[bj].y), (float)(signed char)(xw[bj].y >> 8), (float)(signed char)(xw[bj].y >> 16), (float)((int)xw[bj].y >> 24)} * sxr;
                    const pg8::i32x4 a0 = acc[ai][bj][m][0], a1 = acc[ai][bj][m][1];
                    const f32x4 v0 = (f32x4){(float)a0[0], (float)a0[1], (float)a0[2], (float)a0[3]} * (sw[bj][0] * syr) + x0, v1 = (f32x4){(float)a1[0], (float)a1[1], (float)a1[2], (float)a1[3]} * (sw[bj][1] * syr) + x1;
                    q += (v0[0] * v0[0] + v0[1] * v0[1]) + (v0[2] * v0[2] + v0[3] * v0[3]) + (v1[0] * v1[0] + v1[1] * v1[1]) + (v1[2] * v1[2] + v1[3] * v1[3]);
                    u32x4 w; w.x = cvt_pk_bf16(v0[0], v0[1]); w.y = cvt_pk_bf16(v0[2], v0[3]); w.z = cvt_pk_bf16(v1[0], v1[1]); w.w = cvt_pk_bf16(v1[2], v1[3]);
                    *(u32x4*)(rowp + bj * 128) = w; }
                q += __shfl_xor(q, 16); q += __shfl_xor(q, 32);
                if (fq == 0) ssq[(size_t)row * 16 + u.pn * 4 + wc] = q;
            }
    }
};
template <bool MAPIN> __device__ __forceinline__ void p0_transpose_item(const float* W, int K, int N, bf16* WT, LAS float* scr, int item, int lane,
                                                  const float* g_lo, const float* g_hi, int split) {
    const int nblk = N / 32, kb = item / nblk, nb = item % nblk, k0 = 64 * kb, n0 = 32 * nb;
#pragma unroll 8
    for (int i = 0; i < 32; ++i) { const int kk = 2 * i + (lane >> 5); const int k = k0 + kk;
        const float g = (k < split) ? g_lo[k] : g_hi[k - split];
        scr[kk * 33 + (lane & 31)] = W[(size_t)k * N + (MAPIN ? win_src_col(n0) : n0) + (lane & 31)] * g; }
    asm volatile("s_waitcnt lgkmcnt(0)" ::: "memory");
    const int c = lane & 7;
#pragma unroll
    for (int j = 0; j < 4; ++j) { const int n = (lane >> 3) + 8 * j; const LAS float* s = scr + (8 * c) * 33 + n;
        u32x4 o; o.x = pk2(s[0 * 33], s[1 * 33]); o.y = pk2(s[2 * 33], s[3 * 33]); o.z = pk2(s[4 * 33], s[5 * 33]); o.w = pk2(s[6 * 33], s[7 * 33]);
        *(u32x4*)(WT + (size_t)(n0 + n) * K + k0 + 8 * c) = o; }
    asm volatile("s_waitcnt lgkmcnt(0)" ::: "memory");
}

constexpr int CW_COLMAX = 5120;
__device__ __forceinline__ void p0_colmax_item(const float* W, int N, unsigned* colmax, int item, int lane, const float* g) {
    const int nblk = N / 32, kb = item / nblk, nb = item % nblk, k0 = 64 * kb, n0 = 32 * nb;
    float mx = 0.f;
#pragma unroll
    for (int i = 0; i < 32; ++i) { const int k = k0 + 2 * i + (lane >> 5); mx = fmaxf(mx, fabsf(W[(size_t)k * N + n0 + (lane & 31)] * g[k])); }
    mx = fmaxf(mx, __shfl_xor(mx, 32));
    if (lane < 32) atomicMax(colmax + n0 + lane, __float_as_uint(mx));
}
__device__ __forceinline__ void p1_quant_item(const float* W, int K, int N, signed char* WT8, float* swout, const unsigned* colmax, LAS float* scr, int item, int lane, const float* g) {
    const int nblk = N / 32, kb = item / nblk, nb = item % nblk, k0 = 64 * kb, n0 = 32 * nb, s0 = win_src_col(n0);
    const float cm = fmaxf(__uint_as_float(colmax[s0 + (lane & 31)]), 1e-30f), inv = 127.f / cm;
    if (kb == 0 && lane < 32) swout[n0 + lane] = cm * (1.f / 127.f);
#pragma unroll
    for (int i = 0; i < 32; ++i) { const int kk = 2 * i + (lane >> 5); const int k = k0 + kk;
        scr[kk * 33 + (lane & 31)] = W[(size_t)k * N + s0 + (lane & 31)] * g[k] * inv; }
    asm volatile("s_waitcnt lgkmcnt(0)" ::: "memory");
    const int c = lane & 7;
#pragma unroll
    for (int j = 0; j < 4; ++j) { const int n = (lane >> 3) + 8 * j; const LAS float* sp = scr + (8 * c) * 33 + n;
        unsigned w0 = 0u, w1 = 0u;
#pragma unroll
        for (int i = 0; i < 4; ++i) { w0 |= ((unsigned)(int)rintf(sp[i * 33]) & 255u) << (8 * i); w1 |= ((unsigned)(int)rintf(sp[(4 + i) * 33]) & 255u) << (8 * i); }
        u32x2 o; o.x = w0; o.y = w1;
        *(u32x2*)(WT8 + (size_t)(n0 + n) * K + k0 + 8 * c) = o; }
    asm volatile("s_waitcnt lgkmcnt(0)" ::: "memory");
}
constexpr int CW_COLMAX2 = 7680;
__device__ __forceinline__ void p0_colmax_item2(const float* W, int N, unsigned* colmax, int item, int lane, const float* g_lo, const float* g_hi, int split) {
    const int nblk = N / 32, kb = item / nblk, nb = item % nblk, k0 = 64 * kb, n0 = 32 * nb;
    float mx = 0.f;
#pragma unroll
    for (int i = 0; i < 32; ++i) { const int k = k0 + 2 * i + (lane >> 5); const float g = (k < split) ? g_lo[k] : g_hi[k - split]; mx = fmaxf(mx, fabsf(W[(size_t)k * N + n0 + (lane & 31)] * g)); }
    mx = fmaxf(mx, __shfl_xor(mx, 32));
    if (lane < 32) atomicMax(colmax + n0 + lane, __float_as_uint(mx));
}
__device__ __forceinline__ void p1_quant_item2(const float* W, int K, int N, signed char* WT8, float* swout, const unsigned* colmax, LAS float* scr, int item, int lane, const float* g_lo, const float* g_hi, int split) {
    const int nblk = N / 32, kb = item / nblk, nb = item % nblk, k0 = 64 * kb, n0 = 32 * nb;
    const float cm = fmaxf(__uint_as_float(colmax[n0 + (lane & 31)]), 1e-30f), inv = 127.f / cm;
    if (kb == 0 && lane < 32) swout[n0 + lane] = cm * (1.f / 127.f);
#pragma unroll
    for (int i = 0; i < 32; ++i) { const int kk = 2 * i + (lane >> 5); const int k = k0 + kk; const float g = (k < split) ? g_lo[k] : g_hi[k - split];
        scr[kk * 33 + (lane & 31)] = W[(size_t)k * N + n0 + (lane & 31)] * g * inv; }
    asm volatile("s_waitcnt lgkmcnt(0)" ::: "memory");
    const int c = lane & 7;
#pragma unroll
    for (int j = 0; j < 4; ++j) { const int n = (lane >> 3) + 8 * j; const LAS float* sp = scr + (8 * c) * 33 + n;
        unsigned w0 = 0u, w1 = 0u;
#pragma unroll
        for (int i = 0; i < 4; ++i) { w0 |= ((unsigned)(int)rintf(sp[i * 33]) & 255u) << (8 * i); w1 |= ((unsigned)(int)rintf(sp[(4 + i) * 33]) & 255u) << (8 * i); }
        u32x2 o; o.x = w0; o.y = w1;
        *(u32x2*)(WT8 + (size_t)(n0 + n) * K + k0 + 8 * c) = o; }
    asm volatile("s_waitcnt lgkmcnt(0)" ::: "memory");
}
__device__ __forceinline__ void phase_winq(const Params& P, LAS unsigned char* lds) {
    const int tid = threadIdx.x, lane = tid & 63, wave = __builtin_amdgcn_readfirstlane(tid >> 6);
    const int gw = blockIdx.x * NWAVES + wave, NGW = gridDim.x * NWAVES;
    LAS float* scr = (LAS float*)(lds + wave * 16384);
    constexpr int NI1 = (DM / 64) * (DIN / 32), NI2 = (DM / 64) * (DM / 32);
    for (int it = gw; it < NI1 + NI2; it += NGW) {
        if (it < NI1) p1_quant_item(P.w_in, DM, DIN, (signed char*)(P.ws + WS_WIN_T), (float*)(P.ws + WS_SW), (const unsigned*)(P.ws + WS_CTL) + CW_COLMAX, scr, it, lane, P.g_mix);
        else p1_quant_item2(P.w_out, DM, DM, (signed char*)(P.ws + WS_WOUT_T), (float*)(P.ws + WS_SWO), (const unsigned*)(P.ws + WS_CTL) + CW_COLMAX2, scr, it - NI1, lane, P.g_sc, P.g_cf, 512);
    }
}
__device__ __forceinline__ float q4(float x, float inv_s) {
    const float a = fabsf(x) * inv_s; float r;
    if (a < 2.f) r = rintf(a * 2.f) * 0.5f; else if (a < 4.f) r = rintf(a); else r = fminf(6.f, rintf(a * 0.5f) * 2.f);
    return copysignf(r, x);
}
__device__ __forceinline__ void phase_prep(const Params& P, LAS unsigned char* lds) {
    const int tid = threadIdx.x, lane = tid & 63, wave = __builtin_amdgcn_readfirstlane(tid >> 6);
    const int gw = blockIdx.x * NWAVES + wave, NGW = gridDim.x * NWAVES;
    unsigned char* ws = P.ws;
    LAS float* scr = (LAS float*)(lds + wave * 16384);
    constexpr int I_IN = (DM / 64) * (DIN / 32), I_OUT = (DM / 64) * (DM / 32), I_Q = (DM / 64) * (2048 / 32);
    for (int it = gw; it < I_IN + I_OUT + I_Q; it += NGW) {
        int r = it;
        if (r < I_IN) { p0_colmax_item(P.w_in, DIN, (unsigned*)(ws + WS_CTL) + CW_COLMAX, r, lane, P.g_mix); continue; } r -= I_IN;
        if (r < I_OUT) { p0_colmax_item2(P.w_out, DM, (unsigned*)(ws + WS_CTL) + CW_COLMAX2, r, lane, P.g_sc, P.g_cf, 512); continue; } r -= I_OUT;
        p0_transpose_item<false>(P.w_q, DM, 2048, (bf16*)(ws + WS_WQ_T), scr, r, lane, P.g_ffn, P.g_ffn, DM);
    }
    {
        unsigned* H0I8 = (unsigned*)(ws + WS_H0I8); float* RS1 = (float*)(ws + WS_RSTD1); float* SXp = (float*)(ws + WS_SX);
        for (int t0 = gw * 4; t0 < NTOK; t0 += NGW * 4) {
            f32x4 v[4][4];
#pragma unroll
            for (int q = 0; q < 4; ++q) { const f32x4* xr = (const f32x4*)(P.x + (size_t)(t0 + q) * DM) + lane;
#pragma unroll
                for (int j = 0; j < 4; ++j) v[q][j] = xr[64 * j]; }
#pragma unroll
            for (int q = 0; q < 4; ++q) { float sq = 0.f, mx = 0.f;
#pragma unroll
                for (int j = 0; j < 4; ++j) { sq += (v[q][j].x * v[q][j].x + v[q][j].y * v[q][j].y) + (v[q][j].z * v[q][j].z + v[q][j].w * v[q][j].w);
                    mx = fmaxf(mx, fmaxf(fmaxf(fabsf(v[q][j].x), fabsf(v[q][j].y)), fmaxf(fabsf(v[q][j].z), fabsf(v[q][j].w)))); }
                sq = wave_sum_fast(sq); mx = fmaxf(wave_max_fast(mx), 1e-30f);
                const float sx = mx * (1.f / 127.f), inv = 127.f / mx;
                if (lane == 0) { RS1[t0 + q] = sx * rsqrtf(sq * (1.f / DM) + EPS); SXp[t0 + q] = sx; }
                unsigned* o = H0I8 + (size_t)(t0 + q) * (DM / 4) + lane;
#pragma unroll
                for (int j = 0; j < 4; ++j) { const int a = (int)rintf(v[q][j].x * inv), b = (int)rintf(v[q][j].y * inv), c = (int)rintf(v[q][j].z * inv), d = (int)rintf(v[q][j].w * inv);
                    o[64 * j] = ((unsigned)a & 255u) | (((unsigned)b & 255u) << 8) | (((unsigned)c & 255u) << 16) | ((unsigned)d << 24); } }
        }
    }
    {
        unsigned char* U8 = ws + WS_U8; unsigned char* V8 = ws + WS_V8;
        f32x4 gf[4];
#pragma unroll
        for (int j = 0; j < 4; ++j) gf[j] = ((const f32x4*)P.g_ffn)[64 * j + lane];
        float* ESC = (float*)(ws + WS_ESCALE);
        for (int e0 = gw * 2; e0 < 2 * 16384; e0 += NGW * 2) {
            const bool isv = e0 >= 16384; const int ee0 = isv ? e0 - 16384 : e0;
            f32x4 v[2][4];
#pragma unroll
            for (int q = 0; q < 2; ++q) { const f32x4* src = (const f32x4*)((isv ? P.pv : P.pu) + (size_t)(ee0 + q) * DM) + lane;
#pragma unroll
                for (int j = 0; j < 4; ++j) v[q][j] = src[64 * j]; }
#pragma unroll
            for (int q = 0; q < 2; ++q) {
                float mx = 0.f;
#pragma unroll
                for (int j = 0; j < 4; ++j) { if (!isv) v[q][j] = v[q][j] * gf[j];
                    mx = fmaxf(mx, fmaxf(fmaxf(fabsf(v[q][j].x), fabsf(v[q][j].y)), fmaxf(fabsf(v[q][j].z), fabsf(v[q][j].w)))); }
#pragma unroll
                for (int o = 1; o < 64; o <<= 1) mx = fmaxf(mx, __shfl_xor(mx, o));
                if (!isv) {
                    float sq2 = 0.f;
#pragma unroll
                    for (int j = 0; j < 4; ++j) sq2 += (v[q][j].x * v[q][j].x + v[q][j].y * v[q][j].y) + (v[q][j].z * v[q][j].z + v[q][j].w * v[q][j].w);
                    const float rms = sqrtf(wave_sum_fast(sq2) * (1.f / DM));
                    const float su = fmaxf(fminf(mx, U4_CLIP * rms), 1e-30f) * (1.f / 7.f), inv = 1.f / su;
                    unsigned wq[2] = {0u, 0u}; int csum = 0;
#pragma unroll
                    for (int j = 0; j < 4; ++j) { const float e4[4] = {v[q][j].x, v[q][j].y, v[q][j].z, v[q][j].w};
#pragma unroll
                        for (int i = 0; i < 4; ++i) { int c = (int)rintf(fminf(fmaxf(e4[i] * inv, -7.f), 7.f)); csum += c;
                            wq[j >> 1] |= ((unsigned)c & 15u) << (16 * (j & 1) + 4 * i); } }
                    const float cs = wave_sum_fast((float)csum);
                    if (lane == 0) { ESC[e0 + q] = su; ((float*)(ws + WS_SUMQ))[e0 + q] = cs; }
                    u32x2 o; o.x = wq[0]; o.y = wq[1];
                    *(u32x2*)(U8 + (size_t)(ee0 + q) * 512 + 8 * lane) = o;
                    continue;
                }
                const float sc = fmaxf(mx, 1e-30f) * (1.f / 6.f), inv = 1.f / sc;
                if (lane == 0) ESC[e0 + q] = sc;
                unsigned w0 = 0u, w1 = 0u;
                w0 = __builtin_amdgcn_cvt_scalef32_pk_fp4_f32(w0, v[q][0].x * inv, v[q][0].y * inv, 1.0f, 0); w0 = __builtin_amdgcn_cvt_scalef32_pk_fp4_f32(w0, v[q][0].z * inv, v[q][0].w * inv, 1.0f, 1);
                w0 = __builtin_amdgcn_cvt_scalef32_pk_fp4_f32(w0, v[q][1].x * inv, v[q][1].y * inv, 1.0f, 2); w0 = __builtin_amdgcn_cvt_scalef32_pk_fp4_f32(w0, v[q][1].z * inv, v[q][1].w * inv, 1.0f, 3);
                w1 = __builtin_amdgcn_cvt_scalef32_pk_fp4_f32(w1, v[q][2].x * inv, v[q][2].y * inv, 1.0f, 0); w1 = __builtin_amdgcn_cvt_scalef32_pk_fp4_f32(w1, v[q][2].z * inv, v[q][2].w * inv, 1.0f, 1);
                w1 = __builtin_amdgcn_cvt_scalef32_pk_fp4_f32(w1, v[q][3].x * inv, v[q][3].y * inv, 1.0f, 2); w1 = __builtin_amdgcn_cvt_scalef32_pk_fp4_f32(w1, v[q][3].z * inv, v[q][3].w * inv, 1.0f, 3);
                u32x2 o; o.x = w0; o.y = w1;
                *(u32x2*)((isv ? V8 : U8) + (size_t)(ee0 + q) * 512 + 8 * lane) = o;
            }
        }
    }
    {
        bf16* KB = (bf16*)(ws + WS_KEYS);
        const int gt = blockIdx.x * NTHREADS + tid, NGT = gridDim.x * NTHREADS;
        for (int i = gt; i < 8 * 2 * 128 * 128 / 4; i += NGT) { const f32x4 v = ((const f32x4*)P.keys)[i]; u32x2 w; w.x = pk2(v.x, v.y); w.y = pk2(v.z, v.w); ((u32x2*)KB)[i] = w; }
    }
    {
        float* MP = (float*)(ws + WS_METAPART); float* MR = (float*)(ws + WS_METARSTD);
        for (int r = gw; r < NMETA; r += NGW) {
            float s = 0.f;
            for (int k = lane; k < DM; k += 64) { const float v = P.meta[r * DM + k]; s += v * v; }
            s = wave_sum(s);
            if (lane == 0) MR[r] = rsqrtf(s * (1.f / DM) + EPS);
        }
        for (int it = gw; it < MKC * 40; it += NGW) {
            const int kc = it / 40, nb = it % 40, n = nb * 64 + lane;
            float acc[NMETA];
#pragma unroll
            for (int r = 0; r < NMETA; ++r) acc[r] = 0.f;
            for (int k = kc * (DM / MKC); k < (kc + 1) * (DM / MKC); ++k) {
                const float w = P.w_in[(size_t)k * DIN + n] * P.g_mix[k];
#pragma unroll
                for (int r = 0; r < NMETA; ++r) acc[r] += P.meta[r * DM + k] * w;
            }
#pragma unroll
            for (int r = 0; r < NMETA; ++r) MP[(size_t)(kc * 16 + r) * DIN + n] = acc[r];
        }
    }
}

__device__ __forceinline__ float metaraw(const float* MP, const float* MR, int p, int col) { float s = 0.f;
#pragma unroll 8
    for (int kc = 0; kc < MKC; ++kc) s += MP[(size_t)(kc * 16 + p) * DIN + col];
    return s * MR[p]; }
__device__ __forceinline__ void phase_metaproj(const Params& P) {
    const float* MP = (const float*)(P.ws + WS_METAPART); const float* MR = (const float*)(P.ws + WS_METARSTD); float* MJ = (float*)(P.ws + WS_METAPROJ);
    for (int gt = blockIdx.x * NTHREADS + threadIdx.x; gt < NMETA * PDIM; gt += gridDim.x * NTHREADS) { const int p = gt / PDIM, c = gt % PDIM; float v;
        if (c < 512) v = metaraw(MP, MR, p, c) * metaraw(MP, MR, p, 1024 + c);
        else if (c < 1024) v = metaraw(MP, MR, p, c);
        else v = metaraw(MP, MR, p, 1536 + (c - 1024)) * sigmoid_f(metaraw(MP, MR, p, 2048 + (c - 1024)));
        MJ[gt] = v; }
}
__device__ __forceinline__ float meta_val(const float* MJ, const float*, int p, int col) { return MJ[p * PDIM + col]; }
__device__ __forceinline__ float proj_at(const bf16* PROJ, const float* MP, const float* MR, int b, int pos, int col) {
    if (pos < 0) return 0.f;
    if (pos < NMETA) return meta_val(MP, MR, pos, col);
    return bf2f(PROJ[(size_t)(b * SEQ + pos - NMETA) * PDIM + col]);
}
__device__ __forceinline__ void proj8_at(const bf16* PROJ, const float* MP, const float* MR, int b, int pos, int col, float (&v)[8]) {
    if (pos < 0) {
#pragma unroll
        for (int i = 0; i < 8; ++i) v[i] = 0.f;
    } else if (pos < NMETA) {
        const f32x4 a = *(const f32x4*)(MP + pos * PDIM + col), bq = *(const f32x4*)(MP + pos * PDIM + col + 4);
        v[0] = a.x; v[1] = a.y; v[2] = a.z; v[3] = a.w; v[4] = bq.x; v[5] = bq.y; v[6] = bq.z; v[7] = bq.w;
    } else {
        const u32x4 w = *(const u32x4*)(PROJ + (size_t)(b * SEQ + pos - NMETA) * PDIM + col);
        v[0] = bflo(w.x); v[1] = bfhi(w.x); v[2] = bflo(w.y); v[3] = bfhi(w.y); v[4] = bflo(w.z); v[5] = bfhi(w.z); v[6] = bflo(w.w); v[7] = bfhi(w.w);
    }
}

template <int R> __device__ __forceinline__ void conv_rows(const LAS unsigned char* ubase, const f32x2 (&wcf)[31], f32x2 (&acc)[32]) {
    if constexpr (R < 62) {
        const unsigned uw = *(const LAS unsigned*)(ubase + R * 1024);
        const f32x2 x = (f32x2){bflo(uw), bfhi(uw)};
        constexpr int lo = R > 30 ? R - 30 : 0, hi = R < 31 ? R : 31;
#pragma unroll
        for (int ii = lo; ii <= hi; ++ii) acc[ii] += wcf[R - ii] * x;
        conv_rows<R + 1>(ubase, wcf, acc);
    }
}
__device__ __forceinline__ void phase_conv(const Params& P, LAS unsigned char* lds) {
    const int tid = threadIdx.x, lane = tid & 63, wave = __builtin_amdgcn_readfirstlane(tid >> 6);
    unsigned char* ws = P.ws;
    const bf16* PROJ = (const bf16*)(ws + WS_PROJ); const float* MP = (const float*)(ws + WS_METAPROJ); const float* MR = nullptr;
    bf16* Y = (bf16*)(ws + WS_Y);
    constexpr int TT = 64, NTILE = NTOK / TT, UROWS = TT + 30;
    const int cgp = wave & 3, th = wave >> 2, ch2 = cgp * 128 + 2 * lane;
    f32x2 wcf[31];
#pragma unroll
    for (int j = 0; j < 31; ++j) wcf[j] = *(const f32x2*)(P.cf_w + j * 512 + ch2);
    const f32x2 bcf = *(const f32x2*)(P.cf_b + ch2);
    for (int tile = blockIdx.x; tile < NTILE; tile += gridDim.x) {
        const int b = tile / (SEQ / TT), s0 = (tile % (SEQ / TT)) * TT;
#pragma unroll 4
        for (int p = 0; p < (UROWS + 7) / 8; ++p) {
            const int r = p * 8 + wave;
            if (r < UROWS) {
                const int pos = NMETA + s0 - 30 + r;
                float uu[8];
                proj8_at(PROJ, MP, MR, b, pos, 1024 + 8 * lane, uu);
                u32x4 w; w.x = pk2(uu[0], uu[1]); w.y = pk2(uu[2], uu[3]); w.z = pk2(uu[4], uu[5]); w.w = pk2(uu[6], uu[7]);
                *(LAS u32x4*)(lds + r * 1024 + lane * 16) = w;
            }
        }
        __syncthreads();
        f32x2 acc[32];
#pragma unroll
        for (int ii = 0; ii < 32; ++ii) acc[ii] = bcf;
        conv_rows<0>(lds + (32 * th) * 1024 + ch2 * 2, wcf, acc);
        __syncthreads();
#pragma unroll
        for (int ii = 0; ii < 32; ++ii) *(LAS f32x2*)(lds + (32 * th + ii) * 2048 + ch2 * 4) = acc[ii];
        __syncthreads();
        {
            float lng[8], lnb[8];
            { const f32x4 a = *(const f32x4*)(P.ln_g + 8 * lane), c = *(const f32x4*)(P.ln_g + 8 * lane + 4), d = *(const f32x4*)(P.ln_b + 8 * lane), e = *(const f32x4*)(P.ln_b + 8 * lane + 4);
              lng[0] = a.x; lng[1] = a.y; lng[2] = a.z; lng[3] = a.w; lng[4] = c.x; lng[5] = c.y; lng[6] = c.z; lng[7] = c.w;
              lnb[0] = d.x; lnb[1] = d.y; lnb[2] = d.z; lnb[3] = d.w; lnb[4] = e.x; lnb[5] = e.y; lnb[6] = e.z; lnb[7] = e.w; }
            float wsc[3][8];
#pragma unroll
            for (int j = 0; j < 3; ++j) { const f32x4 a = *(const f32x4*)(P.sc_w + j * 512 + 8 * lane), c = *(const f32x4*)(P.sc_w + j * 512 + 8 * lane + 4);
                wsc[j][0] = a.x; wsc[j][1] = a.y; wsc[j][2] = a.z; wsc[j][3] = a.w; wsc[j][4] = c.x; wsc[j][5] = c.y; wsc[j][6] = c.z; wsc[j][7] = c.w; }
            float cxa[8], cxb[8];
            { const int pos = NMETA + s0 + 8 * wave - 2;
              proj8_at(PROJ, MP, MR, b, pos, 8 * lane, cxa); proj8_at(PROJ, MP, MR, b, pos + 1, 8 * lane, cxb); }
#pragma unroll 2
            for (int q = 0; q < 8; ++q) {
                const int ii = 8 * wave + q, s = s0 + ii; const size_t t = (size_t)b * SEQ + s;
                float o[8];
                { const f32x4 a = *(const LAS f32x4*)(lds + ii * 2048 + lane * 32), c = *(const LAS f32x4*)(lds + ii * 2048 + lane * 32 + 16);
                  o[0] = a.x; o[1] = a.y; o[2] = a.z; o[3] = a.w; o[4] = c.x; o[5] = c.y; o[6] = c.z; o[7] = c.w; }
                float s1 = 0.f;
#pragma unroll
                for (int i = 0; i < 8; ++i) s1 += o[i];
                const float mean = wave_sum_fast(s1) * (1.f / 512.f);
                float s2 = 0.f;
#pragma unroll
                for (int i = 0; i < 8; ++i) { o[i] -= mean; s2 += o[i] * o[i]; }
                const float rs = rsqrtf(wave_sum_fast(s2) * (1.f / 512.f) + EPS);
                float s3 = 0.f;
#pragma unroll
                for (int i = 0; i < 8; ++i) { float y = o[i] * rs * lng[i] + lnb[i]; y = y * sigmoid_f(y); o[i] = y; s3 += y * y; }
                const float r2 = rsqrtf(wave_sum_fast(s3) * (1.f / 512.f) + EPS);
                float bgv[8], cxc[8], accs[8];
                proj8_at(PROJ, MP, MR, b, NMETA + s, 8 * lane, cxc); proj8_at(PROJ, MP, MR, b, NMETA + s, 512 + 8 * lane, bgv);
                float s4 = 0.f;
#pragma unroll
                for (int i = 0; i < 8; ++i) { accs[i] = bgv[i] * (wsc[0][i] * cxa[i] + wsc[1][i] * cxb[i] + wsc[2][i] * cxc[i]); s4 += accs[i] * accs[i]; cxa[i] = cxb[i]; cxb[i] = cxc[i]; }
                const float r4 = rsqrtf(wave_sum_fast(s4) * (1.f / 512.f) + EPS);
                float ym = 0.f;
#pragma unroll
                for (int i = 0; i < 8; ++i) { o[i] *= r2; accs[i] *= r4; ym = fmaxf(ym, fmaxf(fabsf(o[i]), fabsf(accs[i]))); }
                ym = fmaxf(wave_max_fast(ym), 1e-30f);
                const float yinv = 127.f / ym;
                if (lane == 0) ((float*)(ws + WS_SY))[t] = ym * (1.f / 127.f);
                u32x2 wz, wv;
                wz.x = ((unsigned)(int)rintf(accs[0] * yinv) & 255u) | (((unsigned)(int)rintf(accs[1] * yinv) & 255u) << 8) | (((unsigned)(int)rintf(accs[2] * yinv) & 255u) << 16) | ((unsigned)(int)rintf(accs[3] * yinv) << 24);
                wz.y = ((unsigned)(int)rintf(accs[4] * yinv) & 255u) | (((unsigned)(int)rintf(accs[5] * yinv) & 255u) << 8) | (((unsigned)(int)rintf(accs[6] * yinv) & 255u) << 16) | ((unsigned)(int)rintf(accs[7] * yinv) << 24);
                wv.x = ((unsigned)(int)rintf(o[0] * yinv) & 255u) | (((unsigned)(int)rintf(o[1] * yinv) & 255u) << 8) | (((unsigned)(int)rintf(o[2] * yinv) & 255u) << 16) | ((unsigned)(int)rintf(o[3] * yinv) << 24);
                wv.y = ((unsigned)(int)rintf(o[4] * yinv) & 255u) | (((unsigned)(int)rintf(o[5] * yinv) & 255u) << 8) | (((unsigned)(int)rintf(o[6] * yinv) & 255u) << 16) | ((unsigned)(int)rintf(o[7] * yinv) << 24);
                *(u32x2*)(ws + WS_Y + t * DM + 8 * lane) = wz;
                *(u32x2*)(ws + WS_Y + t * DM + 512 + 8 * lane) = wv;
            }
        }
        __syncthreads();
    }
}

__device__ __forceinline__ int ord_i(float s) { int k = __builtin_bit_cast(int, s); k ^= (k >> 31) & 0x7fffffff; return k; }
__device__ __forceinline__ float unord_f(int k) { k ^= (k >> 31) & 0x7fffffff; return __builtin_bit_cast(float, k); }
#define TOP_INSERT(L, x_) do { int _x = (x_); _Pragma("unroll") for (int _i = 0; _i < 16; ++_i) { const int _hi = max(L[_i], _x); _x = min(L[_i], _x); L[_i] = _hi; } } while (0)

typedef short bf16x8 __attribute__((ext_vector_type(8)));
typedef float f32x16 __attribute__((ext_vector_type(16)));
template <bool DESC> __device__ __forceinline__ void ce_i(int& a, int& b) { const int hi = max(a, b), lo = min(a, b); if (DESC) { a = hi; b = lo; } else { a = lo; b = hi; } }
__device__ __forceinline__ void bitonic_sort16(int (&a)[16]) {
#pragma unroll
    for (int k = 2; k <= 16; k <<= 1)
#pragma unroll
        for (int j = k >> 1; j > 0; j >>= 1)
#pragma unroll
            for (int i = 0; i < 16; ++i) { const int l = i ^ j; if (l > i) { if ((i & k) == 0) ce_i<true>(a[i], a[l]); else ce_i<false>(a[i], a[l]); } }
}
__device__ __forceinline__ void bitonic_merge16(int (&a)[16]) {
#pragma unroll
    for (int j = 8; j > 0; j >>= 1)
#pragma unroll
        for (int i = 0; i < 16; ++i) { const int l = i ^ j; if (l > i) ce_i<true>(a[i], a[l]); }
}
__device__ __forceinline__ void merge_top16(int (&a)[16], const int (&b)[16]) {
#pragma unroll
    for (int i = 0; i < 16; ++i) a[i] = max(a[i], b[15 - i]);
    bitonic_merge16(a);
}
__device__ __forceinline__ int lut16(const unsigned (&T)[4], int i) {
    const unsigned sel = (unsigned)(i & 7) | 0x0c0c0c00u;
    const unsigned lo = __builtin_amdgcn_perm(T[1], T[0], sel), hi = __builtin_amdgcn_perm(T[3], T[2], sel);
    return (int)((i & 8) ? hi : lo);
}
constexpr int KROW = 272;
constexpr float SCORE_BIAS = 8.0f;

__device__ __forceinline__ void route_load_q(bf16x8 (&qf)[8], const bf16* qrow, int hb) {
#pragma unroll
    for (int ks = 0; ks < 8; ++ks) qf[ks] = *(const bf16x8*)(qrow + 64 * hb + 8 * ks);
}
__device__ __forceinline__ void route_half(const LAS unsigned char* kl, const bf16x8 (&qf)[8], int nl, int hb, int (&L)[16]) {
    f32x16 acc[4];
#pragma unroll
    for (int nt = 0; nt < 4; ++nt)
#pragma unroll
        for (int r = 0; r < 16; ++r) acc[nt][r] = SCORE_BIAS;
#pragma unroll
    for (int ks = 0; ks < 8; ++ks)
#pragma unroll
        for (int nt = 0; nt < 4; ++nt) {
            const bf16x8 a = *(const LAS bf16x8*)(kl + (32 * nt + nl) * KROW + (64 * hb + 8 * ks) * 2);
            acc[nt] = __builtin_amdgcn_mfma_f32_32x32x16_bf16(a, qf[ks], acc[nt], 0, 0, 0);
        }
    const int hb4 = 4 * hb;
    int T[4][16];
#pragma unroll
    for (int nt = 0; nt < 4; ++nt)
#pragma unroll
        for (int r = 0; r < 16; ++r) { const int n0 = 32 * nt + (r & 3) + 8 * (r >> 2); const float sc = acc[nt][r];
            T[nt][r] = (__float_as_int(sc) & ~127) | ((127 - n0) - hb4); }
    bitonic_sort16(T[0]); bitonic_sort16(T[1]); bitonic_sort16(T[2]); bitonic_sort16(T[3]);
    merge_top16(T[0], T[1]); merge_top16(T[2], T[3]); merge_top16(T[0], T[2]);
#pragma unroll
    for (int i = 0; i < 16; ++i) { const unsigned v = (unsigned)T[0][15 - i]; auto r = __builtin_amdgcn_permlane32_swap(v, v, false, false);
        const unsigned r0 = r[0], r1 = r[1]; const int partner = (int)(hb ? r0 : r1); L[i] = max(T[0][i], partner); }
    bitonic_merge16(L);
}

__device__ __forceinline__ void phase_route(const Params& P, LAS unsigned char* lds) {
    const int tid = threadIdx.x, lane = tid & 63, wave = __builtin_amdgcn_readfirstlane(tid >> 6);
    const int nl = lane & 31, hb = lane >> 5;
    unsigned char* ws = P.ws;
    const bf16* KEYS = (const bf16*)(ws + WS_KEYS); const bf16* Q = (const bf16*)(ws + WS_Q);
    int* IDX = (int*)(ws + WS_IDX); float* GATE = (float*)(ws + WS_GATE);
    int last_h = -1;
    pg8::StaticOrder S; S.init(NTOK, 2048, (int)gridDim.x, (int)blockIdx.x);
    pg8::Unit ucur, unxt;
    bool have = S.next(0, ucur);
    bf16x8 qfA[8], qfB[8];
    if (have) route_load_q(qfA, Q + ((size_t)ucur.pm * 256 + wave * 32 + nl) * 2048 + ucur.pn * 256, hb);
    for (int ui = 0; have; ++ui) {
        const int h = ucur.pn, tb = ucur.pm;
        const bool have_next = S.next(ui + 1, unxt);
        if (h != last_h) {
            __syncthreads();
            for (int c = tid; c < 4096; c += NTHREADS) { const u32x4 v = ((const u32x4*)(KEYS + (size_t)h * 32768))[c];
                *(LAS u32x4*)(lds + (c >> 4) * KROW + (c & 15) * 16) = v; }
            __syncthreads();
            last_h = h;
        }
        const size_t t = (size_t)tb * 256 + wave * 32 + nl;
        int L1[16], L2[16];
        route_load_q(qfB, Q + t * 2048 + h * 256 + 128, hb);
        route_half(lds, qfA, nl, hb, L1);
        if (have_next) route_load_q(qfA, Q + ((size_t)unxt.pm * 256 + wave * 32 + nl) * 2048 + unxt.pn * 256, hb);
        route_half(lds + 128 * KROW, qfB, nl, hb, L2);
        float v1[16], v2[16];
#pragma unroll
        for (int i = 0; i < 16; ++i) { v1[i] = __int_as_float(L1[i] & ~127); v2[i] = __int_as_float(L2[i] & ~127); }
#define CAND(i, j) ((__float_as_int(v1[i] + v2[j]) & ~255) | (255 - (16 * (i) + (j))))
        int A[16], B[16], C[16];
#pragma unroll
        for (int j = 0; j < 16; ++j) A[j] = CAND(0, j);
#pragma unroll
        for (int j = 0; j < 8; ++j) { B[j] = CAND(1, j); B[8 + j] = CAND(15 - j, 0); }
        bitonic_merge16(B);
        C[0] = CAND(2, 0); C[1] = CAND(2, 1); C[2] = CAND(2, 2); C[3] = CAND(2, 3); C[4] = CAND(2, 4);
        C[5] = CAND(3, 0); C[6] = CAND(3, 1); C[7] = CAND(3, 2); C[8] = CAND(3, 3);
        C[9] = CAND(4, 0); C[10] = CAND(4, 1); C[11] = CAND(4, 2);
        C[12] = CAND(5, 0); C[13] = CAND(5, 1); C[14] = CAND(6, 0); C[15] = CAND(6, 1);
        bitonic_sort16(C);
        { const int d0 = CAND(7, 0), d1 = CAND(7, 1); C[14] = max(C[14], d1); C[15] = max(C[15], d0); bitonic_merge16(C); }
#undef CAND
        merge_top16(A, B); merge_top16(A, C);
        unsigned T1[4], T2[4];
#pragma unroll
        for (int q = 0; q < 4; ++q) {
            T1[q] = (unsigned)(127 - (L1[4 * q] & 127)) | ((unsigned)(127 - (L1[4 * q + 1] & 127)) << 8) | ((unsigned)(127 - (L1[4 * q + 2] & 127)) << 16) | ((unsigned)(127 - (L1[4 * q + 3] & 127)) << 24);
            T2[q] = (unsigned)(127 - (L2[4 * q] & 127)) | ((unsigned)(127 - (L2[4 * q + 1] & 127)) << 8) | ((unsigned)(127 - (L2[4 * q + 2] & 127)) << 16) | ((unsigned)(127 - (L2[4 * q + 3] & 127)) << 24); }
        float val[16]; int ex[16];
#pragma unroll
        for (int k = 0; k < 16; ++k) { const int pos = 255 - (A[k] & 255); val[k] = __int_as_float(A[k] & ~255);
            ex[k] = lut16(T1, pos >> 4) * NKEYS + lut16(T2, pos & 15); }
        float sum = 0.f; const float vmax = val[0];
#pragma unroll
        for (int k = 0; k < 16; ++k) { val[k] = __expf(val[k] - vmax); sum += val[k]; }
        const float inv = 1.f / sum;
        if (hb == 0) {
            int* ip = IDX + t * NSEL + h * TOPK; float* gp = GATE + t * NSEL + h * TOPK;
#pragma unroll
            for (int k4 = 0; k4 < 4; ++k4) {
                *(int4*)(ip + 4 * k4) = make_int4(ex[4 * k4], ex[4 * k4 + 1], ex[4 * k4 + 2], ex[4 * k4 + 3]);
                *(f32x4*)(gp + 4 * k4) = (f32x4){val[4 * k4] * inv, val[4 * k4 + 1] * inv, val[4 * k4 + 2] * inv, val[4 * k4 + 3] * inv};
            }
        }
        ucur = unxt; have = have_next;
    }
}

#define FP4X2(w, sel) __builtin_amdgcn_cvt_scalef32_pk_f32_fp4((w), 1.0f, (sel))
__device__ __forceinline__ float dot16_fp4(const u32x2 r, const f32x4 (&xs)[4]) {
    float p = 0.f;
    { const f32x2 a = FP4X2(r.x, 0), b = FP4X2(r.x, 1), c = FP4X2(r.x, 2), d = FP4X2(r.x, 3);
      p += (a.x * xs[0].x + a.y * xs[0].y) + (b.x * xs[0].z + b.y * xs[0].w); p += (c.x * xs[1].x + c.y * xs[1].y) + (d.x * xs[1].z + d.y * xs[1].w); }
    { const f32x2 a = FP4X2(r.y, 0), b = FP4X2(r.y, 1), c = FP4X2(r.y, 2), d = FP4X2(r.y, 3);
      p += (a.x * xs[2].x + a.y * xs[2].y) + (b.x * xs[2].z + b.y * xs[2].w); p += (c.x * xs[3].x + c.y * xs[3].y) + (d.x * xs[3].z + d.y * xs[3].w); }
    return p;
}
__device__ __forceinline__ void axpy16_fp4(const u32x2 r, float w, f32x4 (&o)[4]) {
    { const f32x2 a = FP4X2(r.x, 0), b = FP4X2(r.x, 1), c = FP4X2(r.x, 2), d = FP4X2(r.x, 3);
      o[0].x += w * a.x; o[0].y += w * a.y; o[0].z += w * b.x; o[0].w += w * b.y; o[1].x += w * c.x; o[1].y += w * c.y; o[1].z += w * d.x; o[1].w += w * d.y; }
    { const f32x2 a = FP4X2(r.y, 0), b = FP4X2(r.y, 1), c = FP4X2(r.y, 2), d = FP4X2(r.y, 3);
      o[2].x += w * a.x; o[2].y += w * a.y; o[2].z += w * b.x; o[2].w += w * b.y; o[3].x += w * c.x; o[3].y += w * c.y; o[3].z += w * d.x; o[3].w += w * d.y; }
}
__device__ __forceinline__ float swap32_add(float a, float b) { auto r = __builtin_amdgcn_permlane32_swap(__float_as_uint(a), __float_as_uint(b), false, false); return __uint_as_float(r[0]) + __uint_as_float(r[1]); }
__device__ __forceinline__ float swap16_add(float a, float b) { auto r = __builtin_amdgcn_permlane16_swap(__float_as_uint(a), __float_as_uint(b), false, false); return __uint_as_float(r[0]) + __uint_as_float(r[1]); }
__device__ __forceinline__ float row_sum16(float v) { v += dpp_f<0xB1>(v); v += dpp_f<0x4E>(v); v += dpp_f<0x141>(v); v += dpp_f<0x140>(v); return v; }
constexpr int GB = 32;
typedef __attribute__((address_space(8))) void* rsrc_t;
__device__ __forceinline__ void g_issue(u32x2 (&buf)[GB], __amdgpu_buffer_rsrc_t rs, int idxr, int lb, int voff) {
#pragma unroll
    for (int j = 0; j < GB; ++j) { const int e = __builtin_amdgcn_readlane(idxr, lb + j); buf[j] = __builtin_amdgcn_raw_buffer_load_b64(rs, voff, e * 512, 0); }
}
__device__ __forceinline__ float dot16_fp4p(const u32x2 r, const f32x2 (&xp)[8]) {
    f32x2 a = FP4X2(r.x, 0) * xp[0];
    a += FP4X2(r.x, 1) * xp[1]; a += FP4X2(r.x, 2) * xp[2]; a += FP4X2(r.x, 3) * xp[3];
    a += FP4X2(r.y, 0) * xp[4]; a += FP4X2(r.y, 1) * xp[5]; a += FP4X2(r.y, 2) * xp[6]; a += FP4X2(r.y, 3) * xp[7];
    return a.x + a.y;
}
__device__ __forceinline__ void axpy16_fp4p(const u32x2 r, float w, f32x2 (&o)[8]) {
    const f32x2 ww = (f32x2){w, w};
    o[0] += FP4X2(r.x, 0) * ww; o[1] += FP4X2(r.x, 1) * ww; o[2] += FP4X2(r.x, 2) * ww; o[3] += FP4X2(r.x, 3) * ww;
    o[4] += FP4X2(r.y, 0) * ww; o[5] += FP4X2(r.y, 1) * ww; o[6] += FP4X2(r.y, 2) * ww; o[7] += FP4X2(r.y, 3) * ww;
}
template <int H> __device__ __forceinline__ void g_compute_u(const u32x2 (&buf)[GB], int q, int i16, const f32x2 (&xp)[8], float& zlo, float& zhi) {
    float p[16];
#pragma unroll
    for (int j = 0; j < 16; ++j) p[j] = dot16_fp4p(buf[16 * H + j], xp);
    float s1[8], s2[4];
#pragma unroll
    for (int m = 0; m < 8; ++m) s1[m] = swap32_add(p[2 * m], p[2 * m + 1]);
#pragma unroll
    for (int n = 0; n < 4; ++n) s2[n] = swap16_add(s1[2 * n], s1[2 * n + 1]);
#pragma unroll
    for (int r = 0; r < 4; ++r) { const float z = row_sum16(s2[r]); const bool mine = i16 == ((4 * q + r) & 15);
        zlo = (mine && q < 4) ? z : zlo; zhi = (mine && q >= 4) ? z : zhi; }
}
template <int H> __device__ __forceinline__ void g_compute_v(const u32x2 (&buf)[GB], int q, float alo, float ahi, f32x2 (&o)[8]) {
    const int areg = __builtin_bit_cast(int, (q < 4) ? alo : ahi), sb = 4 * (q & 3);
#pragma unroll
    for (int j = 0; j < 16; ++j) { const int src = 32 * (j & 1) + 16 * ((j >> 1) & 1) + (j >> 2) + sb;
        const float w = __builtin_bit_cast(float, __builtin_amdgcn_readlane(areg, src));
        axpy16_fp4p(buf[16 * H + j], w, o); }
}
__device__ __forceinline__ void q_issue(u32x2 (&buf)[16], __amdgpu_buffer_rsrc_t rs, int ixr  , int lb, int voff) {
#pragma unroll
    for (int j = 0; j < 16; ++j) { const int e9 = __builtin_amdgcn_readlane(ixr, lb + j); buf[j] = __builtin_amdgcn_raw_buffer_load_b64(rs, voff, e9, 0); }
}
__device__ __forceinline__ void q_compute_u(const u32x2 (&buf)[16], int q, int i16, const f32x2 (&xp)[8], float& zlo, float& zhi) {
    float p[16];
#pragma unroll
    for (int j = 0; j < 16; ++j) p[j] = dot16_fp4p(buf[j], xp);
    float s1[8], s2[4];
#pragma unroll
    for (int m = 0; m < 8; ++m) s1[m] = swap32_add(p[2 * m], p[2 * m + 1]);
#pragma unroll
    for (int n = 0; n < 4; ++n) s2[n] = swap16_add(s1[2 * n], s1[2 * n + 1]);
#pragma unroll
    for (int r = 0; r < 4; ++r) { const float z = row_sum16(s2[r]); const bool mine = i16 == ((4 * q + r) & 15);
        zlo = (mine && q < 4) ? z : zlo; zhi = (mine && q >= 4) ? z : zhi; }
}
typedef _Float16 h16x2 __attribute__((ext_vector_type(2)));
#define FP4H2(w, sel) __builtin_amdgcn_cvt_scalef32_pk_f16_fp4((w), 1.0f, (sel))
__device__ __forceinline__ void axpy16_fp4h(const u32x2 r, const h16x2 ww, h16x2 (&o)[8]) {
    o[0] += FP4H2(r.x, 0) * ww; o[1] += FP4H2(r.x, 1) * ww; o[2] += FP4H2(r.x, 2) * ww; o[3] += FP4H2(r.x, 3) * ww;
    o[4] += FP4H2(r.y, 0) * ww; o[5] += FP4H2(r.y, 1) * ww; o[6] += FP4H2(r.y, 2) * ww; o[7] += FP4H2(r.y, 3) * ww;
}
__device__ __forceinline__ void q_compute_vh(const u32x2 (&buf)[16], int q, int alo, int ahi, h16x2 (&o)[8]) {
    const int areg = (q < 4) ? alo : ahi, sb = 4 * (q & 3);
#pragma unroll
    for (int j = 0; j < 16; ++j) { const int src = 32 * (j & 1) + 16 * ((j >> 1) & 1) + (j >> 2) + sb;
        const h16x2 w = __builtin_bit_cast(h16x2, __builtin_amdgcn_readlane(areg, src));
        axpy16_fp4h(buf[j], w, o); }
}
__device__ __forceinline__ void q_compute_v(const u32x2 (&buf)[16], int q, float alo, float ahi, f32x2 (&o)[8]) {
    const int areg = __builtin_bit_cast(int, (q < 4) ? alo : ahi), sb = 4 * (q & 3);
#pragma unroll
    for (int j = 0; j < 16; ++j) { const int src = 32 * (j & 1) + 16 * ((j >> 1) & 1) + (j >> 2) + sb;
        const float w = __builtin_bit_cast(float, __builtin_amdgcn_readlane(areg, src));
        axpy16_fp4p(buf[j], w, o); }
}
__device__ __forceinline__ int swap32_addi(int a, int b) { auto r = __builtin_amdgcn_permlane32_swap((unsigned)a, (unsigned)b, false, false); const unsigned r0 = r[0], r1 = r[1]; return (int)(r0 + r1); }
__device__ __forceinline__ int swap16_addi(int a, int b) { auto r = __builtin_amdgcn_permlane16_swap((unsigned)a, (unsigned)b, false, false); const unsigned r0 = r[0], r1 = r[1]; return (int)(r0 + r1); }
template <int CTRL> __device__ __forceinline__ int dpp_i(int v) { return __builtin_amdgcn_update_dpp(0, v, CTRL, 0xf, 0xf, true); }
__device__ __forceinline__ int row_sum16i(int v) { v += dpp_i<0xB1>(v); v += dpp_i<0x4E>(v); v += dpp_i<0x141>(v); v += dpp_i<0x140>(v); return v; }
__device__ __forceinline__ void q_compute_ui(const u32x2 (&buf)[16], int q, int i16, int xh0, int xh1, int xl0, int xl1, int& zlo, int& zhi) {
    int p[16];
#pragma unroll
    for (int j = 0; j < 16; ++j) { const int d1 = __builtin_amdgcn_sdot8((int)buf[j].x, xh0, __builtin_amdgcn_sdot8((int)buf[j].y, xh1, 0, false), false);
        const int d2 = __builtin_amdgcn_sdot8((int)buf[j].x, xl0, __builtin_amdgcn_sdot8((int)buf[j].y, xl1, 0, false), false);
        p[j] = (d1 << 4) + d2; }
    int s1[8], s2[4];
#pragma unroll
    for (int m = 0; m < 8; ++m) s1[m] = swap32_addi(p[2 * m], p[2 * m + 1]);
#pragma unroll
    for (int n = 0; n < 4; ++n) s2[n] = swap16_addi(s1[2 * n], s1[2 * n + 1]);
#pragma unroll
    for (int r = 0; r < 4; ++r) { const int z = row_sum16i(s2[r]); const bool mine = i16 == ((4 * q + r) & 15);
        zlo = (mine && q < 4) ? z : zlo; zhi = (mine && q >= 4) ? z : zhi; }
}
__device__ __forceinline__ void phase_gather_u(const Params& P) {
    const int tid = threadIdx.x, lane = tid & 63, wave = __builtin_amdgcn_readfirstlane(tid >> 6);
    const int gw = blockIdx.x * NWAVES + wave, NGW = gridDim.x * NWAVES;
    unsigned char* ws = P.ws;
    const int* IDX = (const int*)(ws + WS_IDX); const float* GATE = (const float*)(ws + WS_GATE); const float* ESC = (const float*)(ws + WS_ESCALE); float* AW = (float*)(ws + WS_AW);
    const __amdgpu_buffer_rsrc_t rsU = __builtin_amdgcn_make_buffer_rsrc((void*)(ws + WS_U8), 0, 16384 * 512, 0x00020000);
    const bf16* H2B = (const bf16*)(ws + WS_H2B); const float* SSQ = (const float*)(ws + WS_SSQ);
    const int hh = lane >> 5, rr = (lane >> 4) & 1, i16 = lane & 15, gsel = 4 * i16 + 2 * rr + hh;
    const int voff = 8 * lane;
    const unsigned ul = (unsigned)lane;
    int t = gw;
    if (t < NTOK) {
        int idx0, idx1; u32x2 hraw[4]; float sqv;
        { const int* ip = IDX + (size_t)t * NSEL; idx0 = ip[ul]; idx1 = ip[64u + ul];
          const u32x2* hp = (const u32x2*)(H2B + (size_t)t * DM);
#pragma unroll
          for (int j = 0; j < 4; ++j) hraw[j] = hp[64u * j + ul];
          sqv = (SSQ + (size_t)t * 16)[ul & 15u]; }
        u32x2 R0[16], R1[16], R2[16], R3[16];
        { const int ix0 = idx0 << 9; q_issue(R0, rsU, ix0, 0, voff); q_issue(R1, rsU, ix0, 16, voff); q_issue(R2, rsU, ix0, 32, voff); }
        for (;;) {
            const int tn = t + NGW; const bool has_next = tn < NTOK; const int tl = has_next ? tn : t;
            int idx0n, idx1n; u32x2 hrawn[4]; float sqn, g0, g1;
            { const int* ip = IDX + (size_t)tl * NSEL; idx0n = ip[ul]; idx1n = ip[64u + ul];
              const u32x2* hp = (const u32x2*)(H2B + (size_t)tl * DM);
#pragma unroll
              for (int j = 0; j < 4; ++j) hrawn[j] = hp[64u * j + ul];
              sqn = (SSQ + (size_t)tl * 16)[ul & 15u];
              const float* gp = GATE + (size_t)t * NSEL; g0 = gp[ul]; g1 = gp[64u + ul]; }
            const float su0 = ESC[idx0], su1 = ESC[idx1], sv0 = ESC[16384 + idx0], sv1 = ESC[16384 + idx1];
            const float cq0 = ((const float*)(ws + WS_SUMQ))[idx0], cq1 = ((const float*)(ws + WS_SUMQ))[idx1];
            const float rstd2 = rsqrtf(row_sum16(sqv) * (1.f / DM) + EPS);
            float xf[16];
#pragma unroll
            for (int j = 0; j < 4; ++j) { xf[4 * j] = bflo(hraw[j].x); xf[4 * j + 1] = bfhi(hraw[j].x); xf[4 * j + 2] = bflo(hraw[j].y); xf[4 * j + 3] = bfhi(hraw[j].y); }
            float am = 0.f;
#pragma unroll
            for (int e = 0; e < 16; ++e) am = fmaxf(am, fabsf(xf[e]));
            am = fmaxf(wave_max_fast(am), 1e-30f);
            const float xinv = 127.f / am, xscale = am * (1.f / 127.f);
            unsigned xh[2] = {0u, 0u}, xl[2] = {0u, 0u};
#pragma unroll
            for (int j = 0; j < 4; ++j)
#pragma unroll
                for (int i = 0; i < 4; ++i) { const int xi = (int)rintf(xf[4 * j + i] * xinv); const int sh = 16 * (j & 1) + 4 * i;
                    xh[j >> 1] |= ((unsigned)(xi >> 4) & 15u) << sh; xl[j >> 1] |= ((unsigned)((xi & 15) - 8) & 15u) << sh; }
            int zlo = 0, zhi = 0;
            const int ix0 = idx0 << 9, ix1 = idx1 << 9;
#pragma unroll 1
            for (int qq = 0; qq < 8; qq += 4) {
                const int ixn = qq ? (idx0n << 9) : ix1;
                q_issue(R3, rsU, qq ? ix1 : ix0, 48, voff);
                q_compute_ui(R0, qq, i16, (int)xh[0], (int)xh[1], (int)xl[0], (int)xl[1], zlo, zhi);
                q_issue(R0, rsU, ixn, 0, voff);
                q_compute_ui(R1, qq + 1, i16, (int)xh[0], (int)xh[1], (int)xl[0], (int)xl[1], zlo, zhi);
                q_issue(R1, rsU, ixn, 16, voff);
                q_compute_ui(R2, qq + 2, i16, (int)xh[0], (int)xh[1], (int)xl[0], (int)xl[1], zlo, zhi);
                q_issue(R2, rsU, ixn, 32, voff);
                q_compute_ui(R3, qq + 3, i16, (int)xh[0], (int)xh[1], (int)xl[0], (int)xl[1], zlo, zhi);
            }
            const float glo = __shfl(g0, gsel), ghi = __shfl(g1, gsel), sulo = __shfl(su0, gsel), suhi = __shfl(su1, gsel), svlo = __shfl(sv0, gsel), svhi = __shfl(sv1, gsel);
            const float cqlo = __shfl(cq0, gsel), cqhi = __shfl(cq1, gsel);
            const float zfl = ((float)zlo + 8.f * cqlo) * (sulo * xscale * rstd2), zfh = ((float)zhi + 8.f * cqhi) * (suhi * xscale * rstd2);
            float* ap = AW + (size_t)t * NSEL;
            ap[lane] = gelu_tanh_f(zfl) * glo * svlo; ap[64 + lane] = gelu_tanh_f(zfh) * ghi * svhi;
            if (!has_next) break;
            t = tn; idx0 = idx0n; idx1 = idx1n; sqv = sqn;
#pragma unroll
            for (int j = 0; j < 4; ++j) hraw[j] = hrawn[j];
        }
    }
}
__device__ __forceinline__ void phase_gather_v(const Params& P) {
    const int tid = threadIdx.x, lane = tid & 63, wave = __builtin_amdgcn_readfirstlane(tid >> 6);
    const int gw = blockIdx.x * NWAVES + wave, NGW = gridDim.x * NWAVES;
    unsigned char* ws = P.ws;
    const int* IDX = (const int*)(ws + WS_IDX); const float* AW = (const float*)(ws + WS_AW);
    const __amdgpu_buffer_rsrc_t rsV = __builtin_amdgcn_make_buffer_rsrc((void*)(ws + WS_V8), 0, 16384 * 512, 0x00020000);
    const bf16* H2B = (const bf16*)(ws + WS_H2B);
    const int voff = 8 * lane;
    const unsigned ul = (unsigned)lane;
    int t = gw;
    if (t < NTOK) {
        int idx0, idx1; u32x2 hraw[4]; float alo, ahi;
        { const int* ip = IDX + (size_t)t * NSEL; idx0 = ip[ul]; idx1 = ip[64u + ul];
          const u32x2* hp = (const u32x2*)(H2B + (size_t)t * DM);
#pragma unroll
          for (int j = 0; j < 4; ++j) hraw[j] = hp[64u * j + ul];
          const float* ap = AW + (size_t)t * NSEL; alo = ap[ul]; ahi = ap[64u + ul]; }
        u32x2 R0[16], R1[16], R2[16], R3[16];
        { const int ix0 = idx0 << 9; q_issue(R0, rsV, ix0, 0, voff); q_issue(R1, rsV, ix0, 16, voff); q_issue(R2, rsV, ix0, 32, voff); }
        for (;;) {
            const int tn = t + NGW; const bool has_next = tn < NTOK; const int tl = has_next ? tn : t;
            int idx0n, idx1n; u32x2 hrawn[4]; float alon, ahin;
            { const int* ip = IDX + (size_t)tl * NSEL; idx0n = ip[ul]; idx1n = ip[64u + ul];
              const u32x2* hp = (const u32x2*)(H2B + (size_t)tl * DM);
#pragma unroll
              for (int j = 0; j < 4; ++j) hrawn[j] = hp[64u * j + ul];
              const float* ap = AW + (size_t)tl * NSEL; alon = ap[ul]; ahin = ap[64u + ul]; }
            const float wmx = fmaxf(wave_max_fast(fmaxf(fabsf(alo), fabsf(ahi))), 1e-30f), winv = 1.f / wmx;
            int alh, ahh;
            { const h16x2 a = (h16x2){(_Float16)(alo * winv), (_Float16)(alo * winv)}, b = (h16x2){(_Float16)(ahi * winv), (_Float16)(ahi * winv)};
              alh = __builtin_bit_cast(int, a); ahh = __builtin_bit_cast(int, b); }
            h16x2 oh[8];
#pragma unroll
            for (int j = 0; j < 8; ++j) oh[j] = (h16x2){(_Float16)0.f, (_Float16)0.f};
            const int ix0 = idx0 << 9, ix1 = idx1 << 9;
#pragma unroll 1
            for (int qq = 0; qq < 8; qq += 4) {
                const int ixn = qq ? (idx0n << 9) : ix1;
                q_issue(R3, rsV, qq ? ix1 : ix0, 48, voff);
                q_compute_vh(R0, qq, alh, ahh, oh);
                q_issue(R0, rsV, ixn, 0, voff);
                q_compute_vh(R1, qq + 1, alh, ahh, oh);
                q_issue(R1, rsV, ixn, 16, voff);
                q_compute_vh(R2, qq + 2, alh, ahh, oh);
                q_issue(R2, rsV, ixn, 32, voff);
                q_compute_vh(R3, qq + 3, alh, ahh, oh);
            }
            f32x2 o[8];
#pragma unroll
            for (int j = 0; j < 8; ++j) o[j] = (f32x2){(float)oh[j].x * wmx, (float)oh[j].y * wmx};
            float ss = 0.f;
#pragma unroll
            for (int j = 0; j < 4; ++j) { o[2 * j] += (f32x2){bflo(hraw[j].x), bfhi(hraw[j].x)}; o[2 * j + 1] += (f32x2){bflo(hraw[j].y), bfhi(hraw[j].y)}; }
#pragma unroll
            for (int j = 0; j < 8; ++j) ss += o[j].x * o[j].x + o[j].y * o[j].y;
            ss = wave_sum_fast(ss);
            const float r3 = rsqrtf(ss * (1.f / DM) + EPS);
            f32x4* op = (f32x4*)(P.out + (size_t)t * DM);
            const f32x4* gfp = (const f32x4*)P.g_fin;
#pragma unroll
            for (int j = 0; j < 4; ++j) { const f32x4 gv = gfp[64u * j + ul]; op[64u * j + ul] = (f32x4){o[2 * j].x * r3 * gv.x, o[2 * j].y * r3 * gv.y, o[2 * j + 1].x * r3 * gv.z, o[2 * j + 1].y * r3 * gv.w}; }
            if (!has_next) break;
            t = tn; idx0 = idx0n; idx1 = idx1n; alo = alon; ahi = ahin;
#pragma unroll
            for (int j = 0; j < 4; ++j) hraw[j] = hrawn[j];
        }
    }
}

#define XB_TMO      128
#define XB_XCNT(j)  (256  + 64 * (j))
#define XB_XSUB(j)  (1280 + 64 * (j))
#define XB_XGEN(j)  (2304 + 64 * (j))
#define XB_TOP      3328
#define XB_TOPGEN   3392
#define XCD_BAR_WORDS 3456
#define XB_SPIN_CAP (1u << 18)

__device__ __forceinline__ unsigned xb_ld(unsigned* p)              { return __hip_atomic_load(p, __ATOMIC_RELAXED, __HIP_MEMORY_SCOPE_AGENT); }
__device__ __forceinline__ unsigned xb_add(unsigned* p, unsigned v) { return __hip_atomic_fetch_add(p, v, __ATOMIC_RELAXED, __HIP_MEMORY_SCOPE_AGENT); }
__device__ __forceinline__ unsigned xb_xcc_id() { return (unsigned)__builtin_amdgcn_s_getreg((3 << 11) | 20) & 0xFu; }
#define XB_SPIN(cond, bar) do { unsigned _sp = 0; while (cond) { __builtin_amdgcn_s_sleep(1); \
    if ((++_sp & 255u) == 0u) { if (xb_ld(&(bar)[XB_TMO])) break; if (_sp > XB_SPIN_CAP) { atomicAdd(&(bar)[XB_TMO], 1u); break; } } } } while (0)

struct XcdBarrier {
    unsigned* bar; unsigned x;
    volatile LAS unsigned* st;
};

__device__ __forceinline__ XcdBarrier xcd_barrier_post(unsigned* bar, volatile LAS unsigned* st) {
    XcdBarrier b; b.bar = bar; b.x = xb_xcc_id(); b.st = st;
    if (threadIdx.x == 0) (void)xb_add(&bar[XB_XCNT(b.x)], 1u);
    return b;
}
__device__ __forceinline__ void xcd_barrier_complete(unsigned* bar, unsigned x, unsigned& nloc, unsigned& nx) {
    const unsigned G = gridDim.x * gridDim.y * gridDim.z;
    unsigned sum, cnt, mine, sp = 0u;
    for (;;) {
        sum = 0u; cnt = 0u; mine = 0u;
#pragma unroll
        for (unsigned j = 0; j < 16; ++j) { const unsigned c = xb_ld(&bar[XB_XCNT(j)]); sum += c; cnt += (c > 0u) ? 1u : 0u; mine = (j == x) ? c : mine; }
        if (sum == G) break;
        __builtin_amdgcn_s_sleep(1);
        if ((++sp & 255u) == 0u) { if (xb_ld(&bar[XB_TMO])) break; if (sp > XB_SPIN_CAP) { atomicAdd(&bar[XB_TMO], 1u); break; } }
    }
    nloc = mine > 0u ? mine : 1u; nx = cnt > 0u ? cnt : 1u;
}

__device__ __forceinline__ void xcd_barrier(const XcdBarrier& b) {
    asm volatile("s_waitcnt vmcnt(0)" ::: "memory");
    __syncthreads();
    if (threadIdx.x == 0) {
        unsigned* bar = b.bar;
        __builtin_amdgcn_s_waitcnt(0);
        unsigned nloc = b.st[0], nx = b.st[1];
        if (nloc == 0u) { xcd_barrier_complete(bar, b.x, nloc, nx); b.st[0] = nloc; b.st[1] = nx; }
        const unsigned old = xb_add(&bar[XB_XSUB(b.x)], 1u);
        const unsigned gen = old / nloc;
        if (old + 1u == (gen + 1u) * nloc) {
            __builtin_amdgcn_fence(__ATOMIC_RELEASE, "agent");
            asm volatile("s_waitcnt vmcnt(0)" ::: "memory");
            const unsigned og = xb_add(&bar[XB_TOP], 1u);
            const unsigned tg = og / nx;
            if (og + 1u == (tg + 1u) * nx) xb_add(&bar[XB_TOPGEN], 1u);
            else XB_SPIN(xb_ld(&bar[XB_TOPGEN]) == tg, bar);
            __builtin_amdgcn_fence(__ATOMIC_ACQUIRE, "agent");
            xb_add(&bar[XB_XGEN(b.x)], 1u);
            asm volatile("s_waitcnt vmcnt(0)" ::: "memory");
        } else {
            XB_SPIN(xb_ld(&bar[XB_XGEN(b.x)]) == gen, bar);
            __builtin_amdgcn_fence(__ATOMIC_ACQUIRE, "agent");
            asm volatile("s_waitcnt vmcnt(0)" ::: "memory");
        }
    }
    __syncthreads();
}


#ifndef MK_MULTI
#define MK_MULTI 0
#endif
constexpr int NPHASE = 9;
#ifndef REP5
#define REP5 1
#endif
#ifndef REP6
#define REP6 1
#endif
__global__ void __launch_bounds__(NTHREADS, 2) mk_fwd(Params P) {
    extern __shared__ __attribute__((aligned(16))) unsigned char lds_raw[];
    LAS unsigned char* lds = (LAS unsigned char*)lds_raw;
    cg::grid_group grid = cg::this_grid();
    unsigned char* ws = P.ws;
    const int lo = P.ph_lo, hi = P.ph_hi;
    volatile LAS unsigned* bst = (volatile LAS unsigned*)(lds + 131072 + 64);
    if (threadIdx.x < 2) bst[threadIdx.x] = 0u;
    __syncthreads();
    XcdBarrier xbar = xcd_barrier_post((unsigned*)(ws + WS_CTL), bst);
#define IN(k) (lo <= (k) && (k) < hi)
#define SEAM(k) do { if (IN(k) && IN((k) + 1)) { xcd_barrier(xbar); } } while (0)
    if (IN(0)) phase_prep(P, lds);
    SEAM(0);
    if (IN(1)) { phase_metaproj(P); phase_winq(P, lds); }
    SEAM(1);
    if (IN(2)) {
        pg8::Gemm g{(const bf16*)(ws + WS_H0I8), (const bf16*)(ws + WS_WIN_T), NTOK, DIN, DM / 2}; pg8::StaticOrder S; S.init(NTOK, DIN, (int)gridDim.x, (int)blockIdx.x);
        EpiProjI8 E{(bf16*)(ws + WS_PROJ), (const float*)(ws + WS_RSTD1), (const float*)(ws + WS_SW)};
        pg8::gemm_phase_i8<EpiProjI8, pg8::StaticOrder, true, true>(lds, g, S, E);
    }
    SEAM(2);
    if (IN(3)) phase_conv(P, lds);
    SEAM(3);
    if (IN(4)) {
        pg8::Gemm g{(const bf16*)(ws + WS_Y), (const bf16*)(ws + WS_WOUT_T), NTOK, DM, DM / 2}; pg8::StaticOrder S; S.init(NTOK, DM, (int)gridDim.x, (int)blockIdx.x);
        EpiResidualI8 E{(bf16*)(ws + WS_H2B), (const signed char*)(ws + WS_H0I8), (const float*)(ws + WS_SX), (const float*)(ws + WS_SY), (const float*)(ws + WS_SWO), (float*)(ws + WS_SSQ)};
        pg8::gemm_phase_i8<EpiResidualI8, pg8::StaticOrder, true, true>(lds, g, S, E);
    }
    SEAM(4);
    if (IN(5)) {
        pg8::Gemm g{(const bf16*)(ws + WS_H2B), (const bf16*)(ws + WS_WQ_T), NTOK, 2048, DM}; pg8::StaticOrder S; S.init(NTOK, 2048, (int)gridDim.x, (int)blockIdx.x);
        EpiRowScale<1> E{(bf16*)(ws + WS_Q), 2048, (const float*)(ws + WS_SSQ)};
        pg8::gemm_phase<EpiRowScale<1>, pg8::StaticOrder, true, true>(lds, g, S, E);
    }
    if (IN(5) && IN(6)) { asm volatile("s_waitcnt vmcnt(0)" ::: "memory"); __syncthreads(); }
    if (IN(6)) phase_route(P, lds);
    SEAM(6);
    if (IN(7)) phase_gather_u(P);
    SEAM(7);
    if (IN(8)) phase_gather_v(P);
#undef IN
#undef SEAM
}

extern "C" void kernel_launch(void* const* d_in, const int* in_sizes, int n_in, void* d_out, int out_size, void* d_ws, size_t ws_size, hipStream_t stream) {
    static int grid = 0;
    if (grid == 0) {
        if (n_in != 18 || in_sizes[0] != NTOK * DM || out_size != NTOK * DM || ws_size < WS_END) {
            fprintf(stderr, "kernel_launch: unexpected shapes (n_in %d in0 %d out %d ws %zu)\n", n_in, n_in > 0 ? in_sizes[0] : -1, out_size, ws_size); grid = -1; return; }
        int dev = 0, cus = 0, per_cu = 0;
        (void)hipGetDevice(&dev); (void)hipDeviceGetAttribute(&cus, hipDeviceAttributeMultiprocessorCount, dev);
        if (hipFuncSetAttribute((const void*)mk_fwd, hipFuncAttributeMaxDynamicSharedMemorySize, LDS_BYTES) != hipSuccess) { fprintf(stderr, "kernel_launch: hipFuncSetAttribute failed\n"); grid = -1; return; }
        if (hipOccupancyMaxActiveBlocksPerMultiprocessor(&per_cu, (const void*)mk_fwd, NTHREADS, LDS_BYTES) != hipSuccess || per_cu < 1) { fprintf(stderr, "kernel_launch: occupancy query failed (%d)\n", per_cu); (void)hipGetLastError(); per_cu = 1; }
        if (per_cu > 1) per_cu = 1;
        grid = cus * per_cu;
        if (grid <= 0) grid = 256;
    }
    if (grid < 0) return;
    Params p{};
    p.x = (const float*)d_in[0]; p.meta = (const float*)d_in[1]; p.g_mix = (const float*)d_in[2]; p.w_in = (const float*)d_in[3]; p.sc_w = (const float*)d_in[4];
    p.cf_w = (const float*)d_in[5]; p.cf_b = (const float*)d_in[6]; p.ln_g = (const float*)d_in[7]; p.ln_b = (const float*)d_in[8]; p.g_sc = (const float*)d_in[9];
    p.g_cf = (const float*)d_in[10]; p.w_out = (const float*)d_in[11]; p.g_ffn = (const float*)d_in[12]; p.w_q = (const float*)d_in[13]; p.keys = (const float*)d_in[14];
    p.pu = (const float*)d_in[15]; p.pv = (const float*)d_in[16]; p.g_fin = (const float*)d_in[17];
    p.out = (float*)d_out; p.ws = (unsigned char*)d_ws;
    (void)hipMemsetAsync((char*)d_ws + WS_CTL, 0, 40960, stream);
#if MK_MULTI
    for (int ph = 0; ph < NPHASE; ++ph) { p.ph_lo = ph; p.ph_hi = ph + 1; p.coop = 0; p.pad = 0;
        hipLaunchKernelGGL(mk_fwd, dim3(grid), dim3(NTHREADS), LDS_BYTES, stream, p); }
#else
    p.ph_lo = 0; p.ph_hi = NPHASE; p.coop = 1; p.pad = 0;
    void* args[] = {&p};
    hipError_t e = hipLaunchCooperativeKernel((const void*)mk_fwd, dim3(grid), dim3(NTHREADS), args, LDS_BYTES, stream);
    if (e != hipSuccess) fprintf(stderr, "cooperative launch failed: %s (grid %d)\n", hipGetErrorString(e), grid);
#endif
}
```

```cpp
#include <hip/hip_runtime.h>
#include <hip/hip_cooperative_groups.h>
#include <cstdio>
#include <cstdint>
namespace cg = cooperative_groups;

namespace pg8 {
#define PG8_LAS __attribute__((address_space(3)))
typedef unsigned short bf16_t;
typedef short bf16x8 __attribute__((ext_vector_type(8)));
typedef float f32x4 __attribute__((ext_vector_type(4)));
typedef unsigned u32x4 __attribute__((ext_vector_type(4)));
typedef int i32x4 __attribute__((ext_vector_type(4)));
constexpr int BM = 256, BK = 64, HALF = 128, HTB = HALF * BK * 2  , STAGE_BYTES = 8 * HTB, NXCD = 8, WGM = 8;

__host__ __device__ __forceinline__ int lds_byte(int r, int c) { const int st = (r >> 4) * 2 + (c >> 5), rr = r & 15, cc = c & 31, ob = rr * 64 + cc * 2; return st * 1024 + (ob ^ (((ob >> 9) & 1) << 5)); }
__host__ __device__ __forceinline__ void stage_rc(int b, int& R, int& C) { const int st = b / 1024, sb = b % 1024, swz = sb ^ (((sb >> 9) & 1) << 5); R = (st >> 1) * 16 + swz / 64; C = (st & 1) * 32 + (swz % 64) / 2; }
__host__ __device__ __forceinline__ int perm32(int rho) { const int n = rho >> 4, i = rho & 15; return 8 * (i >> 2) + 4 * n + (i & 3); }

struct Unit { int pm, pn; };
struct Gemm { const bf16_t* A; const bf16_t* Bt; int M, N, K; };

struct StaticOrder {
    int nM, nN, nwg, G, c;
    __host__ __device__ void init(int M, int N, int G_, int c_) { nM = M / BM; nN = N / BM; nwg = nM * nN; G = G_; c = c_; }
    __host__ __device__ bool next(int i, Unit& u) const {
        const long L = (long)i * G + c; if (L >= nwg) return false;
        int wgid = (int)L; { const int q = nwg / NXCD, r = nwg % NXCD, xcd = wgid % NXCD, off = wgid / NXCD; wgid = (xcd < r ? xcd * (q + 1) : r * (q + 1) + (xcd - r) * q) + off; }
        const int nig = WGM * nN, gid = wgid / nig, fm = gid * WGM, gsz = (nM - fm) < WGM ? (nM - fm) : WGM;
        u.pm = fm + ((wgid % nig) % gsz); u.pn = (wgid % nig) / gsz; return true;
    }
    __device__ __forceinline__ void a_ready(const Unit&) const {}
    __device__ __forceinline__ void done(const Unit&) const {}
};

template <class Epi, class Sched, bool ALIGN_EPI = false, bool SP2 = false>
__device__ __forceinline__ void gemm_phase(PG8_LAS unsigned char* lds, const Gemm g, const Sched& S, const Epi& E) {
    const int tid = threadIdx.x, wid = __builtin_amdgcn_readfirstlane(tid >> 6), lane = tid & 63, wr = wid >> 2, wc = wid & 3, fr = lane & 15, fq = lane >> 4;
    const int K = g.K, nt = K / BK;
    unsigned voffA[2], voffB[2];
#pragma unroll
    for (int i = 0; i < 2; ++i) { int R, C; stage_rc(tid * 16 + i * 8192, R, C); const int Rb = Epi::PERM ? ((R & ~31) + perm32(R & 31)) : R;
        voffA[i] = (unsigned)(R * K + C) * 2u; voffB[i] = (unsigned)(Rb * K + C) * 2u; }
    const size_t kstep = (size_t)(BK * 2);
    const size_t hstep = (size_t)HALF * K * 2;
    const size_t tstep = 2 * hstep;
    const unsigned ldsw = (unsigned)wid * 1024u;
    const int aoff = lds_byte(wr * 64 + fr, fq * 8), boff = lds_byte(wc * 32 + fr, fq * 8);
#define PG8_SA(b, h) (((b) * 2 + (h)) * HTB)
#define PG8_SB(b, h) ((4 + (b) * 2 + (h)) * HTB)
#define PG8_STAGE(bufoff, gbase, voff) do { _Pragma("unroll") for (int _i = 0; _i < 2; ++_i) \
        __builtin_amdgcn_global_load_lds((const unsigned*)((const char*)(gbase) + (voff)[_i]), (PG8_LAS unsigned*)(lds + (bufoff) + ldsw + _i * 8192), 16, 0, 0); } while (0)
#define PG8_LDA(dst, b, h) do { _Pragma("unroll") for (int m = 0; m < 4; ++m) _Pragma("unroll") for (int k = 0; k < 2; ++k) dst[m][k] = *(const PG8_LAS bf16x8*)(lds + PG8_SA(b, h) + aoff + m * 2048 + k * 1024); } while (0)
#define PG8_LDB(dst, b, h) do { _Pragma("unroll") for (int n = 0; n < 2; ++n) _Pragma("unroll") for (int k = 0; k < 2; ++k) dst[n][k] = *(const PG8_LAS bf16x8*)(lds + PG8_SB(b, h) + boff + n * 2048 + k * 1024); } while (0)
#define PG8_MMA(ai, bj, At, Bt) do { __builtin_amdgcn_s_setprio(1); _Pragma("unroll") for (int m = 0; m < 4; ++m) _Pragma("unroll") for (int n = 0; n < 2; ++n) _Pragma("unroll") for (int k = 0; k < 2; ++k) \
        acc[ai][bj][m][n] = __builtin_amdgcn_mfma_f32_16x16x32_bf16(Bt[n][k], At[m][k], acc[ai][bj][m][n], 0, 0, 0); __builtin_amdgcn_s_setprio(0); } while (0)
#define PG8_WAIT_V(n) asm volatile("s_waitcnt vmcnt(" #n ")" ::: "memory")
#define PG8_WAIT_L(n) asm volatile("s_waitcnt lgkmcnt(" #n ")" ::: "memory")
#define PG8_BAR __builtin_amdgcn_s_barrier()
#define PG8_SCHED __builtin_amdgcn_sched_barrier(0)
    Unit cur, nxt; int ui = 0;
    if (!S.next(0, cur)) return;
    f32x4 acc[2][2][4][2];
#pragma unroll
    for (int a = 0; a < 2; ++a)
#pragma unroll
        for (int b = 0; b < 2; ++b)
#pragma unroll
            for (int m = 0; m < 4; ++m)
#pragma unroll
                for (int n = 0; n < 2; ++n) acc[a][b][m][n] = (f32x4){0.f, 0.f, 0.f, 0.f};
    bf16x8 At[4][2], B0[2][2], B1[2][2];
    const char* cA = (const char*)g.A + (size_t)cur.pm * tstep; const char* cB = (const char*)g.Bt + (size_t)cur.pn * tstep;
    S.a_ready(cur);
    if constexpr (SP2) {
        PG8_STAGE(PG8_SB(0, 0), cB, voffB); PG8_STAGE(PG8_SB(0, 1), cB + hstep, voffB); PG8_STAGE(PG8_SA(0, 0), cA, voffA); PG8_STAGE(PG8_SA(0, 1), cA + hstep, voffA);
        if (wr == 1) PG8_BAR;
        PG8_WAIT_V(2); PG8_BAR;
        PG8_STAGE(PG8_SB(1, 0), cB + kstep, voffB); PG8_STAGE(PG8_SA(1, 0), cA + kstep, voffA); PG8_STAGE(PG8_SB(1, 1), cB + hstep + kstep, voffB);
        PG8_WAIT_V(6); PG8_BAR;
    } else {
        PG8_STAGE(PG8_SB(0, 0), cB, voffB); PG8_STAGE(PG8_SA(0, 0), cA, voffA); PG8_STAGE(PG8_SB(0, 1), cB + hstep, voffB); PG8_STAGE(PG8_SA(0, 1), cA + hstep, voffA);
        if (wr == 1) PG8_BAR;
        PG8_WAIT_V(4); PG8_BAR;
        PG8_STAGE(PG8_SB(1, 0), cB + kstep, voffB); PG8_STAGE(PG8_SA(1, 0), cA + kstep, voffA); PG8_STAGE(PG8_SB(1, 1), cB + hstep + kstep, voffB);
        PG8_WAIT_V(6); PG8_BAR;
    }
    for (;;) {
        const bool has_next = S.next(ui + 1, nxt);
        const char* nA = has_next ? (const char*)g.A + (size_t)nxt.pm * tstep : cA; const char* nB = has_next ? (const char*)g.Bt + (size_t)nxt.pn * tstep : cB;
        for (int t = 0; t < nt; t += 2) {
            const bool last = (t == nt - 2);
            const char* a1 = cA + (size_t)(t + 1) * kstep;
            const char* a2 = last ? nA : cA + (size_t)(t + 2) * kstep; const char* b2 = last ? nB : cB + (size_t)(t + 2) * kstep;
            const char* a3 = a2 + kstep; const char* b3 = b2 + kstep;
            if (last && has_next) S.a_ready(nxt);
            if constexpr (SP2) {
            PG8_LDB(B0, 0, 0); PG8_LDB(B1, 0, 1); PG8_SCHED; PG8_LDA(At, 0, 0); PG8_STAGE(PG8_SA(1, 1), a1 + hstep, voffA);
            PG8_WAIT_V(8); PG8_WAIT_L(0); PG8_BAR; PG8_MMA(0, 0, At, B0); PG8_MMA(0, 1, At, B1); PG8_BAR; PG8_SCHED;
            PG8_LDA(At, 0, 1); PG8_STAGE(PG8_SB(0, 0), b2, voffB); PG8_STAGE(PG8_SB(0, 1), b2 + hstep, voffB); PG8_STAGE(PG8_SA(0, 0), a2, voffA);
            PG8_WAIT_V(8); PG8_WAIT_L(0); PG8_BAR; PG8_MMA(1, 0, At, B0); PG8_MMA(1, 1, At, B1); PG8_BAR; PG8_SCHED;
            PG8_LDB(B0, 1, 0); PG8_LDB(B1, 1, 1); PG8_SCHED; PG8_LDA(At, 1, 0); PG8_STAGE(PG8_SA(0, 1), a2 + hstep, voffA);
            PG8_WAIT_V(8); PG8_WAIT_L(0); PG8_BAR; PG8_MMA(0, 0, At, B0); PG8_MMA(0, 1, At, B1); PG8_BAR; PG8_SCHED;
            PG8_LDA(At, 1, 1); PG8_STAGE(PG8_SB(1, 0), b3, voffB); PG8_STAGE(PG8_SB(1, 1), b3 + hstep, voffB); PG8_STAGE(PG8_SA(1, 0), a3, voffA);
            PG8_WAIT_V(8); PG8_WAIT_L(0); PG8_BAR; PG8_MMA(1, 0, At, B0); PG8_MMA(1, 1, At, B1); PG8_BAR; PG8_SCHED;
            } else {
            PG8_LDB(B0, 0, 0); PG8_SCHED; PG8_LDA(At, 0, 0); PG8_STAGE(PG8_SA(1, 1), a1 + hstep, voffA);
            PG8_WAIT_L(8); PG8_BAR; PG8_WAIT_L(0); PG8_MMA(0, 0, At, B0); PG8_BAR; PG8_SCHED;
            PG8_LDB(B1, 0, 1); PG8_STAGE(PG8_SB(0, 0), b2, voffB);
            PG8_BAR; PG8_WAIT_L(0); PG8_MMA(0, 1, At, B1); PG8_BAR;
            PG8_LDA(At, 0, 1); PG8_STAGE(PG8_SA(0, 0), a2, voffA);
            PG8_BAR; PG8_WAIT_L(0); PG8_MMA(1, 0, At, B0); PG8_BAR; PG8_SCHED;
            PG8_STAGE(PG8_SB(0, 1), b2 + hstep, voffB);
            PG8_WAIT_V(6); PG8_BAR; PG8_MMA(1, 1, At, B1); PG8_BAR;
            PG8_LDB(B0, 1, 0); PG8_SCHED; PG8_LDA(At, 1, 0); PG8_STAGE(PG8_SA(0, 1), a2 + hstep, voffA);
            PG8_WAIT_L(8); PG8_BAR; PG8_WAIT_L(0); PG8_MMA(0, 0, At, B0); PG8_BAR; PG8_SCHED;
            PG8_LDB(B1, 1, 1); PG8_STAGE(PG8_SB(1, 0), b3, voffB);
            PG8_BAR; PG8_WAIT_L(0); PG8_MMA(0, 1, At, B1); PG8_BAR;
            PG8_LDA(At, 1, 1); PG8_STAGE(PG8_SA(1, 0), a3, voffA);
            PG8_BAR; PG8_WAIT_L(0); PG8_MMA(1, 0, At, B0); PG8_BAR; PG8_SCHED;
            PG8_STAGE(PG8_SB(1, 1), b3 + hstep, voffB);
            PG8_WAIT_V(6); PG8_BAR; PG8_MMA(1, 1, At, B1); PG8_BAR;
            }
        }
        if constexpr (ALIGN_EPI) { if (wr == 0) PG8_BAR; }
        if constexpr (!Epi::AFTER_DRAIN) { E(acc, cur, wr, wc, fr, fq); S.done(cur); }
        if (!has_next) break;
#pragma unroll
        for (int a = 0; a < 2; ++a)
#pragma unroll
            for (int b = 0; b < 2; ++b)
#pragma unroll
                for (int m = 0; m < 4; ++m)
#pragma unroll
                    for (int n = 0; n < 2; ++n) acc[a][b][m][n] = (f32x4){0.f, 0.f, 0.f, 0.f};
        cur = nxt; cA = nA; cB = nB; ++ui;
        if constexpr (ALIGN_EPI) { if (wr == 1) PG8_BAR; }
    }
    PG8_WAIT_V(0);
    if constexpr (!ALIGN_EPI) { if (wr == 0) PG8_BAR; }
    PG8_BAR;
    if constexpr (Epi::AFTER_DRAIN) { E.fused(acc, cur, wr, wc, fr, fq, lds, wid, lane); S.done(cur); }
#undef PG8_SA
#undef PG8_SB
#undef PG8_STAGE
#undef PG8_LDA
#undef PG8_LDB
#undef PG8_MMA
#undef PG8_WAIT_V
#undef PG8_WAIT_L
#undef PG8_BAR
#undef PG8_SCHED
}
template <class Epi, class Sched, bool ALIGN_EPI = false, bool SP2 = false>
__device__ __forceinline__ void gemm_phase_i8(PG8_LAS unsigned char* lds, const Gemm g, const Sched& S, const Epi& E) {
    const int tid = threadIdx.x, wid = __builtin_amdgcn_readfirstlane(tid >> 6), lane = tid & 63, wr = wid >> 2, wc = wid & 3, fr = lane & 15, fq = lane >> 4;
    const int K = g.K, nt = K / BK;
    unsigned voffA[2], voffB[2];
#pragma unroll
    for (int i = 0; i < 2; ++i) { int R, C; stage_rc(tid * 16 + i * 8192, R, C); const int Rb = Epi::PERM ? ((R & ~31) + perm32(R & 31)) : R;
        voffA[i] = (unsigned)(R * K + C) * 2u; voffB[i] = (unsigned)(Rb * K + C) * 2u; }
    const size_t kstep = (size_t)(BK * 2);
    const size_t hstep = (size_t)HALF * K * 2;
    const size_t tstep = 2 * hstep;
    const unsigned ldsw = (unsigned)wid * 1024u;
    const int aoff = lds_byte(wr * 64 + fr, fq * 8), boff = lds_byte(wc * 32 + fr, fq * 8);
#define PG8_SA(b, h) (((b) * 2 + (h)) * HTB)
#define PG8_SB(b, h) ((4 + (b) * 2 + (h)) * HTB)
#define PG8_STAGE(bufoff, gbase, voff) do { _Pragma("unroll") for (int _i = 0; _i < 2; ++_i) \
        __builtin_amdgcn_global_load_lds((const unsigned*)((const char*)(gbase) + (voff)[_i]), (PG8_LAS unsigned*)(lds + (bufoff) + ldsw + _i * 8192), 16, 0, 0); } while (0)
#define PG8_LDA(dst, b, h) do { _Pragma("unroll") for (int m = 0; m < 4; ++m) _Pragma("unroll") for (int k = 0; k < 2; ++k) dst[m][k] = *(const PG8_LAS bf16x8*)(lds + PG8_SA(b, h) + aoff + m * 2048 + k * 1024); } while (0)
#define PG8_LDB(dst, b, h) do { _Pragma("unroll") for (int n = 0; n < 2; ++n) _Pragma("unroll") for (int k = 0; k < 2; ++k) dst[n][k] = *(const PG8_LAS bf16x8*)(lds + PG8_SB(b, h) + boff + n * 2048 + k * 1024); } while (0)
#define PG8_MMA(ai, bj, At, Bt) do { __builtin_amdgcn_s_setprio(1); _Pragma("unroll") for (int m = 0; m < 4; ++m) _Pragma("unroll") for (int n = 0; n < 2; ++n) _Pragma("unroll") for (int k = 0; k < 2; ++k) \
        acc[ai][bj][m][n] = __builtin_amdgcn_mfma_i32_16x16x64_i8(__builtin_bit_cast(i32x4, Bt[n][k]), __builtin_bit_cast(i32x4, At[m][k]), acc[ai][bj][m][n], 0, 0, 0); __builtin_amdgcn_s_setprio(0); } while (0)
#define PG8_WAIT_V(n) asm volatile("s_waitcnt vmcnt(" #n ")" ::: "memory")
#define PG8_WAIT_L(n) asm volatile("s_waitcnt lgkmcnt(" #n ")" ::: "memory")
#define PG8_BAR __builtin_amdgcn_s_barrier()
#define PG8_SCHED __builtin_amdgcn_sched_barrier(0)
    Unit cur, nxt; int ui = 0;
    if (!S.next(0, cur)) return;
    i32x4 acc[2][2][4][2];
#pragma unroll
    for (int a = 0; a < 2; ++a)
#pragma unroll
        for (int b = 0; b < 2; ++b)
#pragma unroll
            for (int m = 0; m < 4; ++m)
#pragma unroll
                for (int n = 0; n < 2; ++n) acc[a][b][m][n] = (i32x4){0, 0, 0, 0};
    bf16x8 At[4][2], B0[2][2], B1[2][2];
    const char* cA = (const char*)g.A + (size_t)cur.pm * tstep; const char* cB = (const char*)g.Bt + (size_t)cur.pn * tstep;
    S.a_ready(cur);
    if constexpr (SP2) {
        PG8_STAGE(PG8_SB(0, 0), cB, voffB); PG8_STAGE(PG8_SB(0, 1), cB + hstep, voffB); PG8_STAGE(PG8_SA(0, 0), cA, voffA); PG8_STAGE(PG8_SA(0, 1), cA + hstep, voffA);
        if (wr == 1) PG8_BAR;
        PG8_WAIT_V(2); PG8_BAR;
        PG8_STAGE(PG8_SB(1, 0), cB + kstep, voffB); PG8_STAGE(PG8_SA(1, 0), cA + kstep, voffA); PG8_STAGE(PG8_SB(1, 1), cB + hstep + kstep, voffB);
        PG8_WAIT_V(6); PG8_BAR;
    } else {
        PG8_STAGE(PG8_SB(0, 0), cB, voffB); PG8_STAGE(PG8_SA(0, 0), cA, voffA); PG8_STAGE(PG8_SB(0, 1), cB + hstep, voffB); PG8_STAGE(PG8_SA(0, 1), cA + hstep, voffA);
        if (wr == 1) PG8_BAR;
        PG8_WAIT_V(4); PG8_BAR;
        PG8_STAGE(PG8_SB(1, 0), cB + kstep, voffB); PG8_STAGE(PG8_SA(1, 0), cA + kstep, voffA); PG8_STAGE(PG8_SB(1, 1), cB + hstep + kstep, voffB);
        PG8_WAIT_V(6); PG8_BAR;
    }
    for (;;) {
        const bool has_next = S.next(ui + 1, nxt);
        const char* nA = has_next ? (const char*)g.A + (size_t)nxt.pm * tstep : cA; const char* nB = has_next ? (const char*)g.Bt + (size_t)nxt.pn * tstep : cB;
        for (int t = 0; t < nt; t += 2) {
            const bool last = (t == nt - 2);
            const char* a1 = cA + (size_t)(t + 1) * kstep;
            const char* a2 = last ? nA : cA + (size_t)(t + 2) * kstep; const char* b2 = last ? nB : cB + (size_t)(t + 2) * kstep;
            const char* a3 = a2 + kstep; const char* b3 = b2 + kstep;
            if (last && has_next) S.a_ready(nxt);
            if constexpr (SP2) {
            PG8_LDB(B0, 0, 0); PG8_LDB(B1, 0, 1); PG8_SCHED; PG8_LDA(At, 0, 0); PG8_STAGE(PG8_SA(1, 1), a1 + hstep, voffA);
            PG8_WAIT_V(8); PG8_WAIT_L(0); PG8_BAR; PG8_MMA(0, 0, At, B0); PG8_MMA(0, 1, At, B1); PG8_BAR; PG8_SCHED;
            PG8_LDA(At, 0, 1); PG8_STAGE(PG8_SB(0, 0), b2, voffB); PG8_STAGE(PG8_SB(0, 1), b2 + hstep, voffB); PG8_STAGE(PG8_SA(0, 0), a2, voffA);
            PG8_WAIT_V(8); PG8_WAIT_L(0); PG8_BAR; PG8_MMA(1, 0, At, B0); PG8_MMA(1, 1, At, B1); PG8_BAR; PG8_SCHED;
            PG8_LDB(B0, 1, 0); PG8_LDB(B1, 1, 1); PG8_SCHED; PG8_LDA(At, 1, 0); PG8_STAGE(PG8_SA(0, 1), a2 + hstep, voffA);
            PG8_WAIT_V(8); PG8_WAIT_L(0); PG8_BAR; PG8_MMA(0, 0, At, B0); PG8_MMA(0, 1, At, B1); PG8_BAR; PG8_SCHED;
            PG8_LDA(At, 1, 1); PG8_STAGE(PG8_SB(1, 0), b3, voffB); PG8_STAGE(PG8_SB(1, 1), b3 + hstep, voffB); PG8_STAGE(PG8_SA(1, 0), a3, voffA);
            PG8_WAIT_V(8); PG8_WAIT_L(0); PG8_BAR; PG8_MMA(1, 0, At, B0); PG8_MMA(1, 1, At, B1); PG8_BAR; PG8_SCHED;
            } else {
            PG8_LDB(B0, 0, 0); PG8_SCHED; PG8_LDA(At, 0, 0); PG8_STAGE(PG8_SA(1, 1), a1 + hstep, voffA);
            PG8_WAIT_L(8); PG8_BAR; PG8_WAIT_L(0); PG8_MMA(0, 0, At, B0); PG8_BAR; PG8_SCHED;
            PG8_LDB(B1, 0, 1); PG8_STAGE(PG8_SB(0, 0), b2, voffB);
            PG8_BAR; PG8_WAIT_L(0); PG8_MMA(0, 1, At, B1); PG8_BAR;
            PG8_LDA(At, 0, 1); PG8_STAGE(PG8_SA(0, 0), a2, voffA);
            PG8_BAR; PG8_WAIT_L(0); PG8_MMA(1, 0, At, B0); PG8_BAR; PG8_SCHED;
            PG8_STAGE(PG8_SB(0, 1), b2 + hstep, voffB);
            PG8_WAIT_V(6); PG8_BAR; PG8_MMA(1, 1, At, B1); PG8_BAR;
            PG8_LDB(B0, 1, 0); PG8_SCHED; PG8_LDA(At, 1, 0); PG8_STAGE(PG8_SA(0, 1), a2 + hstep, voffA);
            PG8_WAIT_L(8); PG8_BAR; PG8_WAIT_L(0); PG8_MMA(0, 0, At, B0); PG8_BAR; PG8_SCHED;
            PG8_LDB(B1, 1, 1); PG8_STAGE(PG8_SB(1, 0), b3, voffB);
            PG8_BAR; PG8_WAIT_L(0); PG8_MMA(0, 1, At, B1); PG8_BAR;
            PG8_LDA(At, 1, 1); PG8_STAGE(PG8_SA(1, 0), a3, voffA);
            PG8_BAR; PG8_WAIT_L(0); PG8_MMA(1, 0, At, B0); PG8_BAR; PG8_SCHED;
            PG8_STAGE(PG8_SB(1, 1), b3 + hstep, voffB);
            PG8_WAIT_V(6); PG8_BAR; PG8_MMA(1, 1, At, B1); PG8_BAR;
            }
        }
        if constexpr (ALIGN_EPI) { if (wr == 0) PG8_BAR; }
        if constexpr (!Epi::AFTER_DRAIN) { E(acc, cur, wr, wc, fr, fq); S.done(cur); }
        if (!has_next) break;
#pragma unroll
        for (int a = 0; a < 2; ++a)
#pragma unroll
            for (int b = 0; b < 2; ++b)
#pragma unroll
                for (int m = 0; m < 4; ++m)
#pragma unroll
                    for (int n = 0; n < 2; ++n) acc[a][b][m][n] = (i32x4){0, 0, 0, 0};
        cur = nxt; cA = nA; cB = nB; ++ui;
        if constexpr (ALIGN_EPI) { if (wr == 1) PG8_BAR; }
    }
    PG8_WAIT_V(0);
    if constexpr (!ALIGN_EPI) { if (wr == 0) PG8_BAR; }
    PG8_BAR;
    if constexpr (Epi::AFTER_DRAIN) { E.fused(acc, cur, wr, wc, fr, fq, lds, wid, lane); S.done(cur); }
#undef PG8_SA
#undef PG8_SB
#undef PG8_STAGE
#undef PG8_LDA
#undef PG8_LDB
#undef PG8_MMA
#undef PG8_WAIT_V
#undef PG8_WAIT_L
#undef PG8_BAR
#undef PG8_SCHED
}
}

#define LAS __attribute__((address_space(3)))
typedef unsigned short bf16;
typedef float f32x2 __attribute__((ext_vector_type(2)));
typedef float f32x4 __attribute__((ext_vector_type(4)));
typedef unsigned u32x2 __attribute__((ext_vector_type(2)));
typedef unsigned u32x4 __attribute__((ext_vector_type(4)));

constexpr int PDIM = 1536;
constexpr int NTOK = 32768, DM = 1024, DIN = 2560, SEQ = 8192, NBATCH = 4, NMETA = 16;
constexpr int NHEAD = 8, NKEYS = 128, TOPK = 16, NSEL = NHEAD * TOPK;
constexpr float EPS = 1e-6f;
constexpr float U_SCALE = 64.f, V_SCALE = 16.f;
constexpr float U4_CLIP = 2.6f;
constexpr int NWAVES = 8, NTHREADS = 512;
constexpr int MKC = 32;
constexpr int LDS_BYTES = 147456;

constexpr size_t MiB = 1u << 20;
constexpr size_t WS_CTL = 0, WS_WIN_T = 1 * MiB, WS_WOUT_T = 6 * MiB, WS_WQ_T = 8 * MiB, WS_KEYS = 12 * MiB, WS_METAPART = 160 * MiB  ,
                 WS_METARSTD = 14 * MiB + 512 * 1024, WS_METAPROJ = 14 * MiB + 576 * 1024, WS_RSTD1 = 15 * MiB, WS_SSQ = 16 * MiB, WS_U8 = 32 * MiB, WS_V8 = 48 * MiB,
                 WS_IDX = 64 * MiB, WS_GATE = 80 * MiB, WS_H0B = 96 * MiB, WS_H2B = 96 * MiB, WS_Y = 160 * MiB, WS_PROJ = 224 * MiB,
                 WS_Q = 224 * MiB, WS_ESCALE = 18 * MiB, WS_SUMQ = 19 * MiB, WS_SX = 20 * MiB, WS_SW = 21 * MiB, WS_SY = 22 * MiB, WS_SWO = 23 * MiB, WS_WMX = 24 * MiB, WS_H0I8 = 384 * MiB, WS_AW = 160 * MiB  , WS_END = 416 * MiB;

struct Params {
    const float* x; const float* meta; const float* g_mix; const float* w_in; const float* sc_w; const float* cf_w; const float* cf_b;
    const float* ln_g; const float* ln_b; const float* g_sc; const float* g_cf; const float* w_out; const float* g_ffn; const float* w_q;
    const float* keys; const float* pu; const float* pv; const float* g_fin;
    float* out; unsigned char* ws;
    int ph_lo, ph_hi, coop, pad;
};

__device__ __forceinline__ unsigned f2bf(float f) { unsigned u = __builtin_bit_cast(unsigned, f); return (u + 0x7fffu + ((u >> 16) & 1u)) >> 16; }
__device__ __forceinline__ unsigned pk2(float lo, float hi) { return f2bf(lo) | (f2bf(hi) << 16); }
__device__ __forceinline__ float bf2f(unsigned b) { return __builtin_bit_cast(float, b << 16); }
__device__ __forceinline__ float bflo(unsigned w) { return __builtin_bit_cast(float, w << 16); }
__device__ __forceinline__ float bfhi(unsigned w) { return __builtin_bit_cast(float, w & 0xffff0000u); }
__device__ __forceinline__ float wave_sum(float v) {
#pragma unroll
    for (int o = 1; o < 64; o <<= 1) v += __shfl_xor(v, o);
    return v;
}
template <int CTRL> __device__ __forceinline__ float dpp_f(float v) { return __builtin_bit_cast(float, __builtin_amdgcn_update_dpp(0, __builtin_bit_cast(int, v), CTRL, 0xf, 0xf, true)); }
__device__ __forceinline__ float wave_sum_fast(float v) {
    v += dpp_f<0xB1>(v); v += dpp_f<0x4E>(v); v += dpp_f<0x141>(v); v += dpp_f<0x140>(v);
    { auto r = __builtin_amdgcn_permlane16_swap(__float_as_uint(v), __float_as_uint(v), false, false); v = __uint_as_float(r[0]) + __uint_as_float(r[1]); }
    { auto r = __builtin_amdgcn_permlane32_swap(__float_as_uint(v), __float_as_uint(v), false, false); v = __uint_as_float(r[0]) + __uint_as_float(r[1]); }
    return v;
}
__device__ __forceinline__ float wave_max_fast(float v) {
    v = fmaxf(v, dpp_f<0xB1>(v)); v = fmaxf(v, dpp_f<0x4E>(v)); v = fmaxf(v, dpp_f<0x141>(v)); v = fmaxf(v, dpp_f<0x140>(v));
    { auto r = __builtin_amdgcn_permlane16_swap(__float_as_uint(v), __float_as_uint(v), false, false); v = fmaxf(__uint_as_float(r[0]), __uint_as_float(r[1])); }
    { auto r = __builtin_amdgcn_permlane32_swap(__float_as_uint(v), __float_as_uint(v), false, false); v = fmaxf(__uint_as_float(r[0]), __uint_as_float(r[1])); }
    return v;
}
__device__ __forceinline__ float sigmoid_f(float x) { return 1.f / (1.f + __expf(-x)); }
__device__ __forceinline__ float gelu_tanh_f(float x) {
    const float t = 0.7978845608028654f * (x + 0.044715f * x * x * x);
    const float e = __expf(2.f * t);
    const float th = 1.f - 2.f / (e + 1.f);
    return 0.5f * x * (1.f + th);
}

__device__ __forceinline__ unsigned cvt_pk_bf16(float lo, float hi) { unsigned r; asm volatile("v_cvt_pk_bf16_f32 %0, %1, %2" : "=v"(r) : "v"(lo), "v"(hi)); return r; }

template <int MODE> struct EpiRowScale {
    static constexpr bool PERM = true, AFTER_DRAIN = false;
    bf16* O; int ldc; const float* rs;
    __device__ __forceinline__ void operator()(const pg8::f32x4 (&acc)[2][2][4][2], const pg8::Unit& u, int wr, int wc, int fr, int fq) const {
        const int row0 = u.pm * 256 + wr * 64 + fr, col0 = u.pn * 256 + wc * 32 + 8 * fq;
#pragma unroll
        for (int ai = 0; ai < 2; ++ai)
#pragma unroll
            for (int m = 0; m < 4; ++m) {
                const int row = row0 + ai * 128 + m * 16;
                float s;
                if (MODE == 0) s = rs[row];
                else { const f32x4* p = (const f32x4*)(rs + (size_t)row * 16); const f32x4 a = p[0], b = p[1], c = p[2], d = p[3];
                       const float t = ((a.x + a.y) + (a.z + a.w)) + ((b.x + b.y) + (b.z + b.w)) + ((c.x + c.y) + (c.z + c.w)) + ((d.x + d.y) + (d.z + d.w));
                       s = rsqrtf(t * (1.f / 1024.f) + EPS); }
                bf16* rowp = O + (size_t)row * ldc + col0;
#pragma unroll
                for (int bj = 0; bj < 2; ++bj) { const pg8::f32x4 v0 = acc[ai][bj][m][0] * s, v1 = acc[ai][bj][m][1] * s;
                    u32x4 w; w.x = cvt_pk_bf16(v0[0], v0[1]); w.y = cvt_pk_bf16(v0[2], v0[3]); w.z = cvt_pk_bf16(v1[0], v1[1]); w.w = cvt_pk_bf16(v1[2], v1[3]);
                    *(u32x4*)(rowp + bj * 128) = w; }
            }
    }
};
struct EpiProj {
    static constexpr bool PERM = true, AFTER_DRAIN = false;
    bf16* O; const float* rs;
    __device__ __forceinline__ void operator()(const pg8::f32x4 (&acc)[2][2][4][2], const pg8::Unit& u, int wr, int wc, int fr, int fq) const {
        const int row0 = u.pm * 256 + wr * 64 + fr, cin = wc * 32 + 8 * fq, pn = u.pn;
#pragma unroll
        for (int ai = 0; ai < 2; ++ai)
#pragma unroll
            for (int m = 0; m < 4; ++m) {
                const int row = row0 + ai * 128 + m * 16; const float sc = rs[row];
                float a[8], b[8];
#pragma unroll
                for (int i = 0; i < 4; ++i) { a[i] = acc[ai][0][m][0][i] * sc; a[4 + i] = acc[ai][0][m][1][i] * sc; b[i] = acc[ai][1][m][0][i] * sc; b[4 + i] = acc[ai][1][m][1][i] * sc; }
                bf16* rowp = O + (size_t)row * PDIM;
                if (pn >= 4 && pn < 6) {
                    u32x4 w0, w1; w0.x = cvt_pk_bf16(a[0], a[1]); w0.y = cvt_pk_bf16(a[2], a[3]); w0.z = cvt_pk_bf16(a[4], a[5]); w0.w = cvt_pk_bf16(a[6], a[7]);
                    w1.x = cvt_pk_bf16(b[0], b[1]); w1.y = cvt_pk_bf16(b[2], b[3]); w1.z = cvt_pk_bf16(b[4], b[5]); w1.w = cvt_pk_bf16(b[6], b[7]);
                    *(u32x4*)(rowp + 512 + 256 * (pn - 4) + cin) = w0; *(u32x4*)(rowp + 512 + 256 * (pn - 4) + 128 + cin) = w1;
                } else {
                    float o[8];
                    if (pn < 4) {
#pragma unroll
                        for (int i = 0; i < 8; ++i) o[i] = a[i] * b[i];
                    } else {
#pragma unroll
                        for (int i = 0; i < 8; ++i) o[i] = a[i] * sigmoid_f(b[i]);
                    }
                    u32x4 w; w.x = cvt_pk_bf16(o[0], o[1]); w.y = cvt_pk_bf16(o[2], o[3]); w.z = cvt_pk_bf16(o[4], o[5]); w.w = cvt_pk_bf16(o[6], o[7]);
                    *(u32x4*)(rowp + (pn < 4 ? 128 * pn : 1024 + 128 * (pn - 6)) + cin) = w;
                }
            }
    }
};
struct EpiProjI8 {
    static constexpr bool PERM = true, AFTER_DRAIN = false;
    bf16* O; const float* rs; const float* sw;
    __device__ __forceinline__ void operator()(const pg8::i32x4 (&acc)[2][2][4][2], const pg8::Unit& u, int wr, int wc, int fr, int fq) const {
        const int row0 = u.pm * 256 + wr * 64 + fr, cin = wc * 32 + 8 * fq, pn = u.pn;
        float swa[8], swb[8];
        { const f32x4 a0 = *(const f32x4*)(sw + 256 * pn + cin), a1 = *(const f32x4*)(sw + 256 * pn + cin + 4), b0 = *(const f32x4*)(sw + 256 * pn + 128 + cin), b1 = *(const f32x4*)(sw + 256 * pn + 128 + cin + 4);
          swa[0] = a0.x; swa[1] = a0.y; swa[2] = a0.z; swa[3] = a0.w; swa[4] = a1.x; swa[5] = a1.y; swa[6] = a1.z; swa[7] = a1.w;
          swb[0] = b0.x; swb[1] = b0.y; swb[2] = b0.z; swb[3] = b0.w; swb[4] = b1.x; swb[5] = b1.y; swb[6] = b1.z; swb[7] = b1.w; }
#pragma unroll
        for (int ai = 0; ai < 2; ++ai)
#pragma unroll
            for (int m = 0; m < 4; ++m) {
                const int row = row0 + ai * 128 + m * 16; const float sc = rs[row];
                float a[8], b[8];
#pragma unroll
                for (int i = 0; i < 4; ++i) { a[i] = (float)acc[ai][0][m][0][i] * (sc * swa[i]); a[4 + i] = (float)acc[ai][0][m][1][i] * (sc * swa[4 + i]);
                    b[i] = (float)acc[ai][1][m][0][i] * (sc * swb[i]); b[4 + i] = (float)acc[ai][1][m][1][i] * (sc * swb[4 + i]); }
                bf16* rowp = O + (size_t)row * PDIM;
                if (pn >= 4 && pn < 6) {
                    u32x4 w0, w1; w0.x = cvt_pk_bf16(a[0], a[1]); w0.y = cvt_pk_bf16(a[2], a[3]); w0.z = cvt_pk_bf16(a[4], a[5]); w0.w = cvt_pk_bf16(a[6], a[7]);
                    w1.x = cvt_pk_bf16(b[0], b[1]); w1.y = cvt_pk_bf16(b[2], b[3]); w1.z = cvt_pk_bf16(b[4], b[5]); w1.w = cvt_pk_bf16(b[6], b[7]);
                    *(u32x4*)(rowp + 512 + 256 * (pn - 4) + cin) = w0; *(u32x4*)(rowp + 512 + 256 * (pn - 4) + 128 + cin) = w1;
                } else {
                    float o[8];
                    if (pn < 4) {
#pragma unroll
                        for (int i = 0; i < 8; ++i) o[i] = a[i] * b[i];
                    } else {
#pragma unroll
                        for (int i = 0; i < 8; ++i) o[i] = a[i] * sigmoid_f(b[i]);
                    }
                    u32x4 w; w.x = cvt_pk_bf16(o[0], o[1]); w.y = cvt_pk_bf16(o[2], o[3]); w.z = cvt_pk_bf16(o[4], o[5]); w.w = cvt_pk_bf16(o[6], o[7]);
                    *(u32x4*)(rowp + (pn < 4 ? 128 * pn : 1024 + 128 * (pn - 6)) + cin) = w;
                }
            }
    }
};
__host__ __device__ __forceinline__ int win_src_col(int n) {
    const int t = n >> 8, j = n & 255;
    if (t < 4) return (j < 128) ? 128 * t + j : 1024 + 128 * t + (j - 128);
    if (t < 6) return 512 + 256 * (t - 4) + j;
    return (j < 128) ? 1536 + 128 * (t - 6) + j : 2048 + 128 * (t - 6) + (j - 128);
}
struct EpiResidual {
    static constexpr bool PERM = true, AFTER_DRAIN = false;
    bf16* O; const signed char* XB; const float* SX; float* ssq;
    __device__ __forceinline__ void operator()(const pg8::f32x4 (&acc)[2][2][4][2], const pg8::Unit& u, int wr, int wc, int fr, int fq) const {
        const int row0 = u.pm * 256 + wr * 64 + fr, col0 = u.pn * 256 + wc * 32 + 8 * fq;
#pragma unroll
        for (int ai = 0; ai < 2; ++ai)
#pragma unroll
            for (int m = 0; m < 4; ++m) {
                const int row = row0 + ai * 128 + m * 16;
                const signed char* xr = XB + (size_t)row * DM + col0; bf16* rowp = O + (size_t)row * DM + col0;
                float q = 0.f;
                u32x2 xw[2]; const float sxr = SX[row];
#pragma unroll
                for (int bj = 0; bj < 2; ++bj) xw[bj] = *(const u32x2*)(xr + bj * 128);
#pragma unroll
                for (int bj = 0; bj < 2; ++bj) {
                    const f32x4 x0 = (f32x4){(float)(signed char)(xw[bj].x), (float)(signed char)(xw[bj].x >> 8), (float)(signed char)(xw[bj].x >> 16), (float)((int)xw[bj].x >> 24)} * sxr,
                                x1 = (f32x4){(float)(signed char)(xw[bj].y), (float)(signed char)(xw[bj].y >> 8), (float)(signed char)(xw[bj].y >> 16), (float)((int)xw[bj].y >> 24)} * sxr;
                    const pg8::f32x4 v0 = acc[ai][bj][m][0] + x0, v1 = acc[ai][bj][m][1] + x1;
                    q += (v0[0] * v0[0] + v0[1] * v0[1]) + (v0[2] * v0[2] + v0[3] * v0[3]) + (v1[0] * v1[0] + v1[1] * v1[1]) + (v1[2] * v1[2] + v1[3] * v1[3]);
                    u32x4 w; w.x = cvt_pk_bf16(v0[0], v0[1]); w.y = cvt_pk_bf16(v0[2], v0[3]); w.z = cvt_pk_bf16(v1[0], v1[1]); w.w = cvt_pk_bf16(v1[2], v1[3]);
                    *(u32x4*)(rowp + bj * 128) = w; }
                q += __shfl_xor(q, 16); q += __shfl_xor(q, 32);
                if (fq == 0) ssq[(size_t)row * 16 + u.pn * 4 + wc] = q;
            }
    }
};

struct EpiResidualI8 {
    static constexpr bool PERM = true, AFTER_DRAIN = false;
    bf16* O; const signed char* XB; const float* SX; const float* SY; const float* SWO; float* ssq;
    __device__ __forceinline__ void operator()(const pg8::i32x4 (&acc)[2][2][4][2], const pg8::Unit& u, int wr, int wc, int fr, int fq) const {
        const int row0 = u.pm * 256 + wr * 64 + fr, col0 = u.pn * 256 + wc * 32 + 8 * fq;
        f32x4 sw[2][2];
#pragma unroll
        for (int bj = 0; bj < 2; ++bj) { sw[bj][0] = *(const f32x4*)(SWO + col0 + bj * 128); sw[bj][1] = *(const f32x4*)(SWO + col0 + bj * 128 + 4); }
#pragma unroll
        for (int ai = 0; ai < 2; ++ai)
#pragma unroll
            for (int m = 0; m < 4; ++m) {
                const int row = row0 + ai * 128 + m * 16;
                const signed char* xr = XB + (size_t)row * DM + col0; bf16* rowp = O + (size_t)row * DM + col0;
                float q = 0.f;
                u32x2 xw[2]; const float sxr = SX[row], syr = SY[row];
#pragma unroll
                for (int bj = 0; bj < 2; ++bj) xw[bj] = *(const u32x2*)(xr + bj * 128);
#pragma unroll
                for (int bj = 0; bj < 2; ++bj) {
                    const f32x4 x0 = (f32x4){(float)(signed char)(xw[bj].x), (float)(signed char)(xw[bj].x >> 8), (float)(signed char)(xw[bj].x >> 16), (float)((int)xw[bj].x >> 24)} * sxr,
                                x1 = (f32x4){(float)(signed char)(xw[bj].y), (float)(signed char)(xw[bj].y >> 8), (float)(signed char)(xw[bj].y >> 16), (float)((int)xw[bj].y >> 24)} * sxr;
                    const pg8::i32x4 a0 = acc[ai][bj][m][0], a1 = acc[ai][bj][m][1];
                    const f32x4 v0 = (f32x4){(float)a0[0], (float)a0[1], (float)a0[2], (float)a0[3]} * (sw[bj][0] * syr) + x0, v1 = (f32x4){(float)a1[0], (float)a1[1], (float)a1[2], (float)a1[3]} * (sw[bj][1] * syr) + x1;
                    q += (v0[0] * v0[0] + v0[1] * v0[1]) + (v0[2] * v0[2] + v0[3] * v0[3]) + (v1[0] * v1[0] + v1[1] * v1[1]) + (v1[2] * v1[2] + v1[3] * v1[3]);
                    u32x4 w; w.x = cvt_pk_bf16(v0[0], v0[1]); w.y = cvt_pk_bf16(v0[2], v0[3]); w.z = cvt_pk_bf16(v1[0], v1[1]); w.w = cvt_pk_bf16(v1[2], v1[3]);
                    *(u32x4*)(rowp + bj * 128) = w; }
                q += __shfl_xor(q, 16); q += __shfl_xor(q, 32);
                if (fq == 0) ssq[(size_t)row * 16 + u.pn * 4 + wc] = q;
            }
    }
};
template <bool MAPIN> __device__ __forceinline__ void p0_transpose_item(const float* W, int K, int N, bf16* WT, LAS float* scr, int item, int lane,
                                                  const float* g_lo, const float* g_hi, int split) {
    const int nblk = N / 32, kb = item / nblk, nb = item % nblk, k0 = 64 * kb, n0 = 32 * nb;
#pragma unroll 8
    for (int i = 0; i < 32; ++i) { const int kk = 2 * i + (lane >> 5); const int k = k0 + kk;
        const float g = (k < split) ? g_lo[k] : g_hi[k - split];
        scr[kk * 33 + (lane & 31)] = W[(size_t)k * N + (MAPIN ? win_src_col(n0) : n0) + (lane & 31)] * g; }
    asm volatile("s_waitcnt lgkmcnt(0)" ::: "memory");
    const int c = lane & 7;
#pragma unroll
    for (int j = 0; j < 4; ++j) { const int n = (lane >> 3) + 8 * j; const LAS float* s = scr + (8 * c) * 33 + n;
        u32x4 o; o.x = pk2(s[0 * 33], s[1 * 33]); o.y = pk2(s[2 * 33], s[3 * 33]); o.z = pk2(s[4 * 33], s[5 * 33]); o.w = pk2(s[6 * 33], s[7 * 33]);
        *(u32x4*)(WT + (size_t)(n0 + n) * K + k0 + 8 * c) = o; }
    asm volatile("s_waitcnt lgkmcnt(0)" ::: "memory");
}

constexpr int CW_COLMAX = 5120;
__device__ __forceinline__ void p0_colmax_item(const float* W, int N, unsigned* colmax, int item, int lane, const float* g) {
    const int nblk = N / 32, kb = item / nblk, nb = item % nblk, k0 = 64 * kb, n0 = 32 * nb;
    float mx = 0.f;
#pragma unroll
    for (int i = 0; i < 32; ++i) { const int k = k0 + 2 * i + (lane >> 5); mx = fmaxf(mx, fabsf(W[(size_t)k * N + n0 + (lane & 31)] * g[k])); }
    mx = fmaxf(mx, __shfl_xor(mx, 32));
    if (lane < 32) atomicMax(colmax + n0 + lane, __float_as_uint(mx));
}
__device__ __forceinline__ void p1_quant_item(const float* W, int K, int N, signed char* WT8, float* swout, const unsigned* colmax, LAS float* scr, int item, int lane, const float* g) {
    const int nblk = N / 32, kb = item / nblk, nb = item % nblk, k0 = 64 * kb, n0 = 32 * nb, s0 = win_src_col(n0);
    const float cm = fmaxf(__uint_as_float(colmax[s0 + (lane & 31)]), 1e-30f), inv = 127.f / cm;
    if (kb == 0 && lane < 32) swout[n0 + lane] = cm * (1.f / 127.f);
#pragma unroll
    for (int i = 0; i < 32; ++i) { const int kk = 2 * i + (lane >> 5); const int k = k0 + kk;
        scr[kk * 33 + (lane & 31)] = W[(size_t)k * N + s0 + (lane & 31)] * g[k] * inv; }
    asm volatile("s_waitcnt lgkmcnt(0)" ::: "memory");
    const int c = lane & 7;
#pragma unroll
    for (int j = 0; j < 4; ++j) { const int n = (lane >> 3) + 8 * j; const LAS float* sp = scr + (8 * c) * 33 + n;
        unsigned w0 = 0u, w1 = 0u;
#pragma unroll
        for (int i = 0; i < 4; ++i) { w0 |= ((unsigned)(int)rintf(sp[i * 33]) & 255u) << (8 * i); w1 |= ((unsigned)(int)rintf(sp[(4 + i) * 33]) & 255u) << (8 * i); }
        u32x2 o; o.x = w0; o.y = w1;
        *(u32x2*)(WT8 + (size_t)(n0 + n) * K + k0 + 8 * c) = o; }
    asm volatile("s_waitcnt lgkmcnt(0)" ::: "memory");
}
constexpr int CW_COLMAX2 = 7680;
__device__ __forceinline__ void p0_colmax_item2(const float* W, int N, unsigned* colmax, int item, int lane, const float* g_lo, const float* g_hi, int split) {
    const int nblk = N / 32, kb = item / nblk, nb = item % nblk, k0 = 64 * kb, n0 = 32 * nb;
    float mx = 0.f;
#pragma unroll
    for (int i = 0; i < 32; ++i) { const int k = k0 + 2 * i + (lane >> 5); const float g = (k < split) ? g_lo[k] : g_hi[k - split]; mx = fmaxf(mx, fabsf(W[(size_t)k * N + n0 + (lane & 31)] * g)); }
    mx = fmaxf(mx, __shfl_xor(mx, 32));
    if (lane < 32) atomicMax(colmax + n0 + lane, __float_as_uint(mx));
}
__device__ __forceinline__ void p1_quant_item2(const float* W, int K, int N, signed char* WT8, float* swout, const unsigned* colmax, LAS float* scr, int item, int lane, const float* g_lo, const float* g_hi, int split) {
    const int nblk = N / 32, kb = item / nblk, nb = item % nblk, k0 = 64 * kb, n0 = 32 * nb;
    const float cm = fmaxf(__uint_as_float(colmax[n0 + (lane & 31)]), 1e-30f), inv = 127.f / cm;
    if (kb == 0 && lane < 32) swout[n0 + lane] = cm * (1.f / 127.f);
#pragma unroll
    for (int i = 0; i < 32; ++i) { const int kk = 2 * i + (lane >> 5); const int k = k0 + kk; const float g = (k < split) ? g_lo[k] : g_hi[k - split];
        scr[kk * 33 + (lane & 31)] = W[(size_t)k * N + n0 + (lane & 31)] * g * inv; }
    asm volatile("s_waitcnt lgkmcnt(0)" ::: "memory");
    const int c = lane & 7;
#pragma unroll
    for (int j = 0; j < 4; ++j) { const int n = (lane >> 3) + 8 * j; const LAS float* sp = scr + (8 * c) * 33 + n;
        unsigned w0 = 0u, w1 = 0u;
#pragma unroll
        for (int i = 0; i < 4; ++i) { w0 |= ((unsigned)(int)rintf(sp[i * 33]) & 255u) << (8 * i); w1 |= ((unsigned)(int)rintf(sp[(4 + i) * 33]) & 255u) << (8 * i); }
        u32x2 o; o.x = w0; o.y = w1;
        *(u32x2*)(WT8 + (size_t)(n0 + n) * K + k0 + 8 * c) = o; }
    asm volatile("s_waitcnt lgkmcnt(0)" ::: "memory");
}
__device__ __forceinline__ void phase_winq(const Params& P, LAS unsigned char* lds) {
    const int tid = threadIdx.x, lane = tid & 63, wave = __builtin_amdgcn_readfirstlane(tid >> 6);
    const int gw = blockIdx.x * NWAVES + wave, NGW = gridDim.x * NWAVES;
    LAS float* scr = (LAS float*)(lds + wave * 16384);
    constexpr int NI1 = (DM / 64) * (DIN / 32), NI2 = (DM / 64) * (DM / 32);
    for (int it = gw; it < NI1 + NI2; it += NGW) {
        if (it < NI1) p1_quant_item(P.w_in, DM, DIN, (signed char*)(P.ws + WS_WIN_T), (float*)(P.ws + WS_SW), (const unsigned*)(P.ws + WS_CTL) + CW_COLMAX, scr, it, lane, P.g_mix);
        else p1_quant_item2(P.w_out, DM, DM, (signed char*)(P.ws + WS_WOUT_T), (float*)(P.ws + WS_SWO), (const unsigned*)(P.ws + WS_CTL) + CW_COLMAX2, scr, it - NI1, lane, P.g_sc, P.g_cf, 512);
    }
}
__device__ __forceinline__ float q4(float x, float inv_s) {
    const float a = fabsf(x) * inv_s; float r;
    if (a < 2.f) r = rintf(a * 2.f) * 0.5f; else if (a < 4.f) r = rintf(a); else r = fminf(6.f, rintf(a * 0.5f) * 2.f);
    return copysignf(r, x);
}
__device__ __forceinline__ void phase_prep(const Params& P, LAS unsigned char* lds) {
    const int tid = threadIdx.x, lane = tid & 63, wave = __builtin_amdgcn_readfirstlane(tid >> 6);
    const int gw = blockIdx.x * NWAVES + wave, NGW = gridDim.x * NWAVES;
    unsigned char* ws = P.ws;
    LAS float* scr = (LAS float*)(lds + wave * 16384);
    constexpr int I_IN = (DM / 64) * (DIN / 32), I_OUT = (DM / 64) * (DM / 32), I_Q = (DM / 64) * (2048 / 32);
    for (int it = gw; it < I_IN + I_OUT + I_Q; it += NGW) {
        int r = it;
        if (r < I_IN) { p0_colmax_item(P.w_in, DIN, (unsigned*)(ws + WS_CTL) + CW_COLMAX, r, lane, P.g_mix); continue; } r -= I_IN;
        if (r < I_OUT) { p0_colmax_item2(P.w_out, DM, (unsigned*)(ws + WS_CTL) + CW_COLMAX2, r, lane, P.g_sc, P.g_cf, 512); continue; } r -= I_OUT;
        p0_transpose_item<false>(P.w_q, DM, 2048, (bf16*)(ws + WS_WQ_T), scr, r, lane, P.g_ffn, P.g_ffn, DM);
    }
    {
        unsigned* H0I8 = (unsigned*)(ws + WS_H0I8); float* RS1 = (float*)(ws + WS_RSTD1); float* SXp = (float*)(ws + WS_SX);
        for (int t0 = gw * 4; t0 < NTOK; t0 += NGW * 4) {
            f32x4 v[4][4];
#pragma unroll
            for (int q = 0; q < 4; ++q) { const f32x4* xr = (const f32x4*)(P.x + (size_t)(t0 + q) * DM) + lane;
#pragma unroll
                for (int j = 0; j < 4; ++j) v[q][j] = xr[64 * j]; }
#pragma unroll
            for (int q = 0; q < 4; ++q) { float sq = 0.f, mx = 0.f;
#pragma unroll
                for (int j = 0; j < 4; ++j) { sq += (v[q][j].x * v[q][j].x + v[q][j].y * v[q][j].y) + (v[q][j].z * v[q][j].z + v[q][j].w * v[q][j].w);
                    mx = fmaxf(mx, fmaxf(fmaxf(fabsf(v[q][j].x), fabsf(v[q][j].y)), fmaxf(fabsf(v[q][j].z), fabsf(v[q][j].w)))); }
                sq = wave_sum_fast(sq); mx = fmaxf(wave_max_fast(mx), 1e-30f);
                const float sx = mx * (1.f / 127.f), inv = 127.f / mx;
                if (lane == 0) { RS1[t0 + q] = sx * rsqrtf(sq * (1.f / DM) + EPS); SXp[t0 + q] = sx; }
                unsigned* o = H0I8 + (size_t)(t0 + q) * (DM / 4) + lane;
#pragma unroll
                for (int j = 0; j < 4; ++j) { const int a = (int)rintf(v[q][j].x * inv), b = (int)rintf(v[q][j].y * inv), c = (int)rintf(v[q][j].z * inv), d = (int)rintf(v[q][j].w * inv);
                    o[64 * j] = ((unsigned)a & 255u) | (((unsigned)b & 255u) << 8) | (((unsigned)c & 255u) << 16) | ((unsigned)d << 24); } }
        }
    }
    {
        unsigned char* U8 = ws + WS_U8; unsigned char* V8 = ws + WS_V8;
        f32x4 gf[4];
#pragma unroll
        for (int j = 0; j < 4; ++j) gf[j] = ((const f32x4*)P.g_ffn)[64 * j + lane];
        float* ESC = (float*)(ws + WS_ESCALE);
        for (int e0 = gw * 2; e0 < 2 * 16384; e0 += NGW * 2) {
            const bool isv = e0 >= 16384; const int ee0 = isv ? e0 - 16384 : e0;
            f32x4 v[2][4];
#pragma unroll
            for (int q = 0; q < 2; ++q) { const f32x4* src = (const f32x4*)((isv ? P.pv : P.pu) + (size_t)(ee0 + q) * DM);
#pragma unroll
                for (int j = 0; j < 4; ++j) v[q][j] = isv ? src[4 * lane + j] : src[64 * j + lane]; }
#pragma unroll
            for (int q = 0; q < 2; ++q) {
                float mx = 0.f;
#pragma unroll
                for (int j = 0; j < 4; ++j) { if (!isv) v[q][j] = v[q][j] * gf[j];
                    mx = fmaxf(mx, fmaxf(fmaxf(fabsf(v[q][j].x), fabsf(v[q][j].y)), fmaxf(fabsf(v[q][j].z), fabsf(v[q][j].w)))); }
#pragma unroll
                for (int o = 1; o < 64; o <<= 1) mx = fmaxf(mx, __shfl_xor(mx, o));
                if (!isv) {
                    float sq2 = 0.f;
#pragma unroll
                    for (int j = 0; j < 4; ++j) sq2 += (v[q][j].x * v[q][j].x + v[q][j].y * v[q][j].y) + (v[q][j].z * v[q][j].z + v[q][j].w * v[q][j].w);
                    const float rms = sqrtf(wave_sum_fast(sq2) * (1.f / DM));
                    const float su = fmaxf(fminf(mx, U4_CLIP * rms), 1e-30f) * (1.f / 7.f), inv = 1.f / su;
                    unsigned wq[2] = {0u, 0u}; int csum = 0;
#pragma unroll
                    for (int j = 0; j < 4; ++j) { const float e4[4] = {v[q][j].x, v[q][j].y, v[q][j].z, v[q][j].w};
#pragma unroll
                        for (int i = 0; i < 4; ++i) { int c = (int)rintf(fminf(fmaxf(e4[i] * inv, -7.f), 7.f)); csum += c;
                            wq[j >> 1] |= ((unsigned)c & 15u) << (16 * (j & 1) + 4 * i); } }
                    const float cs = wave_sum_fast((float)csum);
                    if (lane == 0) { ESC[e0 + q] = su; ((float*)(ws + WS_SUMQ))[e0 + q] = cs; }
                    u32x2 o; o.x = wq[0]; o.y = wq[1];
                    *(u32x2*)(U8 + (size_t)(ee0 + q) * 512 + 8 * lane) = o;
                    continue;
                }
                const float sc = fmaxf(mx, 1e-30f) * (1.f / 6.f), inv = 1.f / sc;
                if (lane == 0) ESC[e0 + q] = sc;
                unsigned w0 = 0u, w1 = 0u;
                w0 = __builtin_amdgcn_cvt_scalef32_pk_fp4_f32(w0, v[q][0].x * inv, v[q][0].y * inv, 1.0f, 0); w0 = __builtin_amdgcn_cvt_scalef32_pk_fp4_f32(w0, v[q][0].z * inv, v[q][0].w * inv, 1.0f, 1);
                w0 = __builtin_amdgcn_cvt_scalef32_pk_fp4_f32(w0, v[q][1].x * inv, v[q][1].y * inv, 1.0f, 2); w0 = __builtin_amdgcn_cvt_scalef32_pk_fp4_f32(w0, v[q][1].z * inv, v[q][1].w * inv, 1.0f, 3);
                w1 = __builtin_amdgcn_cvt_scalef32_pk_fp4_f32(w1, v[q][2].x * inv, v[q][2].y * inv, 1.0f, 0); w1 = __builtin_amdgcn_cvt_scalef32_pk_fp4_f32(w1, v[q][2].z * inv, v[q][2].w * inv, 1.0f, 1);
                w1 = __builtin_amdgcn_cvt_scalef32_pk_fp4_f32(w1, v[q][3].x * inv, v[q][3].y * inv, 1.0f, 2); w1 = __builtin_amdgcn_cvt_scalef32_pk_fp4_f32(w1, v[q][3].z * inv, v[q][3].w * inv, 1.0f, 3);
                u32x2 o; o.x = w0; o.y = w1;
                *(u32x2*)((isv ? V8 : U8) + (size_t)(ee0 + q) * 512 + 8 * lane) = o;
            }
        }
    }
    {
        bf16* KB = (bf16*)(ws + WS_KEYS);
        const int gt = blockIdx.x * NTHREADS + tid, NGT = gridDim.x * NTHREADS;
        for (int i = gt; i < 8 * 2 * 128 * 128 / 4; i += NGT) { const f32x4 v = ((const f32x4*)P.keys)[i]; u32x2 w; w.x = pk2(v.x, v.y); w.y = pk2(v.z, v.w); ((u32x2*)KB)[i] = w; }
    }
    {
        float* MP = (float*)(ws + WS_METAPART); float* MR = (float*)(ws + WS_METARSTD);
        for (int r = gw; r < NMETA; r += NGW) {
            float s = 0.f;
            for (int k = lane; k < DM; k += 64) { const float v = P.meta[r * DM + k]; s += v * v; }
            s = wave_sum(s);
            if (lane == 0) MR[r] = rsqrtf(s * (1.f / DM) + EPS);
        }
        for (int it = gw; it < MKC * 40; it += NGW) {
            const int kc = it / 40, nb = it % 40, n = nb * 64 + lane;
            float acc[NMETA];
#pragma unroll
            for (int r = 0; r < NMETA; ++r) acc[r] = 0.f;
            for (int k = kc * (DM / MKC); k < (kc + 1) * (DM / MKC); ++k) {
                const float w = P.w_in[(size_t)k * DIN + n] * P.g_mix[k];
#pragma unroll
                for (int r = 0; r < NMETA; ++r) acc[r] += P.meta[r * DM + k] * w;
            }
#pragma unroll
            for (int r = 0; r < NMETA; ++r) MP[(size_t)(kc * 16 + r) * DIN + n] = acc[r];
        }
    }
}

__device__ __forceinline__ float metaraw(const float* MP, const float* MR, int p, int col) { float s = 0.f;
#pragma unroll 8
    for (int kc = 0; kc < MKC; ++kc) s += MP[(size_t)(kc * 16 + p) * DIN + col];
    return s * MR[p]; }
__device__ __forceinline__ void phase_metaproj(const Params& P) {
    const float* MP = (const float*)(P.ws + WS_METAPART); const float* MR = (const float*)(P.ws + WS_METARSTD); float* MJ = (float*)(P.ws + WS_METAPROJ);
    for (int gt = blockIdx.x * NTHREADS + threadIdx.x; gt < NMETA * PDIM; gt += gridDim.x * NTHREADS) { const int p = gt / PDIM, c = gt % PDIM; float v;
        if (c < 512) v = metaraw(MP, MR, p, c) * metaraw(MP, MR, p, 1024 + c);
        else if (c < 1024) v = metaraw(MP, MR, p, c);
        else v = metaraw(MP, MR, p, 1536 + (c - 1024)) * sigmoid_f(metaraw(MP, MR, p, 2048 + (c - 1024)));
        MJ[gt] = v; }
}
__device__ __forceinline__ float meta_val(const float* MJ, const float*, int p, int col) { return MJ[p * PDIM + col]; }
__device__ __forceinline__ float proj_at(const bf16* PROJ, const float* MP, const float* MR, int b, int pos, int col) {
    if (pos < 0) return 0.f;
    if (pos < NMETA) return meta_val(MP, MR, pos, col);
    return bf2f(PROJ[(size_t)(b * SEQ + pos - NMETA) * PDIM + col]);
}
__device__ __forceinline__ void proj8_at(const bf16* PROJ, const float* MP, const float* MR, int b, int pos, int col, float (&v)[8]) {
    if (pos < 0) {
#pragma unroll
        for (int i = 0; i < 8; ++i) v[i] = 0.f;
    } else if (pos < NMETA) {
        const f32x4 a = *(const f32x4*)(MP + pos * PDIM + col), bq = *(const f32x4*)(MP + pos * PDIM + col + 4);
        v[0] = a.x; v[1] = a.y; v[2] = a.z; v[3] = a.w; v[4] = bq.x; v[5] = bq.y; v[6] = bq.z; v[7] = bq.w;
    } else {
        const u32x4 w = *(const u32x4*)(PROJ + (size_t)(b * SEQ + pos - NMETA) * PDIM + col);
        v[0] = bflo(w.x); v[1] = bfhi(w.x); v[2] = bflo(w.y); v[3] = bfhi(w.y); v[4] = bflo(w.z); v[5] = bfhi(w.z); v[6] = bflo(w.w); v[7] = bfhi(w.w);
    }
}

template <int R> __device__ __forceinline__ void conv_rows(const LAS unsigned char* ubase, const f32x2 (&wcf)[31], f32x2 (&acc)[32]) {
    if constexpr (R < 62) {
        const unsigned uw = *(const LAS unsigned*)(ubase + R * 1024);
        const f32x2 x = (f32x2){bflo(uw), bfhi(uw)};
        constexpr int lo = R > 30 ? R - 30 : 0, hi = R < 31 ? R : 31;
#pragma unroll
        for (int ii = lo; ii <= hi; ++ii) acc[ii] += wcf[R - ii] * x;
        conv_rows<R + 1>(ubase, wcf, acc);
    }
}
__device__ __forceinline__ void phase_conv(const Params& P, LAS unsigned char* lds) {
    const int tid = threadIdx.x, lane = tid & 63, wave = __builtin_amdgcn_readfirstlane(tid >> 6);
    unsigned char* ws = P.ws;
    const bf16* PROJ = (const bf16*)(ws + WS_PROJ); const float* MP = (const float*)(ws + WS_METAPROJ); const float* MR = nullptr;
    bf16* Y = (bf16*)(ws + WS_Y);
    constexpr int TT = 64, NTILE = NTOK / TT, UROWS = TT + 30;
    const int cgp = wave & 3, th = wave >> 2, ch2 = cgp * 128 + 2 * lane;
    f32x2 wcf[31];
#pragma unroll
    for (int j = 0; j < 31; ++j) wcf[j] = *(const f32x2*)(P.cf_w + j * 512 + ch2);
    const f32x2 bcf = *(const f32x2*)(P.cf_b + ch2);
    for (int tile = blockIdx.x; tile < NTILE; tile += gridDim.x) {
        const int b = tile / (SEQ / TT), s0 = (tile % (SEQ / TT)) * TT;
#pragma unroll 4
        for (int p = 0; p < (UROWS + 7) / 8; ++p) {
            const int r = p * 8 + wave;
            if (r < UROWS) {
                const int pos = NMETA + s0 - 30 + r;
                float uu[8];
                proj8_at(PROJ, MP, MR, b, pos, 1024 + 8 * lane, uu);
                u32x4 w; w.x = pk2(uu[0], uu[1]); w.y = pk2(uu[2], uu[3]); w.z = pk2(uu[4], uu[5]); w.w = pk2(uu[6], uu[7]);
                *(LAS u32x4*)(lds + r * 1024 + lane * 16) = w;
            }
        }
        __syncthreads();
        f32x2 acc[32];
#pragma unroll
        for (int ii = 0; ii < 32; ++ii) acc[ii] = bcf;
        conv_rows<0>(lds + (32 * th) * 1024 + ch2 * 2, wcf, acc);
        __syncthreads();
#pragma unroll
        for (int ii = 0; ii < 32; ++ii) *(LAS f32x2*)(lds + (32 * th + ii) * 2048 + ch2 * 4) = acc[ii];
        __syncthreads();
        {
            float lng[8], lnb[8];
            { const f32x4 a = *(const f32x4*)(P.ln_g + 8 * lane), c = *(const f32x4*)(P.ln_g + 8 * lane + 4), d = *(const f32x4*)(P.ln_b + 8 * lane), e = *(const f32x4*)(P.ln_b + 8 * lane + 4);
              lng[0] = a.x; lng[1] = a.y; lng[2] = a.z; lng[3] = a.w; lng[4] = c.x; lng[5] = c.y; lng[6] = c.z; lng[7] = c.w;
              lnb[0] = d.x; lnb[1] = d.y; lnb[2] = d.z; lnb[3] = d.w; lnb[4] = e.x; lnb[5] = e.y; lnb[6] = e.z; lnb[7] = e.w; }
            float wsc[3][8];
#pragma unroll
            for (int j = 0; j < 3; ++j) { const f32x4 a = *(const f32x4*)(P.sc_w + j * 512 + 8 * lane), c = *(const f32x4*)(P.sc_w + j * 512 + 8 * lane + 4);
                wsc[j][0] = a.x; wsc[j][1] = a.y; wsc[j][2] = a.z; wsc[j][3] = a.w; wsc[j][4] = c.x; wsc[j][5] = c.y; wsc[j][6] = c.z; wsc[j][7] = c.w; }
            float cxa[8], cxb[8];
            { const int pos = NMETA + s0 + 8 * wave - 2;
              proj8_at(PROJ, MP, MR, b, pos, 8 * lane, cxa); proj8_at(PROJ, MP, MR, b, pos + 1, 8 * lane, cxb); }
#pragma unroll 2
            for (int q = 0; q < 8; ++q) {
                const int ii = 8 * wave + q, s = s0 + ii; const size_t t = (size_t)b * SEQ + s;
                float o[8];
                { const f32x4 a = *(const LAS f32x4*)(lds + ii * 2048 + lane * 32), c = *(const LAS f32x4*)(lds + ii * 2048 + lane * 32 + 16);
                  o[0] = a.x; o[1] = a.y; o[2] = a.z; o[3] = a.w; o[4] = c.x; o[5] = c.y; o[6] = c.z; o[7] = c.w; }
                float s1 = 0.f;
#pragma unroll
                for (int i = 0; i < 8; ++i) s1 += o[i];
                const float mean = wave_sum_fast(s1) * (1.f / 512.f);
                float s2 = 0.f;
#pragma unroll
                for (int i = 0; i < 8; ++i) { o[i] -= mean; s2 += o[i] * o[i]; }
                const float rs = rsqrtf(wave_sum_fast(s2) * (1.f / 512.f) + EPS);
                float s3 = 0.f;
#pragma unroll
                for (int i = 0; i < 8; ++i) { float y = o[i] * rs * lng[i] + lnb[i]; y = y * sigmoid_f(y); o[i] = y; s3 += y * y; }
                const float r2 = rsqrtf(wave_sum_fast(s3) * (1.f / 512.f) + EPS);
                float bgv[8], cxc[8], accs[8];
                proj8_at(PROJ, MP, MR, b, NMETA + s, 8 * lane, cxc); proj8_at(PROJ, MP, MR, b, NMETA + s, 512 + 8 * lane, bgv);
                float s4 = 0.f;
#pragma unroll
                for (int i = 0; i < 8; ++i) { accs[i] = bgv[i] * (wsc[0][i] * cxa[i] + wsc[1][i] * cxb[i] + wsc[2][i] * cxc[i]); s4 += accs[i] * accs[i]; cxa[i] = cxb[i]; cxb[i] = cxc[i]; }
                const float r4 = rsqrtf(wave_sum_fast(s4) * (1.f / 512.f) + EPS);
                float ym = 0.f;
#pragma unroll
                for (int i = 0; i < 8; ++i) { o[i] *= r2; accs[i] *= r4; ym = fmaxf(ym, fmaxf(fabsf(o[i]), fabsf(accs[i]))); }
                ym = fmaxf(wave_max_fast(ym), 1e-30f);
                const float yinv = 127.f / ym;
                if (lane == 0) ((float*)(ws + WS_SY))[t] = ym * (1.f / 127.f);
                u32x2 wz, wv;
                wz.x = ((unsigned)(int)rintf(accs[0] * yinv) & 255u) | (((unsigned)(int)rintf(accs[1] * yinv) & 255u) << 8) | (((unsigned)(int)rintf(accs[2] * yinv) & 255u) << 16) | ((unsigned)(int)rintf(accs[3] * yinv) << 24);
                wz.y = ((unsigned)(int)rintf(accs[4] * yinv) & 255u) | (((unsigned)(int)rintf(accs[5] * yinv) & 255u) << 8) | (((unsigned)(int)rintf(accs[6] * yinv) & 255u) << 16) | ((unsigned)(int)rintf(accs[7] * yinv) << 24);
                wv.x = ((unsigned)(int)rintf(o[0] * yinv) & 255u) | (((unsigned)(int)rintf(o[1] * yinv) & 255u) << 8) | (((unsigned)(int)rintf(o[2] * yinv) & 255u) << 16) | ((unsigned)(int)rintf(o[3] * yinv) << 24);
                wv.y = ((unsigned)(int)rintf(o[4] * yinv) & 255u) | (((unsigned)(int)rintf(o[5] * yinv) & 255u) << 8) | (((unsigned)(int)rintf(o[6] * yinv) & 255u) << 16) | ((unsigned)(int)rintf(o[7] * yinv) << 24);
                *(u32x2*)(ws + WS_Y + t * DM + 8 * lane) = wz;
                *(u32x2*)(ws + WS_Y + t * DM + 512 + 8 * lane) = wv;
            }
        }
        __syncthreads();
    }
}

__device__ __forceinline__ int ord_i(float s) { int k = __builtin_bit_cast(int, s); k ^= (k >> 31) & 0x7fffffff; return k; }
__device__ __forceinline__ float unord_f(int k) { k ^= (k >> 31) & 0x7fffffff; return __builtin_bit_cast(float, k); }
#define TOP_INSERT(L, x_) do { int _x = (x_); _Pragma("unroll") for (int _i = 0; _i < 16; ++_i) { const int _hi = max(L[_i], _x); _x = min(L[_i], _x); L[_i] = _hi; } } while (0)

typedef short bf16x8 __attribute__((ext_vector_type(8)));
typedef float f32x16 __attribute__((ext_vector_type(16)));
template <bool DESC> __device__ __forceinline__ void ce_i(int& a, int& b) { const int hi = max(a, b), lo = min(a, b); if (DESC) { a = hi; b = lo; } else { a = lo; b = hi; } }
__device__ __forceinline__ void bitonic_sort16(int (&a)[16]) {
#pragma unroll
    for (int k = 2; k <= 16; k <<= 1)
#pragma unroll
        for (int j = k >> 1; j > 0; j >>= 1)
#pragma unroll
            for (int i = 0; i < 16; ++i) { const int l = i ^ j; if (l > i) { if ((i & k) == 0) ce_i<true>(a[i], a[l]); else ce_i<false>(a[i], a[l]); } }
}
__device__ __forceinline__ void bitonic_merge16(int (&a)[16]) {
#pragma unroll
    for (int j = 8; j > 0; j >>= 1)
#pragma unroll
        for (int i = 0; i < 16; ++i) { const int l = i ^ j; if (l > i) ce_i<true>(a[i], a[l]); }
}
__device__ __forceinline__ void merge_top16(int (&a)[16], const int (&b)[16]) {
#pragma unroll
    for (int i = 0; i < 16; ++i) a[i] = max(a[i], b[15 - i]);
    bitonic_merge16(a);
}
__device__ __forceinline__ int lut16(const unsigned (&T)[4], int i) {
    const unsigned sel = (unsigned)(i & 7) | 0x0c0c0c00u;
    const unsigned lo = __builtin_amdgcn_perm(T[1], T[0], sel), hi = __builtin_amdgcn_perm(T[3], T[2], sel);
    return (int)((i & 8) ? hi : lo);
}
constexpr int KROW = 272;
constexpr float SCORE_BIAS = 8.0f;

__device__ __forceinline__ void route_load_q(bf16x8 (&qf)[8], const bf16* qrow, int hb) {
#pragma unroll
    for (int ks = 0; ks < 8; ++ks) qf[ks] = *(const bf16x8*)(qrow + 64 * hb + 8 * ks);
}
__device__ __forceinline__ void route_half(const LAS unsigned char* kl, const bf16x8 (&qf)[8], int nl, int hb, int (&L)[16]) {
    f32x16 acc[4];
#pragma unroll
    for (int nt = 0; nt < 4; ++nt)
#pragma unroll
        for (int r = 0; r < 16; ++r) acc[nt][r] = SCORE_BIAS;
#pragma unroll
    for (int ks = 0; ks < 8; ++ks)
#pragma unroll
        for (int nt = 0; nt < 4; ++nt) {
            const bf16x8 a = *(const LAS bf16x8*)(kl + (32 * nt + nl) * KROW + (64 * hb + 8 * ks) * 2);
            acc[nt] = __builtin_amdgcn_mfma_f32_32x32x16_bf16(a, qf[ks], acc[nt], 0, 0, 0);
        }
    const int hb4 = 4 * hb;
    int T[4][16];
#pragma unroll
    for (int nt = 0; nt < 4; ++nt)
#pragma unroll
        for (int r = 0; r < 16; ++r) { const int n0 = 32 * nt + (r & 3) + 8 * (r >> 2); const float sc = acc[nt][r];
            T[nt][r] = (__float_as_int(sc) & ~127) | ((127 - n0) - hb4); }
    bitonic_sort16(T[0]); bitonic_sort16(T[1]); bitonic_sort16(T[2]); bitonic_sort16(T[3]);
    merge_top16(T[0], T[1]); merge_top16(T[2], T[3]); merge_top16(T[0], T[2]);
#pragma unroll
    for (int i = 0; i < 16; ++i) { const unsigned v = (unsigned)T[0][15 - i]; auto r = __builtin_amdgcn_permlane32_swap(v, v, false, false);
        const unsigned r0 = r[0], r1 = r[1]; const int partner = (int)(hb ? r0 : r1); L[i] = max(T[0][i], partner); }
    bitonic_merge16(L);
}

__device__ __forceinline__ void phase_route(const Params& P, LAS unsigned char* lds) {
    const int tid = threadIdx.x, lane = tid & 63, wave = __builtin_amdgcn_readfirstlane(tid >> 6);
    const int nl = lane & 31, hb = lane >> 5;
    unsigned char* ws = P.ws;
    const bf16* KEYS = (const bf16*)(ws + WS_KEYS); const bf16* Q = (const bf16*)(ws + WS_Q);
    int* IDX = (int*)(ws + WS_IDX); float* GATE = (float*)(ws + WS_GATE);
    int last_h = -1;
    pg8::StaticOrder S; S.init(NTOK, 2048, (int)gridDim.x, (int)blockIdx.x);
    pg8::Unit ucur, unxt;
    bool have = S.next(0, ucur);
    bf16x8 qfA[8], qfB[8];
    if (have) route_load_q(qfA, Q + ((size_t)ucur.pm * 256 + wave * 32 + nl) * 2048 + ucur.pn * 256, hb);
    for (int ui = 0; have; ++ui) {
        const int h = ucur.pn, tb = ucur.pm;
        const bool have_next = S.next(ui + 1, unxt);
        if (h != last_h) {
            __syncthreads();
            for (int c = tid; c < 4096; c += NTHREADS) { const u32x4 v = ((const u32x4*)(KEYS + (size_t)h * 32768))[c];
                *(LAS u32x4*)(lds + (c >> 4) * KROW + (c & 15) * 16) = v; }
            __syncthreads();
            last_h = h;
        }
        const size_t t = (size_t)tb * 256 + wave * 32 + nl;
        int L1[16], L2[16];
        route_load_q(qfB, Q + t * 2048 + h * 256 + 128, hb);
        route_half(lds, qfA, nl, hb, L1);
        if (have_next) route_load_q(qfA, Q + ((size_t)unxt.pm * 256 + wave * 32 + nl) * 2048 + unxt.pn * 256, hb);
        route_half(lds + 128 * KROW, qfB, nl, hb, L2);
        float v1[16], v2[16];
#pragma unroll
        for (int i = 0; i < 16; ++i) { v1[i] = __int_as_float(L1[i] & ~127); v2[i] = __int_as_float(L2[i] & ~127); }
#define CAND(i, j) ((__float_as_int(v1[i] + v2[j]) & ~255) | (255 - (16 * (i) + (j))))
        int A[16], B[16], C[16];
#pragma unroll
        for (int j = 0; j < 16; ++j) A[j] = CAND(0, j);
#pragma unroll
        for (int j = 0; j < 8; ++j) { B[j] = CAND(1, j); B[8 + j] = CAND(15 - j, 0); }
        bitonic_merge16(B);
        C[0] = CAND(2, 0); C[1] = CAND(2, 1); C[2] = CAND(2, 2); C[3] = CAND(2, 3); C[4] = CAND(2, 4);
        C[5] = CAND(3, 0); C[6] = CAND(3, 1); C[7] = CAND(3, 2); C[8] = CAND(3, 3);
        C[9] = CAND(4, 0); C[10] = CAND(4, 1); C[11] = CAND(4, 2);
        C[12] = CAND(5, 0); C[13] = CAND(5, 1); C[14] = CAND(6, 0); C[15] = CAND(6, 1);
        bitonic_sort16(C);
        { const int d0 = CAND(7, 0), d1 = CAND(7, 1); C[14] = max(C[14], d1); C[15] = max(C[15], d0); bitonic_merge16(C); }
#undef CAND
        merge_top16(A, B); merge_top16(A, C);
        unsigned T1[4], T2[4];
#pragma unroll
        for (int q = 0; q < 4; ++q) {
            T1[q] = (unsigned)(127 - (L1[4 * q] & 127)) | ((unsigned)(127 - (L1[4 * q + 1] & 127)) << 8) | ((unsigned)(127 - (L1[4 * q + 2] & 127)) << 16) | ((unsigned)(127 - (L1[4 * q + 3] & 127)) << 24);
            T2[q] = (unsigned)(127 - (L2[4 * q] & 127)) | ((unsigned)(127 - (L2[4 * q + 1] & 127)) << 8) | ((unsigned)(127 - (L2[4 * q + 2] & 127)) << 16) | ((unsigned)(127 - (L2[4 * q + 3] & 127)) << 24); }
        float val[16]; int ex[16];
#pragma unroll
        for (int k = 0; k < 16; ++k) { const int pos = 255 - (A[k] & 255); val[k] = __int_as_float(A[k] & ~255);
            ex[k] = lut16(T1, pos >> 4) * NKEYS + lut16(T2, pos & 15); }
        float sum = 0.f; const float vmax = val[0];
#pragma unroll
        for (int k = 0; k < 16; ++k) { val[k] = __expf(val[k] - vmax); sum += val[k]; }
        const float inv = 1.f / sum;
        if (hb == 0) {
            int* ip = IDX + t * NSEL + h * TOPK; float* gp = GATE + t * NSEL + h * TOPK;
#pragma unroll
            for (int k4 = 0; k4 < 4; ++k4) {
                *(int4*)(ip + 4 * k4) = make_int4(ex[4 * k4], ex[4 * k4 + 1], ex[4 * k4 + 2], ex[4 * k4 + 3]);
                *(f32x4*)(gp + 4 * k4) = (f32x4){val[4 * k4] * inv, val[4 * k4 + 1] * inv, val[4 * k4 + 2] * inv, val[4 * k4 + 3] * inv};
            }
        }
        ucur = unxt; have = have_next;
    }
}

#define FP4X2(w, sel) __builtin_amdgcn_cvt_scalef32_pk_f32_fp4((w), 1.0f, (sel))
__device__ __forceinline__ float dot16_fp4(const u32x2 r, const f32x4 (&xs)[4]) {
    float p = 0.f;
    { const f32x2 a = FP4X2(r.x, 0), b = FP4X2(r.x, 1), c = FP4X2(r.x, 2), d = FP4X2(r.x, 3);
      p += (a.x * xs[0].x + a.y * xs[0].y) + (b.x * xs[0].z + b.y * xs[0].w); p += (c.x * xs[1].x + c.y * xs[1].y) + (d.x * xs[1].z + d.y * xs[1].w); }
    { const f32x2 a = FP4X2(r.y, 0), b = FP4X2(r.y, 1), c = FP4X2(r.y, 2), d = FP4X2(r.y, 3);
      p += (a.x * xs[2].x + a.y * xs[2].y) + (b.x * xs[2].z + b.y * xs[2].w); p += (c.x * xs[3].x + c.y * xs[3].y) + (d.x * xs[3].z + d.y * xs[3].w); }
    return p;
}
__device__ __forceinline__ void axpy16_fp4(const u32x2 r, float w, f32x4 (&o)[4]) {
    { const f32x2 a = FP4X2(r.x, 0), b = FP4X2(r.x, 1), c = FP4X2(r.x, 2), d = FP4X2(r.x, 3);
      o[0].x += w * a.x; o[0].y += w * a.y; o[0].z += w * b.x; o[0].w += w * b.y; o[1].x += w * c.x; o[1].y += w * c.y; o[1].z += w * d.x; o[1].w += w * d.y; }
    { const f32x2 a = FP4X2(r.y, 0), b = FP4X2(r.y, 1), c = FP4X2(r.y, 2), d = FP4X2(r.y, 3);
      o[2].x += w * a.x; o[2].y += w * a.y; o[2].z += w * b.x; o[2].w += w * b.y; o[3].x += w * c.x; o[3].y += w * c.y; o[3].z += w * d.x; o[3].w += w * d.y; }
}
__device__ __forceinline__ float swap32_add(float a, float b) { auto r = __builtin_amdgcn_permlane32_swap(__float_as_uint(a), __float_as_uint(b), false, false); return __uint_as_float(r[0]) + __uint_as_float(r[1]); }
__device__ __forceinline__ float swap16_add(float a, float b) { auto r = __builtin_amdgcn_permlane16_swap(__float_as_uint(a), __float_as_uint(b), false, false); return __uint_as_float(r[0]) + __uint_as_float(r[1]); }
__device__ __forceinline__ float row_sum16(float v) { v += dpp_f<0xB1>(v); v += dpp_f<0x4E>(v); v += dpp_f<0x141>(v); v += dpp_f<0x140>(v); return v; }
constexpr int GB = 32;
typedef __attribute__((address_space(8))) void* rsrc_t;
__device__ __forceinline__ void g_issue(u32x2 (&buf)[GB], __amdgpu_buffer_rsrc_t rs, int idxr, int lb, int voff) {
#pragma unroll
    for (int j = 0; j < GB; ++j) { const int e = __builtin_amdgcn_readlane(idxr, lb + j); buf[j] = __builtin_amdgcn_raw_buffer_load_b64(rs, voff, e * 512, 0); }
}
__device__ __forceinline__ float dot16_fp4p(const u32x2 r, const f32x2 (&xp)[8]) {
    f32x2 a = FP4X2(r.x, 0) * xp[0];
    a += FP4X2(r.x, 1) * xp[1]; a += FP4X2(r.x, 2) * xp[2]; a += FP4X2(r.x, 3) * xp[3];
    a += FP4X2(r.y, 0) * xp[4]; a += FP4X2(r.y, 1) * xp[5]; a += FP4X2(r.y, 2) * xp[6]; a += FP4X2(r.y, 3) * xp[7];
    return a.x + a.y;
}
__device__ __forceinline__ void axpy16_fp4p(const u32x2 r, float w, f32x2 (&o)[8]) {
    const f32x2 ww = (f32x2){w, w};
    o[0] += FP4X2(r.x, 0) * ww; o[1] += FP4X2(r.x, 1) * ww; o[2] += FP4X2(r.x, 2) * ww; o[3] += FP4X2(r.x, 3) * ww;
    o[4] += FP4X2(r.y, 0) * ww; o[5] += FP4X2(r.y, 1) * ww; o[6] += FP4X2(r.y, 2) * ww; o[7] += FP4X2(r.y, 3) * ww;
}
template <int H> __device__ __forceinline__ void g_compute_u(const u32x2 (&buf)[GB], int q, int i16, const f32x2 (&xp)[8], float& zlo, float& zhi) {
    float p[16];
#pragma unroll
    for (int j = 0; j < 16; ++j) p[j] = dot16_fp4p(buf[16 * H + j], xp);
    float s1[8], s2[4];
#pragma unroll
    for (int m = 0; m < 8; ++m) s1[m] = swap32_add(p[2 * m], p[2 * m + 1]);
#pragma unroll
    for (int n = 0; n < 4; ++n) s2[n] = swap16_add(s1[2 * n], s1[2 * n + 1]);
#pragma unroll
    for (int r = 0; r < 4; ++r) { const float z = row_sum16(s2[r]); const bool mine = i16 == ((4 * q + r) & 15);
        zlo = (mine && q < 4) ? z : zlo; zhi = (mine && q >= 4) ? z : zhi; }
}
template <int H> __device__ __forceinline__ void g_compute_v(const u32x2 (&buf)[GB], int q, float alo, float ahi, f32x2 (&o)[8]) {
    const int areg = __builtin_bit_cast(int, (q < 4) ? alo : ahi), sb = 4 * (q & 3);
#pragma unroll
    for (int j = 0; j < 16; ++j) { const int src = 32 * (j & 1) + 16 * ((j >> 1) & 1) + (j >> 2) + sb;
        const float w = __builtin_bit_cast(float, __builtin_amdgcn_readlane(areg, src));
        axpy16_fp4p(buf[16 * H + j], w, o); }
}
__device__ __forceinline__ void q_issue(u32x2 (&buf)[16], __amdgpu_buffer_rsrc_t rs, int ixr  , int lb, int voff) {
#pragma unroll
    for (int j = 0; j < 16; ++j) { const int e9 = __builtin_amdgcn_readlane(ixr, lb + j); buf[j] = __builtin_amdgcn_raw_buffer_load_b64(rs, voff, e9, 0); }
}
__device__ __forceinline__ void q_compute_u(const u32x2 (&buf)[16], int q, int i16, const f32x2 (&xp)[8], float& zlo, float& zhi) {
    float p[16];
#pragma unroll
    for (int j = 0; j < 16; ++j) p[j] = dot16_fp4p(buf[j], xp);
    float s1[8], s2[4];
#pragma unroll
    for (int m = 0; m < 8; ++m) s1[m] = swap32_add(p[2 * m], p[2 * m + 1]);
#pragma unroll
    for (int n = 0; n < 4; ++n) s2[n] = swap16_add(s1[2 * n], s1[2 * n + 1]);
#pragma unroll
    for (int r = 0; r < 4; ++r) { const float z = row_sum16(s2[r]); const bool mine = i16 == ((4 * q + r) & 15);
        zlo = (mine && q < 4) ? z : zlo; zhi = (mine && q >= 4) ? z : zhi; }
}
typedef _Float16 h16x2 __attribute__((ext_vector_type(2)));
#define FP4H2(w, sel) __builtin_amdgcn_cvt_scalef32_pk_f16_fp4((w), 1.0f, (sel))
__device__ __forceinline__ void axpy16_fp4h(const u32x2 r, const h16x2 ww, h16x2 (&o)[8]) {
    o[0] += FP4H2(r.x, 0) * ww; o[1] += FP4H2(r.x, 1) * ww; o[2] += FP4H2(r.x, 2) * ww; o[3] += FP4H2(r.x, 3) * ww;
    o[4] += FP4H2(r.y, 0) * ww; o[5] += FP4H2(r.y, 1) * ww; o[6] += FP4H2(r.y, 2) * ww; o[7] += FP4H2(r.y, 3) * ww;
}
__device__ __forceinline__ void q_compute_vh(const u32x2 (&buf)[16], int q, int alo, int ahi, h16x2 (&o)[8]) {
    const int areg = (q < 4) ? alo : ahi, sb = 4 * (q & 3);
#pragma unroll
    for (int j = 0; j < 16; ++j) { const int src = 32 * (j & 1) + 16 * ((j >> 1) & 1) + (j >> 2) + sb;
        const h16x2 w = __builtin_bit_cast(h16x2, __builtin_amdgcn_readlane(areg, src));
        axpy16_fp4h(buf[j], w, o); }
}
__device__ __forceinline__ void q_compute_v(const u32x2 (&buf)[16], int q, float alo, float ahi, f32x2 (&o)[8]) {
    const int areg = __builtin_bit_cast(int, (q < 4) ? alo : ahi), sb = 4 * (q & 3);
#pragma unroll
    for (int j = 0; j < 16; ++j) { const int src = 32 * (j & 1) + 16 * ((j >> 1) & 1) + (j >> 2) + sb;
        const float w = __builtin_bit_cast(float, __builtin_amdgcn_readlane(areg, src));
        axpy16_fp4p(buf[j], w, o); }
}
__device__ __forceinline__ int swap32_addi(int a, int b) { auto r = __builtin_amdgcn_permlane32_swap((unsigned)a, (unsigned)b, false, false); const unsigned r0 = r[0], r1 = r[1]; return (int)(r0 + r1); }
__device__ __forceinline__ int swap16_addi(int a, int b) { auto r = __builtin_amdgcn_permlane16_swap((unsigned)a, (unsigned)b, false, false); const unsigned r0 = r[0], r1 = r[1]; return (int)(r0 + r1); }
template <int CTRL> __device__ __forceinline__ int dpp_i(int v) { return __builtin_amdgcn_update_dpp(0, v, CTRL, 0xf, 0xf, true); }
__device__ __forceinline__ int row_sum16i(int v) { v += dpp_i<0xB1>(v); v += dpp_i<0x4E>(v); v += dpp_i<0x141>(v); v += dpp_i<0x140>(v); return v; }
__device__ __forceinline__ void q_compute_ui(const u32x2 (&buf)[16], int q, int i16, int xh0, int xh1, int xl0, int xl1, int& zlo, int& zhi) {
    int p[16];
#pragma unroll
    for (int j = 0; j < 16; ++j) { const int d1 = __builtin_amdgcn_sdot8((int)buf[j].x, xh0, __builtin_amdgcn_sdot8((int)buf[j].y, xh1, 0, false), false);
        const int d2 = __builtin_amdgcn_sdot8((int)buf[j].x, xl0, __builtin_amdgcn_sdot8((int)buf[j].y, xl1, 0, false), false);
        p[j] = (d1 << 4) + d2; }
    int s1[8], s2[4];
#pragma unroll
    for (int m = 0; m < 8; ++m) s1[m] = swap32_addi(p[2 * m], p[2 * m + 1]);
#pragma unroll
    for (int n = 0; n < 4; ++n) s2[n] = swap16_addi(s1[2 * n], s1[2 * n + 1]);
#pragma unroll
    for (int r = 0; r < 4; ++r) { const int z = row_sum16i(s2[r]); const bool mine = i16 == ((4 * q + r) & 15);
        zlo = (mine && q < 4) ? z : zlo; zhi = (mine && q >= 4) ? z : zhi; }
}
__device__ __forceinline__ void phase_gather_u(const Params& P) {
    const int tid = threadIdx.x, lane = tid & 63, wave = __builtin_amdgcn_readfirstlane(tid >> 6);
    const int gw = blockIdx.x * NWAVES + wave, NGW = gridDim.x * NWAVES;
    unsigned char* ws = P.ws;
    const int* IDX = (const int*)(ws + WS_IDX); const float* GATE = (const float*)(ws + WS_GATE); const float* ESC = (const float*)(ws + WS_ESCALE); float* AW = (float*)(ws + WS_AW);
    const __amdgpu_buffer_rsrc_t rsU = __builtin_amdgcn_make_buffer_rsrc((void*)(ws + WS_U8), 0, 16384 * 512, 0x00020000);
    const bf16* H2B = (const bf16*)(ws + WS_H2B); const float* SSQ = (const float*)(ws + WS_SSQ);
    const int hh = lane >> 5, rr = (lane >> 4) & 1, i16 = lane & 15, gsel = 4 * i16 + 2 * rr + hh;
    const int voff = 8 * lane;
    const unsigned ul = (unsigned)lane;
    int t = gw;
    if (t < NTOK) {
        int idx0, idx1; u32x2 hraw[4]; float sqv;
        { const int* ip = IDX + (size_t)t * NSEL; idx0 = ip[ul]; idx1 = ip[64u + ul];
          const u32x2* hp = (const u32x2*)(H2B + (size_t)t * DM);
#pragma unroll
          for (int j = 0; j < 4; ++j) hraw[j] = hp[64u * j + ul];
          sqv = (SSQ + (size_t)t * 16)[ul & 15u]; }
        u32x2 R0[16], R1[16], R2[16], R3[16];
        { const int ix0 = idx0 << 9; q_issue(R0, rsU, ix0, 0, voff); q_issue(R1, rsU, ix0, 16, voff); q_issue(R2, rsU, ix0, 32, voff); }
        for (;;) {
            const int tn = t + NGW; const bool has_next = tn < NTOK; const int tl = has_next ? tn : t;
            int idx0n, idx1n; u32x2 hrawn[4]; float sqn, g0, g1;
            { const int* ip = IDX + (size_t)tl * NSEL; idx0n = ip[ul]; idx1n = ip[64u + ul];
              const u32x2* hp = (const u32x2*)(H2B + (size_t)tl * DM);
#pragma unroll
              for (int j = 0; j < 4; ++j) hrawn[j] = hp[64u * j + ul];
              sqn = (SSQ + (size_t)tl * 16)[ul & 15u];
              const float* gp = GATE + (size_t)t * NSEL; g0 = gp[ul]; g1 = gp[64u + ul]; }
            const float su0 = ESC[idx0], su1 = ESC[idx1], sv0 = ESC[16384 + idx0], sv1 = ESC[16384 + idx1];
            const float cq0 = ((const float*)(ws + WS_SUMQ))[idx0], cq1 = ((const float*)(ws + WS_SUMQ))[idx1];
            const float rstd2 = rsqrtf(row_sum16(sqv) * (1.f / DM) + EPS);
            float xf[16];
#pragma unroll
            for (int j = 0; j < 4; ++j) { xf[4 * j] = bflo(hraw[j].x); xf[4 * j + 1] = bfhi(hraw[j].x); xf[4 * j + 2] = bflo(hraw[j].y); xf[4 * j + 3] = bfhi(hraw[j].y); }
            float am = 0.f;
#pragma unroll
            for (int e = 0; e < 16; ++e) am = fmaxf(am, fabsf(xf[e]));
            am = fmaxf(wave_max_fast(am), 1e-30f);
            const float xinv = 127.f / am, xscale = am * (1.f / 127.f);
            unsigned xh[2] = {0u, 0u}, xl[2] = {0u, 0u};
#pragma unroll
            for (int j = 0; j < 4; ++j)
#pragma unroll
                for (int i = 0; i < 4; ++i) { const int xi = (int)rintf(xf[4 * j + i] * xinv); const int sh = 16 * (j & 1) + 4 * i;
                    xh[j >> 1] |= ((unsigned)(xi >> 4) & 15u) << sh; xl[j >> 1] |= ((unsigned)((xi & 15) - 8) & 15u) << sh; }
            int zlo = 0, zhi = 0;
            const int ix0 = idx0 << 9, ix1 = idx1 << 9;
#pragma unroll 1
            for (int qq = 0; qq < 8; qq += 4) {
                const int ixn = qq ? (idx0n << 9) : ix1;
                q_issue(R3, rsU, qq ? ix1 : ix0, 48, voff);
                q_compute_ui(R0, qq, i16, (int)xh[0], (int)xh[1], (int)xl[0], (int)xl[1], zlo, zhi);
                q_issue(R0, rsU, ixn, 0, voff);
                q_compute_ui(R1, qq + 1, i16, (int)xh[0], (int)xh[1], (int)xl[0], (int)xl[1], zlo, zhi);
                q_issue(R1, rsU, ixn, 16, voff);
                q_compute_ui(R2, qq + 2, i16, (int)xh[0], (int)xh[1], (int)xl[0], (int)xl[1], zlo, zhi);
                q_issue(R2, rsU, ixn, 32, voff);
                q_compute_ui(R3, qq + 3, i16, (int)xh[0], (int)xh[1], (int)xl[0], (int)xl[1], zlo, zhi);
            }
            const float glo = __shfl(g0, gsel), ghi = __shfl(g1, gsel), sulo = __shfl(su0, gsel), suhi = __shfl(su1, gsel), svlo = __shfl(sv0, gsel), svhi = __shfl(sv1, gsel);
            const float cqlo = __shfl(cq0, gsel), cqhi = __shfl(cq1, gsel);
            const float zfl = ((float)zlo + 8.f * cqlo) * (sulo * xscale * rstd2), zfh = ((float)zhi + 8.f * cqhi) * (suhi * xscale * rstd2);
            const float wl = gelu_tanh_f(zfl) * glo * svlo, wh = gelu_tanh_f(zfh) * ghi * svhi;
            const float wmx = fmaxf(wave_max_fast(fmaxf(fabsf(wl), fabsf(wh))), 1e-30f), wsc = 256.f / wmx;
            { const float a = wl * wsc, c = wh * wsc;
              const int ah = __builtin_amdgcn_cvt_pk_fp8_f32(a, a, 0, false) & 255, ch = __builtin_amdgcn_cvt_pk_fp8_f32(c, c, 0, false) & 255;
              const float ar = a - __builtin_amdgcn_cvt_f32_fp8(ah, 0), cr = c - __builtin_amdgcn_cvt_f32_fp8(ch, 0);
              const int al = __builtin_amdgcn_cvt_pk_fp8_f32(ar, ar, 0, false) & 255, cl = __builtin_amdgcn_cvt_pk_fp8_f32(cr, cr, 0, false) & 255;
              unsigned char* ap = (unsigned char*)AW + (size_t)t * 256;
              ap[gsel] = (unsigned char)ah; ap[64 + gsel] = (unsigned char)ch; ap[128 + gsel] = (unsigned char)al; ap[192 + gsel] = (unsigned char)cl;
              if (lane == 0) ((float*)(ws + WS_WMX))[t] = wmx * (1.f / 256.f); }
            if (!has_next) break;
            t = tn; idx0 = idx0n; idx1 = idx1n; sqv = sqn;
#pragma unroll
            for (int j = 0; j < 4; ++j) hraw[j] = hrawn[j];
        }
    }
}
__device__ __forceinline__ void phase_gather_v(const Params& P) {
    const int tid = threadIdx.x, lane = tid & 63, wave = __builtin_amdgcn_readfirstlane(tid >> 6);
    const int gw = blockIdx.x * NWAVES + wave, NGW = gridDim.x * NWAVES;
    unsigned char* ws = P.ws;
    const int* IDX = (const int*)(ws + WS_IDX); const float* AW = (const float*)(ws + WS_AW);
    const __amdgpu_buffer_rsrc_t rsV = __builtin_amdgcn_make_buffer_rsrc((void*)(ws + WS_V8), 0, 16384 * 512, 0x00020000);
    const bf16* H2B = (const bf16*)(ws + WS_H2B);
    const int voff = 8 * lane;
    const unsigned ul = (unsigned)lane;
    int t = gw;
    if (t < NTOK) {
        int idx0, idx1; u32x2 hraw[4]; float alo, ahi;
        { const int* ip = IDX + (size_t)t * NSEL; idx0 = ip[ul]; idx1 = ip[64u + ul];
          const u32x2* hp = (const u32x2*)(H2B + (size_t)t * DM);
#pragma unroll
          for (int j = 0; j < 4; ++j) hraw[j] = hp[64u * j + ul];
          const float* ap = AW + (size_t)t * NSEL; alo = ap[ul]; ahi = ap[64u + ul]; }
        u32x2 R0[16], R1[16], R2[16], R3[16];
        { const int ix0 = idx0 << 9; q_issue(R0, rsV, ix0, 0, voff); q_issue(R1, rsV, ix0, 16, voff); q_issue(R2, rsV, ix0, 32, voff); }
        for (;;) {
            const int tn = t + NGW; const bool has_next = tn < NTOK; const int tl = has_next ? tn : t;
            int idx0n, idx1n; u32x2 hrawn[4]; float alon, ahin;
            { const int* ip = IDX + (size_t)tl * NSEL; idx0n = ip[ul]; idx1n = ip[64u + ul];
              const u32x2* hp = (const u32x2*)(H2B + (size_t)tl * DM);
#pragma unroll
              for (int j = 0; j < 4; ++j) hrawn[j] = hp[64u * j + ul];
              const float* ap = AW + (size_t)tl * NSEL; alon = ap[ul]; ahin = ap[64u + ul]; }
            const float wmx = fmaxf(wave_max_fast(fmaxf(fabsf(alo), fabsf(ahi))), 1e-30f), winv = 1.f / wmx;
            int alh, ahh;
            { const h16x2 a = (h16x2){(_Float16)(alo * winv), (_Float16)(alo * winv)}, b = (h16x2){(_Float16)(ahi * winv), (_Float16)(ahi * winv)};
              alh = __builtin_bit_cast(int, a); ahh = __builtin_bit_cast(int, b); }
            h16x2 oh[8];
#pragma unroll
            for (int j = 0; j < 8; ++j) oh[j] = (h16x2){(_Float16)0.f, (_Float16)0.f};
            const int ix0 = idx0 << 9, ix1 = idx1 << 9;
#pragma unroll 1
            for (int qq = 0; qq < 8; qq += 4) {
                const int ixn = qq ? (idx0n << 9) : ix1;
                q_issue(R3, rsV, qq ? ix1 : ix0, 48, voff);
                q_compute_vh(R0, qq, alh, ahh, oh);
                q_issue(R0, rsV, ixn, 0, voff);
                q_compute_vh(R1, qq + 1, alh, ahh, oh);
                q_issue(R1, rsV, ixn, 16, voff);
                q_compute_vh(R2, qq + 2, alh, ahh, oh);
                q_issue(R2, rsV, ixn, 32, voff);
                q_compute_vh(R3, qq + 3, alh, ahh, oh);
            }
            f32x2 o[8];
#pragma unroll
            for (int j = 0; j < 8; ++j) o[j] = (f32x2){(float)oh[j].x * wmx, (float)oh[j].y * wmx};
            float ss = 0.f;
#pragma unroll
            for (int j = 0; j < 4; ++j) { o[2 * j] += (f32x2){bflo(hraw[j].x), bfhi(hraw[j].x)}; o[2 * j + 1] += (f32x2){bflo(hraw[j].y), bfhi(hraw[j].y)}; }
#pragma unroll
            for (int j = 0; j < 8; ++j) ss += o[j].x * o[j].x + o[j].y * o[j].y;
            ss = wave_sum_fast(ss);
            const float r3 = rsqrtf(ss * (1.f / DM) + EPS);
            f32x4* op = (f32x4*)(P.out + (size_t)t * DM);
            const f32x4* gfp = (const f32x4*)P.g_fin;
#pragma unroll
            for (int j = 0; j < 4; ++j) { const f32x4 gv = gfp[64u * j + ul]; op[64u * j + ul] = (f32x4){o[2 * j].x * r3 * gv.x, o[2 * j].y * r3 * gv.y, o[2 * j + 1].x * r3 * gv.z, o[2 * j + 1].y * r3 * gv.w}; }
            if (!has_next) break;
            t = tn; idx0 = idx0n; idx1 = idx1n; alo = alon; ahi = ahin;
#pragma unroll
            for (int j = 0; j < 4; ++j) hraw[j] = hrawn[j];
        }
    }
}


typedef int i32x2v __attribute__((ext_vector_type(2)));
typedef int i32x8v __attribute__((ext_vector_type(8)));
#define VM_X 9
#define VM_WAIT(n) asm volatile("s_waitcnt vmcnt(" #n ")" ::: "memory")
__device__ __forceinline__ void phase_gather_v_mfma(const Params& P, LAS unsigned char* lds) {
    const int tid = threadIdx.x, lane = tid & 63, wave = __builtin_amdgcn_readfirstlane(tid >> 6);
    unsigned char* ws = P.ws;
    const int* IDX = (const int*)(ws + WS_IDX);
    const unsigned char* V8 = ws + WS_V8; const unsigned char* AW8 = ws + WS_AW; const float* WMX = (const float*)(ws + WS_WMX);
    const unsigned short* H2S = (const unsigned short*)(ws + WS_H2B);
    const int TPB = NTOK / (int)gridDim.x, t0 = blockIdx.x * TPB, NST = TPB * 4;
    const int r0 = 16 * wave + (lane >> 3), r1 = r0 + 8;
    const unsigned c0 = 16u * (unsigned)((lane & 7) ^ ((r0 >> 1) & 7)), c1 = 16u * (unsigned)((lane & 7) ^ ((r1 >> 1) & 7));
    const int i16 = lane & 15, kb = lane >> 4;
    const int ra = 32 * kb + i16, rb = ra + 16;
    const unsigned offa = (unsigned)(ra * 128 + 16 * (wave ^ ((ra >> 1) & 7))), offb = (unsigned)(rb * 128 + 16 * (wave ^ ((rb >> 1) & 7)));
    const unsigned aoffb = (unsigned)(((i16 & 1) ? 128 : 0) + 16 * kb);
    const bool arow = (i16 & 3) < 2;
    const int colb = 256 * kb + 32 * wave + i16;
    const float gf0 = P.g_fin[colb], gf1 = P.g_fin[colb + 16];
    LAS float* SS = (LAS float*)(lds + 131072 + 1024);
    const unsigned lbase = (unsigned)(unsigned long long)lds;
    struct VTok { u32x4 a, b; float w; unsigned h0, h1; };
    VTok C0, C1;
    int ia1, ib1, ia2, ib2, ia3, ib3;
#define VM_ISSUE(g, e0, e1) do { LAS unsigned char* _d = lds + (((g) & 7) * 16384) + wave * 2048; const unsigned _cb = 128u * (unsigned)((g) & 3); \
        __builtin_amdgcn_global_load_lds((const unsigned*)(V8 + (size_t)(e0) * 512 + _cb + c0), (LAS unsigned*)(_d), 16, 0, 0); \
        __builtin_amdgcn_global_load_lds((const unsigned*)(V8 + (size_t)(e1) * 512 + _cb + c1), (LAS unsigned*)(_d + 1024), 16, 0, 0); } while (0)
    {
        const int ia0 = IDX[(size_t)t0 * NSEL + r0], ib0 = IDX[(size_t)t0 * NSEL + r1];
        ia1 = IDX[(size_t)(t0 + 1) * NSEL + r0]; ib1 = IDX[(size_t)(t0 + 1) * NSEL + r1];
        ia2 = IDX[(size_t)(t0 + 2) * NSEL + r0]; ib2 = IDX[(size_t)(t0 + 2) * NSEL + r1];
        ia3 = IDX[(size_t)(t0 + 3) * NSEL + r0]; ib3 = IDX[(size_t)(t0 + 3) * NSEL + r1];
        const unsigned char* ap = AW8 + (size_t)t0 * 256 + aoffb;
        C0.a = *(const u32x4*)ap; C0.b = *(const u32x4*)(ap + 64); C0.w = WMX[t0]; C0.h0 = H2S[(size_t)t0 * DM + colb]; C0.h1 = H2S[(size_t)t0 * DM + colb + 16];
        C1.a = *(const u32x4*)(ap + 256); C1.b = *(const u32x4*)(ap + 256 + 64); C1.w = WMX[t0 + 1]; C1.h0 = H2S[(size_t)(t0 + 1) * DM + colb]; C1.h1 = H2S[(size_t)(t0 + 1) * DM + colb + 16];
        asm volatile("s_waitcnt vmcnt(0)" ::: "memory");
        VM_ISSUE(0, ia0, ib0); VM_ISSUE(1, ia0, ib0); VM_ISSUE(2, ia0, ib0); VM_ISSUE(3, ia0, ib0);
        VM_ISSUE(4, ia1, ib1); VM_ISSUE(5, ia1, ib1); VM_ISSUE(6, ia1, ib1);
    }
    float pv0 = 0.f, pv1 = 0.f;
    VTok N0, N1; int na4, nb4, na5, nb5;
    auto token = [&](const int i, const bool even, const VTok& C, const int e1a, const int e1b, const int e2a, const int e2b) __attribute__((always_inline)) {
        const int t = t0 + i;
        const u32x4 z = (u32x4){0u, 0u, 0u, 0u}; const u32x4 Alo = arow ? C.a : z, Ahi = arow ? C.b : z;
        const i32x8v A = (i32x8v){(int)Alo.x, (int)Alo.y, (int)Alo.z, (int)Alo.w, (int)Ahi.x, (int)Ahi.y, (int)Ahi.z, (int)Ahi.w};
        f32x4 acc[4][2];
#pragma unroll
        for (int cc = 0; cc < 4; ++cc) {
            const int g = 4 * i + cc;
            if (even && cc == 0) { VM_WAIT(12); } else { VM_WAIT(26); }
            asm volatile("s_waitcnt lgkmcnt(0)" ::: "memory");
            __builtin_amdgcn_s_barrier();
            __builtin_amdgcn_sched_barrier(0);
            { const int gn = g + 7;
              if (cc == 0) VM_ISSUE(gn, e1a, e1b); else VM_ISSUE(gn, e2a, e2b); }
            __builtin_amdgcn_sched_barrier(0);
            if (cc == 0) {
                if (even) {
                    const int tA = t0 + ((i + 2 < TPB) ? i + 2 : TPB - 2), tI = t0 + ((i + 4 < TPB) ? i + 4 : TPB - 2);
                    const unsigned char* ap = AW8 + (size_t)tA * 256 + aoffb; const float* wp = WMX + tA; const int* ipa = IDX + (size_t)tI * NSEL + r0; const unsigned short* hp = H2S + (size_t)tA * DM + colb;
                    asm volatile("global_load_dwordx4 %0, %14, off\n\tglobal_load_dwordx4 %1, %14, off offset:64\n\tglobal_load_dwordx4 %2, %14, off offset:256\n\tglobal_load_dwordx4 %3, %14, off offset:320\n\t"
                                 "global_load_dword %4, %15, off\n\tglobal_load_dword %5, %15, off offset:4\n\t"
                                 "global_load_ushort %6, %17, off\n\tglobal_load_ushort %7, %17, off offset:32\n\tglobal_load_ushort %8, %17, off offset:2048\n\tglobal_load_ushort %9, %17, off offset:2080\n\t"
                                 "global_load_dword %10, %16, off\n\tglobal_load_dword %11, %16, off offset:32\n\tglobal_load_dword %12, %16, off offset:512\n\tglobal_load_dword %13, %16, off offset:544"
                                 : "=&v"(N0.a), "=&v"(N0.b), "=&v"(N1.a), "=&v"(N1.b), "=&v"(N0.w), "=&v"(N1.w), "=&v"(N0.h0), "=&v"(N0.h1), "=&v"(N1.h0), "=&v"(N1.h1), "=&v"(na4), "=&v"(nb4), "=&v"(na5), "=&v"(nb5)
                                 : "v"(ap), "v"(wp), "v"(ipa), "v"(hp) : "memory");
                }
                { const f32x4 s0 = *(const LAS f32x4*)(SS + 8 * ((i + 1) & 1)), s1 = *(const LAS f32x4*)(SS + 8 * ((i + 1) & 1) + 4);
                  const float ss = ((s0.x + s0.y) + (s0.z + s0.w)) + ((s1.x + s1.y) + (s1.z + s1.w));
                  const float r3 = rsqrtf(ss * (1.f / DM) + EPS);
                  float* op = P.out + (size_t)((i > 0) ? t - 1 : t) * DM + colb;
                  op[0] = pv0 * r3 * gf0; op[16] = pv1 * r3 * gf1; }
                __builtin_amdgcn_sched_barrier(0);
            }
            const unsigned sa = lbase + (unsigned)((g & 7) * 16384) + offa, sbb = lbase + (unsigned)((g & 7) * 16384) + offb;
            i32x2v b00, b01, b10, b11;
            asm volatile("ds_read_b64_tr_b4 %0, %4\n\tds_read_b64_tr_b4 %1, %5\n\tds_read_b64_tr_b4 %2, %4 offset:8\n\tds_read_b64_tr_b4 %3, %5 offset:8\n\ts_waitcnt lgkmcnt(0)"
                         : "=&v"(b00), "=&v"(b01), "=&v"(b10), "=&v"(b11) : "v"(sa), "v"(sbb) : "memory");
            const i32x8v B0 = (i32x8v){b00.x, b00.y, b01.x, b01.y, 0, 0, 0, 0}, B1 = (i32x8v){b10.x, b10.y, b11.x, b11.y, 0, 0, 0, 0};
            const f32x4 z4 = (f32x4){0.f, 0.f, 0.f, 0.f};
            acc[cc][0] = __builtin_amdgcn_mfma_scale_f32_16x16x128_f8f6f4(A, B0, z4, 0  , 4  , 0, 0x7f7f7f7f, 0, 0x7f7f7f7f);
            acc[cc][1] = __builtin_amdgcn_mfma_scale_f32_16x16x128_f8f6f4(A, B1, z4, 0, 4, 0, 0x7f7f7f7f, 0, 0x7f7f7f7f);
        }
        float s0 = acc[0][0].x + acc[0][0].y, s1 = acc[0][1].x + acc[0][1].y;
        { const float a0 = acc[1][0].x + acc[1][0].y, a1 = acc[1][1].x + acc[1][1].y, b0 = acc[2][0].x + acc[2][0].y, b1 = acc[2][1].x + acc[2][1].y, d0 = acc[3][0].x + acc[3][0].y, d1 = acc[3][1].x + acc[3][1].y;
          s0 = (kb == 1) ? a0 : s0; s1 = (kb == 1) ? a1 : s1; s0 = (kb == 2) ? b0 : s0; s1 = (kb == 2) ? b1 : s1; s0 = (kb == 3) ? d0 : s0; s1 = (kb == 3) ? d1 : s1; }
        pv0 = s0 * C.w + __uint_as_float(C.h0 << 16); pv1 = s1 * C.w + __uint_as_float(C.h1 << 16);
        const float sq = wave_sum_fast(pv0 * pv0 + pv1 * pv1);
        if (lane == 0) SS[8 * (i & 1) + wave] = sq;
    };
#pragma unroll 1
    for (int i = 0; i < TPB; i += 2) {
        token(i, true, C0, ia1, ib1, ia2, ib2);
        token(i + 1, false, C1, ia2, ib2, ia3, ib3);
        asm volatile("s_waitcnt vmcnt(14)" : "+v"(N0.a), "+v"(N0.b), "+v"(N1.a), "+v"(N1.b), "+v"(N0.w), "+v"(N1.w), "+v"(N0.h0), "+v"(N0.h1), "+v"(N1.h0), "+v"(N1.h1), "+v"(na4), "+v"(nb4), "+v"(na5), "+v"(nb5) :: "memory");
        C0 = N0; C1 = N1; ia1 = ia3; ib1 = ib3; ia2 = na4; ib2 = nb4; ia3 = na5; ib3 = nb5;
    }
    asm volatile("s_waitcnt vmcnt(0)" ::: "memory");
    __builtin_amdgcn_s_barrier();
    { const int i = TPB; const f32x4 s0 = *(const LAS f32x4*)(SS + 8 * ((i + 1) & 1)), s1 = *(const LAS f32x4*)(SS + 8 * ((i + 1) & 1) + 4);
      const float ss = ((s0.x + s0.y) + (s0.z + s0.w)) + ((s1.x + s1.y) + (s1.z + s1.w));
      const float r3 = rsqrtf(ss * (1.f / DM) + EPS);
      float* op = P.out + (size_t)(t0 + TPB - 1) * DM + colb;
      op[0] = pv0 * r3 * gf0; op[16] = pv1 * r3 * gf1; }
#undef VM_ISSUE
}
#define XB_TMO      128
#define XB_XCNT(j)  (256  + 64 * (j))
#define XB_XSUB(j)  (1280 + 64 * (j))
#define XB_XGEN(j)  (2304 + 64 * (j))
#define XB_TOP      3328
#define XB_TOPGEN   3392
#define XCD_BAR_WORDS 3456
#define XB_SPIN_CAP (1u << 18)

__device__ __forceinline__ unsigned xb_ld(unsigned* p)              { return __hip_atomic_load(p, __ATOMIC_RELAXED, __HIP_MEMORY_SCOPE_AGENT); }
__device__ __forceinline__ unsigned xb_add(unsigned* p, unsigned v) { return __hip_atomic_fetch_add(p, v, __ATOMIC_RELAXED, __HIP_MEMORY_SCOPE_AGENT); }
__device__ __forceinline__ unsigned xb_xcc_id() { return (unsigned)__builtin_amdgcn_s_getreg((3 << 11) | 20) & 0xFu; }
#define XB_SPIN(cond, bar) do { unsigned _sp = 0; while (cond) { __builtin_amdgcn_s_sleep(1); \
    if ((++_sp & 255u) == 0u) { if (xb_ld(&(bar)[XB_TMO])) break; if (_sp > XB_SPIN_CAP) { atomicAdd(&(bar)[XB_TMO], 1u); break; } } } } while (0)

struct XcdBarrier {
    unsigned* bar; unsigned x;
    volatile LAS unsigned* st;
};

__device__ __forceinline__ XcdBarrier xcd_barrier_post(unsigned* bar, volatile LAS unsigned* st) {
    XcdBarrier b; b.bar = bar; b.x = xb_xcc_id(); b.st = st;
    if (threadIdx.x == 0) (void)xb_add(&bar[XB_XCNT(b.x)], 1u);
    return b;
}
__device__ __forceinline__ void xcd_barrier_complete(unsigned* bar, unsigned x, unsigned& nloc, unsigned& nx) {
    const unsigned G = gridDim.x * gridDim.y * gridDim.z;
    unsigned sum, cnt, mine, sp = 0u;
    for (;;) {
        sum = 0u; cnt = 0u; mine = 0u;
#pragma unroll
        for (unsigned j = 0; j < 16; ++j) { const unsigned c = xb_ld(&bar[XB_XCNT(j)]); sum += c; cnt += (c > 0u) ? 1u : 0u; mine = (j == x) ? c : mine; }
        if (sum == G) break;
        __builtin_amdgcn_s_sleep(1);
        if ((++sp & 255u) == 0u) { if (xb_ld(&bar[XB_TMO])) break; if (sp > XB_SPIN_CAP) { atomicAdd(&bar[XB_TMO], 1u); break; } }
    }
    nloc = mine > 0u ? mine : 1u; nx = cnt > 0u ? cnt : 1u;
}

__device__ __forceinline__ void xcd_barrier(const XcdBarrier& b) {
    asm volatile("s_waitcnt vmcnt(0)" ::: "memory");
    __syncthreads();
    if (threadIdx.x == 0) {
        unsigned* bar = b.bar;
        __builtin_amdgcn_s_waitcnt(0);
        unsigned nloc = b.st[0], nx = b.st[1];
        if (nloc == 0u) { xcd_barrier_complete(bar, b.x, nloc, nx); b.st[0] = nloc; b.st[1] = nx; }
        const unsigned old = xb_add(&bar[XB_XSUB(b.x)], 1u);
        const unsigned gen = old / nloc;
        if (old + 1u == (gen + 1u) * nloc) {
            __builtin_amdgcn_fence(__ATOMIC_RELEASE, "agent");
            asm volatile("s_waitcnt vmcnt(0)" ::: "memory");
            const unsigned og = xb_add(&bar[XB_TOP], 1u);
            const unsigned tg = og / nx;
            if (og + 1u == (tg + 1u) * nx) xb_add(&bar[XB_TOPGEN], 1u);
            else XB_SPIN(xb_ld(&bar[XB_TOPGEN]) == tg, bar);
            __builtin_amdgcn_fence(__ATOMIC_ACQUIRE, "agent");
            xb_add(&bar[XB_XGEN(b.x)], 1u);
            asm volatile("s_waitcnt vmcnt(0)" ::: "memory");
        } else {
            XB_SPIN(xb_ld(&bar[XB_XGEN(b.x)]) == gen, bar);
            __builtin_amdgcn_fence(__ATOMIC_ACQUIRE, "agent");
            asm volatile("s_waitcnt vmcnt(0)" ::: "memory");
        }
    }
    __syncthreads();
}


#ifndef MK_MULTI
#define MK_MULTI 0
#endif
constexpr int NPHASE = 9;
#ifndef REP5
#define REP5 1
#endif
#ifndef REP6
#define REP6 1
#endif
__global__ void __launch_bounds__(NTHREADS, 2) mk_fwd(Params P) {
    extern __shared__ __attribute__((aligned(16))) unsigned char lds_raw[];
    LAS unsigned char* lds = (LAS unsigned char*)lds_raw;
    cg::grid_group grid = cg::this_grid();
    unsigned char* ws = P.ws;
    const int lo = P.ph_lo, hi = P.ph_hi;
    volatile LAS unsigned* bst = (volatile LAS unsigned*)(lds + 131072 + 64);
    if (threadIdx.x < 2) bst[threadIdx.x] = 0u;
    __syncthreads();
    XcdBarrier xbar = xcd_barrier_post((unsigned*)(ws + WS_CTL), bst);
#define IN(k) (lo <= (k) && (k) < hi)
#define SEAM(k) do { if (IN(k) && IN((k) + 1)) { xcd_barrier(xbar); } } while (0)
    if (IN(0)) phase_prep(P, lds);
    SEAM(0);
    if (IN(1)) { phase_metaproj(P); phase_winq(P, lds); }
    SEAM(1);
    if (IN(2)) {
        pg8::Gemm g{(const bf16*)(ws + WS_H0I8), (const bf16*)(ws + WS_WIN_T), NTOK, DIN, DM / 2}; pg8::StaticOrder S; S.init(NTOK, DIN, (int)gridDim.x, (int)blockIdx.x);
        EpiProjI8 E{(bf16*)(ws + WS_PROJ), (const float*)(ws + WS_RSTD1), (const float*)(ws + WS_SW)};
        pg8::gemm_phase_i8<EpiProjI8, pg8::StaticOrder, true, true>(lds, g, S, E);
    }
    SEAM(2);
    if (IN(3)) phase_conv(P, lds);
    SEAM(3);
    if (IN(4)) {
        pg8::Gemm g{(const bf16*)(ws + WS_Y), (const bf16*)(ws + WS_WOUT_T), NTOK, DM, DM / 2}; pg8::StaticOrder S; S.init(NTOK, DM, (int)gridDim.x, (int)blockIdx.x);
        EpiResidualI8 E{(bf16*)(ws + WS_H2B), (const signed char*)(ws + WS_H0I8), (const float*)(ws + WS_SX), (const float*)(ws + WS_SY), (const float*)(ws + WS_SWO), (float*)(ws + WS_SSQ)};
        pg8::gemm_phase_i8<EpiResidualI8, pg8::StaticOrder, true, true>(lds, g, S, E);
    }
    SEAM(4);
    if (IN(5)) {
        pg8::Gemm g{(const bf16*)(ws + WS_H2B), (const bf16*)(ws + WS_WQ_T), NTOK, 2048, DM}; pg8::StaticOrder S; S.init(NTOK, 2048, (int)gridDim.x, (int)blockIdx.x);
        EpiRowScale<1> E{(bf16*)(ws + WS_Q), 2048, (const float*)(ws + WS_SSQ)};
        pg8::gemm_phase<EpiRowScale<1>, pg8::StaticOrder, true, true>(lds, g, S, E);
    }
    if (IN(5) && IN(6)) { asm volatile("s_waitcnt vmcnt(0)" ::: "memory"); __syncthreads(); }
    if (IN(6)) phase_route(P, lds);
    SEAM(6);
    if (IN(7)) phase_gather_u(P);
    SEAM(7);
    if (IN(8)) phase_gather_v_mfma(P, lds);
#undef IN
#undef SEAM
}

extern "C" void kernel_launch(void* const* d_in, const int* in_sizes, int n_in, void* d_out, int out_size, void* d_ws, size_t ws_size, hipStream_t stream) {
    static int grid = 0;
    if (grid == 0) {
        if (n_in != 18 || in_sizes[0] != NTOK * DM || out_size != NTOK * DM || ws_size < WS_END) {
            fprintf(stderr, "kernel_launch: unexpected shapes (n_in %d in0 %d out %d ws %zu)\n", n_in, n_in > 0 ? in_sizes[0] : -1, out_size, ws_size); grid = -1; return; }
        int dev = 0, cus = 0, per_cu = 0;
        (void)hipGetDevice(&dev); (void)hipDeviceGetAttribute(&cus, hipDeviceAttributeMultiprocessorCount, dev);
        if (hipFuncSetAttribute((const void*)mk_fwd, hipFuncAttributeMaxDynamicSharedMemorySize, LDS_BYTES) != hipSuccess) { fprintf(stderr, "kernel_launch: hipFuncSetAttribute failed\n"); grid = -1; return; }
        if (hipOccupancyMaxActiveBlocksPerMultiprocessor(&per_cu, (const void*)mk_fwd, NTHREADS, LDS_BYTES) != hipSuccess || per_cu < 1) { fprintf(stderr, "kernel_launch: occupancy query failed (%d)\n", per_cu); (void)hipGetLastError(); per_cu = 1; }
        if (per_cu > 1) per_cu = 1;
        grid = cus * per_cu;
        if (grid <= 0) grid = 256;
    }
    if (grid < 0) return;
    Params p{};
    p.x = (const float*)d_in[0]; p.meta = (const float*)d_in[1]; p.g_mix = (const float*)d_in[2]; p.w_in = (const float*)d_in[3]; p.sc_w = (const float*)d_in[4];
    p.cf_w = (const float*)d_in[5]; p.cf_b = (const float*)d_in[6]; p.ln_g = (const float*)d_in[7]; p.ln_b = (const float*)d_in[8]; p.g_sc = (const float*)d_in[9];
    p.g_cf = (const float*)d_in[10]; p.w_out = (const float*)d_in[11]; p.g_ffn = (const float*)d_in[12]; p.w_q = (const float*)d_in[13]; p.keys = (const float*)d_in[14];
    p.pu = (const float*)d_in[15]; p.pv = (const float*)d_in[16]; p.g_fin = (const float*)d_in[17];
    p.out = (float*)d_out; p.ws = (unsigned char*)d_ws;
    (void)hipMemsetAsync((char*)d_ws + WS_CTL, 0, 40960, stream);
#if MK_MULTI
    for (int ph = 0; ph < NPHASE; ++ph) { p.ph_lo = ph; p.ph_hi = ph + 1; p.coop = 0; p.pad = 0;
        hipLaunchKernelGGL(mk_fwd, dim3(grid), dim3(NTHREADS), LDS_BYTES, stream, p); }
#else
    p.ph_lo = 0; p.ph_hi = NPHASE; p.coop = 1; p.pad = 0;
    void* args[] = {&p};
    hipError_t e = hipLaunchCooperativeKernel((const void*)mk_fwd, dim3(grid), dim3(NTHREADS), args, LDS_BYTES, stream);
    if (e != hipSuccess) fprintf(stderr, "cooperative launch failed: %s (grid %d)\n", hipGetErrorString(e), grid);
#endif
}
```

```cpp
#include <hip/hip_runtime.h>
#include <hip/hip_cooperative_groups.h>
#include <cstdio>
#include <cstdint>
namespace cg = cooperative_groups;

namespace pg8 {
#define PG8_LAS __attribute__((address_space(3)))
typedef unsigned short bf16_t;
typedef short bf16x8 __attribute__((ext_vector_type(8)));
typedef float f32x4 __attribute__((ext_vector_type(4)));
typedef unsigned u32x4 __attribute__((ext_vector_type(4)));
typedef int i32x4 __attribute__((ext_vector_type(4)));
constexpr int BM = 256, BK = 64, HALF = 128, HTB = HALF * BK * 2  , STAGE_BYTES = 8 * HTB, NXCD = 8, WGM = 8;

__host__ __device__ __forceinline__ int lds_byte(int r, int c) { const int st = (r >> 4) * 2 + (c >> 5), rr = r & 15, cc = c & 31, ob = rr * 64 + cc * 2; return st * 1024 + (ob ^ (((ob >> 9) & 1) << 5)); }
__host__ __device__ __forceinline__ void stage_rc(int b, int& R, int& C) { const int st = b / 1024, sb = b % 1024, swz = sb ^ (((sb >> 9) & 1) << 5); R = (st >> 1) * 16 + swz / 64; C = (st & 1) * 32 + (swz % 64) / 2; }
__host__ __device__ __forceinline__ int perm32(int rho) { const int n = rho >> 4, i = rho & 15; return 8 * (i >> 2) + 4 * n + (i & 3); }

struct Unit { int pm, pn; };
struct Gemm { const bf16_t* A; const bf16_t* Bt; int M, N, K; };

struct StaticOrder {
    int nM, nN, nwg, G, c;
    __host__ __device__ void init(int M, int N, int G_, int c_) { nM = M / BM; nN = N / BM; nwg = nM * nN; G = G_; c = c_; }
    __host__ __device__ bool next(int i, Unit& u) const {
        const long L = (long)i * G + c; if (L >= nwg) return false;
        int wgid = (int)L; { const int q = nwg / NXCD, r = nwg % NXCD, xcd = wgid % NXCD, off = wgid / NXCD; wgid = (xcd < r ? xcd * (q + 1) : r * (q + 1) + (xcd - r) * q) + off; }
        const int nig = WGM * nN, gid = wgid / nig, fm = gid * WGM, gsz = (nM - fm) < WGM ? (nM - fm) : WGM;
        u.pm = fm + ((wgid % nig) % gsz); u.pn = (wgid % nig) / gsz; return true;
    }
    __device__ __forceinline__ void a_ready(const Unit&) const {}
    __device__ __forceinline__ void done(const Unit&) const {}
};

template <class Epi, class Sched, bool ALIGN_EPI = false, bool SP2 = false>
__device__ __forceinline__ void gemm_phase(PG8_LAS unsigned char* lds, const Gemm g, const Sched& S, const Epi& E) {
    const int tid = threadIdx.x, wid = __builtin_amdgcn_readfirstlane(tid >> 6), lane = tid & 63, wr = wid >> 2, wc = wid & 3, fr = lane & 15, fq = lane >> 4;
    const int K = g.K, nt = K / BK;
    unsigned voffA[2], voffB[2];
#pragma unroll
    for (int i = 0; i < 2; ++i) { int R, C; stage_rc(tid * 16 + i * 8192, R, C); const int Rb = Epi::PERM ? ((R & ~31) + perm32(R & 31)) : R;
        voffA[i] = (unsigned)(R * K + C) * 2u; voffB[i] = (unsigned)(Rb * K + C) * 2u; }
    const size_t kstep = (size_t)(BK * 2);
    const size_t hstep = (size_t)HALF * K * 2;
    const size_t tstep = 2 * hstep;
    const unsigned ldsw = (unsigned)wid * 1024u;
    const int aoff = lds_byte(wr * 64 + fr, fq * 8), boff = lds_byte(wc * 32 + fr, fq * 8);
#define PG8_SA(b, h) (((b) * 2 + (h)) * HTB)
#define PG8_SB(b, h) ((4 + (b) * 2 + (h)) * HTB)
#define PG8_STAGE(bufoff, gbase, voff) do { _Pragma("unroll") for (int _i = 0; _i < 2; ++_i) \
        __builtin_amdgcn_global_load_lds((const unsigned*)((const char*)(gbase) + (voff)[_i]), (PG8_LAS unsigned*)(lds + (bufoff) + ldsw + _i * 8192), 16, 0, 0); } while (0)
#define PG8_LDA(dst, b, h) do { _Pragma("unroll") for (int m = 0; m < 4; ++m) _Pragma("unroll") for (int k = 0; k < 2; ++k) dst[m][k] = *(const PG8_LAS bf16x8*)(lds + PG8_SA(b, h) + aoff + m * 2048 + k * 1024); } while (0)
#define PG8_LDB(dst, b, h) do { _Pragma("unroll") for (int n = 0; n < 2; ++n) _Pragma("unroll") for (int k = 0; k < 2; ++k) dst[n][k] = *(const PG8_LAS bf16x8*)(lds + PG8_SB(b, h) + boff + n * 2048 + k * 1024); } while (0)
#define PG8_MMA(ai, bj, At, Bt) do { __builtin_amdgcn_s_setprio(1); _Pragma("unroll") for (int m = 0; m < 4; ++m) _Pragma("unroll") for (int n = 0; n < 2; ++n) _Pragma("unroll") for (int k = 0; k < 2; ++k) \
        acc[ai][bj][m][n] = __builtin_amdgcn_mfma_f32_16x16x32_bf16(Bt[n][k], At[m][k], acc[ai][bj][m][n], 0, 0, 0); __builtin_amdgcn_s_setprio(0); } while (0)
#define PG8_WAIT_V(n) asm volatile("s_waitcnt vmcnt(" #n ")" ::: "memory")
#define PG8_WAIT_L(n) asm volatile("s_waitcnt lgkmcnt(" #n ")" ::: "memory")
#define PG8_BAR __builtin_amdgcn_s_barrier()
#define PG8_SCHED __builtin_amdgcn_sched_barrier(0)
    Unit cur, nxt; int ui = 0;
    if (!S.next(0, cur)) return;
    f32x4 acc[2][2][4][2];
#pragma unroll
    for (int a = 0; a < 2; ++a)
#pragma unroll
        for (int b = 0; b < 2; ++b)
#pragma unroll
            for (int m = 0; m < 4; ++m)
#pragma unroll
                for (int n = 0; n < 2; ++n) acc[a][b][m][n] = (f32x4){0.f, 0.f, 0.f, 0.f};
    bf16x8 At[4][2], B0[2][2], B1[2][2];
    const char* cA = (const char*)g.A + (size_t)cur.pm * tstep; const char* cB = (const char*)g.Bt + (size_t)cur.pn * tstep;
    S.a_ready(cur);
    if constexpr (SP2) {
        PG8_STAGE(PG8_SB(0, 0), cB, voffB); PG8_STAGE(PG8_SB(0, 1), cB + hstep, voffB); PG8_STAGE(PG8_SA(0, 0), cA, voffA); PG8_STAGE(PG8_SA(0, 1), cA + hstep, voffA);
        if (wr == 1) PG8_BAR;
        PG8_WAIT_V(2); PG8_BAR;
        PG8_STAGE(PG8_SB(1, 0), cB + kstep, voffB); PG8_STAGE(PG8_SA(1, 0), cA + kstep, voffA); PG8_STAGE(PG8_SB(1, 1), cB + hstep + kstep, voffB);
        PG8_WAIT_V(6); PG8_BAR;
    } else {
        PG8_STAGE(PG8_SB(0, 0), cB, voffB); PG8_STAGE(PG8_SA(0, 0), cA, voffA); PG8_STAGE(PG8_SB(0, 1), cB + hstep, voffB); PG8_STAGE(PG8_SA(0, 1), cA + hstep, voffA);
        if (wr == 1) PG8_BAR;
        PG8_WAIT_V(4); PG8_BAR;
        PG8_STAGE(PG8_SB(1, 0), cB + kstep, voffB); PG8_STAGE(PG8_SA(1, 0), cA + kstep, voffA); PG8_STAGE(PG8_SB(1, 1), cB + hstep + kstep, voffB);
        PG8_WAIT_V(6); PG8_BAR;
    }
    for (;;) {
        const bool has_next = S.next(ui + 1, nxt);
        const char* nA = has_next ? (const char*)g.A + (size_t)nxt.pm * tstep : cA; const char* nB = has_next ? (const char*)g.Bt + (size_t)nxt.pn * tstep : cB;
        for (int t = 0; t < nt; t += 2) {
            const bool last = (t == nt - 2);
            const char* a1 = cA + (size_t)(t + 1) * kstep;
            const char* a2 = last ? nA : cA + (size_t)(t + 2) * kstep; const char* b2 = last ? nB : cB + (size_t)(t + 2) * kstep;
            const char* a3 = a2 + kstep; const char* b3 = b2 + kstep;
            if (last && has_next) S.a_ready(nxt);
            if constexpr (SP2) {
            PG8_LDB(B0, 0, 0); PG8_LDB(B1, 0, 1); PG8_SCHED; PG8_LDA(At, 0, 0); PG8_STAGE(PG8_SA(1, 1), a1 + hstep, voffA);
            PG8_WAIT_V(8); PG8_WAIT_L(0); PG8_BAR; PG8_MMA(0, 0, At, B0); PG8_MMA(0, 1, At, B1); PG8_BAR; PG8_SCHED;
            PG8_LDA(At, 0, 1); PG8_STAGE(PG8_SB(0, 0), b2, voffB); PG8_STAGE(PG8_SB(0, 1), b2 + hstep, voffB); PG8_STAGE(PG8_SA(0, 0), a2, voffA);
            PG8_WAIT_V(8); PG8_WAIT_L(0); PG8_BAR; PG8_MMA(1, 0, At, B0); PG8_MMA(1, 1, At, B1); PG8_BAR; PG8_SCHED;
            PG8_LDB(B0, 1, 0); PG8_LDB(B1, 1, 1); PG8_SCHED; PG8_LDA(At, 1, 0); PG8_STAGE(PG8_SA(0, 1), a2 + hstep, voffA);
            PG8_WAIT_V(8); PG8_WAIT_L(0); PG8_BAR; PG8_MMA(0, 0, At, B0); PG8_MMA(0, 1, At, B1); PG8_BAR; PG8_SCHED;
            PG8_LDA(At, 1, 1); PG8_STAGE(PG8_SB(1, 0), b3, voffB); PG8_STAGE(PG8_SB(1, 1), b3 + hstep, voffB); PG8_STAGE(PG8_SA(1, 0), a3, voffA);
            PG8_WAIT_V(8); PG8_WAIT_L(0); PG8_BAR; PG8_MMA(1, 0, At, B0); PG8_MMA(1, 1, At, B1); PG8_BAR; PG8_SCHED;
            } else {
            PG8_LDB(B0, 0, 0); PG8_SCHED; PG8_LDA(At, 0, 0); PG8_STAGE(PG8_SA(1, 1), a1 + hstep, voffA);
            PG8_WAIT_L(8); PG8_BAR; PG8_WAIT_L(0); PG8_MMA(0, 0, At, B0); PG8_BAR; PG8_SCHED;
            PG8_LDB(B1, 0, 1); PG8_STAGE(PG8_SB(0, 0), b2, voffB);
            PG8_BAR; PG8_WAIT_L(0); PG8_MMA(0, 1, At, B1); PG8_BAR;
            PG8_LDA(At, 0, 1); PG8_STAGE(PG8_SA(0, 0), a2, voffA);
            PG8_BAR; PG8_WAIT_L(0); PG8_MMA(1, 0, At, B0); PG8_BAR; PG8_SCHED;
            PG8_STAGE(PG8_SB(0, 1), b2 + hstep, voffB);
            PG8_WAIT_V(6); PG8_BAR; PG8_MMA(1, 1, At, B1); PG8_BAR;
            PG8_LDB(B0, 1, 0); PG8_SCHED; PG8_LDA(At, 1, 0); PG8_STAGE(PG8_SA(0, 1), a2 + hstep, voffA);
            PG8_WAIT_L(8); PG8_BAR; PG8_WAIT_L(0); PG8_MMA(0, 0, At, B0); PG8_BAR; PG8_SCHED;
            PG8_LDB(B1, 1, 1); PG8_STAGE(PG8_SB(1, 0), b3, voffB);
            PG8_BAR; PG8_WAIT_L(0); PG8_MMA(0, 1, At, B1); PG8_BAR;
            PG8_LDA(At, 1, 1); PG8_STAGE(PG8_SA(1, 0), a3, voffA);
            PG8_BAR; PG8_WAIT_L(0); PG8_MMA(1, 0, At, B0); PG8_BAR; PG8_SCHED;
            PG8_STAGE(PG8_SB(1, 1), b3 + hstep, voffB);
            PG8_WAIT_V(6); PG8_BAR; PG8_MMA(1, 1, At, B1); PG8_BAR;
            }
        }
        if constexpr (ALIGN_EPI) { if (wr == 0) PG8_BAR; }
        if constexpr (!Epi::AFTER_DRAIN) { E(acc, cur, wr, wc, fr, fq); S.done(cur); }
        if (!has_next) break;
#pragma unroll
        for (int a = 0; a < 2; ++a)
#pragma unroll
            for (int b = 0; b < 2; ++b)
#pragma unroll
                for (int m = 0; m < 4; ++m)
#pragma unroll
                    for (int n = 0; n < 2; ++n) acc[a][b][m][n] = (f32x4){0.f, 0.f, 0.f, 0.f};
        cur = nxt; cA = nA; cB = nB; ++ui;
        if constexpr (ALIGN_EPI) { if (wr == 1) PG8_BAR; }
    }
    PG8_WAIT_V(0);
    if constexpr (!ALIGN_EPI) { if (wr == 0) PG8_BAR; }
    PG8_BAR;
    if constexpr (Epi::AFTER_DRAIN) { E.fused(acc, cur, wr, wc, fr, fq, lds, wid, lane); S.done(cur); }
#undef PG8_SA
#undef PG8_SB
#undef PG8_STAGE
#undef PG8_LDA
#undef PG8_LDB
#undef PG8_MMA
#undef PG8_WAIT_V
#undef PG8_WAIT_L
#undef PG8_BAR
#undef PG8_SCHED
}
template <class Epi, class Sched, bool ALIGN_EPI = false, bool SP2 = false>
__device__ __forceinline__ void gemm_phase_i8(PG8_LAS unsigned char* lds, const Gemm g, const Sched& S, const Epi& E) {
    const int tid = threadIdx.x, wid = __builtin_amdgcn_readfirstlane(tid >> 6), lane = tid & 63, wr = wid >> 2, wc = wid & 3, fr = lane & 15, fq = lane >> 4;
    const int K = g.K, nt = K / BK;
    unsigned voffA[2], voffB[2];
#pragma unroll
    for (int i = 0; i < 2; ++i) { int R, C; stage_rc(tid * 16 + i * 8192, R, C); const int Rb = Epi::PERM ? ((R & ~31) + perm32(R & 31)) : R;
        voffA[i] = (unsigned)(R * K + C) * 2u; voffB[i] = (unsigned)(Rb * K + C) * 2u; }
    const size_t kstep = (size_t)(BK * 2);
    const size_t hstep = (size_t)HALF * K * 2;
    const size_t tstep = 2 * hstep;
    const unsigned ldsw = (unsigned)wid * 1024u;
    const int aoff = lds_byte(wr * 64 + fr, fq * 8), boff = lds_byte(wc * 32 + fr, fq * 8);
#define PG8_SA(b, h) (((b) * 2 + (h)) * HTB)
#define PG8_SB(b, h) ((4 + (b) * 2 + (h)) * HTB)
#define PG8_STAGE(bufoff, gbase, voff) do { _Pragma("unroll") for (int _i = 0; _i < 2; ++_i) \
        __builtin_amdgcn_global_load_lds((const unsigned*)((const char*)(gbase) + (voff)[_i]), (PG8_LAS unsigned*)(lds + (bufoff) + ldsw + _i * 8192), 16, 0, 0); } while (0)
#define PG8_LDA(dst, b, h) do { _Pragma("unroll") for (int m = 0; m < 4; ++m) _Pragma("unroll") for (int k = 0; k < 2; ++k) dst[m][k] = *(const PG8_LAS bf16x8*)(lds + PG8_SA(b, h) + aoff + m * 2048 + k * 1024); } while (0)
#define PG8_LDB(dst, b, h) do { _Pragma("unroll") for (int n = 0; n < 2; ++n) _Pragma("unroll") for (int k = 0; k < 2; ++k) dst[n][k] = *(const PG8_LAS bf16x8*)(lds + PG8_SB(b, h) + boff + n * 2048 + k * 1024); } while (0)
#define PG8_MMA(ai, bj, At, Bt) do { __builtin_amdgcn_s_setprio(1); _Pragma("unroll") for (int m = 0; m < 4; ++m) _Pragma("unroll") for (int n = 0; n < 2; ++n) _Pragma("unroll") for (int k = 0; k < 2; ++k) \
        acc[ai][bj][m][n] = __builtin_amdgcn_mfma_i32_16x16x64_i8(__builtin_bit_cast(i32x4, Bt[n][k]), __builtin_bit_cast(i32x4, At[m][k]), acc[ai][bj][m][n], 0, 0, 0); __builtin_amdgcn_s_setprio(0); } while (0)
#define PG8_WAIT_V(n) asm volatile("s_waitcnt vmcnt(" #n ")" ::: "memory")
#define PG8_WAIT_L(n) asm volatile("s_waitcnt lgkmcnt(" #n ")" ::: "memory")
#define PG8_BAR __builtin_amdgcn_s_barrier()
#define PG8_SCHED __builtin_amdgcn_sched_barrier(0)
    Unit cur, nxt; int ui = 0;
    if (!S.next(0, cur)) return;
    i32x4 acc[2][2][4][2];
#pragma unroll
    for (int a = 0; a < 2; ++a)
#pragma unroll
        for (int b = 0; b < 2; ++b)
#pragma unroll
            for (int m = 0; m < 4; ++m)
#pragma unroll
                for (int n = 0; n < 2; ++n) acc[a][b][m][n] = (i32x4){0, 0, 0, 0};
    bf16x8 At[4][2], B0[2][2], B1[2][2];
    const char* cA = (const char*)g.A + (size_t)cur.pm * tstep; const char* cB = (const char*)g.Bt + (size_t)cur.pn * tstep;
    S.a_ready(cur);
    if constexpr (SP2) {
        PG8_STAGE(PG8_SB(0, 0), cB, voffB); PG8_STAGE(PG8_SB(0, 1), cB + hstep, voffB); PG8_STAGE(PG8_SA(0, 0), cA, voffA); PG8_STAGE(PG8_SA(0, 1), cA + hstep, voffA);
        if (wr == 1) PG8_BAR;
        PG8_WAIT_V(2); PG8_BAR;
        PG8_STAGE(PG8_SB(1, 0), cB + kstep, voffB); PG8_STAGE(PG8_SA(1, 0), cA + kstep, voffA); PG8_STAGE(PG8_SB(1, 1), cB + hstep + kstep, voffB);
        PG8_WAIT_V(6); PG8_BAR;
    } else {
        PG8_STAGE(PG8_SB(0, 0), cB, voffB); PG8_STAGE(PG8_SA(0, 0), cA, voffA); PG8_STAGE(PG8_SB(0, 1), cB + hstep, voffB); PG8_STAGE(PG8_SA(0, 1), cA + hstep, voffA);
        if (wr == 1) PG8_BAR;
        PG8_WAIT_V(4); PG8_BAR;
        PG8_STAGE(PG8_SB(1, 0), cB + kstep, voffB); PG8_STAGE(PG8_SA(1, 0), cA + kstep, voffA); PG8_STAGE(PG8_SB(1, 1), cB + hstep + kstep, voffB);
        PG8_WAIT_V(6); PG8_BAR;
    }
    for (;;) {
        const bool has_next = S.next(ui + 1, nxt);
        const char* nA = has_next ? (const char*)g.A + (size_t)nxt.pm * tstep : cA; const char* nB = has_next ? (const char*)g.Bt + (size_t)nxt.pn * tstep : cB;
        for (int t = 0; t < nt; t += 2) {
            const bool last = (t == nt - 2);
            const char* a1 = cA + (size_t)(t + 1) * kstep;
            const char* a2 = last ? nA : cA + (size_t)(t + 2) * kstep; const char* b2 = last ? nB : cB + (size_t)(t + 2) * kstep;
            const char* a3 = a2 + kstep; const char* b3 = b2 + kstep;
            if (last && has_next) S.a_ready(nxt);
            if constexpr (SP2) {
            PG8_LDB(B0, 0, 0); PG8_LDB(B1, 0, 1); PG8_SCHED; PG8_LDA(At, 0, 0); PG8_STAGE(PG8_SA(1, 1), a1 + hstep, voffA);
            PG8_WAIT_V(8); PG8_WAIT_L(0); PG8_BAR; PG8_MMA(0, 0, At, B0); PG8_MMA(0, 1, At, B1); PG8_BAR; PG8_SCHED;
            PG8_LDA(At, 0, 1); PG8_STAGE(PG8_SB(0, 0), b2, voffB); PG8_STAGE(PG8_SB(0, 1), b2 + hstep, voffB); PG8_STAGE(PG8_SA(0, 0), a2, voffA);
            PG8_WAIT_V(8); PG8_WAIT_L(0); PG8_BAR; PG8_MMA(1, 0, At, B0); PG8_MMA(1, 1, At, B1); PG8_BAR; PG8_SCHED;
            PG8_LDB(B0, 1, 0); PG8_LDB(B1, 1, 1); PG8_SCHED; PG8_LDA(At, 1, 0); PG8_STAGE(PG8_SA(0, 1), a2 + hstep, voffA);
            PG8_WAIT_V(8); PG8_WAIT_L(0); PG8_BAR; PG8_MMA(0, 0, At, B0); PG8_MMA(0, 1, At, B1); PG8_BAR; PG8_SCHED;
            PG8_LDA(At, 1, 1); PG8_STAGE(PG8_SB(1, 0), b3, voffB); PG8_STAGE(PG8_SB(1, 1), b3 + hstep, voffB); PG8_STAGE(PG8_SA(1, 0), a3, voffA);
            PG8_WAIT_V(8); PG8_WAIT_L(0); PG8_BAR; PG8_MMA(1, 0, At, B0); PG8_MMA(1, 1, At, B1); PG8_BAR; PG8_SCHED;
            } else {
            PG8_LDB(B0, 0, 0); PG8_SCHED; PG8_LDA(At, 0, 0); PG8_STAGE(PG8_SA(1, 1), a1 + hstep, voffA);
            PG8_WAIT_L(8); PG8_BAR; PG8_WAIT_L(0); PG8_MMA(0, 0, At, B0); PG8_BAR; PG8_SCHED;
            PG8_LDB(B1, 0, 1); PG8_STAGE(PG8_SB(0, 0), b2, voffB);
            PG8_BAR; PG8_WAIT_L(0); PG8_MMA(0, 1, At, B1); PG8_BAR;
            PG8_LDA(At, 0, 1); PG8_STAGE(PG8_SA(0, 0), a2, voffA);
            PG8_BAR; PG8_WAIT_L(0); PG8_MMA(1, 0, At, B0); PG8_BAR; PG8_SCHED;
            PG8_STAGE(PG8_SB(0, 1), b2 + hstep, voffB);
            PG8_WAIT_V(6); PG8_BAR; PG8_MMA(1, 1, At, B1); PG8_BAR;
            PG8_LDB(B0, 1, 0); PG8_SCHED; PG8_LDA(At, 1, 0); PG8_STAGE(PG8_SA(0, 1), a2 + hstep, voffA);
            PG8_WAIT_L(8); PG8_BAR; PG8_WAIT_L(0); PG8_MMA(0, 0, At, B0); PG8_BAR; PG8_SCHED;
            PG8_LDB(B1, 1, 1); PG8_STAGE(PG8_SB(1, 0), b3, voffB);
            PG8_BAR; PG8_WAIT_L(0); PG8_MMA(0, 1, At, B1); PG8_BAR;
            PG8_LDA(At, 1, 1); PG8_STAGE(PG8_SA(1, 0), a3, voffA);
            PG8_BAR; PG8_WAIT_L(0); PG8_MMA(1, 0, At, B0); PG8_BAR; PG8_SCHED;
            PG8_STAGE(PG8_SB(1, 1), b3 + hstep, voffB);
            PG8_WAIT_V(6); PG8_BAR; PG8_MMA(1, 1, At, B1); PG8_BAR;
            }
        }
        if constexpr (ALIGN_EPI) { if (wr == 0) PG8_BAR; }
        if constexpr (!Epi::AFTER_DRAIN) { E(acc, cur, wr, wc, fr, fq); S.done(cur); }
        if (!has_next) break;
#pragma unroll
        for (int a = 0; a < 2; ++a)
#pragma unroll
            for (int b = 0; b < 2; ++b)
#pragma unroll
                for (int m = 0; m < 4; ++m)
#pragma unroll
                    for (int n = 0; n < 2; ++n) acc[a][b][m][n] = (i32x4){0, 0, 0, 0};
        cur = nxt; cA = nA; cB = nB; ++ui;
        if constexpr (ALIGN_EPI) { if (wr == 1) PG8_BAR; }
    }
    PG8_WAIT_V(0);
    if constexpr (!ALIGN_EPI) { if (wr == 0) PG8_BAR; }
    PG8_BAR;
    if constexpr (Epi::AFTER_DRAIN) { E.fused(acc, cur, wr, wc, fr, fq, lds, wid, lane); S.done(cur); }
#undef PG8_SA
#undef PG8_SB
#undef PG8_STAGE
#undef PG8_LDA
#undef PG8_LDB
#undef PG8_MMA
#undef PG8_WAIT_V
#undef PG8_WAIT_L
#undef PG8_BAR
#undef PG8_SCHED
}
}

#define LAS __attribute__((address_space(3)))
typedef unsigned short bf16;
typedef float f32x2 __attribute__((ext_vector_type(2)));
typedef float f32x4 __attribute__((ext_vector_type(4)));
typedef unsigned u32x2 __attribute__((ext_vector_type(2)));
typedef unsigned u32x4 __attribute__((ext_vector_type(4)));

constexpr int PDIM = 1536;
constexpr int NTOK = 32768, DM = 1024, DIN = 2560, SEQ = 8192, NBATCH = 4, NMETA = 16;
constexpr int NHEAD = 8, NKEYS = 128, TOPK = 16, NSEL = NHEAD * TOPK;
constexpr float EPS = 1e-6f;
constexpr float U_SCALE = 64.f, V_SCALE = 16.f;
constexpr float U4_CLIP = 2.6f;
constexpr int NWAVES = 8, NTHREADS = 512;
constexpr int MKC = 32;
constexpr int LDS_BYTES = 147456;

constexpr size_t MiB = 1u << 20;
constexpr size_t WS_CTL = 0, WS_WIN_T = 1 * MiB, WS_WOUT_T = 6 * MiB, WS_WQ_T = 8 * MiB, WS_KEYS = 12 * MiB, WS_METAPART = 160 * MiB  ,
                 WS_METARSTD = 14 * MiB + 512 * 1024, WS_METAPROJ = 14 * MiB + 576 * 1024, WS_RSTD1 = 15 * MiB, WS_SSQ = 16 * MiB, WS_U8 = 32 * MiB, WS_V8 = 48 * MiB,
                 WS_IDX = 64 * MiB, WS_GATE = 80 * MiB, WS_H0B = 96 * MiB, WS_H2B = 96 * MiB, WS_Y = 160 * MiB, WS_PROJ = 224 * MiB,
                 WS_Q = 224 * MiB, WS_ESCALE = 18 * MiB, WS_SUMQ = 19 * MiB, WS_SX = 20 * MiB, WS_SW = 21 * MiB, WS_SY = 22 * MiB, WS_SWO = 23 * MiB, WS_WMX = 24 * MiB, WS_H0I8 = 384 * MiB, WS_AW = 160 * MiB  , WS_END = 416 * MiB;

struct Params {
    const float* x; const float* meta; const float* g_mix; const float* w_in; const float* sc_w; const float* cf_w; const float* cf_b;
    const float* ln_g; const float* ln_b; const float* g_sc; const float* g_cf; const float* w_out; const float* g_ffn; const float* w_q;
    const float* keys; const float* pu; const float* pv; const float* g_fin;
    float* out; unsigned char* ws;
    int ph_lo, ph_hi, coop, pad;
};

__device__ __forceinline__ unsigned f2bf(float f) { unsigned u = __builtin_bit_cast(unsigned, f); return (u + 0x7fffu + ((u >> 16) & 1u)) >> 16; }
__device__ __forceinline__ unsigned pk2(float lo, float hi) { return f2bf(lo) | (f2bf(hi) << 16); }
__device__ __forceinline__ float bf2f(unsigned b) { return __builtin_bit_cast(float, b << 16); }
__device__ __forceinline__ float bflo(unsigned w) { return __builtin_bit_cast(float, w << 16); }
__device__ __forceinline__ float bfhi(unsigned w) { return __builtin_bit_cast(float, w & 0xffff0000u); }
__device__ __forceinline__ float wave_sum(float v) {
#pragma unroll
    for (int o = 1; o < 64; o <<= 1) v += __shfl_xor(v, o);
    return v;
}
template <int CTRL> __device__ __forceinline__ float dpp_f(float v) { return __builtin_bit_cast(float, __builtin_amdgcn_update_dpp(0, __builtin_bit_cast(int, v), CTRL, 0xf, 0xf, true)); }
__device__ __forceinline__ float wave_sum_fast(float v) {
    v += dpp_f<0xB1>(v); v += dpp_f<0x4E>(v); v += dpp_f<0x141>(v); v += dpp_f<0x140>(v);
    { auto r = __builtin_amdgcn_permlane16_swap(__float_as_uint(v), __float_as_uint(v), false, false); v = __uint_as_float(r[0]) + __uint_as_float(r[1]); }
    { auto r = __builtin_amdgcn_permlane32_swap(__float_as_uint(v), __float_as_uint(v), false, false); v = __uint_as_float(r[0]) + __uint_as_float(r[1]); }
    return v;
}
__device__ __forceinline__ float wave_max_fast(float v) {
    v = fmaxf(v, dpp_f<0xB1>(v)); v = fmaxf(v, dpp_f<0x4E>(v)); v = fmaxf(v, dpp_f<0x141>(v)); v = fmaxf(v, dpp_f<0x140>(v));
    { auto r = __builtin_amdgcn_permlane16_swap(__float_as_uint(v), __float_as_uint(v), false, false); v = fmaxf(__uint_as_float(r[0]), __uint_as_float(r[1])); }
    { auto r = __builtin_amdgcn_permlane32_swap(__float_as_uint(v), __float_as_uint(v), false, false); v = fmaxf(__uint_as_float(r[0]), __uint_as_float(r[1])); }
    return v;
}
__device__ __forceinline__ float sigmoid_f(float x) { return 1.f / (1.f + __expf(-x)); }
__device__ __forceinline__ float gelu_tanh_f(float x) {
    const float t = 0.7978845608028654f * (x + 0.044715f * x * x * x);
    const float e = __expf(2.f * t);
    const float th = 1.f - 2.f / (e + 1.f);
    return 0.5f * x * (1.f + th);
}

__device__ __forceinline__ unsigned cvt_pk_bf16(float lo, float hi) { unsigned r; asm volatile("v_cvt_pk_bf16_f32 %0, %1, %2" : "=v"(r) : "v"(lo), "v"(hi)); return r; }

template <int MODE> struct EpiRowScale {
    static constexpr bool PERM = true, AFTER_DRAIN = false;
    bf16* O; int ldc; const float* rs;
    __device__ __forceinline__ void operator()(const pg8::f32x4 (&acc)[2][2][4][2], const pg8::Unit& u, int wr, int wc, int fr, int fq) const {
        const int row0 = u.pm * 256 + wr * 64 + fr, col0 = u.pn * 256 + wc * 32 + 8 * fq;
#pragma unroll
        for (int ai = 0; ai < 2; ++ai)
#pragma unroll
            for (int m = 0; m < 4; ++m) {
                const int row = row0 + ai * 128 + m * 16;
                float s;
                if (MODE == 0) s = rs[row];
                else { const f32x4* p = (const f32x4*)(rs + (size_t)row * 16); const f32x4 a = p[0], b = p[1], c = p[2], d = p[3];
                       const float t = ((a.x + a.y) + (a.z + a.w)) + ((b.x + b.y) + (b.z + b.w)) + ((c.x + c.y) + (c.z + c.w)) + ((d.x + d.y) + (d.z + d.w));
                       s = rsqrtf(t * (1.f / 1024.f) + EPS); }
                bf16* rowp = O + (size_t)row * ldc + col0;
#pragma unroll
                for (int bj = 0; bj < 2; ++bj) { const pg8::f32x4 v0 = acc[ai][bj][m][0] * s, v1 = acc[ai][bj][m][1] * s;
                    u32x4 w; w.x = cvt_pk_bf16(v0[0], v0[1]); w.y = cvt_pk_bf16(v0[2], v0[3]); w.z = cvt_pk_bf16(v1[0], v1[1]); w.w = cvt_pk_bf16(v1[2], v1[3]);
                    *(u32x4*)(rowp + bj * 128) = w; }
            }
    }
};
struct EpiProj {
    static constexpr bool PERM = true, AFTER_DRAIN = false;
    bf16* O; const float* rs;
    __device__ __forceinline__ void operator()(const pg8::f32x4 (&acc)[2][2][4][2], const pg8::Unit& u, int wr, int wc, int fr, int fq) const {
        const int row0 = u.pm * 256 + wr * 64 + fr, cin = wc * 32 + 8 * fq, pn = u.pn;
#pragma unroll
        for (int ai = 0; ai < 2; ++ai)
#pragma unroll
            for (int m = 0; m < 4; ++m) {
                const int row = row0 + ai * 128 + m * 16; const float sc = rs[row];
                float a[8], b[8];
#pragma unroll
                for (int i = 0; i < 4; ++i) { a[i] = acc[ai][0][m][0][i] * sc; a[4 + i] = acc[ai][0][m][1][i] * sc; b[i] = acc[ai][1][m][0][i] * sc; b[4 + i] = acc[ai][1][m][1][i] * sc; }
                bf16* rowp = O + (size_t)row * PDIM;
                if (pn >= 4 && pn < 6) {
                    u32x4 w0, w1; w0.x = cvt_pk_bf16(a[0], a[1]); w0.y = cvt_pk_bf16(a[2], a[3]); w0.z = cvt_pk_bf16(a[4], a[5]); w0.w = cvt_pk_bf16(a[6], a[7]);
                    w1.x = cvt_pk_bf16(b[0], b[1]); w1.y = cvt_pk_bf16(b[2], b[3]); w1.z = cvt_pk_bf16(b[4], b[5]); w1.w = cvt_pk_bf16(b[6], b[7]);
                    *(u32x4*)(rowp + 512 + 256 * (pn - 4) + cin) = w0; *(u32x4*)(rowp + 512 + 256 * (pn - 4) + 128 + cin) = w1;
                } else {
                    float o[8];
                    if (pn < 4) {
#pragma unroll
                        for (int i = 0; i < 8; ++i) o[i] = a[i] * b[i];
                    } else {
#pragma unroll
                        for (int i = 0; i < 8; ++i) o[i] = a[i] * sigmoid_f(b[i]);
                    }
                    u32x4 w; w.x = cvt_pk_bf16(o[0], o[1]); w.y = cvt_pk_bf16(o[2], o[3]); w.z = cvt_pk_bf16(o[4], o[5]); w.w = cvt_pk_bf16(o[6], o[7]);
                    *(u32x4*)(rowp + (pn < 4 ? 128 * pn : 1024 + 128 * (pn - 6)) + cin) = w;
                }
            }
    }
};
struct EpiProjI8 {
    static constexpr bool PERM = true, AFTER_DRAIN = false;
    bf16* O; const float* rs; const float* sw;
    __device__ __forceinline__ void operator()(const pg8::i32x4 (&acc)[2][2][4][2], const pg8::Unit& u, int wr, int wc, int fr, int fq) const {
        const int row0 = u.pm * 256 + wr * 64 + fr, cin = wc * 32 + 8 * fq, pn = u.pn;
        float swa[8], swb[8];
        { const f32x4 a0 = *(const f32x4*)(sw + 256 * pn + cin), a1 = *(const f32x4*)(sw + 256 * pn + cin + 4), b0 = *(const f32x4*)(sw + 256 * pn + 128 + cin), b1 = *(const f32x4*)(sw + 256 * pn + 128 + cin + 4);
          swa[0] = a0.x; swa[1] = a0.y; swa[2] = a0.z; swa[3] = a0.w; swa[4] = a1.x; swa[5] = a1.y; swa[6] = a1.z; swa[7] = a1.w;
          swb[0] = b0.x; swb[1] = b0.y; swb[2] = b0.z; swb[3] = b0.w; swb[4] = b1.x; swb[5] = b1.y; swb[6] = b1.z; swb[7] = b1.w; }
#pragma unroll
        for (int ai = 0; ai < 2; ++ai)
#pragma unroll
            for (int m = 0; m < 4; ++m) {
                const int row = row0 + ai * 128 + m * 16; const float sc = rs[row];
                float a[8], b[8];
#pragma unroll
                for (int i = 0; i < 4; ++i) { a[i] = (float)acc[ai][0][m][0][i] * (sc * swa[i]); a[4 + i] = (float)acc[ai][0][m][1][i] * (sc * swa[4 + i]);
                    b[i] = (float)acc[ai][1][m][0][i] * (sc * swb[i]); b[4 + i] = (float)acc[ai][1][m][1][i] * (sc * swb[4 + i]); }
                bf16* rowp = O + (size_t)row * PDIM;
                if (pn >= 4 && pn < 6) {
                    u32x4 w0, w1; w0.x = cvt_pk_bf16(a[0], a[1]); w0.y = cvt_pk_bf16(a[2], a[3]); w0.z = cvt_pk_bf16(a[4], a[5]); w0.w = cvt_pk_bf16(a[6], a[7]);
                    w1.x = cvt_pk_bf16(b[0], b[1]); w1.y = cvt_pk_bf16(b[2], b[3]); w1.z = cvt_pk_bf16(b[4], b[5]); w1.w = cvt_pk_bf16(b[6], b[7]);
                    *(u32x4*)(rowp + 512 + 256 * (pn - 4) + cin) = w0; *(u32x4*)(rowp + 512 + 256 * (pn - 4) + 128 + cin) = w1;
                } else {
                    float o[8];
                    if (pn < 4) {
#pragma unroll
                        for (int i = 0; i < 8; ++i) o[i] = a[i] * b[i];
                    } else {
#pragma unroll
                        for (int i = 0; i < 8; ++i) o[i] = a[i] * sigmoid_f(b[i]);
                    }
                    u32x4 w; w.x = cvt_pk_bf16(o[0], o[1]); w.y = cvt_pk_bf16(o[2], o[3]); w.z = cvt_pk_bf16(o[4], o[5]); w.w = cvt_pk_bf16(o[6], o[7]);
                    *(u32x4*)(rowp + (pn < 4 ? 128 * pn : 1024 + 128 * (pn - 6)) + cin) = w;
                }
            }
    }
};
__host__ __device__ __forceinline__ int win_src_col(int n) {
    const int t = n >> 8, j = n & 255;
    if (t < 4) return (j < 128) ? 128 * t + j : 1024 + 128 * t + (j - 128);
    if (t < 6) return 512 + 256 * (t - 4) + j;
    return (j < 128) ? 1536 + 128 * (t - 6) + j : 2048 + 128 * (t - 6) + (j - 128);
}
struct EpiResidual {
    static constexpr bool PERM = true, AFTER_DRAIN = false;
    bf16* O; const signed char* XB; const float* SX; float* ssq;
    __device__ __forceinline__ void operator()(const pg8::f32x4 (&acc)[2][2][4][2], const pg8::Unit& u, int wr, int wc, int fr, int fq) const {
        const int row0 = u.pm * 256 + wr * 64 + fr, col0 = u.pn * 256 + wc * 32 + 8 * fq;
#pragma unroll
        for (int ai = 0; ai < 2; ++ai)
#pragma unroll
            for (int m = 0; m < 4; ++m) {
                const int row = row0 + ai * 128 + m * 16;
                const signed char* xr = XB + (size_t)row * DM + col0; bf16* rowp = O + (size_t)row * DM + col0;
                float q = 0.f;
                u32x2 xw[2]; const float sxr = SX[row];
#pragma unroll
                for (int bj = 0; bj < 2; ++bj) xw[bj] = *(const u32x2*)(xr + bj * 128);
#pragma unroll
                for (int bj = 0; bj < 2; ++bj) {
                    const f32x4 x0 = (f32x4){(float)(signed char)(xw[bj].x), (float)(signed char)(xw[bj].x >> 8), (float)(signed char)(xw[bj].x >> 16), (float)((int)xw[bj].x >> 24)} * sxr,
                                x1 = (f32x4){(float)(signed char)(xw[bj].y), (float)(signed char)(xw[bj].y >> 8), (float)(signed char)(xw[bj].y >> 16), (float)((int)xw[bj].y >> 24)} * sxr;
                    const pg8::f32x4 v0 = acc[ai][bj][m][0] + x0, v1 = acc[ai][bj][m][1] + x1;
                    q += (v0[0] * v0[0] + v0[1] * v0[1]) + (v0[2] * v0[2] + v0[3] * v0[3]) + (v1[0] * v1[0] + v1[1] * v1[1]) + (v1[2] * v1[2] + v1[3] * v1[3]);
                    u32x4 w; w.x = cvt_pk_bf16(v0[0], v0[1]); w.y = cvt_pk_bf16(v0[2], v0[3]); w.z = cvt_pk_bf16(v1[0], v1[1]); w.w = cvt_pk_bf16(v1[2], v1[3]);
                    *(u32x4*)(rowp + bj * 128) = w; }
                q += __shfl_xor(q, 16); q += __shfl_xor(q, 32);
                if (fq == 0) ssq[(size_t)row * 16 + u.pn * 4 + wc] = q;
            }
    }
};

struct EpiResidualI8 {
    static constexpr bool PERM = true, AFTER_DRAIN = false;
    bf16* O; const signed char* XB; const float* SX; const float* SY; const float* SWO; float* ssq;
    __device__ __forceinline__ void operator()(const pg8::i32x4 (&acc)[2][2][4][2], const pg8::Unit& u, int wr, int wc, int fr, int fq) const {
        const int row0 = u.pm * 256 + wr * 64 + fr, col0 = u.pn * 256 + wc * 32 + 8 * fq;
        f32x4 sw[2][2];
#pragma unroll
        for (int bj = 0; bj < 2; ++bj) { sw[bj][0] = *(const f32x4*)(SWO + col0 + bj * 128); sw[bj][1] = *(const f32x4*)(SWO + col0 + bj * 128 + 4); }
#pragma unroll
        for (int ai = 0; ai < 2; ++ai)
#pragma unroll
            for (int m = 0; m < 4; ++m) {
                const int row = row0 + ai * 128 + m * 16;
                const signed char* xr = XB + (size_t)row * DM + col0; bf16* rowp = O + (size_t)row * DM + col0;
                float q = 0.f;
                u32x2 xw[2]; const float sxr = SX[row], syr = SY[row];
#pragma unroll
                for (int bj = 0; bj < 2; ++bj) xw[bj] = *(const u32x2*)(xr + bj * 128);
#pragma unroll
                for (int bj = 0; bj < 2; ++bj) {
                    const f32x4 x0 = (f32x4){(float)(signed char)(xw[bj].x), (float)(signed char)(xw[bj].x >> 8), (float)(signed char)(xw[bj].x >> 16), (float)((int)xw[bj].x >> 24)} * sxr,
                                x1 = (f32x4){(float)(signed char)(xw[bj].y), (float)(signed char)(xw[bj].y >> 8), (float)(signed char)(xw[bj].y >> 16), (float)((int)xw[bj].y >> 24)} * sxr;
                    const pg8::i32x4 a0 = acc[ai][bj][m][0], a1 = acc[ai][bj][m][1];
                    const f32x4 v0 = (f32x4){(float)a0[0], (float)a0[1], (float)a0[2], (float)a0[3]} * (sw[bj][0] * syr) + x0, v1 = (f32x4){(float)a1[0], (float)a1[1], (float)a1[2], (float)a1[3]} * (sw[bj][1] * syr) + x1;
                    q += (v0[0] * v0[0] + v0[1] * v0[1]) + (v0[2] * v0[2] + v0[3] * v0[3]) + (v1[0] * v1[0] + v1[1] * v1[1]) + (v1[2] * v1[2] + v1[3] * v1[3]);
                    u32x4 w; w.x = cvt_pk_bf16(v0[0], v0[1]); w.y = cvt_pk_bf16(v0[2], v0[3]); w.z = cvt_pk_bf16(v1[0], v1[1]); w.w = cvt_pk_bf16(v1[2], v1[3]);
                    *(u32x4*)(rowp + bj * 128) = w; }
                q += __shfl_xor(q, 16); q += __shfl_xor(q, 32);
                if (fq == 0) ssq[(size_t)row * 16 + u.pn * 4 + wc] = q;
            }
    }
};
template <bool MAPIN> __device__ __forceinline__ void p0_transpose_item(const float* W, int K, int N, bf16* WT, LAS float* scr, int item, int lane,
                                                  const float* g_lo, const float* g_hi, int split) {
    const int nblk = N / 32, kb = item / nblk, nb = item % nblk, k0 = 64 * kb, n0 = 32 * nb;
#pragma unroll 8
    for (int i = 0; i < 32; ++i) { const int kk = 2 * i + (lane >> 5); const int k = k0 + kk;
        const float g = (k < split) ? g_lo[k] : g_hi[k - split];
        scr[kk * 33 + (lane & 31)] = W[(size_t)k * N + (MAPIN ? win_src_col(n0) : n0) + (lane & 31)] * g; }
    asm volatile("s_waitcnt lgkmcnt(0)" ::: "memory");
    const int c = lane & 7;
#pragma unroll
    for (int j = 0; j < 4; ++j) { const int n = (lane >> 3) + 8 * j; const LAS float* s = scr + (8 * c) * 33 + n;
        u32x4 o; o.x = pk2(s[0 * 33], s[1 * 33]); o.y = pk2(s[2 * 33], s[3 * 33]); o.z = pk2(s[4 * 33], s[5 * 33]); o.w = pk2(s[6 * 33], s[7 * 33]);
        *(u32x4*)(WT + (size_t)(n0 + n) * K + k0 + 8 * c) = o; }
    asm volatile("s_waitcnt lgkmcnt(0)" ::: "memory");
}

constexpr int CW_COLMAX = 5120;
__device__ __forceinline__ void p0_colmax_item(const float* W, int N, unsigned* colmax, int item, int lane, const float* g) {
    const int nblk = N / 32, kb = item / nblk, nb = item % nblk, k0 = 64 * kb, n0 = 32 * nb;
    float mx = 0.f;
#pragma unroll
    for (int i = 0; i < 32; ++i) { const int k = k0 + 2 * i + (lane >> 5); mx = fmaxf(mx, fabsf(W[(size_t)k * N + n0 + (lane & 31)] * g[k])); }
    mx = fmaxf(mx, __shfl_xor(mx, 32));
    if (lane < 32) atomicMax(colmax + n0 + lane, __float_as_uint(mx));
}
__device__ __forceinline__ void p1_quant_item(const float* W, int K, int N, signed char* WT8, float* swout, const unsigned* colmax, LAS float* scr, int item, int lane, const float* g) {
    const int nblk = N / 32, kb = item / nblk, nb = item % nblk, k0 = 64 * kb, n0 = 32 * nb, s0 = win_src_col(n0);
    const float cm = fmaxf(__uint_as_float(colmax[s0 + (lane & 31)]), 1e-30f), inv = 127.f / cm;
    if (kb == 0 && lane < 32) swout[n0 + lane] = cm * (1.f / 127.f);
#pragma unroll
    for (int i = 0; i < 32; ++i) { const int kk = 2 * i + (lane >> 5); const int k = k0 + kk;
        scr[kk * 33 + (lane & 31)] = W[(size_t)k * N + s0 + (lane & 31)] * g[k] * inv; }
    asm volatile("s_waitcnt lgkmcnt(0)" ::: "memory");
    const int c = lane & 7;
#pragma unroll
    for (int j = 0; j < 4; ++j) { const int n = (lane >> 3) + 8 * j; const LAS float* sp = scr + (8 * c) * 33 + n;
        unsigned w0 = 0u, w1 = 0u;
#pragma unroll
        for (int i = 0; i < 4; ++i) { w0 |= ((unsigned)(int)rintf(sp[i * 33]) & 255u) << (8 * i); w1 |= ((unsigned)(int)rintf(sp[(4 + i) * 33]) & 255u) << (8 * i); }
        u32x2 o; o.x = w0; o.y = w1;
        *(u32x2*)(WT8 + (size_t)(n0 + n) * K + k0 + 8 * c) = o; }
    asm volatile("s_waitcnt lgkmcnt(0)" ::: "memory");
}
constexpr int CW_COLMAX2 = 7680;
__device__ __forceinline__ void p0_colmax_item2(const float* W, int N, unsigned* colmax, int item, int lane, const float* g_lo, const float* g_hi, int split) {
    const int nblk = N / 32, kb = item / nblk, nb = item % nblk, k0 = 64 * kb, n0 = 32 * nb;
    float mx = 0.f;
#pragma unroll
    for (int i = 0; i < 32; ++i) { const int k = k0 + 2 * i + (lane >> 5); const float g = (k < split) ? g_lo[k] : g_hi[k - split]; mx = fmaxf(mx, fabsf(W[(size_t)k * N + n0 + (lane & 31)] * g)); }
    mx = fmaxf(mx, __shfl_xor(mx, 32));
    if (lane < 32) atomicMax(colmax + n0 + lane, __float_as_uint(mx));
}
__device__ __forceinline__ void p1_quant_item2(const float* W, int K, int N, signed char* WT8, float* swout, const unsigned* colmax, LAS float* scr, int item, int lane, const float* g_lo, const float* g_hi, int split) {
    const int nblk = N / 32, kb = item / nblk, nb = item % nblk, k0 = 64 * kb, n0 = 32 * nb;
    const float cm = fmaxf(__uint_as_float(colmax[n0 + (lane & 31)]), 1e-30f), inv = 127.f / cm;
    if (kb == 0 && lane < 32) swout[n0 + lane] = cm * (1.f / 127.f);
#pragma unroll
    for (int i = 0; i < 32; ++i) { const int kk = 2 * i + (lane >> 5); const int k = k0 + kk; const float g = (k < split) ? g_lo[k] : g_hi[k - split];
        scr[kk * 33 + (lane & 31)] = W[(size_t)k * N + n0 + (lane & 31)] * g * inv; }
    asm volatile("s_waitcnt lgkmcnt(0)" ::: "memory");
    const int c = lane & 7;
#pragma unroll
    for (int j = 0; j < 4; ++j) { const int n = (lane >> 3) + 8 * j; const LAS float* sp = scr + (8 * c) * 33 + n;
        unsigned w0 = 0u, w1 = 0u;
#pragma unroll
        for (int i = 0; i < 4; ++i) { w0 |= ((unsigned)(int)rintf(sp[i * 33]) & 255u) << (8 * i); w1 |= ((unsigned)(int)rintf(sp[(4 + i) * 33]) & 255u) << (8 * i); }
        u32x2 o; o.x = w0; o.y = w1;
        *(u32x2*)(WT8 + (size_t)(n0 + n) * K + k0 + 8 * c) = o; }
    asm volatile("s_waitcnt lgkmcnt(0)" ::: "memory");
}
__device__ __forceinline__ void phase_winq(const Params& P, LAS unsigned char* lds) {
    const int tid = threadIdx.x, lane = tid & 63, wave = __builtin_amdgcn_readfirstlane(tid >> 6);
    const int gw = blockIdx.x * NWAVES + wave, NGW = gridDim.x * NWAVES;
    LAS float* scr = (LAS float*)(lds + wave * 16384);
    constexpr int NI1 = (DM / 64) * (DIN / 32), NI2 = (DM / 64) * (DM / 32);
    for (int it = gw; it < NI1 + NI2; it += NGW) {
        if (it < NI1) p1_quant_item(P.w_in, DM, DIN, (signed char*)(P.ws + WS_WIN_T), (float*)(P.ws + WS_SW), (const unsigned*)(P.ws + WS_CTL) + CW_COLMAX, scr, it, lane, P.g_mix);
        else p1_quant_item2(P.w_out, DM, DM, (signed char*)(P.ws + WS_WOUT_T), (float*)(P.ws + WS_SWO), (const unsigned*)(P.ws + WS_CTL) + CW_COLMAX2, scr, it - NI1, lane, P.g_sc, P.g_cf, 512);
    }
}
__device__ __forceinline__ float q4(float x, float inv_s) {
    const float a = fabsf(x) * inv_s; float r;
    if (a < 2.f) r = rintf(a * 2.f) * 0.5f; else if (a < 4.f) r = rintf(a); else r = fminf(6.f, rintf(a * 0.5f) * 2.f);
    return copysignf(r, x);
}
__device__ __forceinline__ void phase_prep(const Params& P, LAS unsigned char* lds) {
    const int tid = threadIdx.x, lane = tid & 63, wave = __builtin_amdgcn_readfirstlane(tid >> 6);
    const int gw = blockIdx.x * NWAVES + wave, NGW = gridDim.x * NWAVES;
    unsigned char* ws = P.ws;
    LAS float* scr = (LAS float*)(lds + wave * 16384);
    constexpr int I_IN = (DM / 64) * (DIN / 32), I_OUT = (DM / 64) * (DM / 32), I_Q = (DM / 64) * (2048 / 32);
    for (int it = gw; it < I_IN + I_OUT + I_Q; it += NGW) {
        int r = it;
        if (r < I_IN) { p0_colmax_item(P.w_in, DIN, (unsigned*)(ws + WS_CTL) + CW_COLMAX, r, lane, P.g_mix); continue; } r -= I_IN;
        if (r < I_OUT) { p0_colmax_item2(P.w_out, DM, (unsigned*)(ws + WS_CTL) + CW_COLMAX2, r, lane, P.g_sc, P.g_cf, 512); continue; } r -= I_OUT;
        p0_transpose_item<false>(P.w_q, DM, 2048, (bf16*)(ws + WS_WQ_T), scr, r, lane, P.g_ffn, P.g_ffn, DM);
    }
    {
        unsigned* H0I8 = (unsigned*)(ws + WS_H0I8); float* RS1 = (float*)(ws + WS_RSTD1); float* SXp = (float*)(ws + WS_SX);
        for (int t0 = gw * 4; t0 < NTOK; t0 += NGW * 4) {
            f32x4 v[4][4];
#pragma unroll
            for (int q = 0; q < 4; ++q) { const f32x4* xr = (const f32x4*)(P.x + (size_t)(t0 + q) * DM) + lane;
#pragma unroll
                for (int j = 0; j < 4; ++j) v[q][j] = xr[64 * j]; }
#pragma unroll
            for (int q = 0; q < 4; ++q) { float sq = 0.f, mx = 0.f;
#pragma unroll
                for (int j = 0; j < 4; ++j) { sq += (v[q][j].x * v[q][j].x + v[q][j].y * v[q][j].y) + (v[q][j].z * v[q][j].z + v[q][j].w * v[q][j].w);
                    mx = fmaxf(mx, fmaxf(fmaxf(fabsf(v[q][j].x), fabsf(v[q][j].y)), fmaxf(fabsf(v[q][j].z), fabsf(v[q][j].w)))); }
                sq = wave_sum_fast(sq); mx = fmaxf(wave_max_fast(mx), 1e-30f);
                const float sx = mx * (1.f / 127.f), inv = 127.f / mx;
                if (lane == 0) { RS1[t0 + q] = sx * rsqrtf(sq * (1.f / DM) + EPS); SXp[t0 + q] = sx; }
                unsigned* o = H0I8 + (size_t)(t0 + q) * (DM / 4) + lane;
#pragma unroll
                for (int j = 0; j < 4; ++j) { const int a = (int)rintf(v[q][j].x * inv), b = (int)rintf(v[q][j].y * inv), c = (int)rintf(v[q][j].z * inv), d = (int)rintf(v[q][j].w * inv);
                    o[64 * j] = ((unsigned)a & 255u) | (((unsigned)b & 255u) << 8) | (((unsigned)c & 255u) << 16) | ((unsigned)d << 24); } }
        }
    }
    {
        unsigned char* U8 = ws + WS_U8; unsigned char* V8 = ws + WS_V8;
        f32x4 gf[4];
#pragma unroll
        for (int j = 0; j < 4; ++j) gf[j] = ((const f32x4*)P.g_ffn)[64 * j + lane];
        float* ESC = (float*)(ws + WS_ESCALE);
        for (int e0 = gw * 2; e0 < 2 * 16384; e0 += NGW * 2) {
            const bool isv = e0 >= 16384; const int ee0 = isv ? e0 - 16384 : e0;
            f32x4 v[2][4];
#pragma unroll
            for (int q = 0; q < 2; ++q) { const f32x4* src = (const f32x4*)((isv ? P.pv : P.pu) + (size_t)(ee0 + q) * DM);
#pragma unroll
                for (int j = 0; j < 4; ++j) v[q][j] = isv ? src[4 * lane + j] : src[64 * j + lane]; }
#pragma unroll
            for (int q = 0; q < 2; ++q) {
                float mx = 0.f;
#pragma unroll
                for (int j = 0; j < 4; ++j) { if (!isv) v[q][j] = v[q][j] * gf[j];
                    mx = fmaxf(mx, fmaxf(fmaxf(fabsf(v[q][j].x), fabsf(v[q][j].y)), fmaxf(fabsf(v[q][j].z), fabsf(v[q][j].w)))); }
#pragma unroll
                for (int o = 1; o < 64; o <<= 1) mx = fmaxf(mx, __shfl_xor(mx, o));
                if (!isv) {
                    float sq2 = 0.f;
#pragma unroll
                    for (int j = 0; j < 4; ++j) sq2 += (v[q][j].x * v[q][j].x + v[q][j].y * v[q][j].y) + (v[q][j].z * v[q][j].z + v[q][j].w * v[q][j].w);
                    const float rms = sqrtf(wave_sum_fast(sq2) * (1.f / DM));
                    const float su = fmaxf(fminf(mx, U4_CLIP * rms), 1e-30f) * (1.f / 7.f), inv = 1.f / su;
                    unsigned wq[2] = {0u, 0u}; int csum = 0;
#pragma unroll
                    for (int j = 0; j < 4; ++j) { const float e4[4] = {v[q][j].x, v[q][j].y, v[q][j].z, v[q][j].w};
#pragma unroll
                        for (int i = 0; i < 4; ++i) { int c = (int)rintf(fminf(fmaxf(e4[i] * inv, -7.f), 7.f)); csum += c;
                            wq[j >> 1] |= ((unsigned)c & 15u) << (16 * (j & 1) + 4 * i); } }
                    const float cs = wave_sum_fast((float)csum);
                    if (lane == 0) { ESC[e0 + q] = su; ((float*)(ws + WS_SUMQ))[e0 + q] = cs; }
                    u32x2 o; o.x = wq[0]; o.y = wq[1];
                    *(u32x2*)(U8 + (size_t)(ee0 + q) * 512 + 8 * lane) = o;
                    continue;
                }
                const float sc = fmaxf(mx, 1e-30f) * (1.f / 6.f), inv = 1.f / sc;
                if (lane == 0) ESC[e0 + q] = sc;
                unsigned w0 = 0u, w1 = 0u;
                w0 = __builtin_amdgcn_cvt_scalef32_pk_fp4_f32(w0, v[q][0].x * inv, v[q][0].y * inv, 1.0f, 0); w0 = __builtin_amdgcn_cvt_scalef32_pk_fp4_f32(w0, v[q][0].z * inv, v[q][0].w * inv, 1.0f, 1);
                w0 = __builtin_amdgcn_cvt_scalef32_pk_fp4_f32(w0, v[q][1].x * inv, v[q][1].y * inv, 1.0f, 2); w0 = __builtin_amdgcn_cvt_scalef32_pk_fp4_f32(w0, v[q][1].z * inv, v[q][1].w * inv, 1.0f, 3);
                w1 = __builtin_amdgcn_cvt_scalef32_pk_fp4_f32(w1, v[q][2].x * inv, v[q][2].y * inv, 1.0f, 0); w1 = __builtin_amdgcn_cvt_scalef32_pk_fp4_f32(w1, v[q][2].z * inv, v[q][2].w * inv, 1.0f, 1);
                w1 = __builtin_amdgcn_cvt_scalef32_pk_fp4_f32(w1, v[q][3].x * inv, v[q][3].y * inv, 1.0f, 2); w1 = __builtin_amdgcn_cvt_scalef32_pk_fp4_f32(w1, v[q][3].z * inv, v[q][3].w * inv, 1.0f, 3);
                u32x2 o; o.x = w0; o.y = w1;
                *(u32x2*)((isv ? V8 : U8) + (size_t)(ee0 + q) * 512 + 8 * lane) = o;
            }
        }
    }
    {
        bf16* KB = (bf16*)(ws + WS_KEYS);
        const int gt = blockIdx.x * NTHREADS + tid, NGT = gridDim.x * NTHREADS;
        for (int i = gt; i < 8 * 2 * 128 * 128 / 4; i += NGT) { const f32x4 v = ((const f32x4*)P.keys)[i]; u32x2 w; w.x = pk2(v.x, v.y); w.y = pk2(v.z, v.w); ((u32x2*)KB)[i] = w; }
    }
    {
        float* MP = (float*)(ws + WS_METAPART); float* MR = (float*)(ws + WS_METARSTD);
        for (int r = gw; r < NMETA; r += NGW) {
            float s = 0.f;
            for (int k = lane; k < DM; k += 64) { const float v = P.meta[r * DM + k]; s += v * v; }
            s = wave_sum(s);
            if (lane == 0) MR[r] = rsqrtf(s * (1.f / DM) + EPS);
        }
        for (int it = gw; it < MKC * 40; it += NGW) {
            const int kc = it / 40, nb = it % 40, n = nb * 64 + lane;
            float acc[NMETA];
#pragma unroll
            for (int r = 0; r < NMETA; ++r) acc[r] = 0.f;
            for (int k = kc * (DM / MKC); k < (kc + 1) * (DM / MKC); ++k) {
                const float w = P.w_in[(size_t)k * DIN + n] * P.g_mix[k];
#pragma unroll
                for (int r = 0; r < NMETA; ++r) acc[r] += P.meta[r * DM + k] * w;
            }
#pragma unroll
            for (int r = 0; r < NMETA; ++r) MP[(size_t)(kc * 16 + r) * DIN + n] = acc[r];
        }
    }
}

__device__ __forceinline__ float metaraw(const float* MP, const float* MR, int p, int col) { float s = 0.f;
#pragma unroll 8
    for (int kc = 0; kc < MKC; ++kc) s += MP[(size_t)(kc * 16 + p) * DIN + col];
    return s * MR[p]; }
__device__ __forceinline__ void phase_metaproj(const Params& P) {
    const float* MP = (const float*)(P.ws + WS_METAPART); const float* MR = (const float*)(P.ws + WS_METARSTD); float* MJ = (float*)(P.ws + WS_METAPROJ);
    for (int gt = blockIdx.x * NTHREADS + threadIdx.x; gt < NMETA * PDIM; gt += gridDim.x * NTHREADS) { const int p = gt / PDIM, c = gt % PDIM; float v;
        if (c < 512) v = metaraw(MP, MR, p, c) * metaraw(MP, MR, p, 1024 + c);
        else if (c < 1024) v = metaraw(MP, MR, p, c);
        else v = metaraw(MP, MR, p, 1536 + (c - 1024)) * sigmoid_f(metaraw(MP, MR, p, 2048 + (c - 1024)));
        MJ[gt] = v; }
}
__device__ __forceinline__ float meta_val(const float* MJ, const float*, int p, int col) { return MJ[p * PDIM + col]; }
__device__ __forceinline__ float proj_at(const bf16* PROJ, const float* MP, const float* MR, int b, int pos, int col) {
    if (pos < 0) return 0.f;
    if (pos < NMETA) return meta_val(MP, MR, pos, col);
    return bf2f(PROJ[(size_t)(b * SEQ + pos - NMETA) * PDIM + col]);
}
__device__ __forceinline__ void proj8_at(const bf16* PROJ, const float* MP, const float* MR, int b, int pos, int col, float (&v)[8]) {
    if (pos < 0) {
#pragma unroll
        for (int i = 0; i < 8; ++i) v[i] = 0.f;
    } else if (pos < NMETA) {
        const f32x4 a = *(const f32x4*)(MP + pos * PDIM + col), bq = *(const f32x4*)(MP + pos * PDIM + col + 4);
        v[0] = a.x; v[1] = a.y; v[2] = a.z; v[3] = a.w; v[4] = bq.x; v[5] = bq.y; v[6] = bq.z; v[7] = bq.w;
    } else {
        const u32x4 w = *(const u32x4*)(PROJ + (size_t)(b * SEQ + pos - NMETA) * PDIM + col);
        v[0] = bflo(w.x); v[1] = bfhi(w.x); v[2] = bflo(w.y); v[3] = bfhi(w.y); v[4] = bflo(w.z); v[5] = bfhi(w.z); v[6] = bflo(w.w); v[7] = bfhi(w.w);
    }
}

template <int R> __device__ __forceinline__ void conv_rows(const LAS unsigned char* ubase, const f32x2 (&wcf)[31], f32x2 (&acc)[32]) {
    if constexpr (R < 62) {
        const unsigned uw = *(const LAS unsigned*)(ubase + R * 1024);
        const f32x2 x = (f32x2){bflo(uw), bfhi(uw)};
        constexpr int lo = R > 30 ? R - 30 : 0, hi = R < 31 ? R : 31;
#pragma unroll
        for (int ii = lo; ii <= hi; ++ii) acc[ii] += wcf[R - ii] * x;
        conv_rows<R + 1>(ubase, wcf, acc);
    }
}
__device__ __forceinline__ void phase_conv(const Params& P, LAS unsigned char* lds) {
    const int tid = threadIdx.x, lane = tid & 63, wave = __builtin_amdgcn_readfirstlane(tid >> 6);
    unsigned char* ws = P.ws;
    const bf16* PROJ = (const bf16*)(ws + WS_PROJ); const float* MP = (const float*)(ws + WS_METAPROJ); const float* MR = nullptr;
    bf16* Y = (bf16*)(ws + WS_Y);
    constexpr int TT = 64, NTILE = NTOK / TT, UROWS = TT + 30;
    const int cgp = wave & 3, th = wave >> 2, ch2 = cgp * 128 + 2 * lane;
    f32x2 wcf[31];
#pragma unroll
    for (int j = 0; j < 31; ++j) wcf[j] = *(const f32x2*)(P.cf_w + j * 512 + ch2);
    const f32x2 bcf = *(const f32x2*)(P.cf_b + ch2);
    for (int tile = blockIdx.x; tile < NTILE; tile += gridDim.x) {
        const int b = tile / (SEQ / TT), s0 = (tile % (SEQ / TT)) * TT;
#pragma unroll 4
        for (int p = 0; p < (UROWS + 7) / 8; ++p) {
            const int r = p * 8 + wave;
            if (r < UROWS) {
                const int pos = NMETA + s0 - 30 + r;
                float uu[8];
                proj8_at(PROJ, MP, MR, b, pos, 1024 + 8 * lane, uu);
                u32x4 w; w.x = pk2(uu[0], uu[1]); w.y = pk2(uu[2], uu[3]); w.z = pk2(uu[4], uu[5]); w.w = pk2(uu[6], uu[7]);
                *(LAS u32x4*)(lds + r * 1024 + lane * 16) = w;
            }
        }
        __syncthreads();
        f32x2 acc[32];
#pragma unroll
        for (int ii = 0; ii < 32; ++ii) acc[ii] = bcf;
        conv_rows<0>(lds + (32 * th) * 1024 + ch2 * 2, wcf, acc);
        __syncthreads();
#pragma unroll
        for (int ii = 0; ii < 32; ++ii) *(LAS f32x2*)(lds + (32 * th + ii) * 2048 + ch2 * 4) = acc[ii];
        __syncthreads();
        {
            float lng[8], lnb[8];
            { const f32x4 a = *(const f32x4*)(P.ln_g + 8 * lane), c = *(const f32x4*)(P.ln_g + 8 * lane + 4), d = *(const f32x4*)(P.ln_b + 8 * lane), e = *(const f32x4*)(P.ln_b + 8 * lane + 4);
              lng[0] = a.x; lng[1] = a.y; lng[2] = a.z; lng[3] = a.w; lng[4] = c.x; lng[5] = c.y; lng[6] = c.z; lng[7] = c.w;
              lnb[0] = d.x; lnb[1] = d.y; lnb[2] = d.z; lnb[3] = d.w; lnb[4] = e.x; lnb[5] = e.y; lnb[6] = e.z; lnb[7] = e.w; }
            float wsc[3][8];
#pragma unroll
            for (int j = 0; j < 3; ++j) { const f32x4 a = *(const f32x4*)(P.sc_w + j * 512 + 8 * lane), c = *(const f32x4*)(P.sc_w + j * 512 + 8 * lane + 4);
                wsc[j][0] = a.x; wsc[j][1] = a.y; wsc[j][2] = a.z; wsc[j][3] = a.w; wsc[j][4] = c.x; wsc[j][5] = c.y; wsc[j][6] = c.z; wsc[j][7] = c.w; }
            float cxa[8], cxb[8];
            { const int pos = NMETA + s0 + 8 * wave - 2;
              proj8_at(PROJ, MP, MR, b, pos, 8 * lane, cxa); proj8_at(PROJ, MP, MR, b, pos + 1, 8 * lane, cxb); }
#pragma unroll 2
            for (int q = 0; q < 8; ++q) {
                const int ii = 8 * wave + q, s = s0 + ii; const size_t t = (size_t)b * SEQ + s;
                float o[8];
                { const f32x4 a = *(const LAS f32x4*)(lds + ii * 2048 + lane * 32), c = *(const LAS f32x4*)(lds + ii * 2048 + lane * 32 + 16);
                  o[0] = a.x; o[1] = a.y; o[2] = a.z; o[3] = a.w; o[4] = c.x; o[5] = c.y; o[6] = c.z; o[7] = c.w; }
                float s1 = 0.f;
#pragma unroll
                for (int i = 0; i < 8; ++i) s1 += o[i];
                const float mean = wave_sum_fast(s1) * (1.f / 512.f);
                float s2 = 0.f;
#pragma unroll
                for (int i = 0; i < 8; ++i) { o[i] -= mean; s2 += o[i] * o[i]; }
                const float rs = rsqrtf(wave_sum_fast(s2) * (1.f / 512.f) + EPS);
                float s3 = 0.f;
#pragma unroll
                for (int i = 0; i < 8; ++i) { float y = o[i] * rs * lng[i] + lnb[i]; y = y * sigmoid_f(y); o[i] = y; s3 += y * y; }
                const float r2 = rsqrtf(wave_sum_fast(s3) * (1.f / 512.f) + EPS);
                float bgv[8], cxc[8], accs[8];
                proj8_at(PROJ, MP, MR, b, NMETA + s, 8 * lane, cxc); proj8_at(PROJ, MP, MR, b, NMETA + s, 512 + 8 * lane, bgv);
                float s4 = 0.f;
#pragma unroll
                for (int i = 0; i < 8; ++i) { accs[i] = bgv[i] * (wsc[0][i] * cxa[i] + wsc[1][i] * cxb[i] + wsc[2][i] * cxc[i]); s4 += accs[i] * accs[i]; cxa[i] = cxb[i]; cxb[i] = cxc[i]; }
                const float r4 = rsqrtf(wave_sum_fast(s4) * (1.f / 512.f) + EPS);
                float ym = 0.f;
#pragma unroll
                for (int i = 0; i < 8; ++i) { o[i] *= r2; accs[i] *= r4; ym = fmaxf(ym, fmaxf(fabsf(o[i]), fabsf(accs[i]))); }
                ym = fmaxf(wave_max_fast(ym), 1e-30f);
                const float yinv = 127.f / ym;
                if (lane == 0) ((float*)(ws + WS_SY))[t] = ym * (1.f / 127.f);
                u32x2 wz, wv;
                wz.x = ((unsigned)(int)rintf(accs[0] * yinv) & 255u) | (((unsigned)(int)rintf(accs[1] * yinv) & 255u) << 8) | (((unsigned)(int)rintf(accs[2] * yinv) & 255u) << 16) | ((unsigned)(int)rintf(accs[3] * yinv) << 24);
                wz.y = ((unsigned)(int)rintf(accs[4] * yinv) & 255u) | (((unsigned)(int)rintf(accs[5] * yinv) & 255u) << 8) | (((unsigned)(int)rintf(accs[6] * yinv) & 255u) << 16) | ((unsigned)(int)rintf(accs[7] * yinv) << 24);
                wv.x = ((unsigned)(int)rintf(o[0] * yinv) & 255u) | (((unsigned)(int)rintf(o[1] * yinv) & 255u) << 8) | (((unsigned)(int)rintf(o[2] * yinv) & 255u) << 16) | ((unsigned)(int)rintf(o[3] * yinv) << 24);
                wv.y = ((unsigned)(int)rintf(o[4] * yinv) & 255u) | (((unsigned)(int)rintf(o[5] * yinv) & 255u) << 8) | (((unsigned)(int)rintf(o[6] * yinv) & 255u) << 16) | ((unsigned)(int)rintf(o[7] * yinv) << 24);
                *(u32x2*)(ws + WS_Y + t * DM + 8 * lane) = wz;
                *(u32x2*)(ws + WS_Y + t * DM + 512 + 8 * lane) = wv;
            }
        }
        __syncthreads();
    }
}

__device__ __forceinline__ int ord_i(float s) { int k = __builtin_bit_cast(int, s); k ^= (k >> 31) & 0x7fffffff; return k; }
__device__ __forceinline__ float unord_f(int k) { k ^= (k >> 31) & 0x7fffffff; return __builtin_bit_cast(float, k); }
#define TOP_INSERT(L, x_) do { int _x = (x_); _Pragma("unroll") for (int _i = 0; _i < 16; ++_i) { const int _hi = max(L[_i], _x); _x = min(L[_i], _x); L[_i] = _hi; } } while (0)

typedef short bf16x8 __attribute__((ext_vector_type(8)));
typedef float f32x16 __attribute__((ext_vector_type(16)));
template <bool DESC> __device__ __forceinline__ void ce_i(int& a, int& b) { const int hi = max(a, b), lo = min(a, b); if (DESC) { a = hi; b = lo; } else { a = lo; b = hi; } }
__device__ __forceinline__ void bitonic_sort16(int (&a)[16]) {
#pragma unroll
    for (int k = 2; k <= 16; k <<= 1)
#pragma unroll
        for (int j = k >> 1; j > 0; j >>= 1)
#pragma unroll
            for (int i = 0; i < 16; ++i) { const int l = i ^ j; if (l > i) { if ((i & k) == 0) ce_i<true>(a[i], a[l]); else ce_i<false>(a[i], a[l]); } }
}
__device__ __forceinline__ void bitonic_merge16(int (&a)[16]) {
#pragma unroll
    for (int j = 8; j > 0; j >>= 1)
#pragma unroll
        for (int i = 0; i < 16; ++i) { const int l = i ^ j; if (l > i) ce_i<true>(a[i], a[l]); }
}
__device__ __forceinline__ void merge_top16(int (&a)[16], const int (&b)[16]) {
#pragma unroll
    for (int i = 0; i < 16; ++i) a[i] = max(a[i], b[15 - i]);
    bitonic_merge16(a);
}
__device__ __forceinline__ int lut16(const unsigned (&T)[4], int i) {
    const unsigned sel = (unsigned)(i & 7) | 0x0c0c0c00u;
    const unsigned lo = __builtin_amdgcn_perm(T[1], T[0], sel), hi = __builtin_amdgcn_perm(T[3], T[2], sel);
    return (int)((i & 8) ? hi : lo);
}
constexpr int KROW = 272;
constexpr float SCORE_BIAS = 8.0f;

__device__ __forceinline__ void route_load_q(bf16x8 (&qf)[8], const bf16* qrow, int hb) {
#pragma unroll
    for (int ks = 0; ks < 8; ++ks) qf[ks] = *(const bf16x8*)(qrow + 64 * hb + 8 * ks);
}
__device__ __forceinline__ void route_half(const LAS unsigned char* kl, const bf16x8 (&qf)[8], int nl, int hb, int (&L)[16]) {
    f32x16 acc[4];
#pragma unroll
    for (int nt = 0; nt < 4; ++nt)
#pragma unroll
        for (int r = 0; r < 16; ++r) acc[nt][r] = SCORE_BIAS;
#pragma unroll
    for (int ks = 0; ks < 8; ++ks)
#pragma unroll
        for (int nt = 0; nt < 4; ++nt) {
            const bf16x8 a = *(const LAS bf16x8*)(kl + (32 * nt + nl) * KROW + (64 * hb + 8 * ks) * 2);
            acc[nt] = __builtin_amdgcn_mfma_f32_32x32x16_bf16(a, qf[ks], acc[nt], 0, 0, 0);
        }
    const int hb4 = 4 * hb;
    int T[4][16];
#pragma unroll
    for (int nt = 0; nt < 4; ++nt)
#pragma unroll
        for (int r = 0; r < 16; ++r) { const int n0 = 32 * nt + (r & 3) + 8 * (r >> 2); const float sc = acc[nt][r];
            T[nt][r] = (__float_as_int(sc) & ~127) | ((127 - n0) - hb4); }
    bitonic_sort16(T[0]); bitonic_sort16(T[1]); bitonic_sort16(T[2]); bitonic_sort16(T[3]);
    merge_top16(T[0], T[1]); merge_top16(T[2], T[3]); merge_top16(T[0], T[2]);
#pragma unroll
    for (int i = 0; i < 16; ++i) { const unsigned v = (unsigned)T[0][15 - i]; auto r = __builtin_amdgcn_permlane32_swap(v, v, false, false);
        const unsigned r0 = r[0], r1 = r[1]; const int partner = (int)(hb ? r0 : r1); L[i] = max(T[0][i], partner); }
    bitonic_merge16(L);
}

__device__ __forceinline__ void phase_route(const Params& P, LAS unsigned char* lds) {
    const int tid = threadIdx.x, lane = tid & 63, wave = __builtin_amdgcn_readfirstlane(tid >> 6);
    const int nl = lane & 31, hb = lane >> 5;
    unsigned char* ws = P.ws;
    const bf16* KEYS = (const bf16*)(ws + WS_KEYS); const bf16* Q = (const bf16*)(ws + WS_Q);
    int* IDX = (int*)(ws + WS_IDX); float* GATE = (float*)(ws + WS_GATE);
    int last_h = -1;
    pg8::StaticOrder S; S.init(NTOK, 2048, (int)gridDim.x, (int)blockIdx.x);
    pg8::Unit ucur, unxt;
    bool have = S.next(0, ucur);
    bf16x8 qfA[8], qfB[8];
    if (have) route_load_q(qfA, Q + ((size_t)ucur.pm * 256 + wave * 32 + nl) * 2048 + ucur.pn * 256, hb);
    for (int ui = 0; have; ++ui) {
        const int h = ucur.pn, tb = ucur.pm;
        const bool have_next = S.next(ui + 1, unxt);
        if (h != last_h) {
            __syncthreads();
            for (int c = tid; c < 4096; c += NTHREADS) { const u32x4 v = ((const u32x4*)(KEYS + (size_t)h * 32768))[c];
                *(LAS u32x4*)(lds + (c >> 4) * KROW + (c & 15) * 16) = v; }
            __syncthreads();
            last_h = h;
        }
        const size_t t = (size_t)tb * 256 + wave * 32 + nl;
        int L1[16], L2[16];
        route_load_q(qfB, Q + t * 2048 + h * 256 + 128, hb);
        route_half(lds, qfA, nl, hb, L1);
        if (have_next) route_load_q(qfA, Q + ((size_t)unxt.pm * 256 + wave * 32 + nl) * 2048 + unxt.pn * 256, hb);
        route_half(lds + 128 * KROW, qfB, nl, hb, L2);
        float v1[16], v2[16];
#pragma unroll
        for (int i = 0; i < 16; ++i) { v1[i] = __int_as_float(L1[i] & ~127); v2[i] = __int_as_float(L2[i] & ~127); }
#define CAND(i, j) ((__float_as_int(v1[i] + v2[j]) & ~255) | (255 - (16 * (i) + (j))))
        int A[16], B[16], C[16];
#pragma unroll
        for (int j = 0; j < 16; ++j) A[j] = CAND(0, j);
#pragma unroll
        for (int j = 0; j < 8; ++j) { B[j] = CAND(1, j); B[8 + j] = CAND(15 - j, 0); }
        bitonic_merge16(B);
        C[0] = CAND(2, 0); C[1] = CAND(2, 1); C[2] = CAND(2, 2); C[3] = CAND(2, 3); C[4] = CAND(2, 4);
        C[5] = CAND(3, 0); C[6] = CAND(3, 1); C[7] = CAND(3, 2); C[8] = CAND(3, 3);
        C[9] = CAND(4, 0); C[10] = CAND(4, 1); C[11] = CAND(4, 2);
        C[12] = CAND(5, 0); C[13] = CAND(5, 1); C[14] = CAND(6, 0); C[15] = CAND(6, 1);
        bitonic_sort16(C);
        { const int d0 = CAND(7, 0), d1 = CAND(7, 1); C[14] = max(C[14], d1); C[15] = max(C[15], d0); bitonic_merge16(C); }
#undef CAND
        merge_top16(A, B); merge_top16(A, C);
        unsigned T1[4], T2[4];
#pragma unroll
        for (int q = 0; q < 4; ++q) {
            T1[q] = (unsigned)(127 - (L1[4 * q] & 127)) | ((unsigned)(127 - (L1[4 * q + 1] & 127)) << 8) | ((unsigned)(127 - (L1[4 * q + 2] & 127)) << 16) | ((unsigned)(127 - (L1[4 * q + 3] & 127)) << 24);
            T2[q] = (unsigned)(127 - (L2[4 * q] & 127)) | ((unsigned)(127 - (L2[4 * q + 1] & 127)) << 8) | ((unsigned)(127 - (L2[4 * q + 2] & 127)) << 16) | ((unsigned)(127 - (L2[4 * q + 3] & 127)) << 24); }
        float val[16]; int ex[16];
#pragma unroll
        for (int k = 0; k < 16; ++k) { const int pos = 255 - (A[k] & 255); val[k] = __int_as_float(A[k] & ~255);
            ex[k] = lut16(T1, pos >> 4) * NKEYS + lut16(T2, pos & 15); }
        float sum = 0.f; const float vmax = val[0];
#pragma unroll
        for (int k = 0; k < 16; ++k) { val[k] = __expf(val[k] - vmax); sum += val[k]; }
        const float inv = 1.f / sum;
        if (hb == 0) {
            int* ip = IDX + t * NSEL + h * TOPK; float* gp = GATE + t * NSEL + h * TOPK;
#pragma unroll
            for (int k4 = 0; k4 < 4; ++k4) {
                *(int4*)(ip + 4 * k4) = make_int4(ex[4 * k4], ex[4 * k4 + 1], ex[4 * k4 + 2], ex[4 * k4 + 3]);
                *(f32x4*)(gp + 4 * k4) = (f32x4){val[4 * k4] * inv, val[4 * k4 + 1] * inv, val[4 * k4 + 2] * inv, val[4 * k4 + 3] * inv};
            }
        }
        ucur = unxt; have = have_next;
    }
}

#define FP4X2(w, sel) __builtin_amdgcn_cvt_scalef32_pk_f32_fp4((w), 1.0f, (sel))
__device__ __forceinline__ float dot16_fp4(const u32x2 r, const f32x4 (&xs)[4]) {
    float p = 0.f;
    { const f32x2 a = FP4X2(r.x, 0), b = FP4X2(r.x, 1), c = FP4X2(r.x, 2), d = FP4X2(r.x, 3);
      p += (a.x * xs[0].x + a.y * xs[0].y) + (b.x * xs[0].z + b.y * xs[0].w); p += (c.x * xs[1].x + c.y * xs[1].y) + (d.x * xs[1].z + d.y * xs[1].w); }
    { const f32x2 a = FP4X2(r.y, 0), b = FP4X2(r.y, 1), c = FP4X2(r.y, 2), d = FP4X2(r.y, 3);
      p += (a.x * xs[2].x + a.y * xs[2].y) + (b.x * xs[2].z + b.y * xs[2].w); p += (c.x * xs[3].x + c.y * xs[3].y) + (d.x * xs[3].z + d.y * xs[3].w); }
    return p;
}
__device__ __forceinline__ void axpy16_fp4(const u32x2 r, float w, f32x4 (&o)[4]) {
    { const f32x2 a = FP4X2(r.x, 0), b = FP4X2(r.x, 1), c = FP4X2(r.x, 2), d = FP4X2(r.x, 3);
      o[0].x += w * a.x; o[0].y += w * a.y; o[0].z += w * b.x; o[0].w += w * b.y; o[1].x += w * c.x; o[1].y += w * c.y; o[1].z += w * d.x; o[1].w += w * d.y; }
    { const f32x2 a = FP4X2(r.y, 0), b = FP4X2(r.y, 1), c = FP4X2(r.y, 2), d = FP4X2(r.y, 3);
      o[2].x += w * a.x; o[2].y += w * a.y; o[2].z += w * b.x; o[2].w += w * b.y; o[3].x += w * c.x; o[3].y += w * c.y; o[3].z += w * d.x; o[3].w += w * d.y; }
}
__device__ __forceinline__ float swap32_add(float a, float b) { auto r = __builtin_amdgcn_permlane32_swap(__float_as_uint(a), __float_as_uint(b), false, false); return __uint_as_float(r[0]) + __uint_as_float(r[1]); }
__device__ __forceinline__ float swap16_add(float a, float b) { auto r = __builtin_amdgcn_permlane16_swap(__float_as_uint(a), __float_as_uint(b), false, false); return __uint_as_float(r[0]) + __uint_as_float(r[1]); }
__device__ __forceinline__ float row_sum16(float v) { v += dpp_f<0xB1>(v); v += dpp_f<0x4E>(v); v += dpp_f<0x141>(v); v += dpp_f<0x140>(v); return v; }
constexpr int GB = 32;
typedef __attribute__((address_space(8))) void* rsrc_t;
__device__ __forceinline__ void g_issue(u32x2 (&buf)[GB], __amdgpu_buffer_rsrc_t rs, int idxr, int lb, int voff) {
#pragma unroll
    for (int j = 0; j < GB; ++j) { const int e = __builtin_amdgcn_readlane(idxr, lb + j); buf[j] = __builtin_amdgcn_raw_buffer_load_b64(rs, voff, e * 512, 0); }
}
__device__ __forceinline__ float dot16_fp4p(const u32x2 r, const f32x2 (&xp)[8]) {
    f32x2 a = FP4X2(r.x, 0) * xp[0];
    a += FP4X2(r.x, 1) * xp[1]; a += FP4X2(r.x, 2) * xp[2]; a += FP4X2(r.x, 3) * xp[3];
    a += FP4X2(r.y, 0) * xp[4]; a += FP4X2(r.y, 1) * xp[5]; a += FP4X2(r.y, 2) * xp[6]; a += FP4X2(r.y, 3) * xp[7];
    return a.x + a.y;
}
__device__ __forceinline__ void axpy16_fp4p(const u32x2 r, float w, f32x2 (&o)[8]) {
    const f32x2 ww = (f32x2){w, w};
    o[0] += FP4X2(r.x, 0) * ww; o[1] += FP4X2(r.x, 1) * ww; o[2] += FP4X2(r.x, 2) * ww; o[3] += FP4X2(r.x, 3) * ww;
    o[4] += FP4X2(r.y, 0) * ww; o[5] += FP4X2(r.y, 1) * ww; o[6] += FP4X2(r.y, 2) * ww; o[7] += FP4X2(r.y, 3) * ww;
}
template <int H> __device__ __forceinline__ void g_compute_u(const u32x2 (&buf)[GB], int q, int i16, const f32x2 (&xp)[8], float& zlo, float& zhi) {
    float p[16];
#pragma unroll
    for (int j = 0; j < 16; ++j) p[j] = dot16_fp4p(buf[16 * H + j], xp);
    float s1[8], s2[4];
#pragma unroll
    for (int m = 0; m < 8; ++m) s1[m] = swap32_add(p[2 * m], p[2 * m + 1]);
#pragma unroll
    for (int n = 0; n < 4; ++n) s2[n] = swap16_add(s1[2 * n], s1[2 * n + 1]);
#pragma unroll
    for (int r = 0; r < 4; ++r) { const float z = row_sum16(s2[r]); const bool mine = i16 == ((4 * q + r) & 15);
        zlo = (mine && q < 4) ? z : zlo; zhi = (mine && q >= 4) ? z : zhi; }
}
template <int H> __device__ __forceinline__ void g_compute_v(const u32x2 (&buf)[GB], int q, float alo, float ahi, f32x2 (&o)[8]) {
    const int areg = __builtin_bit_cast(int, (q < 4) ? alo : ahi), sb = 4 * (q & 3);
#pragma unroll
    for (int j = 0; j < 16; ++j) { const int src = 32 * (j & 1) + 16 * ((j >> 1) & 1) + (j >> 2) + sb;
        const float w = __builtin_bit_cast(float, __builtin_amdgcn_readlane(areg, src));
        axpy16_fp4p(buf[16 * H + j], w, o); }
}
__device__ __forceinline__ void q_issue(u32x2 (&buf)[16], __amdgpu_buffer_rsrc_t rs, int ixr  , int lb, int voff) {
#pragma unroll
    for (int j = 0; j < 16; ++j) { const int e9 = __builtin_amdgcn_readlane(ixr, lb + j); buf[j] = __builtin_amdgcn_raw_buffer_load_b64(rs, voff, e9, 0); }
}
__device__ __forceinline__ void q_compute_u(const u32x2 (&buf)[16], int q, int i16, const f32x2 (&xp)[8], float& zlo, float& zhi) {
    float p[16];
#pragma unroll
    for (int j = 0; j < 16; ++j) p[j] = dot16_fp4p(buf[j], xp);
    float s1[8], s2[4];
#pragma unroll
    for (int m = 0; m < 8; ++m) s1[m] = swap32_add(p[2 * m], p[2 * m + 1]);
#pragma unroll
    for (int n = 0; n < 4; ++n) s2[n] = swap16_add(s1[2 * n], s1[2 * n + 1]);
#pragma unroll
    for (int r = 0; r < 4; ++r) { const float z = row_sum16(s2[r]); const bool mine = i16 == ((4 * q + r) & 15);
        zlo = (mine && q < 4) ? z : zlo; zhi = (mine && q >= 4) ? z : zhi; }
}
typedef _Float16 h16x2 __attribute__((ext_vector_type(2)));
#define FP4H2(w, sel) __builtin_amdgcn_cvt_scalef32_pk_f16_fp4((w), 1.0f, (sel))
__device__ __forceinline__ void axpy16_fp4h(const u32x2 r, const h16x2 ww, h16x2 (&o)[8]) {
    o[0] += FP4H2(r.x, 0) * ww; o[1] += FP4H2(r.x, 1) * ww; o[2] += FP4H2(r.x, 2) * ww; o[3] += FP4H2(r.x, 3) * ww;
    o[4] += FP4H2(r.y, 0) * ww; o[5] += FP4H2(r.y, 1) * ww; o[6] += FP4H2(r.y, 2) * ww; o[7] += FP4H2(r.y, 3) * ww;
}
__device__ __forceinline__ void q_compute_vh(const u32x2 (&buf)[16], int q, int alo, int ahi, h16x2 (&o)[8]) {
    const int areg = (q < 4) ? alo : ahi, sb = 4 * (q & 3);
#pragma unroll
    for (int j = 0; j < 16; ++j) { const int src = 32 * (j & 1) + 16 * ((j >> 1) & 1) + (j >> 2) + sb;
        const h16x2 w = __builtin_bit_cast(h16x2, __builtin_amdgcn_readlane(areg, src));
        axpy16_fp4h(buf[j], w, o); }
}
__device__ __forceinline__ void q_compute_v(const u32x2 (&buf)[16], int q, float alo, float ahi, f32x2 (&o)[8]) {
    const int areg = __builtin_bit_cast(int, (q < 4) ? alo : ahi), sb = 4 * (q & 3);
#pragma unroll
    for (int j = 0; j < 16; ++j) { const int src = 32 * (j & 1) + 16 * ((j >> 1) & 1) + (j >> 2) + sb;
        const float w = __builtin_bit_cast(float, __builtin_amdgcn_readlane(areg, src));
        axpy16_fp4p(buf[j], w, o); }
}
__device__ __forceinline__ int swap32_addi(int a, int b) { auto r = __builtin_amdgcn_permlane32_swap((unsigned)a, (unsigned)b, false, false); const unsigned r0 = r[0], r1 = r[1]; return (int)(r0 + r1); }
__device__ __forceinline__ int swap16_addi(int a, int b) { auto r = __builtin_amdgcn_permlane16_swap((unsigned)a, (unsigned)b, false, false); const unsigned r0 = r[0], r1 = r[1]; return (int)(r0 + r1); }
template <int CTRL> __device__ __forceinline__ int dpp_i(int v) { return __builtin_amdgcn_update_dpp(0, v, CTRL, 0xf, 0xf, true); }
__device__ __forceinline__ int row_sum16i(int v) { v += dpp_i<0xB1>(v); v += dpp_i<0x4E>(v); v += dpp_i<0x141>(v); v += dpp_i<0x140>(v); return v; }
__device__ __forceinline__ void q_compute_ui(const u32x2 (&buf)[16], int q, int i16, int xh0, int xh1, int xl0, int xl1, int& zlo, int& zhi) {
    int p[16];
#pragma unroll
    for (int j = 0; j < 16; ++j) { const int d1 = __builtin_amdgcn_sdot8((int)buf[j].x, xh0, __builtin_amdgcn_sdot8((int)buf[j].y, xh1, 0, false), false);
        const int d2 = __builtin_amdgcn_sdot8((int)buf[j].x, xl0, __builtin_amdgcn_sdot8((int)buf[j].y, xl1, 0, false), false);
        p[j] = (d1 << 4) + d2; }
    int s1[8], s2[4];
#pragma unroll
    for (int m = 0; m < 8; ++m) s1[m] = swap32_addi(p[2 * m], p[2 * m + 1]);
#pragma unroll
    for (int n = 0; n < 4; ++n) s2[n] = swap16_addi(s1[2 * n], s1[2 * n + 1]);
#pragma unroll
    for (int r = 0; r < 4; ++r) { const int z = row_sum16i(s2[r]); const bool mine = i16 == ((4 * q + r) & 15);
        zlo = (mine && q < 4) ? z : zlo; zhi = (mine && q >= 4) ? z : zhi; }
}
__device__ __forceinline__ void phase_gather_u(const Params& P) {
    const int tid = threadIdx.x, lane = tid & 63, wave = __builtin_amdgcn_readfirstlane(tid >> 6);
    const int gw = blockIdx.x * NWAVES + wave, NGW = gridDim.x * NWAVES;
    unsigned char* ws = P.ws;
    const int* IDX = (const int*)(ws + WS_IDX); const float* GATE = (const float*)(ws + WS_GATE); const float* ESC = (const float*)(ws + WS_ESCALE); float* AW = (float*)(ws + WS_AW);
    const __amdgpu_buffer_rsrc_t rsU = __builtin_amdgcn_make_buffer_rsrc((void*)(ws + WS_U8), 0, 16384 * 512, 0x00020000);
    const bf16* H2B = (const bf16*)(ws + WS_H2B); const float* SSQ = (const float*)(ws + WS_SSQ);
    const int hh = lane >> 5, rr = (lane >> 4) & 1, i16 = lane & 15, gsel = 4 * i16 + 2 * rr + hh;
    const int voff = 8 * lane;
    const unsigned ul = (unsigned)lane;
    int t = gw;
    if (t < NTOK) {
        int idx0, idx1; u32x2 hraw[4]; float sqv;
        { const int* ip = IDX + (size_t)t * NSEL; idx0 = ip[ul]; idx1 = ip[64u + ul];
          const u32x2* hp = (const u32x2*)(H2B + (size_t)t * DM);
#pragma unroll
          for (int j = 0; j < 4; ++j) hraw[j] = hp[64u * j + ul];
          sqv = (SSQ + (size_t)t * 16)[ul & 15u]; }
        u32x2 R0[16], R1[16], R2[16], R3[16];
        { const int ix0 = idx0 << 9; q_issue(R0, rsU, ix0, 0, voff); q_issue(R1, rsU, ix0, 16, voff); q_issue(R2, rsU, ix0, 32, voff); }
        for (;;) {
            const int tn = t + NGW; const bool has_next = tn < NTOK; const int tl = has_next ? tn : t;
            int idx0n, idx1n; u32x2 hrawn[4]; float sqn, g0, g1;
            { const int* ip = IDX + (size_t)tl * NSEL; idx0n = ip[ul]; idx1n = ip[64u + ul];
              const u32x2* hp = (const u32x2*)(H2B + (size_t)tl * DM);
#pragma unroll
              for (int j = 0; j < 4; ++j) hrawn[j] = hp[64u * j + ul];
              sqn = (SSQ + (size_t)tl * 16)[ul & 15u];
              const float* gp = GATE + (size_t)t * NSEL; g0 = gp[ul]; g1 = gp[64u + ul]; }
            const float su0 = ESC[idx0], su1 = ESC[idx1], sv0 = ESC[16384 + idx0], sv1 = ESC[16384 + idx1];
            const float cq0 = ((const float*)(ws + WS_SUMQ))[idx0], cq1 = ((const float*)(ws + WS_SUMQ))[idx1];
            const float rstd2 = rsqrtf(row_sum16(sqv) * (1.f / DM) + EPS);
            float xf[16];
#pragma unroll
            for (int j = 0; j < 4; ++j) { xf[4 * j] = bflo(hraw[j].x); xf[4 * j + 1] = bfhi(hraw[j].x); xf[4 * j + 2] = bflo(hraw[j].y); xf[4 * j + 3] = bfhi(hraw[j].y); }
            float am = 0.f;
#pragma unroll
            for (int e = 0; e < 16; ++e) am = fmaxf(am, fabsf(xf[e]));
            am = fmaxf(wave_max_fast(am), 1e-30f);
            const float xinv = 127.f / am, xscale = am * (1.f / 127.f);
            unsigned xh[2] = {0u, 0u}, xl[2] = {0u, 0u};
#pragma unroll
            for (int j = 0; j < 4; ++j)
#pragma unroll
                for (int i = 0; i < 4; ++i) { const int xi = (int)rintf(xf[4 * j + i] * xinv); const int sh = 16 * (j & 1) + 4 * i;
                    xh[j >> 1] |= ((unsigned)(xi >> 4) & 15u) << sh; xl[j >> 1] |= ((unsigned)((xi & 15) - 8) & 15u) << sh; }
            int zlo = 0, zhi = 0;
            const int ix0 = idx0 << 9, ix1 = idx1 << 9;
#pragma unroll 1
            for (int qq = 0; qq < 8; qq += 4) {
                const int ixn = qq ? (idx0n << 9) : ix1;
                q_issue(R3, rsU, qq ? ix1 : ix0, 48, voff);
                q_compute_ui(R0, qq, i16, (int)xh[0], (int)xh[1], (int)xl[0], (int)xl[1], zlo, zhi);
                q_issue(R0, rsU, ixn, 0, voff);
                q_compute_ui(R1, qq + 1, i16, (int)xh[0], (int)xh[1], (int)xl[0], (int)xl[1], zlo, zhi);
                q_issue(R1, rsU, ixn, 16, voff);
                q_compute_ui(R2, qq + 2, i16, (int)xh[0], (int)xh[1], (int)xl[0], (int)xl[1], zlo, zhi);
                q_issue(R2, rsU, ixn, 32, voff);
                q_compute_ui(R3, qq + 3, i16, (int)xh[0], (int)xh[1], (int)xl[0], (int)xl[1], zlo, zhi);
            }
            const float glo = __shfl(g0, gsel), ghi = __shfl(g1, gsel), sulo = __shfl(su0, gsel), suhi = __shfl(su1, gsel), svlo = __shfl(sv0, gsel), svhi = __shfl(sv1, gsel);
            const float cqlo = __shfl(cq0, gsel), cqhi = __shfl(cq1, gsel);
            const float zfl = ((float)zlo + 8.f * cqlo) * (sulo * xscale * rstd2), zfh = ((float)zhi + 8.f * cqhi) * (suhi * xscale * rstd2);
            const float wl = gelu_tanh_f(zfl) * glo * svlo, wh = gelu_tanh_f(zfh) * ghi * svhi;
            const float wmx = fmaxf(wave_max_fast(fmaxf(fabsf(wl), fabsf(wh))), 1e-30f), wsc = 256.f / wmx;
            { const float a = wl * wsc, c = wh * wsc;
              const int ah = __builtin_amdgcn_cvt_pk_fp8_f32(a, a, 0, false) & 255, ch = __builtin_amdgcn_cvt_pk_fp8_f32(c, c, 0, false) & 255;
              const float ar = a - __builtin_amdgcn_cvt_f32_fp8(ah, 0), cr = c - __builtin_amdgcn_cvt_f32_fp8(ch, 0);
              const int al = __builtin_amdgcn_cvt_pk_fp8_f32(ar, ar, 0, false) & 255, cl = __builtin_amdgcn_cvt_pk_fp8_f32(cr, cr, 0, false) & 255;
              unsigned char* ap = (unsigned char*)AW + (size_t)t * 256;
              ap[gsel] = (unsigned char)ah; ap[64 + gsel] = (unsigned char)ch; ap[128 + gsel] = (unsigned char)al; ap[192 + gsel] = (unsigned char)cl;
              if (lane == 0) ((float*)(ws + WS_WMX))[t] = wmx * (1.f / 256.f); }
            if (!has_next) break;
            t = tn; idx0 = idx0n; idx1 = idx1n; sqv = sqn;
#pragma unroll
            for (int j = 0; j < 4; ++j) hraw[j] = hrawn[j];
        }
    }
}
__device__ __forceinline__ void phase_gather_v(const Params& P) {
    const int tid = threadIdx.x, lane = tid & 63, wave = __builtin_amdgcn_readfirstlane(tid >> 6);
    const int gw = blockIdx.x * NWAVES + wave, NGW = gridDim.x * NWAVES;
    unsigned char* ws = P.ws;
    const int* IDX = (const int*)(ws + WS_IDX); const float* AW = (const float*)(ws + WS_AW);
    const __amdgpu_buffer_rsrc_t rsV = __builtin_amdgcn_make_buffer_rsrc((void*)(ws + WS_V8), 0, 16384 * 512, 0x00020000);
    const bf16* H2B = (const bf16*)(ws + WS_H2B);
    const int voff = 8 * lane;
    const unsigned ul = (unsigned)lane;
    int t = gw;
    if (t < NTOK) {
        int idx0, idx1; u32x2 hraw[4]; float alo, ahi;
        { const int* ip = IDX + (size_t)t * NSEL; idx0 = ip[ul]; idx1 = ip[64u + ul];
          const u32x2* hp = (const u32x2*)(H2B + (size_t)t * DM);
#pragma unroll
          for (int j = 0; j < 4; ++j) hraw[j] = hp[64u * j + ul];
          const float* ap = AW + (size_t)t * NSEL; alo = ap[ul]; ahi = ap[64u + ul]; }
        u32x2 R0[16], R1[16], R2[16], R3[16];
        { const int ix0 = idx0 << 9; q_issue(R0, rsV, ix0, 0, voff); q_issue(R1, rsV, ix0, 16, voff); q_issue(R2, rsV, ix0, 32, voff); }
        for (;;) {
            const int tn = t + NGW; const bool has_next = tn < NTOK; const int tl = has_next ? tn : t;
            int idx0n, idx1n; u32x2 hrawn[4]; float alon, ahin;
            { const int* ip = IDX + (size_t)tl * NSEL; idx0n = ip[ul]; idx1n = ip[64u + ul];
              const u32x2* hp = (const u32x2*)(H2B + (size_t)tl * DM);
#pragma unroll
              for (int j = 0; j < 4; ++j) hrawn[j] = hp[64u * j + ul];
              const float* ap = AW + (size_t)tl * NSEL; alon = ap[ul]; ahin = ap[64u + ul]; }
            const float wmx = fmaxf(wave_max_fast(fmaxf(fabsf(alo), fabsf(ahi))), 1e-30f), winv = 1.f / wmx;
            int alh, ahh;
            { const h16x2 a = (h16x2){(_Float16)(alo * winv), (_Float16)(alo * winv)}, b = (h16x2){(_Float16)(ahi * winv), (_Float16)(ahi * winv)};
              alh = __builtin_bit_cast(int, a); ahh = __builtin_bit_cast(int, b); }
            h16x2 oh[8];
#pragma unroll
            for (int j = 0; j < 8; ++j) oh[j] = (h16x2){(_Float16)0.f, (_Float16)0.f};
            const int ix0 = idx0 << 9, ix1 = idx1 << 9;
#pragma unroll 1
            for (int qq = 0; qq < 8; qq += 4) {
                const int ixn = qq ? (idx0n << 9) : ix1;
                q_issue(R3, rsV, qq ? ix1 : ix0, 48, voff);
                q_compute_vh(R0, qq, alh, ahh, oh);
                q_issue(R0, rsV, ixn, 0, voff);
                q_compute_vh(R1, qq + 1, alh, ahh, oh);
                q_issue(R1, rsV, ixn, 16, voff);
                q_compute_vh(R2, qq + 2, alh, ahh, oh);
                q_issue(R2, rsV, ixn, 32, voff);
                q_compute_vh(R3, qq + 3, alh, ahh, oh);
            }
            f32x2 o[8];
#pragma unroll
            for (int j = 0; j < 8; ++j) o[j] = (f32x2){(float)oh[j].x * wmx, (float)oh[j].y * wmx};
            float ss = 0.f;
#pragma unroll
            for (int j = 0; j < 4; ++j) { o[2 * j] += (f32x2){bflo(hraw[j].x), bfhi(hraw[j].x)}; o[2 * j + 1] += (f32x2){bflo(hraw[j].y), bfhi(hraw[j].y)}; }
#pragma unroll
            for (int j = 0; j < 8; ++j) ss += o[j].x * o[j].x + o[j].y * o[j].y;
            ss = wave_sum_fast(ss);
            const float r3 = rsqrtf(ss * (1.f / DM) + EPS);
            f32x4* op = (f32x4*)(P.out + (size_t)t * DM);
            const f32x4* gfp = (const f32x4*)P.g_fin;
#pragma unroll
            for (int j = 0; j < 4; ++j) { const f32x4 gv = gfp[64u * j + ul]; op[64u * j + ul] = (f32x4){o[2 * j].x * r3 * gv.x, o[2 * j].y * r3 * gv.y, o[2 * j + 1].x * r3 * gv.z, o[2 * j + 1].y * r3 * gv.w}; }
            if (!has_next) break;
            t = tn; idx0 = idx0n; idx1 = idx1n; alo = alon; ahi = ahin;
#pragma unroll
            for (int j = 0; j < 4; ++j) hraw[j] = hrawn[j];
        }
    }
}


typedef int i32x2v __attribute__((ext_vector_type(2)));
typedef int i32x8v __attribute__((ext_vector_type(8)));
#define VM_X 9
#define VM_WAIT(n) asm volatile("s_waitcnt vmcnt(" #n ")" ::: "memory")
__device__ __forceinline__ void phase_gather_v_mfma(const Params& P, LAS unsigned char* lds) {
    const int tid = threadIdx.x, lane = tid & 63, wave = __builtin_amdgcn_readfirstlane(tid >> 6);
    unsigned char* ws = P.ws;
    const int* IDX = (const int*)(ws + WS_IDX);
    const unsigned char* V8 = ws + WS_V8; const unsigned char* AW8 = ws + WS_AW; const float* WMX = (const float*)(ws + WS_WMX);
    const unsigned short* H2S = (const unsigned short*)(ws + WS_H2B);
    const int TPB = NTOK / (int)gridDim.x, t0 = blockIdx.x * TPB, NST = TPB * 4;
    const int r0 = 16 * wave + (lane >> 3), r1 = r0 + 8;
    const unsigned c0 = 16u * (unsigned)((lane & 7) ^ ((r0 >> 1) & 7)), c1 = 16u * (unsigned)((lane & 7) ^ ((r1 >> 1) & 7));
    const int i16 = lane & 15, kb = lane >> 4;
    const int ra = 32 * kb + i16, rb = ra + 16;
    const unsigned offa = (unsigned)(ra * 128 + 16 * (wave ^ ((ra >> 1) & 7))), offb = (unsigned)(rb * 128 + 16 * (wave ^ ((rb >> 1) & 7)));
    const unsigned aoffb = (unsigned)(((i16 & 1) ? 128 : 0) + 16 * kb);
    const bool arow = (i16 & 3) < 2;
    const int colb = 256 * kb + 32 * wave + i16;
    const float gf0 = P.g_fin[colb], gf1 = P.g_fin[colb + 16];
    LAS float* SS = (LAS float*)(lds + 131072 + 1024);
    const unsigned lbase = (unsigned)(unsigned long long)lds;
    struct VTok { u32x4 a, b; float w; unsigned h0, h1; };
    VTok C0, C1;
    int ia1, ib1, ia2, ib2, ia3, ib3;
#define VM_ISSUE(g, e0, e1) do { LAS unsigned char* _d = lds + (((g) & 7) * 16384) + wave * 2048; const unsigned _cb = 128u * (unsigned)((g) & 3); \
        __builtin_amdgcn_global_load_lds((const unsigned*)(V8 + (size_t)(e0) * 512 + _cb + c0), (LAS unsigned*)(_d), 16, 0, 0); \
        __builtin_amdgcn_global_load_lds((const unsigned*)(V8 + (size_t)(e1) * 512 + _cb + c1), (LAS unsigned*)(_d + 1024), 16, 0, 0); } while (0)
    {
        const int ia0 = IDX[(size_t)t0 * NSEL + r0], ib0 = IDX[(size_t)t0 * NSEL + r1];
        ia1 = IDX[(size_t)(t0 + 1) * NSEL + r0]; ib1 = IDX[(size_t)(t0 + 1) * NSEL + r1];
        ia2 = IDX[(size_t)(t0 + 2) * NSEL + r0]; ib2 = IDX[(size_t)(t0 + 2) * NSEL + r1];
        ia3 = IDX[(size_t)(t0 + 3) * NSEL + r0]; ib3 = IDX[(size_t)(t0 + 3) * NSEL + r1];
        const unsigned char* ap = AW8 + (size_t)t0 * 256 + aoffb;
        C0.a = *(const u32x4*)ap; C0.b = *(const u32x4*)(ap + 64); C0.w = WMX[t0]; C0.h0 = H2S[(size_t)t0 * DM + colb]; C0.h1 = H2S[(size_t)t0 * DM + colb + 16];
        C1.a = *(const u32x4*)(ap + 256); C1.b = *(const u32x4*)(ap + 256 + 64); C1.w = WMX[t0 + 1]; C1.h0 = H2S[(size_t)(t0 + 1) * DM + colb]; C1.h1 = H2S[(size_t)(t0 + 1) * DM + colb + 16];
        asm volatile("s_waitcnt vmcnt(0)" ::: "memory");
        VM_ISSUE(0, ia0, ib0); VM_ISSUE(1, ia0, ib0); VM_ISSUE(2, ia0, ib0); VM_ISSUE(3, ia0, ib0);
        VM_ISSUE(4, ia1, ib1); VM_ISSUE(5, ia1, ib1); VM_ISSUE(6, ia1, ib1);
    }
    float pv0 = 0.f, pv1 = 0.f;
    VTok N0, N1; int na4, nb4, na5, nb5;
    auto token = [&](const int i, const bool even, const VTok& C, const int e1a, const int e1b, const int e2a, const int e2b) __attribute__((always_inline)) {
        const int t = t0 + i;
        const u32x4 z = (u32x4){0u, 0u, 0u, 0u}; const u32x4 Alo = arow ? C.a : z, Ahi = arow ? C.b : z;
        const i32x8v A = (i32x8v){(int)Alo.x, (int)Alo.y, (int)Alo.z, (int)Alo.w, (int)Ahi.x, (int)Ahi.y, (int)Ahi.z, (int)Ahi.w};
        f32x4 acc[4][2];
#pragma unroll
        for (int cc = 0; cc < 4; ++cc) {
            const int g = 4 * i + cc;
            if (even && cc == 0) { VM_WAIT(12); } else { VM_WAIT(26); }
            asm volatile("s_waitcnt lgkmcnt(0)" ::: "memory");
            __builtin_amdgcn_s_barrier();
            __builtin_amdgcn_sched_barrier(0);
            const unsigned sa = lbase + (unsigned)((g & 7) * 16384) + offa, sbb = lbase + (unsigned)((g & 7) * 16384) + offb;
            i32x2v b00, b01, b10, b11;
            asm volatile("ds_read_b64_tr_b4 %0, %4\n\tds_read_b64_tr_b4 %1, %5\n\tds_read_b64_tr_b4 %2, %4 offset:8\n\tds_read_b64_tr_b4 %3, %5 offset:8"
                         : "=&v"(b00), "=&v"(b01), "=&v"(b10), "=&v"(b11) : "v"(sa), "v"(sbb) : "memory");
            { const int gn = g + 7;
              if (cc == 0) VM_ISSUE(gn, e1a, e1b); else VM_ISSUE(gn, e2a, e2b); }
            __builtin_amdgcn_sched_barrier(0);
            if (cc == 0) {
                if (even) {
                    const int tA = t0 + ((i + 2 < TPB) ? i + 2 : TPB - 2), tI = t0 + ((i + 4 < TPB) ? i + 4 : TPB - 2);
                    const unsigned char* ap = AW8 + (size_t)tA * 256 + aoffb; const float* wp = WMX + tA; const int* ipa = IDX + (size_t)tI * NSEL + r0; const unsigned short* hp = H2S + (size_t)tA * DM + colb;
                    asm volatile("global_load_dwordx4 %0, %14, off\n\tglobal_load_dwordx4 %1, %14, off offset:64\n\tglobal_load_dwordx4 %2, %14, off offset:256\n\tglobal_load_dwordx4 %3, %14, off offset:320\n\t"
                                 "global_load_dword %4, %15, off\n\tglobal_load_dword %5, %15, off offset:4\n\t"
                                 "global_load_ushort %6, %17, off\n\tglobal_load_ushort %7, %17, off offset:32\n\tglobal_load_ushort %8, %17, off offset:2048\n\tglobal_load_ushort %9, %17, off offset:2080\n\t"
                                 "global_load_dword %10, %16, off\n\tglobal_load_dword %11, %16, off offset:32\n\tglobal_load_dword %12, %16, off offset:512\n\tglobal_load_dword %13, %16, off offset:544"
                                 : "=&v"(N0.a), "=&v"(N0.b), "=&v"(N1.a), "=&v"(N1.b), "=&v"(N0.w), "=&v"(N1.w), "=&v"(N0.h0), "=&v"(N0.h1), "=&v"(N1.h0), "=&v"(N1.h1), "=&v"(na4), "=&v"(nb4), "=&v"(na5), "=&v"(nb5)
                                 : "v"(ap), "v"(wp), "v"(ipa), "v"(hp) : "memory");
                }
                { const f32x4 s0 = *(const LAS f32x4*)(SS + 8 * ((i + 1) & 1)), s1 = *(const LAS f32x4*)(SS + 8 * ((i + 1) & 1) + 4);
                  const float ss = ((s0.x + s0.y) + (s0.z + s0.w)) + ((s1.x + s1.y) + (s1.z + s1.w));
                  const float r3 = rsqrtf(ss * (1.f / DM) + EPS);
                  float* op = P.out + (size_t)((i > 0) ? t - 1 : t) * DM + colb;
                  op[0] = pv0 * r3 * gf0; op[16] = pv1 * r3 * gf1; }
                __builtin_amdgcn_sched_barrier(0);
            }
            asm volatile("s_waitcnt lgkmcnt(0)" : "+v"(b00), "+v"(b01), "+v"(b10), "+v"(b11) :: "memory");
            const i32x8v B0 = (i32x8v){b00.x, b00.y, b01.x, b01.y, 0, 0, 0, 0}, B1 = (i32x8v){b10.x, b10.y, b11.x, b11.y, 0, 0, 0, 0};
            const f32x4 z4 = (f32x4){0.f, 0.f, 0.f, 0.f};
            acc[cc][0] = __builtin_amdgcn_mfma_scale_f32_16x16x128_f8f6f4(A, B0, z4, 0  , 4  , 0, 0x7f7f7f7f, 0, 0x7f7f7f7f);
            acc[cc][1] = __builtin_amdgcn_mfma_scale_f32_16x16x128_f8f6f4(A, B1, z4, 0, 4, 0, 0x7f7f7f7f, 0, 0x7f7f7f7f);
        }
#pragma unroll
        for (int c = 0; c < 4; ++c) asm volatile("" :: "v"(acc[c][0]), "v"(acc[c][1]));
        float s0 = acc[0][0].x + acc[0][0].y, s1 = acc[0][1].x + acc[0][1].y;
        { const float a0 = acc[1][0].x + acc[1][0].y, a1 = acc[1][1].x + acc[1][1].y, b0 = acc[2][0].x + acc[2][0].y, b1 = acc[2][1].x + acc[2][1].y, d0 = acc[3][0].x + acc[3][0].y, d1 = acc[3][1].x + acc[3][1].y;
          s0 = (kb == 1) ? a0 : s0; s1 = (kb == 1) ? a1 : s1; s0 = (kb == 2) ? b0 : s0; s1 = (kb == 2) ? b1 : s1; s0 = (kb == 3) ? d0 : s0; s1 = (kb == 3) ? d1 : s1; }
        pv0 = s0 * C.w + __uint_as_float(C.h0 << 16); pv1 = s1 * C.w + __uint_as_float(C.h1 << 16);
        const float sq = wave_sum_fast(pv0 * pv0 + pv1 * pv1);
        if (lane == 0) SS[8 * (i & 1) + wave] = sq;
    };
#pragma unroll 1
    for (int i = 0; i < TPB; i += 2) {
        token(i, true, C0, ia1, ib1, ia2, ib2);
        token(i + 1, false, C1, ia2, ib2, ia3, ib3);
        asm volatile("s_waitcnt vmcnt(14)" : "+v"(N0.a), "+v"(N0.b), "+v"(N1.a), "+v"(N1.b), "+v"(N0.w), "+v"(N1.w), "+v"(N0.h0), "+v"(N0.h1), "+v"(N1.h0), "+v"(N1.h1), "+v"(na4), "+v"(nb4), "+v"(na5), "+v"(nb5) :: "memory");
        C0 = N0; C1 = N1; ia1 = ia3; ib1 = ib3; ia2 = na4; ib2 = nb4; ia3 = na5; ib3 = nb5;
    }
    asm volatile("s_waitcnt vmcnt(0)" ::: "memory");
    __builtin_amdgcn_s_barrier();
    { const int i = TPB; const f32x4 s0 = *(const LAS f32x4*)(SS + 8 * ((i + 1) & 1)), s1 = *(const LAS f32x4*)(SS + 8 * ((i + 1) & 1) + 4);
      const float ss = ((s0.x + s0.y) + (s0.z + s0.w)) + ((s1.x + s1.y) + (s1.z + s1.w));
      const float r3 = rsqrtf(ss * (1.f / DM) + EPS);
      float* op = P.out + (size_t)(t0 + TPB - 1) * DM + colb;
      op[0] = pv0 * r3 * gf0; op[16] = pv1 * r3 * gf1; }
#undef VM_ISSUE
}
#define XB_TMO      128
#define XB_XCNT(j)  (256  + 64 * (j))
#define XB_XSUB(j)  (1280 + 64 * (j))
#define XB_XGEN(j)  (2304 + 64 * (j))
#define XB_TOP      3328
#define XB_TOPGEN   3392
#define XCD_BAR_WORDS 3456
#define XB_SPIN_CAP (1u << 18)

__device__ __forceinline__ unsigned xb_ld(unsigned* p)              { return __hip_atomic_load(p, __ATOMIC_RELAXED, __HIP_MEMORY_SCOPE_AGENT); }
__device__ __forceinline__ unsigned xb_add(unsigned* p, unsigned v) { return __hip_atomic_fetch_add(p, v, __ATOMIC_RELAXED, __HIP_MEMORY_SCOPE_AGENT); }
__device__ __forceinline__ unsigned xb_xcc_id() { return (unsigned)__builtin_amdgcn_s_getreg((3 << 11) | 20) & 0xFu; }
#define XB_SPIN(cond, bar) do { unsigned _sp = 0; while (cond) { __builtin_amdgcn_s_sleep(1); \
    if ((++_sp & 255u) == 0u) { if (xb_ld(&(bar)[XB_TMO])) break; if (_sp > XB_SPIN_CAP) { atomicAdd(&(bar)[XB_TMO], 1u); break; } } } } while (0)

struct XcdBarrier {
    unsigned* bar; unsigned x;
    volatile LAS unsigned* st;
};

__device__ __forceinline__ XcdBarrier xcd_barrier_post(unsigned* bar, volatile LAS unsigned* st) {
    XcdBarrier b; b.bar = bar; b.x = xb_xcc_id(); b.st = st;
    if (threadIdx.x == 0) (void)xb_add(&bar[XB_XCNT(b.x)], 1u);
    return b;
}
__device__ __forceinline__ void xcd_barrier_complete(unsigned* bar, unsigned x, unsigned& nloc, unsigned& nx) {
    const unsigned G = gridDim.x * gridDim.y * gridDim.z;
    unsigned sum, cnt, mine, sp = 0u;
    for (;;) {
        sum = 0u; cnt = 0u; mine = 0u;
#pragma unroll
        for (unsigned j = 0; j < 16; ++j) { const unsigned c = xb_ld(&bar[XB_XCNT(j)]); sum += c; cnt += (c > 0u) ? 1u : 0u; mine = (j == x) ? c : mine; }
        if (sum == G) break;
        __builtin_amdgcn_s_sleep(1);
        if ((++sp & 255u) == 0u) { if (xb_ld(&bar[XB_TMO])) break; if (sp > XB_SPIN_CAP) { atomicAdd(&bar[XB_TMO], 1u); break; } }
    }
    nloc = mine > 0u ? mine : 1u; nx = cnt > 0u ? cnt : 1u;
}

__device__ __forceinline__ void xcd_barrier(const XcdBarrier& b) {
    asm volatile("s_waitcnt vmcnt(0)" ::: "memory");
    __syncthreads();
    if (threadIdx.x == 0) {
        unsigned* bar = b.bar;
        __builtin_amdgcn_s_waitcnt(0);
        unsigned nloc = b.st[0], nx = b.st[1];
        if (nloc == 0u) { xcd_barrier_complete(bar, b.x, nloc, nx); b.st[0] = nloc; b.st[1] = nx; }
        const unsigned old = xb_add(&bar[XB_XSUB(b.x)], 1u);
        const unsigned gen = old / nloc;
        if (old + 1u == (gen + 1u) * nloc) {
            __builtin_amdgcn_fence(__ATOMIC_RELEASE, "agent");
            asm volatile("s_waitcnt vmcnt(0)" ::: "memory");
            const unsigned og = xb_add(&bar[XB_TOP], 1u);
            const unsigned tg = og / nx;
            if (og + 1u == (tg + 1u) * nx) xb_add(&bar[XB_TOPGEN], 1u);
            else XB_SPIN(xb_ld(&bar[XB_TOPGEN]) == tg, bar);
            __builtin_amdgcn_fence(__ATOMIC_ACQUIRE, "agent");
            xb_add(&bar[XB_XGEN(b.x)], 1u);
            asm volatile("s_waitcnt vmcnt(0)" ::: "memory");
        } else {
            XB_SPIN(xb_ld(&bar[XB_XGEN(b.x)]) == gen, bar);
            __builtin_amdgcn_fence(__ATOMIC_ACQUIRE, "agent");
            asm volatile("s_waitcnt vmcnt(0)" ::: "memory");
        }
    }
    __syncthreads();
}


#ifndef MK_MULTI
#define MK_MULTI 0
#endif
constexpr int NPHASE = 9;
#ifndef REP5
#define REP5 1
#endif
#ifndef REP6
#define REP6 1
#endif
__global__ void __launch_bounds__(NTHREADS, 2) mk_fwd(Params P) {
    extern __shared__ __attribute__((aligned(16))) unsigned char lds_raw[];
    LAS unsigned char* lds = (LAS unsigned char*)lds_raw;
    cg::grid_group grid = cg::this_grid();
    unsigned char* ws = P.ws;
    const int lo = P.ph_lo, hi = P.ph_hi;
    volatile LAS unsigned* bst = (volatile LAS unsigned*)(lds + 131072 + 64);
    if (threadIdx.x < 2) bst[threadIdx.x] = 0u;
    __syncthreads();
    XcdBarrier xbar = xcd_barrier_post((unsigned*)(ws + WS_CTL), bst);
#define IN(k) (lo <= (k) && (k) < hi)
#define SEAM(k) do { if (IN(k) && IN((k) + 1)) { xcd_barrier(xbar); } } while (0)
    if (IN(0)) phase_prep(P, lds);
    SEAM(0);
    if (IN(1)) { phase_metaproj(P); phase_winq(P, lds); }
    SEAM(1);
    if (IN(2)) {
        pg8::Gemm g{(const bf16*)(ws + WS_H0I8), (const bf16*)(ws + WS_WIN_T), NTOK, DIN, DM / 2}; pg8::StaticOrder S; S.init(NTOK, DIN, (int)gridDim.x, (int)blockIdx.x);
        EpiProjI8 E{(bf16*)(ws + WS_PROJ), (const float*)(ws + WS_RSTD1), (const float*)(ws + WS_SW)};
        pg8::gemm_phase_i8<EpiProjI8, pg8::StaticOrder, true, true>(lds, g, S, E);
    }
    SEAM(2);
    if (IN(3)) phase_conv(P, lds);
    SEAM(3);
    if (IN(4)) {
        pg8::Gemm g{(const bf16*)(ws + WS_Y), (const bf16*)(ws + WS_WOUT_T), NTOK, DM, DM / 2}; pg8::StaticOrder S; S.init(NTOK, DM, (int)gridDim.x, (int)blockIdx.x);
        EpiResidualI8 E{(bf16*)(ws + WS_H2B), (const signed char*)(ws + WS_H0I8), (const float*)(ws + WS_SX), (const float*)(ws + WS_SY), (const float*)(ws + WS_SWO), (float*)(ws + WS_SSQ)};
        pg8::gemm_phase_i8<EpiResidualI8, pg8::StaticOrder, true, true>(lds, g, S, E);
    }
    SEAM(4);
    if (IN(5)) {
        pg8::Gemm g{(const bf16*)(ws + WS_H2B), (const bf16*)(ws + WS_WQ_T), NTOK, 2048, DM}; pg8::StaticOrder S; S.init(NTOK, 2048, (int)gridDim.x, (int)blockIdx.x);
        EpiRowScale<1> E{(bf16*)(ws + WS_Q), 2048, (const float*)(ws + WS_SSQ)};
        pg8::gemm_phase<EpiRowScale<1>, pg8::StaticOrder, true, true>(lds, g, S, E);
    }
    if (IN(5) && IN(6)) { asm volatile("s_waitcnt vmcnt(0)" ::: "memory"); __syncthreads(); }
    if (IN(6)) phase_route(P, lds);
    SEAM(6);
    if (IN(7)) phase_gather_u(P);
    SEAM(7);
    if (IN(8)) phase_gather_v_mfma(P, lds);
#undef IN
#undef SEAM
}

extern "C" void kernel_launch(void* const* d_in, const int* in_sizes, int n_in, void* d_out, int out_size, void* d_ws, size_t ws_size, hipStream_t stream) {
    static int grid = 0;
    if (grid == 0) {
        if (n_in != 18 || in_sizes[0] != NTOK * DM || out_size != NTOK * DM || ws_size < WS_END) {
            fprintf(stderr, "kernel_launch: unexpected shapes (n_in %d in0 %d out %d ws %zu)\n", n_in, n_in > 0 ? in_sizes[0] : -1, out_size, ws_size); grid = -1; return; }
        int dev = 0, cus = 0, per_cu = 0;
        (void)hipGetDevice(&dev); (void)hipDeviceGetAttribute(&cus, hipDeviceAttributeMultiprocessorCount, dev);
        if (hipFuncSetAttribute((const void*)mk_fwd, hipFuncAttributeMaxDynamicSharedMemorySize, LDS_BYTES) != hipSuccess) { fprintf(stderr, "kernel_launch: hipFuncSetAttribute failed\n"); grid = -1; return; }
        if (hipOccupancyMaxActiveBlocksPerMultiprocessor(&per_cu, (const void*)mk_fwd, NTHREADS, LDS_BYTES) != hipSuccess || per_cu < 1) { fprintf(stderr, "kernel_launch: occupancy query failed (%d)\n", per_cu); (void)hipGetLastError(); per_cu = 1; }
        if (per_cu > 1) per_cu = 1;
        grid = cus * per_cu;
        if (grid <= 0) grid = 256;
    }
    if (grid < 0) return;
    Params p{};
    p.x = (const float*)d_in[0]; p.meta = (const float*)d_in[1]; p.g_mix = (const float*)d_in[2]; p.w_in = (const float*)d_in[3]; p.sc_w = (const float*)d_in[4];
    p.cf_w = (const float*)d_in[5]; p.cf_b = (const float*)d_in[6]; p.ln_g = (const float*)d_in[7]; p.ln_b = (const float*)d_in[8]; p.g_sc = (const float*)d_in[9];
    p.g_cf = (const float*)d_in[10]; p.w_out = (const float*)d_in[11]; p.g_ffn = (const float*)d_in[12]; p.w_q = (const float*)d_in[13]; p.keys = (const float*)d_in[14];
    p.pu = (const float*)d_in[15]; p.pv = (const float*)d_in[16]; p.g_fin = (const float*)d_in[17];
    p.out = (float*)d_out; p.ws = (unsigned char*)d_ws;
    (void)hipMemsetAsync((char*)d_ws + WS_CTL, 0, 40960, stream);
#if MK_MULTI
    for (int ph = 0; ph < NPHASE; ++ph) { p.ph_lo = ph; p.ph_hi = ph + 1; p.coop = 0; p.pad = 0;
        hipLaunchKernelGGL(mk_fwd, dim3(grid), dim3(NTHREADS), LDS_BYTES, stream, p); }
#else
    p.ph_lo = 0; p.ph_hi = NPHASE; p.coop = 1; p.pad = 0;
    void* args[] = {&p};
    hipError_t e = hipLaunchCooperativeKernel((const void*)mk_fwd, dim3(grid), dim3(NTHREADS), args, LDS_BYTES, stream);
    if (e != hipSuccess) fprintf(stderr, "cooperative launch failed: %s (grid %d)\n", hipGetErrorString(e), grid);
#endif
}
```

```cpp
#include <hip/hip_runtime.h>
#include <hip/hip_cooperative_groups.h>
#include <cstdio>
#include <cstdint>
namespace cg = cooperative_groups;

namespace pg8 {
#define PG8_LAS __attribute__((address_space(3)))
typedef unsigned short bf16_t;
typedef short bf16x8 __attribute__((ext_vector_type(8)));
typedef float f32x4 __attribute__((ext_vector_type(4)));
typedef unsigned u32x4 __attribute__((ext_vector_type(4)));
typedef int i32x4 __attribute__((ext_vector_type(4)));
constexpr int BM = 256, BK = 64, HALF = 128, HTB = HALF * BK * 2  , STAGE_BYTES = 8 * HTB, NXCD = 8, WGM = 8;

__host__ __device__ __forceinline__ int lds_byte(int r, int c) { const int st = (r >> 4) * 2 + (c >> 5), rr = r & 15, cc = c & 31, ob = rr * 64 + cc * 2; return st * 1024 + (ob ^ (((ob >> 9) & 1) << 5)); }
__host__ __device__ __forceinline__ void stage_rc(int b, int& R, int& C) { const int st = b / 1024, sb = b % 1024, swz = sb ^ (((sb >> 9) & 1) << 5); R = (st >> 1) * 16 + swz / 64; C = (st & 1) * 32 + (swz % 64) / 2; }
__host__ __device__ __forceinline__ int perm32(int rho) { const int n = rho >> 4, i = rho & 15; return 8 * (i >> 2) + 4 * n + (i & 3); }

struct Unit { int pm, pn; };
struct Gemm { const bf16_t* A; const bf16_t* Bt; int M, N, K; };

struct StaticOrder {
    int nM, nN, nwg, G, c;
    __host__ __device__ void init(int M, int N, int G_, int c_) { nM = M / BM; nN = N / BM; nwg = nM * nN; G = G_; c = c_; }
    __host__ __device__ bool next(int i, Unit& u) const {
        const long L = (long)i * G + c; if (L >= nwg) return false;
        int wgid = (int)L; { const int q = nwg / NXCD, r = nwg % NXCD, xcd = wgid % NXCD, off = wgid / NXCD; wgid = (xcd < r ? xcd * (q + 1) : r * (q + 1) + (xcd - r) * q) + off; }
        const int nig = WGM * nN, gid = wgid / nig, fm = gid * WGM, gsz = (nM - fm) < WGM ? (nM - fm) : WGM;
        u.pm = fm + ((wgid % nig) % gsz); u.pn = (wgid % nig) / gsz; return true;
    }
    __device__ __forceinline__ void a_ready(const Unit&) const {}
    __device__ __forceinline__ void done(const Unit&) const {}
};

template <class Epi, class Sched, bool ALIGN_EPI = false, bool SP2 = false>
__device__ __forceinline__ void gemm_phase(PG8_LAS unsigned char* lds, const Gemm g, const Sched& S, const Epi& E) {
    const int tid = threadIdx.x, wid = __builtin_amdgcn_readfirstlane(tid >> 6), lane = tid & 63, wr = wid >> 2, wc = wid & 3, fr = lane & 15, fq = lane >> 4;
    const int K = g.K, nt = K / BK;
    unsigned voffA[2], voffB[2];
#pragma unroll
    for (int i = 0; i < 2; ++i) { int R, C; stage_rc(tid * 16 + i * 8192, R, C); const int Rb = Epi::PERM ? ((R & ~31) + perm32(R & 31)) : R;
        voffA[i] = (unsigned)(R * K + C) * 2u; voffB[i] = (unsigned)(Rb * K + C) * 2u; }
    const size_t kstep = (size_t)(BK * 2);
    const size_t hstep = (size_t)HALF * K * 2;
    const size_t tstep = 2 * hstep;
    const unsigned ldsw = (unsigned)wid * 1024u;
    const int aoff = lds_byte(wr * 64 + fr, fq * 8), boff = lds_byte(wc * 32 + fr, fq * 8);
#define PG8_SA(b, h) (((b) * 2 + (h)) * HTB)
#define PG8_SB(b, h) ((4 + (b) * 2 + (h)) * HTB)
#define PG8_STAGE(bufoff, gbase, voff) do { _Pragma("unroll") for (int _i = 0; _i < 2; ++_i) \
        __builtin_amdgcn_global_load_lds((const unsigned*)((const char*)(gbase) + (voff)[_i]), (PG8_LAS unsigned*)(lds + (bufoff) + ldsw + _i * 8192), 16, 0, 0); } while (0)
#define PG8_LDA(dst, b, h) do { _Pragma("unroll") for (int m = 0; m < 4; ++m) _Pragma("unroll") for (int k = 0; k < 2; ++k) dst[m][k] = *(const PG8_LAS bf16x8*)(lds + PG8_SA(b, h) + aoff + m * 2048 + k * 1024); } while (0)
#define PG8_LDB(dst, b, h) do { _Pragma("unroll") for (int n = 0; n < 2; ++n) _Pragma("unroll") for (int k = 0; k < 2; ++k) dst[n][k] = *(const PG8_LAS bf16x8*)(lds + PG8_SB(b, h) + boff + n * 2048 + k * 1024); } while (0)
#define PG8_MMA(ai, bj, At, Bt) do { __builtin_amdgcn_s_setprio(1); _Pragma("unroll") for (int m = 0; m < 4; ++m) _Pragma("unroll") for (int n = 0; n < 2; ++n) _Pragma("unroll") for (int k = 0; k < 2; ++k) \
        acc[ai][bj][m][n] = __builtin_amdgcn_mfma_f32_16x16x32_bf16(Bt[n][k], At[m][k], acc[ai][bj][m][n], 0, 0, 0); __builtin_amdgcn_s_setprio(0); } while (0)
#define PG8_WAIT_V(n) asm volatile("s_waitcnt vmcnt(" #n ")" ::: "memory")
#define PG8_WAIT_L(n) asm volatile("s_waitcnt lgkmcnt(" #n ")" ::: "memory")
#define PG8_BAR __builtin_amdgcn_s_barrier()
#define PG8_SCHED __builtin_amdgcn_sched_barrier(0)
    Unit cur, nxt; int ui = 0;
    if (!S.next(0, cur)) return;
    f32x4 acc[2][2][4][2];
#pragma unroll
    for (int a = 0; a < 2; ++a)
#pragma unroll
        for (int b = 0; b < 2; ++b)
#pragma unroll
            for (int m = 0; m < 4; ++m)
#pragma unroll
                for (int n = 0; n < 2; ++n) acc[a][b][m][n] = (f32x4){0.f, 0.f, 0.f, 0.f};
    bf16x8 At[4][2], B0[2][2], B1[2][2];
    const char* cA = (const char*)g.A + (size_t)cur.pm * tstep; const char* cB = (const char*)g.Bt + (size_t)cur.pn * tstep;
    S.a_ready(cur);
    if constexpr (SP2) {
        PG8_STAGE(PG8_SB(0, 0), cB, voffB); PG8_STAGE(PG8_SB(0, 1), cB + hstep, voffB); PG8_STAGE(PG8_SA(0, 0), cA, voffA); PG8_STAGE(PG8_SA(0, 1), cA + hstep, voffA);
        if (wr == 1) PG8_BAR;
        PG8_WAIT_V(2); PG8_BAR;
        PG8_STAGE(PG8_SB(1, 0), cB + kstep, voffB); PG8_STAGE(PG8_SA(1, 0), cA + kstep, voffA); PG8_STAGE(PG8_SB(1, 1), cB + hstep + kstep, voffB);
        PG8_WAIT_V(6); PG8_BAR;
    } else {
        PG8_STAGE(PG8_SB(0, 0), cB, voffB); PG8_STAGE(PG8_SA(0, 0), cA, voffA); PG8_STAGE(PG8_SB(0, 1), cB + hstep, voffB); PG8_STAGE(PG8_SA(0, 1), cA + hstep, voffA);
        if (wr == 1) PG8_BAR;
        PG8_WAIT_V(4); PG8_BAR;
        PG8_STAGE(PG8_SB(1, 0), cB + kstep, voffB); PG8_STAGE(PG8_SA(1, 0), cA + kstep, voffA); PG8_STAGE(PG8_SB(1, 1), cB + hstep + kstep, voffB);
        PG8_WAIT_V(6); PG8_BAR;
    }
    for (;;) {
        const bool has_next = S.next(ui + 1, nxt);
        const char* nA = has_next ? (const char*)g.A + (size_t)nxt.pm * tstep : cA; const char* nB = has_next ? (const char*)g.Bt + (size_t)nxt.pn * tstep : cB;
        for (int t = 0; t < nt; t += 2) {
            const bool last = (t == nt - 2);
            const char* a1 = cA + (size_t)(t + 1) * kstep;
            const char* a2 = last ? nA : cA + (size_t)(t + 2) * kstep; const char* b2 = last ? nB : cB + (size_t)(t + 2) * kstep;
            const char* a3 = a2 + kstep; const char* b3 = b2 + kstep;
            if (last && has_next) S.a_ready(nxt);
            if constexpr (SP2) {
            PG8_LDB(B0, 0, 0); PG8_LDB(B1, 0, 1); PG8_SCHED; PG8_LDA(At, 0, 0); PG8_STAGE(PG8_SA(1, 1), a1 + hstep, voffA);
            PG8_WAIT_V(8); PG8_WAIT_L(0); PG8_BAR; PG8_MMA(0, 0, At, B0); PG8_MMA(0, 1, At, B1); PG8_BAR; PG8_SCHED;
            PG8_LDA(At, 0, 1); PG8_STAGE(PG8_SB(0, 0), b2, voffB); PG8_STAGE(PG8_SB(0, 1), b2 + hstep, voffB); PG8_STAGE(PG8_SA(0, 0), a2, voffA);
            PG8_WAIT_V(8); PG8_WAIT_L(0); PG8_BAR; PG8_MMA(1, 0, At, B0); PG8_MMA(1, 1, At, B1); PG8_BAR; PG8_SCHED;
            PG8_LDB(B0, 1, 0); PG8_LDB(B1, 1, 1); PG8_SCHED; PG8_LDA(At, 1, 0); PG8_STAGE(PG8_SA(0, 1), a2 + hstep, voffA);
            PG8_WAIT_V(8); PG8_WAIT_L(0); PG8_BAR; PG8_MMA(0, 0, At, B0); PG8_MMA(0, 1, At, B1); PG8_BAR; PG8_SCHED;
            PG8_LDA(At, 1, 1); PG8_STAGE(PG8_SB(1, 0), b3, voffB); PG8_STAGE(PG8_SB(1, 1), b3 + hstep, voffB); PG8_STAGE(PG8_SA(1, 0), a3, voffA);
            PG8_WAIT_V(8); PG8_WAIT_L(0); PG8_BAR; PG8_MMA(1, 0, At, B0); PG8_MMA(1, 1, At, B1); PG8_BAR; PG8_SCHED;
            } else {
            PG8_LDB(B0, 0, 0); PG8_SCHED; PG8_LDA(At, 0, 0); PG8_STAGE(PG8_SA(1, 1), a1 + hstep, voffA);
            PG8_WAIT_L(8); PG8_BAR; PG8_WAIT_L(0); PG8_MMA(0, 0, At, B0); PG8_BAR; PG8_SCHED;
            PG8_LDB(B1, 0, 1); PG8_STAGE(PG8_SB(0, 0), b2, voffB);
            PG8_BAR; PG8_WAIT_L(0); PG8_MMA(0, 1, At, B1); PG8_BAR;
            PG8_LDA(At, 0, 1); PG8_STAGE(PG8_SA(0, 0), a2, voffA);
            PG8_BAR; PG8_WAIT_L(0); PG8_MMA(1, 0, At, B0); PG8_BAR; PG8_SCHED;
            PG8_STAGE(PG8_SB(0, 1), b2 + hstep, voffB);
            PG8_WAIT_V(6); PG8_BAR; PG8_MMA(1, 1, At, B1); PG8_BAR;
            PG8_LDB(B0, 1, 0); PG8_SCHED; PG8_LDA(At, 1, 0); PG8_STAGE(PG8_SA(0, 1), a2 + hstep, voffA);
            PG8_WAIT_L(8); PG8_BAR; PG8_WAIT_L(0); PG8_MMA(0, 0, At, B0); PG8_BAR; PG8_SCHED;
            PG8_LDB(B1, 1, 1); PG8_STAGE(PG8_SB(1, 0), b3, voffB);
            PG8_BAR; PG8_WAIT_L(0); PG8_MMA(0, 1, At, B1); PG8_BAR;
            PG8_LDA(At, 1, 1); PG8_STAGE(PG8_SA(1, 0), a3, voffA);
            PG8_BAR; PG8_WAIT_L(0); PG8_MMA(1, 0, At, B0); PG8_BAR; PG8_SCHED;
            PG8_STAGE(PG8_SB(1, 1), b3 + hstep, voffB);
            PG8_WAIT_V(6); PG8_BAR; PG8_MMA(1, 1, At, B1); PG8_BAR;
            }
        }
        if constexpr (ALIGN_EPI) { if (wr == 0) PG8_BAR; }
        if constexpr (!Epi::AFTER_DRAIN) { E(acc, cur, wr, wc, fr, fq); S.done(cur); }
        if (!has_next) break;
#pragma unroll
        for (int a = 0; a < 2; ++a)
#pragma unroll
            for (int b = 0; b < 2; ++b)
#pragma unroll
                for (int m = 0; m < 4; ++m)
#pragma unroll
                    for (int n = 0; n < 2; ++n) acc[a][b][m][n] = (f32x4){0.f, 0.f, 0.f, 0.f};
        cur = nxt; cA = nA; cB = nB; ++ui;
        if constexpr (ALIGN_EPI) { if (wr == 1) PG8_BAR; }
    }
    PG8_WAIT_V(0);
    if constexpr (!ALIGN_EPI) { if (wr == 0) PG8_BAR; }
    PG8_BAR;
    if constexpr (Epi::AFTER_DRAIN) { E.fused(acc, cur, wr, wc, fr, fq, lds, wid, lane); S.done(cur); }
#undef PG8_SA
#undef PG8_SB
#undef PG8_STAGE
#undef PG8_LDA
#undef PG8_LDB
#undef PG8_MMA
#undef PG8_WAIT_V
#undef PG8_WAIT_L
#undef PG8_BAR
#undef PG8_SCHED
}
template <class Epi, class Sched, bool ALIGN_EPI = false, bool SP2 = false>
__device__ __forceinline__ void gemm_phase_i8(PG8_LAS unsigned char* lds, const Gemm g, const Sched& S, const Epi& E) {
    const int tid = threadIdx.x, wid = __builtin_amdgcn_readfirstlane(tid >> 6), lane = tid & 63, wr = wid >> 2, wc = wid & 3, fr = lane & 15, fq = lane >> 4;
    const int K = g.K, nt = K / BK;
    unsigned voffA[2], voffB[2];
#pragma unroll
    for (int i = 0; i < 2; ++i) { int R, C; stage_rc(tid * 16 + i * 8192, R, C); const int Rb = Epi::PERM ? ((R & ~31) + perm32(R & 31)) : R;
        voffA[i] = (unsigned)(R * K + C) * 2u; voffB[i] = (unsigned)(Rb * K + C) * 2u; }
    const size_t kstep = (size_t)(BK * 2);
    const size_t hstep = (size_t)HALF * K * 2;
    const size_t tstep = 2 * hstep;
    const unsigned ldsw = (unsigned)wid * 1024u;
    const int aoff = lds_byte(wr * 64 + fr, fq * 8), boff = lds_byte(wc * 32 + fr, fq * 8);
#define PG8_SA(b, h) (((b) * 2 + (h)) * HTB)
#define PG8_SB(b, h) ((4 + (b) * 2 + (h)) * HTB)
#define PG8_STAGE(bufoff, gbase, voff) do { _Pragma("unroll") for (int _i = 0; _i < 2; ++_i) \
        __builtin_amdgcn_global_load_lds((const unsigned*)((const char*)(gbase) + (voff)[_i]), (PG8_LAS unsigned*)(lds + (bufoff) + ldsw + _i * 8192), 16, 0, 0); } while (0)
#define PG8_LDA(dst, b, h) do { _Pragma("unroll") for (int m = 0; m < 4; ++m) _Pragma("unroll") for (int k = 0; k < 2; ++k) dst[m][k] = *(const PG8_LAS bf16x8*)(lds + PG8_SA(b, h) + aoff + m * 2048 + k * 1024); } while (0)
#define PG8_LDB(dst, b, h) do { _Pragma("unroll") for (int n = 0; n < 2; ++n) _Pragma("unroll") for (int k = 0; k < 2; ++k) dst[n][k] = *(const PG8_LAS bf16x8*)(lds + PG8_SB(b, h) + boff + n * 2048 + k * 1024); } while (0)
#define PG8_MMA(ai, bj, At, Bt) do { __builtin_amdgcn_s_setprio(1); _Pragma("unroll") for (int m = 0; m < 4; ++m) _Pragma("unroll") for (int n = 0; n < 2; ++n) _Pragma("unroll") for (int k = 0; k < 2; ++k) \
        acc[ai][bj][m][n] = __builtin_amdgcn_mfma_i32_16x16x64_i8(__builtin_bit_cast(i32x4, Bt[n][k]), __builtin_bit_cast(i32x4, At[m][k]), acc[ai][bj][m][n], 0, 0, 0); __builtin_amdgcn_s_setprio(0); } while (0)
#define PG8_WAIT_V(n) asm volatile("s_waitcnt vmcnt(" #n ")" ::: "memory")
#define PG8_WAIT_L(n) asm volatile("s_waitcnt lgkmcnt(" #n ")" ::: "memory")
#define PG8_BAR __builtin_amdgcn_s_barrier()
#define PG8_SCHED __builtin_amdgcn_sched_barrier(0)
    Unit cur, nxt; int ui = 0;
    if (!S.next(0, cur)) return;
    i32x4 acc[2][2][4][2];
#pragma unroll
    for (int a = 0; a < 2; ++a)
#pragma unroll
        for (int b = 0; b < 2; ++b)
#pragma unroll
            for (int m = 0; m < 4; ++m)
#pragma unroll
                for (int n = 0; n < 2; ++n) acc[a][b][m][n] = (i32x4){0, 0, 0, 0};
    bf16x8 At[4][2], B0[2][2], B1[2][2];
    const char* cA = (const char*)g.A + (size_t)cur.pm * tstep; const char* cB = (const char*)g.Bt + (size_t)cur.pn * tstep;
    S.a_ready(cur);
    if constexpr (SP2) {
        PG8_STAGE(PG8_SB(0, 0), cB, voffB); PG8_STAGE(PG8_SB(0, 1), cB + hstep, voffB); PG8_STAGE(PG8_SA(0, 0), cA, voffA); PG8_STAGE(PG8_SA(0, 1), cA + hstep, voffA);
        if (wr == 1) PG8_BAR;
        PG8_WAIT_V(2); PG8_BAR;
        PG8_STAGE(PG8_SB(1, 0), cB + kstep, voffB); PG8_STAGE(PG8_SA(1, 0), cA + kstep, voffA); PG8_STAGE(PG8_SB(1, 1), cB + hstep + kstep, voffB);
        PG8_WAIT_V(6); PG8_BAR;
    } else {
        PG8_STAGE(PG8_SB(0, 0), cB, voffB); PG8_STAGE(PG8_SA(0, 0), cA, voffA); PG8_STAGE(PG8_SB(0, 1), cB + hstep, voffB); PG8_STAGE(PG8_SA(0, 1), cA + hstep, voffA);
        if (wr == 1) PG8_BAR;
        PG8_WAIT_V(4); PG8_BAR;
        PG8_STAGE(PG8_SB(1, 0), cB + kstep, voffB); PG8_STAGE(PG8_SA(1, 0), cA + kstep, voffA); PG8_STAGE(PG8_SB(1, 1), cB + hstep + kstep, voffB);
        PG8_WAIT_V(6); PG8_BAR;
    }
    for (;;) {
        const bool has_next = S.next(ui + 1, nxt);
        const char* nA = has_next ? (const char*)g.A + (size_t)nxt.pm * tstep : cA; const char* nB = has_next ? (const char*)g.Bt + (size_t)nxt.pn * tstep : cB;
        for (int t = 0; t < nt; t += 2) {
            const bool last = (t == nt - 2);
            const char* a1 = cA + (size_t)(t + 1) * kstep;
            const char* a2 = last ? nA : cA + (size_t)(t + 2) * kstep; const char* b2 = last ? nB : cB + (size_t)(t + 2) * kstep;
            const char* a3 = a2 + kstep; const char* b3 = b2 + kstep;
            if (last && has_next) S.a_ready(nxt);
            if constexpr (SP2) {
            PG8_LDB(B0, 0, 0); PG8_LDB(B1, 0, 1); PG8_SCHED; PG8_LDA(At, 0, 0); PG8_STAGE(PG8_SA(1, 1), a1 + hstep, voffA);
            PG8_WAIT_V(8); PG8_WAIT_L(0); PG8_BAR; PG8_MMA(0, 0, At, B0); PG8_MMA(0, 1, At, B1); PG8_BAR; PG8_SCHED;
            PG8_LDA(At, 0, 1); PG8_STAGE(PG8_SB(0, 0), b2, voffB); PG8_STAGE(PG8_SB(0, 1), b2 + hstep, voffB); PG8_STAGE(PG8_SA(0, 0), a2, voffA);
            PG8_WAIT_V(8); PG8_WAIT_L(0); PG8_BAR; PG8_MMA(1, 0, At, B0); PG8_MMA(1, 1, At, B1); PG8_BAR; PG8_SCHED;
            PG8_LDB(B0, 1, 0); PG8_LDB(B1, 1, 1); PG8_SCHED; PG8_LDA(At, 1, 0); PG8_STAGE(PG8_SA(0, 1), a2 + hstep, voffA);
            PG8_WAIT_V(8); PG8_WAIT_L(0); PG8_BAR; PG8_MMA(0, 0, At, B0); PG8_MMA(0, 1, At, B1); PG8_BAR; PG8_SCHED;
            PG8_LDA(At, 1, 1); PG8_STAGE(PG8_SB(1, 0), b3, voffB); PG8_STAGE(PG8_SB(1, 1), b3 + hstep, voffB); PG8_STAGE(PG8_SA(1, 0), a3, voffA);
            PG8_WAIT_V(8); PG8_WAIT_L(0); PG8_BAR; PG8_MMA(1, 0, At, B0); PG8_MMA(1, 1, At, B1); PG8_BAR; PG8_SCHED;
            } else {
            PG8_LDB(B0, 0, 0); PG8_SCHED; PG8_LDA(At, 0, 0); PG8_STAGE(PG8_SA(1, 1), a1 + hstep, voffA);
            PG8_WAIT_L(8); PG8_BAR; PG8_WAIT_L(0); PG8_MMA(0, 0, At, B0); PG8_BAR; PG8_SCHED;
            PG8_LDB(B1, 0, 1); PG8_STAGE(PG8_SB(0, 0), b2, voffB);
            PG8_BAR; PG8_WAIT_L(0); PG8_MMA(0, 1, At, B1); PG8_BAR;
            PG8_LDA(At, 0, 1); PG8_STAGE(PG8_SA(0, 0), a2, voffA);
            PG8_BAR; PG8_WAIT_L(0); PG8_MMA(1, 0, At, B0); PG8_BAR; PG8_SCHED;
            PG8_STAGE(PG8_SB(0, 1), b2 + hstep, voffB);
            PG8_WAIT_V(6); PG8_BAR; PG8_MMA(1, 1, At, B1); PG8_BAR;
            PG8_LDB(B0, 1, 0); PG8_SCHED; PG8_LDA(At, 1, 0); PG8_STAGE(PG8_SA(0, 1), a2 + hstep, voffA);
            PG8_WAIT_L(8); PG8_BAR; PG8_WAIT_L(0); PG8_MMA(0, 0, At, B0); PG8_BAR; PG8_SCHED;
            PG8_LDB(B1, 1, 1); PG8_STAGE(PG8_SB(1, 0), b3, voffB);
            PG8_BAR; PG8_WAIT_L(0); PG8_MMA(0, 1, At, B1); PG8_BAR;
            PG8_LDA(At, 1, 1); PG8_STAGE(PG8_SA(1, 0), a3, voffA);
            PG8_BAR; PG8_WAIT_L(0); PG8_MMA(1, 0, At, B0); PG8_BAR; PG8_SCHED;
            PG8_STAGE(PG8_SB(1, 1), b3 + hstep, voffB);
            PG8_WAIT_V(6); PG8_BAR; PG8_MMA(1, 1, At, B1); PG8_BAR;
            }
        }
        if constexpr (ALIGN_EPI) { if (wr == 0) PG8_BAR; }
        if constexpr (!Epi::AFTER_DRAIN) { E(acc, cur, wr, wc, fr, fq); S.done(cur); }
        if (!has_next) break;
#pragma unroll
        for (int a = 0; a < 2; ++a)
#pragma unroll
            for (int b = 0; b < 2; ++b)
#pragma unroll
                for (int m = 0; m < 4; ++m)
#pragma unroll
                    for (int n = 0; n < 2; ++n) acc[a][b][m][n] = (i32x4){0, 0, 0, 0};
        cur = nxt; cA = nA; cB = nB; ++ui;
        if constexpr (ALIGN_EPI) { if (wr == 1) PG8_BAR; }
    }
    PG8_WAIT_V(0);
    if constexpr (!ALIGN_EPI) { if (wr == 0) PG8_BAR; }
    PG8_BAR;
    if constexpr (Epi::AFTER_DRAIN) { E.fused(acc, cur, wr, wc, fr, fq, lds, wid, lane); S.done(cur); }
#undef PG8_SA
#undef PG8_SB
#undef PG8_STAGE
#undef PG8_LDA
#undef PG8_LDB
#undef PG8_MMA
#undef PG8_WAIT_V
#undef PG8_WAIT_L
#undef PG8_BAR
#undef PG8_SCHED
}
}

#define LAS __attribute__((address_space(3)))
typedef unsigned short bf16;
typedef float f32x2 __attribute__((ext_vector_type(2)));
typedef float f32x4 __attribute__((ext_vector_type(4)));
typedef unsigned u32x2 __attribute__((ext_vector_type(2)));
typedef unsigned u32x4 __attribute__((ext_vector_type(4)));

constexpr int PDIM = 1536;
constexpr int NTOK = 32768, DM = 1024, DIN = 2560, SEQ = 8192, NBATCH = 4, NMETA = 16;
constexpr int NHEAD = 8, NKEYS = 128, TOPK = 16, NSEL = NHEAD * TOPK;
constexpr float EPS = 1e-6f;
constexpr float U_SCALE = 64.f, V_SCALE = 16.f;
constexpr float U4_CLIP = 2.6f;
constexpr int NWAVES = 8, NTHREADS = 512;
constexpr int MKC = 32;
constexpr int LDS_BYTES = 147456;

constexpr size_t MiB = 1u << 20;
constexpr size_t WS_CTL = 0, WS_WIN_T = 1 * MiB, WS_WOUT_T = 6 * MiB, WS_WQ_T = 8 * MiB, WS_KEYS = 12 * MiB, WS_METAPART = 160 * MiB  ,
                 WS_METARSTD = 14 * MiB + 512 * 1024, WS_METAPROJ = 14 * MiB + 576 * 1024, WS_RSTD1 = 15 * MiB, WS_SSQ = 16 * MiB, WS_U8 = 32 * MiB, WS_V8 = 48 * MiB,
                 WS_IDX = 64 * MiB, WS_GATE = 80 * MiB, WS_H0B = 96 * MiB, WS_H2B = 96 * MiB, WS_Y = 160 * MiB, WS_PROJ = 224 * MiB,
                 WS_Q = 224 * MiB, WS_ESCALE = 18 * MiB, WS_SUMQ = 19 * MiB, WS_SX = 20 * MiB, WS_SW = 21 * MiB, WS_SY = 22 * MiB, WS_SWO = 23 * MiB, WS_WMX = 24 * MiB, WS_AMX = 26 * MiB, WS_RF = 28 * MiB, WS_SWQ = 29 * MiB, WS_H0I8 = 384 * MiB, WS_AW = 160 * MiB  , WS_END = 416 * MiB;

struct Params {
    const float* x; const float* meta; const float* g_mix; const float* w_in; const float* sc_w; const float* cf_w; const float* cf_b;
    const float* ln_g; const float* ln_b; const float* g_sc; const float* g_cf; const float* w_out; const float* g_ffn; const float* w_q;
    const float* keys; const float* pu; const float* pv; const float* g_fin;
    float* out; unsigned char* ws;
    int ph_lo, ph_hi, coop, pad;
};

__device__ __forceinline__ unsigned f2bf(float f) { unsigned u = __builtin_bit_cast(unsigned, f); return (u + 0x7fffu + ((u >> 16) & 1u)) >> 16; }
__device__ __forceinline__ unsigned pk2(float lo, float hi) { return f2bf(lo) | (f2bf(hi) << 16); }
__device__ __forceinline__ float bf2f(unsigned b) { return __builtin_bit_cast(float, b << 16); }
__device__ __forceinline__ float bflo(unsigned w) { return __builtin_bit_cast(float, w << 16); }
__device__ __forceinline__ float bfhi(unsigned w) { return __builtin_bit_cast(float, w & 0xffff0000u); }
__device__ __forceinline__ float wave_sum(float v) {
#pragma unroll
    for (int o = 1; o < 64; o <<= 1) v += __shfl_xor(v, o);
    return v;
}
template <int CTRL> __device__ __forceinline__ float dpp_f(float v) { return __builtin_bit_cast(float, __builtin_amdgcn_update_dpp(0, __builtin_bit_cast(int, v), CTRL, 0xf, 0xf, true)); }
__device__ __forceinline__ float wave_sum_fast(float v) {
    v += dpp_f<0xB1>(v); v += dpp_f<0x4E>(v); v += dpp_f<0x141>(v); v += dpp_f<0x140>(v);
    { auto r = __builtin_amdgcn_permlane16_swap(__float_as_uint(v), __float_as_uint(v), false, false); v = __uint_as_float(r[0]) + __uint_as_float(r[1]); }
    { auto r = __builtin_amdgcn_permlane32_swap(__float_as_uint(v), __float_as_uint(v), false, false); v = __uint_as_float(r[0]) + __uint_as_float(r[1]); }
    return v;
}
__device__ __forceinline__ float wave_max_fast(float v) {
    v = fmaxf(v, dpp_f<0xB1>(v)); v = fmaxf(v, dpp_f<0x4E>(v)); v = fmaxf(v, dpp_f<0x141>(v)); v = fmaxf(v, dpp_f<0x140>(v));
    { auto r = __builtin_amdgcn_permlane16_swap(__float_as_uint(v), __float_as_uint(v), false, false); v = fmaxf(__uint_as_float(r[0]), __uint_as_float(r[1])); }
    { auto r = __builtin_amdgcn_permlane32_swap(__float_as_uint(v), __float_as_uint(v), false, false); v = fmaxf(__uint_as_float(r[0]), __uint_as_float(r[1])); }
    return v;
}
__device__ __forceinline__ float sigmoid_f(float x) { return 1.f / (1.f + __expf(-x)); }
__device__ __forceinline__ float gelu_tanh_f(float x) {
    const float t = 0.7978845608028654f * (x + 0.044715f * x * x * x);
    const float e = __expf(2.f * t);
    const float th = 1.f - 2.f / (e + 1.f);
    return 0.5f * x * (1.f + th);
}

__device__ __forceinline__ unsigned cvt_pk_bf16(float lo, float hi) { unsigned r; asm volatile("v_cvt_pk_bf16_f32 %0, %1, %2" : "=v"(r) : "v"(lo), "v"(hi)); return r; }

template <int MODE> struct EpiRowScale {
    static constexpr bool PERM = true, AFTER_DRAIN = false;
    bf16* O; int ldc; const float* rs;
    __device__ __forceinline__ void operator()(const pg8::f32x4 (&acc)[2][2][4][2], const pg8::Unit& u, int wr, int wc, int fr, int fq) const {
        const int row0 = u.pm * 256 + wr * 64 + fr, col0 = u.pn * 256 + wc * 32 + 8 * fq;
#pragma unroll
        for (int ai = 0; ai < 2; ++ai)
#pragma unroll
            for (int m = 0; m < 4; ++m) {
                const int row = row0 + ai * 128 + m * 16;
                float s;
                if (MODE == 0) s = rs[row];
                else { const f32x4* p = (const f32x4*)(rs + (size_t)row * 16); const f32x4 a = p[0], b = p[1], c = p[2], d = p[3];
                       const float t = ((a.x + a.y) + (a.z + a.w)) + ((b.x + b.y) + (b.z + b.w)) + ((c.x + c.y) + (c.z + c.w)) + ((d.x + d.y) + (d.z + d.w));
                       s = rsqrtf(t * (1.f / 1024.f) + EPS); }
                bf16* rowp = O + (size_t)row * ldc + col0;
#pragma unroll
                for (int bj = 0; bj < 2; ++bj) { const pg8::f32x4 v0 = acc[ai][bj][m][0] * s, v1 = acc[ai][bj][m][1] * s;
                    u32x4 w; w.x = cvt_pk_bf16(v0[0], v0[1]); w.y = cvt_pk_bf16(v0[2], v0[3]); w.z = cvt_pk_bf16(v1[0], v1[1]); w.w = cvt_pk_bf16(v1[2], v1[3]);
                    *(u32x4*)(rowp + bj * 128) = w; }
            }
    }
};
struct EpiProj {
    static constexpr bool PERM = true, AFTER_DRAIN = false;
    bf16* O; const float* rs;
    __device__ __forceinline__ void operator()(const pg8::f32x4 (&acc)[2][2][4][2], const pg8::Unit& u, int wr, int wc, int fr, int fq) const {
        const int row0 = u.pm * 256 + wr * 64 + fr, cin = wc * 32 + 8 * fq, pn = u.pn;
#pragma unroll
        for (int ai = 0; ai < 2; ++ai)
#pragma unroll
            for (int m = 0; m < 4; ++m) {
                const int row = row0 + ai * 128 + m * 16; const float sc = rs[row];
                float a[8], b[8];
#pragma unroll
                for (int i = 0; i < 4; ++i) { a[i] = acc[ai][0][m][0][i] * sc; a[4 + i] = acc[ai][0][m][1][i] * sc; b[i] = acc[ai][1][m][0][i] * sc; b[4 + i] = acc[ai][1][m][1][i] * sc; }
                bf16* rowp = O + (size_t)row * PDIM;
                if (pn >= 4 && pn < 6) {
                    u32x4 w0, w1; w0.x = cvt_pk_bf16(a[0], a[1]); w0.y = cvt_pk_bf16(a[2], a[3]); w0.z = cvt_pk_bf16(a[4], a[5]); w0.w = cvt_pk_bf16(a[6], a[7]);
                    w1.x = cvt_pk_bf16(b[0], b[1]); w1.y = cvt_pk_bf16(b[2], b[3]); w1.z = cvt_pk_bf16(b[4], b[5]); w1.w = cvt_pk_bf16(b[6], b[7]);
                    *(u32x4*)(rowp + 512 + 256 * (pn - 4) + cin) = w0; *(u32x4*)(rowp + 512 + 256 * (pn - 4) + 128 + cin) = w1;
                } else {
                    float o[8];
                    if (pn < 4) {
#pragma unroll
                        for (int i = 0; i < 8; ++i) o[i] = a[i] * b[i];
                    } else {
#pragma unroll
                        for (int i = 0; i < 8; ++i) o[i] = a[i] * sigmoid_f(b[i]);
                    }
                    u32x4 w; w.x = cvt_pk_bf16(o[0], o[1]); w.y = cvt_pk_bf16(o[2], o[3]); w.z = cvt_pk_bf16(o[4], o[5]); w.w = cvt_pk_bf16(o[6], o[7]);
                    *(u32x4*)(rowp + (pn < 4 ? 128 * pn : 1024 + 128 * (pn - 6)) + cin) = w;
                }
            }
    }
};
struct EpiProjI8 {
    static constexpr bool PERM = true, AFTER_DRAIN = false;
    bf16* O; const float* rs; const float* sw;
    __device__ __forceinline__ void operator()(const pg8::i32x4 (&acc)[2][2][4][2], const pg8::Unit& u, int wr, int wc, int fr, int fq) const {
        const int row0 = u.pm * 256 + wr * 64 + fr, cin = wc * 32 + 8 * fq, pn = u.pn;
        float swa[8], swb[8];
        { const f32x4 a0 = *(const f32x4*)(sw + 256 * pn + cin), a1 = *(const f32x4*)(sw + 256 * pn + cin + 4), b0 = *(const f32x4*)(sw + 256 * pn + 128 + cin), b1 = *(const f32x4*)(sw + 256 * pn + 128 + cin + 4);
          swa[0] = a0.x; swa[1] = a0.y; swa[2] = a0.z; swa[3] = a0.w; swa[4] = a1.x; swa[5] = a1.y; swa[6] = a1.z; swa[7] = a1.w;
          swb[0] = b0.x; swb[1] = b0.y; swb[2] = b0.z; swb[3] = b0.w; swb[4] = b1.x; swb[5] = b1.y; swb[6] = b1.z; swb[7] = b1.w; }
#pragma unroll
        for (int ai = 0; ai < 2; ++ai)
#pragma unroll
            for (int m = 0; m < 4; ++m) {
                const int row = row0 + ai * 128 + m * 16; const float sc = rs[row];
                float a[8], b[8];
#pragma unroll
                for (int i = 0; i < 4; ++i) { a[i] = (float)acc[ai][0][m][0][i] * (sc * swa[i]); a[4 + i] = (float)acc[ai][0][m][1][i] * (sc * swa[4 + i]);
                    b[i] = (float)acc[ai][1][m][0][i] * (sc * swb[i]); b[4 + i] = (float)acc[ai][1][m][1][i] * (sc * swb[4 + i]); }
                bf16* rowp = O + (size_t)row * PDIM;
                if (pn >= 4 && pn < 6) {
                    u32x4 w0, w1; w0.x = cvt_pk_bf16(a[0], a[1]); w0.y = cvt_pk_bf16(a[2], a[3]); w0.z = cvt_pk_bf16(a[4], a[5]); w0.w = cvt_pk_bf16(a[6], a[7]);
                    w1.x = cvt_pk_bf16(b[0], b[1]); w1.y = cvt_pk_bf16(b[2], b[3]); w1.z = cvt_pk_bf16(b[4], b[5]); w1.w = cvt_pk_bf16(b[6], b[7]);
                    *(u32x4*)(rowp + 512 + 256 * (pn - 4) + cin) = w0; *(u32x4*)(rowp + 512 + 256 * (pn - 4) + 128 + cin) = w1;
                } else {
                    float o[8];
                    if (pn < 4) {
#pragma unroll
                        for (int i = 0; i < 8; ++i) o[i] = a[i] * b[i];
                    } else {
#pragma unroll
                        for (int i = 0; i < 8; ++i) o[i] = a[i] * sigmoid_f(b[i]);
                    }
                    u32x4 w; w.x = cvt_pk_bf16(o[0], o[1]); w.y = cvt_pk_bf16(o[2], o[3]); w.z = cvt_pk_bf16(o[4], o[5]); w.w = cvt_pk_bf16(o[6], o[7]);
                    *(u32x4*)(rowp + (pn < 4 ? 128 * pn : 1024 + 128 * (pn - 6)) + cin) = w;
                }
            }
    }
};
__host__ __device__ __forceinline__ int win_src_col(int n) {
    const int t = n >> 8, j = n & 255;
    if (t < 4) return (j < 128) ? 128 * t + j : 1024 + 128 * t + (j - 128);
    if (t < 6) return 512 + 256 * (t - 4) + j;
    return (j < 128) ? 1536 + 128 * (t - 6) + j : 2048 + 128 * (t - 6) + (j - 128);
}
struct EpiResidual {
    static constexpr bool PERM = true, AFTER_DRAIN = false;
    bf16* O; const signed char* XB; const float* SX; float* ssq;
    __device__ __forceinline__ void operator()(const pg8::f32x4 (&acc)[2][2][4][2], const pg8::Unit& u, int wr, int wc, int fr, int fq) const {
        const int row0 = u.pm * 256 + wr * 64 + fr, col0 = u.pn * 256 + wc * 32 + 8 * fq;
#pragma unroll
        for (int ai = 0; ai < 2; ++ai)
#pragma unroll
            for (int m = 0; m < 4; ++m) {
                const int row = row0 + ai * 128 + m * 16;
                const signed char* xr = XB + (size_t)row * DM + col0; bf16* rowp = O + (size_t)row * DM + col0;
                float q = 0.f;
                u32x2 xw[2]; const float sxr = SX[row];
#pragma unroll
                for (int bj = 0; bj < 2; ++bj) xw[bj] = *(const u32x2*)(xr + bj * 128);
#pragma unroll
                for (int bj = 0; bj < 2; ++bj) {
                    const f32x4 x0 = (f32x4){(float)(signed char)(xw[bj].x), (float)(signed char)(xw[bj].x >> 8), (float)(signed char)(xw[bj].x >> 16), (float)((int)xw[bj].x >> 24)} * sxr,
                                x1 = (f32x4){(float)(signed char)(xw[bj].y), (float)(signed char)(xw[bj].y >> 8), (float)(signed char)(xw[bj].y >> 16), (float)((int)xw[bj].y >> 24)} * sxr;
                    const pg8::f32x4 v0 = acc[ai][bj][m][0] + x0, v1 = acc[ai][bj][m][1] + x1;
                    q += (v0[0] * v0[0] + v0[1] * v0[1]) + (v0[2] * v0[2] + v0[3] * v0[3]) + (v1[0] * v1[0] + v1[1] * v1[1]) + (v1[2] * v1[2] + v1[3] * v1[3]);
                    u32x4 w; w.x = cvt_pk_bf16(v0[0], v0[1]); w.y = cvt_pk_bf16(v0[2], v0[3]); w.z = cvt_pk_bf16(v1[0], v1[1]); w.w = cvt_pk_bf16(v1[2], v1[3]);
                    *(u32x4*)(rowp + bj * 128) = w; }
                q += __shfl_xor(q, 16); q += __shfl_xor(q, 32);
                if (fq == 0) ssq[(size_t)row * 16 + u.pn * 4 + wc] = q;
            }
    }
};

struct EpiResidualI8 {
    static constexpr bool PERM = true, AFTER_DRAIN = false;
    bf16* O; const signed char* XB; const float* SX; const float* SY; const float* SWO; float* ssq; float* amx;
    __device__ __forceinline__ void operator()(const pg8::i32x4 (&acc)[2][2][4][2], const pg8::Unit& u, int wr, int wc, int fr, int fq) const {
        const int row0 = u.pm * 256 + wr * 64 + fr, col0 = u.pn * 256 + wc * 32 + 8 * fq;
        f32x4 sw[2][2];
#pragma unroll
        for (int bj = 0; bj < 2; ++bj) { sw[bj][0] = *(const f32x4*)(SWO + col0 + bj * 128); sw[bj][1] = *(const f32x4*)(SWO + col0 + bj * 128 + 4); }
#pragma unroll
        for (int ai = 0; ai < 2; ++ai)
#pragma unroll
            for (int m = 0; m < 4; ++m) {
                const int row = row0 + ai * 128 + m * 16;
                const signed char* xr = XB + (size_t)row * DM + col0; bf16* rowp = O + (size_t)row * DM + col0;
                float q = 0.f, mxa = 0.f;
                u32x2 xw[2]; const float sxr = SX[row], syr = SY[row];
#pragma unroll
                for (int bj = 0; bj < 2; ++bj) xw[bj] = *(const u32x2*)(xr + bj * 128);
#pragma unroll
                for (int bj = 0; bj < 2; ++bj) {
                    const f32x4 x0 = (f32x4){(float)(signed char)(xw[bj].x), (float)(signed char)(xw[bj].x >> 8), (float)(signed char)(xw[bj].x >> 16), (float)((int)xw[bj].x >> 24)} * sxr,
                                x1 = (f32x4){(float)(signed char)(xw[bj].y), (float)(signed char)(xw[bj].y >> 8), (float)(signed char)(xw[bj].y >> 16), (float)((int)xw[bj].y >> 24)} * sxr;
                    const pg8::i32x4 a0 = acc[ai][bj][m][0], a1 = acc[ai][bj][m][1];
                    const f32x4 v0 = (f32x4){(float)a0[0], (float)a0[1], (float)a0[2], (float)a0[3]} * (sw[bj][0] * syr) + x0, v1 = (f32x4){(float)a1[0], (float)a1[1], (float)a1[2], (float)a1[3]} * (sw[bj][1] * syr) + x1;
                    q += (v0[0] * v0[0] + v0[1] * v0[1]) + (v0[2] * v0[2] + v0[3] * v0[3]) + (v1[0] * v1[0] + v1[1] * v1[1]) + (v1[2] * v1[2] + v1[3] * v1[3]);
                    mxa = fmaxf(mxa, fmaxf(fmaxf(fmaxf(fabsf(v0[0]), fabsf(v0[1])), fmaxf(fabsf(v0[2]), fabsf(v0[3]))), fmaxf(fmaxf(fabsf(v1[0]), fabsf(v1[1])), fmaxf(fabsf(v1[2]), fabsf(v1[3])))));
                    u32x4 w; w.x = cvt_pk_bf16(v0[0], v0[1]); w.y = cvt_pk_bf16(v0[2], v0[3]); w.z = cvt_pk_bf16(v1[0], v1[1]); w.w = cvt_pk_bf16(v1[2], v1[3]);
                    *(u32x4*)(rowp + bj * 128) = w; }
                q += __shfl_xor(q, 16); q += __shfl_xor(q, 32);
                mxa = fmaxf(mxa, __shfl_xor(mxa, 16)); mxa = fmaxf(mxa, __shfl_xor(mxa, 32));
                if (fq == 0) { ssq[(size_t)row * 16 + u.pn * 4 + wc] = q; amx[(size_t)row * 16 + u.pn * 4 + wc] = mxa; }
            }
    }
};
template <bool MAPIN> __device__ __forceinline__ void p0_transpose_item(const float* W, int K, int N, bf16* WT, LAS float* scr, int item, int lane,
                                                  const float* g_lo, const float* g_hi, int split) {
    const int nblk = N / 32, kb = item / nblk, nb = item % nblk, k0 = 64 * kb, n0 = 32 * nb;
#pragma unroll 8
    for (int i = 0; i < 32; ++i) { const int kk = 2 * i + (lane >> 5); const int k = k0 + kk;
        const float g = (k < split) ? g_lo[k] : g_hi[k - split];
        scr[kk * 33 + (lane & 31)] = W[(size_t)k * N + (MAPIN ? win_src_col(n0) : n0) + (lane & 31)] * g; }
    asm volatile("s_waitcnt lgkmcnt(0)" ::: "memory");
    const int c = lane & 7;
#pragma unroll
    for (int j = 0; j < 4; ++j) { const int n = (lane >> 3) + 8 * j; const LAS float* s = scr + (8 * c) * 33 + n;
        u32x4 o; o.x = pk2(s[0 * 33], s[1 * 33]); o.y = pk2(s[2 * 33], s[3 * 33]); o.z = pk2(s[4 * 33], s[5 * 33]); o.w = pk2(s[6 * 33], s[7 * 33]);
        *(u32x4*)(WT + (size_t)(n0 + n) * K + k0 + 8 * c) = o; }
    asm volatile("s_waitcnt lgkmcnt(0)" ::: "memory");
}

constexpr int CW_COLMAX = 5120;
__device__ __forceinline__ void p0_colmax_item(const float* W, int N, unsigned* colmax, int item, int lane, const float* g) {
    const int nblk = N / 32, kb = item / nblk, nb = item % nblk, k0 = 64 * kb, n0 = 32 * nb;
    float mx = 0.f;
#pragma unroll
    for (int i = 0; i < 32; ++i) { const int k = k0 + 2 * i + (lane >> 5); mx = fmaxf(mx, fabsf(W[(size_t)k * N + n0 + (lane & 31)] * g[k])); }
    mx = fmaxf(mx, __shfl_xor(mx, 32));
    if (lane < 32) atomicMax(colmax + n0 + lane, __float_as_uint(mx));
}
__device__ __forceinline__ void p1_quant_item(const float* W, int K, int N, signed char* WT8, float* swout, const unsigned* colmax, LAS float* scr, int item, int lane, const float* g) {
    const int nblk = N / 32, kb = item / nblk, nb = item % nblk, k0 = 64 * kb, n0 = 32 * nb, s0 = win_src_col(n0);
    const float cm = fmaxf(__uint_as_float(colmax[s0 + (lane & 31)]), 1e-30f), inv = 127.f / cm;
    if (kb == 0 && lane < 32) swout[n0 + lane] = cm * (1.f / 127.f);
#pragma unroll
    for (int i = 0; i < 32; ++i) { const int kk = 2 * i + (lane >> 5); const int k = k0 + kk;
        scr[kk * 33 + (lane & 31)] = W[(size_t)k * N + s0 + (lane & 31)] * g[k] * inv; }
    asm volatile("s_waitcnt lgkmcnt(0)" ::: "memory");
    const int c = lane & 7;
#pragma unroll
    for (int j = 0; j < 4; ++j) { const int n = (lane >> 3) + 8 * j; const LAS float* sp = scr + (8 * c) * 33 + n;
        unsigned w0 = 0u, w1 = 0u;
#pragma unroll
        for (int i = 0; i < 4; ++i) { w0 |= ((unsigned)(int)rintf(sp[i * 33]) & 255u) << (8 * i); w1 |= ((unsigned)(int)rintf(sp[(4 + i) * 33]) & 255u) << (8 * i); }
        u32x2 o; o.x = w0; o.y = w1;
        *(u32x2*)(WT8 + (size_t)(n0 + n) * K + k0 + 8 * c) = o; }
    asm volatile("s_waitcnt lgkmcnt(0)" ::: "memory");
}
constexpr int CW_COLMAX3 = 8704;
constexpr int CW_COLMAX2 = 7680;
__device__ __forceinline__ void p0_colmax_item2(const float* W, int N, unsigned* colmax, int item, int lane, const float* g_lo, const float* g_hi, int split) {
    const int nblk = N / 32, kb = item / nblk, nb = item % nblk, k0 = 64 * kb, n0 = 32 * nb;
    float mx = 0.f;
#pragma unroll
    for (int i = 0; i < 32; ++i) { const int k = k0 + 2 * i + (lane >> 5); const float g = (k < split) ? g_lo[k] : g_hi[k - split]; mx = fmaxf(mx, fabsf(W[(size_t)k * N + n0 + (lane & 31)] * g)); }
    mx = fmaxf(mx, __shfl_xor(mx, 32));
    if (lane < 32) atomicMax(colmax + n0 + lane, __float_as_uint(mx));
}
__device__ __forceinline__ void p1_quant_item2(const float* W, int K, int N, signed char* WT8, float* swout, const unsigned* colmax, LAS float* scr, int item, int lane, const float* g_lo, const float* g_hi, int split) {
    const int nblk = N / 32, kb = item / nblk, nb = item % nblk, k0 = 64 * kb, n0 = 32 * nb;
    const float cm = fmaxf(__uint_as_float(colmax[n0 + (lane & 31)]), 1e-30f), inv = 127.f / cm;
    if (kb == 0 && lane < 32) swout[n0 + lane] = cm * (1.f / 127.f);
#pragma unroll
    for (int i = 0; i < 32; ++i) { const int kk = 2 * i + (lane >> 5); const int k = k0 + kk; const float g = (k < split) ? g_lo[k] : g_hi[k - split];
        scr[kk * 33 + (lane & 31)] = W[(size_t)k * N + n0 + (lane & 31)] * g * inv; }
    asm volatile("s_waitcnt lgkmcnt(0)" ::: "memory");
    const int c = lane & 7;
#pragma unroll
    for (int j = 0; j < 4; ++j) { const int n = (lane >> 3) + 8 * j; const LAS float* sp = scr + (8 * c) * 33 + n;
        unsigned w0 = 0u, w1 = 0u;
#pragma unroll
        for (int i = 0; i < 4; ++i) { w0 |= ((unsigned)(int)rintf(sp[i * 33]) & 255u) << (8 * i); w1 |= ((unsigned)(int)rintf(sp[(4 + i) * 33]) & 255u) << (8 * i); }
        u32x2 o; o.x = w0; o.y = w1;
        *(u32x2*)(WT8 + (size_t)(n0 + n) * K + k0 + 8 * c) = o; }
    asm volatile("s_waitcnt lgkmcnt(0)" ::: "memory");
}
__device__ __forceinline__ void phase_winq(const Params& P, LAS unsigned char* lds) {
    const int tid = threadIdx.x, lane = tid & 63, wave = __builtin_amdgcn_readfirstlane(tid >> 6);
    const int gw = blockIdx.x * NWAVES + wave, NGW = gridDim.x * NWAVES;
    LAS float* scr = (LAS float*)(lds + wave * 16384);
    constexpr int NI1 = (DM / 64) * (DIN / 32), NI2 = (DM / 64) * (DM / 32), NI3 = (DM / 64) * (2048 / 32);
    for (int it = gw; it < NI1 + NI2 + NI3; it += NGW) {
        if (it < NI1) p1_quant_item(P.w_in, DM, DIN, (signed char*)(P.ws + WS_WIN_T), (float*)(P.ws + WS_SW), (const unsigned*)(P.ws + WS_CTL) + CW_COLMAX, scr, it, lane, P.g_mix);
        else if (it < NI1 + NI2) p1_quant_item2(P.w_out, DM, DM, (signed char*)(P.ws + WS_WOUT_T), (float*)(P.ws + WS_SWO), (const unsigned*)(P.ws + WS_CTL) + CW_COLMAX2, scr, it - NI1, lane, P.g_sc, P.g_cf, 512);
        else p1_quant_item2(P.w_q, DM, 2048, (signed char*)(P.ws + WS_WQ_T), (float*)(P.ws + WS_SWQ), (const unsigned*)(P.ws + WS_CTL) + CW_COLMAX3, scr, it - NI1 - NI2, lane, P.g_ffn, P.g_ffn, DM);
    }
}
__device__ __forceinline__ float q4(float x, float inv_s) {
    const float a = fabsf(x) * inv_s; float r;
    if (a < 2.f) r = rintf(a * 2.f) * 0.5f; else if (a < 4.f) r = rintf(a); else r = fminf(6.f, rintf(a * 0.5f) * 2.f);
    return copysignf(r, x);
}
__device__ __forceinline__ void phase_prep(const Params& P, LAS unsigned char* lds) {
    const int tid = threadIdx.x, lane = tid & 63, wave = __builtin_amdgcn_readfirstlane(tid >> 6);
    const int gw = blockIdx.x * NWAVES + wave, NGW = gridDim.x * NWAVES;
    unsigned char* ws = P.ws;
    LAS float* scr = (LAS float*)(lds + wave * 16384);
    constexpr int I_IN = (DM / 64) * (DIN / 32), I_OUT = (DM / 64) * (DM / 32), I_Q = (DM / 64) * (2048 / 32);
    for (int it = gw; it < I_IN + I_OUT + I_Q; it += NGW) {
        int r = it;
        if (r < I_IN) { p0_colmax_item(P.w_in, DIN, (unsigned*)(ws + WS_CTL) + CW_COLMAX, r, lane, P.g_mix); continue; } r -= I_IN;
        if (r < I_OUT) { p0_colmax_item2(P.w_out, DM, (unsigned*)(ws + WS_CTL) + CW_COLMAX2, r, lane, P.g_sc, P.g_cf, 512); continue; } r -= I_OUT;
        p0_colmax_item2(P.w_q, 2048, (unsigned*)(ws + WS_CTL) + CW_COLMAX3, r, lane, P.g_ffn, P.g_ffn, DM);
    }
    {
        unsigned* H0I8 = (unsigned*)(ws + WS_H0I8); float* RS1 = (float*)(ws + WS_RSTD1); float* SXp = (float*)(ws + WS_SX);
        for (int t0 = gw * 4; t0 < NTOK; t0 += NGW * 4) {
            f32x4 v[4][4];
#pragma unroll
            for (int q = 0; q < 4; ++q) { const f32x4* xr = (const f32x4*)(P.x + (size_t)(t0 + q) * DM) + lane;
#pragma unroll
                for (int j = 0; j < 4; ++j) v[q][j] = xr[64 * j]; }
#pragma unroll
            for (int q = 0; q < 4; ++q) { float sq = 0.f, mx = 0.f;
#pragma unroll
                for (int j = 0; j < 4; ++j) { sq += (v[q][j].x * v[q][j].x + v[q][j].y * v[q][j].y) + (v[q][j].z * v[q][j].z + v[q][j].w * v[q][j].w);
                    mx = fmaxf(mx, fmaxf(fmaxf(fabsf(v[q][j].x), fabsf(v[q][j].y)), fmaxf(fabsf(v[q][j].z), fabsf(v[q][j].w)))); }
                sq = wave_sum_fast(sq); mx = fmaxf(wave_max_fast(mx), 1e-30f);
                const float sx = mx * (1.f / 127.f), inv = 127.f / mx;
                if (lane == 0) { RS1[t0 + q] = sx * rsqrtf(sq * (1.f / DM) + EPS); SXp[t0 + q] = sx; }
                unsigned* o = H0I8 + (size_t)(t0 + q) * (DM / 4) + lane;
#pragma unroll
                for (int j = 0; j < 4; ++j) { const int a = (int)rintf(v[q][j].x * inv), b = (int)rintf(v[q][j].y * inv), c = (int)rintf(v[q][j].z * inv), d = (int)rintf(v[q][j].w * inv);
                    o[64 * j] = ((unsigned)a & 255u) | (((unsigned)b & 255u) << 8) | (((unsigned)c & 255u) << 16) | ((unsigned)d << 24); } }
        }
    }
    {
        unsigned char* U8 = ws + WS_U8; unsigned char* V8 = ws + WS_V8;
        f32x4 gf[4];
#pragma unroll
        for (int j = 0; j < 4; ++j) gf[j] = ((const f32x4*)P.g_ffn)[64 * j + lane];
        float* ESC = (float*)(ws + WS_ESCALE);
        for (int e0 = gw * 2; e0 < 2 * 16384; e0 += NGW * 2) {
            const bool isv = e0 >= 16384; const int ee0 = isv ? e0 - 16384 : e0;
            f32x4 v[2][4];
#pragma unroll
            for (int q = 0; q < 2; ++q) { const f32x4* src = (const f32x4*)((isv ? P.pv : P.pu) + (size_t)(ee0 + q) * DM);
#pragma unroll
                for (int j = 0; j < 4; ++j) v[q][j] = isv ? src[4 * lane + j] : src[64 * j + lane]; }
#pragma unroll
            for (int q = 0; q < 2; ++q) {
                float mx = 0.f;
#pragma unroll
                for (int j = 0; j < 4; ++j) { if (!isv) v[q][j] = v[q][j] * gf[j];
                    mx = fmaxf(mx, fmaxf(fmaxf(fabsf(v[q][j].x), fabsf(v[q][j].y)), fmaxf(fabsf(v[q][j].z), fabsf(v[q][j].w)))); }
#pragma unroll
                for (int o = 1; o < 64; o <<= 1) mx = fmaxf(mx, __shfl_xor(mx, o));
                if (!isv) {
                    float sq2 = 0.f;
#pragma unroll
                    for (int j = 0; j < 4; ++j) sq2 += (v[q][j].x * v[q][j].x + v[q][j].y * v[q][j].y) + (v[q][j].z * v[q][j].z + v[q][j].w * v[q][j].w);
                    const float rms = sqrtf(wave_sum_fast(sq2) * (1.f / DM));
                    const float su = fmaxf(fminf(mx, U4_CLIP * rms), 1e-30f) * (1.f / 7.f), inv = 1.f / su;
                    unsigned wq[2] = {0u, 0u}; int csum = 0;
#pragma unroll
                    for (int j = 0; j < 4; ++j) { const float e4[4] = {v[q][j].x, v[q][j].y, v[q][j].z, v[q][j].w};
#pragma unroll
                        for (int i = 0; i < 4; ++i) { int c = (int)rintf(fminf(fmaxf(e4[i] * inv, -7.f), 7.f)); csum += c;
                            wq[j >> 1] |= ((unsigned)c & 15u) << (16 * (j & 1) + 4 * i); } }
                    const float cs = wave_sum_fast((float)csum);
                    if (lane == 0) { ESC[e0 + q] = su; ((float*)(ws + WS_SUMQ))[e0 + q] = cs; }
                    u32x2 o; o.x = wq[0]; o.y = wq[1];
                    *(u32x2*)(U8 + (size_t)(ee0 + q) * 512 + 8 * lane) = o;
                    continue;
                }
                const float sc = fmaxf(mx, 1e-30f) * (1.f / 6.f), inv = 1.f / sc;
                if (lane == 0) ESC[e0 + q] = sc;
                unsigned w0 = 0u, w1 = 0u;
                w0 = __builtin_amdgcn_cvt_scalef32_pk_fp4_f32(w0, v[q][0].x * inv, v[q][0].y * inv, 1.0f, 0); w0 = __builtin_amdgcn_cvt_scalef32_pk_fp4_f32(w0, v[q][0].z * inv, v[q][0].w * inv, 1.0f, 1);
                w0 = __builtin_amdgcn_cvt_scalef32_pk_fp4_f32(w0, v[q][1].x * inv, v[q][1].y * inv, 1.0f, 2); w0 = __builtin_amdgcn_cvt_scalef32_pk_fp4_f32(w0, v[q][1].z * inv, v[q][1].w * inv, 1.0f, 3);
                w1 = __builtin_amdgcn_cvt_scalef32_pk_fp4_f32(w1, v[q][2].x * inv, v[q][2].y * inv, 1.0f, 0); w1 = __builtin_amdgcn_cvt_scalef32_pk_fp4_f32(w1, v[q][2].z * inv, v[q][2].w * inv, 1.0f, 1);
                w1 = __builtin_amdgcn_cvt_scalef32_pk_fp4_f32(w1, v[q][3].x * inv, v[q][3].y * inv, 1.0f, 2); w1 = __builtin_amdgcn_cvt_scalef32_pk_fp4_f32(w1, v[q][3].z * inv, v[q][3].w * inv, 1.0f, 3);
                u32x2 o; o.x = w0; o.y = w1;
                *(u32x2*)((isv ? V8 : U8) + (size_t)(ee0 + q) * 512 + 8 * lane) = o;
            }
        }
    }
    {
        bf16* KB = (bf16*)(ws + WS_KEYS);
        const int gt = blockIdx.x * NTHREADS + tid, NGT = gridDim.x * NTHREADS;
        for (int i = gt; i < 8 * 2 * 128 * 128 / 4; i += NGT) { const f32x4 v = ((const f32x4*)P.keys)[i]; u32x2 w; w.x = pk2(v.x, v.y); w.y = pk2(v.z, v.w); ((u32x2*)KB)[i] = w; }
    }
    {
        float* MP = (float*)(ws + WS_METAPART); float* MR = (float*)(ws + WS_METARSTD);
        for (int r = gw; r < NMETA; r += NGW) {
            float s = 0.f;
            for (int k = lane; k < DM; k += 64) { const float v = P.meta[r * DM + k]; s += v * v; }
            s = wave_sum(s);
            if (lane == 0) MR[r] = rsqrtf(s * (1.f / DM) + EPS);
        }
        for (int it = gw; it < MKC * 40; it += NGW) {
            const int kc = it / 40, nb = it % 40, n = nb * 64 + lane;
            float acc[NMETA];
#pragma unroll
            for (int r = 0; r < NMETA; ++r) acc[r] = 0.f;
            for (int k = kc * (DM / MKC); k < (kc + 1) * (DM / MKC); ++k) {
                const float w = P.w_in[(size_t)k * DIN + n] * P.g_mix[k];
#pragma unroll
                for (int r = 0; r < NMETA; ++r) acc[r] += P.meta[r * DM + k] * w;
            }
#pragma unroll
            for (int r = 0; r < NMETA; ++r) MP[(size_t)(kc * 16 + r) * DIN + n] = acc[r];
        }
    }
}

__device__ __forceinline__ float metaraw(const float* MP, const float* MR, int p, int col) { float s = 0.f;
#pragma unroll 8
    for (int kc = 0; kc < MKC; ++kc) s += MP[(size_t)(kc * 16 + p) * DIN + col];
    return s * MR[p]; }
__device__ __forceinline__ void phase_metaproj(const Params& P) {
    const float* MP = (const float*)(P.ws + WS_METAPART); const float* MR = (const float*)(P.ws + WS_METARSTD); float* MJ = (float*)(P.ws + WS_METAPROJ);
    for (int gt = blockIdx.x * NTHREADS + threadIdx.x; gt < NMETA * PDIM; gt += gridDim.x * NTHREADS) { const int p = gt / PDIM, c = gt % PDIM; float v;
        if (c < 512) v = metaraw(MP, MR, p, c) * metaraw(MP, MR, p, 1024 + c);
        else if (c < 1024) v = metaraw(MP, MR, p, c);
        else v = metaraw(MP, MR, p, 1536 + (c - 1024)) * sigmoid_f(metaraw(MP, MR, p, 2048 + (c - 1024)));
        MJ[gt] = v; }
}
__device__ __forceinline__ float meta_val(const float* MJ, const float*, int p, int col) { return MJ[p * PDIM + col]; }
__device__ __forceinline__ float proj_at(const bf16* PROJ, const float* MP, const float* MR, int b, int pos, int col) {
    if (pos < 0) return 0.f;
    if (pos < NMETA) return meta_val(MP, MR, pos, col);
    return bf2f(PROJ[(size_t)(b * SEQ + pos - NMETA) * PDIM + col]);
}
__device__ __forceinline__ void proj8_at(const bf16* PROJ, const float* MP, const float* MR, int b, int pos, int col, float (&v)[8]) {
    if (pos < 0) {
#pragma unroll
        for (int i = 0; i < 8; ++i) v[i] = 0.f;
    } else if (pos < NMETA) {
        const f32x4 a = *(const f32x4*)(MP + pos * PDIM + col), bq = *(const f32x4*)(MP + pos * PDIM + col + 4);
        v[0] = a.x; v[1] = a.y; v[2] = a.z; v[3] = a.w; v[4] = bq.x; v[5] = bq.y; v[6] = bq.z; v[7] = bq.w;
    } else {
        const u32x4 w = *(const u32x4*)(PROJ + (size_t)(b * SEQ + pos - NMETA) * PDIM + col);
        v[0] = bflo(w.x); v[1] = bfhi(w.x); v[2] = bflo(w.y); v[3] = bfhi(w.y); v[4] = bflo(w.z); v[5] = bfhi(w.z); v[6] = bflo(w.w); v[7] = bfhi(w.w);
    }
}

template <int R> __device__ __forceinline__ void conv_rows(const LAS unsigned char* ubase, const f32x2 (&wcf)[31], f32x2 (&acc)[32]) {
    if constexpr (R < 62) {
        const unsigned uw = *(const LAS unsigned*)(ubase + R * 1024);
        const f32x2 x = (f32x2){bflo(uw), bfhi(uw)};
        constexpr int lo = R > 30 ? R - 30 : 0, hi = R < 31 ? R : 31;
#pragma unroll
        for (int ii = lo; ii <= hi; ++ii) acc[ii] += wcf[R - ii] * x;
        conv_rows<R + 1>(ubase, wcf, acc);
    }
}
__device__ __forceinline__ void phase_conv(const Params& P, LAS unsigned char* lds) {
    const int tid = threadIdx.x, lane = tid & 63, wave = __builtin_amdgcn_readfirstlane(tid >> 6);
    unsigned char* ws = P.ws;
    const bf16* PROJ = (const bf16*)(ws + WS_PROJ); const float* MP = (const float*)(ws + WS_METAPROJ); const float* MR = nullptr;
    bf16* Y = (bf16*)(ws + WS_Y);
    constexpr int TT = 64, NTILE = NTOK / TT, UROWS = TT + 30;
    const int cgp = wave & 3, th = wave >> 2, ch2 = cgp * 128 + 2 * lane;
    f32x2 wcf[31];
#pragma unroll
    for (int j = 0; j < 31; ++j) wcf[j] = *(const f32x2*)(P.cf_w + j * 512 + ch2);
    const f32x2 bcf = *(const f32x2*)(P.cf_b + ch2);
    for (int tile = blockIdx.x; tile < NTILE; tile += gridDim.x) {
        const int b = tile / (SEQ / TT), s0 = (tile % (SEQ / TT)) * TT;
#pragma unroll 4
        for (int p = 0; p < (UROWS + 7) / 8; ++p) {
            const int r = p * 8 + wave;
            if (r < UROWS) {
                const int pos = NMETA + s0 - 30 + r;
                float uu[8];
                proj8_at(PROJ, MP, MR, b, pos, 1024 + 8 * lane, uu);
                u32x4 w; w.x = pk2(uu[0], uu[1]); w.y = pk2(uu[2], uu[3]); w.z = pk2(uu[4], uu[5]); w.w = pk2(uu[6], uu[7]);
                *(LAS u32x4*)(lds + r * 1024 + lane * 16) = w;
            }
        }
        __syncthreads();
        f32x2 acc[32];
#pragma unroll
        for (int ii = 0; ii < 32; ++ii) acc[ii] = bcf;
        conv_rows<0>(lds + (32 * th) * 1024 + ch2 * 2, wcf, acc);
        __syncthreads();
#pragma unroll
        for (int ii = 0; ii < 32; ++ii) *(LAS f32x2*)(lds + (32 * th + ii) * 2048 + ch2 * 4) = acc[ii];
        __syncthreads();
        {
            float lng[8], lnb[8];
            { const f32x4 a = *(const f32x4*)(P.ln_g + 8 * lane), c = *(const f32x4*)(P.ln_g + 8 * lane + 4), d = *(const f32x4*)(P.ln_b + 8 * lane), e = *(const f32x4*)(P.ln_b + 8 * lane + 4);
              lng[0] = a.x; lng[1] = a.y; lng[2] = a.z; lng[3] = a.w; lng[4] = c.x; lng[5] = c.y; lng[6] = c.z; lng[7] = c.w;
              lnb[0] = d.x; lnb[1] = d.y; lnb[2] = d.z; lnb[3] = d.w; lnb[4] = e.x; lnb[5] = e.y; lnb[6] = e.z; lnb[7] = e.w; }
            float wsc[3][8];
#pragma unroll
            for (int j = 0; j < 3; ++j) { const f32x4 a = *(const f32x4*)(P.sc_w + j * 512 + 8 * lane), c = *(const f32x4*)(P.sc_w + j * 512 + 8 * lane + 4);
                wsc[j][0] = a.x; wsc[j][1] = a.y; wsc[j][2] = a.z; wsc[j][3] = a.w; wsc[j][4] = c.x; wsc[j][5] = c.y; wsc[j][6] = c.z; wsc[j][7] = c.w; }
            float cxa[8], cxb[8];
            { const int pos = NMETA + s0 + 8 * wave - 2;
              proj8_at(PROJ, MP, MR, b, pos, 8 * lane, cxa); proj8_at(PROJ, MP, MR, b, pos + 1, 8 * lane, cxb); }
#pragma unroll 2
            for (int q = 0; q < 8; ++q) {
                const int ii = 8 * wave + q, s = s0 + ii; const size_t t = (size_t)b * SEQ + s;
                float o[8];
                { const f32x4 a = *(const LAS f32x4*)(lds + ii * 2048 + lane * 32), c = *(const LAS f32x4*)(lds + ii * 2048 + lane * 32 + 16);
                  o[0] = a.x; o[1] = a.y; o[2] = a.z; o[3] = a.w; o[4] = c.x; o[5] = c.y; o[6] = c.z; o[7] = c.w; }
                float s1 = 0.f;
#pragma unroll
                for (int i = 0; i < 8; ++i) s1 += o[i];
                const float mean = wave_sum_fast(s1) * (1.f / 512.f);
                float s2 = 0.f;
#pragma unroll
                for (int i = 0; i < 8; ++i) { o[i] -= mean; s2 += o[i] * o[i]; }
                const float rs = rsqrtf(wave_sum_fast(s2) * (1.f / 512.f) + EPS);
                float s3 = 0.f;
#pragma unroll
                for (int i = 0; i < 8; ++i) { float y = o[i] * rs * lng[i] + lnb[i]; y = y * sigmoid_f(y); o[i] = y; s3 += y * y; }
                const float r2 = rsqrtf(wave_sum_fast(s3) * (1.f / 512.f) + EPS);
                float bgv[8], cxc[8], accs[8];
                proj8_at(PROJ, MP, MR, b, NMETA + s, 8 * lane, cxc); proj8_at(PROJ, MP, MR, b, NMETA + s, 512 + 8 * lane, bgv);
                float s4 = 0.f;
#pragma unroll
                for (int i = 0; i < 8; ++i) { accs[i] = bgv[i] * (wsc[0][i] * cxa[i] + wsc[1][i] * cxb[i] + wsc[2][i] * cxc[i]); s4 += accs[i] * accs[i]; cxa[i] = cxb[i]; cxb[i] = cxc[i]; }
                const float r4 = rsqrtf(wave_sum_fast(s4) * (1.f / 512.f) + EPS);
                float ym = 0.f;
#pragma unroll
                for (int i = 0; i < 8; ++i) { o[i] *= r2; accs[i] *= r4; ym = fmaxf(ym, fmaxf(fabsf(o[i]), fabsf(accs[i]))); }
                ym = fmaxf(wave_max_fast(ym), 1e-30f);
                const float yinv = 127.f / ym;
                if (lane == 0) ((float*)(ws + WS_SY))[t] = ym * (1.f / 127.f);
                u32x2 wz, wv;
                wz.x = ((unsigned)(int)rintf(accs[0] * yinv) & 255u) | (((unsigned)(int)rintf(accs[1] * yinv) & 255u) << 8) | (((unsigned)(int)rintf(accs[2] * yinv) & 255u) << 16) | ((unsigned)(int)rintf(accs[3] * yinv) << 24);
                wz.y = ((unsigned)(int)rintf(accs[4] * yinv) & 255u) | (((unsigned)(int)rintf(accs[5] * yinv) & 255u) << 8) | (((unsigned)(int)rintf(accs[6] * yinv) & 255u) << 16) | ((unsigned)(int)rintf(accs[7] * yinv) << 24);
                wv.x = ((unsigned)(int)rintf(o[0] * yinv) & 255u) | (((unsigned)(int)rintf(o[1] * yinv) & 255u) << 8) | (((unsigned)(int)rintf(o[2] * yinv) & 255u) << 16) | ((unsigned)(int)rintf(o[3] * yinv) << 24);
                wv.y = ((unsigned)(int)rintf(o[4] * yinv) & 255u) | (((unsigned)(int)rintf(o[5] * yinv) & 255u) << 8) | (((unsigned)(int)rintf(o[6] * yinv) & 255u) << 16) | ((unsigned)(int)rintf(o[7] * yinv) << 24);
                *(u32x2*)(ws + WS_Y + t * DM + 8 * lane) = wz;
                *(u32x2*)(ws + WS_Y + t * DM + 512 + 8 * lane) = wv;
            }
        }
        __syncthreads();
    }
}

__device__ __forceinline__ int ord_i(float s) { int k = __builtin_bit_cast(int, s); k ^= (k >> 31) & 0x7fffffff; return k; }
__device__ __forceinline__ float unord_f(int k) { k ^= (k >> 31) & 0x7fffffff; return __builtin_bit_cast(float, k); }
#define TOP_INSERT(L, x_) do { int _x = (x_); _Pragma("unroll") for (int _i = 0; _i < 16; ++_i) { const int _hi = max(L[_i], _x); _x = min(L[_i], _x); L[_i] = _hi; } } while (0)

typedef short bf16x8 __attribute__((ext_vector_type(8)));
typedef float f32x16 __attribute__((ext_vector_type(16)));
template <bool DESC> __device__ __forceinline__ void ce_i(int& a, int& b) { const int hi = max(a, b), lo = min(a, b); if (DESC) { a = hi; b = lo; } else { a = lo; b = hi; } }
__device__ __forceinline__ void bitonic_sort16(int (&a)[16]) {
#pragma unroll
    for (int k = 2; k <= 16; k <<= 1)
#pragma unroll
        for (int j = k >> 1; j > 0; j >>= 1)
#pragma unroll
            for (int i = 0; i < 16; ++i) { const int l = i ^ j; if (l > i) { if ((i & k) == 0) ce_i<true>(a[i], a[l]); else ce_i<false>(a[i], a[l]); } }
}
__device__ __forceinline__ void bitonic_merge16(int (&a)[16]) {
#pragma unroll
    for (int j = 8; j > 0; j >>= 1)
#pragma unroll
        for (int i = 0; i < 16; ++i) { const int l = i ^ j; if (l > i) ce_i<true>(a[i], a[l]); }
}
__device__ __forceinline__ void merge_top16(int (&a)[16], const int (&b)[16]) {
#pragma unroll
    for (int i = 0; i < 16; ++i) a[i] = max(a[i], b[15 - i]);
    bitonic_merge16(a);
}
__device__ __forceinline__ int lut16(const unsigned (&T)[4], int i) {
    const unsigned sel = (unsigned)(i & 7) | 0x0c0c0c00u;
    const unsigned lo = __builtin_amdgcn_perm(T[1], T[0], sel), hi = __builtin_amdgcn_perm(T[3], T[2], sel);
    return (int)((i & 8) ? hi : lo);
}
constexpr int KROW = 272;
constexpr float SCORE_BIAS = 8.0f;

__device__ __forceinline__ void route_load_q(bf16x8 (&qf)[8], const bf16* qrow, int hb) {
#pragma unroll
    for (int ks = 0; ks < 8; ++ks) qf[ks] = *(const bf16x8*)(qrow + 64 * hb + 8 * ks);
}
__device__ __forceinline__ void route_half(const LAS unsigned char* kl, const bf16x8 (&qf)[8], int nl, int hb, int (&L)[16]) {
    f32x16 acc[4];
#pragma unroll
    for (int nt = 0; nt < 4; ++nt)
#pragma unroll
        for (int r = 0; r < 16; ++r) acc[nt][r] = SCORE_BIAS;
#pragma unroll
    for (int ks = 0; ks < 8; ++ks)
#pragma unroll
        for (int nt = 0; nt < 4; ++nt) {
            const bf16x8 a = *(const LAS bf16x8*)(kl + (32 * nt + nl) * KROW + (64 * hb + 8 * ks) * 2);
            acc[nt] = __builtin_amdgcn_mfma_f32_32x32x16_bf16(a, qf[ks], acc[nt], 0, 0, 0);
        }
    const int hb4 = 4 * hb;
    int T[4][16];
#pragma unroll
    for (int nt = 0; nt < 4; ++nt)
#pragma unroll
        for (int r = 0; r < 16; ++r) { const int n0 = 32 * nt + (r & 3) + 8 * (r >> 2); const float sc = acc[nt][r];
            T[nt][r] = (__float_as_int(sc) & ~127) | ((127 - n0) - hb4); }
    bitonic_sort16(T[0]); bitonic_sort16(T[1]); bitonic_sort16(T[2]); bitonic_sort16(T[3]);
    merge_top16(T[0], T[1]); merge_top16(T[2], T[3]); merge_top16(T[0], T[2]);
#pragma unroll
    for (int i = 0; i < 16; ++i) { const unsigned v = (unsigned)T[0][15 - i]; auto r = __builtin_amdgcn_permlane32_swap(v, v, false, false);
        const unsigned r0 = r[0], r1 = r[1]; const int partner = (int)(hb ? r0 : r1); L[i] = max(T[0][i], partner); }
    bitonic_merge16(L);
}

__device__ __forceinline__ void phase_route(const Params& P, LAS unsigned char* lds) {
    const int tid = threadIdx.x, lane = tid & 63, wave = __builtin_amdgcn_readfirstlane(tid >> 6);
    const int nl = lane & 31, hb = lane >> 5;
    unsigned char* ws = P.ws;
    const bf16* KEYS = (const bf16*)(ws + WS_KEYS); const bf16* Q = (const bf16*)(ws + WS_Q);
    int* IDX = (int*)(ws + WS_IDX); float* GATE = (float*)(ws + WS_GATE);
    int last_h = -1;
    pg8::StaticOrder S; S.init(NTOK, 2048, (int)gridDim.x, (int)blockIdx.x);
    pg8::Unit ucur, unxt;
    bool have = S.next(0, ucur);
    bf16x8 qfA[8], qfB[8];
    if (have) route_load_q(qfA, Q + ((size_t)ucur.pm * 256 + wave * 32 + nl) * 2048 + ucur.pn * 256, hb);
    for (int ui = 0; have; ++ui) {
        const int h = ucur.pn, tb = ucur.pm;
        const bool have_next = S.next(ui + 1, unxt);
        if (h != last_h) {
            __syncthreads();
            for (int c = tid; c < 4096; c += NTHREADS) { const u32x4 v = ((const u32x4*)(KEYS + (size_t)h * 32768))[c];
                *(LAS u32x4*)(lds + (c >> 4) * KROW + (c & 15) * 16) = v; }
            __syncthreads();
            last_h = h;
        }
        const size_t t = (size_t)tb * 256 + wave * 32 + nl;
        int L1[16], L2[16];
        route_load_q(qfB, Q + t * 2048 + h * 256 + 128, hb);
        route_half(lds, qfA, nl, hb, L1);
        if (have_next) route_load_q(qfA, Q + ((size_t)unxt.pm * 256 + wave * 32 + nl) * 2048 + unxt.pn * 256, hb);
        route_half(lds + 128 * KROW, qfB, nl, hb, L2);
        float v1[16], v2[16];
#pragma unroll
        for (int i = 0; i < 16; ++i) { v1[i] = __int_as_float(L1[i] & ~127); v2[i] = __int_as_float(L2[i] & ~127); }
#define CAND(i, j) ((__float_as_int(v1[i] + v2[j]) & ~255) | (255 - (16 * (i) + (j))))
        int A[16], B[16], C[16];
#pragma unroll
        for (int j = 0; j < 16; ++j) A[j] = CAND(0, j);
#pragma unroll
        for (int j = 0; j < 8; ++j) { B[j] = CAND(1, j); B[8 + j] = CAND(15 - j, 0); }
        bitonic_merge16(B);
        C[0] = CAND(2, 0); C[1] = CAND(2, 1); C[2] = CAND(2, 2); C[3] = CAND(2, 3); C[4] = CAND(2, 4);
        C[5] = CAND(3, 0); C[6] = CAND(3, 1); C[7] = CAND(3, 2); C[8] = CAND(3, 3);
        C[9] = CAND(4, 0); C[10] = CAND(4, 1); C[11] = CAND(4, 2);
        C[12] = CAND(5, 0); C[13] = CAND(5, 1); C[14] = CAND(6, 0); C[15] = CAND(6, 1);
        bitonic_sort16(C);
        { const int d0 = CAND(7, 0), d1 = CAND(7, 1); C[14] = max(C[14], d1); C[15] = max(C[15], d0); bitonic_merge16(C); }
#undef CAND
        merge_top16(A, B); merge_top16(A, C);
        unsigned T1[4], T2[4];
#pragma unroll
        for (int q = 0; q < 4; ++q) {
            T1[q] = (unsigned)(127 - (L1[4 * q] & 127)) | ((unsigned)(127 - (L1[4 * q + 1] & 127)) << 8) | ((unsigned)(127 - (L1[4 * q + 2] & 127)) << 16) | ((unsigned)(127 - (L1[4 * q + 3] & 127)) << 24);
            T2[q] = (unsigned)(127 - (L2[4 * q] & 127)) | ((unsigned)(127 - (L2[4 * q + 1] & 127)) << 8) | ((unsigned)(127 - (L2[4 * q + 2] & 127)) << 16) | ((unsigned)(127 - (L2[4 * q + 3] & 127)) << 24); }
        float val[16]; int ex[16];
#pragma unroll
        for (int k = 0; k < 16; ++k) { const int pos = 255 - (A[k] & 255); val[k] = __int_as_float(A[k] & ~255);
            ex[k] = lut16(T1, pos >> 4) * NKEYS + lut16(T2, pos & 15); }
        float sum = 0.f; const float vmax = val[0];
#pragma unroll
        for (int k = 0; k < 16; ++k) { val[k] = __expf(val[k] - vmax); sum += val[k]; }
        const float inv = 1.f / sum;
        if (hb == 0) {
            int* ip = IDX + t * NSEL + h * TOPK; float* gp = GATE + t * NSEL + h * TOPK;
#pragma unroll
            for (int k4 = 0; k4 < 4; ++k4) {
                *(int4*)(ip + 4 * k4) = make_int4(ex[4 * k4], ex[4 * k4 + 1], ex[4 * k4 + 2], ex[4 * k4 + 3]);
                *(f32x4*)(gp + 4 * k4) = (f32x4){val[4 * k4] * inv, val[4 * k4 + 1] * inv, val[4 * k4 + 2] * inv, val[4 * k4 + 3] * inv};
            }
        }
        ucur = unxt; have = have_next;
    }
}

#define FP4X2(w, sel) __builtin_amdgcn_cvt_scalef32_pk_f32_fp4((w), 1.0f, (sel))
__device__ __forceinline__ float dot16_fp4(const u32x2 r, const f32x4 (&xs)[4]) {
    float p = 0.f;
    { const f32x2 a = FP4X2(r.x, 0), b = FP4X2(r.x, 1), c = FP4X2(r.x, 2), d = FP4X2(r.x, 3);
      p += (a.x * xs[0].x + a.y * xs[0].y) + (b.x * xs[0].z + b.y * xs[0].w); p += (c.x * xs[1].x + c.y * xs[1].y) + (d.x * xs[1].z + d.y * xs[1].w); }
    { const f32x2 a = FP4X2(r.y, 0), b = FP4X2(r.y, 1), c = FP4X2(r.y, 2), d = FP4X2(r.y, 3);
      p += (a.x * xs[2].x + a.y * xs[2].y) + (b.x * xs[2].z + b.y * xs[2].w); p += (c.x * xs[3].x + c.y * xs[3].y) + (d.x * xs[3].z + d.y * xs[3].w); }
    return p;
}
__device__ __forceinline__ void axpy16_fp4(const u32x2 r, float w, f32x4 (&o)[4]) {
    { const f32x2 a = FP4X2(r.x, 0), b = FP4X2(r.x, 1), c = FP4X2(r.x, 2), d = FP4X2(r.x, 3);
      o[0].x += w * a.x; o[0].y += w * a.y; o[0].z += w * b.x; o[0].w += w * b.y; o[1].x += w * c.x; o[1].y += w * c.y; o[1].z += w * d.x; o[1].w += w * d.y; }
    { const f32x2 a = FP4X2(r.y, 0), b = FP4X2(r.y, 1), c = FP4X2(r.y, 2), d = FP4X2(r.y, 3);
      o[2].x += w * a.x; o[2].y += w * a.y; o[2].z += w * b.x; o[2].w += w * b.y; o[3].x += w * c.x; o[3].y += w * c.y; o[3].z += w * d.x; o[3].w += w * d.y; }
}
__device__ __forceinline__ float swap32_add(float a, float b) { auto r = __builtin_amdgcn_permlane32_swap(__float_as_uint(a), __float_as_uint(b), false, false); return __uint_as_float(r[0]) + __uint_as_float(r[1]); }
__device__ __forceinline__ float swap16_add(float a, float b) { auto r = __builtin_amdgcn_permlane16_swap(__float_as_uint(a), __float_as_uint(b), false, false); return __uint_as_float(r[0]) + __uint_as_float(r[1]); }
__device__ __forceinline__ float row_sum16(float v) { v += dpp_f<0xB1>(v); v += dpp_f<0x4E>(v); v += dpp_f<0x141>(v); v += dpp_f<0x140>(v); return v; }
__device__ __forceinline__ float row_max16(float v) { v = fmaxf(v, dpp_f<0xB1>(v)); v = fmaxf(v, dpp_f<0x4E>(v)); v = fmaxf(v, dpp_f<0x141>(v)); v = fmaxf(v, dpp_f<0x140>(v)); return v; }
constexpr int GB = 32;
typedef __attribute__((address_space(8))) void* rsrc_t;
__device__ __forceinline__ void g_issue(u32x2 (&buf)[GB], __amdgpu_buffer_rsrc_t rs, int idxr, int lb, int voff) {
#pragma unroll
    for (int j = 0; j < GB; ++j) { const int e = __builtin_amdgcn_readlane(idxr, lb + j); buf[j] = __builtin_amdgcn_raw_buffer_load_b64(rs, voff, e * 512, 0); }
}
__device__ __forceinline__ float dot16_fp4p(const u32x2 r, const f32x2 (&xp)[8]) {
    f32x2 a = FP4X2(r.x, 0) * xp[0];
    a += FP4X2(r.x, 1) * xp[1]; a += FP4X2(r.x, 2) * xp[2]; a += FP4X2(r.x, 3) * xp[3];
    a += FP4X2(r.y, 0) * xp[4]; a += FP4X2(r.y, 1) * xp[5]; a += FP4X2(r.y, 2) * xp[6]; a += FP4X2(r.y, 3) * xp[7];
    return a.x + a.y;
}
__device__ __forceinline__ void axpy16_fp4p(const u32x2 r, float w, f32x2 (&o)[8]) {
    const f32x2 ww = (f32x2){w, w};
    o[0] += FP4X2(r.x, 0) * ww; o[1] += FP4X2(r.x, 1) * ww; o[2] += FP4X2(r.x, 2) * ww; o[3] += FP4X2(r.x, 3) * ww;
    o[4] += FP4X2(r.y, 0) * ww; o[5] += FP4X2(r.y, 1) * ww; o[6] += FP4X2(r.y, 2) * ww; o[7] += FP4X2(r.y, 3) * ww;
}
template <int H> __device__ __forceinline__ void g_compute_u(const u32x2 (&buf)[GB], int q, int i16, const f32x2 (&xp)[8], float& zlo, float& zhi) {
    float p[16];
#pragma unroll
    for (int j = 0; j < 16; ++j) p[j] = dot16_fp4p(buf[16 * H + j], xp);
    float s1[8], s2[4];
#pragma unroll
    for (int m = 0; m < 8; ++m) s1[m] = swap32_add(p[2 * m], p[2 * m + 1]);
#pragma unroll
    for (int n = 0; n < 4; ++n) s2[n] = swap16_add(s1[2 * n], s1[2 * n + 1]);
#pragma unroll
    for (int r = 0; r < 4; ++r) { const float z = row_sum16(s2[r]); const bool mine = i16 == ((4 * q + r) & 15);
        zlo = (mine && q < 4) ? z : zlo; zhi = (mine && q >= 4) ? z : zhi; }
}
template <int H> __device__ __forceinline__ void g_compute_v(const u32x2 (&buf)[GB], int q, float alo, float ahi, f32x2 (&o)[8]) {
    const int areg = __builtin_bit_cast(int, (q < 4) ? alo : ahi), sb = 4 * (q & 3);
#pragma unroll
    for (int j = 0; j < 16; ++j) { const int src = 32 * (j & 1) + 16 * ((j >> 1) & 1) + (j >> 2) + sb;
        const float w = __builtin_bit_cast(float, __builtin_amdgcn_readlane(areg, src));
        axpy16_fp4p(buf[16 * H + j], w, o); }
}
__device__ __forceinline__ void q_issue(u32x2 (&buf)[16], __amdgpu_buffer_rsrc_t rs, int ixr  , int lb, int voff) {
#pragma unroll
    for (int j = 0; j < 16; ++j) { const int e9 = __builtin_amdgcn_readlane(ixr, lb + j); buf[j] = __builtin_amdgcn_raw_buffer_load_b64(rs, voff, e9, 0); }
}
__device__ __forceinline__ void q_compute_u(const u32x2 (&buf)[16], int q, int i16, const f32x2 (&xp)[8], float& zlo, float& zhi) {
    float p[16];
#pragma unroll
    for (int j = 0; j < 16; ++j) p[j] = dot16_fp4p(buf[j], xp);
    float s1[8], s2[4];
#pragma unroll
    for (int m = 0; m < 8; ++m) s1[m] = swap32_add(p[2 * m], p[2 * m + 1]);
#pragma unroll
    for (int n = 0; n < 4; ++n) s2[n] = swap16_add(s1[2 * n], s1[2 * n + 1]);
#pragma unroll
    for (int r = 0; r < 4; ++r) { const float z = row_sum16(s2[r]); const bool mine = i16 == ((4 * q + r) & 15);
        zlo = (mine && q < 4) ? z : zlo; zhi = (mine && q >= 4) ? z : zhi; }
}
typedef _Float16 h16x2 __attribute__((ext_vector_type(2)));
#define FP4H2(w, sel) __builtin_amdgcn_cvt_scalef32_pk_f16_fp4((w), 1.0f, (sel))
__device__ __forceinline__ void axpy16_fp4h(const u32x2 r, const h16x2 ww, h16x2 (&o)[8]) {
    o[0] += FP4H2(r.x, 0) * ww; o[1] += FP4H2(r.x, 1) * ww; o[2] += FP4H2(r.x, 2) * ww; o[3] += FP4H2(r.x, 3) * ww;
    o[4] += FP4H2(r.y, 0) * ww; o[5] += FP4H2(r.y, 1) * ww; o[6] += FP4H2(r.y, 2) * ww; o[7] += FP4H2(r.y, 3) * ww;
}
__device__ __forceinline__ void q_compute_vh(const u32x2 (&buf)[16], int q, int alo, int ahi, h16x2 (&o)[8]) {
    const int areg = (q < 4) ? alo : ahi, sb = 4 * (q & 3);
#pragma unroll
    for (int j = 0; j < 16; ++j) { const int src = 32 * (j & 1) + 16 * ((j >> 1) & 1) + (j >> 2) + sb;
        const h16x2 w = __builtin_bit_cast(h16x2, __builtin_amdgcn_readlane(areg, src));
        axpy16_fp4h(buf[j], w, o); }
}
__device__ __forceinline__ void q_compute_v(const u32x2 (&buf)[16], int q, float alo, float ahi, f32x2 (&o)[8]) {
    const int areg = __builtin_bit_cast(int, (q < 4) ? alo : ahi), sb = 4 * (q & 3);
#pragma unroll
    for (int j = 0; j < 16; ++j) { const int src = 32 * (j & 1) + 16 * ((j >> 1) & 1) + (j >> 2) + sb;
        const float w = __builtin_bit_cast(float, __builtin_amdgcn_readlane(areg, src));
        axpy16_fp4p(buf[j], w, o); }
}
__device__ __forceinline__ int swap32_addi(int a, int b) { auto r = __builtin_amdgcn_permlane32_swap((unsigned)a, (unsigned)b, false, false); const unsigned r0 = r[0], r1 = r[1]; return (int)(r0 + r1); }
__device__ __forceinline__ int swap16_addi(int a, int b) { auto r = __builtin_amdgcn_permlane16_swap((unsigned)a, (unsigned)b, false, false); const unsigned r0 = r[0], r1 = r[1]; return (int)(r0 + r1); }
template <int CTRL> __device__ __forceinline__ int dpp_i(int v) { return __builtin_amdgcn_update_dpp(0, v, CTRL, 0xf, 0xf, true); }
__device__ __forceinline__ int row_sum16i(int v) { v += dpp_i<0xB1>(v); v += dpp_i<0x4E>(v); v += dpp_i<0x141>(v); v += dpp_i<0x140>(v); return v; }
__device__ __forceinline__ void q_compute_ui(const u32x2 (&buf)[16], int q, int i16, int xh0, int xh1, int xl0, int xl1, int& zlo, int& zhi) {
    int p[16];
#pragma unroll
    for (int j = 0; j < 16; ++j) { const int d1 = __builtin_amdgcn_sdot8((int)buf[j].x, xh0, __builtin_amdgcn_sdot8((int)buf[j].y, xh1, 0, false), false);
        const int d2 = __builtin_amdgcn_sdot8((int)buf[j].x, xl0, __builtin_amdgcn_sdot8((int)buf[j].y, xl1, 0, false), false);
        p[j] = (d1 << 4) + d2; }
    int s1[8], s2[4];
#pragma unroll
    for (int m = 0; m < 8; ++m) s1[m] = swap32_addi(p[2 * m], p[2 * m + 1]);
#pragma unroll
    for (int n = 0; n < 4; ++n) s2[n] = swap16_addi(s1[2 * n], s1[2 * n + 1]);
#pragma unroll
    for (int r = 0; r < 4; ++r) { const int z = row_sum16i(s2[r]); const bool mine = i16 == ((4 * q + r) & 15);
        zlo = (mine && q < 4) ? z : zlo; zhi = (mine && q >= 4) ? z : zhi; }
}
__device__ __forceinline__ void phase_gather_u(const Params& P) {
    const int tid = threadIdx.x, lane = tid & 63, wave = __builtin_amdgcn_readfirstlane(tid >> 6);
    const int gw = blockIdx.x * NWAVES + wave, NGW = gridDim.x * NWAVES;
    unsigned char* ws = P.ws;
    const int* IDX = (const int*)(ws + WS_IDX); const float* GATE = (const float*)(ws + WS_GATE); const float* ESC = (const float*)(ws + WS_ESCALE); float* AW = (float*)(ws + WS_AW);
    const __amdgpu_buffer_rsrc_t rsU = __builtin_amdgcn_make_buffer_rsrc((void*)(ws + WS_U8), 0, 16384 * 512, 0x00020000);
    const bf16* H2B = (const bf16*)(ws + WS_H2B); const float* SSQ = (const float*)(ws + WS_SSQ);
    const int hh = lane >> 5, rr = (lane >> 4) & 1, i16 = lane & 15, gsel = 4 * i16 + 2 * rr + hh;
    const int voff = 8 * lane;
    const unsigned ul = (unsigned)lane;
    int t = gw;
    if (t < NTOK) {
        int idx0, idx1; u32x2 hraw[4]; float sqv;
        { const int* ip = IDX + (size_t)t * NSEL; idx0 = ip[ul]; idx1 = ip[64u + ul];
          const u32x2* hp = (const u32x2*)(H2B + (size_t)t * DM);
#pragma unroll
          for (int j = 0; j < 4; ++j) hraw[j] = hp[64u * j + ul];
          sqv = (SSQ + (size_t)t * 16)[ul & 15u]; }
        u32x2 R0[16], R1[16], R2[16], R3[16];
        { const int ix0 = idx0 << 9; q_issue(R0, rsU, ix0, 0, voff); q_issue(R1, rsU, ix0, 16, voff); q_issue(R2, rsU, ix0, 32, voff); }
        for (;;) {
            const int tn = t + NGW; const bool has_next = tn < NTOK; const int tl = has_next ? tn : t;
            int idx0n, idx1n; u32x2 hrawn[4]; float sqn, g0, g1;
            { const int* ip = IDX + (size_t)tl * NSEL; idx0n = ip[ul]; idx1n = ip[64u + ul];
              const u32x2* hp = (const u32x2*)(H2B + (size_t)tl * DM);
#pragma unroll
              for (int j = 0; j < 4; ++j) hrawn[j] = hp[64u * j + ul];
              sqn = (SSQ + (size_t)tl * 16)[ul & 15u];
              const float* gp = GATE + (size_t)t * NSEL; g0 = gp[ul]; g1 = gp[64u + ul]; }
            const float su0 = ESC[idx0], su1 = ESC[idx1], sv0 = ESC[16384 + idx0], sv1 = ESC[16384 + idx1];
            const float cq0 = ((const float*)(ws + WS_SUMQ))[idx0], cq1 = ((const float*)(ws + WS_SUMQ))[idx1];
            const float rstd2 = rsqrtf(row_sum16(sqv) * (1.f / DM) + EPS);
            float xf[16];
#pragma unroll
            for (int j = 0; j < 4; ++j) { xf[4 * j] = bflo(hraw[j].x); xf[4 * j + 1] = bfhi(hraw[j].x); xf[4 * j + 2] = bflo(hraw[j].y); xf[4 * j + 3] = bfhi(hraw[j].y); }
            float am = 0.f;
#pragma unroll
            for (int e = 0; e < 16; ++e) am = fmaxf(am, fabsf(xf[e]));
            am = fmaxf(wave_max_fast(am), 1e-30f);
            const float xinv = 127.f / am, xscale = am * (1.f / 127.f);
            unsigned xh[2] = {0u, 0u}, xl[2] = {0u, 0u};
#pragma unroll
            for (int j = 0; j < 4; ++j)
#pragma unroll
                for (int i = 0; i < 4; ++i) { const int xi = (int)rintf(xf[4 * j + i] * xinv); const int sh = 16 * (j & 1) + 4 * i;
                    xh[j >> 1] |= ((unsigned)(xi >> 4) & 15u) << sh; xl[j >> 1] |= ((unsigned)((xi & 15) - 8) & 15u) << sh; }
            int zlo = 0, zhi = 0;
            const int ix0 = idx0 << 9, ix1 = idx1 << 9;
#pragma unroll 1
            for (int qq = 0; qq < 8; qq += 4) {
                const int ixn = qq ? (idx0n << 9) : ix1;
                q_issue(R3, rsU, qq ? ix1 : ix0, 48, voff);
                q_compute_ui(R0, qq, i16, (int)xh[0], (int)xh[1], (int)xl[0], (int)xl[1], zlo, zhi);
                q_issue(R0, rsU, ixn, 0, voff);
                q_compute_ui(R1, qq + 1, i16, (int)xh[0], (int)xh[1], (int)xl[0], (int)xl[1], zlo, zhi);
                q_issue(R1, rsU, ixn, 16, voff);
                q_compute_ui(R2, qq + 2, i16, (int)xh[0], (int)xh[1], (int)xl[0], (int)xl[1], zlo, zhi);
                q_issue(R2, rsU, ixn, 32, voff);
                q_compute_ui(R3, qq + 3, i16, (int)xh[0], (int)xh[1], (int)xl[0], (int)xl[1], zlo, zhi);
            }
            const float glo = __shfl(g0, gsel), ghi = __shfl(g1, gsel), sulo = __shfl(su0, gsel), suhi = __shfl(su1, gsel), svlo = __shfl(sv0, gsel), svhi = __shfl(sv1, gsel);
            const float cqlo = __shfl(cq0, gsel), cqhi = __shfl(cq1, gsel);
            const float zfl = ((float)zlo + 8.f * cqlo) * (sulo * xscale * rstd2), zfh = ((float)zhi + 8.f * cqhi) * (suhi * xscale * rstd2);
            const float wl = gelu_tanh_f(zfl) * glo * svlo, wh = gelu_tanh_f(zfh) * ghi * svhi;
            const float wmx = fmaxf(wave_max_fast(fmaxf(fabsf(wl), fabsf(wh))), 1e-30f), wsc = 256.f / wmx;
            { const float a = wl * wsc, c = wh * wsc;
              const int ah = __builtin_amdgcn_cvt_pk_fp8_f32(a, a, 0, false) & 255, ch = __builtin_amdgcn_cvt_pk_fp8_f32(c, c, 0, false) & 255;
              const float ar = a - __builtin_amdgcn_cvt_f32_fp8(ah, 0), cr = c - __builtin_amdgcn_cvt_f32_fp8(ch, 0);
              const int al = __builtin_amdgcn_cvt_pk_fp8_f32(ar, ar, 0, false) & 255, cl = __builtin_amdgcn_cvt_pk_fp8_f32(cr, cr, 0, false) & 255;
              unsigned char* ap = (unsigned char*)AW + (size_t)t * 256;
              ap[gsel] = (unsigned char)ah; ap[64 + gsel] = (unsigned char)ch; ap[128 + gsel] = (unsigned char)al; ap[192 + gsel] = (unsigned char)cl;
              if (lane == 0) ((float*)(ws + WS_WMX))[t] = wmx * (1.f / 256.f); }
            if (!has_next) break;
            t = tn; idx0 = idx0n; idx1 = idx1n; sqv = sqn;
#pragma unroll
            for (int j = 0; j < 4; ++j) hraw[j] = hrawn[j];
        }
    }
}
__device__ __forceinline__ void phase_gather_v(const Params& P) {
    const int tid = threadIdx.x, lane = tid & 63, wave = __builtin_amdgcn_readfirstlane(tid >> 6);
    const int gw = blockIdx.x * NWAVES + wave, NGW = gridDim.x * NWAVES;
    unsigned char* ws = P.ws;
    const int* IDX = (const int*)(ws + WS_IDX); const float* AW = (const float*)(ws + WS_AW);
    const __amdgpu_buffer_rsrc_t rsV = __builtin_amdgcn_make_buffer_rsrc((void*)(ws + WS_V8), 0, 16384 * 512, 0x00020000);
    const bf16* H2B = (const bf16*)(ws + WS_H2B);
    const int voff = 8 * lane;
    const unsigned ul = (unsigned)lane;
    int t = gw;
    if (t < NTOK) {
        int idx0, idx1; u32x2 hraw[4]; float alo, ahi;
        { const int* ip = IDX + (size_t)t * NSEL; idx0 = ip[ul]; idx1 = ip[64u + ul];
          const u32x2* hp = (const u32x2*)(H2B + (size_t)t * DM);
#pragma unroll
          for (int j = 0; j < 4; ++j) hraw[j] = hp[64u * j + ul];
          const float* ap = AW + (size_t)t * NSEL; alo = ap[ul]; ahi = ap[64u + ul]; }
        u32x2 R0[16], R1[16], R2[16], R3[16];
        { const int ix0 = idx0 << 9; q_issue(R0, rsV, ix0, 0, voff); q_issue(R1, rsV, ix0, 16, voff); q_issue(R2, rsV, ix0, 32, voff); }
        for (;;) {
            const int tn = t + NGW; const bool has_next = tn < NTOK; const int tl = has_next ? tn : t;
            int idx0n, idx1n; u32x2 hrawn[4]; float alon, ahin;
            { const int* ip = IDX + (size_t)tl * NSEL; idx0n = ip[ul]; idx1n = ip[64u + ul];
              const u32x2* hp = (const u32x2*)(H2B + (size_t)tl * DM);
#pragma unroll
              for (int j = 0; j < 4; ++j) hrawn[j] = hp[64u * j + ul];
              const float* ap = AW + (size_t)tl * NSEL; alon = ap[ul]; ahin = ap[64u + ul]; }
            const float wmx = fmaxf(wave_max_fast(fmaxf(fabsf(alo), fabsf(ahi))), 1e-30f), winv = 1.f / wmx;
            int alh, ahh;
            { const h16x2 a = (h16x2){(_Float16)(alo * winv), (_Float16)(alo * winv)}, b = (h16x2){(_Float16)(ahi * winv), (_Float16)(ahi * winv)};
              alh = __builtin_bit_cast(int, a); ahh = __builtin_bit_cast(int, b); }
            h16x2 oh[8];
#pragma unroll
            for (int j = 0; j < 8; ++j) oh[j] = (h16x2){(_Float16)0.f, (_Float16)0.f};
            const int ix0 = idx0 << 9, ix1 = idx1 << 9;
#pragma unroll 1
            for (int qq = 0; qq < 8; qq += 4) {
                const int ixn = qq ? (idx0n << 9) : ix1;
                q_issue(R3, rsV, qq ? ix1 : ix0, 48, voff);
                q_compute_vh(R0, qq, alh, ahh, oh);
                q_issue(R0, rsV, ixn, 0, voff);
                q_compute_vh(R1, qq + 1, alh, ahh, oh);
                q_issue(R1, rsV, ixn, 16, voff);
                q_compute_vh(R2, qq + 2, alh, ahh, oh);
                q_issue(R2, rsV, ixn, 32, voff);
                q_compute_vh(R3, qq + 3, alh, ahh, oh);
            }
            f32x2 o[8];
#pragma unroll
            for (int j = 0; j < 8; ++j) o[j] = (f32x2){(float)oh[j].x * wmx, (float)oh[j].y * wmx};
            float ss = 0.f;
#pragma unroll
            for (int j = 0; j < 4; ++j) { o[2 * j] += (f32x2){bflo(hraw[j].x), bfhi(hraw[j].x)}; o[2 * j + 1] += (f32x2){bflo(hraw[j].y), bfhi(hraw[j].y)}; }
#pragma unroll
            for (int j = 0; j < 8; ++j) ss += o[j].x * o[j].x + o[j].y * o[j].y;
            ss = wave_sum_fast(ss);
            const float r3 = rsqrtf(ss * (1.f / DM) + EPS);
            f32x4* op = (f32x4*)(P.out + (size_t)t * DM);
            const f32x4* gfp = (const f32x4*)P.g_fin;
#pragma unroll
            for (int j = 0; j < 4; ++j) { const f32x4 gv = gfp[64u * j + ul]; op[64u * j + ul] = (f32x4){o[2 * j].x * r3 * gv.x, o[2 * j].y * r3 * gv.y, o[2 * j + 1].x * r3 * gv.z, o[2 * j + 1].y * r3 * gv.w}; }
            if (!has_next) break;
            t = tn; idx0 = idx0n; idx1 = idx1n; alo = alon; ahi = ahin;
#pragma unroll
            for (int j = 0; j < 4; ++j) hraw[j] = hrawn[j];
        }
    }
}


typedef int i32x2v __attribute__((ext_vector_type(2)));
typedef int i32x8v __attribute__((ext_vector_type(8)));
#define VM_X 9
#define VM_WAIT(n) asm volatile("s_waitcnt vmcnt(" #n ")" ::: "memory")
__device__ __forceinline__ void phase_gather_v_mfma(const Params& P, LAS unsigned char* lds) {
    const int tid = threadIdx.x, lane = tid & 63, wave = __builtin_amdgcn_readfirstlane(tid >> 6);
    unsigned char* ws = P.ws;
    const int* IDX = (const int*)(ws + WS_IDX);
    const unsigned char* V8 = ws + WS_V8; const unsigned char* AW8 = ws + WS_AW; const float* WMX = (const float*)(ws + WS_WMX);
    const unsigned short* H2S = (const unsigned short*)(ws + WS_H2B);
    const int TPB = NTOK / (int)gridDim.x, t0 = blockIdx.x * TPB, NST = TPB * 4;
    const int r0 = 16 * wave + (lane >> 3), r1 = r0 + 8;
    const unsigned c0 = 16u * (unsigned)((lane & 7) ^ ((r0 >> 1) & 7)), c1 = 16u * (unsigned)((lane & 7) ^ ((r1 >> 1) & 7));
    const int i16 = lane & 15, kb = lane >> 4;
    const int ra = 32 * kb + i16, rb = ra + 16;
    const unsigned offa = (unsigned)(ra * 128 + 16 * (wave ^ ((ra >> 1) & 7))), offb = (unsigned)(rb * 128 + 16 * (wave ^ ((rb >> 1) & 7)));
    const unsigned aoffb = (unsigned)(((i16 & 1) ? 128 : 0) + 16 * kb);
    const bool arow = (i16 & 3) < 2;
    const int colb = 256 * kb + 32 * wave + i16;
    const float gf0 = P.g_fin[colb], gf1 = P.g_fin[colb + 16];
    LAS float* SS = (LAS float*)(lds + 131072 + 1024);
    const unsigned lbase = (unsigned)(unsigned long long)lds;
    struct VTok { u32x4 a, b; float w; unsigned h0, h1; };
    VTok C0, C1;
    int ia1, ib1, ia2, ib2, ia3, ib3;
#define VM_ISSUE(g, e0, e1) do { LAS unsigned char* _d = lds + (((g) & 7) * 16384) + wave * 2048; const unsigned _cb = 128u * (unsigned)((g) & 3); \
        __builtin_amdgcn_global_load_lds((const unsigned*)(V8 + (size_t)(e0) * 512 + _cb + c0), (LAS unsigned*)(_d), 16, 0, 0); \
        __builtin_amdgcn_global_load_lds((const unsigned*)(V8 + (size_t)(e1) * 512 + _cb + c1), (LAS unsigned*)(_d + 1024), 16, 0, 0); } while (0)
    {
        const int ia0 = IDX[(size_t)t0 * NSEL + r0], ib0 = IDX[(size_t)t0 * NSEL + r1];
        ia1 = IDX[(size_t)(t0 + 1) * NSEL + r0]; ib1 = IDX[(size_t)(t0 + 1) * NSEL + r1];
        ia2 = IDX[(size_t)(t0 + 2) * NSEL + r0]; ib2 = IDX[(size_t)(t0 + 2) * NSEL + r1];
        ia3 = IDX[(size_t)(t0 + 3) * NSEL + r0]; ib3 = IDX[(size_t)(t0 + 3) * NSEL + r1];
        const unsigned char* ap = AW8 + (size_t)t0 * 256 + aoffb;
        C0.a = *(const u32x4*)ap; C0.b = *(const u32x4*)(ap + 64); C0.w = WMX[t0]; C0.h0 = H2S[(size_t)t0 * DM + colb]; C0.h1 = H2S[(size_t)t0 * DM + colb + 16];
        C1.a = *(const u32x4*)(ap + 256); C1.b = *(const u32x4*)(ap + 256 + 64); C1.w = WMX[t0 + 1]; C1.h0 = H2S[(size_t)(t0 + 1) * DM + colb]; C1.h1 = H2S[(size_t)(t0 + 1) * DM + colb + 16];
        asm volatile("s_waitcnt vmcnt(0)" ::: "memory");
        VM_ISSUE(0, ia0, ib0); VM_ISSUE(1, ia0, ib0); VM_ISSUE(2, ia0, ib0); VM_ISSUE(3, ia0, ib0);
        VM_ISSUE(4, ia1, ib1); VM_ISSUE(5, ia1, ib1); VM_ISSUE(6, ia1, ib1);
    }
    float pv0 = 0.f, pv1 = 0.f;
    VTok N0, N1; int na4, nb4, na5, nb5;
    auto token = [&](const int i, const bool even, const VTok& C, const int e1a, const int e1b, const int e2a, const int e2b) __attribute__((always_inline)) {
        const int t = t0 + i;
        const u32x4 z = (u32x4){0u, 0u, 0u, 0u}; const u32x4 Alo = arow ? C.a : z, Ahi = arow ? C.b : z;
        const i32x8v A = (i32x8v){(int)Alo.x, (int)Alo.y, (int)Alo.z, (int)Alo.w, (int)Ahi.x, (int)Ahi.y, (int)Ahi.z, (int)Ahi.w};
        f32x4 acc[4][2];
#pragma unroll
        for (int cc = 0; cc < 4; ++cc) {
            const int g = 4 * i + cc;
            if (even && cc == 0) { VM_WAIT(12); } else { VM_WAIT(26); }
            asm volatile("s_waitcnt lgkmcnt(0)" ::: "memory");
            __builtin_amdgcn_s_barrier();
            __builtin_amdgcn_sched_barrier(0);
            const unsigned sa = lbase + (unsigned)((g & 7) * 16384) + offa, sbb = lbase + (unsigned)((g & 7) * 16384) + offb;
            i32x2v b00, b01, b10, b11;
            asm volatile("ds_read_b64_tr_b4 %0, %4\n\tds_read_b64_tr_b4 %1, %5\n\tds_read_b64_tr_b4 %2, %4 offset:8\n\tds_read_b64_tr_b4 %3, %5 offset:8"
                         : "=&v"(b00), "=&v"(b01), "=&v"(b10), "=&v"(b11) : "v"(sa), "v"(sbb) : "memory");
            { const int gn = g + 7;
              if (cc == 0) VM_ISSUE(gn, e1a, e1b); else VM_ISSUE(gn, e2a, e2b); }
            __builtin_amdgcn_sched_barrier(0);
            if (cc == 0) {
                if (even) {
                    const int tA = t0 + ((i + 2 < TPB) ? i + 2 : TPB - 2), tI = t0 + ((i + 4 < TPB) ? i + 4 : TPB - 2);
                    const unsigned char* ap = AW8 + (size_t)tA * 256 + aoffb; const float* wp = WMX + tA; const int* ipa = IDX + (size_t)tI * NSEL + r0; const unsigned short* hp = H2S + (size_t)tA * DM + colb;
                    asm volatile("global_load_dwordx4 %0, %14, off\n\tglobal_load_dwordx4 %1, %14, off offset:64\n\tglobal_load_dwordx4 %2, %14, off offset:256\n\tglobal_load_dwordx4 %3, %14, off offset:320\n\t"
                                 "global_load_dword %4, %15, off\n\tglobal_load_dword %5, %15, off offset:4\n\t"
                                 "global_load_ushort %6, %17, off\n\tglobal_load_ushort %7, %17, off offset:32\n\tglobal_load_ushort %8, %17, off offset:2048\n\tglobal_load_ushort %9, %17, off offset:2080\n\t"
                                 "global_load_dword %10, %16, off\n\tglobal_load_dword %11, %16, off offset:32\n\tglobal_load_dword %12, %16, off offset:512\n\tglobal_load_dword %13, %16, off offset:544"
                                 : "=&v"(N0.a), "=&v"(N0.b), "=&v"(N1.a), "=&v"(N1.b), "=&v"(N0.w), "=&v"(N1.w), "=&v"(N0.h0), "=&v"(N0.h1), "=&v"(N1.h0), "=&v"(N1.h1), "=&v"(na4), "=&v"(nb4), "=&v"(na5), "=&v"(nb5)
                                 : "v"(ap), "v"(wp), "v"(ipa), "v"(hp) : "memory");
                }
                { const f32x4 s0 = *(const LAS f32x4*)(SS + 8 * ((i + 1) & 1)), s1 = *(const LAS f32x4*)(SS + 8 * ((i + 1) & 1) + 4);
                  const float ss = ((s0.x + s0.y) + (s0.z + s0.w)) + ((s1.x + s1.y) + (s1.z + s1.w));
                  const float r3 = rsqrtf(ss * (1.f / DM) + EPS);
                  float* op = P.out + (size_t)((i > 0) ? t - 1 : t) * DM + colb;
                  op[0] = pv0 * r3 * gf0; op[16] = pv1 * r3 * gf1; }
                __builtin_amdgcn_sched_barrier(0);
            }
            asm volatile("s_waitcnt lgkmcnt(0)" : "+v"(b00), "+v"(b01), "+v"(b10), "+v"(b11) :: "memory");
            const i32x8v B0 = (i32x8v){b00.x, b00.y, b01.x, b01.y, 0, 0, 0, 0}, B1 = (i32x8v){b10.x, b10.y, b11.x, b11.y, 0, 0, 0, 0};
            const f32x4 z4 = (f32x4){0.f, 0.f, 0.f, 0.f};
            acc[cc][0] = __builtin_amdgcn_mfma_scale_f32_16x16x128_f8f6f4(A, B0, z4, 0  , 4  , 0, 0x7f7f7f7f, 0, 0x7f7f7f7f);
            acc[cc][1] = __builtin_amdgcn_mfma_scale_f32_16x16x128_f8f6f4(A, B1, z4, 0, 4, 0, 0x7f7f7f7f, 0, 0x7f7f7f7f);
        }
#pragma unroll
        for (int c = 0; c < 4; ++c) asm volatile("" :: "v"(acc[c][0]), "v"(acc[c][1]));
        float s0 = acc[0][0].x + acc[0][0].y, s1 = acc[0][1].x + acc[0][1].y;
        { const float a0 = acc[1][0].x + acc[1][0].y, a1 = acc[1][1].x + acc[1][1].y, b0 = acc[2][0].x + acc[2][0].y, b1 = acc[2][1].x + acc[2][1].y, d0 = acc[3][0].x + acc[3][0].y, d1 = acc[3][1].x + acc[3][1].y;
          s0 = (kb == 1) ? a0 : s0; s1 = (kb == 1) ? a1 : s1; s0 = (kb == 2) ? b0 : s0; s1 = (kb == 2) ? b1 : s1; s0 = (kb == 3) ? d0 : s0; s1 = (kb == 3) ? d1 : s1; }
        pv0 = s0 * C.w + __uint_as_float(C.h0 << 16); pv1 = s1 * C.w + __uint_as_float(C.h1 << 16);
        const float sq = wave_sum_fast(pv0 * pv0 + pv1 * pv1);
        if (lane == 0) SS[8 * (i & 1) + wave] = sq;
    };
#pragma unroll 1
    for (int i = 0; i < TPB; i += 2) {
        token(i, true, C0, ia1, ib1, ia2, ib2);
        token(i + 1, false, C1, ia2, ib2, ia3, ib3);
        asm volatile("s_waitcnt vmcnt(14)" : "+v"(N0.a), "+v"(N0.b), "+v"(N1.a), "+v"(N1.b), "+v"(N0.w), "+v"(N1.w), "+v"(N0.h0), "+v"(N0.h1), "+v"(N1.h0), "+v"(N1.h1), "+v"(na4), "+v"(nb4), "+v"(na5), "+v"(nb5) :: "memory");
        C0 = N0; C1 = N1; ia1 = ia3; ib1 = ib3; ia2 = na4; ib2 = nb4; ia3 = na5; ib3 = nb5;
    }
    asm volatile("s_waitcnt vmcnt(0)" ::: "memory");
    __builtin_amdgcn_s_barrier();
    { const int i = TPB; const f32x4 s0 = *(const LAS f32x4*)(SS + 8 * ((i + 1) & 1)), s1 = *(const LAS f32x4*)(SS + 8 * ((i + 1) & 1) + 4);
      const float ss = ((s0.x + s0.y) + (s0.z + s0.w)) + ((s1.x + s1.y) + (s1.z + s1.w));
      const float r3 = rsqrtf(ss * (1.f / DM) + EPS);
      float* op = P.out + (size_t)(t0 + TPB - 1) * DM + colb;
      op[0] = pv0 * r3 * gf0; op[16] = pv1 * r3 * gf1; }
#undef VM_ISSUE
}

__device__ __forceinline__ void phase_quant_h2(const Params& P) {
    const int tid = threadIdx.x, lane = tid & 63, wave = __builtin_amdgcn_readfirstlane(tid >> 6);
    const int gw = blockIdx.x * NWAVES + wave, NGW = gridDim.x * NWAVES;
    unsigned char* ws = P.ws;
    const float* SSQ = (const float*)(ws + WS_SSQ); const float* AMX = (const float*)(ws + WS_AMX); float* RF = (float*)(ws + WS_RF);
    for (int row = gw; row < NTOK; row += NGW) {
        const u32x4* hp = (const u32x4*)(ws + WS_H2B + (size_t)row * DM * 2) + 2 * lane;
        const u32x4 a = hp[0], b = hp[1];
        const float am = fmaxf(row_max16(AMX[(size_t)row * 16 + (lane & 15)]), 1e-30f) * 1.0078125f;
        const float rstd2 = rsqrtf(row_sum16(SSQ[(size_t)row * 16 + (lane & 15)]) * (1.f / DM) + EPS);
        const float inv = 127.f / am;
        const unsigned w[8] = {a.x, a.y, a.z, a.w, b.x, b.y, b.z, b.w};
        unsigned o[4];
#pragma unroll
        for (int j = 0; j < 4; ++j) {
            const int q0 = (int)rintf(__uint_as_float(w[2 * j] << 16) * inv), q1 = (int)rintf(__uint_as_float(w[2 * j] & 0xffff0000u) * inv);
            const int q2 = (int)rintf(__uint_as_float(w[2 * j + 1] << 16) * inv), q3 = (int)rintf(__uint_as_float(w[2 * j + 1] & 0xffff0000u) * inv);
            o[j] = ((unsigned)q0 & 255u) | (((unsigned)q1 & 255u) << 8) | (((unsigned)q2 & 255u) << 16) | ((unsigned)q3 << 24); }
        u32x4 ov; ov.x = o[0]; ov.y = o[1]; ov.z = o[2]; ov.w = o[3];
        *((u32x4*)(ws + WS_H0I8 + (size_t)row * DM) + lane) = ov;
        if (lane == 0) RF[row] = am * (1.f / 127.f) * rstd2;
    }
}
struct EpiQI8 {
    static constexpr bool PERM = true, AFTER_DRAIN = false;
    bf16* O; int ldc; const float* rf; const float* sw;
    __device__ __forceinline__ void operator()(const pg8::i32x4 (&acc)[2][2][4][2], const pg8::Unit& u, int wr, int wc, int fr, int fq) const {
        const int row0 = u.pm * 256 + wr * 64 + fr, col0 = u.pn * 256 + wc * 32 + 8 * fq;
        f32x4 swv[2][2];
#pragma unroll
        for (int bj = 0; bj < 2; ++bj) { swv[bj][0] = *(const f32x4*)(sw + col0 + bj * 128); swv[bj][1] = *(const f32x4*)(sw + col0 + bj * 128 + 4); }
#pragma unroll
        for (int ai = 0; ai < 2; ++ai)
#pragma unroll
            for (int m = 0; m < 4; ++m) {
                const int row = row0 + ai * 128 + m * 16;
                const float s = rf[row];
                bf16* rowp = O + (size_t)row * ldc + col0;
#pragma unroll
                for (int bj = 0; bj < 2; ++bj) { const pg8::i32x4 a0 = acc[ai][bj][m][0], a1 = acc[ai][bj][m][1];
                    const f32x4 v0 = (f32x4){(float)a0[0], (float)a0[1], (float)a0[2], (float)a0[3]} * (swv[bj][0] * s), v1 = (f32x4){(float)a1[0], (float)a1[1], (float)a1[2], (float)a1[3]} * (swv[bj][1] * s);
                    u32x4 w; w.x = cvt_pk_bf16(v0[0], v0[1]); w.y = cvt_pk_bf16(v0[2], v0[3]); w.z = cvt_pk_bf16(v1[0], v1[1]); w.w = cvt_pk_bf16(v1[2], v1[3]);
                    *(u32x4*)(rowp + bj * 128) = w; }
            }
    }
};
#define XB_TMO      128
#define XB_XCNT(j)  (256  + 64 * (j))
#define XB_XSUB(j)  (1280 + 64 * (j))
#define XB_XGEN(j)  (2304 + 64 * (j))
#define XB_TOP      3328
#define XB_TOPGEN   3392
#define XCD_BAR_WORDS 3456
#define XB_SPIN_CAP (1u << 18)

__device__ __forceinline__ unsigned xb_ld(unsigned* p)              { return __hip_atomic_load(p, __ATOMIC_RELAXED, __HIP_MEMORY_SCOPE_AGENT); }
__device__ __forceinline__ unsigned xb_add(unsigned* p, unsigned v) { return __hip_atomic_fetch_add(p, v, __ATOMIC_RELAXED, __HIP_MEMORY_SCOPE_AGENT); }
__device__ __forceinline__ unsigned xb_xcc_id() { return (unsigned)__builtin_amdgcn_s_getreg((3 << 11) | 20) & 0xFu; }
#define XB_SPIN(cond, bar) do { unsigned _sp = 0; while (cond) { __builtin_amdgcn_s_sleep(1); \
    if ((++_sp & 255u) == 0u) { if (xb_ld(&(bar)[XB_TMO])) break; if (_sp > XB_SPIN_CAP) { atomicAdd(&(bar)[XB_TMO], 1u); break; } } } } while (0)

struct XcdBarrier {
    unsigned* bar; unsigned x;
    volatile LAS unsigned* st;
};

__device__ __forceinline__ XcdBarrier xcd_barrier_post(unsigned* bar, volatile LAS unsigned* st) {
    XcdBarrier b; b.bar = bar; b.x = xb_xcc_id(); b.st = st;
    if (threadIdx.x == 0) (void)xb_add(&bar[XB_XCNT(b.x)], 1u);
    return b;
}
__device__ __forceinline__ void xcd_barrier_complete(unsigned* bar, unsigned x, unsigned& nloc, unsigned& nx) {
    const unsigned G = gridDim.x * gridDim.y * gridDim.z;
    unsigned sum, cnt, mine, sp = 0u;
    for (;;) {
        sum = 0u; cnt = 0u; mine = 0u;
#pragma unroll
        for (unsigned j = 0; j < 16; ++j) { const unsigned c = xb_ld(&bar[XB_XCNT(j)]); sum += c; cnt += (c > 0u) ? 1u : 0u; mine = (j == x) ? c : mine; }
        if (sum == G) break;
        __builtin_amdgcn_s_sleep(1);
        if ((++sp & 255u) == 0u) { if (xb_ld(&bar[XB_TMO])) break; if (sp > XB_SPIN_CAP) { atomicAdd(&bar[XB_TMO], 1u); break; } }
    }
    nloc = mine > 0u ? mine : 1u; nx = cnt > 0u ? cnt : 1u;
}

__device__ __forceinline__ void xcd_barrier(const XcdBarrier& b) {
    asm volatile("s_waitcnt vmcnt(0)" ::: "memory");
    __syncthreads();
    if (threadIdx.x == 0) {
        unsigned* bar = b.bar;
        __builtin_amdgcn_s_waitcnt(0);
        unsigned nloc = b.st[0], nx = b.st[1];
        if (nloc == 0u) { xcd_barrier_complete(bar, b.x, nloc, nx); b.st[0] = nloc; b.st[1] = nx; }
        const unsigned old = xb_add(&bar[XB_XSUB(b.x)], 1u);
        const unsigned gen = old / nloc;
        if (old + 1u == (gen + 1u) * nloc) {
            __builtin_amdgcn_fence(__ATOMIC_RELEASE, "agent");
            asm volatile("s_waitcnt vmcnt(0)" ::: "memory");
            const unsigned og = xb_add(&bar[XB_TOP], 1u);
            const unsigned tg = og / nx;
            if (og + 1u == (tg + 1u) * nx) xb_add(&bar[XB_TOPGEN], 1u);
            else XB_SPIN(xb_ld(&bar[XB_TOPGEN]) == tg, bar);
            __builtin_amdgcn_fence(__ATOMIC_ACQUIRE, "agent");
            xb_add(&bar[XB_XGEN(b.x)], 1u);
            asm volatile("s_waitcnt vmcnt(0)" ::: "memory");
        } else {
            XB_SPIN(xb_ld(&bar[XB_XGEN(b.x)]) == gen, bar);
            __builtin_amdgcn_fence(__ATOMIC_ACQUIRE, "agent");
            asm volatile("s_waitcnt vmcnt(0)" ::: "memory");
        }
    }
    __syncthreads();
}


#ifndef MK_MULTI
#define MK_MULTI 0
#endif
constexpr int NPHASE = 10;
#ifndef REP5
#define REP5 1
#endif
#ifndef REP6
#define REP6 1
#endif
__global__ void __launch_bounds__(NTHREADS, 2) mk_fwd(Params P) {
    extern __shared__ __attribute__((aligned(16))) unsigned char lds_raw[];
    LAS unsigned char* lds = (LAS unsigned char*)lds_raw;
    cg::grid_group grid = cg::this_grid();
    unsigned char* ws = P.ws;
    const int lo = P.ph_lo, hi = P.ph_hi;
    volatile LAS unsigned* bst = (volatile LAS unsigned*)(lds + 131072 + 64);
    if (threadIdx.x < 2) bst[threadIdx.x] = 0u;
    __syncthreads();
    XcdBarrier xbar = xcd_barrier_post((unsigned*)(ws + WS_CTL), bst);
#define IN(k) (lo <= (k) && (k) < hi)
#define SEAM(k) do { if (IN(k) && IN((k) + 1)) { xcd_barrier(xbar); } } while (0)
    if (IN(0)) phase_prep(P, lds);
    SEAM(0);
    if (IN(1)) { phase_metaproj(P); phase_winq(P, lds); }
    SEAM(1);
    if (IN(2)) {
        pg8::Gemm g{(const bf16*)(ws + WS_H0I8), (const bf16*)(ws + WS_WIN_T), NTOK, DIN, DM / 2}; pg8::StaticOrder S; S.init(NTOK, DIN, (int)gridDim.x, (int)blockIdx.x);
        EpiProjI8 E{(bf16*)(ws + WS_PROJ), (const float*)(ws + WS_RSTD1), (const float*)(ws + WS_SW)};
        pg8::gemm_phase_i8<EpiProjI8, pg8::StaticOrder, true, true>(lds, g, S, E);
    }
    SEAM(2);
    if (IN(3)) phase_conv(P, lds);
    SEAM(3);
    if (IN(4)) {
        pg8::Gemm g{(const bf16*)(ws + WS_Y), (const bf16*)(ws + WS_WOUT_T), NTOK, DM, DM / 2}; pg8::StaticOrder S; S.init(NTOK, DM, (int)gridDim.x, (int)blockIdx.x);
        EpiResidualI8 E{(bf16*)(ws + WS_H2B), (const signed char*)(ws + WS_H0I8), (const float*)(ws + WS_SX), (const float*)(ws + WS_SY), (const float*)(ws + WS_SWO), (float*)(ws + WS_SSQ), (float*)(ws + WS_AMX)};
        pg8::gemm_phase_i8<EpiResidualI8, pg8::StaticOrder, true, true>(lds, g, S, E);
    }
    SEAM(4);
    if (IN(5)) phase_quant_h2(P);
    SEAM(5);
    if (IN(6)) {
        pg8::Gemm g{(const bf16*)(ws + WS_H0I8), (const bf16*)(ws + WS_WQ_T), NTOK, 2048, DM / 2}; pg8::StaticOrder S; S.init(NTOK, 2048, (int)gridDim.x, (int)blockIdx.x);
        EpiQI8 E{(bf16*)(ws + WS_Q), 2048, (const float*)(ws + WS_RF), (const float*)(ws + WS_SWQ)};
        pg8::gemm_phase_i8<EpiQI8, pg8::StaticOrder, true, true>(lds, g, S, E);
    }
    if (IN(6) && IN(7)) { asm volatile("s_waitcnt vmcnt(0)" ::: "memory"); __syncthreads(); }
    if (IN(7)) phase_route(P, lds);
    SEAM(7);
    if (IN(8)) phase_gather_u(P);
    SEAM(8);
    if (IN(9)) phase_gather_v_mfma(P, lds);
#undef IN
#undef SEAM
}

extern "C" void kernel_launch(void* const* d_in, const int* in_sizes, int n_in, void* d_out, int out_size, void* d_ws, size_t ws_size, hipStream_t stream) {
    static int grid = 0;
    if (grid == 0) {
        if (n_in != 18 || in_sizes[0] != NTOK * DM || out_size != NTOK * DM || ws_size < WS_END) {
            fprintf(stderr, "kernel_launch: unexpected shapes (n_in %d in0 %d out %d ws %zu)\n", n_in, n_in > 0 ? in_sizes[0] : -1, out_size, ws_size); grid = -1; return; }
        int dev = 0, cus = 0, per_cu = 0;
        (void)hipGetDevice(&dev); (void)hipDeviceGetAttribute(&cus, hipDeviceAttributeMultiprocessorCount, dev);
        if (hipFuncSetAttribute((const void*)mk_fwd, hipFuncAttributeMaxDynamicSharedMemorySize, LDS_BYTES) != hipSuccess) { fprintf(stderr, "kernel_launch: hipFuncSetAttribute failed\n"); grid = -1; return; }
        if (hipOccupancyMaxActiveBlocksPerMultiprocessor(&per_cu, (const void*)mk_fwd, NTHREADS, LDS_BYTES) != hipSuccess || per_cu < 1) { fprintf(stderr, "kernel_launch: occupancy query failed (%d)\n", per_cu); (void)hipGetLastError(); per_cu = 1; }
        if (per_cu > 1) per_cu = 1;
        grid = cus * per_cu;
        if (grid <= 0) grid = 256;
    }
    if (grid < 0) return;
    Params p{};
    p.x = (const float*)d_in[0]; p.meta = (const float*)d_in[1]; p.g_mix = (const float*)d_in[2]; p.w_in = (const float*)d_in[3]; p.sc_w = (const float*)d_in[4];
    p.cf_w = (const float*)d_in[5]; p.cf_b = (const float*)d_in[6]; p.ln_g = (const float*)d_in[7]; p.ln_b = (const float*)d_in[8]; p.g_sc = (const float*)d_in[9];
    p.g_cf = (const float*)d_in[10]; p.w_out = (const float*)d_in[11]; p.g_ffn = (const float*)d_in[12]; p.w_q = (const float*)d_in[13]; p.keys = (const float*)d_in[14];
    p.pu = (const float*)d_in[15]; p.pv = (const float*)d_in[16]; p.g_fin = (const float*)d_in[17];
    p.out = (float*)d_out; p.ws = (unsigned char*)d_ws;
    (void)hipMemsetAsync((char*)d_ws + WS_CTL, 0, 45056, stream);
#if MK_MULTI
    for (int ph = 0; ph < NPHASE; ++ph) { p.ph_lo = ph; p.ph_hi = ph + 1; p.coop = 0; p.pad = 0;
        hipLaunchKernelGGL(mk_fwd, dim3(grid), dim3(NTHREADS), LDS_BYTES, stream, p); }
#else
    p.ph_lo = 0; p.ph_hi = NPHASE; p.coop = 1; p.pad = 0;
    void* args[] = {&p};
    hipError_t e = hipLaunchCooperativeKernel((const void*)mk_fwd, dim3(grid), dim3(NTHREADS), args, LDS_BYTES, stream);
    if (e != hipSuccess) fprintf(stderr, "cooperative launch failed: %s (grid %d)\n", hipGetErrorString(e), grid);
#endif
}
```

```cpp
#include <hip/hip_runtime.h>
#include <hip/hip_cooperative_groups.h>
#include <cstdio>
#include <cstdint>
namespace cg = cooperative_groups;

namespace pg8 {
#define PG8_LAS __attribute__((address_space(3)))
typedef unsigned short bf16_t;
typedef short bf16x8 __attribute__((ext_vector_type(8)));
typedef float f32x4 __attribute__((ext_vector_type(4)));
typedef unsigned u32x4 __attribute__((ext_vector_type(4)));
typedef int i32x4 __attribute__((ext_vector_type(4)));
constexpr int BM = 256, BK = 64, HALF = 128, HTB = HALF * BK * 2  , STAGE_BYTES = 8 * HTB, NXCD = 8, WGM = 8;

__host__ __device__ __forceinline__ int lds_byte(int r, int c) { const int st = (r >> 4) * 2 + (c >> 5), rr = r & 15, cc = c & 31, ob = rr * 64 + cc * 2; return st * 1024 + (ob ^ (((ob >> 9) & 1) << 5)); }
__host__ __device__ __forceinline__ void stage_rc(int b, int& R, int& C) { const int st = b / 1024, sb = b % 1024, swz = sb ^ (((sb >> 9) & 1) << 5); R = (st >> 1) * 16 + swz / 64; C = (st & 1) * 32 + (swz % 64) / 2; }
__host__ __device__ __forceinline__ int perm32(int rho) { const int n = rho >> 4, i = rho & 15; return 8 * (i >> 2) + 4 * n + (i & 3); }

struct Unit { int pm, pn; };
struct Gemm { const bf16_t* A; const bf16_t* Bt; int M, N, K; };

struct StaticOrder {
    int nM, nN, nwg, G, c;
    __host__ __device__ void init(int M, int N, int G_, int c_) { nM = M / BM; nN = N / BM; nwg = nM * nN; G = G_; c = c_; }
    __host__ __device__ bool next(int i, Unit& u) const {
        const long L = (long)i * G + c; if (L >= nwg) return false;
        int wgid = (int)L; { const int q = nwg / NXCD, r = nwg % NXCD, xcd = wgid % NXCD, off = wgid / NXCD; wgid = (xcd < r ? xcd * (q + 1) : r * (q + 1) + (xcd - r) * q) + off; }
        const int nig = WGM * nN, gid = wgid / nig, fm = gid * WGM, gsz = (nM - fm) < WGM ? (nM - fm) : WGM;
        u.pm = fm + ((wgid % nig) % gsz); u.pn = (wgid % nig) / gsz; return true;
    }
    __device__ __forceinline__ void a_ready(const Unit&) const {}
    __device__ __forceinline__ void done(const Unit&) const {}
};

template <class Epi, class Sched, bool ALIGN_EPI = false, bool SP2 = false>
__device__ __forceinline__ void gemm_phase(PG8_LAS unsigned char* lds, const Gemm g, const Sched& S, const Epi& E) {
    const int tid = threadIdx.x, wid = __builtin_amdgcn_readfirstlane(tid >> 6), lane = tid & 63, wr = wid >> 2, wc = wid & 3, fr = lane & 15, fq = lane >> 4;
    const int K = g.K, nt = K / BK;
    unsigned voffA[2], voffB[2];
#pragma unroll
    for (int i = 0; i < 2; ++i) { int R, C; stage_rc(tid * 16 + i * 8192, R, C); const int Rb = Epi::PERM ? ((R & ~31) + perm32(R & 31)) : R;
        voffA[i] = (unsigned)(R * K + C) * 2u; voffB[i] = (unsigned)(Rb * K + C) * 2u; }
    const size_t kstep = (size_t)(BK * 2);
    const size_t hstep = (size_t)HALF * K * 2;
    const size_t tstep = 2 * hstep;
    const unsigned ldsw = (unsigned)wid * 1024u;
    const int aoff = lds_byte(wr * 64 + fr, fq * 8), boff = lds_byte(wc * 32 + fr, fq * 8);
#define PG8_SA(b, h) (((b) * 2 + (h)) * HTB)
#define PG8_SB(b, h) ((4 + (b) * 2 + (h)) * HTB)
#define PG8_STAGE(bufoff, gbase, voff) do { _Pragma("unroll") for (int _i = 0; _i < 2; ++_i) \
        __builtin_amdgcn_global_load_lds((const unsigned*)((const char*)(gbase) + (voff)[_i]), (PG8_LAS unsigned*)(lds + (bufoff) + ldsw + _i * 8192), 16, 0, 0); } while (0)
#define PG8_LDA(dst, b, h) do { _Pragma("unroll") for (int m = 0; m < 4; ++m) _Pragma("unroll") for (int k = 0; k < 2; ++k) dst[m][k] = *(const PG8_LAS bf16x8*)(lds + PG8_SA(b, h) + aoff + m * 2048 + k * 1024); } while (0)
#define PG8_LDB(dst, b, h) do { _Pragma("unroll") for (int n = 0; n < 2; ++n) _Pragma("unroll") for (int k = 0; k < 2; ++k) dst[n][k] = *(const PG8_LAS bf16x8*)(lds + PG8_SB(b, h) + boff + n * 2048 + k * 1024); } while (0)
#define PG8_MMA(ai, bj, At, Bt) do { __builtin_amdgcn_s_setprio(1); _Pragma("unroll") for (int m = 0; m < 4; ++m) _Pragma("unroll") for (int n = 0; n < 2; ++n) _Pragma("unroll") for (int k = 0; k < 2; ++k) \
        acc[ai][bj][m][n] = __builtin_amdgcn_mfma_f32_16x16x32_bf16(Bt[n][k], At[m][k], acc[ai][bj][m][n], 0, 0, 0); __builtin_amdgcn_s_setprio(0); } while (0)
#define PG8_WAIT_V(n) asm volatile("s_waitcnt vmcnt(" #n ")" ::: "memory")
#define PG8_WAIT_L(n) asm volatile("s_waitcnt lgkmcnt(" #n ")" ::: "memory")
#define PG8_BAR __builtin_amdgcn_s_barrier()
#define PG8_SCHED __builtin_amdgcn_sched_barrier(0)
    Unit cur, nxt; int ui = 0;
    if (!S.next(0, cur)) return;
    f32x4 acc[2][2][4][2];
#pragma unroll
    for (int a = 0; a < 2; ++a)
#pragma unroll
        for (int b = 0; b < 2; ++b)
#pragma unroll
            for (int m = 0; m < 4; ++m)
#pragma unroll
                for (int n = 0; n < 2; ++n) acc[a][b][m][n] = (f32x4){0.f, 0.f, 0.f, 0.f};
    bf16x8 At[4][2], B0[2][2], B1[2][2];
    const char* cA = (const char*)g.A + (size_t)cur.pm * tstep; const char* cB = (const char*)g.Bt + (size_t)cur.pn * tstep;
    S.a_ready(cur);
    if constexpr (SP2) {
        PG8_STAGE(PG8_SB(0, 0), cB, voffB); PG8_STAGE(PG8_SB(0, 1), cB + hstep, voffB); PG8_STAGE(PG8_SA(0, 0), cA, voffA); PG8_STAGE(PG8_SA(0, 1), cA + hstep, voffA);
        if (wr == 1) PG8_BAR;
        PG8_WAIT_V(2); PG8_BAR;
        PG8_STAGE(PG8_SB(1, 0), cB + kstep, voffB); PG8_STAGE(PG8_SA(1, 0), cA + kstep, voffA); PG8_STAGE(PG8_SB(1, 1), cB + hstep + kstep, voffB);
        PG8_WAIT_V(6); PG8_BAR;
    } else {
        PG8_STAGE(PG8_SB(0, 0), cB, voffB); PG8_STAGE(PG8_SA(0, 0), cA, voffA); PG8_STAGE(PG8_SB(0, 1), cB + hstep, voffB); PG8_STAGE(PG8_SA(0, 1), cA + hstep, voffA);
        if (wr == 1) PG8_BAR;
        PG8_WAIT_V(4); PG8_BAR;
        PG8_STAGE(PG8_SB(1, 0), cB + kstep, voffB); PG8_STAGE(PG8_SA(1, 0), cA + kstep, voffA); PG8_STAGE(PG8_SB(1, 1), cB + hstep + kstep, voffB);
        PG8_WAIT_V(6); PG8_BAR;
    }
    for (;;) {
        const bool has_next = S.next(ui + 1, nxt);
        const char* nA = has_next ? (const char*)g.A + (size_t)nxt.pm * tstep : cA; const char* nB = has_next ? (const char*)g.Bt + (size_t)nxt.pn * tstep : cB;
        for (int t = 0; t < nt; t += 2) {
            const bool last = (t == nt - 2);
            const char* a1 = cA + (size_t)(t + 1) * kstep;
            const char* a2 = last ? nA : cA + (size_t)(t + 2) * kstep; const char* b2 = last ? nB : cB + (size_t)(t + 2) * kstep;
            const char* a3 = a2 + kstep; const char* b3 = b2 + kstep;
            if (last && has_next) S.a_ready(nxt);
            if constexpr (SP2) {
            PG8_LDB(B0, 0, 0); PG8_LDB(B1, 0, 1); PG8_SCHED; PG8_LDA(At, 0, 0); PG8_STAGE(PG8_SA(1, 1), a1 + hstep, voffA);
            PG8_WAIT_V(8); PG8_WAIT_L(0); PG8_BAR; PG8_MMA(0, 0, At, B0); PG8_MMA(0, 1, At, B1); PG8_BAR; PG8_SCHED;
            PG8_LDA(At, 0, 1); PG8_STAGE(PG8_SB(0, 0), b2, voffB); PG8_STAGE(PG8_SB(0, 1), b2 + hstep, voffB); PG8_STAGE(PG8_SA(0, 0), a2, voffA);
            PG8_WAIT_V(8); PG8_WAIT_L(0); PG8_BAR; PG8_MMA(1, 0, At, B0); PG8_MMA(1, 1, At, B1); PG8_BAR; PG8_SCHED;
            PG8_LDB(B0, 1, 0); PG8_LDB(B1, 1, 1); PG8_SCHED; PG8_LDA(At, 1, 0); PG8_STAGE(PG8_SA(0, 1), a2 + hstep, voffA);
            PG8_WAIT_V(8); PG8_WAIT_L(0); PG8_BAR; PG8_MMA(0, 0, At, B0); PG8_MMA(0, 1, At, B1); PG8_BAR; PG8_SCHED;
            PG8_LDA(At, 1, 1); PG8_STAGE(PG8_SB(1, 0), b3, voffB); PG8_STAGE(PG8_SB(1, 1), b3 + hstep, voffB); PG8_STAGE(PG8_SA(1, 0), a3, voffA);
            PG8_WAIT_V(8); PG8_WAIT_L(0); PG8_BAR; PG8_MMA(1, 0, At, B0); PG8_MMA(1, 1, At, B1); PG8_BAR; PG8_SCHED;
            } else {
            PG8_LDB(B0, 0, 0); PG8_SCHED; PG8_LDA(At, 0, 0); PG8_STAGE(PG8_SA(1, 1), a1 + hstep, voffA);
            PG8_WAIT_L(8); PG8_BAR; PG8_WAIT_L(0); PG8_MMA(0, 0, At, B0); PG8_BAR; PG8_SCHED;
            PG8_LDB(B1, 0, 1); PG8_STAGE(PG8_SB(0, 0), b2, voffB);
            PG8_BAR; PG8_WAIT_L(0); PG8_MMA(0, 1, At, B1); PG8_BAR;
            PG8_LDA(At, 0, 1); PG8_STAGE(PG8_SA(0, 0), a2, voffA);
            PG8_BAR; PG8_WAIT_L(0); PG8_MMA(1, 0, At, B0); PG8_BAR; PG8_SCHED;
            PG8_STAGE(PG8_SB(0, 1), b2 + hstep, voffB);
            PG8_WAIT_V(6); PG8_BAR; PG8_MMA(1, 1, At, B1); PG8_BAR;
            PG8_LDB(B0, 1, 0); PG8_SCHED; PG8_LDA(At, 1, 0); PG8_STAGE(PG8_SA(0, 1), a2 + hstep, voffA);
            PG8_WAIT_L(8); PG8_BAR; PG8_WAIT_L(0); PG8_MMA(0, 0, At, B0); PG8_BAR; PG8_SCHED;
            PG8_LDB(B1, 1, 1); PG8_STAGE(PG8_SB(1, 0), b3, voffB);
            PG8_BAR; PG8_WAIT_L(0); PG8_MMA(0, 1, At, B1); PG8_BAR;
            PG8_LDA(At, 1, 1); PG8_STAGE(PG8_SA(1, 0), a3, voffA);
            PG8_BAR; PG8_WAIT_L(0); PG8_MMA(1, 0, At, B0); PG8_BAR; PG8_SCHED;
            PG8_STAGE(PG8_SB(1, 1), b3 + hstep, voffB);
            PG8_WAIT_V(6); PG8_BAR; PG8_MMA(1, 1, At, B1); PG8_BAR;
            }
        }
        if constexpr (ALIGN_EPI) { if (wr == 0) PG8_BAR; }
        if constexpr (!Epi::AFTER_DRAIN) { E(acc, cur, wr, wc, fr, fq); S.done(cur); }
        if (!has_next) break;
#pragma unroll
        for (int a = 0; a < 2; ++a)
#pragma unroll
            for (int b = 0; b < 2; ++b)
#pragma unroll
                for (int m = 0; m < 4; ++m)
#pragma unroll
                    for (int n = 0; n < 2; ++n) acc[a][b][m][n] = (f32x4){0.f, 0.f, 0.f, 0.f};
        cur = nxt; cA = nA; cB = nB; ++ui;
        if constexpr (ALIGN_EPI) { if (wr == 1) PG8_BAR; }
    }
    PG8_WAIT_V(0);
    if constexpr (!ALIGN_EPI) { if (wr == 0) PG8_BAR; }
    PG8_BAR;
    if constexpr (Epi::AFTER_DRAIN) { E.fused(acc, cur, wr, wc, fr, fq, lds, wid, lane); S.done(cur); }
#undef PG8_SA
#undef PG8_SB
#undef PG8_STAGE
#undef PG8_LDA
#undef PG8_LDB
#undef PG8_MMA
#undef PG8_WAIT_V
#undef PG8_WAIT_L
#undef PG8_BAR
#undef PG8_SCHED
}
template <class Epi, class Sched, bool ALIGN_EPI = false, bool SP2 = false>
__device__ __forceinline__ void gemm_phase_i8(PG8_LAS unsigned char* lds, const Gemm g, const Sched& S, const Epi& E) {
    const int tid = threadIdx.x, wid = __builtin_amdgcn_readfirstlane(tid >> 6), lane = tid & 63, wr = wid >> 2, wc = wid & 3, fr = lane & 15, fq = lane >> 4;
    const int K = g.K, nt = K / BK;
    unsigned voffA[2], voffB[2];
#pragma unroll
    for (int i = 0; i < 2; ++i) { int R, C; stage_rc(tid * 16 + i * 8192, R, C); const int Rb = Epi::PERM ? ((R & ~31) + perm32(R & 31)) : R;
        voffA[i] = (unsigned)(R * K + C) * 2u; voffB[i] = (unsigned)(Rb * K + C) * 2u; }
    const size_t kstep = (size_t)(BK * 2);
    const size_t hstep = (size_t)HALF * K * 2;
    const size_t tstep = 2 * hstep;
    const unsigned ldsw = (unsigned)wid * 1024u;
    const int aoff = lds_byte(wr * 64 + fr, fq * 8), boff = lds_byte(wc * 32 + fr, fq * 8);
#define PG8_SA(b, h) (((b) * 2 + (h)) * HTB)
#define PG8_SB(b, h) ((4 + (b) * 2 + (h)) * HTB)
#define PG8_STAGE(bufoff, gbase, voff) do { _Pragma("unroll") for (int _i = 0; _i < 2; ++_i) \
        __builtin_amdgcn_global_load_lds((const unsigned*)((const char*)(gbase) + (voff)[_i]), (PG8_LAS unsigned*)(lds + (bufoff) + ldsw + _i * 8192), 16, 0, 0); } while (0)
#define PG8_LDA(dst, b, h) do { _Pragma("unroll") for (int m = 0; m < 4; ++m) _Pragma("unroll") for (int k = 0; k < 2; ++k) dst[m][k] = *(const PG8_LAS bf16x8*)(lds + PG8_SA(b, h) + aoff + m * 2048 + k * 1024); } while (0)
#define PG8_LDB(dst, b, h) do { _Pragma("unroll") for (int n = 0; n < 2; ++n) _Pragma("unroll") for (int k = 0; k < 2; ++k) dst[n][k] = *(const PG8_LAS bf16x8*)(lds + PG8_SB(b, h) + boff + n * 2048 + k * 1024); } while (0)
#define PG8_MMA(ai, bj, At, Bt) do { __builtin_amdgcn_s_setprio(1); _Pragma("unroll") for (int m = 0; m < 4; ++m) _Pragma("unroll") for (int n = 0; n < 2; ++n) _Pragma("unroll") for (int k = 0; k < 2; ++k) \
        acc[ai][bj][m][n] = __builtin_amdgcn_mfma_i32_16x16x64_i8(__builtin_bit_cast(i32x4, Bt[n][k]), __builtin_bit_cast(i32x4, At[m][k]), acc[ai][bj][m][n], 0, 0, 0); __builtin_amdgcn_s_setprio(0); } while (0)
#define PG8_WAIT_V(n) asm volatile("s_waitcnt vmcnt(" #n ")" ::: "memory")
#define PG8_WAIT_L(n) asm volatile("s_waitcnt lgkmcnt(" #n ")" ::: "memory")
#define PG8_BAR __builtin_amdgcn_s_barrier()
#define PG8_SCHED __builtin_amdgcn_sched_barrier(0)
    Unit cur, nxt; int ui = 0;
    if (!S.next(0, cur)) return;
    i32x4 acc[2][2][4][2];
#pragma unroll
    for (int a = 0; a < 2; ++a)
#pragma unroll
        for (int b = 0; b < 2; ++b)
#pragma unroll
            for (int m = 0; m < 4; ++m)
#pragma unroll
                for (int n = 0; n < 2; ++n) acc[a][b][m][n] = (i32x4){0, 0, 0, 0};
    bf16x8 At[4][2], B0[2][2], B1[2][2];
    const char* cA = (const char*)g.A + (size_t)cur.pm * tstep; const char* cB = (const char*)g.Bt + (size_t)cur.pn * tstep;
    S.a_ready(cur);
    if constexpr (SP2) {
        PG8_STAGE(PG8_SB(0, 0), cB, voffB); PG8_STAGE(PG8_SB(0, 1), cB + hstep, voffB); PG8_STAGE(PG8_SA(0, 0), cA, voffA); PG8_STAGE(PG8_SA(0, 1), cA + hstep, voffA);
        if (wr == 1) PG8_BAR;
        PG8_WAIT_V(2); PG8_BAR;
        PG8_STAGE(PG8_SB(1, 0), cB + kstep, voffB); PG8_STAGE(PG8_SA(1, 0), cA + kstep, voffA); PG8_STAGE(PG8_SB(1, 1), cB + hstep + kstep, voffB);
        PG8_WAIT_V(6); PG8_BAR;
    } else {
        PG8_STAGE(PG8_SB(0, 0), cB, voffB); PG8_STAGE(PG8_SA(0, 0), cA, voffA); PG8_STAGE(PG8_SB(0, 1), cB + hstep, voffB); PG8_STAGE(PG8_SA(0, 1), cA + hstep, voffA);
        if (wr == 1) PG8_BAR;
        PG8_WAIT_V(4); PG8_BAR;
        PG8_STAGE(PG8_SB(1, 0), cB + kstep, voffB); PG8_STAGE(PG8_SA(1, 0), cA + kstep, voffA); PG8_STAGE(PG8_SB(1, 1), cB + hstep + kstep, voffB);
        PG8_WAIT_V(6); PG8_BAR;
    }
    for (;;) {
        const bool has_next = S.next(ui + 1, nxt);
        const char* nA = has_next ? (const char*)g.A + (size_t)nxt.pm * tstep : cA; const char* nB = has_next ? (const char*)g.Bt + (size_t)nxt.pn * tstep : cB;
        for (int t = 0; t < nt; t += 2) {
            const bool last = (t == nt - 2);
            const char* a1 = cA + (size_t)(t + 1) * kstep;
            const char* a2 = last ? nA : cA + (size_t)(t + 2) * kstep; const char* b2 = last ? nB : cB + (size_t)(t + 2) * kstep;
            const char* a3 = a2 + kstep; const char* b3 = b2 + kstep;
            if (last && has_next) S.a_ready(nxt);
            if constexpr (SP2) {
            PG8_LDB(B0, 0, 0); PG8_LDB(B1, 0, 1); PG8_SCHED; PG8_LDA(At, 0, 0); PG8_STAGE(PG8_SA(1, 1), a1 + hstep, voffA);
            PG8_WAIT_V(8); PG8_WAIT_L(0); PG8_BAR; PG8_MMA(0, 0, At, B0); PG8_MMA(0, 1, At, B1); PG8_BAR; PG8_SCHED;
            PG8_LDA(At, 0, 1); PG8_STAGE(PG8_SB(0, 0), b2, voffB); PG8_STAGE(PG8_SB(0, 1), b2 + hstep, voffB); PG8_STAGE(PG8_SA(0, 0), a2, voffA);
            PG8_WAIT_V(8); PG8_WAIT_L(0); PG8_BAR; PG8_MMA(1, 0, At, B0); PG8_MMA(1, 1, At, B1); PG8_BAR; PG8_SCHED;
            PG8_LDB(B0, 1, 0); PG8_LDB(B1, 1, 1); PG8_SCHED; PG8_LDA(At, 1, 0); PG8_STAGE(PG8_SA(0, 1), a2 + hstep, voffA);
            PG8_WAIT_V(8); PG8_WAIT_L(0); PG8_BAR; PG8_MMA(0, 0, At, B0); PG8_MMA(0, 1, At, B1); PG8_BAR; PG8_SCHED;
            PG8_LDA(At, 1, 1); PG8_STAGE(PG8_SB(1, 0), b3, voffB); PG8_STAGE(PG8_SB(1, 1), b3 + hstep, voffB); PG8_STAGE(PG8_SA(1, 0), a3, voffA);
            PG8_WAIT_V(8); PG8_WAIT_L(0); PG8_BAR; PG8_MMA(1, 0, At, B0); PG8_MMA(1, 1, At, B1); PG8_BAR; PG8_SCHED;
            } else {
            PG8_LDB(B0, 0, 0); PG8_SCHED; PG8_LDA(At, 0, 0); PG8_STAGE(PG8_SA(1, 1), a1 + hstep, voffA);
            PG8_WAIT_L(8); PG8_BAR; PG8_WAIT_L(0); PG8_MMA(0, 0, At, B0); PG8_BAR; PG8_SCHED;
            PG8_LDB(B1, 0, 1); PG8_STAGE(PG8_SB(0, 0), b2, voffB);
            PG8_BAR; PG8_WAIT_L(0); PG8_MMA(0, 1, At, B1); PG8_BAR;
            PG8_LDA(At, 0, 1); PG8_STAGE(PG8_SA(0, 0), a2, voffA);
            PG8_BAR; PG8_WAIT_L(0); PG8_MMA(1, 0, At, B0); PG8_BAR; PG8_SCHED;
            PG8_STAGE(PG8_SB(0, 1), b2 + hstep, voffB);
            PG8_WAIT_V(6); PG8_BAR; PG8_MMA(1, 1, At, B1); PG8_BAR;
            PG8_LDB(B0, 1, 0); PG8_SCHED; PG8_LDA(At, 1, 0); PG8_STAGE(PG8_SA(0, 1), a2 + hstep, voffA);
            PG8_WAIT_L(8); PG8_BAR; PG8_WAIT_L(0); PG8_MMA(0, 0, At, B0); PG8_BAR; PG8_SCHED;
            PG8_LDB(B1, 1, 1); PG8_STAGE(PG8_SB(1, 0), b3, voffB);
            PG8_BAR; PG8_WAIT_L(0); PG8_MMA(0, 1, At, B1); PG8_BAR;
            PG8_LDA(At, 1, 1); PG8_STAGE(PG8_SA(1, 0), a3, voffA);
            PG8_BAR; PG8_WAIT_L(0); PG8_MMA(1, 0, At, B0); PG8_BAR; PG8_SCHED;
            PG8_STAGE(PG8_SB(1, 1), b3 + hstep, voffB);
            PG8_WAIT_V(6); PG8_BAR; PG8_MMA(1, 1, At, B1); PG8_BAR;
            }
        }
        if constexpr (ALIGN_EPI) { if (wr == 0) PG8_BAR; }
        if constexpr (!Epi::AFTER_DRAIN) { E(acc, cur, wr, wc, fr, fq); S.done(cur); }
        if (!has_next) break;
#pragma unroll
        for (int a = 0; a < 2; ++a)
#pragma unroll
            for (int b = 0; b < 2; ++b)
#pragma unroll
                for (int m = 0; m < 4; ++m)
#pragma unroll
                    for (int n = 0; n < 2; ++n) acc[a][b][m][n] = (i32x4){0, 0, 0, 0};
        cur = nxt; cA = nA; cB = nB; ++ui;
        if constexpr (ALIGN_EPI) { if (wr == 1) PG8_BAR; }
    }
    PG8_WAIT_V(0);
    if constexpr (!ALIGN_EPI) { if (wr == 0) PG8_BAR; }
    PG8_BAR;
    if constexpr (Epi::AFTER_DRAIN) { E.fused(acc, cur, wr, wc, fr, fq, lds, wid, lane); S.done(cur); }
#undef PG8_SA
#undef PG8_SB
#undef PG8_STAGE
#undef PG8_LDA
#undef PG8_LDB
#undef PG8_MMA
#undef PG8_WAIT_V
#undef PG8_WAIT_L
#undef PG8_BAR
#undef PG8_SCHED
}
}

#define LAS __attribute__((address_space(3)))
typedef unsigned short bf16;
typedef float f32x2 __attribute__((ext_vector_type(2)));
typedef float f32x4 __attribute__((ext_vector_type(4)));
typedef unsigned u32x2 __attribute__((ext_vector_type(2)));
typedef unsigned u32x4 __attribute__((ext_vector_type(4)));

constexpr int PDIM = 1536;
constexpr int NTOK = 32768, DM = 1024, DIN = 2560, SEQ = 8192, NBATCH = 4, NMETA = 16;
constexpr int NHEAD = 8, NKEYS = 128, TOPK = 16, NSEL = NHEAD * TOPK;
constexpr float EPS = 1e-6f;
constexpr float U_SCALE = 64.f, V_SCALE = 16.f;
constexpr float U4_CLIP = 2.6f;
constexpr int NWAVES = 8, NTHREADS = 512;
constexpr int MKC = 32;
constexpr int LDS_BYTES = 147456;

constexpr size_t MiB = 1u << 20;
constexpr size_t WS_CTL = 0, WS_WIN_T = 1 * MiB, WS_WOUT_T = 6 * MiB, WS_WQ_T = 8 * MiB, WS_KEYS = 12 * MiB, WS_METAPART = 160 * MiB  ,
                 WS_METARSTD = 14 * MiB + 512 * 1024, WS_METAPROJ = 14 * MiB + 576 * 1024, WS_RSTD1 = 15 * MiB, WS_SSQ = 16 * MiB, WS_U8 = 32 * MiB, WS_V8 = 48 * MiB,
                 WS_IDX = 64 * MiB, WS_GATE = 80 * MiB, WS_H0B = 96 * MiB, WS_H2B = 96 * MiB, WS_Y = 160 * MiB, WS_PROJ = 224 * MiB,
                 WS_Q = 224 * MiB, WS_ESCALE = 18 * MiB, WS_SUMQ = 19 * MiB, WS_SX = 20 * MiB, WS_SW = 21 * MiB, WS_SY = 22 * MiB, WS_SWO = 23 * MiB, WS_WMX = 24 * MiB, WS_AMX = 26 * MiB, WS_RF = 28 * MiB, WS_SWQ = 29 * MiB, WS_H0I8 = 384 * MiB, WS_AW = 160 * MiB  , WS_END = 416 * MiB;

struct Params {
    const float* x; const float* meta; const float* g_mix; const float* w_in; const float* sc_w; const float* cf_w; const float* cf_b;
    const float* ln_g; const float* ln_b; const float* g_sc; const float* g_cf; const float* w_out; const float* g_ffn; const float* w_q;
    const float* keys; const float* pu; const float* pv; const float* g_fin;
    float* out; unsigned char* ws;
    int ph_lo, ph_hi, coop, pad;
};

__device__ __forceinline__ unsigned f2bf(float f) { unsigned u = __builtin_bit_cast(unsigned, f); return (u + 0x7fffu + ((u >> 16) & 1u)) >> 16; }
__device__ __forceinline__ unsigned pk2(float lo, float hi) { return f2bf(lo) | (f2bf(hi) << 16); }
__device__ __forceinline__ float bf2f(unsigned b) { return __builtin_bit_cast(float, b << 16); }
__device__ __forceinline__ float bflo(unsigned w) { return __builtin_bit_cast(float, w << 16); }
__device__ __forceinline__ float bfhi(unsigned w) { return __builtin_bit_cast(float, w & 0xffff0000u); }
__device__ __forceinline__ float wave_sum(float v) {
#pragma unroll
    for (int o = 1; o < 64; o <<= 1) v += __shfl_xor(v, o);
    return v;
}
template <int CTRL> __device__ __forceinline__ float dpp_f(float v) { return __builtin_bit_cast(float, __builtin_amdgcn_update_dpp(0, __builtin_bit_cast(int, v), CTRL, 0xf, 0xf, true)); }
__device__ __forceinline__ float wave_sum_fast(float v) {
    v += dpp_f<0xB1>(v); v += dpp_f<0x4E>(v); v += dpp_f<0x141>(v); v += dpp_f<0x140>(v);
    { auto r = __builtin_amdgcn_permlane16_swap(__float_as_uint(v), __float_as_uint(v), false, false); v = __uint_as_float(r[0]) + __uint_as_float(r[1]); }
    { auto r = __builtin_amdgcn_permlane32_swap(__float_as_uint(v), __float_as_uint(v), false, false); v = __uint_as_float(r[0]) + __uint_as_float(r[1]); }
    return v;
}
__device__ __forceinline__ float wave_max_fast(float v) {
    v = fmaxf(v, dpp_f<0xB1>(v)); v = fmaxf(v, dpp_f<0x4E>(v)); v = fmaxf(v, dpp_f<0x141>(v)); v = fmaxf(v, dpp_f<0x140>(v));
    { auto r = __builtin_amdgcn_permlane16_swap(__float_as_uint(v), __float_as_uint(v), false, false); v = fmaxf(__uint_as_float(r[0]), __uint_as_float(r[1])); }
    { auto r = __builtin_amdgcn_permlane32_swap(__float_as_uint(v), __float_as_uint(v), false, false); v = fmaxf(__uint_as_float(r[0]), __uint_as_float(r[1])); }
    return v;
}
__device__ __forceinline__ float sigmoid_f(float x) { return 1.f / (1.f + __expf(-x)); }
__device__ __forceinline__ float gelu_tanh_f(float x) {
    const float t = 0.7978845608028654f * (x + 0.044715f * x * x * x);
    const float e = __expf(2.f * t);
    const float th = 1.f - 2.f / (e + 1.f);
    return 0.5f * x * (1.f + th);
}

__device__ __forceinline__ unsigned cvt_pk_bf16(float lo, float hi) { unsigned r; asm volatile("v_cvt_pk_bf16_f32 %0, %1, %2" : "=v"(r) : "v"(lo), "v"(hi)); return r; }

template <int MODE> struct EpiRowScale {
    static constexpr bool PERM = true, AFTER_DRAIN = false;
    bf16* O; int ldc; const float* rs;
    __device__ __forceinline__ void operator()(const pg8::f32x4 (&acc)[2][2][4][2], const pg8::Unit& u, int wr, int wc, int fr, int fq) const {
        const int row0 = u.pm * 256 + wr * 64 + fr, col0 = u.pn * 256 + wc * 32 + 8 * fq;
#pragma unroll
        for (int ai = 0; ai < 2; ++ai)
#pragma unroll
            for (int m = 0; m < 4; ++m) {
                const int row = row0 + ai * 128 + m * 16;
                float s;
                if (MODE == 0) s = rs[row];
                else { const f32x4* p = (const f32x4*)(rs + (size_t)row * 16); const f32x4 a = p[0], b = p[1], c = p[2], d = p[3];
                       const float t = ((a.x + a.y) + (a.z + a.w)) + ((b.x + b.y) + (b.z + b.w)) + ((c.x + c.y) + (c.z + c.w)) + ((d.x + d.y) + (d.z + d.w));
                       s = rsqrtf(t * (1.f / 1024.f) + EPS); }
                bf16* rowp = O + (size_t)row * ldc + col0;
#pragma unroll
                for (int bj = 0; bj < 2; ++bj) { const pg8::f32x4 v0 = acc[ai][bj][m][0] * s, v1 = acc[ai][bj][m][1] * s;
                    u32x4 w; w.x = cvt_pk_bf16(v0[0], v0[1]); w.y = cvt_pk_bf16(v0[2], v0[3]); w.z = cvt_pk_bf16(v1[0], v1[1]); w.w = cvt_pk_bf16(v1[2], v1[3]);
                    *(u32x4*)(rowp + bj * 128) = w; }
            }
    }
};
struct EpiProj {
    static constexpr bool PERM = true, AFTER_DRAIN = false;
    bf16* O; const float* rs;
    __device__ __forceinline__ void operator()(const pg8::f32x4 (&acc)[2][2][4][2], const pg8::Unit& u, int wr, int wc, int fr, int fq) const {
        const int row0 = u.pm * 256 + wr * 64 + fr, cin = wc * 32 + 8 * fq, pn = u.pn;
#pragma unroll
        for (int ai = 0; ai < 2; ++ai)
#pragma unroll
            for (int m = 0; m < 4; ++m) {
                const int row = row0 + ai * 128 + m * 16; const float sc = rs[row];
                float a[8], b[8];
#pragma unroll
                for (int i = 0; i < 4; ++i) { a[i] = acc[ai][0][m][0][i] * sc; a[4 + i] = acc[ai][0][m][1][i] * sc; b[i] = acc[ai][1][m][0][i] * sc; b[4 + i] = acc[ai][1][m][1][i] * sc; }
                bf16* rowp = O + (size_t)row * PDIM;
                if (pn >= 4 && pn < 6) {
                    u32x4 w0, w1; w0.x = cvt_pk_bf16(a[0], a[1]); w0.y = cvt_pk_bf16(a[2], a[3]); w0.z = cvt_pk_bf16(a[4], a[5]); w0.w = cvt_pk_bf16(a[6], a[7]);
                    w1.x = cvt_pk_bf16(b[0], b[1]); w1.y = cvt_pk_bf16(b[2], b[3]); w1.z = cvt_pk_bf16(b[4], b[5]); w1.w = cvt_pk_bf16(b[6], b[7]);
                    *(u32x4*)(rowp + 512 + 256 * (pn - 4) + cin) = w0; *(u32x4*)(rowp + 512 + 256 * (pn - 4) + 128 + cin) = w1;
                } else {
                    float o[8];
                    if (pn < 4) {
#pragma unroll
                        for (int i = 0; i < 8; ++i) o[i] = a[i] * b[i];
                    } else {
#pragma unroll
                        for (int i = 0; i < 8; ++i) o[i] = a[i] * sigmoid_f(b[i]);
                    }
                    u32x4 w; w.x = cvt_pk_bf16(o[0], o[1]); w.y = cvt_pk_bf16(o[2], o[3]); w.z = cvt_pk_bf16(o[4], o[5]); w.w = cvt_pk_bf16(o[6], o[7]);
                    *(u32x4*)(rowp + (pn < 4 ? 128 * pn : 1024 + 128 * (pn - 6)) + cin) = w;
                }
            }
    }
};
struct EpiProjI8 {
    static constexpr bool PERM = true, AFTER_DRAIN = false;
    bf16* O; const float* rs; const float* sw;
    __device__ __forceinline__ void operator()(const pg8::i32x4 (&acc)[2][2][4][2], const pg8::Unit& u, int wr, int wc, int fr, int fq) const {
        const int row0 = u.pm * 256 + wr * 64 + fr, cin = wc * 32 + 8 * fq, pn = u.pn;
        float swa[8], swb[8];
        { const f32x4 a0 = *(const f32x4*)(sw + 256 * pn + cin), a1 = *(const f32x4*)(sw + 256 * pn + cin + 4), b0 = *(const f32x4*)(sw + 256 * pn + 128 + cin), b1 = *(const f32x4*)(sw + 256 * pn + 128 + cin + 4);
          swa[0] = a0.x; swa[1] = a0.y; swa[2] = a0.z; swa[3] = a0.w; swa[4] = a1.x; swa[5] = a1.y; swa[6] = a1.z; swa[7] = a1.w;
          swb[0] = b0.x; swb[1] = b0.y; swb[2] = b0.z; swb[3] = b0.w; swb[4] = b1.x; swb[5] = b1.y; swb[6] = b1.z; swb[7] = b1.w; }
#pragma unroll
        for (int ai = 0; ai < 2; ++ai)
#pragma unroll
            for (int m = 0; m < 4; ++m) {
                const int row = row0 + ai * 128 + m * 16; const float sc = rs[row];
                float a[8], b[8];
#pragma unroll
                for (int i = 0; i < 4; ++i) { a[i] = (float)acc[ai][0][m][0][i] * (sc * swa[i]); a[4 + i] = (float)acc[ai][0][m][1][i] * (sc * swa[4 + i]);
                    b[i] = (float)acc[ai][1][m][0][i] * (sc * swb[i]); b[4 + i] = (float)acc[ai][1][m][1][i] * (sc * swb[4 + i]); }
                bf16* rowp = O + (size_t)row * PDIM;
                if (pn >= 4 && pn < 6) {
                    u32x4 w0, w1; w0.x = cvt_pk_bf16(a[0], a[1]); w0.y = cvt_pk_bf16(a[2], a[3]); w0.z = cvt_pk_bf16(a[4], a[5]); w0.w = cvt_pk_bf16(a[6], a[7]);
                    w1.x = cvt_pk_bf16(b[0], b[1]); w1.y = cvt_pk_bf16(b[2], b[3]); w1.z = cvt_pk_bf16(b[4], b[5]); w1.w = cvt_pk_bf16(b[6], b[7]);
                    *(u32x4*)(rowp + 512 + 256 * (pn - 4) + cin) = w0; *(u32x4*)(rowp + 512 + 256 * (pn - 4) + 128 + cin) = w1;
                } else {
                    float o[8];
                    if (pn < 4) {
#pragma unroll
                        for (int i = 0; i < 8; ++i) o[i] = a[i] * b[i];
                    } else {
#pragma unroll
                        for (int i = 0; i < 8; ++i) o[i] = a[i] * sigmoid_f(b[i]);
                    }
                    u32x4 w; w.x = cvt_pk_bf16(o[0], o[1]); w.y = cvt_pk_bf16(o[2], o[3]); w.z = cvt_pk_bf16(o[4], o[5]); w.w = cvt_pk_bf16(o[6], o[7]);
                    *(u32x4*)(rowp + (pn < 4 ? 128 * pn : 1024 + 128 * (pn - 6)) + cin) = w;
                }
            }
    }
};
__host__ __device__ __forceinline__ int win_src_col(int n) {
    const int t = n >> 8, j = n & 255;
    if (t < 4) return (j < 128) ? 128 * t + j : 1024 + 128 * t + (j - 128);
    if (t < 6) return 512 + 256 * (t - 4) + j;
    return (j < 128) ? 1536 + 128 * (t - 6) + j : 2048 + 128 * (t - 6) + (j - 128);
}
struct EpiResidual {
    static constexpr bool PERM = true, AFTER_DRAIN = false;
    bf16* O; const signed char* XB; const float* SX; float* ssq;
    __device__ __forceinline__ void operator()(const pg8::f32x4 (&acc)[2][2][4][2], const pg8::Unit& u, int wr, int wc, int fr, int fq) const {
        const int row0 = u.pm * 256 + wr * 64 + fr, col0 = u.pn * 256 + wc * 32 + 8 * fq;
#pragma unroll
        for (int ai = 0; ai < 2; ++ai)
#pragma unroll
            for (int m = 0; m < 4; ++m) {
                const int row = row0 + ai * 128 + m * 16;
                const signed char* xr = XB + (size_t)row * DM + col0; bf16* rowp = O + (size_t)row * DM + col0;
                float q = 0.f;
                u32x2 xw[2]; const float sxr = SX[row];
#pragma unroll
                for (int bj = 0; bj < 2; ++bj) xw[bj] = *(const u32x2*)(xr + bj * 128);
#pragma unroll
                for (int bj = 0; bj < 2; ++bj) {
                    const f32x4 x0 = (f32x4){(float)(signed char)(xw[bj].x), (float)(signed char)(xw[bj].x >> 8), (float)(signed char)(xw[bj].x >> 16), (float)((int)xw[bj].x >> 24)} * sxr,
                                x1 = (f32x4){(float)(signed char)(xw[bj].y), (float)(signed char)(xw[bj].y >> 8), (float)(signed char)(xw[bj].y >> 16), (float)((int)xw[bj].y >> 24)} * sxr;
                    const pg8::f32x4 v0 = acc[ai][bj][m][0] + x0, v1 = acc[ai][bj][m][1] + x1;
                    q += (v0[0] * v0[0] + v0[1] * v0[1]) + (v0[2] * v0[2] + v0[3] * v0[3]) + (v1[0] * v1[0] + v1[1] * v1[1]) + (v1[2] * v1[2] + v1[3] * v1[3]);
                    u32x4 w; w.x = cvt_pk_bf16(v0[0], v0[1]); w.y = cvt_pk_bf16(v0[2], v0[3]); w.z = cvt_pk_bf16(v1[0], v1[1]); w.w = cvt_pk_bf16(v1[2], v1[3]);
                    *(u32x4*)(rowp + bj * 128) = w; }
                q += __shfl_xor(q, 16); q += __shfl_xor(q, 32);
                if (fq == 0) ssq[(size_t)row * 16 + u.pn * 4 + wc] = q;
            }
    }
};

struct EpiResidualI8 {
    static constexpr bool PERM = true, AFTER_DRAIN = false;
    bf16* O; const signed char* XB; const float* SX; const float* SY; const float* SWO; float* ssq; float* amx;
    __device__ __forceinline__ void operator()(const pg8::i32x4 (&acc)[2][2][4][2], const pg8::Unit& u, int wr, int wc, int fr, int fq) const {
        const int row0 = u.pm * 256 + wr * 64 + fr, col0 = u.pn * 256 + wc * 32 + 8 * fq;
        f32x4 sw[2][2];
#pragma unroll
        for (int bj = 0; bj < 2; ++bj) { sw[bj][0] = *(const f32x4*)(SWO + col0 + bj * 128); sw[bj][1] = *(const f32x4*)(SWO + col0 + bj * 128 + 4); }
#pragma unroll
        for (int ai = 0; ai < 2; ++ai)
#pragma unroll
            for (int m = 0; m < 4; ++m) {
                const int row = row0 + ai * 128 + m * 16;
                const signed char* xr = XB + (size_t)row * DM + col0; bf16* rowp = O + (size_t)row * DM + col0;
                float q = 0.f, mxa = 0.f;
                u32x2 xw[2]; const float sxr = SX[row], syr = SY[row];
#pragma unroll
                for (int bj = 0; bj < 2; ++bj) xw[bj] = *(const u32x2*)(xr + bj * 128);
#pragma unroll
                for (int bj = 0; bj < 2; ++bj) {
                    const f32x4 x0 = (f32x4){(float)(signed char)(xw[bj].x), (float)(signed char)(xw[bj].x >> 8), (float)(signed char)(xw[bj].x >> 16), (float)((int)xw[bj].x >> 24)} * sxr,
                                x1 = (f32x4){(float)(signed char)(xw[bj].y), (float)(signed char)(xw[bj].y >> 8), (float)(signed char)(xw[bj].y >> 16), (float)((int)xw[bj].y >> 24)} * sxr;
                    const pg8::i32x4 a0 = acc[ai][bj][m][0], a1 = acc[ai][bj][m][1];
                    const f32x4 v0 = (f32x4){(float)a0[0], (float)a0[1], (float)a0[2], (float)a0[3]} * (sw[bj][0] * syr) + x0, v1 = (f32x4){(float)a1[0], (float)a1[1], (float)a1[2], (float)a1[3]} * (sw[bj][1] * syr) + x1;
                    q += (v0[0] * v0[0] + v0[1] * v0[1]) + (v0[2] * v0[2] + v0[3] * v0[3]) + (v1[0] * v1[0] + v1[1] * v1[1]) + (v1[2] * v1[2] + v1[3] * v1[3]);
                    mxa = fmaxf(mxa, fmaxf(fmaxf(fmaxf(fabsf(v0[0]), fabsf(v0[1])), fmaxf(fabsf(v0[2]), fabsf(v0[3]))), fmaxf(fmaxf(fabsf(v1[0]), fabsf(v1[1])), fmaxf(fabsf(v1[2]), fabsf(v1[3])))));
                    u32x4 w; w.x = cvt_pk_bf16(v0[0], v0[1]); w.y = cvt_pk_bf16(v0[2], v0[3]); w.z = cvt_pk_bf16(v1[0], v1[1]); w.w = cvt_pk_bf16(v1[2], v1[3]);
                    *(u32x4*)(rowp + bj * 128) = w; }
                q += __shfl_xor(q, 16); q += __shfl_xor(q, 32);
                mxa = fmaxf(mxa, __shfl_xor(mxa, 16)); mxa = fmaxf(mxa, __shfl_xor(mxa, 32));
                if (fq == 0) { ssq[(size_t)row * 16 + u.pn * 4 + wc] = q; amx[(size_t)row * 16 + u.pn * 4 + wc] = mxa; }
            }
    }
};
template <bool MAPIN> __device__ __forceinline__ void p0_transpose_item(const float* W, int K, int N, bf16* WT, LAS float* scr, int item, int lane,
                                                  const float* g_lo, const float* g_hi, int split) {
    const int nblk = N / 32, kb = item / nblk, nb = item % nblk, k0 = 64 * kb, n0 = 32 * nb;
#pragma unroll 8
    for (int i = 0; i < 32; ++i) { const int kk = 2 * i + (lane >> 5); const int k = k0 + kk;
        const float g = (k < split) ? g_lo[k] : g_hi[k - split];
        scr[kk * 33 + (lane & 31)] = W[(size_t)k * N + (MAPIN ? win_src_col(n0) : n0) + (lane & 31)] * g; }
    asm volatile("s_waitcnt lgkmcnt(0)" ::: "memory");
    const int c = lane & 7;
#pragma unroll
    for (int j = 0; j < 4; ++j) { const int n = (lane >> 3) + 8 * j; const LAS float* s = scr + (8 * c) * 33 + n;
        u32x4 o; o.x = pk2(s[0 * 33], s[1 * 33]); o.y = pk2(s[2 * 33], s[3 * 33]); o.z = pk2(s[4 * 33], s[5 * 33]); o.w = pk2(s[6 * 33], s[7 * 33]);
        *(u32x4*)(WT + (size_t)(n0 + n) * K + k0 + 8 * c) = o; }
    asm volatile("s_waitcnt lgkmcnt(0)" ::: "memory");
}

constexpr int CW_COLMAX = 5120;
__device__ __forceinline__ void p0_colmax_item(const float* W, int N, unsigned* colmax, int item, int lane, const float* g) {
    const int nblk = N / 32, kb = item / nblk, nb = item % nblk, k0 = 64 * kb, n0 = 32 * nb;
    float mx = 0.f;
#pragma unroll
    for (int i = 0; i < 32; ++i) { const int k = k0 + 2 * i + (lane >> 5); mx = fmaxf(mx, fabsf(W[(size_t)k * N + n0 + (lane & 31)] * g[k])); }
    mx = fmaxf(mx, __shfl_xor(mx, 32));
    if (lane < 32) atomicMax(colmax + n0 + lane, __float_as_uint(mx));
}
__device__ __forceinline__ void p1_quant_item(const float* W, int K, int N, signed char* WT8, float* swout, const unsigned* colmax, LAS float* scr, int item, int lane, const float* g) {
    const int nblk = N / 32, kb = item / nblk, nb = item % nblk, k0 = 64 * kb, n0 = 32 * nb, s0 = win_src_col(n0);
    const float cm = fmaxf(__uint_as_float(colmax[s0 + (lane & 31)]), 1e-30f), inv = 127.f / cm;
    if (kb == 0 && lane < 32) swout[n0 + lane] = cm * (1.f / 127.f);
#pragma unroll
    for (int i = 0; i < 32; ++i) { const int kk = 2 * i + (lane >> 5); const int k = k0 + kk;
        scr[kk * 33 + (lane & 31)] = W[(size_t)k * N + s0 + (lane & 31)] * g[k] * inv; }
    asm volatile("s_waitcnt lgkmcnt(0)" ::: "memory");
    const int c = lane & 7;
#pragma unroll
    for (int j = 0; j < 4; ++j) { const int n = (lane >> 3) + 8 * j; const LAS float* sp = scr + (8 * c) * 33 + n;
        unsigned w0 = 0u, w1 = 0u;
#pragma unroll
        for (int i = 0; i < 4; ++i) { w0 |= ((unsigned)(int)rintf(sp[i * 33]) & 255u) << (8 * i); w1 |= ((unsigned)(int)rintf(sp[(4 + i) * 33]) & 255u) << (8 * i); }
        u32x2 o; o.x = w0; o.y = w1;
        *(u32x2*)(WT8 + (size_t)(n0 + n) * K + k0 + 8 * c) = o; }
    asm volatile("s_waitcnt lgkmcnt(0)" ::: "memory");
}
constexpr int CW_COLMAX3 = 8704;
constexpr int CW_COLMAX2 = 7680;
__device__ __forceinline__ void p0_colmax_item2(const float* W, int N, unsigned* colmax, int item, int lane, const float* g_lo, const float* g_hi, int split) {
    const int nblk = N / 32, kb = item / nblk, nb = item % nblk, k0 = 64 * kb, n0 = 32 * nb;
    float mx = 0.f;
#pragma unroll
    for (int i = 0; i < 32; ++i) { const int k = k0 + 2 * i + (lane >> 5); const float g = (k < split) ? g_lo[k] : g_hi[k - split]; mx = fmaxf(mx, fabsf(W[(size_t)k * N + n0 + (lane & 31)] * g)); }
    mx = fmaxf(mx, __shfl_xor(mx, 32));
    if (lane < 32) atomicMax(colmax + n0 + lane, __float_as_uint(mx));
}
__device__ __forceinline__ void p1_quant_item2(const float* W, int K, int N, signed char* WT8, float* swout, const unsigned* colmax, LAS float* scr, int item, int lane, const float* g_lo, const float* g_hi, int split) {
    const int nblk = N / 32, kb = item / nblk, nb = item % nblk, k0 = 64 * kb, n0 = 32 * nb;
    const float cm = fmaxf(__uint_as_float(colmax[n0 + (lane & 31)]), 1e-30f), inv = 127.f / cm;
    if (kb == 0 && lane < 32) swout[n0 + lane] = cm * (1.f / 127.f);
#pragma unroll
    for (int i = 0; i < 32; ++i) { const int kk = 2 * i + (lane >> 5); const int k = k0 + kk; const float g = (k < split) ? g_lo[k] : g_hi[k - split];
        scr[kk * 33 + (lane & 31)] = W[(size_t)k * N + n0 + (lane & 31)] * g * inv; }
    asm volatile("s_waitcnt lgkmcnt(0)" ::: "memory");
    const int c = lane & 7;
#pragma unroll
    for (int j = 0; j < 4; ++j) { const int n = (lane >> 3) + 8 * j; const LAS float* sp = scr + (8 * c) * 33 + n;
        unsigned w0 = 0u, w1 = 0u;
#pragma unroll
        for (int i = 0; i < 4; ++i) { w0 |= ((unsigned)(int)rintf(sp[i * 33]) & 255u) << (8 * i); w1 |= ((unsigned)(int)rintf(sp[(4 + i) * 33]) & 255u) << (8 * i); }
        u32x2 o; o.x = w0; o.y = w1;
        *(u32x2*)(WT8 + (size_t)(n0 + n) * K + k0 + 8 * c) = o; }
    asm volatile("s_waitcnt lgkmcnt(0)" ::: "memory");
}
__device__ __forceinline__ void phase_winq(const Params& P, LAS unsigned char* lds) {
    const int tid = threadIdx.x, lane = tid & 63, wave = __builtin_amdgcn_readfirstlane(tid >> 6);
    const int gw = blockIdx.x * NWAVES + wave, NGW = gridDim.x * NWAVES;
    LAS float* scr = (LAS float*)(lds + wave * 16384);
    constexpr int NI1 = (DM / 64) * (DIN / 32), NI2 = (DM / 64) * (DM / 32), NI3 = (DM / 64) * (2048 / 32);
    for (int it = gw; it < NI1 + NI2 + NI3; it += NGW) {
        if (it < NI1) p1_quant_item(P.w_in, DM, DIN, (signed char*)(P.ws + WS_WIN_T), (float*)(P.ws + WS_SW), (const unsigned*)(P.ws + WS_CTL) + CW_COLMAX, scr, it, lane, P.g_mix);
        else if (it < NI1 + NI2) p1_quant_item2(P.w_out, DM, DM, (signed char*)(P.ws + WS_WOUT_T), (float*)(P.ws + WS_SWO), (const unsigned*)(P.ws + WS_CTL) + CW_COLMAX2, scr, it - NI1, lane, P.g_sc, P.g_cf, 512);
        else p1_quant_item2(P.w_q, DM, 2048, (signed char*)(P.ws + WS_WQ_T), (float*)(P.ws + WS_SWQ), (const unsigned*)(P.ws + WS_CTL) + CW_COLMAX3, scr, it - NI1 - NI2, lane, P.g_ffn, P.g_ffn, DM);
    }
}
__device__ __forceinline__ float q4(float x, float inv_s) {
    const float a = fabsf(x) * inv_s; float r;
    if (a < 2.f) r = rintf(a * 2.f) * 0.5f; else if (a < 4.f) r = rintf(a); else r = fminf(6.f, rintf(a * 0.5f) * 2.f);
    return copysignf(r, x);
}
__device__ __forceinline__ void phase_prep(const Params& P, LAS unsigned char* lds) {
    const int tid = threadIdx.x, lane = tid & 63, wave = __builtin_amdgcn_readfirstlane(tid >> 6);
    const int gw = blockIdx.x * NWAVES + wave, NGW = gridDim.x * NWAVES;
    unsigned char* ws = P.ws;
    LAS float* scr = (LAS float*)(lds + wave * 16384);
    constexpr int I_IN = (DM / 64) * (DIN / 32), I_OUT = (DM / 64) * (DM / 32), I_Q = (DM / 64) * (2048 / 32);
    for (int it = gw; it < I_IN + I_OUT + I_Q; it += NGW) {
        int r = it;
        if (r < I_IN) { p0_colmax_item(P.w_in, DIN, (unsigned*)(ws + WS_CTL) + CW_COLMAX, r, lane, P.g_mix); continue; } r -= I_IN;
        if (r < I_OUT) { p0_colmax_item2(P.w_out, DM, (unsigned*)(ws + WS_CTL) + CW_COLMAX2, r, lane, P.g_sc, P.g_cf, 512); continue; } r -= I_OUT;
        p0_colmax_item2(P.w_q, 2048, (unsigned*)(ws + WS_CTL) + CW_COLMAX3, r, lane, P.g_ffn, P.g_ffn, DM);
    }
    {
        unsigned* H0I8 = (unsigned*)(ws + WS_H0I8); float* RS1 = (float*)(ws + WS_RSTD1); float* SXp = (float*)(ws + WS_SX);
        for (int t0 = gw * 4; t0 < NTOK; t0 += NGW * 4) {
            f32x4 v[4][4];
#pragma unroll
            for (int q = 0; q < 4; ++q) { const f32x4* xr = (const f32x4*)(P.x + (size_t)(t0 + q) * DM) + lane;
#pragma unroll
                for (int j = 0; j < 4; ++j) v[q][j] = xr[64 * j]; }
#pragma unroll
            for (int q = 0; q < 4; ++q) { float sq = 0.f, mx = 0.f;
#pragma unroll
                for (int j = 0; j < 4; ++j) { sq += (v[q][j].x * v[q][j].x + v[q][j].y * v[q][j].y) + (v[q][j].z * v[q][j].z + v[q][j].w * v[q][j].w);
                    mx = fmaxf(mx, fmaxf(fmaxf(fabsf(v[q][j].x), fabsf(v[q][j].y)), fmaxf(fabsf(v[q][j].z), fabsf(v[q][j].w)))); }
                sq = wave_sum_fast(sq); mx = fmaxf(wave_max_fast(mx), 1e-30f);
                const float sx = mx * (1.f / 127.f), inv = 127.f / mx;
                if (lane == 0) { RS1[t0 + q] = sx * rsqrtf(sq * (1.f / DM) + EPS); SXp[t0 + q] = sx; }
                unsigned* o = H0I8 + (size_t)(t0 + q) * (DM / 4) + lane;
#pragma unroll
                for (int j = 0; j < 4; ++j) { const int a = (int)rintf(v[q][j].x * inv), b = (int)rintf(v[q][j].y * inv), c = (int)rintf(v[q][j].z * inv), d = (int)rintf(v[q][j].w * inv);
                    o[64 * j] = ((unsigned)a & 255u) | (((unsigned)b & 255u) << 8) | (((unsigned)c & 255u) << 16) | ((unsigned)d << 24); } }
        }
    }
    {
        unsigned char* U8 = ws + WS_U8; unsigned char* V8 = ws + WS_V8;
        f32x4 gf[4];
#pragma unroll
        for (int j = 0; j < 4; ++j) gf[j] = ((const f32x4*)P.g_ffn)[64 * j + lane];
        float* ESC = (float*)(ws + WS_ESCALE);
        for (int e0 = gw * 2; e0 < 2 * 16384; e0 += NGW * 2) {
            const bool isv = e0 >= 16384; const int ee0 = isv ? e0 - 16384 : e0;
            f32x4 v[2][4];
#pragma unroll
            for (int q = 0; q < 2; ++q) { const f32x4* src = (const f32x4*)((isv ? P.pv : P.pu) + (size_t)(ee0 + q) * DM);
#pragma unroll
                for (int j = 0; j < 4; ++j) v[q][j] = isv ? src[4 * lane + j] : src[64 * j + lane]; }
#pragma unroll
            for (int q = 0; q < 2; ++q) {
                float mx = 0.f;
#pragma unroll
                for (int j = 0; j < 4; ++j) { if (!isv) v[q][j] = v[q][j] * gf[j];
                    mx = fmaxf(mx, fmaxf(fmaxf(fabsf(v[q][j].x), fabsf(v[q][j].y)), fmaxf(fabsf(v[q][j].z), fabsf(v[q][j].w)))); }
#pragma unroll
                for (int o = 1; o < 64; o <<= 1) mx = fmaxf(mx, __shfl_xor(mx, o));
                if (!isv) {
                    float sq2 = 0.f;
#pragma unroll
                    for (int j = 0; j < 4; ++j) sq2 += (v[q][j].x * v[q][j].x + v[q][j].y * v[q][j].y) + (v[q][j].z * v[q][j].z + v[q][j].w * v[q][j].w);
                    const float rms = sqrtf(wave_sum_fast(sq2) * (1.f / DM));
                    const float su = fmaxf(fminf(mx, U4_CLIP * rms), 1e-30f) * (1.f / 7.f), inv = 1.f / su;
                    unsigned wq[2] = {0u, 0u}; int csum = 0;
#pragma unroll
                    for (int j = 0; j < 4; ++j) { const float e4[4] = {v[q][j].x, v[q][j].y, v[q][j].z, v[q][j].w};
#pragma unroll
                        for (int i = 0; i < 4; ++i) { int c = (int)rintf(fminf(fmaxf(e4[i] * inv, -7.f), 7.f)); csum += c;
                            wq[j >> 1] |= ((unsigned)c & 15u) << (16 * (j & 1) + 4 * i); } }
                    const float cs = wave_sum_fast((float)csum);
                    if (lane == 0) { ESC[e0 + q] = su; ((float*)(ws + WS_SUMQ))[e0 + q] = cs; }
                    u32x2 o; o.x = wq[0]; o.y = wq[1];
                    *(u32x2*)(U8 + (size_t)(ee0 + q) * 512 + 8 * lane) = o;
                    continue;
                }
                const float sc = fmaxf(mx, 1e-30f) * (1.f / 6.f), inv = 1.f / sc;
                if (lane == 0) ESC[e0 + q] = sc;
                unsigned w0 = 0u, w1 = 0u;
                w0 = __builtin_amdgcn_cvt_scalef32_pk_fp4_f32(w0, v[q][0].x * inv, v[q][0].y * inv, 1.0f, 0); w0 = __builtin_amdgcn_cvt_scalef32_pk_fp4_f32(w0, v[q][0].z * inv, v[q][0].w * inv, 1.0f, 1);
                w0 = __builtin_amdgcn_cvt_scalef32_pk_fp4_f32(w0, v[q][1].x * inv, v[q][1].y * inv, 1.0f, 2); w0 = __builtin_amdgcn_cvt_scalef32_pk_fp4_f32(w0, v[q][1].z * inv, v[q][1].w * inv, 1.0f, 3);
                w1 = __builtin_amdgcn_cvt_scalef32_pk_fp4_f32(w1, v[q][2].x * inv, v[q][2].y * inv, 1.0f, 0); w1 = __builtin_amdgcn_cvt_scalef32_pk_fp4_f32(w1, v[q][2].z * inv, v[q][2].w * inv, 1.0f, 1);
                w1 = __builtin_amdgcn_cvt_scalef32_pk_fp4_f32(w1, v[q][3].x * inv, v[q][3].y * inv, 1.0f, 2); w1 = __builtin_amdgcn_cvt_scalef32_pk_fp4_f32(w1, v[q][3].z * inv, v[q][3].w * inv, 1.0f, 3);
                u32x2 o; o.x = w0; o.y = w1;
                *(u32x2*)((isv ? V8 : U8) + (size_t)(ee0 + q) * 512 + 8 * lane) = o;
            }
        }
    }
    {
        bf16* KB = (bf16*)(ws + WS_KEYS);
        const int gt = blockIdx.x * NTHREADS + tid, NGT = gridDim.x * NTHREADS;
        for (int i = gt; i < 8 * 2 * 128 * 128 / 4; i += NGT) { const f32x4 v = ((const f32x4*)P.keys)[i]; u32x2 w; w.x = pk2(v.x, v.y); w.y = pk2(v.z, v.w); ((u32x2*)KB)[i] = w; }
    }
    {
        float* MP = (float*)(ws + WS_METAPART); float* MR = (float*)(ws + WS_METARSTD);
        for (int r = gw; r < NMETA; r += NGW) {
            float s = 0.f;
            for (int k = lane; k < DM; k += 64) { const float v = P.meta[r * DM + k]; s += v * v; }
            s = wave_sum(s);
            if (lane == 0) MR[r] = rsqrtf(s * (1.f / DM) + EPS);
        }
        for (int it = gw; it < MKC * 40; it += NGW) {
            const int kc = it / 40, nb = it % 40, n = nb * 64 + lane;
            float acc[NMETA];
#pragma unroll
            for (int r = 0; r < NMETA; ++r) acc[r] = 0.f;
            for (int k = kc * (DM / MKC); k < (kc + 1) * (DM / MKC); ++k) {
                const float w = P.w_in[(size_t)k * DIN + n] * P.g_mix[k];
#pragma unroll
                for (int r = 0; r < NMETA; ++r) acc[r] += P.meta[r * DM + k] * w;
            }
#pragma unroll
            for (int r = 0; r < NMETA; ++r) MP[(size_t)(kc * 16 + r) * DIN + n] = acc[r];
        }
    }
}

__device__ __forceinline__ float metaraw(const float* MP, const float* MR, int p, int col) { float s = 0.f;
#pragma unroll 8
    for (int kc = 0; kc < MKC; ++kc) s += MP[(size_t)(kc * 16 + p) * DIN + col];
    return s * MR[p]; }
__device__ __forceinline__ void phase_metaproj(const Params& P) {
    const float* MP = (const float*)(P.ws + WS_METAPART); const float* MR = (const float*)(P.ws + WS_METARSTD); float* MJ = (float*)(P.ws + WS_METAPROJ);
    for (int gt = blockIdx.x * NTHREADS + threadIdx.x; gt < NMETA * PDIM; gt += gridDim.x * NTHREADS) { const int p = gt / PDIM, c = gt % PDIM; float v;
        if (c < 512) v = metaraw(MP, MR, p, c) * metaraw(MP, MR, p, 1024 + c);
        else if (c < 1024) v = metaraw(MP, MR, p, c);
        else v = metaraw(MP, MR, p, 1536 + (c - 1024)) * sigmoid_f(metaraw(MP, MR, p, 2048 + (c - 1024)));
        MJ[gt] = v; }
}
__device__ __forceinline__ float meta_val(const float* MJ, const float*, int p, int col) { return MJ[p * PDIM + col]; }
__device__ __forceinline__ float proj_at(const bf16* PROJ, const float* MP, const float* MR, int b, int pos, int col) {
    if (pos < 0) return 0.f;
    if (pos < NMETA) return meta_val(MP, MR, pos, col);
    return bf2f(PROJ[(size_t)(b * SEQ + pos - NMETA) * PDIM + col]);
}
__device__ __forceinline__ void proj8_at(const bf16* PROJ, const float* MP, const float* MR, int b, int pos, int col, float (&v)[8]) {
    if (pos < 0) {
#pragma unroll
        for (int i = 0; i < 8; ++i) v[i] = 0.f;
    } else if (pos < NMETA) {
        const f32x4 a = *(const f32x4*)(MP + pos * PDIM + col), bq = *(const f32x4*)(MP + pos * PDIM + col + 4);
        v[0] = a.x; v[1] = a.y; v[2] = a.z; v[3] = a.w; v[4] = bq.x; v[5] = bq.y; v[6] = bq.z; v[7] = bq.w;
    } else {
        const u32x4 w = *(const u32x4*)(PROJ + (size_t)(b * SEQ + pos - NMETA) * PDIM + col);
        v[0] = bflo(w.x); v[1] = bfhi(w.x); v[2] = bflo(w.y); v[3] = bfhi(w.y); v[4] = bflo(w.z); v[5] = bfhi(w.z); v[6] = bflo(w.w); v[7] = bfhi(w.w);
    }
}

template <int R> __device__ __forceinline__ void conv_rows(const LAS unsigned char* ubase, const f32x2 (&wcf)[31], f32x2 (&acc)[32]) {
    if constexpr (R < 62) {
        const unsigned uw = *(const LAS unsigned*)(ubase + R * 1024);
        const f32x2 x = (f32x2){bflo(uw), bfhi(uw)};
        constexpr int lo = R > 30 ? R - 30 : 0, hi = R < 31 ? R : 31;
#pragma unroll
        for (int ii = lo; ii <= hi; ++ii) acc[ii] += wcf[R - ii] * x;
        conv_rows<R + 1>(ubase, wcf, acc);
    }
}
__device__ __forceinline__ void phase_conv(const Params& P, LAS unsigned char* lds) {
    const int tid = threadIdx.x, lane = tid & 63, wave = __builtin_amdgcn_readfirstlane(tid >> 6);
    unsigned char* ws = P.ws;
    const bf16* PROJ = (const bf16*)(ws + WS_PROJ); const float* MP = (const float*)(ws + WS_METAPROJ); const float* MR = nullptr;
    bf16* Y = (bf16*)(ws + WS_Y);
    constexpr int TT = 64, NTILE = NTOK / TT, UROWS = TT + 30;
    const int cgp = wave & 3, th = wave >> 2, ch2 = cgp * 128 + 2 * lane;
    f32x2 wcf[31];
#pragma unroll
    for (int j = 0; j < 31; ++j) wcf[j] = *(const f32x2*)(P.cf_w + j * 512 + ch2);
    const f32x2 bcf = *(const f32x2*)(P.cf_b + ch2);
    for (int tile = blockIdx.x; tile < NTILE; tile += gridDim.x) {
        const int b = tile / (SEQ / TT), s0 = (tile % (SEQ / TT)) * TT;
#pragma unroll 4
        for (int p = 0; p < (UROWS + 7) / 8; ++p) {
            const int r = p * 8 + wave;
            if (r < UROWS) {
                const int pos = NMETA + s0 - 30 + r;
                float uu[8];
                proj8_at(PROJ, MP, MR, b, pos, 1024 + 8 * lane, uu);
                u32x4 w; w.x = pk2(uu[0], uu[1]); w.y = pk2(uu[2], uu[3]); w.z = pk2(uu[4], uu[5]); w.w = pk2(uu[6], uu[7]);
                *(LAS u32x4*)(lds + r * 1024 + lane * 16) = w;
            }
        }
        __syncthreads();
        f32x2 acc[32];
#pragma unroll
        for (int ii = 0; ii < 32; ++ii) acc[ii] = bcf;
        conv_rows<0>(lds + (32 * th) * 1024 + ch2 * 2, wcf, acc);
        u32x4 rcx[8], rbg[8];
        { const bf16* pr = PROJ + ((size_t)b * SEQ + s0 + 8 * wave) * PDIM + 8 * lane;
#pragma unroll
          for (int q = 0; q < 8; ++q) { rcx[q] = *(const u32x4*)(pr + (size_t)q * PDIM); rbg[q] = *(const u32x4*)(pr + (size_t)q * PDIM + 512); } }
        __syncthreads();
#pragma unroll
        for (int ii = 0; ii < 32; ++ii) *(LAS f32x2*)(lds + (32 * th + ii) * 2048 + ch2 * 4) = acc[ii];
        __syncthreads();
        {
            float lng[8], lnb[8];
            { const f32x4 a = *(const f32x4*)(P.ln_g + 8 * lane), c = *(const f32x4*)(P.ln_g + 8 * lane + 4), d = *(const f32x4*)(P.ln_b + 8 * lane), e = *(const f32x4*)(P.ln_b + 8 * lane + 4);
              lng[0] = a.x; lng[1] = a.y; lng[2] = a.z; lng[3] = a.w; lng[4] = c.x; lng[5] = c.y; lng[6] = c.z; lng[7] = c.w;
              lnb[0] = d.x; lnb[1] = d.y; lnb[2] = d.z; lnb[3] = d.w; lnb[4] = e.x; lnb[5] = e.y; lnb[6] = e.z; lnb[7] = e.w; }
            float wsc[3][8];
#pragma unroll
            for (int j = 0; j < 3; ++j) { const f32x4 a = *(const f32x4*)(P.sc_w + j * 512 + 8 * lane), c = *(const f32x4*)(P.sc_w + j * 512 + 8 * lane + 4);
                wsc[j][0] = a.x; wsc[j][1] = a.y; wsc[j][2] = a.z; wsc[j][3] = a.w; wsc[j][4] = c.x; wsc[j][5] = c.y; wsc[j][6] = c.z; wsc[j][7] = c.w; }
            float cxa[8], cxb[8];
            { const int pos = NMETA + s0 + 8 * wave - 2;
              proj8_at(PROJ, MP, MR, b, pos, 8 * lane, cxa); proj8_at(PROJ, MP, MR, b, pos + 1, 8 * lane, cxb); }
#pragma unroll
            for (int q = 0; q < 8; ++q) {
                const int ii = 8 * wave + q, s = s0 + ii; const size_t t = (size_t)b * SEQ + s;
                float o[8];
                { const f32x4 a = *(const LAS f32x4*)(lds + ii * 2048 + lane * 32), c = *(const LAS f32x4*)(lds + ii * 2048 + lane * 32 + 16);
                  o[0] = a.x; o[1] = a.y; o[2] = a.z; o[3] = a.w; o[4] = c.x; o[5] = c.y; o[6] = c.z; o[7] = c.w; }
                float s1 = 0.f;
#pragma unroll
                for (int i = 0; i < 8; ++i) s1 += o[i];
                const float mean = wave_sum_fast(s1) * (1.f / 512.f);
                float s2 = 0.f;
#pragma unroll
                for (int i = 0; i < 8; ++i) { o[i] -= mean; s2 += o[i] * o[i]; }
                const float rs = rsqrtf(wave_sum_fast(s2) * (1.f / 512.f) + EPS);
                float s3 = 0.f;
#pragma unroll
                for (int i = 0; i < 8; ++i) { float y = o[i] * rs * lng[i] + lnb[i]; y = y * sigmoid_f(y); o[i] = y; s3 += y * y; }
                const float r2 = rsqrtf(wave_sum_fast(s3) * (1.f / 512.f) + EPS);
                float bgv[8], cxc[8], accs[8];
                { const u32x4 w = rcx[q], z = rbg[q];
                  cxc[0] = bflo(w.x); cxc[1] = bfhi(w.x); cxc[2] = bflo(w.y); cxc[3] = bfhi(w.y); cxc[4] = bflo(w.z); cxc[5] = bfhi(w.z); cxc[6] = bflo(w.w); cxc[7] = bfhi(w.w);
                  bgv[0] = bflo(z.x); bgv[1] = bfhi(z.x); bgv[2] = bflo(z.y); bgv[3] = bfhi(z.y); bgv[4] = bflo(z.z); bgv[5] = bfhi(z.z); bgv[6] = bflo(z.w); bgv[7] = bfhi(z.w); }
                float s4 = 0.f;
#pragma unroll
                for (int i = 0; i < 8; ++i) { accs[i] = bgv[i] * (wsc[0][i] * cxa[i] + wsc[1][i] * cxb[i] + wsc[2][i] * cxc[i]); s4 += accs[i] * accs[i]; cxa[i] = cxb[i]; cxb[i] = cxc[i]; }
                const float r4 = rsqrtf(wave_sum_fast(s4) * (1.f / 512.f) + EPS);
                float ym = 0.f;
#pragma unroll
                for (int i = 0; i < 8; ++i) { o[i] *= r2; accs[i] *= r4; ym = fmaxf(ym, fmaxf(fabsf(o[i]), fabsf(accs[i]))); }
                ym = fmaxf(wave_max_fast(ym), 1e-30f);
                const float yinv = 127.f / ym;
                if (lane == 0) ((float*)(ws + WS_SY))[t] = ym * (1.f / 127.f);
                u32x2 wz, wv;
                wz.x = ((unsigned)(int)rintf(accs[0] * yinv) & 255u) | (((unsigned)(int)rintf(accs[1] * yinv) & 255u) << 8) | (((unsigned)(int)rintf(accs[2] * yinv) & 255u) << 16) | ((unsigned)(int)rintf(accs[3] * yinv) << 24);
                wz.y = ((unsigned)(int)rintf(accs[4] * yinv) & 255u) | (((unsigned)(int)rintf(accs[5] * yinv) & 255u) << 8) | (((unsigned)(int)rintf(accs[6] * yinv) & 255u) << 16) | ((unsigned)(int)rintf(accs[7] * yinv) << 24);
                wv.x = ((unsigned)(int)rintf(o[0] * yinv) & 255u) | (((unsigned)(int)rintf(o[1] * yinv) & 255u) << 8) | (((unsigned)(int)rintf(o[2] * yinv) & 255u) << 16) | ((unsigned)(int)rintf(o[3] * yinv) << 24);
                wv.y = ((unsigned)(int)rintf(o[4] * yinv) & 255u) | (((unsigned)(int)rintf(o[5] * yinv) & 255u) << 8) | (((unsigned)(int)rintf(o[6] * yinv) & 255u) << 16) | ((unsigned)(int)rintf(o[7] * yinv) << 24);
                *(u32x2*)(ws + WS_Y + t * DM + 8 * lane) = wz;
                *(u32x2*)(ws + WS_Y + t * DM + 512 + 8 * lane) = wv;
            }
        }
        __syncthreads();
    }
}

__device__ __forceinline__ int ord_i(float s) { int k = __builtin_bit_cast(int, s); k ^= (k >> 31) & 0x7fffffff; return k; }
__device__ __forceinline__ float unord_f(int k) { k ^= (k >> 31) & 0x7fffffff; return __builtin_bit_cast(float, k); }
#define TOP_INSERT(L, x_) do { int _x = (x_); _Pragma("unroll") for (int _i = 0; _i < 16; ++_i) { const int _hi = max(L[_i], _x); _x = min(L[_i], _x); L[_i] = _hi; } } while (0)

typedef short bf16x8 __attribute__((ext_vector_type(8)));
typedef float f32x16 __attribute__((ext_vector_type(16)));
template <bool DESC> __device__ __forceinline__ void ce_i(int& a, int& b) { const int hi = max(a, b), lo = min(a, b); if (DESC) { a = hi; b = lo; } else { a = lo; b = hi; } }
__device__ __forceinline__ void bitonic_sort16(int (&a)[16]) {
#pragma unroll
    for (int k = 2; k <= 16; k <<= 1)
#pragma unroll
        for (int j = k >> 1; j > 0; j >>= 1)
#pragma unroll
            for (int i = 0; i < 16; ++i) { const int l = i ^ j; if (l > i) { if ((i & k) == 0) ce_i<true>(a[i], a[l]); else ce_i<false>(a[i], a[l]); } }
}
__device__ __forceinline__ void bitonic_merge16(int (&a)[16]) {
#pragma unroll
    for (int j = 8; j > 0; j >>= 1)
#pragma unroll
        for (int i = 0; i < 16; ++i) { const int l = i ^ j; if (l > i) ce_i<true>(a[i], a[l]); }
}
__device__ __forceinline__ void merge_top16(int (&a)[16], const int (&b)[16]) {
#pragma unroll
    for (int i = 0; i < 16; ++i) a[i] = max(a[i], b[15 - i]);
    bitonic_merge16(a);
}
__device__ __forceinline__ int lut16(const unsigned (&T)[4], int i) {
    const unsigned sel = (unsigned)(i & 7) | 0x0c0c0c00u;
    const unsigned lo = __builtin_amdgcn_perm(T[1], T[0], sel), hi = __builtin_amdgcn_perm(T[3], T[2], sel);
    return (int)((i & 8) ? hi : lo);
}
constexpr int KROW = 272;
constexpr float SCORE_BIAS = 8.0f;

__device__ __forceinline__ void route_load_q(bf16x8 (&qf)[8], const bf16* qrow, int hb) {
#pragma unroll
    for (int ks = 0; ks < 8; ++ks) qf[ks] = *(const bf16x8*)(qrow + 64 * hb + 8 * ks);
}
__device__ __forceinline__ void route_half(const LAS unsigned char* kl, const bf16x8 (&qf)[8], int nl, int hb, int (&L)[16]) {
    f32x16 acc[4];
#pragma unroll
    for (int nt = 0; nt < 4; ++nt)
#pragma unroll
        for (int r = 0; r < 16; ++r) acc[nt][r] = SCORE_BIAS;
#pragma unroll
    for (int ks = 0; ks < 8; ++ks)
#pragma unroll
        for (int nt = 0; nt < 4; ++nt) {
            const bf16x8 a = *(const LAS bf16x8*)(kl + (32 * nt + nl) * KROW + (64 * hb + 8 * ks) * 2);
            acc[nt] = __builtin_amdgcn_mfma_f32_32x32x16_bf16(a, qf[ks], acc[nt], 0, 0, 0);
        }
    const int hb4 = 4 * hb;
    int T[4][16];
#pragma unroll
    for (int nt = 0; nt < 4; ++nt)
#pragma unroll
        for (int r = 0; r < 16; ++r) { const int n0 = 32 * nt + (r & 3) + 8 * (r >> 2); const float sc = acc[nt][r];
            T[nt][r] = (__float_as_int(sc) & ~127) | ((127 - n0) - hb4); }
    bitonic_sort16(T[0]); bitonic_sort16(T[1]); bitonic_sort16(T[2]); bitonic_sort16(T[3]);
    merge_top16(T[0], T[1]); merge_top16(T[2], T[3]); merge_top16(T[0], T[2]);
#pragma unroll
    for (int i = 0; i < 16; ++i) { const unsigned v = (unsigned)T[0][15 - i]; auto r = __builtin_amdgcn_permlane32_swap(v, v, false, false);
        const unsigned r0 = r[0], r1 = r[1]; const int partner = (int)(hb ? r0 : r1); L[i] = max(T[0][i], partner); }
    bitonic_merge16(L);
}

__device__ __forceinline__ void phase_route(const Params& P, LAS unsigned char* lds) {
    const int tid = threadIdx.x, lane = tid & 63, wave = __builtin_amdgcn_readfirstlane(tid >> 6);
    const int nl = lane & 31, hb = lane >> 5;
    unsigned char* ws = P.ws;
    const bf16* KEYS = (const bf16*)(ws + WS_KEYS); const bf16* Q = (const bf16*)(ws + WS_Q);
    int* IDX = (int*)(ws + WS_IDX); float* GATE = (float*)(ws + WS_GATE);
    int last_h = -1;
    pg8::StaticOrder S; S.init(NTOK, 2048, (int)gridDim.x, (int)blockIdx.x);
    pg8::Unit ucur, unxt;
    bool have = S.next(0, ucur);
    bf16x8 qfA[8], qfB[8];
    if (have) route_load_q(qfA, Q + ((size_t)ucur.pm * 256 + wave * 32 + nl) * 2048 + ucur.pn * 256, hb);
    for (int ui = 0; have; ++ui) {
        const int h = ucur.pn, tb = ucur.pm;
        const bool have_next = S.next(ui + 1, unxt);
        if (h != last_h) {
            __syncthreads();
            for (int c = tid; c < 4096; c += NTHREADS) { const u32x4 v = ((const u32x4*)(KEYS + (size_t)h * 32768))[c];
                *(LAS u32x4*)(lds + (c >> 4) * KROW + (c & 15) * 16) = v; }
            __syncthreads();
            last_h = h;
        }
        const size_t t = (size_t)tb * 256 + wave * 32 + nl;
        int L1[16], L2[16];
        route_load_q(qfB, Q + t * 2048 + h * 256 + 128, hb);
        route_half(lds, qfA, nl, hb, L1);
        if (have_next) route_load_q(qfA, Q + ((size_t)unxt.pm * 256 + wave * 32 + nl) * 2048 + unxt.pn * 256, hb);
        route_half(lds + 128 * KROW, qfB, nl, hb, L2);
        float v1[16], v2[16];
#pragma unroll
        for (int i = 0; i < 16; ++i) { v1[i] = __int_as_float(L1[i] & ~127); v2[i] = __int_as_float(L2[i] & ~127); }
#define CAND(i, j) ((__float_as_int(v1[i] + v2[j]) & ~255) | (255 - (16 * (i) + (j))))
        int A[16], B[16], C[16];
#pragma unroll
        for (int j = 0; j < 16; ++j) A[j] = CAND(0, j);
#pragma unroll
        for (int j = 0; j < 8; ++j) { B[j] = CAND(1, j); B[8 + j] = CAND(15 - j, 0); }
        bitonic_merge16(B);
        C[0] = CAND(2, 0); C[1] = CAND(2, 1); C[2] = CAND(2, 2); C[3] = CAND(2, 3); C[4] = CAND(2, 4);
        C[5] = CAND(3, 0); C[6] = CAND(3, 1); C[7] = CAND(3, 2); C[8] = CAND(3, 3);
        C[9] = CAND(4, 0); C[10] = CAND(4, 1); C[11] = CAND(4, 2);
        C[12] = CAND(5, 0); C[13] = CAND(5, 1); C[14] = CAND(6, 0); C[15] = CAND(6, 1);
        bitonic_sort16(C);
        { const int d0 = CAND(7, 0), d1 = CAND(7, 1); C[14] = max(C[14], d1); C[15] = max(C[15], d0); bitonic_merge16(C); }
#undef CAND
        merge_top16(A, B); merge_top16(A, C);
        unsigned T1[4], T2[4];
#pragma unroll
        for (int q = 0; q < 4; ++q) {
            T1[q] = (unsigned)(127 - (L1[4 * q] & 127)) | ((unsigned)(127 - (L1[4 * q + 1] & 127)) << 8) | ((unsigned)(127 - (L1[4 * q + 2] & 127)) << 16) | ((unsigned)(127 - (L1[4 * q + 3] & 127)) << 24);
            T2[q] = (unsigned)(127 - (L2[4 * q] & 127)) | ((unsigned)(127 - (L2[4 * q + 1] & 127)) << 8) | ((unsigned)(127 - (L2[4 * q + 2] & 127)) << 16) | ((unsigned)(127 - (L2[4 * q + 3] & 127)) << 24); }
        float val[16]; int ex[16];
#pragma unroll
        for (int k = 0; k < 16; ++k) { const int pos = 255 - (A[k] & 255); val[k] = __int_as_float(A[k] & ~255);
            ex[k] = lut16(T1, pos >> 4) * NKEYS + lut16(T2, pos & 15); }
        float sum = 0.f; const float vmax = val[0];
#pragma unroll
        for (int k = 0; k < 16; ++k) { val[k] = __expf(val[k] - vmax); sum += val[k]; }
        const float inv = 1.f / sum;
        if (hb == 0) {
            int* ip = IDX + t * NSEL + h * TOPK; float* gp = GATE + t * NSEL + h * TOPK;
#pragma unroll
            for (int k4 = 0; k4 < 4; ++k4) {
                *(int4*)(ip + 4 * k4) = make_int4(ex[4 * k4], ex[4 * k4 + 1], ex[4 * k4 + 2], ex[4 * k4 + 3]);
                *(f32x4*)(gp + 4 * k4) = (f32x4){val[4 * k4] * inv, val[4 * k4 + 1] * inv, val[4 * k4 + 2] * inv, val[4 * k4 + 3] * inv};
            }
        }
        ucur = unxt; have = have_next;
    }
}

#define FP4X2(w, sel) __builtin_amdgcn_cvt_scalef32_pk_f32_fp4((w), 1.0f, (sel))
__device__ __forceinline__ float dot16_fp4(const u32x2 r, const f32x4 (&xs)[4]) {
    float p = 0.f;
    { const f32x2 a = FP4X2(r.x, 0), b = FP4X2(r.x, 1), c = FP4X2(r.x, 2), d = FP4X2(r.x, 3);
      p += (a.x * xs[0].x + a.y * xs[0].y) + (b.x * xs[0].z + b.y * xs[0].w); p += (c.x * xs[1].x + c.y * xs[1].y) + (d.x * xs[1].z + d.y * xs[1].w); }
    { const f32x2 a = FP4X2(r.y, 0), b = FP4X2(r.y, 1), c = FP4X2(r.y, 2), d = FP4X2(r.y, 3);
      p += (a.x * xs[2].x + a.y * xs[2].y) + (b.x * xs[2].z + b.y * xs[2].w); p += (c.x * xs[3].x + c.y * xs[3].y) + (d.x * xs[3].z + d.y * xs[3].w); }
    return p;
}
__device__ __forceinline__ void axpy16_fp4(const u32x2 r, float w, f32x4 (&o)[4]) {
    { const f32x2 a = FP4X2(r.x, 0), b = FP4X2(r.x, 1), c = FP4X2(r.x, 2), d = FP4X2(r.x, 3);
      o[0].x += w * a.x; o[0].y += w * a.y; o[0].z += w * b.x; o[0].w += w * b.y; o[1].x += w * c.x; o[1].y += w * c.y; o[1].z += w * d.x; o[1].w += w * d.y; }
    { const f32x2 a = FP4X2(r.y, 0), b = FP4X2(r.y, 1), c = FP4X2(r.y, 2), d = FP4X2(r.y, 3);
      o[2].x += w * a.x; o[2].y += w * a.y; o[2].z += w * b.x; o[2].w += w * b.y; o[3].x += w * c.x; o[3].y += w * c.y; o[3].z += w * d.x; o[3].w += w * d.y; }
}
__device__ __forceinline__ float swap32_add(float a, float b) { auto r = __builtin_amdgcn_permlane32_swap(__float_as_uint(a), __float_as_uint(b), false, false); return __uint_as_float(r[0]) + __uint_as_float(r[1]); }
__device__ __forceinline__ float swap16_add(float a, float b) { auto r = __builtin_amdgcn_permlane16_swap(__float_as_uint(a), __float_as_uint(b), false, false); return __uint_as_float(r[0]) + __uint_as_float(r[1]); }
__device__ __forceinline__ float row_sum16(float v) { v += dpp_f<0xB1>(v); v += dpp_f<0x4E>(v); v += dpp_f<0x141>(v); v += dpp_f<0x140>(v); return v; }
__device__ __forceinline__ float row_max16(float v) { v = fmaxf(v, dpp_f<0xB1>(v)); v = fmaxf(v, dpp_f<0x4E>(v)); v = fmaxf(v, dpp_f<0x141>(v)); v = fmaxf(v, dpp_f<0x140>(v)); return v; }
constexpr int GB = 32;
typedef __attribute__((address_space(8))) void* rsrc_t;
__device__ __forceinline__ void g_issue(u32x2 (&buf)[GB], __amdgpu_buffer_rsrc_t rs, int idxr, int lb, int voff) {
#pragma unroll
    for (int j = 0; j < GB; ++j) { const int e = __builtin_amdgcn_readlane(idxr, lb + j); buf[j] = __builtin_amdgcn_raw_buffer_load_b64(rs, voff, e * 512, 0); }
}
__device__ __forceinline__ float dot16_fp4p(const u32x2 r, const f32x2 (&xp)[8]) {
    f32x2 a = FP4X2(r.x, 0) * xp[0];
    a += FP4X2(r.x, 1) * xp[1]; a += FP4X2(r.x, 2) * xp[2]; a += FP4X2(r.x, 3) * xp[3];
    a += FP4X2(r.y, 0) * xp[4]; a += FP4X2(r.y, 1) * xp[5]; a += FP4X2(r.y, 2) * xp[6]; a += FP4X2(r.y, 3) * xp[7];
    return a.x + a.y;
}
__device__ __forceinline__ void axpy16_fp4p(const u32x2 r, float w, f32x2 (&o)[8]) {
    const f32x2 ww = (f32x2){w, w};
    o[0] += FP4X2(r.x, 0) * ww; o[1] += FP4X2(r.x, 1) * ww; o[2] += FP4X2(r.x, 2) * ww; o[3] += FP4X2(r.x, 3) * ww;
    o[4] += FP4X2(r.y, 0) * ww; o[5] += FP4X2(r.y, 1) * ww; o[6] += FP4X2(r.y, 2) * ww; o[7] += FP4X2(r.y, 3) * ww;
}
template <int H> __device__ __forceinline__ void g_compute_u(const u32x2 (&buf)[GB], int q, int i16, const f32x2 (&xp)[8], float& zlo, float& zhi) {
    float p[16];
#pragma unroll
    for (int j = 0; j < 16; ++j) p[j] = dot16_fp4p(buf[16 * H + j], xp);
    float s1[8], s2[4];
#pragma unroll
    for (int m = 0; m < 8; ++m) s1[m] = swap32_add(p[2 * m], p[2 * m + 1]);
#pragma unroll
    for (int n = 0; n < 4; ++n) s2[n] = swap16_add(s1[2 * n], s1[2 * n + 1]);
#pragma unroll
    for (int r = 0; r < 4; ++r) { const float z = row_sum16(s2[r]); const bool mine = i16 == ((4 * q + r) & 15);
        zlo = (mine && q < 4) ? z : zlo; zhi = (mine && q >= 4) ? z : zhi; }
}
template <int H> __device__ __forceinline__ void g_compute_v(const u32x2 (&buf)[GB], int q, float alo, float ahi, f32x2 (&o)[8]) {
    const int areg = __builtin_bit_cast(int, (q < 4) ? alo : ahi), sb = 4 * (q & 3);
#pragma unroll
    for (int j = 0; j < 16; ++j) { const int src = 32 * (j & 1) + 16 * ((j >> 1) & 1) + (j >> 2) + sb;
        const float w = __builtin_bit_cast(float, __builtin_amdgcn_readlane(areg, src));
        axpy16_fp4p(buf[16 * H + j], w, o); }
}
__device__ __forceinline__ void q_issue(u32x2 (&buf)[16], __amdgpu_buffer_rsrc_t rs, int ixr  , int lb, int voff) {
#pragma unroll
    for (int j = 0; j < 16; ++j) { const int e9 = __builtin_amdgcn_readlane(ixr, lb + j); buf[j] = __builtin_amdgcn_raw_buffer_load_b64(rs, voff, e9, 0); }
}
__device__ __forceinline__ void q_compute_u(const u32x2 (&buf)[16], int q, int i16, const f32x2 (&xp)[8], float& zlo, float& zhi) {
    float p[16];
#pragma unroll
    for (int j = 0; j < 16; ++j) p[j] = dot16_fp4p(buf[j], xp);
    float s1[8], s2[4];
#pragma unroll
    for (int m = 0; m < 8; ++m) s1[m] = swap32_add(p[2 * m], p[2 * m + 1]);
#pragma unroll
    for (int n = 0; n < 4; ++n) s2[n] = swap16_add(s1[2 * n], s1[2 * n + 1]);
#pragma unroll
    for (int r = 0; r < 4; ++r) { const float z = row_sum16(s2[r]); const bool mine = i16 == ((4 * q + r) & 15);
        zlo = (mine && q < 4) ? z : zlo; zhi = (mine && q >= 4) ? z : zhi; }
}
typedef _Float16 h16x2 __attribute__((ext_vector_type(2)));
#define FP4H2(w, sel) __builtin_amdgcn_cvt_scalef32_pk_f16_fp4((w), 1.0f, (sel))
__device__ __forceinline__ void axpy16_fp4h(const u32x2 r, const h16x2 ww, h16x2 (&o)[8]) {
    o[0] += FP4H2(r.x, 0) * ww; o[1] += FP4H2(r.x, 1) * ww; o[2] += FP4H2(r.x, 2) * ww; o[3] += FP4H2(r.x, 3) * ww;
    o[4] += FP4H2(r.y, 0) * ww; o[5] += FP4H2(r.y, 1) * ww; o[6] += FP4H2(r.y, 2) * ww; o[7] += FP4H2(r.y, 3) * ww;
}
__device__ __forceinline__ void q_compute_vh(const u32x2 (&buf)[16], int q, int alo, int ahi, h16x2 (&o)[8]) {
    const int areg = (q < 4) ? alo : ahi, sb = 4 * (q & 3);
#pragma unroll
    for (int j = 0; j < 16; ++j) { const int src = 32 * (j & 1) + 16 * ((j >> 1) & 1) + (j >> 2) + sb;
        const h16x2 w = __builtin_bit_cast(h16x2, __builtin_amdgcn_readlane(areg, src));
        axpy16_fp4h(buf[j], w, o); }
}
__device__ __forceinline__ void q_compute_v(const u32x2 (&buf)[16], int q, float alo, float ahi, f32x2 (&o)[8]) {
    const int areg = __builtin_bit_cast(int, (q < 4) ? alo : ahi), sb = 4 * (q & 3);
#pragma unroll
    for (int j = 0; j < 16; ++j) { const int src = 32 * (j & 1) + 16 * ((j >> 1) & 1) + (j >> 2) + sb;
        const float w = __builtin_bit_cast(float, __builtin_amdgcn_readlane(areg, src));
        axpy16_fp4p(buf[j], w, o); }
}
__device__ __forceinline__ int swap32_addi(int a, int b) { auto r = __builtin_amdgcn_permlane32_swap((unsigned)a, (unsigned)b, false, false); const unsigned r0 = r[0], r1 = r[1]; return (int)(r0 + r1); }
__device__ __forceinline__ int swap16_addi(int a, int b) { auto r = __builtin_amdgcn_permlane16_swap((unsigned)a, (unsigned)b, false, false); const unsigned r0 = r[0], r1 = r[1]; return (int)(r0 + r1); }
template <int CTRL> __device__ __forceinline__ int dpp_i(int v) { return __builtin_amdgcn_update_dpp(0, v, CTRL, 0xf, 0xf, true); }
__device__ __forceinline__ int row_sum16i(int v) { v += dpp_i<0xB1>(v); v += dpp_i<0x4E>(v); v += dpp_i<0x141>(v); v += dpp_i<0x140>(v); return v; }
__device__ __forceinline__ void q_compute_ui(const u32x2 (&buf)[16], int q, int i16, int xh0, int xh1, int xl0, int xl1, int& zlo, int& zhi) {
    int p[16];
#pragma unroll
    for (int j = 0; j < 16; ++j) { const int d1 = __builtin_amdgcn_sdot8((int)buf[j].x, xh0, __builtin_amdgcn_sdot8((int)buf[j].y, xh1, 0, false), false);
        const int d2 = __builtin_amdgcn_sdot8((int)buf[j].x, xl0, __builtin_amdgcn_sdot8((int)buf[j].y, xl1, 0, false), false);
        p[j] = (d1 << 4) + d2; }
    int s1[8], s2[4];
#pragma unroll
    for (int m = 0; m < 8; ++m) s1[m] = swap32_addi(p[2 * m], p[2 * m + 1]);
#pragma unroll
    for (int n = 0; n < 4; ++n) s2[n] = swap16_addi(s1[2 * n], s1[2 * n + 1]);
#pragma unroll
    for (int r = 0; r < 4; ++r) { const int z = row_sum16i(s2[r]); const bool mine = i16 == ((4 * q + r) & 15);
        zlo = (mine && q < 4) ? z : zlo; zhi = (mine && q >= 4) ? z : zhi; }
}
__device__ __forceinline__ void phase_gather_u(const Params& P) {
    const int tid = threadIdx.x, lane = tid & 63, wave = __builtin_amdgcn_readfirstlane(tid >> 6);
    const int gw = blockIdx.x * NWAVES + wave, NGW = gridDim.x * NWAVES;
    unsigned char* ws = P.ws;
    const int* IDX = (const int*)(ws + WS_IDX); const float* GATE = (const float*)(ws + WS_GATE); const float* ESC = (const float*)(ws + WS_ESCALE); float* AW = (float*)(ws + WS_AW);
    const __amdgpu_buffer_rsrc_t rsU = __builtin_amdgcn_make_buffer_rsrc((void*)(ws + WS_U8), 0, 16384 * 512, 0x00020000);
    const bf16* H2B = (const bf16*)(ws + WS_H2B); const float* SSQ = (const float*)(ws + WS_SSQ);
    const int hh = lane >> 5, rr = (lane >> 4) & 1, i16 = lane & 15, gsel = 4 * i16 + 2 * rr + hh;
    const int voff = 8 * lane;
    const unsigned ul = (unsigned)lane;
    int t = gw;
    if (t < NTOK) {
        int idx0, idx1; u32x2 hraw[4]; float sqv;
        { const int* ip = IDX + (size_t)t * NSEL; idx0 = ip[ul]; idx1 = ip[64u + ul];
          const u32x2* hp = (const u32x2*)(H2B + (size_t)t * DM);
#pragma unroll
          for (int j = 0; j < 4; ++j) hraw[j] = hp[64u * j + ul];
          sqv = (SSQ + (size_t)t * 16)[ul & 15u]; }
        u32x2 R0[16], R1[16], R2[16], R3[16];
        { const int ix0 = idx0 << 9; q_issue(R0, rsU, ix0, 0, voff); q_issue(R1, rsU, ix0, 16, voff); q_issue(R2, rsU, ix0, 32, voff); }
        for (;;) {
            const int tn = t + NGW; const bool has_next = tn < NTOK; const int tl = has_next ? tn : t;
            int idx0n, idx1n; u32x2 hrawn[4]; float sqn, g0, g1;
            { const int* ip = IDX + (size_t)tl * NSEL; idx0n = ip[ul]; idx1n = ip[64u + ul];
              const u32x2* hp = (const u32x2*)(H2B + (size_t)tl * DM);
#pragma unroll
              for (int j = 0; j < 4; ++j) hrawn[j] = hp[64u * j + ul];
              sqn = (SSQ + (size_t)tl * 16)[ul & 15u];
              const float* gp = GATE + (size_t)t * NSEL; g0 = gp[ul]; g1 = gp[64u + ul]; }
            const float su0 = ESC[idx0], su1 = ESC[idx1], sv0 = ESC[16384 + idx0], sv1 = ESC[16384 + idx1];
            const float cq0 = ((const float*)(ws + WS_SUMQ))[idx0], cq1 = ((const float*)(ws + WS_SUMQ))[idx1];
            const float rstd2 = rsqrtf(row_sum16(sqv) * (1.f / DM) + EPS);
            float xf[16];
#pragma unroll
            for (int j = 0; j < 4; ++j) { xf[4 * j] = bflo(hraw[j].x); xf[4 * j + 1] = bfhi(hraw[j].x); xf[4 * j + 2] = bflo(hraw[j].y); xf[4 * j + 3] = bfhi(hraw[j].y); }
            float am = 0.f;
#pragma unroll
            for (int e = 0; e < 16; ++e) am = fmaxf(am, fabsf(xf[e]));
            am = fmaxf(wave_max_fast(am), 1e-30f);
            const float xinv = 127.f / am, xscale = am * (1.f / 127.f);
            unsigned xh[2] = {0u, 0u}, xl[2] = {0u, 0u};
#pragma unroll
            for (int j = 0; j < 4; ++j)
#pragma unroll
                for (int i = 0; i < 4; ++i) { const int xi = (int)rintf(xf[4 * j + i] * xinv); const int sh = 16 * (j & 1) + 4 * i;
                    xh[j >> 1] |= ((unsigned)(xi >> 4) & 15u) << sh; xl[j >> 1] |= ((unsigned)((xi & 15) - 8) & 15u) << sh; }
            int zlo = 0, zhi = 0;
            const int ix0 = idx0 << 9, ix1 = idx1 << 9;
#pragma unroll 1
            for (int qq = 0; qq < 8; qq += 4) {
                const int ixn = qq ? (idx0n << 9) : ix1;
                q_issue(R3, rsU, qq ? ix1 : ix0, 48, voff);
                q_compute_ui(R0, qq, i16, (int)xh[0], (int)xh[1], (int)xl[0], (int)xl[1], zlo, zhi);
                q_issue(R0, rsU, ixn, 0, voff);
                q_compute_ui(R1, qq + 1, i16, (int)xh[0], (int)xh[1], (int)xl[0], (int)xl[1], zlo, zhi);
                q_issue(R1, rsU, ixn, 16, voff);
                q_compute_ui(R2, qq + 2, i16, (int)xh[0], (int)xh[1], (int)xl[0], (int)xl[1], zlo, zhi);
                q_issue(R2, rsU, ixn, 32, voff);
                q_compute_ui(R3, qq + 3, i16, (int)xh[0], (int)xh[1], (int)xl[0], (int)xl[1], zlo, zhi);
            }
            const float glo = __shfl(g0, gsel), ghi = __shfl(g1, gsel), sulo = __shfl(su0, gsel), suhi = __shfl(su1, gsel), svlo = __shfl(sv0, gsel), svhi = __shfl(sv1, gsel);
            const float cqlo = __shfl(cq0, gsel), cqhi = __shfl(cq1, gsel);
            const float zfl = ((float)zlo + 8.f * cqlo) * (sulo * xscale * rstd2), zfh = ((float)zhi + 8.f * cqhi) * (suhi * xscale * rstd2);
            const float wl = gelu_tanh_f(zfl) * glo * svlo, wh = gelu_tanh_f(zfh) * ghi * svhi;
            const float wmx = fmaxf(wave_max_fast(fmaxf(fabsf(wl), fabsf(wh))), 1e-30f), wsc = 256.f / wmx;
            { const float a = wl * wsc, c = wh * wsc;
              const int ah = __builtin_amdgcn_cvt_pk_fp8_f32(a, a, 0, false) & 255, ch = __builtin_amdgcn_cvt_pk_fp8_f32(c, c, 0, false) & 255;
              const float ar = a - __builtin_amdgcn_cvt_f32_fp8(ah, 0), cr = c - __builtin_amdgcn_cvt_f32_fp8(ch, 0);
              const int al = __builtin_amdgcn_cvt_pk_fp8_f32(ar, ar, 0, false) & 255, cl = __builtin_amdgcn_cvt_pk_fp8_f32(cr, cr, 0, false) & 255;
              unsigned char* ap = (unsigned char*)AW + (size_t)t * 256;
              ap[gsel] = (unsigned char)ah; ap[64 + gsel] = (unsigned char)ch; ap[128 + gsel] = (unsigned char)al; ap[192 + gsel] = (unsigned char)cl;
              if (lane == 0) ((float*)(ws + WS_WMX))[t] = wmx * (1.f / 256.f); }
            if (!has_next) break;
            t = tn; idx0 = idx0n; idx1 = idx1n; sqv = sqn;
#pragma unroll
            for (int j = 0; j < 4; ++j) hraw[j] = hrawn[j];
        }
    }
}
__device__ __forceinline__ void phase_gather_v(const Params& P) {
    const int tid = threadIdx.x, lane = tid & 63, wave = __builtin_amdgcn_readfirstlane(tid >> 6);
    const int gw = blockIdx.x * NWAVES + wave, NGW = gridDim.x * NWAVES;
    unsigned char* ws = P.ws;
    const int* IDX = (const int*)(ws + WS_IDX); const float* AW = (const float*)(ws + WS_AW);
    const __amdgpu_buffer_rsrc_t rsV = __builtin_amdgcn_make_buffer_rsrc((void*)(ws + WS_V8), 0, 16384 * 512, 0x00020000);
    const bf16* H2B = (const bf16*)(ws + WS_H2B);
    const int voff = 8 * lane;
    const unsigned ul = (unsigned)lane;
    int t = gw;
    if (t < NTOK) {
        int idx0, idx1; u32x2 hraw[4]; float alo, ahi;
        { const int* ip = IDX + (size_t)t * NSEL; idx0 = ip[ul]; idx1 = ip[64u + ul];
          const u32x2* hp = (const u32x2*)(H2B + (size_t)t * DM);
#pragma unroll
          for (int j = 0; j < 4; ++j) hraw[j] = hp[64u * j + ul];
          const float* ap = AW + (size_t)t * NSEL; alo = ap[ul]; ahi = ap[64u + ul]; }
        u32x2 R0[16], R1[16], R2[16], R3[16];
        { const int ix0 = idx0 << 9; q_issue(R0, rsV, ix0, 0, voff); q_issue(R1, rsV, ix0, 16, voff); q_issue(R2, rsV, ix0, 32, voff); }
        for (;;) {
            const int tn = t + NGW; const bool has_next = tn < NTOK; const int tl = has_next ? tn : t;
            int idx0n, idx1n; u32x2 hrawn[4]; float alon, ahin;
            { const int* ip = IDX + (size_t)tl * NSEL; idx0n = ip[ul]; idx1n = ip[64u + ul];
              const u32x2* hp = (const u32x2*)(H2B + (size_t)tl * DM);
#pragma unroll
              for (int j = 0; j < 4; ++j) hrawn[j] = hp[64u * j + ul];
              const float* ap = AW + (size_t)tl * NSEL; alon = ap[ul]; ahin = ap[64u + ul]; }
            const float wmx = fmaxf(wave_max_fast(fmaxf(fabsf(alo), fabsf(ahi))), 1e-30f), winv = 1.f / wmx;
            int alh, ahh;
            { const h16x2 a = (h16x2){(_Float16)(alo * winv), (_Float16)(alo * winv)}, b = (h16x2){(_Float16)(ahi * winv), (_Float16)(ahi * winv)};
              alh = __builtin_bit_cast(int, a); ahh = __builtin_bit_cast(int, b); }
            h16x2 oh[8];
#pragma unroll
            for (int j = 0; j < 8; ++j) oh[j] = (h16x2){(_Float16)0.f, (_Float16)0.f};
            const int ix0 = idx0 << 9, ix1 = idx1 << 9;
#pragma unroll 1
            for (int qq = 0; qq < 8; qq += 4) {
                const int ixn = qq ? (idx0n << 9) : ix1;
                q_issue(R3, rsV, qq ? ix1 : ix0, 48, voff);
                q_compute_vh(R0, qq, alh, ahh, oh);
                q_issue(R0, rsV, ixn, 0, voff);
                q_compute_vh(R1, qq + 1, alh, ahh, oh);
                q_issue(R1, rsV, ixn, 16, voff);
                q_compute_vh(R2, qq + 2, alh, ahh, oh);
                q_issue(R2, rsV, ixn, 32, voff);
                q_compute_vh(R3, qq + 3, alh, ahh, oh);
            }
            f32x2 o[8];
#pragma unroll
            for (int j = 0; j < 8; ++j) o[j] = (f32x2){(float)oh[j].x * wmx, (float)oh[j].y * wmx};
            float ss = 0.f;
#pragma unroll
            for (int j = 0; j < 4; ++j) { o[2 * j] += (f32x2){bflo(hraw[j].x), bfhi(hraw[j].x)}; o[2 * j + 1] += (f32x2){bflo(hraw[j].y), bfhi(hraw[j].y)}; }
#pragma unroll
            for (int j = 0; j < 8; ++j) ss += o[j].x * o[j].x + o[j].y * o[j].y;
            ss = wave_sum_fast(ss);
            const float r3 = rsqrtf(ss * (1.f / DM) + EPS);
            f32x4* op = (f32x4*)(P.out + (size_t)t * DM);
            const f32x4* gfp = (const f32x4*)P.g_fin;
#pragma unroll
            for (int j = 0; j < 4; ++j) { const f32x4 gv = gfp[64u * j + ul]; op[64u * j + ul] = (f32x4){o[2 * j].x * r3 * gv.x, o[2 * j].y * r3 * gv.y, o[2 * j + 1].x * r3 * gv.z, o[2 * j + 1].y * r3 * gv.w}; }
            if (!has_next) break;
            t = tn; idx0 = idx0n; idx1 = idx1n; alo = alon; ahi = ahin;
#pragma unroll
            for (int j = 0; j < 4; ++j) hraw[j] = hrawn[j];
        }
    }
}


typedef int i32x2v __attribute__((ext_vector_type(2)));
typedef int i32x8v __attribute__((ext_vector_type(8)));
#define VM_X 9
#define VM_WAIT(n) asm volatile("s_waitcnt vmcnt(" #n ")" ::: "memory")
__device__ __forceinline__ void phase_gather_v_mfma(const Params& P, LAS unsigned char* lds) {
    const int tid = threadIdx.x, lane = tid & 63, wave = __builtin_amdgcn_readfirstlane(tid >> 6);
    unsigned char* ws = P.ws;
    const int* IDX = (const int*)(ws + WS_IDX);
    const unsigned char* V8 = ws + WS_V8; const unsigned char* AW8 = ws + WS_AW; const float* WMX = (const float*)(ws + WS_WMX);
    const unsigned short* H2S = (const unsigned short*)(ws + WS_H2B);
    const int TPB = NTOK / (int)gridDim.x, t0 = blockIdx.x * TPB, NST = TPB * 4;
    const int r0 = 16 * wave + (lane >> 3), r1 = r0 + 8;
    const unsigned c0 = 16u * (unsigned)((lane & 7) ^ ((r0 >> 1) & 7)), c1 = 16u * (unsigned)((lane & 7) ^ ((r1 >> 1) & 7));
    const int i16 = lane & 15, kb = lane >> 4;
    const int ra = 32 * kb + i16, rb = ra + 16;
    const unsigned offa = (unsigned)(ra * 128 + 16 * (wave ^ ((ra >> 1) & 7))), offb = (unsigned)(rb * 128 + 16 * (wave ^ ((rb >> 1) & 7)));
    const unsigned aoffb = (unsigned)(((i16 & 1) ? 128 : 0) + 16 * kb);
    const bool arow = (i16 & 3) < 2;
    const int colb = 256 * kb + 32 * wave + i16;
    const float gf0 = P.g_fin[colb], gf1 = P.g_fin[colb + 16];
    LAS float* SS = (LAS float*)(lds + 131072 + 1024);
    const unsigned lbase = (unsigned)(unsigned long long)lds;
    struct VTok { u32x4 a, b; float w; unsigned h0, h1; };
    VTok C0, C1;
    int ia1, ib1, ia2, ib2, ia3, ib3;
#define VM_ISSUE(g, e0, e1) do { LAS unsigned char* _d = lds + (((g) & 7) * 16384) + wave * 2048; const unsigned _cb = 128u * (unsigned)((g) & 3); \
        __builtin_amdgcn_global_load_lds((const unsigned*)(V8 + (size_t)(e0) * 512 + _cb + c0), (LAS unsigned*)(_d), 16, 0, 0); \
        __builtin_amdgcn_global_load_lds((const unsigned*)(V8 + (size_t)(e1) * 512 + _cb + c1), (LAS unsigned*)(_d + 1024), 16, 0, 0); } while (0)
    {
        const int ia0 = IDX[(size_t)t0 * NSEL + r0], ib0 = IDX[(size_t)t0 * NSEL + r1];
        ia1 = IDX[(size_t)(t0 + 1) * NSEL + r0]; ib1 = IDX[(size_t)(t0 + 1) * NSEL + r1];
        ia2 = IDX[(size_t)(t0 + 2) * NSEL + r0]; ib2 = IDX[(size_t)(t0 + 2) * NSEL + r1];
        ia3 = IDX[(size_t)(t0 + 3) * NSEL + r0]; ib3 = IDX[(size_t)(t0 + 3) * NSEL + r1];
        const unsigned char* ap = AW8 + (size_t)t0 * 256 + aoffb;
        C0.a = *(const u32x4*)ap; C0.b = *(const u32x4*)(ap + 64); C0.w = WMX[t0]; C0.h0 = H2S[(size_t)t0 * DM + colb]; C0.h1 = H2S[(size_t)t0 * DM + colb + 16];
        C1.a = *(const u32x4*)(ap + 256); C1.b = *(const u32x4*)(ap + 256 + 64); C1.w = WMX[t0 + 1]; C1.h0 = H2S[(size_t)(t0 + 1) * DM + colb]; C1.h1 = H2S[(size_t)(t0 + 1) * DM + colb + 16];
        asm volatile("s_waitcnt vmcnt(0)" ::: "memory");
        VM_ISSUE(0, ia0, ib0); VM_ISSUE(1, ia0, ib0); VM_ISSUE(2, ia0, ib0); VM_ISSUE(3, ia0, ib0);
        VM_ISSUE(4, ia1, ib1); VM_ISSUE(5, ia1, ib1); VM_ISSUE(6, ia1, ib1);
    }
    float pv0 = 0.f, pv1 = 0.f;
    VTok N0, N1; int na4, nb4, na5, nb5;
    auto token = [&](const int i, const bool even, const VTok& C, const int e1a, const int e1b, const int e2a, const int e2b) __attribute__((always_inline)) {
        const int t = t0 + i;
        const u32x4 z = (u32x4){0u, 0u, 0u, 0u}; const u32x4 Alo = arow ? C.a : z, Ahi = arow ? C.b : z;
        const i32x8v A = (i32x8v){(int)Alo.x, (int)Alo.y, (int)Alo.z, (int)Alo.w, (int)Ahi.x, (int)Ahi.y, (int)Ahi.z, (int)Ahi.w};
        f32x4 acc[4][2];
#pragma unroll
        for (int cc = 0; cc < 4; ++cc) {
            const int g = 4 * i + cc;
            if (even && cc == 0) { VM_WAIT(12); } else { VM_WAIT(26); }
            asm volatile("s_waitcnt lgkmcnt(0)" ::: "memory");
            __builtin_amdgcn_s_barrier();
            __builtin_amdgcn_sched_barrier(0);
            const unsigned sa = lbase + (unsigned)((g & 7) * 16384) + offa, sbb = lbase + (unsigned)((g & 7) * 16384) + offb;
            i32x2v b00, b01, b10, b11;
            asm volatile("ds_read_b64_tr_b4 %0, %4\n\tds_read_b64_tr_b4 %1, %5\n\tds_read_b64_tr_b4 %2, %4 offset:8\n\tds_read_b64_tr_b4 %3, %5 offset:8"
                         : "=&v"(b00), "=&v"(b01), "=&v"(b10), "=&v"(b11) : "v"(sa), "v"(sbb) : "memory");
            { const int gn = g + 7;
              if (cc == 0) VM_ISSUE(gn, e1a, e1b); else VM_ISSUE(gn, e2a, e2b); }
            __builtin_amdgcn_sched_barrier(0);
            if (cc == 0) {
                if (even) {
                    const int tA = t0 + ((i + 2 < TPB) ? i + 2 : TPB - 2), tI = t0 + ((i + 4 < TPB) ? i + 4 : TPB - 2);
                    const unsigned char* ap = AW8 + (size_t)tA * 256 + aoffb; const float* wp = WMX + tA; const int* ipa = IDX + (size_t)tI * NSEL + r0; const unsigned short* hp = H2S + (size_t)tA * DM + colb;
                    asm volatile("global_load_dwordx4 %0, %14, off\n\tglobal_load_dwordx4 %1, %14, off offset:64\n\tglobal_load_dwordx4 %2, %14, off offset:256\n\tglobal_load_dwordx4 %3, %14, off offset:320\n\t"
                                 "global_load_dword %4, %15, off\n\tglobal_load_dword %5, %15, off offset:4\n\t"
                                 "global_load_ushort %6, %17, off\n\tglobal_load_ushort %7, %17, off offset:32\n\tglobal_load_ushort %8, %17, off offset:2048\n\tglobal_load_ushort %9, %17, off offset:2080\n\t"
                                 "global_load_dword %10, %16, off\n\tglobal_load_dword %11, %16, off offset:32\n\tglobal_load_dword %12, %16, off offset:512\n\tglobal_load_dword %13, %16, off offset:544"
                                 : "=&v"(N0.a), "=&v"(N0.b), "=&v"(N1.a), "=&v"(N1.b), "=&v"(N0.w), "=&v"(N1.w), "=&v"(N0.h0), "=&v"(N0.h1), "=&v"(N1.h0), "=&v"(N1.h1), "=&v"(na4), "=&v"(nb4), "=&v"(na5), "=&v"(nb5)
                                 : "v"(ap), "v"(wp), "v"(ipa), "v"(hp) : "memory");
                }
                { const f32x4 s0 = *(const LAS f32x4*)(SS + 8 * ((i + 1) & 1)), s1 = *(const LAS f32x4*)(SS + 8 * ((i + 1) & 1) + 4);
                  const float ss = ((s0.x + s0.y) + (s0.z + s0.w)) + ((s1.x + s1.y) + (s1.z + s1.w));
                  const float r3 = rsqrtf(ss * (1.f / DM) + EPS);
                  float* op = P.out + (size_t)((i > 0) ? t - 1 : t) * DM + colb;
                  op[0] = pv0 * r3 * gf0; op[16] = pv1 * r3 * gf1; }
                __builtin_amdgcn_sched_barrier(0);
            }
            asm volatile("s_waitcnt lgkmcnt(0)" : "+v"(b00), "+v"(b01), "+v"(b10), "+v"(b11) :: "memory");
            const i32x8v B0 = (i32x8v){b00.x, b00.y, b01.x, b01.y, 0, 0, 0, 0}, B1 = (i32x8v){b10.x, b10.y, b11.x, b11.y, 0, 0, 0, 0};
            const f32x4 z4 = (f32x4){0.f, 0.f, 0.f, 0.f};
            acc[cc][0] = __builtin_amdgcn_mfma_scale_f32_16x16x128_f8f6f4(A, B0, z4, 0  , 4  , 0, 0x7f7f7f7f, 0, 0x7f7f7f7f);
            acc[cc][1] = __builtin_amdgcn_mfma_scale_f32_16x16x128_f8f6f4(A, B1, z4, 0, 4, 0, 0x7f7f7f7f, 0, 0x7f7f7f7f);
        }
#pragma unroll
        for (int c = 0; c < 4; ++c) asm volatile("" :: "v"(acc[c][0]), "v"(acc[c][1]));
        float s0 = acc[0][0].x + acc[0][0].y, s1 = acc[0][1].x + acc[0][1].y;
        { const float a0 = acc[1][0].x + acc[1][0].y, a1 = acc[1][1].x + acc[1][1].y, b0 = acc[2][0].x + acc[2][0].y, b1 = acc[2][1].x + acc[2][1].y, d0 = acc[3][0].x + acc[3][0].y, d1 = acc[3][1].x + acc[3][1].y;
          s0 = (kb == 1) ? a0 : s0; s1 = (kb == 1) ? a1 : s1; s0 = (kb == 2) ? b0 : s0; s1 = (kb == 2) ? b1 : s1; s0 = (kb == 3) ? d0 : s0; s1 = (kb == 3) ? d1 : s1; }
        pv0 = s0 * C.w + __uint_as_float(C.h0 << 16); pv1 = s1 * C.w + __uint_as_float(C.h1 << 16);
        const float sq = wave_sum_fast(pv0 * pv0 + pv1 * pv1);
        if (lane == 0) SS[8 * (i & 1) + wave] = sq;
    };
#pragma unroll 1
    for (int i = 0; i < TPB; i += 2) {
        token(i, true, C0, ia1, ib1, ia2, ib2);
        token(i + 1, false, C1, ia2, ib2, ia3, ib3);
        asm volatile("s_waitcnt vmcnt(14)" : "+v"(N0.a), "+v"(N0.b), "+v"(N1.a), "+v"(N1.b), "+v"(N0.w), "+v"(N1.w), "+v"(N0.h0), "+v"(N0.h1), "+v"(N1.h0), "+v"(N1.h1), "+v"(na4), "+v"(nb4), "+v"(na5), "+v"(nb5) :: "memory");
        C0 = N0; C1 = N1; ia1 = ia3; ib1 = ib3; ia2 = na4; ib2 = nb4; ia3 = na5; ib3 = nb5;
    }
    asm volatile("s_waitcnt vmcnt(0)" ::: "memory");
    __builtin_amdgcn_s_barrier();
    { const int i = TPB; const f32x4 s0 = *(const LAS f32x4*)(SS + 8 * ((i + 1) & 1)), s1 = *(const LAS f32x4*)(SS + 8 * ((i + 1) & 1) + 4);
      const float ss = ((s0.x + s0.y) + (s0.z + s0.w)) + ((s1.x + s1.y) + (s1.z + s1.w));
      const float r3 = rsqrtf(ss * (1.f / DM) + EPS);
      float* op = P.out + (size_t)(t0 + TPB - 1) * DM + colb;
      op[0] = pv0 * r3 * gf0; op[16] = pv1 * r3 * gf1; }
#undef VM_ISSUE
}

__device__ __forceinline__ void phase_quant_h2(const Params& P) {
    const int tid = threadIdx.x, lane = tid & 63, wave = __builtin_amdgcn_readfirstlane(tid >> 6);
    const int gw = blockIdx.x * NWAVES + wave, NGW = gridDim.x * NWAVES;
    unsigned char* ws = P.ws;
    const float* SSQ = (const float*)(ws + WS_SSQ); const float* AMX = (const float*)(ws + WS_AMX); float* RF = (float*)(ws + WS_RF);
    for (int row = gw; row < NTOK; row += NGW) {
        const u32x4* hp = (const u32x4*)(ws + WS_H2B + (size_t)row * DM * 2) + 2 * lane;
        const u32x4 a = hp[0], b = hp[1];
        const float am = fmaxf(row_max16(AMX[(size_t)row * 16 + (lane & 15)]), 1e-30f) * 1.0078125f;
        const float rstd2 = rsqrtf(row_sum16(SSQ[(size_t)row * 16 + (lane & 15)]) * (1.f / DM) + EPS);
        const float inv = 127.f / am;
        const unsigned w[8] = {a.x, a.y, a.z, a.w, b.x, b.y, b.z, b.w};
        unsigned o[4];
#pragma unroll
        for (int j = 0; j < 4; ++j) {
            const int q0 = (int)rintf(__uint_as_float(w[2 * j] << 16) * inv), q1 = (int)rintf(__uint_as_float(w[2 * j] & 0xffff0000u) * inv);
            const int q2 = (int)rintf(__uint_as_float(w[2 * j + 1] << 16) * inv), q3 = (int)rintf(__uint_as_float(w[2 * j + 1] & 0xffff0000u) * inv);
            o[j] = ((unsigned)q0 & 255u) | (((unsigned)q1 & 255u) << 8) | (((unsigned)q2 & 255u) << 16) | ((unsigned)q3 << 24); }
        u32x4 ov; ov.x = o[0]; ov.y = o[1]; ov.z = o[2]; ov.w = o[3];
        *((u32x4*)(ws + WS_H0I8 + (size_t)row * DM) + lane) = ov;
        if (lane == 0) RF[row] = am * (1.f / 127.f) * rstd2;
    }
}
struct EpiQI8 {
    static constexpr bool PERM = true, AFTER_DRAIN = false;
    bf16* O; int ldc; const float* rf; const float* sw;
    __device__ __forceinline__ void operator()(const pg8::i32x4 (&acc)[2][2][4][2], const pg8::Unit& u, int wr, int wc, int fr, int fq) const {
        const int row0 = u.pm * 256 + wr * 64 + fr, col0 = u.pn * 256 + wc * 32 + 8 * fq;
        f32x4 swv[2][2];
#pragma unroll
        for (int bj = 0; bj < 2; ++bj) { swv[bj][0] = *(const f32x4*)(sw + col0 + bj * 128); swv[bj][1] = *(const f32x4*)(sw + col0 + bj * 128 + 4); }
#pragma unroll
        for (int ai = 0; ai < 2; ++ai)
#pragma unroll
            for (int m = 0; m < 4; ++m) {
                const int row = row0 + ai * 128 + m * 16;
                const float s = rf[row];
                bf16* rowp = O + (size_t)row * ldc + col0;
#pragma unroll
                for (int bj = 0; bj < 2; ++bj) { const pg8::i32x4 a0 = acc[ai][bj][m][0], a1 = acc[ai][bj][m][1];
                    const f32x4 v0 = (f32x4){(float)a0[0], (float)a0[1], (float)a0[2], (float)a0[3]} * (swv[bj][0] * s), v1 = (f32x4){(float)a1[0], (float)a1[1], (float)a1[2], (float)a1[3]} * (swv[bj][1] * s);
                    u32x4 w; w.x = cvt_pk_bf16(v0[0], v0[1]); w.y = cvt_pk_bf16(v0[2], v0[3]); w.z = cvt_pk_bf16(v1[0], v1[1]); w.w = cvt_pk_bf16(v1[2], v1[3]);
                    *(u32x4*)(rowp + bj * 128) = w; }
            }
    }
};
#define XB_TMO      128
#define XB_XCNT(j)  (256  + 64 * (j))
#define XB_XSUB(j)  (1280 + 64 * (j))
#define XB_XGEN(j)  (2304 + 64 * (j))
#define XB_TOP      3328
#define XB_TOPGEN   3392
#define XCD_BAR_WORDS 3456
#define XB_SPIN_CAP (1u << 18)

__device__ __forceinline__ unsigned xb_ld(unsigned* p)              { return __hip_atomic_load(p, __ATOMIC_RELAXED, __HIP_MEMORY_SCOPE_AGENT); }
__device__ __forceinline__ unsigned xb_add(unsigned* p, unsigned v) { return __hip_atomic_fetch_add(p, v, __ATOMIC_RELAXED, __HIP_MEMORY_SCOPE_AGENT); }
__device__ __forceinline__ unsigned xb_xcc_id() { return (unsigned)__builtin_amdgcn_s_getreg((3 << 11) | 20) & 0xFu; }
#define XB_SPIN(cond, bar) do { unsigned _sp = 0; while (cond) { __builtin_amdgcn_s_sleep(1); \
    if ((++_sp & 255u) == 0u) { if (xb_ld(&(bar)[XB_TMO])) break; if (_sp > XB_SPIN_CAP) { atomicAdd(&(bar)[XB_TMO], 1u); break; } } } } while (0)

struct XcdBarrier {
    unsigned* bar; unsigned x;
    volatile LAS unsigned* st;
};

__device__ __forceinline__ XcdBarrier xcd_barrier_post(unsigned* bar, volatile LAS unsigned* st) {
    XcdBarrier b; b.bar = bar; b.x = xb_xcc_id(); b.st = st;
    if (threadIdx.x == 0) (void)xb_add(&bar[XB_XCNT(b.x)], 1u);
    return b;
}
__device__ __forceinline__ void xcd_barrier_complete(unsigned* bar, unsigned x, unsigned& nloc, unsigned& nx) {
    const unsigned G = gridDim.x * gridDim.y * gridDim.z;
    unsigned sum, cnt, mine, sp = 0u;
    for (;;) {
        sum = 0u; cnt = 0u; mine = 0u;
#pragma unroll
        for (unsigned j = 0; j < 16; ++j) { const unsigned c = xb_ld(&bar[XB_XCNT(j)]); sum += c; cnt += (c > 0u) ? 1u : 0u; mine = (j == x) ? c : mine; }
        if (sum == G) break;
        __builtin_amdgcn_s_sleep(1);
        if ((++sp & 255u) == 0u) { if (xb_ld(&bar[XB_TMO])) break; if (sp > XB_SPIN_CAP) { atomicAdd(&bar[XB_TMO], 1u); break; } }
    }
    nloc = mine > 0u ? mine : 1u; nx = cnt > 0u ? cnt : 1u;
}

__device__ __forceinline__ void xcd_barrier(const XcdBarrier& b) {
    asm volatile("s_waitcnt vmcnt(0)" ::: "memory");
    __syncthreads();
    if (threadIdx.x == 0) {
        unsigned* bar = b.bar;
        __builtin_amdgcn_s_waitcnt(0);
        unsigned nloc = b.st[0], nx = b.st[1];
        if (nloc == 0u) { xcd_barrier_complete(bar, b.x, nloc, nx); b.st[0] = nloc; b.st[1] = nx; }
        const unsigned old = xb_add(&bar[XB_XSUB(b.x)], 1u);
        const unsigned gen = old / nloc;
        if (old + 1u == (gen + 1u) * nloc) {
            __builtin_amdgcn_fence(__ATOMIC_RELEASE, "agent");
            asm volatile("s_waitcnt vmcnt(0)" ::: "memory");
            const unsigned og = xb_add(&bar[XB_TOP], 1u);
            const unsigned tg = og / nx;
            if (og + 1u == (tg + 1u) * nx) xb_add(&bar[XB_TOPGEN], 1u);
            else XB_SPIN(xb_ld(&bar[XB_TOPGEN]) == tg, bar);
            __builtin_amdgcn_fence(__ATOMIC_ACQUIRE, "agent");
            xb_add(&bar[XB_XGEN(b.x)], 1u);
            asm volatile("s_waitcnt vmcnt(0)" ::: "memory");
        } else {
            XB_SPIN(xb_ld(&bar[XB_XGEN(b.x)]) == gen, bar);
            __builtin_amdgcn_fence(__ATOMIC_ACQUIRE, "agent");
            asm volatile("s_waitcnt vmcnt(0)" ::: "memory");
        }
    }
    __syncthreads();
}


#ifndef MK_MULTI
#define MK_MULTI 0
#endif
constexpr int NPHASE = 10;
#ifndef REP5
#define REP5 1
#endif
#ifndef REP6
#define REP6 1
#endif
__global__ void __launch_bounds__(NTHREADS, 2) mk_fwd(Params P) {
    extern __shared__ __attribute__((aligned(16))) unsigned char lds_raw[];
    LAS unsigned char* lds = (LAS unsigned char*)lds_raw;
    cg::grid_group grid = cg::this_grid();
    unsigned char* ws = P.ws;
    const int lo = P.ph_lo, hi = P.ph_hi;
    volatile LAS unsigned* bst = (volatile LAS unsigned*)(lds + 131072 + 64);
    if (threadIdx.x < 2) bst[threadIdx.x] = 0u;
    __syncthreads();
    XcdBarrier xbar = xcd_barrier_post((unsigned*)(ws + WS_CTL), bst);
#define IN(k) (lo <= (k) && (k) < hi)
#define SEAM(k) do { if (IN(k) && IN((k) + 1)) { xcd_barrier(xbar); } } while (0)
    if (IN(0)) phase_prep(P, lds);
    SEAM(0);
    if (IN(1)) { phase_metaproj(P); phase_winq(P, lds); }
    SEAM(1);
    if (IN(2)) {
        pg8::Gemm g{(const bf16*)(ws + WS_H0I8), (const bf16*)(ws + WS_WIN_T), NTOK, DIN, DM / 2}; pg8::StaticOrder S; S.init(NTOK, DIN, (int)gridDim.x, (int)blockIdx.x);
        EpiProjI8 E{(bf16*)(ws + WS_PROJ), (const float*)(ws + WS_RSTD1), (const float*)(ws + WS_SW)};
        pg8::gemm_phase_i8<EpiProjI8, pg8::StaticOrder, true, true>(lds, g, S, E);
    }
    SEAM(2);
    if (IN(3)) phase_conv(P, lds);
    SEAM(3);
    if (IN(4)) {
        pg8::Gemm g{(const bf16*)(ws + WS_Y), (const bf16*)(ws + WS_WOUT_T), NTOK, DM, DM / 2}; pg8::StaticOrder S; S.init(NTOK, DM, (int)gridDim.x, (int)blockIdx.x);
        EpiResidualI8 E{(bf16*)(ws + WS_H2B), (const signed char*)(ws + WS_H0I8), (const float*)(ws + WS_SX), (const float*)(ws + WS_SY), (const float*)(ws + WS_SWO), (float*)(ws + WS_SSQ), (float*)(ws + WS_AMX)};
        pg8::gemm_phase_i8<EpiResidualI8, pg8::StaticOrder, true, true>(lds, g, S, E);
    }
    SEAM(4);
    if (IN(5)) phase_quant_h2(P);
    SEAM(5);
    if (IN(6)) {
        pg8::Gemm g{(const bf16*)(ws + WS_H0I8), (const bf16*)(ws + WS_WQ_T), NTOK, 2048, DM / 2}; pg8::StaticOrder S; S.init(NTOK, 2048, (int)gridDim.x, (int)blockIdx.x);
        EpiQI8 E{(bf16*)(ws + WS_Q), 2048, (const float*)(ws + WS_RF), (const float*)(ws + WS_SWQ)};
        pg8::gemm_phase_i8<EpiQI8, pg8::StaticOrder, true, true>(lds, g, S, E);
    }
    if (IN(6) && IN(7)) { asm volatile("s_waitcnt vmcnt(0)" ::: "memory"); __syncthreads(); }
    if (IN(7)) phase_route(P, lds);
    SEAM(7);
    if (IN(8)) phase_gather_u(P);
    SEAM(8);
    if (IN(9)) phase_gather_v_mfma(P, lds);
#undef IN
#undef SEAM
}

extern "C" void kernel_launch(void* const* d_in, const int* in_sizes, int n_in, void* d_out, int out_size, void* d_ws, size_t ws_size, hipStream_t stream) {
    static int grid = 0;
    if (grid == 0) {
        if (n_in != 18 || in_sizes[0] != NTOK * DM || out_size != NTOK * DM || ws_size < WS_END) {
            fprintf(stderr, "kernel_launch: unexpected shapes (n_in %d in0 %d out %d ws %zu)\n", n_in, n_in > 0 ? in_sizes[0] : -1, out_size, ws_size); grid = -1; return; }
        int dev = 0, cus = 0, per_cu = 0;
        (void)hipGetDevice(&dev); (void)hipDeviceGetAttribute(&cus, hipDeviceAttributeMultiprocessorCount, dev);
        if (hipFuncSetAttribute((const void*)mk_fwd, hipFuncAttributeMaxDynamicSharedMemorySize, LDS_BYTES) != hipSuccess) { fprintf(stderr, "kernel_launch: hipFuncSetAttribute failed\n"); grid = -1; return; }
        if (hipOccupancyMaxActiveBlocksPerMultiprocessor(&per_cu, (const void*)mk_fwd, NTHREADS, LDS_BYTES) != hipSuccess || per_cu < 1) { fprintf(stderr, "kernel_launch: occupancy query failed (%d)\n", per_cu); (void)hipGetLastError(); per_cu = 1; }
        if (per_cu > 1) per_cu = 1;
        grid = cus * per_cu;
        if (grid <= 0) grid = 256;
    }
    if (grid < 0) return;
    Params p{};
    p.x = (const float*)d_in[0]; p.meta = (const float*)d_in[1]; p.g_mix = (const float*)d_in[2]; p.w_in = (const float*)d_in[3]; p.sc_w = (const float*)d_in[4];
    p.cf_w = (const float*)d_in[5]; p.cf_b = (const float*)d_in[6]; p.ln_g = (const float*)d_in[7]; p.ln_b = (const float*)d_in[8]; p.g_sc = (const float*)d_in[9];
    p.g_cf = (const float*)d_in[10]; p.w_out = (const float*)d_in[11]; p.g_ffn = (const float*)d_in[12]; p.w_q = (const float*)d_in[13]; p.keys = (const float*)d_in[14];
    p.pu = (const float*)d_in[15]; p.pv = (const float*)d_in[16]; p.g_fin = (const float*)d_in[17];
    p.out = (float*)d_out; p.ws = (unsigned char*)d_ws;
    (void)hipMemsetAsync((char*)d_ws + WS_CTL, 0, 45056, stream);
#if MK_MULTI
    for (int ph = 0; ph < NPHASE; ++ph) { p.ph_lo = ph; p.ph_hi = ph + 1; p.coop = 0; p.pad = 0;
        hipLaunchKernelGGL(mk_fwd, dim3(grid), dim3(NTHREADS), LDS_BYTES, stream, p); }
#else
    p.ph_lo = 0; p.ph_hi = NPHASE; p.coop = 1; p.pad = 0;
    void* args[] = {&p};
    hipError_t e = hipLaunchCooperativeKernel((const void*)mk_fwd, dim3(grid), dim3(NTHREADS), args, LDS_BYTES, stream);
    if (e != hipSuccess) fprintf(stderr, "cooperative launch failed: %s (grid %d)\n", hipGetErrorString(e), grid);
#endif
}
```

```cpp
#include <hip/hip_runtime.h>
#include <hip/hip_cooperative_groups.h>
#include <cstdio>
#include <cstdint>
namespace cg = cooperative_groups;

namespace pg8 {
#define PG8_LAS __attribute__((address_space(3)))
typedef unsigned short bf16_t;
typedef short bf16x8 __attribute__((ext_vector_type(8)));
typedef float f32x4 __attribute__((ext_vector_type(4)));
typedef unsigned u32x4 __attribute__((ext_vector_type(4)));
typedef int i32x4 __attribute__((ext_vector_type(4)));
constexpr int BM = 256, BK = 64, HALF = 128, HTB = HALF * BK * 2  , STAGE_BYTES = 8 * HTB, NXCD = 8, WGM = 8;

__host__ __device__ __forceinline__ int lds_byte(int r, int c) { const int st = (r >> 4) * 2 + (c >> 5), rr = r & 15, cc = c & 31, ob = rr * 64 + cc * 2; return st * 1024 + (ob ^ (((ob >> 9) & 1) << 5)); }
__host__ __device__ __forceinline__ void stage_rc(int b, int& R, int& C) { const int st = b / 1024, sb = b % 1024, swz = sb ^ (((sb >> 9) & 1) << 5); R = (st >> 1) * 16 + swz / 64; C = (st & 1) * 32 + (swz % 64) / 2; }
__host__ __device__ __forceinline__ int perm32(int rho) { const int n = rho >> 4, i = rho & 15; return 8 * (i >> 2) + 4 * n + (i & 3); }

struct Unit { int pm, pn; };
struct Gemm { const bf16_t* A; const bf16_t* Bt; int M, N, K; };

struct StaticOrder {
    int nM, nN, nwg, G, c;
    __host__ __device__ void init(int M, int N, int G_, int c_) { nM = M / BM; nN = N / BM; nwg = nM * nN; G = G_; c = c_; }
    __host__ __device__ bool next(int i, Unit& u) const {
        const long L = (long)i * G + c; if (L >= nwg) return false;
        int wgid = (int)L; { const int q = nwg / NXCD, r = nwg % NXCD, xcd = wgid % NXCD, off = wgid / NXCD; wgid = (xcd < r ? xcd * (q + 1) : r * (q + 1) + (xcd - r) * q) + off; }
        const int nig = WGM * nN, gid = wgid / nig, fm = gid * WGM, gsz = (nM - fm) < WGM ? (nM - fm) : WGM;
        u.pm = fm + ((wgid % nig) % gsz); u.pn = (wgid % nig) / gsz; return true;
    }
    __device__ __forceinline__ void a_ready(const Unit&) const {}
    __device__ __forceinline__ void done(const Unit&) const {}
};

template <class Epi, class Sched, bool ALIGN_EPI = false, bool SP2 = false>
__device__ __forceinline__ void gemm_phase(PG8_LAS unsigned char* lds, const Gemm g, const Sched& S, const Epi& E) {
    const int tid = threadIdx.x, wid = __builtin_amdgcn_readfirstlane(tid >> 6), lane = tid & 63, wr = wid >> 2, wc = wid & 3, fr = lane & 15, fq = lane >> 4;
    const int K = g.K, nt = K / BK;
    unsigned voffA[2], voffB[2];
#pragma unroll
    for (int i = 0; i < 2; ++i) { int R, C; stage_rc(tid * 16 + i * 8192, R, C); const int Rb = Epi::PERM ? ((R & ~31) + perm32(R & 31)) : R;
        voffA[i] = (unsigned)(R * K + C) * 2u; voffB[i] = (unsigned)(Rb * K + C) * 2u; }
    const size_t kstep = (size_t)(BK * 2);
    const size_t hstep = (size_t)HALF * K * 2;
    const size_t tstep = 2 * hstep;
    const unsigned ldsw = (unsigned)wid * 1024u;
    const int aoff = lds_byte(wr * 64 + fr, fq * 8), boff = lds_byte(wc * 32 + fr, fq * 8);
#define PG8_SA(b, h) (((b) * 2 + (h)) * HTB)
#define PG8_SB(b, h) ((4 + (b) * 2 + (h)) * HTB)
#define PG8_STAGE(bufoff, gbase, voff) do { _Pragma("unroll") for (int _i = 0; _i < 2; ++_i) \
        __builtin_amdgcn_global_load_lds((const unsigned*)((const char*)(gbase) + (voff)[_i]), (PG8_LAS unsigned*)(lds + (bufoff) + ldsw + _i * 8192), 16, 0, 0); } while (0)
#define PG8_LDA(dst, b, h) do { _Pragma("unroll") for (int m = 0; m < 4; ++m) _Pragma("unroll") for (int k = 0; k < 2; ++k) dst[m][k] = *(const PG8_LAS bf16x8*)(lds + PG8_SA(b, h) + aoff + m * 2048 + k * 1024); } while (0)
#define PG8_LDB(dst, b, h) do { _Pragma("unroll") for (int n = 0; n < 2; ++n) _Pragma("unroll") for (int k = 0; k < 2; ++k) dst[n][k] = *(const PG8_LAS bf16x8*)(lds + PG8_SB(b, h) + boff + n * 2048 + k * 1024); } while (0)
#define PG8_MMA(ai, bj, At, Bt) do { __builtin_amdgcn_s_setprio(1); _Pragma("unroll") for (int m = 0; m < 4; ++m) _Pragma("unroll") for (int n = 0; n < 2; ++n) _Pragma("unroll") for (int k = 0; k < 2; ++k) \
        acc[ai][bj][m][n] = __builtin_amdgcn_mfma_f32_16x16x32_bf16(Bt[n][k], At[m][k], acc[ai][bj][m][n], 0, 0, 0); __builtin_amdgcn_s_setprio(0); } while (0)
#define PG8_WAIT_V(n) asm volatile("s_waitcnt vmcnt(" #n ")" ::: "memory")
#define PG8_WAIT_L(n) asm volatile("s_waitcnt lgkmcnt(" #n ")" ::: "memory")
#define PG8_BAR __builtin_amdgcn_s_barrier()
#define PG8_SCHED __builtin_amdgcn_sched_barrier(0)
    Unit cur, nxt; int ui = 0;
    if (!S.next(0, cur)) return;
    f32x4 acc[2][2][4][2];
#pragma unroll
    for (int a = 0; a < 2; ++a)
#pragma unroll
        for (int b = 0; b < 2; ++b)
#pragma unroll
            for (int m = 0; m < 4; ++m)
#pragma unroll
                for (int n = 0; n < 2; ++n) acc[a][b][m][n] = (f32x4){0.f, 0.f, 0.f, 0.f};
    bf16x8 At[4][2], B0[2][2], B1[2][2];
    const char* cA = (const char*)g.A + (size_t)cur.pm * tstep; const char* cB = (const char*)g.Bt + (size_t)cur.pn * tstep;
    S.a_ready(cur);
    if constexpr (SP2) {
        PG8_STAGE(PG8_SB(0, 0), cB, voffB); PG8_STAGE(PG8_SB(0, 1), cB + hstep, voffB); PG8_STAGE(PG8_SA(0, 0), cA, voffA); PG8_STAGE(PG8_SA(0, 1), cA + hstep, voffA);
        if (wr == 1) PG8_BAR;
        PG8_WAIT_V(2); PG8_BAR;
        PG8_STAGE(PG8_SB(1, 0), cB + kstep, voffB); PG8_STAGE(PG8_SA(1, 0), cA + kstep, voffA); PG8_STAGE(PG8_SB(1, 1), cB + hstep + kstep, voffB);
        PG8_WAIT_V(6); PG8_BAR;
    } else {
        PG8_STAGE(PG8_SB(0, 0), cB, voffB); PG8_STAGE(PG8_SA(0, 0), cA, voffA); PG8_STAGE(PG8_SB(0, 1), cB + hstep, voffB); PG8_STAGE(PG8_SA(0, 1), cA + hstep, voffA);
        if (wr == 1) PG8_BAR;
        PG8_WAIT_V(4); PG8_BAR;
        PG8_STAGE(PG8_SB(1, 0), cB + kstep, voffB); PG8_STAGE(PG8_SA(1, 0), cA + kstep, voffA); PG8_STAGE(PG8_SB(1, 1), cB + hstep + kstep, voffB);
        PG8_WAIT_V(6); PG8_BAR;
    }
    for (;;) {
        const bool has_next = S.next(ui + 1, nxt);
        const char* nA = has_next ? (const char*)g.A + (size_t)nxt.pm * tstep : cA; const char* nB = has_next ? (const char*)g.Bt + (size_t)nxt.pn * tstep : cB;
        for (int t = 0; t < nt; t += 2) {
            const bool last = (t == nt - 2);
            const char* a1 = cA + (size_t)(t + 1) * kstep;
            const char* a2 = last ? nA : cA + (size_t)(t + 2) * kstep; const char* b2 = last ? nB : cB + (size_t)(t + 2) * kstep;
            const char* a3 = a2 + kstep; const char* b3 = b2 + kstep;
            if (last && has_next) S.a_ready(nxt);
            if constexpr (SP2) {
            PG8_LDB(B0, 0, 0); PG8_LDB(B1, 0, 1); PG8_SCHED; PG8_LDA(At, 0, 0); PG8_STAGE(PG8_SA(1, 1), a1 + hstep, voffA);
            PG8_WAIT_V(8); PG8_WAIT_L(0); PG8_BAR; PG8_MMA(0, 0, At, B0); PG8_MMA(0, 1, At, B1); PG8_BAR; PG8_SCHED;
            PG8_LDA(At, 0, 1); PG8_STAGE(PG8_SB(0, 0), b2, voffB); PG8_STAGE(PG8_SB(0, 1), b2 + hstep, voffB); PG8_STAGE(PG8_SA(0, 0), a2, voffA);
            PG8_WAIT_V(8); PG8_WAIT_L(0); PG8_BAR; PG8_MMA(1, 0, At, B0); PG8_MMA(1, 1, At, B1); PG8_BAR; PG8_SCHED;
            PG8_LDB(B0, 1, 0); PG8_LDB(B1, 1, 1); PG8_SCHED; PG8_LDA(At, 1, 0); PG8_STAGE(PG8_SA(0, 1), a2 + hstep, voffA);
            PG8_WAIT_V(8); PG8_WAIT_L(0); PG8_BAR; PG8_MMA(0, 0, At, B0); PG8_MMA(0, 1, At, B1); PG8_BAR; PG8_SCHED;
            PG8_LDA(At, 1, 1); PG8_STAGE(PG8_SB(1, 0), b3, voffB); PG8_STAGE(PG8_SB(1, 1), b3 + hstep, voffB); PG8_STAGE(PG8_SA(1, 0), a3, voffA);
            PG8_WAIT_V(8); PG8_WAIT_L(0); PG8_BAR; PG8_MMA(1, 0, At, B0); PG8_MMA(1, 1, At, B1); PG8_BAR; PG8_SCHED;
            } else {
            PG8_LDB(B0, 0, 0); PG8_SCHED; PG8_LDA(At, 0, 0); PG8_STAGE(PG8_SA(1, 1), a1 + hstep, voffA);
            PG8_WAIT_L(8); PG8_BAR; PG8_WAIT_L(0); PG8_MMA(0, 0, At, B0); PG8_BAR; PG8_SCHED;
            PG8_LDB(B1, 0, 1); PG8_STAGE(PG8_SB(0, 0), b2, voffB);
            PG8_BAR; PG8_WAIT_L(0); PG8_MMA(0, 1, At, B1); PG8_BAR;
            PG8_LDA(At, 0, 1); PG8_STAGE(PG8_SA(0, 0), a2, voffA);
            PG8_BAR; PG8_WAIT_L(0); PG8_MMA(1, 0, At, B0); PG8_BAR; PG8_SCHED;
            PG8_STAGE(PG8_SB(0, 1), b2 + hstep, voffB);
            PG8_WAIT_V(6); PG8_BAR; PG8_MMA(1, 1, At, B1); PG8_BAR;
            PG8_LDB(B0, 1, 0); PG8_SCHED; PG8_LDA(At, 1, 0); PG8_STAGE(PG8_SA(0, 1), a2 + hstep, voffA);
            PG8_WAIT_L(8); PG8_BAR; PG8_WAIT_L(0); PG8_MMA(0, 0, At, B0); PG8_BAR; PG8_SCHED;
            PG8_LDB(B1, 1, 1); PG8_STAGE(PG8_SB(1, 0), b3, voffB);
            PG8_BAR; PG8_WAIT_L(0); PG8_MMA(0, 1, At, B1); PG8_BAR;
            PG8_LDA(At, 1, 1); PG8_STAGE(PG8_SA(1, 0), a3, voffA);
            PG8_BAR; PG8_WAIT_L(0); PG8_MMA(1, 0, At, B0); PG8_BAR; PG8_SCHED;
            PG8_STAGE(PG8_SB(1, 1), b3 + hstep, voffB);
            PG8_WAIT_V(6); PG8_BAR; PG8_MMA(1, 1, At, B1); PG8_BAR;
            }
        }
        if constexpr (ALIGN_EPI) { if (wr == 0) PG8_BAR; }
        if constexpr (!Epi::AFTER_DRAIN) { E(acc, cur, wr, wc, fr, fq); S.done(cur); }
        if (!has_next) break;
#pragma unroll
        for (int a = 0; a < 2; ++a)
#pragma unroll
            for (int b = 0; b < 2; ++b)
#pragma unroll
                for (int m = 0; m < 4; ++m)
#pragma unroll
                    for (int n = 0; n < 2; ++n) acc[a][b][m][n] = (f32x4){0.f, 0.f, 0.f, 0.f};
        cur = nxt; cA = nA; cB = nB; ++ui;
        if constexpr (ALIGN_EPI) { if (wr == 1) PG8_BAR; }
    }
    PG8_WAIT_V(0);
    if constexpr (!ALIGN_EPI) { if (wr == 0) PG8_BAR; }
    PG8_BAR;
    if constexpr (Epi::AFTER_DRAIN) { E.fused(acc, cur, wr, wc, fr, fq, lds, wid, lane); S.done(cur); }
#undef PG8_SA
#undef PG8_SB
#undef PG8_STAGE
#undef PG8_LDA
#undef PG8_LDB
#undef PG8_MMA
#undef PG8_WAIT_V
#undef PG8_WAIT_L
#undef PG8_BAR
#undef PG8_SCHED
}
template <class Epi, class Sched, bool ALIGN_EPI = false, bool SP2 = false>
__device__ __forceinline__ void gemm_phase_i8(PG8_LAS unsigned char* lds, const Gemm g, const Sched& S, const Epi& E) {
    const int tid = threadIdx.x, wid = __builtin_amdgcn_readfirstlane(tid >> 6), lane = tid & 63, wr = wid >> 2, wc = wid & 3, fr = lane & 15, fq = lane >> 4;
    const int K = g.K, nt = K / BK;
    unsigned voffA[2], voffB[2];
#pragma unroll
    for (int i = 0; i < 2; ++i) { int R, C; stage_rc(tid * 16 + i * 8192, R, C); const int Rb = Epi::PERM ? ((R & ~31) + perm32(R & 31)) : R;
        voffA[i] = (unsigned)(R * K + C) * 2u; voffB[i] = (unsigned)(Rb * K + C) * 2u; }
    const size_t kstep = (size_t)(BK * 2);
    const size_t hstep = (size_t)HALF * K * 2;
    const size_t tstep = 2 * hstep;
    const unsigned ldsw = (unsigned)wid * 1024u;
    const int aoff = lds_byte(wr * 64 + fr, fq * 8), boff = lds_byte(wc * 32 + fr, fq * 8);
#define PG8_SA(b, h) (((b) * 2 + (h)) * HTB)
#define PG8_SB(b, h) ((4 + (b) * 2 + (h)) * HTB)
#define PG8_STAGE(bufoff, gbase, voff) do { _Pragma("unroll") for (int _i = 0; _i < 2; ++_i) \
        __builtin_amdgcn_global_load_lds((const unsigned*)((const char*)(gbase) + (voff)[_i]), (PG8_LAS unsigned*)(lds + (bufoff) + ldsw + _i * 8192), 16, 0, 0); } while (0)
#define PG8_LDA(dst, b, h) do { _Pragma("unroll") for (int m = 0; m < 4; ++m) _Pragma("unroll") for (int k = 0; k < 2; ++k) dst[m][k] = *(const PG8_LAS bf16x8*)(lds + PG8_SA(b, h) + aoff + m * 2048 + k * 1024); } while (0)
#define PG8_LDB(dst, b, h) do { _Pragma("unroll") for (int n = 0; n < 2; ++n) _Pragma("unroll") for (int k = 0; k < 2; ++k) dst[n][k] = *(const PG8_LAS bf16x8*)(lds + PG8_SB(b, h) + boff + n * 2048 + k * 1024); } while (0)
#define PG8_MMA(ai, bj, At, Bt) do { __builtin_amdgcn_s_setprio(1); _Pragma("unroll") for (int m = 0; m < 4; ++m) _Pragma("unroll") for (int n = 0; n < 2; ++n) _Pragma("unroll") for (int k = 0; k < 2; ++k) \
        acc[ai][bj][m][n] = __builtin_amdgcn_mfma_i32_16x16x64_i8(__builtin_bit_cast(i32x4, Bt[n][k]), __builtin_bit_cast(i32x4, At[m][k]), acc[ai][bj][m][n], 0, 0, 0); __builtin_amdgcn_s_setprio(0); } while (0)
#define PG8_WAIT_V(n) asm volatile("s_waitcnt vmcnt(" #n ")" ::: "memory")
#define PG8_WAIT_L(n) asm volatile("s_waitcnt lgkmcnt(" #n ")" ::: "memory")
#define PG8_BAR __builtin_amdgcn_s_barrier()
#define PG8_SCHED __builtin_amdgcn_sched_barrier(0)
    Unit cur, nxt; int ui = 0;
    if (!S.next(0, cur)) return;
    i32x4 acc[2][2][4][2];
#pragma unroll
    for (int a = 0; a < 2; ++a)
#pragma unroll
        for (int b = 0; b < 2; ++b)
#pragma unroll
            for (int m = 0; m < 4; ++m)
#pragma unroll
                for (int n = 0; n < 2; ++n) acc[a][b][m][n] = (i32x4){0, 0, 0, 0};
    bf16x8 At[4][2], B0[2][2], B1[2][2];
    const char* cA = (const char*)g.A + (size_t)cur.pm * tstep; const char* cB = (const char*)g.Bt + (size_t)cur.pn * tstep;
    S.a_ready(cur);
    if constexpr (SP2) {
        PG8_STAGE(PG8_SB(0, 0), cB, voffB); PG8_STAGE(PG8_SB(0, 1), cB + hstep, voffB); PG8_STAGE(PG8_SA(0, 0), cA, voffA); PG8_STAGE(PG8_SA(0, 1), cA + hstep, voffA);
        if (wr == 1) PG8_BAR;
        PG8_WAIT_V(2); PG8_BAR;
        PG8_STAGE(PG8_SB(1, 0), cB + kstep, voffB); PG8_STAGE(PG8_SA(1, 0), cA + kstep, voffA); PG8_STAGE(PG8_SB(1, 1), cB + hstep + kstep, voffB);
        PG8_WAIT_V(6); PG8_BAR;
    } else {
        PG8_STAGE(PG8_SB(0, 0), cB, voffB); PG8_STAGE(PG8_SA(0, 0), cA, voffA); PG8_STAGE(PG8_SB(0, 1), cB + hstep, voffB); PG8_STAGE(PG8_SA(0, 1), cA + hstep, voffA);
        if (wr == 1) PG8_BAR;
        PG8_WAIT_V(4); PG8_BAR;
        PG8_STAGE(PG8_SB(1, 0), cB + kstep, voffB); PG8_STAGE(PG8_SA(1, 0), cA + kstep, voffA); PG8_STAGE(PG8_SB(1, 1), cB + hstep + kstep, voffB);
        PG8_WAIT_V(6); PG8_BAR;
    }
    for (;;) {
        const bool has_next = S.next(ui + 1, nxt);
        const char* nA = has_next ? (const char*)g.A + (size_t)nxt.pm * tstep : cA; const char* nB = has_next ? (const char*)g.Bt + (size_t)nxt.pn * tstep : cB;
        for (int t = 0; t < nt; t += 2) {
            const bool last = (t == nt - 2);
            const char* a1 = cA + (size_t)(t + 1) * kstep;
            const char* a2 = last ? nA : cA + (size_t)(t + 2) * kstep; const char* b2 = last ? nB : cB + (size_t)(t + 2) * kstep;
            const char* a3 = a2 + kstep; const char* b3 = b2 + kstep;
            if (last && has_next) S.a_ready(nxt);
            if constexpr (SP2) {
            PG8_LDB(B0, 0, 0); PG8_LDB(B1, 0, 1); PG8_SCHED; PG8_LDA(At, 0, 0); PG8_STAGE(PG8_SA(1, 1), a1 + hstep, voffA);
            PG8_WAIT_V(8); PG8_WAIT_L(0); PG8_BAR; PG8_MMA(0, 0, At, B0); PG8_MMA(0, 1, At, B1); PG8_BAR; PG8_SCHED;
            PG8_LDA(At, 0, 1); PG8_STAGE(PG8_SB(0, 0), b2, voffB); PG8_STAGE(PG8_SB(0, 1), b2 + hstep, voffB); PG8_STAGE(PG8_SA(0, 0), a2, voffA);
            PG8_WAIT_V(8); PG8_WAIT_L(0); PG8_BAR; PG8_MMA(1, 0, At, B0); PG8_MMA(1, 1, At, B1); PG8_BAR; PG8_SCHED;
            PG8_LDB(B0, 1, 0); PG8_LDB(B1, 1, 1); PG8_SCHED; PG8_LDA(At, 1, 0); PG8_STAGE(PG8_SA(0, 1), a2 + hstep, voffA);
            PG8_WAIT_V(8); PG8_WAIT_L(0); PG8_BAR; PG8_MMA(0, 0, At, B0); PG8_MMA(0, 1, At, B1); PG8_BAR; PG8_SCHED;
            PG8_LDA(At, 1, 1); PG8_STAGE(PG8_SB(1, 0), b3, voffB); PG8_STAGE(PG8_SB(1, 1), b3 + hstep, voffB); PG8_STAGE(PG8_SA(1, 0), a3, voffA);
            PG8_WAIT_V(8); PG8_WAIT_L(0); PG8_BAR; PG8_MMA(1, 0, At, B0); PG8_MMA(1, 1, At, B1); PG8_BAR; PG8_SCHED;
            } else {
            PG8_LDB(B0, 0, 0); PG8_SCHED; PG8_LDA(At, 0, 0); PG8_STAGE(PG8_SA(1, 1), a1 + hstep, voffA);
            PG8_WAIT_L(8); PG8_BAR; PG8_WAIT_L(0); PG8_MMA(0, 0, At, B0); PG8_BAR; PG8_SCHED;
            PG8_LDB(B1, 0, 1); PG8_STAGE(PG8_SB(0, 0), b2, voffB);
            PG8_BAR; PG8_WAIT_L(0); PG8_MMA(0, 1, At, B1); PG8_BAR;
            PG8_LDA(At, 0, 1); PG8_STAGE(PG8_SA(0, 0), a2, voffA);
            PG8_BAR; PG8_WAIT_L(0); PG8_MMA(1, 0, At, B0); PG8_BAR; PG8_SCHED;
            PG8_STAGE(PG8_SB(0, 1), b2 + hstep, voffB);
            PG8_WAIT_V(6); PG8_BAR; PG8_MMA(1, 1, At, B1); PG8_BAR;
            PG8_LDB(B0, 1, 0); PG8_SCHED; PG8_LDA(At, 1, 0); PG8_STAGE(PG8_SA(0, 1), a2 + hstep, voffA);
            PG8_WAIT_L(8); PG8_BAR; PG8_WAIT_L(0); PG8_MMA(0, 0, At, B0); PG8_BAR; PG8_SCHED;
            PG8_LDB(B1, 1, 1); PG8_STAGE(PG8_SB(1, 0), b3, voffB);
            PG8_BAR; PG8_WAIT_L(0); PG8_MMA(0, 1, At, B1); PG8_BAR;
            PG8_LDA(At, 1, 1); PG8_STAGE(PG8_SA(1, 0), a3, voffA);
            PG8_BAR; PG8_WAIT_L(0); PG8_MMA(1, 0, At, B0); PG8_BAR; PG8_SCHED;
            PG8_STAGE(PG8_SB(1, 1), b3 + hstep, voffB);
            PG8_WAIT_V(6); PG8_BAR; PG8_MMA(1, 1, At, B1); PG8_BAR;
            }
        }
        if constexpr (ALIGN_EPI) { if (wr == 0) PG8_BAR; }
        if constexpr (!Epi::AFTER_DRAIN) { E(acc, cur, wr, wc, fr, fq); S.done(cur); }
        if (!has_next) break;
#pragma unroll
        for (int a = 0; a < 2; ++a)
#pragma unroll
            for (int b = 0; b < 2; ++b)
#pragma unroll
                for (int m = 0; m < 4; ++m)
#pragma unroll
                    for (int n = 0; n < 2; ++n) acc[a][b][m][n] = (i32x4){0, 0, 0, 0};
        cur = nxt; cA = nA; cB = nB; ++ui;
        if constexpr (ALIGN_EPI) { if (wr == 1) PG8_BAR; }
    }
    PG8_WAIT_V(0);
    if constexpr (!ALIGN_EPI) { if (wr == 0) PG8_BAR; }
    PG8_BAR;
    if constexpr (Epi::AFTER_DRAIN) { E.fused(acc, cur, wr, wc, fr, fq, lds, wid, lane); S.done(cur); }
#undef PG8_SA
#undef PG8_SB
#undef PG8_STAGE
#undef PG8_LDA
#undef PG8_LDB
#undef PG8_MMA
#undef PG8_WAIT_V
#undef PG8_WAIT_L
#undef PG8_BAR
#undef PG8_SCHED
}
}

#define LAS __attribute__((address_space(3)))
typedef unsigned short bf16;
typedef float f32x2 __attribute__((ext_vector_type(2)));
typedef float f32x4 __attribute__((ext_vector_type(4)));
typedef unsigned u32x2 __attribute__((ext_vector_type(2)));
typedef unsigned u32x4 __attribute__((ext_vector_type(4)));

constexpr int PDIM = 1536;
constexpr int NTOK = 32768, DM = 1024, DIN = 2560, SEQ = 8192, NBATCH = 4, NMETA = 16;
constexpr int NHEAD = 8, NKEYS = 128, TOPK = 16, NSEL = NHEAD * TOPK;
constexpr float EPS = 1e-6f;
constexpr float U_SCALE = 64.f, V_SCALE = 16.f;
constexpr float U4_CLIP = 2.6f;
constexpr int NWAVES = 8, NTHREADS = 512;
constexpr int MKC = 32;
constexpr int LDS_BYTES = 147456;

constexpr size_t MiB = 1u << 20;
constexpr size_t WS_CTL = 0, WS_WIN_T = 1 * MiB, WS_WOUT_T = 6 * MiB, WS_WQ_T = 8 * MiB, WS_KEYS = 12 * MiB, WS_METAPART = 160 * MiB  ,
                 WS_METARSTD = 14 * MiB + 512 * 1024, WS_METAPROJ = 14 * MiB + 576 * 1024, WS_RSTD1 = 15 * MiB, WS_SSQ = 16 * MiB, WS_U8 = 32 * MiB, WS_V8 = 48 * MiB,
                 WS_IDX = 64 * MiB, WS_GATE = 80 * MiB, WS_H0B = 96 * MiB, WS_H2B = 96 * MiB, WS_Y = 160 * MiB, WS_PROJ = 224 * MiB,
                 WS_Q = 224 * MiB, WS_ESCALE = 18 * MiB, WS_SUMQ = 19 * MiB, WS_SX = 20 * MiB, WS_SW = 21 * MiB, WS_SY = 22 * MiB, WS_SWO = 23 * MiB, WS_WMX = 24 * MiB, WS_AMX = 26 * MiB, WS_RF = 28 * MiB, WS_SWQ = 29 * MiB, WS_H0I8 = 384 * MiB, WS_AW = 160 * MiB  , WS_END = 416 * MiB;

struct Params {
    const float* x; const float* meta; const float* g_mix; const float* w_in; const float* sc_w; const float* cf_w; const float* cf_b;
    const float* ln_g; const float* ln_b; const float* g_sc; const float* g_cf; const float* w_out; const float* g_ffn; const float* w_q;
    const float* keys; const float* pu; const float* pv; const float* g_fin;
    float* out; unsigned char* ws;
    int ph_lo, ph_hi, coop, pad;
};

__device__ __forceinline__ unsigned f2bf(float f) { unsigned u = __builtin_bit_cast(unsigned, f); return (u + 0x7fffu + ((u >> 16) & 1u)) >> 16; }
__device__ __forceinline__ unsigned pk2(float lo, float hi) { return f2bf(lo) | (f2bf(hi) << 16); }
__device__ __forceinline__ float bf2f(unsigned b) { return __builtin_bit_cast(float, b << 16); }
__device__ __forceinline__ float bflo(unsigned w) { return __builtin_bit_cast(float, w << 16); }
__device__ __forceinline__ float bfhi(unsigned w) { return __builtin_bit_cast(float, w & 0xffff0000u); }
__device__ __forceinline__ float wave_sum(float v) {
#pragma unroll
    for (int o = 1; o < 64; o <<= 1) v += __shfl_xor(v, o);
    return v;
}
template <int CTRL> __device__ __forceinline__ float dpp_f(float v) { return __builtin_bit_cast(float, __builtin_amdgcn_update_dpp(0, __builtin_bit_cast(int, v), CTRL, 0xf, 0xf, true)); }
__device__ __forceinline__ float wave_sum_fast(float v) {
    v += dpp_f<0xB1>(v); v += dpp_f<0x4E>(v); v += dpp_f<0x141>(v); v += dpp_f<0x140>(v);
    { auto r = __builtin_amdgcn_permlane16_swap(__float_as_uint(v), __float_as_uint(v), false, false); v = __uint_as_float(r[0]) + __uint_as_float(r[1]); }
    { auto r = __builtin_amdgcn_permlane32_swap(__float_as_uint(v), __float_as_uint(v), false, false); v = __uint_as_float(r[0]) + __uint_as_float(r[1]); }
    return v;
}
__device__ __forceinline__ float wave_max_fast(float v) {
    v = fmaxf(v, dpp_f<0xB1>(v)); v = fmaxf(v, dpp_f<0x4E>(v)); v = fmaxf(v, dpp_f<0x141>(v)); v = fmaxf(v, dpp_f<0x140>(v));
    { auto r = __builtin_amdgcn_permlane16_swap(__float_as_uint(v), __float_as_uint(v), false, false); v = fmaxf(__uint_as_float(r[0]), __uint_as_float(r[1])); }
    { auto r = __builtin_amdgcn_permlane32_swap(__float_as_uint(v), __float_as_uint(v), false, false); v = fmaxf(__uint_as_float(r[0]), __uint_as_float(r[1])); }
    return v;
}
__device__ __forceinline__ float sigmoid_f(float x) { return 1.f / (1.f + __expf(-x)); }
__device__ __forceinline__ float gelu_tanh_f(float x) {
    const float t = 0.7978845608028654f * (x + 0.044715f * x * x * x);
    const float e = __expf(2.f * t);
    const float th = 1.f - 2.f / (e + 1.f);
    return 0.5f * x * (1.f + th);
}

__device__ __forceinline__ unsigned cvt_pk_bf16(float lo, float hi) { unsigned r; asm volatile("v_cvt_pk_bf16_f32 %0, %1, %2" : "=v"(r) : "v"(lo), "v"(hi)); return r; }

template <int MODE> struct EpiRowScale {
    static constexpr bool PERM = true, AFTER_DRAIN = false;
    bf16* O; int ldc; const float* rs;
    __device__ __forceinline__ void operator()(const pg8::f32x4 (&acc)[2][2][4][2], const pg8::Unit& u, int wr, int wc, int fr, int fq) const {
        const int row0 = u.pm * 256 + wr * 64 + fr, col0 = u.pn * 256 + wc * 32 + 8 * fq;
#pragma unroll
        for (int ai = 0; ai < 2; ++ai)
#pragma unroll
            for (int m = 0; m < 4; ++m) {
                const int row = row0 + ai * 128 + m * 16;
                float s;
                if (MODE == 0) s = rs[row];
                else { const f32x4* p = (const f32x4*)(rs + (size_t)row * 16); const f32x4 a = p[0], b = p[1], c = p[2], d = p[3];
                       const float t = ((a.x + a.y) + (a.z + a.w)) + ((b.x + b.y) + (b.z + b.w)) + ((c.x + c.y) + (c.z + c.w)) + ((d.x + d.y) + (d.z + d.w));
                       s = rsqrtf(t * (1.f / 1024.f) + EPS); }
                bf16* rowp = O + (size_t)row * ldc + col0;
#pragma unroll
                for (int bj = 0; bj < 2; ++bj) { const pg8::f32x4 v0 = acc[ai][bj][m][0] * s, v1 = acc[ai][bj][m][1] * s;
                    u32x4 w; w.x = cvt_pk_bf16(v0[0], v0[1]); w.y = cvt_pk_bf16(v0[2], v0[3]); w.z = cvt_pk_bf16(v1[0], v1[1]); w.w = cvt_pk_bf16(v1[2], v1[3]);
                    *(u32x4*)(rowp + bj * 128) = w; }
            }
    }
};
struct EpiProj {
    static constexpr bool PERM = true, AFTER_DRAIN = false;
    bf16* O; const float* rs;
    __device__ __forceinline__ void operator()(const pg8::f32x4 (&acc)[2][2][4][2], const pg8::Unit& u, int wr, int wc, int fr, int fq) const {
        const int row0 = u.pm * 256 + wr * 64 + fr, cin = wc * 32 + 8 * fq, pn = u.pn;
#pragma unroll
        for (int ai = 0; ai < 2; ++ai)
#pragma unroll
            for (int m = 0; m < 4; ++m) {
                const int row = row0 + ai * 128 + m * 16; const float sc = rs[row];
                float a[8], b[8];
#pragma unroll
                for (int i = 0; i < 4; ++i) { a[i] = acc[ai][0][m][0][i] * sc; a[4 + i] = acc[ai][0][m][1][i] * sc; b[i] = acc[ai][1][m][0][i] * sc; b[4 + i] = acc[ai][1][m][1][i] * sc; }
                bf16* rowp = O + (size_t)row * PDIM;
                if (pn >= 4 && pn < 6) {
                    u32x4 w0, w1; w0.x = cvt_pk_bf16(a[0], a[1]); w0.y = cvt_pk_bf16(a[2], a[3]); w0.z = cvt_pk_bf16(a[4], a[5]); w0.w = cvt_pk_bf16(a[6], a[7]);
                    w1.x = cvt_pk_bf16(b[0], b[1]); w1.y = cvt_pk_bf16(b[2], b[3]); w1.z = cvt_pk_bf16(b[4], b[5]); w1.w = cvt_pk_bf16(b[6], b[7]);
                    *(u32x4*)(rowp + 512 + 256 * (pn - 4) + cin) = w0; *(u32x4*)(rowp + 512 + 256 * (pn - 4) + 128 + cin) = w1;
                } else {
                    float o[8];
                    if (pn < 4) {
#pragma unroll
                        for (int i = 0; i < 8; ++i) o[i] = a[i] * b[i];
                    } else {
#pragma unroll
                        for (int i = 0; i < 8; ++i) o[i] = a[i] * sigmoid_f(b[i]);
                    }
                    u32x4 w; w.x = cvt_pk_bf16(o[0], o[1]); w.y = cvt_pk_bf16(o[2], o[3]); w.z = cvt_pk_bf16(o[4], o[5]); w.w = cvt_pk_bf16(o[6], o[7]);
                    *(u32x4*)(rowp + (pn < 4 ? 128 * pn : 1024 + 128 * (pn - 6)) + cin) = w;
                }
            }
    }
};
struct EpiProjI8 {
    static constexpr bool PERM = true, AFTER_DRAIN = false;
    bf16* O; const float* rs; const float* sw;
    __device__ __forceinline__ void operator()(const pg8::i32x4 (&acc)[2][2][4][2], const pg8::Unit& u, int wr, int wc, int fr, int fq) const {
        const int row0 = u.pm * 256 + wr * 64 + fr, cin = wc * 32 + 8 * fq, pn = u.pn;
        float swa[8], swb[8];
        { const f32x4 a0 = *(const f32x4*)(sw + 256 * pn + cin), a1 = *(const f32x4*)(sw + 256 * pn + cin + 4), b0 = *(const f32x4*)(sw + 256 * pn + 128 + cin), b1 = *(const f32x4*)(sw + 256 * pn + 128 + cin + 4);
          swa[0] = a0.x; swa[1] = a0.y; swa[2] = a0.z; swa[3] = a0.w; swa[4] = a1.x; swa[5] = a1.y; swa[6] = a1.z; swa[7] = a1.w;
          swb[0] = b0.x; swb[1] = b0.y; swb[2] = b0.z; swb[3] = b0.w; swb[4] = b1.x; swb[5] = b1.y; swb[6] = b1.z; swb[7] = b1.w; }
#pragma unroll
        for (int ai = 0; ai < 2; ++ai)
#pragma unroll
            for (int m = 0; m < 4; ++m) {
                const int row = row0 + ai * 128 + m * 16; const float sc = rs[row];
                float a[8], b[8];
#pragma unroll
                for (int i = 0; i < 4; ++i) { a[i] = (float)acc[ai][0][m][0][i] * (sc * swa[i]); a[4 + i] = (float)acc[ai][0][m][1][i] * (sc * swa[4 + i]);
                    b[i] = (float)acc[ai][1][m][0][i] * (sc * swb[i]); b[4 + i] = (float)acc[ai][1][m][1][i] * (sc * swb[4 + i]); }
                bf16* rowp = O + (size_t)row * PDIM;
                if (pn >= 4 && pn < 6) {
                    u32x4 w0, w1; w0.x = cvt_pk_bf16(a[0], a[1]); w0.y = cvt_pk_bf16(a[2], a[3]); w0.z = cvt_pk_bf16(a[4], a[5]); w0.w = cvt_pk_bf16(a[6], a[7]);
                    w1.x = cvt_pk_bf16(b[0], b[1]); w1.y = cvt_pk_bf16(b[2], b[3]); w1.z = cvt_pk_bf16(b[4], b[5]); w1.w = cvt_pk_bf16(b[6], b[7]);
                    *(u32x4*)(rowp + 512 + 256 * (pn - 4) + cin) = w0; *(u32x4*)(rowp + 512 + 256 * (pn - 4) + 128 + cin) = w1;
                } else {
                    float o[8];
                    if (pn < 4) {
#pragma unroll
                        for (int i = 0; i < 8; ++i) o[i] = a[i] * b[i];
                    } else {
#pragma unroll
                        for (int i = 0; i < 8; ++i) o[i] = a[i] * sigmoid_f(b[i]);
                    }
                    u32x4 w; w.x = cvt_pk_bf16(o[0], o[1]); w.y = cvt_pk_bf16(o[2], o[3]); w.z = cvt_pk_bf16(o[4], o[5]); w.w = cvt_pk_bf16(o[6], o[7]);
                    *(u32x4*)(rowp + (pn < 4 ? 128 * pn : 1024 + 128 * (pn - 6)) + cin) = w;
                }
            }
    }
};
__host__ __device__ __forceinline__ int win_src_col(int n) {
    const int t = n >> 8, j = n & 255;
    if (t < 4) return (j < 128) ? 128 * t + j : 1024 + 128 * t + (j - 128);
    if (t < 6) return 512 + 256 * (t - 4) + j;
    return (j < 128) ? 1536 + 128 * (t - 6) + j : 2048 + 128 * (t - 6) + (j - 128);
}
struct EpiResidual {
    static constexpr bool PERM = true, AFTER_DRAIN = false;
    bf16* O; const signed char* XB; const float* SX; float* ssq;
    __device__ __forceinline__ void operator()(const pg8::f32x4 (&acc)[2][2][4][2], const pg8::Unit& u, int wr, int wc, int fr, int fq) const {
        const int row0 = u.pm * 256 + wr * 64 + fr, col0 = u.pn * 256 + wc * 32 + 8 * fq;
#pragma unroll
        for (int ai = 0; ai < 2; ++ai)
#pragma unroll
            for (int m = 0; m < 4; ++m) {
                const int row = row0 + ai * 128 + m * 16;
                const signed char* xr = XB + (size_t)row * DM + col0; bf16* rowp = O + (size_t)row * DM + col0;
                float q = 0.f;
                u32x2 xw[2]; const float sxr = SX[row];
#pragma unroll
                for (int bj = 0; bj < 2; ++bj) xw[bj] = *(const u32x2*)(xr + bj * 128);
#pragma unroll
                for (int bj = 0; bj < 2; ++bj) {
                    const f32x4 x0 = (f32x4){(float)(signed char)(xw[bj].x), (float)(signed char)(xw[bj].x >> 8), (float)(signed char)(xw[bj].x >> 16), (float)((int)xw[bj].x >> 24)} * sxr,
                                x1 = (f32x4){(float)(signed char)(xw[bj].y), (float)(signed char)(xw[bj].y >> 8), (float)(signed char)(xw[bj].y >> 16), (float)((int)xw[bj].y >> 24)} * sxr;
                    const pg8::f32x4 v0 = acc[ai][bj][m][0] + x0, v1 = acc[ai][bj][m][1] + x1;
                    q += (v0[0] * v0[0] + v0[1] * v0[1]) + (v0[2] * v0[2] + v0[3] * v0[3]) + (v1[0] * v1[0] + v1[1] * v1[1]) + (v1[2] * v1[2] + v1[3] * v1[3]);
                    u32x4 w; w.x = cvt_pk_bf16(v0[0], v0[1]); w.y = cvt_pk_bf16(v0[2], v0[3]); w.z = cvt_pk_bf16(v1[0], v1[1]); w.w = cvt_pk_bf16(v1[2], v1[3]);
                    *(u32x4*)(rowp + bj * 128) = w; }
                q += __shfl_xor(q, 16); q += __shfl_xor(q, 32);
                if (fq == 0) ssq[(size_t)row * 16 + u.pn * 4 + wc] = q;
            }
    }
};

struct EpiResidualI8 {
    static constexpr bool PERM = true, AFTER_DRAIN = false;
    bf16* O; const signed char* XB; const float* SX; const float* SY; const float* SWO; float* ssq; float* amx;
    __device__ __forceinline__ void operator()(const pg8::i32x4 (&acc)[2][2][4][2], const pg8::Unit& u, int wr, int wc, int fr, int fq) const {
        const int row0 = u.pm * 256 + wr * 64 + fr, col0 = u.pn * 256 + wc * 32 + 8 * fq;
        f32x4 sw[2][2];
#pragma unroll
        for (int bj = 0; bj < 2; ++bj) { sw[bj][0] = *(const f32x4*)(SWO + col0 + bj * 128); sw[bj][1] = *(const f32x4*)(SWO + col0 + bj * 128 + 4); }
#pragma unroll
        for (int ai = 0; ai < 2; ++ai)
#pragma unroll
            for (int m = 0; m < 4; ++m) {
                const int row = row0 + ai * 128 + m * 16;
                const signed char* xr = XB + (size_t)row * DM + col0; bf16* rowp = O + (size_t)row * DM + col0;
                float q = 0.f, mxa = 0.f;
                u32x2 xw[2]; const float sxr = SX[row], syr = SY[row];
#pragma unroll
                for (int bj = 0; bj < 2; ++bj) xw[bj] = *(const u32x2*)(xr + bj * 128);
#pragma unroll
                for (int bj = 0; bj < 2; ++bj) {
                    const f32x4 x0 = (f32x4){(float)(signed char)(xw[bj].x), (float)(signed char)(xw[bj].x >> 8), (float)(signed char)(xw[bj].x >> 16), (float)((int)xw[bj].x >> 24)} * sxr,
                                x1 = (f32x4){(float)(signed char)(xw[bj].y), (float)(signed char)(xw[bj].y >> 8), (float)(signed char)(xw[bj].y >> 16), (float)((int)xw[bj].y >> 24)} * sxr;
                    const pg8::i32x4 a0 = acc[ai][bj][m][0], a1 = acc[ai][bj][m][1];
                    const f32x4 v0 = (f32x4){(float)a0[0], (float)a0[1], (float)a0[2], (float)a0[3]} * (sw[bj][0] * syr) + x0, v1 = (f32x4){(float)a1[0], (float)a1[1], (float)a1[2], (float)a1[3]} * (sw[bj][1] * syr) + x1;
                    q += (v0[0] * v0[0] + v0[1] * v0[1]) + (v0[2] * v0[2] + v0[3] * v0[3]) + (v1[0] * v1[0] + v1[1] * v1[1]) + (v1[2] * v1[2] + v1[3] * v1[3]);
                    mxa = fmaxf(mxa, fmaxf(fmaxf(fmaxf(fabsf(v0[0]), fabsf(v0[1])), fmaxf(fabsf(v0[2]), fabsf(v0[3]))), fmaxf(fmaxf(fabsf(v1[0]), fabsf(v1[1])), fmaxf(fabsf(v1[2]), fabsf(v1[3])))));
                    u32x4 w; w.x = cvt_pk_bf16(v0[0], v0[1]); w.y = cvt_pk_bf16(v0[2], v0[3]); w.z = cvt_pk_bf16(v1[0], v1[1]); w.w = cvt_pk_bf16(v1[2], v1[3]);
                    *(u32x4*)(rowp + bj * 128) = w; }
                q += __shfl_xor(q, 16); q += __shfl_xor(q, 32);
                mxa = fmaxf(mxa, __shfl_xor(mxa, 16)); mxa = fmaxf(mxa, __shfl_xor(mxa, 32));
                if (fq == 0) { ssq[(size_t)row * 16 + u.pn * 4 + wc] = q; amx[(size_t)row * 16 + u.pn * 4 + wc] = mxa; }
            }
    }
};
template <bool MAPIN> __device__ __forceinline__ void p0_transpose_item(const float* W, int K, int N, bf16* WT, LAS float* scr, int item, int lane,
                                                  const float* g_lo, const float* g_hi, int split) {
    const int nblk = N / 32, kb = item / nblk, nb = item % nblk, k0 = 64 * kb, n0 = 32 * nb;
#pragma unroll 8
    for (int i = 0; i < 32; ++i) { const int kk = 2 * i + (lane >> 5); const int k = k0 + kk;
        const float g = (k < split) ? g_lo[k] : g_hi[k - split];
        scr[kk * 33 + (lane & 31)] = W[(size_t)k * N + (MAPIN ? win_src_col(n0) : n0) + (lane & 31)] * g; }
    asm volatile("s_waitcnt lgkmcnt(0)" ::: "memory");
    const int c = lane & 7;
#pragma unroll
    for (int j = 0; j < 4; ++j) { const int n = (lane >> 3) + 8 * j; const LAS float* s = scr + (8 * c) * 33 + n;
        u32x4 o; o.x = pk2(s[0 * 33], s[1 * 33]); o.y = pk2(s[2 * 33], s[3 * 33]); o.z = pk2(s[4 * 33], s[5 * 33]); o.w = pk2(s[6 * 33], s[7 * 33]);
        *(u32x4*)(WT + (size_t)(n0 + n) * K + k0 + 8 * c) = o; }
    asm volatile("s_waitcnt lgkmcnt(0)" ::: "memory");
}

constexpr int CW_COLMAX = 5120;
__device__ __forceinline__ void p0_colmax_item(const float* W, int N, unsigned* colmax, int item, int lane, const float* g) {
    const int nblk = N / 32, kb = item / nblk, nb = item % nblk, k0 = 64 * kb, n0 = 32 * nb;
    float mx = 0.f;
#pragma unroll
    for (int i = 0; i < 32; ++i) { const int k = k0 + 2 * i + (lane >> 5); mx = fmaxf(mx, fabsf(W[(size_t)k * N + n0 + (lane & 31)] * g[k])); }
    mx = fmaxf(mx, __shfl_xor(mx, 32));
    if (lane < 32) atomicMax(colmax + n0 + lane, __float_as_uint(mx));
}
__device__ __forceinline__ void p1_quant_item(const float* W, int K, int N, signed char* WT8, float* swout, const unsigned* colmax, LAS float* scr, int item, int lane, const float* g) {
    const int nblk = N / 32, kb = item / nblk, nb = item % nblk, k0 = 64 * kb, n0 = 32 * nb, s0 = win_src_col(n0);
    const float cm = fmaxf(__uint_as_float(colmax[s0 + (lane & 31)]), 1e-30f), inv = 127.f / cm;
    if (kb == 0 && lane < 32) swout[n0 + lane] = cm * (1.f / 127.f);
#pragma unroll
    for (int i = 0; i < 32; ++i) { const int kk = 2 * i + (lane >> 5); const int k = k0 + kk;
        scr[kk * 33 + (lane & 31)] = W[(size_t)k * N + s0 + (lane & 31)] * g[k] * inv; }
    asm volatile("s_waitcnt lgkmcnt(0)" ::: "memory");
    const int c = lane & 7;
#pragma unroll
    for (int j = 0; j < 4; ++j) { const int n = (lane >> 3) + 8 * j; const LAS float* sp = scr + (8 * c) * 33 + n;
        unsigned w0 = 0u, w1 = 0u;
#pragma unroll
        for (int i = 0; i < 4; ++i) { w0 |= ((unsigned)(int)rintf(sp[i * 33]) & 255u) << (8 * i); w1 |= ((unsigned)(int)rintf(sp[(4 + i) * 33]) & 255u) << (8 * i); }
        u32x2 o; o.x = w0; o.y = w1;
        *(u32x2*)(WT8 + (size_t)(n0 + n) * K + k0 + 8 * c) = o; }
    asm volatile("s_waitcnt lgkmcnt(0)" ::: "memory");
}
constexpr int CW_COLMAX3 = 8704;
constexpr int CW_COLMAX2 = 7680;
__device__ __forceinline__ void p0_colmax_item2(const float* W, int N, unsigned* colmax, int item, int lane, const float* g_lo, const float* g_hi, int split) {
    const int nblk = N / 32, kb = item / nblk, nb = item % nblk, k0 = 64 * kb, n0 = 32 * nb;
    float mx = 0.f;
#pragma unroll
    for (int i = 0; i < 32; ++i) { const int k = k0 + 2 * i + (lane >> 5); const float g = (k < split) ? g_lo[k] : g_hi[k - split]; mx = fmaxf(mx, fabsf(W[(size_t)k * N + n0 + (lane & 31)] * g)); }
    mx = fmaxf(mx, __shfl_xor(mx, 32));
    if (lane < 32) atomicMax(colmax + n0 + lane, __float_as_uint(mx));
}
__device__ __forceinline__ void p1_quant_item2(const float* W, int K, int N, signed char* WT8, float* swout, const unsigned* colmax, LAS float* scr, int item, int lane, const float* g_lo, const float* g_hi, int split) {
    const int nblk = N / 32, kb = item / nblk, nb = item % nblk, k0 = 64 * kb, n0 = 32 * nb;
    const float cm = fmaxf(__uint_as_float(colmax[n0 + (lane & 31)]), 1e-30f), inv = 127.f / cm;
    if (kb == 0 && lane < 32) swout[n0 + lane] = cm * (1.f / 127.f);
#pragma unroll
    for (int i = 0; i < 32; ++i) { const int kk = 2 * i + (lane >> 5); const int k = k0 + kk; const float g = (k < split) ? g_lo[k] : g_hi[k - split];
        scr[kk * 33 + (lane & 31)] = W[(size_t)k * N + n0 + (lane & 31)] * g * inv; }
    asm volatile("s_waitcnt lgkmcnt(0)" ::: "memory");
    const int c = lane & 7;
#pragma unroll
    for (int j = 0; j < 4; ++j) { const int n = (lane >> 3) + 8 * j; const LAS float* sp = scr + (8 * c) * 33 + n;
        unsigned w0 = 0u, w1 = 0u;
#pragma unroll
        for (int i = 0; i < 4; ++i) { w0 |= ((unsigned)(int)rintf(sp[i * 33]) & 255u) << (8 * i); w1 |= ((unsigned)(int)rintf(sp[(4 + i) * 33]) & 255u) << (8 * i); }
        u32x2 o; o.x = w0; o.y = w1;
        *(u32x2*)(WT8 + (size_t)(n0 + n) * K + k0 + 8 * c) = o; }
    asm volatile("s_waitcnt lgkmcnt(0)" ::: "memory");
}
__device__ __forceinline__ void phase_winq(const Params& P, LAS unsigned char* lds) {
    const int tid = threadIdx.x, lane = tid & 63, wave = __builtin_amdgcn_readfirstlane(tid >> 6);
    const int gw = blockIdx.x * NWAVES + wave, NGW = gridDim.x * NWAVES;
    LAS float* scr = (LAS float*)(lds + wave * 16384);
    constexpr int NI1 = (DM / 64) * (DIN / 32), NI2 = (DM / 64) * (DM / 32), NI3 = (DM / 64) * (2048 / 32);
    for (int it = gw; it < NI1 + NI2 + NI3; it += NGW) {
        if (it < NI1) p1_quant_item(P.w_in, DM, DIN, (signed char*)(P.ws + WS_WIN_T), (float*)(P.ws + WS_SW), (const unsigned*)(P.ws + WS_CTL) + CW_COLMAX, scr, it, lane, P.g_mix);
        else if (it < NI1 + NI2) p1_quant_item2(P.w_out, DM, DM, (signed char*)(P.ws + WS_WOUT_T), (float*)(P.ws + WS_SWO), (const unsigned*)(P.ws + WS_CTL) + CW_COLMAX2, scr, it - NI1, lane, P.g_sc, P.g_cf, 512);
        else p1_quant_item2(P.w_q, DM, 2048, (signed char*)(P.ws + WS_WQ_T), (float*)(P.ws + WS_SWQ), (const unsigned*)(P.ws + WS_CTL) + CW_COLMAX3, scr, it - NI1 - NI2, lane, P.g_ffn, P.g_ffn, DM);
    }
}
__device__ __forceinline__ float q4(float x, float inv_s) {
    const float a = fabsf(x) * inv_s; float r;
    if (a < 2.f) r = rintf(a * 2.f) * 0.5f; else if (a < 4.f) r = rintf(a); else r = fminf(6.f, rintf(a * 0.5f) * 2.f);
    return copysignf(r, x);
}
__device__ __forceinline__ void phase_prep(const Params& P, LAS unsigned char* lds) {
    const int tid = threadIdx.x, lane = tid & 63, wave = __builtin_amdgcn_readfirstlane(tid >> 6);
    const int gw = blockIdx.x * NWAVES + wave, NGW = gridDim.x * NWAVES;
    unsigned char* ws = P.ws;
    LAS float* scr = (LAS float*)(lds + wave * 16384);
    constexpr int I_IN = (DM / 64) * (DIN / 32), I_OUT = (DM / 64) * (DM / 32), I_Q = (DM / 64) * (2048 / 32);
    for (int it = gw; it < I_IN + I_OUT + I_Q; it += NGW) {
        int r = it;
        if (r < I_IN) { p0_colmax_item(P.w_in, DIN, (unsigned*)(ws + WS_CTL) + CW_COLMAX, r, lane, P.g_mix); continue; } r -= I_IN;
        if (r < I_OUT) { p0_colmax_item2(P.w_out, DM, (unsigned*)(ws + WS_CTL) + CW_COLMAX2, r, lane, P.g_sc, P.g_cf, 512); continue; } r -= I_OUT;
        p0_colmax_item2(P.w_q, 2048, (unsigned*)(ws + WS_CTL) + CW_COLMAX3, r, lane, P.g_ffn, P.g_ffn, DM);
    }
    {
        unsigned* H0I8 = (unsigned*)(ws + WS_H0I8); float* RS1 = (float*)(ws + WS_RSTD1); float* SXp = (float*)(ws + WS_SX);
        for (int t0 = gw * 4; t0 < NTOK; t0 += NGW * 4) {
            f32x4 v[4][4];
#pragma unroll
            for (int q = 0; q < 4; ++q) { const f32x4* xr = (const f32x4*)(P.x + (size_t)(t0 + q) * DM) + lane;
#pragma unroll
                for (int j = 0; j < 4; ++j) v[q][j] = xr[64 * j]; }
#pragma unroll
            for (int q = 0; q < 4; ++q) { float sq = 0.f, mx = 0.f;
#pragma unroll
                for (int j = 0; j < 4; ++j) { sq += (v[q][j].x * v[q][j].x + v[q][j].y * v[q][j].y) + (v[q][j].z * v[q][j].z + v[q][j].w * v[q][j].w);
                    mx = fmaxf(mx, fmaxf(fmaxf(fabsf(v[q][j].x), fabsf(v[q][j].y)), fmaxf(fabsf(v[q][j].z), fabsf(v[q][j].w)))); }
                sq = wave_sum_fast(sq); mx = fmaxf(wave_max_fast(mx), 1e-30f);
                const float sx = mx * (1.f / 127.f), inv = 127.f / mx;
                if (lane == 0) { RS1[t0 + q] = sx * rsqrtf(sq * (1.f / DM) + EPS); SXp[t0 + q] = sx; }
                unsigned* o = H0I8 + (size_t)(t0 + q) * (DM / 4) + lane;
#pragma unroll
                for (int j = 0; j < 4; ++j) { const int a = (int)rintf(v[q][j].x * inv), b = (int)rintf(v[q][j].y * inv), c = (int)rintf(v[q][j].z * inv), d = (int)rintf(v[q][j].w * inv);
                    o[64 * j] = ((unsigned)a & 255u) | (((unsigned)b & 255u) << 8) | (((unsigned)c & 255u) << 16) | ((unsigned)d << 24); } }
        }
    }
    {
        unsigned char* U8 = ws + WS_U8; unsigned char* V8 = ws + WS_V8;
        f32x4 gf[4];
#pragma unroll
        for (int j = 0; j < 4; ++j) gf[j] = ((const f32x4*)P.g_ffn)[64 * j + lane];
        float* ESC = (float*)(ws + WS_ESCALE);
        for (int e0 = gw * 2; e0 < 2 * 16384; e0 += NGW * 2) {
            const bool isv = e0 >= 16384; const int ee0 = isv ? e0 - 16384 : e0;
            f32x4 v[2][4];
#pragma unroll
            for (int q = 0; q < 2; ++q) { const f32x4* src = (const f32x4*)((isv ? P.pv : P.pu) + (size_t)(ee0 + q) * DM);
#pragma unroll
                for (int j = 0; j < 4; ++j) v[q][j] = isv ? src[4 * lane + j] : src[64 * j + lane]; }
#pragma unroll
            for (int q = 0; q < 2; ++q) {
                float mx = 0.f;
#pragma unroll
                for (int j = 0; j < 4; ++j) { if (!isv) v[q][j] = v[q][j] * gf[j];
                    mx = fmaxf(mx, fmaxf(fmaxf(fabsf(v[q][j].x), fabsf(v[q][j].y)), fmaxf(fabsf(v[q][j].z), fabsf(v[q][j].w)))); }
#pragma unroll
                for (int o = 1; o < 64; o <<= 1) mx = fmaxf(mx, __shfl_xor(mx, o));
                if (!isv) {
                    float sq2 = 0.f;
#pragma unroll
                    for (int j = 0; j < 4; ++j) sq2 += (v[q][j].x * v[q][j].x + v[q][j].y * v[q][j].y) + (v[q][j].z * v[q][j].z + v[q][j].w * v[q][j].w);
                    const float rms = sqrtf(wave_sum_fast(sq2) * (1.f / DM));
                    const float su = fmaxf(fminf(mx, U4_CLIP * rms), 1e-30f) * (1.f / 7.f), inv = 1.f / su;
                    unsigned wq[2] = {0u, 0u}; int csum = 0;
#pragma unroll
                    for (int j = 0; j < 4; ++j) { const float e4[4] = {v[q][j].x, v[q][j].y, v[q][j].z, v[q][j].w};
#pragma unroll
                        for (int i = 0; i < 4; ++i) { int c = (int)rintf(fminf(fmaxf(e4[i] * inv, -7.f), 7.f)); csum += c;
                            wq[j >> 1] |= ((unsigned)c & 15u) << (16 * (j & 1) + 4 * i); } }
                    const float cs = wave_sum_fast((float)csum);
                    if (lane == 0) { ESC[e0 + q] = su; ((float*)(ws + WS_SUMQ))[e0 + q] = cs; }
                    u32x2 o; o.x = wq[0]; o.y = wq[1];
                    *(u32x2*)(U8 + (size_t)(ee0 + q) * 512 + 8 * lane) = o;
                    continue;
                }
                const float sc = fmaxf(mx, 1e-30f) * (1.f / 6.f), inv = 1.f / sc;
                if (lane == 0) ESC[e0 + q] = sc;
                unsigned w0 = 0u, w1 = 0u;
                w0 = __builtin_amdgcn_cvt_scalef32_pk_fp4_f32(w0, v[q][0].x * inv, v[q][0].y * inv, 1.0f, 0); w0 = __builtin_amdgcn_cvt_scalef32_pk_fp4_f32(w0, v[q][0].z * inv, v[q][0].w * inv, 1.0f, 1);
                w0 = __builtin_amdgcn_cvt_scalef32_pk_fp4_f32(w0, v[q][1].x * inv, v[q][1].y * inv, 1.0f, 2); w0 = __builtin_amdgcn_cvt_scalef32_pk_fp4_f32(w0, v[q][1].z * inv, v[q][1].w * inv, 1.0f, 3);
                w1 = __builtin_amdgcn_cvt_scalef32_pk_fp4_f32(w1, v[q][2].x * inv, v[q][2].y * inv, 1.0f, 0); w1 = __builtin_amdgcn_cvt_scalef32_pk_fp4_f32(w1, v[q][2].z * inv, v[q][2].w * inv, 1.0f, 1);
                w1 = __builtin_amdgcn_cvt_scalef32_pk_fp4_f32(w1, v[q][3].x * inv, v[q][3].y * inv, 1.0f, 2); w1 = __builtin_amdgcn_cvt_scalef32_pk_fp4_f32(w1, v[q][3].z * inv, v[q][3].w * inv, 1.0f, 3);
                u32x2 o; o.x = w0; o.y = w1;
                *(u32x2*)((isv ? V8 : U8) + (size_t)(ee0 + q) * 512 + 8 * lane) = o;
            }
        }
    }
    {
        bf16* KB = (bf16*)(ws + WS_KEYS);
        const int gt = blockIdx.x * NTHREADS + tid, NGT = gridDim.x * NTHREADS;
        for (int i = gt; i < 8 * 2 * 128 * 128 / 4; i += NGT) { const f32x4 v = ((const f32x4*)P.keys)[i]; u32x2 w; w.x = pk2(v.x, v.y); w.y = pk2(v.z, v.w); ((u32x2*)KB)[i] = w; }
    }
    {
        float* MP = (float*)(ws + WS_METAPART); float* MR = (float*)(ws + WS_METARSTD);
        for (int r = gw; r < NMETA; r += NGW) {
            float s = 0.f;
            for (int k = lane; k < DM; k += 64) { const float v = P.meta[r * DM + k]; s += v * v; }
            s = wave_sum(s);
            if (lane == 0) MR[r] = rsqrtf(s * (1.f / DM) + EPS);
        }
        for (int it = gw; it < MKC * 40; it += NGW) {
            const int kc = it / 40, nb = it % 40, n = nb * 64 + lane;
            float acc[NMETA];
#pragma unroll
            for (int r = 0; r < NMETA; ++r) acc[r] = 0.f;
            for (int k = kc * (DM / MKC); k < (kc + 1) * (DM / MKC); ++k) {
                const float w = P.w_in[(size_t)k * DIN + n] * P.g_mix[k];
#pragma unroll
                for (int r = 0; r < NMETA; ++r) acc[r] += P.meta[r * DM + k] * w;
            }
#pragma unroll
            for (int r = 0; r < NMETA; ++r) MP[(size_t)(kc * 16 + r) * DIN + n] = acc[r];
        }
    }
}

__device__ __forceinline__ float metaraw(const float* MP, const float* MR, int p, int col) { float s = 0.f;
#pragma unroll 8
    for (int kc = 0; kc < MKC; ++kc) s += MP[(size_t)(kc * 16 + p) * DIN + col];
    return s * MR[p]; }
__device__ __forceinline__ void phase_metaproj(const Params& P) {
    const float* MP = (const float*)(P.ws + WS_METAPART); const float* MR = (const float*)(P.ws + WS_METARSTD); float* MJ = (float*)(P.ws + WS_METAPROJ);
    for (int gt = blockIdx.x * NTHREADS + threadIdx.x; gt < NMETA * PDIM; gt += gridDim.x * NTHREADS) { const int p = gt / PDIM, c = gt % PDIM; float v;
        if (c < 512) v = metaraw(MP, MR, p, c) * metaraw(MP, MR, p, 1024 + c);
        else if (c < 1024) v = metaraw(MP, MR, p, c);
        else v = metaraw(MP, MR, p, 1536 + (c - 1024)) * sigmoid_f(metaraw(MP, MR, p, 2048 + (c - 1024)));
        MJ[gt] = v; }
}
__device__ __forceinline__ float meta_val(const float* MJ, const float*, int p, int col) { return MJ[p * PDIM + col]; }
__device__ __forceinline__ float proj_at(const bf16* PROJ, const float* MP, const float* MR, int b, int pos, int col) {
    if (pos < 0) return 0.f;
    if (pos < NMETA) return meta_val(MP, MR, pos, col);
    return bf2f(PROJ[(size_t)(b * SEQ + pos - NMETA) * PDIM + col]);
}
__device__ __forceinline__ void proj8_at(const bf16* PROJ, const float* MP, const float* MR, int b, int pos, int col, float (&v)[8]) {
    if (pos < 0) {
#pragma unroll
        for (int i = 0; i < 8; ++i) v[i] = 0.f;
    } else if (pos < NMETA) {
        const f32x4 a = *(const f32x4*)(MP + pos * PDIM + col), bq = *(const f32x4*)(MP + pos * PDIM + col + 4);
        v[0] = a.x; v[1] = a.y; v[2] = a.z; v[3] = a.w; v[4] = bq.x; v[5] = bq.y; v[6] = bq.z; v[7] = bq.w;
    } else {
        const u32x4 w = *(const u32x4*)(PROJ + (size_t)(b * SEQ + pos - NMETA) * PDIM + col);
        v[0] = bflo(w.x); v[1] = bfhi(w.x); v[2] = bflo(w.y); v[3] = bfhi(w.y); v[4] = bflo(w.z); v[5] = bfhi(w.z); v[6] = bflo(w.w); v[7] = bfhi(w.w);
    }
}

template <int R> __device__ __forceinline__ void conv_rows(const LAS unsigned char* ubase, const f32x2 (&wcf)[31], f32x2 (&acc)[32]) {
    if constexpr (R < 62) {
        const unsigned uw = *(const LAS unsigned*)(ubase + R * 1024);
        const f32x2 x = (f32x2){bflo(uw), bfhi(uw)};
        constexpr int lo = R > 30 ? R - 30 : 0, hi = R < 31 ? R : 31;
#pragma unroll
        for (int ii = lo; ii <= hi; ++ii) acc[ii] += wcf[R - ii] * x;
        conv_rows<R + 1>(ubase, wcf, acc);
    }
}
__device__ __forceinline__ void phase_conv(const Params& P, LAS unsigned char* lds) {
    const int tid = threadIdx.x, lane = tid & 63, wave = __builtin_amdgcn_readfirstlane(tid >> 6);
    unsigned char* ws = P.ws;
    const bf16* PROJ = (const bf16*)(ws + WS_PROJ); const float* MP = (const float*)(ws + WS_METAPROJ); const float* MR = nullptr;
    bf16* Y = (bf16*)(ws + WS_Y);
    constexpr int TT = 64, NTILE = NTOK / TT, UROWS = TT + 30;
    const int cgp = wave & 3, th = wave >> 2, ch2 = cgp * 128 + 2 * lane;
    f32x2 wcf[31];
#pragma unroll
    for (int j = 0; j < 31; ++j) wcf[j] = *(const f32x2*)(P.cf_w + j * 512 + ch2);
    const f32x2 bcf = *(const f32x2*)(P.cf_b + ch2);
    for (int tile = blockIdx.x; tile < NTILE; tile += gridDim.x) {
        const int b = tile / (SEQ / TT), s0 = (tile % (SEQ / TT)) * TT;
#pragma unroll 4
        for (int p = 0; p < (UROWS + 7) / 8; ++p) {
            const int r = p * 8 + wave;
            if (r < UROWS) {
                const int pos = NMETA + s0 - 30 + r;
                float uu[8];
                proj8_at(PROJ, MP, MR, b, pos, 1024 + 8 * lane, uu);
                u32x4 w; w.x = pk2(uu[0], uu[1]); w.y = pk2(uu[2], uu[3]); w.z = pk2(uu[4], uu[5]); w.w = pk2(uu[6], uu[7]);
                *(LAS u32x4*)(lds + r * 1024 + lane * 16) = w;
            }
        }
        __syncthreads();
        f32x2 acc[32];
#pragma unroll
        for (int ii = 0; ii < 32; ++ii) acc[ii] = bcf;
        conv_rows<0>(lds + (32 * th) * 1024 + ch2 * 2, wcf, acc);
        u32x4 rcx[8], rbg[8];
        { const bf16* pr = PROJ + ((size_t)b * SEQ + s0 + 8 * wave) * PDIM + 8 * lane;
#pragma unroll
          for (int q = 0; q < 8; ++q) { rcx[q] = *(const u32x4*)(pr + (size_t)q * PDIM); rbg[q] = *(const u32x4*)(pr + (size_t)q * PDIM + 512); } }
        __syncthreads();
#pragma unroll
        for (int ii = 0; ii < 32; ++ii) *(LAS f32x2*)(lds + (32 * th + ii) * 2048 + ch2 * 4) = acc[ii];
        __syncthreads();
        {
            float lng[8], lnb[8];
            { const f32x4 a = *(const f32x4*)(P.ln_g + 8 * lane), c = *(const f32x4*)(P.ln_g + 8 * lane + 4), d = *(const f32x4*)(P.ln_b + 8 * lane), e = *(const f32x4*)(P.ln_b + 8 * lane + 4);
              lng[0] = a.x; lng[1] = a.y; lng[2] = a.z; lng[3] = a.w; lng[4] = c.x; lng[5] = c.y; lng[6] = c.z; lng[7] = c.w;
              lnb[0] = d.x; lnb[1] = d.y; lnb[2] = d.z; lnb[3] = d.w; lnb[4] = e.x; lnb[5] = e.y; lnb[6] = e.z; lnb[7] = e.w; }
            float wsc[3][8];
#pragma unroll
            for (int j = 0; j < 3; ++j) { const f32x4 a = *(const f32x4*)(P.sc_w + j * 512 + 8 * lane), c = *(const f32x4*)(P.sc_w + j * 512 + 8 * lane + 4);
                wsc[j][0] = a.x; wsc[j][1] = a.y; wsc[j][2] = a.z; wsc[j][3] = a.w; wsc[j][4] = c.x; wsc[j][5] = c.y; wsc[j][6] = c.z; wsc[j][7] = c.w; }
            float cxa[8], cxb[8];
            { const int pos = NMETA + s0 + 8 * wave - 2;
              proj8_at(PROJ, MP, MR, b, pos, 8 * lane, cxa); proj8_at(PROJ, MP, MR, b, pos + 1, 8 * lane, cxb); }
#pragma unroll
            for (int q = 0; q < 8; ++q) {
                const int ii = 8 * wave + q, s = s0 + ii; const size_t t = (size_t)b * SEQ + s;
                float o[8];
                { const f32x4 a = *(const LAS f32x4*)(lds + ii * 2048 + lane * 32), c = *(const LAS f32x4*)(lds + ii * 2048 + lane * 32 + 16);
                  o[0] = a.x; o[1] = a.y; o[2] = a.z; o[3] = a.w; o[4] = c.x; o[5] = c.y; o[6] = c.z; o[7] = c.w; }
                float s1 = 0.f;
#pragma unroll
                for (int i = 0; i < 8; ++i) s1 += o[i];
                const float mean = wave_sum_fast(s1) * (1.f / 512.f);
                float s2 = 0.f;
#pragma unroll
                for (int i = 0; i < 8; ++i) { o[i] -= mean; s2 += o[i] * o[i]; }
                const float rs = rsqrtf(wave_sum_fast(s2) * (1.f / 512.f) + EPS);
                float s3 = 0.f;
#pragma unroll
                for (int i = 0; i < 8; ++i) { float y = o[i] * rs * lng[i] + lnb[i]; y = y * sigmoid_f(y); o[i] = y; s3 += y * y; }
                const float r2 = rsqrtf(wave_sum_fast(s3) * (1.f / 512.f) + EPS);
                float bgv[8], cxc[8], accs[8];
                { const u32x4 w = rcx[q], z = rbg[q];
                  cxc[0] = bflo(w.x); cxc[1] = bfhi(w.x); cxc[2] = bflo(w.y); cxc[3] = bfhi(w.y); cxc[4] = bflo(w.z); cxc[5] = bfhi(w.z); cxc[6] = bflo(w.w); cxc[7] = bfhi(w.w);
                  bgv[0] = bflo(z.x); bgv[1] = bfhi(z.x); bgv[2] = bflo(z.y); bgv[3] = bfhi(z.y); bgv[4] = bflo(z.z); bgv[5] = bfhi(z.z); bgv[6] = bflo(z.w); bgv[7] = bfhi(z.w); }
                float s4 = 0.f;
#pragma unroll
                for (int i = 0; i < 8; ++i) { accs[i] = bgv[i] * (wsc[0][i] * cxa[i] + wsc[1][i] * cxb[i] + wsc[2][i] * cxc[i]); s4 += accs[i] * accs[i]; cxa[i] = cxb[i]; cxb[i] = cxc[i]; }
                const float r4 = rsqrtf(wave_sum_fast(s4) * (1.f / 512.f) + EPS);
                float ym = 0.f;
#pragma unroll
                for (int i = 0; i < 8; ++i) { o[i] *= r2; accs[i] *= r4; ym = fmaxf(ym, fmaxf(fabsf(o[i]), fabsf(accs[i]))); }
                ym = fmaxf(wave_max_fast(ym), 1e-30f);
                const float yinv = 127.f / ym;
                if (lane == 0) ((float*)(ws + WS_SY))[t] = ym * (1.f / 127.f);
                u32x2 wz, wv;
                wz.x = ((unsigned)(int)rintf(accs[0] * yinv) & 255u) | (((unsigned)(int)rintf(accs[1] * yinv) & 255u) << 8) | (((unsigned)(int)rintf(accs[2] * yinv) & 255u) << 16) | ((unsigned)(int)rintf(accs[3] * yinv) << 24);
                wz.y = ((unsigned)(int)rintf(accs[4] * yinv) & 255u) | (((unsigned)(int)rintf(accs[5] * yinv) & 255u) << 8) | (((unsigned)(int)rintf(accs[6] * yinv) & 255u) << 16) | ((unsigned)(int)rintf(accs[7] * yinv) << 24);
                wv.x = ((unsigned)(int)rintf(o[0] * yinv) & 255u) | (((unsigned)(int)rintf(o[1] * yinv) & 255u) << 8) | (((unsigned)(int)rintf(o[2] * yinv) & 255u) << 16) | ((unsigned)(int)rintf(o[3] * yinv) << 24);
                wv.y = ((unsigned)(int)rintf(o[4] * yinv) & 255u) | (((unsigned)(int)rintf(o[5] * yinv) & 255u) << 8) | (((unsigned)(int)rintf(o[6] * yinv) & 255u) << 16) | ((unsigned)(int)rintf(o[7] * yinv) << 24);
                *(u32x2*)(ws + WS_Y + t * DM + 8 * lane) = wz;
                *(u32x2*)(ws + WS_Y + t * DM + 512 + 8 * lane) = wv;
            }
        }
        __syncthreads();
    }
}

__device__ __forceinline__ int ord_i(float s) { int k = __builtin_bit_cast(int, s); k ^= (k >> 31) & 0x7fffffff; return k; }
__device__ __forceinline__ float unord_f(int k) { k ^= (k >> 31) & 0x7fffffff; return __builtin_bit_cast(float, k); }
#define TOP_INSERT(L, x_) do { int _x = (x_); _Pragma("unroll") for (int _i = 0; _i < 16; ++_i) { const int _hi = max(L[_i], _x); _x = min(L[_i], _x); L[_i] = _hi; } } while (0)

typedef short bf16x8 __attribute__((ext_vector_type(8)));
typedef float f32x16 __attribute__((ext_vector_type(16)));
template <bool DESC> __device__ __forceinline__ void ce_i(int& a, int& b) { const int hi = max(a, b), lo = min(a, b); if (DESC) { a = hi; b = lo; } else { a = lo; b = hi; } }
__device__ __forceinline__ void bitonic_sort16(int (&a)[16]) {
#pragma unroll
    for (int k = 2; k <= 16; k <<= 1)
#pragma unroll
        for (int j = k >> 1; j > 0; j >>= 1)
#pragma unroll
            for (int i = 0; i < 16; ++i) { const int l = i ^ j; if (l > i) { if ((i & k) == 0) ce_i<true>(a[i], a[l]); else ce_i<false>(a[i], a[l]); } }
}
__device__ __forceinline__ void bitonic_merge16(int (&a)[16]) {
#pragma unroll
    for (int j = 8; j > 0; j >>= 1)
#pragma unroll
        for (int i = 0; i < 16; ++i) { const int l = i ^ j; if (l > i) ce_i<true>(a[i], a[l]); }
}
__device__ __forceinline__ void merge_top16(int (&a)[16], const int (&b)[16]) {
#pragma unroll
    for (int i = 0; i < 16; ++i) a[i] = max(a[i], b[15 - i]);
    bitonic_merge16(a);
}
__device__ __forceinline__ int lut16(const unsigned (&T)[4], int i) {
    const unsigned sel = (unsigned)(i & 7) | 0x0c0c0c00u;
    const unsigned lo = __builtin_amdgcn_perm(T[1], T[0], sel), hi = __builtin_amdgcn_perm(T[3], T[2], sel);
    return (int)((i & 8) ? hi : lo);
}
constexpr int KROW = 272;
constexpr float SCORE_BIAS = 8.0f;

__device__ __forceinline__ void route_load_q(bf16x8 (&qf)[8], const bf16* qrow, int hb) {
#pragma unroll
    for (int ks = 0; ks < 8; ++ks) qf[ks] = *(const bf16x8*)(qrow + 64 * hb + 8 * ks);
}
__device__ __forceinline__ void route_half(const LAS unsigned char* kl, const bf16x8 (&qf)[8], int nl, int hb, int (&L)[16]) {
    f32x16 acc[4];
#pragma unroll
    for (int nt = 0; nt < 4; ++nt)
#pragma unroll
        for (int r = 0; r < 16; ++r) acc[nt][r] = SCORE_BIAS;
#pragma unroll
    for (int ks = 0; ks < 8; ++ks)
#pragma unroll
        for (int nt = 0; nt < 4; ++nt) {
            const bf16x8 a = *(const LAS bf16x8*)(kl + (32 * nt + nl) * KROW + (64 * hb + 8 * ks) * 2);
            acc[nt] = __builtin_amdgcn_mfma_f32_32x32x16_bf16(a, qf[ks], acc[nt], 0, 0, 0);
        }
    const int hb4 = 4 * hb;
    int T[4][16];
#pragma unroll
    for (int nt = 0; nt < 4; ++nt)
#pragma unroll
        for (int r = 0; r < 16; ++r) { const int n0 = 32 * nt + (r & 3) + 8 * (r >> 2); const float sc = acc[nt][r];
            T[nt][r] = (__float_as_int(sc) & ~127) | ((127 - n0) - hb4); }
    bitonic_sort16(T[0]); bitonic_sort16(T[1]); bitonic_sort16(T[2]); bitonic_sort16(T[3]);
    merge_top16(T[0], T[1]); merge_top16(T[2], T[3]); merge_top16(T[0], T[2]);
#pragma unroll
    for (int i = 0; i < 16; ++i) { const unsigned v = (unsigned)T[0][15 - i]; auto r = __builtin_amdgcn_permlane32_swap(v, v, false, false);
        const unsigned r0 = r[0], r1 = r[1]; const int partner = (int)(hb ? r0 : r1); L[i] = max(T[0][i], partner); }
    bitonic_merge16(L);
}

__device__ __forceinline__ void phase_route(const Params& P, LAS unsigned char* lds) {
    const int tid = threadIdx.x, lane = tid & 63, wave = __builtin_amdgcn_readfirstlane(tid >> 6);
    const int nl = lane & 31, hb = lane >> 5;
    unsigned char* ws = P.ws;
    const bf16* KEYS = (const bf16*)(ws + WS_KEYS); const bf16* Q = (const bf16*)(ws + WS_Q);
    int* IDX = (int*)(ws + WS_IDX); float* GATE = (float*)(ws + WS_GATE);
    int last_h = -1;
    pg8::StaticOrder S; S.init(NTOK, 2048, (int)gridDim.x, (int)blockIdx.x);
    pg8::Unit ucur, unxt;
    bool have = S.next(0, ucur);
    bf16x8 qfA[8], qfB[8];
    if (have) route_load_q(qfA, Q + ((size_t)ucur.pm * 256 + wave * 32 + nl) * 2048 + ucur.pn * 256, hb);
    for (int ui = 0; have; ++ui) {
        const int h = ucur.pn, tb = ucur.pm;
        const bool have_next = S.next(ui + 1, unxt);
        if (h != last_h) {
            __syncthreads();
            for (int c = tid; c < 4096; c += NTHREADS) { const u32x4 v = ((const u32x4*)(KEYS + (size_t)h * 32768))[c];
                *(LAS u32x4*)(lds + (c >> 4) * KROW + (c & 15) * 16) = v; }
            __syncthreads();
            last_h = h;
        }
        const size_t t = (size_t)tb * 256 + wave * 32 + nl;
        int L1[16], L2[16];
        route_load_q(qfB, Q + t * 2048 + h * 256 + 128, hb);
        route_half(lds, qfA, nl, hb, L1);
        if (have_next) route_load_q(qfA, Q + ((size_t)unxt.pm * 256 + wave * 32 + nl) * 2048 + unxt.pn * 256, hb);
        route_half(lds + 128 * KROW, qfB, nl, hb, L2);
        float v1[16], v2[16];
#pragma unroll
        for (int i = 0; i < 16; ++i) { v1[i] = __int_as_float(L1[i] & ~127); v2[i] = __int_as_float(L2[i] & ~127); }
#define CAND(i, j) ((__float_as_int(v1[i] + v2[j]) & ~255) | (255 - (16 * (i) + (j))))
        int A[16], B[16], C[16];
#pragma unroll
        for (int j = 0; j < 16; ++j) A[j] = CAND(0, j);
#pragma unroll
        for (int j = 0; j < 8; ++j) { B[j] = CAND(1, j); B[8 + j] = CAND(15 - j, 0); }
        bitonic_merge16(B);
        C[0] = CAND(2, 0); C[1] = CAND(2, 1); C[2] = CAND(2, 2); C[3] = CAND(2, 3); C[4] = CAND(2, 4);
        C[5] = CAND(3, 0); C[6] = CAND(3, 1); C[7] = CAND(3, 2); C[8] = CAND(3, 3);
        C[9] = CAND(4, 0); C[10] = CAND(4, 1); C[11] = CAND(4, 2);
        C[12] = CAND(5, 0); C[13] = CAND(5, 1); C[14] = CAND(6, 0); C[15] = CAND(6, 1);
        bitonic_sort16(C);
        { const int d0 = CAND(7, 0), d1 = CAND(7, 1); C[14] = max(C[14], d1); C[15] = max(C[15], d0); bitonic_merge16(C); }
#undef CAND
        merge_top16(A, B); merge_top16(A, C);
        unsigned T1[4], T2[4];
#pragma unroll
        for (int q = 0; q < 4; ++q) {
            T1[q] = (unsigned)(127 - (L1[4 * q] & 127)) | ((unsigned)(127 - (L1[4 * q + 1] & 127)) << 8) | ((unsigned)(127 - (L1[4 * q + 2] & 127)) << 16) | ((unsigned)(127 - (L1[4 * q + 3] & 127)) << 24);
            T2[q] = (unsigned)(127 - (L2[4 * q] & 127)) | ((unsigned)(127 - (L2[4 * q + 1] & 127)) << 8) | ((unsigned)(127 - (L2[4 * q + 2] & 127)) << 16) | ((unsigned)(127 - (L2[4 * q + 3] & 127)) << 24); }
        float val[16]; int ex[16];
#pragma unroll
        for (int k = 0; k < 16; ++k) { const int pos = 255 - (A[k] & 255); val[k] = __int_as_float(A[k] & ~255);
            ex[k] = lut16(T1, pos >> 4) * NKEYS + lut16(T2, pos & 15); }
        float sum = 0.f; const float vmax = val[0];
#pragma unroll
        for (int k = 0; k < 16; ++k) { val[k] = __expf(val[k] - vmax); sum += val[k]; }
        const float inv = 1.f / sum;
        if (hb == 0) {
            int* ip = IDX + t * NSEL + h * TOPK; float* gp = GATE + t * NSEL + h * TOPK;
#pragma unroll
            for (int k4 = 0; k4 < 4; ++k4) {
                *(int4*)(ip + 4 * k4) = make_int4(ex[4 * k4], ex[4 * k4 + 1], ex[4 * k4 + 2], ex[4 * k4 + 3]);
                *(f32x4*)(gp + 4 * k4) = (f32x4){val[4 * k4] * inv, val[4 * k4 + 1] * inv, val[4 * k4 + 2] * inv, val[4 * k4 + 3] * inv};
            }
        }
        ucur = unxt; have = have_next;
    }
}

#define FP4X2(w, sel) __builtin_amdgcn_cvt_scalef32_pk_f32_fp4((w), 1.0f, (sel))
__device__ __forceinline__ float dot16_fp4(const u32x2 r, const f32x4 (&xs)[4]) {
    float p = 0.f;
    { const f32x2 a = FP4X2(r.x, 0), b = FP4X2(r.x, 1), c = FP4X2(r.x, 2), d = FP4X2(r.x, 3);
      p += (a.x * xs[0].x + a.y * xs[0].y) + (b.x * xs[0].z + b.y * xs[0].w); p += (c.x * xs[1].x + c.y * xs[1].y) + (d.x * xs[1].z + d.y * xs[1].w); }
    { const f32x2 a = FP4X2(r.y, 0), b = FP4X2(r.y, 1), c = FP4X2(r.y, 2), d = FP4X2(r.y, 3);
      p += (a.x * xs[2].x + a.y * xs[2].y) + (b.x * xs[2].z + b.y * xs[2].w); p += (c.x * xs[3].x + c.y * xs[3].y) + (d.x * xs[3].z + d.y * xs[3].w); }
    return p;
}
__device__ __forceinline__ void axpy16_fp4(const u32x2 r, float w, f32x4 (&o)[4]) {
    { const f32x2 a = FP4X2(r.x, 0), b = FP4X2(r.x, 1), c = FP4X2(r.x, 2), d = FP4X2(r.x, 3);
      o[0].x += w * a.x; o[0].y += w * a.y; o[0].z += w * b.x; o[0].w += w * b.y; o[1].x += w * c.x; o[1].y += w * c.y; o[1].z += w * d.x; o[1].w += w * d.y; }
    { const f32x2 a = FP4X2(r.y, 0), b = FP4X2(r.y, 1), c = FP4X2(r.y, 2), d = FP4X2(r.y, 3);
      o[2].x += w * a.x; o[2].y += w * a.y; o[2].z += w * b.x; o[2].w += w * b.y; o[3].x += w * c.x; o[3].y += w * c.y; o[3].z += w * d.x; o[3].w += w * d.y; }
}
__device__ __forceinline__ float swap32_add(float a, float b) { auto r = __builtin_amdgcn_permlane32_swap(__float_as_uint(a), __float_as_uint(b), false, false); return __uint_as_float(r[0]) + __uint_as_float(r[1]); }
__device__ __forceinline__ float swap16_add(float a, float b) { auto r = __builtin_amdgcn_permlane16_swap(__float_as_uint(a), __float_as_uint(b), false, false); return __uint_as_float(r[0]) + __uint_as_float(r[1]); }
__device__ __forceinline__ float row_sum16(float v) { v += dpp_f<0xB1>(v); v += dpp_f<0x4E>(v); v += dpp_f<0x141>(v); v += dpp_f<0x140>(v); return v; }
__device__ __forceinline__ float row_max16(float v) { v = fmaxf(v, dpp_f<0xB1>(v)); v = fmaxf(v, dpp_f<0x4E>(v)); v = fmaxf(v, dpp_f<0x141>(v)); v = fmaxf(v, dpp_f<0x140>(v)); return v; }
constexpr int GB = 32;
typedef __attribute__((address_space(8))) void* rsrc_t;
__device__ __forceinline__ void g_issue(u32x2 (&buf)[GB], __amdgpu_buffer_rsrc_t rs, int idxr, int lb, int voff) {
#pragma unroll
    for (int j = 0; j < GB; ++j) { const int e = __builtin_amdgcn_readlane(idxr, lb + j); buf[j] = __builtin_amdgcn_raw_buffer_load_b64(rs, voff, e * 512, 0); }
}
__device__ __forceinline__ float dot16_fp4p(const u32x2 r, const f32x2 (&xp)[8]) {
    f32x2 a = FP4X2(r.x, 0) * xp[0];
    a += FP4X2(r.x, 1) * xp[1]; a += FP4X2(r.x, 2) * xp[2]; a += FP4X2(r.x, 3) * xp[3];
    a += FP4X2(r.y, 0) * xp[4]; a += FP4X2(r.y, 1) * xp[5]; a += FP4X2(r.y, 2) * xp[6]; a += FP4X2(r.y, 3) * xp[7];
    return a.x + a.y;
}
__device__ __forceinline__ void axpy16_fp4p(const u32x2 r, float w, f32x2 (&o)[8]) {
    const f32x2 ww = (f32x2){w, w};
    o[0] += FP4X2(r.x, 0) * ww; o[1] += FP4X2(r.x, 1) * ww; o[2] += FP4X2(r.x, 2) * ww; o[3] += FP4X2(r.x, 3) * ww;
    o[4] += FP4X2(r.y, 0) * ww; o[5] += FP4X2(r.y, 1) * ww; o[6] += FP4X2(r.y, 2) * ww; o[7] += FP4X2(r.y, 3) * ww;
}
template <int H> __device__ __forceinline__ void g_compute_u(const u32x2 (&buf)[GB], int q, int i16, const f32x2 (&xp)[8], float& zlo, float& zhi) {
    float p[16];
#pragma unroll
    for (int j = 0; j < 16; ++j) p[j] = dot16_fp4p(buf[16 * H + j], xp);
    float s1[8], s2[4];
#pragma unroll
    for (int m = 0; m < 8; ++m) s1[m] = swap32_add(p[2 * m], p[2 * m + 1]);
#pragma unroll
    for (int n = 0; n < 4; ++n) s2[n] = swap16_add(s1[2 * n], s1[2 * n + 1]);
#pragma unroll
    for (int r = 0; r < 4; ++r) { const float z = row_sum16(s2[r]); const bool mine = i16 == ((4 * q + r) & 15);
        zlo = (mine && q < 4) ? z : zlo; zhi = (mine && q >= 4) ? z : zhi; }
}
template <int H> __device__ __forceinline__ void g_compute_v(const u32x2 (&buf)[GB], int q, float alo, float ahi, f32x2 (&o)[8]) {
    const int areg = __builtin_bit_cast(int, (q < 4) ? alo : ahi), sb = 4 * (q & 3);
#pragma unroll
    for (int j = 0; j < 16; ++j) { const int src = 32 * (j & 1) + 16 * ((j >> 1) & 1) + (j >> 2) + sb;
        const float w = __builtin_bit_cast(float, __builtin_amdgcn_readlane(areg, src));
        axpy16_fp4p(buf[16 * H + j], w, o); }
}
__device__ __forceinline__ void q_issue(u32x2 (&buf)[16], __amdgpu_buffer_rsrc_t rs, int ixr  , int lb, int voff) {
#pragma unroll
    for (int j = 0; j < 16; ++j) { const int e9 = __builtin_amdgcn_readlane(ixr, lb + j); buf[j] = __builtin_amdgcn_raw_buffer_load_b64(rs, voff, e9, 0); }
}
__device__ __forceinline__ void q_compute_u(const u32x2 (&buf)[16], int q, int i16, const f32x2 (&xp)[8], float& zlo, float& zhi) {
    float p[16];
#pragma unroll
    for (int j = 0; j < 16; ++j) p[j] = dot16_fp4p(buf[j], xp);
    float s1[8], s2[4];
#pragma unroll
    for (int m = 0; m < 8; ++m) s1[m] = swap32_add(p[2 * m], p[2 * m + 1]);
#pragma unroll
    for (int n = 0; n < 4; ++n) s2[n] = swap16_add(s1[2 * n], s1[2 * n + 1]);
#pragma unroll
    for (int r = 0; r < 4; ++r) { const float z = row_sum16(s2[r]); const bool mine = i16 == ((4 * q + r) & 15);
        zlo = (mine && q < 4) ? z : zlo; zhi = (mine && q >= 4) ? z : zhi; }
}
typedef _Float16 h16x2 __attribute__((ext_vector_type(2)));
#define FP4H2(w, sel) __builtin_amdgcn_cvt_scalef32_pk_f16_fp4((w), 1.0f, (sel))
__device__ __forceinline__ void axpy16_fp4h(const u32x2 r, const h16x2 ww, h16x2 (&o)[8]) {
    o[0] += FP4H2(r.x, 0) * ww; o[1] += FP4H2(r.x, 1) * ww; o[2] += FP4H2(r.x, 2) * ww; o[3] += FP4H2(r.x, 3) * ww;
    o[4] += FP4H2(r.y, 0) * ww; o[5] += FP4H2(r.y, 1) * ww; o[6] += FP4H2(r.y, 2) * ww; o[7] += FP4H2(r.y, 3) * ww;
}
__device__ __forceinline__ void q_compute_vh(const u32x2 (&buf)[16], int q, int alo, int ahi, h16x2 (&o)[8]) {
    const int areg = (q < 4) ? alo : ahi, sb = 4 * (q & 3);
#pragma unroll
    for (int j = 0; j < 16; ++j) { const int src = 32 * (j & 1) + 16 * ((j >> 1) & 1) + (j >> 2) + sb;
        const h16x2 w = __builtin_bit_cast(h16x2, __builtin_amdgcn_readlane(areg, src));
        axpy16_fp4h(buf[j], w, o); }
}
__device__ __forceinline__ void q_compute_v(const u32x2 (&buf)[16], int q, float alo, float ahi, f32x2 (&o)[8]) {
    const int areg = __builtin_bit_cast(int, (q < 4) ? alo : ahi), sb = 4 * (q & 3);
#pragma unroll
    for (int j = 0; j < 16; ++j) { const int src = 32 * (j & 1) + 16 * ((j >> 1) & 1) + (j >> 2) + sb;
        const float w = __builtin_bit_cast(float, __builtin_amdgcn_readlane(areg, src));
        axpy16_fp4p(buf[j], w, o); }
}
__device__ __forceinline__ int swap32_addi(int a, int b) { auto r = __builtin_amdgcn_permlane32_swap((unsigned)a, (unsigned)b, false, false); const unsigned r0 = r[0], r1 = r[1]; return (int)(r0 + r1); }
__device__ __forceinline__ int swap16_addi(int a, int b) { auto r = __builtin_amdgcn_permlane16_swap((unsigned)a, (unsigned)b, false, false); const unsigned r0 = r[0], r1 = r[1]; return (int)(r0 + r1); }
template <int CTRL> __device__ __forceinline__ int dpp_i(int v) { return __builtin_amdgcn_update_dpp(0, v, CTRL, 0xf, 0xf, true); }
__device__ __forceinline__ int row_sum16i(int v) { v += dpp_i<0xB1>(v); v += dpp_i<0x4E>(v); v += dpp_i<0x141>(v); v += dpp_i<0x140>(v); return v; }
__device__ __forceinline__ void q_compute_ui(const u32x2 (&buf)[16], int q, int i16, int xh0, int xh1, int xl0, int xl1, int& zlo, int& zhi) {
    int p[16];
#pragma unroll
    for (int j = 0; j < 16; ++j) { const int d1 = __builtin_amdgcn_sdot8((int)buf[j].x, xh0, __builtin_amdgcn_sdot8((int)buf[j].y, xh1, 0, false), false);
        const int d2 = __builtin_amdgcn_sdot8((int)buf[j].x, xl0, __builtin_amdgcn_sdot8((int)buf[j].y, xl1, 0, false), false);
        p[j] = (d1 << 4) + d2; }
    int s1[8], s2[4];
#pragma unroll
    for (int m = 0; m < 8; ++m) s1[m] = swap32_addi(p[2 * m], p[2 * m + 1]);
#pragma unroll
    for (int n = 0; n < 4; ++n) s2[n] = swap16_addi(s1[2 * n], s1[2 * n + 1]);
#pragma unroll
    for (int r = 0; r < 4; ++r) { const int z = row_sum16i(s2[r]); const bool mine = i16 == ((4 * q + r) & 15);
        zlo = (mine && q < 4) ? z : zlo; zhi = (mine && q >= 4) ? z : zhi; }
}
__device__ __forceinline__ void phase_gather_u(const Params& P) {
    const int tid = threadIdx.x, lane = tid & 63, wave = __builtin_amdgcn_readfirstlane(tid >> 6);
    const int gw = blockIdx.x * NWAVES + wave, NGW = gridDim.x * NWAVES;
    unsigned char* ws = P.ws;
    const int* IDX = (const int*)(ws + WS_IDX); const float* GATE = (const float*)(ws + WS_GATE); const float* ESC = (const float*)(ws + WS_ESCALE); float* AW = (float*)(ws + WS_AW);
    const __amdgpu_buffer_rsrc_t rsU = __builtin_amdgcn_make_buffer_rsrc((void*)(ws + WS_U8), 0, 16384 * 512, 0x00020000);
    const unsigned char* H2I = ws + WS_H0I8; const float* RF = (const float*)(ws + WS_RF);
    const int hh = lane >> 5, rr = (lane >> 4) & 1, i16 = lane & 15, gsel = 4 * i16 + 2 * rr + hh;
    const int voff = 8 * lane;
    const unsigned ul = (unsigned)lane;
    int t = gw;
    if (t < NTOK) {
        int idx0, idx1; unsigned hraw[4]; float sqv;
        { const int* ip = IDX + (size_t)t * NSEL; idx0 = ip[ul]; idx1 = ip[64u + ul];
          const unsigned* hp = (const unsigned*)(H2I + (size_t)t * DM);
#pragma unroll
          for (int j = 0; j < 4; ++j) hraw[j] = hp[64u * j + ul];
          sqv = RF[t]; }
        u32x2 R0[16], R1[16], R2[16], R3[16];
        { const int ix0 = idx0 << 9; q_issue(R0, rsU, ix0, 0, voff); q_issue(R1, rsU, ix0, 16, voff); q_issue(R2, rsU, ix0, 32, voff); }
        for (;;) {
            const int tn = t + NGW; const bool has_next = tn < NTOK; const int tl = has_next ? tn : t;
            int idx0n, idx1n; unsigned hrawn[4]; float sqn, g0, g1;
            { const int* ip = IDX + (size_t)tl * NSEL; idx0n = ip[ul]; idx1n = ip[64u + ul];
              const unsigned* hp = (const unsigned*)(H2I + (size_t)tl * DM);
#pragma unroll
              for (int j = 0; j < 4; ++j) hrawn[j] = hp[64u * j + ul];
              sqn = RF[tl];
              const float* gp = GATE + (size_t)t * NSEL; g0 = gp[ul]; g1 = gp[64u + ul]; }
            const float su0 = ESC[idx0], su1 = ESC[idx1], sv0 = ESC[16384 + idx0], sv1 = ESC[16384 + idx1];
            const float cq0 = ((const float*)(ws + WS_SUMQ))[idx0], cq1 = ((const float*)(ws + WS_SUMQ))[idx1];
            unsigned xh[2] = {0u, 0u}, xl[2] = {0u, 0u};
#pragma unroll
            for (int j = 0; j < 4; ++j) {
                const unsigned lo4 = hraw[j] & 0x0f0f0f0fu, hi4 = (hraw[j] >> 4) & 0x0f0f0f0fu;
                const unsigned tl4 = (lo4 | (lo4 >> 4)) & 0x00ff00ffu, th4 = (hi4 | (hi4 >> 4)) & 0x00ff00ffu;
                const unsigned pl = ((tl4 | (tl4 >> 8)) & 0xffffu) ^ 0x8888u, ph = (th4 | (th4 >> 8)) & 0xffffu;
                xl[j >> 1] |= pl << (16 * (j & 1)); xh[j >> 1] |= ph << (16 * (j & 1)); }
            int zlo = 0, zhi = 0;
            const int ix0 = idx0 << 9, ix1 = idx1 << 9;
#pragma unroll 1
            for (int qq = 0; qq < 8; qq += 4) {
                const int ixn = qq ? (idx0n << 9) : ix1;
                q_issue(R3, rsU, qq ? ix1 : ix0, 48, voff);
                q_compute_ui(R0, qq, i16, (int)xh[0], (int)xh[1], (int)xl[0], (int)xl[1], zlo, zhi);
                q_issue(R0, rsU, ixn, 0, voff);
                q_compute_ui(R1, qq + 1, i16, (int)xh[0], (int)xh[1], (int)xl[0], (int)xl[1], zlo, zhi);
                q_issue(R1, rsU, ixn, 16, voff);
                q_compute_ui(R2, qq + 2, i16, (int)xh[0], (int)xh[1], (int)xl[0], (int)xl[1], zlo, zhi);
                q_issue(R2, rsU, ixn, 32, voff);
                q_compute_ui(R3, qq + 3, i16, (int)xh[0], (int)xh[1], (int)xl[0], (int)xl[1], zlo, zhi);
            }
            const float glo = __shfl(g0, gsel), ghi = __shfl(g1, gsel), sulo = __shfl(su0, gsel), suhi = __shfl(su1, gsel), svlo = __shfl(sv0, gsel), svhi = __shfl(sv1, gsel);
            const float cqlo = __shfl(cq0, gsel), cqhi = __shfl(cq1, gsel);
            const float zfl = ((float)zlo + 8.f * cqlo) * (sulo * sqv), zfh = ((float)zhi + 8.f * cqhi) * (suhi * sqv);
            const float wl = gelu_tanh_f(zfl) * glo * svlo, wh = gelu_tanh_f(zfh) * ghi * svhi;
            const float wmx = fmaxf(wave_max_fast(fmaxf(fabsf(wl), fabsf(wh))), 1e-30f), wsc = 256.f / wmx;
            { const float a = wl * wsc, c = wh * wsc;
              const int ah = __builtin_amdgcn_cvt_pk_fp8_f32(a, a, 0, false) & 255, ch = __builtin_amdgcn_cvt_pk_fp8_f32(c, c, 0, false) & 255;
              const float ar = a - __builtin_amdgcn_cvt_f32_fp8(ah, 0), cr = c - __builtin_amdgcn_cvt_f32_fp8(ch, 0);
              const int al = __builtin_amdgcn_cvt_pk_fp8_f32(ar, ar, 0, false) & 255, cl = __builtin_amdgcn_cvt_pk_fp8_f32(cr, cr, 0, false) & 255;
              unsigned char* ap = (unsigned char*)AW + (size_t)t * 256;
              ap[gsel] = (unsigned char)ah; ap[64 + gsel] = (unsigned char)ch; ap[128 + gsel] = (unsigned char)al; ap[192 + gsel] = (unsigned char)cl;
              if (lane == 0) ((float*)(ws + WS_WMX))[t] = wmx * (1.f / 256.f); }
            if (!has_next) break;
            t = tn; idx0 = idx0n; idx1 = idx1n; sqv = sqn;
#pragma unroll
            for (int j = 0; j < 4; ++j) hraw[j] = hrawn[j];
        }
    }
}
__device__ __forceinline__ void phase_gather_v(const Params& P) {
    const int tid = threadIdx.x, lane = tid & 63, wave = __builtin_amdgcn_readfirstlane(tid >> 6);
    const int gw = blockIdx.x * NWAVES + wave, NGW = gridDim.x * NWAVES;
    unsigned char* ws = P.ws;
    const int* IDX = (const int*)(ws + WS_IDX); const float* AW = (const float*)(ws + WS_AW);
    const __amdgpu_buffer_rsrc_t rsV = __builtin_amdgcn_make_buffer_rsrc((void*)(ws + WS_V8), 0, 16384 * 512, 0x00020000);
    const bf16* H2B = (const bf16*)(ws + WS_H2B);
    const int voff = 8 * lane;
    const unsigned ul = (unsigned)lane;
    int t = gw;
    if (t < NTOK) {
        int idx0, idx1; u32x2 hraw[4]; float alo, ahi;
        { const int* ip = IDX + (size_t)t * NSEL; idx0 = ip[ul]; idx1 = ip[64u + ul];
          const u32x2* hp = (const u32x2*)(H2B + (size_t)t * DM);
#pragma unroll
          for (int j = 0; j < 4; ++j) hraw[j] = hp[64u * j + ul];
          const float* ap = AW + (size_t)t * NSEL; alo = ap[ul]; ahi = ap[64u + ul]; }
        u32x2 R0[16], R1[16], R2[16], R3[16];
        { const int ix0 = idx0 << 9; q_issue(R0, rsV, ix0, 0, voff); q_issue(R1, rsV, ix0, 16, voff); q_issue(R2, rsV, ix0, 32, voff); }
        for (;;) {
            const int tn = t + NGW; const bool has_next = tn < NTOK; const int tl = has_next ? tn : t;
            int idx0n, idx1n; u32x2 hrawn[4]; float alon, ahin;
            { const int* ip = IDX + (size_t)tl * NSEL; idx0n = ip[ul]; idx1n = ip[64u + ul];
              const u32x2* hp = (const u32x2*)(H2B + (size_t)tl * DM);
#pragma unroll
              for (int j = 0; j < 4; ++j) hrawn[j] = hp[64u * j + ul];
              const float* ap = AW + (size_t)tl * NSEL; alon = ap[ul]; ahin = ap[64u + ul]; }
            const float wmx = fmaxf(wave_max_fast(fmaxf(fabsf(alo), fabsf(ahi))), 1e-30f), winv = 1.f / wmx;
            int alh, ahh;
            { const h16x2 a = (h16x2){(_Float16)(alo * winv), (_Float16)(alo * winv)}, b = (h16x2){(_Float16)(ahi * winv), (_Float16)(ahi * winv)};
              alh = __builtin_bit_cast(int, a); ahh = __builtin_bit_cast(int, b); }
            h16x2 oh[8];
#pragma unroll
            for (int j = 0; j < 8; ++j) oh[j] = (h16x2){(_Float16)0.f, (_Float16)0.f};
            const int ix0 = idx0 << 9, ix1 = idx1 << 9;
#pragma unroll 1
            for (int qq = 0; qq < 8; qq += 4) {
                const int ixn = qq ? (idx0n << 9) : ix1;
                q_issue(R3, rsV, qq ? ix1 : ix0, 48, voff);
                q_compute_vh(R0, qq, alh, ahh, oh);
                q_issue(R0, rsV, ixn, 0, voff);
                q_compute_vh(R1, qq + 1, alh, ahh, oh);
                q_issue(R1, rsV, ixn, 16, voff);
                q_compute_vh(R2, qq + 2, alh, ahh, oh);
                q_issue(R2, rsV, ixn, 32, voff);
                q_compute_vh(R3, qq + 3, alh, ahh, oh);
            }
            f32x2 o[8];
#pragma unroll
            for (int j = 0; j < 8; ++j) o[j] = (f32x2){(float)oh[j].x * wmx, (float)oh[j].y * wmx};
            float ss = 0.f;
#pragma unroll
            for (int j = 0; j < 4; ++j) { o[2 * j] += (f32x2){bflo(hraw[j].x), bfhi(hraw[j].x)}; o[2 * j + 1] += (f32x2){bflo(hraw[j].y), bfhi(hraw[j].y)}; }
#pragma unroll
            for (int j = 0; j < 8; ++j) ss += o[j].x * o[j].x + o[j].y * o[j].y;
            ss = wave_sum_fast(ss);
            const float r3 = rsqrtf(ss * (1.f / DM) + EPS);
            f32x4* op = (f32x4*)(P.out + (size_t)t * DM);
            const f32x4* gfp = (const f32x4*)P.g_fin;
#pragma unroll
            for (int j = 0; j < 4; ++j) { const f32x4 gv = gfp[64u * j + ul]; op[64u * j + ul] = (f32x4){o[2 * j].x * r3 * gv.x, o[2 * j].y * r3 * gv.y, o[2 * j + 1].x * r3 * gv.z, o[2 * j + 1].y * r3 * gv.w}; }
            if (!has_next) break;
            t = tn; idx0 = idx0n; idx1 = idx1n; alo = alon; ahi = ahin;
#pragma unroll
            for (int j = 0; j < 4; ++j) hraw[j] = hrawn[j];
        }
    }
}


typedef int i32x2v __attribute__((ext_vector_type(2)));
typedef int i32x8v __attribute__((ext_vector_type(8)));
#define VM_X 9
#define VM_WAIT(n) asm volatile("s_waitcnt vmcnt(" #n ")" ::: "memory")
__device__ __forceinline__ void phase_gather_v_mfma(const Params& P, LAS unsigned char* lds) {
    const int tid = threadIdx.x, lane = tid & 63, wave = __builtin_amdgcn_readfirstlane(tid >> 6);
    unsigned char* ws = P.ws;
    const int* IDX = (const int*)(ws + WS_IDX);
    const unsigned char* V8 = ws + WS_V8; const unsigned char* AW8 = ws + WS_AW; const float* WMX = (const float*)(ws + WS_WMX);
    const unsigned short* H2S = (const unsigned short*)(ws + WS_H2B);
    const int TPB = NTOK / (int)gridDim.x, t0 = blockIdx.x * TPB, NST = TPB * 4;
    const int r0 = 16 * wave + (lane >> 3), r1 = r0 + 8;
    const unsigned c0 = 16u * (unsigned)((lane & 7) ^ ((r0 >> 1) & 7)), c1 = 16u * (unsigned)((lane & 7) ^ ((r1 >> 1) & 7));
    const int i16 = lane & 15, kb = lane >> 4;
    const int ra = 32 * kb + i16, rb = ra + 16;
    const unsigned offa = (unsigned)(ra * 128 + 16 * (wave ^ ((ra >> 1) & 7))), offb = (unsigned)(rb * 128 + 16 * (wave ^ ((rb >> 1) & 7)));
    const unsigned aoffb = (unsigned)(((i16 & 1) ? 128 : 0) + 16 * kb);
    const bool arow = (i16 & 3) < 2;
    const int colb = 256 * kb + 32 * wave + i16;
    const float gf0 = P.g_fin[colb], gf1 = P.g_fin[colb + 16];
    LAS float* SS = (LAS float*)(lds + 131072 + 1024);
    const unsigned lbase = (unsigned)(unsigned long long)lds;
    struct VTok { u32x4 a, b; float w; unsigned h0, h1; };
    VTok C0, C1;
    int ia1, ib1, ia2, ib2, ia3, ib3;
#define VM_ISSUE(g, e0, e1) do { LAS unsigned char* _d = lds + (((g) & 7) * 16384) + wave * 2048; const unsigned _cb = 128u * (unsigned)((g) & 3); \
        __builtin_amdgcn_global_load_lds((const unsigned*)(V8 + (size_t)(e0) * 512 + _cb + c0), (LAS unsigned*)(_d), 16, 0, 0); \
        __builtin_amdgcn_global_load_lds((const unsigned*)(V8 + (size_t)(e1) * 512 + _cb + c1), (LAS unsigned*)(_d + 1024), 16, 0, 0); } while (0)
    {
        const int ia0 = IDX[(size_t)t0 * NSEL + r0], ib0 = IDX[(size_t)t0 * NSEL + r1];
        ia1 = IDX[(size_t)(t0 + 1) * NSEL + r0]; ib1 = IDX[(size_t)(t0 + 1) * NSEL + r1];
        ia2 = IDX[(size_t)(t0 + 2) * NSEL + r0]; ib2 = IDX[(size_t)(t0 + 2) * NSEL + r1];
        ia3 = IDX[(size_t)(t0 + 3) * NSEL + r0]; ib3 = IDX[(size_t)(t0 + 3) * NSEL + r1];
        const unsigned char* ap = AW8 + (size_t)t0 * 256 + aoffb;
        C0.a = *(const u32x4*)ap; C0.b = *(const u32x4*)(ap + 64); C0.w = WMX[t0]; C0.h0 = H2S[(size_t)t0 * DM + colb]; C0.h1 = H2S[(size_t)t0 * DM + colb + 16];
        C1.a = *(const u32x4*)(ap + 256); C1.b = *(const u32x4*)(ap + 256 + 64); C1.w = WMX[t0 + 1]; C1.h0 = H2S[(size_t)(t0 + 1) * DM + colb]; C1.h1 = H2S[(size_t)(t0 + 1) * DM + colb + 16];
        asm volatile("s_waitcnt vmcnt(0)" ::: "memory");
        VM_ISSUE(0, ia0, ib0); VM_ISSUE(1, ia0, ib0); VM_ISSUE(2, ia0, ib0); VM_ISSUE(3, ia0, ib0);
        VM_ISSUE(4, ia1, ib1); VM_ISSUE(5, ia1, ib1); VM_ISSUE(6, ia1, ib1);
    }
    float pv0 = 0.f, pv1 = 0.f;
    VTok N0, N1; int na4, nb4, na5, nb5;
    auto token = [&](const int i, const bool even, const VTok& C, const int e1a, const int e1b, const int e2a, const int e2b) __attribute__((always_inline)) {
        const int t = t0 + i;
        const u32x4 z = (u32x4){0u, 0u, 0u, 0u}; const u32x4 Alo = arow ? C.a : z, Ahi = arow ? C.b : z;
        const i32x8v A = (i32x8v){(int)Alo.x, (int)Alo.y, (int)Alo.z, (int)Alo.w, (int)Ahi.x, (int)Ahi.y, (int)Ahi.z, (int)Ahi.w};
        f32x4 acc[4][2];
#pragma unroll
        for (int cc = 0; cc < 4; ++cc) {
            const int g = 4 * i + cc;
            if (even && cc == 0) { VM_WAIT(12); } else { VM_WAIT(26); }
            asm volatile("s_waitcnt lgkmcnt(0)" ::: "memory");
            __builtin_amdgcn_s_barrier();
            __builtin_amdgcn_sched_barrier(0);
            const unsigned sa = lbase + (unsigned)((g & 7) * 16384) + offa, sbb = lbase + (unsigned)((g & 7) * 16384) + offb;
            i32x2v b00, b01, b10, b11;
            asm volatile("ds_read_b64_tr_b4 %0, %4\n\tds_read_b64_tr_b4 %1, %5\n\tds_read_b64_tr_b4 %2, %4 offset:8\n\tds_read_b64_tr_b4 %3, %5 offset:8"
                         : "=&v"(b00), "=&v"(b01), "=&v"(b10), "=&v"(b11) : "v"(sa), "v"(sbb) : "memory");
            { const int gn = g + 7;
              if (cc == 0) VM_ISSUE(gn, e1a, e1b); else VM_ISSUE(gn, e2a, e2b); }
            __builtin_amdgcn_sched_barrier(0);
            if (cc == 0) {
                if (even) {
                    const int tA = t0 + ((i + 2 < TPB) ? i + 2 : TPB - 2), tI = t0 + ((i + 4 < TPB) ? i + 4 : TPB - 2);
                    const unsigned char* ap = AW8 + (size_t)tA * 256 + aoffb; const float* wp = WMX + tA; const int* ipa = IDX + (size_t)tI * NSEL + r0; const unsigned short* hp = H2S + (size_t)tA * DM + colb;
                    asm volatile("global_load_dwordx4 %0, %14, off\n\tglobal_load_dwordx4 %1, %14, off offset:64\n\tglobal_load_dwordx4 %2, %14, off offset:256\n\tglobal_load_dwordx4 %3, %14, off offset:320\n\t"
                                 "global_load_dword %4, %15, off\n\tglobal_load_dword %5, %15, off offset:4\n\t"
                                 "global_load_ushort %6, %17, off\n\tglobal_load_ushort %7, %17, off offset:32\n\tglobal_load_ushort %8, %17, off offset:2048\n\tglobal_load_ushort %9, %17, off offset:2080\n\t"
                                 "global_load_dword %10, %16, off\n\tglobal_load_dword %11, %16, off offset:32\n\tglobal_load_dword %12, %16, off offset:512\n\tglobal_load_dword %13, %16, off offset:544"
                                 : "=&v"(N0.a), "=&v"(N0.b), "=&v"(N1.a), "=&v"(N1.b), "=&v"(N0.w), "=&v"(N1.w), "=&v"(N0.h0), "=&v"(N0.h1), "=&v"(N1.h0), "=&v"(N1.h1), "=&v"(na4), "=&v"(nb4), "=&v"(na5), "=&v"(nb5)
                                 : "v"(ap), "v"(wp), "v"(ipa), "v"(hp) : "memory");
                }
                { const f32x4 s0 = *(const LAS f32x4*)(SS + 8 * ((i + 1) & 1)), s1 = *(const LAS f32x4*)(SS + 8 * ((i + 1) & 1) + 4);
                  const float ss = ((s0.x + s0.y) + (s0.z + s0.w)) + ((s1.x + s1.y) + (s1.z + s1.w));
                  const float r3 = rsqrtf(ss * (1.f / DM) + EPS);
                  float* op = P.out + (size_t)((i > 0) ? t - 1 : t) * DM + colb;
                  op[0] = pv0 * r3 * gf0; op[16] = pv1 * r3 * gf1; }
                __builtin_amdgcn_sched_barrier(0);
            }
            asm volatile("s_waitcnt lgkmcnt(0)" : "+v"(b00), "+v"(b01), "+v"(b10), "+v"(b11) :: "memory");
            const i32x8v B0 = (i32x8v){b00.x, b00.y, b01.x, b01.y, 0, 0, 0, 0}, B1 = (i32x8v){b10.x, b10.y, b11.x, b11.y, 0, 0, 0, 0};
            const f32x4 z4 = (f32x4){0.f, 0.f, 0.f, 0.f};
            acc[cc][0] = __builtin_amdgcn_mfma_scale_f32_16x16x128_f8f6f4(A, B0, z4, 0  , 4  , 0, 0x7f7f7f7f, 0, 0x7f7f7f7f);
            acc[cc][1] = __builtin_amdgcn_mfma_scale_f32_16x16x128_f8f6f4(A, B1, z4, 0, 4, 0, 0x7f7f7f7f, 0, 0x7f7f7f7f);
        }
#pragma unroll
        for (int c = 0; c < 4; ++c) asm volatile("" :: "v"(acc[c][0]), "v"(acc[c][1]));
        float s0 = acc[0][0].x + acc[0][0].y, s1 = acc[0][1].x + acc[0][1].y;
        { const float a0 = acc[1][0].x + acc[1][0].y, a1 = acc[1][1].x + acc[1][1].y, b0 = acc[2][0].x + acc[2][0].y, b1 = acc[2][1].x + acc[2][1].y, d0 = acc[3][0].x + acc[3][0].y, d1 = acc[3][1].x + acc[3][1].y;
          s0 = (kb == 1) ? a0 : s0; s1 = (kb == 1) ? a1 : s1; s0 = (kb == 2) ? b0 : s0; s1 = (kb == 2) ? b1 : s1; s0 = (kb == 3) ? d0 : s0; s1 = (kb == 3) ? d1 : s1; }
        pv0 = s0 * C.w + __uint_as_float(C.h0 << 16); pv1 = s1 * C.w + __uint_as_float(C.h1 << 16);
        const float sq = wave_sum_fast(pv0 * pv0 + pv1 * pv1);
        if (lane == 0) SS[8 * (i & 1) + wave] = sq;
    };
#pragma unroll 1
    for (int i = 0; i < TPB; i += 2) {
        token(i, true, C0, ia1, ib1, ia2, ib2);
        token(i + 1, false, C1, ia2, ib2, ia3, ib3);
        asm volatile("s_waitcnt vmcnt(14)" : "+v"(N0.a), "+v"(N0.b), "+v"(N1.a), "+v"(N1.b), "+v"(N0.w), "+v"(N1.w), "+v"(N0.h0), "+v"(N0.h1), "+v"(N1.h0), "+v"(N1.h1), "+v"(na4), "+v"(nb4), "+v"(na5), "+v"(nb5) :: "memory");
        C0 = N0; C1 = N1; ia1 = ia3; ib1 = ib3; ia2 = na4; ib2 = nb4; ia3 = na5; ib3 = nb5;
    }
    asm volatile("s_waitcnt vmcnt(0)" ::: "memory");
    __builtin_amdgcn_s_barrier();
    { const int i = TPB; const f32x4 s0 = *(const LAS f32x4*)(SS + 8 * ((i + 1) & 1)), s1 = *(const LAS f32x4*)(SS + 8 * ((i + 1) & 1) + 4);
      const float ss = ((s0.x + s0.y) + (s0.z + s0.w)) + ((s1.x + s1.y) + (s1.z + s1.w));
      const float r3 = rsqrtf(ss * (1.f / DM) + EPS);
      float* op = P.out + (size_t)(t0 + TPB - 1) * DM + colb;
      op[0] = pv0 * r3 * gf0; op[16] = pv1 * r3 * gf1; }
#undef VM_ISSUE
}

__device__ __forceinline__ void phase_quant_h2(const Params& P) {
    const int tid = threadIdx.x, lane = tid & 63, wave = __builtin_amdgcn_readfirstlane(tid >> 6);
    const int gw = blockIdx.x * NWAVES + wave, NGW = gridDim.x * NWAVES;
    unsigned char* ws = P.ws;
    const float* SSQ = (const float*)(ws + WS_SSQ); const float* AMX = (const float*)(ws + WS_AMX); float* RF = (float*)(ws + WS_RF);
    for (int row = gw; row < NTOK; row += NGW) {
        const u32x4* hp = (const u32x4*)(ws + WS_H2B + (size_t)row * DM * 2) + 2 * lane;
        const u32x4 a = hp[0], b = hp[1];
        const float am = fmaxf(row_max16(AMX[(size_t)row * 16 + (lane & 15)]), 1e-30f) * 1.0078125f;
        const float rstd2 = rsqrtf(row_sum16(SSQ[(size_t)row * 16 + (lane & 15)]) * (1.f / DM) + EPS);
        const float inv = 127.f / am;
        const unsigned w[8] = {a.x, a.y, a.z, a.w, b.x, b.y, b.z, b.w};
        unsigned o[4];
#pragma unroll
        for (int j = 0; j < 4; ++j) {
            const int q0 = (int)rintf(__uint_as_float(w[2 * j] << 16) * inv), q1 = (int)rintf(__uint_as_float(w[2 * j] & 0xffff0000u) * inv);
            const int q2 = (int)rintf(__uint_as_float(w[2 * j + 1] << 16) * inv), q3 = (int)rintf(__uint_as_float(w[2 * j + 1] & 0xffff0000u) * inv);
            o[j] = ((unsigned)q0 & 255u) | (((unsigned)q1 & 255u) << 8) | (((unsigned)q2 & 255u) << 16) | ((unsigned)q3 << 24); }
        u32x4 ov; ov.x = o[0]; ov.y = o[1]; ov.z = o[2]; ov.w = o[3];
        *((u32x4*)(ws + WS_H0I8 + (size_t)row * DM) + lane) = ov;
        if (lane == 0) RF[row] = am * (1.f / 127.f) * rstd2;
    }
}
struct EpiQI8 {
    static constexpr bool PERM = true, AFTER_DRAIN = false;
    bf16* O; int ldc; const float* rf; const float* sw;
    __device__ __forceinline__ void operator()(const pg8::i32x4 (&acc)[2][2][4][2], const pg8::Unit& u, int wr, int wc, int fr, int fq) const {
        const int row0 = u.pm * 256 + wr * 64 + fr, col0 = u.pn * 256 + wc * 32 + 8 * fq;
        f32x4 swv[2][2];
#pragma unroll
        for (int bj = 0; bj < 2; ++bj) { swv[bj][0] = *(const f32x4*)(sw + col0 + bj * 128); swv[bj][1] = *(const f32x4*)(sw + col0 + bj * 128 + 4); }
#pragma unroll
        for (int ai = 0; ai < 2; ++ai)
#pragma unroll
            for (int m = 0; m < 4; ++m) {
                const int row = row0 + ai * 128 + m * 16;
                const float s = rf[row];
                bf16* rowp = O + (size_t)row * ldc + col0;
#pragma unroll
                for (int bj = 0; bj < 2; ++bj) { const pg8::i32x4 a0 = acc[ai][bj][m][0], a1 = acc[ai][bj][m][1];
                    const f32x4 v0 = (f32x4){(float)a0[0], (float)a0[1], (float)a0[2], (float)a0[3]} * (swv[bj][0] * s), v1 = (f32x4){(float)a1[0], (float)a1[1], (float)a1[2], (float)a1[3]} * (swv[bj][1] * s);
                    u32x4 w; w.x = cvt_pk_bf16(v0[0], v0[1]); w.y = cvt_pk_bf16(v0[2], v0[3]); w.z = cvt_pk_bf16(v1[0], v1[1]); w.w = cvt_pk_bf16(v1[2], v1[3]);
                    *(u32x4*)(rowp + bj * 128) = w; }
            }
    }
};
#define XB_TMO      128
#define XB_XCNT(j)  (256  + 64 * (j))
#define XB_XSUB(j)  (1280 + 64 * (j))
#define XB_XGEN(j)  (2304 + 64 * (j))
#define XB_TOP      3328
#define XB_TOPGEN   3392
#define XCD_BAR_WORDS 3456
#define XB_SPIN_CAP (1u << 18)

__device__ __forceinline__ unsigned xb_ld(unsigned* p)              { return __hip_atomic_load(p, __ATOMIC_RELAXED, __HIP_MEMORY_SCOPE_AGENT); }
__device__ __forceinline__ unsigned xb_add(unsigned* p, unsigned v) { return __hip_atomic_fetch_add(p, v, __ATOMIC_RELAXED, __HIP_MEMORY_SCOPE_AGENT); }
__device__ __forceinline__ unsigned xb_xcc_id() { return (unsigned)__builtin_amdgcn_s_getreg((3 << 11) | 20) & 0xFu; }
#define XB_SPIN(cond, bar) do { unsigned _sp = 0; while (cond) { __builtin_amdgcn_s_sleep(1); \
    if ((++_sp & 255u) == 0u) { if (xb_ld(&(bar)[XB_TMO])) break; if (_sp > XB_SPIN_CAP) { atomicAdd(&(bar)[XB_TMO], 1u); break; } } } } while (0)

struct XcdBarrier {
    unsigned* bar; unsigned x;
    volatile LAS unsigned* st;
};

__device__ __forceinline__ XcdBarrier xcd_barrier_post(unsigned* bar, volatile LAS unsigned* st) {
    XcdBarrier b; b.bar = bar; b.x = xb_xcc_id(); b.st = st;
    if (threadIdx.x == 0) (void)xb_add(&bar[XB_XCNT(b.x)], 1u);
    return b;
}
__device__ __forceinline__ void xcd_barrier_complete(unsigned* bar, unsigned x, unsigned& nloc, unsigned& nx) {
    const unsigned G = gridDim.x * gridDim.y * gridDim.z;
    unsigned sum, cnt, mine, sp = 0u;
    for (;;) {
        sum = 0u; cnt = 0u; mine = 0u;
#pragma unroll
        for (unsigned j = 0; j < 16; ++j) { const unsigned c = xb_ld(&bar[XB_XCNT(j)]); sum += c; cnt += (c > 0u) ? 1u : 0u; mine = (j == x) ? c : mine; }
        if (sum == G) break;
        __builtin_amdgcn_s_sleep(1);
        if ((++sp & 255u) == 0u) { if (xb_ld(&bar[XB_TMO])) break; if (sp > XB_SPIN_CAP) { atomicAdd(&bar[XB_TMO], 1u); break; } }
    }
    nloc = mine > 0u ? mine : 1u; nx = cnt > 0u ? cnt : 1u;
}

__device__ __forceinline__ void xcd_barrier(const XcdBarrier& b) {
    asm volatile("s_waitcnt vmcnt(0)" ::: "memory");
    __syncthreads();
    if (threadIdx.x == 0) {
        unsigned* bar = b.bar;
        __builtin_amdgcn_s_waitcnt(0);
        unsigned nloc = b.st[0], nx = b.st[1];
        if (nloc == 0u) { xcd_barrier_complete(bar, b.x, nloc, nx); b.st[0] = nloc; b.st[1] = nx; }
        const unsigned old = xb_add(&bar[XB_XSUB(b.x)], 1u);
        const unsigned gen = old / nloc;
        if (old + 1u == (gen + 1u) * nloc) {
            __builtin_amdgcn_fence(__ATOMIC_RELEASE, "agent");
            asm volatile("s_waitcnt vmcnt(0)" ::: "memory");
            const unsigned og = xb_add(&bar[XB_TOP], 1u);
            const unsigned tg = og / nx;
            if (og + 1u == (tg + 1u) * nx) xb_add(&bar[XB_TOPGEN], 1u);
            else XB_SPIN(xb_ld(&bar[XB_TOPGEN]) == tg, bar);
            __builtin_amdgcn_fence(__ATOMIC_ACQUIRE, "agent");
            xb_add(&bar[XB_XGEN(b.x)], 1u);
            asm volatile("s_waitcnt vmcnt(0)" ::: "memory");
        } else {
            XB_SPIN(xb_ld(&bar[XB_XGEN(b.x)]) == gen, bar);
            __builtin_amdgcn_fence(__ATOMIC_ACQUIRE, "agent");
            asm volatile("s_waitcnt vmcnt(0)" ::: "memory");
        }
    }
    __syncthreads();
}


#ifndef MK_MULTI
#define MK_MULTI 0
#endif
constexpr int NPHASE = 10;
#ifndef REP5
#define REP5 1
#endif
#ifndef REP6
#define REP6 1
#endif
__global__ void __launch_bounds__(NTHREADS, 2) mk_fwd(Params P) {
    extern __shared__ __attribute__((aligned(16))) unsigned char lds_raw[];
    LAS unsigned char* lds = (LAS unsigned char*)lds_raw;
    cg::grid_group grid = cg::this_grid();
    unsigned char* ws = P.ws;
    const int lo = P.ph_lo, hi = P.ph_hi;
    volatile LAS unsigned* bst = (volatile LAS unsigned*)(lds + 131072 + 64);
    if (threadIdx.x < 2) bst[threadIdx.x] = 0u;
    __syncthreads();
    XcdBarrier xbar = xcd_barrier_post((unsigned*)(ws + WS_CTL), bst);
#define IN(k) (lo <= (k) && (k) < hi)
#define SEAM(k) do { if (IN(k) && IN((k) + 1)) { xcd_barrier(xbar); } } while (0)
    if (IN(0)) phase_prep(P, lds);
    SEAM(0);
    if (IN(1)) { phase_metaproj(P); phase_winq(P, lds); }
    SEAM(1);
    if (IN(2)) {
        pg8::Gemm g{(const bf16*)(ws + WS_H0I8), (const bf16*)(ws + WS_WIN_T), NTOK, DIN, DM / 2}; pg8::StaticOrder S; S.init(NTOK, DIN, (int)gridDim.x, (int)blockIdx.x);
        EpiProjI8 E{(bf16*)(ws + WS_PROJ), (const float*)(ws + WS_RSTD1), (const float*)(ws + WS_SW)};
        pg8::gemm_phase_i8<EpiProjI8, pg8::StaticOrder, true, true>(lds, g, S, E);
    }
    SEAM(2);
    if (IN(3)) phase_conv(P, lds);
    SEAM(3);
    if (IN(4)) {
        pg8::Gemm g{(const bf16*)(ws + WS_Y), (const bf16*)(ws + WS_WOUT_T), NTOK, DM, DM / 2}; pg8::StaticOrder S; S.init(NTOK, DM, (int)gridDim.x, (int)blockIdx.x);
        EpiResidualI8 E{(bf16*)(ws + WS_H2B), (const signed char*)(ws + WS_H0I8), (const float*)(ws + WS_SX), (const float*)(ws + WS_SY), (const float*)(ws + WS_SWO), (float*)(ws + WS_SSQ), (float*)(ws + WS_AMX)};
        pg8::gemm_phase_i8<EpiResidualI8, pg8::StaticOrder, true, true>(lds, g, S, E);
    }
    SEAM(4);
    if (IN(5)) phase_quant_h2(P);
    SEAM(5);
    if (IN(6)) {
        pg8::Gemm g{(const bf16*)(ws + WS_H0I8), (const bf16*)(ws + WS_WQ_T), NTOK, 2048, DM / 2}; pg8::StaticOrder S; S.init(NTOK, 2048, (int)gridDim.x, (int)blockIdx.x);
        EpiQI8 E{(bf16*)(ws + WS_Q), 2048, (const float*)(ws + WS_RF), (const float*)(ws + WS_SWQ)};
        pg8::gemm_phase_i8<EpiQI8, pg8::StaticOrder, true, true>(lds, g, S, E);
    }
    if (IN(6) && IN(7)) { asm volatile("s_waitcnt vmcnt(0)" ::: "memory"); __syncthreads(); }
    if (IN(7)) phase_route(P, lds);
    SEAM(7);
    if (IN(8)) phase_gather_u(P);
    SEAM(8);
    if (IN(9)) phase_gather_v_mfma(P, lds);
#undef IN
#undef SEAM
}

extern "C" void kernel_launch(void* const* d_in, const int* in_sizes, int n_in, void* d_out, int out_size, void* d_ws, size_t ws_size, hipStream_t stream) {
    static int grid = 0;
    if (grid == 0) {
        if (n_in != 18 || in_sizes[0] != NTOK * DM || out_size != NTOK * DM || ws_size < WS_END) {
            fprintf(stderr, "kernel_launch: unexpected shapes (n_in %d in0 %d out %d ws %zu)\n", n_in, n_in > 0 ? in_sizes[0] : -1, out_size, ws_size); grid = -1; return; }
        int dev = 0, cus = 0, per_cu = 0;
        (void)hipGetDevice(&dev); (void)hipDeviceGetAttribute(&cus, hipDeviceAttributeMultiprocessorCount, dev);
        if (hipFuncSetAttribute((const void*)mk_fwd, hipFuncAttributeMaxDynamicSharedMemorySize, LDS_BYTES) != hipSuccess) { fprintf(stderr, "kernel_launch: hipFuncSetAttribute failed\n"); grid = -1; return; }
        if (hipOccupancyMaxActiveBlocksPerMultiprocessor(&per_cu, (const void*)mk_fwd, NTHREADS, LDS_BYTES) != hipSuccess || per_cu < 1) { fprintf(stderr, "kernel_launch: occupancy query failed (%d)\n", per_cu); (void)hipGetLastError(); per_cu = 1; }
        if (per_cu > 1) per_cu = 1;
        grid = cus * per_cu;
        if (grid <= 0) grid = 256;
    }
    if (grid < 0) return;
    Params p{};
    p.x = (const float*)d_in[0]; p.meta = (const float*)d_in[1]; p.g_mix = (const float*)d_in[2]; p.w_in = (const float*)d_in[3]; p.sc_w = (const float*)d_in[4];
    p.cf_w = (const float*)d_in[5]; p.cf_b = (const float*)d_in[6]; p.ln_g = (const float*)d_in[7]; p.ln_b = (const float*)d_in[8]; p.g_sc = (const float*)d_in[9];
    p.g_cf = (const float*)d_in[10]; p.w_out = (const float*)d_in[11]; p.g_ffn = (const float*)d_in[12]; p.w_q = (const float*)d_in[13]; p.keys = (const float*)d_in[14];
    p.pu = (const float*)d_in[15]; p.pv = (const float*)d_in[16]; p.g_fin = (const float*)d_in[17];
    p.out = (float*)d_out; p.ws = (unsigned char*)d_ws;
    (void)hipMemsetAsync((char*)d_ws + WS_CTL, 0, 45056, stream);
#if MK_MULTI
    for (int ph = 0; ph < NPHASE; ++ph) { p.ph_lo = ph; p.ph_hi = ph + 1; p.coop = 0; p.pad = 0;
        hipLaunchKernelGGL(mk_fwd, dim3(grid), dim3(NTHREADS), LDS_BYTES, stream, p); }
#else
    p.ph_lo = 0; p.ph_hi = NPHASE; p.coop = 1; p.pad = 0;
    void* args[] = {&p};
    hipError_t e = hipLaunchCooperativeKernel((const void*)mk_fwd, dim3(grid), dim3(NTHREADS), args, LDS_BYTES, stream);
    if (e != hipSuccess) fprintf(stderr, "cooperative launch failed: %s (grid %d)\n", hipGetErrorString(e), grid);
#endif
}
```

```cpp
#include <hip/hip_runtime.h>
#include <hip/hip_cooperative_groups.h>
#include <cstdio>
#include <cstdint>
namespace cg = cooperative_groups;

namespace pg8 {
#define PG8_LAS __attribute__((address_space(3)))
typedef unsigned short bf16_t;
typedef short bf16x8 __attribute__((ext_vector_type(8)));
typedef float f32x4 __attribute__((ext_vector_type(4)));
typedef unsigned u32x4 __attribute__((ext_vector_type(4)));
typedef int i32x4 __attribute__((ext_vector_type(4)));
constexpr int BM = 256, BK = 64, HALF = 128, HTB = HALF * BK * 2  , STAGE_BYTES = 8 * HTB, NXCD = 8, WGM = 8;

__host__ __device__ __forceinline__ int lds_byte(int r, int c) { const int st = (r >> 4) * 2 + (c >> 5), rr = r & 15, cc = c & 31, ob = rr * 64 + cc * 2; return st * 1024 + (ob ^ (((ob >> 9) & 1) << 5)); }
__host__ __device__ __forceinline__ void stage_rc(int b, int& R, int& C) { const int st = b / 1024, sb = b % 1024, swz = sb ^ (((sb >> 9) & 1) << 5); R = (st >> 1) * 16 + swz / 64; C = (st & 1) * 32 + (swz % 64) / 2; }
__host__ __device__ __forceinline__ int perm32(int rho) { const int n = rho >> 4, i = rho & 15; return 8 * (i >> 2) + 4 * n + (i & 3); }

struct Unit { int pm, pn; };
struct Gemm { const bf16_t* A; const bf16_t* Bt; int M, N, K; };

struct StaticOrder {
    int nM, nN, nwg, G, c;
    __host__ __device__ void init(int M, int N, int G_, int c_) { nM = M / BM; nN = N / BM; nwg = nM * nN; G = G_; c = c_; }
    __host__ __device__ bool next(int i, Unit& u) const {
        const long L = (long)i * G + c; if (L >= nwg) return false;
        int wgid = (int)L; { const int q = nwg / NXCD, r = nwg % NXCD, xcd = wgid % NXCD, off = wgid / NXCD; wgid = (xcd < r ? xcd * (q + 1) : r * (q + 1) + (xcd - r) * q) + off; }
        const int nig = WGM * nN, gid = wgid / nig, fm = gid * WGM, gsz = (nM - fm) < WGM ? (nM - fm) : WGM;
        u.pm = fm + ((wgid % nig) % gsz); u.pn = (wgid % nig) / gsz; return true;
    }
    __device__ __forceinline__ void a_ready(const Unit&) const {}
    __device__ __forceinline__ void done(const Unit&) const {}
};

template <class Epi, class Sched, bool ALIGN_EPI = false, bool SP2 = false>
__device__ __forceinline__ void gemm_phase(PG8_LAS unsigned char* lds, const Gemm g, const Sched& S, const Epi& E) {
    const int tid = threadIdx.x, wid = __builtin_amdgcn_readfirstlane(tid >> 6), lane = tid & 63, wr = wid >> 2, wc = wid & 3, fr = lane & 15, fq = lane >> 4;
    const int K = g.K, nt = K / BK;
    unsigned voffA[2], voffB[2];
#pragma unroll
    for (int i = 0; i < 2; ++i) { int R, C; stage_rc(tid * 16 + i * 8192, R, C); const int Rb = Epi::PERM ? ((R & ~31) + perm32(R & 31)) : R;
        voffA[i] = (unsigned)(R * K + C) * 2u; voffB[i] = (unsigned)(Rb * K + C) * 2u; }
    const size_t kstep = (size_t)(BK * 2);
    const size_t hstep = (size_t)HALF * K * 2;
    const size_t tstep = 2 * hstep;
    const unsigned ldsw = (unsigned)wid * 1024u;
    const int aoff = lds_byte(wr * 64 + fr, fq * 8), boff = lds_byte(wc * 32 + fr, fq * 8);
#define PG8_SA(b, h) (((b) * 2 + (h)) * HTB)
#define PG8_SB(b, h) ((4 + (b) * 2 + (h)) * HTB)
#define PG8_STAGE(bufoff, gbase, voff) do { _Pragma("unroll") for (int _i = 0; _i < 2; ++_i) \
        __builtin_amdgcn_global_load_lds((const unsigned*)((const char*)(gbase) + (voff)[_i]), (PG8_LAS unsigned*)(lds + (bufoff) + ldsw + _i * 8192), 16, 0, 0); } while (0)
#define PG8_LDA(dst, b, h) do { _Pragma("unroll") for (int m = 0; m < 4; ++m) _Pragma("unroll") for (int k = 0; k < 2; ++k) dst[m][k] = *(const PG8_LAS bf16x8*)(lds + PG8_SA(b, h) + aoff + m * 2048 + k * 1024); } while (0)
#define PG8_LDB(dst, b, h) do { _Pragma("unroll") for (int n = 0; n < 2; ++n) _Pragma("unroll") for (int k = 0; k < 2; ++k) dst[n][k] = *(const PG8_LAS bf16x8*)(lds + PG8_SB(b, h) + boff + n * 2048 + k * 1024); } while (0)
#define PG8_MMA(ai, bj, At, Bt) do { __builtin_amdgcn_s_setprio(1); _Pragma("unroll") for (int m = 0; m < 4; ++m) _Pragma("unroll") for (int n = 0; n < 2; ++n) _Pragma("unroll") for (int k = 0; k < 2; ++k) \
        acc[ai][bj][m][n] = __builtin_amdgcn_mfma_f32_16x16x32_bf16(Bt[n][k], At[m][k], acc[ai][bj][m][n], 0, 0, 0); __builtin_amdgcn_s_setprio(0); } while (0)
#define PG8_WAIT_V(n) asm volatile("s_waitcnt vmcnt(" #n ")" ::: "memory")
#define PG8_WAIT_L(n) asm volatile("s_waitcnt lgkmcnt(" #n ")" ::: "memory")
#define PG8_BAR __builtin_amdgcn_s_barrier()
#define PG8_SCHED __builtin_amdgcn_sched_barrier(0)
    Unit cur, nxt; int ui = 0;
    if (!S.next(0, cur)) return;
    f32x4 acc[2][2][4][2];
#pragma unroll
    for (int a = 0; a < 2; ++a)
#pragma unroll
        for (int b = 0; b < 2; ++b)
#pragma unroll
            for (int m = 0; m < 4; ++m)
#pragma unroll
                for (int n = 0; n < 2; ++n) acc[a][b][m][n] = (f32x4){0.f, 0.f, 0.f, 0.f};
    bf16x8 At[4][2], B0[2][2], B1[2][2];
    const char* cA = (const char*)g.A + (size_t)cur.pm * tstep; const char* cB = (const char*)g.Bt + (size_t)cur.pn * tstep;
    S.a_ready(cur);
    if constexpr (SP2) {
        PG8_STAGE(PG8_SB(0, 0), cB, voffB); PG8_STAGE(PG8_SB(0, 1), cB + hstep, voffB); PG8_STAGE(PG8_SA(0, 0), cA, voffA); PG8_STAGE(PG8_SA(0, 1), cA + hstep, voffA);
        if (wr == 1) PG8_BAR;
        PG8_WAIT_V(2); PG8_BAR;
        PG8_STAGE(PG8_SB(1, 0), cB + kstep, voffB); PG8_STAGE(PG8_SA(1, 0), cA + kstep, voffA); PG8_STAGE(PG8_SB(1, 1), cB + hstep + kstep, voffB);
        PG8_WAIT_V(6); PG8_BAR;
    } else {
        PG8_STAGE(PG8_SB(0, 0), cB, voffB); PG8_STAGE(PG8_SA(0, 0), cA, voffA); PG8_STAGE(PG8_SB(0, 1), cB + hstep, voffB); PG8_STAGE(PG8_SA(0, 1), cA + hstep, voffA);
        if (wr == 1) PG8_BAR;
        PG8_WAIT_V(4); PG8_BAR;
        PG8_STAGE(PG8_SB(1, 0), cB + kstep, voffB); PG8_STAGE(PG8_SA(1, 0), cA + kstep, voffA); PG8_STAGE(PG8_SB(1, 1), cB + hstep + kstep, voffB);
        PG8_WAIT_V(6); PG8_BAR;
    }
    for (;;) {
        const bool has_next = S.next(ui + 1, nxt);
        const char* nA = has_next ? (const char*)g.A + (size_t)nxt.pm * tstep : cA; const char* nB = has_next ? (const char*)g.Bt + (size_t)nxt.pn * tstep : cB;
        for (int t = 0; t < nt; t += 2) {
            const bool last = (t == nt - 2);
            const char* a1 = cA + (size_t)(t + 1) * kstep;
            const char* a2 = last ? nA : cA + (size_t)(t + 2) * kstep; const char* b2 = last ? nB : cB + (size_t)(t + 2) * kstep;
            const char* a3 = a2 + kstep; const char* b3 = b2 + kstep;
            if (last && has_next) S.a_ready(nxt);
            if constexpr (SP2) {
            PG8_LDB(B0, 0, 0); PG8_LDB(B1, 0, 1); PG8_SCHED; PG8_LDA(At, 0, 0); PG8_STAGE(PG8_SA(1, 1), a1 + hstep, voffA);
            PG8_WAIT_V(8); PG8_WAIT_L(0); PG8_BAR; PG8_MMA(0, 0, At, B0); PG8_MMA(0, 1, At, B1); PG8_BAR; PG8_SCHED;
            PG8_LDA(At, 0, 1); PG8_STAGE(PG8_SB(0, 0), b2, voffB); PG8_STAGE(PG8_SB(0, 1), b2 + hstep, voffB); PG8_STAGE(PG8_SA(0, 0), a2, voffA);
            PG8_WAIT_V(8); PG8_WAIT_L(0); PG8_BAR; PG8_MMA(1, 0, At, B0); PG8_MMA(1, 1, At, B1); PG8_BAR; PG8_SCHED;
            PG8_LDB(B0, 1, 0); PG8_LDB(B1, 1, 1); PG8_SCHED; PG8_LDA(At, 1, 0); PG8_STAGE(PG8_SA(0, 1), a2 + hstep, voffA);
            PG8_WAIT_V(8); PG8_WAIT_L(0); PG8_BAR; PG8_MMA(0, 0, At, B0); PG8_MMA(0, 1, At, B1); PG8_BAR; PG8_SCHED;
            PG8_LDA(At, 1, 1); PG8_STAGE(PG8_SB(1, 0), b3, voffB); PG8_STAGE(PG8_SB(1, 1), b3 + hstep, voffB); PG8_STAGE(PG8_SA(1, 0), a3, voffA);
            PG8_WAIT_V(8); PG8_WAIT_L(0); PG8_BAR; PG8_MMA(1, 0, At, B0); PG8_MMA(1, 1, At, B1); PG8_BAR; PG8_SCHED;
            } else {
            PG8_LDB(B0, 0, 0); PG8_SCHED; PG8_LDA(At, 0, 0); PG8_STAGE(PG8_SA(1, 1), a1 + hstep, voffA);
            PG8_WAIT_L(8); PG8_BAR; PG8_WAIT_L(0); PG8_MMA(0, 0, At, B0); PG8_BAR; PG8_SCHED;
            PG8_LDB(B1, 0, 1); PG8_STAGE(PG8_SB(0, 0), b2, voffB);
            PG8_BAR; PG8_WAIT_L(0); PG8_MMA(0, 1, At, B1); PG8_BAR;
            PG8_LDA(At, 0, 1); PG8_STAGE(PG8_SA(0, 0), a2, voffA);
            PG8_BAR; PG8_WAIT_L(0); PG8_MMA(1, 0, At, B0); PG8_BAR; PG8_SCHED;
            PG8_STAGE(PG8_SB(0, 1), b2 + hstep, voffB);
            PG8_WAIT_V(6); PG8_BAR; PG8_MMA(1, 1, At, B1); PG8_BAR;
            PG8_LDB(B0, 1, 0); PG8_SCHED; PG8_LDA(At, 1, 0); PG8_STAGE(PG8_SA(0, 1), a2 + hstep, voffA);
            PG8_WAIT_L(8); PG8_BAR; PG8_WAIT_L(0); PG8_MMA(0, 0, At, B0); PG8_BAR; PG8_SCHED;
            PG8_LDB(B1, 1, 1); PG8_STAGE(PG8_SB(1, 0), b3, voffB);
            PG8_BAR; PG8_WAIT_L(0); PG8_MMA(0, 1, At, B1); PG8_BAR;
            PG8_LDA(At, 1, 1); PG8_STAGE(PG8_SA(1, 0), a3, voffA);
            PG8_BAR; PG8_WAIT_L(0); PG8_MMA(1, 0, At, B0); PG8_BAR; PG8_SCHED;
            PG8_STAGE(PG8_SB(1, 1), b3 + hstep, voffB);
            PG8_WAIT_V(6); PG8_BAR; PG8_MMA(1, 1, At, B1); PG8_BAR;
            }
        }
        if constexpr (ALIGN_EPI) { if (wr == 0) PG8_BAR; }
        if constexpr (!Epi::AFTER_DRAIN) { E(acc, cur, wr, wc, fr, fq); S.done(cur); }
        if (!has_next) break;
#pragma unroll
        for (int a = 0; a < 2; ++a)
#pragma unroll
            for (int b = 0; b < 2; ++b)
#pragma unroll
                for (int m = 0; m < 4; ++m)
#pragma unroll
                    for (int n = 0; n < 2; ++n) acc[a][b][m][n] = (f32x4){0.f, 0.f, 0.f, 0.f};
        cur = nxt; cA = nA; cB = nB; ++ui;
        if constexpr (ALIGN_EPI) { if (wr == 1) PG8_BAR; }
    }
    PG8_WAIT_V(0);
    if constexpr (!ALIGN_EPI) { if (wr == 0) PG8_BAR; }
    PG8_BAR;
    if constexpr (Epi::AFTER_DRAIN) { E.fused(acc, cur, wr, wc, fr, fq, lds, wid, lane); S.done(cur); }
#undef PG8_SA
#undef PG8_SB
#undef PG8_STAGE
#undef PG8_LDA
#undef PG8_LDB
#undef PG8_MMA
#undef PG8_WAIT_V
#undef PG8_WAIT_L
#undef PG8_BAR
#undef PG8_SCHED
}
template <class Epi, class Sched, bool ALIGN_EPI = false, bool SP2 = false>
__device__ __forceinline__ void gemm_phase_i8(PG8_LAS unsigned char* lds, const Gemm g, const Sched& S, const Epi& E) {
    const int tid = threadIdx.x, wid = __builtin_amdgcn_readfirstlane(tid >> 6), lane = tid & 63, wr = wid >> 2, wc = wid & 3, fr = lane & 15, fq = lane >> 4;
    const int K = g.K, nt = K / BK;
    unsigned voffA[2], voffB[2];
#pragma unroll
    for (int i = 0; i < 2; ++i) { int R, C; stage_rc(tid * 16 + i * 8192, R, C); const int Rb = Epi::PERM ? ((R & ~31) + perm32(R & 31)) : R;
        voffA[i] = (unsigned)(R * K + C) * 2u; voffB[i] = (unsigned)(Rb * K + C) * 2u; }
    const size_t kstep = (size_t)(BK * 2);
    const size_t hstep = (size_t)HALF * K * 2;
    const size_t tstep = 2 * hstep;
    const unsigned ldsw = (unsigned)wid * 1024u;
    const int aoff = lds_byte(wr * 64 + fr, fq * 8), boff = lds_byte(wc * 32 + fr, fq * 8);
#define PG8_SA(b, h) (((b) * 2 + (h)) * HTB)
#define PG8_SB(b, h) ((4 + (b) * 2 + (h)) * HTB)
#define PG8_STAGE(bufoff, gbase, voff) do { _Pragma("unroll") for (int _i = 0; _i < 2; ++_i) \
        __builtin_amdgcn_global_load_lds((const unsigned*)((const char*)(gbase) + (voff)[_i]), (PG8_LAS unsigned*)(lds + (bufoff) + ldsw + _i * 8192), 16, 0, 0); } while (0)
#define PG8_LDA(dst, b, h) do { _Pragma("unroll") for (int m = 0; m < 4; ++m) _Pragma("unroll") for (int k = 0; k < 2; ++k) dst[m][k] = *(const PG8_LAS bf16x8*)(lds + PG8_SA(b, h) + aoff + m * 2048 + k * 1024); } while (0)
#define PG8_LDB(dst, b, h) do { _Pragma("unroll") for (int n = 0; n < 2; ++n) _Pragma("unroll") for (int k = 0; k < 2; ++k) dst[n][k] = *(const PG8_LAS bf16x8*)(lds + PG8_SB(b, h) + boff + n * 2048 + k * 1024); } while (0)
#define PG8_MMA(ai, bj, At, Bt) do { __builtin_amdgcn_s_setprio(1); _Pragma("unroll") for (int m = 0; m < 4; ++m) _Pragma("unroll") for (int n = 0; n < 2; ++n) _Pragma("unroll") for (int k = 0; k < 2; ++k) \
        acc[ai][bj][m][n] = __builtin_amdgcn_mfma_i32_16x16x64_i8(__builtin_bit_cast(i32x4, Bt[n][k]), __builtin_bit_cast(i32x4, At[m][k]), acc[ai][bj][m][n], 0, 0, 0); __builtin_amdgcn_s_setprio(0); } while (0)
#define PG8_WAIT_V(n) asm volatile("s_waitcnt vmcnt(" #n ")" ::: "memory")
#define PG8_WAIT_L(n) asm volatile("s_waitcnt lgkmcnt(" #n ")" ::: "memory")
#define PG8_BAR __builtin_amdgcn_s_barrier()
#define PG8_SCHED __builtin_amdgcn_sched_barrier(0)
    Unit cur, nxt; int ui = 0;
    if (!S.next(0, cur)) return;
    i32x4 acc[2][2][4][2];
#pragma unroll
    for (int a = 0; a < 2; ++a)
#pragma unroll
        for (int b = 0; b < 2; ++b)
#pragma unroll
            for (int m = 0; m < 4; ++m)
#pragma unroll
                for (int n = 0; n < 2; ++n) acc[a][b][m][n] = (i32x4){0, 0, 0, 0};
    bf16x8 At[4][2], B0[2][2], B1[2][2];
    const char* cA = (const char*)g.A + (size_t)cur.pm * tstep; const char* cB = (const char*)g.Bt + (size_t)cur.pn * tstep;
    S.a_ready(cur);
    if constexpr (SP2) {
        PG8_STAGE(PG8_SB(0, 0), cB, voffB); PG8_STAGE(PG8_SB(0, 1), cB + hstep, voffB); PG8_STAGE(PG8_SA(0, 0), cA, voffA); PG8_STAGE(PG8_SA(0, 1), cA + hstep, voffA);
        if (wr == 1) PG8_BAR;
        PG8_WAIT_V(2); PG8_BAR;
        PG8_STAGE(PG8_SB(1, 0), cB + kstep, voffB); PG8_STAGE(PG8_SA(1, 0), cA + kstep, voffA); PG8_STAGE(PG8_SB(1, 1), cB + hstep + kstep, voffB);
        PG8_WAIT_V(6); PG8_BAR;
    } else {
        PG8_STAGE(PG8_SB(0, 0), cB, voffB); PG8_STAGE(PG8_SA(0, 0), cA, voffA); PG8_STAGE(PG8_SB(0, 1), cB + hstep, voffB); PG8_STAGE(PG8_SA(0, 1), cA + hstep, voffA);
        if (wr == 1) PG8_BAR;
        PG8_WAIT_V(4); PG8_BAR;
        PG8_STAGE(PG8_SB(1, 0), cB + kstep, voffB); PG8_STAGE(PG8_SA(1, 0), cA + kstep, voffA); PG8_STAGE(PG8_SB(1, 1), cB + hstep + kstep, voffB);
        PG8_WAIT_V(6); PG8_BAR;
    }
    for (;;) {
        const bool has_next = S.next(ui + 1, nxt);
        const char* nA = has_next ? (const char*)g.A + (size_t)nxt.pm * tstep : cA; const char* nB = has_next ? (const char*)g.Bt + (size_t)nxt.pn * tstep : cB;
        for (int t = 0; t < nt; t += 2) {
            const bool last = (t == nt - 2);
            const char* a1 = cA + (size_t)(t + 1) * kstep;
            const char* a2 = last ? nA : cA + (size_t)(t + 2) * kstep; const char* b2 = last ? nB : cB + (size_t)(t + 2) * kstep;
            const char* a3 = a2 + kstep; const char* b3 = b2 + kstep;
            if (last && has_next) S.a_ready(nxt);
            if constexpr (SP2) {
            PG8_LDB(B0, 0, 0); PG8_LDB(B1, 0, 1); PG8_SCHED; PG8_LDA(At, 0, 0); PG8_STAGE(PG8_SA(1, 1), a1 + hstep, voffA);
            PG8_WAIT_V(8); PG8_WAIT_L(0); PG8_BAR; PG8_MMA(0, 0, At, B0); PG8_MMA(0, 1, At, B1); PG8_BAR; PG8_SCHED;
            PG8_LDA(At, 0, 1); PG8_STAGE(PG8_SB(0, 0), b2, voffB); PG8_STAGE(PG8_SB(0, 1), b2 + hstep, voffB); PG8_STAGE(PG8_SA(0, 0), a2, voffA);
            PG8_WAIT_V(8); PG8_WAIT_L(0); PG8_BAR; PG8_MMA(1, 0, At, B0); PG8_MMA(1, 1, At, B1); PG8_BAR; PG8_SCHED;
            PG8_LDB(B0, 1, 0); PG8_LDB(B1, 1, 1); PG8_SCHED; PG8_LDA(At, 1, 0); PG8_STAGE(PG8_SA(0, 1), a2 + hstep, voffA);
            PG8_WAIT_V(8); PG8_WAIT_L(0); PG8_BAR; PG8_MMA(0, 0, At, B0); PG8_MMA(0, 1, At, B1); PG8_BAR; PG8_SCHED;
            PG8_LDA(At, 1, 1); PG8_STAGE(PG8_SB(1, 0), b3, voffB); PG8_STAGE(PG8_SB(1, 1), b3 + hstep, voffB); PG8_STAGE(PG8_SA(1, 0), a3, voffA);
            PG8_WAIT_V(8); PG8_WAIT_L(0); PG8_BAR; PG8_MMA(1, 0, At, B0); PG8_MMA(1, 1, At, B1); PG8_BAR; PG8_SCHED;
            } else {
            PG8_LDB(B0, 0, 0); PG8_SCHED; PG8_LDA(At, 0, 0); PG8_STAGE(PG8_SA(1, 1), a1 + hstep, voffA);
            PG8_WAIT_L(8); PG8_BAR; PG8_WAIT_L(0); PG8_MMA(0, 0, At, B0); PG8_BAR; PG8_SCHED;
            PG8_LDB(B1, 0, 1); PG8_STAGE(PG8_SB(0, 0), b2, voffB);
            PG8_BAR; PG8_WAIT_L(0); PG8_MMA(0, 1, At, B1); PG8_BAR;
            PG8_LDA(At, 0, 1); PG8_STAGE(PG8_SA(0, 0), a2, voffA);
            PG8_BAR; PG8_WAIT_L(0); PG8_MMA(1, 0, At, B0); PG8_BAR; PG8_SCHED;
            PG8_STAGE(PG8_SB(0, 1), b2 + hstep, voffB);
            PG8_WAIT_V(6); PG8_BAR; PG8_MMA(1, 1, At, B1); PG8_BAR;
            PG8_LDB(B0, 1, 0); PG8_SCHED; PG8_LDA(At, 1, 0); PG8_STAGE(PG8_SA(0, 1), a2 + hstep, voffA);
            PG8_WAIT_L(8); PG8_BAR; PG8_WAIT_L(0); PG8_MMA(0, 0, At, B0); PG8_BAR; PG8_SCHED;
            PG8_LDB(B1, 1, 1); PG8_STAGE(PG8_SB(1, 0), b3, voffB);
            PG8_BAR; PG8_WAIT_L(0); PG8_MMA(0, 1, At, B1); PG8_BAR;
            PG8_LDA(At, 1, 1); PG8_STAGE(PG8_SA(1, 0), a3, voffA);
            PG8_BAR; PG8_WAIT_L(0); PG8_MMA(1, 0, At, B0); PG8_BAR; PG8_SCHED;
            PG8_STAGE(PG8_SB(1, 1), b3 + hstep, voffB);
            PG8_WAIT_V(6); PG8_BAR; PG8_MMA(1, 1, At, B1); PG8_BAR;
            }
        }
        if constexpr (ALIGN_EPI) { if (wr == 0) PG8_BAR; }
        if constexpr (!Epi::AFTER_DRAIN) { E(acc, cur, wr, wc, fr, fq); S.done(cur); }
        if (!has_next) break;
#pragma unroll
        for (int a = 0; a < 2; ++a)
#pragma unroll
            for (int b = 0; b < 2; ++b)
#pragma unroll
                for (int m = 0; m < 4; ++m)
#pragma unroll
                    for (int n = 0; n < 2; ++n) acc[a][b][m][n] = (i32x4){0, 0, 0, 0};
        cur = nxt; cA = nA; cB = nB; ++ui;
        if constexpr (ALIGN_EPI) { if (wr == 1) PG8_BAR; }
    }
    PG8_WAIT_V(0);
    if constexpr (!ALIGN_EPI) { if (wr == 0) PG8_BAR; }
    PG8_BAR;
    if constexpr (Epi::AFTER_DRAIN) { E.fused(acc, cur, wr, wc, fr, fq, lds, wid, lane); S.done(cur); }
#undef PG8_SA
#undef PG8_SB
#undef PG8_STAGE
#undef PG8_LDA
#undef PG8_LDB
#undef PG8_MMA
#undef PG8_WAIT_V
#undef PG8_WAIT_L
#undef PG8_BAR
#undef PG8_SCHED
}
}

#define LAS __attribute__((address_space(3)))
typedef unsigned short bf16;
typedef float f32x2 __attribute__((ext_vector_type(2)));
typedef float f32x4 __attribute__((ext_vector_type(4)));
typedef unsigned u32x2 __attribute__((ext_vector_type(2)));
typedef unsigned u32x4 __attribute__((ext_vector_type(4)));

constexpr int PDIM = 1536;
constexpr int NTOK = 32768, DM = 1024, DIN = 2560, SEQ = 8192, NBATCH = 4, NMETA = 16;
constexpr int NHEAD = 8, NKEYS = 128, TOPK = 16, NSEL = NHEAD * TOPK;
constexpr float EPS = 1e-6f;
constexpr float U_SCALE = 64.f, V_SCALE = 16.f;
constexpr float U4_CLIP = 2.6f;
constexpr int NWAVES = 8, NTHREADS = 512;
constexpr int MKC = 32;
constexpr int LDS_BYTES = 147456;

constexpr size_t MiB = 1u << 20;
constexpr size_t WS_CTL = 0, WS_WIN_T = 1 * MiB, WS_WOUT_T = 6 * MiB, WS_WQ_T = 8 * MiB, WS_KEYS = 12 * MiB, WS_METAPART = 160 * MiB  ,
                 WS_METARSTD = 14 * MiB + 512 * 1024, WS_METAPROJ = 14 * MiB + 576 * 1024, WS_RSTD1 = 15 * MiB, WS_SSQ = 16 * MiB, WS_U8 = 32 * MiB, WS_V8 = 48 * MiB,
                 WS_IDX = 64 * MiB, WS_GATE = 80 * MiB, WS_H0B = 96 * MiB, WS_H2B = 96 * MiB, WS_Y = 160 * MiB, WS_PROJ = 224 * MiB,
                 WS_Q = 224 * MiB, WS_ESCALE = 18 * MiB, WS_SUMQ = 19 * MiB, WS_SX = 20 * MiB, WS_SW = 21 * MiB, WS_SY = 22 * MiB, WS_SWO = 23 * MiB, WS_WMX = 24 * MiB, WS_AMX = 26 * MiB, WS_RF = 28 * MiB, WS_SWQ = 29 * MiB, WS_H0I8 = 384 * MiB, WS_AW = 160 * MiB  , WS_END = 416 * MiB;

struct Params {
    const float* x; const float* meta; const float* g_mix; const float* w_in; const float* sc_w; const float* cf_w; const float* cf_b;
    const float* ln_g; const float* ln_b; const float* g_sc; const float* g_cf; const float* w_out; const float* g_ffn; const float* w_q;
    const float* keys; const float* pu; const float* pv; const float* g_fin;
    float* out; unsigned char* ws;
    int ph_lo, ph_hi, coop, pad;
};

__device__ __forceinline__ unsigned f2bf(float f) { unsigned u = __builtin_bit_cast(unsigned, f); return (u + 0x7fffu + ((u >> 16) & 1u)) >> 16; }
__device__ __forceinline__ unsigned pk2(float lo, float hi) { return f2bf(lo) | (f2bf(hi) << 16); }
__device__ __forceinline__ float bf2f(unsigned b) { return __builtin_bit_cast(float, b << 16); }
__device__ __forceinline__ float bflo(unsigned w) { return __builtin_bit_cast(float, w << 16); }
__device__ __forceinline__ float bfhi(unsigned w) { return __builtin_bit_cast(float, w & 0xffff0000u); }
__device__ __forceinline__ float wave_sum(float v) {
#pragma unroll
    for (int o = 1; o < 64; o <<= 1) v += __shfl_xor(v, o);
    return v;
}
template <int CTRL> __device__ __forceinline__ float dpp_f(float v) { return __builtin_bit_cast(float, __builtin_amdgcn_update_dpp(0, __builtin_bit_cast(int, v), CTRL, 0xf, 0xf, true)); }
__device__ __forceinline__ float wave_sum_fast(float v) {
    v += dpp_f<0xB1>(v); v += dpp_f<0x4E>(v); v += dpp_f<0x141>(v); v += dpp_f<0x140>(v);
    { auto r = __builtin_amdgcn_permlane16_swap(__float_as_uint(v), __float_as_uint(v), false, false); v = __uint_as_float(r[0]) + __uint_as_float(r[1]); }
    { auto r = __builtin_amdgcn_permlane32_swap(__float_as_uint(v), __float_as_uint(v), false, false); v = __uint_as_float(r[0]) + __uint_as_float(r[1]); }
    return v;
}
__device__ __forceinline__ float wave_max_fast(float v) {
    v = fmaxf(v, dpp_f<0xB1>(v)); v = fmaxf(v, dpp_f<0x4E>(v)); v = fmaxf(v, dpp_f<0x141>(v)); v = fmaxf(v, dpp_f<0x140>(v));
    { auto r = __builtin_amdgcn_permlane16_swap(__float_as_uint(v), __float_as_uint(v), false, false); v = fmaxf(__uint_as_float(r[0]), __uint_as_float(r[1])); }
    { auto r = __builtin_amdgcn_permlane32_swap(__float_as_uint(v), __float_as_uint(v), false, false); v = fmaxf(__uint_as_float(r[0]), __uint_as_float(r[1])); }
    return v;
}
__device__ __forceinline__ float sigmoid_f(float x) { return 1.f / (1.f + __expf(-x)); }
__device__ __forceinline__ float gelu_tanh_f(float x) {
    const float t = 0.7978845608028654f * (x + 0.044715f * x * x * x);
    const float e = __expf(2.f * t);
    const float th = 1.f - 2.f / (e + 1.f);
    return 0.5f * x * (1.f + th);
}

__device__ __forceinline__ unsigned cvt_pk_bf16(float lo, float hi) { unsigned r; asm volatile("v_cvt_pk_bf16_f32 %0, %1, %2" : "=v"(r) : "v"(lo), "v"(hi)); return r; }

template <int MODE> struct EpiRowScale {
    static constexpr bool PERM = true, AFTER_DRAIN = false;
    bf16* O; int ldc; const float* rs;
    __device__ __forceinline__ void operator()(const pg8::f32x4 (&acc)[2][2][4][2], const pg8::Unit& u, int wr, int wc, int fr, int fq) const {
        const int row0 = u.pm * 256 + wr * 64 + fr, col0 = u.pn * 256 + wc * 32 + 8 * fq;
#pragma unroll
        for (int ai = 0; ai < 2; ++ai)
#pragma unroll
            for (int m = 0; m < 4; ++m) {
                const int row = row0 + ai * 128 + m * 16;
                float s;
                if (MODE == 0) s = rs[row];
                else { const f32x4* p = (const f32x4*)(rs + (size_t)row * 16); const f32x4 a = p[0], b = p[1], c = p[2], d = p[3];
                       const float t = ((a.x + a.y) + (a.z + a.w)) + ((b.x + b.y) + (b.z + b.w)) + ((c.x + c.y) + (c.z + c.w)) + ((d.x + d.y) + (d.z + d.w));
                       s = rsqrtf(t * (1.f / 1024.f) + EPS); }
                bf16* rowp = O + (size_t)row * ldc + col0;
#pragma unroll
                for (int bj = 0; bj < 2; ++bj) { const pg8::f32x4 v0 = acc[ai][bj][m][0] * s, v1 = acc[ai][bj][m][1] * s;
                    u32x4 w; w.x = cvt_pk_bf16(v0[0], v0[1]); w.y = cvt_pk_bf16(v0[2], v0[3]); w.z = cvt_pk_bf16(v1[0], v1[1]); w.w = cvt_pk_bf16(v1[2], v1[3]);
                    *(u32x4*)(rowp + bj * 128) = w; }
            }
    }
};
struct EpiProj {
    static constexpr bool PERM = true, AFTER_DRAIN = false;
    bf16* O; const float* rs;
    __device__ __forceinline__ void operator()(const pg8::f32x4 (&acc)[2][2][4][2], const pg8::Unit& u, int wr, int wc, int fr, int fq) const {
        const int row0 = u.pm * 256 + wr * 64 + fr, cin = wc * 32 + 8 * fq, pn = u.pn;
#pragma unroll
        for (int ai = 0; ai < 2; ++ai)
#pragma unroll
            for (int m = 0; m < 4; ++m) {
                const int row = row0 + ai * 128 + m * 16; const float sc = rs[row];
                float a[8], b[8];
#pragma unroll
                for (int i = 0; i < 4; ++i) { a[i] = acc[ai][0][m][0][i] * sc; a[4 + i] = acc[ai][0][m][1][i] * sc; b[i] = acc[ai][1][m][0][i] * sc; b[4 + i] = acc[ai][1][m][1][i] * sc; }
                bf16* rowp = O + (size_t)row * PDIM;
                if (pn >= 4 && pn < 6) {
                    u32x4 w0, w1; w0.x = cvt_pk_bf16(a[0], a[1]); w0.y = cvt_pk_bf16(a[2], a[3]); w0.z = cvt_pk_bf16(a[4], a[5]); w0.w = cvt_pk_bf16(a[6], a[7]);
                    w1.x = cvt_pk_bf16(b[0], b[1]); w1.y = cvt_pk_bf16(b[2], b[3]); w1.z = cvt_pk_bf16(b[4], b[5]); w1.w = cvt_pk_bf16(b[6], b[7]);
                    *(u32x4*)(rowp + 512 + 256 * (pn - 4) + cin) = w0; *(u32x4*)(rowp + 512 + 256 * (pn - 4) + 128 + cin) = w1;
                } else {
                    float o[8];
                    if (pn < 4) {
#pragma unroll
                        for (int i = 0; i < 8; ++i) o[i] = a[i] * b[i];
                    } else {
#pragma unroll
                        for (int i = 0; i < 8; ++i) o[i] = a[i] * sigmoid_f(b[i]);
                    }
                    u32x4 w; w.x = cvt_pk_bf16(o[0], o[1]); w.y = cvt_pk_bf16(o[2], o[3]); w.z = cvt_pk_bf16(o[4], o[5]); w.w = cvt_pk_bf16(o[6], o[7]);
                    *(u32x4*)(rowp + (pn < 4 ? 128 * pn : 1024 + 128 * (pn - 6)) + cin) = w;
                }
            }
    }
};
struct EpiProjI8 {
    static constexpr bool PERM = true, AFTER_DRAIN = false;
    bf16* O; const float* rs; const float* sw;
    __device__ __forceinline__ void operator()(const pg8::i32x4 (&acc)[2][2][4][2], const pg8::Unit& u, int wr, int wc, int fr, int fq) const {
        const int row0 = u.pm * 256 + wr * 64 + fr, cin = wc * 32 + 8 * fq, pn = u.pn;
        float swa[8], swb[8];
        { const f32x4 a0 = *(const f32x4*)(sw + 256 * pn + cin), a1 = *(const f32x4*)(sw + 256 * pn + cin + 4), b0 = *(const f32x4*)(sw + 256 * pn + 128 + cin), b1 = *(const f32x4*)(sw + 256 * pn + 128 + cin + 4);
          swa[0] = a0.x; swa[1] = a0.y; swa[2] = a0.z; swa[3] = a0.w; swa[4] = a1.x; swa[5] = a1.y; swa[6] = a1.z; swa[7] = a1.w;
          swb[0] = b0.x; swb[1] = b0.y; swb[2] = b0.z; swb[3] = b0.w; swb[4] = b1.x; swb[5] = b1.y; swb[6] = b1.z; swb[7] = b1.w; }
#pragma unroll
        for (int ai = 0; ai < 2; ++ai)
#pragma unroll
            for (int m = 0; m < 4; ++m) {
                const int row = row0 + ai * 128 + m * 16; const float sc = rs[row];
                float a[8], b[8];
#pragma unroll
                for (int i = 0; i < 4; ++i) { a[i] = (float)acc[ai][0][m][0][i] * (sc * swa[i]); a[4 + i] = (float)acc[ai][0][m][1][i] * (sc * swa[4 + i]);
                    b[i] = (float)acc[ai][1][m][0][i] * (sc * swb[i]); b[4 + i] = (float)acc[ai][1][m][1][i] * (sc * swb[4 + i]); }
                bf16* rowp = O + (size_t)row * PDIM;
                if (pn >= 4 && pn < 6) {
                    u32x4 w0, w1; w0.x = cvt_pk_bf16(a[0], a[1]); w0.y = cvt_pk_bf16(a[2], a[3]); w0.z = cvt_pk_bf16(a[4], a[5]); w0.w = cvt_pk_bf16(a[6], a[7]);
                    w1.x = cvt_pk_bf16(b[0], b[1]); w1.y = cvt_pk_bf16(b[2], b[3]); w1.z = cvt_pk_bf16(b[4], b[5]); w1.w = cvt_pk_bf16(b[6], b[7]);
                    *(u32x4*)(rowp + 512 + 256 * (pn - 4) + cin) = w0; *(u32x4*)(rowp + 512 + 256 * (pn - 4) + 128 + cin) = w1;
                } else {
                    float o[8];
                    if (pn < 4) {
#pragma unroll
                        for (int i = 0; i < 8; ++i) o[i] = a[i] * b[i];
                    } else {
#pragma unroll
                        for (int i = 0; i < 8; ++i) o[i] = a[i] * sigmoid_f(b[i]);
                    }
                    u32x4 w; w.x = cvt_pk_bf16(o[0], o[1]); w.y = cvt_pk_bf16(o[2], o[3]); w.z = cvt_pk_bf16(o[4], o[5]); w.w = cvt_pk_bf16(o[6], o[7]);
                    *(u32x4*)(rowp + (pn < 4 ? 128 * pn : 1024 + 128 * (pn - 6)) + cin) = w;
                }
            }
    }
};
__host__ __device__ __forceinline__ int win_src_col(int n) {
    const int t = n >> 8, j = n & 255;
    if (t < 4) return (j < 128) ? 128 * t + j : 1024 + 128 * t + (j - 128);
    if (t < 6) return 512 + 256 * (t - 4) + j;
    return (j < 128) ? 1536 + 128 * (t - 6) + j : 2048 + 128 * (t - 6) + (j - 128);
}
struct EpiResidual {
    static constexpr bool PERM = true, AFTER_DRAIN = false;
    bf16* O; const signed char* XB; const float* SX; float* ssq;
    __device__ __forceinline__ void operator()(const pg8::f32x4 (&acc)[2][2][4][2], const pg8::Unit& u, int wr, int wc, int fr, int fq) const {
        const int row0 = u.pm * 256 + wr * 64 + fr, col0 = u.pn * 256 + wc * 32 + 8 * fq;
#pragma unroll
        for (int ai = 0; ai < 2; ++ai)
#pragma unroll
            for (int m = 0; m < 4; ++m) {
                const int row = row0 + ai * 128 + m * 16;
                const signed char* xr = XB + (size_t)row * DM + col0; bf16* rowp = O + (size_t)row * DM + col0;
                float q = 0.f;
                u32x2 xw[2]; const float sxr = SX[row];
#pragma unroll
                for (int bj = 0; bj < 2; ++bj) xw[bj] = *(const u32x2*)(xr + bj * 128);
#pragma unroll
                for (int bj = 0; bj < 2; ++bj) {
                    const f32x4 x0 = (f32x4){(float)(signed char)(xw[bj].x), (float)(signed char)(xw[bj].x >> 8), (float)(signed char)(xw[bj].x >> 16), (float)((int)xw[bj].x >> 24)} * sxr,
                                x1 = (f32x4){(float)(signed char)(xw[bj].y), (float)(signed char)(xw[bj].y >> 8), (float)(signed char)(xw[bj].y >> 16), (float)((int)xw[bj].y >> 24)} * sxr;
                    const pg8::f32x4 v0 = acc[ai][bj][m][0] + x0, v1 = acc[ai][bj][m][1] + x1;
                    q += (v0[0] * v0[0] + v0[1] * v0[1]) + (v0[2] * v0[2] + v0[3] * v0[3]) + (v1[0] * v1[0] + v1[1] * v1[1]) + (v1[2] * v1[2] + v1[3] * v1[3]);
                    u32x4 w; w.x = cvt_pk_bf16(v0[0], v0[1]); w.y = cvt_pk_bf16(v0[2], v0[3]); w.z = cvt_pk_bf16(v1[0], v1[1]); w.w = cvt_pk_bf16(v1[2], v1[3]);
                    *(u32x4*)(rowp + bj * 128) = w; }
                q += __shfl_xor(q, 16); q += __shfl_xor(q, 32);
                if (fq == 0) ssq[(size_t)row * 16 + u.pn * 4 + wc] = q;
            }
    }
};

struct EpiResidualI8 {
    static constexpr bool PERM = true, AFTER_DRAIN = false;
    bf16* O; const signed char* XB; const float* SX; const float* SY; const float* SWO; float* ssq; float* amx;
    __device__ __forceinline__ void operator()(const pg8::i32x4 (&acc)[2][2][4][2], const pg8::Unit& u, int wr, int wc, int fr, int fq) const {
        const int row0 = u.pm * 256 + wr * 64 + fr, col0 = u.pn * 256 + wc * 32 + 8 * fq;
        f32x4 sw[2][2];
#pragma unroll
        for (int bj = 0; bj < 2; ++bj) { sw[bj][0] = *(const f32x4*)(SWO + col0 + bj * 128); sw[bj][1] = *(const f32x4*)(SWO + col0 + bj * 128 + 4); }
#pragma unroll
        for (int ai = 0; ai < 2; ++ai)
#pragma unroll
            for (int m = 0; m < 4; ++m) {
                const int row = row0 + ai * 128 + m * 16;
                const signed char* xr = XB + (size_t)row * DM + col0; bf16* rowp = O + (size_t)row * DM + col0;
                float q = 0.f, mxa = 0.f;
                u32x2 xw[2]; const float sxr = SX[row], syr = SY[row];
#pragma unroll
                for (int bj = 0; bj < 2; ++bj) xw[bj] = *(const u32x2*)(xr + bj * 128);
#pragma unroll
                for (int bj = 0; bj < 2; ++bj) {
                    const f32x4 x0 = (f32x4){(float)(signed char)(xw[bj].x), (float)(signed char)(xw[bj].x >> 8), (float)(signed char)(xw[bj].x >> 16), (float)((int)xw[bj].x >> 24)} * sxr,
                                x1 = (f32x4){(float)(signed char)(xw[bj].y), (float)(signed char)(xw[bj].y >> 8), (float)(signed char)(xw[bj].y >> 16), (float)((int)xw[bj].y >> 24)} * sxr;
                    const pg8::i32x4 a0 = acc[ai][bj][m][0], a1 = acc[ai][bj][m][1];
                    const f32x4 v0 = (f32x4){(float)a0[0], (float)a0[1], (float)a0[2], (float)a0[3]} * (sw[bj][0] * syr) + x0, v1 = (f32x4){(float)a1[0], (float)a1[1], (float)a1[2], (float)a1[3]} * (sw[bj][1] * syr) + x1;
                    q += (v0[0] * v0[0] + v0[1] * v0[1]) + (v0[2] * v0[2] + v0[3] * v0[3]) + (v1[0] * v1[0] + v1[1] * v1[1]) + (v1[2] * v1[2] + v1[3] * v1[3]);
                    mxa = fmaxf(mxa, fmaxf(fmaxf(fmaxf(fabsf(v0[0]), fabsf(v0[1])), fmaxf(fabsf(v0[2]), fabsf(v0[3]))), fmaxf(fmaxf(fabsf(v1[0]), fabsf(v1[1])), fmaxf(fabsf(v1[2]), fabsf(v1[3])))));
                    u32x4 w; w.x = cvt_pk_bf16(v0[0], v0[1]); w.y = cvt_pk_bf16(v0[2], v0[3]); w.z = cvt_pk_bf16(v1[0], v1[1]); w.w = cvt_pk_bf16(v1[2], v1[3]);
                    *(u32x4*)(rowp + bj * 128) = w; }
                q += __shfl_xor(q, 16); q += __shfl_xor(q, 32);
                mxa = fmaxf(mxa, __shfl_xor(mxa, 16)); mxa = fmaxf(mxa, __shfl_xor(mxa, 32));
                if (fq == 0) { ssq[(size_t)row * 16 + u.pn * 4 + wc] = q; amx[(size_t)row * 16 + u.pn * 4 + wc] = mxa; }
            }
    }
};
template <bool MAPIN> __device__ __forceinline__ void p0_transpose_item(const float* W, int K, int N, bf16* WT, LAS float* scr, int item, int lane,
                                                  const float* g_lo, const float* g_hi, int split) {
    const int nblk = N / 32, kb = item / nblk, nb = item % nblk, k0 = 64 * kb, n0 = 32 * nb;
#pragma unroll 8
    for (int i = 0; i < 32; ++i) { const int kk = 2 * i + (lane >> 5); const int k = k0 + kk;
        const float g = (k < split) ? g_lo[k] : g_hi[k - split];
        scr[kk * 33 + (lane & 31)] = W[(size_t)k * N + (MAPIN ? win_src_col(n0) : n0) + (lane & 31)] * g; }
    asm volatile("s_waitcnt lgkmcnt(0)" ::: "memory");
    const int c = lane & 7;
#pragma unroll
    for (int j = 0; j < 4; ++j) { const int n = (lane >> 3) + 8 * j; const LAS float* s = scr + (8 * c) * 33 + n;
        u32x4 o; o.x = pk2(s[0 * 33], s[1 * 33]); o.y = pk2(s[2 * 33], s[3 * 33]); o.z = pk2(s[4 * 33], s[5 * 33]); o.w = pk2(s[6 * 33], s[7 * 33]);
        *(u32x4*)(WT + (size_t)(n0 + n) * K + k0 + 8 * c) = o; }
    asm volatile("s_waitcnt lgkmcnt(0)" ::: "memory");
}

constexpr int CW_COLMAX = 5120;
__device__ __forceinline__ void p0_colmax_item(const float* W, int N, unsigned* colmax, int item, int lane, const float* g) {
    const int nblk = N / 32, kb = item / nblk, nb = item % nblk, k0 = 64 * kb, n0 = 32 * nb;
    float mx = 0.f;
#pragma unroll
    for (int i = 0; i < 32; ++i) { const int k = k0 + 2 * i + (lane >> 5); mx = fmaxf(mx, fabsf(W[(size_t)k * N + n0 + (lane & 31)] * g[k])); }
    mx = fmaxf(mx, __shfl_xor(mx, 32));
    if (lane < 32) atomicMax(colmax + n0 + lane, __float_as_uint(mx));
}
__device__ __forceinline__ void p1_quant_item(const float* W, int K, int N, signed char* WT8, float* swout, const unsigned* colmax, LAS float* scr, int item, int lane, const float* g) {
    const int nblk = N / 32, kb = item / nblk, nb = item % nblk, k0 = 64 * kb, n0 = 32 * nb, s0 = win_src_col(n0);
    const float cm = fmaxf(__uint_as_float(colmax[s0 + (lane & 31)]), 1e-30f), inv = 127.f / cm;
    if (kb == 0 && lane < 32) swout[n0 + lane] = cm * (1.f / 127.f);
#pragma unroll
    for (int i = 0; i < 32; ++i) { const int kk = 2 * i + (lane >> 5); const int k = k0 + kk;
        scr[kk * 33 + (lane & 31)] = W[(size_t)k * N + s0 + (lane & 31)] * g[k] * inv; }
    asm volatile("s_waitcnt lgkmcnt(0)" ::: "memory");
    const int c = lane & 7;
#pragma unroll
    for (int j = 0; j < 4; ++j) { const int n = (lane >> 3) + 8 * j; const LAS float* sp = scr + (8 * c) * 33 + n;
        unsigned w0 = 0u, w1 = 0u;
#pragma unroll
        for (int i = 0; i < 4; ++i) { w0 |= ((unsigned)(int)rintf(sp[i * 33]) & 255u) << (8 * i); w1 |= ((unsigned)(int)rintf(sp[(4 + i) * 33]) & 255u) << (8 * i); }
        u32x2 o; o.x = w0; o.y = w1;
        *(u32x2*)(WT8 + (size_t)(n0 + n) * K + k0 + 8 * c) = o; }
    asm volatile("s_waitcnt lgkmcnt(0)" ::: "memory");
}
constexpr int CW_COLMAX3 = 8704;
constexpr int CW_COLMAX2 = 7680;
__device__ __forceinline__ void p0_colmax_item2(const float* W, int N, unsigned* colmax, int item, int lane, const float* g_lo, const float* g_hi, int split) {
    const int nblk = N / 32, kb = item / nblk, nb = item % nblk, k0 = 64 * kb, n0 = 32 * nb;
    float mx = 0.f;
#pragma unroll
    for (int i = 0; i < 32; ++i) { const int k = k0 + 2 * i + (lane >> 5); const float g = (k < split) ? g_lo[k] : g_hi[k - split]; mx = fmaxf(mx, fabsf(W[(size_t)k * N + n0 + (lane & 31)] * g)); }
    mx = fmaxf(mx, __shfl_xor(mx, 32));
    if (lane < 32) atomicMax(colmax + n0 + lane, __float_as_uint(mx));
}
__device__ __forceinline__ void p1_quant_item2(const float* W, int K, int N, signed char* WT8, float* swout, const unsigned* colmax, LAS float* scr, int item, int lane, const float* g_lo, const float* g_hi, int split) {
    const int nblk = N / 32, kb = item / nblk, nb = item % nblk, k0 = 64 * kb, n0 = 32 * nb;
    const float cm = fmaxf(__uint_as_float(colmax[n0 + (lane & 31)]), 1e-30f), inv = 127.f / cm;
    if (kb == 0 && lane < 32) swout[n0 + lane] = cm * (1.f / 127.f);
#pragma unroll
    for (int i = 0; i < 32; ++i) { const int kk = 2 * i + (lane >> 5); const int k = k0 + kk; const float g = (k < split) ? g_lo[k] : g_hi[k - split];
        scr[kk * 33 + (lane & 31)] = W[(size_t)k * N + n0 + (lane & 31)] * g * inv; }
    asm volatile("s_waitcnt lgkmcnt(0)" ::: "memory");
    const int c = lane & 7;
#pragma unroll
    for (int j = 0; j < 4; ++j) { const int n = (lane >> 3) + 8 * j; const LAS float* sp = scr + (8 * c) * 33 + n;
        unsigned w0 = 0u, w1 = 0u;
#pragma unroll
        for (int i = 0; i < 4; ++i) { w0 |= ((unsigned)(int)rintf(sp[i * 33]) & 255u) << (8 * i); w1 |= ((unsigned)(int)rintf(sp[(4 + i) * 33]) & 255u) << (8 * i); }
        u32x2 o; o.x = w0; o.y = w1;
        *(u32x2*)(WT8 + (size_t)(n0 + n) * K + k0 + 8 * c) = o; }
    asm volatile("s_waitcnt lgkmcnt(0)" ::: "memory");
}
__device__ __forceinline__ void phase_winq(const Params& P, LAS unsigned char* lds) {
    const int tid = threadIdx.x, lane = tid & 63, wave = __builtin_amdgcn_readfirstlane(tid >> 6);
    const int gw = blockIdx.x * NWAVES + wave, NGW = gridDim.x * NWAVES;
    LAS float* scr = (LAS float*)(lds + wave * 16384);
    constexpr int NI1 = (DM / 64) * (DIN / 32), NI2 = (DM / 64) * (DM / 32), NI3 = (DM / 64) * (2048 / 32);
    for (int it = gw; it < NI1 + NI2 + NI3; it += NGW) {
        if (it < NI1) p1_quant_item(P.w_in, DM, DIN, (signed char*)(P.ws + WS_WIN_T), (float*)(P.ws + WS_SW), (const unsigned*)(P.ws + WS_CTL) + CW_COLMAX, scr, it, lane, P.g_mix);
        else if (it < NI1 + NI2) p1_quant_item2(P.w_out, DM, DM, (signed char*)(P.ws + WS_WOUT_T), (float*)(P.ws + WS_SWO), (const unsigned*)(P.ws + WS_CTL) + CW_COLMAX2, scr, it - NI1, lane, P.g_sc, P.g_cf, 512);
        else p1_quant_item2(P.w_q, DM, 2048, (signed char*)(P.ws + WS_WQ_T), (float*)(P.ws + WS_SWQ), (const unsigned*)(P.ws + WS_CTL) + CW_COLMAX3, scr, it - NI1 - NI2, lane, P.g_ffn, P.g_ffn, DM);
    }
}
__device__ __forceinline__ float q4(float x, float inv_s) {
    const float a = fabsf(x) * inv_s; float r;
    if (a < 2.f) r = rintf(a * 2.f) * 0.5f; else if (a < 4.f) r = rintf(a); else r = fminf(6.f, rintf(a * 0.5f) * 2.f);
    return copysignf(r, x);
}
__device__ __forceinline__ void phase_prep(const Params& P, LAS unsigned char* lds) {
    const int tid = threadIdx.x, lane = tid & 63, wave = __builtin_amdgcn_readfirstlane(tid >> 6);
    const int gw = blockIdx.x * NWAVES + wave, NGW = gridDim.x * NWAVES;
    unsigned char* ws = P.ws;
    LAS float* scr = (LAS float*)(lds + wave * 16384);
    constexpr int I_IN = (DM / 64) * (DIN / 32), I_OUT = (DM / 64) * (DM / 32), I_Q = (DM / 64) * (2048 / 32);
    for (int it = gw; it < I_IN + I_OUT + I_Q; it += NGW) {
        int r = it;
        if (r < I_IN) { p0_colmax_item(P.w_in, DIN, (unsigned*)(ws + WS_CTL) + CW_COLMAX, r, lane, P.g_mix); continue; } r -= I_IN;
        if (r < I_OUT) { p0_colmax_item2(P.w_out, DM, (unsigned*)(ws + WS_CTL) + CW_COLMAX2, r, lane, P.g_sc, P.g_cf, 512); continue; } r -= I_OUT;
        p0_colmax_item2(P.w_q, 2048, (unsigned*)(ws + WS_CTL) + CW_COLMAX3, r, lane, P.g_ffn, P.g_ffn, DM);
    }
    {
        unsigned* H0I8 = (unsigned*)(ws + WS_H0I8); float* RS1 = (float*)(ws + WS_RSTD1); float* SXp = (float*)(ws + WS_SX);
        for (int t0 = gw * 4; t0 < NTOK; t0 += NGW * 4) {
            f32x4 v[4][4];
#pragma unroll
            for (int q = 0; q < 4; ++q) { const f32x4* xr = (const f32x4*)(P.x + (size_t)(t0 + q) * DM) + lane;
#pragma unroll
                for (int j = 0; j < 4; ++j) v[q][j] = xr[64 * j]; }
#pragma unroll
            for (int q = 0; q < 4; ++q) { float sq = 0.f, mx = 0.f;
#pragma unroll
                for (int j = 0; j < 4; ++j) { sq += (v[q][j].x * v[q][j].x + v[q][j].y * v[q][j].y) + (v[q][j].z * v[q][j].z + v[q][j].w * v[q][j].w);
                    mx = fmaxf(mx, fmaxf(fmaxf(fabsf(v[q][j].x), fabsf(v[q][j].y)), fmaxf(fabsf(v[q][j].z), fabsf(v[q][j].w)))); }
                sq = wave_sum_fast(sq); mx = fmaxf(wave_max_fast(mx), 1e-30f);
                const float sx = mx * (1.f / 127.f), inv = 127.f / mx;
                if (lane == 0) { RS1[t0 + q] = sx * rsqrtf(sq * (1.f / DM) + EPS); SXp[t0 + q] = sx; }
                unsigned* o = H0I8 + (size_t)(t0 + q) * (DM / 4) + lane;
#pragma unroll
                for (int j = 0; j < 4; ++j) { const int a = (int)rintf(v[q][j].x * inv), b = (int)rintf(v[q][j].y * inv), c = (int)rintf(v[q][j].z * inv), d = (int)rintf(v[q][j].w * inv);
                    o[64 * j] = ((unsigned)a & 255u) | (((unsigned)b & 255u) << 8) | (((unsigned)c & 255u) << 16) | ((unsigned)d << 24); } }
        }
    }
    {
        unsigned char* U8 = ws + WS_U8; unsigned char* V8 = ws + WS_V8;
        f32x4 gf[4];
#pragma unroll
        for (int j = 0; j < 4; ++j) gf[j] = ((const f32x4*)P.g_ffn)[64 * j + lane];
        float* ESC = (float*)(ws + WS_ESCALE);
        for (int e0 = gw * 2; e0 < 2 * 16384; e0 += NGW * 2) {
            const bool isv = e0 >= 16384; const int ee0 = isv ? e0 - 16384 : e0;
            f32x4 v[2][4];
#pragma unroll
            for (int q = 0; q < 2; ++q) { const f32x4* src = (const f32x4*)((isv ? P.pv : P.pu) + (size_t)(ee0 + q) * DM);
#pragma unroll
                for (int j = 0; j < 4; ++j) v[q][j] = isv ? src[4 * lane + j] : src[64 * j + lane]; }
#pragma unroll
            for (int q = 0; q < 2; ++q) {
                float mx = 0.f;
#pragma unroll
                for (int j = 0; j < 4; ++j) { if (!isv) v[q][j] = v[q][j] * gf[j];
                    mx = fmaxf(mx, fmaxf(fmaxf(fabsf(v[q][j].x), fabsf(v[q][j].y)), fmaxf(fabsf(v[q][j].z), fabsf(v[q][j].w)))); }
#pragma unroll
                for (int o = 1; o < 64; o <<= 1) mx = fmaxf(mx, __shfl_xor(mx, o));
                if (!isv) {
                    float sq2 = 0.f;
#pragma unroll
                    for (int j = 0; j < 4; ++j) sq2 += (v[q][j].x * v[q][j].x + v[q][j].y * v[q][j].y) + (v[q][j].z * v[q][j].z + v[q][j].w * v[q][j].w);
                    const float rms = sqrtf(wave_sum_fast(sq2) * (1.f / DM));
                    const float su = fmaxf(fminf(mx, U4_CLIP * rms), 1e-30f) * (1.f / 7.f), inv = 1.f / su;
                    unsigned wq[2] = {0u, 0u}; int csum = 0;
#pragma unroll
                    for (int j = 0; j < 4; ++j) { const float e4[4] = {v[q][j].x, v[q][j].y, v[q][j].z, v[q][j].w};
#pragma unroll
                        for (int i = 0; i < 4; ++i) { int c = (int)rintf(fminf(fmaxf(e4[i] * inv, -7.f), 7.f)); csum += c;
                            wq[j >> 1] |= ((unsigned)c & 15u) << (16 * (j & 1) + 4 * i); } }
                    const float cs = wave_sum_fast((float)csum);
                    if (lane == 0) { ESC[e0 + q] = su; ((float*)(ws + WS_SUMQ))[e0 + q] = cs; }
                    u32x2 o; o.x = wq[0]; o.y = wq[1];
                    *(u32x2*)(U8 + (size_t)(ee0 + q) * 512 + 8 * lane) = o;
                    continue;
                }
                const float sc = fmaxf(mx, 1e-30f) * (1.f / 6.f), inv = 1.f / sc;
                if (lane == 0) ESC[e0 + q] = sc;
                unsigned w0 = 0u, w1 = 0u;
                w0 = __builtin_amdgcn_cvt_scalef32_pk_fp4_f32(w0, v[q][0].x * inv, v[q][0].y * inv, 1.0f, 0); w0 = __builtin_amdgcn_cvt_scalef32_pk_fp4_f32(w0, v[q][0].z * inv, v[q][0].w * inv, 1.0f, 1);
                w0 = __builtin_amdgcn_cvt_scalef32_pk_fp4_f32(w0, v[q][1].x * inv, v[q][1].y * inv, 1.0f, 2); w0 = __builtin_amdgcn_cvt_scalef32_pk_fp4_f32(w0, v[q][1].z * inv, v[q][1].w * inv, 1.0f, 3);
                w1 = __builtin_amdgcn_cvt_scalef32_pk_fp4_f32(w1, v[q][2].x * inv, v[q][2].y * inv, 1.0f, 0); w1 = __builtin_amdgcn_cvt_scalef32_pk_fp4_f32(w1, v[q][2].z * inv, v[q][2].w * inv, 1.0f, 1);
                w1 = __builtin_amdgcn_cvt_scalef32_pk_fp4_f32(w1, v[q][3].x * inv, v[q][3].y * inv, 1.0f, 2); w1 = __builtin_amdgcn_cvt_scalef32_pk_fp4_f32(w1, v[q][3].z * inv, v[q][3].w * inv, 1.0f, 3);
                u32x2 o; o.x = w0; o.y = w1;
                *(u32x2*)((isv ? V8 : U8) + (size_t)(ee0 + q) * 512 + 8 * lane) = o;
            }
        }
    }
    {
        bf16* KB = (bf16*)(ws + WS_KEYS);
        const int gt = blockIdx.x * NTHREADS + tid, NGT = gridDim.x * NTHREADS;
        for (int i = gt; i < 8 * 2 * 128 * 128 / 4; i += NGT) { const f32x4 v = ((const f32x4*)P.keys)[i]; u32x2 w; w.x = pk2(v.x, v.y); w.y = pk2(v.z, v.w); ((u32x2*)KB)[i] = w; }
    }
    {
        float* MP = (float*)(ws + WS_METAPART); float* MR = (float*)(ws + WS_METARSTD);
        for (int r = gw; r < NMETA; r += NGW) {
            float s = 0.f;
            for (int k = lane; k < DM; k += 64) { const float v = P.meta[r * DM + k]; s += v * v; }
            s = wave_sum(s);
            if (lane == 0) MR[r] = rsqrtf(s * (1.f / DM) + EPS);
        }
        for (int it = gw; it < MKC * 40; it += NGW) {
            const int kc = it / 40, nb = it % 40, n = nb * 64 + lane;
            float acc[NMETA];
#pragma unroll
            for (int r = 0; r < NMETA; ++r) acc[r] = 0.f;
            for (int k = kc * (DM / MKC); k < (kc + 1) * (DM / MKC); ++k) {
                const float w = P.w_in[(size_t)k * DIN + n] * P.g_mix[k];
#pragma unroll
                for (int r = 0; r < NMETA; ++r) acc[r] += P.meta[r * DM + k] * w;
            }
#pragma unroll
            for (int r = 0; r < NMETA; ++r) MP[(size_t)(kc * 16 + r) * DIN + n] = acc[r];
        }
    }
}

__device__ __forceinline__ float metaraw(const float* MP, const float* MR, int p, int col) { float s = 0.f;
#pragma unroll 8
    for (int kc = 0; kc < MKC; ++kc) s += MP[(size_t)(kc * 16 + p) * DIN + col];
    return s * MR[p]; }
__device__ __forceinline__ void phase_metaproj(const Params& P) {
    const float* MP = (const float*)(P.ws + WS_METAPART); const float* MR = (const float*)(P.ws + WS_METARSTD); float* MJ = (float*)(P.ws + WS_METAPROJ);
    for (int gt = blockIdx.x * NTHREADS + threadIdx.x; gt < NMETA * PDIM; gt += gridDim.x * NTHREADS) { const int p = gt / PDIM, c = gt % PDIM; float v;
        if (c < 512) v = metaraw(MP, MR, p, c) * metaraw(MP, MR, p, 1024 + c);
        else if (c < 1024) v = metaraw(MP, MR, p, c);
        else v = metaraw(MP, MR, p, 1536 + (c - 1024)) * sigmoid_f(metaraw(MP, MR, p, 2048 + (c - 1024)));
        MJ[gt] = v; }
}
__device__ __forceinline__ float meta_val(const float* MJ, const float*, int p, int col) { return MJ[p * PDIM + col]; }
__device__ __forceinline__ float proj_at(const bf16* PROJ, const float* MP, const float* MR, int b, int pos, int col) {
    if (pos < 0) return 0.f;
    if (pos < NMETA) return meta_val(MP, MR, pos, col);
    return bf2f(PROJ[(size_t)(b * SEQ + pos - NMETA) * PDIM + col]);
}
__device__ __forceinline__ void proj8_at(const bf16* PROJ, const float* MP, const float* MR, int b, int pos, int col, float (&v)[8]) {
    if (pos < 0) {
#pragma unroll
        for (int i = 0; i < 8; ++i) v[i] = 0.f;
    } else if (pos < NMETA) {
        const f32x4 a = *(const f32x4*)(MP + pos * PDIM + col), bq = *(const f32x4*)(MP + pos * PDIM + col + 4);
        v[0] = a.x; v[1] = a.y; v[2] = a.z; v[3] = a.w; v[4] = bq.x; v[5] = bq.y; v[6] = bq.z; v[7] = bq.w;
    } else {
        const u32x4 w = *(const u32x4*)(PROJ + (size_t)(b * SEQ + pos - NMETA) * PDIM + col);
        v[0] = bflo(w.x); v[1] = bfhi(w.x); v[2] = bflo(w.y); v[3] = bfhi(w.y); v[4] = bflo(w.z); v[5] = bfhi(w.z); v[6] = bflo(w.w); v[7] = bfhi(w.w);
    }
}

template <int R> __device__ __forceinline__ void conv_rows(const LAS unsigned char* ubase, const f32x2 (&wcf)[31], f32x2 (&acc)[32]) {
    if constexpr (R < 62) {
        const unsigned uw = *(const LAS unsigned*)(ubase + R * 1024);
        const f32x2 x = (f32x2){bflo(uw), bfhi(uw)};
        constexpr int lo = R > 30 ? R - 30 : 0, hi = R < 31 ? R : 31;
#pragma unroll
        for (int ii = lo; ii <= hi; ++ii) acc[ii] += wcf[R - ii] * x;
        conv_rows<R + 1>(ubase, wcf, acc);
    }
}
__device__ __forceinline__ void phase_conv(const Params& P, LAS unsigned char* lds) {
    const int tid = threadIdx.x, lane = tid & 63, wave = __builtin_amdgcn_readfirstlane(tid >> 6);
    unsigned char* ws = P.ws;
    const bf16* PROJ = (const bf16*)(ws + WS_PROJ); const float* MP = (const float*)(ws + WS_METAPROJ); const float* MR = nullptr;
    bf16* Y = (bf16*)(ws + WS_Y);
    constexpr int TT = 64, NTILE = NTOK / TT, UROWS = TT + 30;
    const int cgp = wave & 3, th = wave >> 2, ch2 = cgp * 128 + 2 * lane;
    f32x2 wcf[31];
#pragma unroll
    for (int j = 0; j < 31; ++j) wcf[j] = *(const f32x2*)(P.cf_w + j * 512 + ch2);
    const f32x2 bcf = *(const f32x2*)(P.cf_b + ch2);
    for (int tile = blockIdx.x; tile < NTILE; tile += gridDim.x) {
        const int b = tile / (SEQ / TT), s0 = (tile % (SEQ / TT)) * TT;
#pragma unroll 4
        for (int p = 0; p < (UROWS + 7) / 8; ++p) {
            const int r = p * 8 + wave;
            if (r < UROWS) {
                const int pos = NMETA + s0 - 30 + r;
                float uu[8];
                proj8_at(PROJ, MP, MR, b, pos, 1024 + 8 * lane, uu);
                u32x4 w; w.x = pk2(uu[0], uu[1]); w.y = pk2(uu[2], uu[3]); w.z = pk2(uu[4], uu[5]); w.w = pk2(uu[6], uu[7]);
                *(LAS u32x4*)(lds + r * 1024 + lane * 16) = w;
            }
        }
        __syncthreads();
        f32x2 acc[32];
#pragma unroll
        for (int ii = 0; ii < 32; ++ii) acc[ii] = bcf;
        conv_rows<0>(lds + (32 * th) * 1024 + ch2 * 2, wcf, acc);
        u32x4 rcx[8], rbg[8];
        { const bf16* pr = PROJ + ((size_t)b * SEQ + s0 + 8 * wave) * PDIM + 8 * lane;
#pragma unroll
          for (int q = 0; q < 8; ++q) { rcx[q] = *(const u32x4*)(pr + (size_t)q * PDIM); rbg[q] = *(const u32x4*)(pr + (size_t)q * PDIM + 512); } }
        __syncthreads();
#pragma unroll
        for (int ii = 0; ii < 32; ++ii) *(LAS f32x2*)(lds + (32 * th + ii) * 2048 + ch2 * 4) = acc[ii];
        __syncthreads();
        {
            float lng[8], lnb[8];
            { const f32x4 a = *(const f32x4*)(P.ln_g + 8 * lane), c = *(const f32x4*)(P.ln_g + 8 * lane + 4), d = *(const f32x4*)(P.ln_b + 8 * lane), e = *(const f32x4*)(P.ln_b + 8 * lane + 4);
              lng[0] = a.x; lng[1] = a.y; lng[2] = a.z; lng[3] = a.w; lng[4] = c.x; lng[5] = c.y; lng[6] = c.z; lng[7] = c.w;
              lnb[0] = d.x; lnb[1] = d.y; lnb[2] = d.z; lnb[3] = d.w; lnb[4] = e.x; lnb[5] = e.y; lnb[6] = e.z; lnb[7] = e.w; }
            float wsc[3][8];
#pragma unroll
            for (int j = 0; j < 3; ++j) { const f32x4 a = *(const f32x4*)(P.sc_w + j * 512 + 8 * lane), c = *(const f32x4*)(P.sc_w + j * 512 + 8 * lane + 4);
                wsc[j][0] = a.x; wsc[j][1] = a.y; wsc[j][2] = a.z; wsc[j][3] = a.w; wsc[j][4] = c.x; wsc[j][5] = c.y; wsc[j][6] = c.z; wsc[j][7] = c.w; }
            float cxa[8], cxb[8];
            { const int pos = NMETA + s0 + 8 * wave - 2;
              proj8_at(PROJ, MP, MR, b, pos, 8 * lane, cxa); proj8_at(PROJ, MP, MR, b, pos + 1, 8 * lane, cxb); }
#pragma unroll
            for (int q = 0; q < 8; ++q) {
                const int ii = 8 * wave + q, s = s0 + ii; const size_t t = (size_t)b * SEQ + s;
                float o[8];
                { const f32x4 a = *(const LAS f32x4*)(lds + ii * 2048 + lane * 32), c = *(const LAS f32x4*)(lds + ii * 2048 + lane * 32 + 16);
                  o[0] = a.x; o[1] = a.y; o[2] = a.z; o[3] = a.w; o[4] = c.x; o[5] = c.y; o[6] = c.z; o[7] = c.w; }
                float s1 = 0.f;
#pragma unroll
                for (int i = 0; i < 8; ++i) s1 += o[i];
                const float mean = wave_sum_fast(s1) * (1.f / 512.f);
                float s2 = 0.f;
#pragma unroll
                for (int i = 0; i < 8; ++i) { o[i] -= mean; s2 += o[i] * o[i]; }
                const float rs = rsqrtf(wave_sum_fast(s2) * (1.f / 512.f) + EPS);
                float s3 = 0.f;
#pragma unroll
                for (int i = 0; i < 8; ++i) { float y = o[i] * rs * lng[i] + lnb[i]; y = y * sigmoid_f(y); o[i] = y; s3 += y * y; }
                const float r2 = rsqrtf(wave_sum_fast(s3) * (1.f / 512.f) + EPS);
                float bgv[8], cxc[8], accs[8];
                { const u32x4 w = rcx[q], z = rbg[q];
                  cxc[0] = bflo(w.x); cxc[1] = bfhi(w.x); cxc[2] = bflo(w.y); cxc[3] = bfhi(w.y); cxc[4] = bflo(w.z); cxc[5] = bfhi(w.z); cxc[6] = bflo(w.w); cxc[7] = bfhi(w.w);
                  bgv[0] = bflo(z.x); bgv[1] = bfhi(z.x); bgv[2] = bflo(z.y); bgv[3] = bfhi(z.y); bgv[4] = bflo(z.z); bgv[5] = bfhi(z.z); bgv[6] = bflo(z.w); bgv[7] = bfhi(z.w); }
                float s4 = 0.f;
#pragma unroll
                for (int i = 0; i < 8; ++i) { accs[i] = bgv[i] * (wsc[0][i] * cxa[i] + wsc[1][i] * cxb[i] + wsc[2][i] * cxc[i]); s4 += accs[i] * accs[i]; cxa[i] = cxb[i]; cxb[i] = cxc[i]; }
                const float r4 = rsqrtf(wave_sum_fast(s4) * (1.f / 512.f) + EPS);
                float ym = 0.f;
#pragma unroll
                for (int i = 0; i < 8; ++i) { o[i] *= r2; accs[i] *= r4; ym = fmaxf(ym, fmaxf(fabsf(o[i]), fabsf(accs[i]))); }
                ym = fmaxf(wave_max_fast(ym), 1e-30f);
                const float yinv = 127.f / ym;
                if (lane == 0) ((float*)(ws + WS_SY))[t] = ym * (1.f / 127.f);
                u32x2 wz, wv;
                wz.x = ((unsigned)(int)rintf(accs[0] * yinv) & 255u) | (((unsigned)(int)rintf(accs[1] * yinv) & 255u) << 8) | (((unsigned)(int)rintf(accs[2] * yinv) & 255u) << 16) | ((unsigned)(int)rintf(accs[3] * yinv) << 24);
                wz.y = ((unsigned)(int)rintf(accs[4] * yinv) & 255u) | (((unsigned)(int)rintf(accs[5] * yinv) & 255u) << 8) | (((unsigned)(int)rintf(accs[6] * yinv) & 255u) << 16) | ((unsigned)(int)rintf(accs[7] * yinv) << 24);
                wv.x = ((unsigned)(int)rintf(o[0] * yinv) & 255u) | (((unsigned)(int)rintf(o[1] * yinv) & 255u) << 8) | (((unsigned)(int)rintf(o[2] * yinv) & 255u) << 16) | ((unsigned)(int)rintf(o[3] * yinv) << 24);
                wv.y = ((unsigned)(int)rintf(o[4] * yinv) & 255u) | (((unsigned)(int)rintf(o[5] * yinv) & 255u) << 8) | (((unsigned)(int)rintf(o[6] * yinv) & 255u) << 16) | ((unsigned)(int)rintf(o[7] * yinv) << 24);
                *(u32x2*)(ws + WS_Y + t * DM + 8 * lane) = wz;
                *(u32x2*)(ws + WS_Y + t * DM + 512 + 8 * lane) = wv;
            }
        }
        __syncthreads();
    }
}

__device__ __forceinline__ int ord_i(float s) { int k = __builtin_bit_cast(int, s); k ^= (k >> 31) & 0x7fffffff; return k; }
__device__ __forceinline__ float unord_f(int k) { k ^= (k >> 31) & 0x7fffffff; return __builtin_bit_cast(float, k); }
#define TOP_INSERT(L, x_) do { int _x = (x_); _Pragma("unroll") for (int _i = 0; _i < 16; ++_i) { const int _hi = max(L[_i], _x); _x = min(L[_i], _x); L[_i] = _hi; } } while (0)

typedef short bf16x8 __attribute__((ext_vector_type(8)));
typedef float f32x16 __attribute__((ext_vector_type(16)));
template <bool DESC> __device__ __forceinline__ void ce_i(int& a, int& b) { const int hi = max(a, b), lo = min(a, b); if (DESC) { a = hi; b = lo; } else { a = lo; b = hi; } }
__device__ __forceinline__ void bitonic_sort16(int (&a)[16]) {
#pragma unroll
    for (int k = 2; k <= 16; k <<= 1)
#pragma unroll
        for (int j = k >> 1; j > 0; j >>= 1)
#pragma unroll
            for (int i = 0; i < 16; ++i) { const int l = i ^ j; if (l > i) { if ((i & k) == 0) ce_i<true>(a[i], a[l]); else ce_i<false>(a[i], a[l]); } }
}
__device__ __forceinline__ void bitonic_merge16(int (&a)[16]) {
#pragma unroll
    for (int j = 8; j > 0; j >>= 1)
#pragma unroll
        for (int i = 0; i < 16; ++i) { const int l = i ^ j; if (l > i) ce_i<true>(a[i], a[l]); }
}
__device__ __forceinline__ void merge_top16(int (&a)[16], const int (&b)[16]) {
#pragma unroll
    for (int i = 0; i < 16; ++i) a[i] = max(a[i], b[15 - i]);
    bitonic_merge16(a);
}
__device__ __forceinline__ int lut16(const unsigned (&T)[4], int i) {
    const unsigned sel = (unsigned)(i & 7) | 0x0c0c0c00u;
    const unsigned lo = __builtin_amdgcn_perm(T[1], T[0], sel), hi = __builtin_amdgcn_perm(T[3], T[2], sel);
    return (int)((i & 8) ? hi : lo);
}
constexpr int KROW = 272;
constexpr float SCORE_BIAS = 8.0f;

__device__ __forceinline__ void route_load_q(bf16x8 (&qf)[8], const bf16* qrow, int hb) {
#pragma unroll
    for (int ks = 0; ks < 8; ++ks) qf[ks] = *(const bf16x8*)(qrow + 64 * hb + 8 * ks);
}
__device__ __forceinline__ void route_half(const LAS unsigned char* kl, const bf16x8 (&qf)[8], int nl, int hb, int (&L)[16]) {
    f32x16 acc[4];
#pragma unroll
    for (int nt = 0; nt < 4; ++nt)
#pragma unroll
        for (int r = 0; r < 16; ++r) acc[nt][r] = SCORE_BIAS;
#pragma unroll
    for (int ks = 0; ks < 8; ++ks)
#pragma unroll
        for (int nt = 0; nt < 4; ++nt) {
            const bf16x8 a = *(const LAS bf16x8*)(kl + (32 * nt + nl) * KROW + (64 * hb + 8 * ks) * 2);
            acc[nt] = __builtin_amdgcn_mfma_f32_32x32x16_bf16(a, qf[ks], acc[nt], 0, 0, 0);
        }
    const int hb4 = 4 * hb;
    int T[4][16];
#pragma unroll
    for (int nt = 0; nt < 4; ++nt)
#pragma unroll
        for (int r = 0; r < 16; ++r) { const int n0 = 32 * nt + (r & 3) + 8 * (r >> 2); const float sc = acc[nt][r];
            T[nt][r] = (__float_as_int(sc) & ~127) | ((127 - n0) - hb4); }
    bitonic_sort16(T[0]); bitonic_sort16(T[1]); bitonic_sort16(T[2]); bitonic_sort16(T[3]);
    merge_top16(T[0], T[1]); merge_top16(T[2], T[3]); merge_top16(T[0], T[2]);
#pragma unroll
    for (int i = 0; i < 16; ++i) { const unsigned v = (unsigned)T[0][15 - i]; auto r = __builtin_amdgcn_permlane32_swap(v, v, false, false);
        const unsigned r0 = r[0], r1 = r[1]; const int partner = (int)(hb ? r0 : r1); L[i] = max(T[0][i], partner); }
    bitonic_merge16(L);
}

__device__ __forceinline__ void phase_route(const Params& P, LAS unsigned char* lds) {
    const int tid = threadIdx.x, lane = tid & 63, wave = __builtin_amdgcn_readfirstlane(tid >> 6);
    const int nl = lane & 31, hb = lane >> 5;
    unsigned char* ws = P.ws;
    const bf16* KEYS = (const bf16*)(ws + WS_KEYS); const bf16* Q = (const bf16*)(ws + WS_Q);
    int* IDX = (int*)(ws + WS_IDX); float* GATE = (float*)(ws + WS_GATE);
    int last_h = -1;
    pg8::StaticOrder S; S.init(NTOK, 2048, (int)gridDim.x, (int)blockIdx.x);
    pg8::Unit ucur, unxt;
    bool have = S.next(0, ucur);
    bf16x8 qfA[8], qfB[8];
    if (have) route_load_q(qfA, Q + ((size_t)ucur.pm * 256 + wave * 32 + nl) * 2048 + ucur.pn * 256, hb);
    for (int ui = 0; have; ++ui) {
        const int h = ucur.pn, tb = ucur.pm;
        const bool have_next = S.next(ui + 1, unxt);
        if (h != last_h) {
            __syncthreads();
            for (int c = tid; c < 4096; c += NTHREADS) { const u32x4 v = ((const u32x4*)(KEYS + (size_t)h * 32768))[c];
                *(LAS u32x4*)(lds + (c >> 4) * KROW + (c & 15) * 16) = v; }
            __syncthreads();
            last_h = h;
        }
        const size_t t = (size_t)tb * 256 + wave * 32 + nl;
        int L1[16], L2[16];
        route_load_q(qfB, Q + t * 2048 + h * 256 + 128, hb);
        route_half(lds, qfA, nl, hb, L1);
        if (have_next) route_load_q(qfA, Q + ((size_t)unxt.pm * 256 + wave * 32 + nl) * 2048 + unxt.pn * 256, hb);
        route_half(lds + 128 * KROW, qfB, nl, hb, L2);
        float v1[16], v2[16];
#pragma unroll
        for (int i = 0; i < 16; ++i) { v1[i] = __int_as_float(L1[i] & ~127); v2[i] = __int_as_float(L2[i] & ~127); }
#define CAND(i, j) ((__float_as_int(v1[i] + v2[j]) & ~255) | (255 - (16 * (i) + (j))))
        int A[16], B[16], C[16];
#pragma unroll
        for (int j = 0; j < 16; ++j) A[j] = CAND(0, j);
#pragma unroll
        for (int j = 0; j < 8; ++j) { B[j] = CAND(1, j); B[8 + j] = CAND(15 - j, 0); }
        bitonic_merge16(B);
        C[0] = CAND(2, 0); C[1] = CAND(2, 1); C[2] = CAND(2, 2); C[3] = CAND(2, 3); C[4] = CAND(2, 4);
        C[5] = CAND(3, 0); C[6] = CAND(3, 1); C[7] = CAND(3, 2); C[8] = CAND(3, 3);
        C[9] = CAND(4, 0); C[10] = CAND(4, 1); C[11] = CAND(4, 2);
        C[12] = CAND(5, 0); C[13] = CAND(5, 1); C[14] = CAND(6, 0); C[15] = CAND(6, 1);
        bitonic_sort16(C);
        { const int d0 = CAND(7, 0), d1 = CAND(7, 1); C[14] = max(C[14], d1); C[15] = max(C[15], d0); bitonic_merge16(C); }
#undef CAND
        merge_top16(A, B); merge_top16(A, C);
        unsigned T1[4], T2[4];
#pragma unroll
        for (int q = 0; q < 4; ++q) {
            T1[q] = (unsigned)(127 - (L1[4 * q] & 127)) | ((unsigned)(127 - (L1[4 * q + 1] & 127)) << 8) | ((unsigned)(127 - (L1[4 * q + 2] & 127)) << 16) | ((unsigned)(127 - (L1[4 * q + 3] & 127)) << 24);
            T2[q] = (unsigned)(127 - (L2[4 * q] & 127)) | ((unsigned)(127 - (L2[4 * q + 1] & 127)) << 8) | ((unsigned)(127 - (L2[4 * q + 2] & 127)) << 16) | ((unsigned)(127 - (L2[4 * q + 3] & 127)) << 24); }
        float val[16]; int ex[16];
#pragma unroll
        for (int k = 0; k < 16; ++k) { const int pos = 255 - (A[k] & 255); val[k] = __int_as_float(A[k] & ~255);
            ex[k] = lut16(T1, pos >> 4) * NKEYS + lut16(T2, pos & 15); }
        float sum = 0.f; const float vmax = val[0];
#pragma unroll
        for (int k = 0; k < 16; ++k) { val[k] = __expf(val[k] - vmax); sum += val[k]; }
        const float inv = 1.f / sum;
        if (hb == 0) {
            int* ip = IDX + t * NSEL + h * TOPK; float* gp = GATE + t * NSEL + h * TOPK;
#pragma unroll
            for (int k4 = 0; k4 < 4; ++k4) {
                *(int4*)(ip + 4 * k4) = make_int4(ex[4 * k4], ex[4 * k4 + 1], ex[4 * k4 + 2], ex[4 * k4 + 3]);
                *(f32x4*)(gp + 4 * k4) = (f32x4){val[4 * k4] * inv, val[4 * k4 + 1] * inv, val[4 * k4 + 2] * inv, val[4 * k4 + 3] * inv};
            }
        }
        ucur = unxt; have = have_next;
    }
}

#define FP4X2(w, sel) __builtin_amdgcn_cvt_scalef32_pk_f32_fp4((w), 1.0f, (sel))
__device__ __forceinline__ float dot16_fp4(const u32x2 r, const f32x4 (&xs)[4]) {
    float p = 0.f;
    { const f32x2 a = FP4X2(r.x, 0), b = FP4X2(r.x, 1), c = FP4X2(r.x, 2), d = FP4X2(r.x, 3);
      p += (a.x * xs[0].x + a.y * xs[0].y) + (b.x * xs[0].z + b.y * xs[0].w); p += (c.x * xs[1].x + c.y * xs[1].y) + (d.x * xs[1].z + d.y * xs[1].w); }
    { const f32x2 a = FP4X2(r.y, 0), b = FP4X2(r.y, 1), c = FP4X2(r.y, 2), d = FP4X2(r.y, 3);
      p += (a.x * xs[2].x + a.y * xs[2].y) + (b.x * xs[2].z + b.y * xs[2].w); p += (c.x * xs[3].x + c.y * xs[3].y) + (d.x * xs[3].z + d.y * xs[3].w); }
    return p;
}
__device__ __forceinline__ void axpy16_fp4(const u32x2 r, float w, f32x4 (&o)[4]) {
    { const f32x2 a = FP4X2(r.x, 0), b = FP4X2(r.x, 1), c = FP4X2(r.x, 2), d = FP4X2(r.x, 3);
      o[0].x += w * a.x; o[0].y += w * a.y; o[0].z += w * b.x; o[0].w += w * b.y; o[1].x += w * c.x; o[1].y += w * c.y; o[1].z += w * d.x; o[1].w += w * d.y; }
    { const f32x2 a = FP4X2(r.y, 0), b = FP4X2(r.y, 1), c = FP4X2(r.y, 2), d = FP4X2(r.y, 3);
      o[2].x += w * a.x; o[2].y += w * a.y; o[2].z += w * b.x; o[2].w += w * b.y; o[3].x += w * c.x; o[3].y += w * c.y; o[3].z += w * d.x; o[3].w += w * d.y; }
}
__device__ __forceinline__ float swap32_add(float a, float b) { auto r = __builtin_amdgcn_permlane32_swap(__float_as_uint(a), __float_as_uint(b), false, false); return __uint_as_float(r[0]) + __uint_as_float(r[1]); }
__device__ __forceinline__ float swap16_add(float a, float b) { auto r = __builtin_amdgcn_permlane16_swap(__float_as_uint(a), __float_as_uint(b), false, false); return __uint_as_float(r[0]) + __uint_as_float(r[1]); }
__device__ __forceinline__ float row_sum16(float v) { v += dpp_f<0xB1>(v); v += dpp_f<0x4E>(v); v += dpp_f<0x141>(v); v += dpp_f<0x140>(v); return v; }
__device__ __forceinline__ float row_max16(float v) { v = fmaxf(v, dpp_f<0xB1>(v)); v = fmaxf(v, dpp_f<0x4E>(v)); v = fmaxf(v, dpp_f<0x141>(v)); v = fmaxf(v, dpp_f<0x140>(v)); return v; }
constexpr int GB = 32;
typedef __attribute__((address_space(8))) void* rsrc_t;
__device__ __forceinline__ void g_issue(u32x2 (&buf)[GB], __amdgpu_buffer_rsrc_t rs, int idxr, int lb, int voff) {
#pragma unroll
    for (int j = 0; j < GB; ++j) { const int e = __builtin_amdgcn_readlane(idxr, lb + j); buf[j] = __builtin_amdgcn_raw_buffer_load_b64(rs, voff, e * 512, 0); }
}
__device__ __forceinline__ float dot16_fp4p(const u32x2 r, const f32x2 (&xp)[8]) {
    f32x2 a = FP4X2(r.x, 0) * xp[0];
    a += FP4X2(r.x, 1) * xp[1]; a += FP4X2(r.x, 2) * xp[2]; a += FP4X2(r.x, 3) * xp[3];
    a += FP4X2(r.y, 0) * xp[4]; a += FP4X2(r.y, 1) * xp[5]; a += FP4X2(r.y, 2) * xp[6]; a += FP4X2(r.y, 3) * xp[7];
    return a.x + a.y;
}
__device__ __forceinline__ void axpy16_fp4p(const u32x2 r, float w, f32x2 (&o)[8]) {
    const f32x2 ww = (f32x2){w, w};
    o[0] += FP4X2(r.x, 0) * ww; o[1] += FP4X2(r.x, 1) * ww; o[2] += FP4X2(r.x, 2) * ww; o[3] += FP4X2(r.x, 3) * ww;
    o[4] += FP4X2(r.y, 0) * ww; o[5] += FP4X2(r.y, 1) * ww; o[6] += FP4X2(r.y, 2) * ww; o[7] += FP4X2(r.y, 3) * ww;
}
template <int H> __device__ __forceinline__ void g_compute_u(const u32x2 (&buf)[GB], int q, int i16, const f32x2 (&xp)[8], float& zlo, float& zhi) {
    float p[16];
#pragma unroll
    for (int j = 0; j < 16; ++j) p[j] = dot16_fp4p(buf[16 * H + j], xp);
    float s1[8], s2[4];
#pragma unroll
    for (int m = 0; m < 8; ++m) s1[m] = swap32_add(p[2 * m], p[2 * m + 1]);
#pragma unroll
    for (int n = 0; n < 4; ++n) s2[n] = swap16_add(s1[2 * n], s1[2 * n + 1]);
#pragma unroll
    for (int r = 0; r < 4; ++r) { const float z = row_sum16(s2[r]); const bool mine = i16 == ((4 * q + r) & 15);
        zlo = (mine && q < 4) ? z : zlo; zhi = (mine && q >= 4) ? z : zhi; }
}
template <int H> __device__ __forceinline__ void g_compute_v(const u32x2 (&buf)[GB], int q, float alo, float ahi, f32x2 (&o)[8]) {
    const int areg = __builtin_bit_cast(int, (q < 4) ? alo : ahi), sb = 4 * (q & 3);
#pragma unroll
    for (int j = 0; j < 16; ++j) { const int src = 32 * (j & 1) + 16 * ((j >> 1) & 1) + (j >> 2) + sb;
        const float w = __builtin_bit_cast(float, __builtin_amdgcn_readlane(areg, src));
        axpy16_fp4p(buf[16 * H + j], w, o); }
}
__device__ __forceinline__ void q_issue(u32x2 (&buf)[16], __amdgpu_buffer_rsrc_t rs, int ixr  , int lb, int voff) {
#pragma unroll
    for (int j = 0; j < 16; ++j) { const int e9 = __builtin_amdgcn_readlane(ixr, lb + j); buf[j] = __builtin_amdgcn_raw_buffer_load_b64(rs, voff, e9, 0); }
}
__device__ __forceinline__ void q_compute_u(const u32x2 (&buf)[16], int q, int i16, const f32x2 (&xp)[8], float& zlo, float& zhi) {
    float p[16];
#pragma unroll
    for (int j = 0; j < 16; ++j) p[j] = dot16_fp4p(buf[j], xp);
    float s1[8], s2[4];
#pragma unroll
    for (int m = 0; m < 8; ++m) s1[m] = swap32_add(p[2 * m], p[2 * m + 1]);
#pragma unroll
    for (int n = 0; n < 4; ++n) s2[n] = swap16_add(s1[2 * n], s1[2 * n + 1]);
#pragma unroll
    for (int r = 0; r < 4; ++r) { const float z = row_sum16(s2[r]); const bool mine = i16 == ((4 * q + r) & 15);
        zlo = (mine && q < 4) ? z : zlo; zhi = (mine && q >= 4) ? z : zhi; }
}
typedef _Float16 h16x2 __attribute__((ext_vector_type(2)));
#define FP4H2(w, sel) __builtin_amdgcn_cvt_scalef32_pk_f16_fp4((w), 1.0f, (sel))
__device__ __forceinline__ void axpy16_fp4h(const u32x2 r, const h16x2 ww, h16x2 (&o)[8]) {
    o[0] += FP4H2(r.x, 0) * ww; o[1] += FP4H2(r.x, 1) * ww; o[2] += FP4H2(r.x, 2) * ww; o[3] += FP4H2(r.x, 3) * ww;
    o[4] += FP4H2(r.y, 0) * ww; o[5] += FP4H2(r.y, 1) * ww; o[6] += FP4H2(r.y, 2) * ww; o[7] += FP4H2(r.y, 3) * ww;
}
__device__ __forceinline__ void q_compute_vh(const u32x2 (&buf)[16], int q, int alo, int ahi, h16x2 (&o)[8]) {
    const int areg = (q < 4) ? alo : ahi, sb = 4 * (q & 3);
#pragma unroll
    for (int j = 0; j < 16; ++j) { const int src = 32 * (j & 1) + 16 * ((j >> 1) & 1) + (j >> 2) + sb;
        const h16x2 w = __builtin_bit_cast(h16x2, __builtin_amdgcn_readlane(areg, src));
        axpy16_fp4h(buf[j], w, o); }
}
__device__ __forceinline__ void q_compute_v(const u32x2 (&buf)[16], int q, float alo, float ahi, f32x2 (&o)[8]) {
    const int areg = __builtin_bit_cast(int, (q < 4) ? alo : ahi), sb = 4 * (q & 3);
#pragma unroll
    for (int j = 0; j < 16; ++j) { const int src = 32 * (j & 1) + 16 * ((j >> 1) & 1) + (j >> 2) + sb;
        const float w = __builtin_bit_cast(float, __builtin_amdgcn_readlane(areg, src));
        axpy16_fp4p(buf[j], w, o); }
}
__device__ __forceinline__ int swap32_addi(int a, int b) { auto r = __builtin_amdgcn_permlane32_swap((unsigned)a, (unsigned)b, false, false); const unsigned r0 = r[0], r1 = r[1]; return (int)(r0 + r1); }
__device__ __forceinline__ int swap16_addi(int a, int b) { auto r = __builtin_amdgcn_permlane16_swap((unsigned)a, (unsigned)b, false, false); const unsigned r0 = r[0], r1 = r[1]; return (int)(r0 + r1); }
template <int CTRL> __device__ __forceinline__ int dpp_i(int v) { return __builtin_amdgcn_update_dpp(0, v, CTRL, 0xf, 0xf, true); }
__device__ __forceinline__ int row_sum16i(int v) { v += dpp_i<0xB1>(v); v += dpp_i<0x4E>(v); v += dpp_i<0x141>(v); v += dpp_i<0x140>(v); return v; }
__device__ __forceinline__ void q_compute_ui(const u32x2 (&buf)[16], int q, int i16, int xh0, int xh1, int xl0, int xl1, int& zlo, int& zhi) {
    int p[16];
#pragma unroll
    for (int j = 0; j < 16; ++j) { const int d1 = __builtin_amdgcn_sdot8((int)buf[j].x, xh0, __builtin_amdgcn_sdot8((int)buf[j].y, xh1, 0, false), false);
        const int d2 = __builtin_amdgcn_sdot8((int)buf[j].x, xl0, __builtin_amdgcn_sdot8((int)buf[j].y, xl1, 0, false), false);
        p[j] = (d1 << 4) + d2; }
    int s1[8], s2[4];
#pragma unroll
    for (int m = 0; m < 8; ++m) s1[m] = swap32_addi(p[2 * m], p[2 * m + 1]);
#pragma unroll
    for (int n = 0; n < 4; ++n) s2[n] = swap16_addi(s1[2 * n], s1[2 * n + 1]);
#pragma unroll
    for (int r = 0; r < 4; ++r) { const int z = row_sum16i(s2[r]); const bool mine = i16 == ((4 * q + r) & 15);
        zlo = (mine && q < 4) ? z : zlo; zhi = (mine && q >= 4) ? z : zhi; }
}
__device__ __forceinline__ void phase_gather_u(const Params& P) {
    const int tid = threadIdx.x, lane = tid & 63, wave = __builtin_amdgcn_readfirstlane(tid >> 6);
    const int gw = blockIdx.x * NWAVES + wave, NGW = gridDim.x * NWAVES;
    unsigned char* ws = P.ws;
    const int* IDX = (const int*)(ws + WS_IDX); const float* GATE = (const float*)(ws + WS_GATE); const float* ESC = (const float*)(ws + WS_ESCALE); float* AW = (float*)(ws + WS_AW);
    const __amdgpu_buffer_rsrc_t rsU = __builtin_amdgcn_make_buffer_rsrc((void*)(ws + WS_U8), 0, 16384 * 512, 0x00020000);
    const unsigned char* H2I = ws + WS_H0I8; const float* RF = (const float*)(ws + WS_RF);
    const int hh = lane >> 5, rr = (lane >> 4) & 1, i16 = lane & 15, gsel = 4 * i16 + 2 * rr + hh;
    const int voff = 8 * lane;
    const unsigned ul = (unsigned)lane;
    int t = gw;
    if (t < NTOK) {
        int idx0, idx1; unsigned hraw[4]; float sqv;
        { const int* ip = IDX + (size_t)t * NSEL; idx0 = ip[ul]; idx1 = ip[64u + ul];
          const unsigned* hp = (const unsigned*)(H2I + (size_t)t * DM);
#pragma unroll
          for (int j = 0; j < 4; ++j) hraw[j] = hp[64u * j + ul];
          sqv = RF[t]; }
        u32x2 R0[16], R1[16], R2[16], R3[16];
        { const int ix0 = idx0 << 9; q_issue(R0, rsU, ix0, 0, voff); q_issue(R1, rsU, ix0, 16, voff); q_issue(R2, rsU, ix0, 32, voff); }
        for (;;) {
            const int tn = t + NGW; const bool has_next = tn < NTOK; const int tl = has_next ? tn : t;
            int idx0n, idx1n; unsigned hrawn[4]; float sqn, g0, g1;
            { const int* ip = IDX + (size_t)tl * NSEL; idx0n = ip[ul]; idx1n = ip[64u + ul];
              const unsigned* hp = (const unsigned*)(H2I + (size_t)tl * DM);
#pragma unroll
              for (int j = 0; j < 4; ++j) hrawn[j] = hp[64u * j + ul];
              sqn = RF[tl];
              const float* gp = GATE + (size_t)t * NSEL; g0 = gp[ul]; g1 = gp[64u + ul]; }
            const float su0 = ESC[idx0], su1 = ESC[idx1], sv0 = ESC[16384 + idx0], sv1 = ESC[16384 + idx1];
            const float cq0 = ((const float*)(ws + WS_SUMQ))[idx0], cq1 = ((const float*)(ws + WS_SUMQ))[idx1];
            unsigned xh[2] = {0u, 0u}, xl[2] = {0u, 0u};
#pragma unroll
            for (int j = 0; j < 4; ++j) {
                const unsigned lo4 = hraw[j] & 0x0f0f0f0fu, hi4 = (hraw[j] >> 4) & 0x0f0f0f0fu;
                const unsigned tl4 = (lo4 | (lo4 >> 4)) & 0x00ff00ffu, th4 = (hi4 | (hi4 >> 4)) & 0x00ff00ffu;
                const unsigned pl = ((tl4 | (tl4 >> 8)) & 0xffffu) ^ 0x8888u, ph = (th4 | (th4 >> 8)) & 0xffffu;
                xl[j >> 1] |= pl << (16 * (j & 1)); xh[j >> 1] |= ph << (16 * (j & 1)); }
            int zlo = 0, zhi = 0;
            const int ix0 = idx0 << 9, ix1 = idx1 << 9;
#pragma unroll 1
            for (int qq = 0; qq < 8; qq += 4) {
                const int ixn = qq ? (idx0n << 9) : ix1;
                q_issue(R3, rsU, qq ? ix1 : ix0, 48, voff);
                q_compute_ui(R0, qq, i16, (int)xh[0], (int)xh[1], (int)xl[0], (int)xl[1], zlo, zhi);
                q_issue(R0, rsU, ixn, 0, voff);
                q_compute_ui(R1, qq + 1, i16, (int)xh[0], (int)xh[1], (int)xl[0], (int)xl[1], zlo, zhi);
                q_issue(R1, rsU, ixn, 16, voff);
                q_compute_ui(R2, qq + 2, i16, (int)xh[0], (int)xh[1], (int)xl[0], (int)xl[1], zlo, zhi);
                q_issue(R2, rsU, ixn, 32, voff);
                q_compute_ui(R3, qq + 3, i16, (int)xh[0], (int)xh[1], (int)xl[0], (int)xl[1], zlo, zhi);
            }
            const float glo = __shfl(g0, gsel), ghi = __shfl(g1, gsel), sulo = __shfl(su0, gsel), suhi = __shfl(su1, gsel), svlo = __shfl(sv0, gsel), svhi = __shfl(sv1, gsel);
            const float cqlo = __shfl(cq0, gsel), cqhi = __shfl(cq1, gsel);
            const float zfl = ((float)zlo + 8.f * cqlo) * (sulo * sqv), zfh = ((float)zhi + 8.f * cqhi) * (suhi * sqv);
            const float wl = gelu_tanh_f(zfl) * glo * svlo, wh = gelu_tanh_f(zfh) * ghi * svhi;
            const float wmx = fmaxf(wave_max_fast(fmaxf(fabsf(wl), fabsf(wh))), 1e-30f), wsc = 256.f / wmx;
            { const float a = wl * wsc, c = wh * wsc;
              const int ah = __builtin_amdgcn_cvt_pk_fp8_f32(a, a, 0, false) & 255, ch = __builtin_amdgcn_cvt_pk_fp8_f32(c, c, 0, false) & 255;
              const float ar = a - __builtin_amdgcn_cvt_f32_fp8(ah, 0), cr = c - __builtin_amdgcn_cvt_f32_fp8(ch, 0);
              const int al = __builtin_amdgcn_cvt_pk_fp8_f32(ar, ar, 0, false) & 255, cl = __builtin_amdgcn_cvt_pk_fp8_f32(cr, cr, 0, false) & 255;
              unsigned char* ap = (unsigned char*)AW + (size_t)t * 256;
              ap[gsel] = (unsigned char)ah; ap[64 + gsel] = (unsigned char)ch; ap[128 + gsel] = (unsigned char)al; ap[192 + gsel] = (unsigned char)cl;
              if (lane == 0) ((float*)(ws + WS_WMX))[t] = wmx * (1.f / 256.f); }
            if (!has_next) break;
            t = tn; idx0 = idx0n; idx1 = idx1n; sqv = sqn;
#pragma unroll
            for (int j = 0; j < 4; ++j) hraw[j] = hrawn[j];
        }
    }
}
__device__ __forceinline__ void phase_gather_v(const Params& P) {
    const int tid = threadIdx.x, lane = tid & 63, wave = __builtin_amdgcn_readfirstlane(tid >> 6);
    const int gw = blockIdx.x * NWAVES + wave, NGW = gridDim.x * NWAVES;
    unsigned char* ws = P.ws;
    const int* IDX = (const int*)(ws + WS_IDX); const float* AW = (const float*)(ws + WS_AW);
    const __amdgpu_buffer_rsrc_t rsV = __builtin_amdgcn_make_buffer_rsrc((void*)(ws + WS_V8), 0, 16384 * 512, 0x00020000);
    const bf16* H2B = (const bf16*)(ws + WS_H2B);
    const int voff = 8 * lane;
    const unsigned ul = (unsigned)lane;
    int t = gw;
    if (t < NTOK) {
        int idx0, idx1; u32x2 hraw[4]; float alo, ahi;
        { const int* ip = IDX + (size_t)t * NSEL; idx0 = ip[ul]; idx1 = ip[64u + ul];
          const u32x2* hp = (const u32x2*)(H2B + (size_t)t * DM);
#pragma unroll
          for (int j = 0; j < 4; ++j) hraw[j] = hp[64u * j + ul];
          const float* ap = AW + (size_t)t * NSEL; alo = ap[ul]; ahi = ap[64u + ul]; }
        u32x2 R0[16], R1[16], R2[16], R3[16];
        { const int ix0 = idx0 << 9; q_issue(R0, rsV, ix0, 0, voff); q_issue(R1, rsV, ix0, 16, voff); q_issue(R2, rsV, ix0, 32, voff); }
        for (;;) {
            const int tn = t + NGW; const bool has_next = tn < NTOK; const int tl = has_next ? tn : t;
            int idx0n, idx1n; u32x2 hrawn[4]; float alon, ahin;
            { const int* ip = IDX + (size_t)tl * NSEL; idx0n = ip[ul]; idx1n = ip[64u + ul];
              const u32x2* hp = (const u32x2*)(H2B + (size_t)tl * DM);
#pragma unroll
              for (int j = 0; j < 4; ++j) hrawn[j] = hp[64u * j + ul];
              const float* ap = AW + (size_t)tl * NSEL; alon = ap[ul]; ahin = ap[64u + ul]; }
            const float wmx = fmaxf(wave_max_fast(fmaxf(fabsf(alo), fabsf(ahi))), 1e-30f), winv = 1.f / wmx;
            int alh, ahh;
            { const h16x2 a = (h16x2){(_Float16)(alo * winv), (_Float16)(alo * winv)}, b = (h16x2){(_Float16)(ahi * winv), (_Float16)(ahi * winv)};
              alh = __builtin_bit_cast(int, a); ahh = __builtin_bit_cast(int, b); }
            h16x2 oh[8];
#pragma unroll
            for (int j = 0; j < 8; ++j) oh[j] = (h16x2){(_Float16)0.f, (_Float16)0.f};
            const int ix0 = idx0 << 9, ix1 = idx1 << 9;
#pragma unroll 1
            for (int qq = 0; qq < 8; qq += 4) {
                const int ixn = qq ? (idx0n << 9) : ix1;
                q_issue(R3, rsV, qq ? ix1 : ix0, 48, voff);
                q_compute_vh(R0, qq, alh, ahh, oh);
                q_issue(R0, rsV, ixn, 0, voff);
                q_compute_vh(R1, qq + 1, alh, ahh, oh);
                q_issue(R1, rsV, ixn, 16, voff);
                q_compute_vh(R2, qq + 2, alh, ahh, oh);
                q_issue(R2, rsV, ixn, 32, voff);
                q_compute_vh(R3, qq + 3, alh, ahh, oh);
            }
            f32x2 o[8];
#pragma unroll
            for (int j = 0; j < 8; ++j) o[j] = (f32x2){(float)oh[j].x * wmx, (float)oh[j].y * wmx};
            float ss = 0.f;
#pragma unroll
            for (int j = 0; j < 4; ++j) { o[2 * j] += (f32x2){bflo(hraw[j].x), bfhi(hraw[j].x)}; o[2 * j + 1] += (f32x2){bflo(hraw[j].y), bfhi(hraw[j].y)}; }
#pragma unroll
            for (int j = 0; j < 8; ++j) ss += o[j].x * o[j].x + o[j].y * o[j].y;
            ss = wave_sum_fast(ss);
            const float r3 = rsqrtf(ss * (1.f / DM) + EPS);
            f32x4* op = (f32x4*)(P.out + (size_t)t * DM);
            const f32x4* gfp = (const f32x4*)P.g_fin;
#pragma unroll
            for (int j = 0; j < 4; ++j) { const f32x4 gv = gfp[64u * j + ul]; op[64u * j + ul] = (f32x4){o[2 * j].x * r3 * gv.x, o[2 * j].y * r3 * gv.y, o[2 * j + 1].x * r3 * gv.z, o[2 * j + 1].y * r3 * gv.w}; }
            if (!has_next) break;
            t = tn; idx0 = idx0n; idx1 = idx1n; alo = alon; ahi = ahin;
#pragma unroll
            for (int j = 0; j < 4; ++j) hraw[j] = hrawn[j];
        }
    }
}


typedef int i32x2v __attribute__((ext_vector_type(2)));
typedef int i32x8v __attribute__((ext_vector_type(8)));
#define VM_X 9
#define VM_WAIT(n) asm volatile("s_waitcnt vmcnt(" #n ")" ::: "memory")
__device__ __forceinline__ void phase_gather_v_mfma(const Params& P, LAS unsigned char* lds) {
    const int tid = threadIdx.x, lane = tid & 63, wave = __builtin_amdgcn_readfirstlane(tid >> 6);
    unsigned char* ws = P.ws;
    const int* IDX = (const int*)(ws + WS_IDX);
    const unsigned char* V8 = ws + WS_V8; const unsigned char* AW8 = ws + WS_AW; const float* WMX = (const float*)(ws + WS_WMX);
    const unsigned short* H2S = (const unsigned short*)(ws + WS_H2B);
    const int TPB = NTOK / (int)gridDim.x, t0 = blockIdx.x * TPB, NST = TPB * 4;
    const int r0 = 16 * wave + (lane >> 3), r1 = r0 + 8;
    const unsigned c0 = 16u * (unsigned)((lane & 7) ^ ((r0 >> 1) & 7)), c1 = 16u * (unsigned)((lane & 7) ^ ((r1 >> 1) & 7));
    const int i16 = lane & 15, kb = lane >> 4;
    const int ra = 32 * kb + i16, rb = ra + 16;
    const unsigned offa = (unsigned)(ra * 128 + 16 * (wave ^ ((ra >> 1) & 7))), offb = (unsigned)(rb * 128 + 16 * (wave ^ ((rb >> 1) & 7)));
    const unsigned aoffb = (unsigned)(((i16 & 1) ? 128 : 0) + 16 * kb);
    const bool arow = (i16 & 3) < 2;
    const int colb = 256 * kb + 32 * wave + i16;
    LAS float* SS = (LAS float*)(lds + 131072 + 1024);
    LAS float* OUTB = (LAS float*)(lds + 131072 + 2048);
    const f32x4 gfv = *(const f32x4*)(P.g_fin + 256 * (wave & 3) + 4 * lane);
    const unsigned lbase = (unsigned)(unsigned long long)lds;
    struct VTok { u32x4 a, b; float w; unsigned h0, h1; };
    VTok C0, C1;
    int ia1, ib1, ia2, ib2, ia3, ib3;
#define VM_ISSUE(g, e0, e1) do { LAS unsigned char* _d = lds + (((g) & 7) * 16384) + wave * 2048; const unsigned _cb = 128u * (unsigned)((g) & 3); \
        __builtin_amdgcn_global_load_lds((const unsigned*)(V8 + (size_t)(e0) * 512 + _cb + c0), (LAS unsigned*)(_d), 16, 0, 0); \
        __builtin_amdgcn_global_load_lds((const unsigned*)(V8 + (size_t)(e1) * 512 + _cb + c1), (LAS unsigned*)(_d + 1024), 16, 0, 0); } while (0)
    {
        const int ia0 = IDX[(size_t)t0 * NSEL + r0], ib0 = IDX[(size_t)t0 * NSEL + r1];
        ia1 = IDX[(size_t)(t0 + 1) * NSEL + r0]; ib1 = IDX[(size_t)(t0 + 1) * NSEL + r1];
        ia2 = IDX[(size_t)(t0 + 2) * NSEL + r0]; ib2 = IDX[(size_t)(t0 + 2) * NSEL + r1];
        ia3 = IDX[(size_t)(t0 + 3) * NSEL + r0]; ib3 = IDX[(size_t)(t0 + 3) * NSEL + r1];
        const unsigned char* ap = AW8 + (size_t)t0 * 256 + aoffb;
        C0.a = *(const u32x4*)ap; C0.b = *(const u32x4*)(ap + 64); C0.w = WMX[t0]; C0.h0 = H2S[(size_t)t0 * DM + colb]; C0.h1 = H2S[(size_t)t0 * DM + colb + 16];
        C1.a = *(const u32x4*)(ap + 256); C1.b = *(const u32x4*)(ap + 256 + 64); C1.w = WMX[t0 + 1]; C1.h0 = H2S[(size_t)(t0 + 1) * DM + colb]; C1.h1 = H2S[(size_t)(t0 + 1) * DM + colb + 16];
        asm volatile("s_waitcnt vmcnt(0)" ::: "memory");
        VM_ISSUE(0, ia0, ib0); VM_ISSUE(1, ia0, ib0); VM_ISSUE(2, ia0, ib0); VM_ISSUE(3, ia0, ib0);
        VM_ISSUE(4, ia1, ib1); VM_ISSUE(5, ia1, ib1); VM_ISSUE(6, ia1, ib1);
    }
    float pv0 = 0.f, pv1 = 0.f;
    VTok N0, N1; int na4, nb4, na5, nb5;
    auto token = [&](const int i, const bool even, const VTok& C, const int e1a, const int e1b, const int e2a, const int e2b) __attribute__((always_inline)) {
        const int t = t0 + i;
        const u32x4 z = (u32x4){0u, 0u, 0u, 0u}; const u32x4 Alo = arow ? C.a : z, Ahi = arow ? C.b : z;
        const i32x8v A = (i32x8v){(int)Alo.x, (int)Alo.y, (int)Alo.z, (int)Alo.w, (int)Ahi.x, (int)Ahi.y, (int)Ahi.z, (int)Ahi.w};
        f32x4 acc[4][2];
#pragma unroll
        for (int cc = 0; cc < 4; ++cc) {
            const int g = 4 * i + cc;
            if (even && cc == 0) { VM_WAIT(12); } else { VM_WAIT(26); }
            asm volatile("s_waitcnt lgkmcnt(0)" ::: "memory");
            __builtin_amdgcn_s_barrier();
            __builtin_amdgcn_sched_barrier(0);
            const unsigned sa = lbase + (unsigned)((g & 7) * 16384) + offa, sbb = lbase + (unsigned)((g & 7) * 16384) + offb;
            i32x2v b00, b01, b10, b11;
            asm volatile("ds_read_b64_tr_b4 %0, %4\n\tds_read_b64_tr_b4 %1, %5\n\tds_read_b64_tr_b4 %2, %4 offset:8\n\tds_read_b64_tr_b4 %3, %5 offset:8"
                         : "=&v"(b00), "=&v"(b01), "=&v"(b10), "=&v"(b11) : "v"(sa), "v"(sbb) : "memory");
            { const int gn = g + 7;
              if (cc == 0) VM_ISSUE(gn, e1a, e1b); else VM_ISSUE(gn, e2a, e2b); }
            __builtin_amdgcn_sched_barrier(0);
            if (cc == 0) {
                if (even) {
                    const int tA = t0 + ((i + 2 < TPB) ? i + 2 : TPB - 2), tI = t0 + ((i + 4 < TPB) ? i + 4 : TPB - 2);
                    const unsigned char* ap = AW8 + (size_t)tA * 256 + aoffb; const float* wp = WMX + tA; const int* ipa = IDX + (size_t)tI * NSEL + r0; const unsigned short* hp = H2S + (size_t)tA * DM + colb;
                    asm volatile("global_load_dwordx4 %0, %14, off\n\tglobal_load_dwordx4 %1, %14, off offset:64\n\tglobal_load_dwordx4 %2, %14, off offset:256\n\tglobal_load_dwordx4 %3, %14, off offset:320\n\t"
                                 "global_load_dword %4, %15, off\n\tglobal_load_dword %5, %15, off offset:4\n\t"
                                 "global_load_ushort %6, %17, off\n\tglobal_load_ushort %7, %17, off offset:32\n\tglobal_load_ushort %8, %17, off offset:2048\n\tglobal_load_ushort %9, %17, off offset:2080\n\t"
                                 "global_load_dword %10, %16, off\n\tglobal_load_dword %11, %16, off offset:32\n\tglobal_load_dword %12, %16, off offset:512\n\tglobal_load_dword %13, %16, off offset:544"
                                 : "=&v"(N0.a), "=&v"(N0.b), "=&v"(N1.a), "=&v"(N1.b), "=&v"(N0.w), "=&v"(N1.w), "=&v"(N0.h0), "=&v"(N0.h1), "=&v"(N1.h0), "=&v"(N1.h1), "=&v"(na4), "=&v"(nb4), "=&v"(na5), "=&v"(nb5)
                                 : "v"(ap), "v"(wp), "v"(ipa), "v"(hp) : "memory");
                }
                { const f32x4 s0 = *(const LAS f32x4*)(SS + 8 * ((i + 1) & 1)), s1 = *(const LAS f32x4*)(SS + 8 * ((i + 1) & 1) + 4);
                  const float ss = ((s0.x + s0.y) + (s0.z + s0.w)) + ((s1.x + s1.y) + (s1.z + s1.w));
                  const float r3 = rsqrtf(ss * (1.f / DM) + EPS);
                  if ((wave >> 2) == ((i + 1) & 1)) {
                      const f32x4 v = *(const LAS f32x4*)(OUTB + 1024 * ((i + 1) & 1) + 256 * (wave & 3) + 4 * lane);
                      *(f32x4*)(P.out + (size_t)((i > 0) ? t - 1 : t) * DM + 256 * (wave & 3) + 4 * lane) = (f32x4){v.x * r3 * gfv.x, v.y * r3 * gfv.y, v.z * r3 * gfv.z, v.w * r3 * gfv.w}; } }
                __builtin_amdgcn_sched_barrier(0);
            }
            asm volatile("s_waitcnt lgkmcnt(0)" : "+v"(b00), "+v"(b01), "+v"(b10), "+v"(b11) :: "memory");
            const i32x8v B0 = (i32x8v){b00.x, b00.y, b01.x, b01.y, 0, 0, 0, 0}, B1 = (i32x8v){b10.x, b10.y, b11.x, b11.y, 0, 0, 0, 0};
            const f32x4 z4 = (f32x4){0.f, 0.f, 0.f, 0.f};
            acc[cc][0] = __builtin_amdgcn_mfma_scale_f32_16x16x128_f8f6f4(A, B0, z4, 0  , 4  , 0, 0x7f7f7f7f, 0, 0x7f7f7f7f);
            acc[cc][1] = __builtin_amdgcn_mfma_scale_f32_16x16x128_f8f6f4(A, B1, z4, 0, 4, 0, 0x7f7f7f7f, 0, 0x7f7f7f7f);
        }
#pragma unroll
        for (int c = 0; c < 4; ++c) asm volatile("" :: "v"(acc[c][0]), "v"(acc[c][1]));
        float s0 = acc[0][0].x + acc[0][0].y, s1 = acc[0][1].x + acc[0][1].y;
        { const float a0 = acc[1][0].x + acc[1][0].y, a1 = acc[1][1].x + acc[1][1].y, b0 = acc[2][0].x + acc[2][0].y, b1 = acc[2][1].x + acc[2][1].y, d0 = acc[3][0].x + acc[3][0].y, d1 = acc[3][1].x + acc[3][1].y;
          s0 = (kb == 1) ? a0 : s0; s1 = (kb == 1) ? a1 : s1; s0 = (kb == 2) ? b0 : s0; s1 = (kb == 2) ? b1 : s1; s0 = (kb == 3) ? d0 : s0; s1 = (kb == 3) ? d1 : s1; }
        pv0 = s0 * C.w + __uint_as_float(C.h0 << 16); pv1 = s1 * C.w + __uint_as_float(C.h1 << 16);
        OUTB[1024 * (i & 1) + colb] = pv0; OUTB[1024 * (i & 1) + colb + 16] = pv1;
        const float sq = wave_sum_fast(pv0 * pv0 + pv1 * pv1);
        if (lane == 0) SS[8 * (i & 1) + wave] = sq;
    };
#pragma unroll 1
    for (int i = 0; i < TPB; i += 2) {
        token(i, true, C0, ia1, ib1, ia2, ib2);
        token(i + 1, false, C1, ia2, ib2, ia3, ib3);
        asm volatile("s_waitcnt vmcnt(14)" : "+v"(N0.a), "+v"(N0.b), "+v"(N1.a), "+v"(N1.b), "+v"(N0.w), "+v"(N1.w), "+v"(N0.h0), "+v"(N0.h1), "+v"(N1.h0), "+v"(N1.h1), "+v"(na4), "+v"(nb4), "+v"(na5), "+v"(nb5) :: "memory");
        C0 = N0; C1 = N1; ia1 = ia3; ib1 = ib3; ia2 = na4; ib2 = nb4; ia3 = na5; ib3 = nb5;
    }
    asm volatile("s_waitcnt vmcnt(0)" ::: "memory");
    __builtin_amdgcn_s_barrier();
    { const int i = TPB; const f32x4 s0 = *(const LAS f32x4*)(SS + 8 * ((i + 1) & 1)), s1 = *(const LAS f32x4*)(SS + 8 * ((i + 1) & 1) + 4);
      const float ss = ((s0.x + s0.y) + (s0.z + s0.w)) + ((s1.x + s1.y) + (s1.z + s1.w));
      const float r3 = rsqrtf(ss * (1.f / DM) + EPS);
      if ((wave >> 2) == ((i + 1) & 1)) {
          const f32x4 v = *(const LAS f32x4*)(OUTB + 1024 * ((i + 1) & 1) + 256 * (wave & 3) + 4 * lane);
          *(f32x4*)(P.out + (size_t)(t0 + TPB - 1) * DM + 256 * (wave & 3) + 4 * lane) = (f32x4){v.x * r3 * gfv.x, v.y * r3 * gfv.y, v.z * r3 * gfv.z, v.w * r3 * gfv.w}; } }
#undef VM_ISSUE
}

__device__ __forceinline__ void phase_quant_h2(const Params& P) {
    const int tid = threadIdx.x, lane = tid & 63, wave = __builtin_amdgcn_readfirstlane(tid >> 6);
    const int gw = blockIdx.x * NWAVES + wave, NGW = gridDim.x * NWAVES;
    unsigned char* ws = P.ws;
    const float* SSQ = (const float*)(ws + WS_SSQ); const float* AMX = (const float*)(ws + WS_AMX); float* RF = (float*)(ws + WS_RF);
    for (int row = gw; row < NTOK; row += NGW) {
        const u32x4* hp = (const u32x4*)(ws + WS_H2B + (size_t)row * DM * 2) + 2 * lane;
        const u32x4 a = hp[0], b = hp[1];
        const float am = fmaxf(row_max16(AMX[(size_t)row * 16 + (lane & 15)]), 1e-30f) * 1.0078125f;
        const float rstd2 = rsqrtf(row_sum16(SSQ[(size_t)row * 16 + (lane & 15)]) * (1.f / DM) + EPS);
        const float inv = 127.f / am;
        const unsigned w[8] = {a.x, a.y, a.z, a.w, b.x, b.y, b.z, b.w};
        unsigned o[4];
#pragma unroll
        for (int j = 0; j < 4; ++j) {
            const int q0 = (int)rintf(__uint_as_float(w[2 * j] << 16) * inv), q1 = (int)rintf(__uint_as_float(w[2 * j] & 0xffff0000u) * inv);
            const int q2 = (int)rintf(__uint_as_float(w[2 * j + 1] << 16) * inv), q3 = (int)rintf(__uint_as_float(w[2 * j + 1] & 0xffff0000u) * inv);
            o[j] = ((unsigned)q0 & 255u) | (((unsigned)q1 & 255u) << 8) | (((unsigned)q2 & 255u) << 16) | ((unsigned)q3 << 24); }
        u32x4 ov; ov.x = o[0]; ov.y = o[1]; ov.z = o[2]; ov.w = o[3];
        *((u32x4*)(ws + WS_H0I8 + (size_t)row * DM) + lane) = ov;
        if (lane == 0) RF[row] = am * (1.f / 127.f) * rstd2;
    }
}
struct EpiQI8 {
    static constexpr bool PERM = true, AFTER_DRAIN = false;
    bf16* O; int ldc; const float* rf; const float* sw;
    __device__ __forceinline__ void operator()(const pg8::i32x4 (&acc)[2][2][4][2], const pg8::Unit& u, int wr, int wc, int fr, int fq) const {
        const int row0 = u.pm * 256 + wr * 64 + fr, col0 = u.pn * 256 + wc * 32 + 8 * fq;
        f32x4 swv[2][2];
#pragma unroll
        for (int bj = 0; bj < 2; ++bj) { swv[bj][0] = *(const f32x4*)(sw + col0 + bj * 128); swv[bj][1] = *(const f32x4*)(sw + col0 + bj * 128 + 4); }
#pragma unroll
        for (int ai = 0; ai < 2; ++ai)
#pragma unroll
            for (int m = 0; m < 4; ++m) {
                const int row = row0 + ai * 128 + m * 16;
                const float s = rf[row];
                bf16* rowp = O + (size_t)row * ldc + col0;
#pragma unroll
                for (int bj = 0; bj < 2; ++bj) { const pg8::i32x4 a0 = acc[ai][bj][m][0], a1 = acc[ai][bj][m][1];
                    const f32x4 v0 = (f32x4){(float)a0[0], (float)a0[1], (float)a0[2], (float)a0[3]} * (swv[bj][0] * s), v1 = (f32x4){(float)a1[0], (float)a1[1], (float)a1[2], (float)a1[3]} * (swv[bj][1] * s);
                    u32x4 w; w.x = cvt_pk_bf16(v0[0], v0[1]); w.y = cvt_pk_bf16(v0[2], v0[3]); w.z = cvt_pk_bf16(v1[0], v1[1]); w.w = cvt_pk_bf16(v1[2], v1[3]);
                    *(u32x4*)(rowp + bj * 128) = w; }
            }
    }
};
#define XB_TMO      128
#define XB_XCNT(j)  (256  + 64 * (j))
#define XB_XSUB(j)  (1280 + 64 * (j))
#define XB_XGEN(j)  (2304 + 64 * (j))
#define XB_TOP      3328
#define XB_TOPGEN   3392
#define XCD_BAR_WORDS 3456
#define XB_SPIN_CAP (1u << 18)

__device__ __forceinline__ unsigned xb_ld(unsigned* p)              { return __hip_atomic_load(p, __ATOMIC_RELAXED, __HIP_MEMORY_SCOPE_AGENT); }
__device__ __forceinline__ unsigned xb_add(unsigned* p, unsigned v) { return __hip_atomic_fetch_add(p, v, __ATOMIC_RELAXED, __HIP_MEMORY_SCOPE_AGENT); }
__device__ __forceinline__ unsigned xb_xcc_id() { return (unsigned)__builtin_amdgcn_s_getreg((3 << 11) | 20) & 0xFu; }
#define XB_SPIN(cond, bar) do { unsigned _sp = 0; while (cond) { __builtin_amdgcn_s_sleep(1); \
    if ((++_sp & 255u) == 0u) { if (xb_ld(&(bar)[XB_TMO])) break; if (_sp > XB_SPIN_CAP) { atomicAdd(&(bar)[XB_TMO], 1u); break; } } } } while (0)

struct XcdBarrier {
    unsigned* bar; unsigned x;
    volatile LAS unsigned* st;
};

__device__ __forceinline__ XcdBarrier xcd_barrier_post(unsigned* bar, volatile LAS unsigned* st) {
    XcdBarrier b; b.bar = bar; b.x = xb_xcc_id(); b.st = st;
    if (threadIdx.x == 0) (void)xb_add(&bar[XB_XCNT(b.x)], 1u);
    return b;
}
__device__ __forceinline__ void xcd_barrier_complete(unsigned* bar, unsigned x, unsigned& nloc, unsigned& nx) {
    const unsigned G = gridDim.x * gridDim.y * gridDim.z;
    unsigned sum, cnt, mine, sp = 0u;
    for (;;) {
        sum = 0u; cnt = 0u; mine = 0u;
#pragma unroll
        for (unsigned j = 0; j < 16; ++j) { const unsigned c = xb_ld(&bar[XB_XCNT(j)]); sum += c; cnt += (c > 0u) ? 1u : 0u; mine = (j == x) ? c : mine; }
        if (sum == G) break;
        __builtin_amdgcn_s_sleep(1);
        if ((++sp & 255u) == 0u) { if (xb_ld(&bar[XB_TMO])) break; if (sp > XB_SPIN_CAP) { atomicAdd(&bar[XB_TMO], 1u); break; } }
    }
    nloc = mine > 0u ? mine : 1u; nx = cnt > 0u ? cnt : 1u;
}

__device__ __forceinline__ void xcd_barrier(const XcdBarrier& b) {
    asm volatile("s_waitcnt vmcnt(0)" ::: "memory");
    __syncthreads();
    if (threadIdx.x == 0) {
        unsigned* bar = b.bar;
        __builtin_amdgcn_s_waitcnt(0);
        unsigned nloc = b.st[0], nx = b.st[1];
        if (nloc == 0u) { xcd_barrier_complete(bar, b.x, nloc, nx); b.st[0] = nloc; b.st[1] = nx; }
        const unsigned old = xb_add(&bar[XB_XSUB(b.x)], 1u);
        const unsigned gen = old / nloc;
        if (old + 1u == (gen + 1u) * nloc) {
            __builtin_amdgcn_fence(__ATOMIC_RELEASE, "agent");
            asm volatile("s_waitcnt vmcnt(0)" ::: "memory");
            const unsigned og = xb_add(&bar[XB_TOP], 1u);
            const unsigned tg = og / nx;
            if (og + 1u == (tg + 1u) * nx) xb_add(&bar[XB_TOPGEN], 1u);
            else XB_SPIN(xb_ld(&bar[XB_TOPGEN]) == tg, bar);
            __builtin_amdgcn_fence(__ATOMIC_ACQUIRE, "agent");
            xb_add(&bar[XB_XGEN(b.x)], 1u);
            asm volatile("s_waitcnt vmcnt(0)" ::: "memory");
        } else {
            XB_SPIN(xb_ld(&bar[XB_XGEN(b.x)]) == gen, bar);
            __builtin_amdgcn_fence(__ATOMIC_ACQUIRE, "agent");
            asm volatile("s_waitcnt vmcnt(0)" ::: "memory");
        }
    }
    __syncthreads();
}


#ifndef MK_MULTI
#define MK_MULTI 0
#endif
constexpr int NPHASE = 10;
#ifndef REP5
#define REP5 1
#endif
#ifndef REP6
#define REP6 1
#endif
__global__ void __launch_bounds__(NTHREADS, 2) mk_fwd(Params P) {
    extern __shared__ __attribute__((aligned(16))) unsigned char lds_raw[];
    LAS unsigned char* lds = (LAS unsigned char*)lds_raw;
    cg::grid_group grid = cg::this_grid();
    unsigned char* ws = P.ws;
    const int lo = P.ph_lo, hi = P.ph_hi;
    volatile LAS unsigned* bst = (volatile LAS unsigned*)(lds + 131072 + 64);
    if (threadIdx.x < 2) bst[threadIdx.x] = 0u;
    __syncthreads();
    XcdBarrier xbar = xcd_barrier_post((unsigned*)(ws + WS_CTL), bst);
#define IN(k) (lo <= (k) && (k) < hi)
#define SEAM(k) do { if (IN(k) && IN((k) + 1)) { xcd_barrier(xbar); } } while (0)
    if (IN(0)) phase_prep(P, lds);
    SEAM(0);
    if (IN(1)) { phase_metaproj(P); phase_winq(P, lds); }
    SEAM(1);
    if (IN(2)) {
        pg8::Gemm g{(const bf16*)(ws + WS_H0I8), (const bf16*)(ws + WS_WIN_T), NTOK, DIN, DM / 2}; pg8::StaticOrder S; S.init(NTOK, DIN, (int)gridDim.x, (int)blockIdx.x);
        EpiProjI8 E{(bf16*)(ws + WS_PROJ), (const float*)(ws + WS_RSTD1), (const float*)(ws + WS_SW)};
        pg8::gemm_phase_i8<EpiProjI8, pg8::StaticOrder, true, true>(lds, g, S, E);
    }
    SEAM(2);
    if (IN(3)) phase_conv(P, lds);
    SEAM(3);
    if (IN(4)) {
        pg8::Gemm g{(const bf16*)(ws + WS_Y), (const bf16*)(ws + WS_WOUT_T), NTOK, DM, DM / 2}; pg8::StaticOrder S; S.init(NTOK, DM, (int)gridDim.x, (int)blockIdx.x);
        EpiResidualI8 E{(bf16*)(ws + WS_H2B), (const signed char*)(ws + WS_H0I8), (const float*)(ws + WS_SX), (const float*)(ws + WS_SY), (const float*)(ws + WS_SWO), (float*)(ws + WS_SSQ), (float*)(ws + WS_AMX)};
        pg8::gemm_phase_i8<EpiResidualI8, pg8::StaticOrder, true, true>(lds, g, S, E);
    }
    SEAM(4);
    if (IN(5)) phase_quant_h2(P);
    SEAM(5);
    if (IN(6)) {
        pg8::Gemm g{(const bf16*)(ws + WS_H0I8), (const bf16*)(ws + WS_WQ_T), NTOK, 2048, DM / 2}; pg8::StaticOrder S; S.init(NTOK, 2048, (int)gridDim.x, (int)blockIdx.x);
        EpiQI8 E{(bf16*)(ws + WS_Q), 2048, (const float*)(ws + WS_RF), (const float*)(ws + WS_SWQ)};
        pg8::gemm_phase_i8<EpiQI8, pg8::StaticOrder, true, true>(lds, g, S, E);
    }
    if (IN(6) && IN(7)) { asm volatile("s_waitcnt vmcnt(0)" ::: "memory"); __syncthreads(); }
    if (IN(7)) phase_route(P, lds);
    SEAM(7);
    if (IN(8)) phase_gather_u(P);
    SEAM(8);
    if (IN(9)) phase_gather_v_mfma(P, lds);
#undef IN
#undef SEAM
}

extern "C" void kernel_launch(void* const* d_in, const int* in_sizes, int n_in, void* d_out, int out_size, void* d_ws, size_t ws_size, hipStream_t stream) {
    static int grid = 0;
    if (grid == 0) {
        if (n_in != 18 || in_sizes[0] != NTOK * DM || out_size != NTOK * DM || ws_size < WS_END) {
            fprintf(stderr, "kernel_launch: unexpected shapes (n_in %d in0 %d out %d ws %zu)\n", n_in, n_in > 0 ? in_sizes[0] : -1, out_size, ws_size); grid = -1; return; }
        int dev = 0, cus = 0, per_cu = 0;
        (void)hipGetDevice(&dev); (void)hipDeviceGetAttribute(&cus, hipDeviceAttributeMultiprocessorCount, dev);
        if (hipFuncSetAttribute((const void*)mk_fwd, hipFuncAttributeMaxDynamicSharedMemorySize, LDS_BYTES) != hipSuccess) { fprintf(stderr, "kernel_launch: hipFuncSetAttribute failed\n"); grid = -1; return; }
        if (hipOccupancyMaxActiveBlocksPerMultiprocessor(&per_cu, (const void*)mk_fwd, NTHREADS, LDS_BYTES) != hipSuccess || per_cu < 1) { fprintf(stderr, "kernel_launch: occupancy query failed (%d)\n", per_cu); (void)hipGetLastError(); per_cu = 1; }
        if (per_cu > 1) per_cu = 1;
        grid = cus * per_cu;
        if (grid <= 0) grid = 256;
    }
    if (grid < 0) return;
    Params p{};
    p.x = (const float*)d_in[0]; p.meta = (const float*)d_in[1]; p.g_mix = (const float*)d_in[2]; p.w_in = (const float*)d_in[3]; p.sc_w = (const float*)d_in[4];
    p.cf_w = (const float*)d_in[5]; p.cf_b = (const float*)d_in[6]; p.ln_g = (const float*)d_in[7]; p.ln_b = (const float*)d_in[8]; p.g_sc = (const float*)d_in[9];
    p.g_cf = (const float*)d_in[10]; p.w_out = (const float*)d_in[11]; p.g_ffn = (const float*)d_in[12]; p.w_q = (const float*)d_in[13]; p.keys = (const float*)d_in[14];
    p.pu = (const float*)d_in[15]; p.pv = (const float*)d_in[16]; p.g_fin = (const float*)d_in[17];
    p.out = (float*)d_out; p.ws = (unsigned char*)d_ws;
    (void)hipMemsetAsync((char*)d_ws + WS_CTL, 0, 45056, stream);
#if MK_MULTI
    for (int ph = 0; ph < NPHASE; ++ph) { p.ph_lo = ph; p.ph_hi = ph + 1; p.coop = 0; p.pad = 0;
        hipLaunchKernelGGL(mk_fwd, dim3(grid), dim3(NTHREADS), LDS_BYTES, stream, p); }
#else
    p.ph_lo = 0; p.ph_hi = NPHASE; p.coop = 1; p.pad = 0;
    void* args[] = {&p};
    hipError_t e = hipLaunchCooperativeKernel((const void*)mk_fwd, dim3(grid), dim3(NTHREADS), args, LDS_BYTES, stream);
    if (e != hipSuccess) fprintf(stderr, "cooperative launch failed: %s (grid %d)\n", hipGetErrorString(e), grid);
#endif
}
```

```cpp
#include <hip/hip_runtime.h>
#include <hip/hip_cooperative_groups.h>
#include <cstdio>
#include <cstdint>
namespace cg = cooperative_groups;

namespace pg8 {
#define PG8_LAS __attribute__((address_space(3)))
typedef unsigned short bf16_t;
typedef short bf16x8 __attribute__((ext_vector_type(8)));
typedef float f32x4 __attribute__((ext_vector_type(4)));
typedef unsigned u32x4 __attribute__((ext_vector_type(4)));
typedef int i32x4 __attribute__((ext_vector_type(4)));
constexpr int BM = 256, BK = 64, HALF = 128, HTB = HALF * BK * 2  , STAGE_BYTES = 8 * HTB, NXCD = 8, WGM = 8;

__host__ __device__ __forceinline__ int lds_byte(int r, int c) { const int st = (r >> 4) * 2 + (c >> 5), rr = r & 15, cc = c & 31, ob = rr * 64 + cc * 2; return st * 1024 + (ob ^ (((ob >> 9) & 1) << 5)); }
__host__ __device__ __forceinline__ void stage_rc(int b, int& R, int& C) { const int st = b / 1024, sb = b % 1024, swz = sb ^ (((sb >> 9) & 1) << 5); R = (st >> 1) * 16 + swz / 64; C = (st & 1) * 32 + (swz % 64) / 2; }
__host__ __device__ __forceinline__ int perm32(int rho) { const int n = rho >> 4, i = rho & 15; return 8 * (i >> 2) + 4 * n + (i & 3); }

struct Unit { int pm, pn; };
struct Gemm { const bf16_t* A; const bf16_t* Bt; int M, N, K; };

struct StaticOrder {
    int nM, nN, nwg, G, c;
    __host__ __device__ void init(int M, int N, int G_, int c_) { nM = M / BM; nN = N / BM; nwg = nM * nN; G = G_; c = c_; }
    __host__ __device__ bool next(int i, Unit& u) const {
        const long L = (long)i * G + c; if (L >= nwg) return false;
        int wgid = (int)L; { const int q = nwg / NXCD, r = nwg % NXCD, xcd = wgid % NXCD, off = wgid / NXCD; wgid = (xcd < r ? xcd * (q + 1) : r * (q + 1) + (xcd - r) * q) + off; }
        const int nig = WGM * nN, gid = wgid / nig, fm = gid * WGM, gsz = (nM - fm) < WGM ? (nM - fm) : WGM;
        u.pm = fm + ((wgid % nig) % gsz); u.pn = (wgid % nig) / gsz; return true;
    }
    __device__ __forceinline__ void a_ready(const Unit&) const {}
    __device__ __forceinline__ void done(const Unit&) const {}
};

template <class Epi, class Sched, bool ALIGN_EPI = false, bool SP2 = false>
__device__ __forceinline__ void gemm_phase(PG8_LAS unsigned char* lds, const Gemm g, const Sched& S, const Epi& E) {
    const int tid = threadIdx.x, wid = __builtin_amdgcn_readfirstlane(tid >> 6), lane = tid & 63, wr = wid >> 2, wc = wid & 3, fr = lane & 15, fq = lane >> 4;
    const int K = g.K, nt = K / BK;
    unsigned voffA[2], voffB[2];
#pragma unroll
    for (int i = 0; i < 2; ++i) { int R, C; stage_rc(tid * 16 + i * 8192, R, C); const int Rb = Epi::PERM ? ((R & ~31) + perm32(R & 31)) : R;
        voffA[i] = (unsigned)(R * K + C) * 2u; voffB[i] = (unsigned)(Rb * K + C) * 2u; }
    const size_t kstep = (size_t)(BK * 2);
    const size_t hstep = (size_t)HALF * K * 2;
    const size_t tstep = 2 * hstep;
    const unsigned ldsw = (unsigned)wid * 1024u;
    const int aoff = lds_byte(wr * 64 + fr, fq * 8), boff = lds_byte(wc * 32 + fr, fq * 8);
#define PG8_SA(b, h) (((b) * 2 + (h)) * HTB)
#define PG8_SB(b, h) ((4 + (b) * 2 + (h)) * HTB)
#define PG8_STAGE(bufoff, gbase, voff) do { _Pragma("unroll") for (int _i = 0; _i < 2; ++_i) \
        __builtin_amdgcn_global_load_lds((const unsigned*)((const char*)(gbase) + (voff)[_i]), (PG8_LAS unsigned*)(lds + (bufoff) + ldsw + _i * 8192), 16, 0, 0); } while (0)
#define PG8_LDA(dst, b, h) do { _Pragma("unroll") for (int m = 0; m < 4; ++m) _Pragma("unroll") for (int k = 0; k < 2; ++k) dst[m][k] = *(const PG8_LAS bf16x8*)(lds + PG8_SA(b, h) + aoff + m * 2048 + k * 1024); } while (0)
#define PG8_LDB(dst, b, h) do { _Pragma("unroll") for (int n = 0; n < 2; ++n) _Pragma("unroll") for (int k = 0; k < 2; ++k) dst[n][k] = *(const PG8_LAS bf16x8*)(lds + PG8_SB(b, h) + boff + n * 2048 + k * 1024); } while (0)
#define PG8_MMA(ai, bj, At, Bt) do { __builtin_amdgcn_s_setprio(1); _Pragma("unroll") for (int m = 0; m < 4; ++m) _Pragma("unroll") for (int n = 0; n < 2; ++n) _Pragma("unroll") for (int k = 0; k < 2; ++k) \
        acc[ai][bj][m][n] = __builtin_amdgcn_mfma_f32_16x16x32_bf16(Bt[n][k], At[m][k], acc[ai][bj][m][n], 0, 0, 0); __builtin_amdgcn_s_setprio(0); } while (0)
#define PG8_WAIT_V(n) asm volatile("s_waitcnt vmcnt(" #n ")" ::: "memory")
#define PG8_WAIT_L(n) asm volatile("s_waitcnt lgkmcnt(" #n ")" ::: "memory")
#define PG8_BAR __builtin_amdgcn_s_barrier()
#define PG8_SCHED __builtin_amdgcn_sched_barrier(0)
    Unit cur, nxt; int ui = 0;
    if (!S.next(0, cur)) return;
    f32x4 acc[2][2][4][2];
#pragma unroll
    for (int a = 0; a < 2; ++a)
#pragma unroll
        for (int b = 0; b < 2; ++b)
#pragma unroll
            for (int m = 0; m < 4; ++m)
#pragma unroll
                for (int n = 0; n < 2; ++n) acc[a][b][m][n] = (f32x4){0.f, 0.f, 0.f, 0.f};
    bf16x8 At[4][2], B0[2][2], B1[2][2];
    const char* cA = (const char*)g.A + (size_t)cur.pm * tstep; const char* cB = (const char*)g.Bt + (size_t)cur.pn * tstep;
    S.a_ready(cur);
    if constexpr (SP2) {
        PG8_STAGE(PG8_SB(0, 0), cB, voffB); PG8_STAGE(PG8_SB(0, 1), cB + hstep, voffB); PG8_STAGE(PG8_SA(0, 0), cA, voffA); PG8_STAGE(PG8_SA(0, 1), cA + hstep, voffA);
        if (wr == 1) PG8_BAR;
        PG8_WAIT_V(2); PG8_BAR;
        PG8_STAGE(PG8_SB(1, 0), cB + kstep, voffB); PG8_STAGE(PG8_SA(1, 0), cA + kstep, voffA); PG8_STAGE(PG8_SB(1, 1), cB + hstep + kstep, voffB);
        PG8_WAIT_V(6); PG8_BAR;
    } else {
        PG8_STAGE(PG8_SB(0, 0), cB, voffB); PG8_STAGE(PG8_SA(0, 0), cA, voffA); PG8_STAGE(PG8_SB(0, 1), cB + hstep, voffB); PG8_STAGE(PG8_SA(0, 1), cA + hstep, voffA);
        if (wr == 1) PG8_BAR;
        PG8_WAIT_V(4); PG8_BAR;
        PG8_STAGE(PG8_SB(1, 0), cB + kstep, voffB); PG8_STAGE(PG8_SA(1, 0), cA + kstep, voffA); PG8_STAGE(PG8_SB(1, 1), cB + hstep + kstep, voffB);
        PG8_WAIT_V(6); PG8_BAR;
    }
    for (;;) {
        const bool has_next = S.next(ui + 1, nxt);
        const char* nA = has_next ? (const char*)g.A + (size_t)nxt.pm * tstep : cA; const char* nB = has_next ? (const char*)g.Bt + (size_t)nxt.pn * tstep : cB;
        for (int t = 0; t < nt; t += 2) {
            const bool last = (t == nt - 2);
            const char* a1 = cA + (size_t)(t + 1) * kstep;
            const char* a2 = last ? nA : cA + (size_t)(t + 2) * kstep; const char* b2 = last ? nB : cB + (size_t)(t + 2) * kstep;
            const char* a3 = a2 + kstep; const char* b3 = b2 + kstep;
            if (last && has_next) S.a_ready(nxt);
            if constexpr (SP2) {
            PG8_LDB(B0, 0, 0); PG8_LDB(B1, 0, 1); PG8_SCHED; PG8_LDA(At, 0, 0); PG8_STAGE(PG8_SA(1, 1), a1 + hstep, voffA);
            PG8_WAIT_V(8); PG8_WAIT_L(0); PG8_BAR; PG8_MMA(0, 0, At, B0); PG8_MMA(0, 1, At, B1); PG8_BAR; PG8_SCHED;
            PG8_LDA(At, 0, 1); PG8_STAGE(PG8_SB(0, 0), b2, voffB); PG8_STAGE(PG8_SB(0, 1), b2 + hstep, voffB); PG8_STAGE(PG8_SA(0, 0), a2, voffA);
            PG8_WAIT_V(8); PG8_WAIT_L(0); PG8_BAR; PG8_MMA(1, 0, At, B0); PG8_MMA(1, 1, At, B1); PG8_BAR; PG8_SCHED;
            PG8_LDB(B0, 1, 0); PG8_LDB(B1, 1, 1); PG8_SCHED; PG8_LDA(At, 1, 0); PG8_STAGE(PG8_SA(0, 1), a2 + hstep, voffA);
            PG8_WAIT_V(8); PG8_WAIT_L(0); PG8_BAR; PG8_MMA(0, 0, At, B0); PG8_MMA(0, 1, At, B1); PG8_BAR; PG8_SCHED;
            PG8_LDA(At, 1, 1); PG8_STAGE(PG8_SB(1, 0), b3, voffB); PG8_STAGE(PG8_SB(1, 1), b3 + hstep, voffB); PG8_STAGE(PG8_SA(1, 0), a3, voffA);
            PG8_WAIT_V(8); PG8_WAIT_L(0); PG8_BAR; PG8_MMA(1, 0, At, B0); PG8_MMA(1, 1, At, B1); PG8_BAR; PG8_SCHED;
            } else {
            PG8_LDB(B0, 0, 0); PG8_SCHED; PG8_LDA(At, 0, 0); PG8_STAGE(PG8_SA(1, 1), a1 + hstep, voffA);
            PG8_WAIT_L(8); PG8_BAR; PG8_WAIT_L(0); PG8_MMA(0, 0, At, B0); PG8_BAR; PG8_SCHED;
            PG8_LDB(B1, 0, 1); PG8_STAGE(PG8_SB(0, 0), b2, voffB);
            PG8_BAR; PG8_WAIT_L(0); PG8_MMA(0, 1, At, B1); PG8_BAR;
            PG8_LDA(At, 0, 1); PG8_STAGE(PG8_SA(0, 0), a2, voffA);
            PG8_BAR; PG8_WAIT_L(0); PG8_MMA(1, 0, At, B0); PG8_BAR; PG8_SCHED;
            PG8_STAGE(PG8_SB(0, 1), b2 + hstep, voffB);
            PG8_WAIT_V(6); PG8_BAR; PG8_MMA(1, 1, At, B1); PG8_BAR;
            PG8_LDB(B0, 1, 0); PG8_SCHED; PG8_LDA(At, 1, 0); PG8_STAGE(PG8_SA(0, 1), a2 + hstep, voffA);
            PG8_WAIT_L(8); PG8_BAR; PG8_WAIT_L(0); PG8_MMA(0, 0, At, B0); PG8_BAR; PG8_SCHED;
            PG8_LDB(B1, 1, 1); PG8_STAGE(PG8_SB(1, 0), b3, voffB);
            PG8_BAR; PG8_WAIT_L(0); PG8_MMA(0, 1, At, B1); PG8_BAR;
            PG8_LDA(At, 1, 1); PG8_STAGE(PG8_SA(1, 0), a3, voffA);
            PG8_BAR; PG8_WAIT_L(0); PG8_MMA(1, 0, At, B0); PG8_BAR; PG8_SCHED;
            PG8_STAGE(PG8_SB(1, 1), b3 + hstep, voffB);
            PG8_WAIT_V(6); PG8_BAR; PG8_MMA(1, 1, At, B1); PG8_BAR;
            }
        }
        if constexpr (ALIGN_EPI) { if (wr == 0) PG8_BAR; }
        if constexpr (!Epi::AFTER_DRAIN) { E(acc, cur, wr, wc, fr, fq); S.done(cur); }
        if (!has_next) break;
#pragma unroll
        for (int a = 0; a < 2; ++a)
#pragma unroll
            for (int b = 0; b < 2; ++b)
#pragma unroll
                for (int m = 0; m < 4; ++m)
#pragma unroll
                    for (int n = 0; n < 2; ++n) acc[a][b][m][n] = (f32x4){0.f, 0.f, 0.f, 0.f};
        cur = nxt; cA = nA; cB = nB; ++ui;
        if constexpr (ALIGN_EPI) { if (wr == 1) PG8_BAR; }
    }
    PG8_WAIT_V(0);
    if constexpr (!ALIGN_EPI) { if (wr == 0) PG8_BAR; }
    PG8_BAR;
    if constexpr (Epi::AFTER_DRAIN) { E.fused(acc, cur, wr, wc, fr, fq, lds, wid, lane); S.done(cur); }
#undef PG8_SA
#undef PG8_SB
#undef PG8_STAGE
#undef PG8_LDA
#undef PG8_LDB
#undef PG8_MMA
#undef PG8_WAIT_V
#undef PG8_WAIT_L
#undef PG8_BAR
#undef PG8_SCHED
}
template <class Epi, class Sched, bool ALIGN_EPI = false, bool SP2 = false>
__device__ __forceinline__ void gemm_phase_i8(PG8_LAS unsigned char* lds, const Gemm g, const Sched& S, const Epi& E) {
    const int tid = threadIdx.x, wid = __builtin_amdgcn_readfirstlane(tid >> 6), lane = tid & 63, wr = wid >> 2, wc = wid & 3, fr = lane & 15, fq = lane >> 4;
    const int K = g.K, nt = K / BK;
    unsigned voffA[2], voffB[2];
#pragma unroll
    for (int i = 0; i < 2; ++i) { int R, C; stage_rc(tid * 16 + i * 8192, R, C); const int Rb = Epi::PERM ? ((R & ~31) + perm32(R & 31)) : R;
        voffA[i] = (unsigned)(R * K + C) * 2u; voffB[i] = (unsigned)(Rb * K + C) * 2u; }
    const size_t kstep = (size_t)(BK * 2);
    const size_t hstep = (size_t)HALF * K * 2;
    const size_t tstep = 2 * hstep;
    const unsigned ldsw = (unsigned)wid * 1024u;
    const int aoff = lds_byte(wr * 64 + fr, fq * 8), boff = lds_byte(wc * 32 + fr, fq * 8);
#define PG8_SA(b, h) (((b) * 2 + (h)) * HTB)
#define PG8_SB(b, h) ((4 + (b) * 2 + (h)) * HTB)
#define PG8_STAGE(bufoff, gbase, voff) do { _Pragma("unroll") for (int _i = 0; _i < 2; ++_i) \
        __builtin_amdgcn_global_load_lds((const unsigned*)((const char*)(gbase) + (voff)[_i]), (PG8_LAS unsigned*)(lds + (bufoff) + ldsw + _i * 8192), 16, 0, 0); } while (0)
#define PG8_LDA(dst, b, h) do { _Pragma("unroll") for (int m = 0; m < 4; ++m) _Pragma("unroll") for (int k = 0; k < 2; ++k) dst[m][k] = *(const PG8_LAS bf16x8*)(lds + PG8_SA(b, h) + aoff + m * 2048 + k * 1024); } while (0)
#define PG8_LDB(dst, b, h) do { _Pragma("unroll") for (int n = 0; n < 2; ++n) _Pragma("unroll") for (int k = 0; k < 2; ++k) dst[n][k] = *(const PG8_LAS bf16x8*)(lds + PG8_SB(b, h) + boff + n * 2048 + k * 1024); } while (0)
#define PG8_MMA(ai, bj, At, Bt) do { __builtin_amdgcn_s_setprio(1); _Pragma("unroll") for (int m = 0; m < 4; ++m) _Pragma("unroll") for (int n = 0; n < 2; ++n) _Pragma("unroll") for (int k = 0; k < 2; ++k) \
        acc[ai][bj][m][n] = __builtin_amdgcn_mfma_i32_16x16x64_i8(__builtin_bit_cast(i32x4, Bt[n][k]), __builtin_bit_cast(i32x4, At[m][k]), acc[ai][bj][m][n], 0, 0, 0); __builtin_amdgcn_s_setprio(0); } while (0)
#define PG8_WAIT_V(n) asm volatile("s_waitcnt vmcnt(" #n ")" ::: "memory")
#define PG8_WAIT_L(n) asm volatile("s_waitcnt lgkmcnt(" #n ")" ::: "memory")
#define PG8_BAR __builtin_amdgcn_s_barrier()
#define PG8_SCHED __builtin_amdgcn_sched_barrier(0)
    Unit cur, nxt; int ui = 0;
    if (!S.next(0, cur)) return;
    i32x4 acc[2][2][4][2];
#pragma unroll
    for (int a = 0; a < 2; ++a)
#pragma unroll
        for (int b = 0; b < 2; ++b)
#pragma unroll
            for (int m = 0; m < 4; ++m)
#pragma unroll
                for (int n = 0; n < 2; ++n) acc[a][b][m][n] = (i32x4){0, 0, 0, 0};
    bf16x8 At[4][2], B0[2][2], B1[2][2];
    const char* cA = (const char*)g.A + (size_t)cur.pm * tstep; const char* cB = (const char*)g.Bt + (size_t)cur.pn * tstep;
    S.a_ready(cur);
    if constexpr (SP2) {
        PG8_STAGE(PG8_SB(0, 0), cB, voffB); PG8_STAGE(PG8_SB(0, 1), cB + hstep, voffB); PG8_STAGE(PG8_SA(0, 0), cA, voffA); PG8_STAGE(PG8_SA(0, 1), cA + hstep, voffA);
        if (wr == 1) PG8_BAR;
        PG8_WAIT_V(2); PG8_BAR;
        PG8_STAGE(PG8_SB(1, 0), cB + kstep, voffB); PG8_STAGE(PG8_SA(1, 0), cA + kstep, voffA); PG8_STAGE(PG8_SB(1, 1), cB + hstep + kstep, voffB);
        PG8_WAIT_V(6); PG8_BAR;
    } else {
        PG8_STAGE(PG8_SB(0, 0), cB, voffB); PG8_STAGE(PG8_SA(0, 0), cA, voffA); PG8_STAGE(PG8_SB(0, 1), cB + hstep, voffB); PG8_STAGE(PG8_SA(0, 1), cA + hstep, voffA);
        if (wr == 1) PG8_BAR;
        PG8_WAIT_V(4); PG8_BAR;
        PG8_STAGE(PG8_SB(1, 0), cB + kstep, voffB); PG8_STAGE(PG8_SA(1, 0), cA + kstep, voffA); PG8_STAGE(PG8_SB(1, 1), cB + hstep + kstep, voffB);
        PG8_WAIT_V(6); PG8_BAR;
    }
    for (;;) {
        const bool has_next = S.next(ui + 1, nxt);
        const char* nA = has_next ? (const char*)g.A + (size_t)nxt.pm * tstep : cA; const char* nB = has_next ? (const char*)g.Bt + (size_t)nxt.pn * tstep : cB;
        for (int t = 0; t < nt; t += 2) {
            const bool last = (t == nt - 2);
            const char* a1 = cA + (size_t)(t + 1) * kstep;
            const char* a2 = last ? nA : cA + (size_t)(t + 2) * kstep; const char* b2 = last ? nB : cB + (size_t)(t + 2) * kstep;
            const char* a3 = a2 + kstep; const char* b3 = b2 + kstep;
            if (last && has_next) S.a_ready(nxt);
            if constexpr (SP2) {
            PG8_LDB(B0, 0, 0); PG8_LDB(B1, 0, 1); PG8_SCHED; PG8_LDA(At, 0, 0); PG8_STAGE(PG8_SA(1, 1), a1 + hstep, voffA);
            PG8_WAIT_V(8); PG8_WAIT_L(0); PG8_BAR; PG8_MMA(0, 0, At, B0); PG8_MMA(0, 1, At, B1); PG8_BAR; PG8_SCHED;
            PG8_LDA(At, 0, 1); PG8_STAGE(PG8_SB(0, 0), b2, voffB); PG8_STAGE(PG8_SB(0, 1), b2 + hstep, voffB); PG8_STAGE(PG8_SA(0, 0), a2, voffA);
            PG8_WAIT_V(8); PG8_WAIT_L(0); PG8_BAR; PG8_MMA(1, 0, At, B0); PG8_MMA(1, 1, At, B1); PG8_BAR; PG8_SCHED;
            PG8_LDB(B0, 1, 0); PG8_LDB(B1, 1, 1); PG8_SCHED; PG8_LDA(At, 1, 0); PG8_STAGE(PG8_SA(0, 1), a2 + hstep, voffA);
            PG8_WAIT_V(8); PG8_WAIT_L(0); PG8_BAR; PG8_MMA(0, 0, At, B0); PG8_MMA(0, 1, At, B1); PG8_BAR; PG8_SCHED;
            PG8_LDA(At, 1, 1); PG8_STAGE(PG8_SB(1, 0), b3, voffB); PG8_STAGE(PG8_SB(1, 1), b3 + hstep, voffB); PG8_STAGE(PG8_SA(1, 0), a3, voffA);
            PG8_WAIT_V(8); PG8_WAIT_L(0); PG8_BAR; PG8_MMA(1, 0, At, B0); PG8_MMA(1, 1, At, B1); PG8_BAR; PG8_SCHED;
            } else {
            PG8_LDB(B0, 0, 0); PG8_SCHED; PG8_LDA(At, 0, 0); PG8_STAGE(PG8_SA(1, 1), a1 + hstep, voffA);
            PG8_WAIT_L(8); PG8_BAR; PG8_WAIT_L(0); PG8_MMA(0, 0, At, B0); PG8_BAR; PG8_SCHED;
            PG8_LDB(B1, 0, 1); PG8_STAGE(PG8_SB(0, 0), b2, voffB);
            PG8_BAR; PG8_WAIT_L(0); PG8_MMA(0, 1, At, B1); PG8_BAR;
            PG8_LDA(At, 0, 1); PG8_STAGE(PG8_SA(0, 0), a2, voffA);
            PG8_BAR; PG8_WAIT_L(0); PG8_MMA(1, 0, At, B0); PG8_BAR; PG8_SCHED;
            PG8_STAGE(PG8_SB(0, 1), b2 + hstep, voffB);
            PG8_WAIT_V(6); PG8_BAR; PG8_MMA(1, 1, At, B1); PG8_BAR;
            PG8_LDB(B0, 1, 0); PG8_SCHED; PG8_LDA(At, 1, 0); PG8_STAGE(PG8_SA(0, 1), a2 + hstep, voffA);
            PG8_WAIT_L(8); PG8_BAR; PG8_WAIT_L(0); PG8_MMA(0, 0, At, B0); PG8_BAR; PG8_SCHED;
            PG8_LDB(B1, 1, 1); PG8_STAGE(PG8_SB(1, 0), b3, voffB);
            PG8_BAR; PG8_WAIT_L(0); PG8_MMA(0, 1, At, B1); PG8_BAR;
            PG8_LDA(At, 1, 1); PG8_STAGE(PG8_SA(1, 0), a3, voffA);
            PG8_BAR; PG8_WAIT_L(0); PG8_MMA(1, 0, At, B0); PG8_BAR; PG8_SCHED;
            PG8_STAGE(PG8_SB(1, 1), b3 + hstep, voffB);
            PG8_WAIT_V(6); PG8_BAR; PG8_MMA(1, 1, At, B1); PG8_BAR;
            }
        }
        if constexpr (ALIGN_EPI) { if (wr == 0) PG8_BAR; }
        if constexpr (!Epi::AFTER_DRAIN) { E(acc, cur, wr, wc, fr, fq); S.done(cur); }
        if (!has_next) break;
#pragma unroll
        for (int a = 0; a < 2; ++a)
#pragma unroll
            for (int b = 0; b < 2; ++b)
#pragma unroll
                for (int m = 0; m < 4; ++m)
#pragma unroll
                    for (int n = 0; n < 2; ++n) acc[a][b][m][n] = (i32x4){0, 0, 0, 0};
        cur = nxt; cA = nA; cB = nB; ++ui;
        if constexpr (ALIGN_EPI) { if (wr == 1) PG8_BAR; }
    }
    PG8_WAIT_V(0);
    if constexpr (!ALIGN_EPI) { if (wr == 0) PG8_BAR; }
    PG8_BAR;
    if constexpr (Epi::AFTER_DRAIN) { E.fused(acc, cur, wr, wc, fr, fq, lds, wid, lane); S.done(cur); }
#undef PG8_SA
#undef PG8_SB
#undef PG8_STAGE
#undef PG8_LDA
#undef PG8_LDB
#undef PG8_MMA
#undef PG8_WAIT_V
#undef PG8_WAIT_L
#undef PG8_BAR
#undef PG8_SCHED
}
}

#define LAS __attribute__((address_space(3)))
typedef unsigned short bf16;
typedef float f32x2 __attribute__((ext_vector_type(2)));
typedef float f32x4 __attribute__((ext_vector_type(4)));
typedef unsigned u32x2 __attribute__((ext_vector_type(2)));
typedef unsigned u32x4 __attribute__((ext_vector_type(4)));

constexpr int PDIM = 1536;
constexpr int NTOK = 32768, DM = 1024, DIN = 2560, SEQ = 8192, NBATCH = 4, NMETA = 16;
constexpr int NHEAD = 8, NKEYS = 128, TOPK = 16, NSEL = NHEAD * TOPK;
constexpr float EPS = 1e-6f;
constexpr float U_SCALE = 64.f, V_SCALE = 16.f;
constexpr float U4_CLIP = 2.6f;
constexpr int NWAVES = 8, NTHREADS = 512;
constexpr int MKC = 32;
constexpr int LDS_BYTES = 147456;

constexpr size_t MiB = 1u << 20;
constexpr size_t WS_CTL = 0, WS_WIN_T = 1 * MiB, WS_WOUT_T = 6 * MiB, WS_WQ_T = 8 * MiB, WS_KEYS = 12 * MiB, WS_METAPART = 160 * MiB  ,
                 WS_METARSTD = 14 * MiB + 512 * 1024, WS_METAPROJ = 14 * MiB + 576 * 1024, WS_RSTD1 = 15 * MiB, WS_SSQ = 16 * MiB, WS_U8 = 32 * MiB, WS_V8 = 48 * MiB,
                 WS_IDX = 64 * MiB, WS_GATE = 80 * MiB, WS_H0B = 96 * MiB, WS_H2B = 96 * MiB, WS_Y = 160 * MiB, WS_PROJ = 224 * MiB,
                 WS_Q = 224 * MiB, WS_ESCALE = 18 * MiB, WS_SUMQ = 19 * MiB, WS_SX = 20 * MiB, WS_SW = 21 * MiB, WS_SY = 22 * MiB, WS_SWO = 23 * MiB, WS_WMX = 24 * MiB, WS_AMX = 26 * MiB, WS_RF = 28 * MiB, WS_SWQ = 29 * MiB, WS_H0I8 = 384 * MiB, WS_AW = 160 * MiB  , WS_END = 416 * MiB;

struct Params {
    const float* x; const float* meta; const float* g_mix; const float* w_in; const float* sc_w; const float* cf_w; const float* cf_b;
    const float* ln_g; const float* ln_b; const float* g_sc; const float* g_cf; const float* w_out; const float* g_ffn; const float* w_q;
    const float* keys; const float* pu; const float* pv; const float* g_fin;
    float* out; unsigned char* ws;
    int ph_lo, ph_hi, coop, pad;
};

__device__ __forceinline__ unsigned f2bf(float f) { unsigned u = __builtin_bit_cast(unsigned, f); return (u + 0x7fffu + ((u >> 16) & 1u)) >> 16; }
__device__ __forceinline__ unsigned pk2(float lo, float hi) { return f2bf(lo) | (f2bf(hi) << 16); }
__device__ __forceinline__ float bf2f(unsigned b) { return __builtin_bit_cast(float, b << 16); }
__device__ __forceinline__ float bflo(unsigned w) { return __builtin_bit_cast(float, w << 16); }
__device__ __forceinline__ float bfhi(unsigned w) { return __builtin_bit_cast(float, w & 0xffff0000u); }
__device__ __forceinline__ float wave_sum(float v) {
#pragma unroll
    for (int o = 1; o < 64; o <<= 1) v += __shfl_xor(v, o);
    return v;
}
template <int CTRL> __device__ __forceinline__ float dpp_f(float v) { return __builtin_bit_cast(float, __builtin_amdgcn_update_dpp(0, __builtin_bit_cast(int, v), CTRL, 0xf, 0xf, true)); }
__device__ __forceinline__ float wave_sum_fast(float v) {
    v += dpp_f<0xB1>(v); v += dpp_f<0x4E>(v); v += dpp_f<0x141>(v); v += dpp_f<0x140>(v);
    { auto r = __builtin_amdgcn_permlane16_swap(__float_as_uint(v), __float_as_uint(v), false, false); v = __uint_as_float(r[0]) + __uint_as_float(r[1]); }
    { auto r = __builtin_amdgcn_permlane32_swap(__float_as_uint(v), __float_as_uint(v), false, false); v = __uint_as_float(r[0]) + __uint_as_float(r[1]); }
    return v;
}
__device__ __forceinline__ float wave_max_fast(float v) {
    v = fmaxf(v, dpp_f<0xB1>(v)); v = fmaxf(v, dpp_f<0x4E>(v)); v = fmaxf(v, dpp_f<0x141>(v)); v = fmaxf(v, dpp_f<0x140>(v));
    { auto r = __builtin_amdgcn_permlane16_swap(__float_as_uint(v), __float_as_uint(v), false, false); v = fmaxf(__uint_as_float(r[0]), __uint_as_float(r[1])); }
    { auto r = __builtin_amdgcn_permlane32_swap(__float_as_uint(v), __float_as_uint(v), false, false); v = fmaxf(__uint_as_float(r[0]), __uint_as_float(r[1])); }
    return v;
}
__device__ __forceinline__ float sigmoid_f(float x) { return 1.f / (1.f + __expf(-x)); }
__device__ __forceinline__ float gelu_tanh_f(float x) {
    const float t = 0.7978845608028654f * (x + 0.044715f * x * x * x);
    const float e = __expf(2.f * t);
    const float th = 1.f - 2.f / (e + 1.f);
    return 0.5f * x * (1.f + th);
}

__device__ __forceinline__ unsigned cvt_pk_bf16(float lo, float hi) { unsigned r; asm volatile("v_cvt_pk_bf16_f32 %0, %1, %2" : "=v"(r) : "v"(lo), "v"(hi)); return r; }

template <int MODE> struct EpiRowScale {
    static constexpr bool PERM = true, AFTER_DRAIN = false;
    bf16* O; int ldc; const float* rs;
    __device__ __forceinline__ void operator()(const pg8::f32x4 (&acc)[2][2][4][2], const pg8::Unit& u, int wr, int wc, int fr, int fq) const {
        const int row0 = u.pm * 256 + wr * 64 + fr, col0 = u.pn * 256 + wc * 32 + 8 * fq;
#pragma unroll
        for (int ai = 0; ai < 2; ++ai)
#pragma unroll
            for (int m = 0; m < 4; ++m) {
                const int row = row0 + ai * 128 + m * 16;
                float s;
                if (MODE == 0) s = rs[row];
                else { const f32x4* p = (const f32x4*)(rs + (size_t)row * 16); const f32x4 a = p[0], b = p[1], c = p[2], d = p[3];
                       const float t = ((a.x + a.y) + (a.z + a.w)) + ((b.x + b.y) + (b.z + b.w)) + ((c.x + c.y) + (c.z + c.w)) + ((d.x + d.y) + (d.z + d.w));
                       s = rsqrtf(t * (1.f / 1024.f) + EPS); }
                bf16* rowp = O + (size_t)row * ldc + col0;
#pragma unroll
                for (int bj = 0; bj < 2; ++bj) { const pg8::f32x4 v0 = acc[ai][bj][m][0] * s, v1 = acc[ai][bj][m][1] * s;
                    u32x4 w; w.x = cvt_pk_bf16(v0[0], v0[1]); w.y = cvt_pk_bf16(v0[2], v0[3]); w.z = cvt_pk_bf16(v1[0], v1[1]); w.w = cvt_pk_bf16(v1[2], v1[3]);
                    *(u32x4*)(rowp + bj * 128) = w; }
            }
    }
};
struct EpiProj {
    static constexpr bool PERM = true, AFTER_DRAIN = false;
    bf16* O; const float* rs;
    __device__ __forceinline__ void operator()(const pg8::f32x4 (&acc)[2][2][4][2], const pg8::Unit& u, int wr, int wc, int fr, int fq) const {
        const int row0 = u.pm * 256 + wr * 64 + fr, cin = wc * 32 + 8 * fq, pn = u.pn;
#pragma unroll
        for (int ai = 0; ai < 2; ++ai)
#pragma unroll
            for (int m = 0; m < 4; ++m) {
                const int row = row0 + ai * 128 + m * 16; const float sc = rs[row];
                float a[8], b[8];
#pragma unroll
                for (int i = 0; i < 4; ++i) { a[i] = acc[ai][0][m][0][i] * sc; a[4 + i] = acc[ai][0][m][1][i] * sc; b[i] = acc[ai][1][m][0][i] * sc; b[4 + i] = acc[ai][1][m][1][i] * sc; }
                bf16* rowp = O + (size_t)row * PDIM;
                if (pn >= 4 && pn < 6) {
                    u32x4 w0, w1; w0.x = cvt_pk_bf16(a[0], a[1]); w0.y = cvt_pk_bf16(a[2], a[3]); w0.z = cvt_pk_bf16(a[4], a[5]); w0.w = cvt_pk_bf16(a[6], a[7]);
                    w1.x = cvt_pk_bf16(b[0], b[1]); w1.y = cvt_pk_bf16(b[2], b[3]); w1.z = cvt_pk_bf16(b[4], b[5]); w1.w = cvt_pk_bf16(b[6], b[7]);
                    *(u32x4*)(rowp + 512 + 256 * (pn - 4) + cin) = w0; *(u32x4*)(rowp + 512 + 256 * (pn - 4) + 128 + cin) = w1;
                } else {
                    float o[8];
                    if (pn < 4) {
#pragma unroll
                        for (int i = 0; i < 8; ++i) o[i] = a[i] * b[i];
                    } else {
#pragma unroll
                        for (int i = 0; i < 8; ++i) o[i] = a[i] * sigmoid_f(b[i]);
                    }
                    u32x4 w; w.x = cvt_pk_bf16(o[0], o[1]); w.y = cvt_pk_bf16(o[2], o[3]); w.z = cvt_pk_bf16(o[4], o[5]); w.w = cvt_pk_bf16(o[6], o[7]);
                    *(u32x4*)(rowp + (pn < 4 ? 128 * pn : 1024 + 128 * (pn - 6)) + cin) = w;
                }
            }
    }
};
struct EpiProjI8 {
    static constexpr bool PERM = true, AFTER_DRAIN = false;
    bf16* O; const float* rs; const float* sw;
    __device__ __forceinline__ void operator()(const pg8::i32x4 (&acc)[2][2][4][2], const pg8::Unit& u, int wr, int wc, int fr, int fq) const {
        const int row0 = u.pm * 256 + wr * 64 + fr, cin = wc * 32 + 8 * fq, pn = u.pn;
        float swa[8], swb[8];
        { const f32x4 a0 = *(const f32x4*)(sw + 256 * pn + cin), a1 = *(const f32x4*)(sw + 256 * pn + cin + 4), b0 = *(const f32x4*)(sw + 256 * pn + 128 + cin), b1 = *(const f32x4*)(sw + 256 * pn + 128 + cin + 4);
          swa[0] = a0.x; swa[1] = a0.y; swa[2] = a0.z; swa[3] = a0.w; swa[4] = a1.x; swa[5] = a1.y; swa[6] = a1.z; swa[7] = a1.w;
          swb[0] = b0.x; swb[1] = b0.y; swb[2] = b0.z; swb[3] = b0.w; swb[4] = b1.x; swb[5] = b1.y; swb[6] = b1.z; swb[7] = b1.w; }
#pragma unroll
        for (int ai = 0; ai < 2; ++ai)
#pragma unroll
            for (int m = 0; m < 4; ++m) {
                const int row = row0 + ai * 128 + m * 16; const float sc = rs[row];
                float a[8], b[8];
#pragma unroll
                for (int i = 0; i < 4; ++i) { a[i] = (float)acc[ai][0][m][0][i] * (sc * swa[i]); a[4 + i] = (float)acc[ai][0][m][1][i] * (sc * swa[4 + i]);
                    b[i] = (float)acc[ai][1][m][0][i] * (sc * swb[i]); b[4 + i] = (float)acc[ai][1][m][1][i] * (sc * swb[4 + i]); }
                bf16* rowp = O + (size_t)row * PDIM;
                if (pn >= 4 && pn < 6) {
                    u32x4 w0, w1; w0.x = cvt_pk_bf16(a[0], a[1]); w0.y = cvt_pk_bf16(a[2], a[3]); w0.z = cvt_pk_bf16(a[4], a[5]); w0.w = cvt_pk_bf16(a[6], a[7]);
                    w1.x = cvt_pk_bf16(b[0], b[1]); w1.y = cvt_pk_bf16(b[2], b[3]); w1.z = cvt_pk_bf16(b[4], b[5]); w1.w = cvt_pk_bf16(b[6], b[7]);
                    *(u32x4*)(rowp + 512 + 256 * (pn - 4) + cin) = w0; *(u32x4*)(rowp + 512 + 256 * (pn - 4) + 128 + cin) = w1;
                } else {
                    float o[8];
                    if (pn < 4) {
#pragma unroll
                        for (int i = 0; i < 8; ++i) o[i] = a[i] * b[i];
                    } else {
#pragma unroll
                        for (int i = 0; i < 8; ++i) o[i] = a[i] * sigmoid_f(b[i]);
                    }
                    u32x4 w; w.x = cvt_pk_bf16(o[0], o[1]); w.y = cvt_pk_bf16(o[2], o[3]); w.z = cvt_pk_bf16(o[4], o[5]); w.w = cvt_pk_bf16(o[6], o[7]);
                    *(u32x4*)(rowp + (pn < 4 ? 128 * pn : 1024 + 128 * (pn - 6)) + cin) = w;
                }
            }
    }
};
__host__ __device__ __forceinline__ int win_src_col(int n) {
    const int t = n >> 8, j = n & 255;
    if (t < 4) return (j < 128) ? 128 * t + j : 1024 + 128 * t + (j - 128);
    if (t < 6) return 512 + 256 * (t - 4) + j;
    return (j < 128) ? 1536 + 128 * (t - 6) + j : 2048 + 128 * (t - 6) + (j - 128);
}
struct EpiResidual {
    static constexpr bool PERM = true, AFTER_DRAIN = false;
    bf16* O; const signed char* XB; const float* SX; float* ssq;
    __device__ __forceinline__ void operator()(const pg8::f32x4 (&acc)[2][2][4][2], const pg8::Unit& u, int wr, int wc, int fr, int fq) const {
        const int row0 = u.pm * 256 + wr * 64 + fr, col0 = u.pn * 256 + wc * 32 + 8 * fq;
#pragma unroll
        for (int ai = 0; ai < 2; ++ai)
#pragma unroll
            for (int m = 0; m < 4; ++m) {
                const int row = row0 + ai * 128 + m * 16;
                const signed char* xr = XB + (size_t)row * DM + col0; bf16* rowp = O + (size_t)row * DM + col0;
                float q = 0.f;
                u32x2 xw[2]; const float sxr = SX[row];
#pragma unroll
                for (int bj = 0; bj < 2; ++bj) xw[bj] = *(const u32x2*)(xr + bj * 128);
#pragma unroll
                for (int bj = 0; bj < 2; ++bj) {
                    const f32x4 x0 = (f32x4){(float)(signed char)(xw[bj].x), (float)(signed char)(xw[bj].x >> 8), (float)(signed char)(xw[bj].x >> 16), (float)((int)xw[bj].x >> 24)} * sxr,
                                x1 = (f32x4){(float)(signed char)(xw[bj].y), (float)(signed char)(xw[bj].y >> 8), (float)(signed char)(xw[bj].y >> 16), (float)((int)xw[bj].y >> 24)} * sxr;
                    const pg8::f32x4 v0 = acc[ai][bj][m][0] + x0, v1 = acc[ai][bj][m][1] + x1;
                    q += (v0[0] * v0[0] + v0[1] * v0[1]) + (v0[2] * v0[2] + v0[3] * v0[3]) + (v1[0] * v1[0] + v1[1] * v1[1]) + (v1[2] * v1[2] + v1[3] * v1[3]);
                    u32x4 w; w.x = cvt_pk_bf16(v0[0], v0[1]); w.y = cvt_pk_bf16(v0[2], v0[3]); w.z = cvt_pk_bf16(v1[0], v1[1]); w.w = cvt_pk_bf16(v1[2], v1[3]);
                    *(u32x4*)(rowp + bj * 128) = w; }
                q += __shfl_xor(q, 16); q += __shfl_xor(q, 32);
                if (fq == 0) ssq[(size_t)row * 16 + u.pn * 4 + wc] = q;
            }
    }
};

struct EpiResidualI8 {
    static constexpr bool PERM = true, AFTER_DRAIN = false;
    bf16* O; const signed char* XB; const float* SX; const float* SY; const float* SWO; float* ssq; float* amx;
    __device__ __forceinline__ void operator()(const pg8::i32x4 (&acc)[2][2][4][2], const pg8::Unit& u, int wr, int wc, int fr, int fq) const {
        const int row0 = u.pm * 256 + wr * 64 + fr, col0 = u.pn * 256 + wc * 32 + 8 * fq;
        f32x4 sw[2][2];
#pragma unroll
        for (int bj = 0; bj < 2; ++bj) { sw[bj][0] = *(const f32x4*)(SWO + col0 + bj * 128); sw[bj][1] = *(const f32x4*)(SWO + col0 + bj * 128 + 4); }
#pragma unroll
        for (int ai = 0; ai < 2; ++ai)
#pragma unroll
            for (int m = 0; m < 4; ++m) {
                const int row = row0 + ai * 128 + m * 16;
                const signed char* xr = XB + (size_t)row * DM + col0; bf16* rowp = O + (size_t)row * DM + col0;
                float q = 0.f, mxa = 0.f;
                u32x2 xw[2]; const float sxr = SX[row], syr = SY[row];
#pragma unroll
                for (int bj = 0; bj < 2; ++bj) xw[bj] = *(const u32x2*)(xr + bj * 128);
#pragma unroll
                for (int bj = 0; bj < 2; ++bj) {
                    const f32x4 x0 = (f32x4){(float)(signed char)(xw[bj].x), (float)(signed char)(xw[bj].x >> 8), (float)(signed char)(xw[bj].x >> 16), (float)((int)xw[bj].x >> 24)} * sxr,
                                x1 = (f32x4){(float)(signed char)(xw[bj].y), (float)(signed char)(xw[bj].y >> 8), (float)(signed char)(xw[bj].y >> 16), (float)((int)xw[bj].y >> 24)} * sxr;
                    const pg8::i32x4 a0 = acc[ai][bj][m][0], a1 = acc[ai][bj][m][1];
                    const f32x4 v0 = (f32x4){(float)a0[0], (float)a0[1], (float)a0[2], (float)a0[3]} * (sw[bj][0] * syr) + x0, v1 = (f32x4){(float)a1[0], (float)a1[1], (float)a1[2], (float)a1[3]} * (sw[bj][1] * syr) + x1;
                    q += (v0[0] * v0[0] + v0[1] * v0[1]) + (v0[2] * v0[2] + v0[3] * v0[3]) + (v1[0] * v1[0] + v1[1] * v1[1]) + (v1[2] * v1[2] + v1[3] * v1[3]);
                    mxa = fmaxf(mxa, fmaxf(fmaxf(fmaxf(fabsf(v0[0]), fabsf(v0[1])), fmaxf(fabsf(v0[2]), fabsf(v0[3]))), fmaxf(fmaxf(fabsf(v1[0]), fabsf(v1[1])), fmaxf(fabsf(v1[2]), fabsf(v1[3])))));
                    u32x4 w; w.x = cvt_pk_bf16(v0[0], v0[1]); w.y = cvt_pk_bf16(v0[2], v0[3]); w.z = cvt_pk_bf16(v1[0], v1[1]); w.w = cvt_pk_bf16(v1[2], v1[3]);
                    *(u32x4*)(rowp + bj * 128) = w; }
                q += __shfl_xor(q, 16); q += __shfl_xor(q, 32);
                mxa = fmaxf(mxa, __shfl_xor(mxa, 16)); mxa = fmaxf(mxa, __shfl_xor(mxa, 32));
                if (fq == 0) { ssq[(size_t)row * 16 + u.pn * 4 + wc] = q; amx[(size_t)row * 16 + u.pn * 4 + wc] = mxa; }
            }
    }
};
template <bool MAPIN> __device__ __forceinline__ void p0_transpose_item(const float* W, int K, int N, bf16* WT, LAS float* scr, int item, int lane,
                                                  const float* g_lo, const float* g_hi, int split) {
    const int nblk = N / 32, kb = item / nblk, nb = item % nblk, k0 = 64 * kb, n0 = 32 * nb;
#pragma unroll 8
    for (int i = 0; i < 32; ++i) { const int kk = 2 * i + (lane >> 5); const int k = k0 + kk;
        const float g = (k < split) ? g_lo[k] : g_hi[k - split];
        scr[kk * 33 + (lane & 31)] = W[(size_t)k * N + (MAPIN ? win_src_col(n0) : n0) + (lane & 31)] * g; }
    asm volatile("s_waitcnt lgkmcnt(0)" ::: "memory");
    const int c = lane & 7;
#pragma unroll
    for (int j = 0; j < 4; ++j) { const int n = (lane >> 3) + 8 * j; const LAS float* s = scr + (8 * c) * 33 + n;
        u32x4 o; o.x = pk2(s[0 * 33], s[1 * 33]); o.y = pk2(s[2 * 33], s[3 * 33]); o.z = pk2(s[4 * 33], s[5 * 33]); o.w = pk2(s[6 * 33], s[7 * 33]);
        *(u32x4*)(WT + (size_t)(n0 + n) * K + k0 + 8 * c) = o; }
    asm volatile("s_waitcnt lgkmcnt(0)" ::: "memory");
}

constexpr int CW_COLMAX = 5120;
__device__ __forceinline__ void p0_colmax_item(const float* W, int N, unsigned* colmax, int item, int lane, const float* g) {
    const int nblk = N / 32, kb = item / nblk, nb = item % nblk, k0 = 64 * kb, n0 = 32 * nb;
    float mx = 0.f;
#pragma unroll
    for (int i = 0; i < 32; ++i) { const int k = k0 + 2 * i + (lane >> 5); mx = fmaxf(mx, fabsf(W[(size_t)k * N + n0 + (lane & 31)] * g[k])); }
    mx = fmaxf(mx, __shfl_xor(mx, 32));
    if (lane < 32) atomicMax(colmax + n0 + lane, __float_as_uint(mx));
}
__device__ __forceinline__ void p1_quant_item(const float* W, int K, int N, signed char* WT8, float* swout, const unsigned* colmax, LAS float* scr, int item, int lane, const float* g) {
    const int nblk = N / 32, kb = item / nblk, nb = item % nblk, k0 = 64 * kb, n0 = 32 * nb, s0 = win_src_col(n0);
    const float cm = fmaxf(__uint_as_float(colmax[s0 + (lane & 31)]), 1e-30f), inv = 127.f / cm;
    if (kb == 0 && lane < 32) swout[n0 + lane] = cm * (1.f / 127.f);
#pragma unroll
    for (int i = 0; i < 32; ++i) { const int kk = 2 * i + (lane >> 5); const int k = k0 + kk;
        scr[kk * 33 + (lane & 31)] = W[(size_t)k * N + s0 + (lane & 31)] * g[k] * inv; }
    asm volatile("s_waitcnt lgkmcnt(0)" ::: "memory");
    const int c = lane & 7;
#pragma unroll
    for (int j = 0; j < 4; ++j) { const int n = (lane >> 3) + 8 * j; const LAS float* sp = scr + (8 * c) * 33 + n;
        unsigned w0 = 0u, w1 = 0u;
#pragma unroll
        for (int i = 0; i < 4; ++i) { w0 |= ((unsigned)(int)rintf(sp[i * 33]) & 255u) << (8 * i); w1 |= ((unsigned)(int)rintf(sp[(4 + i) * 33]) & 255u) << (8 * i); }
        u32x2 o; o.x = w0; o.y = w1;
        *(u32x2*)(WT8 + (size_t)(n0 + n) * K + k0 + 8 * c) = o; }
    asm volatile("s_waitcnt lgkmcnt(0)" ::: "memory");
}
constexpr int CW_COLMAX3 = 8704;
constexpr int CW_COLMAX2 = 7680;
__device__ __forceinline__ void p0_colmax_item2(const float* W, int N, unsigned* colmax, int item, int lane, const float* g_lo, const float* g_hi, int split) {
    const int nblk = N / 32, kb = item / nblk, nb = item % nblk, k0 = 64 * kb, n0 = 32 * nb;
    float mx = 0.f;
#pragma unroll
    for (int i = 0; i < 32; ++i) { const int k = k0 + 2 * i + (lane >> 5); const float g = (k < split) ? g_lo[k] : g_hi[k - split]; mx = fmaxf(mx, fabsf(W[(size_t)k * N + n0 + (lane & 31)] * g)); }
    mx = fmaxf(mx, __shfl_xor(mx, 32));
    if (lane < 32) atomicMax(colmax + n0 + lane, __float_as_uint(mx));
}
__device__ __forceinline__ void p1_quant_item2(const float* W, int K, int N, signed char* WT8, float* swout, const unsigned* colmax, LAS float* scr, int item, int lane, const float* g_lo, const float* g_hi, int split) {
    const int nblk = N / 32, kb = item / nblk, nb = item % nblk, k0 = 64 * kb, n0 = 32 * nb;
    const float cm = fmaxf(__uint_as_float(colmax[n0 + (lane & 31)]), 1e-30f), inv = 127.f / cm;
    if (kb == 0 && lane < 32) swout[n0 + lane] = cm * (1.f / 127.f);
#pragma unroll
    for (int i = 0; i < 32; ++i) { const int kk = 2 * i + (lane >> 5); const int k = k0 + kk; const float g = (k < split) ? g_lo[k] : g_hi[k - split];
        scr[kk * 33 + (lane & 31)] = W[(size_t)k * N + n0 + (lane & 31)] * g * inv; }
    asm volatile("s_waitcnt lgkmcnt(0)" ::: "memory");
    const int c = lane & 7;
#pragma unroll
    for (int j = 0; j < 4; ++j) { const int n = (lane >> 3) + 8 * j; const LAS float* sp = scr + (8 * c) * 33 + n;
        unsigned w0 = 0u, w1 = 0u;
#pragma unroll
        for (int i = 0; i < 4; ++i) { w0 |= ((unsigned)(int)rintf(sp[i * 33]) & 255u) << (8 * i); w1 |= ((unsigned)(int)rintf(sp[(4 + i) * 33]) & 255u) << (8 * i); }
        u32x2 o; o.x = w0; o.y = w1;
        *(u32x2*)(WT8 + (size_t)(n0 + n) * K + k0 + 8 * c) = o; }
    asm volatile("s_waitcnt lgkmcnt(0)" ::: "memory");
}
__device__ __forceinline__ void phase_winq(const Params& P, LAS unsigned char* lds) {
    const int tid = threadIdx.x, lane = tid & 63, wave = __builtin_amdgcn_readfirstlane(tid >> 6);
    const int gw = blockIdx.x * NWAVES + wave, NGW = gridDim.x * NWAVES;
    LAS float* scr = (LAS float*)(lds + wave * 16384);
    constexpr int NI1 = (DM / 64) * (DIN / 32), NI2 = (DM / 64) * (DM / 32), NI3 = (DM / 64) * (2048 / 32);
    for (int it = gw; it < NI1 + NI2 + NI3; it += NGW) {
        if (it < NI1) p1_quant_item(P.w_in, DM, DIN, (signed char*)(P.ws + WS_WIN_T), (float*)(P.ws + WS_SW), (const unsigned*)(P.ws + WS_CTL) + CW_COLMAX, scr, it, lane, P.g_mix);
        else if (it < NI1 + NI2) p1_quant_item2(P.w_out, DM, DM, (signed char*)(P.ws + WS_WOUT_T), (float*)(P.ws + WS_SWO), (const unsigned*)(P.ws + WS_CTL) + CW_COLMAX2, scr, it - NI1, lane, P.g_sc, P.g_cf, 512);
        else p1_quant_item2(P.w_q, DM, 2048, (signed char*)(P.ws + WS_WQ_T), (float*)(P.ws + WS_SWQ), (const unsigned*)(P.ws + WS_CTL) + CW_COLMAX3, scr, it - NI1 - NI2, lane, P.g_ffn, P.g_ffn, DM);
    }
}
__device__ __forceinline__ float q4(float x, float inv_s) {
    const float a = fabsf(x) * inv_s; float r;
    if (a < 2.f) r = rintf(a * 2.f) * 0.5f; else if (a < 4.f) r = rintf(a); else r = fminf(6.f, rintf(a * 0.5f) * 2.f);
    return copysignf(r, x);
}
__device__ __forceinline__ void phase_prep(const Params& P, LAS unsigned char* lds) {
    const int tid = threadIdx.x, lane = tid & 63, wave = __builtin_amdgcn_readfirstlane(tid >> 6);
    const int gw = blockIdx.x * NWAVES + wave, NGW = gridDim.x * NWAVES;
    unsigned char* ws = P.ws;
    LAS float* scr = (LAS float*)(lds + wave * 16384);
    constexpr int I_IN = (DM / 64) * (DIN / 32), I_OUT = (DM / 64) * (DM / 32), I_Q = (DM / 64) * (2048 / 32);
    for (int it = gw; it < I_IN + I_OUT + I_Q; it += NGW) {
        int r = it;
        if (r < I_IN) { p0_colmax_item(P.w_in, DIN, (unsigned*)(ws + WS_CTL) + CW_COLMAX, r, lane, P.g_mix); continue; } r -= I_IN;
        if (r < I_OUT) { p0_colmax_item2(P.w_out, DM, (unsigned*)(ws + WS_CTL) + CW_COLMAX2, r, lane, P.g_sc, P.g_cf, 512); continue; } r -= I_OUT;
        p0_colmax_item2(P.w_q, 2048, (unsigned*)(ws + WS_CTL) + CW_COLMAX3, r, lane, P.g_ffn, P.g_ffn, DM);
    }
    {
        unsigned* H0I8 = (unsigned*)(ws + WS_H0I8); float* RS1 = (float*)(ws + WS_RSTD1); float* SXp = (float*)(ws + WS_SX);
        for (int t0 = gw * 4; t0 < NTOK; t0 += NGW * 4) {
            f32x4 v[4][4];
#pragma unroll
            for (int q = 0; q < 4; ++q) { const f32x4* xr = (const f32x4*)(P.x + (size_t)(t0 + q) * DM) + lane;
#pragma unroll
                for (int j = 0; j < 4; ++j) v[q][j] = xr[64 * j]; }
#pragma unroll
            for (int q = 0; q < 4; ++q) { float sq = 0.f, mx = 0.f;
#pragma unroll
                for (int j = 0; j < 4; ++j) { sq += (v[q][j].x * v[q][j].x + v[q][j].y * v[q][j].y) + (v[q][j].z * v[q][j].z + v[q][j].w * v[q][j].w);
                    mx = fmaxf(mx, fmaxf(fmaxf(fabsf(v[q][j].x), fabsf(v[q][j].y)), fmaxf(fabsf(v[q][j].z), fabsf(v[q][j].w)))); }
                sq = wave_sum_fast(sq); mx = fmaxf(wave_max_fast(mx), 1e-30f);
                const float sx = mx * (1.f / 127.f), inv = 127.f / mx;
                if (lane == 0) { RS1[t0 + q] = sx * rsqrtf(sq * (1.f / DM) + EPS); SXp[t0 + q] = sx; }
                unsigned* o = H0I8 + (size_t)(t0 + q) * (DM / 4) + lane;
#pragma unroll
                for (int j = 0; j < 4; ++j) { const int a = (int)rintf(v[q][j].x * inv), b = (int)rintf(v[q][j].y * inv), c = (int)rintf(v[q][j].z * inv), d = (int)rintf(v[q][j].w * inv);
                    o[64 * j] = ((unsigned)a & 255u) | (((unsigned)b & 255u) << 8) | (((unsigned)c & 255u) << 16) | ((unsigned)d << 24); } }
        }
    }
    {
        unsigned char* U8 = ws + WS_U8; unsigned char* V8 = ws + WS_V8;
        f32x4 gf[4];
#pragma unroll
        for (int j = 0; j < 4; ++j) gf[j] = ((const f32x4*)P.g_ffn)[64 * j + lane];
        float* ESC = (float*)(ws + WS_ESCALE);
        for (int e0 = gw * 2; e0 < 2 * 16384; e0 += NGW * 2) {
            const bool isv = e0 >= 16384; const int ee0 = isv ? e0 - 16384 : e0;
            f32x4 v[2][4];
#pragma unroll
            for (int q = 0; q < 2; ++q) { const f32x4* src = (const f32x4*)((isv ? P.pv : P.pu) + (size_t)(ee0 + q) * DM);
#pragma unroll
                for (int j = 0; j < 4; ++j) v[q][j] = isv ? src[4 * lane + j] : src[64 * j + lane]; }
#pragma unroll
            for (int q = 0; q < 2; ++q) {
                float mx = 0.f;
#pragma unroll
                for (int j = 0; j < 4; ++j) { if (!isv) v[q][j] = v[q][j] * gf[j];
                    mx = fmaxf(mx, fmaxf(fmaxf(fabsf(v[q][j].x), fabsf(v[q][j].y)), fmaxf(fabsf(v[q][j].z), fabsf(v[q][j].w)))); }
#pragma unroll
                for (int o = 1; o < 64; o <<= 1) mx = fmaxf(mx, __shfl_xor(mx, o));
                if (!isv) {
                    float sq2 = 0.f;
#pragma unroll
                    for (int j = 0; j < 4; ++j) sq2 += (v[q][j].x * v[q][j].x + v[q][j].y * v[q][j].y) + (v[q][j].z * v[q][j].z + v[q][j].w * v[q][j].w);
                    const float rms = sqrtf(wave_sum_fast(sq2) * (1.f / DM));
                    const float su = fmaxf(fminf(mx, U4_CLIP * rms), 1e-30f) * (1.f / 7.f), inv = 1.f / su;
                    unsigned wq[2] = {0u, 0u}; int csum = 0;
#pragma unroll
                    for (int j = 0; j < 4; ++j) { const float e4[4] = {v[q][j].x, v[q][j].y, v[q][j].z, v[q][j].w};
#pragma unroll
                        for (int i = 0; i < 4; ++i) { int c = (int)rintf(fminf(fmaxf(e4[i] * inv, -7.f), 7.f)); csum += c;
                            wq[j >> 1] |= ((unsigned)c & 15u) << (16 * (j & 1) + 4 * i); } }
                    const float cs = wave_sum_fast((float)csum);
                    if (lane == 0) { ESC[e0 + q] = su; ((float*)(ws + WS_SUMQ))[e0 + q] = cs; }
                    u32x2 o; o.x = wq[0]; o.y = wq[1];
                    *(u32x2*)(U8 + (size_t)(ee0 + q) * 512 + 8 * lane) = o;
                    continue;
                }
                const float sc = fmaxf(mx, 1e-30f) * (1.f / 6.f), inv = 1.f / sc;
                if (lane == 0) ESC[e0 + q] = sc;
                unsigned w0 = 0u, w1 = 0u;
                w0 = __builtin_amdgcn_cvt_scalef32_pk_fp4_f32(w0, v[q][0].x * inv, v[q][0].y * inv, 1.0f, 0); w0 = __builtin_amdgcn_cvt_scalef32_pk_fp4_f32(w0, v[q][0].z * inv, v[q][0].w * inv, 1.0f, 1);
                w0 = __builtin_amdgcn_cvt_scalef32_pk_fp4_f32(w0, v[q][1].x * inv, v[q][1].y * inv, 1.0f, 2); w0 = __builtin_amdgcn_cvt_scalef32_pk_fp4_f32(w0, v[q][1].z * inv, v[q][1].w * inv, 1.0f, 3);
                w1 = __builtin_amdgcn_cvt_scalef32_pk_fp4_f32(w1, v[q][2].x * inv, v[q][2].y * inv, 1.0f, 0); w1 = __builtin_amdgcn_cvt_scalef32_pk_fp4_f32(w1, v[q][2].z * inv, v[q][2].w * inv, 1.0f, 1);
                w1 = __builtin_amdgcn_cvt_scalef32_pk_fp4_f32(w1, v[q][3].x * inv, v[q][3].y * inv, 1.0f, 2); w1 = __builtin_amdgcn_cvt_scalef32_pk_fp4_f32(w1, v[q][3].z * inv, v[q][3].w * inv, 1.0f, 3);
                u32x2 o; o.x = w0; o.y = w1;
                *(u32x2*)((isv ? V8 : U8) + (size_t)(ee0 + q) * 512 + 8 * lane) = o;
            }
        }
    }
    {
        bf16* KB = (bf16*)(ws + WS_KEYS);
        const int gt = blockIdx.x * NTHREADS + tid, NGT = gridDim.x * NTHREADS;
        for (int i = gt; i < 8 * 2 * 128 * 128 / 4; i += NGT) { const f32x4 v = ((const f32x4*)P.keys)[i]; u32x2 w; w.x = pk2(v.x, v.y); w.y = pk2(v.z, v.w); ((u32x2*)KB)[i] = w; }
    }
    {
        float* MP = (float*)(ws + WS_METAPART); float* MR = (float*)(ws + WS_METARSTD);
        for (int r = gw; r < NMETA; r += NGW) {
            float s = 0.f;
            for (int k = lane; k < DM; k += 64) { const float v = P.meta[r * DM + k]; s += v * v; }
            s = wave_sum(s);
            if (lane == 0) MR[r] = rsqrtf(s * (1.f / DM) + EPS);
        }
        for (int it = gw; it < MKC * 40; it += NGW) {
            const int kc = it / 40, nb = it % 40, n = nb * 64 + lane;
            float acc[NMETA];
#pragma unroll
            for (int r = 0; r < NMETA; ++r) acc[r] = 0.f;
            for (int k = kc * (DM / MKC); k < (kc + 1) * (DM / MKC); ++k) {
                const float w = P.w_in[(size_t)k * DIN + n] * P.g_mix[k];
#pragma unroll
                for (int r = 0; r < NMETA; ++r) acc[r] += P.meta[r * DM + k] * w;
            }
#pragma unroll
            for (int r = 0; r < NMETA; ++r) MP[(size_t)(kc * 16 + r) * DIN + n] = acc[r];
        }
    }
}

__device__ __forceinline__ float metaraw(const float* MP, const float* MR, int p, int col) { float s = 0.f;
#pragma unroll 8
    for (int kc = 0; kc < MKC; ++kc) s += MP[(size_t)(kc * 16 + p) * DIN + col];
    return s * MR[p]; }
__device__ __forceinline__ void phase_metaproj(const Params& P) {
    const float* MP = (const float*)(P.ws + WS_METAPART); const float* MR = (const float*)(P.ws + WS_METARSTD); float* MJ = (float*)(P.ws + WS_METAPROJ);
    for (int gt = blockIdx.x * NTHREADS + threadIdx.x; gt < NMETA * PDIM; gt += gridDim.x * NTHREADS) { const int p = gt / PDIM, c = gt % PDIM; float v;
        if (c < 512) v = metaraw(MP, MR, p, c) * metaraw(MP, MR, p, 1024 + c);
        else if (c < 1024) v = metaraw(MP, MR, p, c);
        else v = metaraw(MP, MR, p, 1536 + (c - 1024)) * sigmoid_f(metaraw(MP, MR, p, 2048 + (c - 1024)));
        MJ[gt] = v; }
}
__device__ __forceinline__ float meta_val(const float* MJ, const float*, int p, int col) { return MJ[p * PDIM + col]; }
__device__ __forceinline__ float proj_at(const bf16* PROJ, const float* MP, const float* MR, int b, int pos, int col) {
    if (pos < 0) return 0.f;
    if (pos < NMETA) return meta_val(MP, MR, pos, col);
    return bf2f(PROJ[(size_t)(b * SEQ + pos - NMETA) * PDIM + col]);
}
__device__ __forceinline__ void proj8_at(const bf16* PROJ, const float* MP, const float* MR, int b, int pos, int col, float (&v)[8]) {
    if (pos < 0) {
#pragma unroll
        for (int i = 0; i < 8; ++i) v[i] = 0.f;
    } else if (pos < NMETA) {
        const f32x4 a = *(const f32x4*)(MP + pos * PDIM + col), bq = *(const f32x4*)(MP + pos * PDIM + col + 4);
        v[0] = a.x; v[1] = a.y; v[2] = a.z; v[3] = a.w; v[4] = bq.x; v[5] = bq.y; v[6] = bq.z; v[7] = bq.w;
    } else {
        const u32x4 w = *(const u32x4*)(PROJ + (size_t)(b * SEQ + pos - NMETA) * PDIM + col);
        v[0] = bflo(w.x); v[1] = bfhi(w.x); v[2] = bflo(w.y); v[3] = bfhi(w.y); v[4] = bflo(w.z); v[5] = bfhi(w.z); v[6] = bflo(w.w); v[7] = bfhi(w.w);
    }
}

template <int R> __device__ __forceinline__ void conv_rows(const LAS unsigned char* ubase, const f32x2 (&wcf)[31], f32x2 (&acc)[32]) {
    if constexpr (R < 62) {
        const unsigned uw = *(const LAS unsigned*)(ubase + R * 1024);
        const f32x2 x = (f32x2){bflo(uw), bfhi(uw)};
        constexpr int lo = R > 30 ? R - 30 : 0, hi = R < 31 ? R : 31;
#pragma unroll
        for (int ii = lo; ii <= hi; ++ii) acc[ii] += wcf[R - ii] * x;
        conv_rows<R + 1>(ubase, wcf, acc);
    }
}
__device__ __forceinline__ void phase_conv(const Params& P, LAS unsigned char* lds) {
    const int tid = threadIdx.x, lane = tid & 63, wave = __builtin_amdgcn_readfirstlane(tid >> 6);
    unsigned char* ws = P.ws;
    const bf16* PROJ = (const bf16*)(ws + WS_PROJ); const float* MP = (const float*)(ws + WS_METAPROJ); const float* MR = nullptr;
    bf16* Y = (bf16*)(ws + WS_Y);
    constexpr int TT = 64, NTILE = NTOK / TT, UROWS = TT + 30;
    const int cgp = wave & 3, th = wave >> 2, ch2 = cgp * 128 + 2 * lane;
    f32x2 wcf[31];
#pragma unroll
    for (int j = 0; j < 31; ++j) wcf[j] = *(const f32x2*)(P.cf_w + j * 512 + ch2);
    const f32x2 bcf = *(const f32x2*)(P.cf_b + ch2);
    for (int tile = blockIdx.x; tile < NTILE; tile += gridDim.x) {
        const int b = tile / (SEQ / TT), s0 = (tile % (SEQ / TT)) * TT;
#pragma unroll 4
        for (int p = 0; p < (UROWS + 7) / 8; ++p) {
            const int r = p * 8 + wave;
            if (r < UROWS) {
                const int pos = NMETA + s0 - 30 + r;
                float uu[8];
                proj8_at(PROJ, MP, MR, b, pos, 1024 + 8 * lane, uu);
                u32x4 w; w.x = pk2(uu[0], uu[1]); w.y = pk2(uu[2], uu[3]); w.z = pk2(uu[4], uu[5]); w.w = pk2(uu[6], uu[7]);
                *(LAS u32x4*)(lds + r * 1024 + lane * 16) = w;
            }
        }
        __syncthreads();
        f32x2 acc[32];
#pragma unroll
        for (int ii = 0; ii < 32; ++ii) acc[ii] = bcf;
        conv_rows<0>(lds + (32 * th) * 1024 + ch2 * 2, wcf, acc);
        u32x4 rcx[8], rbg[8];
        { const bf16* pr = PROJ + ((size_t)b * SEQ + s0 + 8 * wave) * PDIM + 8 * lane;
#pragma unroll
          for (int q = 0; q < 8; ++q) { rcx[q] = *(const u32x4*)(pr + (size_t)q * PDIM); rbg[q] = *(const u32x4*)(pr + (size_t)q * PDIM + 512); } }
        __syncthreads();
#pragma unroll
        for (int ii = 0; ii < 32; ++ii) *(LAS f32x2*)(lds + (32 * th + ii) * 2048 + ch2 * 4) = acc[ii];
        __syncthreads();
        {
            float lng[8], lnb[8];
            { const f32x4 a = *(const f32x4*)(P.ln_g + 8 * lane), c = *(const f32x4*)(P.ln_g + 8 * lane + 4), d = *(const f32x4*)(P.ln_b + 8 * lane), e = *(const f32x4*)(P.ln_b + 8 * lane + 4);
              lng[0] = a.x; lng[1] = a.y; lng[2] = a.z; lng[3] = a.w; lng[4] = c.x; lng[5] = c.y; lng[6] = c.z; lng[7] = c.w;
              lnb[0] = d.x; lnb[1] = d.y; lnb[2] = d.z; lnb[3] = d.w; lnb[4] = e.x; lnb[5] = e.y; lnb[6] = e.z; lnb[7] = e.w; }
            float wsc[3][8];
#pragma unroll
            for (int j = 0; j < 3; ++j) { const f32x4 a = *(const f32x4*)(P.sc_w + j * 512 + 8 * lane), c = *(const f32x4*)(P.sc_w + j * 512 + 8 * lane + 4);
                wsc[j][0] = a.x; wsc[j][1] = a.y; wsc[j][2] = a.z; wsc[j][3] = a.w; wsc[j][4] = c.x; wsc[j][5] = c.y; wsc[j][6] = c.z; wsc[j][7] = c.w; }
            float cxa[8], cxb[8];
            { const int pos = NMETA + s0 + 8 * wave - 2;
              proj8_at(PROJ, MP, MR, b, pos, 8 * lane, cxa); proj8_at(PROJ, MP, MR, b, pos + 1, 8 * lane, cxb); }
#pragma unroll
            for (int q = 0; q < 8; ++q) {
                const int ii = 8 * wave + q, s = s0 + ii; const size_t t = (size_t)b * SEQ + s;
                float o[8];
                { const f32x4 a = *(const LAS f32x4*)(lds + ii * 2048 + lane * 32), c = *(const LAS f32x4*)(lds + ii * 2048 + lane * 32 + 16);
                  o[0] = a.x; o[1] = a.y; o[2] = a.z; o[3] = a.w; o[4] = c.x; o[5] = c.y; o[6] = c.z; o[7] = c.w; }
                float s1 = 0.f;
#pragma unroll
                for (int i = 0; i < 8; ++i) s1 += o[i];
                const float mean = wave_sum_fast(s1) * (1.f / 512.f);
                float s2 = 0.f;
#pragma unroll
                for (int i = 0; i < 8; ++i) { o[i] -= mean; s2 += o[i] * o[i]; }
                const float rs = rsqrtf(wave_sum_fast(s2) * (1.f / 512.f) + EPS);
                float s3 = 0.f;
#pragma unroll
                for (int i = 0; i < 8; ++i) { float y = o[i] * rs * lng[i] + lnb[i]; y = y * sigmoid_f(y); o[i] = y; s3 += y * y; }
                const float r2 = rsqrtf(wave_sum_fast(s3) * (1.f / 512.f) + EPS);
                float bgv[8], cxc[8], accs[8];
                { const u32x4 w = rcx[q], z = rbg[q];
                  cxc[0] = bflo(w.x); cxc[1] = bfhi(w.x); cxc[2] = bflo(w.y); cxc[3] = bfhi(w.y); cxc[4] = bflo(w.z); cxc[5] = bfhi(w.z); cxc[6] = bflo(w.w); cxc[7] = bfhi(w.w);
                  bgv[0] = bflo(z.x); bgv[1] = bfhi(z.x); bgv[2] = bflo(z.y); bgv[3] = bfhi(z.y); bgv[4] = bflo(z.z); bgv[5] = bfhi(z.z); bgv[6] = bflo(z.w); bgv[7] = bfhi(z.w); }
                float s4 = 0.f;
#pragma unroll
                for (int i = 0; i < 8; ++i) { accs[i] = bgv[i] * (wsc[0][i] * cxa[i] + wsc[1][i] * cxb[i] + wsc[2][i] * cxc[i]); s4 += accs[i] * accs[i]; cxa[i] = cxb[i]; cxb[i] = cxc[i]; }
                const float r4 = rsqrtf(wave_sum_fast(s4) * (1.f / 512.f) + EPS);
                float ym = 0.f;
#pragma unroll
                for (int i = 0; i < 8; ++i) { o[i] *= r2; accs[i] *= r4; ym = fmaxf(ym, fmaxf(fabsf(o[i]), fabsf(accs[i]))); }
                ym = fmaxf(wave_max_fast(ym), 1e-30f);
                const float yinv = 127.f / ym;
                if (lane == 0) ((float*)(ws + WS_SY))[t] = ym * (1.f / 127.f);
                u32x2 wz, wv;
                wz.x = ((unsigned)(int)rintf(accs[0] * yinv) & 255u) | (((unsigned)(int)rintf(accs[1] * yinv) & 255u) << 8) | (((unsigned)(int)rintf(accs[2] * yinv) & 255u) << 16) | ((unsigned)(int)rintf(accs[3] * yinv) << 24);
                wz.y = ((unsigned)(int)rintf(accs[4] * yinv) & 255u) | (((unsigned)(int)rintf(accs[5] * yinv) & 255u) << 8) | (((unsigned)(int)rintf(accs[6] * yinv) & 255u) << 16) | ((unsigned)(int)rintf(accs[7] * yinv) << 24);
                wv.x = ((unsigned)(int)rintf(o[0] * yinv) & 255u) | (((unsigned)(int)rintf(o[1] * yinv) & 255u) << 8) | (((unsigned)(int)rintf(o[2] * yinv) & 255u) << 16) | ((unsigned)(int)rintf(o[3] * yinv) << 24);
                wv.y = ((unsigned)(int)rintf(o[4] * yinv) & 255u) | (((unsigned)(int)rintf(o[5] * yinv) & 255u) << 8) | (((unsigned)(int)rintf(o[6] * yinv) & 255u) << 16) | ((unsigned)(int)rintf(o[7] * yinv) << 24);
                *(u32x2*)(ws + WS_Y + t * DM + 8 * lane) = wz;
                *(u32x2*)(ws + WS_Y + t * DM + 512 + 8 * lane) = wv;
            }
        }
        __syncthreads();
    }
}

__device__ __forceinline__ int ord_i(float s) { int k = __builtin_bit_cast(int, s); k ^= (k >> 31) & 0x7fffffff; return k; }
__device__ __forceinline__ float unord_f(int k) { k ^= (k >> 31) & 0x7fffffff; return __builtin_bit_cast(float, k); }
#define TOP_INSERT(L, x_) do { int _x = (x_); _Pragma("unroll") for (int _i = 0; _i < 16; ++_i) { const int _hi = max(L[_i], _x); _x = min(L[_i], _x); L[_i] = _hi; } } while (0)

typedef short bf16x8 __attribute__((ext_vector_type(8)));
typedef float f32x16 __attribute__((ext_vector_type(16)));
template <bool DESC> __device__ __forceinline__ void ce_i(int& a, int& b) { const int hi = max(a, b), lo = min(a, b); if (DESC) { a = hi; b = lo; } else { a = lo; b = hi; } }
__device__ __forceinline__ void bitonic_sort16(int (&a)[16]) {
#pragma unroll
    for (int k = 2; k <= 16; k <<= 1)
#pragma unroll
        for (int j = k >> 1; j > 0; j >>= 1)
#pragma unroll
            for (int i = 0; i < 16; ++i) { const int l = i ^ j; if (l > i) { if ((i & k) == 0) ce_i<true>(a[i], a[l]); else ce_i<false>(a[i], a[l]); } }
}
__device__ __forceinline__ void bitonic_merge16(int (&a)[16]) {
#pragma unroll
    for (int j = 8; j > 0; j >>= 1)
#pragma unroll
        for (int i = 0; i < 16; ++i) { const int l = i ^ j; if (l > i) ce_i<true>(a[i], a[l]); }
}
__device__ __forceinline__ void merge_top16(int (&a)[16], const int (&b)[16]) {
#pragma unroll
    for (int i = 0; i < 16; ++i) a[i] = max(a[i], b[15 - i]);
    bitonic_merge16(a);
}
__device__ __forceinline__ int lut16(const unsigned (&T)[4], int i) {
    const unsigned sel = (unsigned)(i & 7) | 0x0c0c0c00u;
    const unsigned lo = __builtin_amdgcn_perm(T[1], T[0], sel), hi = __builtin_amdgcn_perm(T[3], T[2], sel);
    return (int)((i & 8) ? hi : lo);
}
constexpr int KROW = 272;
constexpr float SCORE_BIAS = 8.0f;

__device__ __forceinline__ void route_load_q(bf16x8 (&qf)[8], const bf16* qrow, int hb) {
#pragma unroll
    for (int ks = 0; ks < 8; ++ks) qf[ks] = *(const bf16x8*)(qrow + 64 * hb + 8 * ks);
}
__device__ __forceinline__ void route_half(const LAS unsigned char* kl, const bf16x8 (&qf)[8], int nl, int hb, int (&L)[16]) {
    f32x16 acc[4];
#pragma unroll
    for (int nt = 0; nt < 4; ++nt)
#pragma unroll
        for (int r = 0; r < 16; ++r) acc[nt][r] = SCORE_BIAS;
#pragma unroll
    for (int ks = 0; ks < 8; ++ks)
#pragma unroll
        for (int nt = 0; nt < 4; ++nt) {
            const bf16x8 a = *(const LAS bf16x8*)(kl + (32 * nt + nl) * KROW + (64 * hb + 8 * ks) * 2);
            acc[nt] = __builtin_amdgcn_mfma_f32_32x32x16_bf16(a, qf[ks], acc[nt], 0, 0, 0);
        }
    const int hb4 = 4 * hb;
    int T[4][16];
#pragma unroll
    for (int nt = 0; nt < 4; ++nt)
#pragma unroll
        for (int r = 0; r < 16; ++r) { const int n0 = 32 * nt + (r & 3) + 8 * (r >> 2); const float sc = acc[nt][r];
            T[nt][r] = (__float_as_int(sc) & ~127) | ((127 - n0) - hb4); }
    bitonic_sort16(T[0]); bitonic_sort16(T[1]); bitonic_sort16(T[2]); bitonic_sort16(T[3]);
    merge_top16(T[0], T[1]); merge_top16(T[2], T[3]); merge_top16(T[0], T[2]);
#pragma unroll
    for (int i = 0; i < 16; ++i) { const unsigned v = (unsigned)T[0][15 - i]; auto r = __builtin_amdgcn_permlane32_swap(v, v, false, false);
        const unsigned r0 = r[0], r1 = r[1]; const int partner = (int)(hb ? r0 : r1); L[i] = max(T[0][i], partner); }
    bitonic_merge16(L);
}

__device__ __forceinline__ void phase_route(const Params& P, LAS unsigned char* lds) {
    const int tid = threadIdx.x, lane = tid & 63, wave = __builtin_amdgcn_readfirstlane(tid >> 6);
    const int nl = lane & 31, hb = lane >> 5;
    unsigned char* ws = P.ws;
    const bf16* KEYS = (const bf16*)(ws + WS_KEYS); const bf16* Q = (const bf16*)(ws + WS_Q);
    int* IDX = (int*)(ws + WS_IDX); float* GATE = (float*)(ws + WS_GATE);
    int last_h = -1;
    pg8::StaticOrder S; S.init(NTOK, 2048, (int)gridDim.x, (int)blockIdx.x);
    pg8::Unit ucur, unxt;
    bool have = S.next(0, ucur);
    bf16x8 qfA[8], qfB[8];
    if (have) route_load_q(qfA, Q + ((size_t)ucur.pm * 256 + wave * 32 + nl) * 2048 + ucur.pn * 256, hb);
    for (int ui = 0; have; ++ui) {
        const int h = ucur.pn, tb = ucur.pm;
        const bool have_next = S.next(ui + 1, unxt);
        if (h != last_h) {
            __syncthreads();
            for (int c = tid; c < 4096; c += NTHREADS) { const u32x4 v = ((const u32x4*)(KEYS + (size_t)h * 32768))[c];
                *(LAS u32x4*)(lds + (c >> 4) * KROW + (c & 15) * 16) = v; }
            __syncthreads();
            last_h = h;
        }
        const size_t t = (size_t)tb * 256 + wave * 32 + nl;
        int L1[16], L2[16];
        route_load_q(qfB, Q + t * 2048 + h * 256 + 128, hb);
        route_half(lds, qfA, nl, hb, L1);
        if (have_next) route_load_q(qfA, Q + ((size_t)unxt.pm * 256 + wave * 32 + nl) * 2048 + unxt.pn * 256, hb);
        route_half(lds + 128 * KROW, qfB, nl, hb, L2);
        float v1[16], v2[16];
#pragma unroll
        for (int i = 0; i < 16; ++i) { v1[i] = __int_as_float(L1[i] & ~127); v2[i] = __int_as_float(L2[i] & ~127); }
#define CAND(i, j) ((__float_as_int(v1[i] + v2[j]) & ~255) | (255 - (16 * (i) + (j))))
        int A[16], B[16], C[16];
#pragma unroll
        for (int j = 0; j < 16; ++j) A[j] = CAND(0, j);
#pragma unroll
        for (int j = 0; j < 8; ++j) { B[j] = CAND(1, j); B[8 + j] = CAND(15 - j, 0); }
        bitonic_merge16(B);
        C[0] = CAND(2, 0); C[1] = CAND(2, 1); C[2] = CAND(2, 2); C[3] = CAND(2, 3); C[4] = CAND(2, 4);
        C[5] = CAND(3, 0); C[6] = CAND(3, 1); C[7] = CAND(3, 2); C[8] = CAND(3, 3);
        C[9] = CAND(4, 0); C[10] = CAND(4, 1); C[11] = CAND(4, 2);
        C[12] = CAND(5, 0); C[13] = CAND(5, 1); C[14] = CAND(6, 0); C[15] = CAND(6, 1);
        bitonic_sort16(C);
        { const int d0 = CAND(7, 0), d1 = CAND(7, 1); C[14] = max(C[14], d1); C[15] = max(C[15], d0); bitonic_merge16(C); }
#undef CAND
        merge_top16(A, B); merge_top16(A, C);
        unsigned T1[4], T2[4];
#pragma unroll
        for (int q = 0; q < 4; ++q) {
            T1[q] = (unsigned)(127 - (L1[4 * q] & 127)) | ((unsigned)(127 - (L1[4 * q + 1] & 127)) << 8) | ((unsigned)(127 - (L1[4 * q + 2] & 127)) << 16) | ((unsigned)(127 - (L1[4 * q + 3] & 127)) << 24);
            T2[q] = (unsigned)(127 - (L2[4 * q] & 127)) | ((unsigned)(127 - (L2[4 * q + 1] & 127)) << 8) | ((unsigned)(127 - (L2[4 * q + 2] & 127)) << 16) | ((unsigned)(127 - (L2[4 * q + 3] & 127)) << 24); }
        float val[16]; int ex[16];
#pragma unroll
        for (int k = 0; k < 16; ++k) { const int pos = 255 - (A[k] & 255); val[k] = __int_as_float(A[k] & ~255);
            ex[k] = lut16(T1, pos >> 4) * NKEYS + lut16(T2, pos & 15); }
        float sum = 0.f; const float vmax = val[0];
#pragma unroll
        for (int k = 0; k < 16; ++k) { val[k] = __expf(val[k] - vmax); sum += val[k]; }
        const float inv = 1.f / sum;
        if (hb == 0) {
            int* ip = IDX + t * NSEL + h * TOPK; float* gp = GATE + t * NSEL + h * TOPK;
#pragma unroll
            for (int k4 = 0; k4 < 4; ++k4) {
                *(int4*)(ip + 4 * k4) = make_int4(ex[4 * k4], ex[4 * k4 + 1], ex[4 * k4 + 2], ex[4 * k4 + 3]);
                *(f32x4*)(gp + 4 * k4) = (f32x4){val[4 * k4] * inv, val[4 * k4 + 1] * inv, val[4 * k4 + 2] * inv, val[4 * k4 + 3] * inv};
            }
        }
        ucur = unxt; have = have_next;
    }
}

#define FP4X2(w, sel) __builtin_amdgcn_cvt_scalef32_pk_f32_fp4((w), 1.0f, (sel))
__device__ __forceinline__ float dot16_fp4(const u32x2 r, const f32x4 (&xs)[4]) {
    float p = 0.f;
    { const f32x2 a = FP4X2(r.x, 0), b = FP4X2(r.x, 1), c = FP4X2(r.x, 2), d = FP4X2(r.x, 3);
      p += (a.x * xs[0].x + a.y * xs[0].y) + (b.x * xs[0].z + b.y * xs[0].w); p += (c.x * xs[1].x + c.y * xs[1].y) + (d.x * xs[1].z + d.y * xs[1].w); }
    { const f32x2 a = FP4X2(r.y, 0), b = FP4X2(r.y, 1), c = FP4X2(r.y, 2), d = FP4X2(r.y, 3);
      p += (a.x * xs[2].x + a.y * xs[2].y) + (b.x * xs[2].z + b.y * xs[2].w); p += (c.x * xs[3].x + c.y * xs[3].y) + (d.x * xs[3].z + d.y * xs[3].w); }
    return p;
}
__device__ __forceinline__ void axpy16_fp4(const u32x2 r, float w, f32x4 (&o)[4]) {
    { const f32x2 a = FP4X2(r.x, 0), b = FP4X2(r.x, 1), c = FP4X2(r.x, 2), d = FP4X2(r.x, 3);
      o[0].x += w * a.x; o[0].y += w * a.y; o[0].z += w * b.x; o[0].w += w * b.y; o[1].x += w * c.x; o[1].y += w * c.y; o[1].z += w * d.x; o[1].w += w * d.y; }
    { const f32x2 a = FP4X2(r.y, 0), b = FP4X2(r.y, 1), c = FP4X2(r.y, 2), d = FP4X2(r.y, 3);
      o[2].x += w * a.x; o[2].y += w * a.y; o[2].z += w * b.x; o[2].w += w * b.y; o[3].x += w * c.x; o[3].y += w * c.y; o[3].z += w * d.x; o[3].w += w * d.y; }
}
__device__ __forceinline__ float swap32_add(float a, float b) { auto r = __builtin_amdgcn_permlane32_swap(__float_as_uint(a), __float_as_uint(b), false, false); return __uint_as_float(r[0]) + __uint_as_float(r[1]); }
__device__ __forceinline__ float swap16_add(float a, float b) { auto r = __builtin_amdgcn_permlane16_swap(__float_as_uint(a), __float_as_uint(b), false, false); return __uint_as_float(r[0]) + __uint_as_float(r[1]); }
__device__ __forceinline__ float row_sum16(float v) { v += dpp_f<0xB1>(v); v += dpp_f<0x4E>(v); v += dpp_f<0x141>(v); v += dpp_f<0x140>(v); return v; }
__device__ __forceinline__ float row_max16(float v) { v = fmaxf(v, dpp_f<0xB1>(v)); v = fmaxf(v, dpp_f<0x4E>(v)); v = fmaxf(v, dpp_f<0x141>(v)); v = fmaxf(v, dpp_f<0x140>(v)); return v; }
constexpr int GB = 32;
typedef __attribute__((address_space(8))) void* rsrc_t;
__device__ __forceinline__ void g_issue(u32x2 (&buf)[GB], __amdgpu_buffer_rsrc_t rs, int idxr, int lb, int voff) {
#pragma unroll
    for (int j = 0; j < GB; ++j) { const int e = __builtin_amdgcn_readlane(idxr, lb + j); buf[j] = __builtin_amdgcn_raw_buffer_load_b64(rs, voff, e * 512, 0); }
}
__device__ __forceinline__ float dot16_fp4p(const u32x2 r, const f32x2 (&xp)[8]) {
    f32x2 a = FP4X2(r.x, 0) * xp[0];
    a += FP4X2(r.x, 1) * xp[1]; a += FP4X2(r.x, 2) * xp[2]; a += FP4X2(r.x, 3) * xp[3];
    a += FP4X2(r.y, 0) * xp[4]; a += FP4X2(r.y, 1) * xp[5]; a += FP4X2(r.y, 2) * xp[6]; a += FP4X2(r.y, 3) * xp[7];
    return a.x + a.y;
}
__device__ __forceinline__ void axpy16_fp4p(const u32x2 r, float w, f32x2 (&o)[8]) {
    const f32x2 ww = (f32x2){w, w};
    o[0] += FP4X2(r.x, 0) * ww; o[1] += FP4X2(r.x, 1) * ww; o[2] += FP4X2(r.x, 2) * ww; o[3] += FP4X2(r.x, 3) * ww;
    o[4] += FP4X2(r.y, 0) * ww; o[5] += FP4X2(r.y, 1) * ww; o[6] += FP4X2(r.y, 2) * ww; o[7] += FP4X2(r.y, 3) * ww;
}
template <int H> __device__ __forceinline__ void g_compute_u(const u32x2 (&buf)[GB], int q, int i16, const f32x2 (&xp)[8], float& zlo, float& zhi) {
    float p[16];
#pragma unroll
    for (int j = 0; j < 16; ++j) p[j] = dot16_fp4p(buf[16 * H + j], xp);
    float s1[8], s2[4];
#pragma unroll
    for (int m = 0; m < 8; ++m) s1[m] = swap32_add(p[2 * m], p[2 * m + 1]);
#pragma unroll
    for (int n = 0; n < 4; ++n) s2[n] = swap16_add(s1[2 * n], s1[2 * n + 1]);
#pragma unroll
    for (int r = 0; r < 4; ++r) { const float z = row_sum16(s2[r]); const bool mine = i16 == ((4 * q + r) & 15);
        zlo = (mine && q < 4) ? z : zlo; zhi = (mine && q >= 4) ? z : zhi; }
}
template <int H> __device__ __forceinline__ void g_compute_v(const u32x2 (&buf)[GB], int q, float alo, float ahi, f32x2 (&o)[8]) {
    const int areg = __builtin_bit_cast(int, (q < 4) ? alo : ahi), sb = 4 * (q & 3);
#pragma unroll
    for (int j = 0; j < 16; ++j) { const int src = 32 * (j & 1) + 16 * ((j >> 1) & 1) + (j >> 2) + sb;
        const float w = __builtin_bit_cast(float, __builtin_amdgcn_readlane(areg, src));
        axpy16_fp4p(buf[16 * H + j], w, o); }
}
__device__ __forceinline__ void q_issue(u32x2 (&buf)[16], __amdgpu_buffer_rsrc_t rs, int ixr  , int lb, int voff) {
#pragma unroll
    for (int j = 0; j < 16; ++j) { const int e9 = __builtin_amdgcn_readlane(ixr, lb + j); buf[j] = __builtin_amdgcn_raw_buffer_load_b64(rs, voff, e9, 0); }
}
__device__ __forceinline__ void q_compute_u(const u32x2 (&buf)[16], int q, int i16, const f32x2 (&xp)[8], float& zlo, float& zhi) {
    float p[16];
#pragma unroll
    for (int j = 0; j < 16; ++j) p[j] = dot16_fp4p(buf[j], xp);
    float s1[8], s2[4];
#pragma unroll
    for (int m = 0; m < 8; ++m) s1[m] = swap32_add(p[2 * m], p[2 * m + 1]);
#pragma unroll
    for (int n = 0; n < 4; ++n) s2[n] = swap16_add(s1[2 * n], s1[2 * n + 1]);
#pragma unroll
    for (int r = 0; r < 4; ++r) { const float z = row_sum16(s2[r]); const bool mine = i16 == ((4 * q + r) & 15);
        zlo = (mine && q < 4) ? z : zlo; zhi = (mine && q >= 4) ? z : zhi; }
}
typedef _Float16 h16x2 __attribute__((ext_vector_type(2)));
#define FP4H2(w, sel) __builtin_amdgcn_cvt_scalef32_pk_f16_fp4((w), 1.0f, (sel))
__device__ __forceinline__ void axpy16_fp4h(const u32x2 r, const h16x2 ww, h16x2 (&o)[8]) {
    o[0] += FP4H2(r.x, 0) * ww; o[1] += FP4H2(r.x, 1) * ww; o[2] += FP4H2(r.x, 2) * ww; o[3] += FP4H2(r.x, 3) * ww;
    o[4] += FP4H2(r.y, 0) * ww; o[5] += FP4H2(r.y, 1) * ww; o[6] += FP4H2(r.y, 2) * ww; o[7] += FP4H2(r.y, 3) * ww;
}
__device__ __forceinline__ void q_compute_vh(const u32x2 (&buf)[16], int q, int alo, int ahi, h16x2 (&o)[8]) {
    const int areg = (q < 4) ? alo : ahi, sb = 4 * (q & 3);
#pragma unroll
    for (int j = 0; j < 16; ++j) { const int src = 32 * (j & 1) + 16 * ((j >> 1) & 1) + (j >> 2) + sb;
        const h16x2 w = __builtin_bit_cast(h16x2, __builtin_amdgcn_readlane(areg, src));
        axpy16_fp4h(buf[j], w, o); }
}
__device__ __forceinline__ void q_compute_v(const u32x2 (&buf)[16], int q, float alo, float ahi, f32x2 (&o)[8]) {
    const int areg = __builtin_bit_cast(int, (q < 4) ? alo : ahi), sb = 4 * (q & 3);
#pragma unroll
    for (int j = 0; j < 16; ++j) { const int src = 32 * (j & 1) + 16 * ((j >> 1) & 1) + (j >> 2) + sb;
        const float w = __builtin_bit_cast(float, __builtin_amdgcn_readlane(areg, src));
        axpy16_fp4p(buf[j], w, o); }
}
__device__ __forceinline__ int swap32_addi(int a, int b) { auto r = __builtin_amdgcn_permlane32_swap((unsigned)a, (unsigned)b, false, false); const unsigned r0 = r[0], r1 = r[1]; return (int)(r0 + r1); }
__device__ __forceinline__ int swap16_addi(int a, int b) { auto r = __builtin_amdgcn_permlane16_swap((unsigned)a, (unsigned)b, false, false); const unsigned r0 = r[0], r1 = r[1]; return (int)(r0 + r1); }
template <int CTRL> __device__ __forceinline__ int dpp_i(int v) { return __builtin_amdgcn_update_dpp(0, v, CTRL, 0xf, 0xf, true); }
__device__ __forceinline__ int row_sum16i(int v) { v += dpp_i<0xB1>(v); v += dpp_i<0x4E>(v); v += dpp_i<0x141>(v); v += dpp_i<0x140>(v); return v; }
__device__ __forceinline__ void q_compute_ui(const u32x2 (&buf)[16], int q, int i16, int xh0, int xh1, int xl0, int xl1, int& zlo, int& zhi) {
    int p[16];
#pragma unroll
    for (int j = 0; j < 16; ++j) { const int d1 = __builtin_amdgcn_sdot8((int)buf[j].x, xh0, __builtin_amdgcn_sdot8((int)buf[j].y, xh1, 0, false), false);
        const int d2 = __builtin_amdgcn_sdot8((int)buf[j].x, xl0, __builtin_amdgcn_sdot8((int)buf[j].y, xl1, 0, false), false);
        p[j] = (d1 << 4) + d2; }
    int s1[8], s2[4];
#pragma unroll
    for (int m = 0; m < 8; ++m) s1[m] = swap32_addi(p[2 * m], p[2 * m + 1]);
#pragma unroll
    for (int n = 0; n < 4; ++n) s2[n] = swap16_addi(s1[2 * n], s1[2 * n + 1]);
#pragma unroll
    for (int r = 0; r < 4; ++r) { const int z = row_sum16i(s2[r]); const bool mine = i16 == ((4 * q + r) & 15);
        zlo = (mine && q < 4) ? z : zlo; zhi = (mine && q >= 4) ? z : zhi; }
}
__device__ __forceinline__ void phase_gather_u(const Params& P) {
    const int tid = threadIdx.x, lane = tid & 63, wave = __builtin_amdgcn_readfirstlane(tid >> 6);
    const int gw = blockIdx.x * NWAVES + wave, NGW = gridDim.x * NWAVES;
    unsigned char* ws = P.ws;
    const int* IDX = (const int*)(ws + WS_IDX); const float* GATE = (const float*)(ws + WS_GATE); const float* ESC = (const float*)(ws + WS_ESCALE); float* AW = (float*)(ws + WS_AW);
    const __amdgpu_buffer_rsrc_t rsU = __builtin_amdgcn_make_buffer_rsrc((void*)(ws + WS_U8), 0, 16384 * 512, 0x00020000);
    const unsigned char* H2I = ws + WS_H0I8; const float* RF = (const float*)(ws + WS_RF);
    const int hh = lane >> 5, rr = (lane >> 4) & 1, i16 = lane & 15, gsel = 4 * i16 + 2 * rr + hh;
    const int voff = 8 * lane;
    const unsigned ul = (unsigned)lane;
    int t = gw;
    if (t < NTOK) {
        int idx0, idx1; unsigned hraw[4]; float sqv;
        { const int* ip = IDX + (size_t)t * NSEL; idx0 = ip[ul]; idx1 = ip[64u + ul];
          const unsigned* hp = (const unsigned*)(H2I + (size_t)t * DM);
#pragma unroll
          for (int j = 0; j < 4; ++j) hraw[j] = hp[64u * j + ul];
          sqv = RF[t]; }
        u32x2 R0[16], R1[16], R2[16], R3[16];
        { const int ix0 = idx0 << 9; q_issue(R0, rsU, ix0, 0, voff); q_issue(R1, rsU, ix0, 16, voff); q_issue(R2, rsU, ix0, 32, voff); }
        for (;;) {
            const int tn = t + NGW; const bool has_next = tn < NTOK; const int tl = has_next ? tn : t;
            int idx0n, idx1n; unsigned hrawn[4]; float sqn, g0, g1;
            { const int* ip = IDX + (size_t)tl * NSEL; idx0n = ip[ul]; idx1n = ip[64u + ul];
              const unsigned* hp = (const unsigned*)(H2I + (size_t)tl * DM);
#pragma unroll
              for (int j = 0; j < 4; ++j) hrawn[j] = hp[64u * j + ul];
              sqn = RF[tl];
              const float* gp = GATE + (size_t)t * NSEL; g0 = gp[ul]; g1 = gp[64u + ul]; }
            const float su0 = ESC[idx0], su1 = ESC[idx1], sv0 = ESC[16384 + idx0], sv1 = ESC[16384 + idx1];
            const float cq0 = ((const float*)(ws + WS_SUMQ))[idx0], cq1 = ((const float*)(ws + WS_SUMQ))[idx1];
            unsigned xh[2] = {0u, 0u}, xl[2] = {0u, 0u};
#pragma unroll
            for (int j = 0; j < 4; ++j) {
                const unsigned lo4 = hraw[j] & 0x0f0f0f0fu, hi4 = (hraw[j] >> 4) & 0x0f0f0f0fu;
                const unsigned tl4 = (lo4 | (lo4 >> 4)) & 0x00ff00ffu, th4 = (hi4 | (hi4 >> 4)) & 0x00ff00ffu;
                const unsigned pl = ((tl4 | (tl4 >> 8)) & 0xffffu) ^ 0x8888u, ph = (th4 | (th4 >> 8)) & 0xffffu;
                xl[j >> 1] |= pl << (16 * (j & 1)); xh[j >> 1] |= ph << (16 * (j & 1)); }
            int zlo = 0, zhi = 0;
            const int ix0 = idx0 << 9, ix1 = idx1 << 9;
#pragma unroll 1
            for (int qq = 0; qq < 8; qq += 4) {
                const int ixn = qq ? (idx0n << 9) : ix1;
                q_issue(R3, rsU, qq ? ix1 : ix0, 48, voff);
                q_compute_ui(R0, qq, i16, (int)xh[0], (int)xh[1], (int)xl[0], (int)xl[1], zlo, zhi);
                q_issue(R0, rsU, ixn, 0, voff);
                q_compute_ui(R1, qq + 1, i16, (int)xh[0], (int)xh[1], (int)xl[0], (int)xl[1], zlo, zhi);
                q_issue(R1, rsU, ixn, 16, voff);
                q_compute_ui(R2, qq + 2, i16, (int)xh[0], (int)xh[1], (int)xl[0], (int)xl[1], zlo, zhi);
                q_issue(R2, rsU, ixn, 32, voff);
                q_compute_ui(R3, qq + 3, i16, (int)xh[0], (int)xh[1], (int)xl[0], (int)xl[1], zlo, zhi);
            }
            const float glo = __shfl(g0, gsel), ghi = __shfl(g1, gsel), sulo = __shfl(su0, gsel), suhi = __shfl(su1, gsel), svlo = __shfl(sv0, gsel), svhi = __shfl(sv1, gsel);
            const float cqlo = __shfl(cq0, gsel), cqhi = __shfl(cq1, gsel);
            const float zfl = ((float)zlo + 8.f * cqlo) * (sulo * sqv), zfh = ((float)zhi + 8.f * cqhi) * (suhi * sqv);
            const float wl = gelu_tanh_f(zfl) * glo * svlo, wh = gelu_tanh_f(zfh) * ghi * svhi;
            const float wmx = fmaxf(wave_max_fast(fmaxf(fabsf(wl), fabsf(wh))), 1e-30f), wsc = 256.f / wmx;
            { const float a = wl * wsc, c = wh * wsc;
              const int ah = __builtin_amdgcn_cvt_pk_fp8_f32(a, a, 0, false) & 255, ch = __builtin_amdgcn_cvt_pk_fp8_f32(c, c, 0, false) & 255;
              const float ar = a - __builtin_amdgcn_cvt_f32_fp8(ah, 0), cr = c - __builtin_amdgcn_cvt_f32_fp8(ch, 0);
              const int al = __builtin_amdgcn_cvt_pk_fp8_f32(ar, ar, 0, false) & 255, cl = __builtin_amdgcn_cvt_pk_fp8_f32(cr, cr, 0, false) & 255;
              unsigned char* ap = (unsigned char*)AW + (size_t)t * 256;
              ap[gsel] = (unsigned char)ah; ap[64 + gsel] = (unsigned char)ch; ap[128 + gsel] = (unsigned char)al; ap[192 + gsel] = (unsigned char)cl;
              if (lane == 0) ((float*)(ws + WS_WMX))[t] = wmx * (1.f / 256.f); }
            if (!has_next) break;
            t = tn; idx0 = idx0n; idx1 = idx1n; sqv = sqn;
#pragma unroll
            for (int j = 0; j < 4; ++j) hraw[j] = hrawn[j];
        }
    }
}
__device__ __forceinline__ void phase_gather_v(const Params& P) {
    const int tid = threadIdx.x, lane = tid & 63, wave = __builtin_amdgcn_readfirstlane(tid >> 6);
    const int gw = blockIdx.x * NWAVES + wave, NGW = gridDim.x * NWAVES;
    unsigned char* ws = P.ws;
    const int* IDX = (const int*)(ws + WS_IDX); const float* AW = (const float*)(ws + WS_AW);
    const __amdgpu_buffer_rsrc_t rsV = __builtin_amdgcn_make_buffer_rsrc((void*)(ws + WS_V8), 0, 16384 * 512, 0x00020000);
    const bf16* H2B = (const bf16*)(ws + WS_H2B);
    const int voff = 8 * lane;
    const unsigned ul = (unsigned)lane;
    int t = gw;
    if (t < NTOK) {
        int idx0, idx1; u32x2 hraw[4]; float alo, ahi;
        { const int* ip = IDX + (size_t)t * NSEL; idx0 = ip[ul]; idx1 = ip[64u + ul];
          const u32x2* hp = (const u32x2*)(H2B + (size_t)t * DM);
#pragma unroll
          for (int j = 0; j < 4; ++j) hraw[j] = hp[64u * j + ul];
          const float* ap = AW + (size_t)t * NSEL; alo = ap[ul]; ahi = ap[64u + ul]; }
        u32x2 R0[16], R1[16], R2[16], R3[16];
        { const int ix0 = idx0 << 9; q_issue(R0, rsV, ix0, 0, voff); q_issue(R1, rsV, ix0, 16, voff); q_issue(R2, rsV, ix0, 32, voff); }
        for (;;) {
            const int tn = t + NGW; const bool has_next = tn < NTOK; const int tl = has_next ? tn : t;
            int idx0n, idx1n; u32x2 hrawn[4]; float alon, ahin;
            { const int* ip = IDX + (size_t)tl * NSEL; idx0n = ip[ul]; idx1n = ip[64u + ul];
              const u32x2* hp = (const u32x2*)(H2B + (size_t)tl * DM);
#pragma unroll
              for (int j = 0; j < 4; ++j) hrawn[j] = hp[64u * j + ul];
              const float* ap = AW + (size_t)tl * NSEL; alon = ap[ul]; ahin = ap[64u + ul]; }
            const float wmx = fmaxf(wave_max_fast(fmaxf(fabsf(alo), fabsf(ahi))), 1e-30f), winv = 1.f / wmx;
            int alh, ahh;
            { const h16x2 a = (h16x2){(_Float16)(alo * winv), (_Float16)(alo * winv)}, b = (h16x2){(_Float16)(ahi * winv), (_Float16)(ahi * winv)};
              alh = __builtin_bit_cast(int, a); ahh = __builtin_bit_cast(int, b); }
            h16x2 oh[8];
#pragma unroll
            for (int j = 0; j < 8; ++j) oh[j] = (h16x2){(_Float16)0.f, (_Float16)0.f};
            const int ix0 = idx0 << 9, ix1 = idx1 << 9;
#pragma unroll 1
            for (int qq = 0; qq < 8; qq += 4) {
                const int ixn = qq ? (idx0n << 9) : ix1;
                q_issue(R3, rsV, qq ? ix1 : ix0, 48, voff);
                q_compute_vh(R0, qq, alh, ahh, oh);
                q_issue(R0, rsV, ixn, 0, voff);
                q_compute_vh(R1, qq + 1, alh, ahh, oh);
                q_issue(R1, rsV, ixn, 16, voff);
                q_compute_vh(R2, qq + 2, alh, ahh, oh);
                q_issue(R2, rsV, ixn, 32, voff);
                q_compute_vh(R3, qq + 3, alh, ahh, oh);
            }
            f32x2 o[8];
#pragma unroll
            for (int j = 0; j < 8; ++j) o[j] = (f32x2){(float)oh[j].x * wmx, (float)oh[j].y * wmx};
            float ss = 0.f;
#pragma unroll
            for (int j = 0; j < 4; ++j) { o[2 * j] += (f32x2){bflo(hraw[j].x), bfhi(hraw[j].x)}; o[2 * j + 1] += (f32x2){bflo(hraw[j].y), bfhi(hraw[j].y)}; }
#pragma unroll
            for (int j = 0; j < 8; ++j) ss += o[j].x * o[j].x + o[j].y * o[j].y;
            ss = wave_sum_fast(ss);
            const float r3 = rsqrtf(ss * (1.f / DM) + EPS);
            f32x4* op = (f32x4*)(P.out + (size_t)t * DM);
            const f32x4* gfp = (const f32x4*)P.g_fin;
#pragma unroll
            for (int j = 0; j < 4; ++j) { const f32x4 gv = gfp[64u * j + ul]; op[64u * j + ul] = (f32x4){o[2 * j].x * r3 * gv.x, o[2 * j].y * r3 * gv.y, o[2 * j + 1].x * r3 * gv.z, o[2 * j + 1].y * r3 * gv.w}; }
            if (!has_next) break;
            t = tn; idx0 = idx0n; idx1 = idx1n; alo = alon; ahi = ahin;
#pragma unroll
            for (int j = 0; j < 4; ++j) hraw[j] = hrawn[j];
        }
    }
}


typedef int i32x2v __attribute__((ext_vector_type(2)));
typedef int i32x8v __attribute__((ext_vector_type(8)));
#define VM_X 9
#define VM_WAIT(n) asm volatile("s_waitcnt vmcnt(" #n ")" ::: "memory")
__device__ __forceinline__ void phase_gather_v_mfma(const Params& P, LAS unsigned char* lds) {
    const int tid = threadIdx.x, lane = tid & 63, wave = __builtin_amdgcn_readfirstlane(tid >> 6);
    unsigned char* ws = P.ws;
    const int* IDX = (const int*)(ws + WS_IDX);
    const unsigned char* V8 = ws + WS_V8; const unsigned char* AW8 = ws + WS_AW; const float* WMX = (const float*)(ws + WS_WMX);
    const unsigned short* H2S = (const unsigned short*)(ws + WS_H2B);
    const int TPB = NTOK / (int)gridDim.x, t0 = blockIdx.x * TPB, NST = TPB * 4;
    const int r0 = 16 * wave + (lane >> 3), r1 = r0 + 8;
    const unsigned c0 = 16u * (unsigned)((lane & 7) ^ ((r0 >> 1) & 7)), c1 = 16u * (unsigned)((lane & 7) ^ ((r1 >> 1) & 7));
    const int i16 = lane & 15, kb = lane >> 4;
    const int ra = 32 * kb + i16, rb = ra + 16;
    const unsigned offa = (unsigned)(ra * 128 + 16 * (wave ^ ((ra >> 1) & 7))), offb = (unsigned)(rb * 128 + 16 * (wave ^ ((rb >> 1) & 7)));
    const unsigned aoffb = (unsigned)(((i16 & 1) ? 128 : 0) + 16 * kb);
    const bool arow = (i16 & 3) < 2;
    const int colb = 256 * kb + 32 * wave + i16;
    LAS float* SS = (LAS float*)(lds + 131072 + 1024);
    LAS float* OUTB = (LAS float*)(lds + 131072 + 2048);
    const f32x4 gfv = *(const f32x4*)(P.g_fin + 256 * (wave & 3) + 4 * lane);
    const unsigned lbase = (unsigned)(unsigned long long)lds;
    struct VTok { u32x4 a, b; float w; unsigned h0, h1; };
    VTok C0, C1;
    int ia1, ib1, ia2, ib2, ia3, ib3;
#define VM_ISSUE(g, e0, e1) do { LAS unsigned char* _d = lds + (((g) & 7) * 16384) + wave * 2048; const unsigned _cb = 128u * (unsigned)((g) & 3); \
        __builtin_amdgcn_global_load_lds((const unsigned*)(V8 + (size_t)(e0) * 512 + _cb + c0), (LAS unsigned*)(_d), 16, 0, 0); \
        __builtin_amdgcn_global_load_lds((const unsigned*)(V8 + (size_t)(e1) * 512 + _cb + c1), (LAS unsigned*)(_d + 1024), 16, 0, 0); } while (0)
    {
        const int ia0 = IDX[(size_t)t0 * NSEL + r0], ib0 = IDX[(size_t)t0 * NSEL + r1];
        ia1 = IDX[(size_t)(t0 + 1) * NSEL + r0]; ib1 = IDX[(size_t)(t0 + 1) * NSEL + r1];
        ia2 = IDX[(size_t)(t0 + 2) * NSEL + r0]; ib2 = IDX[(size_t)(t0 + 2) * NSEL + r1];
        ia3 = IDX[(size_t)(t0 + 3) * NSEL + r0]; ib3 = IDX[(size_t)(t0 + 3) * NSEL + r1];
        const unsigned char* ap = AW8 + (size_t)t0 * 256 + aoffb;
        C0.a = *(const u32x4*)ap; C0.b = *(const u32x4*)(ap + 64); C0.w = WMX[t0]; C0.h0 = H2S[(size_t)t0 * DM + colb]; C0.h1 = H2S[(size_t)t0 * DM + colb + 16];
        C1.a = *(const u32x4*)(ap + 256); C1.b = *(const u32x4*)(ap + 256 + 64); C1.w = WMX[t0 + 1]; C1.h0 = H2S[(size_t)(t0 + 1) * DM + colb]; C1.h1 = H2S[(size_t)(t0 + 1) * DM + colb + 16];
        asm volatile("s_waitcnt vmcnt(0)" ::: "memory");
        VM_ISSUE(0, ia0, ib0); VM_ISSUE(1, ia0, ib0); VM_ISSUE(2, ia0, ib0); VM_ISSUE(3, ia0, ib0);
        VM_ISSUE(4, ia1, ib1); VM_ISSUE(5, ia1, ib1); VM_ISSUE(6, ia1, ib1);
    }
    float pv0 = 0.f, pv1 = 0.f;
    VTok N0, N1; int na4, nb4, na5, nb5;
    auto token = [&](const int i, const bool even, const VTok& C, const int e1a, const int e1b, const int e2a, const int e2b) __attribute__((always_inline)) {
        const int t = t0 + i;
        const u32x4 z = (u32x4){0u, 0u, 0u, 0u}; const u32x4 Alo = arow ? C.a : z, Ahi = arow ? C.b : z;
        const i32x8v A = (i32x8v){(int)Alo.x, (int)Alo.y, (int)Alo.z, (int)Alo.w, (int)Ahi.x, (int)Ahi.y, (int)Ahi.z, (int)Ahi.w};
        f32x4 acc[4][2];
#pragma unroll
        for (int cc = 0; cc < 4; ++cc) {
            const int g = 4 * i + cc;
            if (even && cc == 0) { VM_WAIT(12); } else { VM_WAIT(26); }
            asm volatile("s_waitcnt lgkmcnt(0)" ::: "memory");
            __builtin_amdgcn_s_barrier();
            __builtin_amdgcn_sched_barrier(0);
            const unsigned sa = lbase + (unsigned)((g & 7) * 16384) + offa, sbb = lbase + (unsigned)((g & 7) * 16384) + offb;
            i32x2v b00, b01, b10, b11;
            asm volatile("ds_read_b64_tr_b4 %0, %4\n\tds_read_b64_tr_b4 %1, %5\n\tds_read_b64_tr_b4 %2, %4 offset:8\n\tds_read_b64_tr_b4 %3, %5 offset:8"
                         : "=&v"(b00), "=&v"(b01), "=&v"(b10), "=&v"(b11) : "v"(sa), "v"(sbb) : "memory");
            { const int gn = g + 7;
              if (cc == 0) VM_ISSUE(gn, e1a, e1b); else VM_ISSUE(gn, e2a, e2b); }
            __builtin_amdgcn_sched_barrier(0);
            if (cc == 0) {
                if (even) {
                    const int tA = t0 + ((i + 2 < TPB) ? i + 2 : TPB - 2), tI = t0 + ((i + 4 < TPB) ? i + 4 : TPB - 2);
                    const unsigned char* ap = AW8 + (size_t)tA * 256 + aoffb; const float* wp = WMX + tA; const int* ipa = IDX + (size_t)tI * NSEL + r0; const unsigned short* hp = H2S + (size_t)tA * DM + colb;
                    asm volatile("global_load_dwordx4 %0, %14, off\n\tglobal_load_dwordx4 %1, %14, off offset:64\n\tglobal_load_dwordx4 %2, %14, off offset:256\n\tglobal_load_dwordx4 %3, %14, off offset:320\n\t"
                                 "global_load_dword %4, %15, off\n\tglobal_load_dword %5, %15, off offset:4\n\t"
                                 "global_load_ushort %6, %17, off\n\tglobal_load_ushort %7, %17, off offset:32\n\tglobal_load_ushort %8, %17, off offset:2048\n\tglobal_load_ushort %9, %17, off offset:2080\n\t"
                                 "global_load_dword %10, %16, off\n\tglobal_load_dword %11, %16, off offset:32\n\tglobal_load_dword %12, %16, off offset:512\n\tglobal_load_dword %13, %16, off offset:544"
                                 : "=&v"(N0.a), "=&v"(N0.b), "=&v"(N1.a), "=&v"(N1.b), "=&v"(N0.w), "=&v"(N1.w), "=&v"(N0.h0), "=&v"(N0.h1), "=&v"(N1.h0), "=&v"(N1.h1), "=&v"(na4), "=&v"(nb4), "=&v"(na5), "=&v"(nb5)
                                 : "v"(ap), "v"(wp), "v"(ipa), "v"(hp) : "memory");
                }
                { const f32x4 s0 = *(const LAS f32x4*)(SS + 8 * ((i + 1) & 1)), s1 = *(const LAS f32x4*)(SS + 8 * ((i + 1) & 1) + 4);
                  const float ss = ((s0.x + s0.y) + (s0.z + s0.w)) + ((s1.x + s1.y) + (s1.z + s1.w));
                  const float r3 = rsqrtf(ss * (1.f / DM) + EPS);
                  if (i > 0 && (wave >> 2) == ((i + 1) & 1)) {
                      const f32x4 v = *(const LAS f32x4*)(OUTB + 1024 * ((i + 1) & 1) + 256 * (wave & 3) + 4 * lane);
                      *(f32x4*)(P.out + (size_t)(t - 1) * DM + 256 * (wave & 3) + 4 * lane) = (f32x4){v.x * r3 * gfv.x, v.y * r3 * gfv.y, v.z * r3 * gfv.z, v.w * r3 * gfv.w}; } }
                __builtin_amdgcn_sched_barrier(0);
            }
            asm volatile("s_waitcnt lgkmcnt(0)" : "+v"(b00), "+v"(b01), "+v"(b10), "+v"(b11) :: "memory");
            const i32x8v B0 = (i32x8v){b00.x, b00.y, b01.x, b01.y, 0, 0, 0, 0}, B1 = (i32x8v){b10.x, b10.y, b11.x, b11.y, 0, 0, 0, 0};
            const f32x4 z4 = (f32x4){0.f, 0.f, 0.f, 0.f};
            acc[cc][0] = __builtin_amdgcn_mfma_scale_f32_16x16x128_f8f6f4(A, B0, z4, 0  , 4  , 0, 0x7f7f7f7f, 0, 0x7f7f7f7f);
            acc[cc][1] = __builtin_amdgcn_mfma_scale_f32_16x16x128_f8f6f4(A, B1, z4, 0, 4, 0, 0x7f7f7f7f, 0, 0x7f7f7f7f);
        }
#pragma unroll
        for (int c = 0; c < 4; ++c) asm volatile("" :: "v"(acc[c][0]), "v"(acc[c][1]));
        float s0 = acc[0][0].x + acc[0][0].y, s1 = acc[0][1].x + acc[0][1].y;
        { const float a0 = acc[1][0].x + acc[1][0].y, a1 = acc[1][1].x + acc[1][1].y, b0 = acc[2][0].x + acc[2][0].y, b1 = acc[2][1].x + acc[2][1].y, d0 = acc[3][0].x + acc[3][0].y, d1 = acc[3][1].x + acc[3][1].y;
          s0 = (kb == 1) ? a0 : s0; s1 = (kb == 1) ? a1 : s1; s0 = (kb == 2) ? b0 : s0; s1 = (kb == 2) ? b1 : s1; s0 = (kb == 3) ? d0 : s0; s1 = (kb == 3) ? d1 : s1; }
        pv0 = s0 * C.w + __uint_as_float(C.h0 << 16); pv1 = s1 * C.w + __uint_as_float(C.h1 << 16);
        OUTB[1024 * (i & 1) + colb] = pv0; OUTB[1024 * (i & 1) + colb + 16] = pv1;
        const float sq = wave_sum_fast(pv0 * pv0 + pv1 * pv1);
        if (lane == 0) SS[8 * (i & 1) + wave] = sq;
    };
#pragma unroll 1
    for (int i = 0; i < TPB; i += 2) {
        token(i, true, C0, ia1, ib1, ia2, ib2);
        token(i + 1, false, C1, ia2, ib2, ia3, ib3);
        asm volatile("s_waitcnt vmcnt(14)" : "+v"(N0.a), "+v"(N0.b), "+v"(N1.a), "+v"(N1.b), "+v"(N0.w), "+v"(N1.w), "+v"(N0.h0), "+v"(N0.h1), "+v"(N1.h0), "+v"(N1.h1), "+v"(na4), "+v"(nb4), "+v"(na5), "+v"(nb5) :: "memory");
        C0 = N0; C1 = N1; ia1 = ia3; ib1 = ib3; ia2 = na4; ib2 = nb4; ia3 = na5; ib3 = nb5;
    }
    asm volatile("s_waitcnt vmcnt(0)" ::: "memory");
    __builtin_amdgcn_s_barrier();
    { const int i = TPB; const f32x4 s0 = *(const LAS f32x4*)(SS + 8 * ((i + 1) & 1)), s1 = *(const LAS f32x4*)(SS + 8 * ((i + 1) & 1) + 4);
      const float ss = ((s0.x + s0.y) + (s0.z + s0.w)) + ((s1.x + s1.y) + (s1.z + s1.w));
      const float r3 = rsqrtf(ss * (1.f / DM) + EPS);
      if ((wave >> 2) == ((i + 1) & 1)) {
          const f32x4 v = *(const LAS f32x4*)(OUTB + 1024 * ((i + 1) & 1) + 256 * (wave & 3) + 4 * lane);
          *(f32x4*)(P.out + (size_t)(t0 + TPB - 1) * DM + 256 * (wave & 3) + 4 * lane) = (f32x4){v.x * r3 * gfv.x, v.y * r3 * gfv.y, v.z * r3 * gfv.z, v.w * r3 * gfv.w}; } }
#undef VM_ISSUE
}

__device__ __forceinline__ void phase_quant_h2(const Params& P) {
    const int tid = threadIdx.x, lane = tid & 63, wave = __builtin_amdgcn_readfirstlane(tid >> 6);
    const int gw = blockIdx.x * NWAVES + wave, NGW = gridDim.x * NWAVES;
    unsigned char* ws = P.ws;
    const float* SSQ = (const float*)(ws + WS_SSQ); const float* AMX = (const float*)(ws + WS_AMX); float* RF = (float*)(ws + WS_RF);
    for (int row = gw; row < NTOK; row += NGW) {
        const u32x4* hp = (const u32x4*)(ws + WS_H2B + (size_t)row * DM * 2) + 2 * lane;
        const u32x4 a = hp[0], b = hp[1];
        const float am = fmaxf(row_max16(AMX[(size_t)row * 16 + (lane & 15)]), 1e-30f) * 1.0078125f;
        const float rstd2 = rsqrtf(row_sum16(SSQ[(size_t)row * 16 + (lane & 15)]) * (1.f / DM) + EPS);
        const float inv = 127.f / am;
        const unsigned w[8] = {a.x, a.y, a.z, a.w, b.x, b.y, b.z, b.w};
        unsigned o[4];
#pragma unroll
        for (int j = 0; j < 4; ++j) {
            const int q0 = (int)rintf(__uint_as_float(w[2 * j] << 16) * inv), q1 = (int)rintf(__uint_as_float(w[2 * j] & 0xffff0000u) * inv);
            const int q2 = (int)rintf(__uint_as_float(w[2 * j + 1] << 16) * inv), q3 = (int)rintf(__uint_as_float(w[2 * j + 1] & 0xffff0000u) * inv);
            o[j] = ((unsigned)q0 & 255u) | (((unsigned)q1 & 255u) << 8) | (((unsigned)q2 & 255u) << 16) | ((unsigned)q3 << 24); }
        u32x4 ov; ov.x = o[0]; ov.y = o[1]; ov.z = o[2]; ov.w = o[3];
        *((u32x4*)(ws + WS_H0I8 + (size_t)row * DM) + lane) = ov;
        if (lane == 0) RF[row] = am * (1.f / 127.f) * rstd2;
    }
}
struct EpiQI8 {
    static constexpr bool PERM = true, AFTER_DRAIN = false;
    bf16* O; int ldc; const float* rf; const float* sw;
    __device__ __forceinline__ void operator()(const pg8::i32x4 (&acc)[2][2][4][2], const pg8::Unit& u, int wr, int wc, int fr, int fq) const {
        const int row0 = u.pm * 256 + wr * 64 + fr, col0 = u.pn * 256 + wc * 32 + 8 * fq;
        f32x4 swv[2][2];
#pragma unroll
        for (int bj = 0; bj < 2; ++bj) { swv[bj][0] = *(const f32x4*)(sw + col0 + bj * 128); swv[bj][1] = *(const f32x4*)(sw + col0 + bj * 128 + 4); }
#pragma unroll
        for (int ai = 0; ai < 2; ++ai)
#pragma unroll
            for (int m = 0; m < 4; ++m) {
                const int row = row0 + ai * 128 + m * 16;
                const float s = rf[row];
                bf16* rowp = O + (size_t)row * ldc + col0;
#pragma unroll
                for (int bj = 0; bj < 2; ++bj) { const pg8::i32x4 a0 = acc[ai][bj][m][0], a1 = acc[ai][bj][m][1];
                    const f32x4 v0 = (f32x4){(float)a0[0], (float)a0[1], (float)a0[2], (float)a0[3]} * (swv[bj][0] * s), v1 = (f32x4){(float)a1[0], (float)a1[1], (float)a1[2], (float)a1[3]} * (swv[bj][1] * s);
                    u32x4 w; w.x = cvt_pk_bf16(v0[0], v0[1]); w.y = cvt_pk_bf16(v0[2], v0[3]); w.z = cvt_pk_bf16(v1[0], v1[1]); w.w = cvt_pk_bf16(v1[2], v1[3]);
                    *(u32x4*)(rowp + bj * 128) = w; }
            }
    }
};
#define XB_TMO      128
#define XB_XCNT(j)  (256  + 64 * (j))
#define XB_XSUB(j)  (1280 + 64 * (j))
#define XB_XGEN(j)  (2304 + 64 * (j))
#define XB_TOP      3328
#define XB_TOPGEN   3392
#define XCD_BAR_WORDS 3456
#define XB_SPIN_CAP (1u << 18)

__device__ __forceinline__ unsigned xb_ld(unsigned* p)              { return __hip_atomic_load(p, __ATOMIC_RELAXED, __HIP_MEMORY_SCOPE_AGENT); }
__device__ __forceinline__ unsigned xb_add(unsigned* p, unsigned v) { return __hip_atomic_fetch_add(p, v, __ATOMIC_RELAXED, __HIP_MEMORY_SCOPE_AGENT); }
__device__ __forceinline__ unsigned xb_xcc_id() { return (unsigned)__builtin_amdgcn_s_getreg((3 << 11) | 20) & 0xFu; }
#define XB_SPIN(cond, bar) do { unsigned _sp = 0; while (cond) { __builtin_amdgcn_s_sleep(1); \
    if ((++_sp & 255u) == 0u) { if (xb_ld(&(bar)[XB_TMO])) break; if (_sp > XB_SPIN_CAP) { atomicAdd(&(bar)[XB_TMO], 1u); break; } } } } while (0)

struct XcdBarrier {
    unsigned* bar; unsigned x;
    volatile LAS unsigned* st;
};

__device__ __forceinline__ XcdBarrier xcd_barrier_post(unsigned* bar, volatile LAS unsigned* st) {
    XcdBarrier b; b.bar = bar; b.x = xb_xcc_id(); b.st = st;
    if (threadIdx.x == 0) (void)xb_add(&bar[XB_XCNT(b.x)], 1u);
    return b;
}
__device__ __forceinline__ void xcd_barrier_complete(unsigned* bar, unsigned x, unsigned& nloc, unsigned& nx) {
    const unsigned G = gridDim.x * gridDim.y * gridDim.z;
    unsigned sum, cnt, mine, sp = 0u;
    for (;;) {
        sum = 0u; cnt = 0u; mine = 0u;
#pragma unroll
        for (unsigned j = 0; j < 16; ++j) { const unsigned c = xb_ld(&bar[XB_XCNT(j)]); sum += c; cnt += (c > 0u) ? 1u : 0u; mine = (j == x) ? c : mine; }
        if (sum == G) break;
        __builtin_amdgcn_s_sleep(1);
        if ((++sp & 255u) == 0u) { if (xb_ld(&bar[XB_TMO])) break; if (sp > XB_SPIN_CAP) { atomicAdd(&bar[XB_TMO], 1u); break; } }
    }
    nloc = mine > 0u ? mine : 1u; nx = cnt > 0u ? cnt : 1u;
}

__device__ __forceinline__ void xcd_barrier(const XcdBarrier& b) {
    asm volatile("s_waitcnt vmcnt(0)" ::: "memory");
    __syncthreads();
    if (threadIdx.x == 0) {
        unsigned* bar = b.bar;
        __builtin_amdgcn_s_waitcnt(0);
        unsigned nloc = b.st[0], nx = b.st[1];
        if (nloc == 0u) { xcd_barrier_complete(bar, b.x, nloc, nx); b.st[0] = nloc; b.st[1] = nx; }
        const unsigned old = xb_add(&bar[XB_XSUB(b.x)], 1u);
        const unsigned gen = old / nloc;
        if (old + 1u == (gen + 1u) * nloc) {
            __builtin_amdgcn_fence(__ATOMIC_RELEASE, "agent");
            asm volatile("s_waitcnt vmcnt(0)" ::: "memory");
            const unsigned og = xb_add(&bar[XB_TOP], 1u);
            const unsigned tg = og / nx;
            if (og + 1u == (tg + 1u) * nx) xb_add(&bar[XB_TOPGEN], 1u);
            else XB_SPIN(xb_ld(&bar[XB_TOPGEN]) == tg, bar);
            __builtin_amdgcn_fence(__ATOMIC_ACQUIRE, "agent");
            xb_add(&bar[XB_XGEN(b.x)], 1u);
            asm volatile("s_waitcnt vmcnt(0)" ::: "memory");
        } else {
            XB_SPIN(xb_ld(&bar[XB_XGEN(b.x)]) == gen, bar);
            __builtin_amdgcn_fence(__ATOMIC_ACQUIRE, "agent");
            asm volatile("s_waitcnt vmcnt(0)" ::: "memory");
        }
    }
    __syncthreads();
}


#ifndef MK_MULTI
#define MK_MULTI 0
#endif
constexpr int NPHASE = 10;
#ifndef REP5
#define REP5 1
#endif
#ifndef REP6
#define REP6 1
#endif
__global__ void __launch_bounds__(NTHREADS, 2) mk_fwd(Params P) {
    extern __shared__ __attribute__((aligned(16))) unsigned char lds_raw[];
    LAS unsigned char* lds = (LAS unsigned char*)lds_raw;
    cg::grid_group grid = cg::this_grid();
    unsigned char* ws = P.ws;
    const int lo = P.ph_lo, hi = P.ph_hi;
    volatile LAS unsigned* bst = (volatile LAS unsigned*)(lds + 131072 + 64);
    if (threadIdx.x < 2) bst[threadIdx.x] = 0u;
    __syncthreads();
    XcdBarrier xbar = xcd_barrier_post((unsigned*)(ws + WS_CTL), bst);
#define IN(k) (lo <= (k) && (k) < hi)
#define SEAM(k) do { if (IN(k) && IN((k) + 1)) { xcd_barrier(xbar); } } while (0)
    if (IN(0)) phase_prep(P, lds);
    SEAM(0);
    if (IN(1)) { phase_metaproj(P); phase_winq(P, lds); }
    SEAM(1);
    if (IN(2)) {
        pg8::Gemm g{(const bf16*)(ws + WS_H0I8), (const bf16*)(ws + WS_WIN_T), NTOK, DIN, DM / 2}; pg8::StaticOrder S; S.init(NTOK, DIN, (int)gridDim.x, (int)blockIdx.x);
        EpiProjI8 E{(bf16*)(ws + WS_PROJ), (const float*)(ws + WS_RSTD1), (const float*)(ws + WS_SW)};
        pg8::gemm_phase_i8<EpiProjI8, pg8::StaticOrder, true, true>(lds, g, S, E);
    }
    SEAM(2);
    if (IN(3)) phase_conv(P, lds);
    SEAM(3);
    if (IN(4)) {
        pg8::Gemm g{(const bf16*)(ws + WS_Y), (const bf16*)(ws + WS_WOUT_T), NTOK, DM, DM / 2}; pg8::StaticOrder S; S.init(NTOK, DM, (int)gridDim.x, (int)blockIdx.x);
        EpiResidualI8 E{(bf16*)(ws + WS_H2B), (const signed char*)(ws + WS_H0I8), (const float*)(ws + WS_SX), (const float*)(ws + WS_SY), (const float*)(ws + WS_SWO), (float*)(ws + WS_SSQ), (float*)(ws + WS_AMX)};
        pg8::gemm_phase_i8<EpiResidualI8, pg8::StaticOrder, true, true>(lds, g, S, E);
    }
    SEAM(4);
    if (IN(5)) phase_quant_h2(P);
    SEAM(5);
    if (IN(6)) {
        pg8::Gemm g{(const bf16*)(ws + WS_H0I8), (const bf16*)(ws + WS_WQ_T), NTOK, 2048, DM / 2}; pg8::StaticOrder S; S.init(NTOK, 2048, (int)gridDim.x, (int)blockIdx.x);
        EpiQI8 E{(bf16*)(ws + WS_Q), 2048, (const float*)(ws + WS_RF), (const float*)(ws + WS_SWQ)};
        pg8::gemm_phase_i8<EpiQI8, pg8::StaticOrder, true, true>(lds, g, S, E);
    }
    if (IN(6) && IN(7)) { asm volatile("s_waitcnt vmcnt(0)" ::: "memory"); __syncthreads(); }
    if (IN(7)) phase_route(P, lds);
    SEAM(7);
    if (IN(8)) phase_gather_u(P);
    SEAM(8);
    if (IN(9)) phase_gather_v_mfma(P, lds);
#undef IN
#undef SEAM
}

extern "C" void kernel_launch(void* const* d_in, const int* in_sizes, int n_in, void* d_out, int out_size, void* d_ws, size_t ws_size, hipStream_t stream) {
    static int grid = 0;
    if (grid == 0) {
        if (n_in != 18 || in_sizes[0] != NTOK * DM || out_size != NTOK * DM || ws_size < WS_END) {
            fprintf(stderr, "kernel_launch: unexpected shapes (n_in %d in0 %d out %d ws %zu)\n", n_in, n_in > 0 ? in_sizes[0] : -1, out_size, ws_size); grid = -1; return; }
        int dev = 0, cus = 0, per_cu = 0;
        (void)hipGetDevice(&dev); (void)hipDeviceGetAttribute(&cus, hipDeviceAttributeMultiprocessorCount, dev);
        if (hipFuncSetAttribute((const void*)mk_fwd, hipFuncAttributeMaxDynamicSharedMemorySize, LDS_BYTES) != hipSuccess) { fprintf(stderr, "kernel_launch: hipFuncSetAttribute failed\n"); grid = -1; return; }
        if (hipOccupancyMaxActiveBlocksPerMultiprocessor(&per_cu, (const void*)mk_fwd, NTHREADS, LDS_BYTES) != hipSuccess || per_cu < 1) { fprintf(stderr, "kernel_launch: occupancy query failed (%d)\n", per_cu); (void)hipGetLastError(); per_cu = 1; }
        if (per_cu > 1) per_cu = 1;
        grid = cus * per_cu;
        if (grid <= 0) grid = 256;
    }
    if (grid < 0) return;
    Params p{};
    p.x = (const float*)d_in[0]; p.meta = (const float*)d_in[1]; p.g_mix = (const float*)d_in[2]; p.w_in = (const float*)d_in[3]; p.sc_w = (const float*)d_in[4];
    p.cf_w = (const float*)d_in[5]; p.cf_b = (const float*)d_in[6]; p.ln_g = (const float*)d_in[7]; p.ln_b = (const float*)d_in[8]; p.g_sc = (const float*)d_in[9];
    p.g_cf = (const float*)d_in[10]; p.w_out = (const float*)d_in[11]; p.g_ffn = (const float*)d_in[12]; p.w_q = (const float*)d_in[13]; p.keys = (const float*)d_in[14];
    p.pu = (const float*)d_in[15]; p.pv = (const float*)d_in[16]; p.g_fin = (const float*)d_in[17];
    p.out = (float*)d_out; p.ws = (unsigned char*)d_ws;
    (void)hipMemsetAsync((char*)d_ws + WS_CTL, 0, 45056, stream);
#if MK_MULTI
    for (int ph = 0; ph < NPHASE; ++ph) { p.ph_lo = ph; p.ph_hi = ph + 1; p.coop = 0; p.pad = 0;
        hipLaunchKernelGGL(mk_fwd, dim3(grid), dim3(NTHREADS), LDS_BYTES, stream, p); }
#else
    p.ph_lo = 0; p.ph_hi = NPHASE; p.coop = 1; p.pad = 0;
    void* args[] = {&p};
    hipError_t e = hipLaunchCooperativeKernel((const void*)mk_fwd, dim3(grid), dim3(NTHREADS), args, LDS_BYTES, stream);
    if (e != hipSuccess) fprintf(stderr, "cooperative launch failed: %s (grid %d)\n", hipGetErrorString(e), grid);
#endif
}
```

```cpp
#include <hip/hip_runtime.h>
#include <hip/hip_cooperative_groups.h>
#include <cstdio>
#include <cstdint>
namespace cg = cooperative_groups;

namespace pg8 {
#define PG8_LAS __attribute__((address_space(3)))
typedef unsigned short bf16_t;
typedef short bf16x8 __attribute__((ext_vector_type(8)));
typedef float f32x4 __attribute__((ext_vector_type(4)));
typedef unsigned u32x4 __attribute__((ext_vector_type(4)));
typedef int i32x4 __attribute__((ext_vector_type(4)));
constexpr int BM = 256, BK = 64, HALF = 128, HTB = HALF * BK * 2  , STAGE_BYTES = 8 * HTB, NXCD = 8, WGM = 8;

__host__ __device__ __forceinline__ int lds_byte(int r, int c) { const int st = (r >> 4) * 2 + (c >> 5), rr = r & 15, cc = c & 31, ob = rr * 64 + cc * 2; return st * 1024 + (ob ^ (((ob >> 9) & 1) << 5)); }
__host__ __device__ __forceinline__ void stage_rc(int b, int& R, int& C) { const int st = b / 1024, sb = b % 1024, swz = sb ^ (((sb >> 9) & 1) << 5); R = (st >> 1) * 16 + swz / 64; C = (st & 1) * 32 + (swz % 64) / 2; }
__host__ __device__ __forceinline__ int perm32(int rho) { const int n = rho >> 4, i = rho & 15; return 8 * (i >> 2) + 4 * n + (i & 3); }

struct Unit { int pm, pn; };
struct Gemm { const bf16_t* A; const bf16_t* Bt; int M, N, K; };

struct StaticOrder {
    int nM, nN, nwg, G, c;
    __host__ __device__ void init(int M, int N, int G_, int c_) { nM = M / BM; nN = N / BM; nwg = nM * nN; G = G_; c = c_; }
    __host__ __device__ bool next(int i, Unit& u) const {
        const long L = (long)i * G + c; if (L >= nwg) return false;
        int wgid = (int)L; { const int q = nwg / NXCD, r = nwg % NXCD, xcd = wgid % NXCD, off = wgid / NXCD; wgid = (xcd < r ? xcd * (q + 1) : r * (q + 1) + (xcd - r) * q) + off; }
        const int nig = WGM * nN, gid = wgid / nig, fm = gid * WGM, gsz = (nM - fm) < WGM ? (nM - fm) : WGM;
        u.pm = fm + ((wgid % nig) % gsz); u.pn = (wgid % nig) / gsz; return true;
    }
    __device__ __forceinline__ void a_ready(const Unit&) const {}
    __device__ __forceinline__ void done(const Unit&) const {}
};

template <class Epi, class Sched, bool ALIGN_EPI = false, bool SP2 = false>
__device__ __forceinline__ void gemm_phase(PG8_LAS unsigned char* lds, const Gemm g, const Sched& S, const Epi& E) {
    const int tid = threadIdx.x, wid = __builtin_amdgcn_readfirstlane(tid >> 6), lane = tid & 63, wr = wid >> 2, wc = wid & 3, fr = lane & 15, fq = lane >> 4;
    const int K = g.K, nt = K / BK;
    unsigned voffA[2], voffB[2];
#pragma unroll
    for (int i = 0; i < 2; ++i) { int R, C; stage_rc(tid * 16 + i * 8192, R, C); const int Rb = Epi::PERM ? ((R & ~31) + perm32(R & 31)) : R;
        voffA[i] = (unsigned)(R * K + C) * 2u; voffB[i] = (unsigned)(Rb * K + C) * 2u; }
    const size_t kstep = (size_t)(BK * 2);
    const size_t hstep = (size_t)HALF * K * 2;
    const size_t tstep = 2 * hstep;
    const unsigned ldsw = (unsigned)wid * 1024u;
    const int aoff = lds_byte(wr * 64 + fr, fq * 8), boff = lds_byte(wc * 32 + fr, fq * 8);
#define PG8_SA(b, h) (((b) * 2 + (h)) * HTB)
#define PG8_SB(b, h) ((4 + (b) * 2 + (h)) * HTB)
#define PG8_STAGE(bufoff, gbase, voff) do { _Pragma("unroll") for (int _i = 0; _i < 2; ++_i) \
        __builtin_amdgcn_global_load_lds((const unsigned*)((const char*)(gbase) + (voff)[_i]), (PG8_LAS unsigned*)(lds + (bufoff) + ldsw + _i * 8192), 16, 0, 0); } while (0)
#define PG8_LDA(dst, b, h) do { _Pragma("unroll") for (int m = 0; m < 4; ++m) _Pragma("unroll") for (int k = 0; k < 2; ++k) dst[m][k] = *(const PG8_LAS bf16x8*)(lds + PG8_SA(b, h) + aoff + m * 2048 + k * 1024); } while (0)
#define PG8_LDB(dst, b, h) do { _Pragma("unroll") for (int n = 0; n < 2; ++n) _Pragma("unroll") for (int k = 0; k < 2; ++k) dst[n][k] = *(const PG8_LAS bf16x8*)(lds + PG8_SB(b, h) + boff + n * 2048 + k * 1024); } while (0)
#define PG8_MMA(ai, bj, At, Bt) do { __builtin_amdgcn_s_setprio(1); _Pragma("unroll") for (int m = 0; m < 4; ++m) _Pragma("unroll") for (int n = 0; n < 2; ++n) _Pragma("unroll") for (int k = 0; k < 2; ++k) \
        acc[ai][bj][m][n] = __builtin_amdgcn_mfma_f32_16x16x32_bf16(Bt[n][k], At[m][k], acc[ai][bj][m][n], 0, 0, 0); __builtin_amdgcn_s_setprio(0); } while (0)
#define PG8_WAIT_V(n) asm volatile("s_waitcnt vmcnt(" #n ")" ::: "memory")
#define PG8_WAIT_L(n) asm volatile("s_waitcnt lgkmcnt(" #n ")" ::: "memory")
#define PG8_BAR __builtin_amdgcn_s_barrier()
#define PG8_SCHED __builtin_amdgcn_sched_barrier(0)
    Unit cur, nxt; int ui = 0;
    if (!S.next(0, cur)) return;
    f32x4 acc[2][2][4][2];
#pragma unroll
    for (int a = 0; a < 2; ++a)
#pragma unroll
        for (int b = 0; b < 2; ++b)
#pragma unroll
            for (int m = 0; m < 4; ++m)
#pragma unroll
                for (int n = 0; n < 2; ++n) acc[a][b][m][n] = (f32x4){0.f, 0.f, 0.f, 0.f};
    bf16x8 At[4][2], B0[2][2], B1[2][2];
    const char* cA = (const char*)g.A + (size_t)cur.pm * tstep; const char* cB = (const char*)g.Bt + (size_t)cur.pn * tstep;
    S.a_ready(cur);
    if constexpr (SP2) {
        PG8_STAGE(PG8_SB(0, 0), cB, voffB); PG8_STAGE(PG8_SB(0, 1), cB + hstep, voffB); PG8_STAGE(PG8_SA(0, 0), cA, voffA); PG8_STAGE(PG8_SA(0, 1), cA + hstep, voffA);
        if (wr == 1) PG8_BAR;
        PG8_WAIT_V(2); PG8_BAR;
        PG8_STAGE(PG8_SB(1, 0), cB + kstep, voffB); PG8_STAGE(PG8_SA(1, 0), cA + kstep, voffA); PG8_STAGE(PG8_SB(1, 1), cB + hstep + kstep, voffB);
        PG8_WAIT_V(6); PG8_BAR;
    } else {
        PG8_STAGE(PG8_SB(0, 0), cB, voffB); PG8_STAGE(PG8_SA(0, 0), cA, voffA); PG8_STAGE(PG8_SB(0, 1), cB + hstep, voffB); PG8_STAGE(PG8_SA(0, 1), cA + hstep, voffA);
        if (wr == 1) PG8_BAR;
        PG8_WAIT_V(4); PG8_BAR;
        PG8_STAGE(PG8_SB(1, 0), cB + kstep, voffB); PG8_STAGE(PG8_SA(1, 0), cA + kstep, voffA); PG8_STAGE(PG8_SB(1, 1), cB + hstep + kstep, voffB);
        PG8_WAIT_V(6); PG8_BAR;
    }
    for (;;) {
        const bool has_next = S.next(ui + 1, nxt);
        const char* nA = has_next ? (const char*)g.A + (size_t)nxt.pm * tstep : cA; const char* nB = has_next ? (const char*)g.Bt + (size_t)nxt.pn * tstep : cB;
        for (int t = 0; t < nt; t += 2) {
            const bool last = (t == nt - 2);
            const char* a1 = cA + (size_t)(t + 1) * kstep;
            const char* a2 = last ? nA : cA + (size_t)(t + 2) * kstep; const char* b2 = last ? nB : cB + (size_t)(t + 2) * kstep;
            const char* a3 = a2 + kstep; const char* b3 = b2 + kstep;
            if (last && has_next) S.a_ready(nxt);
            if constexpr (SP2) {
            PG8_LDB(B0, 0, 0); PG8_LDB(B1, 0, 1); PG8_SCHED; PG8_LDA(At, 0, 0); PG8_STAGE(PG8_SA(1, 1), a1 + hstep, voffA);
            PG8_WAIT_V(8); PG8_WAIT_L(0); PG8_BAR; PG8_MMA(0, 0, At, B0); PG8_MMA(0, 1, At, B1); PG8_BAR; PG8_SCHED;
            PG8_LDA(At, 0, 1); PG8_STAGE(PG8_SB(0, 0), b2, voffB); PG8_STAGE(PG8_SB(0, 1), b2 + hstep, voffB); PG8_STAGE(PG8_SA(0, 0), a2, voffA);
            PG8_WAIT_V(8); PG8_WAIT_L(0); PG8_BAR; PG8_MMA(1, 0, At, B0); PG8_MMA(1, 1, At, B1); PG8_BAR; PG8_SCHED;
            PG8_LDB(B0, 1, 0); PG8_LDB(B1, 1, 1); PG8_SCHED; PG8_LDA(At, 1, 0); PG8_STAGE(PG8_SA(0, 1), a2 + hstep, voffA);
            PG8_WAIT_V(8); PG8_WAIT_L(0); PG8_BAR; PG8_MMA(0, 0, At, B0); PG8_MMA(0, 1, At, B1); PG8_BAR; PG8_SCHED;
            PG8_LDA(At, 1, 1); PG8_STAGE(PG8_SB(1, 0), b3, voffB); PG8_STAGE(PG8_SB(1, 1), b3 + hstep, voffB); PG8_STAGE(PG8_SA(1, 0), a3, voffA);
            PG8_WAIT_V(8); PG8_WAIT_L(0); PG8_BAR; PG8_MMA(1, 0, At, B0); PG8_MMA(1, 1, At, B1); PG8_BAR; PG8_SCHED;
            } else {
            PG8_LDB(B0, 0, 0); PG8_SCHED; PG8_LDA(At, 0, 0); PG8_STAGE(PG8_SA(1, 1), a1 + hstep, voffA);
            PG8_WAIT_L(8); PG8_BAR; PG8_WAIT_L(0); PG8_MMA(0, 0, At, B0); PG8_BAR; PG8_SCHED;
            PG8_LDB(B1, 0, 1); PG8_STAGE(PG8_SB(0, 0), b2, voffB);
            PG8_BAR; PG8_WAIT_L(0); PG8_MMA(0, 1, At, B1); PG8_BAR;
            PG8_LDA(At, 0, 1); PG8_STAGE(PG8_SA(0, 0), a2, voffA);
            PG8_BAR; PG8_WAIT_L(0); PG8_MMA(1, 0, At, B0); PG8_BAR; PG8_SCHED;
            PG8_STAGE(PG8_SB(0, 1), b2 + hstep, voffB);
            PG8_WAIT_V(6); PG8_BAR; PG8_MMA(1, 1, At, B1); PG8_BAR;
            PG8_LDB(B0, 1, 0); PG8_SCHED; PG8_LDA(At, 1, 0); PG8_STAGE(PG8_SA(0, 1), a2 + hstep, voffA);
            PG8_WAIT_L(8); PG8_BAR; PG8_WAIT_L(0); PG8_MMA(0, 0, At, B0); PG8_BAR; PG8_SCHED;
            PG8_LDB(B1, 1, 1); PG8_STAGE(PG8_SB(1, 0), b3, voffB);
            PG8_BAR; PG8_WAIT_L(0); PG8_MMA(0, 1, At, B1); PG8_BAR;
            PG8_LDA(At, 1, 1); PG8_STAGE(PG8_SA(1, 0), a3, voffA);
            PG8_BAR; PG8_WAIT_L(0); PG8_MMA(1, 0, At, B0); PG8_BAR; PG8_SCHED;
            PG8_STAGE(PG8_SB(1, 1), b3 + hstep, voffB);
            PG8_WAIT_V(6); PG8_BAR; PG8_MMA(1, 1, At, B1); PG8_BAR;
            }
        }
        if constexpr (ALIGN_EPI) { if (wr == 0) PG8_BAR; }
        if constexpr (!Epi::AFTER_DRAIN) { E(acc, cur, wr, wc, fr, fq); S.done(cur); }
        if (!has_next) break;
#pragma unroll
        for (int a = 0; a < 2; ++a)
#pragma unroll
            for (int b = 0; b < 2; ++b)
#pragma unroll
                for (int m = 0; m < 4; ++m)
#pragma unroll
                    for (int n = 0; n < 2; ++n) acc[a][b][m][n] = (f32x4){0.f, 0.f, 0.f, 0.f};
        cur = nxt; cA = nA; cB = nB; ++ui;
        if constexpr (ALIGN_EPI) { if (wr == 1) PG8_BAR; }
    }
    PG8_WAIT_V(0);
    if constexpr (!ALIGN_EPI) { if (wr == 0) PG8_BAR; }
    PG8_BAR;
    if constexpr (Epi::AFTER_DRAIN) { E.fused(acc, cur, wr, wc, fr, fq, lds, wid, lane); S.done(cur); }
#undef PG8_SA
#undef PG8_SB
#undef PG8_STAGE
#undef PG8_LDA
#undef PG8_LDB
#undef PG8_MMA
#undef PG8_WAIT_V
#undef PG8_WAIT_L
#undef PG8_BAR
#undef PG8_SCHED
}
template <class Epi, class Sched, bool ALIGN_EPI = false, bool SP2 = false>
__device__ __forceinline__ void gemm_phase_i8(PG8_LAS unsigned char* lds, const Gemm g, const Sched& S, const Epi& E) {
    const int tid = threadIdx.x, wid = __builtin_amdgcn_readfirstlane(tid >> 6), lane = tid & 63, wr = wid >> 2, wc = wid & 3, fr = lane & 15, fq = lane >> 4;
    const int K = g.K, nt = K / BK;
    unsigned voffA[2], voffB[2];
#pragma unroll
    for (int i = 0; i < 2; ++i) { int R, C; stage_rc(tid * 16 + i * 8192, R, C); const int Rb = Epi::PERM ? ((R & ~31) + perm32(R & 31)) : R;
        voffA[i] = (unsigned)(R * K + C) * 2u; voffB[i] = (unsigned)(Rb * K + C) * 2u; }
    const size_t kstep = (size_t)(BK * 2);
    const size_t hstep = (size_t)HALF * K * 2;
    const size_t tstep = 2 * hstep;
    const unsigned ldsw = (unsigned)wid * 1024u;
    const int aoff = lds_byte(wr * 64 + fr, fq * 8), boff = lds_byte(wc * 32 + fr, fq * 8);
#define PG8_SA(b, h) (((b) * 2 + (h)) * HTB)
#define PG8_SB(b, h) ((4 + (b) * 2 + (h)) * HTB)
#define PG8_STAGE(bufoff, gbase, voff) do { _Pragma("unroll") for (int _i = 0; _i < 2; ++_i) \
        __builtin_amdgcn_global_load_lds((const unsigned*)((const char*)(gbase) + (voff)[_i]), (PG8_LAS unsigned*)(lds + (bufoff) + ldsw + _i * 8192), 16, 0, 0); } while (0)
#define PG8_LDA(dst, b, h) do { _Pragma("unroll") for (int m = 0; m < 4; ++m) _Pragma("unroll") for (int k = 0; k < 2; ++k) dst[m][k] = *(const PG8_LAS bf16x8*)(lds + PG8_SA(b, h) + aoff + m * 2048 + k * 1024); } while (0)
#define PG8_LDB(dst, b, h) do { _Pragma("unroll") for (int n = 0; n < 2; ++n) _Pragma("unroll") for (int k = 0; k < 2; ++k) dst[n][k] = *(const PG8_LAS bf16x8*)(lds + PG8_SB(b, h) + boff + n * 2048 + k * 1024); } while (0)
#define PG8_MMA(ai, bj, At, Bt) do { __builtin_amdgcn_s_setprio(1); _Pragma("unroll") for (int m = 0; m < 4; ++m) _Pragma("unroll") for (int n = 0; n < 2; ++n) _Pragma("unroll") for (int k = 0; k < 2; ++k) \
        acc[ai][bj][m][n] = __builtin_amdgcn_mfma_i32_16x16x64_i8(__builtin_bit_cast(i32x4, Bt[n][k]), __builtin_bit_cast(i32x4, At[m][k]), acc[ai][bj][m][n], 0, 0, 0); __builtin_amdgcn_s_setprio(0); } while (0)
#define PG8_WAIT_V(n) asm volatile("s_waitcnt vmcnt(" #n ")" ::: "memory")
#define PG8_WAIT_L(n) asm volatile("s_waitcnt lgkmcnt(" #n ")" ::: "memory")
#define PG8_BAR __builtin_amdgcn_s_barrier()
#define PG8_SCHED __builtin_amdgcn_sched_barrier(0)
    Unit cur, nxt; int ui = 0;
    if (!S.next(0, cur)) return;
    i32x4 acc[2][2][4][2];
#pragma unroll
    for (int a = 0; a < 2; ++a)
#pragma unroll
        for (int b = 0; b < 2; ++b)
#pragma unroll
            for (int m = 0; m < 4; ++m)
#pragma unroll
                for (int n = 0; n < 2; ++n) acc[a][b][m][n] = (i32x4){0, 0, 0, 0};
    bf16x8 At[4][2], B0[2][2], B1[2][2];
    const char* cA = (const char*)g.A + (size_t)cur.pm * tstep; const char* cB = (const char*)g.Bt + (size_t)cur.pn * tstep;
    S.a_ready(cur);
    if constexpr (SP2) {
        PG8_STAGE(PG8_SB(0, 0), cB, voffB); PG8_STAGE(PG8_SB(0, 1), cB + hstep, voffB); PG8_STAGE(PG8_SA(0, 0), cA, voffA); PG8_STAGE(PG8_SA(0, 1), cA + hstep, voffA);
        if (wr == 1) PG8_BAR;
        PG8_WAIT_V(2); PG8_BAR;
        PG8_STAGE(PG8_SB(1, 0), cB + kstep, voffB); PG8_STAGE(PG8_SA(1, 0), cA + kstep, voffA); PG8_STAGE(PG8_SB(1, 1), cB + hstep + kstep, voffB);
        PG8_WAIT_V(6); PG8_BAR;
    } else {
        PG8_STAGE(PG8_SB(0, 0), cB, voffB); PG8_STAGE(PG8_SA(0, 0), cA, voffA); PG8_STAGE(PG8_SB(0, 1), cB + hstep, voffB); PG8_STAGE(PG8_SA(0, 1), cA + hstep, voffA);
        if (wr == 1) PG8_BAR;
        PG8_WAIT_V(4); PG8_BAR;
        PG8_STAGE(PG8_SB(1, 0), cB + kstep, voffB); PG8_STAGE(PG8_SA(1, 0), cA + kstep, voffA); PG8_STAGE(PG8_SB(1, 1), cB + hstep + kstep, voffB);
        PG8_WAIT_V(6); PG8_BAR;
    }
    for (;;) {
        const bool has_next = S.next(ui + 1, nxt);
        const char* nA = has_next ? (const char*)g.A + (size_t)nxt.pm * tstep : cA; const char* nB = has_next ? (const char*)g.Bt + (size_t)nxt.pn * tstep : cB;
        for (int t = 0; t < nt; t += 2) {
            const bool last = (t == nt - 2);
            const char* a1 = cA + (size_t)(t + 1) * kstep;
            const char* a2 = last ? nA : cA + (size_t)(t + 2) * kstep; const char* b2 = last ? nB : cB + (size_t)(t + 2) * kstep;
            const char* a3 = a2 + kstep; const char* b3 = b2 + kstep;
            if (last && has_next) S.a_ready(nxt);
            if constexpr (SP2) {
            PG8_LDB(B0, 0, 0); PG8_LDB(B1, 0, 1); PG8_SCHED; PG8_LDA(At, 0, 0); PG8_STAGE(PG8_SA(1, 1), a1 + hstep, voffA);
            PG8_WAIT_V(8); PG8_WAIT_L(0); PG8_BAR; PG8_MMA(0, 0, At, B0); PG8_MMA(0, 1, At, B1); PG8_BAR; PG8_SCHED;
            PG8_LDA(At, 0, 1); PG8_STAGE(PG8_SB(0, 0), b2, voffB); PG8_STAGE(PG8_SB(0, 1), b2 + hstep, voffB); PG8_STAGE(PG8_SA(0, 0), a2, voffA);
            PG8_WAIT_V(8); PG8_WAIT_L(0); PG8_BAR; PG8_MMA(1, 0, At, B0); PG8_MMA(1, 1, At, B1); PG8_BAR; PG8_SCHED;
            PG8_LDB(B0, 1, 0); PG8_LDB(B1, 1, 1); PG8_SCHED; PG8_LDA(At, 1, 0); PG8_STAGE(PG8_SA(0, 1), a2 + hstep, voffA);
            PG8_WAIT_V(8); PG8_WAIT_L(0); PG8_BAR; PG8_MMA(0, 0, At, B0); PG8_MMA(0, 1, At, B1); PG8_BAR; PG8_SCHED;
            PG8_LDA(At, 1, 1); PG8_STAGE(PG8_SB(1, 0), b3, voffB); PG8_STAGE(PG8_SB(1, 1), b3 + hstep, voffB); PG8_STAGE(PG8_SA(1, 0), a3, voffA);
            PG8_WAIT_V(8); PG8_WAIT_L(0); PG8_BAR; PG8_MMA(1, 0, At, B0); PG8_MMA(1, 1, At, B1); PG8_BAR; PG8_SCHED;
            } else {
            PG8_LDB(B0, 0, 0); PG8_SCHED; PG8_LDA(At, 0, 0); PG8_STAGE(PG8_SA(1, 1), a1 + hstep, voffA);
            PG8_WAIT_L(8); PG8_BAR; PG8_WAIT_L(0); PG8_MMA(0, 0, At, B0); PG8_BAR; PG8_SCHED;
            PG8_LDB(B1, 0, 1); PG8_STAGE(PG8_SB(0, 0), b2, voffB);
            PG8_BAR; PG8_WAIT_L(0); PG8_MMA(0, 1, At, B1); PG8_BAR;
            PG8_LDA(At, 0, 1); PG8_STAGE(PG8_SA(0, 0), a2, voffA);
            PG8_BAR; PG8_WAIT_L(0); PG8_MMA(1, 0, At, B0); PG8_BAR; PG8_SCHED;
            PG8_STAGE(PG8_SB(0, 1), b2 + hstep, voffB);
            PG8_WAIT_V(6); PG8_BAR; PG8_MMA(1, 1, At, B1); PG8_BAR;
            PG8_LDB(B0, 1, 0); PG8_SCHED; PG8_LDA(At, 1, 0); PG8_STAGE(PG8_SA(0, 1), a2 + hstep, voffA);
            PG8_WAIT_L(8); PG8_BAR; PG8_WAIT_L(0); PG8_MMA(0, 0, At, B0); PG8_BAR; PG8_SCHED;
            PG8_LDB(B1, 1, 1); PG8_STAGE(PG8_SB(1, 0), b3, voffB);
            PG8_BAR; PG8_WAIT_L(0); PG8_MMA(0, 1, At, B1); PG8_BAR;
            PG8_LDA(At, 1, 1); PG8_STAGE(PG8_SA(1, 0), a3, voffA);
            PG8_BAR; PG8_WAIT_L(0); PG8_MMA(1, 0, At, B0); PG8_BAR; PG8_SCHED;
            PG8_STAGE(PG8_SB(1, 1), b3 + hstep, voffB);
            PG8_WAIT_V(6); PG8_BAR; PG8_MMA(1, 1, At, B1); PG8_BAR;
            }
        }
        if constexpr (ALIGN_EPI) { if (wr == 0) PG8_BAR; }
        if constexpr (!Epi::AFTER_DRAIN) { E(acc, cur, wr, wc, fr, fq); S.done(cur); }
        if (!has_next) break;
#pragma unroll
        for (int a = 0; a < 2; ++a)
#pragma unroll
            for (int b = 0; b < 2; ++b)
#pragma unroll
                for (int m = 0; m < 4; ++m)
#pragma unroll
                    for (int n = 0; n < 2; ++n) acc[a][b][m][n] = (i32x4){0, 0, 0, 0};
        cur = nxt; cA = nA; cB = nB; ++ui;
        if constexpr (ALIGN_EPI) { if (wr == 1) PG8_BAR; }
    }
    PG8_WAIT_V(0);
    if constexpr (!ALIGN_EPI) { if (wr == 0) PG8_BAR; }
    PG8_BAR;
    if constexpr (Epi::AFTER_DRAIN) { E.fused(acc, cur, wr, wc, fr, fq, lds, wid, lane); S.done(cur); }
#undef PG8_SA
#undef PG8_SB
#undef PG8_STAGE
#undef PG8_LDA
#undef PG8_LDB
#undef PG8_MMA
#undef PG8_WAIT_V
#undef PG8_WAIT_L
#undef PG8_BAR
#undef PG8_SCHED
}
}

#define LAS __attribute__((address_space(3)))
typedef unsigned short bf16;
typedef float f32x2 __attribute__((ext_vector_type(2)));
typedef float f32x4 __attribute__((ext_vector_type(4)));
typedef unsigned u32x2 __attribute__((ext_vector_type(2)));
typedef unsigned u32x4 __attribute__((ext_vector_type(4)));

constexpr int PDIM = 1536;
constexpr int NTOK = 32768, DM = 1024, DIN = 2560, SEQ = 8192, NBATCH = 4, NMETA = 16;
constexpr int NHEAD = 8, NKEYS = 128, TOPK = 16, NSEL = NHEAD * TOPK;
constexpr float EPS = 1e-6f;
constexpr float U_SCALE = 64.f, V_SCALE = 16.f;
constexpr float U4_CLIP = 2.6f;
constexpr int NWAVES = 8, NTHREADS = 512;
constexpr int MKC = 32;
constexpr int LDS_BYTES = 147456;

constexpr size_t MiB = 1u << 20;
constexpr size_t WS_CTL = 0, WS_WIN_T = 1 * MiB, WS_WOUT_T = 6 * MiB, WS_WQ_T = 8 * MiB, WS_KEYS = 12 * MiB, WS_METAPART = 160 * MiB  ,
                 WS_METARSTD = 14 * MiB + 512 * 1024, WS_METAPROJ = 14 * MiB + 576 * 1024, WS_RSTD1 = 15 * MiB, WS_SSQ = 16 * MiB, WS_U8 = 32 * MiB, WS_V8 = 48 * MiB,
                 WS_IDX = 64 * MiB, WS_GATE = 80 * MiB, WS_H0B = 96 * MiB, WS_H2B = 96 * MiB, WS_Y = 160 * MiB, WS_PROJ = 224 * MiB,
                 WS_Q = 224 * MiB, WS_ESCALE = 18 * MiB, WS_SUMQ = 19 * MiB, WS_SX = 20 * MiB, WS_SW = 21 * MiB, WS_SY = 22 * MiB, WS_SWO = 23 * MiB, WS_WMX = 24 * MiB, WS_AMX = 26 * MiB, WS_RF = 28 * MiB, WS_SWQ = 29 * MiB, WS_H0I8 = 384 * MiB, WS_AW = 160 * MiB  , WS_END = 416 * MiB;

struct Params {
    const float* x; const float* meta; const float* g_mix; const float* w_in; const float* sc_w; const float* cf_w; const float* cf_b;
    const float* ln_g; const float* ln_b; const float* g_sc; const float* g_cf; const float* w_out; const float* g_ffn; const float* w_q;
    const float* keys; const float* pu; const float* pv; const float* g_fin;
    float* out; unsigned char* ws;
    int ph_lo, ph_hi, coop, pad;
};

__device__ __forceinline__ unsigned f2bf(float f) { unsigned u = __builtin_bit_cast(unsigned, f); return (u + 0x7fffu + ((u >> 16) & 1u)) >> 16; }
__device__ __forceinline__ unsigned pk2(float lo, float hi) { return f2bf(lo) | (f2bf(hi) << 16); }
__device__ __forceinline__ float bf2f(unsigned b) { return __builtin_bit_cast(float, b << 16); }
__device__ __forceinline__ float bflo(unsigned w) { return __builtin_bit_cast(float, w << 16); }
__device__ __forceinline__ float bfhi(unsigned w) { return __builtin_bit_cast(float, w & 0xffff0000u); }
__device__ __forceinline__ float wave_sum(float v) {
#pragma unroll
    for (int o = 1; o < 64; o <<= 1) v += __shfl_xor(v, o);
    return v;
}
template <int CTRL> __device__ __forceinline__ float dpp_f(float v) { return __builtin_bit_cast(float, __builtin_amdgcn_update_dpp(0, __builtin_bit_cast(int, v), CTRL, 0xf, 0xf, true)); }
__device__ __forceinline__ float wave_sum_fast(float v) {
    v += dpp_f<0xB1>(v); v += dpp_f<0x4E>(v); v += dpp_f<0x141>(v); v += dpp_f<0x140>(v);
    { auto r = __builtin_amdgcn_permlane16_swap(__float_as_uint(v), __float_as_uint(v), false, false); v = __uint_as_float(r[0]) + __uint_as_float(r[1]); }
    { auto r = __builtin_amdgcn_permlane32_swap(__float_as_uint(v), __float_as_uint(v), false, false); v = __uint_as_float(r[0]) + __uint_as_float(r[1]); }
    return v;
}
__device__ __forceinline__ float wave_max_fast(float v) {
    v = fmaxf(v, dpp_f<0xB1>(v)); v = fmaxf(v, dpp_f<0x4E>(v)); v = fmaxf(v, dpp_f<0x141>(v)); v = fmaxf(v, dpp_f<0x140>(v));
    { auto r = __builtin_amdgcn_permlane16_swap(__float_as_uint(v), __float_as_uint(v), false, false); v = fmaxf(__uint_as_float(r[0]), __uint_as_float(r[1])); }
    { auto r = __builtin_amdgcn_permlane32_swap(__float_as_uint(v), __float_as_uint(v), false, false); v = fmaxf(__uint_as_float(r[0]), __uint_as_float(r[1])); }
    return v;
}
__device__ __forceinline__ float sigmoid_f(float x) { return 1.f / (1.f + __expf(-x)); }
__device__ __forceinline__ float gelu_tanh_f(float x) {
    const float t = 0.7978845608028654f * (x + 0.044715f * x * x * x);
    const float e = __expf(2.f * t);
    const float th = 1.f - 2.f / (e + 1.f);
    return 0.5f * x * (1.f + th);
}

__device__ __forceinline__ unsigned cvt_pk_bf16(float lo, float hi) { unsigned r; asm volatile("v_cvt_pk_bf16_f32 %0, %1, %2" : "=v"(r) : "v"(lo), "v"(hi)); return r; }

template <int MODE> struct EpiRowScale {
    static constexpr bool PERM = true, AFTER_DRAIN = false;
    bf16* O; int ldc; const float* rs;
    __device__ __forceinline__ void operator()(const pg8::f32x4 (&acc)[2][2][4][2], const pg8::Unit& u, int wr, int wc, int fr, int fq) const {
        const int row0 = u.pm * 256 + wr * 64 + fr, col0 = u.pn * 256 + wc * 32 + 8 * fq;
#pragma unroll
        for (int ai = 0; ai < 2; ++ai)
#pragma unroll
            for (int m = 0; m < 4; ++m) {
                const int row = row0 + ai * 128 + m * 16;
                float s;
                if (MODE == 0) s = rs[row];
                else { const f32x4* p = (const f32x4*)(rs + (size_t)row * 16); const f32x4 a = p[0], b = p[1], c = p[2], d = p[3];
                       const float t = ((a.x + a.y) + (a.z + a.w)) + ((b.x + b.y) + (b.z + b.w)) + ((c.x + c.y) + (c.z + c.w)) + ((d.x + d.y) + (d.z + d.w));
                       s = rsqrtf(t * (1.f / 1024.f) + EPS); }
                bf16* rowp = O + (size_t)row * ldc + col0;
#pragma unroll
                for (int bj = 0; bj < 2; ++bj) { const pg8::f32x4 v0 = acc[ai][bj][m][0] * s, v1 = acc[ai][bj][m][1] * s;
                    u32x4 w; w.x = cvt_pk_bf16(v0[0], v0[1]); w.y = cvt_pk_bf16(v0[2], v0[3]); w.z = cvt_pk_bf16(v1[0], v1[1]); w.w = cvt_pk_bf16(v1[2], v1[3]);
                    *(u32x4*)(rowp + bj * 128) = w; }
            }
    }
};
struct EpiProj {
    static constexpr bool PERM = true, AFTER_DRAIN = false;
    bf16* O; const float* rs;
    __device__ __forceinline__ void operator()(const pg8::f32x4 (&acc)[2][2][4][2], const pg8::Unit& u, int wr, int wc, int fr, int fq) const {
        const int row0 = u.pm * 256 + wr * 64 + fr, cin = wc * 32 + 8 * fq, pn = u.pn;
#pragma unroll
        for (int ai = 0; ai < 2; ++ai)
#pragma unroll
            for (int m = 0; m < 4; ++m) {
                const int row = row0 + ai * 128 + m * 16; const float sc = rs[row];
                float a[8], b[8];
#pragma unroll
                for (int i = 0; i < 4; ++i) { a[i] = acc[ai][0][m][0][i] * sc; a[4 + i] = acc[ai][0][m][1][i] * sc; b[i] = acc[ai][1][m][0][i] * sc; b[4 + i] = acc[ai][1][m][1][i] * sc; }
                bf16* rowp = O + (size_t)row * PDIM;
                if (pn >= 4 && pn < 6) {
                    u32x4 w0, w1; w0.x = cvt_pk_bf16(a[0], a[1]); w0.y = cvt_pk_bf16(a[2], a[3]); w0.z = cvt_pk_bf16(a[4], a[5]); w0.w = cvt_pk_bf16(a[6], a[7]);
                    w1.x = cvt_pk_bf16(b[0], b[1]); w1.y = cvt_pk_bf16(b[2], b[3]); w1.z = cvt_pk_bf16(b[4], b[5]); w1.w = cvt_pk_bf16(b[6], b[7]);
                    *(u32x4*)(rowp + 512 + 256 * (pn - 4) + cin) = w0; *(u32x4*)(rowp + 512 + 256 * (pn - 4) + 128 + cin) = w1;
                } else {
                    float o[8];
                    if (pn < 4) {
#pragma unroll
                        for (int i = 0; i < 8; ++i) o[i] = a[i] * b[i];
                    } else {
#pragma unroll
                        for (int i = 0; i < 8; ++i) o[i] = a[i] * sigmoid_f(b[i]);
                    }
                    u32x4 w; w.x = cvt_pk_bf16(o[0], o[1]); w.y = cvt_pk_bf16(o[2], o[3]); w.z = cvt_pk_bf16(o[4], o[5]); w.w = cvt_pk_bf16(o[6], o[7]);
                    *(u32x4*)(rowp + (pn < 4 ? 128 * pn : 1024 + 128 * (pn - 6)) + cin) = w;
                }
            }
    }
};
struct EpiProjI8 {
    static constexpr bool PERM = true, AFTER_DRAIN = false;
    bf16* O; const float* rs; const float* sw;
    __device__ __forceinline__ void operator()(const pg8::i32x4 (&acc)[2][2][4][2], const pg8::Unit& u, int wr, int wc, int fr, int fq) const {
        const int row0 = u.pm * 256 + wr * 64 + fr, cin = wc * 32 + 8 * fq, pn = u.pn;
        float swa[8], swb[8];
        { const f32x4 a0 = *(const f32x4*)(sw + 256 * pn + cin), a1 = *(const f32x4*)(sw + 256 * pn + cin + 4), b0 = *(const f32x4*)(sw + 256 * pn + 128 + cin), b1 = *(const f32x4*)(sw + 256 * pn + 128 + cin + 4);
          swa[0] = a0.x; swa[1] = a0.y; swa[2] = a0.z; swa[3] = a0.w; swa[4] = a1.x; swa[5] = a1.y; swa[6] = a1.z; swa[7] = a1.w;
          swb[0] = b0.x; swb[1] = b0.y; swb[2] = b0.z; swb[3] = b0.w; swb[4] = b1.x; swb[5] = b1.y; swb[6] = b1.z; swb[7] = b1.w; }
#pragma unroll
        for (int ai = 0; ai < 2; ++ai)
#pragma unroll
            for (int m = 0; m < 4; ++m) {
                const int row = row0 + ai * 128 + m * 16; const float sc = rs[row];
                float a[8], b[8];
#pragma unroll
                for (int i = 0; i < 4; ++i) { a[i] = (float)acc[ai][0][m][0][i] * (sc * swa[i]); a[4 + i] = (float)acc[ai][0][m][1][i] * (sc * swa[4 + i]);
                    b[i] = (float)acc[ai][1][m][0][i] * (sc * swb[i]); b[4 + i] = (float)acc[ai][1][m][1][i] * (sc * swb[4 + i]); }
                bf16* rowp = O + (size_t)row * PDIM;
                if (pn >= 4 && pn < 6) {
                    u32x4 w0, w1; w0.x = cvt_pk_bf16(a[0], a[1]); w0.y = cvt_pk_bf16(a[2], a[3]); w0.z = cvt_pk_bf16(a[4], a[5]); w0.w = cvt_pk_bf16(a[6], a[7]);
                    w1.x = cvt_pk_bf16(b[0], b[1]); w1.y = cvt_pk_bf16(b[2], b[3]); w1.z = cvt_pk_bf16(b[4], b[5]); w1.w = cvt_pk_bf16(b[6], b[7]);
                    *(u32x4*)(rowp + 512 + 256 * (pn - 4) + cin) = w0; *(u32x4*)(rowp + 512 + 256 * (pn - 4) + 128 + cin) = w1;
                } else {
                    float o[8];
                    if (pn < 4) {
#pragma unroll
                        for (int i = 0; i < 8; ++i) o[i] = a[i] * b[i];
                    } else {
#pragma unroll
                        for (int i = 0; i < 8; ++i) o[i] = a[i] * sigmoid_f(b[i]);
                    }
                    u32x4 w; w.x = cvt_pk_bf16(o[0], o[1]); w.y = cvt_pk_bf16(o[2], o[3]); w.z = cvt_pk_bf16(o[4], o[5]); w.w = cvt_pk_bf16(o[6], o[7]);
                    *(u32x4*)(rowp + (pn < 4 ? 128 * pn : 1024 + 128 * (pn - 6)) + cin) = w;
                }
            }
    }
};
__host__ __device__ __forceinline__ int win_src_col(int n) {
    const int t = n >> 8, j = n & 255;
    if (t < 4) return (j < 128) ? 128 * t + j : 1024 + 128 * t + (j - 128);
    if (t < 6) return 512 + 256 * (t - 4) + j;
    return (j < 128) ? 1536 + 128 * (t - 6) + j : 2048 + 128 * (t - 6) + (j - 128);
}
struct EpiResidual {
    static constexpr bool PERM = true, AFTER_DRAIN = false;
    bf16* O; const signed char* XB; const float* SX; float* ssq;
    __device__ __forceinline__ void operator()(const pg8::f32x4 (&acc)[2][2][4][2], const pg8::Unit& u, int wr, int wc, int fr, int fq) const {
        const int row0 = u.pm * 256 + wr * 64 + fr, col0 = u.pn * 256 + wc * 32 + 8 * fq;
#pragma unroll
        for (int ai = 0; ai < 2; ++ai)
#pragma unroll
            for (int m = 0; m < 4; ++m) {
                const int row = row0 + ai * 128 + m * 16;
                const signed char* xr = XB + (size_t)row * DM + col0; bf16* rowp = O + (size_t)row * DM + col0;
                float q = 0.f;
                u32x2 xw[2]; const float sxr = SX[row];
#pragma unroll
                for (int bj = 0; bj < 2; ++bj) xw[bj] = *(const u32x2*)(xr + bj * 128);
#pragma unroll
                for (int bj = 0; bj < 2; ++bj) {
                    const f32x4 x0 = (f32x4){(float)(signed char)(xw[bj].x), (float)(signed char)(xw[bj].x >> 8), (float)(signed char)(xw[bj].x >> 16), (float)((int)xw[bj].x >> 24)} * sxr,
                                x1 = (f32x4){(float)(signed char)(xw[bj].y), (float)(signed char)(xw[bj].y >> 8), (float)(signed char)(xw[bj].y >> 16), (float)((int)xw[bj].y >> 24)} * sxr;
                    const pg8::f32x4 v0 = acc[ai][bj][m][0] + x0, v1 = acc[ai][bj][m][1] + x1;
                    q += (v0[0] * v0[0] + v0[1] * v0[1]) + (v0[2] * v0[2] + v0[3] * v0[3]) + (v1[0] * v1[0] + v1[1] * v1[1]) + (v1[2] * v1[2] + v1[3] * v1[3]);
                    u32x4 w; w.x = cvt_pk_bf16(v0[0], v0[1]); w.y = cvt_pk_bf16(v0[2], v0[3]); w.z = cvt_pk_bf16(v1[0], v1[1]); w.w = cvt_pk_bf16(v1[2], v1[3]);
                    *(u32x4*)(rowp + bj * 128) = w; }
                q += __shfl_xor(q, 16); q += __shfl_xor(q, 32);
                if (fq == 0) ssq[(size_t)row * 16 + u.pn * 4 + wc] = q;
            }
    }
};

struct EpiResidualI8 {
    static constexpr bool PERM = true, AFTER_DRAIN = false;
    bf16* O; const signed char* XB; const float* SX; const float* SY; const float* SWO; float* ssq; float* amx;
    __device__ __forceinline__ void operator()(const pg8::i32x4 (&acc)[2][2][4][2], const pg8::Unit& u, int wr, int wc, int fr, int fq) const {
        const int row0 = u.pm * 256 + wr * 64 + fr, col0 = u.pn * 256 + wc * 32 + 8 * fq;
        f32x4 sw[2][2];
#pragma unroll
        for (int bj = 0; bj < 2; ++bj) { sw[bj][0] = *(const f32x4*)(SWO + col0 + bj * 128); sw[bj][1] = *(const f32x4*)(SWO + col0 + bj * 128 + 4); }
#pragma unroll
        for (int ai = 0; ai < 2; ++ai)
#pragma unroll
            for (int m = 0; m < 4; ++m) {
                const int row = row0 + ai * 128 + m * 16;
                const signed char* xr = XB + (size_t)row * DM + col0; bf16* rowp = O + (size_t)row * DM + col0;
                float q = 0.f, mxa = 0.f;
                u32x2 xw[2]; const float sxr = SX[row], syr = SY[row];
#pragma unroll
                for (int bj = 0; bj < 2; ++bj) xw[bj] = *(const u32x2*)(xr + bj * 128);
#pragma unroll
                for (int bj = 0; bj < 2; ++bj) {
                    const f32x4 x0 = (f32x4){(float)(signed char)(xw[bj].x), (float)(signed char)(xw[bj].x >> 8), (float)(signed char)(xw[bj].x >> 16), (float)((int)xw[bj].x >> 24)} * sxr,
                                x1 = (f32x4){(float)(signed char)(xw[bj].y), (float)(signed char)(xw[bj].y >> 8), (float)(signed char)(xw[bj].y >> 16), (float)((int)xw[bj].y >> 24)} * sxr;
                    const pg8::i32x4 a0 = acc[ai][bj][m][0], a1 = acc[ai][bj][m][1];
                    const f32x4 v0 = (f32x4){(float)a0[0], (float)a0[1], (float)a0[2], (float)a0[3]} * (sw[bj][0] * syr) + x0, v1 = (f32x4){(float)a1[0], (float)a1[1], (float)a1[2], (float)a1[3]} * (sw[bj][1] * syr) + x1;
                    q += (v0[0] * v0[0] + v0[1] * v0[1]) + (v0[2] * v0[2] + v0[3] * v0[3]) + (v1[0] * v1[0] + v1[1] * v1[1]) + (v1[2] * v1[2] + v1[3] * v1[3]);
                    mxa = fmaxf(mxa, fmaxf(fmaxf(fmaxf(fabsf(v0[0]), fabsf(v0[1])), fmaxf(fabsf(v0[2]), fabsf(v0[3]))), fmaxf(fmaxf(fabsf(v1[0]), fabsf(v1[1])), fmaxf(fabsf(v1[2]), fabsf(v1[3])))));
                    u32x4 w; w.x = cvt_pk_bf16(v0[0], v0[1]); w.y = cvt_pk_bf16(v0[2], v0[3]); w.z = cvt_pk_bf16(v1[0], v1[1]); w.w = cvt_pk_bf16(v1[2], v1[3]);
                    *(u32x4*)(rowp + bj * 128) = w; }
                q += __shfl_xor(q, 16); q += __shfl_xor(q, 32);
                mxa = fmaxf(mxa, __shfl_xor(mxa, 16)); mxa = fmaxf(mxa, __shfl_xor(mxa, 32));
                if (fq == 0) { ssq[(size_t)row * 16 + u.pn * 4 + wc] = q; amx[(size_t)row * 16 + u.pn * 4 + wc] = mxa; }
            }
    }
};
template <bool MAPIN> __device__ __forceinline__ void p0_transpose_item(const float* W, int K, int N, bf16* WT, LAS float* scr, int item, int lane,
                                                  const float* g_lo, const float* g_hi, int split) {
    const int nblk = N / 32, kb = item / nblk, nb = item % nblk, k0 = 64 * kb, n0 = 32 * nb;
#pragma unroll 8
    for (int i = 0; i < 32; ++i) { const int kk = 2 * i + (lane >> 5); const int k = k0 + kk;
        const float g = (k < split) ? g_lo[k] : g_hi[k - split];
        scr[kk * 33 + (lane & 31)] = W[(size_t)k * N + (MAPIN ? win_src_col(n0) : n0) + (lane & 31)] * g; }
    asm volatile("s_waitcnt lgkmcnt(0)" ::: "memory");
    const int c = lane & 7;
#pragma unroll
    for (int j = 0; j < 4; ++j) { const int n = (lane >> 3) + 8 * j; const LAS float* s = scr + (8 * c) * 33 + n;
        u32x4 o; o.x = pk2(s[0 * 33], s[1 * 33]); o.y = pk2(s[2 * 33], s[3 * 33]); o.z = pk2(s[4 * 33], s[5 * 33]); o.w = pk2(s[6 * 33], s[7 * 33]);
        *(u32x4*)(WT + (size_t)(n0 + n) * K + k0 + 8 * c) = o; }
    asm volatile("s_waitcnt lgkmcnt(0)" ::: "memory");
}

constexpr int CW_COLMAX = 5120;
__device__ __forceinline__ void p0_colmax_item(const float* W, int N, unsigned* colmax, int item, int lane, const float* g) {
    const int nblk = N / 32, kb = item / nblk, nb = item % nblk, k0 = 64 * kb, n0 = 32 * nb;
    float mx = 0.f;
#pragma unroll
    for (int i = 0; i < 32; ++i) { const int k = k0 + 2 * i + (lane >> 5); mx = fmaxf(mx, fabsf(W[(size_t)k * N + n0 + (lane & 31)] * g[k])); }
    mx = fmaxf(mx, __shfl_xor(mx, 32));
    if (lane < 32) atomicMax(colmax + n0 + lane, __float_as_uint(mx));
}
__device__ __forceinline__ void p1_quant_item(const float* W, int K, int N, signed char* WT8, float* swout, const unsigned* colmax, LAS float* scr, int item, int lane, const float* g) {
    const int nblk = N / 32, kb = item / nblk, nb = item % nblk, k0 = 64 * kb, n0 = 32 * nb, s0 = win_src_col(n0);
    const float cm = fmaxf(__uint_as_float(colmax[s0 + (lane & 31)]), 1e-30f), inv = 127.f / cm;
    if (kb == 0 && lane < 32) swout[n0 + lane] = cm * (1.f / 127.f);
#pragma unroll
    for (int i = 0; i < 32; ++i) { const int kk = 2 * i + (lane >> 5); const int k = k0 + kk;
        scr[kk * 33 + (lane & 31)] = W[(size_t)k * N + s0 + (lane & 31)] * g[k] * inv; }
    asm volatile("s_waitcnt lgkmcnt(0)" ::: "memory");
    const int c = lane & 7;
#pragma unroll
    for (int j = 0; j < 4; ++j) { const int n = (lane >> 3) + 8 * j; const LAS float* sp = scr + (8 * c) * 33 + n;
        unsigned w0 = 0u, w1 = 0u;
#pragma unroll
        for (int i = 0; i < 4; ++i) { w0 |= ((unsigned)(int)rintf(sp[i * 33]) & 255u) << (8 * i); w1 |= ((unsigned)(int)rintf(sp[(4 + i) * 33]) & 255u) << (8 * i); }
        u32x2 o; o.x = w0; o.y = w1;
        *(u32x2*)(WT8 + (size_t)(n0 + n) * K + k0 + 8 * c) = o; }
    asm volatile("s_waitcnt lgkmcnt(0)" ::: "memory");
}
constexpr int CW_COLMAX3 = 8704;
constexpr int CW_COLMAX2 = 7680;
__device__ __forceinline__ void p0_colmax_item2(const float* W, int N, unsigned* colmax, int item, int lane, const float* g_lo, const float* g_hi, int split) {
    const int nblk = N / 32, kb = item / nblk, nb = item % nblk, k0 = 64 * kb, n0 = 32 * nb;
    float mx = 0.f;
#pragma unroll
    for (int i = 0; i < 32; ++i) { const int k = k0 + 2 * i + (lane >> 5); const float g = (k < split) ? g_lo[k] : g_hi[k - split]; mx = fmaxf(mx, fabsf(W[(size_t)k * N + n0 + (lane & 31)] * g)); }
    mx = fmaxf(mx, __shfl_xor(mx, 32));
    if (lane < 32) atomicMax(colmax + n0 + lane, __float_as_uint(mx));
}
__device__ __forceinline__ void p1_quant_item2(const float* W, int K, int N, signed char* WT8, float* swout, const unsigned* colmax, LAS float* scr, int item, int lane, const float* g_lo, const float* g_hi, int split) {
    const int nblk = N / 32, kb = item / nblk, nb = item % nblk, k0 = 64 * kb, n0 = 32 * nb;
    const float cm = fmaxf(__uint_as_float(colmax[n0 + (lane & 31)]), 1e-30f), inv = 127.f / cm;
    if (kb == 0 && lane < 32) swout[n0 + lane] = cm * (1.f / 127.f);
#pragma unroll
    for (int i = 0; i < 32; ++i) { const int kk = 2 * i + (lane >> 5); const int k = k0 + kk; const float g = (k < split) ? g_lo[k] : g_hi[k - split];
        scr[kk * 33 + (lane & 31)] = W[(size_t)k * N + n0 + (lane & 31)] * g * inv; }
    asm volatile("s_waitcnt lgkmcnt(0)" ::: "memory");
    const int c = lane & 7;
#pragma unroll
    for (int j = 0; j < 4; ++j) { const int n = (lane >> 3) + 8 * j; const LAS float* sp = scr + (8 * c) * 33 + n;
        unsigned w0 = 0u, w1 = 0u;
#pragma unroll
        for (int i = 0; i < 4; ++i) { w0 |= ((unsigned)(int)rintf(sp[i * 33]) & 255u) << (8 * i); w1 |= ((unsigned)(int)rintf(sp[(4 + i) * 33]) & 255u) << (8 * i); }
        u32x2 o; o.x = w0; o.y = w1;
        *(u32x2*)(WT8 + (size_t)(n0 + n) * K + k0 + 8 * c) = o; }
    asm volatile("s_waitcnt lgkmcnt(0)" ::: "memory");
}
__device__ __forceinline__ void phase_winq(const Params& P, LAS unsigned char* lds) {
    const int tid = threadIdx.x, lane = tid & 63, wave = __builtin_amdgcn_readfirstlane(tid >> 6);
    const int gw = blockIdx.x * NWAVES + wave, NGW = gridDim.x * NWAVES;
    LAS float* scr = (LAS float*)(lds + wave * 16384);
    constexpr int NI1 = (DM / 64) * (DIN / 32), NI2 = (DM / 64) * (DM / 32), NI3 = (DM / 64) * (2048 / 32);
    for (int it = gw; it < NI1 + NI2 + NI3; it += NGW) {
        if (it < NI1) p1_quant_item(P.w_in, DM, DIN, (signed char*)(P.ws + WS_WIN_T), (float*)(P.ws + WS_SW), (const unsigned*)(P.ws + WS_CTL) + CW_COLMAX, scr, it, lane, P.g_mix);
        else if (it < NI1 + NI2) p1_quant_item2(P.w_out, DM, DM, (signed char*)(P.ws + WS_WOUT_T), (float*)(P.ws + WS_SWO), (const unsigned*)(P.ws + WS_CTL) + CW_COLMAX2, scr, it - NI1, lane, P.g_sc, P.g_cf, 512);
        else p1_quant_item2(P.w_q, DM, 2048, (signed char*)(P.ws + WS_WQ_T), (float*)(P.ws + WS_SWQ), (const unsigned*)(P.ws + WS_CTL) + CW_COLMAX3, scr, it - NI1 - NI2, lane, P.g_ffn, P.g_ffn, DM);
    }
}
__device__ __forceinline__ float q4(float x, float inv_s) {
    const float a = fabsf(x) * inv_s; float r;
    if (a < 2.f) r = rintf(a * 2.f) * 0.5f; else if (a < 4.f) r = rintf(a); else r = fminf(6.f, rintf(a * 0.5f) * 2.f);
    return copysignf(r, x);
}
__device__ __forceinline__ void phase_prep(const Params& P, LAS unsigned char* lds) {
    const int tid = threadIdx.x, lane = tid & 63, wave = __builtin_amdgcn_readfirstlane(tid >> 6);
    const int gw = blockIdx.x * NWAVES + wave, NGW = gridDim.x * NWAVES;
    unsigned char* ws = P.ws;
    LAS float* scr = (LAS float*)(lds + wave * 16384);
    constexpr int I_IN = (DM / 64) * (DIN / 32), I_OUT = (DM / 64) * (DM / 32), I_Q = (DM / 64) * (2048 / 32);
    for (int it = gw; it < I_IN + I_OUT + I_Q; it += NGW) {
        int r = it;
        if (r < I_IN) { p0_colmax_item(P.w_in, DIN, (unsigned*)(ws + WS_CTL) + CW_COLMAX, r, lane, P.g_mix); continue; } r -= I_IN;
        if (r < I_OUT) { p0_colmax_item2(P.w_out, DM, (unsigned*)(ws + WS_CTL) + CW_COLMAX2, r, lane, P.g_sc, P.g_cf, 512); continue; } r -= I_OUT;
        p0_colmax_item2(P.w_q, 2048, (unsigned*)(ws + WS_CTL) + CW_COLMAX3, r, lane, P.g_ffn, P.g_ffn, DM);
    }
    {
        unsigned* H0I8 = (unsigned*)(ws + WS_H0I8); float* RS1 = (float*)(ws + WS_RSTD1); float* SXp = (float*)(ws + WS_SX);
        for (int t0 = gw * 4; t0 < NTOK; t0 += NGW * 4) {
            f32x4 v[4][4];
#pragma unroll
            for (int q = 0; q < 4; ++q) { const f32x4* xr = (const f32x4*)(P.x + (size_t)(t0 + q) * DM) + lane;
#pragma unroll
                for (int j = 0; j < 4; ++j) v[q][j] = xr[64 * j]; }
#pragma unroll
            for (int q = 0; q < 4; ++q) { float sq = 0.f, mx = 0.f;
#pragma unroll
                for (int j = 0; j < 4; ++j) { sq += (v[q][j].x * v[q][j].x + v[q][j].y * v[q][j].y) + (v[q][j].z * v[q][j].z + v[q][j].w * v[q][j].w);
                    mx = fmaxf(mx, fmaxf(fmaxf(fabsf(v[q][j].x), fabsf(v[q][j].y)), fmaxf(fabsf(v[q][j].z), fabsf(v[q][j].w)))); }
                sq = wave_sum_fast(sq); mx = fmaxf(wave_max_fast(mx), 1e-30f);
                const float sx = mx * (1.f / 127.f), inv = 127.f / mx;
                if (lane == 0) { RS1[t0 + q] = sx * rsqrtf(sq * (1.f / DM) + EPS); SXp[t0 + q] = sx; }
                unsigned* o = H0I8 + (size_t)(t0 + q) * (DM / 4) + lane;
#pragma unroll
                for (int j = 0; j < 4; ++j) { const int a = (int)rintf(v[q][j].x * inv), b = (int)rintf(v[q][j].y * inv), c = (int)rintf(v[q][j].z * inv), d = (int)rintf(v[q][j].w * inv);
                    o[64 * j] = ((unsigned)a & 255u) | (((unsigned)b & 255u) << 8) | (((unsigned)c & 255u) << 16) | ((unsigned)d << 24); } }
        }
    }
    {
        unsigned char* U8 = ws + WS_U8; unsigned char* V8 = ws + WS_V8;
        f32x4 gf[4];
#pragma unroll
        for (int j = 0; j < 4; ++j) gf[j] = ((const f32x4*)P.g_ffn)[64 * j + lane];
        float* ESC = (float*)(ws + WS_ESCALE);
        for (int e0 = gw * 2; e0 < 2 * 16384; e0 += NGW * 2) {
            const bool isv = e0 >= 16384; const int ee0 = isv ? e0 - 16384 : e0;
            f32x4 v[2][4];
#pragma unroll
            for (int q = 0; q < 2; ++q) { const f32x4* src = (const f32x4*)((isv ? P.pv : P.pu) + (size_t)(ee0 + q) * DM);
#pragma unroll
                for (int j = 0; j < 4; ++j) v[q][j] = isv ? src[4 * lane + j] : src[64 * j + lane]; }
#pragma unroll
            for (int q = 0; q < 2; ++q) {
                float mx = 0.f;
#pragma unroll
                for (int j = 0; j < 4; ++j) { if (!isv) v[q][j] = v[q][j] * gf[j];
                    mx = fmaxf(mx, fmaxf(fmaxf(fabsf(v[q][j].x), fabsf(v[q][j].y)), fmaxf(fabsf(v[q][j].z), fabsf(v[q][j].w)))); }
#pragma unroll
                for (int o = 1; o < 64; o <<= 1) mx = fmaxf(mx, __shfl_xor(mx, o));
                if (!isv) {
                    float sq2 = 0.f;
#pragma unroll
                    for (int j = 0; j < 4; ++j) sq2 += (v[q][j].x * v[q][j].x + v[q][j].y * v[q][j].y) + (v[q][j].z * v[q][j].z + v[q][j].w * v[q][j].w);
                    const float rms = sqrtf(wave_sum_fast(sq2) * (1.f / DM));
                    const float su = fmaxf(fminf(mx, U4_CLIP * rms), 1e-30f) * (1.f / 7.f), inv = 1.f / su;
                    unsigned wq[2] = {0u, 0u}; int csum = 0;
#pragma unroll
                    for (int j = 0; j < 4; ++j) { const float e4[4] = {v[q][j].x, v[q][j].y, v[q][j].z, v[q][j].w};
#pragma unroll
                        for (int i = 0; i < 4; ++i) { int c = (int)rintf(fminf(fmaxf(e4[i] * inv, -7.f), 7.f)); csum += c;
                            wq[j >> 1] |= ((unsigned)c & 15u) << (16 * (j & 1) + 4 * i); } }
                    const float cs = wave_sum_fast((float)csum);
                    if (lane == 0) { ESC[e0 + q] = su; ((float*)(ws + WS_SUMQ))[e0 + q] = cs; }
                    u32x2 o; o.x = wq[0]; o.y = wq[1];
                    *(u32x2*)(U8 + (size_t)(ee0 + q) * 512 + 8 * lane) = o;
                    continue;
                }
                const float sc = fmaxf(mx, 1e-30f) * (1.f / 6.f), inv = 1.f / sc;
                if (lane == 0) ESC[e0 + q] = sc;
                unsigned w0 = 0u, w1 = 0u;
                w0 = __builtin_amdgcn_cvt_scalef32_pk_fp4_f32(w0, v[q][0].x * inv, v[q][0].y * inv, 1.0f, 0); w0 = __builtin_amdgcn_cvt_scalef32_pk_fp4_f32(w0, v[q][0].z * inv, v[q][0].w * inv, 1.0f, 1);
                w0 = __builtin_amdgcn_cvt_scalef32_pk_fp4_f32(w0, v[q][1].x * inv, v[q][1].y * inv, 1.0f, 2); w0 = __builtin_amdgcn_cvt_scalef32_pk_fp4_f32(w0, v[q][1].z * inv, v[q][1].w * inv, 1.0f, 3);
                w1 = __builtin_amdgcn_cvt_scalef32_pk_fp4_f32(w1, v[q][2].x * inv, v[q][2].y * inv, 1.0f, 0); w1 = __builtin_amdgcn_cvt_scalef32_pk_fp4_f32(w1, v[q][2].z * inv, v[q][2].w * inv, 1.0f, 1);
                w1 = __builtin_amdgcn_cvt_scalef32_pk_fp4_f32(w1, v[q][3].x * inv, v[q][3].y * inv, 1.0f, 2); w1 = __builtin_amdgcn_cvt_scalef32_pk_fp4_f32(w1, v[q][3].z * inv, v[q][3].w * inv, 1.0f, 3);
                u32x2 o; o.x = w0; o.y = w1;
                *(u32x2*)((isv ? V8 : U8) + (size_t)(ee0 + q) * 512 + 8 * lane) = o;
            }
        }
    }
    {
        bf16* KB = (bf16*)(ws + WS_KEYS);
        const int gt = blockIdx.x * NTHREADS + tid, NGT = gridDim.x * NTHREADS;
        for (int i = gt; i < 8 * 2 * 128 * 128 / 4; i += NGT) { const f32x4 v = ((const f32x4*)P.keys)[i]; u32x2 w; w.x = pk2(v.x, v.y); w.y = pk2(v.z, v.w); ((u32x2*)KB)[i] = w; }
    }
    {
        float* MP = (float*)(ws + WS_METAPART); float* MR = (float*)(ws + WS_METARSTD);
        for (int r = gw; r < NMETA; r += NGW) {
            float s = 0.f;
            for (int k = lane; k < DM; k += 64) { const float v = P.meta[r * DM + k]; s += v * v; }
            s = wave_sum(s);
            if (lane == 0) MR[r] = rsqrtf(s * (1.f / DM) + EPS);
        }
        for (int it = gw; it < MKC * 40; it += NGW) {
            const int kc = it / 40, nb = it % 40, n = nb * 64 + lane;
            float acc[NMETA];
#pragma unroll
            for (int r = 0; r < NMETA; ++r) acc[r] = 0.f;
            for (int k = kc * (DM / MKC); k < (kc + 1) * (DM / MKC); ++k) {
                const float w = P.w_in[(size_t)k * DIN + n] * P.g_mix[k];
#pragma unroll
                for (int r = 0; r < NMETA; ++r) acc[r] += P.meta[r * DM + k] * w;
            }
#pragma unroll
            for (int r = 0; r < NMETA; ++r) MP[(size_t)(kc * 16 + r) * DIN + n] = acc[r];
        }
    }
}

__device__ __forceinline__ float metaraw(const float* MP, const float* MR, int p, int col) { float s = 0.f;
#pragma unroll 8
    for (int kc = 0; kc < MKC; ++kc) s += MP[(size_t)(kc * 16 + p) * DIN + col];
    return s * MR[p]; }
__device__ __forceinline__ void phase_metaproj(const Params& P) {
    const float* MP = (const float*)(P.ws + WS_METAPART); const float* MR = (const float*)(P.ws + WS_METARSTD); float* MJ = (float*)(P.ws + WS_METAPROJ);
    for (int gt = blockIdx.x * NTHREADS + threadIdx.x; gt < NMETA * PDIM; gt += gridDim.x * NTHREADS) { const int p = gt / PDIM, c = gt % PDIM; float v;
        if (c < 512) v = metaraw(MP, MR, p, c) * metaraw(MP, MR, p, 1024 + c);
        else if (c < 1024) v = metaraw(MP, MR, p, c);
        else v = metaraw(MP, MR, p, 1536 + (c - 1024)) * sigmoid_f(metaraw(MP, MR, p, 2048 + (c - 1024)));
        MJ[gt] = v; }
}
__device__ __forceinline__ float meta_val(const float* MJ, const float*, int p, int col) { return MJ[p * PDIM + col]; }
__device__ __forceinline__ float proj_at(const bf16* PROJ, const float* MP, const float* MR, int b, int pos, int col) {
    if (pos < 0) return 0.f;
    if (pos < NMETA) return meta_val(MP, MR, pos, col);
    return bf2f(PROJ[(size_t)(b * SEQ + pos - NMETA) * PDIM + col]);
}
__device__ __forceinline__ void proj8_at(const bf16* PROJ, const float* MP, const float* MR, int b, int pos, int col, float (&v)[8]) {
    if (pos < 0) {
#pragma unroll
        for (int i = 0; i < 8; ++i) v[i] = 0.f;
    } else if (pos < NMETA) {
        const f32x4 a = *(const f32x4*)(MP + pos * PDIM + col), bq = *(const f32x4*)(MP + pos * PDIM + col + 4);
        v[0] = a.x; v[1] = a.y; v[2] = a.z; v[3] = a.w; v[4] = bq.x; v[5] = bq.y; v[6] = bq.z; v[7] = bq.w;
    } else {
        const u32x4 w = *(const u32x4*)(PROJ + (size_t)(b * SEQ + pos - NMETA) * PDIM + col);
        v[0] = bflo(w.x); v[1] = bfhi(w.x); v[2] = bflo(w.y); v[3] = bfhi(w.y); v[4] = bflo(w.z); v[5] = bfhi(w.z); v[6] = bflo(w.w); v[7] = bfhi(w.w);
    }
}

template <int R> __device__ __forceinline__ void conv_rows(const LAS unsigned char* ubase, const f32x2 (&wcf)[31], f32x2 (&acc)[32]) {
    if constexpr (R < 62) {
        const unsigned uw = *(const LAS unsigned*)(ubase + R * 1024);
        const f32x2 x = (f32x2){bflo(uw), bfhi(uw)};
        constexpr int lo = R > 30 ? R - 30 : 0, hi = R < 31 ? R : 31;
#pragma unroll
        for (int ii = lo; ii <= hi; ++ii) acc[ii] += wcf[R - ii] * x;
        conv_rows<R + 1>(ubase, wcf, acc);
    }
}
__device__ __forceinline__ void phase_conv(const Params& P, LAS unsigned char* lds) {
    const int tid = threadIdx.x, lane = tid & 63, wave = __builtin_amdgcn_readfirstlane(tid >> 6);
    unsigned char* ws = P.ws;
    const bf16* PROJ = (const bf16*)(ws + WS_PROJ); const float* MP = (const float*)(ws + WS_METAPROJ); const float* MR = nullptr;
    bf16* Y = (bf16*)(ws + WS_Y);
    constexpr int TT = 64, NTILE = NTOK / TT, UROWS = TT + 30;
    const int cgp = wave & 3, th = wave >> 2, ch2 = cgp * 128 + 2 * lane;
    f32x2 wcf[31];
#pragma unroll
    for (int j = 0; j < 31; ++j) wcf[j] = *(const f32x2*)(P.cf_w + j * 512 + ch2);
    const f32x2 bcf = *(const f32x2*)(P.cf_b + ch2);
    for (int tile = blockIdx.x; tile < NTILE; tile += gridDim.x) {
        const int b = tile / (SEQ / TT), s0 = (tile % (SEQ / TT)) * TT;
        if (s0 >= 30) {
            const bf16* pr = PROJ + ((size_t)b * SEQ + s0 - 30) * PDIM + 1024 + 8 * lane;
            u32x4 rw[(UROWS + 7) / 8];
#pragma unroll
            for (int p = 0; p < (UROWS + 7) / 8; ++p) { const int r = p * 8 + wave; rw[p] = *(const u32x4*)(pr + (size_t)(r < UROWS ? r : UROWS - 1) * PDIM); }
#pragma unroll
            for (int p = 0; p < (UROWS + 7) / 8; ++p) { const int r = p * 8 + wave; if (r < UROWS) *(LAS u32x4*)(lds + r * 1024 + lane * 16) = rw[p]; }
        } else {
#pragma unroll 4
        for (int p = 0; p < (UROWS + 7) / 8; ++p) {
            const int r = p * 8 + wave;
            if (r < UROWS) {
                const int pos = NMETA + s0 - 30 + r;
                float uu[8];
                proj8_at(PROJ, MP, MR, b, pos, 1024 + 8 * lane, uu);
                u32x4 w; w.x = pk2(uu[0], uu[1]); w.y = pk2(uu[2], uu[3]); w.z = pk2(uu[4], uu[5]); w.w = pk2(uu[6], uu[7]);
                *(LAS u32x4*)(lds + r * 1024 + lane * 16) = w;
            }
        }
        }
        __syncthreads();
        f32x2 acc[32];
#pragma unroll
        for (int ii = 0; ii < 32; ++ii) acc[ii] = bcf;
        conv_rows<0>(lds + (32 * th) * 1024 + ch2 * 2, wcf, acc);
        u32x4 rcx[8], rbg[8];
        { const bf16* pr = PROJ + ((size_t)b * SEQ + s0 + 8 * wave) * PDIM + 8 * lane;
#pragma unroll
          for (int q = 0; q < 8; ++q) { rcx[q] = *(const u32x4*)(pr + (size_t)q * PDIM); rbg[q] = *(const u32x4*)(pr + (size_t)q * PDIM + 512); } }
        __syncthreads();
#pragma unroll
        for (int ii = 0; ii < 32; ++ii) *(LAS f32x2*)(lds + (32 * th + ii) * 2048 + ch2 * 4) = acc[ii];
        __syncthreads();
        {
            float lng[8], lnb[8];
            { const f32x4 a = *(const f32x4*)(P.ln_g + 8 * lane), c = *(const f32x4*)(P.ln_g + 8 * lane + 4), d = *(const f32x4*)(P.ln_b + 8 * lane), e = *(const f32x4*)(P.ln_b + 8 * lane + 4);
              lng[0] = a.x; lng[1] = a.y; lng[2] = a.z; lng[3] = a.w; lng[4] = c.x; lng[5] = c.y; lng[6] = c.z; lng[7] = c.w;
              lnb[0] = d.x; lnb[1] = d.y; lnb[2] = d.z; lnb[3] = d.w; lnb[4] = e.x; lnb[5] = e.y; lnb[6] = e.z; lnb[7] = e.w; }
            float wsc[3][8];
#pragma unroll
            for (int j = 0; j < 3; ++j) { const f32x4 a = *(const f32x4*)(P.sc_w + j * 512 + 8 * lane), c = *(const f32x4*)(P.sc_w + j * 512 + 8 * lane + 4);
                wsc[j][0] = a.x; wsc[j][1] = a.y; wsc[j][2] = a.z; wsc[j][3] = a.w; wsc[j][4] = c.x; wsc[j][5] = c.y; wsc[j][6] = c.z; wsc[j][7] = c.w; }
            float cxa[8], cxb[8];
            { const int pos = NMETA + s0 + 8 * wave - 2;
              proj8_at(PROJ, MP, MR, b, pos, 8 * lane, cxa); proj8_at(PROJ, MP, MR, b, pos + 1, 8 * lane, cxb); }
#pragma unroll
            for (int q = 0; q < 8; ++q) {
                const int ii = 8 * wave + q, s = s0 + ii; const size_t t = (size_t)b * SEQ + s;
                float o[8];
                { const f32x4 a = *(const LAS f32x4*)(lds + ii * 2048 + lane * 32), c = *(const LAS f32x4*)(lds + ii * 2048 + lane * 32 + 16);
                  o[0] = a.x; o[1] = a.y; o[2] = a.z; o[3] = a.w; o[4] = c.x; o[5] = c.y; o[6] = c.z; o[7] = c.w; }
                float s1 = 0.f;
#pragma unroll
                for (int i = 0; i < 8; ++i) s1 += o[i];
                const float mean = wave_sum_fast(s1) * (1.f / 512.f);
                float s2 = 0.f;
#pragma unroll
                for (int i = 0; i < 8; ++i) { o[i] -= mean; s2 += o[i] * o[i]; }
                const float rs = rsqrtf(wave_sum_fast(s2) * (1.f / 512.f) + EPS);
                float s3 = 0.f;
#pragma unroll
                for (int i = 0; i < 8; ++i) { float y = o[i] * rs * lng[i] + lnb[i]; y = y * sigmoid_f(y); o[i] = y; s3 += y * y; }
                const float r2 = rsqrtf(wave_sum_fast(s3) * (1.f / 512.f) + EPS);
                float bgv[8], cxc[8], accs[8];
                { const u32x4 w = rcx[q], z = rbg[q];
                  cxc[0] = bflo(w.x); cxc[1] = bfhi(w.x); cxc[2] = bflo(w.y); cxc[3] = bfhi(w.y); cxc[4] = bflo(w.z); cxc[5] = bfhi(w.z); cxc[6] = bflo(w.w); cxc[7] = bfhi(w.w);
                  bgv[0] = bflo(z.x); bgv[1] = bfhi(z.x); bgv[2] = bflo(z.y); bgv[3] = bfhi(z.y); bgv[4] = bflo(z.z); bgv[5] = bfhi(z.z); bgv[6] = bflo(z.w); bgv[7] = bfhi(z.w); }
                float s4 = 0.f;
#pragma unroll
                for (int i = 0; i < 8; ++i) { accs[i] = bgv[i] * (wsc[0][i] * cxa[i] + wsc[1][i] * cxb[i] + wsc[2][i] * cxc[i]); s4 += accs[i] * accs[i]; cxa[i] = cxb[i]; cxb[i] = cxc[i]; }
                const float r4 = rsqrtf(wave_sum_fast(s4) * (1.f / 512.f) + EPS);
                float ym = 0.f;
#pragma unroll
                for (int i = 0; i < 8; ++i) { o[i] *= r2; accs[i] *= r4; ym = fmaxf(ym, fmaxf(fabsf(o[i]), fabsf(accs[i]))); }
                ym = fmaxf(wave_max_fast(ym), 1e-30f);
                const float yinv = 127.f / ym;
                if (lane == 0) ((float*)(ws + WS_SY))[t] = ym * (1.f / 127.f);
                u32x2 wz, wv;
                wz.x = ((unsigned)(int)rintf(accs[0] * yinv) & 255u) | (((unsigned)(int)rintf(accs[1] * yinv) & 255u) << 8) | (((unsigned)(int)rintf(accs[2] * yinv) & 255u) << 16) | ((unsigned)(int)rintf(accs[3] * yinv) << 24);
                wz.y = ((unsigned)(int)rintf(accs[4] * yinv) & 255u) | (((unsigned)(int)rintf(accs[5] * yinv) & 255u) << 8) | (((unsigned)(int)rintf(accs[6] * yinv) & 255u) << 16) | ((unsigned)(int)rintf(accs[7] * yinv) << 24);
                wv.x = ((unsigned)(int)rintf(o[0] * yinv) & 255u) | (((unsigned)(int)rintf(o[1] * yinv) & 255u) << 8) | (((unsigned)(int)rintf(o[2] * yinv) & 255u) << 16) | ((unsigned)(int)rintf(o[3] * yinv) << 24);
                wv.y = ((unsigned)(int)rintf(o[4] * yinv) & 255u) | (((unsigned)(int)rintf(o[5] * yinv) & 255u) << 8) | (((unsigned)(int)rintf(o[6] * yinv) & 255u) << 16) | ((unsigned)(int)rintf(o[7] * yinv) << 24);
                *(u32x2*)(ws + WS_Y + t * DM + 8 * lane) = wz;
                *(u32x2*)(ws + WS_Y + t * DM + 512 + 8 * lane) = wv;
            }
        }
        __syncthreads();
    }
}

__device__ __forceinline__ int ord_i(float s) { int k = __builtin_bit_cast(int, s); k ^= (k >> 31) & 0x7fffffff; return k; }
__device__ __forceinline__ float unord_f(int k) { k ^= (k >> 31) & 0x7fffffff; return __builtin_bit_cast(float, k); }
#define TOP_INSERT(L, x_) do { int _x = (x_); _Pragma("unroll") for (int _i = 0; _i < 16; ++_i) { const int _hi = max(L[_i], _x); _x = min(L[_i], _x); L[_i] = _hi; } } while (0)

typedef short bf16x8 __attribute__((ext_vector_type(8)));
typedef float f32x16 __attribute__((ext_vector_type(16)));
template <bool DESC> __device__ __forceinline__ void ce_i(int& a, int& b) { const int hi = max(a, b), lo = min(a, b); if (DESC) { a = hi; b = lo; } else { a = lo; b = hi; } }
__device__ __forceinline__ void bitonic_sort16(int (&a)[16]) {
#pragma unroll
    for (int k = 2; k <= 16; k <<= 1)
#pragma unroll
        for (int j = k >> 1; j > 0; j >>= 1)
#pragma unroll
            for (int i = 0; i < 16; ++i) { const int l = i ^ j; if (l > i) { if ((i & k) == 0) ce_i<true>(a[i], a[l]); else ce_i<false>(a[i], a[l]); } }
}
__device__ __forceinline__ void bitonic_merge16(int (&a)[16]) {
#pragma unroll
    for (int j = 8; j > 0; j >>= 1)
#pragma unroll
        for (int i = 0; i < 16; ++i) { const int l = i ^ j; if (l > i) ce_i<true>(a[i], a[l]); }
}
__device__ __forceinline__ void merge_top16(int (&a)[16], const int (&b)[16]) {
#pragma unroll
    for (int i = 0; i < 16; ++i) a[i] = max(a[i], b[15 - i]);
    bitonic_merge16(a);
}
__device__ __forceinline__ int lut16(const unsigned (&T)[4], int i) {
    const unsigned sel = (unsigned)(i & 7) | 0x0c0c0c00u;
    const unsigned lo = __builtin_amdgcn_perm(T[1], T[0], sel), hi = __builtin_amdgcn_perm(T[3], T[2], sel);
    return (int)((i & 8) ? hi : lo);
}
constexpr int KROW = 272;
constexpr float SCORE_BIAS = 8.0f;

__device__ __forceinline__ void route_load_q(bf16x8 (&qf)[8], const bf16* qrow, int hb) {
#pragma unroll
    for (int ks = 0; ks < 8; ++ks) qf[ks] = *(const bf16x8*)(qrow + 64 * hb + 8 * ks);
}
__device__ __forceinline__ void route_half(const LAS unsigned char* kl, const bf16x8 (&qf)[8], int nl, int hb, int (&L)[16]) {
    f32x16 acc[4];
#pragma unroll
    for (int nt = 0; nt < 4; ++nt)
#pragma unroll
        for (int r = 0; r < 16; ++r) acc[nt][r] = SCORE_BIAS;
#pragma unroll
    for (int ks = 0; ks < 8; ++ks)
#pragma unroll
        for (int nt = 0; nt < 4; ++nt) {
            const bf16x8 a = *(const LAS bf16x8*)(kl + (32 * nt + nl) * KROW + (64 * hb + 8 * ks) * 2);
            acc[nt] = __builtin_amdgcn_mfma_f32_32x32x16_bf16(a, qf[ks], acc[nt], 0, 0, 0);
        }
    const int hb4 = 4 * hb;
    int T[4][16];
#pragma unroll
    for (int nt = 0; nt < 4; ++nt)
#pragma unroll
        for (int r = 0; r < 16; ++r) { const int n0 = 32 * nt + (r & 3) + 8 * (r >> 2); const float sc = acc[nt][r];
            T[nt][r] = (__float_as_int(sc) & ~127) | ((127 - n0) - hb4); }
    bitonic_sort16(T[0]); bitonic_sort16(T[1]); bitonic_sort16(T[2]); bitonic_sort16(T[3]);
    merge_top16(T[0], T[1]); merge_top16(T[2], T[3]); merge_top16(T[0], T[2]);
#pragma unroll
    for (int i = 0; i < 16; ++i) { const unsigned v = (unsigned)T[0][15 - i]; auto r = __builtin_amdgcn_permlane32_swap(v, v, false, false);
        const unsigned r0 = r[0], r1 = r[1]; const int partner = (int)(hb ? r0 : r1); L[i] = max(T[0][i], partner); }
    bitonic_merge16(L);
}

__device__ __forceinline__ void phase_route(const Params& P, LAS unsigned char* lds) {
    const int tid = threadIdx.x, lane = tid & 63, wave = __builtin_amdgcn_readfirstlane(tid >> 6);
    const int nl = lane & 31, hb = lane >> 5;
    unsigned char* ws = P.ws;
    const bf16* KEYS = (const bf16*)(ws + WS_KEYS); const bf16* Q = (const bf16*)(ws + WS_Q);
    int* IDX = (int*)(ws + WS_IDX); float* GATE = (float*)(ws + WS_GATE);
    int last_h = -1;
    pg8::StaticOrder S; S.init(NTOK, 2048, (int)gridDim.x, (int)blockIdx.x);
    pg8::Unit ucur, unxt;
    bool have = S.next(0, ucur);
    bf16x8 qfA[8], qfB[8];
    if (have) route_load_q(qfA, Q + ((size_t)ucur.pm * 256 + wave * 32 + nl) * 2048 + ucur.pn * 256, hb);
    for (int ui = 0; have; ++ui) {
        const int h = ucur.pn, tb = ucur.pm;
        const bool have_next = S.next(ui + 1, unxt);
        if (h != last_h) {
            __syncthreads();
            for (int c = tid; c < 4096; c += NTHREADS) { const u32x4 v = ((const u32x4*)(KEYS + (size_t)h * 32768))[c];
                *(LAS u32x4*)(lds + (c >> 4) * KROW + (c & 15) * 16) = v; }
            __syncthreads();
            last_h = h;
        }
        const size_t t = (size_t)tb * 256 + wave * 32 + nl;
        int L1[16], L2[16];
        route_load_q(qfB, Q + t * 2048 + h * 256 + 128, hb);
        route_half(lds, qfA, nl, hb, L1);
        if (have_next) route_load_q(qfA, Q + ((size_t)unxt.pm * 256 + wave * 32 + nl) * 2048 + unxt.pn * 256, hb);
        route_half(lds + 128 * KROW, qfB, nl, hb, L2);
        float v1[16], v2[16];
#pragma unroll
        for (int i = 0; i < 16; ++i) { v1[i] = __int_as_float(L1[i] & ~127); v2[i] = __int_as_float(L2[i] & ~127); }
#define CAND(i, j) ((__float_as_int(v1[i] + v2[j]) & ~255) | (255 - (16 * (i) + (j))))
        int A[16], B[16], C[16];
#pragma unroll
        for (int j = 0; j < 16; ++j) A[j] = CAND(0, j);
#pragma unroll
        for (int j = 0; j < 8; ++j) { B[j] = CAND(1, j); B[8 + j] = CAND(15 - j, 0); }
        bitonic_merge16(B);
        C[0] = CAND(2, 0); C[1] = CAND(2, 1); C[2] = CAND(2, 2); C[3] = CAND(2, 3); C[4] = CAND(2, 4);
        C[5] = CAND(3, 0); C[6] = CAND(3, 1); C[7] = CAND(3, 2); C[8] = CAND(3, 3);
        C[9] = CAND(4, 0); C[10] = CAND(4, 1); C[11] = CAND(4, 2);
        C[12] = CAND(5, 0); C[13] = CAND(5, 1); C[14] = CAND(6, 0); C[15] = CAND(6, 1);
        bitonic_sort16(C);
        { const int d0 = CAND(7, 0), d1 = CAND(7, 1); C[14] = max(C[14], d1); C[15] = max(C[15], d0); bitonic_merge16(C); }
#undef CAND
        merge_top16(A, B); merge_top16(A, C);
        unsigned T1[4], T2[4];
#pragma unroll
        for (int q = 0; q < 4; ++q) {
            T1[q] = (unsigned)(127 - (L1[4 * q] & 127)) | ((unsigned)(127 - (L1[4 * q + 1] & 127)) << 8) | ((unsigned)(127 - (L1[4 * q + 2] & 127)) << 16) | ((unsigned)(127 - (L1[4 * q + 3] & 127)) << 24);
            T2[q] = (unsigned)(127 - (L2[4 * q] & 127)) | ((unsigned)(127 - (L2[4 * q + 1] & 127)) << 8) | ((unsigned)(127 - (L2[4 * q + 2] & 127)) << 16) | ((unsigned)(127 - (L2[4 * q + 3] & 127)) << 24); }
        float val[16]; int ex[16];
#pragma unroll
        for (int k = 0; k < 16; ++k) { const int pos = 255 - (A[k] & 255); val[k] = __int_as_float(A[k] & ~255);
            ex[k] = lut16(T1, pos >> 4) * NKEYS + lut16(T2, pos & 15); }
        float sum = 0.f; const float vmax = val[0];
#pragma unroll
        for (int k = 0; k < 16; ++k) { val[k] = __expf(val[k] - vmax); sum += val[k]; }
        const float inv = 1.f / sum;
        if (hb == 0) {
            int* ip = IDX + t * NSEL + h * TOPK; float* gp = GATE + t * NSEL + h * TOPK;
#pragma unroll
            for (int k4 = 0; k4 < 4; ++k4) {
                *(int4*)(ip + 4 * k4) = make_int4(ex[4 * k4], ex[4 * k4 + 1], ex[4 * k4 + 2], ex[4 * k4 + 3]);
                *(f32x4*)(gp + 4 * k4) = (f32x4){val[4 * k4] * inv, val[4 * k4 + 1] * inv, val[4 * k4 + 2] * inv, val[4 * k4 + 3] * inv};
            }
        }
        ucur = unxt; have = have_next;
    }
}

#define FP4X2(w, sel) __builtin_amdgcn_cvt_scalef32_pk_f32_fp4((w), 1.0f, (sel))
__device__ __forceinline__ float dot16_fp4(const u32x2 r, const f32x4 (&xs)[4]) {
    float p = 0.f;
    { const f32x2 a = FP4X2(r.x, 0), b = FP4X2(r.x, 1), c = FP4X2(r.x, 2), d = FP4X2(r.x, 3);
      p += (a.x * xs[0].x + a.y * xs[0].y) + (b.x * xs[0].z + b.y * xs[0].w); p += (c.x * xs[1].x + c.y * xs[1].y) + (d.x * xs[1].z + d.y * xs[1].w); }
    { const f32x2 a = FP4X2(r.y, 0), b = FP4X2(r.y, 1), c = FP4X2(r.y, 2), d = FP4X2(r.y, 3);
      p += (a.x * xs[2].x + a.y * xs[2].y) + (b.x * xs[2].z + b.y * xs[2].w); p += (c.x * xs[3].x + c.y * xs[3].y) + (d.x * xs[3].z + d.y * xs[3].w); }
    return p;
}
__device__ __forceinline__ void axpy16_fp4(const u32x2 r, float w, f32x4 (&o)[4]) {
    { const f32x2 a = FP4X2(r.x, 0), b = FP4X2(r.x, 1), c = FP4X2(r.x, 2), d = FP4X2(r.x, 3);
      o[0].x += w * a.x; o[0].y += w * a.y; o[0].z += w * b.x; o[0].w += w * b.y; o[1].x += w * c.x; o[1].y += w * c.y; o[1].z += w * d.x; o[1].w += w * d.y; }
    { const f32x2 a = FP4X2(r.y, 0), b = FP4X2(r.y, 1), c = FP4X2(r.y, 2), d = FP4X2(r.y, 3);
      o[2].x += w * a.x; o[2].y += w * a.y; o[2].z += w * b.x; o[2].w += w * b.y; o[3].x += w * c.x; o[3].y += w * c.y; o[3].z += w * d.x; o[3].w += w * d.y; }
}
__device__ __forceinline__ float swap32_add(float a, float b) { auto r = __builtin_amdgcn_permlane32_swap(__float_as_uint(a), __float_as_uint(b), false, false); return __uint_as_float(r[0]) + __uint_as_float(r[1]); }
__device__ __forceinline__ float swap16_add(float a, float b) { auto r = __builtin_amdgcn_permlane16_swap(__float_as_uint(a), __float_as_uint(b), false, false); return __uint_as_float(r[0]) + __uint_as_float(r[1]); }
__device__ __forceinline__ float row_sum16(float v) { v += dpp_f<0xB1>(v); v += dpp_f<0x4E>(v); v += dpp_f<0x141>(v); v += dpp_f<0x140>(v); return v; }
__device__ __forceinline__ float row_max16(float v) { v = fmaxf(v, dpp_f<0xB1>(v)); v = fmaxf(v, dpp_f<0x4E>(v)); v = fmaxf(v, dpp_f<0x141>(v)); v = fmaxf(v, dpp_f<0x140>(v)); return v; }
constexpr int GB = 32;
typedef __attribute__((address_space(8))) void* rsrc_t;
__device__ __forceinline__ void g_issue(u32x2 (&buf)[GB], __amdgpu_buffer_rsrc_t rs, int idxr, int lb, int voff) {
#pragma unroll
    for (int j = 0; j < GB; ++j) { const int e = __builtin_amdgcn_readlane(idxr, lb + j); buf[j] = __builtin_amdgcn_raw_buffer_load_b64(rs, voff, e * 512, 0); }
}
__device__ __forceinline__ float dot16_fp4p(const u32x2 r, const f32x2 (&xp)[8]) {
    f32x2 a = FP4X2(r.x, 0) * xp[0];
    a += FP4X2(r.x, 1) * xp[1]; a += FP4X2(r.x, 2) * xp[2]; a += FP4X2(r.x, 3) * xp[3];
    a += FP4X2(r.y, 0) * xp[4]; a += FP4X2(r.y, 1) * xp[5]; a += FP4X2(r.y, 2) * xp[6]; a += FP4X2(r.y, 3) * xp[7];
    return a.x + a.y;
}
__device__ __forceinline__ void axpy16_fp4p(const u32x2 r, float w, f32x2 (&o)[8]) {
    const f32x2 ww = (f32x2){w, w};
    o[0] += FP4X2(r.x, 0) * ww; o[1] += FP4X2(r.x, 1) * ww; o[2] += FP4X2(r.x, 2) * ww; o[3] += FP4X2(r.x, 3) * ww;
    o[4] += FP4X2(r.y, 0) * ww; o[5] += FP4X2(r.y, 1) * ww; o[6] += FP4X2(r.y, 2) * ww; o[7] += FP4X2(r.y, 3) * ww;
}
template <int H> __device__ __forceinline__ void g_compute_u(const u32x2 (&buf)[GB], int q, int i16, const f32x2 (&xp)[8], float& zlo, float& zhi) {
    float p[16];
#pragma unroll
    for (int j = 0; j < 16; ++j) p[j] = dot16_fp4p(buf[16 * H + j], xp);
    float s1[8], s2[4];
#pragma unroll
    for (int m = 0; m < 8; ++m) s1[m] = swap32_add(p[2 * m], p[2 * m + 1]);
#pragma unroll
    for (int n = 0; n < 4; ++n) s2[n] = swap16_add(s1[2 * n], s1[2 * n + 1]);
#pragma unroll
    for (int r = 0; r < 4; ++r) { const float z = row_sum16(s2[r]); const bool mine = i16 == ((4 * q + r) & 15);
        zlo = (mine && q < 4) ? z : zlo; zhi = (mine && q >= 4) ? z : zhi; }
}
template <int H> __device__ __forceinline__ void g_compute_v(const u32x2 (&buf)[GB], int q, float alo, float ahi, f32x2 (&o)[8]) {
    const int areg = __builtin_bit_cast(int, (q < 4) ? alo : ahi), sb = 4 * (q & 3);
#pragma unroll
    for (int j = 0; j < 16; ++j) { const int src = 32 * (j & 1) + 16 * ((j >> 1) & 1) + (j >> 2) + sb;
        const float w = __builtin_bit_cast(float, __builtin_amdgcn_readlane(areg, src));
        axpy16_fp4p(buf[16 * H + j], w, o); }
}
__device__ __forceinline__ void q_issue(u32x2 (&buf)[16], __amdgpu_buffer_rsrc_t rs, int ixr  , int lb, int voff) {
#pragma unroll
    for (int j = 0; j < 16; ++j) { const int e9 = __builtin_amdgcn_readlane(ixr, lb + j); buf[j] = __builtin_amdgcn_raw_buffer_load_b64(rs, voff, e9, 0); }
}
__device__ __forceinline__ void q_compute_u(const u32x2 (&buf)[16], int q, int i16, const f32x2 (&xp)[8], float& zlo, float& zhi) {
    float p[16];
#pragma unroll
    for (int j = 0; j < 16; ++j) p[j] = dot16_fp4p(buf[j], xp);
    float s1[8], s2[4];
#pragma unroll
    for (int m = 0; m < 8; ++m) s1[m] = swap32_add(p[2 * m], p[2 * m + 1]);
#pragma unroll
    for (int n = 0; n < 4; ++n) s2[n] = swap16_add(s1[2 * n], s1[2 * n + 1]);
#pragma unroll
    for (int r = 0; r < 4; ++r) { const float z = row_sum16(s2[r]); const bool mine = i16 == ((4 * q + r) & 15);
        zlo = (mine && q < 4) ? z : zlo; zhi = (mine && q >= 4) ? z : zhi; }
}
typedef _Float16 h16x2 __attribute__((ext_vector_type(2)));
#define FP4H2(w, sel) __builtin_amdgcn_cvt_scalef32_pk_f16_fp4((w), 1.0f, (sel))
__device__ __forceinline__ void axpy16_fp4h(const u32x2 r, const h16x2 ww, h16x2 (&o)[8]) {
    o[0] += FP4H2(r.x, 0) * ww; o[1] += FP4H2(r.x, 1) * ww; o[2] += FP4H2(r.x, 2) * ww; o[3] += FP4H2(r.x, 3) * ww;
    o[4] += FP4H2(r.y, 0) * ww; o[5] += FP4H2(r.y, 1) * ww; o[6] += FP4H2(r.y, 2) * ww; o[7] += FP4H2(r.y, 3) * ww;
}
__device__ __forceinline__ void q_compute_vh(const u32x2 (&buf)[16], int q, int alo, int ahi, h16x2 (&o)[8]) {
    const int areg = (q < 4) ? alo : ahi, sb = 4 * (q & 3);
#pragma unroll
    for (int j = 0; j < 16; ++j) { const int src = 32 * (j & 1) + 16 * ((j >> 1) & 1) + (j >> 2) + sb;
        const h16x2 w = __builtin_bit_cast(h16x2, __builtin_amdgcn_readlane(areg, src));
        axpy16_fp4h(buf[j], w, o); }
}
__device__ __forceinline__ void q_compute_v(const u32x2 (&buf)[16], int q, float alo, float ahi, f32x2 (&o)[8]) {
    const int areg = __builtin_bit_cast(int, (q < 4) ? alo : ahi), sb = 4 * (q & 3);
#pragma unroll
    for (int j = 0; j < 16; ++j) { const int src = 32 * (j & 1) + 16 * ((j >> 1) & 1) + (j >> 2) + sb;
        const float w = __builtin_bit_cast(float, __builtin_amdgcn_readlane(areg, src));
        axpy16_fp4p(buf[j], w, o); }
}
__device__ __forceinline__ int swap32_addi(int a, int b) { auto r = __builtin_amdgcn_permlane32_swap((unsigned)a, (unsigned)b, false, false); const unsigned r0 = r[0], r1 = r[1]; return (int)(r0 + r1); }
__device__ __forceinline__ int swap16_addi(int a, int b) { auto r = __builtin_amdgcn_permlane16_swap((unsigned)a, (unsigned)b, false, false); const unsigned r0 = r[0], r1 = r[1]; return (int)(r0 + r1); }
template <int CTRL> __device__ __forceinline__ int dpp_i(int v) { return __builtin_amdgcn_update_dpp(0, v, CTRL, 0xf, 0xf, true); }
__device__ __forceinline__ int row_sum16i(int v) { v += dpp_i<0xB1>(v); v += dpp_i<0x4E>(v); v += dpp_i<0x141>(v); v += dpp_i<0x140>(v); return v; }
__device__ __forceinline__ void q_compute_ui(const u32x2 (&buf)[16], int q, int i16, int xh0, int xh1, int xl0, int xl1, int& zlo, int& zhi) {
    int p[16];
#pragma unroll
    for (int j = 0; j < 16; ++j) { const int d1 = __builtin_amdgcn_sdot8((int)buf[j].x, xh0, __builtin_amdgcn_sdot8((int)buf[j].y, xh1, 0, false), false);
        const int d2 = __builtin_amdgcn_sdot8((int)buf[j].x, xl0, __builtin_amdgcn_sdot8((int)buf[j].y, xl1, 0, false), false);
        p[j] = (d1 << 4) + d2; }
    int s1[8], s2[4];
#pragma unroll
    for (int m = 0; m < 8; ++m) s1[m] = swap32_addi(p[2 * m], p[2 * m + 1]);
#pragma unroll
    for (int n = 0; n < 4; ++n) s2[n] = swap16_addi(s1[2 * n], s1[2 * n + 1]);
#pragma unroll
    for (int r = 0; r < 4; ++r) { const int z = row_sum16i(s2[r]); const bool mine = i16 == ((4 * q + r) & 15);
        zlo = (mine && q < 4) ? z : zlo; zhi = (mine && q >= 4) ? z : zhi; }
}
__device__ __forceinline__ void phase_gather_u(const Params& P) {
    const int tid = threadIdx.x, lane = tid & 63, wave = __builtin_amdgcn_readfirstlane(tid >> 6);
    const int gw = blockIdx.x * NWAVES + wave, NGW = gridDim.x * NWAVES;
    unsigned char* ws = P.ws;
    const int* IDX = (const int*)(ws + WS_IDX); const float* GATE = (const float*)(ws + WS_GATE); const float* ESC = (const float*)(ws + WS_ESCALE); float* AW = (float*)(ws + WS_AW);
    const __amdgpu_buffer_rsrc_t rsU = __builtin_amdgcn_make_buffer_rsrc((void*)(ws + WS_U8), 0, 16384 * 512, 0x00020000);
    const unsigned char* H2I = ws + WS_H0I8; const float* RF = (const float*)(ws + WS_RF);
    const int hh = lane >> 5, rr = (lane >> 4) & 1, i16 = lane & 15, gsel = 4 * i16 + 2 * rr + hh;
    const int voff = 8 * lane;
    const unsigned ul = (unsigned)lane;
    int t = gw;
    if (t < NTOK) {
        int idx0, idx1; unsigned hraw[4]; float sqv;
        { const int* ip = IDX + (size_t)t * NSEL; idx0 = ip[ul]; idx1 = ip[64u + ul];
          const unsigned* hp = (const unsigned*)(H2I + (size_t)t * DM);
#pragma unroll
          for (int j = 0; j < 4; ++j) hraw[j] = hp[64u * j + ul];
          sqv = RF[t]; }
        u32x2 R0[16], R1[16], R2[16], R3[16];
        { const int ix0 = idx0 << 9; q_issue(R0, rsU, ix0, 0, voff); q_issue(R1, rsU, ix0, 16, voff); q_issue(R2, rsU, ix0, 32, voff); }
        for (;;) {
            const int tn = t + NGW; const bool has_next = tn < NTOK; const int tl = has_next ? tn : t;
            int idx0n, idx1n; unsigned hrawn[4]; float sqn, g0, g1;
            { const int* ip = IDX + (size_t)tl * NSEL; idx0n = ip[ul]; idx1n = ip[64u + ul];
              const unsigned* hp = (const unsigned*)(H2I + (size_t)tl * DM);
#pragma unroll
              for (int j = 0; j < 4; ++j) hrawn[j] = hp[64u * j + ul];
              sqn = RF[tl];
              const float* gp = GATE + (size_t)t * NSEL; g0 = gp[ul]; g1 = gp[64u + ul]; }
            const float su0 = ESC[idx0], su1 = ESC[idx1], sv0 = ESC[16384 + idx0], sv1 = ESC[16384 + idx1];
            const float cq0 = ((const float*)(ws + WS_SUMQ))[idx0], cq1 = ((const float*)(ws + WS_SUMQ))[idx1];
            unsigned xh[2] = {0u, 0u}, xl[2] = {0u, 0u};
#pragma unroll
            for (int j = 0; j < 4; ++j) {
                const unsigned lo4 = hraw[j] & 0x0f0f0f0fu, hi4 = (hraw[j] >> 4) & 0x0f0f0f0fu;
                const unsigned tl4 = (lo4 | (lo4 >> 4)) & 0x00ff00ffu, th4 = (hi4 | (hi4 >> 4)) & 0x00ff00ffu;
                const unsigned pl = ((tl4 | (tl4 >> 8)) & 0xffffu) ^ 0x8888u, ph = (th4 | (th4 >> 8)) & 0xffffu;
                xl[j >> 1] |= pl << (16 * (j & 1)); xh[j >> 1] |= ph << (16 * (j & 1)); }
            int zlo = 0, zhi = 0;
            const int ix0 = idx0 << 9, ix1 = idx1 << 9;
#pragma unroll 1
            for (int qq = 0; qq < 8; qq += 4) {
                const int ixn = qq ? (idx0n << 9) : ix1;
                q_issue(R3, rsU, qq ? ix1 : ix0, 48, voff);
                q_compute_ui(R0, qq, i16, (int)xh[0], (int)xh[1], (int)xl[0], (int)xl[1], zlo, zhi);
                q_issue(R0, rsU, ixn, 0, voff);
                q_compute_ui(R1, qq + 1, i16, (int)xh[0], (int)xh[1], (int)xl[0], (int)xl[1], zlo, zhi);
                q_issue(R1, rsU, ixn, 16, voff);
                q_compute_ui(R2, qq + 2, i16, (int)xh[0], (int)xh[1], (int)xl[0], (int)xl[1], zlo, zhi);
                q_issue(R2, rsU, ixn, 32, voff);
                q_compute_ui(R3, qq + 3, i16, (int)xh[0], (int)xh[1], (int)xl[0], (int)xl[1], zlo, zhi);
            }
            const float glo = __shfl(g0, gsel), ghi = __shfl(g1, gsel), sulo = __shfl(su0, gsel), suhi = __shfl(su1, gsel), svlo = __shfl(sv0, gsel), svhi = __shfl(sv1, gsel);
            const float cqlo = __shfl(cq0, gsel), cqhi = __shfl(cq1, gsel);
            const float zfl = ((float)zlo + 8.f * cqlo) * (sulo * sqv), zfh = ((float)zhi + 8.f * cqhi) * (suhi * sqv);
            const float wl = gelu_tanh_f(zfl) * glo * svlo, wh = gelu_tanh_f(zfh) * ghi * svhi;
            const float wmx = fmaxf(wave_max_fast(fmaxf(fabsf(wl), fabsf(wh))), 1e-30f), wsc = 256.f / wmx;
            { const float a = wl * wsc, c = wh * wsc;
              const int ah = __builtin_amdgcn_cvt_pk_fp8_f32(a, a, 0, false) & 255, ch = __builtin_amdgcn_cvt_pk_fp8_f32(c, c, 0, false) & 255;
              const float ar = a - __builtin_amdgcn_cvt_f32_fp8(ah, 0), cr = c - __builtin_amdgcn_cvt_f32_fp8(ch, 0);
              const int al = __builtin_amdgcn_cvt_pk_fp8_f32(ar, ar, 0, false) & 255, cl = __builtin_amdgcn_cvt_pk_fp8_f32(cr, cr, 0, false) & 255;
              unsigned char* ap = (unsigned char*)AW + (size_t)t * 256;
              ap[gsel] = (unsigned char)ah; ap[64 + gsel] = (unsigned char)ch; ap[128 + gsel] = (unsigned char)al; ap[192 + gsel] = (unsigned char)cl;
              if (lane == 0) ((float*)(ws + WS_WMX))[t] = wmx * (1.f / 256.f); }
            if (!has_next) break;
            t = tn; idx0 = idx0n; idx1 = idx1n; sqv = sqn;
#pragma unroll
            for (int j = 0; j < 4; ++j) hraw[j] = hrawn[j];
        }
    }
}
__device__ __forceinline__ void phase_gather_v(const Params& P) {
    const int tid = threadIdx.x, lane = tid & 63, wave = __builtin_amdgcn_readfirstlane(tid >> 6);
    const int gw = blockIdx.x * NWAVES + wave, NGW = gridDim.x * NWAVES;
    unsigned char* ws = P.ws;
    const int* IDX = (const int*)(ws + WS_IDX); const float* AW = (const float*)(ws + WS_AW);
    const __amdgpu_buffer_rsrc_t rsV = __builtin_amdgcn_make_buffer_rsrc((void*)(ws + WS_V8), 0, 16384 * 512, 0x00020000);
    const bf16* H2B = (const bf16*)(ws + WS_H2B);
    const int voff = 8 * lane;
    const unsigned ul = (unsigned)lane;
    int t = gw;
    if (t < NTOK) {
        int idx0, idx1; u32x2 hraw[4]; float alo, ahi;
        { const int* ip = IDX + (size_t)t * NSEL; idx0 = ip[ul]; idx1 = ip[64u + ul];
          const u32x2* hp = (const u32x2*)(H2B + (size_t)t * DM);
#pragma unroll
          for (int j = 0; j < 4; ++j) hraw[j] = hp[64u * j + ul];
          const float* ap = AW + (size_t)t * NSEL; alo = ap[ul]; ahi = ap[64u + ul]; }
        u32x2 R0[16], R1[16], R2[16], R3[16];
        { const int ix0 = idx0 << 9; q_issue(R0, rsV, ix0, 0, voff); q_issue(R1, rsV, ix0, 16, voff); q_issue(R2, rsV, ix0, 32, voff); }
        for (;;) {
            const int tn = t + NGW; const bool has_next = tn < NTOK; const int tl = has_next ? tn : t;
            int idx0n, idx1n; u32x2 hrawn[4]; float alon, ahin;
            { const int* ip = IDX + (size_t)tl * NSEL; idx0n = ip[ul]; idx1n = ip[64u + ul];
              const u32x2* hp = (const u32x2*)(H2B + (size_t)tl * DM);
#pragma unroll
              for (int j = 0; j < 4; ++j) hrawn[j] = hp[64u * j + ul];
              const float* ap = AW + (size_t)tl * NSEL; alon = ap[ul]; ahin = ap[64u + ul]; }
            const float wmx = fmaxf(wave_max_fast(fmaxf(fabsf(alo), fabsf(ahi))), 1e-30f), winv = 1.f / wmx;
            int alh, ahh;
            { const h16x2 a = (h16x2){(_Float16)(alo * winv), (_Float16)(alo * winv)}, b = (h16x2){(_Float16)(ahi * winv), (_Float16)(ahi * winv)};
              alh = __builtin_bit_cast(int, a); ahh = __builtin_bit_cast(int, b); }
            h16x2 oh[8];
#pragma unroll
            for (int j = 0; j < 8; ++j) oh[j] = (h16x2){(_Float16)0.f, (_Float16)0.f};
            const int ix0 = idx0 << 9, ix1 = idx1 << 9;
#pragma unroll 1
            for (int qq = 0; qq < 8; qq += 4) {
                const int ixn = qq ? (idx0n << 9) : ix1;
                q_issue(R3, rsV, qq ? ix1 : ix0, 48, voff);
                q_compute_vh(R0, qq, alh, ahh, oh);
                q_issue(R0, rsV, ixn, 0, voff);
                q_compute_vh(R1, qq + 1, alh, ahh, oh);
                q_issue(R1, rsV, ixn, 16, voff);
                q_compute_vh(R2, qq + 2, alh, ahh, oh);
                q_issue(R2, rsV, ixn, 32, voff);
                q_compute_vh(R3, qq + 3, alh, ahh, oh);
            }
            f32x2 o[8];
#pragma unroll
            for (int j = 0; j < 8; ++j) o[j] = (f32x2){(float)oh[j].x * wmx, (float)oh[j].y * wmx};
            float ss = 0.f;
#pragma unroll
            for (int j = 0; j < 4; ++j) { o[2 * j] += (f32x2){bflo(hraw[j].x), bfhi(hraw[j].x)}; o[2 * j + 1] += (f32x2){bflo(hraw[j].y), bfhi(hraw[j].y)}; }
#pragma unroll
            for (int j = 0; j < 8; ++j) ss += o[j].x * o[j].x + o[j].y * o[j].y;
            ss = wave_sum_fast(ss);
            const float r3 = rsqrtf(ss * (1.f / DM) + EPS);
            f32x4* op = (f32x4*)(P.out + (size_t)t * DM);
            const f32x4* gfp = (const f32x4*)P.g_fin;
#pragma unroll
            for (int j = 0; j < 4; ++j) { const f32x4 gv = gfp[64u * j + ul]; op[64u * j + ul] = (f32x4){o[2 * j].x * r3 * gv.x, o[2 * j].y * r3 * gv.y, o[2 * j + 1].x * r3 * gv.z, o[2 * j + 1].y * r3 * gv.w}; }
            if (!has_next) break;
            t = tn; idx0 = idx0n; idx1 = idx1n; alo = alon; ahi = ahin;
#pragma unroll
            for (int j = 0; j < 4; ++j) hraw[j] = hrawn[j];
        }
    }
}


typedef int i32x2v __attribute__((ext_vector_type(2)));
typedef int i32x8v __attribute__((ext_vector_type(8)));
#define VM_X 9
#define VM_WAIT(n) asm volatile("s_waitcnt vmcnt(" #n ")" ::: "memory")
__device__ __forceinline__ void phase_gather_v_mfma(const Params& P, LAS unsigned char* lds) {
    const int tid = threadIdx.x, lane = tid & 63, wave = __builtin_amdgcn_readfirstlane(tid >> 6);
    unsigned char* ws = P.ws;
    const int* IDX = (const int*)(ws + WS_IDX);
    const unsigned char* V8 = ws + WS_V8; const unsigned char* AW8 = ws + WS_AW; const float* WMX = (const float*)(ws + WS_WMX);
    const unsigned short* H2S = (const unsigned short*)(ws + WS_H2B);
    const int TPB = NTOK / (int)gridDim.x, t0 = blockIdx.x * TPB, NST = TPB * 4;
    const int r0 = 16 * wave + (lane >> 3), r1 = r0 + 8;
    const unsigned c0 = 16u * (unsigned)((lane & 7) ^ ((r0 >> 1) & 7)), c1 = 16u * (unsigned)((lane & 7) ^ ((r1 >> 1) & 7));
    const int i16 = lane & 15, kb = lane >> 4;
    const int ra = 32 * kb + i16, rb = ra + 16;
    const unsigned offa = (unsigned)(ra * 128 + 16 * (wave ^ ((ra >> 1) & 7))), offb = (unsigned)(rb * 128 + 16 * (wave ^ ((rb >> 1) & 7)));
    const unsigned aoffb = (unsigned)(((i16 & 1) ? 128 : 0) + 16 * kb);
    const bool arow = (i16 & 3) < 2;
    const int colb = 256 * kb + 32 * wave + i16;
    LAS float* SS = (LAS float*)(lds + 131072 + 1024);
    LAS float* OUTB = (LAS float*)(lds + 131072 + 2048);
    const f32x4 gfv = *(const f32x4*)(P.g_fin + 256 * (wave & 3) + 4 * lane);
    const unsigned lbase = (unsigned)(unsigned long long)lds;
    struct VTok { u32x4 a, b; float w; unsigned h0, h1; };
    VTok C0, C1;
    int ia1, ib1, ia2, ib2, ia3, ib3;
#define VM_ISSUE(g, e0, e1) do { LAS unsigned char* _d = lds + (((g) & 7) * 16384) + wave * 2048; const unsigned _cb = 128u * (unsigned)((g) & 3); \
        __builtin_amdgcn_global_load_lds((const unsigned*)(V8 + (size_t)(e0) * 512 + _cb + c0), (LAS unsigned*)(_d), 16, 0, 0); \
        __builtin_amdgcn_global_load_lds((const unsigned*)(V8 + (size_t)(e1) * 512 + _cb + c1), (LAS unsigned*)(_d + 1024), 16, 0, 0); } while (0)
    {
        const int ia0 = IDX[(size_t)t0 * NSEL + r0], ib0 = IDX[(size_t)t0 * NSEL + r1];
        ia1 = IDX[(size_t)(t0 + 1) * NSEL + r0]; ib1 = IDX[(size_t)(t0 + 1) * NSEL + r1];
        ia2 = IDX[(size_t)(t0 + 2) * NSEL + r0]; ib2 = IDX[(size_t)(t0 + 2) * NSEL + r1];
        ia3 = IDX[(size_t)(t0 + 3) * NSEL + r0]; ib3 = IDX[(size_t)(t0 + 3) * NSEL + r1];
        const unsigned char* ap = AW8 + (size_t)t0 * 256 + aoffb;
        C0.a = *(const u32x4*)ap; C0.b = *(const u32x4*)(ap + 64); C0.w = WMX[t0]; C0.h0 = H2S[(size_t)t0 * DM + colb]; C0.h1 = H2S[(size_t)t0 * DM + colb + 16];
        C1.a = *(const u32x4*)(ap + 256); C1.b = *(const u32x4*)(ap + 256 + 64); C1.w = WMX[t0 + 1]; C1.h0 = H2S[(size_t)(t0 + 1) * DM + colb]; C1.h1 = H2S[(size_t)(t0 + 1) * DM + colb + 16];
        asm volatile("s_waitcnt vmcnt(0)" ::: "memory");
        VM_ISSUE(0, ia0, ib0); VM_ISSUE(1, ia0, ib0); VM_ISSUE(2, ia0, ib0); VM_ISSUE(3, ia0, ib0);
        VM_ISSUE(4, ia1, ib1); VM_ISSUE(5, ia1, ib1); VM_ISSUE(6, ia1, ib1);
    }
    float pv0 = 0.f, pv1 = 0.f;
    VTok N0, N1; int na4, nb4, na5, nb5;
    auto token = [&](const int i, const bool even, const VTok& C, const int e1a, const int e1b, const int e2a, const int e2b) __attribute__((always_inline)) {
        const int t = t0 + i;
        const u32x4 z = (u32x4){0u, 0u, 0u, 0u}; const u32x4 Alo = arow ? C.a : z, Ahi = arow ? C.b : z;
        const i32x8v A = (i32x8v){(int)Alo.x, (int)Alo.y, (int)Alo.z, (int)Alo.w, (int)Ahi.x, (int)Ahi.y, (int)Ahi.z, (int)Ahi.w};
        f32x4 acc[4][2];
#pragma unroll
        for (int cc = 0; cc < 4; ++cc) {
            const int g = 4 * i + cc;
            if (even && cc == 0) { VM_WAIT(12); } else { VM_WAIT(26); }
            asm volatile("s_waitcnt lgkmcnt(0)" ::: "memory");
            __builtin_amdgcn_s_barrier();
            __builtin_amdgcn_sched_barrier(0);
            const unsigned sa = lbase + (unsigned)((g & 7) * 16384) + offa, sbb = lbase + (unsigned)((g & 7) * 16384) + offb;
            i32x2v b00, b01, b10, b11;
            asm volatile("ds_read_b64_tr_b4 %0, %4\n\tds_read_b64_tr_b4 %1, %5\n\tds_read_b64_tr_b4 %2, %4 offset:8\n\tds_read_b64_tr_b4 %3, %5 offset:8"
                         : "=&v"(b00), "=&v"(b01), "=&v"(b10), "=&v"(b11) : "v"(sa), "v"(sbb) : "memory");
            { const int gn = g + 7;
              if (cc == 0) VM_ISSUE(gn, e1a, e1b); else VM_ISSUE(gn, e2a, e2b); }
            __builtin_amdgcn_sched_barrier(0);
            if (cc == 0) {
                if (even) {
                    const int tA = t0 + ((i + 2 < TPB) ? i + 2 : TPB - 2), tI = t0 + ((i + 4 < TPB) ? i + 4 : TPB - 2);
                    const unsigned char* ap = AW8 + (size_t)tA * 256 + aoffb; const float* wp = WMX + tA; const int* ipa = IDX + (size_t)tI * NSEL + r0; const unsigned short* hp = H2S + (size_t)tA * DM + colb;
                    asm volatile("global_load_dwordx4 %0, %14, off\n\tglobal_load_dwordx4 %1, %14, off offset:64\n\tglobal_load_dwordx4 %2, %14, off offset:256\n\tglobal_load_dwordx4 %3, %14, off offset:320\n\t"
                                 "global_load_dword %4, %15, off\n\tglobal_load_dword %5, %15, off offset:4\n\t"
                                 "global_load_ushort %6, %17, off\n\tglobal_load_ushort %7, %17, off offset:32\n\tglobal_load_ushort %8, %17, off offset:2048\n\tglobal_load_ushort %9, %17, off offset:2080\n\t"
                                 "global_load_dword %10, %16, off\n\tglobal_load_dword %11, %16, off offset:32\n\tglobal_load_dword %12, %16, off offset:512\n\tglobal_load_dword %13, %16, off offset:544"
                                 : "=&v"(N0.a), "=&v"(N0.b), "=&v"(N1.a), "=&v"(N1.b), "=&v"(N0.w), "=&v"(N1.w), "=&v"(N0.h0), "=&v"(N0.h1), "=&v"(N1.h0), "=&v"(N1.h1), "=&v"(na4), "=&v"(nb4), "=&v"(na5), "=&v"(nb5)
                                 : "v"(ap), "v"(wp), "v"(ipa), "v"(hp) : "memory");
                }
                { const f32x4 s0 = *(const LAS f32x4*)(SS + 8 * ((i + 1) & 1)), s1 = *(const LAS f32x4*)(SS + 8 * ((i + 1) & 1) + 4);
                  const float ss = ((s0.x + s0.y) + (s0.z + s0.w)) + ((s1.x + s1.y) + (s1.z + s1.w));
                  const float r3 = rsqrtf(ss * (1.f / DM) + EPS);
                  if (i > 0 && (wave >> 2) == ((i + 1) & 1)) {
                      const f32x4 v = *(const LAS f32x4*)(OUTB + 1024 * ((i + 1) & 1) + 256 * (wave & 3) + 4 * lane);
                      *(f32x4*)(P.out + (size_t)(t - 1) * DM + 256 * (wave & 3) + 4 * lane) = (f32x4){v.x * r3 * gfv.x, v.y * r3 * gfv.y, v.z * r3 * gfv.z, v.w * r3 * gfv.w}; } }
                __builtin_amdgcn_sched_barrier(0);
            }
            asm volatile("s_waitcnt lgkmcnt(0)" : "+v"(b00), "+v"(b01), "+v"(b10), "+v"(b11) :: "memory");
            const i32x8v B0 = (i32x8v){b00.x, b00.y, b01.x, b01.y, 0, 0, 0, 0}, B1 = (i32x8v){b10.x, b10.y, b11.x, b11.y, 0, 0, 0, 0};
            const f32x4 z4 = (f32x4){0.f, 0.f, 0.f, 0.f};
            acc[cc][0] = __builtin_amdgcn_mfma_scale_f32_16x16x128_f8f6f4(A, B0, z4, 0  , 4  , 0, 0x7f7f7f7f, 0, 0x7f7f7f7f);
            acc[cc][1] = __builtin_amdgcn_mfma_scale_f32_16x16x128_f8f6f4(A, B1, z4, 0, 4, 0, 0x7f7f7f7f, 0, 0x7f7f7f7f);
        }
#pragma unroll
        for (int c = 0; c < 4; ++c) asm volatile("" :: "v"(acc[c][0]), "v"(acc[c][1]));
        float s0 = acc[0][0].x + acc[0][0].y, s1 = acc[0][1].x + acc[0][1].y;
        { const float a0 = acc[1][0].x + acc[1][0].y, a1 = acc[1][1].x + acc[1][1].y, b0 = acc[2][0].x + acc[2][0].y, b1 = acc[2][1].x + acc[2][1].y, d0 = acc[3][0].x + acc[3][0].y, d1 = acc[3][1].x + acc[3][1].y;
          s0 = (kb == 1) ? a0 : s0; s1 = (kb == 1) ? a1 : s1; s0 = (kb == 2) ? b0 : s0; s1 = (kb == 2) ? b1 : s1; s0 = (kb == 3) ? d0 : s0; s1 = (kb == 3) ? d1 : s1; }
        pv0 = s0 * C.w + __uint_as_float(C.h0 << 16); pv1 = s1 * C.w + __uint_as_float(C.h1 << 16);
        OUTB[1024 * (i & 1) + colb] = pv0; OUTB[1024 * (i & 1) + colb + 16] = pv1;
        const float sq = wave_sum_fast(pv0 * pv0 + pv1 * pv1);
        if (lane == 0) SS[8 * (i & 1) + wave] = sq;
    };
#pragma unroll 1
    for (int i = 0; i < TPB; i += 2) {
        token(i, true, C0, ia1, ib1, ia2, ib2);
        token(i + 1, false, C1, ia2, ib2, ia3, ib3);
        asm volatile("s_waitcnt vmcnt(14)" : "+v"(N0.a), "+v"(N0.b), "+v"(N1.a), "+v"(N1.b), "+v"(N0.w), "+v"(N1.w), "+v"(N0.h0), "+v"(N0.h1), "+v"(N1.h0), "+v"(N1.h1), "+v"(na4), "+v"(nb4), "+v"(na5), "+v"(nb5) :: "memory");
        C0 = N0; C1 = N1; ia1 = ia3; ib1 = ib3; ia2 = na4; ib2 = nb4; ia3 = na5; ib3 = nb5;
    }
    asm volatile("s_waitcnt vmcnt(0)" ::: "memory");
    __builtin_amdgcn_s_barrier();
    { const int i = TPB; const f32x4 s0 = *(const LAS f32x4*)(SS + 8 * ((i + 1) & 1)), s1 = *(const LAS f32x4*)(SS + 8 * ((i + 1) & 1) + 4);
      const float ss = ((s0.x + s0.y) + (s0.z + s0.w)) + ((s1.x + s1.y) + (s1.z + s1.w));
      const float r3 = rsqrtf(ss * (1.f / DM) + EPS);
      if ((wave >> 2) == ((i + 1) & 1)) {
          const f32x4 v = *(const LAS f32x4*)(OUTB + 1024 * ((i + 1) & 1) + 256 * (wave & 3) + 4 * lane);
          *(f32x4*)(P.out + (size_t)(t0 + TPB - 1) * DM + 256 * (wave & 3) + 4 * lane) = (f32x4){v.x * r3 * gfv.x, v.y * r3 * gfv.y, v.z * r3 * gfv.z, v.w * r3 * gfv.w}; } }
#undef VM_ISSUE
}

__device__ __forceinline__ void phase_quant_h2(const Params& P) {
    const int tid = threadIdx.x, lane = tid & 63, wave = __builtin_amdgcn_readfirstlane(tid >> 6);
    const int gw = blockIdx.x * NWAVES + wave, NGW = gridDim.x * NWAVES;
    unsigned char* ws = P.ws;
    const float* SSQ = (const float*)(ws + WS_SSQ); const float* AMX = (const float*)(ws + WS_AMX); float* RF = (float*)(ws + WS_RF);
    for (int row = gw; row < NTOK; row += NGW) {
        const u32x4* hp = (const u32x4*)(ws + WS_H2B + (size_t)row * DM * 2) + 2 * lane;
        const u32x4 a = hp[0], b = hp[1];
        const float am = fmaxf(row_max16(AMX[(size_t)row * 16 + (lane & 15)]), 1e-30f) * 1.0078125f;
        const float rstd2 = rsqrtf(row_sum16(SSQ[(size_t)row * 16 + (lane & 15)]) * (1.f / DM) + EPS);
        const float inv = 127.f / am;
        const unsigned w[8] = {a.x, a.y, a.z, a.w, b.x, b.y, b.z, b.w};
        unsigned o[4];
#pragma unroll
        for (int j = 0; j < 4; ++j) {
            const int q0 = (int)rintf(__uint_as_float(w[2 * j] << 16) * inv), q1 = (int)rintf(__uint_as_float(w[2 * j] & 0xffff0000u) * inv);
            const int q2 = (int)rintf(__uint_as_float(w[2 * j + 1] << 16) * inv), q3 = (int)rintf(__uint_as_float(w[2 * j + 1] & 0xffff0000u) * inv);
            o[j] = ((unsigned)q0 & 255u) | (((unsigned)q1 & 255u) << 8) | (((unsigned)q2 & 255u) << 16) | ((unsigned)q3 << 24); }
        u32x4 ov; ov.x = o[0]; ov.y = o[1]; ov.z = o[2]; ov.w = o[3];
        *((u32x4*)(ws + WS_H0I8 + (size_t)row * DM) + lane) = ov;
        if (lane == 0) RF[row] = am * (1.f / 127.f) * rstd2;
    }
}
struct EpiQI8 {
    static constexpr bool PERM = true, AFTER_DRAIN = false;
    bf16* O; int ldc; const float* rf; const float* sw;
    __device__ __forceinline__ void operator()(const pg8::i32x4 (&acc)[2][2][4][2], const pg8::Unit& u, int wr, int wc, int fr, int fq) const {
        const int row0 = u.pm * 256 + wr * 64 + fr, col0 = u.pn * 256 + wc * 32 + 8 * fq;
        f32x4 swv[2][2];
#pragma unroll
        for (int bj = 0; bj < 2; ++bj) { swv[bj][0] = *(const f32x4*)(sw + col0 + bj * 128); swv[bj][1] = *(const f32x4*)(sw + col0 + bj * 128 + 4); }
#pragma unroll
        for (int ai = 0; ai < 2; ++ai)
#pragma unroll
            for (int m = 0; m < 4; ++m) {
                const int row = row0 + ai * 128 + m * 16;
                const float s = rf[row];
                bf16* rowp = O + (size_t)row * ldc + col0;
#pragma unroll
                for (int bj = 0; bj < 2; ++bj) { const pg8::i32x4 a0 = acc[ai][bj][m][0], a1 = acc[ai][bj][m][1];
                    const f32x4 v0 = (f32x4){(float)a0[0], (float)a0[1], (float)a0[2], (float)a0[3]} * (swv[bj][0] * s), v1 = (f32x4){(float)a1[0], (float)a1[1], (float)a1[2], (float)a1[3]} * (swv[bj][1] * s);
                    u32x4 w; w.x = cvt_pk_bf16(v0[0], v0[1]); w.y = cvt_pk_bf16(v0[2], v0[3]); w.z = cvt_pk_bf16(v1[0], v1[1]); w.w = cvt_pk_bf16(v1[2], v1[3]);
                    *(u32x4*)(rowp + bj * 128) = w; }
            }
    }
};
#define XB_TMO      128
#define XB_XCNT(j)  (256  + 64 * (j))
#define XB_XSUB(j)  (1280 + 64 * (j))
#define XB_XGEN(j)  (2304 + 64 * (j))
#define XB_TOP      3328
#define XB_TOPGEN   3392
#define XCD_BAR_WORDS 3456
#define XB_SPIN_CAP (1u << 18)

__device__ __forceinline__ unsigned xb_ld(unsigned* p)              { return __hip_atomic_load(p, __ATOMIC_RELAXED, __HIP_MEMORY_SCOPE_AGENT); }
__device__ __forceinline__ unsigned xb_add(unsigned* p, unsigned v) { return __hip_atomic_fetch_add(p, v, __ATOMIC_RELAXED, __HIP_MEMORY_SCOPE_AGENT); }
__device__ __forceinline__ unsigned xb_xcc_id() { return (unsigned)__builtin_amdgcn_s_getreg((3 << 11) | 20) & 0xFu; }
#define XB_SPIN(cond, bar) do { unsigned _sp = 0; while (cond) { __builtin_amdgcn_s_sleep(1); \
    if ((++_sp & 255u) == 0u) { if (xb_ld(&(bar)[XB_TMO])) break; if (_sp > XB_SPIN_CAP) { atomicAdd(&(bar)[XB_TMO], 1u); break; } } } } while (0)

struct XcdBarrier {
    unsigned* bar; unsigned x;
    volatile LAS unsigned* st;
};

__device__ __forceinline__ XcdBarrier xcd_barrier_post(unsigned* bar, volatile LAS unsigned* st) {
    XcdBarrier b; b.bar = bar; b.x = xb_xcc_id(); b.st = st;
    if (threadIdx.x == 0) (void)xb_add(&bar[XB_XCNT(b.x)], 1u);
    return b;
}
__device__ __forceinline__ void xcd_barrier_complete(unsigned* bar, unsigned x, unsigned& nloc, unsigned& nx) {
    const unsigned G = gridDim.x * gridDim.y * gridDim.z;
    unsigned sum, cnt, mine, sp = 0u;
    for (;;) {
        sum = 0u; cnt = 0u; mine = 0u;
#pragma unroll
        for (unsigned j = 0; j < 16; ++j) { const unsigned c = xb_ld(&bar[XB_XCNT(j)]); sum += c; cnt += (c > 0u) ? 1u : 0u; mine = (j == x) ? c : mine; }
        if (sum == G) break;
        __builtin_amdgcn_s_sleep(1);
        if ((++sp & 255u) == 0u) { if (xb_ld(&bar[XB_TMO])) break; if (sp > XB_SPIN_CAP) { atomicAdd(&bar[XB_TMO], 1u); break; } }
    }
    nloc = mine > 0u ? mine : 1u; nx = cnt > 0u ? cnt : 1u;
}

__device__ __forceinline__ void xcd_barrier(const XcdBarrier& b) {
    asm volatile("s_waitcnt vmcnt(0)" ::: "memory");
    __syncthreads();
    if (threadIdx.x == 0) {
        unsigned* bar = b.bar;
        __builtin_amdgcn_s_waitcnt(0);
        unsigned nloc = b.st[0], nx = b.st[1];
        if (nloc == 0u) { xcd_barrier_complete(bar, b.x, nloc, nx); b.st[0] = nloc; b.st[1] = nx; }
        const unsigned old = xb_add(&bar[XB_XSUB(b.x)], 1u);
        const unsigned gen = old / nloc;
        if (old + 1u == (gen + 1u) * nloc) {
            __builtin_amdgcn_fence(__ATOMIC_RELEASE, "agent");
            asm volatile("s_waitcnt vmcnt(0)" ::: "memory");
            const unsigned og = xb_add(&bar[XB_TOP], 1u);
            const unsigned tg = og / nx;
            if (og + 1u == (tg + 1u) * nx) xb_add(&bar[XB_TOPGEN], 1u);
            else XB_SPIN(xb_ld(&bar[XB_TOPGEN]) == tg, bar);
            __builtin_amdgcn_fence(__ATOMIC_ACQUIRE, "agent");
            xb_add(&bar[XB_XGEN(b.x)], 1u);
            asm volatile("s_waitcnt vmcnt(0)" ::: "memory");
        } else {
            XB_SPIN(xb_ld(&bar[XB_XGEN(b.x)]) == gen, bar);
            __builtin_amdgcn_fence(__ATOMIC_ACQUIRE, "agent");
            asm volatile("s_waitcnt vmcnt(0)" ::: "memory");
        }
    }
    __syncthreads();
}


#ifndef MK_MULTI
#define MK_MULTI 0
#endif
constexpr int NPHASE = 10;
#ifndef REP5
#define REP5 1
#endif
#ifndef REP6
#define REP6 1
#endif
__global__ void __launch_bounds__(NTHREADS, 2) mk_fwd(Params P) {
    extern __shared__ __attribute__((aligned(16))) unsigned char lds_raw[];
    LAS unsigned char* lds = (LAS unsigned char*)lds_raw;
    cg::grid_group grid = cg::this_grid();
    unsigned char* ws = P.ws;
    const int lo = P.ph_lo, hi = P.ph_hi;
    volatile LAS unsigned* bst = (volatile LAS unsigned*)(lds + 131072 + 64);
    if (threadIdx.x < 2) bst[threadIdx.x] = 0u;
    __syncthreads();
    XcdBarrier xbar = xcd_barrier_post((unsigned*)(ws + WS_CTL), bst);
#define IN(k) (lo <= (k) && (k) < hi)
#define SEAM(k) do { if (IN(k) && IN((k) + 1)) { xcd_barrier(xbar); } } while (0)
    if (IN(0)) phase_prep(P, lds);
    SEAM(0);
    if (IN(1)) { phase_metaproj(P); phase_winq(P, lds); }
    SEAM(1);
    if (IN(2)) {
        pg8::Gemm g{(const bf16*)(ws + WS_H0I8), (const bf16*)(ws + WS_WIN_T), NTOK, DIN, DM / 2}; pg8::StaticOrder S; S.init(NTOK, DIN, (int)gridDim.x, (int)blockIdx.x);
        EpiProjI8 E{(bf16*)(ws + WS_PROJ), (const float*)(ws + WS_RSTD1), (const float*)(ws + WS_SW)};
        pg8::gemm_phase_i8<EpiProjI8, pg8::StaticOrder, true, true>(lds, g, S, E);
    }
    SEAM(2);
    if (IN(3)) phase_conv(P, lds);
    SEAM(3);
    if (IN(4)) {
        pg8::Gemm g{(const bf16*)(ws + WS_Y), (const bf16*)(ws + WS_WOUT_T), NTOK, DM, DM / 2}; pg8::StaticOrder S; S.init(NTOK, DM, (int)gridDim.x, (int)blockIdx.x);
        EpiResidualI8 E{(bf16*)(ws + WS_H2B), (const signed char*)(ws + WS_H0I8), (const float*)(ws + WS_SX), (const float*)(ws + WS_SY), (const float*)(ws + WS_SWO), (float*)(ws + WS_SSQ), (float*)(ws + WS_AMX)};
        pg8::gemm_phase_i8<EpiResidualI8, pg8::StaticOrder, true, true>(lds, g, S, E);
    }
    SEAM(4);
    if (IN(5)) phase_quant_h2(P);
    SEAM(5);
    if (IN(6)) {
        pg8::Gemm g{(const bf16*)(ws + WS_H0I8), (const bf16*)(ws + WS_WQ_T), NTOK, 2048, DM / 2}; pg8::StaticOrder S; S.init(NTOK, 2048, (int)gridDim.x, (int)blockIdx.x);
        EpiQI8 E{(bf16*)(ws + WS_Q), 2048, (const float*)(ws + WS_RF), (const float*)(ws + WS_SWQ)};
        pg8::gemm_phase_i8<EpiQI8, pg8::StaticOrder, true, true>(lds, g, S, E);
    }
    if (IN(6) && IN(7)) { asm volatile("s_waitcnt vmcnt(0)" ::: "memory"); __syncthreads(); }
    if (IN(7)) phase_route(P, lds);
    SEAM(7);
    if (IN(8)) phase_gather_u(P);
    SEAM(8);
    if (IN(9)) phase_gather_v_mfma(P, lds);
#undef IN
#undef SEAM
}

extern "C" void kernel_launch(void* const* d_in, const int* in_sizes, int n_in, void* d_out, int out_size, void* d_ws, size_t ws_size, hipStream_t stream) {
    static int grid = 0;
    if (grid == 0) {
        if (n_in != 18 || in_sizes[0] != NTOK * DM || out_size != NTOK * DM || ws_size < WS_END) {
            fprintf(stderr, "kernel_launch: unexpected shapes (n_in %d in0 %d out %d ws %zu)\n", n_in, n_in > 0 ? in_sizes[0] : -1, out_size, ws_size); grid = -1; return; }
        int dev = 0, cus = 0, per_cu = 0;
        (void)hipGetDevice(&dev); (void)hipDeviceGetAttribute(&cus, hipDeviceAttributeMultiprocessorCount, dev);
        if (hipFuncSetAttribute((const void*)mk_fwd, hipFuncAttributeMaxDynamicSharedMemorySize, LDS_BYTES) != hipSuccess) { fprintf(stderr, "kernel_launch: hipFuncSetAttribute failed\n"); grid = -1; return; }
        if (hipOccupancyMaxActiveBlocksPerMultiprocessor(&per_cu, (const void*)mk_fwd, NTHREADS, LDS_BYTES) != hipSuccess || per_cu < 1) { fprintf(stderr, "kernel_launch: occupancy query failed (%d)\n", per_cu); (void)hipGetLastError(); per_cu = 1; }
        if (per_cu > 1) per_cu = 1;
        grid = cus * per_cu;
        if (grid <= 0) grid = 256;
    }
    if (grid < 0) return;
    Params p{};
    p.x = (const float*)d_in[0]; p.meta = (const float*)d_in[1]; p.g_mix = (const float*)d_in[2]; p.w_in = (const float*)d_in[3]; p.sc_w = (const float*)d_in[4];
    p.cf_w = (const float*)d_in[5]; p.cf_b = (const float*)d_in[6]; p.ln_g = (const float*)d_in[7]; p.ln_b = (const float*)d_in[8]; p.g_sc = (const float*)d_in[9];
    p.g_cf = (const float*)d_in[10]; p.w_out = (const float*)d_in[11]; p.g_ffn = (const float*)d_in[12]; p.w_q = (const float*)d_in[13]; p.keys = (const float*)d_in[14];
    p.pu = (const float*)d_in[15]; p.pv = (const float*)d_in[16]; p.g_fin = (const float*)d_in[17];
    p.out = (float*)d_out; p.ws = (unsigned char*)d_ws;
    (void)hipMemsetAsync((char*)d_ws + WS_CTL, 0, 45056, stream);
#if MK_MULTI
    for (int ph = 0; ph < NPHASE; ++ph) { p.ph_lo = ph; p.ph_hi = ph + 1; p.coop = 0; p.pad = 0;
        hipLaunchKernelGGL(mk_fwd, dim3(grid), dim3(NTHREADS), LDS_BYTES, stream, p); }
#else
    p.ph_lo = 0; p.ph_hi = NPHASE; p.coop = 1; p.pad = 0;
    void* args[] = {&p};
    hipError_t e = hipLaunchCooperativeKernel((const void*)mk_fwd, dim3(grid), dim3(NTHREADS), args, LDS_BYTES, stream);
    if (e != hipSuccess) fprintf(stderr, "cooperative launch failed: %s (grid %d)\n", hipGetErrorString(e), grid);
#endif
}
```

```cpp
#include <hip/hip_runtime.h>
#include <hip/hip_cooperative_groups.h>
#include <cstdio>
#include <cstdint>
namespace cg = cooperative_groups;

namespace pg8 {
#define PG8_LAS __attribute__((address_space(3)))
typedef unsigned short bf16_t;
typedef short bf16x8 __attribute__((ext_vector_type(8)));
typedef float f32x4 __attribute__((ext_vector_type(4)));
typedef unsigned u32x4 __attribute__((ext_vector_type(4)));
typedef int i32x4 __attribute__((ext_vector_type(4)));
constexpr int BM = 256, BK = 64, HALF = 128, HTB = HALF * BK * 2  , STAGE_BYTES = 8 * HTB, NXCD = 8, WGM = 8;

__host__ __device__ __forceinline__ int lds_byte(int r, int c) { const int st = (r >> 4) * 2 + (c >> 5), rr = r & 15, cc = c & 31, ob = rr * 64 + cc * 2; return st * 1024 + (ob ^ (((ob >> 9) & 1) << 5)); }
__host__ __device__ __forceinline__ void stage_rc(int b, int& R, int& C) { const int st = b / 1024, sb = b % 1024, swz = sb ^ (((sb >> 9) & 1) << 5); R = (st >> 1) * 16 + swz / 64; C = (st & 1) * 32 + (swz % 64) / 2; }
__host__ __device__ __forceinline__ int perm32(int rho) { const int n = rho >> 4, i = rho & 15; return 8 * (i >> 2) + 4 * n + (i & 3); }

struct Unit { int pm, pn; };
struct Gemm { const bf16_t* A; const bf16_t* Bt; int M, N, K; };

struct StaticOrder {
    int nM, nN, nwg, G, c;
    __host__ __device__ void init(int M, int N, int G_, int c_) { nM = M / BM; nN = N / BM; nwg = nM * nN; G = G_; c = c_; }
    __host__ __device__ bool next(int i, Unit& u) const {
        const long L = (long)i * G + c; if (L >= nwg) return false;
        int wgid = (int)L; { const int q = nwg / NXCD, r = nwg % NXCD, xcd = wgid % NXCD, off = wgid / NXCD; wgid = (xcd < r ? xcd * (q + 1) : r * (q + 1) + (xcd - r) * q) + off; }
        const int nig = WGM * nN, gid = wgid / nig, fm = gid * WGM, gsz = (nM - fm) < WGM ? (nM - fm) : WGM;
        u.pm = fm + ((wgid % nig) % gsz); u.pn = (wgid % nig) / gsz; return true;
    }
    __device__ __forceinline__ void a_ready(const Unit&) const {}
    __device__ __forceinline__ void done(const Unit&) const {}
};

template <class Epi, class Sched, bool ALIGN_EPI = false, bool SP2 = false>
__device__ __forceinline__ void gemm_phase(PG8_LAS unsigned char* lds, const Gemm g, const Sched& S, const Epi& E) {
    const int tid = threadIdx.x, wid = __builtin_amdgcn_readfirstlane(tid >> 6), lane = tid & 63, wr = wid >> 2, wc = wid & 3, fr = lane & 15, fq = lane >> 4;
    const int K = g.K, nt = K / BK;
    unsigned voffA[2], voffB[2];
#pragma unroll
    for (int i = 0; i < 2; ++i) { int R, C; stage_rc(tid * 16 + i * 8192, R, C); const int Rb = Epi::PERM ? ((R & ~31) + perm32(R & 31)) : R;
        voffA[i] = (unsigned)(R * K + C) * 2u; voffB[i] = (unsigned)(Rb * K + C) * 2u; }
    const size_t kstep = (size_t)(BK * 2);
    const size_t hstep = (size_t)HALF * K * 2;
    const size_t tstep = 2 * hstep;
    const unsigned ldsw = (unsigned)wid * 1024u;
    const int aoff = lds_byte(wr * 64 + fr, fq * 8), boff = lds_byte(wc * 32 + fr, fq * 8);
#define PG8_SA(b, h) (((b) * 2 + (h)) * HTB)
#define PG8_SB(b, h) ((4 + (b) * 2 + (h)) * HTB)
#define PG8_STAGE(bufoff, gbase, voff) do { _Pragma("unroll") for (int _i = 0; _i < 2; ++_i) \
        __builtin_amdgcn_global_load_lds((const unsigned*)((const char*)(gbase) + (voff)[_i]), (PG8_LAS unsigned*)(lds + (bufoff) + ldsw + _i * 8192), 16, 0, 0); } while (0)
#define PG8_LDA(dst, b, h) do { _Pragma("unroll") for (int m = 0; m < 4; ++m) _Pragma("unroll") for (int k = 0; k < 2; ++k) dst[m][k] = *(const PG8_LAS bf16x8*)(lds + PG8_SA(b, h) + aoff + m * 2048 + k * 1024); } while (0)
#define PG8_LDB(dst, b, h) do { _Pragma("unroll") for (int n = 0; n < 2; ++n) _Pragma("unroll") for (int k = 0; k < 2; ++k) dst[n][k] = *(const PG8_LAS bf16x8*)(lds + PG8_SB(b, h) + boff + n * 2048 + k * 1024); } while (0)
#define PG8_MMA(ai, bj, At, Bt) do { __builtin_amdgcn_s_setprio(1); _Pragma("unroll") for (int m = 0; m < 4; ++m) _Pragma("unroll") for (int n = 0; n < 2; ++n) _Pragma("unroll") for (int k = 0; k < 2; ++k) \
        acc[ai][bj][m][n] = __builtin_amdgcn_mfma_f32_16x16x32_bf16(Bt[n][k], At[m][k], acc[ai][bj][m][n], 0, 0, 0); __builtin_amdgcn_s_setprio(0); } while (0)
#define PG8_WAIT_V(n) asm volatile("s_waitcnt vmcnt(" #n ")" ::: "memory")
#define PG8_WAIT_L(n) asm volatile("s_waitcnt lgkmcnt(" #n ")" ::: "memory")
#define PG8_BAR __builtin_amdgcn_s_barrier()
#define PG8_SCHED __builtin_amdgcn_sched_barrier(0)
    Unit cur, nxt; int ui = 0;
    if (!S.next(0, cur)) return;
    f32x4 acc[2][2][4][2];
#pragma unroll
    for (int a = 0; a < 2; ++a)
#pragma unroll
        for (int b = 0; b < 2; ++b)
#pragma unroll
            for (int m = 0; m < 4; ++m)
#pragma unroll
                for (int n = 0; n < 2; ++n) acc[a][b][m][n] = (f32x4){0.f, 0.f, 0.f, 0.f};
    bf16x8 At[4][2], B0[2][2], B1[2][2];
    const char* cA = (const char*)g.A + (size_t)cur.pm * tstep; const char* cB = (const char*)g.Bt + (size_t)cur.pn * tstep;
    S.a_ready(cur);
    if constexpr (SP2) {
        PG8_STAGE(PG8_SB(0, 0), cB, voffB); PG8_STAGE(PG8_SB(0, 1), cB + hstep, voffB); PG8_STAGE(PG8_SA(0, 0), cA, voffA); PG8_STAGE(PG8_SA(0, 1), cA + hstep, voffA);
        if (wr == 1) PG8_BAR;
        PG8_WAIT_V(2); PG8_BAR;
        PG8_STAGE(PG8_SB(1, 0), cB + kstep, voffB); PG8_STAGE(PG8_SA(1, 0), cA + kstep, voffA); PG8_STAGE(PG8_SB(1, 1), cB + hstep + kstep, voffB);
        PG8_WAIT_V(6); PG8_BAR;
    } else {
        PG8_STAGE(PG8_SB(0, 0), cB, voffB); PG8_STAGE(PG8_SA(0, 0), cA, voffA); PG8_STAGE(PG8_SB(0, 1), cB + hstep, voffB); PG8_STAGE(PG8_SA(0, 1), cA + hstep, voffA);
        if (wr == 1) PG8_BAR;
        PG8_WAIT_V(4); PG8_BAR;
        PG8_STAGE(PG8_SB(1, 0), cB + kstep, voffB); PG8_STAGE(PG8_SA(1, 0), cA + kstep, voffA); PG8_STAGE(PG8_SB(1, 1), cB + hstep + kstep, voffB);
        PG8_WAIT_V(6); PG8_BAR;
    }
    for (;;) {
        const bool has_next = S.next(ui + 1, nxt);
        const char* nA = has_next ? (const char*)g.A + (size_t)nxt.pm * tstep : cA; const char* nB = has_next ? (const char*)g.Bt + (size_t)nxt.pn * tstep : cB;
        for (int t = 0; t < nt; t += 2) {
            const bool last = (t == nt - 2);
            const char* a1 = cA + (size_t)(t + 1) * kstep;
            const char* a2 = last ? nA : cA + (size_t)(t + 2) * kstep; const char* b2 = last ? nB : cB + (size_t)(t + 2) * kstep;
            const char* a3 = a2 + kstep; const char* b3 = b2 + kstep;
            if (last && has_next) S.a_ready(nxt);
            if constexpr (SP2) {
            PG8_LDB(B0, 0, 0); PG8_LDB(B1, 0, 1); PG8_SCHED; PG8_LDA(At, 0, 0); PG8_STAGE(PG8_SA(1, 1), a1 + hstep, voffA);
            PG8_WAIT_V(8); PG8_WAIT_L(0); PG8_BAR; PG8_MMA(0, 0, At, B0); PG8_MMA(0, 1, At, B1); PG8_BAR; PG8_SCHED;
            PG8_LDA(At, 0, 1); PG8_STAGE(PG8_SB(0, 0), b2, voffB); PG8_STAGE(PG8_SB(0, 1), b2 + hstep, voffB); PG8_STAGE(PG8_SA(0, 0), a2, voffA);
            PG8_WAIT_V(8); PG8_WAIT_L(0); PG8_BAR; PG8_MMA(1, 0, At, B0); PG8_MMA(1, 1, At, B1); PG8_BAR; PG8_SCHED;
            PG8_LDB(B0, 1, 0); PG8_LDB(B1, 1, 1); PG8_SCHED; PG8_LDA(At, 1, 0); PG8_STAGE(PG8_SA(0, 1), a2 + hstep, voffA);
            PG8_WAIT_V(8); PG8_WAIT_L(0); PG8_BAR; PG8_MMA(0, 0, At, B0); PG8_MMA(0, 1, At, B1); PG8_BAR; PG8_SCHED;
            PG8_LDA(At, 1, 1); PG8_STAGE(PG8_SB(1, 0), b3, voffB); PG8_STAGE(PG8_SB(1, 1), b3 + hstep, voffB); PG8_STAGE(PG8_SA(1, 0), a3, voffA);
            PG8_WAIT_V(8); PG8_WAIT_L(0); PG8_BAR; PG8_MMA(1, 0, At, B0); PG8_MMA(1, 1, At, B1); PG8_BAR; PG8_SCHED;
            } else {
            PG8_LDB(B0, 0, 0); PG8_SCHED; PG8_LDA(At, 0, 0); PG8_STAGE(PG8_SA(1, 1), a1 + hstep, voffA);
            PG8_WAIT_L(8); PG8_BAR; PG8_WAIT_L(0); PG8_MMA(0, 0, At, B0); PG8_BAR; PG8_SCHED;
            PG8_LDB(B1, 0, 1); PG8_STAGE(PG8_SB(0, 0), b2, voffB);
            PG8_BAR; PG8_WAIT_L(0); PG8_MMA(0, 1, At, B1); PG8_BAR;
            PG8_LDA(At, 0, 1); PG8_STAGE(PG8_SA(0, 0), a2, voffA);
            PG8_BAR; PG8_WAIT_L(0); PG8_MMA(1, 0, At, B0); PG8_BAR; PG8_SCHED;
            PG8_STAGE(PG8_SB(0, 1), b2 + hstep, voffB);
            PG8_WAIT_V(6); PG8_BAR; PG8_MMA(1, 1, At, B1); PG8_BAR;
            PG8_LDB(B0, 1, 0); PG8_SCHED; PG8_LDA(At, 1, 0); PG8_STAGE(PG8_SA(0, 1), a2 + hstep, voffA);
            PG8_WAIT_L(8); PG8_BAR; PG8_WAIT_L(0); PG8_MMA(0, 0, At, B0); PG8_BAR; PG8_SCHED;
            PG8_LDB(B1, 1, 1); PG8_STAGE(PG8_SB(1, 0), b3, voffB);
            PG8_BAR; PG8_WAIT_L(0); PG8_MMA(0, 1, At, B1); PG8_BAR;
            PG8_LDA(At, 1, 1); PG8_STAGE(PG8_SA(1, 0), a3, voffA);
            PG8_BAR; PG8_WAIT_L(0); PG8_MMA(1, 0, At, B0); PG8_BAR; PG8_SCHED;
            PG8_STAGE(PG8_SB(1, 1), b3 + hstep, voffB);
            PG8_WAIT_V(6); PG8_BAR; PG8_MMA(1, 1, At, B1); PG8_BAR;
            }
        }
        if constexpr (ALIGN_EPI) { if (wr == 0) PG8_BAR; }
        if constexpr (!Epi::AFTER_DRAIN) { E(acc, cur, wr, wc, fr, fq); S.done(cur); }
        if (!has_next) break;
#pragma unroll
        for (int a = 0; a < 2; ++a)
#pragma unroll
            for (int b = 0; b < 2; ++b)
#pragma unroll
                for (int m = 0; m < 4; ++m)
#pragma unroll
                    for (int n = 0; n < 2; ++n) acc[a][b][m][n] = (f32x4){0.f, 0.f, 0.f, 0.f};
        cur = nxt; cA = nA; cB = nB; ++ui;
        if constexpr (ALIGN_EPI) { if (wr == 1) PG8_BAR; }
    }
    PG8_WAIT_V(0);
    if constexpr (!ALIGN_EPI) { if (wr == 0) PG8_BAR; }
    PG8_BAR;
    if constexpr (Epi::AFTER_DRAIN) { E.fused(acc, cur, wr, wc, fr, fq, lds, wid, lane); S.done(cur); }
#undef PG8_SA
#undef PG8_SB
#undef PG8_STAGE
#undef PG8_LDA
#undef PG8_LDB
#undef PG8_MMA
#undef PG8_WAIT_V
#undef PG8_WAIT_L
#undef PG8_BAR
#undef PG8_SCHED
}
template <class Epi, class Sched, bool ALIGN_EPI = false, bool SP2 = false>
__device__ __forceinline__ void gemm_phase_i8(PG8_LAS unsigned char* lds, const Gemm g, const Sched& S, const Epi& E) {
    const int tid = threadIdx.x, wid = __builtin_amdgcn_readfirstlane(tid >> 6), lane = tid & 63, wr = wid >> 2, wc = wid & 3, fr = lane & 15, fq = lane >> 4;
    const int K = g.K, nt = K / BK;
    unsigned voffA[2], voffB[2];
#pragma unroll
    for (int i = 0; i < 2; ++i) { int R, C; stage_rc(tid * 16 + i * 8192, R, C); const int Rb = Epi::PERM ? ((R & ~31) + perm32(R & 31)) : R;
        voffA[i] = (unsigned)(R * K + C) * 2u; voffB[i] = (unsigned)(Rb * K + C) * 2u; }
    const size_t kstep = (size_t)(BK * 2);
    const size_t hstep = (size_t)HALF * K * 2;
    const size_t tstep = 2 * hstep;
    const unsigned ldsw = (unsigned)wid * 1024u;
    const int aoff = lds_byte(wr * 64 + fr, fq * 8), boff = lds_byte(wc * 32 + fr, fq * 8);
#define PG8_SA(b, h) (((b) * 2 + (h)) * HTB)
#define PG8_SB(b, h) ((4 + (b) * 2 + (h)) * HTB)
#define PG8_STAGE(bufoff, gbase, voff) do { _Pragma("unroll") for (int _i = 0; _i < 2; ++_i) \
        __builtin_amdgcn_global_load_lds((const unsigned*)((const char*)(gbase) + (voff)[_i]), (PG8_LAS unsigned*)(lds + (bufoff) + ldsw + _i * 8192), 16, 0, 0); } while (0)
#define PG8_LDA(dst, b, h) do { _Pragma("unroll") for (int m = 0; m < 4; ++m) _Pragma("unroll") for (int k = 0; k < 2; ++k) dst[m][k] = *(const PG8_LAS bf16x8*)(lds + PG8_SA(b, h) + aoff + m * 2048 + k * 1024); } while (0)
#define PG8_LDB(dst, b, h) do { _Pragma("unroll") for (int n = 0; n < 2; ++n) _Pragma("unroll") for (int k = 0; k < 2; ++k) dst[n][k] = *(const PG8_LAS bf16x8*)(lds + PG8_SB(b, h) + boff + n * 2048 + k * 1024); } while (0)
#define PG8_MMA(ai, bj, At, Bt) do { __builtin_amdgcn_s_setprio(1); _Pragma("unroll") for (int m = 0; m < 4; ++m) _Pragma("unroll") for (int n = 0; n < 2; ++n) _Pragma("unroll") for (int k = 0; k < 2; ++k) \
        acc[ai][bj][m][n] = __builtin_amdgcn_mfma_i32_16x16x64_i8(__builtin_bit_cast(i32x4, Bt[n][k]), __builtin_bit_cast(i32x4, At[m][k]), acc[ai][bj][m][n], 0, 0, 0); __builtin_amdgcn_s_setprio(0); } while (0)
#define PG8_WAIT_V(n) asm volatile("s_waitcnt vmcnt(" #n ")" ::: "memory")
#define PG8_WAIT_L(n) asm volatile("s_waitcnt lgkmcnt(" #n ")" ::: "memory")
#define PG8_BAR __builtin_amdgcn_s_barrier()
#define PG8_SCHED __builtin_amdgcn_sched_barrier(0)
    Unit cur, nxt; int ui = 0;
    if (!S.next(0, cur)) return;
    i32x4 acc[2][2][4][2];
#pragma unroll
    for (int a = 0; a < 2; ++a)
#pragma unroll
        for (int b = 0; b < 2; ++b)
#pragma unroll
            for (int m = 0; m < 4; ++m)
#pragma unroll
                for (int n = 0; n < 2; ++n) acc[a][b][m][n] = (i32x4){0, 0, 0, 0};
    bf16x8 At[4][2], B0[2][2], B1[2][2];
    const char* cA = (const char*)g.A + (size_t)cur.pm * tstep; const char* cB = (const char*)g.Bt + (size_t)cur.pn * tstep;
    S.a_ready(cur);
    if constexpr (SP2) {
        PG8_STAGE(PG8_SB(0, 0), cB, voffB); PG8_STAGE(PG8_SB(0, 1), cB + hstep, voffB); PG8_STAGE(PG8_SA(0, 0), cA, voffA); PG8_STAGE(PG8_SA(0, 1), cA + hstep, voffA);
        if (wr == 1) PG8_BAR;
        PG8_WAIT_V(2); PG8_BAR;
        PG8_STAGE(PG8_SB(1, 0), cB + kstep, voffB); PG8_STAGE(PG8_SA(1, 0), cA + kstep, voffA); PG8_STAGE(PG8_SB(1, 1), cB + hstep + kstep, voffB);
        PG8_WAIT_V(6); PG8_BAR;
    } else {
        PG8_STAGE(PG8_SB(0, 0), cB, voffB); PG8_STAGE(PG8_SA(0, 0), cA, voffA); PG8_STAGE(PG8_SB(0, 1), cB + hstep, voffB); PG8_STAGE(PG8_SA(0, 1), cA + hstep, voffA);
        if (wr == 1) PG8_BAR;
        PG8_WAIT_V(4); PG8_BAR;
        PG8_STAGE(PG8_SB(1, 0), cB + kstep, voffB); PG8_STAGE(PG8_SA(1, 0), cA + kstep, voffA); PG8_STAGE(PG8_SB(1, 1), cB + hstep + kstep, voffB);
        PG8_WAIT_V(6); PG8_BAR;
    }
    for (;;) {
        const bool has_next = S.next(ui + 1, nxt);
        const char* nA = has_next ? (const char*)g.A + (size_t)nxt.pm * tstep : cA; const char* nB = has_next ? (const char*)g.Bt + (size_t)nxt.pn * tstep : cB;
        for (int t = 0; t < nt; t += 2) {
            const bool last = (t == nt - 2);
            const char* a1 = cA + (size_t)(t + 1) * kstep;
            const char* a2 = last ? nA : cA + (size_t)(t + 2) * kstep; const char* b2 = last ? nB : cB + (size_t)(t + 2) * kstep;
            const char* a3 = a2 + kstep; const char* b3 = b2 + kstep;
            if (last && has_next) S.a_ready(nxt);
            if constexpr (SP2) {
            PG8_LDB(B0, 0, 0); PG8_LDB(B1, 0, 1); PG8_SCHED; PG8_LDA(At, 0, 0); PG8_STAGE(PG8_SA(1, 1), a1 + hstep, voffA);
            PG8_WAIT_V(8); PG8_WAIT_L(0); PG8_BAR; PG8_MMA(0, 0, At, B0); PG8_MMA(0, 1, At, B1); PG8_BAR; PG8_SCHED;
            PG8_LDA(At, 0, 1); PG8_STAGE(PG8_SB(0, 0), b2, voffB); PG8_STAGE(PG8_SB(0, 1), b2 + hstep, voffB); PG8_STAGE(PG8_SA(0, 0), a2, voffA);
            PG8_WAIT_V(8); PG8_WAIT_L(0); PG8_BAR; PG8_MMA(1, 0, At, B0); PG8_MMA(1, 1, At, B1); PG8_BAR; PG8_SCHED;
            PG8_LDB(B0, 1, 0); PG8_LDB(B1, 1, 1); PG8_SCHED; PG8_LDA(At, 1, 0); PG8_STAGE(PG8_SA(0, 1), a2 + hstep, voffA);
            PG8_WAIT_V(8); PG8_WAIT_L(0); PG8_BAR; PG8_MMA(0, 0, At, B0); PG8_MMA(0, 1, At, B1); PG8_BAR; PG8_SCHED;
            PG8_LDA(At, 1, 1); PG8_STAGE(PG8_SB(1, 0), b3, voffB); PG8_STAGE(PG8_SB(1, 1), b3 + hstep, voffB); PG8_STAGE(PG8_SA(1, 0), a3, voffA);
            PG8_WAIT_V(8); PG8_WAIT_L(0); PG8_BAR; PG8_MMA(1, 0, At, B0); PG8_MMA(1, 1, At, B1); PG8_BAR; PG8_SCHED;
            } else {
            PG8_LDB(B0, 0, 0); PG8_SCHED; PG8_LDA(At, 0, 0); PG8_STAGE(PG8_SA(1, 1), a1 + hstep, voffA);
            PG8_WAIT_L(8); PG8_BAR; PG8_WAIT_L(0); PG8_MMA(0, 0, At, B0); PG8_BAR; PG8_SCHED;
            PG8_LDB(B1, 0, 1); PG8_STAGE(PG8_SB(0, 0), b2, voffB);
            PG8_BAR; PG8_WAIT_L(0); PG8_MMA(0, 1, At, B1); PG8_BAR;
            PG8_LDA(At, 0, 1); PG8_STAGE(PG8_SA(0, 0), a2, voffA);
            PG8_BAR; PG8_WAIT_L(0); PG8_MMA(1, 0, At, B0); PG8_BAR; PG8_SCHED;
            PG8_STAGE(PG8_SB(0, 1), b2 + hstep, voffB);
            PG8_WAIT_V(6); PG8_BAR; PG8_MMA(1, 1, At, B1); PG8_BAR;
            PG8_LDB(B0, 1, 0); PG8_SCHED; PG8_LDA(At, 1, 0); PG8_STAGE(PG8_SA(0, 1), a2 + hstep, voffA);
            PG8_WAIT_L(8); PG8_BAR; PG8_WAIT_L(0); PG8_MMA(0, 0, At, B0); PG8_BAR; PG8_SCHED;
            PG8_LDB(B1, 1, 1); PG8_STAGE(PG8_SB(1, 0), b3, voffB);
            PG8_BAR; PG8_WAIT_L(0); PG8_MMA(0, 1, At, B1); PG8_BAR;
            PG8_LDA(At, 1, 1); PG8_STAGE(PG8_SA(1, 0), a3, voffA);
            PG8_BAR; PG8_WAIT_L(0); PG8_MMA(1, 0, At, B0); PG8_BAR; PG8_SCHED;
            PG8_STAGE(PG8_SB(1, 1), b3 + hstep, voffB);
            PG8_WAIT_V(6); PG8_BAR; PG8_MMA(1, 1, At, B1); PG8_BAR;
            }
        }
        if constexpr (ALIGN_EPI) { if (wr == 0) PG8_BAR; }
        if constexpr (!Epi::AFTER_DRAIN) { E(acc, cur, wr, wc, fr, fq); S.done(cur); }
        if (!has_next) break;
#pragma unroll
        for (int a = 0; a < 2; ++a)
#pragma unroll
            for (int b = 0; b < 2; ++b)
#pragma unroll
                for (int m = 0; m < 4; ++m)
#pragma unroll
                    for (int n = 0; n < 2; ++n) acc[a][b][m][n] = (i32x4){0, 0, 0, 0};
        cur = nxt; cA = nA; cB = nB; ++ui;
        if constexpr (ALIGN_EPI) { if (wr == 1) PG8_BAR; }
    }
    PG8_WAIT_V(0);
    if constexpr (!ALIGN_EPI) { if (wr == 0) PG8_BAR; }
    PG8_BAR;
    if constexpr (Epi::AFTER_DRAIN) { E.fused(acc, cur, wr, wc, fr, fq, lds, wid, lane); S.done(cur); }
#undef PG8_SA
#undef PG8_SB
#undef PG8_STAGE
#undef PG8_LDA
#undef PG8_LDB
#undef PG8_MMA
#undef PG8_WAIT_V
#undef PG8_WAIT_L
#undef PG8_BAR
#undef PG8_SCHED
}
}

#define LAS __attribute__((address_space(3)))
typedef unsigned short bf16;
typedef float f32x2 __attribute__((ext_vector_type(2)));
typedef float f32x4 __attribute__((ext_vector_type(4)));
typedef unsigned u32x2 __attribute__((ext_vector_type(2)));
typedef unsigned u32x4 __attribute__((ext_vector_type(4)));

constexpr int PDIM = 1536;
constexpr int NTOK = 32768, DM = 1024, DIN = 2560, SEQ = 8192, NBATCH = 4, NMETA = 16;
constexpr int NHEAD = 8, NKEYS = 128, TOPK = 16, NSEL = NHEAD * TOPK;
constexpr float EPS = 1e-6f;
constexpr float U_SCALE = 64.f, V_SCALE = 16.f;
constexpr float U4_CLIP = 2.6f;
constexpr int NWAVES = 8, NTHREADS = 512;
constexpr int MKC = 32;
constexpr int LDS_BYTES = 147456;

constexpr size_t MiB = 1u << 20;
constexpr size_t WS_CTL = 0, WS_WIN_T = 1 * MiB, WS_WOUT_T = 6 * MiB, WS_WQ_T = 8 * MiB, WS_KEYS = 12 * MiB, WS_METAPART = 160 * MiB  ,
                 WS_METARSTD = 14 * MiB + 512 * 1024, WS_METAPROJ = 14 * MiB + 576 * 1024, WS_RSTD1 = 15 * MiB, WS_SSQ = 16 * MiB, WS_U8 = 32 * MiB, WS_V8 = 48 * MiB,
                 WS_IDX = 64 * MiB, WS_GATE = 80 * MiB, WS_H0B = 96 * MiB, WS_H2B = 96 * MiB, WS_Y = 160 * MiB, WS_PROJ = 224 * MiB,
                 WS_Q = 224 * MiB, WS_ESCALE = 18 * MiB, WS_SUMQ = 19 * MiB, WS_SX = 20 * MiB, WS_SW = 21 * MiB, WS_SY = 22 * MiB, WS_SWO = 23 * MiB, WS_WMX = 24 * MiB, WS_AMX = 26 * MiB, WS_RF = 28 * MiB, WS_SWQ = 29 * MiB, WS_H0I8 = 384 * MiB, WS_AW = 160 * MiB  , WS_END = 416 * MiB;

struct Params {
    const float* x; const float* meta; const float* g_mix; const float* w_in; const float* sc_w; const float* cf_w; const float* cf_b;
    const float* ln_g; const float* ln_b; const float* g_sc; const float* g_cf; const float* w_out; const float* g_ffn; const float* w_q;
    const float* keys; const float* pu; const float* pv; const float* g_fin;
    float* out; unsigned char* ws;
    int ph_lo, ph_hi, coop, pad;
};

__device__ __forceinline__ unsigned f2bf(float f) { unsigned u = __builtin_bit_cast(unsigned, f); return (u + 0x7fffu + ((u >> 16) & 1u)) >> 16; }
__device__ __forceinline__ unsigned pk2(float lo, float hi) { return f2bf(lo) | (f2bf(hi) << 16); }
__device__ __forceinline__ float bf2f(unsigned b) { return __builtin_bit_cast(float, b << 16); }
__device__ __forceinline__ float bflo(unsigned w) { return __builtin_bit_cast(float, w << 16); }
__device__ __forceinline__ float bfhi(unsigned w) { return __builtin_bit_cast(float, w & 0xffff0000u); }
__device__ __forceinline__ float wave_sum(float v) {
#pragma unroll
    for (int o = 1; o < 64; o <<= 1) v += __shfl_xor(v, o);
    return v;
}
template <int CTRL> __device__ __forceinline__ float dpp_f(float v) { return __builtin_bit_cast(float, __builtin_amdgcn_update_dpp(0, __builtin_bit_cast(int, v), CTRL, 0xf, 0xf, true)); }
__device__ __forceinline__ float wave_sum_fast(float v) {
    v += dpp_f<0xB1>(v); v += dpp_f<0x4E>(v); v += dpp_f<0x141>(v); v += dpp_f<0x140>(v);
    { auto r = __builtin_amdgcn_permlane16_swap(__float_as_uint(v), __float_as_uint(v), false, false); v = __uint_as_float(r[0]) + __uint_as_float(r[1]); }
    { auto r = __builtin_amdgcn_permlane32_swap(__float_as_uint(v), __float_as_uint(v), false, false); v = __uint_as_float(r[0]) + __uint_as_float(r[1]); }
    return v;
}
__device__ __forceinline__ float wave_max_fast(float v) {
    v = fmaxf(v, dpp_f<0xB1>(v)); v = fmaxf(v, dpp_f<0x4E>(v)); v = fmaxf(v, dpp_f<0x141>(v)); v = fmaxf(v, dpp_f<0x140>(v));
    { auto r = __builtin_amdgcn_permlane16_swap(__float_as_uint(v), __float_as_uint(v), false, false); v = fmaxf(__uint_as_float(r[0]), __uint_as_float(r[1])); }
    { auto r = __builtin_amdgcn_permlane32_swap(__float_as_uint(v), __float_as_uint(v), false, false); v = fmaxf(__uint_as_float(r[0]), __uint_as_float(r[1])); }
    return v;
}
__device__ __forceinline__ float sigmoid_f(float x) { return 1.f / (1.f + __expf(-x)); }
__device__ __forceinline__ float gelu_tanh_f(float x) {
    const float t = 0.7978845608028654f * (x + 0.044715f * x * x * x);
    const float e = __expf(2.f * t);
    const float th = 1.f - 2.f / (e + 1.f);
    return 0.5f * x * (1.f + th);
}

__device__ __forceinline__ unsigned cvt_pk_bf16(float lo, float hi) { unsigned r; asm volatile("v_cvt_pk_bf16_f32 %0, %1, %2" : "=v"(r) : "v"(lo), "v"(hi)); return r; }

template <int MODE> struct EpiRowScale {
    static constexpr bool PERM = true, AFTER_DRAIN = false;
    bf16* O; int ldc; const float* rs;
    __device__ __forceinline__ void operator()(const pg8::f32x4 (&acc)[2][2][4][2], const pg8::Unit& u, int wr, int wc, int fr, int fq) const {
        const int row0 = u.pm * 256 + wr * 64 + fr, col0 = u.pn * 256 + wc * 32 + 8 * fq;
#pragma unroll
        for (int ai = 0; ai < 2; ++ai)
#pragma unroll
            for (int m = 0; m < 4; ++m) {
                const int row = row0 + ai * 128 + m * 16;
                float s;
                if (MODE == 0) s = rs[row];
                else { const f32x4* p = (const f32x4*)(rs + (size_t)row * 16); const f32x4 a = p[0], b = p[1], c = p[2], d = p[3];
                       const float t = ((a.x + a.y) + (a.z + a.w)) + ((b.x + b.y) + (b.z + b.w)) + ((c.x + c.y) + (c.z + c.w)) + ((d.x + d.y) + (d.z + d.w));
                       s = rsqrtf(t * (1.f / 1024.f) + EPS); }
                bf16* rowp = O + (size_t)row * ldc + col0;
#pragma unroll
                for (int bj = 0; bj < 2; ++bj) { const pg8::f32x4 v0 = acc[ai][bj][m][0] * s, v1 = acc[ai][bj][m][1] * s;
                    u32x4 w; w.x = cvt_pk_bf16(v0[0], v0[1]); w.y = cvt_pk_bf16(v0[2], v0[3]); w.z = cvt_pk_bf16(v1[0], v1[1]); w.w = cvt_pk_bf16(v1[2], v1[3]);
                    *(u32x4*)(rowp + bj * 128) = w; }
            }
    }
};
struct EpiProj {
    static constexpr bool PERM = true, AFTER_DRAIN = false;
    bf16* O; const float* rs;
    __device__ __forceinline__ void operator()(const pg8::f32x4 (&acc)[2][2][4][2], const pg8::Unit& u, int wr, int wc, int fr, int fq) const {
        const int row0 = u.pm * 256 + wr * 64 + fr, cin = wc * 32 + 8 * fq, pn = u.pn;
#pragma unroll
        for (int ai = 0; ai < 2; ++ai)
#pragma unroll
            for (int m = 0; m < 4; ++m) {
                const int row = row0 + ai * 128 + m * 16; const float sc = rs[row];
                float a[8], b[8];
#pragma unroll
                for (int i = 0; i < 4; ++i) { a[i] = acc[ai][0][m][0][i] * sc; a[4 + i] = acc[ai][0][m][1][i] * sc; b[i] = acc[ai][1][m][0][i] * sc; b[4 + i] = acc[ai][1][m][1][i] * sc; }
                bf16* rowp = O + (size_t)row * PDIM;
                if (pn >= 4 && pn < 6) {
                    u32x4 w0, w1; w0.x = cvt_pk_bf16(a[0], a[1]); w0.y = cvt_pk_bf16(a[2], a[3]); w0.z = cvt_pk_bf16(a[4], a[5]); w0.w = cvt_pk_bf16(a[6], a[7]);
                    w1.x = cvt_pk_bf16(b[0], b[1]); w1.y = cvt_pk_bf16(b[2], b[3]); w1.z = cvt_pk_bf16(b[4], b[5]); w1.w = cvt_pk_bf16(b[6], b[7]);
                    *(u32x4*)(rowp + 512 + 256 * (pn - 4) + cin) = w0; *(u32x4*)(rowp + 512 + 256 * (pn - 4) + 128 + cin) = w1;
                } else {
                    float o[8];
                    if (pn < 4) {
#pragma unroll
                        for (int i = 0; i < 8; ++i) o[i] = a[i] * b[i];
                    } else {
#pragma unroll
                        for (int i = 0; i < 8; ++i) o[i] = a[i] * sigmoid_f(b[i]);
                    }
                    u32x4 w; w.x = cvt_pk_bf16(o[0], o[1]); w.y = cvt_pk_bf16(o[2], o[3]); w.z = cvt_pk_bf16(o[4], o[5]); w.w = cvt_pk_bf16(o[6], o[7]);
                    *(u32x4*)(rowp + (pn < 4 ? 128 * pn : 1024 + 128 * (pn - 6)) + cin) = w;
                }
            }
    }
};
struct EpiProjI8 {
    static constexpr bool PERM = true, AFTER_DRAIN = false;
    bf16* O; const float* rs; const float* sw;
    __device__ __forceinline__ void operator()(const pg8::i32x4 (&acc)[2][2][4][2], const pg8::Unit& u, int wr, int wc, int fr, int fq) const {
        const int row0 = u.pm * 256 + wr * 64 + fr, cin = wc * 32 + 8 * fq, pn = u.pn;
        float swa[8], swb[8];
        { const f32x4 a0 = *(const f32x4*)(sw + 256 * pn + cin), a1 = *(const f32x4*)(sw + 256 * pn + cin + 4), b0 = *(const f32x4*)(sw + 256 * pn + 128 + cin), b1 = *(const f32x4*)(sw + 256 * pn + 128 + cin + 4);
          swa[0] = a0.x; swa[1] = a0.y; swa[2] = a0.z; swa[3] = a0.w; swa[4] = a1.x; swa[5] = a1.y; swa[6] = a1.z; swa[7] = a1.w;
          swb[0] = b0.x; swb[1] = b0.y; swb[2] = b0.z; swb[3] = b0.w; swb[4] = b1.x; swb[5] = b1.y; swb[6] = b1.z; swb[7] = b1.w; }
#pragma unroll
        for (int ai = 0; ai < 2; ++ai)
#pragma unroll
            for (int m = 0; m < 4; ++m) {
                const int row = row0 + ai * 128 + m * 16; const float sc = rs[row];
                float a[8], b[8];
#pragma unroll
                for (int i = 0; i < 4; ++i) { a[i] = (float)acc[ai][0][m][0][i] * (sc * swa[i]); a[4 + i] = (float)acc[ai][0][m][1][i] * (sc * swa[4 + i]);
                    b[i] = (float)acc[ai][1][m][0][i] * (sc * swb[i]); b[4 + i] = (float)acc[ai][1][m][1][i] * (sc * swb[4 + i]); }
                bf16* rowp = O + (size_t)row * PDIM;
                if (pn >= 4 && pn < 6) {
                    u32x4 w0, w1; w0.x = cvt_pk_bf16(a[0], a[1]); w0.y = cvt_pk_bf16(a[2], a[3]); w0.z = cvt_pk_bf16(a[4], a[5]); w0.w = cvt_pk_bf16(a[6], a[7]);
                    w1.x = cvt_pk_bf16(b[0], b[1]); w1.y = cvt_pk_bf16(b[2], b[3]); w1.z = cvt_pk_bf16(b[4], b[5]); w1.w = cvt_pk_bf16(b[6], b[7]);
                    *(u32x4*)(rowp + 512 + 256 * (pn - 4) + cin) = w0; *(u32x4*)(rowp + 512 + 256 * (pn - 4) + 128 + cin) = w1;
                } else {
                    float o[8];
                    if (pn < 4) {
#pragma unroll
                        for (int i = 0; i < 8; ++i) o[i] = a[i] * b[i];
                    } else {
#pragma unroll
                        for (int i = 0; i < 8; ++i) o[i] = a[i] * sigmoid_f(b[i]);
                    }
                    u32x4 w; w.x = cvt_pk_bf16(o[0], o[1]); w.y = cvt_pk_bf16(o[2], o[3]); w.z = cvt_pk_bf16(o[4], o[5]); w.w = cvt_pk_bf16(o[6], o[7]);
                    *(u32x4*)(rowp + (pn < 4 ? 128 * pn : 1024 + 128 * (pn - 6)) + cin) = w;
                }
            }
    }
};
__host__ __device__ __forceinline__ int win_src_col(int n) {
    const int t = n >> 8, j = n & 255;
    if (t < 4) return (j < 128) ? 128 * t + j : 1024 + 128 * t + (j - 128);
    if (t < 6) return 512 + 256 * (t - 4) + j;
    return (j < 128) ? 1536 + 128 * (t - 6) + j : 2048 + 128 * (t - 6) + (j - 128);
}
struct EpiResidual {
    static constexpr bool PERM = true, AFTER_DRAIN = false;
    bf16* O; const signed char* XB; const float* SX; float* ssq;
    __device__ __forceinline__ void operator()(const pg8::f32x4 (&acc)[2][2][4][2], const pg8::Unit& u, int wr, int wc, int fr, int fq) const {
        const int row0 = u.pm * 256 + wr * 64 + fr, col0 = u.pn * 256 + wc * 32 + 8 * fq;
#pragma unroll
        for (int ai = 0; ai < 2; ++ai)
#pragma unroll
            for (int m = 0; m < 4; ++m) {
                const int row = row0 + ai * 128 + m * 16;
                const signed char* xr = XB + (size_t)row * DM + col0; bf16* rowp = O + (size_t)row * DM + col0;
                float q = 0.f;
                u32x2 xw[2]; const float sxr = SX[row];
#pragma unroll
                for (int bj = 0; bj < 2; ++bj) xw[bj] = *(const u32x2*)(xr + bj * 128);
#pragma unroll
                for (int bj = 0; bj < 2; ++bj) {
                    const f32x4 x0 = (f32x4){(float)(signed char)(xw[bj].x), (float)(signed char)(xw[bj].x >> 8), (float)(signed char)(xw[bj].x >> 16), (float)((int)xw[bj].x >> 24)} * sxr,
                                x1 = (f32x4){(float)(signed char)(xw[bj].y), (float)(signed char)(xw[bj].y >> 8), (float)(signed char)(xw[bj].y >> 16), (float)((int)xw[bj].y >> 24)} * sxr;
                    const pg8::f32x4 v0 = acc[ai][bj][m][0] + x0, v1 = acc[ai][bj][m][1] + x1;
                    q += (v0[0] * v0[0] + v0[1] * v0[1]) + (v0[2] * v0[2] + v0[3] * v0[3]) + (v1[0] * v1[0] + v1[1] * v1[1]) + (v1[2] * v1[2] + v1[3] * v1[3]);
                    u32x4 w; w.x = cvt_pk_bf16(v0[0], v0[1]); w.y = cvt_pk_bf16(v0[2], v0[3]); w.z = cvt_pk_bf16(v1[0], v1[1]); w.w = cvt_pk_bf16(v1[2], v1[3]);
                    *(u32x4*)(rowp + bj * 128) = w; }
                q += __shfl_xor(q, 16); q += __shfl_xor(q, 32);
                if (fq == 0) ssq[(size_t)row * 16 + u.pn * 4 + wc] = q;
            }
    }
};

struct EpiResidualI8 {
    static constexpr bool PERM = true, AFTER_DRAIN = false;
    bf16* O; const signed char* XB; const float* SX; const float* SY; const float* SWO; float* ssq; float* amx;
    __device__ __forceinline__ void operator()(const pg8::i32x4 (&acc)[2][2][4][2], const pg8::Unit& u, int wr, int wc, int fr, int fq) const {
        const int row0 = u.pm * 256 + wr * 64 + fr, col0 = u.pn * 256 + wc * 32 + 8 * fq;
        f32x4 sw[2][2];
#pragma unroll
        for (int bj = 0; bj < 2; ++bj) { sw[bj][0] = *(const f32x4*)(SWO + col0 + bj * 128); sw[bj][1] = *(const f32x4*)(SWO + col0 + bj * 128 + 4); }
#pragma unroll
        for (int ai = 0; ai < 2; ++ai)
#pragma unroll
            for (int m = 0; m < 4; ++m) {
                const int row = row0 + ai * 128 + m * 16;
                const signed char* xr = XB + (size_t)row * DM + col0; bf16* rowp = O + (size_t)row * DM + col0;
                float q = 0.f, mxa = 0.f;
                u32x2 xw[2]; const float sxr = SX[row], syr = SY[row];
#pragma unroll
                for (int bj = 0; bj < 2; ++bj) xw[bj] = *(const u32x2*)(xr + bj * 128);
#pragma unroll
                for (int bj = 0; bj < 2; ++bj) {
                    const f32x4 x0 = (f32x4){(float)(signed char)(xw[bj].x), (float)(signed char)(xw[bj].x >> 8), (float)(signed char)(xw[bj].x >> 16), (float)((int)xw[bj].x >> 24)} * sxr,
                                x1 = (f32x4){(float)(signed char)(xw[bj].y), (float)(signed char)(xw[bj].y >> 8), (float)(signed char)(xw[bj].y >> 16), (float)((int)xw[bj].y >> 24)} * sxr;
                    const pg8::i32x4 a0 = acc[ai][bj][m][0], a1 = acc[ai][bj][m][1];
                    const f32x4 v0 = (f32x4){(float)a0[0], (float)a0[1], (float)a0[2], (float)a0[3]} * (sw[bj][0] * syr) + x0, v1 = (f32x4){(float)a1[0], (float)a1[1], (float)a1[2], (float)a1[3]} * (sw[bj][1] * syr) + x1;
                    q += (v0[0] * v0[0] + v0[1] * v0[1]) + (v0[2] * v0[2] + v0[3] * v0[3]) + (v1[0] * v1[0] + v1[1] * v1[1]) + (v1[2] * v1[2] + v1[3] * v1[3]);
                    mxa = fmaxf(mxa, fmaxf(fmaxf(fmaxf(fabsf(v0[0]), fabsf(v0[1])), fmaxf(fabsf(v0[2]), fabsf(v0[3]))), fmaxf(fmaxf(fabsf(v1[0]), fabsf(v1[1])), fmaxf(fabsf(v1[2]), fabsf(v1[3])))));
                    u32x4 w; w.x = cvt_pk_bf16(v0[0], v0[1]); w.y = cvt_pk_bf16(v0[2], v0[3]); w.z = cvt_pk_bf16(v1[0], v1[1]); w.w = cvt_pk_bf16(v1[2], v1[3]);
                    *(u32x4*)(rowp + bj * 128) = w; }
                q += __shfl_xor(q, 16); q += __shfl_xor(q, 32);
                mxa = fmaxf(mxa, __shfl_xor(mxa, 16)); mxa = fmaxf(mxa, __shfl_xor(mxa, 32));
                if (fq == 0) { ssq[(size_t)row * 16 + u.pn * 4 + wc] = q; amx[(size_t)row * 16 + u.pn * 4 + wc] = mxa; }
            }
    }
};
template <bool MAPIN> __device__ __forceinline__ void p0_transpose_item(const float* W, int K, int N, bf16* WT, LAS float* scr, int item, int lane,
                                                  const float* g_lo, const float* g_hi, int split) {
    const int nblk = N / 32, kb = item / nblk, nb = item % nblk, k0 = 64 * kb, n0 = 32 * nb;
#pragma unroll 8
    for (int i = 0; i < 32; ++i) { const int kk = 2 * i + (lane >> 5); const int k = k0 + kk;
        const float g = (k < split) ? g_lo[k] : g_hi[k - split];
        scr[kk * 33 + (lane & 31)] = W[(size_t)k * N + (MAPIN ? win_src_col(n0) : n0) + (lane & 31)] * g; }
    asm volatile("s_waitcnt lgkmcnt(0)" ::: "memory");
    const int c = lane & 7;
#pragma unroll
    for (int j = 0; j < 4; ++j) { const int n = (lane >> 3) + 8 * j; const LAS float* s = scr + (8 * c) * 33 + n;
        u32x4 o; o.x = pk2(s[0 * 33], s[1 * 33]); o.y = pk2(s[2 * 33], s[3 * 33]); o.z = pk2(s[4 * 33], s[5 * 33]); o.w = pk2(s[6 * 33], s[7 * 33]);
        *(u32x4*)(WT + (size_t)(n0 + n) * K + k0 + 8 * c) = o; }
    asm volatile("s_waitcnt lgkmcnt(0)" ::: "memory");
}

constexpr int CW_COLMAX = 5120;
__device__ __forceinline__ void p0_colmax_item(const float* W, int N, unsigned* colmax, int item, int lane, const float* g) {
    const int nblk = N / 32, kb = item / nblk, nb = item % nblk, k0 = 64 * kb, n0 = 32 * nb;
    float mx = 0.f;
#pragma unroll
    for (int i = 0; i < 32; ++i) { const int k = k0 + 2 * i + (lane >> 5); mx = fmaxf(mx, fabsf(W[(size_t)k * N + n0 + (lane & 31)] * g[k])); }
    mx = fmaxf(mx, __shfl_xor(mx, 32));
    if (lane < 32) atomicMax(colmax + n0 + lane, __float_as_uint(mx));
}
__device__ __forceinline__ void p1_quant_item(const float* W, int K, int N, signed char* WT8, float* swout, const unsigned* colmax, LAS float* scr, int item, int lane, const float* g) {
    const int nblk = N / 32, kb = item / nblk, nb = item % nblk, k0 = 64 * kb, n0 = 32 * nb, s0 = win_src_col(n0);
    const float cm = fmaxf(__uint_as_float(__hip_atomic_load((unsigned*)colmax + s0 + (lane & 31), __ATOMIC_RELAXED, __HIP_MEMORY_SCOPE_AGENT)), 1e-30f), inv = 127.f / cm;
    if (kb == 0 && lane < 32) swout[n0 + lane] = cm * (1.f / 127.f);
#pragma unroll
    for (int i = 0; i < 32; ++i) { const int kk = 2 * i + (lane >> 5); const int k = k0 + kk;
        scr[kk * 33 + (lane & 31)] = W[(size_t)k * N + s0 + (lane & 31)] * g[k] * inv; }
    asm volatile("s_waitcnt lgkmcnt(0)" ::: "memory");
    const int c = lane & 7;
#pragma unroll
    for (int j = 0; j < 4; ++j) { const int n = (lane >> 3) + 8 * j; const LAS float* sp = scr + (8 * c) * 33 + n;
        unsigned w0 = 0u, w1 = 0u;
#pragma unroll
        for (int i = 0; i < 4; ++i) { w0 |= ((unsigned)(int)rintf(sp[i * 33]) & 255u) << (8 * i); w1 |= ((unsigned)(int)rintf(sp[(4 + i) * 33]) & 255u) << (8 * i); }
        u32x2 o; o.x = w0; o.y = w1;
        *(u32x2*)(WT8 + (size_t)(n0 + n) * K + k0 + 8 * c) = o; }
    asm volatile("s_waitcnt lgkmcnt(0)" ::: "memory");
}
constexpr int CW_WCNT = 10752;
constexpr size_t WS_METARAW = 65536;
constexpr int CW_COLMAX3 = 8704;
constexpr int CW_COLMAX2 = 7680;
__device__ __forceinline__ void p0_colmax_item2(const float* W, int N, unsigned* colmax, int item, int lane, const float* g_lo, const float* g_hi, int split) {
    const int nblk = N / 32, kb = item / nblk, nb = item % nblk, k0 = 64 * kb, n0 = 32 * nb;
    float mx = 0.f;
#pragma unroll
    for (int i = 0; i < 32; ++i) { const int k = k0 + 2 * i + (lane >> 5); const float g = (k < split) ? g_lo[k] : g_hi[k - split]; mx = fmaxf(mx, fabsf(W[(size_t)k * N + n0 + (lane & 31)] * g)); }
    mx = fmaxf(mx, __shfl_xor(mx, 32));
    if (lane < 32) atomicMax(colmax + n0 + lane, __float_as_uint(mx));
}
__device__ __forceinline__ void p1_quant_item2(const float* W, int K, int N, signed char* WT8, float* swout, const unsigned* colmax, LAS float* scr, int item, int lane, const float* g_lo, const float* g_hi, int split) {
    const int nblk = N / 32, kb = item / nblk, nb = item % nblk, k0 = 64 * kb, n0 = 32 * nb;
    const float cm = fmaxf(__uint_as_float(__hip_atomic_load((unsigned*)colmax + n0 + (lane & 31), __ATOMIC_RELAXED, __HIP_MEMORY_SCOPE_AGENT)), 1e-30f), inv = 127.f / cm;
    if (kb == 0 && lane < 32) swout[n0 + lane] = cm * (1.f / 127.f);
#pragma unroll
    for (int i = 0; i < 32; ++i) { const int kk = 2 * i + (lane >> 5); const int k = k0 + kk; const float g = (k < split) ? g_lo[k] : g_hi[k - split];
        scr[kk * 33 + (lane & 31)] = W[(size_t)k * N + n0 + (lane & 31)] * g * inv; }
    asm volatile("s_waitcnt lgkmcnt(0)" ::: "memory");
    const int c = lane & 7;
#pragma unroll
    for (int j = 0; j < 4; ++j) { const int n = (lane >> 3) + 8 * j; const LAS float* sp = scr + (8 * c) * 33 + n;
        unsigned w0 = 0u, w1 = 0u;
#pragma unroll
        for (int i = 0; i < 4; ++i) { w0 |= ((unsigned)(int)rintf(sp[i * 33]) & 255u) << (8 * i); w1 |= ((unsigned)(int)rintf(sp[(4 + i) * 33]) & 255u) << (8 * i); }
        u32x2 o; o.x = w0; o.y = w1;
        *(u32x2*)(WT8 + (size_t)(n0 + n) * K + k0 + 8 * c) = o; }
    asm volatile("s_waitcnt lgkmcnt(0)" ::: "memory");
}
__device__ __forceinline__ float q4(float x, float inv_s) {
    const float a = fabsf(x) * inv_s; float r;
    if (a < 2.f) r = rintf(a * 2.f) * 0.5f; else if (a < 4.f) r = rintf(a); else r = fminf(6.f, rintf(a * 0.5f) * 2.f);
    return copysignf(r, x);
}
__device__ __forceinline__ void phase_prep(const Params& P, LAS unsigned char* lds) {
    const int tid = threadIdx.x, lane = tid & 63, wave = __builtin_amdgcn_readfirstlane(tid >> 6);
    const int gw = blockIdx.x * NWAVES + wave, NGW = gridDim.x * NWAVES;
    unsigned char* ws = P.ws;
    LAS float* scr = (LAS float*)(lds + wave * 16384);
    constexpr int I_IN = (DM / 64) * (DIN / 32), I_OUT = (DM / 64) * (DM / 32), I_Q = (DM / 64) * (2048 / 32);
    for (int it = gw; it < I_IN + I_OUT + I_Q; it += NGW) {
        int r = it;
        int grp;
        if (r < I_IN) { p0_colmax_item(P.w_in, DIN, (unsigned*)(ws + WS_CTL) + CW_COLMAX, r, lane, P.g_mix); grp = r % (DIN / 32); }
        else if (r < I_IN + I_OUT) { r -= I_IN; p0_colmax_item2(P.w_out, DM, (unsigned*)(ws + WS_CTL) + CW_COLMAX2, r, lane, P.g_sc, P.g_cf, 512); grp = 80 + r % (DM / 32); }
        else { r -= I_IN + I_OUT; p0_colmax_item2(P.w_q, 2048, (unsigned*)(ws + WS_CTL) + CW_COLMAX3, r, lane, P.g_ffn, P.g_ffn, DM); grp = 112 + r % (2048 / 32); }
        asm volatile("s_waitcnt vmcnt(0)" ::: "memory");
        if (lane == 0) (void)__hip_atomic_fetch_add((unsigned*)(ws + WS_CTL) + CW_WCNT + grp, 1u, __ATOMIC_RELAXED, __HIP_MEMORY_SCOPE_AGENT);
    }
    {
        unsigned* H0I8 = (unsigned*)(ws + WS_H0I8); float* RS1 = (float*)(ws + WS_RSTD1); float* SXp = (float*)(ws + WS_SX);
        for (int t0 = gw * 4; t0 < NTOK; t0 += NGW * 4) {
            f32x4 v[4][4];
#pragma unroll
            for (int q = 0; q < 4; ++q) { const f32x4* xr = (const f32x4*)(P.x + (size_t)(t0 + q) * DM) + lane;
#pragma unroll
                for (int j = 0; j < 4; ++j) v[q][j] = xr[64 * j]; }
#pragma unroll
            for (int q = 0; q < 4; ++q) { float sq = 0.f, mx = 0.f;
#pragma unroll
                for (int j = 0; j < 4; ++j) { sq += (v[q][j].x * v[q][j].x + v[q][j].y * v[q][j].y) + (v[q][j].z * v[q][j].z + v[q][j].w * v[q][j].w);
                    mx = fmaxf(mx, fmaxf(fmaxf(fabsf(v[q][j].x), fabsf(v[q][j].y)), fmaxf(fabsf(v[q][j].z), fabsf(v[q][j].w)))); }
                sq = wave_sum_fast(sq); mx = fmaxf(wave_max_fast(mx), 1e-30f);
                const float sx = mx * (1.f / 127.f), inv = 127.f / mx;
                if (lane == 0) { RS1[t0 + q] = sx * rsqrtf(sq * (1.f / DM) + EPS); SXp[t0 + q] = sx; }
                unsigned* o = H0I8 + (size_t)(t0 + q) * (DM / 4) + lane;
#pragma unroll
                for (int j = 0; j < 4; ++j) { const int a = (int)rintf(v[q][j].x * inv), b = (int)rintf(v[q][j].y * inv), c = (int)rintf(v[q][j].z * inv), d = (int)rintf(v[q][j].w * inv);
                    o[64 * j] = ((unsigned)a & 255u) | (((unsigned)b & 255u) << 8) | (((unsigned)c & 255u) << 16) | ((unsigned)d << 24); } }
        }
    }
    {
        unsigned char* U8 = ws + WS_U8; unsigned char* V8 = ws + WS_V8;
        f32x4 gf[4];
#pragma unroll
        for (int j = 0; j < 4; ++j) gf[j] = ((const f32x4*)P.g_ffn)[64 * j + lane];
        float* ESC = (float*)(ws + WS_ESCALE);
        for (int e0 = gw * 2; e0 < 2 * 16384; e0 += NGW * 2) {
            const bool isv = e0 >= 16384; const int ee0 = isv ? e0 - 16384 : e0;
            f32x4 v[2][4];
#pragma unroll
            for (int q = 0; q < 2; ++q) { const f32x4* src = (const f32x4*)((isv ? P.pv : P.pu) + (size_t)(ee0 + q) * DM);
#pragma unroll
                for (int j = 0; j < 4; ++j) v[q][j] = isv ? src[4 * lane + j] : src[64 * j + lane]; }
#pragma unroll
            for (int q = 0; q < 2; ++q) {
                float mx = 0.f;
#pragma unroll
                for (int j = 0; j < 4; ++j) { if (!isv) v[q][j] = v[q][j] * gf[j];
                    mx = fmaxf(mx, fmaxf(fmaxf(fabsf(v[q][j].x), fabsf(v[q][j].y)), fmaxf(fabsf(v[q][j].z), fabsf(v[q][j].w)))); }
#pragma unroll
                for (int o = 1; o < 64; o <<= 1) mx = fmaxf(mx, __shfl_xor(mx, o));
                if (!isv) {
                    float sq2 = 0.f;
#pragma unroll
                    for (int j = 0; j < 4; ++j) sq2 += (v[q][j].x * v[q][j].x + v[q][j].y * v[q][j].y) + (v[q][j].z * v[q][j].z + v[q][j].w * v[q][j].w);
                    const float rms = sqrtf(wave_sum_fast(sq2) * (1.f / DM));
                    const float su = fmaxf(fminf(mx, U4_CLIP * rms), 1e-30f) * (1.f / 7.f), inv = 1.f / su;
                    unsigned wq[2] = {0u, 0u}; int csum = 0;
#pragma unroll
                    for (int j = 0; j < 4; ++j) { const float e4[4] = {v[q][j].x, v[q][j].y, v[q][j].z, v[q][j].w};
#pragma unroll
                        for (int i = 0; i < 4; ++i) { int c = (int)rintf(fminf(fmaxf(e4[i] * inv, -7.f), 7.f)); csum += c;
                            wq[j >> 1] |= ((unsigned)c & 15u) << (16 * (j & 1) + 4 * i); } }
                    const float cs = wave_sum_fast((float)csum);
                    if (lane == 0) { ESC[e0 + q] = su; ((float*)(ws + WS_SUMQ))[e0 + q] = cs; }
                    u32x2 o; o.x = wq[0]; o.y = wq[1];
                    *(u32x2*)(U8 + (size_t)(ee0 + q) * 512 + 8 * lane) = o;
                    continue;
                }
                const float sc = fmaxf(mx, 1e-30f) * (1.f / 6.f), inv = 1.f / sc;
                if (lane == 0) ESC[e0 + q] = sc;
                unsigned w0 = 0u, w1 = 0u;
                w0 = __builtin_amdgcn_cvt_scalef32_pk_fp4_f32(w0, v[q][0].x * inv, v[q][0].y * inv, 1.0f, 0); w0 = __builtin_amdgcn_cvt_scalef32_pk_fp4_f32(w0, v[q][0].z * inv, v[q][0].w * inv, 1.0f, 1);
                w0 = __builtin_amdgcn_cvt_scalef32_pk_fp4_f32(w0, v[q][1].x * inv, v[q][1].y * inv, 1.0f, 2); w0 = __builtin_amdgcn_cvt_scalef32_pk_fp4_f32(w0, v[q][1].z * inv, v[q][1].w * inv, 1.0f, 3);
                w1 = __builtin_amdgcn_cvt_scalef32_pk_fp4_f32(w1, v[q][2].x * inv, v[q][2].y * inv, 1.0f, 0); w1 = __builtin_amdgcn_cvt_scalef32_pk_fp4_f32(w1, v[q][2].z * inv, v[q][2].w * inv, 1.0f, 1);
                w1 = __builtin_amdgcn_cvt_scalef32_pk_fp4_f32(w1, v[q][3].x * inv, v[q][3].y * inv, 1.0f, 2); w1 = __builtin_amdgcn_cvt_scalef32_pk_fp4_f32(w1, v[q][3].z * inv, v[q][3].w * inv, 1.0f, 3);
                u32x2 o; o.x = w0; o.y = w1;
                *(u32x2*)((isv ? V8 : U8) + (size_t)(ee0 + q) * 512 + 8 * lane) = o;
            }
        }
    }
    {
        bf16* KB = (bf16*)(ws + WS_KEYS);
        const int gt = blockIdx.x * NTHREADS + tid, NGT = gridDim.x * NTHREADS;
        for (int i = gt; i < 8 * 2 * 128 * 128 / 4; i += NGT) { const f32x4 v = ((const f32x4*)P.keys)[i]; u32x2 w; w.x = pk2(v.x, v.y); w.y = pk2(v.z, v.w); ((u32x2*)KB)[i] = w; }
    }
    {
        float* MP = (float*)(ws + WS_CTL + WS_METARAW); float* MR = (float*)(ws + WS_METARSTD);
        for (int r = gw; r < NMETA; r += NGW) {
            float s = 0.f;
            for (int k = lane; k < DM; k += 64) { const float v = P.meta[r * DM + k]; s += v * v; }
            s = wave_sum(s);
            if (lane == 0) MR[r] = rsqrtf(s * (1.f / DM) + EPS);
        }
        for (int it = gw; it < MKC * 40; it += NGW) {
            const int kc = it / 40, nb = it % 40, n = nb * 64 + lane;
            float acc[NMETA];
#pragma unroll
            for (int r = 0; r < NMETA; ++r) acc[r] = 0.f;
            for (int k = kc * (DM / MKC); k < (kc + 1) * (DM / MKC); ++k) {
                const float w = P.w_in[(size_t)k * DIN + n] * P.g_mix[k];
#pragma unroll
                for (int r = 0; r < NMETA; ++r) acc[r] += P.meta[r * DM + k] * w;
            }
#pragma unroll
            for (int r = 0; r < NMETA; ++r) (void)__hip_atomic_fetch_add(MP + (size_t)r * DIN + n, acc[r], __ATOMIC_RELAXED, __HIP_MEMORY_SCOPE_AGENT);
        }
    }
    {
        constexpr int NI1 = (DM / 64) * (DIN / 32), NI2 = (DM / 64) * (DM / 32), NI3 = (DM / 64) * (2048 / 32);
        unsigned* cnt = (unsigned*)(ws + WS_CTL) + CW_WCNT;
        for (int it = gw; it < NI1 + NI2 + NI3; it += NGW) {
            int grp;
            if (it < NI1) grp = win_src_col(32 * (it % (DIN / 32))) / 32; else if (it < NI1 + NI2) grp = 80 + (it - NI1) % (DM / 32); else grp = 112 + (it - NI1 - NI2) % (2048 / 32);
            { unsigned sp = 0; while (__hip_atomic_load(cnt + grp, __ATOMIC_RELAXED, __HIP_MEMORY_SCOPE_AGENT) < 16u) { __builtin_amdgcn_s_sleep(2); if (++sp > (1u << 20)) break; } }
            if (it < NI1) p1_quant_item(P.w_in, DM, DIN, (signed char*)(ws + WS_WIN_T), (float*)(ws + WS_SW), (const unsigned*)(ws + WS_CTL) + CW_COLMAX, scr, it, lane, P.g_mix);
            else if (it < NI1 + NI2) p1_quant_item2(P.w_out, DM, DM, (signed char*)(ws + WS_WOUT_T), (float*)(ws + WS_SWO), (const unsigned*)(ws + WS_CTL) + CW_COLMAX2, scr, it - NI1, lane, P.g_sc, P.g_cf, 512);
            else p1_quant_item2(P.w_q, DM, 2048, (signed char*)(ws + WS_WQ_T), (float*)(ws + WS_SWQ), (const unsigned*)(ws + WS_CTL) + CW_COLMAX3, scr, it - NI1 - NI2, lane, P.g_ffn, P.g_ffn, DM);
        }
    }
}

__device__ __forceinline__ float metaval(const float* RAW, const float* MR, int p, int c) {
    const float r = MR[p]; const float* rp = RAW + (size_t)p * DIN;
    if (c < 512) return (rp[c] * r) * (rp[1024 + c] * r);
    if (c < 1024) return rp[c] * r;
    return (rp[1536 + (c - 1024)] * r) * sigmoid_f(rp[2048 + (c - 1024)] * r);
}
__device__ __forceinline__ float meta_val(const float* MJ, const float*, int p, int col) { return MJ[p * PDIM + col]; }
__device__ __forceinline__ float proj_at(const bf16* PROJ, const float* MP, const float* MR, int b, int pos, int col) {
    if (pos < 0) return 0.f;
    if (pos < NMETA) return meta_val(MP, MR, pos, col);
    return bf2f(PROJ[(size_t)(b * SEQ + pos - NMETA) * PDIM + col]);
}
__device__ __forceinline__ void proj8_at(const bf16* PROJ, const float* MP, const float* MR, int b, int pos, int col, float (&v)[8]) {
    if (pos < 0) {
#pragma unroll
        for (int i = 0; i < 8; ++i) v[i] = 0.f;
    } else if (pos < NMETA) {
#pragma unroll
        for (int i = 0; i < 8; ++i) v[i] = metaval(MP, MR, pos, col + i);
    } else {
        const u32x4 w = *(const u32x4*)(PROJ + (size_t)(b * SEQ + pos - NMETA) * PDIM + col);
        v[0] = bflo(w.x); v[1] = bfhi(w.x); v[2] = bflo(w.y); v[3] = bfhi(w.y); v[4] = bflo(w.z); v[5] = bfhi(w.z); v[6] = bflo(w.w); v[7] = bfhi(w.w);
    }
}

template <int R> __device__ __forceinline__ void conv_rows(const LAS unsigned char* ubase, const f32x2 (&wcf)[31], f32x2 (&acc)[32]) {
    if constexpr (R < 62) {
        const unsigned uw = *(const LAS unsigned*)(ubase + R * 1024);
        const f32x2 x = (f32x2){bflo(uw), bfhi(uw)};
        constexpr int lo = R > 30 ? R - 30 : 0, hi = R < 31 ? R : 31;
#pragma unroll
        for (int ii = lo; ii <= hi; ++ii) acc[ii] += wcf[R - ii] * x;
        conv_rows<R + 1>(ubase, wcf, acc);
    }
}
__device__ __forceinline__ void phase_conv(const Params& P, LAS unsigned char* lds) {
    const int tid = threadIdx.x, lane = tid & 63, wave = __builtin_amdgcn_readfirstlane(tid >> 6);
    unsigned char* ws = P.ws;
    const bf16* PROJ = (const bf16*)(ws + WS_PROJ); const float* MP = (const float*)(ws + WS_CTL + WS_METARAW); const float* MR = (const float*)(ws + WS_METARSTD);
    bf16* Y = (bf16*)(ws + WS_Y);
    constexpr int TT = 64, NTILE = NTOK / TT, UROWS = TT + 30;
    const int cgp = wave & 3, th = wave >> 2, ch2 = cgp * 128 + 2 * lane;
    f32x2 wcf[31];
#pragma unroll
    for (int j = 0; j < 31; ++j) wcf[j] = *(const f32x2*)(P.cf_w + j * 512 + ch2);
    const f32x2 bcf = *(const f32x2*)(P.cf_b + ch2);
    for (int tile = blockIdx.x; tile < NTILE; tile += gridDim.x) {
        const int b = tile / (SEQ / TT), s0 = (tile % (SEQ / TT)) * TT;
        if (s0 >= 30) {
            const bf16* pr = PROJ + ((size_t)b * SEQ + s0 - 30) * PDIM + 1024 + 8 * lane;
            u32x4 rw[(UROWS + 7) / 8];
#pragma unroll
            for (int p = 0; p < (UROWS + 7) / 8; ++p) { const int r = p * 8 + wave; rw[p] = *(const u32x4*)(pr + (size_t)(r < UROWS ? r : UROWS - 1) * PDIM); }
#pragma unroll
            for (int p = 0; p < (UROWS + 7) / 8; ++p) { const int r = p * 8 + wave; if (r < UROWS) *(LAS u32x4*)(lds + r * 1024 + lane * 16) = rw[p]; }
        } else {
#pragma unroll 4
        for (int p = 0; p < (UROWS + 7) / 8; ++p) {
            const int r = p * 8 + wave;
            if (r < UROWS) {
                const int pos = NMETA + s0 - 30 + r;
                float uu[8];
                proj8_at(PROJ, MP, MR, b, pos, 1024 + 8 * lane, uu);
                u32x4 w; w.x = pk2(uu[0], uu[1]); w.y = pk2(uu[2], uu[3]); w.z = pk2(uu[4], uu[5]); w.w = pk2(uu[6], uu[7]);
                *(LAS u32x4*)(lds + r * 1024 + lane * 16) = w;
            }
        }
        }
        __syncthreads();
        f32x2 acc[32];
#pragma unroll
        for (int ii = 0; ii < 32; ++ii) acc[ii] = bcf;
        conv_rows<0>(lds + (32 * th) * 1024 + ch2 * 2, wcf, acc);
        u32x4 rcx[8], rbg[8];
        { const bf16* pr = PROJ + ((size_t)b * SEQ + s0 + 8 * wave) * PDIM + 8 * lane;
#pragma unroll
          for (int q = 0; q < 8; ++q) { rcx[q] = *(const u32x4*)(pr + (size_t)q * PDIM); rbg[q] = *(const u32x4*)(pr + (size_t)q * PDIM + 512); } }
        __syncthreads();
#pragma unroll
        for (int ii = 0; ii < 32; ++ii) *(LAS f32x2*)(lds + (32 * th + ii) * 2048 + ch2 * 4) = acc[ii];
        __syncthreads();
        {
            float lng[8], lnb[8];
            { const f32x4 a = *(const f32x4*)(P.ln_g + 8 * lane), c = *(const f32x4*)(P.ln_g + 8 * lane + 4), d = *(const f32x4*)(P.ln_b + 8 * lane), e = *(const f32x4*)(P.ln_b + 8 * lane + 4);
              lng[0] = a.x; lng[1] = a.y; lng[2] = a.z; lng[3] = a.w; lng[4] = c.x; lng[5] = c.y; lng[6] = c.z; lng[7] = c.w;
              lnb[0] = d.x; lnb[1] = d.y; lnb[2] = d.z; lnb[3] = d.w; lnb[4] = e.x; lnb[5] = e.y; lnb[6] = e.z; lnb[7] = e.w; }
            float wsc[3][8];
#pragma unroll
            for (int j = 0; j < 3; ++j) { const f32x4 a = *(const f32x4*)(P.sc_w + j * 512 + 8 * lane), c = *(const f32x4*)(P.sc_w + j * 512 + 8 * lane + 4);
                wsc[j][0] = a.x; wsc[j][1] = a.y; wsc[j][2] = a.z; wsc[j][3] = a.w; wsc[j][4] = c.x; wsc[j][5] = c.y; wsc[j][6] = c.z; wsc[j][7] = c.w; }
            float cxa[8], cxb[8];
            { const int pos = NMETA + s0 + 8 * wave - 2;
              proj8_at(PROJ, MP, MR, b, pos, 8 * lane, cxa); proj8_at(PROJ, MP, MR, b, pos + 1, 8 * lane, cxb); }
#pragma unroll
            for (int q = 0; q < 8; ++q) {
                const int ii = 8 * wave + q, s = s0 + ii; const size_t t = (size_t)b * SEQ + s;
                float o[8];
                { const f32x4 a = *(const LAS f32x4*)(lds + ii * 2048 + lane * 32), c = *(const LAS f32x4*)(lds + ii * 2048 + lane * 32 + 16);
                  o[0] = a.x; o[1] = a.y; o[2] = a.z; o[3] = a.w; o[4] = c.x; o[5] = c.y; o[6] = c.z; o[7] = c.w; }
                float s1 = 0.f;
#pragma unroll
                for (int i = 0; i < 8; ++i) s1 += o[i];
                const float mean = wave_sum_fast(s1) * (1.f / 512.f);
                float s2 = 0.f;
#pragma unroll
                for (int i = 0; i < 8; ++i) { o[i] -= mean; s2 += o[i] * o[i]; }
                const float rs = rsqrtf(wave_sum_fast(s2) * (1.f / 512.f) + EPS);
                float s3 = 0.f;
#pragma unroll
                for (int i = 0; i < 8; ++i) { float y = o[i] * rs * lng[i] + lnb[i]; y = y * sigmoid_f(y); o[i] = y; s3 += y * y; }
                const float r2 = rsqrtf(wave_sum_fast(s3) * (1.f / 512.f) + EPS);
                float bgv[8], cxc[8], accs[8];
                { const u32x4 w = rcx[q], z = rbg[q];
                  cxc[0] = bflo(w.x); cxc[1] = bfhi(w.x); cxc[2] = bflo(w.y); cxc[3] = bfhi(w.y); cxc[4] = bflo(w.z); cxc[5] = bfhi(w.z); cxc[6] = bflo(w.w); cxc[7] = bfhi(w.w);
                  bgv[0] = bflo(z.x); bgv[1] = bfhi(z.x); bgv[2] = bflo(z.y); bgv[3] = bfhi(z.y); bgv[4] = bflo(z.z); bgv[5] = bfhi(z.z); bgv[6] = bflo(z.w); bgv[7] = bfhi(z.w); }
                float s4 = 0.f;
#pragma unroll
                for (int i = 0; i < 8; ++i) { accs[i] = bgv[i] * (wsc[0][i] * cxa[i] + wsc[1][i] * cxb[i] + wsc[2][i] * cxc[i]); s4 += accs[i] * accs[i]; cxa[i] = cxb[i]; cxb[i] = cxc[i]; }
                const float r4 = rsqrtf(wave_sum_fast(s4) * (1.f / 512.f) + EPS);
                float ym = 0.f;
#pragma unroll
                for (int i = 0; i < 8; ++i) { o[i] *= r2; accs[i] *= r4; ym = fmaxf(ym, fmaxf(fabsf(o[i]), fabsf(accs[i]))); }
                ym = fmaxf(wave_max_fast(ym), 1e-30f);
                const float yinv = 127.f / ym;
                if (lane == 0) ((float*)(ws + WS_SY))[t] = ym * (1.f / 127.f);
                u32x2 wz, wv;
                wz.x = ((unsigned)(int)rintf(accs[0] * yinv) & 255u) | (((unsigned)(int)rintf(accs[1] * yinv) & 255u) << 8) | (((unsigned)(int)rintf(accs[2] * yinv) & 255u) << 16) | ((unsigned)(int)rintf(accs[3] * yinv) << 24);
                wz.y = ((unsigned)(int)rintf(accs[4] * yinv) & 255u) | (((unsigned)(int)rintf(accs[5] * yinv) & 255u) << 8) | (((unsigned)(int)rintf(accs[6] * yinv) & 255u) << 16) | ((unsigned)(int)rintf(accs[7] * yinv) << 24);
                wv.x = ((unsigned)(int)rintf(o[0] * yinv) & 255u) | (((unsigned)(int)rintf(o[1] * yinv) & 255u) << 8) | (((unsigned)(int)rintf(o[2] * yinv) & 255u) << 16) | ((unsigned)(int)rintf(o[3] * yinv) << 24);
                wv.y = ((unsigned)(int)rintf(o[4] * yinv) & 255u) | (((unsigned)(int)rintf(o[5] * yinv) & 255u) << 8) | (((unsigned)(int)rintf(o[6] * yinv) & 255u) << 16) | ((unsigned)(int)rintf(o[7] * yinv) << 24);
                *(u32x2*)(ws + WS_Y + t * DM + 8 * lane) = wz;
                *(u32x2*)(ws + WS_Y + t * DM + 512 + 8 * lane) = wv;
            }
        }
        __syncthreads();
    }
}

__device__ __forceinline__ int ord_i(float s) { int k = __builtin_bit_cast(int, s); k ^= (k >> 31) & 0x7fffffff; return k; }
__device__ __forceinline__ float unord_f(int k) { k ^= (k >> 31) & 0x7fffffff; return __builtin_bit_cast(float, k); }
#define TOP_INSERT(L, x_) do { int _x = (x_); _Pragma("unroll") for (int _i = 0; _i < 16; ++_i) { const int _hi = max(L[_i], _x); _x = min(L[_i], _x); L[_i] = _hi; } } while (0)

typedef short bf16x8 __attribute__((ext_vector_type(8)));
typedef float f32x16 __attribute__((ext_vector_type(16)));
template <bool DESC> __device__ __forceinline__ void ce_i(int& a, int& b) { const int hi = max(a, b), lo = min(a, b); if (DESC) { a = hi; b = lo; } else { a = lo; b = hi; } }
__device__ __forceinline__ void bitonic_sort16(int (&a)[16]) {
#pragma unroll
    for (int k = 2; k <= 16; k <<= 1)
#pragma unroll
        for (int j = k >> 1; j > 0; j >>= 1)
#pragma unroll
            for (int i = 0; i < 16; ++i) { const int l = i ^ j; if (l > i) { if ((i & k) == 0) ce_i<true>(a[i], a[l]); else ce_i<false>(a[i], a[l]); } }
}
__device__ __forceinline__ void bitonic_merge16(int (&a)[16]) {
#pragma unroll
    for (int j = 8; j > 0; j >>= 1)
#pragma unroll
        for (int i = 0; i < 16; ++i) { const int l = i ^ j; if (l > i) ce_i<true>(a[i], a[l]); }
}
__device__ __forceinline__ void merge_top16(int (&a)[16], const int (&b)[16]) {
#pragma unroll
    for (int i = 0; i < 16; ++i) a[i] = max(a[i], b[15 - i]);
    bitonic_merge16(a);
}
__device__ __forceinline__ int lut16(const unsigned (&T)[4], int i) {
    const unsigned sel = (unsigned)(i & 7) | 0x0c0c0c00u;
    const unsigned lo = __builtin_amdgcn_perm(T[1], T[0], sel), hi = __builtin_amdgcn_perm(T[3], T[2], sel);
    return (int)((i & 8) ? hi : lo);
}
constexpr int KROW = 272;
constexpr float SCORE_BIAS = 8.0f;

__device__ __forceinline__ void route_load_q(bf16x8 (&qf)[8], const bf16* qrow, int hb) {
#pragma unroll
    for (int ks = 0; ks < 8; ++ks) qf[ks] = *(const bf16x8*)(qrow + 64 * hb + 8 * ks);
}
__device__ __forceinline__ void route_half(const LAS unsigned char* kl, const bf16x8 (&qf)[8], int nl, int hb, int (&L)[16]) {
    f32x16 acc[4];
#pragma unroll
    for (int nt = 0; nt < 4; ++nt)
#pragma unroll
        for (int r = 0; r < 16; ++r) acc[nt][r] = SCORE_BIAS;
#pragma unroll
    for (int ks = 0; ks < 8; ++ks)
#pragma unroll
        for (int nt = 0; nt < 4; ++nt) {
            const bf16x8 a = *(const LAS bf16x8*)(kl + (32 * nt + nl) * KROW + (64 * hb + 8 * ks) * 2);
            acc[nt] = __builtin_amdgcn_mfma_f32_32x32x16_bf16(a, qf[ks], acc[nt], 0, 0, 0);
        }
    const int hb4 = 4 * hb;
    int T[4][16];
#pragma unroll
    for (int nt = 0; nt < 4; ++nt)
#pragma unroll
        for (int r = 0; r < 16; ++r) { const int n0 = 32 * nt + (r & 3) + 8 * (r >> 2); const float sc = acc[nt][r];
            T[nt][r] = (__float_as_int(sc) & ~127) | ((127 - n0) - hb4); }
    bitonic_sort16(T[0]); bitonic_sort16(T[1]); bitonic_sort16(T[2]); bitonic_sort16(T[3]);
    merge_top16(T[0], T[1]); merge_top16(T[2], T[3]); merge_top16(T[0], T[2]);
#pragma unroll
    for (int i = 0; i < 16; ++i) { const unsigned v = (unsigned)T[0][15 - i]; auto r = __builtin_amdgcn_permlane32_swap(v, v, false, false);
        const unsigned r0 = r[0], r1 = r[1]; const int partner = (int)(hb ? r0 : r1); L[i] = max(T[0][i], partner); }
    bitonic_merge16(L);
}

__device__ __forceinline__ void phase_route(const Params& P, LAS unsigned char* lds) {
    const int tid = threadIdx.x, lane = tid & 63, wave = __builtin_amdgcn_readfirstlane(tid >> 6);
    const int nl = lane & 31, hb = lane >> 5;
    unsigned char* ws = P.ws;
    const bf16* KEYS = (const bf16*)(ws + WS_KEYS); const bf16* Q = (const bf16*)(ws + WS_Q);
    int* IDX = (int*)(ws + WS_IDX); float* GATE = (float*)(ws + WS_GATE);
    int last_h = -1;
    pg8::StaticOrder S; S.init(NTOK, 2048, (int)gridDim.x, (int)blockIdx.x);
    pg8::Unit ucur, unxt;
    bool have = S.next(0, ucur);
    bf16x8 qfA[8], qfB[8];
    if (have) route_load_q(qfA, Q + ((size_t)ucur.pm * 256 + wave * 32 + nl) * 2048 + ucur.pn * 256, hb);
    for (int ui = 0; have; ++ui) {
        const int h = ucur.pn, tb = ucur.pm;
        const bool have_next = S.next(ui + 1, unxt);
        if (h != last_h) {
            __syncthreads();
            for (int c = tid; c < 4096; c += NTHREADS) { const u32x4 v = ((const u32x4*)(KEYS + (size_t)h * 32768))[c];
                *(LAS u32x4*)(lds + (c >> 4) * KROW + (c & 15) * 16) = v; }
            __syncthreads();
            last_h = h;
        }
        const size_t t = (size_t)tb * 256 + wave * 32 + nl;
        int L1[16], L2[16];
        route_load_q(qfB, Q + t * 2048 + h * 256 + 128, hb);
        route_half(lds, qfA, nl, hb, L1);
        if (have_next) route_load_q(qfA, Q + ((size_t)unxt.pm * 256 + wave * 32 + nl) * 2048 + unxt.pn * 256, hb);
        route_half(lds + 128 * KROW, qfB, nl, hb, L2);
        float v1[16], v2[16];
#pragma unroll
        for (int i = 0; i < 16; ++i) { v1[i] = __int_as_float(L1[i] & ~127); v2[i] = __int_as_float(L2[i] & ~127); }
#define CAND(i, j) ((__float_as_int(v1[i] + v2[j]) & ~255) | (255 - (16 * (i) + (j))))
        int A[16], B[16], C[16];
#pragma unroll
        for (int j = 0; j < 16; ++j) A[j] = CAND(0, j);
#pragma unroll
        for (int j = 0; j < 8; ++j) { B[j] = CAND(1, j); B[8 + j] = CAND(15 - j, 0); }
        bitonic_merge16(B);
        C[0] = CAND(2, 0); C[1] = CAND(2, 1); C[2] = CAND(2, 2); C[3] = CAND(2, 3); C[4] = CAND(2, 4);
        C[5] = CAND(3, 0); C[6] = CAND(3, 1); C[7] = CAND(3, 2); C[8] = CAND(3, 3);
        C[9] = CAND(4, 0); C[10] = CAND(4, 1); C[11] = CAND(4, 2);
        C[12] = CAND(5, 0); C[13] = CAND(5, 1); C[14] = CAND(6, 0); C[15] = CAND(6, 1);
        bitonic_sort16(C);
        { const int d0 = CAND(7, 0), d1 = CAND(7, 1); C[14] = max(C[14], d1); C[15] = max(C[15], d0); bitonic_merge16(C); }
#undef CAND
        merge_top16(A, B); merge_top16(A, C);
        unsigned T1[4], T2[4];
#pragma unroll
        for (int q = 0; q < 4; ++q) {
            T1[q] = (unsigned)(127 - (L1[4 * q] & 127)) | ((unsigned)(127 - (L1[4 * q + 1] & 127)) << 8) | ((unsigned)(127 - (L1[4 * q + 2] & 127)) << 16) | ((unsigned)(127 - (L1[4 * q + 3] & 127)) << 24);
            T2[q] = (unsigned)(127 - (L2[4 * q] & 127)) | ((unsigned)(127 - (L2[4 * q + 1] & 127)) << 8) | ((unsigned)(127 - (L2[4 * q + 2] & 127)) << 16) | ((unsigned)(127 - (L2[4 * q + 3] & 127)) << 24); }
        float val[16]; int ex[16];
#pragma unroll
        for (int k = 0; k < 16; ++k) { const int pos = 255 - (A[k] & 255); val[k] = __int_as_float(A[k] & ~255);
            ex[k] = lut16(T1, pos >> 4) * NKEYS + lut16(T2, pos & 15); }
        float sum = 0.f; const float vmax = val[0];
#pragma unroll
        for (int k = 0; k < 16; ++k) { val[k] = __expf(val[k] - vmax); sum += val[k]; }
        const float inv = 1.f / sum;
        if (hb == 0) {
            int* ip = IDX + t * NSEL + h * TOPK; float* gp = GATE + t * NSEL + h * TOPK;
#pragma unroll
            for (int k4 = 0; k4 < 4; ++k4) {
                *(int4*)(ip + 4 * k4) = make_int4(ex[4 * k4], ex[4 * k4 + 1], ex[4 * k4 + 2], ex[4 * k4 + 3]);
                *(f32x4*)(gp + 4 * k4) = (f32x4){val[4 * k4] * inv, val[4 * k4 + 1] * inv, val[4 * k4 + 2] * inv, val[4 * k4 + 3] * inv};
            }
        }
        ucur = unxt; have = have_next;
    }
}

#define FP4X2(w, sel) __builtin_amdgcn_cvt_scalef32_pk_f32_fp4((w), 1.0f, (sel))
__device__ __forceinline__ float dot16_fp4(const u32x2 r, const f32x4 (&xs)[4]) {
    float p = 0.f;
    { const f32x2 a = FP4X2(r.x, 0), b = FP4X2(r.x, 1), c = FP4X2(r.x, 2), d = FP4X2(r.x, 3);
      p += (a.x * xs[0].x + a.y * xs[0].y) + (b.x * xs[0].z + b.y * xs[0].w); p += (c.x * xs[1].x + c.y * xs[1].y) + (d.x * xs[1].z + d.y * xs[1].w); }
    { const f32x2 a = FP4X2(r.y, 0), b = FP4X2(r.y, 1), c = FP4X2(r.y, 2), d = FP4X2(r.y, 3);
      p += (a.x * xs[2].x + a.y * xs[2].y) + (b.x * xs[2].z + b.y * xs[2].w); p += (c.x * xs[3].x + c.y * xs[3].y) + (d.x * xs[3].z + d.y * xs[3].w); }
    return p;
}
__device__ __forceinline__ void axpy16_fp4(const u32x2 r, float w, f32x4 (&o)[4]) {
    { const f32x2 a = FP4X2(r.x, 0), b = FP4X2(r.x, 1), c = FP4X2(r.x, 2), d = FP4X2(r.x, 3);
      o[0].x += w * a.x; o[0].y += w * a.y; o[0].z += w * b.x; o[0].w += w * b.y; o[1].x += w * c.x; o[1].y += w * c.y; o[1].z += w * d.x; o[1].w += w * d.y; }
    { const f32x2 a = FP4X2(r.y, 0), b = FP4X2(r.y, 1), c = FP4X2(r.y, 2), d = FP4X2(r.y, 3);
      o[2].x += w * a.x; o[2].y += w * a.y; o[2].z += w * b.x; o[2].w += w * b.y; o[3].x += w * c.x; o[3].y += w * c.y; o[3].z += w * d.x; o[3].w += w * d.y; }
}
__device__ __forceinline__ float swap32_add(float a, float b) { auto r = __builtin_amdgcn_permlane32_swap(__float_as_uint(a), __float_as_uint(b), false, false); return __uint_as_float(r[0]) + __uint_as_float(r[1]); }
__device__ __forceinline__ float swap16_add(float a, float b) { auto r = __builtin_amdgcn_permlane16_swap(__float_as_uint(a), __float_as_uint(b), false, false); return __uint_as_float(r[0]) + __uint_as_float(r[1]); }
__device__ __forceinline__ float row_sum16(float v) { v += dpp_f<0xB1>(v); v += dpp_f<0x4E>(v); v += dpp_f<0x141>(v); v += dpp_f<0x140>(v); return v; }
__device__ __forceinline__ float row_max16(float v) { v = fmaxf(v, dpp_f<0xB1>(v)); v = fmaxf(v, dpp_f<0x4E>(v)); v = fmaxf(v, dpp_f<0x141>(v)); v = fmaxf(v, dpp_f<0x140>(v)); return v; }
constexpr int GB = 32;
typedef __attribute__((address_space(8))) void* rsrc_t;
__device__ __forceinline__ void g_issue(u32x2 (&buf)[GB], __amdgpu_buffer_rsrc_t rs, int idxr, int lb, int voff) {
#pragma unroll
    for (int j = 0; j < GB; ++j) { const int e = __builtin_amdgcn_readlane(idxr, lb + j); buf[j] = __builtin_amdgcn_raw_buffer_load_b64(rs, voff, e * 512, 0); }
}
__device__ __forceinline__ float dot16_fp4p(const u32x2 r, const f32x2 (&xp)[8]) {
    f32x2 a = FP4X2(r.x, 0) * xp[0];
    a += FP4X2(r.x, 1) * xp[1]; a += FP4X2(r.x, 2) * xp[2]; a += FP4X2(r.x, 3) * xp[3];
    a += FP4X2(r.y, 0) * xp[4]; a += FP4X2(r.y, 1) * xp[5]; a += FP4X2(r.y, 2) * xp[6]; a += FP4X2(r.y, 3) * xp[7];
    return a.x + a.y;
}
__device__ __forceinline__ void axpy16_fp4p(const u32x2 r, float w, f32x2 (&o)[8]) {
    const f32x2 ww = (f32x2){w, w};
    o[0] += FP4X2(r.x, 0) * ww; o[1] += FP4X2(r.x, 1) * ww; o[2] += FP4X2(r.x, 2) * ww; o[3] += FP4X2(r.x, 3) * ww;
    o[4] += FP4X2(r.y, 0) * ww; o[5] += FP4X2(r.y, 1) * ww; o[6] += FP4X2(r.y, 2) * ww; o[7] += FP4X2(r.y, 3) * ww;
}
template <int H> __device__ __forceinline__ void g_compute_u(const u32x2 (&buf)[GB], int q, int i16, const f32x2 (&xp)[8], float& zlo, float& zhi) {
    float p[16];
#pragma unroll
    for (int j = 0; j < 16; ++j) p[j] = dot16_fp4p(buf[16 * H + j], xp);
    float s1[8], s2[4];
#pragma unroll
    for (int m = 0; m < 8; ++m) s1[m] = swap32_add(p[2 * m], p[2 * m + 1]);
#pragma unroll
    for (int n = 0; n < 4; ++n) s2[n] = swap16_add(s1[2 * n], s1[2 * n + 1]);
#pragma unroll
    for (int r = 0; r < 4; ++r) { const float z = row_sum16(s2[r]); const bool mine = i16 == ((4 * q + r) & 15);
        zlo = (mine && q < 4) ? z : zlo; zhi = (mine && q >= 4) ? z : zhi; }
}
template <int H> __device__ __forceinline__ void g_compute_v(const u32x2 (&buf)[GB], int q, float alo, float ahi, f32x2 (&o)[8]) {
    const int areg = __builtin_bit_cast(int, (q < 4) ? alo : ahi), sb = 4 * (q & 3);
#pragma unroll
    for (int j = 0; j < 16; ++j) { const int src = 32 * (j & 1) + 16 * ((j >> 1) & 1) + (j >> 2) + sb;
        const float w = __builtin_bit_cast(float, __builtin_amdgcn_readlane(areg, src));
        axpy16_fp4p(buf[16 * H + j], w, o); }
}
__device__ __forceinline__ void q_issue(u32x2 (&buf)[16], __amdgpu_buffer_rsrc_t rs, int ixr  , int lb, int voff) {
#pragma unroll
    for (int j = 0; j < 16; ++j) { const int e9 = __builtin_amdgcn_readlane(ixr, lb + j); buf[j] = __builtin_amdgcn_raw_buffer_load_b64(rs, voff, e9, 0); }
}
__device__ __forceinline__ void q_compute_u(const u32x2 (&buf)[16], int q, int i16, const f32x2 (&xp)[8], float& zlo, float& zhi) {
    float p[16];
#pragma unroll
    for (int j = 0; j < 16; ++j) p[j] = dot16_fp4p(buf[j], xp);
    float s1[8], s2[4];
#pragma unroll
    for (int m = 0; m < 8; ++m) s1[m] = swap32_add(p[2 * m], p[2 * m + 1]);
#pragma unroll
    for (int n = 0; n < 4; ++n) s2[n] = swap16_add(s1[2 * n], s1[2 * n + 1]);
#pragma unroll
    for (int r = 0; r < 4; ++r) { const float z = row_sum16(s2[r]); const bool mine = i16 == ((4 * q + r) & 15);
        zlo = (mine && q < 4) ? z : zlo; zhi = (mine && q >= 4) ? z : zhi; }
}
typedef _Float16 h16x2 __attribute__((ext_vector_type(2)));
#define FP4H2(w, sel) __builtin_amdgcn_cvt_scalef32_pk_f16_fp4((w), 1.0f, (sel))
__device__ __forceinline__ void axpy16_fp4h(const u32x2 r, const h16x2 ww, h16x2 (&o)[8]) {
    o[0] += FP4H2(r.x, 0) * ww; o[1] += FP4H2(r.x, 1) * ww; o[2] += FP4H2(r.x, 2) * ww; o[3] += FP4H2(r.x, 3) * ww;
    o[4] += FP4H2(r.y, 0) * ww; o[5] += FP4H2(r.y, 1) * ww; o[6] += FP4H2(r.y, 2) * ww; o[7] += FP4H2(r.y, 3) * ww;
}
__device__ __forceinline__ void q_compute_vh(const u32x2 (&buf)[16], int q, int alo, int ahi, h16x2 (&o)[8]) {
    const int areg = (q < 4) ? alo : ahi, sb = 4 * (q & 3);
#pragma unroll
    for (int j = 0; j < 16; ++j) { const int src = 32 * (j & 1) + 16 * ((j >> 1) & 1) + (j >> 2) + sb;
        const h16x2 w = __builtin_bit_cast(h16x2, __builtin_amdgcn_readlane(areg, src));
        axpy16_fp4h(buf[j], w, o); }
}
__device__ __forceinline__ void q_compute_v(const u32x2 (&buf)[16], int q, float alo, float ahi, f32x2 (&o)[8]) {
    const int areg = __builtin_bit_cast(int, (q < 4) ? alo : ahi), sb = 4 * (q & 3);
#pragma unroll
    for (int j = 0; j < 16; ++j) { const int src = 32 * (j & 1) + 16 * ((j >> 1) & 1) + (j >> 2) + sb;
        const float w = __builtin_bit_cast(float, __builtin_amdgcn_readlane(areg, src));
        axpy16_fp4p(buf[j], w, o); }
}
__device__ __forceinline__ int swap32_addi(int a, int b) { auto r = __builtin_amdgcn_permlane32_swap((unsigned)a, (unsigned)b, false, false); const unsigned r0 = r[0], r1 = r[1]; return (int)(r0 + r1); }
__device__ __forceinline__ int swap16_addi(int a, int b) { auto r = __builtin_amdgcn_permlane16_swap((unsigned)a, (unsigned)b, false, false); const unsigned r0 = r[0], r1 = r[1]; return (int)(r0 + r1); }
template <int CTRL> __device__ __forceinline__ int dpp_i(int v) { return __builtin_amdgcn_update_dpp(0, v, CTRL, 0xf, 0xf, true); }
__device__ __forceinline__ int row_sum16i(int v) { v += dpp_i<0xB1>(v); v += dpp_i<0x4E>(v); v += dpp_i<0x141>(v); v += dpp_i<0x140>(v); return v; }
__device__ __forceinline__ void q_compute_ui(const u32x2 (&buf)[16], int q, int i16, int xh0, int xh1, int xl0, int xl1, int& zlo, int& zhi) {
    int p[16];
#pragma unroll
    for (int j = 0; j < 16; ++j) { const int d1 = __builtin_amdgcn_sdot8((int)buf[j].x, xh0, __builtin_amdgcn_sdot8((int)buf[j].y, xh1, 0, false), false);
        const int d2 = __builtin_amdgcn_sdot8((int)buf[j].x, xl0, __builtin_amdgcn_sdot8((int)buf[j].y, xl1, 0, false), false);
        p[j] = (d1 << 4) + d2; }
    int s1[8], s2[4];
#pragma unroll
    for (int m = 0; m < 8; ++m) s1[m] = swap32_addi(p[2 * m], p[2 * m + 1]);
#pragma unroll
    for (int n = 0; n < 4; ++n) s2[n] = swap16_addi(s1[2 * n], s1[2 * n + 1]);
#pragma unroll
    for (int r = 0; r < 4; ++r) { const int z = row_sum16i(s2[r]); const bool mine = i16 == ((4 * q + r) & 15);
        zlo = (mine && q < 4) ? z : zlo; zhi = (mine && q >= 4) ? z : zhi; }
}
__device__ __forceinline__ void phase_gather_u(const Params& P) {
    const int tid = threadIdx.x, lane = tid & 63, wave = __builtin_amdgcn_readfirstlane(tid >> 6);
    const int gw = blockIdx.x * NWAVES + wave, NGW = gridDim.x * NWAVES;
    unsigned char* ws = P.ws;
    const int* IDX = (const int*)(ws + WS_IDX); const float* GATE = (const float*)(ws + WS_GATE); const float* ESC = (const float*)(ws + WS_ESCALE); float* AW = (float*)(ws + WS_AW);
    const __amdgpu_buffer_rsrc_t rsU = __builtin_amdgcn_make_buffer_rsrc((void*)(ws + WS_U8), 0, 16384 * 512, 0x00020000);
    const unsigned char* H2I = ws + WS_H0I8; const float* RF = (const float*)(ws + WS_RF);
    const int hh = lane >> 5, rr = (lane >> 4) & 1, i16 = lane & 15, gsel = 4 * i16 + 2 * rr + hh;
    const int voff = 8 * lane;
    const unsigned ul = (unsigned)lane;
    int t = gw;
    if (t < NTOK) {
        int idx0, idx1; unsigned hraw[4]; float sqv;
        { const int* ip = IDX + (size_t)t * NSEL; idx0 = ip[ul]; idx1 = ip[64u + ul];
          const unsigned* hp = (const unsigned*)(H2I + (size_t)t * DM);
#pragma unroll
          for (int j = 0; j < 4; ++j) hraw[j] = hp[64u * j + ul];
          sqv = RF[t]; }
        u32x2 R0[16], R1[16], R2[16], R3[16];
        { const int ix0 = idx0 << 9; q_issue(R0, rsU, ix0, 0, voff); q_issue(R1, rsU, ix0, 16, voff); q_issue(R2, rsU, ix0, 32, voff); }
        for (;;) {
            const int tn = t + NGW; const bool has_next = tn < NTOK; const int tl = has_next ? tn : t;
            int idx0n, idx1n; unsigned hrawn[4]; float sqn, g0, g1;
            { const int* ip = IDX + (size_t)tl * NSEL; idx0n = ip[ul]; idx1n = ip[64u + ul];
              const unsigned* hp = (const unsigned*)(H2I + (size_t)tl * DM);
#pragma unroll
              for (int j = 0; j < 4; ++j) hrawn[j] = hp[64u * j + ul];
              sqn = RF[tl];
              const float* gp = GATE + (size_t)t * NSEL; g0 = gp[ul]; g1 = gp[64u + ul]; }
            const float su0 = ESC[idx0], su1 = ESC[idx1], sv0 = ESC[16384 + idx0], sv1 = ESC[16384 + idx1];
            const float cq0 = ((const float*)(ws + WS_SUMQ))[idx0], cq1 = ((const float*)(ws + WS_SUMQ))[idx1];
            unsigned xh[2] = {0u, 0u}, xl[2] = {0u, 0u};
#pragma unroll
            for (int j = 0; j < 4; ++j) {
                const unsigned lo4 = hraw[j] & 0x0f0f0f0fu, hi4 = (hraw[j] >> 4) & 0x0f0f0f0fu;
                const unsigned tl4 = (lo4 | (lo4 >> 4)) & 0x00ff00ffu, th4 = (hi4 | (hi4 >> 4)) & 0x00ff00ffu;
                const unsigned pl = ((tl4 | (tl4 >> 8)) & 0xffffu) ^ 0x8888u, ph = (th4 | (th4 >> 8)) & 0xffffu;
                xl[j >> 1] |= pl << (16 * (j & 1)); xh[j >> 1] |= ph << (16 * (j & 1)); }
            int zlo = 0, zhi = 0;
            const int ix0 = idx0 << 9, ix1 = idx1 << 9;
#pragma unroll 1
            for (int qq = 0; qq < 8; qq += 4) {
                const int ixn = qq ? (idx0n << 9) : ix1;
                q_issue(R3, rsU, qq ? ix1 : ix0, 48, voff);
                q_compute_ui(R0, qq, i16, (int)xh[0], (int)xh[1], (int)xl[0], (int)xl[1], zlo, zhi);
                q_issue(R0, rsU, ixn, 0, voff);
                q_compute_ui(R1, qq + 1, i16, (int)xh[0], (int)xh[1], (int)xl[0], (int)xl[1], zlo, zhi);
                q_issue(R1, rsU, ixn, 16, voff);
                q_compute_ui(R2, qq + 2, i16, (int)xh[0], (int)xh[1], (int)xl[0], (int)xl[1], zlo, zhi);
                q_issue(R2, rsU, ixn, 32, voff);
                q_compute_ui(R3, qq + 3, i16, (int)xh[0], (int)xh[1], (int)xl[0], (int)xl[1], zlo, zhi);
            }
            const float glo = __shfl(g0, gsel), ghi = __shfl(g1, gsel), sulo = __shfl(su0, gsel), suhi = __shfl(su1, gsel), svlo = __shfl(sv0, gsel), svhi = __shfl(sv1, gsel);
            const float cqlo = __shfl(cq0, gsel), cqhi = __shfl(cq1, gsel);
            const float zfl = ((float)zlo + 8.f * cqlo) * (sulo * sqv), zfh = ((float)zhi + 8.f * cqhi) * (suhi * sqv);
            const float wl = gelu_tanh_f(zfl) * glo * svlo, wh = gelu_tanh_f(zfh) * ghi * svhi;
            const float wmx = fmaxf(wave_max_fast(fmaxf(fabsf(wl), fabsf(wh))), 1e-30f), wsc = 256.f / wmx;
            { const float a = wl * wsc, c = wh * wsc;
              const int ah = __builtin_amdgcn_cvt_pk_fp8_f32(a, a, 0, false) & 255, ch = __builtin_amdgcn_cvt_pk_fp8_f32(c, c, 0, false) & 255;
              const float ar = a - __builtin_amdgcn_cvt_f32_fp8(ah, 0), cr = c - __builtin_amdgcn_cvt_f32_fp8(ch, 0);
              const int al = __builtin_amdgcn_cvt_pk_fp8_f32(ar, ar, 0, false) & 255, cl = __builtin_amdgcn_cvt_pk_fp8_f32(cr, cr, 0, false) & 255;
              unsigned char* ap = (unsigned char*)AW + (size_t)t * 256;
              ap[gsel] = (unsigned char)ah; ap[64 + gsel] = (unsigned char)ch; ap[128 + gsel] = (unsigned char)al; ap[192 + gsel] = (unsigned char)cl;
              if (lane == 0) ((float*)(ws + WS_WMX))[t] = wmx * (1.f / 256.f); }
            if (!has_next) break;
            t = tn; idx0 = idx0n; idx1 = idx1n; sqv = sqn;
#pragma unroll
            for (int j = 0; j < 4; ++j) hraw[j] = hrawn[j];
        }
    }
}
__device__ __forceinline__ void phase_gather_v(const Params& P) {
    const int tid = threadIdx.x, lane = tid & 63, wave = __builtin_amdgcn_readfirstlane(tid >> 6);
    const int gw = blockIdx.x * NWAVES + wave, NGW = gridDim.x * NWAVES;
    unsigned char* ws = P.ws;
    const int* IDX = (const int*)(ws + WS_IDX); const float* AW = (const float*)(ws + WS_AW);
    const __amdgpu_buffer_rsrc_t rsV = __builtin_amdgcn_make_buffer_rsrc((void*)(ws + WS_V8), 0, 16384 * 512, 0x00020000);
    const bf16* H2B = (const bf16*)(ws + WS_H2B);
    const int voff = 8 * lane;
    const unsigned ul = (unsigned)lane;
    int t = gw;
    if (t < NTOK) {
        int idx0, idx1; u32x2 hraw[4]; float alo, ahi;
        { const int* ip = IDX + (size_t)t * NSEL; idx0 = ip[ul]; idx1 = ip[64u + ul];
          const u32x2* hp = (const u32x2*)(H2B + (size_t)t * DM);
#pragma unroll
          for (int j = 0; j < 4; ++j) hraw[j] = hp[64u * j + ul];
          const float* ap = AW + (size_t)t * NSEL; alo = ap[ul]; ahi = ap[64u + ul]; }
        u32x2 R0[16], R1[16], R2[16], R3[16];
        { const int ix0 = idx0 << 9; q_issue(R0, rsV, ix0, 0, voff); q_issue(R1, rsV, ix0, 16, voff); q_issue(R2, rsV, ix0, 32, voff); }
        for (;;) {
            const int tn = t + NGW; const bool has_next = tn < NTOK; const int tl = has_next ? tn : t;
            int idx0n, idx1n; u32x2 hrawn[4]; float alon, ahin;
            { const int* ip = IDX + (size_t)tl * NSEL; idx0n = ip[ul]; idx1n = ip[64u + ul];
              const u32x2* hp = (const u32x2*)(H2B + (size_t)tl * DM);
#pragma unroll
              for (int j = 0; j < 4; ++j) hrawn[j] = hp[64u * j + ul];
              const float* ap = AW + (size_t)tl * NSEL; alon = ap[ul]; ahin = ap[64u + ul]; }
            const float wmx = fmaxf(wave_max_fast(fmaxf(fabsf(alo), fabsf(ahi))), 1e-30f), winv = 1.f / wmx;
            int alh, ahh;
            { const h16x2 a = (h16x2){(_Float16)(alo * winv), (_Float16)(alo * winv)}, b = (h16x2){(_Float16)(ahi * winv), (_Float16)(ahi * winv)};
              alh = __builtin_bit_cast(int, a); ahh = __builtin_bit_cast(int, b); }
            h16x2 oh[8];
#pragma unroll
            for (int j = 0; j < 8; ++j) oh[j] = (h16x2){(_Float16)0.f, (_Float16)0.f};
            const int ix0 = idx0 << 9, ix1 = idx1 << 9;
#pragma unroll 1
            for (int qq = 0; qq < 8; qq += 4) {
                const int ixn = qq ? (idx0n << 9) : ix1;
                q_issue(R3, rsV, qq ? ix1 : ix0, 48, voff);
                q_compute_vh(R0, qq, alh, ahh, oh);
                q_issue(R0, rsV, ixn, 0, voff);
                q_compute_vh(R1, qq + 1, alh, ahh, oh);
                q_issue(R1, rsV, ixn, 16, voff);
                q_compute_vh(R2, qq + 2, alh, ahh, oh);
                q_issue(R2, rsV, ixn, 32, voff);
                q_compute_vh(R3, qq + 3, alh, ahh, oh);
            }
            f32x2 o[8];
#pragma unroll
            for (int j = 0; j < 8; ++j) o[j] = (f32x2){(float)oh[j].x * wmx, (float)oh[j].y * wmx};
            float ss = 0.f;
#pragma unroll
            for (int j = 0; j < 4; ++j) { o[2 * j] += (f32x2){bflo(hraw[j].x), bfhi(hraw[j].x)}; o[2 * j + 1] += (f32x2){bflo(hraw[j].y), bfhi(hraw[j].y)}; }
#pragma unroll
            for (int j = 0; j < 8; ++j) ss += o[j].x * o[j].x + o[j].y * o[j].y;
            ss = wave_sum_fast(ss);
            const float r3 = rsqrtf(ss * (1.f / DM) + EPS);
            f32x4* op = (f32x4*)(P.out + (size_t)t * DM);
            const f32x4* gfp = (const f32x4*)P.g_fin;
#pragma unroll
            for (int j = 0; j < 4; ++j) { const f32x4 gv = gfp[64u * j + ul]; op[64u * j + ul] = (f32x4){o[2 * j].x * r3 * gv.x, o[2 * j].y * r3 * gv.y, o[2 * j + 1].x * r3 * gv.z, o[2 * j + 1].y * r3 * gv.w}; }
            if (!has_next) break;
            t = tn; idx0 = idx0n; idx1 = idx1n; alo = alon; ahi = ahin;
#pragma unroll
            for (int j = 0; j < 4; ++j) hraw[j] = hrawn[j];
        }
    }
}


typedef int i32x2v __attribute__((ext_vector_type(2)));
typedef int i32x8v __attribute__((ext_vector_type(8)));
#define VM_X 9
#define VM_WAIT(n) asm volatile("s_waitcnt vmcnt(" #n ")" ::: "memory")
__device__ __forceinline__ void phase_gather_v_mfma(const Params& P, LAS unsigned char* lds) {
    const int tid = threadIdx.x, lane = tid & 63, wave = __builtin_amdgcn_readfirstlane(tid >> 6);
    unsigned char* ws = P.ws;
    const int* IDX = (const int*)(ws + WS_IDX);
    const unsigned char* V8 = ws + WS_V8; const unsigned char* AW8 = ws + WS_AW; const float* WMX = (const float*)(ws + WS_WMX);
    const unsigned short* H2S = (const unsigned short*)(ws + WS_H2B);
    const int TPB = NTOK / (int)gridDim.x, t0 = blockIdx.x * TPB, NST = TPB * 4;
    const int r0 = 16 * wave + (lane >> 3), r1 = r0 + 8;
    const unsigned c0 = 16u * (unsigned)((lane & 7) ^ ((r0 >> 1) & 7)), c1 = 16u * (unsigned)((lane & 7) ^ ((r1 >> 1) & 7));
    const int i16 = lane & 15, kb = lane >> 4;
    const int ra = 32 * kb + i16, rb = ra + 16;
    const unsigned offa = (unsigned)(ra * 128 + 16 * (wave ^ ((ra >> 1) & 7))), offb = (unsigned)(rb * 128 + 16 * (wave ^ ((rb >> 1) & 7)));
    const unsigned aoffb = (unsigned)(((i16 & 1) ? 128 : 0) + 16 * kb);
    const bool arow = (i16 & 3) < 2;
    const int colb = 256 * kb + 32 * wave + i16;
    LAS float* SS = (LAS float*)(lds + 131072 + 1024);
    LAS float* OUTB = (LAS float*)(lds + 131072 + 2048);
    const f32x4 gfv = *(const f32x4*)(P.g_fin + 256 * (wave & 3) + 4 * lane);
    const unsigned lbase = (unsigned)(unsigned long long)lds;
    struct VTok { u32x4 a, b; float w; unsigned h0, h1; };
    VTok C0, C1;
    int ia1, ib1, ia2, ib2, ia3, ib3;
#define VM_ISSUE(g, e0, e1) do { LAS unsigned char* _d = lds + (((g) & 7) * 16384) + wave * 2048; const unsigned _cb = 128u * (unsigned)((g) & 3); \
        __builtin_amdgcn_global_load_lds((const unsigned*)(V8 + (size_t)(e0) * 512 + _cb + c0), (LAS unsigned*)(_d), 16, 0, 0); \
        __builtin_amdgcn_global_load_lds((const unsigned*)(V8 + (size_t)(e1) * 512 + _cb + c1), (LAS unsigned*)(_d + 1024), 16, 0, 0); } while (0)
    {
        const int ia0 = IDX[(size_t)t0 * NSEL + r0], ib0 = IDX[(size_t)t0 * NSEL + r1];
        ia1 = IDX[(size_t)(t0 + 1) * NSEL + r0]; ib1 = IDX[(size_t)(t0 + 1) * NSEL + r1];
        ia2 = IDX[(size_t)(t0 + 2) * NSEL + r0]; ib2 = IDX[(size_t)(t0 + 2) * NSEL + r1];
        ia3 = IDX[(size_t)(t0 + 3) * NSEL + r0]; ib3 = IDX[(size_t)(t0 + 3) * NSEL + r1];
        const unsigned char* ap = AW8 + (size_t)t0 * 256 + aoffb;
        C0.a = *(const u32x4*)ap; C0.b = *(const u32x4*)(ap + 64); C0.w = WMX[t0]; C0.h0 = H2S[(size_t)t0 * DM + colb]; C0.h1 = H2S[(size_t)t0 * DM + colb + 16];
        C1.a = *(const u32x4*)(ap + 256); C1.b = *(const u32x4*)(ap + 256 + 64); C1.w = WMX[t0 + 1]; C1.h0 = H2S[(size_t)(t0 + 1) * DM + colb]; C1.h1 = H2S[(size_t)(t0 + 1) * DM + colb + 16];
        asm volatile("s_waitcnt vmcnt(0)" ::: "memory");
        VM_ISSUE(0, ia0, ib0); VM_ISSUE(1, ia0, ib0); VM_ISSUE(2, ia0, ib0); VM_ISSUE(3, ia0, ib0);
        VM_ISSUE(4, ia1, ib1); VM_ISSUE(5, ia1, ib1); VM_ISSUE(6, ia1, ib1);
    }
    float pv0 = 0.f, pv1 = 0.f;
    VTok N0, N1; int na4, nb4, na5, nb5;
    auto token = [&](const int i, const bool even, const VTok& C, const int e1a, const int e1b, const int e2a, const int e2b) __attribute__((always_inline)) {
        const int t = t0 + i;
        const u32x4 z = (u32x4){0u, 0u, 0u, 0u}; const u32x4 Alo = arow ? C.a : z, Ahi = arow ? C.b : z;
        const i32x8v A = (i32x8v){(int)Alo.x, (int)Alo.y, (int)Alo.z, (int)Alo.w, (int)Ahi.x, (int)Ahi.y, (int)Ahi.z, (int)Ahi.w};
        f32x4 acc[4][2];
#pragma unroll
        for (int cc = 0; cc < 4; ++cc) {
            const int g = 4 * i + cc;
            if (even && cc == 0) { VM_WAIT(12); } else { VM_WAIT(26); }
            asm volatile("s_waitcnt lgkmcnt(0)" ::: "memory");
            __builtin_amdgcn_s_barrier();
            __builtin_amdgcn_sched_barrier(0);
            const unsigned sa = lbase + (unsigned)((g & 7) * 16384) + offa, sbb = lbase + (unsigned)((g & 7) * 16384) + offb;
            i32x2v b00, b01, b10, b11;
            asm volatile("ds_read_b64_tr_b4 %0, %4\n\tds_read_b64_tr_b4 %1, %5\n\tds_read_b64_tr_b4 %2, %4 offset:8\n\tds_read_b64_tr_b4 %3, %5 offset:8"
                         : "=&v"(b00), "=&v"(b01), "=&v"(b10), "=&v"(b11) : "v"(sa), "v"(sbb) : "memory");
            { const int gn = g + 7;
              if (cc == 0) VM_ISSUE(gn, e1a, e1b); else VM_ISSUE(gn, e2a, e2b); }
            __builtin_amdgcn_sched_barrier(0);
            if (cc == 0) {
                if (even) {
                    const int tA = t0 + ((i + 2 < TPB) ? i + 2 : TPB - 2), tI = t0 + ((i + 4 < TPB) ? i + 4 : TPB - 2);
                    const unsigned char* ap = AW8 + (size_t)tA * 256 + aoffb; const float* wp = WMX + tA; const int* ipa = IDX + (size_t)tI * NSEL + r0; const unsigned short* hp = H2S + (size_t)tA * DM + colb;
                    asm volatile("global_load_dwordx4 %0, %14, off\n\tglobal_load_dwordx4 %1, %14, off offset:64\n\tglobal_load_dwordx4 %2, %14, off offset:256\n\tglobal_load_dwordx4 %3, %14, off offset:320\n\t"
                                 "global_load_dword %4, %15, off\n\tglobal_load_dword %5, %15, off offset:4\n\t"
                                 "global_load_ushort %6, %17, off\n\tglobal_load_ushort %7, %17, off offset:32\n\tglobal_load_ushort %8, %17, off offset:2048\n\tglobal_load_ushort %9, %17, off offset:2080\n\t"
                                 "global_load_dword %10, %16, off\n\tglobal_load_dword %11, %16, off offset:32\n\tglobal_load_dword %12, %16, off offset:512\n\tglobal_load_dword %13, %16, off offset:544"
                                 : "=&v"(N0.a), "=&v"(N0.b), "=&v"(N1.a), "=&v"(N1.b), "=&v"(N0.w), "=&v"(N1.w), "=&v"(N0.h0), "=&v"(N0.h1), "=&v"(N1.h0), "=&v"(N1.h1), "=&v"(na4), "=&v"(nb4), "=&v"(na5), "=&v"(nb5)
                                 : "v"(ap), "v"(wp), "v"(ipa), "v"(hp) : "memory");
                }
                { const f32x4 s0 = *(const LAS f32x4*)(SS + 8 * ((i + 1) & 1)), s1 = *(const LAS f32x4*)(SS + 8 * ((i + 1) & 1) + 4);
                  const float ss = ((s0.x + s0.y) + (s0.z + s0.w)) + ((s1.x + s1.y) + (s1.z + s1.w));
                  const float r3 = rsqrtf(ss * (1.f / DM) + EPS);
                  if (i > 0 && (wave >> 2) == ((i + 1) & 1)) {
                      const f32x4 v = *(const LAS f32x4*)(OUTB + 1024 * ((i + 1) & 1) + 256 * (wave & 3) + 4 * lane);
                      *(f32x4*)(P.out + (size_t)(t - 1) * DM + 256 * (wave & 3) + 4 * lane) = (f32x4){v.x * r3 * gfv.x, v.y * r3 * gfv.y, v.z * r3 * gfv.z, v.w * r3 * gfv.w}; } }
                __builtin_amdgcn_sched_barrier(0);
            }
            asm volatile("s_waitcnt lgkmcnt(0)" : "+v"(b00), "+v"(b01), "+v"(b10), "+v"(b11) :: "memory");
            const i32x8v B0 = (i32x8v){b00.x, b00.y, b01.x, b01.y, 0, 0, 0, 0}, B1 = (i32x8v){b10.x, b10.y, b11.x, b11.y, 0, 0, 0, 0};
            const f32x4 z4 = (f32x4){0.f, 0.f, 0.f, 0.f};
            acc[cc][0] = __builtin_amdgcn_mfma_scale_f32_16x16x128_f8f6f4(A, B0, z4, 0  , 4  , 0, 0x7f7f7f7f, 0, 0x7f7f7f7f);
            acc[cc][1] = __builtin_amdgcn_mfma_scale_f32_16x16x128_f8f6f4(A, B1, z4, 0, 4, 0, 0x7f7f7f7f, 0, 0x7f7f7f7f);
        }
#pragma unroll
        for (int c = 0; c < 4; ++c) asm volatile("" :: "v"(acc[c][0]), "v"(acc[c][1]));
        float s0 = acc[0][0].x + acc[0][0].y, s1 = acc[0][1].x + acc[0][1].y;
        { const float a0 = acc[1][0].x + acc[1][0].y, a1 = acc[1][1].x + acc[1][1].y, b0 = acc[2][0].x + acc[2][0].y, b1 = acc[2][1].x + acc[2][1].y, d0 = acc[3][0].x + acc[3][0].y, d1 = acc[3][1].x + acc[3][1].y;
          s0 = (kb == 1) ? a0 : s0; s1 = (kb == 1) ? a1 : s1; s0 = (kb == 2) ? b0 : s0; s1 = (kb == 2) ? b1 : s1; s0 = (kb == 3) ? d0 : s0; s1 = (kb == 3) ? d1 : s1; }
        pv0 = s0 * C.w + __uint_as_float(C.h0 << 16); pv1 = s1 * C.w + __uint_as_float(C.h1 << 16);
        OUTB[1024 * (i & 1) + colb] = pv0; OUTB[1024 * (i & 1) + colb + 16] = pv1;
        const float sq = wave_sum_fast(pv0 * pv0 + pv1 * pv1);
        if (lane == 0) SS[8 * (i & 1) + wave] = sq;
    };
#pragma unroll 1
    for (int i = 0; i < TPB; i += 2) {
        token(i, true, C0, ia1, ib1, ia2, ib2);
        token(i + 1, false, C1, ia2, ib2, ia3, ib3);
        asm volatile("s_waitcnt vmcnt(14)" : "+v"(N0.a), "+v"(N0.b), "+v"(N1.a), "+v"(N1.b), "+v"(N0.w), "+v"(N1.w), "+v"(N0.h0), "+v"(N0.h1), "+v"(N1.h0), "+v"(N1.h1), "+v"(na4), "+v"(nb4), "+v"(na5), "+v"(nb5) :: "memory");
        C0 = N0; C1 = N1; ia1 = ia3; ib1 = ib3; ia2 = na4; ib2 = nb4; ia3 = na5; ib3 = nb5;
    }
    asm volatile("s_waitcnt vmcnt(0)" ::: "memory");
    __builtin_amdgcn_s_barrier();
    { const int i = TPB; const f32x4 s0 = *(const LAS f32x4*)(SS + 8 * ((i + 1) & 1)), s1 = *(const LAS f32x4*)(SS + 8 * ((i + 1) & 1) + 4);
      const float ss = ((s0.x + s0.y) + (s0.z + s0.w)) + ((s1.x + s1.y) + (s1.z + s1.w));
      const float r3 = rsqrtf(ss * (1.f / DM) + EPS);
      if ((wave >> 2) == ((i + 1) & 1)) {
          const f32x4 v = *(const LAS f32x4*)(OUTB + 1024 * ((i + 1) & 1) + 256 * (wave & 3) + 4 * lane);
          *(f32x4*)(P.out + (size_t)(t0 + TPB - 1) * DM + 256 * (wave & 3) + 4 * lane) = (f32x4){v.x * r3 * gfv.x, v.y * r3 * gfv.y, v.z * r3 * gfv.z, v.w * r3 * gfv.w}; } }
#undef VM_ISSUE
}

__device__ __forceinline__ void phase_quant_h2(const Params& P) {
    const int tid = threadIdx.x, lane = tid & 63, wave = __builtin_amdgcn_readfirstlane(tid >> 6);
    const int gw = blockIdx.x * NWAVES + wave, NGW = gridDim.x * NWAVES;
    unsigned char* ws = P.ws;
    const float* SSQ = (const float*)(ws + WS_SSQ); const float* AMX = (const float*)(ws + WS_AMX); float* RF = (float*)(ws + WS_RF);
    for (int row = gw; row < NTOK; row += NGW) {
        const u32x4* hp = (const u32x4*)(ws + WS_H2B + (size_t)row * DM * 2) + 2 * lane;
        const u32x4 a = hp[0], b = hp[1];
        const float am = fmaxf(row_max16(AMX[(size_t)row * 16 + (lane & 15)]), 1e-30f) * 1.0078125f;
        const float rstd2 = rsqrtf(row_sum16(SSQ[(size_t)row * 16 + (lane & 15)]) * (1.f / DM) + EPS);
        const float inv = 127.f / am;
        const unsigned w[8] = {a.x, a.y, a.z, a.w, b.x, b.y, b.z, b.w};
        unsigned o[4];
#pragma unroll
        for (int j = 0; j < 4; ++j) {
            const int q0 = (int)rintf(__uint_as_float(w[2 * j] << 16) * inv), q1 = (int)rintf(__uint_as_float(w[2 * j] & 0xffff0000u) * inv);
            const int q2 = (int)rintf(__uint_as_float(w[2 * j + 1] << 16) * inv), q3 = (int)rintf(__uint_as_float(w[2 * j + 1] & 0xffff0000u) * inv);
            o[j] = ((unsigned)q0 & 255u) | (((unsigned)q1 & 255u) << 8) | (((unsigned)q2 & 255u) << 16) | ((unsigned)q3 << 24); }
        u32x4 ov; ov.x = o[0]; ov.y = o[1]; ov.z = o[2]; ov.w = o[3];
        *((u32x4*)(ws + WS_H0I8 + (size_t)row * DM) + lane) = ov;
        if (lane == 0) RF[row] = am * (1.f / 127.f) * rstd2;
    }
}
struct EpiQI8 {
    static constexpr bool PERM = true, AFTER_DRAIN = false;
    bf16* O; int ldc; const float* rf; const float* sw;
    __device__ __forceinline__ void operator()(const pg8::i32x4 (&acc)[2][2][4][2], const pg8::Unit& u, int wr, int wc, int fr, int fq) const {
        const int row0 = u.pm * 256 + wr * 64 + fr, col0 = u.pn * 256 + wc * 32 + 8 * fq;
        f32x4 swv[2][2];
#pragma unroll
        for (int bj = 0; bj < 2; ++bj) { swv[bj][0] = *(const f32x4*)(sw + col0 + bj * 128); swv[bj][1] = *(const f32x4*)(sw + col0 + bj * 128 + 4); }
#pragma unroll
        for (int ai = 0; ai < 2; ++ai)
#pragma unroll
            for (int m = 0; m < 4; ++m) {
                const int row = row0 + ai * 128 + m * 16;
                const float s = rf[row];
                bf16* rowp = O + (size_t)row * ldc + col0;
#pragma unroll
                for (int bj = 0; bj < 2; ++bj) { const pg8::i32x4 a0 = acc[ai][bj][m][0], a1 = acc[ai][bj][m][1];
                    const f32x4 v0 = (f32x4){(float)a0[0], (float)a0[1], (float)a0[2], (float)a0[3]} * (swv[bj][0] * s), v1 = (f32x4){(float)a1[0], (float)a1[1], (float)a1[2], (float)a1[3]} * (swv[bj][1] * s);
                    u32x4 w; w.x = cvt_pk_bf16(v0[0], v0[1]); w.y = cvt_pk_bf16(v0[2], v0[3]); w.z = cvt_pk_bf16(v1[0], v1[1]); w.w = cvt_pk_bf16(v1[2], v1[3]);
                    *(u32x4*)(rowp + bj * 128) = w; }
            }
    }
};
#define XB_TMO      128
#define XB_XCNT(j)  (256  + 64 * (j))
#define XB_XSUB(j)  (1280 + 64 * (j))
#define XB_XGEN(j)  (2304 + 64 * (j))
#define XB_TOP      3328
#define XB_TOPGEN   3392
#define XCD_BAR_WORDS 3456
#define XB_SPIN_CAP (1u << 18)

__device__ __forceinline__ unsigned xb_ld(unsigned* p)              { return __hip_atomic_load(p, __ATOMIC_RELAXED, __HIP_MEMORY_SCOPE_AGENT); }
__device__ __forceinline__ unsigned xb_add(unsigned* p, unsigned v) { return __hip_atomic_fetch_add(p, v, __ATOMIC_RELAXED, __HIP_MEMORY_SCOPE_AGENT); }
__device__ __forceinline__ unsigned xb_xcc_id() { return (unsigned)__builtin_amdgcn_s_getreg((3 << 11) | 20) & 0xFu; }
#define XB_SPIN(cond, bar) do { unsigned _sp = 0; while (cond) { __builtin_amdgcn_s_sleep(1); \
    if ((++_sp & 255u) == 0u) { if (xb_ld(&(bar)[XB_TMO])) break; if (_sp > XB_SPIN_CAP) { atomicAdd(&(bar)[XB_TMO], 1u); break; } } } } while (0)

struct XcdBarrier {
    unsigned* bar; unsigned x;
    volatile LAS unsigned* st;
};

__device__ __forceinline__ XcdBarrier xcd_barrier_post(unsigned* bar, volatile LAS unsigned* st) {
    XcdBarrier b; b.bar = bar; b.x = xb_xcc_id(); b.st = st;
    if (threadIdx.x == 0) (void)xb_add(&bar[XB_XCNT(b.x)], 1u);
    return b;
}
__device__ __forceinline__ void xcd_barrier_complete(unsigned* bar, unsigned x, unsigned& nloc, unsigned& nx) {
    const unsigned G = gridDim.x * gridDim.y * gridDim.z;
    unsigned sum, cnt, mine, sp = 0u;
    for (;;) {
        sum = 0u; cnt = 0u; mine = 0u;
#pragma unroll
        for (unsigned j = 0; j < 16; ++j) { const unsigned c = xb_ld(&bar[XB_XCNT(j)]); sum += c; cnt += (c > 0u) ? 1u : 0u; mine = (j == x) ? c : mine; }
        if (sum == G) break;
        __builtin_amdgcn_s_sleep(1);
        if ((++sp & 255u) == 0u) { if (xb_ld(&bar[XB_TMO])) break; if (sp > XB_SPIN_CAP) { atomicAdd(&bar[XB_TMO], 1u); break; } }
    }
    nloc = mine > 0u ? mine : 1u; nx = cnt > 0u ? cnt : 1u;
}

__device__ __forceinline__ void xcd_barrier(const XcdBarrier& b) {
    asm volatile("s_waitcnt vmcnt(0)" ::: "memory");
    __syncthreads();
    if (threadIdx.x == 0) {
        unsigned* bar = b.bar;
        __builtin_amdgcn_s_waitcnt(0);
        unsigned nloc = b.st[0], nx = b.st[1];
        if (nloc == 0u) { xcd_barrier_complete(bar, b.x, nloc, nx); b.st[0] = nloc; b.st[1] = nx; }
        const unsigned old = xb_add(&bar[XB_XSUB(b.x)], 1u);
        const unsigned gen = old / nloc;
        if (old + 1u == (gen + 1u) * nloc) {
            __builtin_amdgcn_fence(__ATOMIC_RELEASE, "agent");
            asm volatile("s_waitcnt vmcnt(0)" ::: "memory");
            const unsigned og = xb_add(&bar[XB_TOP], 1u);
            const unsigned tg = og / nx;
            if (og + 1u == (tg + 1u) * nx) xb_add(&bar[XB_TOPGEN], 1u);
            else XB_SPIN(xb_ld(&bar[XB_TOPGEN]) == tg, bar);
            __builtin_amdgcn_fence(__ATOMIC_ACQUIRE, "agent");
            xb_add(&bar[XB_XGEN(b.x)], 1u);
            asm volatile("s_waitcnt vmcnt(0)" ::: "memory");
        } else {
            XB_SPIN(xb_ld(&bar[XB_XGEN(b.x)]) == gen, bar);
            __builtin_amdgcn_fence(__ATOMIC_ACQUIRE, "agent");
            asm volatile("s_waitcnt vmcnt(0)" ::: "memory");
        }
    }
    __syncthreads();
}


#ifndef MK_MULTI
#define MK_MULTI 0
#endif
constexpr int NPHASE = 10;
#ifndef REP5
#define REP5 1
#endif
#ifndef REP6
#define REP6 1
#endif
__global__ void __launch_bounds__(NTHREADS, 2) mk_fwd(Params P) {
    extern __shared__ __attribute__((aligned(16))) unsigned char lds_raw[];
    LAS unsigned char* lds = (LAS unsigned char*)lds_raw;
    cg::grid_group grid = cg::this_grid();
    unsigned char* ws = P.ws;
    const int lo = P.ph_lo, hi = P.ph_hi;
    volatile LAS unsigned* bst = (volatile LAS unsigned*)(lds + 131072 + 64);
    if (threadIdx.x < 2) bst[threadIdx.x] = 0u;
    __syncthreads();
    XcdBarrier xbar = xcd_barrier_post((unsigned*)(ws + WS_CTL), bst);
#define IN(k) (lo <= (k) && (k) < hi)
#define SEAM(k) do { if (IN(k) && IN((k) + 1)) { xcd_barrier(xbar); } } while (0)
    if (IN(0)) phase_prep(P, lds);
    if (IN(0) && IN(1)) { }
    SEAM(1);
    if (IN(2)) {
        pg8::Gemm g{(const bf16*)(ws + WS_H0I8), (const bf16*)(ws + WS_WIN_T), NTOK, DIN, DM / 2}; pg8::StaticOrder S; S.init(NTOK, DIN, (int)gridDim.x, (int)blockIdx.x);
        EpiProjI8 E{(bf16*)(ws + WS_PROJ), (const float*)(ws + WS_RSTD1), (const float*)(ws + WS_SW)};
        pg8::gemm_phase_i8<EpiProjI8, pg8::StaticOrder, true, true>(lds, g, S, E);
    }
    SEAM(2);
    if (IN(3)) phase_conv(P, lds);
    SEAM(3);
    if (IN(4)) {
        pg8::Gemm g{(const bf16*)(ws + WS_Y), (const bf16*)(ws + WS_WOUT_T), NTOK, DM, DM / 2}; pg8::StaticOrder S; S.init(NTOK, DM, (int)gridDim.x, (int)blockIdx.x);
        EpiResidualI8 E{(bf16*)(ws + WS_H2B), (const signed char*)(ws + WS_H0I8), (const float*)(ws + WS_SX), (const float*)(ws + WS_SY), (const float*)(ws + WS_SWO), (float*)(ws + WS_SSQ), (float*)(ws + WS_AMX)};
        pg8::gemm_phase_i8<EpiResidualI8, pg8::StaticOrder, true, true>(lds, g, S, E);
    }
    SEAM(4);
    if (IN(5)) phase_quant_h2(P);
    SEAM(5);
    if (IN(6)) {
        pg8::Gemm g{(const bf16*)(ws + WS_H0I8), (const bf16*)(ws + WS_WQ_T), NTOK, 2048, DM / 2}; pg8::StaticOrder S; S.init(NTOK, 2048, (int)gridDim.x, (int)blockIdx.x);
        EpiQI8 E{(bf16*)(ws + WS_Q), 2048, (const float*)(ws + WS_RF), (const float*)(ws + WS_SWQ)};
        pg8::gemm_phase_i8<EpiQI8, pg8::StaticOrder, true, true>(lds, g, S, E);
    }
    if (IN(6) && IN(7)) { asm volatile("s_waitcnt vmcnt(0)" ::: "memory"); __syncthreads(); }
    if (IN(7)) phase_route(P, lds);
    SEAM(7);
    if (IN(8)) phase_gather_u(P);
    SEAM(8);
    if (IN(9)) phase_gather_v_mfma(P, lds);
#undef IN
#undef SEAM
}

extern "C" void kernel_launch(void* const* d_in, const int* in_sizes, int n_in, void* d_out, int out_size, void* d_ws, size_t ws_size, hipStream_t stream) {
    static int grid = 0;
    if (grid == 0) {
        if (n_in != 18 || in_sizes[0] != NTOK * DM || out_size != NTOK * DM || ws_size < WS_END) {
            fprintf(stderr, "kernel_launch: unexpected shapes (n_in %d in0 %d out %d ws %zu)\n", n_in, n_in > 0 ? in_sizes[0] : -1, out_size, ws_size); grid = -1; return; }
        int dev = 0, cus = 0, per_cu = 0;
        (void)hipGetDevice(&dev); (void)hipDeviceGetAttribute(&cus, hipDeviceAttributeMultiprocessorCount, dev);
        if (hipFuncSetAttribute((const void*)mk_fwd, hipFuncAttributeMaxDynamicSharedMemorySize, LDS_BYTES) != hipSuccess) { fprintf(stderr, "kernel_launch: hipFuncSetAttribute failed\n"); grid = -1; return; }
        if (hipOccupancyMaxActiveBlocksPerMultiprocessor(&per_cu, (const void*)mk_fwd, NTHREADS, LDS_BYTES) != hipSuccess || per_cu < 1) { fprintf(stderr, "kernel_launch: occupancy query failed (%d)\n", per_cu); (void)hipGetLastError(); per_cu = 1; }
        if (per_cu > 1) per_cu = 1;
        grid = cus * per_cu;
        if (grid <= 0) grid = 256;
    }
    if (grid < 0) return;
    Params p{};
    p.x = (const float*)d_in[0]; p.meta = (const float*)d_in[1]; p.g_mix = (const float*)d_in[2]; p.w_in = (const float*)d_in[3]; p.sc_w = (const float*)d_in[4];
    p.cf_w = (const float*)d_in[5]; p.cf_b = (const float*)d_in[6]; p.ln_g = (const float*)d_in[7]; p.ln_b = (const float*)d_in[8]; p.g_sc = (const float*)d_in[9];
    p.g_cf = (const float*)d_in[10]; p.w_out = (const float*)d_in[11]; p.g_ffn = (const float*)d_in[12]; p.w_q = (const float*)d_in[13]; p.keys = (const float*)d_in[14];
    p.pu = (const float*)d_in[15]; p.pv = (const float*)d_in[16]; p.g_fin = (const float*)d_in[17];
    p.out = (float*)d_out; p.ws = (unsigned char*)d_ws;
    (void)hipMemsetAsync((char*)d_ws + WS_CTL, 0, 65536 + 16 * 2560 * 4, stream);
#if MK_MULTI
    for (int ph = 0; ph < NPHASE; ++ph) { p.ph_lo = ph; p.ph_hi = ph + 1; p.coop = 0; p.pad = 0;
        hipLaunchKernelGGL(mk_fwd, dim3(grid), dim3(NTHREADS), LDS_BYTES, stream, p); }
#else
    p.ph_lo = 0; p.ph_hi = NPHASE; p.coop = 1; p.pad = 0;
    void* args[] = {&p};
    hipError_t e = hipLaunchCooperativeKernel((const void*)mk_fwd, dim3(grid), dim3(NTHREADS), args, LDS_BYTES, stream);
    if (e != hipSuccess) fprintf(stderr, "cooperative launch failed: %s (grid %d)\n", hipGetErrorString(e), grid);
#endif
}
```

```cpp
#include <hip/hip_runtime.h>
#include <hip/hip_cooperative_groups.h>
#include <cstdio>
#include <cstdint>
namespace cg = cooperative_groups;

namespace pg8 {
#define PG8_LAS __attribute__((address_space(3)))
typedef unsigned short bf16_t;
typedef short bf16x8 __attribute__((ext_vector_type(8)));
typedef float f32x4 __attribute__((ext_vector_type(4)));
typedef unsigned u32x4 __attribute__((ext_vector_type(4)));
typedef int i32x4 __attribute__((ext_vector_type(4)));
constexpr int BM = 256, BK = 64, HALF = 128, HTB = HALF * BK * 2  , STAGE_BYTES = 8 * HTB, NXCD = 8, WGM = 8;

__host__ __device__ __forceinline__ int lds_byte(int r, int c) { const int st = (r >> 4) * 2 + (c >> 5), rr = r & 15, cc = c & 31, ob = rr * 64 + cc * 2; return st * 1024 + (ob ^ (((ob >> 9) & 1) << 5)); }
__host__ __device__ __forceinline__ void stage_rc(int b, int& R, int& C) { const int st = b / 1024, sb = b % 1024, swz = sb ^ (((sb >> 9) & 1) << 5); R = (st >> 1) * 16 + swz / 64; C = (st & 1) * 32 + (swz % 64) / 2; }
__host__ __device__ __forceinline__ int perm32(int rho) { const int n = rho >> 4, i = rho & 15; return 8 * (i >> 2) + 4 * n + (i & 3); }

struct Unit { int pm, pn; };
struct Gemm { const bf16_t* A; const bf16_t* Bt; int M, N, K; };

struct StaticOrder {
    int nM, nN, nwg, G, c;
    __host__ __device__ void init(int M, int N, int G_, int c_) { nM = M / BM; nN = N / BM; nwg = nM * nN; G = G_; c = c_; }
    __host__ __device__ bool next(int i, Unit& u) const {
        const long L = (long)i * G + c; if (L >= nwg) return false;
        int wgid = (int)L; { const int q = nwg / NXCD, r = nwg % NXCD, xcd = wgid % NXCD, off = wgid / NXCD; wgid = (xcd < r ? xcd * (q + 1) : r * (q + 1) + (xcd - r) * q) + off; }
        const int nig = WGM * nN, gid = wgid / nig, fm = gid * WGM, gsz = (nM - fm) < WGM ? (nM - fm) : WGM;
        u.pm = fm + ((wgid % nig) % gsz); u.pn = (wgid % nig) / gsz; return true;
    }
    __device__ __forceinline__ void a_ready(const Unit&) const {}
    __device__ __forceinline__ void done(const Unit&) const {}
};

template <class Epi, class Sched, bool ALIGN_EPI = false, bool SP2 = false>
__device__ __forceinline__ void gemm_phase(PG8_LAS unsigned char* lds, const Gemm g, const Sched& S, const Epi& E) {
    const int tid = threadIdx.x, wid = __builtin_amdgcn_readfirstlane(tid >> 6), lane = tid & 63, wr = wid >> 2, wc = wid & 3, fr = lane & 15, fq = lane >> 4;
    const int K = g.K, nt = K / BK;
    unsigned voffA[2], voffB[2];
#pragma unroll
    for (int i = 0; i < 2; ++i) { int R, C; stage_rc(tid * 16 + i * 8192, R, C); const int Rb = Epi::PERM ? ((R & ~31) + perm32(R & 31)) : R;
        voffA[i] = (unsigned)(R * K + C) * 2u; voffB[i] = (unsigned)(Rb * K + C) * 2u; }
    const size_t kstep = (size_t)(BK * 2);
    const size_t hstep = (size_t)HALF * K * 2;
    const size_t tstep = 2 * hstep;
    const unsigned ldsw = (unsigned)wid * 1024u;
    const int aoff = lds_byte(wr * 64 + fr, fq * 8), boff = lds_byte(wc * 32 + fr, fq * 8);
#define PG8_SA(b, h) (((b) * 2 + (h)) * HTB)
#define PG8_SB(b, h) ((4 + (b) * 2 + (h)) * HTB)
#define PG8_STAGE(bufoff, gbase, voff) do { _Pragma("unroll") for (int _i = 0; _i < 2; ++_i) \
        __builtin_amdgcn_global_load_lds((const unsigned*)((const char*)(gbase) + (voff)[_i]), (PG8_LAS unsigned*)(lds + (bufoff) + ldsw + _i * 8192), 16, 0, 0); } while (0)
#define PG8_LDA(dst, b, h) do { _Pragma("unroll") for (int m = 0; m < 4; ++m) _Pragma("unroll") for (int k = 0; k < 2; ++k) dst[m][k] = *(const PG8_LAS bf16x8*)(lds + PG8_SA(b, h) + aoff + m * 2048 + k * 1024); } while (0)
#define PG8_LDB(dst, b, h) do { _Pragma("unroll") for (int n = 0; n < 2; ++n) _Pragma("unroll") for (int k = 0; k < 2; ++k) dst[n][k] = *(const PG8_LAS bf16x8*)(lds + PG8_SB(b, h) + boff + n * 2048 + k * 1024); } while (0)
#define PG8_MMA(ai, bj, At, Bt) do { __builtin_amdgcn_s_setprio(1); _Pragma("unroll") for (int m = 0; m < 4; ++m) _Pragma("unroll") for (int n = 0; n < 2; ++n) _Pragma("unroll") for (int k = 0; k < 2; ++k) \
        acc[ai][bj][m][n] = __builtin_amdgcn_mfma_f32_16x16x32_bf16(Bt[n][k], At[m][k], acc[ai][bj][m][n], 0, 0, 0); __builtin_amdgcn_s_setprio(0); } while (0)
#define PG8_WAIT_V(n) asm volatile("s_waitcnt vmcnt(" #n ")" ::: "memory")
#define PG8_WAIT_L(n) asm volatile("s_waitcnt lgkmcnt(" #n ")" ::: "memory")
#define PG8_BAR __builtin_amdgcn_s_barrier()
#define PG8_SCHED __builtin_amdgcn_sched_barrier(0)
    Unit cur, nxt; int ui = 0;
    if (!S.next(0, cur)) return;
    f32x4 acc[2][2][4][2];
#pragma unroll
    for (int a = 0; a < 2; ++a)
#pragma unroll
        for (int b = 0; b < 2; ++b)
#pragma unroll
            for (int m = 0; m < 4; ++m)
#pragma unroll
                for (int n = 0; n < 2; ++n) acc[a][b][m][n] = (f32x4){0.f, 0.f, 0.f, 0.f};
    bf16x8 At[4][2], B0[2][2], B1[2][2];
    const char* cA = (const char*)g.A + (size_t)cur.pm * tstep; const char* cB = (const char*)g.Bt + (size_t)cur.pn * tstep;
    S.a_ready(cur);
    if constexpr (SP2) {
        PG8_STAGE(PG8_SB(0, 0), cB, voffB); PG8_STAGE(PG8_SB(0, 1), cB + hstep, voffB); PG8_STAGE(PG8_SA(0, 0), cA, voffA); PG8_STAGE(PG8_SA(0, 1), cA + hstep, voffA);
        if (wr == 1) PG8_BAR;
        PG8_WAIT_V(2); PG8_BAR;
        PG8_STAGE(PG8_SB(1, 0), cB + kstep, voffB); PG8_STAGE(PG8_SA(1, 0), cA + kstep, voffA); PG8_STAGE(PG8_SB(1, 1), cB + hstep + kstep, voffB);
        PG8_WAIT_V(6); PG8_BAR;
    } else {
        PG8_STAGE(PG8_SB(0, 0), cB, voffB); PG8_STAGE(PG8_SA(0, 0), cA, voffA); PG8_STAGE(PG8_SB(0, 1), cB + hstep, voffB); PG8_STAGE(PG8_SA(0, 1), cA + hstep, voffA);
        if (wr == 1) PG8_BAR;
        PG8_WAIT_V(4); PG8_BAR;
        PG8_STAGE(PG8_SB(1, 0), cB + kstep, voffB); PG8_STAGE(PG8_SA(1, 0), cA + kstep, voffA); PG8_STAGE(PG8_SB(1, 1), cB + hstep + kstep, voffB);
        PG8_WAIT_V(6); PG8_BAR;
    }
    for (;;) {
        const bool has_next = S.next(ui + 1, nxt);
        const char* nA = has_next ? (const char*)g.A + (size_t)nxt.pm * tstep : cA; const char* nB = has_next ? (const char*)g.Bt + (size_t)nxt.pn * tstep : cB;
        for (int t = 0; t < nt; t += 2) {
            const bool last = (t == nt - 2);
            const char* a1 = cA + (size_t)(t + 1) * kstep;
            const char* a2 = last ? nA : cA + (size_t)(t + 2) * kstep; const char* b2 = last ? nB : cB + (size_t)(t + 2) * kstep;
            const char* a3 = a2 + kstep; const char* b3 = b2 + kstep;
            if (last && has_next) S.a_ready(nxt);
            if constexpr (SP2) {
            PG8_LDB(B0, 0, 0); PG8_LDB(B1, 0, 1); PG8_SCHED; PG8_LDA(At, 0, 0); PG8_STAGE(PG8_SA(1, 1), a1 + hstep, voffA);
            PG8_WAIT_V(8); PG8_WAIT_L(0); PG8_BAR; PG8_MMA(0, 0, At, B0); PG8_MMA(0, 1, At, B1); PG8_BAR; PG8_SCHED;
            PG8_LDA(At, 0, 1); PG8_STAGE(PG8_SB(0, 0), b2, voffB); PG8_STAGE(PG8_SB(0, 1), b2 + hstep, voffB); PG8_STAGE(PG8_SA(0, 0), a2, voffA);
            PG8_WAIT_V(8); PG8_WAIT_L(0); PG8_BAR; PG8_MMA(1, 0, At, B0); PG8_MMA(1, 1, At, B1); PG8_BAR; PG8_SCHED;
            PG8_LDB(B0, 1, 0); PG8_LDB(B1, 1, 1); PG8_SCHED; PG8_LDA(At, 1, 0); PG8_STAGE(PG8_SA(0, 1), a2 + hstep, voffA);
            PG8_WAIT_V(8); PG8_WAIT_L(0); PG8_BAR; PG8_MMA(0, 0, At, B0); PG8_MMA(0, 1, At, B1); PG8_BAR; PG8_SCHED;
            PG8_LDA(At, 1, 1); PG8_STAGE(PG8_SB(1, 0), b3, voffB); PG8_STAGE(PG8_SB(1, 1), b3 + hstep, voffB); PG8_STAGE(PG8_SA(1, 0), a3, voffA);
            PG8_WAIT_V(8); PG8_WAIT_L(0); PG8_BAR; PG8_MMA(1, 0, At, B0); PG8_MMA(1, 1, At, B1); PG8_BAR; PG8_SCHED;
            } else {
            PG8_LDB(B0, 0, 0); PG8_SCHED; PG8_LDA(At, 0, 0); PG8_STAGE(PG8_SA(1, 1), a1 + hstep, voffA);
            PG8_WAIT_L(8); PG8_BAR; PG8_WAIT_L(0); PG8_MMA(0, 0, At, B0); PG8_BAR; PG8_SCHED;
            PG8_LDB(B1, 0, 1); PG8_STAGE(PG8_SB(0, 0), b2, voffB);
            PG8_BAR; PG8_WAIT_L(0); PG8_MMA(0, 1, At, B1); PG8_BAR;
            PG8_LDA(At, 0, 1); PG8_STAGE(PG8_SA(0, 0), a2, voffA);
            PG8_BAR; PG8_WAIT_L(0); PG8_MMA(1, 0, At, B0); PG8_BAR; PG8_SCHED;
            PG8_STAGE(PG8_SB(0, 1), b2 + hstep, voffB);
            PG8_WAIT_V(6); PG8_BAR; PG8_MMA(1, 1, At, B1); PG8_BAR;
            PG8_LDB(B0, 1, 0); PG8_SCHED; PG8_LDA(At, 1, 0); PG8_STAGE(PG8_SA(0, 1), a2 + hstep, voffA);
            PG8_WAIT_L(8); PG8_BAR; PG8_WAIT_L(0); PG8_MMA(0, 0, At, B0); PG8_BAR; PG8_SCHED;
            PG8_LDB(B1, 1, 1); PG8_STAGE(PG8_SB(1, 0), b3, voffB);
            PG8_BAR; PG8_WAIT_L(0); PG8_MMA(0, 1, At, B1); PG8_BAR;
            PG8_LDA(At, 1, 1); PG8_STAGE(PG8_SA(1, 0), a3, voffA);
            PG8_BAR; PG8_WAIT_L(0); PG8_MMA(1, 0, At, B0); PG8_BAR; PG8_SCHED;
            PG8_STAGE(PG8_SB(1, 1), b3 + hstep, voffB);
            PG8_WAIT_V(6); PG8_BAR; PG8_MMA(1, 1, At, B1); PG8_BAR;
            }
        }
        if constexpr (ALIGN_EPI) { if (wr == 0) PG8_BAR; }
        if constexpr (!Epi::AFTER_DRAIN) { E(acc, cur, wr, wc, fr, fq); S.done(cur); }
        if (!has_next) break;
#pragma unroll
        for (int a = 0; a < 2; ++a)
#pragma unroll
            for (int b = 0; b < 2; ++b)
#pragma unroll
                for (int m = 0; m < 4; ++m)
#pragma unroll
                    for (int n = 0; n < 2; ++n) acc[a][b][m][n] = (f32x4){0.f, 0.f, 0.f, 0.f};
        cur = nxt; cA = nA; cB = nB; ++ui;
        if constexpr (ALIGN_EPI) { if (wr == 1) PG8_BAR; }
    }
    PG8_WAIT_V(0);
    if constexpr (!ALIGN_EPI) { if (wr == 0) PG8_BAR; }
    PG8_BAR;
    if constexpr (Epi::AFTER_DRAIN) { E.fused(acc, cur, wr, wc, fr, fq, lds, wid, lane); S.done(cur); }
#undef PG8_SA
#undef PG8_SB
#undef PG8_STAGE
#undef PG8_LDA
#undef PG8_LDB
#undef PG8_MMA
#undef PG8_WAIT_V
#undef PG8_WAIT_L
#undef PG8_BAR
#undef PG8_SCHED
}
template <class Epi, class Sched, bool ALIGN_EPI = false, bool SP2 = false>
__device__ __forceinline__ void gemm_phase_i8(PG8_LAS unsigned char* lds, const Gemm g, const Sched& S, const Epi& E) {
    const int tid = threadIdx.x, wid = __builtin_amdgcn_readfirstlane(tid >> 6), lane = tid & 63, wr = wid >> 2, wc = wid & 3, fr = lane & 15, fq = lane >> 4;
    const int K = g.K, nt = K / BK;
    unsigned voffA[2], voffB[2];
#pragma unroll
    for (int i = 0; i < 2; ++i) { int R, C; stage_rc(tid * 16 + i * 8192, R, C); const int Rb = Epi::PERM ? ((R & ~31) + perm32(R & 31)) : R;
        voffA[i] = (unsigned)(R * K + C) * 2u; voffB[i] = (unsigned)(Rb * K + C) * 2u; }
    const size_t kstep = (size_t)(BK * 2);
    const size_t hstep = (size_t)HALF * K * 2;
    const size_t tstep = 2 * hstep;
    const unsigned ldsw = (unsigned)wid * 1024u;
    const int aoff = lds_byte(wr * 64 + fr, fq * 8), boff = lds_byte(wc * 32 + fr, fq * 8);
#define PG8_SA(b, h) (((b) * 2 + (h)) * HTB)
#define PG8_SB(b, h) ((4 + (b) * 2 + (h)) * HTB)
#define PG8_STAGE(bufoff, gbase, voff) do { _Pragma("unroll") for (int _i = 0; _i < 2; ++_i) \
        __builtin_amdgcn_global_load_lds((const unsigned*)((const char*)(gbase) + (voff)[_i]), (PG8_LAS unsigned*)(lds + (bufoff) + ldsw + _i * 8192), 16, 0, 0); } while (0)
#define PG8_LDA(dst, b, h) do { _Pragma("unroll") for (int m = 0; m < 4; ++m) _Pragma("unroll") for (int k = 0; k < 2; ++k) dst[m][k] = *(const PG8_LAS bf16x8*)(lds + PG8_SA(b, h) + aoff + m * 2048 + k * 1024); } while (0)
#define PG8_LDB(dst, b, h) do { _Pragma("unroll") for (int n = 0; n < 2; ++n) _Pragma("unroll") for (int k = 0; k < 2; ++k) dst[n][k] = *(const PG8_LAS bf16x8*)(lds + PG8_SB(b, h) + boff + n * 2048 + k * 1024); } while (0)
#define PG8_MMA(ai, bj, At, Bt) do { __builtin_amdgcn_s_setprio(1); _Pragma("unroll") for (int m = 0; m < 4; ++m) _Pragma("unroll") for (int n = 0; n < 2; ++n) _Pragma("unroll") for (int k = 0; k < 2; ++k) \
        acc[ai][bj][m][n] = __builtin_amdgcn_mfma_i32_16x16x64_i8(__builtin_bit_cast(i32x4, Bt[n][k]), __builtin_bit_cast(i32x4, At[m][k]), acc[ai][bj][m][n], 0, 0, 0); __builtin_amdgcn_s_setprio(0); } while (0)
#define PG8_WAIT_V(n) asm volatile("s_waitcnt vmcnt(" #n ")" ::: "memory")
#define PG8_WAIT_L(n) asm volatile("s_waitcnt lgkmcnt(" #n ")" ::: "memory")
#define PG8_BAR __builtin_amdgcn_s_barrier()
#define PG8_SCHED __builtin_amdgcn_sched_barrier(0)
    Unit cur, nxt; int ui = 0;
    if (!S.next(0, cur)) return;
    i32x4 acc[2][2][4][2];
#pragma unroll
    for (int a = 0; a < 2; ++a)
#pragma unroll
        for (int b = 0; b < 2; ++b)
#pragma unroll
            for (int m = 0; m < 4; ++m)
#pragma unroll
                for (int n = 0; n < 2; ++n) acc[a][b][m][n] = (i32x4){0, 0, 0, 0};
    bf16x8 At[4][2], B0[2][2], B1[2][2];
    const char* cA = (const char*)g.A + (size_t)cur.pm * tstep; const char* cB = (const char*)g.Bt + (size_t)cur.pn * tstep;
    S.a_ready(cur);
    if constexpr (SP2) {
        PG8_STAGE(PG8_SB(0, 0), cB, voffB); PG8_STAGE(PG8_SB(0, 1), cB + hstep, voffB); PG8_STAGE(PG8_SA(0, 0), cA, voffA); PG8_STAGE(PG8_SA(0, 1), cA + hstep, voffA);
        if (wr == 1) PG8_BAR;
        PG8_WAIT_V(2); PG8_BAR;
        PG8_STAGE(PG8_SB(1, 0), cB + kstep, voffB); PG8_STAGE(PG8_SA(1, 0), cA + kstep, voffA); PG8_STAGE(PG8_SB(1, 1), cB + hstep + kstep, voffB);
        PG8_WAIT_V(6); PG8_BAR;
    } else {
        PG8_STAGE(PG8_SB(0, 0), cB, voffB); PG8_STAGE(PG8_SA(0, 0), cA, voffA); PG8_STAGE(PG8_SB(0, 1), cB + hstep, voffB); PG8_STAGE(PG8_SA(0, 1), cA + hstep, voffA);
        if (wr == 1) PG8_BAR;
        PG8_WAIT_V(4); PG8_BAR;
        PG8_STAGE(PG8_SB(1, 0), cB + kstep, voffB); PG8_STAGE(PG8_SA(1, 0), cA + kstep, voffA); PG8_STAGE(PG8_SB(1, 1), cB + hstep + kstep, voffB);
        PG8_WAIT_V(6); PG8_BAR;
    }
    for (;;) {
        const bool has_next = S.next(ui + 1, nxt);
        const char* nA = has_next ? (const char*)g.A + (size_t)nxt.pm * tstep : cA; const char* nB = has_next ? (const char*)g.Bt + (size_t)nxt.pn * tstep : cB;
        for (int t = 0; t < nt; t += 2) {
            const bool last = (t == nt - 2);
            const char* a1 = cA + (size_t)(t + 1) * kstep;
            const char* a2 = last ? nA : cA + (size_t)(t + 2) * kstep; const char* b2 = last ? nB : cB + (size_t)(t + 2) * kstep;
            const char* a3 = a2 + kstep; const char* b3 = b2 + kstep;
            if (last && has_next) S.a_ready(nxt);
            if constexpr (SP2) {
            PG8_LDB(B0, 0, 0); PG8_LDB(B1, 0, 1); PG8_SCHED; PG8_LDA(At, 0, 0); PG8_STAGE(PG8_SA(1, 1), a1 + hstep, voffA);
            PG8_WAIT_V(8); PG8_WAIT_L(0); PG8_BAR; PG8_MMA(0, 0, At, B0); PG8_MMA(0, 1, At, B1); PG8_BAR; PG8_SCHED;
            PG8_LDA(At, 0, 1); PG8_STAGE(PG8_SB(0, 0), b2, voffB); PG8_STAGE(PG8_SB(0, 1), b2 + hstep, voffB); PG8_STAGE(PG8_SA(0, 0), a2, voffA);
            PG8_WAIT_V(8); PG8_WAIT_L(0); PG8_BAR; PG8_MMA(1, 0, At, B0); PG8_MMA(1, 1, At, B1); PG8_BAR; PG8_SCHED;
            PG8_LDB(B0, 1, 0); PG8_LDB(B1, 1, 1); PG8_SCHED; PG8_LDA(At, 1, 0); PG8_STAGE(PG8_SA(0, 1), a2 + hstep, voffA);
            PG8_WAIT_V(8); PG8_WAIT_L(0); PG8_BAR; PG8_MMA(0, 0, At, B0); PG8_MMA(0, 1, At, B1); PG8_BAR; PG8_SCHED;
            PG8_LDA(At, 1, 1); PG8_STAGE(PG8_SB(1, 0), b3, voffB); PG8_STAGE(PG8_SB(1, 1), b3 + hstep, voffB); PG8_STAGE(PG8_SA(1, 0), a3, voffA);
            PG8_WAIT_V(8); PG8_WAIT_L(0); PG8_BAR; PG8_MMA(1, 0, At, B0); PG8_MMA(1, 1, At, B1); PG8_BAR; PG8_SCHED;
            } else {
            PG8_LDB(B0, 0, 0); PG8_SCHED; PG8_LDA(At, 0, 0); PG8_STAGE(PG8_SA(1, 1), a1 + hstep, voffA);
            PG8_WAIT_L(8); PG8_BAR; PG8_WAIT_L(0); PG8_MMA(0, 0, At, B0); PG8_BAR; PG8_SCHED;
            PG8_LDB(B1, 0, 1); PG8_STAGE(PG8_SB(0, 0), b2, voffB);
            PG8_BAR; PG8_WAIT_L(0); PG8_MMA(0, 1, At, B1); PG8_BAR;
            PG8_LDA(At, 0, 1); PG8_STAGE(PG8_SA(0, 0), a2, voffA);
            PG8_BAR; PG8_WAIT_L(0); PG8_MMA(1, 0, At, B0); PG8_BAR; PG8_SCHED;
            PG8_STAGE(PG8_SB(0, 1), b2 + hstep, voffB);
            PG8_WAIT_V(6); PG8_BAR; PG8_MMA(1, 1, At, B1); PG8_BAR;
            PG8_LDB(B0, 1, 0); PG8_SCHED; PG8_LDA(At, 1, 0); PG8_STAGE(PG8_SA(0, 1), a2 + hstep, voffA);
            PG8_WAIT_L(8); PG8_BAR; PG8_WAIT_L(0); PG8_MMA(0, 0, At, B0); PG8_BAR; PG8_SCHED;
            PG8_LDB(B1, 1, 1); PG8_STAGE(PG8_SB(1, 0), b3, voffB);
            PG8_BAR; PG8_WAIT_L(0); PG8_MMA(0, 1, At, B1); PG8_BAR;
            PG8_LDA(At, 1, 1); PG8_STAGE(PG8_SA(1, 0), a3, voffA);
            PG8_BAR; PG8_WAIT_L(0); PG8_MMA(1, 0, At, B0); PG8_BAR; PG8_SCHED;
            PG8_STAGE(PG8_SB(1, 1), b3 + hstep, voffB);
            PG8_WAIT_V(6); PG8_BAR; PG8_MMA(1, 1, At, B1); PG8_BAR;
            }
        }
        if constexpr (ALIGN_EPI) { if (wr == 0) PG8_BAR; }
        if constexpr (!Epi::AFTER_DRAIN) { E(acc, cur, wr, wc, fr, fq); S.done(cur); }
        if (!has_next) break;
#pragma unroll
        for (int a = 0; a < 2; ++a)
#pragma unroll
            for (int b = 0; b < 2; ++b)
#pragma unroll
                for (int m = 0; m < 4; ++m)
#pragma unroll
                    for (int n = 0; n < 2; ++n) acc[a][b][m][n] = (i32x4){0, 0, 0, 0};
        cur = nxt; cA = nA; cB = nB; ++ui;
        if constexpr (ALIGN_EPI) { if (wr == 1) PG8_BAR; }
    }
    PG8_WAIT_V(0);
    if constexpr (!ALIGN_EPI) { if (wr == 0) PG8_BAR; }
    PG8_BAR;
    if constexpr (Epi::AFTER_DRAIN) { E.fused(acc, cur, wr, wc, fr, fq, lds, wid, lane); S.done(cur); }
#undef PG8_SA
#undef PG8_SB
#undef PG8_STAGE
#undef PG8_LDA
#undef PG8_LDB
#undef PG8_MMA
#undef PG8_WAIT_V
#undef PG8_WAIT_L
#undef PG8_BAR
#undef PG8_SCHED
}
}

#define LAS __attribute__((address_space(3)))
typedef unsigned short bf16;
typedef float f32x2 __attribute__((ext_vector_type(2)));
typedef float f32x4 __attribute__((ext_vector_type(4)));
typedef unsigned u32x2 __attribute__((ext_vector_type(2)));
typedef unsigned u32x4 __attribute__((ext_vector_type(4)));

constexpr int PDIM = 1536;
constexpr int NTOK = 32768, DM = 1024, DIN = 2560, SEQ = 8192, NBATCH = 4, NMETA = 16;
constexpr int NHEAD = 8, NKEYS = 128, TOPK = 16, NSEL = NHEAD * TOPK;
constexpr float EPS = 1e-6f;
constexpr float U_SCALE = 64.f, V_SCALE = 16.f;
constexpr float U4_CLIP = 2.6f;
constexpr int NWAVES = 8, NTHREADS = 512;
constexpr int MKC = 32;
constexpr int LDS_BYTES = 147456;

constexpr size_t MiB = 1u << 20;
constexpr size_t WS_CTL = 0, WS_WIN_T = 1 * MiB, WS_WOUT_T = 6 * MiB, WS_WQ_T = 8 * MiB, WS_KEYS = 12 * MiB, WS_METAPART = 160 * MiB  ,
                 WS_METARSTD = 14 * MiB + 512 * 1024, WS_METAPROJ = 14 * MiB + 576 * 1024, WS_RSTD1 = 15 * MiB, WS_SSQ = 16 * MiB, WS_U8 = 32 * MiB, WS_V8 = 48 * MiB,
                 WS_IDX = 64 * MiB, WS_GATE = 80 * MiB, WS_H0B = 96 * MiB, WS_H2B = 96 * MiB, WS_Y = 160 * MiB, WS_PROJ = 224 * MiB,
                 WS_Q = 224 * MiB, WS_ESCALE = 18 * MiB, WS_SUMQ = 19 * MiB, WS_SX = 20 * MiB, WS_SW = 21 * MiB, WS_SY = 22 * MiB, WS_SWO = 23 * MiB, WS_WMX = 24 * MiB, WS_AMX = 26 * MiB, WS_RF = 28 * MiB, WS_SWQ = 29 * MiB, WS_H0I8 = 384 * MiB, WS_AW = 160 * MiB  , WS_END = 416 * MiB;

struct Params {
    const float* x; const float* meta; const float* g_mix; const float* w_in; const float* sc_w; const float* cf_w; const float* cf_b;
    const float* ln_g; const float* ln_b; const float* g_sc; const float* g_cf; const float* w_out; const float* g_ffn; const float* w_q;
    const float* keys; const float* pu; const float* pv; const float* g_fin;
    float* out; unsigned char* ws;
    int ph_lo, ph_hi, coop, pad;
};

__device__ __forceinline__ unsigned f2bf(float f) { unsigned u = __builtin_bit_cast(unsigned, f); return (u + 0x7fffu + ((u >> 16) & 1u)) >> 16; }
__device__ __forceinline__ unsigned pk2(float lo, float hi) { return f2bf(lo) | (f2bf(hi) << 16); }
__device__ __forceinline__ float bf2f(unsigned b) { return __builtin_bit_cast(float, b << 16); }
__device__ __forceinline__ float bflo(unsigned w) { return __builtin_bit_cast(float, w << 16); }
__device__ __forceinline__ float bfhi(unsigned w) { return __builtin_bit_cast(float, w & 0xffff0000u); }
__device__ __forceinline__ float wave_sum(float v) {
#pragma unroll
    for (int o = 1; o < 64; o <<= 1) v += __shfl_xor(v, o);
    return v;
}
template <int CTRL> __device__ __forceinline__ float dpp_f(float v) { return __builtin_bit_cast(float, __builtin_amdgcn_update_dpp(0, __builtin_bit_cast(int, v), CTRL, 0xf, 0xf, true)); }
__device__ __forceinline__ float wave_sum_fast(float v) {
    v += dpp_f<0xB1>(v); v += dpp_f<0x4E>(v); v += dpp_f<0x141>(v); v += dpp_f<0x140>(v);
    { auto r = __builtin_amdgcn_permlane16_swap(__float_as_uint(v), __float_as_uint(v), false, false); v = __uint_as_float(r[0]) + __uint_as_float(r[1]); }
    { auto r = __builtin_amdgcn_permlane32_swap(__float_as_uint(v), __float_as_uint(v), false, false); v = __uint_as_float(r[0]) + __uint_as_float(r[1]); }
    return v;
}
__device__ __forceinline__ float wave_max_fast(float v) {
    v = fmaxf(v, dpp_f<0xB1>(v)); v = fmaxf(v, dpp_f<0x4E>(v)); v = fmaxf(v, dpp_f<0x141>(v)); v = fmaxf(v, dpp_f<0x140>(v));
    { auto r = __builtin_amdgcn_permlane16_swap(__float_as_uint(v), __float_as_uint(v), false, false); v = fmaxf(__uint_as_float(r[0]), __uint_as_float(r[1])); }
    { auto r = __builtin_amdgcn_permlane32_swap(__float_as_uint(v), __float_as_uint(v), false, false); v = fmaxf(__uint_as_float(r[0]), __uint_as_float(r[1])); }
    return v;
}
__device__ __forceinline__ float sigmoid_f(float x) { return 1.f / (1.f + __expf(-x)); }
__device__ __forceinline__ float gelu_tanh_f(float x) {
    const float t = 0.7978845608028654f * (x + 0.044715f * x * x * x);
    const float e = __expf(2.f * t);
    const float th = 1.f - 2.f / (e + 1.f);
    return 0.5f * x * (1.f + th);
}

__device__ __forceinline__ unsigned cvt_pk_bf16(float lo, float hi) { unsigned r; asm volatile("v_cvt_pk_bf16_f32 %0, %1, %2" : "=v"(r) : "v"(lo), "v"(hi)); return r; }

template <int MODE> struct EpiRowScale {
    static constexpr bool PERM = true, AFTER_DRAIN = false;
    bf16* O; int ldc; const float* rs;
    __device__ __forceinline__ void operator()(const pg8::f32x4 (&acc)[2][2][4][2], const pg8::Unit& u, int wr, int wc, int fr, int fq) const {
        const int row0 = u.pm * 256 + wr * 64 + fr, col0 = u.pn * 256 + wc * 32 + 8 * fq;
#pragma unroll
        for (int ai = 0; ai < 2; ++ai)
#pragma unroll
            for (int m = 0; m < 4; ++m) {
                const int row = row0 + ai * 128 + m * 16;
                float s;
                if (MODE == 0) s = rs[row];
                else { const f32x4* p = (const f32x4*)(rs + (size_t)row * 16); const f32x4 a = p[0], b = p[1], c = p[2], d = p[3];
                       const float t = ((a.x + a.y) + (a.z + a.w)) + ((b.x + b.y) + (b.z + b.w)) + ((c.x + c.y) + (c.z + c.w)) + ((d.x + d.y) + (d.z + d.w));
                       s = rsqrtf(t * (1.f / 1024.f) + EPS); }
                bf16* rowp = O + (size_t)row * ldc + col0;
#pragma unroll
                for (int bj = 0; bj < 2; ++bj) { const pg8::f32x4 v0 = acc[ai][bj][m][0] * s, v1 = acc[ai][bj][m][1] * s;
                    u32x4 w; w.x = cvt_pk_bf16(v0[0], v0[1]); w.y = cvt_pk_bf16(v0[2], v0[3]); w.z = cvt_pk_bf16(v1[0], v1[1]); w.w = cvt_pk_bf16(v1[2], v1[3]);
                    *(u32x4*)(rowp + bj * 128) = w; }
            }
    }
};
struct EpiProj {
    static constexpr bool PERM = true, AFTER_DRAIN = false;
    bf16* O; const float* rs;
    __device__ __forceinline__ void operator()(const pg8::f32x4 (&acc)[2][2][4][2], const pg8::Unit& u, int wr, int wc, int fr, int fq) const {
        const int row0 = u.pm * 256 + wr * 64 + fr, cin = wc * 32 + 8 * fq, pn = u.pn;
#pragma unroll
        for (int ai = 0; ai < 2; ++ai)
#pragma unroll
            for (int m = 0; m < 4; ++m) {
                const int row = row0 + ai * 128 + m * 16; const float sc = rs[row];
                float a[8], b[8];
#pragma unroll
                for (int i = 0; i < 4; ++i) { a[i] = acc[ai][0][m][0][i] * sc; a[4 + i] = acc[ai][0][m][1][i] * sc; b[i] = acc[ai][1][m][0][i] * sc; b[4 + i] = acc[ai][1][m][1][i] * sc; }
                bf16* rowp = O + (size_t)row * PDIM;
                if (pn >= 4 && pn < 6) {
                    u32x4 w0, w1; w0.x = cvt_pk_bf16(a[0], a[1]); w0.y = cvt_pk_bf16(a[2], a[3]); w0.z = cvt_pk_bf16(a[4], a[5]); w0.w = cvt_pk_bf16(a[6], a[7]);
                    w1.x = cvt_pk_bf16(b[0], b[1]); w1.y = cvt_pk_bf16(b[2], b[3]); w1.z = cvt_pk_bf16(b[4], b[5]); w1.w = cvt_pk_bf16(b[6], b[7]);
                    *(u32x4*)(rowp + 512 + 256 * (pn - 4) + cin) = w0; *(u32x4*)(rowp + 512 + 256 * (pn - 4) + 128 + cin) = w1;
                } else {
                    float o[8];
                    if (pn < 4) {
#pragma unroll
                        for (int i = 0; i < 8; ++i) o[i] = a[i] * b[i];
                    } else {
#pragma unroll
                        for (int i = 0; i < 8; ++i) o[i] = a[i] * sigmoid_f(b[i]);
                    }
                    u32x4 w; w.x = cvt_pk_bf16(o[0], o[1]); w.y = cvt_pk_bf16(o[2], o[3]); w.z = cvt_pk_bf16(o[4], o[5]); w.w = cvt_pk_bf16(o[6], o[7]);
                    *(u32x4*)(rowp + (pn < 4 ? 128 * pn : 1024 + 128 * (pn - 6)) + cin) = w;
                }
            }
    }
};
struct EpiProjI8 {
    static constexpr bool PERM = true, AFTER_DRAIN = false;
    bf16* O; const float* rs; const float* sw;
    __device__ __forceinline__ void operator()(const pg8::i32x4 (&acc)[2][2][4][2], const pg8::Unit& u, int wr, int wc, int fr, int fq) const {
        const int row0 = u.pm * 256 + wr * 64 + fr, cin = wc * 32 + 8 * fq, pn = u.pn;
        float swa[8], swb[8];
        { const f32x4 a0 = *(const f32x4*)(sw + 256 * pn + cin), a1 = *(const f32x4*)(sw + 256 * pn + cin + 4), b0 = *(const f32x4*)(sw + 256 * pn + 128 + cin), b1 = *(const f32x4*)(sw + 256 * pn + 128 + cin + 4);
          swa[0] = a0.x; swa[1] = a0.y; swa[2] = a0.z; swa[3] = a0.w; swa[4] = a1.x; swa[5] = a1.y; swa[6] = a1.z; swa[7] = a1.w;
          swb[0] = b0.x; swb[1] = b0.y; swb[2] = b0.z; swb[3] = b0.w; swb[4] = b1.x; swb[5] = b1.y; swb[6] = b1.z; swb[7] = b1.w; }
#pragma unroll
        for (int ai = 0; ai < 2; ++ai)
#pragma unroll
            for (int m = 0; m < 4; ++m) {
                const int row = row0 + ai * 128 + m * 16; const float sc = rs[row];
                float a[8], b[8];
#pragma unroll
                for (int i = 0; i < 4; ++i) { a[i] = (float)acc[ai][0][m][0][i] * (sc * swa[i]); a[4 + i] = (float)acc[ai][0][m][1][i] * (sc * swa[4 + i]);
                    b[i] = (float)acc[ai][1][m][0][i] * (sc * swb[i]); b[4 + i] = (float)acc[ai][1][m][1][i] * (sc * swb[4 + i]); }
                bf16* rowp = O + (size_t)row * PDIM;
                if (pn >= 4 && pn < 6) {
                    u32x4 w0, w1; w0.x = cvt_pk_bf16(a[0], a[1]); w0.y = cvt_pk_bf16(a[2], a[3]); w0.z = cvt_pk_bf16(a[4], a[5]); w0.w = cvt_pk_bf16(a[6], a[7]);
                    w1.x = cvt_pk_bf16(b[0], b[1]); w1.y = cvt_pk_bf16(b[2], b[3]); w1.z = cvt_pk_bf16(b[4], b[5]); w1.w = cvt_pk_bf16(b[6], b[7]);
                    *(u32x4*)(rowp + 512 + 256 * (pn - 4) + cin) = w0; *(u32x4*)(rowp + 512 + 256 * (pn - 4) + 128 + cin) = w1;
                } else {
                    float o[8];
                    if (pn < 4) {
#pragma unroll
                        for (int i = 0; i < 8; ++i) o[i] = a[i] * b[i];
                    } else {
#pragma unroll
                        for (int i = 0; i < 8; ++i) o[i] = a[i] * sigmoid_f(b[i]);
                    }
                    u32x4 w; w.x = cvt_pk_bf16(o[0], o[1]); w.y = cvt_pk_bf16(o[2], o[3]); w.z = cvt_pk_bf16(o[4], o[5]); w.w = cvt_pk_bf16(o[6], o[7]);
                    *(u32x4*)(rowp + (pn < 4 ? 128 * pn : 1024 + 128 * (pn - 6)) + cin) = w;
                }
            }
    }
};
__host__ __device__ __forceinline__ int win_src_col(int n) {
    const int t = n >> 8, j = n & 255;
    if (t < 4) return (j < 128) ? 128 * t + j : 1024 + 128 * t + (j - 128);
    if (t < 6) return 512 + 256 * (t - 4) + j;
    return (j < 128) ? 1536 + 128 * (t - 6) + j : 2048 + 128 * (t - 6) + (j - 128);
}
struct EpiResidual {
    static constexpr bool PERM = true, AFTER_DRAIN = false;
    bf16* O; const signed char* XB; const float* SX; float* ssq;
    __device__ __forceinline__ void operator()(const pg8::f32x4 (&acc)[2][2][4][2], const pg8::Unit& u, int wr, int wc, int fr, int fq) const {
        const int row0 = u.pm * 256 + wr * 64 + fr, col0 = u.pn * 256 + wc * 32 + 8 * fq;
#pragma unroll
        for (int ai = 0; ai < 2; ++ai)
#pragma unroll
            for (int m = 0; m < 4; ++m) {
                const int row = row0 + ai * 128 + m * 16;
                const signed char* xr = XB + (size_t)row * DM + col0; bf16* rowp = O + (size_t)row * DM + col0;
                float q = 0.f;
                u32x2 xw[2]; const float sxr = SX[row];
#pragma unroll
                for (int bj = 0; bj < 2; ++bj) xw[bj] = *(const u32x2*)(xr + bj * 128);
#pragma unroll
                for (int bj = 0; bj < 2; ++bj) {
                    const f32x4 x0 = (f32x4){(float)(signed char)(xw[bj].x), (float)(signed char)(xw[bj].x >> 8), (float)(signed char)(xw[bj].x >> 16), (float)((int)xw[bj].x >> 24)} * sxr,
                                x1 = (f32x4){(float)(signed char)(xw[bj].y), (float)(signed char)(xw[bj].y >> 8), (float)(signed char)(xw[bj].y >> 16), (float)((int)xw[bj].y >> 24)} * sxr;
                    const pg8::f32x4 v0 = acc[ai][bj][m][0] + x0, v1 = acc[ai][bj][m][1] + x1;
                    q += (v0[0] * v0[0] + v0[1] * v0[1]) + (v0[2] * v0[2] + v0[3] * v0[3]) + (v1[0] * v1[0] + v1[1] * v1[1]) + (v1[2] * v1[2] + v1[3] * v1[3]);
                    u32x4 w; w.x = cvt_pk_bf16(v0[0], v0[1]); w.y = cvt_pk_bf16(v0[2], v0[3]); w.z = cvt_pk_bf16(v1[0], v1[1]); w.w = cvt_pk_bf16(v1[2], v1[3]);
                    *(u32x4*)(rowp + bj * 128) = w; }
                q += __shfl_xor(q, 16); q += __shfl_xor(q, 32);
                if (fq == 0) ssq[(size_t)row * 16 + u.pn * 4 + wc] = q;
            }
    }
};

struct EpiResidualI8 {
    static constexpr bool PERM = true, AFTER_DRAIN = false;
    bf16* O; const signed char* XB; const float* SX; const float* SY; const float* SWO; float* ssq; float* amx;
    __device__ __forceinline__ void operator()(const pg8::i32x4 (&acc)[2][2][4][2], const pg8::Unit& u, int wr, int wc, int fr, int fq) const {
        const int row0 = u.pm * 256 + wr * 64 + fr, col0 = u.pn * 256 + wc * 32 + 8 * fq;
        f32x4 sw[2][2];
#pragma unroll
        for (int bj = 0; bj < 2; ++bj) { sw[bj][0] = *(const f32x4*)(SWO + col0 + bj * 128); sw[bj][1] = *(const f32x4*)(SWO + col0 + bj * 128 + 4); }
#pragma unroll
        for (int ai = 0; ai < 2; ++ai)
#pragma unroll
            for (int m = 0; m < 4; ++m) {
                const int row = row0 + ai * 128 + m * 16;
                const signed char* xr = XB + (size_t)row * DM + col0; bf16* rowp = O + (size_t)row * DM + col0;
                float q = 0.f, mxa = 0.f;
                u32x2 xw[2]; const float sxr = SX[row], syr = SY[row];
#pragma unroll
                for (int bj = 0; bj < 2; ++bj) xw[bj] = *(const u32x2*)(xr + bj * 128);
#pragma unroll
                for (int bj = 0; bj < 2; ++bj) {
                    const f32x4 x0 = (f32x4){(float)(signed char)(xw[bj].x), (float)(signed char)(xw[bj].x >> 8), (float)(signed char)(xw[bj].x >> 16), (float)((int)xw[bj].x >> 24)} * sxr,
                                x1 = (f32x4){(float)(signed char)(xw[bj].y), (float)(signed char)(xw[bj].y >> 8), (float)(signed char)(xw[bj].y >> 16), (float)((int)xw[bj].y >> 24)} * sxr;
                    const pg8::i32x4 a0 = acc[ai][bj][m][0], a1 = acc[ai][bj][m][1];
                    const f32x4 v0 = (f32x4){(float)a0[0], (float)a0[1], (float)a0[2], (float)a0[3]} * (sw[bj][0] * syr) + x0, v1 = (f32x4){(float)a1[0], (float)a1[1], (float)a1[2], (float)a1[3]} * (sw[bj][1] * syr) + x1;
                    q += (v0[0] * v0[0] + v0[1] * v0[1]) + (v0[2] * v0[2] + v0[3] * v0[3]) + (v1[0] * v1[0] + v1[1] * v1[1]) + (v1[2] * v1[2] + v1[3] * v1[3]);
                    mxa = fmaxf(mxa, fmaxf(fmaxf(fmaxf(fabsf(v0[0]), fabsf(v0[1])), fmaxf(fabsf(v0[2]), fabsf(v0[3]))), fmaxf(fmaxf(fabsf(v1[0]), fabsf(v1[1])), fmaxf(fabsf(v1[2]), fabsf(v1[3])))));
                    u32x4 w; w.x = cvt_pk_bf16(v0[0], v0[1]); w.y = cvt_pk_bf16(v0[2], v0[3]); w.z = cvt_pk_bf16(v1[0], v1[1]); w.w = cvt_pk_bf16(v1[2], v1[3]);
                    *(u32x4*)(rowp + bj * 128) = w; }
                q += __shfl_xor(q, 16); q += __shfl_xor(q, 32);
                mxa = fmaxf(mxa, __shfl_xor(mxa, 16)); mxa = fmaxf(mxa, __shfl_xor(mxa, 32));
                if (fq == 0) { ssq[(size_t)row * 16 + u.pn * 4 + wc] = q; amx[(size_t)row * 16 + u.pn * 4 + wc] = mxa; }
            }
    }
};
template <bool MAPIN> __device__ __forceinline__ void p0_transpose_item(const float* W, int K, int N, bf16* WT, LAS float* scr, int item, int lane,
                                                  const float* g_lo, const float* g_hi, int split) {
    const int nblk = N / 32, kb = item / nblk, nb = item % nblk, k0 = 64 * kb, n0 = 32 * nb;
#pragma unroll 8
    for (int i = 0; i < 32; ++i) { const int kk = 2 * i + (lane >> 5); const int k = k0 + kk;
        const float g = (k < split) ? g_lo[k] : g_hi[k - split];
        scr[kk * 33 + (lane & 31)] = W[(size_t)k * N + (MAPIN ? win_src_col(n0) : n0) + (lane & 31)] * g; }
    asm volatile("s_waitcnt lgkmcnt(0)" ::: "memory");
    const int c = lane & 7;
#pragma unroll
    for (int j = 0; j < 4; ++j) { const int n = (lane >> 3) + 8 * j; const LAS float* s = scr + (8 * c) * 33 + n;
        u32x4 o; o.x = pk2(s[0 * 33], s[1 * 33]); o.y = pk2(s[2 * 33], s[3 * 33]); o.z = pk2(s[4 * 33], s[5 * 33]); o.w = pk2(s[6 * 33], s[7 * 33]);
        *(u32x4*)(WT + (size_t)(n0 + n) * K + k0 + 8 * c) = o; }
    asm volatile("s_waitcnt lgkmcnt(0)" ::: "memory");
}

constexpr int CW_COLMAX = 5120;
__device__ __forceinline__ void p0_colmax_item(const float* W, int N, unsigned* colmax, int item, int lane, const float* g) {
    const int nblk = N / 32, kb = item / nblk, nb = item % nblk, k0 = 64 * kb, n0 = 32 * nb;
    float mx = 0.f;
#pragma unroll
    for (int i = 0; i < 32; ++i) { const int k = k0 + 2 * i + (lane >> 5); mx = fmaxf(mx, fabsf(W[(size_t)k * N + n0 + (lane & 31)] * g[k])); }
    mx = fmaxf(mx, __shfl_xor(mx, 32));
    if (lane < 32) atomicMax(colmax + n0 + lane, __float_as_uint(mx));
}
__device__ __forceinline__ void p1_quant_item(const float* W, int K, int N, signed char* WT8, float* swout, const unsigned* colmax, LAS float* scr, int item, int lane, const float* g) {
    const int nblk = N / 32, kb = item / nblk, nb = item % nblk, k0 = 64 * kb, n0 = 32 * nb, s0 = win_src_col(n0);
    const float cm = fmaxf(__uint_as_float(__hip_atomic_load((unsigned*)colmax + s0 + (lane & 31), __ATOMIC_RELAXED, __HIP_MEMORY_SCOPE_AGENT)), 1e-30f), inv = 127.f / cm;
    if (kb == 0 && lane < 32) swout[n0 + lane] = cm * (1.f / 127.f);
#pragma unroll
    for (int i = 0; i < 32; ++i) { const int kk = 2 * i + (lane >> 5); const int k = k0 + kk;
        scr[kk * 33 + (lane & 31)] = W[(size_t)k * N + s0 + (lane & 31)] * g[k] * inv; }
    asm volatile("s_waitcnt lgkmcnt(0)" ::: "memory");
    const int c = lane & 7;
#pragma unroll
    for (int j = 0; j < 4; ++j) { const int n = (lane >> 3) + 8 * j; const LAS float* sp = scr + (8 * c) * 33 + n;
        unsigned w0 = 0u, w1 = 0u;
#pragma unroll
        for (int i = 0; i < 4; ++i) { w0 |= ((unsigned)(int)rintf(sp[i * 33]) & 255u) << (8 * i); w1 |= ((unsigned)(int)rintf(sp[(4 + i) * 33]) & 255u) << (8 * i); }
        u32x2 o; o.x = w0; o.y = w1;
        *(u32x2*)(WT8 + (size_t)(n0 + n) * K + k0 + 8 * c) = o; }
    asm volatile("s_waitcnt lgkmcnt(0)" ::: "memory");
}
constexpr int CW_WCNT = 10752;
constexpr size_t WS_METARAW = 65536;
constexpr int CW_COLMAX3 = 8704;
constexpr int CW_COLMAX2 = 7680;
__device__ __forceinline__ void p0_colmax_item2(const float* W, int N, unsigned* colmax, int item, int lane, const float* g_lo, const float* g_hi, int split) {
    const int nblk = N / 32, kb = item / nblk, nb = item % nblk, k0 = 64 * kb, n0 = 32 * nb;
    float mx = 0.f;
#pragma unroll
    for (int i = 0; i < 32; ++i) { const int k = k0 + 2 * i + (lane >> 5); const float g = (k < split) ? g_lo[k] : g_hi[k - split]; mx = fmaxf(mx, fabsf(W[(size_t)k * N + n0 + (lane & 31)] * g)); }
    mx = fmaxf(mx, __shfl_xor(mx, 32));
    if (lane < 32) atomicMax(colmax + n0 + lane, __float_as_uint(mx));
}
__device__ __forceinline__ void p1_quant_item2(const float* W, int K, int N, signed char* WT8, float* swout, const unsigned* colmax, LAS float* scr, int item, int lane, const float* g_lo, const float* g_hi, int split) {
    const int nblk = N / 32, kb = item / nblk, nb = item % nblk, k0 = 64 * kb, n0 = 32 * nb;
    const float cm = fmaxf(__uint_as_float(__hip_atomic_load((unsigned*)colmax + n0 + (lane & 31), __ATOMIC_RELAXED, __HIP_MEMORY_SCOPE_AGENT)), 1e-30f), inv = 127.f / cm;
    if (kb == 0 && lane < 32) swout[n0 + lane] = cm * (1.f / 127.f);
#pragma unroll
    for (int i = 0; i < 32; ++i) { const int kk = 2 * i + (lane >> 5); const int k = k0 + kk; const float g = (k < split) ? g_lo[k] : g_hi[k - split];
        scr[kk * 33 + (lane & 31)] = W[(size_t)k * N + n0 + (lane & 31)] * g * inv; }
    asm volatile("s_waitcnt lgkmcnt(0)" ::: "memory");
    const int c = lane & 7;
#pragma unroll
    for (int j = 0; j < 4; ++j) { const int n = (lane >> 3) + 8 * j; const LAS float* sp = scr + (8 * c) * 33 + n;
        unsigned w0 = 0u, w1 = 0u;
#pragma unroll
        for (int i = 0; i < 4; ++i) { w0 |= ((unsigned)(int)rintf(sp[i * 33]) & 255u) << (8 * i); w1 |= ((unsigned)(int)rintf(sp[(4 + i) * 33]) & 255u) << (8 * i); }
        u32x2 o; o.x = w0; o.y = w1;
        *(u32x2*)(WT8 + (size_t)(n0 + n) * K + k0 + 8 * c) = o; }
    asm volatile("s_waitcnt lgkmcnt(0)" ::: "memory");
}
__device__ __forceinline__ float q4(float x, float inv_s) {
    const float a = fabsf(x) * inv_s; float r;
    if (a < 2.f) r = rintf(a * 2.f) * 0.5f; else if (a < 4.f) r = rintf(a); else r = fminf(6.f, rintf(a * 0.5f) * 2.f);
    return copysignf(r, x);
}
__device__ __forceinline__ void phase_prep(const Params& P, LAS unsigned char* lds) {
    const int tid = threadIdx.x, lane = tid & 63, wave = __builtin_amdgcn_readfirstlane(tid >> 6);
    const int gw = blockIdx.x * NWAVES + wave, NGW = gridDim.x * NWAVES;
    unsigned char* ws = P.ws;
    LAS float* scr = (LAS float*)(lds + wave * 16384);
    constexpr int I_IN = (DM / 64) * (DIN / 32), I_OUT = (DM / 64) * (DM / 32), I_Q = (DM / 64) * (2048 / 32);
    for (int it = gw; it < I_IN + I_OUT + I_Q; it += NGW) {
        int r = it;
        int grp;
        if (r < I_IN) { p0_colmax_item(P.w_in, DIN, (unsigned*)(ws + WS_CTL) + CW_COLMAX, r, lane, P.g_mix); grp = r % (DIN / 32); }
        else if (r < I_IN + I_OUT) { r -= I_IN; p0_colmax_item2(P.w_out, DM, (unsigned*)(ws + WS_CTL) + CW_COLMAX2, r, lane, P.g_sc, P.g_cf, 512); grp = 80 + r % (DM / 32); }
        else { r -= I_IN + I_OUT; p0_colmax_item2(P.w_q, 2048, (unsigned*)(ws + WS_CTL) + CW_COLMAX3, r, lane, P.g_ffn, P.g_ffn, DM); grp = 112 + r % (2048 / 32); }
        asm volatile("s_waitcnt vmcnt(0)" ::: "memory");
        if (lane == 0) (void)__hip_atomic_fetch_add((unsigned*)(ws + WS_CTL) + CW_WCNT + grp, 1u, __ATOMIC_RELAXED, __HIP_MEMORY_SCOPE_AGENT);
    }
    {
        unsigned* H0I8 = (unsigned*)(ws + WS_H0I8); float* RS1 = (float*)(ws + WS_RSTD1); float* SXp = (float*)(ws + WS_SX);
        for (int t0 = gw * 4; t0 < NTOK; t0 += NGW * 4) {
            f32x4 v[4][4];
#pragma unroll
            for (int q = 0; q < 4; ++q) { const f32x4* xr = (const f32x4*)(P.x + (size_t)(t0 + q) * DM) + lane;
#pragma unroll
                for (int j = 0; j < 4; ++j) v[q][j] = xr[64 * j]; }
#pragma unroll
            for (int q = 0; q < 4; ++q) { float sq = 0.f, mx = 0.f;
#pragma unroll
                for (int j = 0; j < 4; ++j) { sq += (v[q][j].x * v[q][j].x + v[q][j].y * v[q][j].y) + (v[q][j].z * v[q][j].z + v[q][j].w * v[q][j].w);
                    mx = fmaxf(mx, fmaxf(fmaxf(fabsf(v[q][j].x), fabsf(v[q][j].y)), fmaxf(fabsf(v[q][j].z), fabsf(v[q][j].w)))); }
                sq = wave_sum_fast(sq); mx = fmaxf(wave_max_fast(mx), 1e-30f);
                const float sx = mx * (1.f / 127.f), inv = 127.f / mx;
                if (lane == 0) { RS1[t0 + q] = sx * rsqrtf(sq * (1.f / DM) + EPS); SXp[t0 + q] = sx; }
                unsigned* o = H0I8 + (size_t)(t0 + q) * (DM / 4) + lane;
#pragma unroll
                for (int j = 0; j < 4; ++j) { const int a = (int)rintf(v[q][j].x * inv), b = (int)rintf(v[q][j].y * inv), c = (int)rintf(v[q][j].z * inv), d = (int)rintf(v[q][j].w * inv);
                    o[64 * j] = ((unsigned)a & 255u) | (((unsigned)b & 255u) << 8) | (((unsigned)c & 255u) << 16) | ((unsigned)d << 24); } }
        }
    }
    {
        bf16* KB = (bf16*)(ws + WS_KEYS);
        const int gt = blockIdx.x * NTHREADS + tid, NGT = gridDim.x * NTHREADS;
        for (int i = gt; i < 8 * 2 * 128 * 128 / 4; i += NGT) { const f32x4 v = ((const f32x4*)P.keys)[i]; u32x2 w; w.x = pk2(v.x, v.y); w.y = pk2(v.z, v.w); ((u32x2*)KB)[i] = w; }
    }
    {
        float* MP = (float*)(ws + WS_CTL + WS_METARAW); float* MR = (float*)(ws + WS_METARSTD);
        for (int r = gw; r < NMETA; r += NGW) {
            float s = 0.f;
            for (int k = lane; k < DM; k += 64) { const float v = P.meta[r * DM + k]; s += v * v; }
            s = wave_sum(s);
            if (lane == 0) MR[r] = rsqrtf(s * (1.f / DM) + EPS);
        }
        for (int it = gw; it < MKC * 40; it += NGW) {
            const int kc = it / 40, nb = it % 40, n = nb * 64 + lane;
            float acc[NMETA];
#pragma unroll
            for (int r = 0; r < NMETA; ++r) acc[r] = 0.f;
            for (int k = kc * (DM / MKC); k < (kc + 1) * (DM / MKC); ++k) {
                const float w = P.w_in[(size_t)k * DIN + n] * P.g_mix[k];
#pragma unroll
                for (int r = 0; r < NMETA; ++r) acc[r] += P.meta[r * DM + k] * w;
            }
#pragma unroll
            for (int r = 0; r < NMETA; ++r) (void)__hip_atomic_fetch_add(MP + (size_t)r * DIN + n, acc[r], __ATOMIC_RELAXED, __HIP_MEMORY_SCOPE_AGENT);
        }
    }
    {
        constexpr int NI1 = (DM / 64) * (DIN / 32), NI2 = (DM / 64) * (DM / 32), NI3 = (DM / 64) * (2048 / 32);
        unsigned* cnt = (unsigned*)(ws + WS_CTL) + CW_WCNT;
        for (int it = gw; it < NI1 + NI2 + NI3; it += NGW) {
            int grp;
            if (it < NI1) grp = win_src_col(32 * (it % (DIN / 32))) / 32; else if (it < NI1 + NI2) grp = 80 + (it - NI1) % (DM / 32); else grp = 112 + (it - NI1 - NI2) % (2048 / 32);
            { unsigned sp = 0; while (__hip_atomic_load(cnt + grp, __ATOMIC_RELAXED, __HIP_MEMORY_SCOPE_AGENT) < 16u) { __builtin_amdgcn_s_sleep(2); if (++sp > (1u << 20)) break; } }
            if (it < NI1) p1_quant_item(P.w_in, DM, DIN, (signed char*)(ws + WS_WIN_T), (float*)(ws + WS_SW), (const unsigned*)(ws + WS_CTL) + CW_COLMAX, scr, it, lane, P.g_mix);
            else if (it < NI1 + NI2) p1_quant_item2(P.w_out, DM, DM, (signed char*)(ws + WS_WOUT_T), (float*)(ws + WS_SWO), (const unsigned*)(ws + WS_CTL) + CW_COLMAX2, scr, it - NI1, lane, P.g_sc, P.g_cf, 512);
            else p1_quant_item2(P.w_q, DM, 2048, (signed char*)(ws + WS_WQ_T), (float*)(ws + WS_SWQ), (const unsigned*)(ws + WS_CTL) + CW_COLMAX3, scr, it - NI1 - NI2, lane, P.g_ffn, P.g_ffn, DM);
        }
    }
}

__device__ __forceinline__ float metaval(const float* RAW, const float* MR, int p, int c) {
    const float r = MR[p]; const float* rp = RAW + (size_t)p * DIN;
    if (c < 512) return (rp[c] * r) * (rp[1024 + c] * r);
    if (c < 1024) return rp[c] * r;
    return (rp[1536 + (c - 1024)] * r) * sigmoid_f(rp[2048 + (c - 1024)] * r);
}
__device__ __forceinline__ float meta_val(const float* MJ, const float*, int p, int col) { return MJ[p * PDIM + col]; }
__device__ __forceinline__ float proj_at(const bf16* PROJ, const float* MP, const float* MR, int b, int pos, int col) {
    if (pos < 0) return 0.f;
    if (pos < NMETA) return meta_val(MP, MR, pos, col);
    return bf2f(PROJ[(size_t)(b * SEQ + pos - NMETA) * PDIM + col]);
}
struct TabRow { f32x4 v[4]; };
__device__ __forceinline__ void tab_load(const Params& P, int e, int lane, TabRow& r) {
    const bool isv = e >= 16384; const int ee = isv ? e - 16384 : e;
    const f32x4* src = (const f32x4*)((isv ? P.pv : P.pu) + (size_t)ee * DM);
#pragma unroll
    for (int j = 0; j < 4; ++j) r.v[j] = isv ? src[4 * lane + j] : src[64 * j + lane];
}
__device__ __forceinline__ void tab_finish(const Params& P, int e, int lane, TabRow& r) {
    unsigned char* ws = P.ws; float* ESC = (float*)(ws + WS_ESCALE);
    const bool isv = e >= 16384; const int ee = isv ? e - 16384 : e;
    float mx = 0.f;
#pragma unroll
    for (int j = 0; j < 4; ++j) { if (!isv) r.v[j] = r.v[j] * ((const f32x4*)P.g_ffn)[64 * j + lane];
        mx = fmaxf(mx, fmaxf(fmaxf(fabsf(r.v[j].x), fabsf(r.v[j].y)), fmaxf(fabsf(r.v[j].z), fabsf(r.v[j].w)))); }
    mx = wave_max_fast(mx);
    if (!isv) {
        float sq2 = 0.f;
#pragma unroll
        for (int j = 0; j < 4; ++j) sq2 += (r.v[j].x * r.v[j].x + r.v[j].y * r.v[j].y) + (r.v[j].z * r.v[j].z + r.v[j].w * r.v[j].w);
        const float rms = sqrtf(wave_sum_fast(sq2) * (1.f / DM));
        const float su = fmaxf(fminf(mx, U4_CLIP * rms), 1e-30f) * (1.f / 7.f), inv = 1.f / su;
        unsigned wq[2] = {0u, 0u}; int csum = 0;
#pragma unroll
        for (int j = 0; j < 4; ++j) { const float e4[4] = {r.v[j].x, r.v[j].y, r.v[j].z, r.v[j].w};
#pragma unroll
            for (int i = 0; i < 4; ++i) { int c = (int)rintf(fminf(fmaxf(e4[i] * inv, -7.f), 7.f)); csum += c;
                wq[j >> 1] |= ((unsigned)c & 15u) << (16 * (j & 1) + 4 * i); } }
        const float cs = wave_sum_fast((float)csum);
        if (lane == 0) { ESC[e] = su; ((float*)(ws + WS_SUMQ))[e] = cs; }
        u32x2 o; o.x = wq[0]; o.y = wq[1];
        *(u32x2*)(ws + WS_U8 + (size_t)ee * 512 + 8 * lane) = o;
        return;
    }
    const float sc = fmaxf(mx, 1e-30f) * (1.f / 6.f), inv = 1.f / sc;
    if (lane == 0) ESC[e] = sc;
    unsigned w0 = 0u, w1 = 0u;
    w0 = __builtin_amdgcn_cvt_scalef32_pk_fp4_f32(w0, r.v[0].x * inv, r.v[0].y * inv, 1.0f, 0); w0 = __builtin_amdgcn_cvt_scalef32_pk_fp4_f32(w0, r.v[0].z * inv, r.v[0].w * inv, 1.0f, 1);
    w0 = __builtin_amdgcn_cvt_scalef32_pk_fp4_f32(w0, r.v[1].x * inv, r.v[1].y * inv, 1.0f, 2); w0 = __builtin_amdgcn_cvt_scalef32_pk_fp4_f32(w0, r.v[1].z * inv, r.v[1].w * inv, 1.0f, 3);
    w1 = __builtin_amdgcn_cvt_scalef32_pk_fp4_f32(w1, r.v[2].x * inv, r.v[2].y * inv, 1.0f, 0); w1 = __builtin_amdgcn_cvt_scalef32_pk_fp4_f32(w1, r.v[2].z * inv, r.v[2].w * inv, 1.0f, 1);
    w1 = __builtin_amdgcn_cvt_scalef32_pk_fp4_f32(w1, r.v[3].x * inv, r.v[3].y * inv, 1.0f, 2); w1 = __builtin_amdgcn_cvt_scalef32_pk_fp4_f32(w1, r.v[3].z * inv, r.v[3].w * inv, 1.0f, 3);
    u32x2 o; o.x = w0; o.y = w1;
    *(u32x2*)(ws + WS_V8 + (size_t)ee * 512 + 8 * lane) = o;
}
__device__ __forceinline__ void proj8_at(const bf16* PROJ, const float* MP, const float* MR, int b, int pos, int col, float (&v)[8]) {
    if (pos < 0) {
#pragma unroll
        for (int i = 0; i < 8; ++i) v[i] = 0.f;
    } else if (pos < NMETA) {
#pragma unroll
        for (int i = 0; i < 8; ++i) v[i] = metaval(MP, MR, pos, col + i);
    } else {
        const u32x4 w = *(const u32x4*)(PROJ + (size_t)(b * SEQ + pos - NMETA) * PDIM + col);
        v[0] = bflo(w.x); v[1] = bfhi(w.x); v[2] = bflo(w.y); v[3] = bfhi(w.y); v[4] = bflo(w.z); v[5] = bfhi(w.z); v[6] = bflo(w.w); v[7] = bfhi(w.w);
    }
}

template <int R> __device__ __forceinline__ void conv_rows(const LAS unsigned char* ubase, const f32x2 (&wcf)[31], f32x2 (&acc)[32]) {
    if constexpr (R < 62) {
        const unsigned uw = *(const LAS unsigned*)(ubase + R * 1024);
        const f32x2 x = (f32x2){bflo(uw), bfhi(uw)};
        constexpr int lo = R > 30 ? R - 30 : 0, hi = R < 31 ? R : 31;
#pragma unroll
        for (int ii = lo; ii <= hi; ++ii) acc[ii] += wcf[R - ii] * x;
        conv_rows<R + 1>(ubase, wcf, acc);
    }
}
__device__ __forceinline__ void phase_conv(const Params& P, LAS unsigned char* lds) {
    const int tid = threadIdx.x, lane = tid & 63, wave = __builtin_amdgcn_readfirstlane(tid >> 6);
    unsigned char* ws = P.ws;
    const bf16* PROJ = (const bf16*)(ws + WS_PROJ); const float* MP = (const float*)(ws + WS_CTL + WS_METARAW); const float* MR = (const float*)(ws + WS_METARSTD);
    bf16* Y = (bf16*)(ws + WS_Y);
    constexpr int TT = 64, NTILE = NTOK / TT, UROWS = TT + 30;
    const int cgp = wave & 3, th = wave >> 2, ch2 = cgp * 128 + 2 * lane;
    f32x2 wcf[31];
#pragma unroll
    for (int j = 0; j < 31; ++j) wcf[j] = *(const f32x2*)(P.cf_w + j * 512 + ch2);
    const f32x2 bcf = *(const f32x2*)(P.cf_b + ch2);
    for (int tile = blockIdx.x; tile < NTILE; tile += gridDim.x) {
        const int b = tile / (SEQ / TT), s0 = (tile % (SEQ / TT)) * TT;
        if (s0 >= 30) {
            const bf16* pr = PROJ + ((size_t)b * SEQ + s0 - 30) * PDIM + 1024 + 8 * lane;
            u32x4 rw[(UROWS + 7) / 8];
#pragma unroll
            for (int p = 0; p < (UROWS + 7) / 8; ++p) { const int r = p * 8 + wave; rw[p] = *(const u32x4*)(pr + (size_t)(r < UROWS ? r : UROWS - 1) * PDIM); }
#pragma unroll
            for (int p = 0; p < (UROWS + 7) / 8; ++p) { const int r = p * 8 + wave; if (r < UROWS) *(LAS u32x4*)(lds + r * 1024 + lane * 16) = rw[p]; }
        } else {
#pragma unroll 4
        for (int p = 0; p < (UROWS + 7) / 8; ++p) {
            const int r = p * 8 + wave;
            if (r < UROWS) {
                const int pos = NMETA + s0 - 30 + r;
                float uu[8];
                proj8_at(PROJ, MP, MR, b, pos, 1024 + 8 * lane, uu);
                u32x4 w; w.x = pk2(uu[0], uu[1]); w.y = pk2(uu[2], uu[3]); w.z = pk2(uu[4], uu[5]); w.w = pk2(uu[6], uu[7]);
                *(LAS u32x4*)(lds + r * 1024 + lane * 16) = w;
            }
        }
        }
        __syncthreads();
        f32x2 acc[32];
#pragma unroll
        for (int ii = 0; ii < 32; ++ii) acc[ii] = bcf;
        conv_rows<0>(lds + (32 * th) * 1024 + ch2 * 2, wcf, acc);
        u32x4 rcx[8], rbg[8];
        { const bf16* pr = PROJ + ((size_t)b * SEQ + s0 + 8 * wave) * PDIM + 8 * lane;
#pragma unroll
          for (int q = 0; q < 8; ++q) { rcx[q] = *(const u32x4*)(pr + (size_t)q * PDIM); rbg[q] = *(const u32x4*)(pr + (size_t)q * PDIM + 512); } }
        __syncthreads();
#pragma unroll
        for (int ii = 0; ii < 32; ++ii) *(LAS f32x2*)(lds + (32 * th + ii) * 2048 + ch2 * 4) = acc[ii];
        __syncthreads();
        {
            float lng[8], lnb[8];
            { const f32x4 a = *(const f32x4*)(P.ln_g + 8 * lane), c = *(const f32x4*)(P.ln_g + 8 * lane + 4), d = *(const f32x4*)(P.ln_b + 8 * lane), e = *(const f32x4*)(P.ln_b + 8 * lane + 4);
              lng[0] = a.x; lng[1] = a.y; lng[2] = a.z; lng[3] = a.w; lng[4] = c.x; lng[5] = c.y; lng[6] = c.z; lng[7] = c.w;
              lnb[0] = d.x; lnb[1] = d.y; lnb[2] = d.z; lnb[3] = d.w; lnb[4] = e.x; lnb[5] = e.y; lnb[6] = e.z; lnb[7] = e.w; }
            float wsc[3][8];
#pragma unroll
            for (int j = 0; j < 3; ++j) { const f32x4 a = *(const f32x4*)(P.sc_w + j * 512 + 8 * lane), c = *(const f32x4*)(P.sc_w + j * 512 + 8 * lane + 4);
                wsc[j][0] = a.x; wsc[j][1] = a.y; wsc[j][2] = a.z; wsc[j][3] = a.w; wsc[j][4] = c.x; wsc[j][5] = c.y; wsc[j][6] = c.z; wsc[j][7] = c.w; }
            float cxa[8], cxb[8];
            { const int pos = NMETA + s0 + 8 * wave - 2;
              proj8_at(PROJ, MP, MR, b, pos, 8 * lane, cxa); proj8_at(PROJ, MP, MR, b, pos + 1, 8 * lane, cxb); }
#pragma unroll
            for (int q = 0; q < 8; ++q) {
                const int ii = 8 * wave + q, s = s0 + ii; const size_t t = (size_t)b * SEQ + s;
                float o[8];
                { const f32x4 a = *(const LAS f32x4*)(lds + ii * 2048 + lane * 32), c = *(const LAS f32x4*)(lds + ii * 2048 + lane * 32 + 16);
                  o[0] = a.x; o[1] = a.y; o[2] = a.z; o[3] = a.w; o[4] = c.x; o[5] = c.y; o[6] = c.z; o[7] = c.w; }
                float s1 = 0.f;
#pragma unroll
                for (int i = 0; i < 8; ++i) s1 += o[i];
                const float mean = wave_sum_fast(s1) * (1.f / 512.f);
                float s2 = 0.f;
#pragma unroll
                for (int i = 0; i < 8; ++i) { o[i] -= mean; s2 += o[i] * o[i]; }
                const float rs = rsqrtf(wave_sum_fast(s2) * (1.f / 512.f) + EPS);
                float s3 = 0.f;
#pragma unroll
                for (int i = 0; i < 8; ++i) { float y = o[i] * rs * lng[i] + lnb[i]; y = y * sigmoid_f(y); o[i] = y; s3 += y * y; }
                const float r2 = rsqrtf(wave_sum_fast(s3) * (1.f / 512.f) + EPS);
                float bgv[8], cxc[8], accs[8];
                { const u32x4 w = rcx[q], z = rbg[q];
                  cxc[0] = bflo(w.x); cxc[1] = bfhi(w.x); cxc[2] = bflo(w.y); cxc[3] = bfhi(w.y); cxc[4] = bflo(w.z); cxc[5] = bfhi(w.z); cxc[6] = bflo(w.w); cxc[7] = bfhi(w.w);
                  bgv[0] = bflo(z.x); bgv[1] = bfhi(z.x); bgv[2] = bflo(z.y); bgv[3] = bfhi(z.y); bgv[4] = bflo(z.z); bgv[5] = bfhi(z.z); bgv[6] = bflo(z.w); bgv[7] = bfhi(z.w); }
                float s4 = 0.f;
#pragma unroll
                for (int i = 0; i < 8; ++i) { accs[i] = bgv[i] * (wsc[0][i] * cxa[i] + wsc[1][i] * cxb[i] + wsc[2][i] * cxc[i]); s4 += accs[i] * accs[i]; cxa[i] = cxb[i]; cxb[i] = cxc[i]; }
                const float r4 = rsqrtf(wave_sum_fast(s4) * (1.f / 512.f) + EPS);
                float ym = 0.f;
#pragma unroll
                for (int i = 0; i < 8; ++i) { o[i] *= r2; accs[i] *= r4; ym = fmaxf(ym, fmaxf(fabsf(o[i]), fabsf(accs[i]))); }
                ym = fmaxf(wave_max_fast(ym), 1e-30f);
                const float yinv = 127.f / ym;
                if (lane == 0) ((float*)(ws + WS_SY))[t] = ym * (1.f / 127.f);
                u32x2 wz, wv;
                wz.x = ((unsigned)(int)rintf(accs[0] * yinv) & 255u) | (((unsigned)(int)rintf(accs[1] * yinv) & 255u) << 8) | (((unsigned)(int)rintf(accs[2] * yinv) & 255u) << 16) | ((unsigned)(int)rintf(accs[3] * yinv) << 24);
                wz.y = ((unsigned)(int)rintf(accs[4] * yinv) & 255u) | (((unsigned)(int)rintf(accs[5] * yinv) & 255u) << 8) | (((unsigned)(int)rintf(accs[6] * yinv) & 255u) << 16) | ((unsigned)(int)rintf(accs[7] * yinv) << 24);
                wv.x = ((unsigned)(int)rintf(o[0] * yinv) & 255u) | (((unsigned)(int)rintf(o[1] * yinv) & 255u) << 8) | (((unsigned)(int)rintf(o[2] * yinv) & 255u) << 16) | ((unsigned)(int)rintf(o[3] * yinv) << 24);
                wv.y = ((unsigned)(int)rintf(o[4] * yinv) & 255u) | (((unsigned)(int)rintf(o[5] * yinv) & 255u) << 8) | (((unsigned)(int)rintf(o[6] * yinv) & 255u) << 16) | ((unsigned)(int)rintf(o[7] * yinv) << 24);
                *(u32x2*)(ws + WS_Y + t * DM + 8 * lane) = wz;
                *(u32x2*)(ws + WS_Y + t * DM + 512 + 8 * lane) = wv;
            }
        }
        __syncthreads();
    }
}

__device__ __forceinline__ int ord_i(float s) { int k = __builtin_bit_cast(int, s); k ^= (k >> 31) & 0x7fffffff; return k; }
__device__ __forceinline__ float unord_f(int k) { k ^= (k >> 31) & 0x7fffffff; return __builtin_bit_cast(float, k); }
#define TOP_INSERT(L, x_) do { int _x = (x_); _Pragma("unroll") for (int _i = 0; _i < 16; ++_i) { const int _hi = max(L[_i], _x); _x = min(L[_i], _x); L[_i] = _hi; } } while (0)

typedef short bf16x8 __attribute__((ext_vector_type(8)));
typedef float f32x16 __attribute__((ext_vector_type(16)));
template <bool DESC> __device__ __forceinline__ void ce_i(int& a, int& b) { const int hi = max(a, b), lo = min(a, b); if (DESC) { a = hi; b = lo; } else { a = lo; b = hi; } }
__device__ __forceinline__ void bitonic_sort16(int (&a)[16]) {
#pragma unroll
    for (int k = 2; k <= 16; k <<= 1)
#pragma unroll
        for (int j = k >> 1; j > 0; j >>= 1)
#pragma unroll
            for (int i = 0; i < 16; ++i) { const int l = i ^ j; if (l > i) { if ((i & k) == 0) ce_i<true>(a[i], a[l]); else ce_i<false>(a[i], a[l]); } }
}
__device__ __forceinline__ void bitonic_merge16(int (&a)[16]) {
#pragma unroll
    for (int j = 8; j > 0; j >>= 1)
#pragma unroll
        for (int i = 0; i < 16; ++i) { const int l = i ^ j; if (l > i) ce_i<true>(a[i], a[l]); }
}
__device__ __forceinline__ void merge_top16(int (&a)[16], const int (&b)[16]) {
#pragma unroll
    for (int i = 0; i < 16; ++i) a[i] = max(a[i], b[15 - i]);
    bitonic_merge16(a);
}
__device__ __forceinline__ int lut16(const unsigned (&T)[4], int i) {
    const unsigned sel = (unsigned)(i & 7) | 0x0c0c0c00u;
    const unsigned lo = __builtin_amdgcn_perm(T[1], T[0], sel), hi = __builtin_amdgcn_perm(T[3], T[2], sel);
    return (int)((i & 8) ? hi : lo);
}
constexpr int KROW = 272;
constexpr float SCORE_BIAS = 8.0f;

__device__ __forceinline__ void route_load_q(bf16x8 (&qf)[8], const bf16* qrow, int hb) {
#pragma unroll
    for (int ks = 0; ks < 8; ++ks) qf[ks] = *(const bf16x8*)(qrow + 64 * hb + 8 * ks);
}
__device__ __forceinline__ void route_half(const LAS unsigned char* kl, const bf16x8 (&qf)[8], int nl, int hb, int (&L)[16]) {
    f32x16 acc[4];
#pragma unroll
    for (int nt = 0; nt < 4; ++nt)
#pragma unroll
        for (int r = 0; r < 16; ++r) acc[nt][r] = SCORE_BIAS;
#pragma unroll
    for (int ks = 0; ks < 8; ++ks)
#pragma unroll
        for (int nt = 0; nt < 4; ++nt) {
            const bf16x8 a = *(const LAS bf16x8*)(kl + (32 * nt + nl) * KROW + (64 * hb + 8 * ks) * 2);
            acc[nt] = __builtin_amdgcn_mfma_f32_32x32x16_bf16(a, qf[ks], acc[nt], 0, 0, 0);
        }
    const int hb4 = 4 * hb;
    int T[4][16];
#pragma unroll
    for (int nt = 0; nt < 4; ++nt)
#pragma unroll
        for (int r = 0; r < 16; ++r) { const int n0 = 32 * nt + (r & 3) + 8 * (r >> 2); const float sc = acc[nt][r];
            T[nt][r] = (__float_as_int(sc) & ~127) | ((127 - n0) - hb4); }
    bitonic_sort16(T[0]); bitonic_sort16(T[1]); bitonic_sort16(T[2]); bitonic_sort16(T[3]);
    merge_top16(T[0], T[1]); merge_top16(T[2], T[3]); merge_top16(T[0], T[2]);
#pragma unroll
    for (int i = 0; i < 16; ++i) { const unsigned v = (unsigned)T[0][15 - i]; auto r = __builtin_amdgcn_permlane32_swap(v, v, false, false);
        const unsigned r0 = r[0], r1 = r[1]; const int partner = (int)(hb ? r0 : r1); L[i] = max(T[0][i], partner); }
    bitonic_merge16(L);
}

__device__ __forceinline__ void phase_route(const Params& P, LAS unsigned char* lds) {
    const int tid = threadIdx.x, lane = tid & 63, wave = __builtin_amdgcn_readfirstlane(tid >> 6);
    const int nl = lane & 31, hb = lane >> 5;
    unsigned char* ws = P.ws;
    const bf16* KEYS = (const bf16*)(ws + WS_KEYS); const bf16* Q = (const bf16*)(ws + WS_Q);
    int* IDX = (int*)(ws + WS_IDX); float* GATE = (float*)(ws + WS_GATE);
    int last_h = -1;
    pg8::StaticOrder S; S.init(NTOK, 2048, (int)gridDim.x, (int)blockIdx.x);
    pg8::Unit ucur, unxt;
    bool have = S.next(0, ucur);
    bf16x8 qfA[8], qfB[8];
    if (have) route_load_q(qfA, Q + ((size_t)ucur.pm * 256 + wave * 32 + nl) * 2048 + ucur.pn * 256, hb);
    for (int ui = 0; have; ++ui) {
        const int h = ucur.pn, tb = ucur.pm;
        const bool have_next = S.next(ui + 1, unxt);
        if (h != last_h) {
            __syncthreads();
            for (int c = tid; c < 4096; c += NTHREADS) { const u32x4 v = ((const u32x4*)(KEYS + (size_t)h * 32768))[c];
                *(LAS u32x4*)(lds + (c >> 4) * KROW + (c & 15) * 16) = v; }
            __syncthreads();
            last_h = h;
        }
        const size_t t = (size_t)tb * 256 + wave * 32 + nl;
        int L1[16], L2[16];
        route_load_q(qfB, Q + t * 2048 + h * 256 + 128, hb);
        route_half(lds, qfA, nl, hb, L1);
        if (have_next) route_load_q(qfA, Q + ((size_t)unxt.pm * 256 + wave * 32 + nl) * 2048 + unxt.pn * 256, hb);
        route_half(lds + 128 * KROW, qfB, nl, hb, L2);
        float v1[16], v2[16];
#pragma unroll
        for (int i = 0; i < 16; ++i) { v1[i] = __int_as_float(L1[i] & ~127); v2[i] = __int_as_float(L2[i] & ~127); }
#define CAND(i, j) ((__float_as_int(v1[i] + v2[j]) & ~255) | (255 - (16 * (i) + (j))))
        int A[16], B[16], C[16];
#pragma unroll
        for (int j = 0; j < 16; ++j) A[j] = CAND(0, j);
#pragma unroll
        for (int j = 0; j < 8; ++j) { B[j] = CAND(1, j); B[8 + j] = CAND(15 - j, 0); }
        bitonic_merge16(B);
        C[0] = CAND(2, 0); C[1] = CAND(2, 1); C[2] = CAND(2, 2); C[3] = CAND(2, 3); C[4] = CAND(2, 4);
        C[5] = CAND(3, 0); C[6] = CAND(3, 1); C[7] = CAND(3, 2); C[8] = CAND(3, 3);
        C[9] = CAND(4, 0); C[10] = CAND(4, 1); C[11] = CAND(4, 2);
        C[12] = CAND(5, 0); C[13] = CAND(5, 1); C[14] = CAND(6, 0); C[15] = CAND(6, 1);
        bitonic_sort16(C);
        { const int d0 = CAND(7, 0), d1 = CAND(7, 1); C[14] = max(C[14], d1); C[15] = max(C[15], d0); bitonic_merge16(C); }
#undef CAND
        merge_top16(A, B); merge_top16(A, C);
        unsigned T1[4], T2[4];
#pragma unroll
        for (int q = 0; q < 4; ++q) {
            T1[q] = (unsigned)(127 - (L1[4 * q] & 127)) | ((unsigned)(127 - (L1[4 * q + 1] & 127)) << 8) | ((unsigned)(127 - (L1[4 * q + 2] & 127)) << 16) | ((unsigned)(127 - (L1[4 * q + 3] & 127)) << 24);
            T2[q] = (unsigned)(127 - (L2[4 * q] & 127)) | ((unsigned)(127 - (L2[4 * q + 1] & 127)) << 8) | ((unsigned)(127 - (L2[4 * q + 2] & 127)) << 16) | ((unsigned)(127 - (L2[4 * q + 3] & 127)) << 24); }
        float val[16]; int ex[16];
#pragma unroll
        for (int k = 0; k < 16; ++k) { const int pos = 255 - (A[k] & 255); val[k] = __int_as_float(A[k] & ~255);
            ex[k] = lut16(T1, pos >> 4) * NKEYS + lut16(T2, pos & 15); }
        float sum = 0.f; const float vmax = val[0];
#pragma unroll
        for (int k = 0; k < 16; ++k) { val[k] = __expf(val[k] - vmax); sum += val[k]; }
        const float inv = 1.f / sum;
        if (hb == 0) {
            int* ip = IDX + t * NSEL + h * TOPK; float* gp = GATE + t * NSEL + h * TOPK;
#pragma unroll
            for (int k4 = 0; k4 < 4; ++k4) {
                *(int4*)(ip + 4 * k4) = make_int4(ex[4 * k4], ex[4 * k4 + 1], ex[4 * k4 + 2], ex[4 * k4 + 3]);
                *(f32x4*)(gp + 4 * k4) = (f32x4){val[4 * k4] * inv, val[4 * k4 + 1] * inv, val[4 * k4 + 2] * inv, val[4 * k4 + 3] * inv};
            }
        }
        ucur = unxt; have = have_next;
    }
}

#define FP4X2(w, sel) __builtin_amdgcn_cvt_scalef32_pk_f32_fp4((w), 1.0f, (sel))
__device__ __forceinline__ float dot16_fp4(const u32x2 r, const f32x4 (&xs)[4]) {
    float p = 0.f;
    { const f32x2 a = FP4X2(r.x, 0), b = FP4X2(r.x, 1), c = FP4X2(r.x, 2), d = FP4X2(r.x, 3);
      p += (a.x * xs[0].x + a.y * xs[0].y) + (b.x * xs[0].z + b.y * xs[0].w); p += (c.x * xs[1].x + c.y * xs[1].y) + (d.x * xs[1].z + d.y * xs[1].w); }
    { const f32x2 a = FP4X2(r.y, 0), b = FP4X2(r.y, 1), c = FP4X2(r.y, 2), d = FP4X2(r.y, 3);
      p += (a.x * xs[2].x + a.y * xs[2].y) + (b.x * xs[2].z + b.y * xs[2].w); p += (c.x * xs[3].x + c.y * xs[3].y) + (d.x * xs[3].z + d.y * xs[3].w); }
    return p;
}
__device__ __forceinline__ void axpy16_fp4(const u32x2 r, float w, f32x4 (&o)[4]) {
    { const f32x2 a = FP4X2(r.x, 0), b = FP4X2(r.x, 1), c = FP4X2(r.x, 2), d = FP4X2(r.x, 3);
      o[0].x += w * a.x; o[0].y += w * a.y; o[0].z += w * b.x; o[0].w += w * b.y; o[1].x += w * c.x; o[1].y += w * c.y; o[1].z += w * d.x; o[1].w += w * d.y; }
    { const f32x2 a = FP4X2(r.y, 0), b = FP4X2(r.y, 1), c = FP4X2(r.y, 2), d = FP4X2(r.y, 3);
      o[2].x += w * a.x; o[2].y += w * a.y; o[2].z += w * b.x; o[2].w += w * b.y; o[3].x += w * c.x; o[3].y += w * c.y; o[3].z += w * d.x; o[3].w += w * d.y; }
}
__device__ __forceinline__ float swap32_add(float a, float b) { auto r = __builtin_amdgcn_permlane32_swap(__float_as_uint(a), __float_as_uint(b), false, false); return __uint_as_float(r[0]) + __uint_as_float(r[1]); }
__device__ __forceinline__ float swap16_add(float a, float b) { auto r = __builtin_amdgcn_permlane16_swap(__float_as_uint(a), __float_as_uint(b), false, false); return __uint_as_float(r[0]) + __uint_as_float(r[1]); }
__device__ __forceinline__ float row_sum16(float v) { v += dpp_f<0xB1>(v); v += dpp_f<0x4E>(v); v += dpp_f<0x141>(v); v += dpp_f<0x140>(v); return v; }
__device__ __forceinline__ float row_max16(float v) { v = fmaxf(v, dpp_f<0xB1>(v)); v = fmaxf(v, dpp_f<0x4E>(v)); v = fmaxf(v, dpp_f<0x141>(v)); v = fmaxf(v, dpp_f<0x140>(v)); return v; }
constexpr int GB = 32;
typedef __attribute__((address_space(8))) void* rsrc_t;
__device__ __forceinline__ void g_issue(u32x2 (&buf)[GB], __amdgpu_buffer_rsrc_t rs, int idxr, int lb, int voff) {
#pragma unroll
    for (int j = 0; j < GB; ++j) { const int e = __builtin_amdgcn_readlane(idxr, lb + j); buf[j] = __builtin_amdgcn_raw_buffer_load_b64(rs, voff, e * 512, 0); }
}
__device__ __forceinline__ float dot16_fp4p(const u32x2 r, const f32x2 (&xp)[8]) {
    f32x2 a = FP4X2(r.x, 0) * xp[0];
    a += FP4X2(r.x, 1) * xp[1]; a += FP4X2(r.x, 2) * xp[2]; a += FP4X2(r.x, 3) * xp[3];
    a += FP4X2(r.y, 0) * xp[4]; a += FP4X2(r.y, 1) * xp[5]; a += FP4X2(r.y, 2) * xp[6]; a += FP4X2(r.y, 3) * xp[7];
    return a.x + a.y;
}
__device__ __forceinline__ void axpy16_fp4p(const u32x2 r, float w, f32x2 (&o)[8]) {
    const f32x2 ww = (f32x2){w, w};
    o[0] += FP4X2(r.x, 0) * ww; o[1] += FP4X2(r.x, 1) * ww; o[2] += FP4X2(r.x, 2) * ww; o[3] += FP4X2(r.x, 3) * ww;
    o[4] += FP4X2(r.y, 0) * ww; o[5] += FP4X2(r.y, 1) * ww; o[6] += FP4X2(r.y, 2) * ww; o[7] += FP4X2(r.y, 3) * ww;
}
template <int H> __device__ __forceinline__ void g_compute_u(const u32x2 (&buf)[GB], int q, int i16, const f32x2 (&xp)[8], float& zlo, float& zhi) {
    float p[16];
#pragma unroll
    for (int j = 0; j < 16; ++j) p[j] = dot16_fp4p(buf[16 * H + j], xp);
    float s1[8], s2[4];
#pragma unroll
    for (int m = 0; m < 8; ++m) s1[m] = swap32_add(p[2 * m], p[2 * m + 1]);
#pragma unroll
    for (int n = 0; n < 4; ++n) s2[n] = swap16_add(s1[2 * n], s1[2 * n + 1]);
#pragma unroll
    for (int r = 0; r < 4; ++r) { const float z = row_sum16(s2[r]); const bool mine = i16 == ((4 * q + r) & 15);
        zlo = (mine && q < 4) ? z : zlo; zhi = (mine && q >= 4) ? z : zhi; }
}
template <int H> __device__ __forceinline__ void g_compute_v(const u32x2 (&buf)[GB], int q, float alo, float ahi, f32x2 (&o)[8]) {
    const int areg = __builtin_bit_cast(int, (q < 4) ? alo : ahi), sb = 4 * (q & 3);
#pragma unroll
    for (int j = 0; j < 16; ++j) { const int src = 32 * (j & 1) + 16 * ((j >> 1) & 1) + (j >> 2) + sb;
        const float w = __builtin_bit_cast(float, __builtin_amdgcn_readlane(areg, src));
        axpy16_fp4p(buf[16 * H + j], w, o); }
}
__device__ __forceinline__ void q_issue(u32x2 (&buf)[16], __amdgpu_buffer_rsrc_t rs, int ixr  , int lb, int voff) {
#pragma unroll
    for (int j = 0; j < 16; ++j) { const int e9 = __builtin_amdgcn_readlane(ixr, lb + j); buf[j] = __builtin_amdgcn_raw_buffer_load_b64(rs, voff, e9, 0); }
}
__device__ __forceinline__ void q_compute_u(const u32x2 (&buf)[16], int q, int i16, const f32x2 (&xp)[8], float& zlo, float& zhi) {
    float p[16];
#pragma unroll
    for (int j = 0; j < 16; ++j) p[j] = dot16_fp4p(buf[j], xp);
    float s1[8], s2[4];
#pragma unroll
    for (int m = 0; m < 8; ++m) s1[m] = swap32_add(p[2 * m], p[2 * m + 1]);
#pragma unroll
    for (int n = 0; n < 4; ++n) s2[n] = swap16_add(s1[2 * n], s1[2 * n + 1]);
#pragma unroll
    for (int r = 0; r < 4; ++r) { const float z = row_sum16(s2[r]); const bool mine = i16 == ((4 * q + r) & 15);
        zlo = (mine && q < 4) ? z : zlo; zhi = (mine && q >= 4) ? z : zhi; }
}
typedef _Float16 h16x2 __attribute__((ext_vector_type(2)));
#define FP4H2(w, sel) __builtin_amdgcn_cvt_scalef32_pk_f16_fp4((w), 1.0f, (sel))
__device__ __forceinline__ void axpy16_fp4h(const u32x2 r, const h16x2 ww, h16x2 (&o)[8]) {
    o[0] += FP4H2(r.x, 0) * ww; o[1] += FP4H2(r.x, 1) * ww; o[2] += FP4H2(r.x, 2) * ww; o[3] += FP4H2(r.x, 3) * ww;
    o[4] += FP4H2(r.y, 0) * ww; o[5] += FP4H2(r.y, 1) * ww; o[6] += FP4H2(r.y, 2) * ww; o[7] += FP4H2(r.y, 3) * ww;
}
__device__ __forceinline__ void q_compute_vh(const u32x2 (&buf)[16], int q, int alo, int ahi, h16x2 (&o)[8]) {
    const int areg = (q < 4) ? alo : ahi, sb = 4 * (q & 3);
#pragma unroll
    for (int j = 0; j < 16; ++j) { const int src = 32 * (j & 1) + 16 * ((j >> 1) & 1) + (j >> 2) + sb;
        const h16x2 w = __builtin_bit_cast(h16x2, __builtin_amdgcn_readlane(areg, src));
        axpy16_fp4h(buf[j], w, o); }
}
__device__ __forceinline__ void q_compute_v(const u32x2 (&buf)[16], int q, float alo, float ahi, f32x2 (&o)[8]) {
    const int areg = __builtin_bit_cast(int, (q < 4) ? alo : ahi), sb = 4 * (q & 3);
#pragma unroll
    for (int j = 0; j < 16; ++j) { const int src = 32 * (j & 1) + 16 * ((j >> 1) & 1) + (j >> 2) + sb;
        const float w = __builtin_bit_cast(float, __builtin_amdgcn_readlane(areg, src));
        axpy16_fp4p(buf[j], w, o); }
}
__device__ __forceinline__ int swap32_addi(int a, int b) { auto r = __builtin_amdgcn_permlane32_swap((unsigned)a, (unsigned)b, false, false); const unsigned r0 = r[0], r1 = r[1]; return (int)(r0 + r1); }
__device__ __forceinline__ int swap16_addi(int a, int b) { auto r = __builtin_amdgcn_permlane16_swap((unsigned)a, (unsigned)b, false, false); const unsigned r0 = r[0], r1 = r[1]; return (int)(r0 + r1); }
template <int CTRL> __device__ __forceinline__ int dpp_i(int v) { return __builtin_amdgcn_update_dpp(0, v, CTRL, 0xf, 0xf, true); }
__device__ __forceinline__ int row_sum16i(int v) { v += dpp_i<0xB1>(v); v += dpp_i<0x4E>(v); v += dpp_i<0x141>(v); v += dpp_i<0x140>(v); return v; }
__device__ __forceinline__ void q_compute_ui(const u32x2 (&buf)[16], int q, int i16, int xh0, int xh1, int xl0, int xl1, int& zlo, int& zhi) {
    int p[16];
#pragma unroll
    for (int j = 0; j < 16; ++j) { const int d1 = __builtin_amdgcn_sdot8((int)buf[j].x, xh0, __builtin_amdgcn_sdot8((int)buf[j].y, xh1, 0, false), false);
        const int d2 = __builtin_amdgcn_sdot8((int)buf[j].x, xl0, __builtin_amdgcn_sdot8((int)buf[j].y, xl1, 0, false), false);
        p[j] = (d1 << 4) + d2; }
    int s1[8], s2[4];
#pragma unroll
    for (int m = 0; m < 8; ++m) s1[m] = swap32_addi(p[2 * m], p[2 * m + 1]);
#pragma unroll
    for (int n = 0; n < 4; ++n) s2[n] = swap16_addi(s1[2 * n], s1[2 * n + 1]);
#pragma unroll
    for (int r = 0; r < 4; ++r) { const int z = row_sum16i(s2[r]); const bool mine = i16 == ((4 * q + r) & 15);
        zlo = (mine && q < 4) ? z : zlo; zhi = (mine && q >= 4) ? z : zhi; }
}
__device__ __forceinline__ void phase_gather_u(const Params& P) {
    const int tid = threadIdx.x, lane = tid & 63, wave = __builtin_amdgcn_readfirstlane(tid >> 6);
    const int gw = blockIdx.x * NWAVES + wave, NGW = gridDim.x * NWAVES;
    unsigned char* ws = P.ws;
    const int* IDX = (const int*)(ws + WS_IDX); const float* GATE = (const float*)(ws + WS_GATE); const float* ESC = (const float*)(ws + WS_ESCALE); float* AW = (float*)(ws + WS_AW);
    const __amdgpu_buffer_rsrc_t rsU = __builtin_amdgcn_make_buffer_rsrc((void*)(ws + WS_U8), 0, 16384 * 512, 0x00020000);
    const unsigned char* H2I = ws + WS_H0I8; const float* RF = (const float*)(ws + WS_RF);
    const int hh = lane >> 5, rr = (lane >> 4) & 1, i16 = lane & 15, gsel = 4 * i16 + 2 * rr + hh;
    const int voff = 8 * lane;
    const unsigned ul = (unsigned)lane;
    int t = gw;
    if (t < NTOK) {
        int idx0, idx1; unsigned hraw[4]; float sqv;
        { const int* ip = IDX + (size_t)t * NSEL; idx0 = ip[ul]; idx1 = ip[64u + ul];
          const unsigned* hp = (const unsigned*)(H2I + (size_t)t * DM);
#pragma unroll
          for (int j = 0; j < 4; ++j) hraw[j] = hp[64u * j + ul];
          sqv = RF[t]; }
        u32x2 R0[16], R1[16], R2[16], R3[16];
        { const int ix0 = idx0 << 9; q_issue(R0, rsU, ix0, 0, voff); q_issue(R1, rsU, ix0, 16, voff); q_issue(R2, rsU, ix0, 32, voff); }
        for (;;) {
            const int tn = t + NGW; const bool has_next = tn < NTOK; const int tl = has_next ? tn : t;
            int idx0n, idx1n; unsigned hrawn[4]; float sqn, g0, g1;
            { const int* ip = IDX + (size_t)tl * NSEL; idx0n = ip[ul]; idx1n = ip[64u + ul];
              const unsigned* hp = (const unsigned*)(H2I + (size_t)tl * DM);
#pragma unroll
              for (int j = 0; j < 4; ++j) hrawn[j] = hp[64u * j + ul];
              sqn = RF[tl];
              const float* gp = GATE + (size_t)t * NSEL; g0 = gp[ul]; g1 = gp[64u + ul]; }
            const float su0 = ESC[idx0], su1 = ESC[idx1], sv0 = ESC[16384 + idx0], sv1 = ESC[16384 + idx1];
            const float cq0 = ((const float*)(ws + WS_SUMQ))[idx0], cq1 = ((const float*)(ws + WS_SUMQ))[idx1];
            unsigned xh[2] = {0u, 0u}, xl[2] = {0u, 0u};
#pragma unroll
            for (int j = 0; j < 4; ++j) {
                const unsigned lo4 = hraw[j] & 0x0f0f0f0fu, hi4 = (hraw[j] >> 4) & 0x0f0f0f0fu;
                const unsigned tl4 = (lo4 | (lo4 >> 4)) & 0x00ff00ffu, th4 = (hi4 | (hi4 >> 4)) & 0x00ff00ffu;
                const unsigned pl = ((tl4 | (tl4 >> 8)) & 0xffffu) ^ 0x8888u, ph = (th4 | (th4 >> 8)) & 0xffffu;
                xl[j >> 1] |= pl << (16 * (j & 1)); xh[j >> 1] |= ph << (16 * (j & 1)); }
            int zlo = 0, zhi = 0;
            const int ix0 = idx0 << 9, ix1 = idx1 << 9;
#pragma unroll 1
            for (int qq = 0; qq < 8; qq += 4) {
                const int ixn = qq ? (idx0n << 9) : ix1;
                q_issue(R3, rsU, qq ? ix1 : ix0, 48, voff);
                q_compute_ui(R0, qq, i16, (int)xh[0], (int)xh[1], (int)xl[0], (int)xl[1], zlo, zhi);
                q_issue(R0, rsU, ixn, 0, voff);
                q_compute_ui(R1, qq + 1, i16, (int)xh[0], (int)xh[1], (int)xl[0], (int)xl[1], zlo, zhi);
                q_issue(R1, rsU, ixn, 16, voff);
                q_compute_ui(R2, qq + 2, i16, (int)xh[0], (int)xh[1], (int)xl[0], (int)xl[1], zlo, zhi);
                q_issue(R2, rsU, ixn, 32, voff);
                q_compute_ui(R3, qq + 3, i16, (int)xh[0], (int)xh[1], (int)xl[0], (int)xl[1], zlo, zhi);
            }
            const float glo = __shfl(g0, gsel), ghi = __shfl(g1, gsel), sulo = __shfl(su0, gsel), suhi = __shfl(su1, gsel), svlo = __shfl(sv0, gsel), svhi = __shfl(sv1, gsel);
            const float cqlo = __shfl(cq0, gsel), cqhi = __shfl(cq1, gsel);
            const float zfl = ((float)zlo + 8.f * cqlo) * (sulo * sqv), zfh = ((float)zhi + 8.f * cqhi) * (suhi * sqv);
            const float wl = gelu_tanh_f(zfl) * glo * svlo, wh = gelu_tanh_f(zfh) * ghi * svhi;
            const float wmx = fmaxf(wave_max_fast(fmaxf(fabsf(wl), fabsf(wh))), 1e-30f), wsc = 256.f / wmx;
            { const float a = wl * wsc, c = wh * wsc;
              const int ah = __builtin_amdgcn_cvt_pk_fp8_f32(a, a, 0, false) & 255, ch = __builtin_amdgcn_cvt_pk_fp8_f32(c, c, 0, false) & 255;
              const float ar = a - __builtin_amdgcn_cvt_f32_fp8(ah, 0), cr = c - __builtin_amdgcn_cvt_f32_fp8(ch, 0);
              const int al = __builtin_amdgcn_cvt_pk_fp8_f32(ar, ar, 0, false) & 255, cl = __builtin_amdgcn_cvt_pk_fp8_f32(cr, cr, 0, false) & 255;
              unsigned char* ap = (unsigned char*)AW + (size_t)t * 256;
              ap[gsel] = (unsigned char)ah; ap[64 + gsel] = (unsigned char)ch; ap[128 + gsel] = (unsigned char)al; ap[192 + gsel] = (unsigned char)cl;
              if (lane == 0) ((float*)(ws + WS_WMX))[t] = wmx * (1.f / 256.f); }
            if (!has_next) break;
            t = tn; idx0 = idx0n; idx1 = idx1n; sqv = sqn;
#pragma unroll
            for (int j = 0; j < 4; ++j) hraw[j] = hrawn[j];
        }
    }
}
__device__ __forceinline__ void phase_gather_v(const Params& P) {
    const int tid = threadIdx.x, lane = tid & 63, wave = __builtin_amdgcn_readfirstlane(tid >> 6);
    const int gw = blockIdx.x * NWAVES + wave, NGW = gridDim.x * NWAVES;
    unsigned char* ws = P.ws;
    const int* IDX = (const int*)(ws + WS_IDX); const float* AW = (const float*)(ws + WS_AW);
    const __amdgpu_buffer_rsrc_t rsV = __builtin_amdgcn_make_buffer_rsrc((void*)(ws + WS_V8), 0, 16384 * 512, 0x00020000);
    const bf16* H2B = (const bf16*)(ws + WS_H2B);
    const int voff = 8 * lane;
    const unsigned ul = (unsigned)lane;
    int t = gw;
    if (t < NTOK) {
        int idx0, idx1; u32x2 hraw[4]; float alo, ahi;
        { const int* ip = IDX + (size_t)t * NSEL; idx0 = ip[ul]; idx1 = ip[64u + ul];
          const u32x2* hp = (const u32x2*)(H2B + (size_t)t * DM);
#pragma unroll
          for (int j = 0; j < 4; ++j) hraw[j] = hp[64u * j + ul];
          const float* ap = AW + (size_t)t * NSEL; alo = ap[ul]; ahi = ap[64u + ul]; }
        u32x2 R0[16], R1[16], R2[16], R3[16];
        { const int ix0 = idx0 << 9; q_issue(R0, rsV, ix0, 0, voff); q_issue(R1, rsV, ix0, 16, voff); q_issue(R2, rsV, ix0, 32, voff); }
        for (;;) {
            const int tn = t + NGW; const bool has_next = tn < NTOK; const int tl = has_next ? tn : t;
            int idx0n, idx1n; u32x2 hrawn[4]; float alon, ahin;
            { const int* ip = IDX + (size_t)tl * NSEL; idx0n = ip[ul]; idx1n = ip[64u + ul];
              const u32x2* hp = (const u32x2*)(H2B + (size_t)tl * DM);
#pragma unroll
              for (int j = 0; j < 4; ++j) hrawn[j] = hp[64u * j + ul];
              const float* ap = AW + (size_t)tl * NSEL; alon = ap[ul]; ahin = ap[64u + ul]; }
            const float wmx = fmaxf(wave_max_fast(fmaxf(fabsf(alo), fabsf(ahi))), 1e-30f), winv = 1.f / wmx;
            int alh, ahh;
            { const h16x2 a = (h16x2){(_Float16)(alo * winv), (_Float16)(alo * winv)}, b = (h16x2){(_Float16)(ahi * winv), (_Float16)(ahi * winv)};
              alh = __builtin_bit_cast(int, a); ahh = __builtin_bit_cast(int, b); }
            h16x2 oh[8];
#pragma unroll
            for (int j = 0; j < 8; ++j) oh[j] = (h16x2){(_Float16)0.f, (_Float16)0.f};
            const int ix0 = idx0 << 9, ix1 = idx1 << 9;
#pragma unroll 1
            for (int qq = 0; qq < 8; qq += 4) {
                const int ixn = qq ? (idx0n << 9) : ix1;
                q_issue(R3, rsV, qq ? ix1 : ix0, 48, voff);
                q_compute_vh(R0, qq, alh, ahh, oh);
                q_issue(R0, rsV, ixn, 0, voff);
                q_compute_vh(R1, qq + 1, alh, ahh, oh);
                q_issue(R1, rsV, ixn, 16, voff);
                q_compute_vh(R2, qq + 2, alh, ahh, oh);
                q_issue(R2, rsV, ixn, 32, voff);
                q_compute_vh(R3, qq + 3, alh, ahh, oh);
            }
            f32x2 o[8];
#pragma unroll
            for (int j = 0; j < 8; ++j) o[j] = (f32x2){(float)oh[j].x * wmx, (float)oh[j].y * wmx};
            float ss = 0.f;
#pragma unroll
            for (int j = 0; j < 4; ++j) { o[2 * j] += (f32x2){bflo(hraw[j].x), bfhi(hraw[j].x)}; o[2 * j + 1] += (f32x2){bflo(hraw[j].y), bfhi(hraw[j].y)}; }
#pragma unroll
            for (int j = 0; j < 8; ++j) ss += o[j].x * o[j].x + o[j].y * o[j].y;
            ss = wave_sum_fast(ss);
            const float r3 = rsqrtf(ss * (1.f / DM) + EPS);
            f32x4* op = (f32x4*)(P.out + (size_t)t * DM);
            const f32x4* gfp = (const f32x4*)P.g_fin;
#pragma unroll
            for (int j = 0; j < 4; ++j) { const f32x4 gv = gfp[64u * j + ul]; op[64u * j + ul] = (f32x4){o[2 * j].x * r3 * gv.x, o[2 * j].y * r3 * gv.y, o[2 * j + 1].x * r3 * gv.z, o[2 * j + 1].y * r3 * gv.w}; }
            if (!has_next) break;
            t = tn; idx0 = idx0n; idx1 = idx1n; alo = alon; ahi = ahin;
#pragma unroll
            for (int j = 0; j < 4; ++j) hraw[j] = hrawn[j];
        }
    }
}


typedef int i32x2v __attribute__((ext_vector_type(2)));
typedef int i32x8v __attribute__((ext_vector_type(8)));
#define VM_X 9
#define VM_WAIT(n) asm volatile("s_waitcnt vmcnt(" #n ")" ::: "memory")
__device__ __forceinline__ void phase_gather_v_mfma(const Params& P, LAS unsigned char* lds) {
    const int tid = threadIdx.x, lane = tid & 63, wave = __builtin_amdgcn_readfirstlane(tid >> 6);
    unsigned char* ws = P.ws;
    const int* IDX = (const int*)(ws + WS_IDX);
    const unsigned char* V8 = ws + WS_V8; const unsigned char* AW8 = ws + WS_AW; const float* WMX = (const float*)(ws + WS_WMX);
    const unsigned short* H2S = (const unsigned short*)(ws + WS_H2B);
    const int TPB = NTOK / (int)gridDim.x, t0 = blockIdx.x * TPB, NST = TPB * 4;
    const int r0 = 16 * wave + (lane >> 3), r1 = r0 + 8;
    const unsigned c0 = 16u * (unsigned)((lane & 7) ^ ((r0 >> 1) & 7)), c1 = 16u * (unsigned)((lane & 7) ^ ((r1 >> 1) & 7));
    const int i16 = lane & 15, kb = lane >> 4;
    const int ra = 32 * kb + i16, rb = ra + 16;
    const unsigned offa = (unsigned)(ra * 128 + 16 * (wave ^ ((ra >> 1) & 7))), offb = (unsigned)(rb * 128 + 16 * (wave ^ ((rb >> 1) & 7)));
    const unsigned aoffb = (unsigned)(((i16 & 1) ? 128 : 0) + 16 * kb);
    const bool arow = (i16 & 3) < 2;
    const int colb = 256 * kb + 32 * wave + i16;
    LAS float* SS = (LAS float*)(lds + 131072 + 1024);
    LAS float* OUTB = (LAS float*)(lds + 131072 + 2048);
    const f32x4 gfv = *(const f32x4*)(P.g_fin + 256 * (wave & 3) + 4 * lane);
    const unsigned lbase = (unsigned)(unsigned long long)lds;
    struct VTok { u32x4 a, b; float w; unsigned h0, h1; };
    VTok C0, C1;
    int ia1, ib1, ia2, ib2, ia3, ib3;
#define VM_ISSUE(g, e0, e1) do { LAS unsigned char* _d = lds + (((g) & 7) * 16384) + wave * 2048; const unsigned _cb = 128u * (unsigned)((g) & 3); \
        __builtin_amdgcn_global_load_lds((const unsigned*)(V8 + (size_t)(e0) * 512 + _cb + c0), (LAS unsigned*)(_d), 16, 0, 0); \
        __builtin_amdgcn_global_load_lds((const unsigned*)(V8 + (size_t)(e1) * 512 + _cb + c1), (LAS unsigned*)(_d + 1024), 16, 0, 0); } while (0)
    {
        const int ia0 = IDX[(size_t)t0 * NSEL + r0], ib0 = IDX[(size_t)t0 * NSEL + r1];
        ia1 = IDX[(size_t)(t0 + 1) * NSEL + r0]; ib1 = IDX[(size_t)(t0 + 1) * NSEL + r1];
        ia2 = IDX[(size_t)(t0 + 2) * NSEL + r0]; ib2 = IDX[(size_t)(t0 + 2) * NSEL + r1];
        ia3 = IDX[(size_t)(t0 + 3) * NSEL + r0]; ib3 = IDX[(size_t)(t0 + 3) * NSEL + r1];
        const unsigned char* ap = AW8 + (size_t)t0 * 256 + aoffb;
        C0.a = *(const u32x4*)ap; C0.b = *(const u32x4*)(ap + 64); C0.w = WMX[t0]; C0.h0 = H2S[(size_t)t0 * DM + colb]; C0.h1 = H2S[(size_t)t0 * DM + colb + 16];
        C1.a = *(const u32x4*)(ap + 256); C1.b = *(const u32x4*)(ap + 256 + 64); C1.w = WMX[t0 + 1]; C1.h0 = H2S[(size_t)(t0 + 1) * DM + colb]; C1.h1 = H2S[(size_t)(t0 + 1) * DM + colb + 16];
        asm volatile("s_waitcnt vmcnt(0)" ::: "memory");
        VM_ISSUE(0, ia0, ib0); VM_ISSUE(1, ia0, ib0); VM_ISSUE(2, ia0, ib0); VM_ISSUE(3, ia0, ib0);
        VM_ISSUE(4, ia1, ib1); VM_ISSUE(5, ia1, ib1); VM_ISSUE(6, ia1, ib1);
    }
    float pv0 = 0.f, pv1 = 0.f;
    VTok N0, N1; int na4, nb4, na5, nb5;
    auto token = [&](const int i, const bool even, const VTok& C, const int e1a, const int e1b, const int e2a, const int e2b) __attribute__((always_inline)) {
        const int t = t0 + i;
        const u32x4 z = (u32x4){0u, 0u, 0u, 0u}; const u32x4 Alo = arow ? C.a : z, Ahi = arow ? C.b : z;
        const i32x8v A = (i32x8v){(int)Alo.x, (int)Alo.y, (int)Alo.z, (int)Alo.w, (int)Ahi.x, (int)Ahi.y, (int)Ahi.z, (int)Ahi.w};
        f32x4 acc[4][2];
#pragma unroll
        for (int cc = 0; cc < 4; ++cc) {
            const int g = 4 * i + cc;
            if (even && cc == 0) { VM_WAIT(12); } else { VM_WAIT(26); }
            asm volatile("s_waitcnt lgkmcnt(0)" ::: "memory");
            __builtin_amdgcn_s_barrier();
            __builtin_amdgcn_sched_barrier(0);
            const unsigned sa = lbase + (unsigned)((g & 7) * 16384) + offa, sbb = lbase + (unsigned)((g & 7) * 16384) + offb;
            i32x2v b00, b01, b10, b11;
            asm volatile("ds_read_b64_tr_b4 %0, %4\n\tds_read_b64_tr_b4 %1, %5\n\tds_read_b64_tr_b4 %2, %4 offset:8\n\tds_read_b64_tr_b4 %3, %5 offset:8"
                         : "=&v"(b00), "=&v"(b01), "=&v"(b10), "=&v"(b11) : "v"(sa), "v"(sbb) : "memory");
            { const int gn = g + 7;
              if (cc == 0) VM_ISSUE(gn, e1a, e1b); else VM_ISSUE(gn, e2a, e2b); }
            __builtin_amdgcn_sched_barrier(0);
            if (cc == 0) {
                if (even) {
                    const int tA = t0 + ((i + 2 < TPB) ? i + 2 : TPB - 2), tI = t0 + ((i + 4 < TPB) ? i + 4 : TPB - 2);
                    const unsigned char* ap = AW8 + (size_t)tA * 256 + aoffb; const float* wp = WMX + tA; const int* ipa = IDX + (size_t)tI * NSEL + r0; const unsigned short* hp = H2S + (size_t)tA * DM + colb;
                    asm volatile("global_load_dwordx4 %0, %14, off\n\tglobal_load_dwordx4 %1, %14, off offset:64\n\tglobal_load_dwordx4 %2, %14, off offset:256\n\tglobal_load_dwordx4 %3, %14, off offset:320\n\t"
                                 "global_load_dword %4, %15, off\n\tglobal_load_dword %5, %15, off offset:4\n\t"
                                 "global_load_ushort %6, %17, off\n\tglobal_load_ushort %7, %17, off offset:32\n\tglobal_load_ushort %8, %17, off offset:2048\n\tglobal_load_ushort %9, %17, off offset:2080\n\t"
                                 "global_load_dword %10, %16, off\n\tglobal_load_dword %11, %16, off offset:32\n\tglobal_load_dword %12, %16, off offset:512\n\tglobal_load_dword %13, %16, off offset:544"
                                 : "=&v"(N0.a), "=&v"(N0.b), "=&v"(N1.a), "=&v"(N1.b), "=&v"(N0.w), "=&v"(N1.w), "=&v"(N0.h0), "=&v"(N0.h1), "=&v"(N1.h0), "=&v"(N1.h1), "=&v"(na4), "=&v"(nb4), "=&v"(na5), "=&v"(nb5)
                                 : "v"(ap), "v"(wp), "v"(ipa), "v"(hp) : "memory");
                }
                { const f32x4 s0 = *(const LAS f32x4*)(SS + 8 * ((i + 1) & 1)), s1 = *(const LAS f32x4*)(SS + 8 * ((i + 1) & 1) + 4);
                  const float ss = ((s0.x + s0.y) + (s0.z + s0.w)) + ((s1.x + s1.y) + (s1.z + s1.w));
                  const float r3 = rsqrtf(ss * (1.f / DM) + EPS);
                  if (i > 0 && (wave >> 2) == ((i + 1) & 1)) {
                      const f32x4 v = *(const LAS f32x4*)(OUTB + 1024 * ((i + 1) & 1) + 256 * (wave & 3) + 4 * lane);
                      *(f32x4*)(P.out + (size_t)(t - 1) * DM + 256 * (wave & 3) + 4 * lane) = (f32x4){v.x * r3 * gfv.x, v.y * r3 * gfv.y, v.z * r3 * gfv.z, v.w * r3 * gfv.w}; } }
                __builtin_amdgcn_sched_barrier(0);
            }
            asm volatile("s_waitcnt lgkmcnt(0)" : "+v"(b00), "+v"(b01), "+v"(b10), "+v"(b11) :: "memory");
            const i32x8v B0 = (i32x8v){b00.x, b00.y, b01.x, b01.y, 0, 0, 0, 0}, B1 = (i32x8v){b10.x, b10.y, b11.x, b11.y, 0, 0, 0, 0};
            const f32x4 z4 = (f32x4){0.f, 0.f, 0.f, 0.f};
            acc[cc][0] = __builtin_amdgcn_mfma_scale_f32_16x16x128_f8f6f4(A, B0, z4, 0  , 4  , 0, 0x7f7f7f7f, 0, 0x7f7f7f7f);
            acc[cc][1] = __builtin_amdgcn_mfma_scale_f32_16x16x128_f8f6f4(A, B1, z4, 0, 4, 0, 0x7f7f7f7f, 0, 0x7f7f7f7f);
        }
#pragma unroll
        for (int c = 0; c < 4; ++c) asm volatile("" :: "v"(acc[c][0]), "v"(acc[c][1]));
        float s0 = acc[0][0].x + acc[0][0].y, s1 = acc[0][1].x + acc[0][1].y;
        { const float a0 = acc[1][0].x + acc[1][0].y, a1 = acc[1][1].x + acc[1][1].y, b0 = acc[2][0].x + acc[2][0].y, b1 = acc[2][1].x + acc[2][1].y, d0 = acc[3][0].x + acc[3][0].y, d1 = acc[3][1].x + acc[3][1].y;
          s0 = (kb == 1) ? a0 : s0; s1 = (kb == 1) ? a1 : s1; s0 = (kb == 2) ? b0 : s0; s1 = (kb == 2) ? b1 : s1; s0 = (kb == 3) ? d0 : s0; s1 = (kb == 3) ? d1 : s1; }
        pv0 = s0 * C.w + __uint_as_float(C.h0 << 16); pv1 = s1 * C.w + __uint_as_float(C.h1 << 16);
        OUTB[1024 * (i & 1) + colb] = pv0; OUTB[1024 * (i & 1) + colb + 16] = pv1;
        const float sq = wave_sum_fast(pv0 * pv0 + pv1 * pv1);
        if (lane == 0) SS[8 * (i & 1) + wave] = sq;
    };
#pragma unroll 1
    for (int i = 0; i < TPB; i += 2) {
        token(i, true, C0, ia1, ib1, ia2, ib2);
        token(i + 1, false, C1, ia2, ib2, ia3, ib3);
        asm volatile("s_waitcnt vmcnt(14)" : "+v"(N0.a), "+v"(N0.b), "+v"(N1.a), "+v"(N1.b), "+v"(N0.w), "+v"(N1.w), "+v"(N0.h0), "+v"(N0.h1), "+v"(N1.h0), "+v"(N1.h1), "+v"(na4), "+v"(nb4), "+v"(na5), "+v"(nb5) :: "memory");
        C0 = N0; C1 = N1; ia1 = ia3; ib1 = ib3; ia2 = na4; ib2 = nb4; ia3 = na5; ib3 = nb5;
    }
    asm volatile("s_waitcnt vmcnt(0)" ::: "memory");
    __builtin_amdgcn_s_barrier();
    { const int i = TPB; const f32x4 s0 = *(const LAS f32x4*)(SS + 8 * ((i + 1) & 1)), s1 = *(const LAS f32x4*)(SS + 8 * ((i + 1) & 1) + 4);
      const float ss = ((s0.x + s0.y) + (s0.z + s0.w)) + ((s1.x + s1.y) + (s1.z + s1.w));
      const float r3 = rsqrtf(ss * (1.f / DM) + EPS);
      if ((wave >> 2) == ((i + 1) & 1)) {
          const f32x4 v = *(const LAS f32x4*)(OUTB + 1024 * ((i + 1) & 1) + 256 * (wave & 3) + 4 * lane);
          *(f32x4*)(P.out + (size_t)(t0 + TPB - 1) * DM + 256 * (wave & 3) + 4 * lane) = (f32x4){v.x * r3 * gfv.x, v.y * r3 * gfv.y, v.z * r3 * gfv.z, v.w * r3 * gfv.w}; } }
#undef VM_ISSUE
}

__device__ __forceinline__ void phase_quant_h2(const Params& P) {
    const int tid = threadIdx.x, lane = tid & 63, wave = __builtin_amdgcn_readfirstlane(tid >> 6);
    const int gw = blockIdx.x * NWAVES + wave, NGW = gridDim.x * NWAVES;
    unsigned char* ws = P.ws;
    const float* SSQ = (const float*)(ws + WS_SSQ); const float* AMX = (const float*)(ws + WS_AMX); float* RF = (float*)(ws + WS_RF);
    TabRow tb0, tb1, tb2;
    if (gw < NTOK) tab_load(P, gw, lane, tb0);
    if (gw + NGW < NTOK) tab_load(P, gw + NGW, lane, tb1);
    int it3 = 0;
    for (int row = gw; row < NTOK; row += NGW, it3 = (it3 == 2) ? 0 : it3 + 1) {
        { const int e2 = row + 2 * NGW;
          if (e2 < NTOK) { if (it3 == 0) tab_load(P, e2, lane, tb2); else if (it3 == 1) tab_load(P, e2, lane, tb0); else tab_load(P, e2, lane, tb1); } }
        const u32x4* hp = (const u32x4*)(ws + WS_H2B + (size_t)row * DM * 2) + 2 * lane;
        const u32x4 a = hp[0], b = hp[1];
        const float am = fmaxf(row_max16(AMX[(size_t)row * 16 + (lane & 15)]), 1e-30f) * 1.0078125f;
        const float rstd2 = rsqrtf(row_sum16(SSQ[(size_t)row * 16 + (lane & 15)]) * (1.f / DM) + EPS);
        const float inv = 127.f / am;
        const unsigned w[8] = {a.x, a.y, a.z, a.w, b.x, b.y, b.z, b.w};
        unsigned o[4];
#pragma unroll
        for (int j = 0; j < 4; ++j) {
            const int q0 = (int)rintf(__uint_as_float(w[2 * j] << 16) * inv), q1 = (int)rintf(__uint_as_float(w[2 * j] & 0xffff0000u) * inv);
            const int q2 = (int)rintf(__uint_as_float(w[2 * j + 1] << 16) * inv), q3 = (int)rintf(__uint_as_float(w[2 * j + 1] & 0xffff0000u) * inv);
            o[j] = ((unsigned)q0 & 255u) | (((unsigned)q1 & 255u) << 8) | (((unsigned)q2 & 255u) << 16) | ((unsigned)q3 << 24); }
        u32x4 ov; ov.x = o[0]; ov.y = o[1]; ov.z = o[2]; ov.w = o[3];
        *((u32x4*)(ws + WS_H0I8 + (size_t)row * DM) + lane) = ov;
        if (lane == 0) RF[row] = am * (1.f / 127.f) * rstd2;
        if (it3 == 0) tab_finish(P, row, lane, tb0); else if (it3 == 1) tab_finish(P, row, lane, tb1); else tab_finish(P, row, lane, tb2);
    }
}
struct EpiQI8 {
    static constexpr bool PERM = true, AFTER_DRAIN = false;
    bf16* O; int ldc; const float* rf; const float* sw;
    __device__ __forceinline__ void operator()(const pg8::i32x4 (&acc)[2][2][4][2], const pg8::Unit& u, int wr, int wc, int fr, int fq) const {
        const int row0 = u.pm * 256 + wr * 64 + fr, col0 = u.pn * 256 + wc * 32 + 8 * fq;
        f32x4 swv[2][2];
#pragma unroll
        for (int bj = 0; bj < 2; ++bj) { swv[bj][0] = *(const f32x4*)(sw + col0 + bj * 128); swv[bj][1] = *(const f32x4*)(sw + col0 + bj * 128 + 4); }
#pragma unroll
        for (int ai = 0; ai < 2; ++ai)
#pragma unroll
            for (int m = 0; m < 4; ++m) {
                const int row = row0 + ai * 128 + m * 16;
                const float s = rf[row];
                bf16* rowp = O + (size_t)row * ldc + col0;
#pragma unroll
                for (int bj = 0; bj < 2; ++bj) { const pg8::i32x4 a0 = acc[ai][bj][m][0], a1 = acc[ai][bj][m][1];
                    const f32x4 v0 = (f32x4){(float)a0[0], (float)a0[1], (float)a0[2], (float)a0[3]} * (swv[bj][0] * s), v1 = (f32x4){(float)a1[0], (float)a1[1], (float)a1[2], (float)a1[3]} * (swv[bj][1] * s);
                    u32x4 w; w.x = cvt_pk_bf16(v0[0], v0[1]); w.y = cvt_pk_bf16(v0[2], v0[3]); w.z = cvt_pk_bf16(v1[0], v1[1]); w.w = cvt_pk_bf16(v1[2], v1[3]);
                    *(u32x4*)(rowp + bj * 128) = w; }
            }
    }
};
#define XB_TMO      128
#define XB_XCNT(j)  (256  + 64 * (j))
#define XB_XSUB(j)  (1280 + 64 * (j))
#define XB_XGEN(j)  (2304 + 64 * (j))
#define XB_TOP      3328
#define XB_TOPGEN   3392
#define XCD_BAR_WORDS 3456
#define XB_SPIN_CAP (1u << 18)

__device__ __forceinline__ unsigned xb_ld(unsigned* p)              { return __hip_atomic_load(p, __ATOMIC_RELAXED, __HIP_MEMORY_SCOPE_AGENT); }
__device__ __forceinline__ unsigned xb_add(unsigned* p, unsigned v) { return __hip_atomic_fetch_add(p, v, __ATOMIC_RELAXED, __HIP_MEMORY_SCOPE_AGENT); }
__device__ __forceinline__ unsigned xb_xcc_id() { return (unsigned)__builtin_amdgcn_s_getreg((3 << 11) | 20) & 0xFu; }
#define XB_SPIN(cond, bar) do { unsigned _sp = 0; while (cond) { __builtin_amdgcn_s_sleep(1); \
    if ((++_sp & 255u) == 0u) { if (xb_ld(&(bar)[XB_TMO])) break; if (_sp > XB_SPIN_CAP) { atomicAdd(&(bar)[XB_TMO], 1u); break; } } } } while (0)

struct XcdBarrier {
    unsigned* bar; unsigned x;
    volatile LAS unsigned* st;
};

__device__ __forceinline__ XcdBarrier xcd_barrier_post(unsigned* bar, volatile LAS unsigned* st) {
    XcdBarrier b; b.bar = bar; b.x = xb_xcc_id(); b.st = st;
    if (threadIdx.x == 0) (void)xb_add(&bar[XB_XCNT(b.x)], 1u);
    return b;
}
__device__ __forceinline__ void xcd_barrier_complete(unsigned* bar, unsigned x, unsigned& nloc, unsigned& nx) {
    const unsigned G = gridDim.x * gridDim.y * gridDim.z;
    unsigned sum, cnt, mine, sp = 0u;
    for (;;) {
        sum = 0u; cnt = 0u; mine = 0u;
#pragma unroll
        for (unsigned j = 0; j < 16; ++j) { const unsigned c = xb_ld(&bar[XB_XCNT(j)]); sum += c; cnt += (c > 0u) ? 1u : 0u; mine = (j == x) ? c : mine; }
        if (sum == G) break;
        __builtin_amdgcn_s_sleep(1);
        if ((++sp & 255u) == 0u) { if (xb_ld(&bar[XB_TMO])) break; if (sp > XB_SPIN_CAP) { atomicAdd(&bar[XB_TMO], 1u); break; } }
    }
    nloc = mine > 0u ? mine : 1u; nx = cnt > 0u ? cnt : 1u;
}

__device__ __forceinline__ void xcd_barrier(const XcdBarrier& b) {
    asm volatile("s_waitcnt vmcnt(0)" ::: "memory");
    __syncthreads();
    if (threadIdx.x == 0) {
        unsigned* bar = b.bar;
        __builtin_amdgcn_s_waitcnt(0);
        unsigned nloc = b.st[0], nx = b.st[1];
        if (nloc == 0u) { xcd_barrier_complete(bar, b.x, nloc, nx); b.st[0] = nloc; b.st[1] = nx; }
        const unsigned old = xb_add(&bar[XB_XSUB(b.x)], 1u);
        const unsigned gen = old / nloc;
        if (old + 1u == (gen + 1u) * nloc) {
            __builtin_amdgcn_fence(__ATOMIC_RELEASE, "agent");
            asm volatile("s_waitcnt vmcnt(0)" ::: "memory");
            const unsigned og = xb_add(&bar[XB_TOP], 1u);
            const unsigned tg = og / nx;
            if (og + 1u == (tg + 1u) * nx) xb_add(&bar[XB_TOPGEN], 1u);
            else XB_SPIN(xb_ld(&bar[XB_TOPGEN]) == tg, bar);
            __builtin_amdgcn_fence(__ATOMIC_ACQUIRE, "agent");
            xb_add(&bar[XB_XGEN(b.x)], 1u);
            asm volatile("s_waitcnt vmcnt(0)" ::: "memory");
        } else {
            XB_SPIN(xb_ld(&bar[XB_XGEN(b.x)]) == gen, bar);
            __builtin_amdgcn_fence(__ATOMIC_ACQUIRE, "agent");
            asm volatile("s_waitcnt vmcnt(0)" ::: "memory");
        }
    }
    __syncthreads();
}


#ifndef MK_MULTI
#define MK_MULTI 0
#endif
constexpr int NPHASE = 10;
#ifndef REP5
#define REP5 1
#endif
#ifndef REP6
#define REP6 1
#endif
__global__ void __launch_bounds__(NTHREADS, 2) mk_fwd(Params P) {
    extern __shared__ __attribute__((aligned(16))) unsigned char lds_raw[];
    LAS unsigned char* lds = (LAS unsigned char*)lds_raw;
    cg::grid_group grid = cg::this_grid();
    unsigned char* ws = P.ws;
    const int lo = P.ph_lo, hi = P.ph_hi;
    volatile LAS unsigned* bst = (volatile LAS unsigned*)(lds + 131072 + 64);
    if (threadIdx.x < 2) bst[threadIdx.x] = 0u;
    __syncthreads();
    XcdBarrier xbar = xcd_barrier_post((unsigned*)(ws + WS_CTL), bst);
#define IN(k) (lo <= (k) && (k) < hi)
#define SEAM(k) do { if (IN(k) && IN((k) + 1)) { xcd_barrier(xbar); } } while (0)
    if (IN(0)) phase_prep(P, lds);
    if (IN(0) && IN(1)) { }
    SEAM(1);
    if (IN(2)) {
        pg8::Gemm g{(const bf16*)(ws + WS_H0I8), (const bf16*)(ws + WS_WIN_T), NTOK, DIN, DM / 2}; pg8::StaticOrder S; S.init(NTOK, DIN, (int)gridDim.x, (int)blockIdx.x);
        EpiProjI8 E{(bf16*)(ws + WS_PROJ), (const float*)(ws + WS_RSTD1), (const float*)(ws + WS_SW)};
        pg8::gemm_phase_i8<EpiProjI8, pg8::StaticOrder, true, true>(lds, g, S, E);
    }
    SEAM(2);
    if (IN(3)) phase_conv(P, lds);
    SEAM(3);
    if (IN(4)) {
        pg8::Gemm g{(const bf16*)(ws + WS_Y), (const bf16*)(ws + WS_WOUT_T), NTOK, DM, DM / 2}; pg8::StaticOrder S; S.init(NTOK, DM, (int)gridDim.x, (int)blockIdx.x);
        EpiResidualI8 E{(bf16*)(ws + WS_H2B), (const signed char*)(ws + WS_H0I8), (const float*)(ws + WS_SX), (const float*)(ws + WS_SY), (const float*)(ws + WS_SWO), (float*)(ws + WS_SSQ), (float*)(ws + WS_AMX)};
        pg8::gemm_phase_i8<EpiResidualI8, pg8::StaticOrder, true, true>(lds, g, S, E);
    }
    SEAM(4);
    if (IN(5)) phase_quant_h2(P);
    SEAM(5);
    if (IN(6)) {
        pg8::Gemm g{(const bf16*)(ws + WS_H0I8), (const bf16*)(ws + WS_WQ_T), NTOK, 2048, DM / 2}; pg8::StaticOrder S; S.init(NTOK, 2048, (int)gridDim.x, (int)blockIdx.x);
        EpiQI8 E{(bf16*)(ws + WS_Q), 2048, (const float*)(ws + WS_RF), (const float*)(ws + WS_SWQ)};
        pg8::gemm_phase_i8<EpiQI8, pg8::StaticOrder, true, true>(lds, g, S, E);
    }
    if (IN(6) && IN(7)) { asm volatile("s_waitcnt vmcnt(0)" ::: "memory"); __syncthreads(); }
    if (IN(7)) phase_route(P, lds);
    SEAM(7);
    if (IN(8)) phase_gather_u(P);
    SEAM(8);
    if (IN(9)) phase_gather_v_mfma(P, lds);
#undef IN
#undef SEAM
}

extern "C" void kernel_launch(void* const* d_in, const int* in_sizes, int n_in, void* d_out, int out_size, void* d_ws, size_t ws_size, hipStream_t stream) {
    static int grid = 0;
    if (grid == 0) {
        if (n_in != 18 || in_sizes[0] != NTOK * DM || out_size != NTOK * DM || ws_size < WS_END) {
            fprintf(stderr, "kernel_launch: unexpected shapes (n_in %d in0 %d out %d ws %zu)\n", n_in, n_in > 0 ? in_sizes[0] : -1, out_size, ws_size); grid = -1; return; }
        int dev = 0, cus = 0, per_cu = 0;
        (void)hipGetDevice(&dev); (void)hipDeviceGetAttribute(&cus, hipDeviceAttributeMultiprocessorCount, dev);
        if (hipFuncSetAttribute((const void*)mk_fwd, hipFuncAttributeMaxDynamicSharedMemorySize, LDS_BYTES) != hipSuccess) { fprintf(stderr, "kernel_launch: hipFuncSetAttribute failed\n"); grid = -1; return; }
        if (hipOccupancyMaxActiveBlocksPerMultiprocessor(&per_cu, (const void*)mk_fwd, NTHREADS, LDS_BYTES) != hipSuccess || per_cu < 1) { fprintf(stderr, "kernel_launch: occupancy query failed (%d)\n", per_cu); (void)hipGetLastError(); per_cu = 1; }
        if (per_cu > 1) per_cu = 1;
        grid = cus * per_cu;
        if (grid <= 0) grid = 256;
    }
    if (grid < 0) return;
    Params p{};
    p.x = (const float*)d_in[0]; p.meta = (const float*)d_in[1]; p.g_mix = (const float*)d_in[2]; p.w_in = (const float*)d_in[3]; p.sc_w = (const float*)d_in[4];
    p.cf_w = (const float*)d_in[5]; p.cf_b = (const float*)d_in[6]; p.ln_g = (const float*)d_in[7]; p.ln_b = (const float*)d_in[8]; p.g_sc = (const float*)d_in[9];
    p.g_cf = (const float*)d_in[10]; p.w_out = (const float*)d_in[11]; p.g_ffn = (const float*)d_in[12]; p.w_q = (const float*)d_in[13]; p.keys = (const float*)d_in[14];
    p.pu = (const float*)d_in[15]; p.pv = (const float*)d_in[16]; p.g_fin = (const float*)d_in[17];
    p.out = (float*)d_out; p.ws = (unsigned char*)d_ws;
    (void)hipMemsetAsync((char*)d_ws + WS_CTL, 0, 65536 + 16 * 2560 * 4, stream);
#if MK_MULTI
    for (int ph = 0; ph < NPHASE; ++ph) { p.ph_lo = ph; p.ph_hi = ph + 1; p.coop = 0; p.pad = 0;
        hipLaunchKernelGGL(mk_fwd, dim3(grid), dim3(NTHREADS), LDS_BYTES, stream, p); }
#else
    p.ph_lo = 0; p.ph_hi = NPHASE; p.coop = 1; p.pad = 0;
    void* args[] = {&p};
    hipError_t e = hipLaunchCooperativeKernel((const void*)mk_fwd, dim3(grid), dim3(NTHREADS), args, LDS_BYTES, stream);
    if (e != hipSuccess) fprintf(stderr, "cooperative launch failed: %s (grid %d)\n", hipGetErrorString(e), grid);
#endif
}
```

```cpp
#include <hip/hip_runtime.h>
#include <hip/hip_cooperative_groups.h>
#include <cstdio>
#include <cstdint>
namespace cg = cooperative_groups;

namespace pg8 {
#define PG8_LAS __attribute__((address_space(3)))
typedef unsigned short bf16_t;
typedef short bf16x8 __attribute__((ext_vector_type(8)));
typedef float f32x4 __attribute__((ext_vector_type(4)));
typedef unsigned u32x4 __attribute__((ext_vector_type(4)));
typedef int i32x4 __attribute__((ext_vector_type(4)));
constexpr int BM = 256, BK = 64, HALF = 128, HTB = HALF * BK * 2  , STAGE_BYTES = 8 * HTB, NXCD = 8, WGM = 8;

__host__ __device__ __forceinline__ int lds_byte(int r, int c) { const int st = (r >> 4) * 2 + (c >> 5), rr = r & 15, cc = c & 31, ob = rr * 64 + cc * 2; return st * 1024 + (ob ^ (((ob >> 9) & 1) << 5)); }
__host__ __device__ __forceinline__ void stage_rc(int b, int& R, int& C) { const int st = b / 1024, sb = b % 1024, swz = sb ^ (((sb >> 9) & 1) << 5); R = (st >> 1) * 16 + swz / 64; C = (st & 1) * 32 + (swz % 64) / 2; }
__host__ __device__ __forceinline__ int perm32(int rho) { const int n = rho >> 4, i = rho & 15; return 8 * (i >> 2) + 4 * n + (i & 3); }

struct Unit { int pm, pn; };
struct Gemm { const bf16_t* A; const bf16_t* Bt; int M, N, K; };

struct StaticOrder {
    int nM, nN, nwg, G, c;
    __host__ __device__ void init(int M, int N, int G_, int c_) { nM = M / BM; nN = N / BM; nwg = nM * nN; G = G_; c = c_; }
    __host__ __device__ bool next(int i, Unit& u) const {
        const long L = (long)i * G + c; if (L >= nwg) return false;
        int wgid = (int)L; { const int q = nwg / NXCD, r = nwg % NXCD, xcd = wgid % NXCD, off = wgid / NXCD; wgid = (xcd < r ? xcd * (q + 1) : r * (q + 1) + (xcd - r) * q) + off; }
        const int nig = WGM * nN, gid = wgid / nig, fm = gid * WGM, gsz = (nM - fm) < WGM ? (nM - fm) : WGM;
        u.pm = fm + ((wgid % nig) % gsz); u.pn = (wgid % nig) / gsz; return true;
    }
    __device__ __forceinline__ void a_ready(const Unit&) const {}
    __device__ __forceinline__ void done(const Unit&) const {}
};

template <class Epi, class Sched, bool ALIGN_EPI = false, bool SP2 = false>
__device__ __forceinline__ void gemm_phase(PG8_LAS unsigned char* lds, const Gemm g, const Sched& S, const Epi& E) {
    const int tid = threadIdx.x, wid = __builtin_amdgcn_readfirstlane(tid >> 6), lane = tid & 63, wr = wid >> 2, wc = wid & 3, fr = lane & 15, fq = lane >> 4;
    const int K = g.K, nt = K / BK;
    unsigned voffA[2], voffB[2];
#pragma unroll
    for (int i = 0; i < 2; ++i) { int R, C; stage_rc(tid * 16 + i * 8192, R, C); const int Rb = Epi::PERM ? ((R & ~31) + perm32(R & 31)) : R;
        voffA[i] = (unsigned)(R * K + C) * 2u; voffB[i] = (unsigned)(Rb * K + C) * 2u; }
    const size_t kstep = (size_t)(BK * 2);
    const size_t hstep = (size_t)HALF * K * 2;
    const size_t tstep = 2 * hstep;
    const unsigned ldsw = (unsigned)wid * 1024u;
    const int aoff = lds_byte(wr * 64 + fr, fq * 8), boff = lds_byte(wc * 32 + fr, fq * 8);
#define PG8_SA(b, h) (((b) * 2 + (h)) * HTB)
#define PG8_SB(b, h) ((4 + (b) * 2 + (h)) * HTB)
#define PG8_STAGE(bufoff, gbase, voff) do { _Pragma("unroll") for (int _i = 0; _i < 2; ++_i) \
        __builtin_amdgcn_global_load_lds((const unsigned*)((const char*)(gbase) + (voff)[_i]), (PG8_LAS unsigned*)(lds + (bufoff) + ldsw + _i * 8192), 16, 0, 0); } while (0)
#define PG8_LDA(dst, b, h) do { _Pragma("unroll") for (int m = 0; m < 4; ++m) _Pragma("unroll") for (int k = 0; k < 2; ++k) dst[m][k] = *(const PG8_LAS bf16x8*)(lds + PG8_SA(b, h) + aoff + m * 2048 + k * 1024); } while (0)
#define PG8_LDB(dst, b, h) do { _Pragma("unroll") for (int n = 0; n < 2; ++n) _Pragma("unroll") for (int k = 0; k < 2; ++k) dst[n][k] = *(const PG8_LAS bf16x8*)(lds + PG8_SB(b, h) + boff + n * 2048 + k * 1024); } while (0)
#define PG8_MMA(ai, bj, At, Bt) do { __builtin_amdgcn_s_setprio(1); _Pragma("unroll") for (int m = 0; m < 4; ++m) _Pragma("unroll") for (int n = 0; n < 2; ++n) _Pragma("unroll") for (int k = 0; k < 2; ++k) \
        acc[ai][bj][m][n] = __builtin_amdgcn_mfma_f32_16x16x32_bf16(Bt[n][k], At[m][k], acc[ai][bj][m][n], 0, 0, 0); __builtin_amdgcn_s_setprio(0); } while (0)
#define PG8_WAIT_V(n) asm volatile("s_waitcnt vmcnt(" #n ")" ::: "memory")
#define PG8_WAIT_L(n) asm volatile("s_waitcnt lgkmcnt(" #n ")" ::: "memory")
#define PG8_BAR __builtin_amdgcn_s_barrier()
#define PG8_SCHED __builtin_amdgcn_sched_barrier(0)
    Unit cur, nxt; int ui = 0;
    if (!S.next(0, cur)) return;
    f32x4 acc[2][2][4][2];
#pragma unroll
    for (int a = 0; a < 2; ++a)
#pragma unroll
        for (int b = 0; b < 2; ++b)
#pragma unroll
            for (int m = 0; m < 4; ++m)
#pragma unroll
                for (int n = 0; n < 2; ++n) acc[a][b][m][n] = (f32x4){0.f, 0.f, 0.f, 0.f};
    bf16x8 At[4][2], B0[2][2], B1[2][2];
    const char* cA = (const char*)g.A + (size_t)cur.pm * tstep; const char* cB = (const char*)g.Bt + (size_t)cur.pn * tstep;
    S.a_ready(cur);
    if constexpr (SP2) {
        PG8_STAGE(PG8_SB(0, 0), cB, voffB); PG8_STAGE(PG8_SB(0, 1), cB + hstep, voffB); PG8_STAGE(PG8_SA(0, 0), cA, voffA); PG8_STAGE(PG8_SA(0, 1), cA + hstep, voffA);
        if (wr == 1) PG8_BAR;
        PG8_WAIT_V(2); PG8_BAR;
        PG8_STAGE(PG8_SB(1, 0), cB + kstep, voffB); PG8_STAGE(PG8_SA(1, 0), cA + kstep, voffA); PG8_STAGE(PG8_SB(1, 1), cB + hstep + kstep, voffB);
        PG8_WAIT_V(6); PG8_BAR;
    } else {
        PG8_STAGE(PG8_SB(0, 0), cB, voffB); PG8_STAGE(PG8_SA(0, 0), cA, voffA); PG8_STAGE(PG8_SB(0, 1), cB + hstep, voffB); PG8_STAGE(PG8_SA(0, 1), cA + hstep, voffA);
        if (wr == 1) PG8_BAR;
        PG8_WAIT_V(4); PG8_BAR;
        PG8_STAGE(PG8_SB(1, 0), cB + kstep, voffB); PG8_STAGE(PG8_SA(1, 0), cA + kstep, voffA); PG8_STAGE(PG8_SB(1, 1), cB + hstep + kstep, voffB);
        PG8_WAIT_V(6); PG8_BAR;
    }
    for (;;) {
        const bool has_next = S.next(ui + 1, nxt);
        const char* nA = has_next ? (const char*)g.A + (size_t)nxt.pm * tstep : cA; const char* nB = has_next ? (const char*)g.Bt + (size_t)nxt.pn * tstep : cB;
        for (int t = 0; t < nt; t += 2) {
            const bool last = (t == nt - 2);
            const char* a1 = cA + (size_t)(t + 1) * kstep;
            const char* a2 = last ? nA : cA + (size_t)(t + 2) * kstep; const char* b2 = last ? nB : cB + (size_t)(t + 2) * kstep;
            const char* a3 = a2 + kstep; const char* b3 = b2 + kstep;
            if (last && has_next) S.a_ready(nxt);
            if constexpr (SP2) {
            PG8_LDB(B0, 0, 0); PG8_LDB(B1, 0, 1); PG8_SCHED; PG8_LDA(At, 0, 0); PG8_STAGE(PG8_SA(1, 1), a1 + hstep, voffA);
            PG8_WAIT_V(8); PG8_WAIT_L(0); PG8_BAR; PG8_MMA(0, 0, At, B0); PG8_MMA(0, 1, At, B1); PG8_BAR; PG8_SCHED;
            PG8_LDA(At, 0, 1); PG8_STAGE(PG8_SB(0, 0), b2, voffB); PG8_STAGE(PG8_SB(0, 1), b2 + hstep, voffB); PG8_STAGE(PG8_SA(0, 0), a2, voffA);
            PG8_WAIT_V(8); PG8_WAIT_L(0); PG8_BAR; PG8_MMA(1, 0, At, B0); PG8_MMA(1, 1, At, B1); PG8_BAR; PG8_SCHED;
            PG8_LDB(B0, 1, 0); PG8_LDB(B1, 1, 1); PG8_SCHED; PG8_LDA(At, 1, 0); PG8_STAGE(PG8_SA(0, 1), a2 + hstep, voffA);
            PG8_WAIT_V(8); PG8_WAIT_L(0); PG8_BAR; PG8_MMA(0, 0, At, B0); PG8_MMA(0, 1, At, B1); PG8_BAR; PG8_SCHED;
            PG8_LDA(At, 1, 1); PG8_STAGE(PG8_SB(1, 0), b3, voffB); PG8_STAGE(PG8_SB(1, 1), b3 + hstep, voffB); PG8_STAGE(PG8_SA(1, 0), a3, voffA);
            PG8_WAIT_V(8); PG8_WAIT_L(0); PG8_BAR; PG8_MMA(1, 0, At, B0); PG8_MMA(1, 1, At, B1); PG8_BAR; PG8_SCHED;
            } else {
            PG8_LDB(B0, 0, 0); PG8_SCHED; PG8_LDA(At, 0, 0); PG8_STAGE(PG8_SA(1, 1), a1 + hstep, voffA);
            PG8_WAIT_L(8); PG8_BAR; PG8_WAIT_L(0); PG8_MMA(0, 0, At, B0); PG8_BAR; PG8_SCHED;
            PG8_LDB(B1, 0, 1); PG8_STAGE(PG8_SB(0, 0), b2, voffB);
            PG8_BAR; PG8_WAIT_L(0); PG8_MMA(0, 1, At, B1); PG8_BAR;
            PG8_LDA(At, 0, 1); PG8_STAGE(PG8_SA(0, 0), a2, voffA);
            PG8_BAR; PG8_WAIT_L(0); PG8_MMA(1, 0, At, B0); PG8_BAR; PG8_SCHED;
            PG8_STAGE(PG8_SB(0, 1), b2 + hstep, voffB);
            PG8_WAIT_V(6); PG8_BAR; PG8_MMA(1, 1, At, B1); PG8_BAR;
            PG8_LDB(B0, 1, 0); PG8_SCHED; PG8_LDA(At, 1, 0); PG8_STAGE(PG8_SA(0, 1), a2 + hstep, voffA);
            PG8_WAIT_L(8); PG8_BAR; PG8_WAIT_L(0); PG8_MMA(0, 0, At, B0); PG8_BAR; PG8_SCHED;
            PG8_LDB(B1, 1, 1); PG8_STAGE(PG8_SB(1, 0), b3, voffB);
            PG8_BAR; PG8_WAIT_L(0); PG8_MMA(0, 1, At, B1); PG8_BAR;
            PG8_LDA(At, 1, 1); PG8_STAGE(PG8_SA(1, 0), a3, voffA);
            PG8_BAR; PG8_WAIT_L(0); PG8_MMA(1, 0, At, B0); PG8_BAR; PG8_SCHED;
            PG8_STAGE(PG8_SB(1, 1), b3 + hstep, voffB);
            PG8_WAIT_V(6); PG8_BAR; PG8_MMA(1, 1, At, B1); PG8_BAR;
            }
        }
        if constexpr (ALIGN_EPI) { if (wr == 0) PG8_BAR; }
        if constexpr (!Epi::AFTER_DRAIN) { E(acc, cur, wr, wc, fr, fq); S.done(cur); }
        if (!has_next) break;
#pragma unroll
        for (int a = 0; a < 2; ++a)
#pragma unroll
            for (int b = 0; b < 2; ++b)
#pragma unroll
                for (int m = 0; m < 4; ++m)
#pragma unroll
                    for (int n = 0; n < 2; ++n) acc[a][b][m][n] = (f32x4){0.f, 0.f, 0.f, 0.f};
        cur = nxt; cA = nA; cB = nB; ++ui;
        if constexpr (ALIGN_EPI) { if (wr == 1) PG8_BAR; }
    }
    PG8_WAIT_V(0);
    if constexpr (!ALIGN_EPI) { if (wr == 0) PG8_BAR; }
    PG8_BAR;
    if constexpr (Epi::AFTER_DRAIN) { E.fused(acc, cur, wr, wc, fr, fq, lds, wid, lane); S.done(cur); }
#undef PG8_SA
#undef PG8_SB
#undef PG8_STAGE
#undef PG8_LDA
#undef PG8_LDB
#undef PG8_MMA
#undef PG8_WAIT_V
#undef PG8_WAIT_L
#undef PG8_BAR
#undef PG8_SCHED
}
template <class Epi, class Sched, bool ALIGN_EPI = false, bool SP2 = false>
__device__ __forceinline__ void gemm_phase_i8(PG8_LAS unsigned char* lds, const Gemm g, const Sched& S, const Epi& E) {
    const int tid = threadIdx.x, wid = __builtin_amdgcn_readfirstlane(tid >> 6), lane = tid & 63, wr = wid >> 2, wc = wid & 3, fr = lane & 15, fq = lane >> 4;
    const int K = g.K, nt = K / BK;
    unsigned voffA[2], voffB[2];
#pragma unroll
    for (int i = 0; i < 2; ++i) { int R, C; stage_rc(tid * 16 + i * 8192, R, C); const int Rb = Epi::PERM ? ((R & ~31) + perm32(R & 31)) : R;
        voffA[i] = (unsigned)(R * K + C) * 2u; voffB[i] = (unsigned)(Rb * K + C) * 2u; }
    const size_t kstep = (size_t)(BK * 2);
    const size_t hstep = (size_t)HALF * K * 2;
    const size_t tstep = 2 * hstep;
    const unsigned ldsw = (unsigned)wid * 1024u;
    const int aoff = lds_byte(wr * 64 + fr, fq * 8), boff = lds_byte(wc * 32 + fr, fq * 8);
#define PG8_SA(b, h) (((b) * 2 + (h)) * HTB)
#define PG8_SB(b, h) ((4 + (b) * 2 + (h)) * HTB)
#define PG8_STAGE(bufoff, gbase, voff) do { _Pragma("unroll") for (int _i = 0; _i < 2; ++_i) \
        __builtin_amdgcn_global_load_lds((const unsigned*)((const char*)(gbase) + (voff)[_i]), (PG8_LAS unsigned*)(lds + (bufoff) + ldsw + _i * 8192), 16, 0, 0); } while (0)
#define PG8_LDA(dst, b, h) do { _Pragma("unroll") for (int m = 0; m < 4; ++m) _Pragma("unroll") for (int k = 0; k < 2; ++k) dst[m][k] = *(const PG8_LAS bf16x8*)(lds + PG8_SA(b, h) + aoff + m * 2048 + k * 1024); } while (0)
#define PG8_LDB(dst, b, h) do { _Pragma("unroll") for (int n = 0; n < 2; ++n) _Pragma("unroll") for (int k = 0; k < 2; ++k) dst[n][k] = *(const PG8_LAS bf16x8*)(lds + PG8_SB(b, h) + boff + n * 2048 + k * 1024); } while (0)
#define PG8_MMA(ai, bj, At, Bt) do { __builtin_amdgcn_s_setprio(1); _Pragma("unroll") for (int m = 0; m < 4; ++m) _Pragma("unroll") for (int n = 0; n < 2; ++n) _Pragma("unroll") for (int k = 0; k < 2; ++k) \
        acc[ai][bj][m][n] = __builtin_amdgcn_mfma_i32_16x16x64_i8(__builtin_bit_cast(i32x4, Bt[n][k]), __builtin_bit_cast(i32x4, At[m][k]), acc[ai][bj][m][n], 0, 0, 0); __builtin_amdgcn_s_setprio(0); } while (0)
#define PG8_WAIT_V(n) asm volatile("s_waitcnt vmcnt(" #n ")" ::: "memory")
#define PG8_WAIT_L(n) asm volatile("s_waitcnt lgkmcnt(" #n ")" ::: "memory")
#define PG8_BAR __builtin_amdgcn_s_barrier()
#define PG8_SCHED __builtin_amdgcn_sched_barrier(0)
    Unit cur, nxt; int ui = 0;
    if (!S.next(0, cur)) return;
    i32x4 acc[2][2][4][2];
#pragma unroll
    for (int a = 0; a < 2; ++a)
#pragma unroll
        for (int b = 0; b < 2; ++b)
#pragma unroll
            for (int m = 0; m < 4; ++m)
#pragma unroll
                for (int n = 0; n < 2; ++n) acc[a][b][m][n] = (i32x4){0, 0, 0, 0};
    bf16x8 At[4][2], B0[2][2], B1[2][2];
    const char* cA = (const char*)g.A + (size_t)cur.pm * tstep; const char* cB = (const char*)g.Bt + (size_t)cur.pn * tstep;
    S.a_ready(cur);
    if constexpr (SP2) {
        PG8_STAGE(PG8_SB(0, 0), cB, voffB); PG8_STAGE(PG8_SB(0, 1), cB + hstep, voffB); PG8_STAGE(PG8_SA(0, 0), cA, voffA); PG8_STAGE(PG8_SA(0, 1), cA + hstep, voffA);
        if (wr == 1) PG8_BAR;
        PG8_WAIT_V(2); PG8_BAR;
        PG8_STAGE(PG8_SB(1, 0), cB + kstep, voffB); PG8_STAGE(PG8_SA(1, 0), cA + kstep, voffA); PG8_STAGE(PG8_SB(1, 1), cB + hstep + kstep, voffB);
        PG8_WAIT_V(6); PG8_BAR;
    } else {
        PG8_STAGE(PG8_SB(0, 0), cB, voffB); PG8_STAGE(PG8_SA(0, 0), cA, voffA); PG8_STAGE(PG8_SB(0, 1), cB + hstep, voffB); PG8_STAGE(PG8_SA(0, 1), cA + hstep, voffA);
        if (wr == 1) PG8_BAR;
        PG8_WAIT_V(4); PG8_BAR;
        PG8_STAGE(PG8_SB(1, 0), cB + kstep, voffB); PG8_STAGE(PG8_SA(1, 0), cA + kstep, voffA); PG8_STAGE(PG8_SB(1, 1), cB + hstep + kstep, voffB);
        PG8_WAIT_V(6); PG8_BAR;
    }
    for (;;) {
        const bool has_next = S.next(ui + 1, nxt);
        const char* nA = has_next ? (const char*)g.A + (size_t)nxt.pm * tstep : cA; const char* nB = has_next ? (const char*)g.Bt + (size_t)nxt.pn * tstep : cB;
        for (int t = 0; t < nt; t += 2) {
            const bool last = (t == nt - 2);
            const char* a1 = cA + (size_t)(t + 1) * kstep;
            const char* a2 = last ? nA : cA + (size_t)(t + 2) * kstep; const char* b2 = last ? nB : cB + (size_t)(t + 2) * kstep;
            const char* a3 = a2 + kstep; const char* b3 = b2 + kstep;
            if (last && has_next) S.a_ready(nxt);
            if constexpr (SP2) {
            PG8_LDB(B0, 0, 0); PG8_LDB(B1, 0, 1); PG8_SCHED; PG8_LDA(At, 0, 0); PG8_STAGE(PG8_SA(1, 1), a1 + hstep, voffA);
            PG8_WAIT_V(8); PG8_WAIT_L(0); PG8_BAR; PG8_MMA(0, 0, At, B0); PG8_MMA(0, 1, At, B1); PG8_BAR; PG8_SCHED;
            PG8_LDA(At, 0, 1); PG8_STAGE(PG8_SB(0, 0), b2, voffB); PG8_STAGE(PG8_SB(0, 1), b2 + hstep, voffB); PG8_STAGE(PG8_SA(0, 0), a2, voffA);
            PG8_WAIT_V(8); PG8_WAIT_L(0); PG8_BAR; PG8_MMA(1, 0, At, B0); PG8_MMA(1, 1, At, B1); PG8_BAR; PG8_SCHED;
            PG8_LDB(B0, 1, 0); PG8_LDB(B1, 1, 1); PG8_SCHED; PG8_LDA(At, 1, 0); PG8_STAGE(PG8_SA(0, 1), a2 + hstep, voffA);
            PG8_WAIT_V(8); PG8_WAIT_L(0); PG8_BAR; PG8_MMA(0, 0, At, B0); PG8_MMA(0, 1, At, B1); PG8_BAR; PG8_SCHED;
            PG8_LDA(At, 1, 1); PG8_STAGE(PG8_SB(1, 0), b3, voffB); PG8_STAGE(PG8_SB(1, 1), b3 + hstep, voffB); PG8_STAGE(PG8_SA(1, 0), a3, voffA);
            PG8_WAIT_V(8); PG8_WAIT_L(0); PG8_BAR; PG8_MMA(1, 0, At, B0); PG8_MMA(1, 1, At, B1); PG8_BAR; PG8_SCHED;
            } else {
            PG8_LDB(B0, 0, 0); PG8_SCHED; PG8_LDA(At, 0, 0); PG8_STAGE(PG8_SA(1, 1), a1 + hstep, voffA);
            PG8_WAIT_L(8); PG8_BAR; PG8_WAIT_L(0); PG8_MMA(0, 0, At, B0); PG8_BAR; PG8_SCHED;
            PG8_LDB(B1, 0, 1); PG8_STAGE(PG8_SB(0, 0), b2, voffB);
            PG8_BAR; PG8_WAIT_L(0); PG8_MMA(0, 1, At, B1); PG8_BAR;
            PG8_LDA(At, 0, 1); PG8_STAGE(PG8_SA(0, 0), a2, voffA);
            PG8_BAR; PG8_WAIT_L(0); PG8_MMA(1, 0, At, B0); PG8_BAR; PG8_SCHED;
            PG8_STAGE(PG8_SB(0, 1), b2 + hstep, voffB);
            PG8_WAIT_V(6); PG8_BAR; PG8_MMA(1, 1, At, B1); PG8_BAR;
            PG8_LDB(B0, 1, 0); PG8_SCHED; PG8_LDA(At, 1, 0); PG8_STAGE(PG8_SA(0, 1), a2 + hstep, voffA);
            PG8_WAIT_L(8); PG8_BAR; PG8_WAIT_L(0); PG8_MMA(0, 0, At, B0); PG8_BAR; PG8_SCHED;
            PG8_LDB(B1, 1, 1); PG8_STAGE(PG8_SB(1, 0), b3, voffB);
            PG8_BAR; PG8_WAIT_L(0); PG8_MMA(0, 1, At, B1); PG8_BAR;
            PG8_LDA(At, 1, 1); PG8_STAGE(PG8_SA(1, 0), a3, voffA);
            PG8_BAR; PG8_WAIT_L(0); PG8_MMA(1, 0, At, B0); PG8_BAR; PG8_SCHED;
            PG8_STAGE(PG8_SB(1, 1), b3 + hstep, voffB);
            PG8_WAIT_V(6); PG8_BAR; PG8_MMA(1, 1, At, B1); PG8_BAR;
            }
        }
        if constexpr (ALIGN_EPI) { if (wr == 0) PG8_BAR; }
        if constexpr (!Epi::AFTER_DRAIN) { E(acc, cur, wr, wc, fr, fq); S.done(cur); }
        if (!has_next) break;
#pragma unroll
        for (int a = 0; a < 2; ++a)
#pragma unroll
            for (int b = 0; b < 2; ++b)
#pragma unroll
                for (int m = 0; m < 4; ++m)
#pragma unroll
                    for (int n = 0; n < 2; ++n) acc[a][b][m][n] = (i32x4){0, 0, 0, 0};
        cur = nxt; cA = nA; cB = nB; ++ui;
        if constexpr (ALIGN_EPI) { if (wr == 1) PG8_BAR; }
    }
    PG8_WAIT_V(0);
    if constexpr (!ALIGN_EPI) { if (wr == 0) PG8_BAR; }
    PG8_BAR;
    if constexpr (Epi::AFTER_DRAIN) { E.fused(acc, cur, wr, wc, fr, fq, lds, wid, lane); S.done(cur); }
#undef PG8_SA
#undef PG8_SB
#undef PG8_STAGE
#undef PG8_LDA
#undef PG8_LDB
#undef PG8_MMA
#undef PG8_WAIT_V
#undef PG8_WAIT_L
#undef PG8_BAR
#undef PG8_SCHED
}
}

#define LAS __attribute__((address_space(3)))
typedef unsigned short bf16;
typedef float f32x2 __attribute__((ext_vector_type(2)));
typedef float f32x4 __attribute__((ext_vector_type(4)));
typedef unsigned u32x2 __attribute__((ext_vector_type(2)));
typedef unsigned u32x4 __attribute__((ext_vector_type(4)));

constexpr int PDIM = 1536;
constexpr int NTOK = 32768, DM = 1024, DIN = 2560, SEQ = 8192, NBATCH = 4, NMETA = 16;
constexpr int NHEAD = 8, NKEYS = 128, TOPK = 16, NSEL = NHEAD * TOPK;
constexpr float EPS = 1e-6f;
constexpr float U_SCALE = 64.f, V_SCALE = 16.f;
constexpr float U4_CLIP = 2.6f;
constexpr int NWAVES = 8, NTHREADS = 512;
constexpr int MKC = 32;
constexpr int LDS_BYTES = 147456;

constexpr size_t MiB = 1u << 20;
constexpr size_t WS_CTL = 0, WS_WIN_T = 1 * MiB, WS_WOUT_T = 6 * MiB, WS_WQ_T = 8 * MiB, WS_KEYS = 12 * MiB, WS_METAPART = 160 * MiB  ,
                 WS_METARSTD = 14 * MiB + 512 * 1024, WS_METAPROJ = 14 * MiB + 576 * 1024, WS_RSTD1 = 15 * MiB, WS_SSQ = 16 * MiB, WS_U8 = 32 * MiB, WS_V8 = 48 * MiB,
                 WS_IDX = 64 * MiB, WS_GATE = 80 * MiB, WS_H0B = 96 * MiB, WS_H2B = 96 * MiB, WS_Y = 160 * MiB, WS_PROJ = 224 * MiB,
                 WS_Q = 224 * MiB, WS_ESCALE = 18 * MiB, WS_SUMQ = 19 * MiB, WS_SX = 20 * MiB, WS_SW = 21 * MiB, WS_SY = 22 * MiB, WS_SWO = 23 * MiB, WS_WMX = 24 * MiB, WS_AMX = 26 * MiB, WS_RF = 28 * MiB, WS_SWQ = 29 * MiB, WS_H0I8 = 384 * MiB, WS_AW = 160 * MiB  , WS_END = 416 * MiB;

struct Params {
    const float* x; const float* meta; const float* g_mix; const float* w_in; const float* sc_w; const float* cf_w; const float* cf_b;
    const float* ln_g; const float* ln_b; const float* g_sc; const float* g_cf; const float* w_out; const float* g_ffn; const float* w_q;
    const float* keys; const float* pu; const float* pv; const float* g_fin;
    float* out; unsigned char* ws;
    int ph_lo, ph_hi, coop, pad;
};

__device__ __forceinline__ unsigned f2bf(float f) { unsigned u = __builtin_bit_cast(unsigned, f); return (u + 0x7fffu + ((u >> 16) & 1u)) >> 16; }
__device__ __forceinline__ unsigned pk2(float lo, float hi) { return f2bf(lo) | (f2bf(hi) << 16); }
__device__ __forceinline__ float bf2f(unsigned b) { return __builtin_bit_cast(float, b << 16); }
__device__ __forceinline__ float bflo(unsigned w) { return __builtin_bit_cast(float, w << 16); }
__device__ __forceinline__ float bfhi(unsigned w) { return __builtin_bit_cast(float, w & 0xffff0000u); }
__device__ __forceinline__ float wave_sum(float v) {
#pragma unroll
    for (int o = 1; o < 64; o <<= 1) v += __shfl_xor(v, o);
    return v;
}
template <int CTRL> __device__ __forceinline__ float dpp_f(float v) { return __builtin_bit_cast(float, __builtin_amdgcn_update_dpp(0, __builtin_bit_cast(int, v), CTRL, 0xf, 0xf, true)); }
__device__ __forceinline__ float wave_sum_fast(float v) {
    v += dpp_f<0xB1>(v); v += dpp_f<0x4E>(v); v += dpp_f<0x141>(v); v += dpp_f<0x140>(v);
    { auto r = __builtin_amdgcn_permlane16_swap(__float_as_uint(v), __float_as_uint(v), false, false); v = __uint_as_float(r[0]) + __uint_as_float(r[1]); }
    { auto r = __builtin_amdgcn_permlane32_swap(__float_as_uint(v), __float_as_uint(v), false, false); v = __uint_as_float(r[0]) + __uint_as_float(r[1]); }
    return v;
}
__device__ __forceinline__ float wave_max_fast(float v) {
    v = fmaxf(v, dpp_f<0xB1>(v)); v = fmaxf(v, dpp_f<0x4E>(v)); v = fmaxf(v, dpp_f<0x141>(v)); v = fmaxf(v, dpp_f<0x140>(v));
    { auto r = __builtin_amdgcn_permlane16_swap(__float_as_uint(v), __float_as_uint(v), false, false); v = fmaxf(__uint_as_float(r[0]), __uint_as_float(r[1])); }
    { auto r = __builtin_amdgcn_permlane32_swap(__float_as_uint(v), __float_as_uint(v), false, false); v = fmaxf(__uint_as_float(r[0]), __uint_as_float(r[1])); }
    return v;
}
__device__ __forceinline__ float sigmoid_f(float x) { return __builtin_amdgcn_rcpf(1.f + __expf(-x)); }
__device__ __forceinline__ float gelu_tanh_f(float x) {
    const float t = 0.7978845608028654f * (x + 0.044715f * x * x * x);
    const float e = __expf(2.f * t);
    const float th = 1.f - 2.f * __builtin_amdgcn_rcpf(e + 1.f);
    return 0.5f * x * (1.f + th);
}

__device__ __forceinline__ unsigned cvt_pk_bf16(float lo, float hi) { unsigned r; asm volatile("v_cvt_pk_bf16_f32 %0, %1, %2" : "=v"(r) : "v"(lo), "v"(hi)); return r; }

template <int MODE> struct EpiRowScale {
    static constexpr bool PERM = true, AFTER_DRAIN = false;
    bf16* O; int ldc; const float* rs;
    __device__ __forceinline__ void operator()(const pg8::f32x4 (&acc)[2][2][4][2], const pg8::Unit& u, int wr, int wc, int fr, int fq) const {
        const int row0 = u.pm * 256 + wr * 64 + fr, col0 = u.pn * 256 + wc * 32 + 8 * fq;
#pragma unroll
        for (int ai = 0; ai < 2; ++ai)
#pragma unroll
            for (int m = 0; m < 4; ++m) {
                const int row = row0 + ai * 128 + m * 16;
                float s;
                if (MODE == 0) s = rs[row];
                else { const f32x4* p = (const f32x4*)(rs + (size_t)row * 16); const f32x4 a = p[0], b = p[1], c = p[2], d = p[3];
                       const float t = ((a.x + a.y) + (a.z + a.w)) + ((b.x + b.y) + (b.z + b.w)) + ((c.x + c.y) + (c.z + c.w)) + ((d.x + d.y) + (d.z + d.w));
                       s = rsqrtf(t * (1.f / 1024.f) + EPS); }
                bf16* rowp = O + (size_t)row * ldc + col0;
#pragma unroll
                for (int bj = 0; bj < 2; ++bj) { const pg8::f32x4 v0 = acc[ai][bj][m][0] * s, v1 = acc[ai][bj][m][1] * s;
                    u32x4 w; w.x = cvt_pk_bf16(v0[0], v0[1]); w.y = cvt_pk_bf16(v0[2], v0[3]); w.z = cvt_pk_bf16(v1[0], v1[1]); w.w = cvt_pk_bf16(v1[2], v1[3]);
                    *(u32x4*)(rowp + bj * 128) = w; }
            }
    }
};
struct EpiProj {
    static constexpr bool PERM = true, AFTER_DRAIN = false;
    bf16* O; const float* rs;
    __device__ __forceinline__ void operator()(const pg8::f32x4 (&acc)[2][2][4][2], const pg8::Unit& u, int wr, int wc, int fr, int fq) const {
        const int row0 = u.pm * 256 + wr * 64 + fr, cin = wc * 32 + 8 * fq, pn = u.pn;
#pragma unroll
        for (int ai = 0; ai < 2; ++ai)
#pragma unroll
            for (int m = 0; m < 4; ++m) {
                const int row = row0 + ai * 128 + m * 16; const float sc = rs[row];
                float a[8], b[8];
#pragma unroll
                for (int i = 0; i < 4; ++i) { a[i] = acc[ai][0][m][0][i] * sc; a[4 + i] = acc[ai][0][m][1][i] * sc; b[i] = acc[ai][1][m][0][i] * sc; b[4 + i] = acc[ai][1][m][1][i] * sc; }
                bf16* rowp = O + (size_t)row * PDIM;
                if (pn >= 4 && pn < 6) {
                    u32x4 w0, w1; w0.x = cvt_pk_bf16(a[0], a[1]); w0.y = cvt_pk_bf16(a[2], a[3]); w0.z = cvt_pk_bf16(a[4], a[5]); w0.w = cvt_pk_bf16(a[6], a[7]);
                    w1.x = cvt_pk_bf16(b[0], b[1]); w1.y = cvt_pk_bf16(b[2], b[3]); w1.z = cvt_pk_bf16(b[4], b[5]); w1.w = cvt_pk_bf16(b[6], b[7]);
                    *(u32x4*)(rowp + 512 + 256 * (pn - 4) + cin) = w0; *(u32x4*)(rowp + 512 + 256 * (pn - 4) + 128 + cin) = w1;
                } else {
                    float o[8];
                    if (pn < 4) {
#pragma unroll
                        for (int i = 0; i < 8; ++i) o[i] = a[i] * b[i];
                    } else {
#pragma unroll
                        for (int i = 0; i < 8; ++i) o[i] = a[i] * sigmoid_f(b[i]);
                    }
                    u32x4 w; w.x = cvt_pk_bf16(o[0], o[1]); w.y = cvt_pk_bf16(o[2], o[3]); w.z = cvt_pk_bf16(o[4], o[5]); w.w = cvt_pk_bf16(o[6], o[7]);
                    *(u32x4*)(rowp + (pn < 4 ? 128 * pn : 1024 + 128 * (pn - 6)) + cin) = w;
                }
            }
    }
};
struct EpiProjI8 {
    static constexpr bool PERM = true, AFTER_DRAIN = false;
    bf16* O; const float* rs; const float* sw;
    __device__ __forceinline__ void operator()(const pg8::i32x4 (&acc)[2][2][4][2], const pg8::Unit& u, int wr, int wc, int fr, int fq) const {
        const int row0 = u.pm * 256 + wr * 64 + fr, cin = wc * 32 + 8 * fq, pn = u.pn;
        float swa[8], swb[8];
        { const f32x4 a0 = *(const f32x4*)(sw + 256 * pn + cin), a1 = *(const f32x4*)(sw + 256 * pn + cin + 4), b0 = *(const f32x4*)(sw + 256 * pn + 128 + cin), b1 = *(const f32x4*)(sw + 256 * pn + 128 + cin + 4);
          swa[0] = a0.x; swa[1] = a0.y; swa[2] = a0.z; swa[3] = a0.w; swa[4] = a1.x; swa[5] = a1.y; swa[6] = a1.z; swa[7] = a1.w;
          swb[0] = b0.x; swb[1] = b0.y; swb[2] = b0.z; swb[3] = b0.w; swb[4] = b1.x; swb[5] = b1.y; swb[6] = b1.z; swb[7] = b1.w; }
#pragma unroll
        for (int ai = 0; ai < 2; ++ai)
#pragma unroll
            for (int m = 0; m < 4; ++m) {
                const int row = row0 + ai * 128 + m * 16; const float sc = rs[row];
                float a[8], b[8];
#pragma unroll
                for (int i = 0; i < 4; ++i) { a[i] = (float)acc[ai][0][m][0][i] * (sc * swa[i]); a[4 + i] = (float)acc[ai][0][m][1][i] * (sc * swa[4 + i]);
                    b[i] = (float)acc[ai][1][m][0][i] * (sc * swb[i]); b[4 + i] = (float)acc[ai][1][m][1][i] * (sc * swb[4 + i]); }
                bf16* rowp = O + (size_t)row * PDIM;
                if (pn >= 4 && pn < 6) {
                    u32x4 w0, w1; w0.x = cvt_pk_bf16(a[0], a[1]); w0.y = cvt_pk_bf16(a[2], a[3]); w0.z = cvt_pk_bf16(a[4], a[5]); w0.w = cvt_pk_bf16(a[6], a[7]);
                    w1.x = cvt_pk_bf16(b[0], b[1]); w1.y = cvt_pk_bf16(b[2], b[3]); w1.z = cvt_pk_bf16(b[4], b[5]); w1.w = cvt_pk_bf16(b[6], b[7]);
                    *(u32x4*)(rowp + 512 + 256 * (pn - 4) + cin) = w0; *(u32x4*)(rowp + 512 + 256 * (pn - 4) + 128 + cin) = w1;
                } else {
                    float o[8];
                    if (pn < 4) {
#pragma unroll
                        for (int i = 0; i < 8; ++i) o[i] = a[i] * b[i];
                    } else {
#pragma unroll
                        for (int i = 0; i < 8; ++i) o[i] = a[i] * sigmoid_f(b[i]);
                    }
                    u32x4 w; w.x = cvt_pk_bf16(o[0], o[1]); w.y = cvt_pk_bf16(o[2], o[3]); w.z = cvt_pk_bf16(o[4], o[5]); w.w = cvt_pk_bf16(o[6], o[7]);
                    *(u32x4*)(rowp + (pn < 4 ? 128 * pn : 1024 + 128 * (pn - 6)) + cin) = w;
                }
            }
    }
};
__host__ __device__ __forceinline__ int win_src_col(int n) {
    const int t = n >> 8, j = n & 255;
    if (t < 4) return (j < 128) ? 128 * t + j : 1024 + 128 * t + (j - 128);
    if (t < 6) return 512 + 256 * (t - 4) + j;
    return (j < 128) ? 1536 + 128 * (t - 6) + j : 2048 + 128 * (t - 6) + (j - 128);
}
struct EpiResidual {
    static constexpr bool PERM = true, AFTER_DRAIN = false;
    bf16* O; const signed char* XB; const float* SX; float* ssq;
    __device__ __forceinline__ void operator()(const pg8::f32x4 (&acc)[2][2][4][2], const pg8::Unit& u, int wr, int wc, int fr, int fq) const {
        const int row0 = u.pm * 256 + wr * 64 + fr, col0 = u.pn * 256 + wc * 32 + 8 * fq;
#pragma unroll
        for (int ai = 0; ai < 2; ++ai)
#pragma unroll
            for (int m = 0; m < 4; ++m) {
                const int row = row0 + ai * 128 + m * 16;
                const signed char* xr = XB + (size_t)row * DM + col0; bf16* rowp = O + (size_t)row * DM + col0;
                float q = 0.f;
                u32x2 xw[2]; const float sxr = SX[row];
#pragma unroll
                for (int bj = 0; bj < 2; ++bj) xw[bj] = *(const u32x2*)(xr + bj * 128);
#pragma unroll
                for (int bj = 0; bj < 2; ++bj) {
                    const f32x4 x0 = (f32x4){(float)(signed char)(xw[bj].x), (float)(signed char)(xw[bj].x >> 8), (float)(signed char)(xw[bj].x >> 16), (float)((int)xw[bj].x >> 24)} * sxr,
                                x1 = (f32x4){(float)(signed char)(xw[bj].y), (float)(signed char)(xw[bj].y >> 8), (float)(signed char)(xw[bj].y >> 16), (float)((int)xw[bj].y >> 24)} * sxr;
                    const pg8::f32x4 v0 = acc[ai][bj][m][0] + x0, v1 = acc[ai][bj][m][1] + x1;
                    q += (v0[0] * v0[0] + v0[1] * v0[1]) + (v0[2] * v0[2] + v0[3] * v0[3]) + (v1[0] * v1[0] + v1[1] * v1[1]) + (v1[2] * v1[2] + v1[3] * v1[3]);
                    u32x4 w; w.x = cvt_pk_bf16(v0[0], v0[1]); w.y = cvt_pk_bf16(v0[2], v0[3]); w.z = cvt_pk_bf16(v1[0], v1[1]); w.w = cvt_pk_bf16(v1[2], v1[3]);
                    *(u32x4*)(rowp + bj * 128) = w; }
                q += __shfl_xor(q, 16); q += __shfl_xor(q, 32);
                if (fq == 0) ssq[(size_t)row * 16 + u.pn * 4 + wc] = q;
            }
    }
};

struct EpiResidualI8 {
    static constexpr bool PERM = true, AFTER_DRAIN = false;
    bf16* O; const signed char* XB; const float* SX; const float* SY; const float* SWO; float* ssq; float* amx;
    __device__ __forceinline__ void operator()(const pg8::i32x4 (&acc)[2][2][4][2], const pg8::Unit& u, int wr, int wc, int fr, int fq) const {
        const int row0 = u.pm * 256 + wr * 64 + fr, col0 = u.pn * 256 + wc * 32 + 8 * fq;
        f32x4 sw[2][2];
#pragma unroll
        for (int bj = 0; bj < 2; ++bj) { sw[bj][0] = *(const f32x4*)(SWO + col0 + bj * 128); sw[bj][1] = *(const f32x4*)(SWO + col0 + bj * 128 + 4); }
#pragma unroll
        for (int ai = 0; ai < 2; ++ai)
#pragma unroll
            for (int m = 0; m < 4; ++m) {
                const int row = row0 + ai * 128 + m * 16;
                const signed char* xr = XB + (size_t)row * DM + col0; bf16* rowp = O + (size_t)row * DM + col0;
                float q = 0.f, mxa = 0.f;
                u32x2 xw[2]; const float sxr = SX[row], syr = SY[row];
#pragma unroll
                for (int bj = 0; bj < 2; ++bj) xw[bj] = *(const u32x2*)(xr + bj * 128);
#pragma unroll
                for (int bj = 0; bj < 2; ++bj) {
                    const f32x4 x0 = (f32x4){(float)(signed char)(xw[bj].x), (float)(signed char)(xw[bj].x >> 8), (float)(signed char)(xw[bj].x >> 16), (float)((int)xw[bj].x >> 24)} * sxr,
                                x1 = (f32x4){(float)(signed char)(xw[bj].y), (float)(signed char)(xw[bj].y >> 8), (float)(signed char)(xw[bj].y >> 16), (float)((int)xw[bj].y >> 24)} * sxr;
                    const pg8::i32x4 a0 = acc[ai][bj][m][0], a1 = acc[ai][bj][m][1];
                    const f32x4 v0 = (f32x4){(float)a0[0], (float)a0[1], (float)a0[2], (float)a0[3]} * (sw[bj][0] * syr) + x0, v1 = (f32x4){(float)a1[0], (float)a1[1], (float)a1[2], (float)a1[3]} * (sw[bj][1] * syr) + x1;
                    q += (v0[0] * v0[0] + v0[1] * v0[1]) + (v0[2] * v0[2] + v0[3] * v0[3]) + (v1[0] * v1[0] + v1[1] * v1[1]) + (v1[2] * v1[2] + v1[3] * v1[3]);
                    mxa = fmaxf(mxa, fmaxf(fmaxf(fmaxf(fabsf(v0[0]), fabsf(v0[1])), fmaxf(fabsf(v0[2]), fabsf(v0[3]))), fmaxf(fmaxf(fabsf(v1[0]), fabsf(v1[1])), fmaxf(fabsf(v1[2]), fabsf(v1[3])))));
                    u32x4 w; w.x = cvt_pk_bf16(v0[0], v0[1]); w.y = cvt_pk_bf16(v0[2], v0[3]); w.z = cvt_pk_bf16(v1[0], v1[1]); w.w = cvt_pk_bf16(v1[2], v1[3]);
                    *(u32x4*)(rowp + bj * 128) = w; }
                q += __shfl_xor(q, 16); q += __shfl_xor(q, 32);
                mxa = fmaxf(mxa, __shfl_xor(mxa, 16)); mxa = fmaxf(mxa, __shfl_xor(mxa, 32));
                if (fq == 0) { ssq[(size_t)row * 16 + u.pn * 4 + wc] = q; amx[(size_t)row * 16 + u.pn * 4 + wc] = mxa; }
            }
    }
};
template <bool MAPIN> __device__ __forceinline__ void p0_transpose_item(const float* W, int K, int N, bf16* WT, LAS float* scr, int item, int lane,
                                                  const float* g_lo, const float* g_hi, int split) {
    const int nblk = N / 32, kb = item / nblk, nb = item % nblk, k0 = 64 * kb, n0 = 32 * nb;
#pragma unroll 8
    for (int i = 0; i < 32; ++i) { const int kk = 2 * i + (lane >> 5); const int k = k0 + kk;
        const float g = (k < split) ? g_lo[k] : g_hi[k - split];
        scr[kk * 33 + (lane & 31)] = W[(size_t)k * N + (MAPIN ? win_src_col(n0) : n0) + (lane & 31)] * g; }
    asm volatile("s_waitcnt lgkmcnt(0)" ::: "memory");
    const int c = lane & 7;
#pragma unroll
    for (int j = 0; j < 4; ++j) { const int n = (lane >> 3) + 8 * j; const LAS float* s = scr + (8 * c) * 33 + n;
        u32x4 o; o.x = pk2(s[0 * 33], s[1 * 33]); o.y = pk2(s[2 * 33], s[3 * 33]); o.z = pk2(s[4 * 33], s[5 * 33]); o.w = pk2(s[6 * 33], s[7 * 33]);
        *(u32x4*)(WT + (size_t)(n0 + n) * K + k0 + 8 * c) = o; }
    asm volatile("s_waitcnt lgkmcnt(0)" ::: "memory");
}

constexpr int CW_COLMAX = 5120;
__device__ __forceinline__ void p0_colmax_item(const float* W, int N, unsigned* colmax, int item, int lane, const float* g) {
    const int nblk = N / 32, kb = item / nblk, nb = item % nblk, k0 = 64 * kb, n0 = 32 * nb;
    float mx = 0.f;
#pragma unroll
    for (int i = 0; i < 32; ++i) { const int k = k0 + 2 * i + (lane >> 5); mx = fmaxf(mx, fabsf(W[(size_t)k * N + n0 + (lane & 31)] * g[k])); }
    mx = fmaxf(mx, __shfl_xor(mx, 32));
    if (lane < 32) atomicMax(colmax + n0 + lane, __float_as_uint(mx));
}
__device__ __forceinline__ void p1_quant_item(const float* W, int K, int N, signed char* WT8, float* swout, const unsigned* colmax, LAS float* scr, int item, int lane, const float* g) {
    const int nblk = N / 32, kb = item / nblk, nb = item % nblk, k0 = 64 * kb, n0 = 32 * nb, s0 = win_src_col(n0);
    const float cm = fmaxf(__uint_as_float(__hip_atomic_load((unsigned*)colmax + s0 + (lane & 31), __ATOMIC_RELAXED, __HIP_MEMORY_SCOPE_AGENT)), 1e-30f), inv = 127.f / cm;
    if (kb == 0 && lane < 32) swout[n0 + lane] = cm * (1.f / 127.f);
#pragma unroll
    for (int i = 0; i < 32; ++i) { const int kk = 2 * i + (lane >> 5); const int k = k0 + kk;
        scr[kk * 33 + (lane & 31)] = W[(size_t)k * N + s0 + (lane & 31)] * g[k] * inv; }
    asm volatile("s_waitcnt lgkmcnt(0)" ::: "memory");
    const int c = lane & 7;
#pragma unroll
    for (int j = 0; j < 4; ++j) { const int n = (lane >> 3) + 8 * j; const LAS float* sp = scr + (8 * c) * 33 + n;
        unsigned w0 = 0u, w1 = 0u;
#pragma unroll
        for (int i = 0; i < 4; ++i) { w0 |= ((unsigned)(int)rintf(sp[i * 33]) & 255u) << (8 * i); w1 |= ((unsigned)(int)rintf(sp[(4 + i) * 33]) & 255u) << (8 * i); }
        u32x2 o; o.x = w0; o.y = w1;
        *(u32x2*)(WT8 + (size_t)(n0 + n) * K + k0 + 8 * c) = o; }
    asm volatile("s_waitcnt lgkmcnt(0)" ::: "memory");
}
constexpr int CW_WCNT = 10752;
constexpr size_t WS_METARAW = 65536;
constexpr int CW_COLMAX3 = 8704;
constexpr int CW_COLMAX2 = 7680;
__device__ __forceinline__ void p0_colmax_item2(const float* W, int N, unsigned* colmax, int item, int lane, const float* g_lo, const float* g_hi, int split) {
    const int nblk = N / 32, kb = item / nblk, nb = item % nblk, k0 = 64 * kb, n0 = 32 * nb;
    float mx = 0.f;
#pragma unroll
    for (int i = 0; i < 32; ++i) { const int k = k0 + 2 * i + (lane >> 5); const float g = (k < split) ? g_lo[k] : g_hi[k - split]; mx = fmaxf(mx, fabsf(W[(size_t)k * N + n0 + (lane & 31)] * g)); }
    mx = fmaxf(mx, __shfl_xor(mx, 32));
    if (lane < 32) atomicMax(colmax + n0 + lane, __float_as_uint(mx));
}
__device__ __forceinline__ void p1_quant_item2(const float* W, int K, int N, signed char* WT8, float* swout, const unsigned* colmax, LAS float* scr, int item, int lane, const float* g_lo, const float* g_hi, int split) {
    const int nblk = N / 32, kb = item / nblk, nb = item % nblk, k0 = 64 * kb, n0 = 32 * nb;
    const float cm = fmaxf(__uint_as_float(__hip_atomic_load((unsigned*)colmax + n0 + (lane & 31), __ATOMIC_RELAXED, __HIP_MEMORY_SCOPE_AGENT)), 1e-30f), inv = 127.f / cm;
    if (kb == 0 && lane < 32) swout[n0 + lane] = cm * (1.f / 127.f);
#pragma unroll
    for (int i = 0; i < 32; ++i) { const int kk = 2 * i + (lane >> 5); const int k = k0 + kk; const float g = (k < split) ? g_lo[k] : g_hi[k - split];
        scr[kk * 33 + (lane & 31)] = W[(size_t)k * N + n0 + (lane & 31)] * g * inv; }
    asm volatile("s_waitcnt lgkmcnt(0)" ::: "memory");
    const int c = lane & 7;
#pragma unroll
    for (int j = 0; j < 4; ++j) { const int n = (lane >> 3) + 8 * j; const LAS float* sp = scr + (8 * c) * 33 + n;
        unsigned w0 = 0u, w1 = 0u;
#pragma unroll
        for (int i = 0; i < 4; ++i) { w0 |= ((unsigned)(int)rintf(sp[i * 33]) & 255u) << (8 * i); w1 |= ((unsigned)(int)rintf(sp[(4 + i) * 33]) & 255u) << (8 * i); }
        u32x2 o; o.x = w0; o.y = w1;
        *(u32x2*)(WT8 + (size_t)(n0 + n) * K + k0 + 8 * c) = o; }
    asm volatile("s_waitcnt lgkmcnt(0)" ::: "memory");
}
__device__ __forceinline__ float q4(float x, float inv_s) {
    const float a = fabsf(x) * inv_s; float r;
    if (a < 2.f) r = rintf(a * 2.f) * 0.5f; else if (a < 4.f) r = rintf(a); else r = fminf(6.f, rintf(a * 0.5f) * 2.f);
    return copysignf(r, x);
}
__device__ __forceinline__ void phase_prep(const Params& P, LAS unsigned char* lds) {
    const int tid = threadIdx.x, lane = tid & 63, wave = __builtin_amdgcn_readfirstlane(tid >> 6);
    const int gw = blockIdx.x * NWAVES + wave, NGW = gridDim.x * NWAVES;
    unsigned char* ws = P.ws;
    LAS float* scr = (LAS float*)(lds + wave * 16384);
    constexpr int I_IN = (DM / 64) * (DIN / 32), I_OUT = (DM / 64) * (DM / 32), I_Q = (DM / 64) * (2048 / 32);
    for (int it = gw; it < I_IN + I_OUT + I_Q; it += NGW) {
        int r = it;
        int grp;
        if (r < I_IN) { p0_colmax_item(P.w_in, DIN, (unsigned*)(ws + WS_CTL) + CW_COLMAX, r, lane, P.g_mix); grp = r % (DIN / 32); }
        else if (r < I_IN + I_OUT) { r -= I_IN; p0_colmax_item2(P.w_out, DM, (unsigned*)(ws + WS_CTL) + CW_COLMAX2, r, lane, P.g_sc, P.g_cf, 512); grp = 80 + r % (DM / 32); }
        else { r -= I_IN + I_OUT; p0_colmax_item2(P.w_q, 2048, (unsigned*)(ws + WS_CTL) + CW_COLMAX3, r, lane, P.g_ffn, P.g_ffn, DM); grp = 112 + r % (2048 / 32); }
        asm volatile("s_waitcnt vmcnt(0)" ::: "memory");
        if (lane == 0) (void)__hip_atomic_fetch_add((unsigned*)(ws + WS_CTL) + CW_WCNT + grp, 1u, __ATOMIC_RELAXED, __HIP_MEMORY_SCOPE_AGENT);
    }
    {
        unsigned* H0I8 = (unsigned*)(ws + WS_H0I8); float* RS1 = (float*)(ws + WS_RSTD1); float* SXp = (float*)(ws + WS_SX);
        for (int t0 = gw * 4; t0 < NTOK; t0 += NGW * 4) {
            f32x4 v[4][4];
#pragma unroll
            for (int q = 0; q < 4; ++q) { const f32x4* xr = (const f32x4*)(P.x + (size_t)(t0 + q) * DM) + lane;
#pragma unroll
                for (int j = 0; j < 4; ++j) v[q][j] = xr[64 * j]; }
#pragma unroll
            for (int q = 0; q < 4; ++q) { float sq = 0.f, mx = 0.f;
#pragma unroll
                for (int j = 0; j < 4; ++j) { sq += (v[q][j].x * v[q][j].x + v[q][j].y * v[q][j].y) + (v[q][j].z * v[q][j].z + v[q][j].w * v[q][j].w);
                    mx = fmaxf(mx, fmaxf(fmaxf(fabsf(v[q][j].x), fabsf(v[q][j].y)), fmaxf(fabsf(v[q][j].z), fabsf(v[q][j].w)))); }
                sq = wave_sum_fast(sq); mx = fmaxf(wave_max_fast(mx), 1e-30f);
                const float sx = mx * (1.f / 127.f), inv = 127.f / mx;
                if (lane == 0) { RS1[t0 + q] = sx * rsqrtf(sq * (1.f / DM) + EPS); SXp[t0 + q] = sx; }
                unsigned* o = H0I8 + (size_t)(t0 + q) * (DM / 4) + lane;
#pragma unroll
                for (int j = 0; j < 4; ++j) { const int a = (int)rintf(v[q][j].x * inv), b = (int)rintf(v[q][j].y * inv), c = (int)rintf(v[q][j].z * inv), d = (int)rintf(v[q][j].w * inv);
                    o[64 * j] = ((unsigned)a & 255u) | (((unsigned)b & 255u) << 8) | (((unsigned)c & 255u) << 16) | ((unsigned)d << 24); } }
        }
    }
    {
        bf16* KB = (bf16*)(ws + WS_KEYS);
        const int gt = blockIdx.x * NTHREADS + tid, NGT = gridDim.x * NTHREADS;
        for (int i = gt; i < 8 * 2 * 128 * 128 / 4; i += NGT) { const f32x4 v = ((const f32x4*)P.keys)[i]; u32x2 w; w.x = pk2(v.x, v.y); w.y = pk2(v.z, v.w); ((u32x2*)KB)[i] = w; }
    }
    {
        float* MP = (float*)(ws + WS_CTL + WS_METARAW); float* MR = (float*)(ws + WS_METARSTD);
        for (int r = gw; r < NMETA; r += NGW) {
            float s = 0.f;
            for (int k = lane; k < DM; k += 64) { const float v = P.meta[r * DM + k]; s += v * v; }
            s = wave_sum(s);
            if (lane == 0) MR[r] = rsqrtf(s * (1.f / DM) + EPS);
        }
        for (int it = gw; it < MKC * 40; it += NGW) {
            const int kc = it / 40, nb = it % 40, n = nb * 64 + lane;
            float acc[NMETA];
#pragma unroll
            for (int r = 0; r < NMETA; ++r) acc[r] = 0.f;
            for (int k = kc * (DM / MKC); k < (kc + 1) * (DM / MKC); ++k) {
                const float w = P.w_in[(size_t)k * DIN + n] * P.g_mix[k];
#pragma unroll
                for (int r = 0; r < NMETA; ++r) acc[r] += P.meta[r * DM + k] * w;
            }
#pragma unroll
            for (int r = 0; r < NMETA; ++r) (void)__hip_atomic_fetch_add(MP + (size_t)r * DIN + n, acc[r], __ATOMIC_RELAXED, __HIP_MEMORY_SCOPE_AGENT);
        }
    }
    {
        constexpr int NI1 = (DM / 64) * (DIN / 32), NI2 = (DM / 64) * (DM / 32), NI3 = (DM / 64) * (2048 / 32);
        unsigned* cnt = (unsigned*)(ws + WS_CTL) + CW_WCNT;
        for (int it = gw; it < NI1 + NI2 + NI3; it += NGW) {
            int grp;
            if (it < NI1) grp = win_src_col(32 * (it % (DIN / 32))) / 32; else if (it < NI1 + NI2) grp = 80 + (it - NI1) % (DM / 32); else grp = 112 + (it - NI1 - NI2) % (2048 / 32);
            { unsigned sp = 0; while (__hip_atomic_load(cnt + grp, __ATOMIC_RELAXED, __HIP_MEMORY_SCOPE_AGENT) < 16u) { __builtin_amdgcn_s_sleep(2); if (++sp > (1u << 20)) break; } }
            if (it < NI1) p1_quant_item(P.w_in, DM, DIN, (signed char*)(ws + WS_WIN_T), (float*)(ws + WS_SW), (const unsigned*)(ws + WS_CTL) + CW_COLMAX, scr, it, lane, P.g_mix);
            else if (it < NI1 + NI2) p1_quant_item2(P.w_out, DM, DM, (signed char*)(ws + WS_WOUT_T), (float*)(ws + WS_SWO), (const unsigned*)(ws + WS_CTL) + CW_COLMAX2, scr, it - NI1, lane, P.g_sc, P.g_cf, 512);
            else p1_quant_item2(P.w_q, DM, 2048, (signed char*)(ws + WS_WQ_T), (float*)(ws + WS_SWQ), (const unsigned*)(ws + WS_CTL) + CW_COLMAX3, scr, it - NI1 - NI2, lane, P.g_ffn, P.g_ffn, DM);
        }
    }
}

__device__ __forceinline__ float metaval(const float* RAW, const float* MR, int p, int c) {
    const float r = MR[p]; const float* rp = RAW + (size_t)p * DIN;
    if (c < 512) return (rp[c] * r) * (rp[1024 + c] * r);
    if (c < 1024) return rp[c] * r;
    return (rp[1536 + (c - 1024)] * r) * sigmoid_f(rp[2048 + (c - 1024)] * r);
}
__device__ __forceinline__ float meta_val(const float* MJ, const float*, int p, int col) { return MJ[p * PDIM + col]; }
__device__ __forceinline__ float proj_at(const bf16* PROJ, const float* MP, const float* MR, int b, int pos, int col) {
    if (pos < 0) return 0.f;
    if (pos < NMETA) return meta_val(MP, MR, pos, col);
    return bf2f(PROJ[(size_t)(b * SEQ + pos - NMETA) * PDIM + col]);
}
struct TabRow { f32x4 v[4]; };
__device__ __forceinline__ void tab_load(const Params& P, int e, int lane, TabRow& r) {
    const bool isv = e >= 16384; const int ee = isv ? e - 16384 : e;
    const f32x4* src = (const f32x4*)((isv ? P.pv : P.pu) + (size_t)ee * DM);
#pragma unroll
    for (int j = 0; j < 4; ++j) r.v[j] = isv ? src[4 * lane + j] : src[64 * j + lane];
}
__device__ __forceinline__ void tab_finish(const Params& P, int e, int lane, TabRow& r) {
    unsigned char* ws = P.ws; float* ESC = (float*)(ws + WS_ESCALE);
    const bool isv = e >= 16384; const int ee = isv ? e - 16384 : e;
    float mx = 0.f;
#pragma unroll
    for (int j = 0; j < 4; ++j) { if (!isv) r.v[j] = r.v[j] * ((const f32x4*)P.g_ffn)[64 * j + lane];
        mx = fmaxf(mx, fmaxf(fmaxf(fabsf(r.v[j].x), fabsf(r.v[j].y)), fmaxf(fabsf(r.v[j].z), fabsf(r.v[j].w)))); }
    mx = wave_max_fast(mx);
    if (!isv) {
        float sq2 = 0.f;
#pragma unroll
        for (int j = 0; j < 4; ++j) sq2 += (r.v[j].x * r.v[j].x + r.v[j].y * r.v[j].y) + (r.v[j].z * r.v[j].z + r.v[j].w * r.v[j].w);
        const float rms = sqrtf(wave_sum_fast(sq2) * (1.f / DM));
        const float su = fmaxf(fminf(mx, U4_CLIP * rms), 1e-30f) * (1.f / 7.f), inv = 1.f / su;
        unsigned wq[2] = {0u, 0u}; int csum = 0;
#pragma unroll
        for (int j = 0; j < 4; ++j) { const float e4[4] = {r.v[j].x, r.v[j].y, r.v[j].z, r.v[j].w};
#pragma unroll
            for (int i = 0; i < 4; ++i) { int c = (int)rintf(fminf(fmaxf(e4[i] * inv, -7.f), 7.f)); csum += c;
                wq[j >> 1] |= ((unsigned)c & 15u) << (16 * (j & 1) + 4 * i); } }
        const float cs = wave_sum_fast((float)csum);
        if (lane == 0) { ESC[e] = su; ((float*)(ws + WS_SUMQ))[e] = cs; }
        u32x2 o; o.x = wq[0]; o.y = wq[1];
        *(u32x2*)(ws + WS_U8 + (size_t)ee * 512 + 8 * lane) = o;
        return;
    }
    const float sc = fmaxf(mx, 1e-30f) * (1.f / 6.f), inv = 1.f / sc;
    if (lane == 0) ESC[e] = sc;
    unsigned w0 = 0u, w1 = 0u;
    w0 = __builtin_amdgcn_cvt_scalef32_pk_fp4_f32(w0, r.v[0].x * inv, r.v[0].y * inv, 1.0f, 0); w0 = __builtin_amdgcn_cvt_scalef32_pk_fp4_f32(w0, r.v[0].z * inv, r.v[0].w * inv, 1.0f, 1);
    w0 = __builtin_amdgcn_cvt_scalef32_pk_fp4_f32(w0, r.v[1].x * inv, r.v[1].y * inv, 1.0f, 2); w0 = __builtin_amdgcn_cvt_scalef32_pk_fp4_f32(w0, r.v[1].z * inv, r.v[1].w * inv, 1.0f, 3);
    w1 = __builtin_amdgcn_cvt_scalef32_pk_fp4_f32(w1, r.v[2].x * inv, r.v[2].y * inv, 1.0f, 0); w1 = __builtin_amdgcn_cvt_scalef32_pk_fp4_f32(w1, r.v[2].z * inv, r.v[2].w * inv, 1.0f, 1);
    w1 = __builtin_amdgcn_cvt_scalef32_pk_fp4_f32(w1, r.v[3].x * inv, r.v[3].y * inv, 1.0f, 2); w1 = __builtin_amdgcn_cvt_scalef32_pk_fp4_f32(w1, r.v[3].z * inv, r.v[3].w * inv, 1.0f, 3);
    u32x2 o; o.x = w0; o.y = w1;
    *(u32x2*)(ws + WS_V8 + (size_t)ee * 512 + 8 * lane) = o;
}
__device__ __forceinline__ void proj8_at(const bf16* PROJ, const float* MP, const float* MR, int b, int pos, int col, float (&v)[8]) {
    if (pos < 0) {
#pragma unroll
        for (int i = 0; i < 8; ++i) v[i] = 0.f;
    } else if (pos < NMETA) {
#pragma unroll
        for (int i = 0; i < 8; ++i) v[i] = metaval(MP, MR, pos, col + i);
    } else {
        const u32x4 w = *(const u32x4*)(PROJ + (size_t)(b * SEQ + pos - NMETA) * PDIM + col);
        v[0] = bflo(w.x); v[1] = bfhi(w.x); v[2] = bflo(w.y); v[3] = bfhi(w.y); v[4] = bflo(w.z); v[5] = bfhi(w.z); v[6] = bflo(w.w); v[7] = bfhi(w.w);
    }
}

template <int R> __device__ __forceinline__ void conv_rows(const LAS unsigned char* ubase, const f32x2 (&wcf)[31], f32x2 (&acc)[32]) {
    if constexpr (R < 62) {
        const unsigned uw = *(const LAS unsigned*)(ubase + R * 1024);
        const f32x2 x = (f32x2){bflo(uw), bfhi(uw)};
        constexpr int lo = R > 30 ? R - 30 : 0, hi = R < 31 ? R : 31;
#pragma unroll
        for (int ii = lo; ii <= hi; ++ii) acc[ii] += wcf[R - ii] * x;
        conv_rows<R + 1>(ubase, wcf, acc);
    }
}
__device__ __forceinline__ void phase_conv(const Params& P, LAS unsigned char* lds) {
    const int tid = threadIdx.x, lane = tid & 63, wave = __builtin_amdgcn_readfirstlane(tid >> 6);
    unsigned char* ws = P.ws;
    const bf16* PROJ = (const bf16*)(ws + WS_PROJ); const float* MP = (const float*)(ws + WS_CTL + WS_METARAW); const float* MR = (const float*)(ws + WS_METARSTD);
    bf16* Y = (bf16*)(ws + WS_Y);
    constexpr int TT = 64, NTILE = NTOK / TT, UROWS = TT + 30;
    const int cgp = wave & 3, th = wave >> 2, ch2 = cgp * 128 + 2 * lane;
    f32x2 wcf[31];
#pragma unroll
    for (int j = 0; j < 31; ++j) wcf[j] = *(const f32x2*)(P.cf_w + j * 512 + ch2);
    const f32x2 bcf = *(const f32x2*)(P.cf_b + ch2);
    for (int tile = blockIdx.x; tile < NTILE; tile += gridDim.x) {
        const int b = tile / (SEQ / TT), s0 = (tile % (SEQ / TT)) * TT;
        if (s0 >= 30) {
            const bf16* pr = PROJ + ((size_t)b * SEQ + s0 - 30) * PDIM + 1024 + 8 * lane;
            u32x4 rw[(UROWS + 7) / 8];
#pragma unroll
            for (int p = 0; p < (UROWS + 7) / 8; ++p) { const int r = p * 8 + wave; rw[p] = *(const u32x4*)(pr + (size_t)(r < UROWS ? r : UROWS - 1) * PDIM); }
#pragma unroll
            for (int p = 0; p < (UROWS + 7) / 8; ++p) { const int r = p * 8 + wave; if (r < UROWS) *(LAS u32x4*)(lds + r * 1024 + lane * 16) = rw[p]; }
        } else {
#pragma unroll 4
        for (int p = 0; p < (UROWS + 7) / 8; ++p) {
            const int r = p * 8 + wave;
            if (r < UROWS) {
                const int pos = NMETA + s0 - 30 + r;
                float uu[8];
                proj8_at(PROJ, MP, MR, b, pos, 1024 + 8 * lane, uu);
                u32x4 w; w.x = pk2(uu[0], uu[1]); w.y = pk2(uu[2], uu[3]); w.z = pk2(uu[4], uu[5]); w.w = pk2(uu[6], uu[7]);
                *(LAS u32x4*)(lds + r * 1024 + lane * 16) = w;
            }
        }
        }
        __syncthreads();
        f32x2 acc[32];
#pragma unroll
        for (int ii = 0; ii < 32; ++ii) acc[ii] = bcf;
        conv_rows<0>(lds + (32 * th) * 1024 + ch2 * 2, wcf, acc);
        u32x4 rcx[8], rbg[8];
        { const bf16* pr = PROJ + ((size_t)b * SEQ + s0 + 8 * wave) * PDIM + 8 * lane;
#pragma unroll
          for (int q = 0; q < 8; ++q) { rcx[q] = *(const u32x4*)(pr + (size_t)q * PDIM); rbg[q] = *(const u32x4*)(pr + (size_t)q * PDIM + 512); } }
        __syncthreads();
#pragma unroll
        for (int ii = 0; ii < 32; ++ii) *(LAS f32x2*)(lds + (32 * th + ii) * 2048 + ch2 * 4) = acc[ii];
        __syncthreads();
        {
            float lng[8], lnb[8];
            { const f32x4 a = *(const f32x4*)(P.ln_g + 8 * lane), c = *(const f32x4*)(P.ln_g + 8 * lane + 4), d = *(const f32x4*)(P.ln_b + 8 * lane), e = *(const f32x4*)(P.ln_b + 8 * lane + 4);
              lng[0] = a.x; lng[1] = a.y; lng[2] = a.z; lng[3] = a.w; lng[4] = c.x; lng[5] = c.y; lng[6] = c.z; lng[7] = c.w;
              lnb[0] = d.x; lnb[1] = d.y; lnb[2] = d.z; lnb[3] = d.w; lnb[4] = e.x; lnb[5] = e.y; lnb[6] = e.z; lnb[7] = e.w; }
            float wsc[3][8];
#pragma unroll
            for (int j = 0; j < 3; ++j) { const f32x4 a = *(const f32x4*)(P.sc_w + j * 512 + 8 * lane), c = *(const f32x4*)(P.sc_w + j * 512 + 8 * lane + 4);
                wsc[j][0] = a.x; wsc[j][1] = a.y; wsc[j][2] = a.z; wsc[j][3] = a.w; wsc[j][4] = c.x; wsc[j][5] = c.y; wsc[j][6] = c.z; wsc[j][7] = c.w; }
            float cxa[8], cxb[8];
            { const int pos = NMETA + s0 + 8 * wave - 2;
              proj8_at(PROJ, MP, MR, b, pos, 8 * lane, cxa); proj8_at(PROJ, MP, MR, b, pos + 1, 8 * lane, cxb); }
#pragma unroll
            for (int q = 0; q < 8; ++q) {
                const int ii = 8 * wave + q, s = s0 + ii; const size_t t = (size_t)b * SEQ + s;
                float o[8];
                { const f32x4 a = *(const LAS f32x4*)(lds + ii * 2048 + lane * 32), c = *(const LAS f32x4*)(lds + ii * 2048 + lane * 32 + 16);
                  o[0] = a.x; o[1] = a.y; o[2] = a.z; o[3] = a.w; o[4] = c.x; o[5] = c.y; o[6] = c.z; o[7] = c.w; }
                float s1 = 0.f;
#pragma unroll
                for (int i = 0; i < 8; ++i) s1 += o[i];
                const float mean = wave_sum_fast(s1) * (1.f / 512.f);
                float s2 = 0.f;
#pragma unroll
                for (int i = 0; i < 8; ++i) { o[i] -= mean; s2 += o[i] * o[i]; }
                const float rs = rsqrtf(wave_sum_fast(s2) * (1.f / 512.f) + EPS);
                float s3 = 0.f;
#pragma unroll
                for (int i = 0; i < 8; ++i) { float y = o[i] * rs * lng[i] + lnb[i]; y = y * sigmoid_f(y); o[i] = y; s3 += y * y; }
                const float r2 = rsqrtf(wave_sum_fast(s3) * (1.f / 512.f) + EPS);
                float bgv[8], cxc[8], accs[8];
                { const u32x4 w = rcx[q], z = rbg[q];
                  cxc[0] = bflo(w.x); cxc[1] = bfhi(w.x); cxc[2] = bflo(w.y); cxc[3] = bfhi(w.y); cxc[4] = bflo(w.z); cxc[5] = bfhi(w.z); cxc[6] = bflo(w.w); cxc[7] = bfhi(w.w);
                  bgv[0] = bflo(z.x); bgv[1] = bfhi(z.x); bgv[2] = bflo(z.y); bgv[3] = bfhi(z.y); bgv[4] = bflo(z.z); bgv[5] = bfhi(z.z); bgv[6] = bflo(z.w); bgv[7] = bfhi(z.w); }
                float s4 = 0.f;
#pragma unroll
                for (int i = 0; i < 8; ++i) { accs[i] = bgv[i] * (wsc[0][i] * cxa[i] + wsc[1][i] * cxb[i] + wsc[2][i] * cxc[i]); s4 += accs[i] * accs[i]; cxa[i] = cxb[i]; cxb[i] = cxc[i]; }
                const float r4 = rsqrtf(wave_sum_fast(s4) * (1.f / 512.f) + EPS);
                float ym = 0.f;
#pragma unroll
                for (int i = 0; i < 8; ++i) { o[i] *= r2; accs[i] *= r4; ym = fmaxf(ym, fmaxf(fabsf(o[i]), fabsf(accs[i]))); }
                ym = fmaxf(wave_max_fast(ym), 1e-30f);
                const float yinv = 127.f * __builtin_amdgcn_rcpf(ym);
                if (lane == 0) ((float*)(ws + WS_SY))[t] = ym * (1.f / 127.f);
                u32x2 wz, wv;
                { unsigned fa[8], fo[8];
#pragma unroll
                  for (int i = 0; i < 8; ++i) { fa[i] = __float_as_uint(fmaf(accs[i], yinv, 12582912.f)); fo[i] = __float_as_uint(fmaf(o[i], yinv, 12582912.f)); }
                  wz.x = __builtin_amdgcn_perm(fa[1], fa[0], 0x0c0c0400u) | __builtin_amdgcn_perm(fa[3], fa[2], 0x04000c0cu);
                  wz.y = __builtin_amdgcn_perm(fa[5], fa[4], 0x0c0c0400u) | __builtin_amdgcn_perm(fa[7], fa[6], 0x04000c0cu);
                  wv.x = __builtin_amdgcn_perm(fo[1], fo[0], 0x0c0c0400u) | __builtin_amdgcn_perm(fo[3], fo[2], 0x04000c0cu);
                  wv.y = __builtin_amdgcn_perm(fo[5], fo[4], 0x0c0c0400u) | __builtin_amdgcn_perm(fo[7], fo[6], 0x04000c0cu); }
                *(u32x2*)(ws + WS_Y + t * DM + 8 * lane) = wz;
                *(u32x2*)(ws + WS_Y + t * DM + 512 + 8 * lane) = wv;
            }
        }
        __syncthreads();
    }
}

__device__ __forceinline__ int ord_i(float s) { int k = __builtin_bit_cast(int, s); k ^= (k >> 31) & 0x7fffffff; return k; }
__device__ __forceinline__ float unord_f(int k) { k ^= (k >> 31) & 0x7fffffff; return __builtin_bit_cast(float, k); }
#define TOP_INSERT(L, x_) do { int _x = (x_); _Pragma("unroll") for (int _i = 0; _i < 16; ++_i) { const int _hi = max(L[_i], _x); _x = min(L[_i], _x); L[_i] = _hi; } } while (0)

typedef short bf16x8 __attribute__((ext_vector_type(8)));
typedef float f32x16 __attribute__((ext_vector_type(16)));
template <bool DESC> __device__ __forceinline__ void ce_i(int& a, int& b) { const int hi = max(a, b), lo = min(a, b); if (DESC) { a = hi; b = lo; } else { a = lo; b = hi; } }
__device__ __forceinline__ void bitonic_sort16(int (&a)[16]) {
#pragma unroll
    for (int k = 2; k <= 16; k <<= 1)
#pragma unroll
        for (int j = k >> 1; j > 0; j >>= 1)
#pragma unroll
            for (int i = 0; i < 16; ++i) { const int l = i ^ j; if (l > i) { if ((i & k) == 0) ce_i<true>(a[i], a[l]); else ce_i<false>(a[i], a[l]); } }
}
__device__ __forceinline__ void bitonic_merge16(int (&a)[16]) {
#pragma unroll
    for (int j = 8; j > 0; j >>= 1)
#pragma unroll
        for (int i = 0; i < 16; ++i) { const int l = i ^ j; if (l > i) ce_i<true>(a[i], a[l]); }
}
__device__ __forceinline__ void merge_top16(int (&a)[16], const int (&b)[16]) {
#pragma unroll
    for (int i = 0; i < 16; ++i) a[i] = max(a[i], b[15 - i]);
    bitonic_merge16(a);
}
__device__ __forceinline__ int lut16(const unsigned (&T)[4], int i) {
    const unsigned sel = (unsigned)(i & 7) | 0x0c0c0c00u;
    const unsigned lo = __builtin_amdgcn_perm(T[1], T[0], sel), hi = __builtin_amdgcn_perm(T[3], T[2], sel);
    return (int)((i & 8) ? hi : lo);
}
constexpr int KROW = 272;
constexpr float SCORE_BIAS = 8.0f;

__device__ __forceinline__ void route_load_q(bf16x8 (&qf)[8], const bf16* qrow, int hb) {
#pragma unroll
    for (int ks = 0; ks < 8; ++ks) qf[ks] = *(const bf16x8*)(qrow + 64 * hb + 8 * ks);
}
__device__ __forceinline__ void route_half(const LAS unsigned char* kl, const bf16x8 (&qf)[8], int nl, int hb, int (&L)[16]) {
    f32x16 acc[4];
#pragma unroll
    for (int nt = 0; nt < 4; ++nt)
#pragma unroll
        for (int r = 0; r < 16; ++r) acc[nt][r] = SCORE_BIAS;
#pragma unroll
    for (int ks = 0; ks < 8; ++ks)
#pragma unroll
        for (int nt = 0; nt < 4; ++nt) {
            const bf16x8 a = *(const LAS bf16x8*)(kl + (32 * nt + nl) * KROW + (64 * hb + 8 * ks) * 2);
            acc[nt] = __builtin_amdgcn_mfma_f32_32x32x16_bf16(a, qf[ks], acc[nt], 0, 0, 0);
        }
    const int hb4 = 4 * hb;
    int T[4][16];
#pragma unroll
    for (int nt = 0; nt < 4; ++nt)
#pragma unroll
        for (int r = 0; r < 16; ++r) { const int n0 = 32 * nt + (r & 3) + 8 * (r >> 2); const float sc = acc[nt][r];
            T[nt][r] = (__float_as_int(sc) & ~127) | ((127 - n0) - hb4); }
    bitonic_sort16(T[0]); bitonic_sort16(T[1]); bitonic_sort16(T[2]); bitonic_sort16(T[3]);
    merge_top16(T[0], T[1]); merge_top16(T[2], T[3]); merge_top16(T[0], T[2]);
#pragma unroll
    for (int i = 0; i < 16; ++i) { const unsigned v = (unsigned)T[0][15 - i]; auto r = __builtin_amdgcn_permlane32_swap(v, v, false, false);
        const unsigned r0 = r[0], r1 = r[1]; const int partner = (int)(hb ? r0 : r1); L[i] = max(T[0][i], partner); }
    bitonic_merge16(L);
}

__device__ __forceinline__ void phase_route(const Params& P, LAS unsigned char* lds) {
    const int tid = threadIdx.x, lane = tid & 63, wave = __builtin_amdgcn_readfirstlane(tid >> 6);
    const int nl = lane & 31, hb = lane >> 5;
    unsigned char* ws = P.ws;
    const bf16* KEYS = (const bf16*)(ws + WS_KEYS); const bf16* Q = (const bf16*)(ws + WS_Q);
    int* IDX = (int*)(ws + WS_IDX); float* GATE = (float*)(ws + WS_GATE);
    int last_h = -1;
    pg8::StaticOrder S; S.init(NTOK, 2048, (int)gridDim.x, (int)blockIdx.x);
    pg8::Unit ucur, unxt;
    bool have = S.next(0, ucur);
    bf16x8 qfA[8], qfB[8];
    if (have) route_load_q(qfA, Q + ((size_t)ucur.pm * 256 + wave * 32 + nl) * 2048 + ucur.pn * 256, hb);
    for (int ui = 0; have; ++ui) {
        const int h = ucur.pn, tb = ucur.pm;
        const bool have_next = S.next(ui + 1, unxt);
        if (h != last_h) {
            __syncthreads();
            for (int c = tid; c < 4096; c += NTHREADS) { const u32x4 v = ((const u32x4*)(KEYS + (size_t)h * 32768))[c];
                *(LAS u32x4*)(lds + (c >> 4) * KROW + (c & 15) * 16) = v; }
            __syncthreads();
            last_h = h;
        }
        const size_t t = (size_t)tb * 256 + wave * 32 + nl;
        int L1[16], L2[16];
        route_load_q(qfB, Q + t * 2048 + h * 256 + 128, hb);
        route_half(lds, qfA, nl, hb, L1);
        if (have_next) route_load_q(qfA, Q + ((size_t)unxt.pm * 256 + wave * 32 + nl) * 2048 + unxt.pn * 256, hb);
        route_half(lds + 128 * KROW, qfB, nl, hb, L2);
        float v1[16], v2[16];
#pragma unroll
        for (int i = 0; i < 16; ++i) { v1[i] = __int_as_float(L1[i] & ~127); v2[i] = __int_as_float(L2[i] & ~127); }
#define CAND(i, j) ((__float_as_int(v1[i] + v2[j]) & ~255) | (255 - (16 * (i) + (j))))
        int A[16], B[16], C[16];
#pragma unroll
        for (int j = 0; j < 16; ++j) A[j] = CAND(0, j);
#pragma unroll
        for (int j = 0; j < 8; ++j) { B[j] = CAND(1, j); B[8 + j] = CAND(15 - j, 0); }
        bitonic_merge16(B);
        C[0] = CAND(2, 0); C[1] = CAND(2, 1); C[2] = CAND(2, 2); C[3] = CAND(2, 3); C[4] = CAND(2, 4);
        C[5] = CAND(3, 0); C[6] = CAND(3, 1); C[7] = CAND(3, 2); C[8] = CAND(3, 3);
        C[9] = CAND(4, 0); C[10] = CAND(4, 1); C[11] = CAND(4, 2);
        C[12] = CAND(5, 0); C[13] = CAND(5, 1); C[14] = CAND(6, 0); C[15] = CAND(6, 1);
        bitonic_sort16(C);
        { const int d0 = CAND(7, 0), d1 = CAND(7, 1); C[14] = max(C[14], d1); C[15] = max(C[15], d0); bitonic_merge16(C); }
#undef CAND
        merge_top16(A, B); merge_top16(A, C);
        unsigned T1[4], T2[4];
#pragma unroll
        for (int q = 0; q < 4; ++q) {
            T1[q] = (unsigned)(127 - (L1[4 * q] & 127)) | ((unsigned)(127 - (L1[4 * q + 1] & 127)) << 8) | ((unsigned)(127 - (L1[4 * q + 2] & 127)) << 16) | ((unsigned)(127 - (L1[4 * q + 3] & 127)) << 24);
            T2[q] = (unsigned)(127 - (L2[4 * q] & 127)) | ((unsigned)(127 - (L2[4 * q + 1] & 127)) << 8) | ((unsigned)(127 - (L2[4 * q + 2] & 127)) << 16) | ((unsigned)(127 - (L2[4 * q + 3] & 127)) << 24); }
        float val[16]; int ex[16];
#pragma unroll
        for (int k = 0; k < 16; ++k) { const int pos = 255 - (A[k] & 255); val[k] = __int_as_float(A[k] & ~255);
            ex[k] = lut16(T1, pos >> 4) * NKEYS + lut16(T2, pos & 15); }
        float sum = 0.f; const float vmax = val[0];
#pragma unroll
        for (int k = 0; k < 16; ++k) { val[k] = __expf(val[k] - vmax); sum += val[k]; }
        const float inv = __builtin_amdgcn_rcpf(sum);
        if (hb == 0) {
            int* ip = IDX + t * NSEL + h * TOPK; float* gp = GATE + t * NSEL + h * TOPK;
#pragma unroll
            for (int k4 = 0; k4 < 4; ++k4) {
                *(int4*)(ip + 4 * k4) = make_int4(ex[4 * k4], ex[4 * k4 + 1], ex[4 * k4 + 2], ex[4 * k4 + 3]);
                *(f32x4*)(gp + 4 * k4) = (f32x4){val[4 * k4] * inv, val[4 * k4 + 1] * inv, val[4 * k4 + 2] * inv, val[4 * k4 + 3] * inv};
            }
        }
        ucur = unxt; have = have_next;
    }
}

#define FP4X2(w, sel) __builtin_amdgcn_cvt_scalef32_pk_f32_fp4((w), 1.0f, (sel))
__device__ __forceinline__ float dot16_fp4(const u32x2 r, const f32x4 (&xs)[4]) {
    float p = 0.f;
    { const f32x2 a = FP4X2(r.x, 0), b = FP4X2(r.x, 1), c = FP4X2(r.x, 2), d = FP4X2(r.x, 3);
      p += (a.x * xs[0].x + a.y * xs[0].y) + (b.x * xs[0].z + b.y * xs[0].w); p += (c.x * xs[1].x + c.y * xs[1].y) + (d.x * xs[1].z + d.y * xs[1].w); }
    { const f32x2 a = FP4X2(r.y, 0), b = FP4X2(r.y, 1), c = FP4X2(r.y, 2), d = FP4X2(r.y, 3);
      p += (a.x * xs[2].x + a.y * xs[2].y) + (b.x * xs[2].z + b.y * xs[2].w); p += (c.x * xs[3].x + c.y * xs[3].y) + (d.x * xs[3].z + d.y * xs[3].w); }
    return p;
}
__device__ __forceinline__ void axpy16_fp4(const u32x2 r, float w, f32x4 (&o)[4]) {
    { const f32x2 a = FP4X2(r.x, 0), b = FP4X2(r.x, 1), c = FP4X2(r.x, 2), d = FP4X2(r.x, 3);
      o[0].x += w * a.x; o[0].y += w * a.y; o[0].z += w * b.x; o[0].w += w * b.y; o[1].x += w * c.x; o[1].y += w * c.y; o[1].z += w * d.x; o[1].w += w * d.y; }
    { const f32x2 a = FP4X2(r.y, 0), b = FP4X2(r.y, 1), c = FP4X2(r.y, 2), d = FP4X2(r.y, 3);
      o[2].x += w * a.x; o[2].y += w * a.y; o[2].z += w * b.x; o[2].w += w * b.y; o[3].x += w * c.x; o[3].y += w * c.y; o[3].z += w * d.x; o[3].w += w * d.y; }
}
__device__ __forceinline__ float swap32_add(float a, float b) { auto r = __builtin_amdgcn_permlane32_swap(__float_as_uint(a), __float_as_uint(b), false, false); return __uint_as_float(r[0]) + __uint_as_float(r[1]); }
__device__ __forceinline__ float swap16_add(float a, float b) { auto r = __builtin_amdgcn_permlane16_swap(__float_as_uint(a), __float_as_uint(b), false, false); return __uint_as_float(r[0]) + __uint_as_float(r[1]); }
__device__ __forceinline__ float row_sum16(float v) { v += dpp_f<0xB1>(v); v += dpp_f<0x4E>(v); v += dpp_f<0x141>(v); v += dpp_f<0x140>(v); return v; }
__device__ __forceinline__ float row_max16(float v) { v = fmaxf(v, dpp_f<0xB1>(v)); v = fmaxf(v, dpp_f<0x4E>(v)); v = fmaxf(v, dpp_f<0x141>(v)); v = fmaxf(v, dpp_f<0x140>(v)); return v; }
constexpr int GB = 32;
typedef __attribute__((address_space(8))) void* rsrc_t;
__device__ __forceinline__ void g_issue(u32x2 (&buf)[GB], __amdgpu_buffer_rsrc_t rs, int idxr, int lb, int voff) {
#pragma unroll
    for (int j = 0; j < GB; ++j) { const int e = __builtin_amdgcn_readlane(idxr, lb + j); buf[j] = __builtin_amdgcn_raw_buffer_load_b64(rs, voff, e * 512, 0); }
}
__device__ __forceinline__ float dot16_fp4p(const u32x2 r, const f32x2 (&xp)[8]) {
    f32x2 a = FP4X2(r.x, 0) * xp[0];
    a += FP4X2(r.x, 1) * xp[1]; a += FP4X2(r.x, 2) * xp[2]; a += FP4X2(r.x, 3) * xp[3];
    a += FP4X2(r.y, 0) * xp[4]; a += FP4X2(r.y, 1) * xp[5]; a += FP4X2(r.y, 2) * xp[6]; a += FP4X2(r.y, 3) * xp[7];
    return a.x + a.y;
}
__device__ __forceinline__ void axpy16_fp4p(const u32x2 r, float w, f32x2 (&o)[8]) {
    const f32x2 ww = (f32x2){w, w};
    o[0] += FP4X2(r.x, 0) * ww; o[1] += FP4X2(r.x, 1) * ww; o[2] += FP4X2(r.x, 2) * ww; o[3] += FP4X2(r.x, 3) * ww;
    o[4] += FP4X2(r.y, 0) * ww; o[5] += FP4X2(r.y, 1) * ww; o[6] += FP4X2(r.y, 2) * ww; o[7] += FP4X2(r.y, 3) * ww;
}
template <int H> __device__ __forceinline__ void g_compute_u(const u32x2 (&buf)[GB], int q, int i16, const f32x2 (&xp)[8], float& zlo, float& zhi) {
    float p[16];
#pragma unroll
    for (int j = 0; j < 16; ++j) p[j] = dot16_fp4p(buf[16 * H + j], xp);
    float s1[8], s2[4];
#pragma unroll
    for (int m = 0; m < 8; ++m) s1[m] = swap32_add(p[2 * m], p[2 * m + 1]);
#pragma unroll
    for (int n = 0; n < 4; ++n) s2[n] = swap16_add(s1[2 * n], s1[2 * n + 1]);
#pragma unroll
    for (int r = 0; r < 4; ++r) { const float z = row_sum16(s2[r]); const bool mine = i16 == ((4 * q + r) & 15);
        zlo = (mine && q < 4) ? z : zlo; zhi = (mine && q >= 4) ? z : zhi; }
}
template <int H> __device__ __forceinline__ void g_compute_v(const u32x2 (&buf)[GB], int q, float alo, float ahi, f32x2 (&o)[8]) {
    const int areg = __builtin_bit_cast(int, (q < 4) ? alo : ahi), sb = 4 * (q & 3);
#pragma unroll
    for (int j = 0; j < 16; ++j) { const int src = 32 * (j & 1) + 16 * ((j >> 1) & 1) + (j >> 2) + sb;
        const float w = __builtin_bit_cast(float, __builtin_amdgcn_readlane(areg, src));
        axpy16_fp4p(buf[16 * H + j], w, o); }
}
__device__ __forceinline__ void q_issue(u32x2 (&buf)[16], __amdgpu_buffer_rsrc_t rs, int ixr  , int lb, int voff) {
#pragma unroll
    for (int j = 0; j < 16; ++j) { const int e9 = __builtin_amdgcn_readlane(ixr, lb + j); buf[j] = __builtin_amdgcn_raw_buffer_load_b64(rs, voff, e9, 0); }
}
__device__ __forceinline__ void q_compute_u(const u32x2 (&buf)[16], int q, int i16, const f32x2 (&xp)[8], float& zlo, float& zhi) {
    float p[16];
#pragma unroll
    for (int j = 0; j < 16; ++j) p[j] = dot16_fp4p(buf[j], xp);
    float s1[8], s2[4];
#pragma unroll
    for (int m = 0; m < 8; ++m) s1[m] = swap32_add(p[2 * m], p[2 * m + 1]);
#pragma unroll
    for (int n = 0; n < 4; ++n) s2[n] = swap16_add(s1[2 * n], s1[2 * n + 1]);
#pragma unroll
    for (int r = 0; r < 4; ++r) { const float z = row_sum16(s2[r]); const bool mine = i16 == ((4 * q + r) & 15);
        zlo = (mine && q < 4) ? z : zlo; zhi = (mine && q >= 4) ? z : zhi; }
}
typedef _Float16 h16x2 __attribute__((ext_vector_type(2)));
#define FP4H2(w, sel) __builtin_amdgcn_cvt_scalef32_pk_f16_fp4((w), 1.0f, (sel))
__device__ __forceinline__ void axpy16_fp4h(const u32x2 r, const h16x2 ww, h16x2 (&o)[8]) {
    o[0] += FP4H2(r.x, 0) * ww; o[1] += FP4H2(r.x, 1) * ww; o[2] += FP4H2(r.x, 2) * ww; o[3] += FP4H2(r.x, 3) * ww;
    o[4] += FP4H2(r.y, 0) * ww; o[5] += FP4H2(r.y, 1) * ww; o[6] += FP4H2(r.y, 2) * ww; o[7] += FP4H2(r.y, 3) * ww;
}
__device__ __forceinline__ void q_compute_vh(const u32x2 (&buf)[16], int q, int alo, int ahi, h16x2 (&o)[8]) {
    const int areg = (q < 4) ? alo : ahi, sb = 4 * (q & 3);
#pragma unroll
    for (int j = 0; j < 16; ++j) { const int src = 32 * (j & 1) + 16 * ((j >> 1) & 1) + (j >> 2) + sb;
        const h16x2 w = __builtin_bit_cast(h16x2, __builtin_amdgcn_readlane(areg, src));
        axpy16_fp4h(buf[j], w, o); }
}
__device__ __forceinline__ void q_compute_v(const u32x2 (&buf)[16], int q, float alo, float ahi, f32x2 (&o)[8]) {
    const int areg = __builtin_bit_cast(int, (q < 4) ? alo : ahi), sb = 4 * (q & 3);
#pragma unroll
    for (int j = 0; j < 16; ++j) { const int src = 32 * (j & 1) + 16 * ((j >> 1) & 1) + (j >> 2) + sb;
        const float w = __builtin_bit_cast(float, __builtin_amdgcn_readlane(areg, src));
        axpy16_fp4p(buf[j], w, o); }
}
__device__ __forceinline__ int swap32_addi(int a, int b) { auto r = __builtin_amdgcn_permlane32_swap((unsigned)a, (unsigned)b, false, false); const unsigned r0 = r[0], r1 = r[1]; return (int)(r0 + r1); }
__device__ __forceinline__ int swap16_addi(int a, int b) { auto r = __builtin_amdgcn_permlane16_swap((unsigned)a, (unsigned)b, false, false); const unsigned r0 = r[0], r1 = r[1]; return (int)(r0 + r1); }
template <int CTRL> __device__ __forceinline__ int dpp_i(int v) { return __builtin_amdgcn_update_dpp(0, v, CTRL, 0xf, 0xf, true); }
__device__ __forceinline__ int row_sum16i(int v) { v += dpp_i<0xB1>(v); v += dpp_i<0x4E>(v); v += dpp_i<0x141>(v); v += dpp_i<0x140>(v); return v; }
__device__ __forceinline__ void q_compute_ui(const u32x2 (&buf)[16], int q, int i16, int xh0, int xh1, int xl0, int xl1, int& zlo, int& zhi) {
    int p[16];
#pragma unroll
    for (int j = 0; j < 16; ++j) { const int d1 = __builtin_amdgcn_sdot8((int)buf[j].x, xh0, __builtin_amdgcn_sdot8((int)buf[j].y, xh1, 0, false), false);
        const int d2 = __builtin_amdgcn_sdot8((int)buf[j].x, xl0, __builtin_amdgcn_sdot8((int)buf[j].y, xl1, 0, false), false);
        p[j] = (d1 << 4) + d2; }
    int s1[8], s2[4];
#pragma unroll
    for (int m = 0; m < 8; ++m) s1[m] = swap32_addi(p[2 * m], p[2 * m + 1]);
#pragma unroll
    for (int n = 0; n < 4; ++n) s2[n] = swap16_addi(s1[2 * n], s1[2 * n + 1]);
#pragma unroll
    for (int r = 0; r < 4; ++r) { const int z = row_sum16i(s2[r]); const bool mine = i16 == ((4 * q + r) & 15);
        zlo = (mine && q < 4) ? z : zlo; zhi = (mine && q >= 4) ? z : zhi; }
}
__device__ __forceinline__ void phase_gather_u(const Params& P) {
    const int tid = threadIdx.x, lane = tid & 63, wave = __builtin_amdgcn_readfirstlane(tid >> 6);
    const int gw = blockIdx.x * NWAVES + wave, NGW = gridDim.x * NWAVES;
    unsigned char* ws = P.ws;
    const int* IDX = (const int*)(ws + WS_IDX); const float* GATE = (const float*)(ws + WS_GATE); const float* ESC = (const float*)(ws + WS_ESCALE); float* AW = (float*)(ws + WS_AW);
    const __amdgpu_buffer_rsrc_t rsU = __builtin_amdgcn_make_buffer_rsrc((void*)(ws + WS_U8), 0, 16384 * 512, 0x00020000);
    const unsigned char* H2I = ws + WS_H0I8; const float* RF = (const float*)(ws + WS_RF);
    const int hh = lane >> 5, rr = (lane >> 4) & 1, i16 = lane & 15, gsel = 4 * i16 + 2 * rr + hh;
    const int voff = 8 * lane;
    const unsigned ul = (unsigned)lane;
    int t = gw;
    if (t < NTOK) {
        int idx0, idx1; unsigned hraw[4]; float sqv;
        { const int* ip = IDX + (size_t)t * NSEL; idx0 = ip[ul]; idx1 = ip[64u + ul];
          const unsigned* hp = (const unsigned*)(H2I + (size_t)t * DM);
#pragma unroll
          for (int j = 0; j < 4; ++j) hraw[j] = hp[64u * j + ul];
          sqv = RF[t]; }
        u32x2 R0[16], R1[16], R2[16], R3[16];
        { const int ix0 = idx0 << 9; q_issue(R0, rsU, ix0, 0, voff); q_issue(R1, rsU, ix0, 16, voff); q_issue(R2, rsU, ix0, 32, voff); }
        for (;;) {
            const int tn = t + NGW; const bool has_next = tn < NTOK; const int tl = has_next ? tn : t;
            int idx0n, idx1n; unsigned hrawn[4]; float sqn, g0, g1;
            { const int* ip = IDX + (size_t)tl * NSEL; idx0n = ip[ul]; idx1n = ip[64u + ul];
              const unsigned* hp = (const unsigned*)(H2I + (size_t)tl * DM);
#pragma unroll
              for (int j = 0; j < 4; ++j) hrawn[j] = hp[64u * j + ul];
              sqn = RF[tl];
              const float* gp = GATE + (size_t)t * NSEL; g0 = gp[ul]; g1 = gp[64u + ul]; }
            const float su0 = ESC[idx0], su1 = ESC[idx1], sv0 = ESC[16384 + idx0], sv1 = ESC[16384 + idx1];
            const float cq0 = ((const float*)(ws + WS_SUMQ))[idx0], cq1 = ((const float*)(ws + WS_SUMQ))[idx1];
            unsigned xh[2] = {0u, 0u}, xl[2] = {0u, 0u};
#pragma unroll
            for (int j = 0; j < 4; ++j) {
                const unsigned lo4 = hraw[j] & 0x0f0f0f0fu, hi4 = (hraw[j] >> 4) & 0x0f0f0f0fu;
                const unsigned tl4 = (lo4 | (lo4 >> 4)) & 0x00ff00ffu, th4 = (hi4 | (hi4 >> 4)) & 0x00ff00ffu;
                const unsigned pl = ((tl4 | (tl4 >> 8)) & 0xffffu) ^ 0x8888u, ph = (th4 | (th4 >> 8)) & 0xffffu;
                xl[j >> 1] |= pl << (16 * (j & 1)); xh[j >> 1] |= ph << (16 * (j & 1)); }
            int zlo = 0, zhi = 0;
            const int ix0 = idx0 << 9, ix1 = idx1 << 9;
#pragma unroll 1
            for (int qq = 0; qq < 8; qq += 4) {
                const int ixn = qq ? (idx0n << 9) : ix1;
                q_issue(R3, rsU, qq ? ix1 : ix0, 48, voff);
                q_compute_ui(R0, qq, i16, (int)xh[0], (int)xh[1], (int)xl[0], (int)xl[1], zlo, zhi);
                q_issue(R0, rsU, ixn, 0, voff);
                q_compute_ui(R1, qq + 1, i16, (int)xh[0], (int)xh[1], (int)xl[0], (int)xl[1], zlo, zhi);
                q_issue(R1, rsU, ixn, 16, voff);
                q_compute_ui(R2, qq + 2, i16, (int)xh[0], (int)xh[1], (int)xl[0], (int)xl[1], zlo, zhi);
                q_issue(R2, rsU, ixn, 32, voff);
                q_compute_ui(R3, qq + 3, i16, (int)xh[0], (int)xh[1], (int)xl[0], (int)xl[1], zlo, zhi);
            }
            const float glo = __shfl(g0, gsel), ghi = __shfl(g1, gsel), sulo = __shfl(su0, gsel), suhi = __shfl(su1, gsel), svlo = __shfl(sv0, gsel), svhi = __shfl(sv1, gsel);
            const float cqlo = __shfl(cq0, gsel), cqhi = __shfl(cq1, gsel);
            const float zfl = ((float)zlo + 8.f * cqlo) * (sulo * sqv), zfh = ((float)zhi + 8.f * cqhi) * (suhi * sqv);
            const float wl = gelu_tanh_f(zfl) * glo * svlo, wh = gelu_tanh_f(zfh) * ghi * svhi;
            const float wmx = fmaxf(wave_max_fast(fmaxf(fabsf(wl), fabsf(wh))), 1e-30f), wsc = 256.f * __builtin_amdgcn_rcpf(wmx);
            { const float a = wl * wsc, c = wh * wsc;
              const int ah = __builtin_amdgcn_cvt_pk_fp8_f32(a, a, 0, false) & 255, ch = __builtin_amdgcn_cvt_pk_fp8_f32(c, c, 0, false) & 255;
              const float ar = a - __builtin_amdgcn_cvt_f32_fp8(ah, 0), cr = c - __builtin_amdgcn_cvt_f32_fp8(ch, 0);
              const int al = __builtin_amdgcn_cvt_pk_fp8_f32(ar, ar, 0, false) & 255, cl = __builtin_amdgcn_cvt_pk_fp8_f32(cr, cr, 0, false) & 255;
              unsigned char* ap = (unsigned char*)AW + (size_t)t * 256;
              ap[gsel] = (unsigned char)ah; ap[64 + gsel] = (unsigned char)ch; ap[128 + gsel] = (unsigned char)al; ap[192 + gsel] = (unsigned char)cl;
              if (lane == 0) ((float*)(ws + WS_WMX))[t] = wmx * (1.f / 256.f); }
            if (!has_next) break;
            t = tn; idx0 = idx0n; idx1 = idx1n; sqv = sqn;
#pragma unroll
            for (int j = 0; j < 4; ++j) hraw[j] = hrawn[j];
        }
    }
}
__device__ __forceinline__ void phase_gather_v(const Params& P) {
    const int tid = threadIdx.x, lane = tid & 63, wave = __builtin_amdgcn_readfirstlane(tid >> 6);
    const int gw = blockIdx.x * NWAVES + wave, NGW = gridDim.x * NWAVES;
    unsigned char* ws = P.ws;
    const int* IDX = (const int*)(ws + WS_IDX); const float* AW = (const float*)(ws + WS_AW);
    const __amdgpu_buffer_rsrc_t rsV = __builtin_amdgcn_make_buffer_rsrc((void*)(ws + WS_V8), 0, 16384 * 512, 0x00020000);
    const bf16* H2B = (const bf16*)(ws + WS_H2B);
    const int voff = 8 * lane;
    const unsigned ul = (unsigned)lane;
    int t = gw;
    if (t < NTOK) {
        int idx0, idx1; u32x2 hraw[4]; float alo, ahi;
        { const int* ip = IDX + (size_t)t * NSEL; idx0 = ip[ul]; idx1 = ip[64u + ul];
          const u32x2* hp = (const u32x2*)(H2B + (size_t)t * DM);
#pragma unroll
          for (int j = 0; j < 4; ++j) hraw[j] = hp[64u * j + ul];
          const float* ap = AW + (size_t)t * NSEL; alo = ap[ul]; ahi = ap[64u + ul]; }
        u32x2 R0[16], R1[16], R2[16], R3[16];
        { const int ix0 = idx0 << 9; q_issue(R0, rsV, ix0, 0, voff); q_issue(R1, rsV, ix0, 16, voff); q_issue(R2, rsV, ix0, 32, voff); }
        for (;;) {
            const int tn = t + NGW; const bool has_next = tn < NTOK; const int tl = has_next ? tn : t;
            int idx0n, idx1n; u32x2 hrawn[4]; float alon, ahin;
            { const int* ip = IDX + (size_t)tl * NSEL; idx0n = ip[ul]; idx1n = ip[64u + ul];
              const u32x2* hp = (const u32x2*)(H2B + (size_t)tl * DM);
#pragma unroll
              for (int j = 0; j < 4; ++j) hrawn[j] = hp[64u * j + ul];
              const float* ap = AW + (size_t)tl * NSEL; alon = ap[ul]; ahin = ap[64u + ul]; }
            const float wmx = fmaxf(wave_max_fast(fmaxf(fabsf(alo), fabsf(ahi))), 1e-30f), winv = 1.f / wmx;
            int alh, ahh;
            { const h16x2 a = (h16x2){(_Float16)(alo * winv), (_Float16)(alo * winv)}, b = (h16x2){(_Float16)(ahi * winv), (_Float16)(ahi * winv)};
              alh = __builtin_bit_cast(int, a); ahh = __builtin_bit_cast(int, b); }
            h16x2 oh[8];
#pragma unroll
            for (int j = 0; j < 8; ++j) oh[j] = (h16x2){(_Float16)0.f, (_Float16)0.f};
            const int ix0 = idx0 << 9, ix1 = idx1 << 9;
#pragma unroll 1
            for (int qq = 0; qq < 8; qq += 4) {
                const int ixn = qq ? (idx0n << 9) : ix1;
                q_issue(R3, rsV, qq ? ix1 : ix0, 48, voff);
                q_compute_vh(R0, qq, alh, ahh, oh);
                q_issue(R0, rsV, ixn, 0, voff);
                q_compute_vh(R1, qq + 1, alh, ahh, oh);
                q_issue(R1, rsV, ixn, 16, voff);
                q_compute_vh(R2, qq + 2, alh, ahh, oh);
                q_issue(R2, rsV, ixn, 32, voff);
                q_compute_vh(R3, qq + 3, alh, ahh, oh);
            }
            f32x2 o[8];
#pragma unroll
            for (int j = 0; j < 8; ++j) o[j] = (f32x2){(float)oh[j].x * wmx, (float)oh[j].y * wmx};
            float ss = 0.f;
#pragma unroll
            for (int j = 0; j < 4; ++j) { o[2 * j] += (f32x2){bflo(hraw[j].x), bfhi(hraw[j].x)}; o[2 * j + 1] += (f32x2){bflo(hraw[j].y), bfhi(hraw[j].y)}; }
#pragma unroll
            for (int j = 0; j < 8; ++j) ss += o[j].x * o[j].x + o[j].y * o[j].y;
            ss = wave_sum_fast(ss);
            const float r3 = rsqrtf(ss * (1.f / DM) + EPS);
            f32x4* op = (f32x4*)(P.out + (size_t)t * DM);
            const f32x4* gfp = (const f32x4*)P.g_fin;
#pragma unroll
            for (int j = 0; j < 4; ++j) { const f32x4 gv = gfp[64u * j + ul]; op[64u * j + ul] = (f32x4){o[2 * j].x * r3 * gv.x, o[2 * j].y * r3 * gv.y, o[2 * j + 1].x * r3 * gv.z, o[2 * j + 1].y * r3 * gv.w}; }
            if (!has_next) break;
            t = tn; idx0 = idx0n; idx1 = idx1n; alo = alon; ahi = ahin;
#pragma unroll
            for (int j = 0; j < 4; ++j) hraw[j] = hrawn[j];
        }
    }
}


typedef int i32x2v __attribute__((ext_vector_type(2)));
typedef int i32x8v __attribute__((ext_vector_type(8)));
#define VM_X 9
#define VM_WAIT(n) asm volatile("s_waitcnt vmcnt(" #n ")" ::: "memory")
__device__ __forceinline__ void phase_gather_v_mfma(const Params& P, LAS unsigned char* lds) {
    const int tid = threadIdx.x, lane = tid & 63, wave = __builtin_amdgcn_readfirstlane(tid >> 6);
    unsigned char* ws = P.ws;
    const int* IDX = (const int*)(ws + WS_IDX);
    const unsigned char* V8 = ws + WS_V8; const unsigned char* AW8 = ws + WS_AW; const float* WMX = (const float*)(ws + WS_WMX);
    const unsigned short* H2S = (const unsigned short*)(ws + WS_H2B);
    const int TPB = NTOK / (int)gridDim.x, t0 = blockIdx.x * TPB, NST = TPB * 4;
    const int r0 = 16 * wave + (lane >> 3), r1 = r0 + 8;
    const unsigned c0 = 16u * (unsigned)((lane & 7) ^ ((r0 >> 1) & 7)), c1 = 16u * (unsigned)((lane & 7) ^ ((r1 >> 1) & 7));
    const int i16 = lane & 15, kb = lane >> 4;
    const int ra = 32 * kb + i16, rb = ra + 16;
    const unsigned offa = (unsigned)(ra * 128 + 16 * (wave ^ ((ra >> 1) & 7))), offb = (unsigned)(rb * 128 + 16 * (wave ^ ((rb >> 1) & 7)));
    const unsigned aoffb = (unsigned)(((i16 & 1) ? 128 : 0) + 16 * kb);
    const bool arow = (i16 & 3) < 2;
    const int colb = 256 * kb + 32 * wave + i16;
    LAS float* SS = (LAS float*)(lds + 131072 + 1024);
    LAS float* OUTB = (LAS float*)(lds + 131072 + 2048);
    const f32x4 gfv = *(const f32x4*)(P.g_fin + 256 * (wave & 3) + 4 * lane);
    const unsigned lbase = (unsigned)(unsigned long long)lds;
    struct VTok { u32x4 a, b; float w; unsigned h0, h1; };
    VTok C0, C1;
    int ia1, ib1, ia2, ib2, ia3, ib3;
#define VM_ISSUE(g, e0, e1) do { LAS unsigned char* _d = lds + (((g) & 7) * 16384) + wave * 2048; const unsigned _cb = 128u * (unsigned)((g) & 3); \
        __builtin_amdgcn_global_load_lds((const unsigned*)(V8 + (size_t)(e0) * 512 + _cb + c0), (LAS unsigned*)(_d), 16, 0, 0); \
        __builtin_amdgcn_global_load_lds((const unsigned*)(V8 + (size_t)(e1) * 512 + _cb + c1), (LAS unsigned*)(_d + 1024), 16, 0, 0); } while (0)
    {
        const int ia0 = IDX[(size_t)t0 * NSEL + r0], ib0 = IDX[(size_t)t0 * NSEL + r1];
        ia1 = IDX[(size_t)(t0 + 1) * NSEL + r0]; ib1 = IDX[(size_t)(t0 + 1) * NSEL + r1];
        ia2 = IDX[(size_t)(t0 + 2) * NSEL + r0]; ib2 = IDX[(size_t)(t0 + 2) * NSEL + r1];
        ia3 = IDX[(size_t)(t0 + 3) * NSEL + r0]; ib3 = IDX[(size_t)(t0 + 3) * NSEL + r1];
        const unsigned char* ap = AW8 + (size_t)t0 * 256 + aoffb;
        C0.a = *(const u32x4*)ap; C0.b = *(const u32x4*)(ap + 64); C0.w = WMX[t0]; C0.h0 = H2S[(size_t)t0 * DM + colb]; C0.h1 = H2S[(size_t)t0 * DM + colb + 16];
        C1.a = *(const u32x4*)(ap + 256); C1.b = *(const u32x4*)(ap + 256 + 64); C1.w = WMX[t0 + 1]; C1.h0 = H2S[(size_t)(t0 + 1) * DM + colb]; C1.h1 = H2S[(size_t)(t0 + 1) * DM + colb + 16];
        asm volatile("s_waitcnt vmcnt(0)" ::: "memory");
        VM_ISSUE(0, ia0, ib0); VM_ISSUE(1, ia0, ib0); VM_ISSUE(2, ia0, ib0); VM_ISSUE(3, ia0, ib0);
        VM_ISSUE(4, ia1, ib1); VM_ISSUE(5, ia1, ib1); VM_ISSUE(6, ia1, ib1);
    }
    float pv0 = 0.f, pv1 = 0.f;
    VTok N0, N1; int na4, nb4, na5, nb5;
    auto token = [&](const int i, const bool even, const VTok& C, const int e1a, const int e1b, const int e2a, const int e2b) __attribute__((always_inline)) {
        const int t = t0 + i;
        const u32x4 z = (u32x4){0u, 0u, 0u, 0u}; const u32x4 Alo = arow ? C.a : z, Ahi = arow ? C.b : z;
        const i32x8v A = (i32x8v){(int)Alo.x, (int)Alo.y, (int)Alo.z, (int)Alo.w, (int)Ahi.x, (int)Ahi.y, (int)Ahi.z, (int)Ahi.w};
        f32x4 acc[4][2];
#pragma unroll
        for (int cc = 0; cc < 4; ++cc) {
            const int g = 4 * i + cc;
            if (even && cc == 0) { VM_WAIT(12); } else { VM_WAIT(26); }
            asm volatile("s_waitcnt lgkmcnt(0)" ::: "memory");
            __builtin_amdgcn_s_barrier();
            __builtin_amdgcn_sched_barrier(0);
            const unsigned sa = lbase + (unsigned)((g & 7) * 16384) + offa, sbb = lbase + (unsigned)((g & 7) * 16384) + offb;
            i32x2v b00, b01, b10, b11;
            asm volatile("ds_read_b64_tr_b4 %0, %4\n\tds_read_b64_tr_b4 %1, %5\n\tds_read_b64_tr_b4 %2, %4 offset:8\n\tds_read_b64_tr_b4 %3, %5 offset:8"
                         : "=&v"(b00), "=&v"(b01), "=&v"(b10), "=&v"(b11) : "v"(sa), "v"(sbb) : "memory");
            { const int gn = g + 7;
              if (cc == 0) VM_ISSUE(gn, e1a, e1b); else VM_ISSUE(gn, e2a, e2b); }
            __builtin_amdgcn_sched_barrier(0);
            if (cc == 0) {
                if (even) {
                    const int tA = t0 + ((i + 2 < TPB) ? i + 2 : TPB - 2), tI = t0 + ((i + 4 < TPB) ? i + 4 : TPB - 2);
                    const unsigned char* ap = AW8 + (size_t)tA * 256 + aoffb; const float* wp = WMX + tA; const int* ipa = IDX + (size_t)tI * NSEL + r0; const unsigned short* hp = H2S + (size_t)tA * DM + colb;
                    asm volatile("global_load_dwordx4 %0, %14, off\n\tglobal_load_dwordx4 %1, %14, off offset:64\n\tglobal_load_dwordx4 %2, %14, off offset:256\n\tglobal_load_dwordx4 %3, %14, off offset:320\n\t"
                                 "global_load_dword %4, %15, off\n\tglobal_load_dword %5, %15, off offset:4\n\t"
                                 "global_load_ushort %6, %17, off\n\tglobal_load_ushort %7, %17, off offset:32\n\tglobal_load_ushort %8, %17, off offset:2048\n\tglobal_load_ushort %9, %17, off offset:2080\n\t"
                                 "global_load_dword %10, %16, off\n\tglobal_load_dword %11, %16, off offset:32\n\tglobal_load_dword %12, %16, off offset:512\n\tglobal_load_dword %13, %16, off offset:544"
                                 : "=&v"(N0.a), "=&v"(N0.b), "=&v"(N1.a), "=&v"(N1.b), "=&v"(N0.w), "=&v"(N1.w), "=&v"(N0.h0), "=&v"(N0.h1), "=&v"(N1.h0), "=&v"(N1.h1), "=&v"(na4), "=&v"(nb4), "=&v"(na5), "=&v"(nb5)
                                 : "v"(ap), "v"(wp), "v"(ipa), "v"(hp) : "memory");
                }
                { const f32x4 s0 = *(const LAS f32x4*)(SS + 8 * ((i + 1) & 1)), s1 = *(const LAS f32x4*)(SS + 8 * ((i + 1) & 1) + 4);
                  const float ss = ((s0.x + s0.y) + (s0.z + s0.w)) + ((s1.x + s1.y) + (s1.z + s1.w));
                  const float r3 = rsqrtf(ss * (1.f / DM) + EPS);
                  if (i > 0 && (wave >> 2) == ((i + 1) & 1)) {
                      const f32x4 v = *(const LAS f32x4*)(OUTB + 1024 * ((i + 1) & 1) + 256 * (wave & 3) + 4 * lane);
                      *(f32x4*)(P.out + (size_t)(t - 1) * DM + 256 * (wave & 3) + 4 * lane) = (f32x4){v.x * r3 * gfv.x, v.y * r3 * gfv.y, v.z * r3 * gfv.z, v.w * r3 * gfv.w}; } }
                __builtin_amdgcn_sched_barrier(0);
            }
            asm volatile("s_waitcnt lgkmcnt(0)" : "+v"(b00), "+v"(b01), "+v"(b10), "+v"(b11) :: "memory");
            const i32x8v B0 = (i32x8v){b00.x, b00.y, b01.x, b01.y, 0, 0, 0, 0}, B1 = (i32x8v){b10.x, b10.y, b11.x, b11.y, 0, 0, 0, 0};
            const f32x4 z4 = (f32x4){0.f, 0.f, 0.f, 0.f};
            acc[cc][0] = __builtin_amdgcn_mfma_scale_f32_16x16x128_f8f6f4(A, B0, z4, 0  , 4  , 0, 0x7f7f7f7f, 0, 0x7f7f7f7f);
            acc[cc][1] = __builtin_amdgcn_mfma_scale_f32_16x16x128_f8f6f4(A, B1, z4, 0, 4, 0, 0x7f7f7f7f, 0, 0x7f7f7f7f);
        }
#pragma unroll
        for (int c = 0; c < 4; ++c) asm volatile("" :: "v"(acc[c][0]), "v"(acc[c][1]));
        float s0 = acc[0][0].x + acc[0][0].y, s1 = acc[0][1].x + acc[0][1].y;
        { const float a0 = acc[1][0].x + acc[1][0].y, a1 = acc[1][1].x + acc[1][1].y, b0 = acc[2][0].x + acc[2][0].y, b1 = acc[2][1].x + acc[2][1].y, d0 = acc[3][0].x + acc[3][0].y, d1 = acc[3][1].x + acc[3][1].y;
          s0 = (kb == 1) ? a0 : s0; s1 = (kb == 1) ? a1 : s1; s0 = (kb == 2) ? b0 : s0; s1 = (kb == 2) ? b1 : s1; s0 = (kb == 3) ? d0 : s0; s1 = (kb == 3) ? d1 : s1; }
        pv0 = s0 * C.w + __uint_as_float(C.h0 << 16); pv1 = s1 * C.w + __uint_as_float(C.h1 << 16);
        OUTB[1024 * (i & 1) + colb] = pv0; OUTB[1024 * (i & 1) + colb + 16] = pv1;
        const float sq = wave_sum_fast(pv0 * pv0 + pv1 * pv1);
        if (lane == 0) SS[8 * (i & 1) + wave] = sq;
    };
#pragma unroll 1
    for (int i = 0; i < TPB; i += 2) {
        token(i, true, C0, ia1, ib1, ia2, ib2);
        token(i + 1, false, C1, ia2, ib2, ia3, ib3);
        asm volatile("s_waitcnt vmcnt(14)" : "+v"(N0.a), "+v"(N0.b), "+v"(N1.a), "+v"(N1.b), "+v"(N0.w), "+v"(N1.w), "+v"(N0.h0), "+v"(N0.h1), "+v"(N1.h0), "+v"(N1.h1), "+v"(na4), "+v"(nb4), "+v"(na5), "+v"(nb5) :: "memory");
        C0 = N0; C1 = N1; ia1 = ia3; ib1 = ib3; ia2 = na4; ib2 = nb4; ia3 = na5; ib3 = nb5;
    }
    asm volatile("s_waitcnt vmcnt(0)" ::: "memory");
    __builtin_amdgcn_s_barrier();
    { const int i = TPB; const f32x4 s0 = *(const LAS f32x4*)(SS + 8 * ((i + 1) & 1)), s1 = *(const LAS f32x4*)(SS + 8 * ((i + 1) & 1) + 4);
      const float ss = ((s0.x + s0.y) + (s0.z + s0.w)) + ((s1.x + s1.y) + (s1.z + s1.w));
      const float r3 = rsqrtf(ss * (1.f / DM) + EPS);
      if ((wave >> 2) == ((i + 1) & 1)) {
          const f32x4 v = *(const LAS f32x4*)(OUTB + 1024 * ((i + 1) & 1) + 256 * (wave & 3) + 4 * lane);
          *(f32x4*)(P.out + (size_t)(t0 + TPB - 1) * DM + 256 * (wave & 3) + 4 * lane) = (f32x4){v.x * r3 * gfv.x, v.y * r3 * gfv.y, v.z * r3 * gfv.z, v.w * r3 * gfv.w}; } }
#undef VM_ISSUE
}

__device__ __forceinline__ void phase_quant_h2(const Params& P) {
    const int tid = threadIdx.x, lane = tid & 63, wave = __builtin_amdgcn_readfirstlane(tid >> 6);
    const int gw = blockIdx.x * NWAVES + wave, NGW = gridDim.x * NWAVES;
    unsigned char* ws = P.ws;
    const float* SSQ = (const float*)(ws + WS_SSQ); const float* AMX = (const float*)(ws + WS_AMX); float* RF = (float*)(ws + WS_RF);
    TabRow tb0, tb1, tb2;
    if (gw < NTOK) tab_load(P, gw, lane, tb0);
    if (gw + NGW < NTOK) tab_load(P, gw + NGW, lane, tb1);
    int it3 = 0;
    for (int row = gw; row < NTOK; row += NGW, it3 = (it3 == 2) ? 0 : it3 + 1) {
        { const int e2 = row + 2 * NGW;
          if (e2 < NTOK) { if (it3 == 0) tab_load(P, e2, lane, tb2); else if (it3 == 1) tab_load(P, e2, lane, tb0); else tab_load(P, e2, lane, tb1); } }
        const u32x4* hp = (const u32x4*)(ws + WS_H2B + (size_t)row * DM * 2) + 2 * lane;
        const u32x4 a = hp[0], b = hp[1];
        const float am = fmaxf(row_max16(AMX[(size_t)row * 16 + (lane & 15)]), 1e-30f) * 1.0078125f;
        const float rstd2 = rsqrtf(row_sum16(SSQ[(size_t)row * 16 + (lane & 15)]) * (1.f / DM) + EPS);
        const float inv = 127.f * __builtin_amdgcn_rcpf(am);
        const unsigned w[8] = {a.x, a.y, a.z, a.w, b.x, b.y, b.z, b.w};
        unsigned o[4];
#pragma unroll
        for (int j = 0; j < 4; ++j) {
            const int q0 = (int)rintf(__uint_as_float(w[2 * j] << 16) * inv), q1 = (int)rintf(__uint_as_float(w[2 * j] & 0xffff0000u) * inv);
            const int q2 = (int)rintf(__uint_as_float(w[2 * j + 1] << 16) * inv), q3 = (int)rintf(__uint_as_float(w[2 * j + 1] & 0xffff0000u) * inv);
            o[j] = ((unsigned)q0 & 255u) | (((unsigned)q1 & 255u) << 8) | (((unsigned)q2 & 255u) << 16) | ((unsigned)q3 << 24); }
        u32x4 ov; ov.x = o[0]; ov.y = o[1]; ov.z = o[2]; ov.w = o[3];
        *((u32x4*)(ws + WS_H0I8 + (size_t)row * DM) + lane) = ov;
        if (lane == 0) RF[row] = am * (1.f / 127.f) * rstd2;
        if (it3 == 0) tab_finish(P, row, lane, tb0); else if (it3 == 1) tab_finish(P, row, lane, tb1); else tab_finish(P, row, lane, tb2);
    }
}
struct EpiQI8 {
    static constexpr bool PERM = true, AFTER_DRAIN = false;
    bf16* O; int ldc; const float* rf; const float* sw;
    __device__ __forceinline__ void operator()(const pg8::i32x4 (&acc)[2][2][4][2], const pg8::Unit& u, int wr, int wc, int fr, int fq) const {
        const int row0 = u.pm * 256 + wr * 64 + fr, col0 = u.pn * 256 + wc * 32 + 8 * fq;
        f32x4 swv[2][2];
#pragma unroll
        for (int bj = 0; bj < 2; ++bj) { swv[bj][0] = *(const f32x4*)(sw + col0 + bj * 128); swv[bj][1] = *(const f32x4*)(sw + col0 + bj * 128 + 4); }
#pragma unroll
        for (int ai = 0; ai < 2; ++ai)
#pragma unroll
            for (int m = 0; m < 4; ++m) {
                const int row = row0 + ai * 128 + m * 16;
                const float s = rf[row];
                bf16* rowp = O + (size_t)row * ldc + col0;
#pragma unroll
                for (int bj = 0; bj < 2; ++bj) { const pg8::i32x4 a0 = acc[ai][bj][m][0], a1 = acc[ai][bj][m][1];
                    const f32x4 v0 = (f32x4){(float)a0[0], (float)a0[1], (float)a0[2], (float)a0[3]} * (swv[bj][0] * s), v1 = (f32x4){(float)a1[0], (float)a1[1], (float)a1[2], (float)a1[3]} * (swv[bj][1] * s);
                    u32x4 w; w.x = cvt_pk_bf16(v0[0], v0[1]); w.y = cvt_pk_bf16(v0[2], v0[3]); w.z = cvt_pk_bf16(v1[0], v1[1]); w.w = cvt_pk_bf16(v1[2], v1[3]);
                    *(u32x4*)(rowp + bj * 128) = w; }
            }
    }
};
#define XB_TMO      128
#define XB_XCNT(j)  (256  + 64 * (j))
#define XB_XSUB(j)  (1280 + 64 * (j))
#define XB_XGEN(j)  (2304 + 64 * (j))
#define XB_TOP      3328
#define XB_TOPGEN   3392
#define XCD_BAR_WORDS 3456
#define XB_SPIN_CAP (1u << 18)

__device__ __forceinline__ unsigned xb_ld(unsigned* p)              { return __hip_atomic_load(p, __ATOMIC_RELAXED, __HIP_MEMORY_SCOPE_AGENT); }
__device__ __forceinline__ unsigned xb_add(unsigned* p, unsigned v) { return __hip_atomic_fetch_add(p, v, __ATOMIC_RELAXED, __HIP_MEMORY_SCOPE_AGENT); }
__device__ __forceinline__ unsigned xb_xcc_id() { return (unsigned)__builtin_amdgcn_s_getreg((3 << 11) | 20) & 0xFu; }
#define XB_SPIN(cond, bar) do { unsigned _sp = 0; while (cond) { __builtin_amdgcn_s_sleep(1); \
    if ((++_sp & 255u) == 0u) { if (xb_ld(&(bar)[XB_TMO])) break; if (_sp > XB_SPIN_CAP) { atomicAdd(&(bar)[XB_TMO], 1u); break; } } } } while (0)

struct XcdBarrier {
    unsigned* bar; unsigned x;
    volatile LAS unsigned* st;
};

__device__ __forceinline__ XcdBarrier xcd_barrier_post(unsigned* bar, volatile LAS unsigned* st) {
    XcdBarrier b; b.bar = bar; b.x = xb_xcc_id(); b.st = st;
    if (threadIdx.x == 0) (void)xb_add(&bar[XB_XCNT(b.x)], 1u);
    return b;
}
__device__ __forceinline__ void xcd_barrier_complete(unsigned* bar, unsigned x, unsigned& nloc, unsigned& nx) {
    const unsigned G = gridDim.x * gridDim.y * gridDim.z;
    unsigned sum, cnt, mine, sp = 0u;
    for (;;) {
        sum = 0u; cnt = 0u; mine = 0u;
#pragma unroll
        for (unsigned j = 0; j < 16; ++j) { const unsigned c = xb_ld(&bar[XB_XCNT(j)]); sum += c; cnt += (c > 0u) ? 1u : 0u; mine = (j == x) ? c : mine; }
        if (sum == G) break;
        __builtin_amdgcn_s_sleep(1);
        if ((++sp & 255u) == 0u) { if (xb_ld(&bar[XB_TMO])) break; if (sp > XB_SPIN_CAP) { atomicAdd(&bar[XB_TMO], 1u); break; } }
    }
    nloc = mine > 0u ? mine : 1u; nx = cnt > 0u ? cnt : 1u;
}

__device__ __forceinline__ void xcd_barrier(const XcdBarrier& b) {
    asm volatile("s_waitcnt vmcnt(0)" ::: "memory");
    __syncthreads();
    if (threadIdx.x == 0) {
        unsigned* bar = b.bar;
        __builtin_amdgcn_s_waitcnt(0);
        unsigned nloc = b.st[0], nx = b.st[1];
        if (nloc == 0u) { xcd_barrier_complete(bar, b.x, nloc, nx); b.st[0] = nloc; b.st[1] = nx; }
        const unsigned old = xb_add(&bar[XB_XSUB(b.x)], 1u);
        const unsigned gen = old / nloc;
        if (old + 1u == (gen + 1u) * nloc) {
            __builtin_amdgcn_fence(__ATOMIC_RELEASE, "agent");
            asm volatile("s_waitcnt vmcnt(0)" ::: "memory");
            const unsigned og = xb_add(&bar[XB_TOP], 1u);
            const unsigned tg = og / nx;
            if (og + 1u == (tg + 1u) * nx) xb_add(&bar[XB_TOPGEN], 1u);
            else XB_SPIN(xb_ld(&bar[XB_TOPGEN]) == tg, bar);
            __builtin_amdgcn_fence(__ATOMIC_ACQUIRE, "agent");
            xb_add(&bar[XB_XGEN(b.x)], 1u);
            asm volatile("s_waitcnt vmcnt(0)" ::: "memory");
        } else {
            XB_SPIN(xb_ld(&bar[XB_XGEN(b.x)]) == gen, bar);
            __builtin_amdgcn_fence(__ATOMIC_ACQUIRE, "agent");
            asm volatile("s_waitcnt vmcnt(0)" ::: "memory");
        }
    }
    __syncthreads();
}


#ifndef MK_MULTI
#define MK_MULTI 0
#endif
constexpr int NPHASE = 10;
#ifndef REP5
#define REP5 1
#endif
#ifndef REP6
#define REP6 1
#endif
__global__ void __launch_bounds__(NTHREADS, 2) mk_fwd(Params P) {
    extern __shared__ __attribute__((aligned(16))) unsigned char lds_raw[];
    LAS unsigned char* lds = (LAS unsigned char*)lds_raw;
    cg::grid_group grid = cg::this_grid();
    unsigned char* ws = P.ws;
    const int lo = P.ph_lo, hi = P.ph_hi;
    volatile LAS unsigned* bst = (volatile LAS unsigned*)(lds + 131072 + 64);
    if (threadIdx.x < 2) bst[threadIdx.x] = 0u;
    __syncthreads();
    XcdBarrier xbar = xcd_barrier_post((unsigned*)(ws + WS_CTL), bst);
#define IN(k) (lo <= (k) && (k) < hi)
#define SEAM(k) do { if (IN(k) && IN((k) + 1)) { xcd_barrier(xbar); } } while (0)
    if (IN(0)) phase_prep(P, lds);
    if (IN(0) && IN(1)) { }
    SEAM(1);
    if (IN(2)) {
        pg8::Gemm g{(const bf16*)(ws + WS_H0I8), (const bf16*)(ws + WS_WIN_T), NTOK, DIN, DM / 2}; pg8::StaticOrder S; S.init(NTOK, DIN, (int)gridDim.x, (int)blockIdx.x);
        EpiProjI8 E{(bf16*)(ws + WS_PROJ), (const float*)(ws + WS_RSTD1), (const float*)(ws + WS_SW)};
        pg8::gemm_phase_i8<EpiProjI8, pg8::StaticOrder, true, true>(lds, g, S, E);
    }
    SEAM(2);
    if (IN(3)) phase_conv(P, lds);
    SEAM(3);
    if (IN(4)) {
        pg8::Gemm g{(const bf16*)(ws + WS_Y), (const bf16*)(ws + WS_WOUT_T), NTOK, DM, DM / 2}; pg8::StaticOrder S; S.init(NTOK, DM, (int)gridDim.x, (int)blockIdx.x);
        EpiResidualI8 E{(bf16*)(ws + WS_H2B), (const signed char*)(ws + WS_H0I8), (const float*)(ws + WS_SX), (const float*)(ws + WS_SY), (const float*)(ws + WS_SWO), (float*)(ws + WS_SSQ), (float*)(ws + WS_AMX)};
        pg8::gemm_phase_i8<EpiResidualI8, pg8::StaticOrder, true, true>(lds, g, S, E);
    }
    SEAM(4);
    if (IN(5)) phase_quant_h2(P);
    SEAM(5);
    if (IN(6)) {
        pg8::Gemm g{(const bf16*)(ws + WS_H0I8), (const bf16*)(ws + WS_WQ_T), NTOK, 2048, DM / 2}; pg8::StaticOrder S; S.init(NTOK, 2048, (int)gridDim.x, (int)blockIdx.x);
        EpiQI8 E{(bf16*)(ws + WS_Q), 2048, (const float*)(ws + WS_RF), (const float*)(ws + WS_SWQ)};
        pg8::gemm_phase_i8<EpiQI8, pg8::StaticOrder, true, true>(lds, g, S, E);
    }
    if (IN(6) && IN(7)) { asm volatile("s_waitcnt vmcnt(0)" ::: "memory"); __syncthreads(); }
    if (IN(7)) phase_route(P, lds);
    SEAM(7);
    if (IN(8)) phase_gather_u(P);
    SEAM(8);
    if (IN(9)) phase_gather_v_mfma(P, lds);
#undef IN
#undef SEAM
}

extern "C" void kernel_launch(void* const* d_in, const int* in_sizes, int n_in, void* d_out, int out_size, void* d_ws, size_t ws_size, hipStream_t stream) {
    static int grid = 0;
    if (grid == 0) {
        if (n_in != 18 || in_sizes[0] != NTOK * DM || out_size != NTOK * DM || ws_size < WS_END) {
            fprintf(stderr, "kernel_launch: unexpected shapes (n_in %d in0 %d out %d ws %zu)\n", n_in, n_in > 0 ? in_sizes[0] : -1, out_size, ws_size); grid = -1; return; }
        int dev = 0, cus = 0, per_cu = 0;
        (void)hipGetDevice(&dev); (void)hipDeviceGetAttribute(&cus, hipDeviceAttributeMultiprocessorCount, dev);
        if (hipFuncSetAttribute((const void*)mk_fwd, hipFuncAttributeMaxDynamicSharedMemorySize, LDS_BYTES) != hipSuccess) { fprintf(stderr, "kernel_launch: hipFuncSetAttribute failed\n"); grid = -1; return; }
        if (hipOccupancyMaxActiveBlocksPerMultiprocessor(&per_cu, (const void*)mk_fwd, NTHREADS, LDS_BYTES) != hipSuccess || per_cu < 1) { fprintf(stderr, "kernel_launch: occupancy query failed (%d)\n", per_cu); (void)hipGetLastError(); per_cu = 1; }
        if (per_cu > 1) per_cu = 1;
        grid = cus * per_cu;
        if (grid <= 0) grid = 256;
    }
    if (grid < 0) return;
    Params p{};
    p.x = (const float*)d_in[0]; p.meta = (const float*)d_in[1]; p.g_mix = (const float*)d_in[2]; p.w_in = (const float*)d_in[3]; p.sc_w = (const float*)d_in[4];
    p.cf_w = (const float*)d_in[5]; p.cf_b = (const float*)d_in[6]; p.ln_g = (const float*)d_in[7]; p.ln_b = (const float*)d_in[8]; p.g_sc = (const float*)d_in[9];
    p.g_cf = (const float*)d_in[10]; p.w_out = (const float*)d_in[11]; p.g_ffn = (const float*)d_in[12]; p.w_q = (const float*)d_in[13]; p.keys = (const float*)d_in[14];
    p.pu = (const float*)d_in[15]; p.pv = (const float*)d_in[16]; p.g_fin = (const float*)d_in[17];
    p.out = (float*)d_out; p.ws = (unsigned char*)d_ws;
    (void)hipMemsetAsync((char*)d_ws + WS_CTL, 0, 65536 + 16 * 2560 * 4, stream);
#if MK_MULTI
    for (int ph = 0; ph < NPHASE; ++ph) { p.ph_lo = ph; p.ph_hi = ph + 1; p.coop = 0; p.pad = 0;
        hipLaunchKernelGGL(mk_fwd, dim3(grid), dim3(NTHREADS), LDS_BYTES, stream, p); }
#else
    p.ph_lo = 0; p.ph_hi = NPHASE; p.coop = 1; p.pad = 0;
    void* args[] = {&p};
    hipError_t e = hipLaunchCooperativeKernel((const void*)mk_fwd, dim3(grid), dim3(NTHREADS), args, LDS_BYTES, stream);
    if (e != hipSuccess) fprintf(stderr, "cooperative launch failed: %s (grid %d)\n", hipGetErrorString(e), grid);
#endif
}
```

```cpp
#include <hip/hip_runtime.h>
#include <hip/hip_cooperative_groups.h>
#include <cstdio>
#include <cstdint>
namespace cg = cooperative_groups;

namespace pg8 {
#define PG8_LAS __attribute__((address_space(3)))
typedef unsigned short bf16_t;
typedef short bf16x8 __attribute__((ext_vector_type(8)));
typedef float f32x4 __attribute__((ext_vector_type(4)));
typedef unsigned u32x4 __attribute__((ext_vector_type(4)));
typedef int i32x4 __attribute__((ext_vector_type(4)));
constexpr int BM = 256, BK = 64, HALF = 128, HTB = HALF * BK * 2  , STAGE_BYTES = 8 * HTB, NXCD = 8, WGM = 8;

__host__ __device__ __forceinline__ int lds_byte(int r, int c) { const int st = (r >> 4) * 2 + (c >> 5), rr = r & 15, cc = c & 31, ob = rr * 64 + cc * 2; return st * 1024 + (ob ^ (((ob >> 9) & 1) << 5)); }
__host__ __device__ __forceinline__ void stage_rc(int b, int& R, int& C) { const int st = b / 1024, sb = b % 1024, swz = sb ^ (((sb >> 9) & 1) << 5); R = (st >> 1) * 16 + swz / 64; C = (st & 1) * 32 + (swz % 64) / 2; }
__host__ __device__ __forceinline__ int perm32(int rho) { const int n = rho >> 4, i = rho & 15; return 8 * (i >> 2) + 4 * n + (i & 3); }

struct Unit { int pm, pn; };
struct Gemm { const bf16_t* A; const bf16_t* Bt; int M, N, K; };

struct StaticOrder {
    int nM, nN, nwg, G, c;
    __host__ __device__ void init(int M, int N, int G_, int c_) { nM = M / BM; nN = N / BM; nwg = nM * nN; G = G_; c = c_; }
    __host__ __device__ bool next(int i, Unit& u) const {
        const long L = (long)i * G + c; if (L >= nwg) return false;
        int wgid = (int)L; { const int q = nwg / NXCD, r = nwg % NXCD, xcd = wgid % NXCD, off = wgid / NXCD; wgid = (xcd < r ? xcd * (q + 1) : r * (q + 1) + (xcd - r) * q) + off; }
        const int nig = WGM * nN, gid = wgid / nig, fm = gid * WGM, gsz = (nM - fm) < WGM ? (nM - fm) : WGM;
        u.pm = fm + ((wgid % nig) % gsz); u.pn = (wgid % nig) / gsz; return true;
    }
    __device__ __forceinline__ void a_ready(const Unit&) const {}
    __device__ __forceinline__ void done(const Unit&) const {}
};

template <class Epi, class Sched, bool ALIGN_EPI = false, bool SP2 = false>
__device__ __forceinline__ void gemm_phase(PG8_LAS unsigned char* lds, const Gemm g, const Sched& S, const Epi& E) {
    const int tid = threadIdx.x, wid = __builtin_amdgcn_readfirstlane(tid >> 6), lane = tid & 63, wr = wid >> 2, wc = wid & 3, fr = lane & 15, fq = lane >> 4;
    const int K = g.K, nt = K / BK;
    unsigned voffA[2], voffB[2];
#pragma unroll
    for (int i = 0; i < 2; ++i) { int R, C; stage_rc(tid * 16 + i * 8192, R, C); const int Rb = Epi::PERM ? ((R & ~31) + perm32(R & 31)) : R;
        voffA[i] = (unsigned)(R * K + C) * 2u; voffB[i] = (unsigned)(Rb * K + C) * 2u; }
    const size_t kstep = (size_t)(BK * 2);
    const size_t hstep = (size_t)HALF * K * 2;
    const size_t tstep = 2 * hstep;
    const unsigned ldsw = (unsigned)wid * 1024u;
    const int aoff = lds_byte(wr * 64 + fr, fq * 8), boff = lds_byte(wc * 32 + fr, fq * 8);
#define PG8_SA(b, h) (((b) * 2 + (h)) * HTB)
#define PG8_SB(b, h) ((4 + (b) * 2 + (h)) * HTB)
#define PG8_STAGE(bufoff, gbase, voff) do { _Pragma("unroll") for (int _i = 0; _i < 2; ++_i) \
        __builtin_amdgcn_global_load_lds((const unsigned*)((const char*)(gbase) + (voff)[_i]), (PG8_LAS unsigned*)(lds + (bufoff) + ldsw + _i * 8192), 16, 0, 0); } while (0)
#define PG8_LDA(dst, b, h) do { _Pragma("unroll") for (int m = 0; m < 4; ++m) _Pragma("unroll") for (int k = 0; k < 2; ++k) dst[m][k] = *(const PG8_LAS bf16x8*)(lds + PG8_SA(b, h) + aoff + m * 2048 + k * 1024); } while (0)
#define PG8_LDB(dst, b, h) do { _Pragma("unroll") for (int n = 0; n < 2; ++n) _Pragma("unroll") for (int k = 0; k < 2; ++k) dst[n][k] = *(const PG8_LAS bf16x8*)(lds + PG8_SB(b, h) + boff + n * 2048 + k * 1024); } while (0)
#define PG8_MMA(ai, bj, At, Bt) do { __builtin_amdgcn_s_setprio(1); _Pragma("unroll") for (int m = 0; m < 4; ++m) _Pragma("unroll") for (int n = 0; n < 2; ++n) _Pragma("unroll") for (int k = 0; k < 2; ++k) \
        acc[ai][bj][m][n] = __builtin_amdgcn_mfma_f32_16x16x32_bf16(Bt[n][k], At[m][k], acc[ai][bj][m][n], 0, 0, 0); __builtin_amdgcn_s_setprio(0); } while (0)
#define PG8_WAIT_V(n) asm volatile("s_waitcnt vmcnt(" #n ")" ::: "memory")
#define PG8_WAIT_L(n) asm volatile("s_waitcnt lgkmcnt(" #n ")" ::: "memory")
#define PG8_BAR __builtin_amdgcn_s_barrier()
#define PG8_SCHED __builtin_amdgcn_sched_barrier(0)
    Unit cur, nxt; int ui = 0;
    if (!S.next(0, cur)) return;
    f32x4 acc[2][2][4][2];
#pragma unroll
    for (int a = 0; a < 2; ++a)
#pragma unroll
        for (int b = 0; b < 2; ++b)
#pragma unroll
            for (int m = 0; m < 4; ++m)
#pragma unroll
                for (int n = 0; n < 2; ++n) acc[a][b][m][n] = (f32x4){0.f, 0.f, 0.f, 0.f};
    bf16x8 At[4][2], B0[2][2], B1[2][2];
    const char* cA = (const char*)g.A + (size_t)cur.pm * tstep; const char* cB = (const char*)g.Bt + (size_t)cur.pn * tstep;
    S.a_ready(cur);
    if constexpr (SP2) {
        PG8_STAGE(PG8_SB(0, 0), cB, voffB); PG8_STAGE(PG8_SB(0, 1), cB + hstep, voffB); PG8_STAGE(PG8_SA(0, 0), cA, voffA); PG8_STAGE(PG8_SA(0, 1), cA + hstep, voffA);
        if (wr == 1) PG8_BAR;
        PG8_WAIT_V(2); PG8_BAR;
        PG8_STAGE(PG8_SB(1, 0), cB + kstep, voffB); PG8_STAGE(PG8_SA(1, 0), cA + kstep, voffA); PG8_STAGE(PG8_SB(1, 1), cB + hstep + kstep, voffB);
        PG8_WAIT_V(6); PG8_BAR;
    } else {
        PG8_STAGE(PG8_SB(0, 0), cB, voffB); PG8_STAGE(PG8_SA(0, 0), cA, voffA); PG8_STAGE(PG8_SB(0, 1), cB + hstep, voffB); PG8_STAGE(PG8_SA(0, 1), cA + hstep, voffA);
        if (wr == 1) PG8_BAR;
        PG8_WAIT_V(4); PG8_BAR;
        PG8_STAGE(PG8_SB(1, 0), cB + kstep, voffB); PG8_STAGE(PG8_SA(1, 0), cA + kstep, voffA); PG8_STAGE(PG8_SB(1, 1), cB + hstep + kstep, voffB);
        PG8_WAIT_V(6); PG8_BAR;
    }
    for (;;) {
        const bool has_next = S.next(ui + 1, nxt);
        const char* nA = has_next ? (const char*)g.A + (size_t)nxt.pm * tstep : cA; const char* nB = has_next ? (const char*)g.Bt + (size_t)nxt.pn * tstep : cB;
        for (int t = 0; t < nt; t += 2) {
            const bool last = (t == nt - 2);
            const char* a1 = cA + (size_t)(t + 1) * kstep;
            const char* a2 = last ? nA : cA + (size_t)(t + 2) * kstep; const char* b2 = last ? nB : cB + (size_t)(t + 2) * kstep;
            const char* a3 = a2 + kstep; const char* b3 = b2 + kstep;
            if (last && has_next) S.a_ready(nxt);
            if constexpr (SP2) {
            PG8_LDB(B0, 0, 0); PG8_LDB(B1, 0, 1); PG8_SCHED; PG8_LDA(At, 0, 0); PG8_STAGE(PG8_SA(1, 1), a1 + hstep, voffA);
            PG8_WAIT_V(8); PG8_WAIT_L(0); PG8_BAR; PG8_MMA(0, 0, At, B0); PG8_MMA(0, 1, At, B1); PG8_BAR; PG8_SCHED;
            PG8_LDA(At, 0, 1); PG8_STAGE(PG8_SB(0, 0), b2, voffB); PG8_STAGE(PG8_SB(0, 1), b2 + hstep, voffB); PG8_STAGE(PG8_SA(0, 0), a2, voffA);
            PG8_WAIT_V(8); PG8_WAIT_L(0); PG8_BAR; PG8_MMA(1, 0, At, B0); PG8_MMA(1, 1, At, B1); PG8_BAR; PG8_SCHED;
            PG8_LDB(B0, 1, 0); PG8_LDB(B1, 1, 1); PG8_SCHED; PG8_LDA(At, 1, 0); PG8_STAGE(PG8_SA(0, 1), a2 + hstep, voffA);
            PG8_WAIT_V(8); PG8_WAIT_L(0); PG8_BAR; PG8_MMA(0, 0, At, B0); PG8_MMA(0, 1, At, B1); PG8_BAR; PG8_SCHED;
            PG8_LDA(At, 1, 1); PG8_STAGE(PG8_SB(1, 0), b3, voffB); PG8_STAGE(PG8_SB(1, 1), b3 + hstep, voffB); PG8_STAGE(PG8_SA(1, 0), a3, voffA);
            PG8_WAIT_V(8); PG8_WAIT_L(0); PG8_BAR; PG8_MMA(1, 0, At, B0); PG8_MMA(1, 1, At, B1); PG8_BAR; PG8_SCHED;
            } else {
            PG8_LDB(B0, 0, 0); PG8_SCHED; PG8_LDA(At, 0, 0); PG8_STAGE(PG8_SA(1, 1), a1 + hstep, voffA);
            PG8_WAIT_L(8); PG8_BAR; PG8_WAIT_L(0); PG8_MMA(0, 0, At, B0); PG8_BAR; PG8_SCHED;
            PG8_LDB(B1, 0, 1); PG8_STAGE(PG8_SB(0, 0), b2, voffB);
            PG8_BAR; PG8_WAIT_L(0); PG8_MMA(0, 1, At, B1); PG8_BAR;
            PG8_LDA(At, 0, 1); PG8_STAGE(PG8_SA(0, 0), a2, voffA);
            PG8_BAR; PG8_WAIT_L(0); PG8_MMA(1, 0, At, B0); PG8_BAR; PG8_SCHED;
            PG8_STAGE(PG8_SB(0, 1), b2 + hstep, voffB);
            PG8_WAIT_V(6); PG8_BAR; PG8_MMA(1, 1, At, B1); PG8_BAR;
            PG8_LDB(B0, 1, 0); PG8_SCHED; PG8_LDA(At, 1, 0); PG8_STAGE(PG8_SA(0, 1), a2 + hstep, voffA);
            PG8_WAIT_L(8); PG8_BAR; PG8_WAIT_L(0); PG8_MMA(0, 0, At, B0); PG8_BAR; PG8_SCHED;
            PG8_LDB(B1, 1, 1); PG8_STAGE(PG8_SB(1, 0), b3, voffB);
            PG8_BAR; PG8_WAIT_L(0); PG8_MMA(0, 1, At, B1); PG8_BAR;
            PG8_LDA(At, 1, 1); PG8_STAGE(PG8_SA(1, 0), a3, voffA);
            PG8_BAR; PG8_WAIT_L(0); PG8_MMA(1, 0, At, B0); PG8_BAR; PG8_SCHED;
            PG8_STAGE(PG8_SB(1, 1), b3 + hstep, voffB);
            PG8_WAIT_V(6); PG8_BAR; PG8_MMA(1, 1, At, B1); PG8_BAR;
            }
        }
        if constexpr (ALIGN_EPI) { if (wr == 0) PG8_BAR; }
        if constexpr (!Epi::AFTER_DRAIN) { E(acc, cur, wr, wc, fr, fq); S.done(cur); }
        if (!has_next) break;
#pragma unroll
        for (int a = 0; a < 2; ++a)
#pragma unroll
            for (int b = 0; b < 2; ++b)
#pragma unroll
                for (int m = 0; m < 4; ++m)
#pragma unroll
                    for (int n = 0; n < 2; ++n) acc[a][b][m][n] = (f32x4){0.f, 0.f, 0.f, 0.f};
        cur = nxt; cA = nA; cB = nB; ++ui;
        if constexpr (ALIGN_EPI) { if (wr == 1) PG8_BAR; }
    }
    PG8_WAIT_V(0);
    if constexpr (!ALIGN_EPI) { if (wr == 0) PG8_BAR; }
    PG8_BAR;
    if constexpr (Epi::AFTER_DRAIN) { E.fused(acc, cur, wr, wc, fr, fq, lds, wid, lane); S.done(cur); }
#undef PG8_SA
#undef PG8_SB
#undef PG8_STAGE
#undef PG8_LDA
#undef PG8_LDB
#undef PG8_MMA
#undef PG8_WAIT_V
#undef PG8_WAIT_L
#undef PG8_BAR
#undef PG8_SCHED
}
template <class Epi, class Sched, bool ALIGN_EPI = false, bool SP2 = false>
__device__ __forceinline__ void gemm_phase_i8(PG8_LAS unsigned char* lds, const Gemm g, const Sched& S, const Epi& E) {
    const int tid = threadIdx.x, wid = __builtin_amdgcn_readfirstlane(tid >> 6), lane = tid & 63, wr = wid >> 2, wc = wid & 3, fr = lane & 15, fq = lane >> 4;
    const int K = g.K, nt = K / BK;
    unsigned voffA[2], voffB[2];
#pragma unroll
    for (int i = 0; i < 2; ++i) { int R, C; stage_rc(tid * 16 + i * 8192, R, C); const int Rb = Epi::PERM ? ((R & ~31) + perm32(R & 31)) : R;
        voffA[i] = (unsigned)(R * K + C) * 2u; voffB[i] = (unsigned)(Rb * K + C) * 2u; }
    const size_t kstep = (size_t)(BK * 2);
    const size_t hstep = (size_t)HALF * K * 2;
    const size_t tstep = 2 * hstep;
    const unsigned ldsw = (unsigned)wid * 1024u;
    const int aoff = lds_byte(wr * 64 + fr, fq * 8), boff = lds_byte(wc * 32 + fr, fq * 8);
#define PG8_SA(b, h) (((b) * 2 + (h)) * HTB)
#define PG8_SB(b, h) ((4 + (b) * 2 + (h)) * HTB)
#define PG8_STAGE(bufoff, gbase, voff) do { _Pragma("unroll") for (int _i = 0; _i < 2; ++_i) \
        __builtin_amdgcn_global_load_lds((const unsigned*)((const char*)(gbase) + (voff)[_i]), (PG8_LAS unsigned*)(lds + (bufoff) + ldsw + _i * 8192), 16, 0, 0); } while (0)
#define PG8_LDA(dst, b, h) do { _Pragma("unroll") for (int m = 0; m < 4; ++m) _Pragma("unroll") for (int k = 0; k < 2; ++k) dst[m][k] = *(const PG8_LAS bf16x8*)(lds + PG8_SA(b, h) + aoff + m * 2048 + k * 1024); } while (0)
#define PG8_LDB(dst, b, h) do { _Pragma("unroll") for (int n = 0; n < 2; ++n) _Pragma("unroll") for (int k = 0; k < 2; ++k) dst[n][k] = *(const PG8_LAS bf16x8*)(lds + PG8_SB(b, h) + boff + n * 2048 + k * 1024); } while (0)
#define PG8_MMA(ai, bj, At, Bt) do { __builtin_amdgcn_s_setprio(1); _Pragma("unroll") for (int m = 0; m < 4; ++m) _Pragma("unroll") for (int n = 0; n < 2; ++n) _Pragma("unroll") for (int k = 0; k < 2; ++k) \
        acc[ai][bj][m][n] = __builtin_amdgcn_mfma_i32_16x16x64_i8(__builtin_bit_cast(i32x4, Bt[n][k]), __builtin_bit_cast(i32x4, At[m][k]), acc[ai][bj][m][n], 0, 0, 0); __builtin_amdgcn_s_setprio(0); } while (0)
#define PG8_WAIT_V(n) asm volatile("s_waitcnt vmcnt(" #n ")" ::: "memory")
#define PG8_WAIT_L(n) asm volatile("s_waitcnt lgkmcnt(" #n ")" ::: "memory")
#define PG8_BAR __builtin_amdgcn_s_barrier()
#define PG8_SCHED __builtin_amdgcn_sched_barrier(0)
    Unit cur, nxt; int ui = 0;
    if (!S.next(0, cur)) return;
    i32x4 acc[2][2][4][2];
#pragma unroll
    for (int a = 0; a < 2; ++a)
#pragma unroll
        for (int b = 0; b < 2; ++b)
#pragma unroll
            for (int m = 0; m < 4; ++m)
#pragma unroll
                for (int n = 0; n < 2; ++n) acc[a][b][m][n] = (i32x4){0, 0, 0, 0};
    bf16x8 At[4][2], B0[2][2], B1[2][2];
    const char* cA = (const char*)g.A + (size_t)cur.pm * tstep; const char* cB = (const char*)g.Bt + (size_t)cur.pn * tstep;
    S.a_ready(cur);
    if constexpr (SP2) {
        PG8_STAGE(PG8_SB(0, 0), cB, voffB); PG8_STAGE(PG8_SB(0, 1), cB + hstep, voffB); PG8_STAGE(PG8_SA(0, 0), cA, voffA); PG8_STAGE(PG8_SA(0, 1), cA + hstep, voffA);
        if (wr == 1) PG8_BAR;
        PG8_WAIT_V(2); PG8_BAR;
        PG8_STAGE(PG8_SB(1, 0), cB + kstep, voffB); PG8_STAGE(PG8_SA(1, 0), cA + kstep, voffA); PG8_STAGE(PG8_SB(1, 1), cB + hstep + kstep, voffB);
        PG8_WAIT_V(6); PG8_BAR;
    } else {
        PG8_STAGE(PG8_SB(0, 0), cB, voffB); PG8_STAGE(PG8_SA(0, 0), cA, voffA); PG8_STAGE(PG8_SB(0, 1), cB + hstep, voffB); PG8_STAGE(PG8_SA(0, 1), cA + hstep, voffA);
        if (wr == 1) PG8_BAR;
        PG8_WAIT_V(4); PG8_BAR;
        PG8_STAGE(PG8_SB(1, 0), cB + kstep, voffB); PG8_STAGE(PG8_SA(1, 0), cA + kstep, voffA); PG8_STAGE(PG8_SB(1, 1), cB + hstep + kstep, voffB);
        PG8_WAIT_V(6); PG8_BAR;
    }
    for (;;) {
        const bool has_next = S.next(ui + 1, nxt);
        const char* nA = has_next ? (const char*)g.A + (size_t)nxt.pm * tstep : cA; const char* nB = has_next ? (const char*)g.Bt + (size_t)nxt.pn * tstep : cB;
        for (int t = 0; t < nt; t += 2) {
            const bool last = (t == nt - 2);
            const char* a1 = cA + (size_t)(t + 1) * kstep;
            const char* a2 = last ? nA : cA + (size_t)(t + 2) * kstep; const char* b2 = last ? nB : cB + (size_t)(t + 2) * kstep;
            const char* a3 = a2 + kstep; const char* b3 = b2 + kstep;
            if (last && has_next) S.a_ready(nxt);
            if constexpr (SP2) {
            PG8_LDB(B0, 0, 0); PG8_LDB(B1, 0, 1); PG8_SCHED; PG8_LDA(At, 0, 0); PG8_STAGE(PG8_SA(1, 1), a1 + hstep, voffA);
            PG8_WAIT_V(8); PG8_WAIT_L(0); PG8_BAR; PG8_MMA(0, 0, At, B0); PG8_MMA(0, 1, At, B1); PG8_BAR; PG8_SCHED;
            PG8_LDA(At, 0, 1); PG8_STAGE(PG8_SB(0, 0), b2, voffB); PG8_STAGE(PG8_SB(0, 1), b2 + hstep, voffB); PG8_STAGE(PG8_SA(0, 0), a2, voffA);
            PG8_WAIT_V(8); PG8_WAIT_L(0); PG8_BAR; PG8_MMA(1, 0, At, B0); PG8_MMA(1, 1, At, B1); PG8_BAR; PG8_SCHED;
            PG8_LDB(B0, 1, 0); PG8_LDB(B1, 1, 1); PG8_SCHED; PG8_LDA(At, 1, 0); PG8_STAGE(PG8_SA(0, 1), a2 + hstep, voffA);
            PG8_WAIT_V(8); PG8_WAIT_L(0); PG8_BAR; PG8_MMA(0, 0, At, B0); PG8_MMA(0, 1, At, B1); PG8_BAR; PG8_SCHED;
            PG8_LDA(At, 1, 1); PG8_STAGE(PG8_SB(1, 0), b3, voffB); PG8_STAGE(PG8_SB(1, 1), b3 + hstep, voffB); PG8_STAGE(PG8_SA(1, 0), a3, voffA);
            PG8_WAIT_V(8); PG8_WAIT_L(0); PG8_BAR; PG8_MMA(1, 0, At, B0); PG8_MMA(1, 1, At, B1); PG8_BAR; PG8_SCHED;
            } else {
            PG8_LDB(B0, 0, 0); PG8_SCHED; PG8_LDA(At, 0, 0); PG8_STAGE(PG8_SA(1, 1), a1 + hstep, voffA);
            PG8_WAIT_L(8); PG8_BAR; PG8_WAIT_L(0); PG8_MMA(0, 0, At, B0); PG8_BAR; PG8_SCHED;
            PG8_LDB(B1, 0, 1); PG8_STAGE(PG8_SB(0, 0), b2, voffB);
            PG8_BAR; PG8_WAIT_L(0); PG8_MMA(0, 1, At, B1); PG8_BAR;
            PG8_LDA(At, 0, 1); PG8_STAGE(PG8_SA(0, 0), a2, voffA);
            PG8_BAR; PG8_WAIT_L(0); PG8_MMA(1, 0, At, B0); PG8_BAR; PG8_SCHED;
            PG8_STAGE(PG8_SB(0, 1), b2 + hstep, voffB);
            PG8_WAIT_V(6); PG8_BAR; PG8_MMA(1, 1, At, B1); PG8_BAR;
            PG8_LDB(B0, 1, 0); PG8_SCHED; PG8_LDA(At, 1, 0); PG8_STAGE(PG8_SA(0, 1), a2 + hstep, voffA);
            PG8_WAIT_L(8); PG8_BAR; PG8_WAIT_L(0); PG8_MMA(0, 0, At, B0); PG8_BAR; PG8_SCHED;
            PG8_LDB(B1, 1, 1); PG8_STAGE(PG8_SB(1, 0), b3, voffB);
            PG8_BAR; PG8_WAIT_L(0); PG8_MMA(0, 1, At, B1); PG8_BAR;
            PG8_LDA(At, 1, 1); PG8_STAGE(PG8_SA(1, 0), a3, voffA);
            PG8_BAR; PG8_WAIT_L(0); PG8_MMA(1, 0, At, B0); PG8_BAR; PG8_SCHED;
            PG8_STAGE(PG8_SB(1, 1), b3 + hstep, voffB);
            PG8_WAIT_V(6); PG8_BAR; PG8_MMA(1, 1, At, B1); PG8_BAR;
            }
        }
        if constexpr (ALIGN_EPI) { if (wr == 0) PG8_BAR; }
        if constexpr (!Epi::AFTER_DRAIN) { E(acc, cur, wr, wc, fr, fq); S.done(cur); }
        if (!has_next) break;
#pragma unroll
        for (int a = 0; a < 2; ++a)
#pragma unroll
            for (int b = 0; b < 2; ++b)
#pragma unroll
                for (int m = 0; m < 4; ++m)
#pragma unroll
                    for (int n = 0; n < 2; ++n) acc[a][b][m][n] = (i32x4){0, 0, 0, 0};
        cur = nxt; cA = nA; cB = nB; ++ui;
        if constexpr (ALIGN_EPI) { if (wr == 1) PG8_BAR; }
    }
    PG8_WAIT_V(0);
    if constexpr (!ALIGN_EPI) { if (wr == 0) PG8_BAR; }
    PG8_BAR;
    if constexpr (Epi::AFTER_DRAIN) { E.fused(acc, cur, wr, wc, fr, fq, lds, wid, lane); S.done(cur); }
#undef PG8_SA
#undef PG8_SB
#undef PG8_STAGE
#undef PG8_LDA
#undef PG8_LDB
#undef PG8_MMA
#undef PG8_WAIT_V
#undef PG8_WAIT_L
#undef PG8_BAR
#undef PG8_SCHED
}
}

#define LAS __attribute__((address_space(3)))
typedef unsigned short bf16;
typedef float f32x2 __attribute__((ext_vector_type(2)));
typedef float f32x4 __attribute__((ext_vector_type(4)));
typedef unsigned u32x2 __attribute__((ext_vector_type(2)));
typedef unsigned u32x4 __attribute__((ext_vector_type(4)));

constexpr int PDIM = 1536;
constexpr int NTOK = 32768, DM = 1024, DIN = 2560, SEQ = 8192, NBATCH = 4, NMETA = 16;
constexpr int NHEAD = 8, NKEYS = 128, TOPK = 16, NSEL = NHEAD * TOPK;
constexpr float EPS = 1e-6f;
constexpr float U_SCALE = 64.f, V_SCALE = 16.f;
constexpr float U4_CLIP = 2.6f;
constexpr int NWAVES = 8, NTHREADS = 512;
constexpr int MKC = 32;
constexpr int LDS_BYTES = 147456;

constexpr size_t MiB = 1u << 20;
constexpr size_t WS_CTL = 0, WS_WIN_T = 1 * MiB, WS_WOUT_T = 6 * MiB, WS_WQ_T = 8 * MiB, WS_KEYS = 12 * MiB, WS_METAPART = 160 * MiB  ,
                 WS_METARSTD = 14 * MiB + 512 * 1024, WS_METAPROJ = 14 * MiB + 576 * 1024, WS_RSTD1 = 15 * MiB, WS_SSQ = 16 * MiB, WS_U8 = 32 * MiB, WS_V8 = 48 * MiB,
                 WS_IDX = 64 * MiB, WS_GATE = 80 * MiB, WS_H0B = 96 * MiB, WS_H2B = 96 * MiB, WS_Y = 160 * MiB, WS_PROJ = 224 * MiB,
                 WS_Q = 224 * MiB, WS_ESCALE = 18 * MiB, WS_SUMQ = 19 * MiB, WS_SX = 20 * MiB, WS_SW = 21 * MiB, WS_SY = 22 * MiB, WS_SWO = 23 * MiB, WS_WMX = 24 * MiB, WS_AMX = 26 * MiB, WS_RF = 28 * MiB, WS_SWQ = 29 * MiB, WS_H0I8 = 384 * MiB, WS_AW = 160 * MiB  , WS_END = 416 * MiB;

struct Params {
    const float* x; const float* meta; const float* g_mix; const float* w_in; const float* sc_w; const float* cf_w; const float* cf_b;
    const float* ln_g; const float* ln_b; const float* g_sc; const float* g_cf; const float* w_out; const float* g_ffn; const float* w_q;
    const float* keys; const float* pu; const float* pv; const float* g_fin;
    float* out; unsigned char* ws;
    int ph_lo, ph_hi, coop, pad;
};

__device__ __forceinline__ unsigned f2bf(float f) { unsigned u = __builtin_bit_cast(unsigned, f); return (u + 0x7fffu + ((u >> 16) & 1u)) >> 16; }
__device__ __forceinline__ unsigned pk2(float lo, float hi) { return f2bf(lo) | (f2bf(hi) << 16); }
__device__ __forceinline__ float bf2f(unsigned b) { return __builtin_bit_cast(float, b << 16); }
__device__ __forceinline__ float bflo(unsigned w) { return __builtin_bit_cast(float, w << 16); }
__device__ __forceinline__ float bfhi(unsigned w) { return __builtin_bit_cast(float, w & 0xffff0000u); }
__device__ __forceinline__ float wave_sum(float v) {
#pragma unroll
    for (int o = 1; o < 64; o <<= 1) v += __shfl_xor(v, o);
    return v;
}
template <int CTRL> __device__ __forceinline__ float dpp_f(float v) { return __builtin_bit_cast(float, __builtin_amdgcn_update_dpp(0, __builtin_bit_cast(int, v), CTRL, 0xf, 0xf, true)); }
__device__ __forceinline__ float wave_sum_fast(float v) {
    v += dpp_f<0xB1>(v); v += dpp_f<0x4E>(v); v += dpp_f<0x141>(v); v += dpp_f<0x140>(v);
    { auto r = __builtin_amdgcn_permlane16_swap(__float_as_uint(v), __float_as_uint(v), false, false); v = __uint_as_float(r[0]) + __uint_as_float(r[1]); }
    { auto r = __builtin_amdgcn_permlane32_swap(__float_as_uint(v), __float_as_uint(v), false, false); v = __uint_as_float(r[0]) + __uint_as_float(r[1]); }
    return v;
}
__device__ __forceinline__ float wave_max_fast(float vf) {
    unsigned v = __float_as_uint(vf);
#define WMX_DPP(ctrl) (unsigned)__builtin_amdgcn_update_dpp(0, (int)v, ctrl, 0xf, 0xf, true)
    v = max(v, WMX_DPP(0xB1)); v = max(v, WMX_DPP(0x4E)); v = max(v, WMX_DPP(0x141)); v = max(v, WMX_DPP(0x140));
#undef WMX_DPP
    { auto r = __builtin_amdgcn_permlane16_swap(v, v, false, false); const unsigned r0 = r[0], r1 = r[1]; v = max(r0, r1); }
    { auto r = __builtin_amdgcn_permlane32_swap(v, v, false, false); const unsigned r0 = r[0], r1 = r[1]; v = max(r0, r1); }
    return __uint_as_float(v);
}
__device__ __forceinline__ float sigmoid_f(float x) { return __builtin_amdgcn_rcpf(1.f + __expf(-x)); }
__device__ __forceinline__ float gelu_tanh_f(float x) {
    const float t = 0.7978845608028654f * (x + 0.044715f * x * x * x);
    const float e = __expf(2.f * t);
    const float th = 1.f - 2.f * __builtin_amdgcn_rcpf(e + 1.f);
    return 0.5f * x * (1.f + th);
}

__device__ __forceinline__ unsigned cvt_pk_bf16(float lo, float hi) { unsigned r; asm volatile("v_cvt_pk_bf16_f32 %0, %1, %2" : "=v"(r) : "v"(lo), "v"(hi)); return r; }

template <int MODE> struct EpiRowScale {
    static constexpr bool PERM = true, AFTER_DRAIN = false;
    bf16* O; int ldc; const float* rs;
    __device__ __forceinline__ void operator()(const pg8::f32x4 (&acc)[2][2][4][2], const pg8::Unit& u, int wr, int wc, int fr, int fq) const {
        const int row0 = u.pm * 256 + wr * 64 + fr, col0 = u.pn * 256 + wc * 32 + 8 * fq;
#pragma unroll
        for (int ai = 0; ai < 2; ++ai)
#pragma unroll
            for (int m = 0; m < 4; ++m) {
                const int row = row0 + ai * 128 + m * 16;
                float s;
                if (MODE == 0) s = rs[row];
                else { const f32x4* p = (const f32x4*)(rs + (size_t)row * 16); const f32x4 a = p[0], b = p[1], c = p[2], d = p[3];
                       const float t = ((a.x + a.y) + (a.z + a.w)) + ((b.x + b.y) + (b.z + b.w)) + ((c.x + c.y) + (c.z + c.w)) + ((d.x + d.y) + (d.z + d.w));
                       s = rsqrtf(t * (1.f / 1024.f) + EPS); }
                bf16* rowp = O + (size_t)row * ldc + col0;
#pragma unroll
                for (int bj = 0; bj < 2; ++bj) { const pg8::f32x4 v0 = acc[ai][bj][m][0] * s, v1 = acc[ai][bj][m][1] * s;
                    u32x4 w; w.x = cvt_pk_bf16(v0[0], v0[1]); w.y = cvt_pk_bf16(v0[2], v0[3]); w.z = cvt_pk_bf16(v1[0], v1[1]); w.w = cvt_pk_bf16(v1[2], v1[3]);
                    *(u32x4*)(rowp + bj * 128) = w; }
            }
    }
};
struct EpiProj {
    static constexpr bool PERM = true, AFTER_DRAIN = false;
    bf16* O; const float* rs;
    __device__ __forceinline__ void operator()(const pg8::f32x4 (&acc)[2][2][4][2], const pg8::Unit& u, int wr, int wc, int fr, int fq) const {
        const int row0 = u.pm * 256 + wr * 64 + fr, cin = wc * 32 + 8 * fq, pn = u.pn;
#pragma unroll
        for (int ai = 0; ai < 2; ++ai)
#pragma unroll
            for (int m = 0; m < 4; ++m) {
                const int row = row0 + ai * 128 + m * 16; const float sc = rs[row];
                float a[8], b[8];
#pragma unroll
                for (int i = 0; i < 4; ++i) { a[i] = acc[ai][0][m][0][i] * sc; a[4 + i] = acc[ai][0][m][1][i] * sc; b[i] = acc[ai][1][m][0][i] * sc; b[4 + i] = acc[ai][1][m][1][i] * sc; }
                bf16* rowp = O + (size_t)row * PDIM;
                if (pn >= 4 && pn < 6) {
                    u32x4 w0, w1; w0.x = cvt_pk_bf16(a[0], a[1]); w0.y = cvt_pk_bf16(a[2], a[3]); w0.z = cvt_pk_bf16(a[4], a[5]); w0.w = cvt_pk_bf16(a[6], a[7]);
                    w1.x = cvt_pk_bf16(b[0], b[1]); w1.y = cvt_pk_bf16(b[2], b[3]); w1.z = cvt_pk_bf16(b[4], b[5]); w1.w = cvt_pk_bf16(b[6], b[7]);
                    *(u32x4*)(rowp + 512 + 256 * (pn - 4) + cin) = w0; *(u32x4*)(rowp + 512 + 256 * (pn - 4) + 128 + cin) = w1;
                } else {
                    float o[8];
                    if (pn < 4) {
#pragma unroll
                        for (int i = 0; i < 8; ++i) o[i] = a[i] * b[i];
                    } else {
#pragma unroll
                        for (int i = 0; i < 8; ++i) o[i] = a[i] * sigmoid_f(b[i]);
                    }
                    u32x4 w; w.x = cvt_pk_bf16(o[0], o[1]); w.y = cvt_pk_bf16(o[2], o[3]); w.z = cvt_pk_bf16(o[4], o[5]); w.w = cvt_pk_bf16(o[6], o[7]);
                    *(u32x4*)(rowp + (pn < 4 ? 128 * pn : 1024 + 128 * (pn - 6)) + cin) = w;
                }
            }
    }
};
struct EpiProjI8 {
    static constexpr bool PERM = true, AFTER_DRAIN = false;
    bf16* O; const float* rs; const float* sw;
    __device__ __forceinline__ void operator()(const pg8::i32x4 (&acc)[2][2][4][2], const pg8::Unit& u, int wr, int wc, int fr, int fq) const {
        const int row0 = u.pm * 256 + wr * 64 + fr, cin = wc * 32 + 8 * fq, pn = u.pn;
        float swa[8], swb[8];
        { const f32x4 a0 = *(const f32x4*)(sw + 256 * pn + cin), a1 = *(const f32x4*)(sw + 256 * pn + cin + 4), b0 = *(const f32x4*)(sw + 256 * pn + 128 + cin), b1 = *(const f32x4*)(sw + 256 * pn + 128 + cin + 4);
          swa[0] = a0.x; swa[1] = a0.y; swa[2] = a0.z; swa[3] = a0.w; swa[4] = a1.x; swa[5] = a1.y; swa[6] = a1.z; swa[7] = a1.w;
          swb[0] = b0.x; swb[1] = b0.y; swb[2] = b0.z; swb[3] = b0.w; swb[4] = b1.x; swb[5] = b1.y; swb[6] = b1.z; swb[7] = b1.w; }
#pragma unroll
        for (int ai = 0; ai < 2; ++ai)
#pragma unroll
            for (int m = 0; m < 4; ++m) {
                const int row = row0 + ai * 128 + m * 16; const float sc = rs[row];
                float a[8], b[8];
#pragma unroll
                for (int i = 0; i < 4; ++i) { a[i] = (float)acc[ai][0][m][0][i] * (sc * swa[i]); a[4 + i] = (float)acc[ai][0][m][1][i] * (sc * swa[4 + i]);
                    b[i] = (float)acc[ai][1][m][0][i] * (sc * swb[i]); b[4 + i] = (float)acc[ai][1][m][1][i] * (sc * swb[4 + i]); }
                bf16* rowp = O + (size_t)row * PDIM;
                if (pn >= 4 && pn < 6) {
                    u32x4 w0, w1; w0.x = cvt_pk_bf16(a[0], a[1]); w0.y = cvt_pk_bf16(a[2], a[3]); w0.z = cvt_pk_bf16(a[4], a[5]); w0.w = cvt_pk_bf16(a[6], a[7]);
                    w1.x = cvt_pk_bf16(b[0], b[1]); w1.y = cvt_pk_bf16(b[2], b[3]); w1.z = cvt_pk_bf16(b[4], b[5]); w1.w = cvt_pk_bf16(b[6], b[7]);
                    *(u32x4*)(rowp + 512 + 256 * (pn - 4) + cin) = w0; *(u32x4*)(rowp + 512 + 256 * (pn - 4) + 128 + cin) = w1;
                } else {
                    float o[8];
                    if (pn < 4) {
#pragma unroll
                        for (int i = 0; i < 8; ++i) o[i] = a[i] * b[i];
                    } else {
#pragma unroll
                        for (int i = 0; i < 8; ++i) o[i] = a[i] * sigmoid_f(b[i]);
                    }
                    u32x4 w; w.x = cvt_pk_bf16(o[0], o[1]); w.y = cvt_pk_bf16(o[2], o[3]); w.z = cvt_pk_bf16(o[4], o[5]); w.w = cvt_pk_bf16(o[6], o[7]);
                    *(u32x4*)(rowp + (pn < 4 ? 128 * pn : 1024 + 128 * (pn - 6)) + cin) = w;
                }
            }
    }
};
__host__ __device__ __forceinline__ int win_src_col(int n) {
    const int t = n >> 8, j = n & 255;
    if (t < 4) return (j < 128) ? 128 * t + j : 1024 + 128 * t + (j - 128);
    if (t < 6) return 512 + 256 * (t - 4) + j;
    return (j < 128) ? 1536 + 128 * (t - 6) + j : 2048 + 128 * (t - 6) + (j - 128);
}
struct EpiResidual {
    static constexpr bool PERM = true, AFTER_DRAIN = false;
    bf16* O; const signed char* XB; const float* SX; float* ssq;
    __device__ __forceinline__ void operator()(const pg8::f32x4 (&acc)[2][2][4][2], const pg8::Unit& u, int wr, int wc, int fr, int fq) const {
        const int row0 = u.pm * 256 + wr * 64 + fr, col0 = u.pn * 256 + wc * 32 + 8 * fq;
#pragma unroll
        for (int ai = 0; ai < 2; ++ai)
#pragma unroll
            for (int m = 0; m < 4; ++m) {
                const int row = row0 + ai * 128 + m * 16;
                const signed char* xr = XB + (size_t)row * DM + col0; bf16* rowp = O + (size_t)row * DM + col0;
                float q = 0.f;
                u32x2 xw[2]; const float sxr = SX[row];
#pragma unroll
                for (int bj = 0; bj < 2; ++bj) xw[bj] = *(const u32x2*)(xr + bj * 128);
#pragma unroll
                for (int bj = 0; bj < 2; ++bj) {
                    const f32x4 x0 = (f32x4){(float)(signed char)(xw[bj].x), (float)(signed char)(xw[bj].x >> 8), (float)(signed char)(xw[bj].x >> 16), (float)((int)xw[bj].x >> 24)} * sxr,
                                x1 = (f32x4){(float)(signed char)(xw[bj].y), (float)(signed char)(xw[bj].y >> 8), (float)(signed char)(xw[bj].y >> 16), (float)((int)xw[bj].y >> 24)} * sxr;
                    const pg8::f32x4 v0 = acc[ai][bj][m][0] + x0, v1 = acc[ai][bj][m][1] + x1;
                    q += (v0[0] * v0[0] + v0[1] * v0[1]) + (v0[2] * v0[2] + v0[3] * v0[3]) + (v1[0] * v1[0] + v1[1] * v1[1]) + (v1[2] * v1[2] + v1[3] * v1[3]);
                    u32x4 w; w.x = cvt_pk_bf16(v0[0], v0[1]); w.y = cvt_pk_bf16(v0[2], v0[3]); w.z = cvt_pk_bf16(v1[0], v1[1]); w.w = cvt_pk_bf16(v1[2], v1[3]);
                    *(u32x4*)(rowp + bj * 128) = w; }
                q += __shfl_xor(q, 16); q += __shfl_xor(q, 32);
                if (fq == 0) ssq[(size_t)row * 16 + u.pn * 4 + wc] = q;
            }
    }
};

struct EpiResidualI8 {
    static constexpr bool PERM = true, AFTER_DRAIN = false;
    bf16* O; const signed char* XB; const float* SX; const float* SY; const float* SWO; float* ssq; float* amx;
    __device__ __forceinline__ void operator()(const pg8::i32x4 (&acc)[2][2][4][2], const pg8::Unit& u, int wr, int wc, int fr, int fq) const {
        const int row0 = u.pm * 256 + wr * 64 + fr, col0 = u.pn * 256 + wc * 32 + 8 * fq;
        f32x4 sw[2][2];
#pragma unroll
        for (int bj = 0; bj < 2; ++bj) { sw[bj][0] = *(const f32x4*)(SWO + col0 + bj * 128); sw[bj][1] = *(const f32x4*)(SWO + col0 + bj * 128 + 4); }
#pragma unroll
        for (int ai = 0; ai < 2; ++ai)
#pragma unroll
            for (int m = 0; m < 4; ++m) {
                const int row = row0 + ai * 128 + m * 16;
                const signed char* xr = XB + (size_t)row * DM + col0; bf16* rowp = O + (size_t)row * DM + col0;
                float q = 0.f, mxa = 0.f;
                u32x2 xw[2]; const float sxr = SX[row], syr = SY[row];
#pragma unroll
                for (int bj = 0; bj < 2; ++bj) xw[bj] = *(const u32x2*)(xr + bj * 128);
#pragma unroll
                for (int bj = 0; bj < 2; ++bj) {
                    const f32x4 x0 = (f32x4){(float)(signed char)(xw[bj].x), (float)(signed char)(xw[bj].x >> 8), (float)(signed char)(xw[bj].x >> 16), (float)((int)xw[bj].x >> 24)} * sxr,
                                x1 = (f32x4){(float)(signed char)(xw[bj].y), (float)(signed char)(xw[bj].y >> 8), (float)(signed char)(xw[bj].y >> 16), (float)((int)xw[bj].y >> 24)} * sxr;
                    const pg8::i32x4 a0 = acc[ai][bj][m][0], a1 = acc[ai][bj][m][1];
                    const f32x4 v0 = (f32x4){(float)a0[0], (float)a0[1], (float)a0[2], (float)a0[3]} * (sw[bj][0] * syr) + x0, v1 = (f32x4){(float)a1[0], (float)a1[1], (float)a1[2], (float)a1[3]} * (sw[bj][1] * syr) + x1;
                    q += (v0[0] * v0[0] + v0[1] * v0[1]) + (v0[2] * v0[2] + v0[3] * v0[3]) + (v1[0] * v1[0] + v1[1] * v1[1]) + (v1[2] * v1[2] + v1[3] * v1[3]);
                    mxa = fmaxf(mxa, fmaxf(fmaxf(fmaxf(fabsf(v0[0]), fabsf(v0[1])), fmaxf(fabsf(v0[2]), fabsf(v0[3]))), fmaxf(fmaxf(fabsf(v1[0]), fabsf(v1[1])), fmaxf(fabsf(v1[2]), fabsf(v1[3])))));
                    u32x4 w; w.x = cvt_pk_bf16(v0[0], v0[1]); w.y = cvt_pk_bf16(v0[2], v0[3]); w.z = cvt_pk_bf16(v1[0], v1[1]); w.w = cvt_pk_bf16(v1[2], v1[3]);
                    *(u32x4*)(rowp + bj * 128) = w; }
                q += __shfl_xor(q, 16); q += __shfl_xor(q, 32);
                mxa = fmaxf(mxa, __shfl_xor(mxa, 16)); mxa = fmaxf(mxa, __shfl_xor(mxa, 32));
                if (fq == 0) { ssq[(size_t)row * 16 + u.pn * 4 + wc] = q; amx[(size_t)row * 16 + u.pn * 4 + wc] = mxa; }
            }
    }
};
template <bool MAPIN> __device__ __forceinline__ void p0_transpose_item(const float* W, int K, int N, bf16* WT, LAS float* scr, int item, int lane,
                                                  const float* g_lo, const float* g_hi, int split) {
    const int nblk = N / 32, kb = item / nblk, nb = item % nblk, k0 = 64 * kb, n0 = 32 * nb;
#pragma unroll 8
    for (int i = 0; i < 32; ++i) { const int kk = 2 * i + (lane >> 5); const int k = k0 + kk;
        const float g = (k < split) ? g_lo[k] : g_hi[k - split];
        scr[kk * 33 + (lane & 31)] = W[(size_t)k * N + (MAPIN ? win_src_col(n0) : n0) + (lane & 31)] * g; }
    asm volatile("s_waitcnt lgkmcnt(0)" ::: "memory");
    const int c = lane & 7;
#pragma unroll
    for (int j = 0; j < 4; ++j) { const int n = (lane >> 3) + 8 * j; const LAS float* s = scr + (8 * c) * 33 + n;
        u32x4 o; o.x = pk2(s[0 * 33], s[1 * 33]); o.y = pk2(s[2 * 33], s[3 * 33]); o.z = pk2(s[4 * 33], s[5 * 33]); o.w = pk2(s[6 * 33], s[7 * 33]);
        *(u32x4*)(WT + (size_t)(n0 + n) * K + k0 + 8 * c) = o; }
    asm volatile("s_waitcnt lgkmcnt(0)" ::: "memory");
}

constexpr int CW_COLMAX = 5120;
__device__ __forceinline__ void p0_colmax_item(const float* W, int N, unsigned* colmax, int item, int lane, const float* g) {
    const int nblk = N / 32, kb = item / nblk, nb = item % nblk, k0 = 64 * kb, n0 = 32 * nb;
    float mx = 0.f;
#pragma unroll
    for (int i = 0; i < 32; ++i) { const int k = k0 + 2 * i + (lane >> 5); mx = fmaxf(mx, fabsf(W[(size_t)k * N + n0 + (lane & 31)] * g[k])); }
    mx = fmaxf(mx, __shfl_xor(mx, 32));
    if (lane < 32) atomicMax(colmax + n0 + lane, __float_as_uint(mx));
}
__device__ __forceinline__ void p1_quant_item(const float* W, int K, int N, signed char* WT8, float* swout, const unsigned* colmax, LAS float* scr, int item, int lane, const float* g) {
    const int nblk = N / 32, kb = item / nblk, nb = item % nblk, k0 = 64 * kb, n0 = 32 * nb, s0 = win_src_col(n0);
    const float cm = fmaxf(__uint_as_float(__hip_atomic_load((unsigned*)colmax + s0 + (lane & 31), __ATOMIC_RELAXED, __HIP_MEMORY_SCOPE_AGENT)), 1e-30f), inv = 127.f / cm;
    if (kb == 0 && lane < 32) swout[n0 + lane] = cm * (1.f / 127.f);
#pragma unroll
    for (int i = 0; i < 32; ++i) { const int kk = 2 * i + (lane >> 5); const int k = k0 + kk;
        scr[kk * 33 + (lane & 31)] = W[(size_t)k * N + s0 + (lane & 31)] * g[k] * inv; }
    asm volatile("s_waitcnt lgkmcnt(0)" ::: "memory");
    const int c = lane & 7;
#pragma unroll
    for (int j = 0; j < 4; ++j) { const int n = (lane >> 3) + 8 * j; const LAS float* sp = scr + (8 * c) * 33 + n;
        unsigned w0 = 0u, w1 = 0u;
#pragma unroll
        for (int i = 0; i < 4; ++i) { w0 |= ((unsigned)(int)rintf(sp[i * 33]) & 255u) << (8 * i); w1 |= ((unsigned)(int)rintf(sp[(4 + i) * 33]) & 255u) << (8 * i); }
        u32x2 o; o.x = w0; o.y = w1;
        *(u32x2*)(WT8 + (size_t)(n0 + n) * K + k0 + 8 * c) = o; }
    asm volatile("s_waitcnt lgkmcnt(0)" ::: "memory");
}
constexpr int CW_WCNT = 10752;
constexpr size_t WS_METARAW = 65536;
constexpr int CW_COLMAX3 = 8704;
constexpr int CW_COLMAX2 = 7680;
__device__ __forceinline__ void p0_colmax_item2(const float* W, int N, unsigned* colmax, int item, int lane, const float* g_lo, const float* g_hi, int split) {
    const int nblk = N / 32, kb = item / nblk, nb = item % nblk, k0 = 64 * kb, n0 = 32 * nb;
    float mx = 0.f;
#pragma unroll
    for (int i = 0; i < 32; ++i) { const int k = k0 + 2 * i + (lane >> 5); const float g = (k < split) ? g_lo[k] : g_hi[k - split]; mx = fmaxf(mx, fabsf(W[(size_t)k * N + n0 + (lane & 31)] * g)); }
    mx = fmaxf(mx, __shfl_xor(mx, 32));
    if (lane < 32) atomicMax(colmax + n0 + lane, __float_as_uint(mx));
}
__device__ __forceinline__ void p1_quant_item2(const float* W, int K, int N, signed char* WT8, float* swout, const unsigned* colmax, LAS float* scr, int item, int lane, const float* g_lo, const float* g_hi, int split) {
    const int nblk = N / 32, kb = item / nblk, nb = item % nblk, k0 = 64 * kb, n0 = 32 * nb;
    const float cm = fmaxf(__uint_as_float(__hip_atomic_load((unsigned*)colmax + n0 + (lane & 31), __ATOMIC_RELAXED, __HIP_MEMORY_SCOPE_AGENT)), 1e-30f), inv = 127.f / cm;
    if (kb == 0 && lane < 32) swout[n0 + lane] = cm * (1.f / 127.f);
#pragma unroll
    for (int i = 0; i < 32; ++i) { const int kk = 2 * i + (lane >> 5); const int k = k0 + kk; const float g = (k < split) ? g_lo[k] : g_hi[k - split];
        scr[kk * 33 + (lane & 31)] = W[(size_t)k * N + n0 + (lane & 31)] * g * inv; }
    asm volatile("s_waitcnt lgkmcnt(0)" ::: "memory");
    const int c = lane & 7;
#pragma unroll
    for (int j = 0; j < 4; ++j) { const int n = (lane >> 3) + 8 * j; const LAS float* sp = scr + (8 * c) * 33 + n;
        unsigned w0 = 0u, w1 = 0u;
#pragma unroll
        for (int i = 0; i < 4; ++i) { w0 |= ((unsigned)(int)rintf(sp[i * 33]) & 255u) << (8 * i); w1 |= ((unsigned)(int)rintf(sp[(4 + i) * 33]) & 255u) << (8 * i); }
        u32x2 o; o.x = w0; o.y = w1;
        *(u32x2*)(WT8 + (size_t)(n0 + n) * K + k0 + 8 * c) = o; }
    asm volatile("s_waitcnt lgkmcnt(0)" ::: "memory");
}
__device__ __forceinline__ float q4(float x, float inv_s) {
    const float a = fabsf(x) * inv_s; float r;
    if (a < 2.f) r = rintf(a * 2.f) * 0.5f; else if (a < 4.f) r = rintf(a); else r = fminf(6.f, rintf(a * 0.5f) * 2.f);
    return copysignf(r, x);
}
__device__ __forceinline__ void phase_prep(const Params& P, LAS unsigned char* lds) {
    const int tid = threadIdx.x, lane = tid & 63, wave = __builtin_amdgcn_readfirstlane(tid >> 6);
    const int gw = blockIdx.x * NWAVES + wave, NGW = gridDim.x * NWAVES;
    unsigned char* ws = P.ws;
    LAS float* scr = (LAS float*)(lds + wave * 16384);
    constexpr int I_IN = (DM / 64) * (DIN / 32), I_OUT = (DM / 64) * (DM / 32), I_Q = (DM / 64) * (2048 / 32);
    for (int it = gw; it < I_IN + I_OUT + I_Q; it += NGW) {
        int r = it;
        int grp;
        if (r < I_IN) { p0_colmax_item(P.w_in, DIN, (unsigned*)(ws + WS_CTL) + CW_COLMAX, r, lane, P.g_mix); grp = r % (DIN / 32); }
        else if (r < I_IN + I_OUT) { r -= I_IN; p0_colmax_item2(P.w_out, DM, (unsigned*)(ws + WS_CTL) + CW_COLMAX2, r, lane, P.g_sc, P.g_cf, 512); grp = 80 + r % (DM / 32); }
        else { r -= I_IN + I_OUT; p0_colmax_item2(P.w_q, 2048, (unsigned*)(ws + WS_CTL) + CW_COLMAX3, r, lane, P.g_ffn, P.g_ffn, DM); grp = 112 + r % (2048 / 32); }
        asm volatile("s_waitcnt vmcnt(0)" ::: "memory");
        if (lane == 0) (void)__hip_atomic_fetch_add((unsigned*)(ws + WS_CTL) + CW_WCNT + grp, 1u, __ATOMIC_RELAXED, __HIP_MEMORY_SCOPE_AGENT);
    }
    {
        unsigned* H0I8 = (unsigned*)(ws + WS_H0I8); float* RS1 = (float*)(ws + WS_RSTD1); float* SXp = (float*)(ws + WS_SX);
        for (int t0 = gw * 4; t0 < NTOK; t0 += NGW * 4) {
            f32x4 v[4][4];
#pragma unroll
            for (int q = 0; q < 4; ++q) { const f32x4* xr = (const f32x4*)(P.x + (size_t)(t0 + q) * DM) + lane;
#pragma unroll
                for (int j = 0; j < 4; ++j) v[q][j] = xr[64 * j]; }
#pragma unroll
            for (int q = 0; q < 4; ++q) { float sq = 0.f, mx = 0.f;
#pragma unroll
                for (int j = 0; j < 4; ++j) { sq += (v[q][j].x * v[q][j].x + v[q][j].y * v[q][j].y) + (v[q][j].z * v[q][j].z + v[q][j].w * v[q][j].w);
                    mx = fmaxf(mx, fmaxf(fmaxf(fabsf(v[q][j].x), fabsf(v[q][j].y)), fmaxf(fabsf(v[q][j].z), fabsf(v[q][j].w)))); }
                sq = wave_sum_fast(sq); mx = fmaxf(wave_max_fast(mx), 1e-30f);
                const float sx = mx * (1.f / 127.f), inv = 127.f / mx;
                if (lane == 0) { RS1[t0 + q] = sx * rsqrtf(sq * (1.f / DM) + EPS); SXp[t0 + q] = sx; }
                unsigned* o = H0I8 + (size_t)(t0 + q) * (DM / 4) + lane;
#pragma unroll
                for (int j = 0; j < 4; ++j) { const int a = (int)rintf(v[q][j].x * inv), b = (int)rintf(v[q][j].y * inv), c = (int)rintf(v[q][j].z * inv), d = (int)rintf(v[q][j].w * inv);
                    o[64 * j] = ((unsigned)a & 255u) | (((unsigned)b & 255u) << 8) | (((unsigned)c & 255u) << 16) | ((unsigned)d << 24); } }
        }
    }
    {
        bf16* KB = (bf16*)(ws + WS_KEYS);
        const int gt = blockIdx.x * NTHREADS + tid, NGT = gridDim.x * NTHREADS;
        for (int i = gt; i < 8 * 2 * 128 * 128 / 4; i += NGT) { const f32x4 v = ((const f32x4*)P.keys)[i]; u32x2 w; w.x = pk2(v.x, v.y); w.y = pk2(v.z, v.w); ((u32x2*)KB)[i] = w; }
    }
    {
        float* MP = (float*)(ws + WS_CTL + WS_METARAW); float* MR = (float*)(ws + WS_METARSTD);
        for (int r = gw; r < NMETA; r += NGW) {
            float s = 0.f;
            for (int k = lane; k < DM; k += 64) { const float v = P.meta[r * DM + k]; s += v * v; }
            s = wave_sum(s);
            if (lane == 0) MR[r] = rsqrtf(s * (1.f / DM) + EPS);
        }
        for (int it = gw; it < MKC * 40; it += NGW) {
            const int kc = it / 40, nb = it % 40, n = nb * 64 + lane;
            float acc[NMETA];
#pragma unroll
            for (int r = 0; r < NMETA; ++r) acc[r] = 0.f;
            for (int k = kc * (DM / MKC); k < (kc + 1) * (DM / MKC); ++k) {
                const float w = P.w_in[(size_t)k * DIN + n] * P.g_mix[k];
#pragma unroll
                for (int r = 0; r < NMETA; ++r) acc[r] += P.meta[r * DM + k] * w;
            }
#pragma unroll
            for (int r = 0; r < NMETA; ++r) (void)__hip_atomic_fetch_add(MP + (size_t)r * DIN + n, acc[r], __ATOMIC_RELAXED, __HIP_MEMORY_SCOPE_AGENT);
        }
    }
    {
        constexpr int NI1 = (DM / 64) * (DIN / 32), NI2 = (DM / 64) * (DM / 32), NI3 = (DM / 64) * (2048 / 32);
        unsigned* cnt = (unsigned*)(ws + WS_CTL) + CW_WCNT;
        for (int it = gw; it < NI1 + NI2 + NI3; it += NGW) {
            int grp;
            if (it < NI1) grp = win_src_col(32 * (it % (DIN / 32))) / 32; else if (it < NI1 + NI2) grp = 80 + (it - NI1) % (DM / 32); else grp = 112 + (it - NI1 - NI2) % (2048 / 32);
            { unsigned sp = 0; while (__hip_atomic_load(cnt + grp, __ATOMIC_RELAXED, __HIP_MEMORY_SCOPE_AGENT) < 16u) { __builtin_amdgcn_s_sleep(2); if (++sp > (1u << 20)) break; } }
            if (it < NI1) p1_quant_item(P.w_in, DM, DIN, (signed char*)(ws + WS_WIN_T), (float*)(ws + WS_SW), (const unsigned*)(ws + WS_CTL) + CW_COLMAX, scr, it, lane, P.g_mix);
            else if (it < NI1 + NI2) p1_quant_item2(P.w_out, DM, DM, (signed char*)(ws + WS_WOUT_T), (float*)(ws + WS_SWO), (const unsigned*)(ws + WS_CTL) + CW_COLMAX2, scr, it - NI1, lane, P.g_sc, P.g_cf, 512);
            else p1_quant_item2(P.w_q, DM, 2048, (signed char*)(ws + WS_WQ_T), (float*)(ws + WS_SWQ), (const unsigned*)(ws + WS_CTL) + CW_COLMAX3, scr, it - NI1 - NI2, lane, P.g_ffn, P.g_ffn, DM);
        }
    }
}

__device__ __forceinline__ float metaval(const float* RAW, const float* MR, int p, int c) {
    const float r = MR[p]; const float* rp = RAW + (size_t)p * DIN;
    if (c < 512) return (rp[c] * r) * (rp[1024 + c] * r);
    if (c < 1024) return rp[c] * r;
    return (rp[1536 + (c - 1024)] * r) * sigmoid_f(rp[2048 + (c - 1024)] * r);
}
__device__ __forceinline__ float meta_val(const float* MJ, const float*, int p, int col) { return MJ[p * PDIM + col]; }
__device__ __forceinline__ float proj_at(const bf16* PROJ, const float* MP, const float* MR, int b, int pos, int col) {
    if (pos < 0) return 0.f;
    if (pos < NMETA) return meta_val(MP, MR, pos, col);
    return bf2f(PROJ[(size_t)(b * SEQ + pos - NMETA) * PDIM + col]);
}
struct TabRow { f32x4 v[4]; };
__device__ __forceinline__ void tab_load(const Params& P, int e, int lane, TabRow& r) {
    const bool isv = e >= 16384; const int ee = isv ? e - 16384 : e;
    const f32x4* src = (const f32x4*)((isv ? P.pv : P.pu) + (size_t)ee * DM);
#pragma unroll
    for (int j = 0; j < 4; ++j) r.v[j] = isv ? src[4 * lane + j] : src[64 * j + lane];
}
__device__ __forceinline__ void tab_finish(const Params& P, int e, int lane, TabRow& r) {
    unsigned char* ws = P.ws; float* ESC = (float*)(ws + WS_ESCALE);
    const bool isv = e >= 16384; const int ee = isv ? e - 16384 : e;
    float mx = 0.f;
#pragma unroll
    for (int j = 0; j < 4; ++j) { if (!isv) r.v[j] = r.v[j] * ((const f32x4*)P.g_ffn)[64 * j + lane];
        mx = fmaxf(mx, fmaxf(fmaxf(fabsf(r.v[j].x), fabsf(r.v[j].y)), fmaxf(fabsf(r.v[j].z), fabsf(r.v[j].w)))); }
    mx = wave_max_fast(mx);
    if (!isv) {
        float sq2 = 0.f;
#pragma unroll
        for (int j = 0; j < 4; ++j) sq2 += (r.v[j].x * r.v[j].x + r.v[j].y * r.v[j].y) + (r.v[j].z * r.v[j].z + r.v[j].w * r.v[j].w);
        const float rms = sqrtf(wave_sum_fast(sq2) * (1.f / DM));
        const float su = fmaxf(fminf(mx, U4_CLIP * rms), 1e-30f) * (1.f / 7.f), inv = 1.f / su;
        unsigned wq[2] = {0u, 0u}; int csum = 0;
#pragma unroll
        for (int j = 0; j < 4; ++j) { const float e4[4] = {r.v[j].x, r.v[j].y, r.v[j].z, r.v[j].w};
#pragma unroll
            for (int i = 0; i < 4; ++i) { int c = (int)rintf(fminf(fmaxf(e4[i] * inv, -7.f), 7.f)); csum += c;
                wq[j >> 1] |= ((unsigned)c & 15u) << (16 * (j & 1) + 4 * i); } }
        const float cs = wave_sum_fast((float)csum);
        if (lane == 0) { ESC[e] = su; ((float*)(ws + WS_SUMQ))[e] = cs; }
        u32x2 o; o.x = wq[0]; o.y = wq[1];
        *(u32x2*)(ws + WS_U8 + (size_t)ee * 512 + 8 * lane) = o;
        return;
    }
    const float sc = fmaxf(mx, 1e-30f) * (1.f / 6.f), inv = 1.f / sc;
    if (lane == 0) ESC[e] = sc;
    unsigned w0 = 0u, w1 = 0u;
    w0 = __builtin_amdgcn_cvt_scalef32_pk_fp4_f32(w0, r.v[0].x * inv, r.v[0].y * inv, 1.0f, 0); w0 = __builtin_amdgcn_cvt_scalef32_pk_fp4_f32(w0, r.v[0].z * inv, r.v[0].w * inv, 1.0f, 1);
    w0 = __builtin_amdgcn_cvt_scalef32_pk_fp4_f32(w0, r.v[1].x * inv, r.v[1].y * inv, 1.0f, 2); w0 = __builtin_amdgcn_cvt_scalef32_pk_fp4_f32(w0, r.v[1].z * inv, r.v[1].w * inv, 1.0f, 3);
    w1 = __builtin_amdgcn_cvt_scalef32_pk_fp4_f32(w1, r.v[2].x * inv, r.v[2].y * inv, 1.0f, 0); w1 = __builtin_amdgcn_cvt_scalef32_pk_fp4_f32(w1, r.v[2].z * inv, r.v[2].w * inv, 1.0f, 1);
    w1 = __builtin_amdgcn_cvt_scalef32_pk_fp4_f32(w1, r.v[3].x * inv, r.v[3].y * inv, 1.0f, 2); w1 = __builtin_amdgcn_cvt_scalef32_pk_fp4_f32(w1, r.v[3].z * inv, r.v[3].w * inv, 1.0f, 3);
    u32x2 o; o.x = w0; o.y = w1;
    *(u32x2*)(ws + WS_V8 + (size_t)ee * 512 + 8 * lane) = o;
}
__device__ __forceinline__ void proj8_at(const bf16* PROJ, const float* MP, const float* MR, int b, int pos, int col, float (&v)[8]) {
    if (pos < 0) {
#pragma unroll
        for (int i = 0; i < 8; ++i) v[i] = 0.f;
    } else if (pos < NMETA) {
#pragma unroll
        for (int i = 0; i < 8; ++i) v[i] = metaval(MP, MR, pos, col + i);
    } else {
        const u32x4 w = *(const u32x4*)(PROJ + (size_t)(b * SEQ + pos - NMETA) * PDIM + col);
        v[0] = bflo(w.x); v[1] = bfhi(w.x); v[2] = bflo(w.y); v[3] = bfhi(w.y); v[4] = bflo(w.z); v[5] = bfhi(w.z); v[6] = bflo(w.w); v[7] = bfhi(w.w);
    }
}

template <int R> __device__ __forceinline__ void conv_rows(const LAS unsigned char* ubase, const f32x2 (&wcf)[31], f32x2 (&acc)[32]) {
    if constexpr (R < 62) {
        const unsigned uw = *(const LAS unsigned*)(ubase + R * 1024);
        const f32x2 x = (f32x2){bflo(uw), bfhi(uw)};
        constexpr int lo = R > 30 ? R - 30 : 0, hi = R < 31 ? R : 31;
#pragma unroll
        for (int ii = lo; ii <= hi; ++ii) acc[ii] += wcf[R - ii] * x;
        conv_rows<R + 1>(ubase, wcf, acc);
    }
}
__device__ __forceinline__ void phase_conv(const Params& P, LAS unsigned char* lds) {
    const int tid = threadIdx.x, lane = tid & 63, wave = __builtin_amdgcn_readfirstlane(tid >> 6);
    unsigned char* ws = P.ws;
    const bf16* PROJ = (const bf16*)(ws + WS_PROJ); const float* MP = (const float*)(ws + WS_CTL + WS_METARAW); const float* MR = (const float*)(ws + WS_METARSTD);
    bf16* Y = (bf16*)(ws + WS_Y);
    constexpr int TT = 64, NTILE = NTOK / TT, UROWS = TT + 30;
    const int cgp = wave & 3, th = wave >> 2, ch2 = cgp * 128 + 2 * lane;
    f32x2 wcf[31];
#pragma unroll
    for (int j = 0; j < 31; ++j) wcf[j] = *(const f32x2*)(P.cf_w + j * 512 + ch2);
    const f32x2 bcf = *(const f32x2*)(P.cf_b + ch2);
    for (int tile = blockIdx.x; tile < NTILE; tile += gridDim.x) {
        const int b = tile / (SEQ / TT), s0 = (tile % (SEQ / TT)) * TT;
        if (s0 >= 30) {
            const bf16* pr = PROJ + ((size_t)b * SEQ + s0 - 30) * PDIM + 1024 + 8 * lane;
            u32x4 rw[(UROWS + 7) / 8];
#pragma unroll
            for (int p = 0; p < (UROWS + 7) / 8; ++p) { const int r = p * 8 + wave; rw[p] = *(const u32x4*)(pr + (size_t)(r < UROWS ? r : UROWS - 1) * PDIM); }
#pragma unroll
            for (int p = 0; p < (UROWS + 7) / 8; ++p) { const int r = p * 8 + wave; if (r < UROWS) *(LAS u32x4*)(lds + r * 1024 + lane * 16) = rw[p]; }
        } else {
#pragma unroll 4
        for (int p = 0; p < (UROWS + 7) / 8; ++p) {
            const int r = p * 8 + wave;
            if (r < UROWS) {
                const int pos = NMETA + s0 - 30 + r;
                float uu[8];
                proj8_at(PROJ, MP, MR, b, pos, 1024 + 8 * lane, uu);
                u32x4 w; w.x = pk2(uu[0], uu[1]); w.y = pk2(uu[2], uu[3]); w.z = pk2(uu[4], uu[5]); w.w = pk2(uu[6], uu[7]);
                *(LAS u32x4*)(lds + r * 1024 + lane * 16) = w;
            }
        }
        }
        __syncthreads();
        f32x2 acc[32];
#pragma unroll
        for (int ii = 0; ii < 32; ++ii) acc[ii] = bcf;
        conv_rows<0>(lds + (32 * th) * 1024 + ch2 * 2, wcf, acc);
        u32x4 rcx[8], rbg[8];
        { const bf16* pr = PROJ + ((size_t)b * SEQ + s0 + 8 * wave) * PDIM + 8 * lane;
#pragma unroll
          for (int q = 0; q < 8; ++q) { rcx[q] = *(const u32x4*)(pr + (size_t)q * PDIM); rbg[q] = *(const u32x4*)(pr + (size_t)q * PDIM + 512); } }
        __syncthreads();
#pragma unroll
        for (int ii = 0; ii < 32; ++ii) *(LAS f32x2*)(lds + (32 * th + ii) * 2048 + ch2 * 4) = acc[ii];
        __syncthreads();
        {
            float lng[8], lnb[8];
            { const f32x4 a = *(const f32x4*)(P.ln_g + 8 * lane), c = *(const f32x4*)(P.ln_g + 8 * lane + 4), d = *(const f32x4*)(P.ln_b + 8 * lane), e = *(const f32x4*)(P.ln_b + 8 * lane + 4);
              lng[0] = a.x; lng[1] = a.y; lng[2] = a.z; lng[3] = a.w; lng[4] = c.x; lng[5] = c.y; lng[6] = c.z; lng[7] = c.w;
              lnb[0] = d.x; lnb[1] = d.y; lnb[2] = d.z; lnb[3] = d.w; lnb[4] = e.x; lnb[5] = e.y; lnb[6] = e.z; lnb[7] = e.w; }
            float wsc[3][8];
#pragma unroll
            for (int j = 0; j < 3; ++j) { const f32x4 a = *(const f32x4*)(P.sc_w + j * 512 + 8 * lane), c = *(const f32x4*)(P.sc_w + j * 512 + 8 * lane + 4);
                wsc[j][0] = a.x; wsc[j][1] = a.y; wsc[j][2] = a.z; wsc[j][3] = a.w; wsc[j][4] = c.x; wsc[j][5] = c.y; wsc[j][6] = c.z; wsc[j][7] = c.w; }
            float cxa[8], cxb[8];
            { const int pos = NMETA + s0 + 8 * wave - 2;
              proj8_at(PROJ, MP, MR, b, pos, 8 * lane, cxa); proj8_at(PROJ, MP, MR, b, pos + 1, 8 * lane, cxb); }
#pragma unroll
            for (int q = 0; q < 8; ++q) {
                const int ii = 8 * wave + q, s = s0 + ii; const size_t t = (size_t)b * SEQ + s;
                float o[8];
                { const f32x4 a = *(const LAS f32x4*)(lds + ii * 2048 + lane * 32), c = *(const LAS f32x4*)(lds + ii * 2048 + lane * 32 + 16);
                  o[0] = a.x; o[1] = a.y; o[2] = a.z; o[3] = a.w; o[4] = c.x; o[5] = c.y; o[6] = c.z; o[7] = c.w; }
                float s1 = 0.f;
#pragma unroll
                for (int i = 0; i < 8; ++i) s1 += o[i];
                const float mean = wave_sum_fast(s1) * (1.f / 512.f);
                float s2 = 0.f;
#pragma unroll
                for (int i = 0; i < 8; ++i) { o[i] -= mean; s2 += o[i] * o[i]; }
                const float rs = __builtin_amdgcn_rsqf(wave_sum_fast(s2) * (1.f / 512.f) + EPS);
                float s3 = 0.f;
#pragma unroll
                for (int i = 0; i < 8; ++i) { float y = o[i] * rs * lng[i] + lnb[i]; y = y * sigmoid_f(y); o[i] = y; s3 += y * y; }
                const float r2 = __builtin_amdgcn_rsqf(wave_sum_fast(s3) * (1.f / 512.f) + EPS);
                float bgv[8], cxc[8], accs[8];
                { const u32x4 w = rcx[q], z = rbg[q];
                  cxc[0] = bflo(w.x); cxc[1] = bfhi(w.x); cxc[2] = bflo(w.y); cxc[3] = bfhi(w.y); cxc[4] = bflo(w.z); cxc[5] = bfhi(w.z); cxc[6] = bflo(w.w); cxc[7] = bfhi(w.w);
                  bgv[0] = bflo(z.x); bgv[1] = bfhi(z.x); bgv[2] = bflo(z.y); bgv[3] = bfhi(z.y); bgv[4] = bflo(z.z); bgv[5] = bfhi(z.z); bgv[6] = bflo(z.w); bgv[7] = bfhi(z.w); }
                float s4 = 0.f;
#pragma unroll
                for (int i = 0; i < 8; ++i) { accs[i] = bgv[i] * (wsc[0][i] * cxa[i] + wsc[1][i] * cxb[i] + wsc[2][i] * cxc[i]); s4 += accs[i] * accs[i]; cxa[i] = cxb[i]; cxb[i] = cxc[i]; }
                const float r4 = __builtin_amdgcn_rsqf(wave_sum_fast(s4) * (1.f / 512.f) + EPS);
                float ym = 0.f;
#pragma unroll
                for (int i = 0; i < 8; ++i) { o[i] *= r2; accs[i] *= r4; ym = fmaxf(ym, fmaxf(fabsf(o[i]), fabsf(accs[i]))); }
                ym = fmaxf(wave_max_fast(ym), 1e-30f);
                const float yinv = 127.f * __builtin_amdgcn_rcpf(ym);
                if (lane == 0) ((float*)(ws + WS_SY))[t] = ym * (1.f / 127.f);
                u32x2 wz, wv;
                { unsigned fa[8], fo[8];
#pragma unroll
                  for (int i = 0; i < 8; ++i) { fa[i] = __float_as_uint(fmaf(accs[i], yinv, 12582912.f)); fo[i] = __float_as_uint(fmaf(o[i], yinv, 12582912.f)); }
                  wz.x = __builtin_amdgcn_perm(fa[1], fa[0], 0x0c0c0400u) | __builtin_amdgcn_perm(fa[3], fa[2], 0x04000c0cu);
                  wz.y = __builtin_amdgcn_perm(fa[5], fa[4], 0x0c0c0400u) | __builtin_amdgcn_perm(fa[7], fa[6], 0x04000c0cu);
                  wv.x = __builtin_amdgcn_perm(fo[1], fo[0], 0x0c0c0400u) | __builtin_amdgcn_perm(fo[3], fo[2], 0x04000c0cu);
                  wv.y = __builtin_amdgcn_perm(fo[5], fo[4], 0x0c0c0400u) | __builtin_amdgcn_perm(fo[7], fo[6], 0x04000c0cu); }
                *(u32x2*)(ws + WS_Y + t * DM + 8 * lane) = wz;
                *(u32x2*)(ws + WS_Y + t * DM + 512 + 8 * lane) = wv;
            }
        }
        __syncthreads();
    }
}

__device__ __forceinline__ int ord_i(float s) { int k = __builtin_bit_cast(int, s); k ^= (k >> 31) & 0x7fffffff; return k; }
__device__ __forceinline__ float unord_f(int k) { k ^= (k >> 31) & 0x7fffffff; return __builtin_bit_cast(float, k); }
#define TOP_INSERT(L, x_) do { int _x = (x_); _Pragma("unroll") for (int _i = 0; _i < 16; ++_i) { const int _hi = max(L[_i], _x); _x = min(L[_i], _x); L[_i] = _hi; } } while (0)

typedef short bf16x8 __attribute__((ext_vector_type(8)));
typedef float f32x16 __attribute__((ext_vector_type(16)));
template <bool DESC> __device__ __forceinline__ void ce_i(int& a, int& b) { const int hi = max(a, b), lo = min(a, b); if (DESC) { a = hi; b = lo; } else { a = lo; b = hi; } }
__device__ __forceinline__ void bitonic_sort16(int (&a)[16]) {
#pragma unroll
    for (int k = 2; k <= 16; k <<= 1)
#pragma unroll
        for (int j = k >> 1; j > 0; j >>= 1)
#pragma unroll
            for (int i = 0; i < 16; ++i) { const int l = i ^ j; if (l > i) { if ((i & k) == 0) ce_i<true>(a[i], a[l]); else ce_i<false>(a[i], a[l]); } }
}
__device__ __forceinline__ void bitonic_merge16(int (&a)[16]) {
#pragma unroll
    for (int j = 8; j > 0; j >>= 1)
#pragma unroll
        for (int i = 0; i < 16; ++i) { const int l = i ^ j; if (l > i) ce_i<true>(a[i], a[l]); }
}
__device__ __forceinline__ void merge_top16(int (&a)[16], const int (&b)[16]) {
#pragma unroll
    for (int i = 0; i < 16; ++i) a[i] = max(a[i], b[15 - i]);
    bitonic_merge16(a);
}
__device__ __forceinline__ int lut16(const unsigned (&T)[4], int i) {
    const unsigned sel = (unsigned)(i & 7) | 0x0c0c0c00u;
    const unsigned lo = __builtin_amdgcn_perm(T[1], T[0], sel), hi = __builtin_amdgcn_perm(T[3], T[2], sel);
    return (int)((i & 8) ? hi : lo);
}
constexpr int KROW = 272;
constexpr float SCORE_BIAS = 8.0f;

__device__ __forceinline__ void route_load_q(bf16x8 (&qf)[8], const bf16* qrow, int hb) {
#pragma unroll
    for (int ks = 0; ks < 8; ++ks) qf[ks] = *(const bf16x8*)(qrow + 64 * hb + 8 * ks);
}
__device__ __forceinline__ void route_half(const LAS unsigned char* kl, const bf16x8 (&qf)[8], int nl, int hb, int (&L)[16]) {
    f32x16 acc[4];
#pragma unroll
    for (int nt = 0; nt < 4; ++nt)
#pragma unroll
        for (int r = 0; r < 16; ++r) acc[nt][r] = SCORE_BIAS;
#pragma unroll
    for (int ks = 0; ks < 8; ++ks)
#pragma unroll
        for (int nt = 0; nt < 4; ++nt) {
            const bf16x8 a = *(const LAS bf16x8*)(kl + (32 * nt + nl) * KROW + (64 * hb + 8 * ks) * 2);
            acc[nt] = __builtin_amdgcn_mfma_f32_32x32x16_bf16(a, qf[ks], acc[nt], 0, 0, 0);
        }
    const int hb4 = 4 * hb;
    int T[4][16];
#pragma unroll
    for (int nt = 0; nt < 4; ++nt)
#pragma unroll
        for (int r = 0; r < 16; ++r) { const int n0 = 32 * nt + (r & 3) + 8 * (r >> 2); const float sc = acc[nt][r];
            T[nt][r] = (__float_as_int(sc) & ~127) | ((127 - n0) - hb4); }
    bitonic_sort16(T[0]); bitonic_sort16(T[1]); bitonic_sort16(T[2]); bitonic_sort16(T[3]);
    merge_top16(T[0], T[1]); merge_top16(T[2], T[3]); merge_top16(T[0], T[2]);
#pragma unroll
    for (int i = 0; i < 16; ++i) { const unsigned v = (unsigned)T[0][15 - i]; auto r = __builtin_amdgcn_permlane32_swap(v, v, false, false);
        const unsigned r0 = r[0], r1 = r[1]; const int partner = (int)(hb ? r0 : r1); L[i] = max(T[0][i], partner); }
    bitonic_merge16(L);
}

__device__ __forceinline__ void phase_route(const Params& P, LAS unsigned char* lds) {
    const int tid = threadIdx.x, lane = tid & 63, wave = __builtin_amdgcn_readfirstlane(tid >> 6);
    const int nl = lane & 31, hb = lane >> 5;
    unsigned char* ws = P.ws;
    const bf16* KEYS = (const bf16*)(ws + WS_KEYS); const bf16* Q = (const bf16*)(ws + WS_Q);
    int* IDX = (int*)(ws + WS_IDX); float* GATE = (float*)(ws + WS_GATE);
    int last_h = -1;
    pg8::StaticOrder S; S.init(NTOK, 2048, (int)gridDim.x, (int)blockIdx.x);
    pg8::Unit ucur, unxt;
    bool have = S.next(0, ucur);
    bf16x8 qfA[8], qfB[8];
    if (have) route_load_q(qfA, Q + ((size_t)ucur.pm * 256 + wave * 32 + nl) * 2048 + ucur.pn * 256, hb);
    for (int ui = 0; have; ++ui) {
        const int h = ucur.pn, tb = ucur.pm;
        const bool have_next = S.next(ui + 1, unxt);
        if (h != last_h) {
            __syncthreads();
            for (int c = tid; c < 4096; c += NTHREADS) { const u32x4 v = ((const u32x4*)(KEYS + (size_t)h * 32768))[c];
                *(LAS u32x4*)(lds + (c >> 4) * KROW + (c & 15) * 16) = v; }
            __syncthreads();
            last_h = h;
        }
        const size_t t = (size_t)tb * 256 + wave * 32 + nl;
        int L1[16], L2[16];
        route_load_q(qfB, Q + t * 2048 + h * 256 + 128, hb);
        route_half(lds, qfA, nl, hb, L1);
        if (have_next) route_load_q(qfA, Q + ((size_t)unxt.pm * 256 + wave * 32 + nl) * 2048 + unxt.pn * 256, hb);
        route_half(lds + 128 * KROW, qfB, nl, hb, L2);
        float v1[16], v2[16];
#pragma unroll
        for (int i = 0; i < 16; ++i) { v1[i] = __int_as_float(L1[i] & ~127); v2[i] = __int_as_float(L2[i] & ~127); }
#define CAND(i, j) ((__float_as_int(v1[i] + v2[j]) & ~255) | (255 - (16 * (i) + (j))))
        int A[16], B[16], C[16];
#pragma unroll
        for (int j = 0; j < 16; ++j) A[j] = CAND(0, j);
#pragma unroll
        for (int j = 0; j < 8; ++j) { B[j] = CAND(1, j); B[8 + j] = CAND(15 - j, 0); }
        bitonic_merge16(B);
        C[0] = CAND(2, 0); C[1] = CAND(2, 1); C[2] = CAND(2, 2); C[3] = CAND(2, 3); C[4] = CAND(2, 4);
        C[5] = CAND(3, 0); C[6] = CAND(3, 1); C[7] = CAND(3, 2); C[8] = CAND(3, 3);
        C[9] = CAND(4, 0); C[10] = CAND(4, 1); C[11] = CAND(4, 2);
        C[12] = CAND(5, 0); C[13] = CAND(5, 1); C[14] = CAND(6, 0); C[15] = CAND(6, 1);
        bitonic_sort16(C);
        { const int d0 = CAND(7, 0), d1 = CAND(7, 1); C[14] = max(C[14], d1); C[15] = max(C[15], d0); bitonic_merge16(C); }
#undef CAND
        merge_top16(A, B); merge_top16(A, C);
        unsigned T1[4], T2[4];
#pragma unroll
        for (int q = 0; q < 4; ++q) {
            T1[q] = (unsigned)(127 - (L1[4 * q] & 127)) | ((unsigned)(127 - (L1[4 * q + 1] & 127)) << 8) | ((unsigned)(127 - (L1[4 * q + 2] & 127)) << 16) | ((unsigned)(127 - (L1[4 * q + 3] & 127)) << 24);
            T2[q] = (unsigned)(127 - (L2[4 * q] & 127)) | ((unsigned)(127 - (L2[4 * q + 1] & 127)) << 8) | ((unsigned)(127 - (L2[4 * q + 2] & 127)) << 16) | ((unsigned)(127 - (L2[4 * q + 3] & 127)) << 24); }
        float val[16]; int ex[16];
#pragma unroll
        for (int k = 0; k < 16; ++k) { const int pos = 255 - (A[k] & 255); val[k] = __int_as_float(A[k] & ~255);
            ex[k] = lut16(T1, pos >> 4) * NKEYS + lut16(T2, pos & 15); }
        float sum = 0.f; const float vmax = val[0];
#pragma unroll
        for (int k = 0; k < 16; ++k) { val[k] = __expf(val[k] - vmax); sum += val[k]; }
        const float inv = __builtin_amdgcn_rcpf(sum);
        if (hb == 0) {
            int* ip = IDX + t * NSEL + h * TOPK; float* gp = GATE + t * NSEL + h * TOPK;
#pragma unroll
            for (int k4 = 0; k4 < 4; ++k4) {
                *(int4*)(ip + 4 * k4) = make_int4(ex[4 * k4], ex[4 * k4 + 1], ex[4 * k4 + 2], ex[4 * k4 + 3]);
                *(f32x4*)(gp + 4 * k4) = (f32x4){val[4 * k4] * inv, val[4 * k4 + 1] * inv, val[4 * k4 + 2] * inv, val[4 * k4 + 3] * inv};
            }
        }
        ucur = unxt; have = have_next;
    }
}

#define FP4X2(w, sel) __builtin_amdgcn_cvt_scalef32_pk_f32_fp4((w), 1.0f, (sel))
__device__ __forceinline__ float dot16_fp4(const u32x2 r, const f32x4 (&xs)[4]) {
    float p = 0.f;
    { const f32x2 a = FP4X2(r.x, 0), b = FP4X2(r.x, 1), c = FP4X2(r.x, 2), d = FP4X2(r.x, 3);
      p += (a.x * xs[0].x + a.y * xs[0].y) + (b.x * xs[0].z + b.y * xs[0].w); p += (c.x * xs[1].x + c.y * xs[1].y) + (d.x * xs[1].z + d.y * xs[1].w); }
    { const f32x2 a = FP4X2(r.y, 0), b = FP4X2(r.y, 1), c = FP4X2(r.y, 2), d = FP4X2(r.y, 3);
      p += (a.x * xs[2].x + a.y * xs[2].y) + (b.x * xs[2].z + b.y * xs[2].w); p += (c.x * xs[3].x + c.y * xs[3].y) + (d.x * xs[3].z + d.y * xs[3].w); }
    return p;
}
__device__ __forceinline__ void axpy16_fp4(const u32x2 r, float w, f32x4 (&o)[4]) {
    { const f32x2 a = FP4X2(r.x, 0), b = FP4X2(r.x, 1), c = FP4X2(r.x, 2), d = FP4X2(r.x, 3);
      o[0].x += w * a.x; o[0].y += w * a.y; o[0].z += w * b.x; o[0].w += w * b.y; o[1].x += w * c.x; o[1].y += w * c.y; o[1].z += w * d.x; o[1].w += w * d.y; }
    { const f32x2 a = FP4X2(r.y, 0), b = FP4X2(r.y, 1), c = FP4X2(r.y, 2), d = FP4X2(r.y, 3);
      o[2].x += w * a.x; o[2].y += w * a.y; o[2].z += w * b.x; o[2].w += w * b.y; o[3].x += w * c.x; o[3].y += w * c.y; o[3].z += w * d.x; o[3].w += w * d.y; }
}
__device__ __forceinline__ float swap32_add(float a, float b) { auto r = __builtin_amdgcn_permlane32_swap(__float_as_uint(a), __float_as_uint(b), false, false); return __uint_as_float(r[0]) + __uint_as_float(r[1]); }
__device__ __forceinline__ float swap16_add(float a, float b) { auto r = __builtin_amdgcn_permlane16_swap(__float_as_uint(a), __float_as_uint(b), false, false); return __uint_as_float(r[0]) + __uint_as_float(r[1]); }
__device__ __forceinline__ float row_sum16(float v) { v += dpp_f<0xB1>(v); v += dpp_f<0x4E>(v); v += dpp_f<0x141>(v); v += dpp_f<0x140>(v); return v; }
__device__ __forceinline__ float row_max16(float v) { v = fmaxf(v, dpp_f<0xB1>(v)); v = fmaxf(v, dpp_f<0x4E>(v)); v = fmaxf(v, dpp_f<0x141>(v)); v = fmaxf(v, dpp_f<0x140>(v)); return v; }
constexpr int GB = 32;
typedef __attribute__((address_space(8))) void* rsrc_t;
__device__ __forceinline__ void g_issue(u32x2 (&buf)[GB], __amdgpu_buffer_rsrc_t rs, int idxr, int lb, int voff) {
#pragma unroll
    for (int j = 0; j < GB; ++j) { const int e = __builtin_amdgcn_readlane(idxr, lb + j); buf[j] = __builtin_amdgcn_raw_buffer_load_b64(rs, voff, e * 512, 0); }
}
__device__ __forceinline__ float dot16_fp4p(const u32x2 r, const f32x2 (&xp)[8]) {
    f32x2 a = FP4X2(r.x, 0) * xp[0];
    a += FP4X2(r.x, 1) * xp[1]; a += FP4X2(r.x, 2) * xp[2]; a += FP4X2(r.x, 3) * xp[3];
    a += FP4X2(r.y, 0) * xp[4]; a += FP4X2(r.y, 1) * xp[5]; a += FP4X2(r.y, 2) * xp[6]; a += FP4X2(r.y, 3) * xp[7];
    return a.x + a.y;
}
__device__ __forceinline__ void axpy16_fp4p(const u32x2 r, float w, f32x2 (&o)[8]) {
    const f32x2 ww = (f32x2){w, w};
    o[0] += FP4X2(r.x, 0) * ww; o[1] += FP4X2(r.x, 1) * ww; o[2] += FP4X2(r.x, 2) * ww; o[3] += FP4X2(r.x, 3) * ww;
    o[4] += FP4X2(r.y, 0) * ww; o[5] += FP4X2(r.y, 1) * ww; o[6] += FP4X2(r.y, 2) * ww; o[7] += FP4X2(r.y, 3) * ww;
}
template <int H> __device__ __forceinline__ void g_compute_u(const u32x2 (&buf)[GB], int q, int i16, const f32x2 (&xp)[8], float& zlo, float& zhi) {
    float p[16];
#pragma unroll
    for (int j = 0; j < 16; ++j) p[j] = dot16_fp4p(buf[16 * H + j], xp);
    float s1[8], s2[4];
#pragma unroll
    for (int m = 0; m < 8; ++m) s1[m] = swap32_add(p[2 * m], p[2 * m + 1]);
#pragma unroll
    for (int n = 0; n < 4; ++n) s2[n] = swap16_add(s1[2 * n], s1[2 * n + 1]);
#pragma unroll
    for (int r = 0; r < 4; ++r) { const float z = row_sum16(s2[r]); const bool mine = i16 == ((4 * q + r) & 15);
        zlo = (mine && q < 4) ? z : zlo; zhi = (mine && q >= 4) ? z : zhi; }
}
template <int H> __device__ __forceinline__ void g_compute_v(const u32x2 (&buf)[GB], int q, float alo, float ahi, f32x2 (&o)[8]) {
    const int areg = __builtin_bit_cast(int, (q < 4) ? alo : ahi), sb = 4 * (q & 3);
#pragma unroll
    for (int j = 0; j < 16; ++j) { const int src = 32 * (j & 1) + 16 * ((j >> 1) & 1) + (j >> 2) + sb;
        const float w = __builtin_bit_cast(float, __builtin_amdgcn_readlane(areg, src));
        axpy16_fp4p(buf[16 * H + j], w, o); }
}
__device__ __forceinline__ void q_issue(u32x2 (&buf)[16], __amdgpu_buffer_rsrc_t rs, int ixr  , int lb, int voff) {
#pragma unroll
    for (int j = 0; j < 16; ++j) { const int e9 = __builtin_amdgcn_readlane(ixr, lb + j); buf[j] = __builtin_amdgcn_raw_buffer_load_b64(rs, voff, e9, 0); }
}
__device__ __forceinline__ void q_compute_u(const u32x2 (&buf)[16], int q, int i16, const f32x2 (&xp)[8], float& zlo, float& zhi) {
    float p[16];
#pragma unroll
    for (int j = 0; j < 16; ++j) p[j] = dot16_fp4p(buf[j], xp);
    float s1[8], s2[4];
#pragma unroll
    for (int m = 0; m < 8; ++m) s1[m] = swap32_add(p[2 * m], p[2 * m + 1]);
#pragma unroll
    for (int n = 0; n < 4; ++n) s2[n] = swap16_add(s1[2 * n], s1[2 * n + 1]);
#pragma unroll
    for (int r = 0; r < 4; ++r) { const float z = row_sum16(s2[r]); const bool mine = i16 == ((4 * q + r) & 15);
        zlo = (mine && q < 4) ? z : zlo; zhi = (mine && q >= 4) ? z : zhi; }
}
typedef _Float16 h16x2 __attribute__((ext_vector_type(2)));
#define FP4H2(w, sel) __builtin_amdgcn_cvt_scalef32_pk_f16_fp4((w), 1.0f, (sel))
__device__ __forceinline__ void axpy16_fp4h(const u32x2 r, const h16x2 ww, h16x2 (&o)[8]) {
    o[0] += FP4H2(r.x, 0) * ww; o[1] += FP4H2(r.x, 1) * ww; o[2] += FP4H2(r.x, 2) * ww; o[3] += FP4H2(r.x, 3) * ww;
    o[4] += FP4H2(r.y, 0) * ww; o[5] += FP4H2(r.y, 1) * ww; o[6] += FP4H2(r.y, 2) * ww; o[7] += FP4H2(r.y, 3) * ww;
}
__device__ __forceinline__ void q_compute_vh(const u32x2 (&buf)[16], int q, int alo, int ahi, h16x2 (&o)[8]) {
    const int areg = (q < 4) ? alo : ahi, sb = 4 * (q & 3);
#pragma unroll
    for (int j = 0; j < 16; ++j) { const int src = 32 * (j & 1) + 16 * ((j >> 1) & 1) + (j >> 2) + sb;
        const h16x2 w = __builtin_bit_cast(h16x2, __builtin_amdgcn_readlane(areg, src));
        axpy16_fp4h(buf[j], w, o); }
}
__device__ __forceinline__ void q_compute_v(const u32x2 (&buf)[16], int q, float alo, float ahi, f32x2 (&o)[8]) {
    const int areg = __builtin_bit_cast(int, (q < 4) ? alo : ahi), sb = 4 * (q & 3);
#pragma unroll
    for (int j = 0; j < 16; ++j) { const int src = 32 * (j & 1) + 16 * ((j >> 1) & 1) + (j >> 2) + sb;
        const float w = __builtin_bit_cast(float, __builtin_amdgcn_readlane(areg, src));
        axpy16_fp4p(buf[j], w, o); }
}
__device__ __forceinline__ int swap32_addi(int a, int b) { auto r = __builtin_amdgcn_permlane32_swap((unsigned)a, (unsigned)b, false, false); const unsigned r0 = r[0], r1 = r[1]; return (int)(r0 + r1); }
__device__ __forceinline__ int swap16_addi(int a, int b) { auto r = __builtin_amdgcn_permlane16_swap((unsigned)a, (unsigned)b, false, false); const unsigned r0 = r[0], r1 = r[1]; return (int)(r0 + r1); }
template <int CTRL> __device__ __forceinline__ int dpp_i(int v) { return __builtin_amdgcn_update_dpp(0, v, CTRL, 0xf, 0xf, true); }
__device__ __forceinline__ int row_sum16i(int v) { v += dpp_i<0xB1>(v); v += dpp_i<0x4E>(v); v += dpp_i<0x141>(v); v += dpp_i<0x140>(v); return v; }
__device__ __forceinline__ void q_compute_ui(const u32x2 (&buf)[16], int q, int i16, int xh0, int xh1, int xl0, int xl1, int& zlo, int& zhi) {
    int p[16];
#pragma unroll
    for (int j = 0; j < 16; ++j) { const int d1 = __builtin_amdgcn_sdot8((int)buf[j].x, xh0, __builtin_amdgcn_sdot8((int)buf[j].y, xh1, 0, false), false);
        const int d2 = __builtin_amdgcn_sdot8((int)buf[j].x, xl0, __builtin_amdgcn_sdot8((int)buf[j].y, xl1, 0, false), false);
        p[j] = (d1 << 4) + d2; }
    int s1[8], s2[4];
#pragma unroll
    for (int m = 0; m < 8; ++m) s1[m] = swap32_addi(p[2 * m], p[2 * m + 1]);
#pragma unroll
    for (int n = 0; n < 4; ++n) s2[n] = swap16_addi(s1[2 * n], s1[2 * n + 1]);
#pragma unroll
    for (int r = 0; r < 4; ++r) { const int z = row_sum16i(s2[r]); const bool mine = i16 == ((4 * q + r) & 15);
        zlo = (mine && q < 4) ? z : zlo; zhi = (mine && q >= 4) ? z : zhi; }
}
__device__ __forceinline__ void phase_gather_u(const Params& P) {
    const int tid = threadIdx.x, lane = tid & 63, wave = __builtin_amdgcn_readfirstlane(tid >> 6);
    const int gw = blockIdx.x * NWAVES + wave, NGW = gridDim.x * NWAVES;
    unsigned char* ws = P.ws;
    const int* IDX = (const int*)(ws + WS_IDX); const float* GATE = (const float*)(ws + WS_GATE); const float* ESC = (const float*)(ws + WS_ESCALE); float* AW = (float*)(ws + WS_AW);
    const __amdgpu_buffer_rsrc_t rsU = __builtin_amdgcn_make_buffer_rsrc((void*)(ws + WS_U8), 0, 16384 * 512, 0x00020000);
    const unsigned char* H2I = ws + WS_H0I8; const float* RF = (const float*)(ws + WS_RF);
    const int hh = lane >> 5, rr = (lane >> 4) & 1, i16 = lane & 15, gsel = 4 * i16 + 2 * rr + hh;
    const int voff = 8 * lane;
    const unsigned ul = (unsigned)lane;
    int t = gw;
    if (t < NTOK) {
        int idx0, idx1; unsigned hraw[4]; float sqv;
        { const int* ip = IDX + (size_t)t * NSEL; idx0 = ip[ul]; idx1 = ip[64u + ul];
          const unsigned* hp = (const unsigned*)(H2I + (size_t)t * DM);
#pragma unroll
          for (int j = 0; j < 4; ++j) hraw[j] = hp[64u * j + ul];
          sqv = RF[t]; }
        u32x2 R0[16], R1[16], R2[16], R3[16];
        { const int ix0 = idx0 << 9; q_issue(R0, rsU, ix0, 0, voff); q_issue(R1, rsU, ix0, 16, voff); q_issue(R2, rsU, ix0, 32, voff); }
        for (;;) {
            const int tn = t + NGW; const bool has_next = tn < NTOK; const int tl = has_next ? tn : t;
            int idx0n, idx1n; unsigned hrawn[4]; float sqn, g0, g1;
            { const int* ip = IDX + (size_t)tl * NSEL; idx0n = ip[ul]; idx1n = ip[64u + ul];
              const unsigned* hp = (const unsigned*)(H2I + (size_t)tl * DM);
#pragma unroll
              for (int j = 0; j < 4; ++j) hrawn[j] = hp[64u * j + ul];
              sqn = RF[tl];
              const float* gp = GATE + (size_t)t * NSEL; g0 = gp[ul]; g1 = gp[64u + ul]; }
            const float su0 = ESC[idx0], su1 = ESC[idx1], sv0 = ESC[16384 + idx0], sv1 = ESC[16384 + idx1];
            const float cq0 = ((const float*)(ws + WS_SUMQ))[idx0], cq1 = ((const float*)(ws + WS_SUMQ))[idx1];
            unsigned xh[2] = {0u, 0u}, xl[2] = {0u, 0u};
#pragma unroll
            for (int j = 0; j < 4; ++j) {
                const unsigned lo4 = hraw[j] & 0x0f0f0f0fu, hi4 = (hraw[j] >> 4) & 0x0f0f0f0fu;
                const unsigned tl4 = (lo4 | (lo4 >> 4)) & 0x00ff00ffu, th4 = (hi4 | (hi4 >> 4)) & 0x00ff00ffu;
                const unsigned pl = ((tl4 | (tl4 >> 8)) & 0xffffu) ^ 0x8888u, ph = (th4 | (th4 >> 8)) & 0xffffu;
                xl[j >> 1] |= pl << (16 * (j & 1)); xh[j >> 1] |= ph << (16 * (j & 1)); }
            int zlo = 0, zhi = 0;
            const int ix0 = idx0 << 9, ix1 = idx1 << 9;
#pragma unroll 1
            for (int qq = 0; qq < 8; qq += 4) {
                const int ixn = qq ? (idx0n << 9) : ix1;
                q_issue(R3, rsU, qq ? ix1 : ix0, 48, voff);
                q_compute_ui(R0, qq, i16, (int)xh[0], (int)xh[1], (int)xl[0], (int)xl[1], zlo, zhi);
                q_issue(R0, rsU, ixn, 0, voff);
                q_compute_ui(R1, qq + 1, i16, (int)xh[0], (int)xh[1], (int)xl[0], (int)xl[1], zlo, zhi);
                q_issue(R1, rsU, ixn, 16, voff);
                q_compute_ui(R2, qq + 2, i16, (int)xh[0], (int)xh[1], (int)xl[0], (int)xl[1], zlo, zhi);
                q_issue(R2, rsU, ixn, 32, voff);
                q_compute_ui(R3, qq + 3, i16, (int)xh[0], (int)xh[1], (int)xl[0], (int)xl[1], zlo, zhi);
            }
            const float glo = __shfl(g0, gsel), ghi = __shfl(g1, gsel), sulo = __shfl(su0, gsel), suhi = __shfl(su1, gsel), svlo = __shfl(sv0, gsel), svhi = __shfl(sv1, gsel);
            const float cqlo = __shfl(cq0, gsel), cqhi = __shfl(cq1, gsel);
            const float zfl = ((float)zlo + 8.f * cqlo) * (sulo * sqv), zfh = ((float)zhi + 8.f * cqhi) * (suhi * sqv);
            const float wl = gelu_tanh_f(zfl) * glo * svlo, wh = gelu_tanh_f(zfh) * ghi * svhi;
            const float wmx = fmaxf(wave_max_fast(fmaxf(fabsf(wl), fabsf(wh))), 1e-30f), wsc = 256.f * __builtin_amdgcn_rcpf(wmx);
            { const float a = wl * wsc, c = wh * wsc;
              const int ah = __builtin_amdgcn_cvt_pk_fp8_f32(a, a, 0, false) & 255, ch = __builtin_amdgcn_cvt_pk_fp8_f32(c, c, 0, false) & 255;
              const float ar = a - __builtin_amdgcn_cvt_f32_fp8(ah, 0), cr = c - __builtin_amdgcn_cvt_f32_fp8(ch, 0);
              const int al = __builtin_amdgcn_cvt_pk_fp8_f32(ar, ar, 0, false) & 255, cl = __builtin_amdgcn_cvt_pk_fp8_f32(cr, cr, 0, false) & 255;
              unsigned char* ap = (unsigned char*)AW + (size_t)t * 256;
              ap[gsel] = (unsigned char)ah; ap[64 + gsel] = (unsigned char)ch; ap[128 + gsel] = (unsigned char)al; ap[192 + gsel] = (unsigned char)cl;
              if (lane == 0) ((float*)(ws + WS_WMX))[t] = wmx * (1.f / 256.f); }
            if (!has_next) break;
            t = tn; idx0 = idx0n; idx1 = idx1n; sqv = sqn;
#pragma unroll
            for (int j = 0; j < 4; ++j) hraw[j] = hrawn[j];
        }
    }
}
__device__ __forceinline__ void phase_gather_v(const Params& P) {
    const int tid = threadIdx.x, lane = tid & 63, wave = __builtin_amdgcn_readfirstlane(tid >> 6);
    const int gw = blockIdx.x * NWAVES + wave, NGW = gridDim.x * NWAVES;
    unsigned char* ws = P.ws;
    const int* IDX = (const int*)(ws + WS_IDX); const float* AW = (const float*)(ws + WS_AW);
    const __amdgpu_buffer_rsrc_t rsV = __builtin_amdgcn_make_buffer_rsrc((void*)(ws + WS_V8), 0, 16384 * 512, 0x00020000);
    const bf16* H2B = (const bf16*)(ws + WS_H2B);
    const int voff = 8 * lane;
    const unsigned ul = (unsigned)lane;
    int t = gw;
    if (t < NTOK) {
        int idx0, idx1; u32x2 hraw[4]; float alo, ahi;
        { const int* ip = IDX + (size_t)t * NSEL; idx0 = ip[ul]; idx1 = ip[64u + ul];
          const u32x2* hp = (const u32x2*)(H2B + (size_t)t * DM);
#pragma unroll
          for (int j = 0; j < 4; ++j) hraw[j] = hp[64u * j + ul];
          const float* ap = AW + (size_t)t * NSEL; alo = ap[ul]; ahi = ap[64u + ul]; }
        u32x2 R0[16], R1[16], R2[16], R3[16];
        { const int ix0 = idx0 << 9; q_issue(R0, rsV, ix0, 0, voff); q_issue(R1, rsV, ix0, 16, voff); q_issue(R2, rsV, ix0, 32, voff); }
        for (;;) {
            const int tn = t + NGW; const bool has_next = tn < NTOK; const int tl = has_next ? tn : t;
            int idx0n, idx1n; u32x2 hrawn[4]; float alon, ahin;
            { const int* ip = IDX + (size_t)tl * NSEL; idx0n = ip[ul]; idx1n = ip[64u + ul];
              const u32x2* hp = (const u32x2*)(H2B + (size_t)tl * DM);
#pragma unroll
              for (int j = 0; j < 4; ++j) hrawn[j] = hp[64u * j + ul];
              const float* ap = AW + (size_t)tl * NSEL; alon = ap[ul]; ahin = ap[64u + ul]; }
            const float wmx = fmaxf(wave_max_fast(fmaxf(fabsf(alo), fabsf(ahi))), 1e-30f), winv = 1.f / wmx;
            int alh, ahh;
            { const h16x2 a = (h16x2){(_Float16)(alo * winv), (_Float16)(alo * winv)}, b = (h16x2){(_Float16)(ahi * winv), (_Float16)(ahi * winv)};
              alh = __builtin_bit_cast(int, a); ahh = __builtin_bit_cast(int, b); }
            h16x2 oh[8];
#pragma unroll
            for (int j = 0; j < 8; ++j) oh[j] = (h16x2){(_Float16)0.f, (_Float16)0.f};
            const int ix0 = idx0 << 9, ix1 = idx1 << 9;
#pragma unroll 1
            for (int qq = 0; qq < 8; qq += 4) {
                const int ixn = qq ? (idx0n << 9) : ix1;
                q_issue(R3, rsV, qq ? ix1 : ix0, 48, voff);
                q_compute_vh(R0, qq, alh, ahh, oh);
                q_issue(R0, rsV, ixn, 0, voff);
                q_compute_vh(R1, qq + 1, alh, ahh, oh);
                q_issue(R1, rsV, ixn, 16, voff);
                q_compute_vh(R2, qq + 2, alh, ahh, oh);
                q_issue(R2, rsV, ixn, 32, voff);
                q_compute_vh(R3, qq + 3, alh, ahh, oh);
            }
            f32x2 o[8];
#pragma unroll
            for (int j = 0; j < 8; ++j) o[j] = (f32x2){(float)oh[j].x * wmx, (float)oh[j].y * wmx};
            float ss = 0.f;
#pragma unroll
            for (int j = 0; j < 4; ++j) { o[2 * j] += (f32x2){bflo(hraw[j].x), bfhi(hraw[j].x)}; o[2 * j + 1] += (f32x2){bflo(hraw[j].y), bfhi(hraw[j].y)}; }
#pragma unroll
            for (int j = 0; j < 8; ++j) ss += o[j].x * o[j].x + o[j].y * o[j].y;
            ss = wave_sum_fast(ss);
            const float r3 = rsqrtf(ss * (1.f / DM) + EPS);
            f32x4* op = (f32x4*)(P.out + (size_t)t * DM);
            const f32x4* gfp = (const f32x4*)P.g_fin;
#pragma unroll
            for (int j = 0; j < 4; ++j) { const f32x4 gv = gfp[64u * j + ul]; op[64u * j + ul] = (f32x4){o[2 * j].x * r3 * gv.x, o[2 * j].y * r3 * gv.y, o[2 * j + 1].x * r3 * gv.z, o[2 * j + 1].y * r3 * gv.w}; }
            if (!has_next) break;
            t = tn; idx0 = idx0n; idx1 = idx1n; alo = alon; ahi = ahin;
#pragma unroll
            for (int j = 0; j < 4; ++j) hraw[j] = hrawn[j];
        }
    }
}


typedef int i32x2v __attribute__((ext_vector_type(2)));
typedef int i32x8v __attribute__((ext_vector_type(8)));
#define VM_X 9
#define VM_WAIT(n) asm volatile("s_waitcnt vmcnt(" #n ")" ::: "memory")
__device__ __forceinline__ void phase_gather_v_mfma(const Params& P, LAS unsigned char* lds) {
    const int tid = threadIdx.x, lane = tid & 63, wave = __builtin_amdgcn_readfirstlane(tid >> 6);
    unsigned char* ws = P.ws;
    const int* IDX = (const int*)(ws + WS_IDX);
    const unsigned char* V8 = ws + WS_V8; const unsigned char* AW8 = ws + WS_AW; const float* WMX = (const float*)(ws + WS_WMX);
    const unsigned short* H2S = (const unsigned short*)(ws + WS_H2B);
    const int TPB = NTOK / (int)gridDim.x, t0 = blockIdx.x * TPB, NST = TPB * 4;
    const int r0 = 16 * wave + (lane >> 3), r1 = r0 + 8;
    const unsigned c0 = 16u * (unsigned)((lane & 7) ^ ((r0 >> 1) & 7)), c1 = 16u * (unsigned)((lane & 7) ^ ((r1 >> 1) & 7));
    const int i16 = lane & 15, kb = lane >> 4;
    const int ra = 32 * kb + i16, rb = ra + 16;
    const unsigned offa = (unsigned)(ra * 128 + 16 * (wave ^ ((ra >> 1) & 7))), offb = (unsigned)(rb * 128 + 16 * (wave ^ ((rb >> 1) & 7)));
    const unsigned aoffb = (unsigned)(((i16 & 1) ? 128 : 0) + 16 * kb);
    const bool arow = (i16 & 3) < 2;
    const int colb = 256 * kb + 32 * wave + i16;
    LAS float* SS = (LAS float*)(lds + 131072 + 1024);
    LAS float* OUTB = (LAS float*)(lds + 131072 + 2048);
    const f32x4 gfv = *(const f32x4*)(P.g_fin + 256 * (wave & 3) + 4 * lane);
    const unsigned lbase = (unsigned)(unsigned long long)lds;
    struct VTok { u32x4 a, b; float w; unsigned h0, h1; };
    VTok C0, C1;
    int ia1, ib1, ia2, ib2, ia3, ib3;
#define VM_ISSUE(g, e0, e1) do { LAS unsigned char* _d = lds + (((g) & 7) * 16384) + wave * 2048; const unsigned _cb = 128u * (unsigned)((g) & 3); \
        __builtin_amdgcn_global_load_lds((const unsigned*)(V8 + (size_t)(e0) * 512 + _cb + c0), (LAS unsigned*)(_d), 16, 0, 0); \
        __builtin_amdgcn_global_load_lds((const unsigned*)(V8 + (size_t)(e1) * 512 + _cb + c1), (LAS unsigned*)(_d + 1024), 16, 0, 0); } while (0)
    {
        const int ia0 = IDX[(size_t)t0 * NSEL + r0], ib0 = IDX[(size_t)t0 * NSEL + r1];
        ia1 = IDX[(size_t)(t0 + 1) * NSEL + r0]; ib1 = IDX[(size_t)(t0 + 1) * NSEL + r1];
        ia2 = IDX[(size_t)(t0 + 2) * NSEL + r0]; ib2 = IDX[(size_t)(t0 + 2) * NSEL + r1];
        ia3 = IDX[(size_t)(t0 + 3) * NSEL + r0]; ib3 = IDX[(size_t)(t0 + 3) * NSEL + r1];
        const unsigned char* ap = AW8 + (size_t)t0 * 256 + aoffb;
        C0.a = *(const u32x4*)ap; C0.b = *(const u32x4*)(ap + 64); C0.w = WMX[t0]; C0.h0 = H2S[(size_t)t0 * DM + colb]; C0.h1 = H2S[(size_t)t0 * DM + colb + 16];
        C1.a = *(const u32x4*)(ap + 256); C1.b = *(const u32x4*)(ap + 256 + 64); C1.w = WMX[t0 + 1]; C1.h0 = H2S[(size_t)(t0 + 1) * DM + colb]; C1.h1 = H2S[(size_t)(t0 + 1) * DM + colb + 16];
        asm volatile("s_waitcnt vmcnt(0)" ::: "memory");
        VM_ISSUE(0, ia0, ib0); VM_ISSUE(1, ia0, ib0); VM_ISSUE(2, ia0, ib0); VM_ISSUE(3, ia0, ib0);
        VM_ISSUE(4, ia1, ib1); VM_ISSUE(5, ia1, ib1); VM_ISSUE(6, ia1, ib1);
    }
    float pv0 = 0.f, pv1 = 0.f;
    VTok N0, N1; int na4, nb4, na5, nb5;
    auto token = [&](const int i, const bool even, const VTok& C, const int e1a, const int e1b, const int e2a, const int e2b) __attribute__((always_inline)) {
        const int t = t0 + i;
        const u32x4 z = (u32x4){0u, 0u, 0u, 0u}; const u32x4 Alo = arow ? C.a : z, Ahi = arow ? C.b : z;
        const i32x8v A = (i32x8v){(int)Alo.x, (int)Alo.y, (int)Alo.z, (int)Alo.w, (int)Ahi.x, (int)Ahi.y, (int)Ahi.z, (int)Ahi.w};
        f32x4 acc[4][2];
#pragma unroll
        for (int cc = 0; cc < 4; ++cc) {
            const int g = 4 * i + cc;
            if (even && cc == 0) { VM_WAIT(12); } else { VM_WAIT(26); }
            asm volatile("s_waitcnt lgkmcnt(0)" ::: "memory");
            __builtin_amdgcn_s_barrier();
            __builtin_amdgcn_sched_barrier(0);
            const unsigned sa = lbase + (unsigned)((g & 7) * 16384) + offa, sbb = lbase + (unsigned)((g & 7) * 16384) + offb;
            i32x2v b00, b01, b10, b11;
            asm volatile("ds_read_b64_tr_b4 %0, %4\n\tds_read_b64_tr_b4 %1, %5\n\tds_read_b64_tr_b4 %2, %4 offset:8\n\tds_read_b64_tr_b4 %3, %5 offset:8"
                         : "=&v"(b00), "=&v"(b01), "=&v"(b10), "=&v"(b11) : "v"(sa), "v"(sbb) : "memory");
            { const int gn = g + 7;
              if (cc == 0) VM_ISSUE(gn, e1a, e1b); else VM_ISSUE(gn, e2a, e2b); }
            __builtin_amdgcn_sched_barrier(0);
            if (cc == 0) {
                if (even) {
                    const int tA = t0 + ((i + 2 < TPB) ? i + 2 : TPB - 2), tI = t0 + ((i + 4 < TPB) ? i + 4 : TPB - 2);
                    const unsigned char* ap = AW8 + (size_t)tA * 256 + aoffb; const float* wp = WMX + tA; const int* ipa = IDX + (size_t)tI * NSEL + r0; const unsigned short* hp = H2S + (size_t)tA * DM + colb;
                    asm volatile("global_load_dwordx4 %0, %14, off\n\tglobal_load_dwordx4 %1, %14, off offset:64\n\tglobal_load_dwordx4 %2, %14, off offset:256\n\tglobal_load_dwordx4 %3, %14, off offset:320\n\t"
                                 "global_load_dword %4, %15, off\n\tglobal_load_dword %5, %15, off offset:4\n\t"
                                 "global_load_ushort %6, %17, off\n\tglobal_load_ushort %7, %17, off offset:32\n\tglobal_load_ushort %8, %17, off offset:2048\n\tglobal_load_ushort %9, %17, off offset:2080\n\t"
                                 "global_load_dword %10, %16, off\n\tglobal_load_dword %11, %16, off offset:32\n\tglobal_load_dword %12, %16, off offset:512\n\tglobal_load_dword %13, %16, off offset:544"
                                 : "=&v"(N0.a), "=&v"(N0.b), "=&v"(N1.a), "=&v"(N1.b), "=&v"(N0.w), "=&v"(N1.w), "=&v"(N0.h0), "=&v"(N0.h1), "=&v"(N1.h0), "=&v"(N1.h1), "=&v"(na4), "=&v"(nb4), "=&v"(na5), "=&v"(nb5)
                                 : "v"(ap), "v"(wp), "v"(ipa), "v"(hp) : "memory");
                }
                { const f32x4 s0 = *(const LAS f32x4*)(SS + 8 * ((i + 1) & 1)), s1 = *(const LAS f32x4*)(SS + 8 * ((i + 1) & 1) + 4);
                  const float ss = ((s0.x + s0.y) + (s0.z + s0.w)) + ((s1.x + s1.y) + (s1.z + s1.w));
                  const float r3 = __builtin_amdgcn_rsqf(ss * (1.f / DM) + EPS);
                  if (i > 0 && (wave >> 2) == ((i + 1) & 1)) {
                      const f32x4 v = *(const LAS f32x4*)(OUTB + 1024 * ((i + 1) & 1) + 256 * (wave & 3) + 4 * lane);
                      *(f32x4*)(P.out + (size_t)(t - 1) * DM + 256 * (wave & 3) + 4 * lane) = (f32x4){v.x * r3 * gfv.x, v.y * r3 * gfv.y, v.z * r3 * gfv.z, v.w * r3 * gfv.w}; } }
                __builtin_amdgcn_sched_barrier(0);
            }
            asm volatile("s_waitcnt lgkmcnt(0)" : "+v"(b00), "+v"(b01), "+v"(b10), "+v"(b11) :: "memory");
            const i32x8v B0 = (i32x8v){b00.x, b00.y, b01.x, b01.y, 0, 0, 0, 0}, B1 = (i32x8v){b10.x, b10.y, b11.x, b11.y, 0, 0, 0, 0};
            const f32x4 z4 = (f32x4){0.f, 0.f, 0.f, 0.f};
            acc[cc][0] = __builtin_amdgcn_mfma_scale_f32_16x16x128_f8f6f4(A, B0, z4, 0  , 4  , 0, 0x7f7f7f7f, 0, 0x7f7f7f7f);
            acc[cc][1] = __builtin_amdgcn_mfma_scale_f32_16x16x128_f8f6f4(A, B1, z4, 0, 4, 0, 0x7f7f7f7f, 0, 0x7f7f7f7f);
        }
#pragma unroll
        for (int c = 0; c < 4; ++c) asm volatile("" :: "v"(acc[c][0]), "v"(acc[c][1]));
        float s0 = acc[0][0].x + acc[0][0].y, s1 = acc[0][1].x + acc[0][1].y;
        { const float a0 = acc[1][0].x + acc[1][0].y, a1 = acc[1][1].x + acc[1][1].y, b0 = acc[2][0].x + acc[2][0].y, b1 = acc[2][1].x + acc[2][1].y, d0 = acc[3][0].x + acc[3][0].y, d1 = acc[3][1].x + acc[3][1].y;
          s0 = (kb == 1) ? a0 : s0; s1 = (kb == 1) ? a1 : s1; s0 = (kb == 2) ? b0 : s0; s1 = (kb == 2) ? b1 : s1; s0 = (kb == 3) ? d0 : s0; s1 = (kb == 3) ? d1 : s1; }
        pv0 = s0 * C.w + __uint_as_float(C.h0 << 16); pv1 = s1 * C.w + __uint_as_float(C.h1 << 16);
        OUTB[1024 * (i & 1) + colb] = pv0; OUTB[1024 * (i & 1) + colb + 16] = pv1;
        const float sq = wave_sum_fast(pv0 * pv0 + pv1 * pv1);
        if (lane == 0) SS[8 * (i & 1) + wave] = sq;
    };
#pragma unroll 1
    for (int i = 0; i < TPB; i += 2) {
        token(i, true, C0, ia1, ib1, ia2, ib2);
        token(i + 1, false, C1, ia2, ib2, ia3, ib3);
        asm volatile("s_waitcnt vmcnt(14)" : "+v"(N0.a), "+v"(N0.b), "+v"(N1.a), "+v"(N1.b), "+v"(N0.w), "+v"(N1.w), "+v"(N0.h0), "+v"(N0.h1), "+v"(N1.h0), "+v"(N1.h1), "+v"(na4), "+v"(nb4), "+v"(na5), "+v"(nb5) :: "memory");
        C0 = N0; C1 = N1; ia1 = ia3; ib1 = ib3; ia2 = na4; ib2 = nb4; ia3 = na5; ib3 = nb5;
    }
    asm volatile("s_waitcnt vmcnt(0)" ::: "memory");
    __builtin_amdgcn_s_barrier();
    { const int i = TPB; const f32x4 s0 = *(const LAS f32x4*)(SS + 8 * ((i + 1) & 1)), s1 = *(const LAS f32x4*)(SS + 8 * ((i + 1) & 1) + 4);
      const float ss = ((s0.x + s0.y) + (s0.z + s0.w)) + ((s1.x + s1.y) + (s1.z + s1.w));
      const float r3 = rsqrtf(ss * (1.f / DM) + EPS);
      if ((wave >> 2) == ((i + 1) & 1)) {
          const f32x4 v = *(const LAS f32x4*)(OUTB + 1024 * ((i + 1) & 1) + 256 * (wave & 3) + 4 * lane);
          *(f32x4*)(P.out + (size_t)(t0 + TPB - 1) * DM + 256 * (wave & 3) + 4 * lane) = (f32x4){v.x * r3 * gfv.x, v.y * r3 * gfv.y, v.z * r3 * gfv.z, v.w * r3 * gfv.w}; } }
#undef VM_ISSUE
}

__device__ __forceinline__ void phase_quant_h2(const Params& P) {
    const int tid = threadIdx.x, lane = tid & 63, wave = __builtin_amdgcn_readfirstlane(tid >> 6);
    const int gw = blockIdx.x * NWAVES + wave, NGW = gridDim.x * NWAVES;
    unsigned char* ws = P.ws;
    const float* SSQ = (const float*)(ws + WS_SSQ); const float* AMX = (const float*)(ws + WS_AMX); float* RF = (float*)(ws + WS_RF);
    TabRow tb0, tb1, tb2;
    if (gw < NTOK) tab_load(P, gw, lane, tb0);
    if (gw + NGW < NTOK) tab_load(P, gw + NGW, lane, tb1);
    int it3 = 0;
    for (int row = gw; row < NTOK; row += NGW, it3 = (it3 == 2) ? 0 : it3 + 1) {
        { const int e2 = row + 2 * NGW;
          if (e2 < NTOK) { if (it3 == 0) tab_load(P, e2, lane, tb2); else if (it3 == 1) tab_load(P, e2, lane, tb0); else tab_load(P, e2, lane, tb1); } }
        const u32x4* hp = (const u32x4*)(ws + WS_H2B + (size_t)row * DM * 2) + 2 * lane;
        const u32x4 a = hp[0], b = hp[1];
        const float am = fmaxf(row_max16(AMX[(size_t)row * 16 + (lane & 15)]), 1e-30f) * 1.0078125f;
        const float rstd2 = __builtin_amdgcn_rsqf(row_sum16(SSQ[(size_t)row * 16 + (lane & 15)]) * (1.f / DM) + EPS);
        const float inv = 127.f * __builtin_amdgcn_rcpf(am);
        const unsigned w[8] = {a.x, a.y, a.z, a.w, b.x, b.y, b.z, b.w};
        unsigned o[4];
#pragma unroll
        for (int j = 0; j < 4; ++j) {
            const int q0 = (int)rintf(__uint_as_float(w[2 * j] << 16) * inv), q1 = (int)rintf(__uint_as_float(w[2 * j] & 0xffff0000u) * inv);
            const int q2 = (int)rintf(__uint_as_float(w[2 * j + 1] << 16) * inv), q3 = (int)rintf(__uint_as_float(w[2 * j + 1] & 0xffff0000u) * inv);
            o[j] = ((unsigned)q0 & 255u) | (((unsigned)q1 & 255u) << 8) | (((unsigned)q2 & 255u) << 16) | ((unsigned)q3 << 24); }
        u32x4 ov; ov.x = o[0]; ov.y = o[1]; ov.z = o[2]; ov.w = o[3];
        *((u32x4*)(ws + WS_H0I8 + (size_t)row * DM) + lane) = ov;
        if (lane == 0) RF[row] = am * (1.f / 127.f) * rstd2;
        if (it3 == 0) tab_finish(P, row, lane, tb0); else if (it3 == 1) tab_finish(P, row, lane, tb1); else tab_finish(P, row, lane, tb2);
    }
}
struct EpiQI8 {
    static constexpr bool PERM = true, AFTER_DRAIN = false;
    bf16* O; int ldc; const float* rf; const float* sw;
    __device__ __forceinline__ void operator()(const pg8::i32x4 (&acc)[2][2][4][2], const pg8::Unit& u, int wr, int wc, int fr, int fq) const {
        const int row0 = u.pm * 256 + wr * 64 + fr, col0 = u.pn * 256 + wc * 32 + 8 * fq;
        f32x4 swv[2][2];
#pragma unroll
        for (int bj = 0; bj < 2; ++bj) { swv[bj][0] = *(const f32x4*)(sw + col0 + bj * 128); swv[bj][1] = *(const f32x4*)(sw + col0 + bj * 128 + 4); }
#pragma unroll
        for (int ai = 0; ai < 2; ++ai)
#pragma unroll
            for (int m = 0; m < 4; ++m) {
                const int row = row0 + ai * 128 + m * 16;
                const float s = rf[row];
                bf16* rowp = O + (size_t)row * ldc + col0;
#pragma unroll
                for (int bj = 0; bj < 2; ++bj) { const pg8::i32x4 a0 = acc[ai][bj][m][0], a1 = acc[ai][bj][m][1];
                    const f32x4 v0 = (f32x4){(float)a0[0], (float)a0[1], (float)a0[2], (float)a0[3]} * (swv[bj][0] * s), v1 = (f32x4){(float)a1[0], (float)a1[1], (float)a1[2], (float)a1[3]} * (swv[bj][1] * s);
                    u32x4 w; w.x = cvt_pk_bf16(v0[0], v0[1]); w.y = cvt_pk_bf16(v0[2], v0[3]); w.z = cvt_pk_bf16(v1[0], v1[1]); w.w = cvt_pk_bf16(v1[2], v1[3]);
                    *(u32x4*)(rowp + bj * 128) = w; }
            }
    }
};
#define XB_TMO      128
#define XB_XCNT(j)  (256  + 64 * (j))
#define XB_XSUB(j)  (1280 + 64 * (j))
#define XB_XGEN(j)  (2304 + 64 * (j))
#define XB_TOP      3328
#define XB_TOPGEN   3392
#define XCD_BAR_WORDS 3456
#define XB_SPIN_CAP (1u << 18)

__device__ __forceinline__ unsigned xb_ld(unsigned* p)              { return __hip_atomic_load(p, __ATOMIC_RELAXED, __HIP_MEMORY_SCOPE_AGENT); }
__device__ __forceinline__ unsigned xb_add(unsigned* p, unsigned v) { return __hip_atomic_fetch_add(p, v, __ATOMIC_RELAXED, __HIP_MEMORY_SCOPE_AGENT); }
__device__ __forceinline__ unsigned xb_xcc_id() { return (unsigned)__builtin_amdgcn_s_getreg((3 << 11) | 20) & 0xFu; }
#define XB_SPIN(cond, bar) do { unsigned _sp = 0; while (cond) { __builtin_amdgcn_s_sleep(1); \
    if ((++_sp & 255u) == 0u) { if (xb_ld(&(bar)[XB_TMO])) break; if (_sp > XB_SPIN_CAP) { atomicAdd(&(bar)[XB_TMO], 1u); break; } } } } while (0)

struct XcdBarrier {
    unsigned* bar; unsigned x;
    volatile LAS unsigned* st;
};

__device__ __forceinline__ XcdBarrier xcd_barrier_post(unsigned* bar, volatile LAS unsigned* st) {
    XcdBarrier b; b.bar = bar; b.x = xb_xcc_id(); b.st = st;
    if (threadIdx.x == 0) (void)xb_add(&bar[XB_XCNT(b.x)], 1u);
    return b;
}
__device__ __forceinline__ void xcd_barrier_complete(unsigned* bar, unsigned x, unsigned& nloc, unsigned& nx) {
    const unsigned G = gridDim.x * gridDim.y * gridDim.z;
    unsigned sum, cnt, mine, sp = 0u;
    for (;;) {
        sum = 0u; cnt = 0u; mine = 0u;
#pragma unroll
        for (unsigned j = 0; j < 16; ++j) { const unsigned c = xb_ld(&bar[XB_XCNT(j)]); sum += c; cnt += (c > 0u) ? 1u : 0u; mine = (j == x) ? c : mine; }
        if (sum == G) break;
        __builtin_amdgcn_s_sleep(1);
        if ((++sp & 255u) == 0u) { if (xb_ld(&bar[XB_TMO])) break; if (sp > XB_SPIN_CAP) { atomicAdd(&bar[XB_TMO], 1u); break; } }
    }
    nloc = mine > 0u ? mine : 1u; nx = cnt > 0u ? cnt : 1u;
}

__device__ __forceinline__ void xcd_barrier(const XcdBarrier& b) {
    asm volatile("s_waitcnt vmcnt(0)" ::: "memory");
    __syncthreads();
    if (threadIdx.x == 0) {
        unsigned* bar = b.bar;
        __builtin_amdgcn_s_waitcnt(0);
        unsigned nloc = b.st[0], nx = b.st[1];
        if (nloc == 0u) { xcd_barrier_complete(bar, b.x, nloc, nx); b.st[0] = nloc; b.st[1] = nx; }
        const unsigned old = xb_add(&bar[XB_XSUB(b.x)], 1u);
        const unsigned gen = old / nloc;
        if (old + 1u == (gen + 1u) * nloc) {
            __builtin_amdgcn_fence(__ATOMIC_RELEASE, "agent");
            asm volatile("s_waitcnt vmcnt(0)" ::: "memory");
            const unsigned og = xb_add(&bar[XB_TOP], 1u);
            const unsigned tg = og / nx;
            if (og + 1u == (tg + 1u) * nx) xb_add(&bar[XB_TOPGEN], 1u);
            else XB_SPIN(xb_ld(&bar[XB_TOPGEN]) == tg, bar);
            __builtin_amdgcn_fence(__ATOMIC_ACQUIRE, "agent");
            xb_add(&bar[XB_XGEN(b.x)], 1u);
            asm volatile("s_waitcnt vmcnt(0)" ::: "memory");
        } else {
            XB_SPIN(xb_ld(&bar[XB_XGEN(b.x)]) == gen, bar);
            __builtin_amdgcn_fence(__ATOMIC_ACQUIRE, "agent");
            asm volatile("s_waitcnt vmcnt(0)" ::: "memory");
        }
    }
    __syncthreads();
}


#ifndef MK_MULTI
#define MK_MULTI 0
#endif
constexpr int NPHASE = 10;
#ifndef REP5
#define REP5 1
#endif
#ifndef REP6
#define REP6 1
#endif
__global__ void __launch_bounds__(NTHREADS, 2) mk_fwd(Params P) {
    extern __shared__ __attribute__((aligned(16))) unsigned char lds_raw[];
    LAS unsigned char* lds = (LAS unsigned char*)lds_raw;
    cg::grid_group grid = cg::this_grid();
    unsigned char* ws = P.ws;
    const int lo = P.ph_lo, hi = P.ph_hi;
    volatile LAS unsigned* bst = (volatile LAS unsigned*)(lds + 131072 + 64);
    if (threadIdx.x < 2) bst[threadIdx.x] = 0u;
    __syncthreads();
    XcdBarrier xbar = xcd_barrier_post((unsigned*)(ws + WS_CTL), bst);
#define IN(k) (lo <= (k) && (k) < hi)
#define SEAM(k) do { if (IN(k) && IN((k) + 1)) { xcd_barrier(xbar); } } while (0)
    if (IN(0)) phase_prep(P, lds);
    if (IN(0) && IN(1)) { }
    SEAM(1);
    if (IN(2)) {
        pg8::Gemm g{(const bf16*)(ws + WS_H0I8), (const bf16*)(ws + WS_WIN_T), NTOK, DIN, DM / 2}; pg8::StaticOrder S; S.init(NTOK, DIN, (int)gridDim.x, (int)blockIdx.x);
        EpiProjI8 E{(bf16*)(ws + WS_PROJ), (const float*)(ws + WS_RSTD1), (const float*)(ws + WS_SW)};
        pg8::gemm_phase_i8<EpiProjI8, pg8::StaticOrder, true, true>(lds, g, S, E);
    }
    SEAM(2);
    if (IN(3)) phase_conv(P, lds);
    SEAM(3);
    if (IN(4)) {
        pg8::Gemm g{(const bf16*)(ws + WS_Y), (const bf16*)(ws + WS_WOUT_T), NTOK, DM, DM / 2}; pg8::StaticOrder S; S.init(NTOK, DM, (int)gridDim.x, (int)blockIdx.x);
        EpiResidualI8 E{(bf16*)(ws + WS_H2B), (const signed char*)(ws + WS_H0I8), (const float*)(ws + WS_SX), (const float*)(ws + WS_SY), (const float*)(ws + WS_SWO), (float*)(ws + WS_SSQ), (float*)(ws + WS_AMX)};
        pg8::gemm_phase_i8<EpiResidualI8, pg8::StaticOrder, true, true>(lds, g, S, E);
    }
    SEAM(4);
    if (IN(5)) phase_quant_h2(P);
    SEAM(5);
    if (IN(6)) {
        pg8::Gemm g{(const bf16*)(ws + WS_H0I8), (const bf16*)(ws + WS_WQ_T), NTOK, 2048, DM / 2}; pg8::StaticOrder S; S.init(NTOK, 2048, (int)gridDim.x, (int)blockIdx.x);
        EpiQI8 E{(bf16*)(ws + WS_Q), 2048, (const float*)(ws + WS_RF), (const float*)(ws + WS_SWQ)};
        pg8::gemm_phase_i8<EpiQI8, pg8::StaticOrder, true, true>(lds, g, S, E);
    }
    if (IN(6) && IN(7)) { asm volatile("s_waitcnt vmcnt(0)" ::: "memory"); __syncthreads(); }
    if (IN(7)) phase_route(P, lds);
    SEAM(7);
    if (IN(8)) phase_gather_u(P);
    SEAM(8);
    if (IN(9)) phase_gather_v_mfma(P, lds);
#undef IN
#undef SEAM
}

extern "C" void kernel_launch(void* const* d_in, const int* in_sizes, int n_in, void* d_out, int out_size, void* d_ws, size_t ws_size, hipStream_t stream) {
    static int grid = 0;
    if (grid == 0) {
        if (n_in != 18 || in_sizes[0] != NTOK * DM || out_size != NTOK * DM || ws_size < WS_END) {
            fprintf(stderr, "kernel_launch: unexpected shapes (n_in %d in0 %d out %d ws %zu)\n", n_in, n_in > 0 ? in_sizes[0] : -1, out_size, ws_size); grid = -1; return; }
        int dev = 0, cus = 0, per_cu = 0;
        (void)hipGetDevice(&dev); (void)hipDeviceGetAttribute(&cus, hipDeviceAttributeMultiprocessorCount, dev);
        if (hipFuncSetAttribute((const void*)mk_fwd, hipFuncAttributeMaxDynamicSharedMemorySize, LDS_BYTES) != hipSuccess) { fprintf(stderr, "kernel_launch: hipFuncSetAttribute failed\n"); grid = -1; return; }
        if (hipOccupancyMaxActiveBlocksPerMultiprocessor(&per_cu, (const void*)mk_fwd, NTHREADS, LDS_BYTES) != hipSuccess || per_cu < 1) { fprintf(stderr, "kernel_launch: occupancy query failed (%d)\n", per_cu); (void)hipGetLastError(); per_cu = 1; }
        if (per_cu > 1) per_cu = 1;
        grid = cus * per_cu;
        if (grid <= 0) grid = 256;
    }
    if (grid < 0) return;
    Params p{};
    p.x = (const float*)d_in[0]; p.meta = (const float*)d_in[1]; p.g_mix = (const float*)d_in[2]; p.w_in = (const float*)d_in[3]; p.sc_w = (const float*)d_in[4];
    p.cf_w = (const float*)d_in[5]; p.cf_b = (const float*)d_in[6]; p.ln_g = (const float*)d_in[7]; p.ln_b = (const float*)d_in[8]; p.g_sc = (const float*)d_in[9];
    p.g_cf = (const float*)d_in[10]; p.w_out = (const float*)d_in[11]; p.g_ffn = (const float*)d_in[12]; p.w_q = (const float*)d_in[13]; p.keys = (const float*)d_in[14];
    p.pu = (const float*)d_in[15]; p.pv = (const float*)d_in[16]; p.g_fin = (const float*)d_in[17];
    p.out = (float*)d_out; p.ws = (unsigned char*)d_ws;
    (void)hipMemsetAsync((char*)d_ws + WS_CTL, 0, 65536 + 16 * 2560 * 4, stream);
#if MK_MULTI
    for (int ph = 0; ph < NPHASE; ++ph) { p.ph_lo = ph; p.ph_hi = ph + 1; p.coop = 0; p.pad = 0;
        hipLaunchKernelGGL(mk_fwd, dim3(grid), dim3(NTHREADS), LDS_BYTES, stream, p); }
#else
    p.ph_lo = 0; p.ph_hi = NPHASE; p.coop = 1; p.pad = 0;
    void* args[] = {&p};
    hipError_t e = hipLaunchCooperativeKernel((const void*)mk_fwd, dim3(grid), dim3(NTHREADS), args, LDS_BYTES, stream);
    if (e != hipSuccess) fprintf(stderr, "cooperative launch failed: %s (grid %d)\n", hipGetErrorString(e), grid);
#endif
}
```

```cpp
#include <hip/hip_runtime.h>
#include <hip/hip_cooperative_groups.h>
#include <cstdio>
#include <cstdint>
namespace cg = cooperative_groups;

namespace pg8 {
#define PG8_LAS __attribute__((address_space(3)))
typedef unsigned short bf16_t;
typedef short bf16x8 __attribute__((ext_vector_type(8)));
typedef float f32x4 __attribute__((ext_vector_type(4)));
typedef unsigned u32x4 __attribute__((ext_vector_type(4)));
typedef int i32x4 __attribute__((ext_vector_type(4)));
constexpr int BM = 256, BK = 64, HALF = 128, HTB = HALF * BK * 2  , STAGE_BYTES = 8 * HTB, NXCD = 8, WGM = 8;

__host__ __device__ __forceinline__ int lds_byte(int r, int c) { const int st = (r >> 4) * 2 + (c >> 5), rr = r & 15, cc = c & 31, ob = rr * 64 + cc * 2; return st * 1024 + (ob ^ (((ob >> 9) & 1) << 5)); }
__host__ __device__ __forceinline__ void stage_rc(int b, int& R, int& C) { const int st = b / 1024, sb = b % 1024, swz = sb ^ (((sb >> 9) & 1) << 5); R = (st >> 1) * 16 + swz / 64; C = (st & 1) * 32 + (swz % 64) / 2; }
__host__ __device__ __forceinline__ int perm32(int rho) { const int n = rho >> 4, i = rho & 15; return 8 * (i >> 2) + 4 * n + (i & 3); }

struct Unit { int pm, pn; };
struct Gemm { const bf16_t* A; const bf16_t* Bt; int M, N, K; };

struct StaticOrder {
    int nM, nN, nwg, G, c;
    __host__ __device__ void init(int M, int N, int G_, int c_) { nM = M / BM; nN = N / BM; nwg = nM * nN; G = G_; c = c_; }
    __host__ __device__ bool next(int i, Unit& u) const {
        const long L = (long)i * G + c; if (L >= nwg) return false;
        int wgid = (int)L; { const int q = nwg / NXCD, r = nwg % NXCD, xcd = wgid % NXCD, off = wgid / NXCD; wgid = (xcd < r ? xcd * (q + 1) : r * (q + 1) + (xcd - r) * q) + off; }
        const int nig = WGM * nN, gid = wgid / nig, fm = gid * WGM, gsz = (nM - fm) < WGM ? (nM - fm) : WGM;
        u.pm = fm + ((wgid % nig) % gsz); u.pn = (wgid % nig) / gsz; return true;
    }
    __device__ __forceinline__ void a_ready(const Unit&) const {}
    __device__ __forceinline__ void done(const Unit&) const {}
};

template <class Epi, class Sched, bool ALIGN_EPI = false, bool SP2 = false>
__device__ __forceinline__ void gemm_phase(PG8_LAS unsigned char* lds, const Gemm g, const Sched& S, const Epi& E) {
    const int tid = threadIdx.x, wid = __builtin_amdgcn_readfirstlane(tid >> 6), lane = tid & 63, wr = wid >> 2, wc = wid & 3, fr = lane & 15, fq = lane >> 4;
    const int K = g.K, nt = K / BK;
    unsigned voffA[2], voffB[2];
#pragma unroll
    for (int i = 0; i < 2; ++i) { int R, C; stage_rc(tid * 16 + i * 8192, R, C); const int Rb = Epi::PERM ? ((R & ~31) + perm32(R & 31)) : R;
        voffA[i] = (unsigned)(R * K + C) * 2u; voffB[i] = (unsigned)(Rb * K + C) * 2u; }
    const size_t kstep = (size_t)(BK * 2);
    const size_t hstep = (size_t)HALF * K * 2;
    const size_t tstep = 2 * hstep;
    const unsigned ldsw = (unsigned)wid * 1024u;
    const int aoff = lds_byte(wr * 64 + fr, fq * 8), boff = lds_byte(wc * 32 + fr, fq * 8);
#define PG8_SA(b, h) (((b) * 2 + (h)) * HTB)
#define PG8_SB(b, h) ((4 + (b) * 2 + (h)) * HTB)
#define PG8_STAGE(bufoff, gbase, voff) do { _Pragma("unroll") for (int _i = 0; _i < 2; ++_i) \
        __builtin_amdgcn_global_load_lds((const unsigned*)((const char*)(gbase) + (voff)[_i]), (PG8_LAS unsigned*)(lds + (bufoff) + ldsw + _i * 8192), 16, 0, 0); } while (0)
#define PG8_LDA(dst, b, h) do { _Pragma("unroll") for (int m = 0; m < 4; ++m) _Pragma("unroll") for (int k = 0; k < 2; ++k) dst[m][k] = *(const PG8_LAS bf16x8*)(lds + PG8_SA(b, h) + aoff + m * 2048 + k * 1024); } while (0)
#define PG8_LDB(dst, b, h) do { _Pragma("unroll") for (int n = 0; n < 2; ++n) _Pragma("unroll") for (int k = 0; k < 2; ++k) dst[n][k] = *(const PG8_LAS bf16x8*)(lds + PG8_SB(b, h) + boff + n * 2048 + k * 1024); } while (0)
#define PG8_MMA(ai, bj, At, Bt) do { __builtin_amdgcn_s_setprio(1); _Pragma("unroll") for (int m = 0; m < 4; ++m) _Pragma("unroll") for (int n = 0; n < 2; ++n) _Pragma("unroll") for (int k = 0; k < 2; ++k) \
        acc[ai][bj][m][n] = __builtin_amdgcn_mfma_f32_16x16x32_bf16(Bt[n][k], At[m][k], acc[ai][bj][m][n], 0, 0, 0); __builtin_amdgcn_s_setprio(0); } while (0)
#define PG8_WAIT_V(n) asm volatile("s_waitcnt vmcnt(" #n ")" ::: "memory")
#define PG8_WAIT_L(n) asm volatile("s_waitcnt lgkmcnt(" #n ")" ::: "memory")
#define PG8_BAR __builtin_amdgcn_s_barrier()
#define PG8_SCHED __builtin_amdgcn_sched_barrier(0)
    Unit cur, nxt; int ui = 0;
    if (!S.next(0, cur)) return;
    f32x4 acc[2][2][4][2];
#pragma unroll
    for (int a = 0; a < 2; ++a)
#pragma unroll
        for (int b = 0; b < 2; ++b)
#pragma unroll
            for (int m = 0; m < 4; ++m)
#pragma unroll
                for (int n = 0; n < 2; ++n) acc[a][b][m][n] = (f32x4){0.f, 0.f, 0.f, 0.f};
    bf16x8 At[4][2], B0[2][2], B1[2][2];
    const char* cA = (const char*)g.A + (size_t)cur.pm * tstep; const char* cB = (const char*)g.Bt + (size_t)cur.pn * tstep;
    S.a_ready(cur);
    if constexpr (SP2) {
        PG8_STAGE(PG8_SB(0, 0), cB, voffB); PG8_STAGE(PG8_SB(0, 1), cB + hstep, voffB); PG8_STAGE(PG8_SA(0, 0), cA, voffA); PG8_STAGE(PG8_SA(0, 1), cA + hstep, voffA);
        if (wr == 1) PG8_BAR;
        PG8_WAIT_V(2); PG8_BAR;
        PG8_STAGE(PG8_SB(1, 0), cB + kstep, voffB); PG8_STAGE(PG8_SA(1, 0), cA + kstep, voffA); PG8_STAGE(PG8_SB(1, 1), cB + hstep + kstep, voffB);
        PG8_WAIT_V(6); PG8_BAR;
    } else {
        PG8_STAGE(PG8_SB(0, 0), cB, voffB); PG8_STAGE(PG8_SA(0, 0), cA, voffA); PG8_STAGE(PG8_SB(0, 1), cB + hstep, voffB); PG8_STAGE(PG8_SA(0, 1), cA + hstep, voffA);
        if (wr == 1) PG8_BAR;
        PG8_WAIT_V(4); PG8_BAR;
        PG8_STAGE(PG8_SB(1, 0), cB + kstep, voffB); PG8_STAGE(PG8_SA(1, 0), cA + kstep, voffA); PG8_STAGE(PG8_SB(1, 1), cB + hstep + kstep, voffB);
        PG8_WAIT_V(6); PG8_BAR;
    }
    for (;;) {
        const bool has_next = S.next(ui + 1, nxt);
        const char* nA = has_next ? (const char*)g.A + (size_t)nxt.pm * tstep : cA; const char* nB = has_next ? (const char*)g.Bt + (size_t)nxt.pn * tstep : cB;
        for (int t = 0; t < nt; t += 2) {
            const bool last = (t == nt - 2);
            const char* a1 = cA + (size_t)(t + 1) * kstep;
            const char* a2 = last ? nA : cA + (size_t)(t + 2) * kstep; const char* b2 = last ? nB : cB + (size_t)(t + 2) * kstep;
            const char* a3 = a2 + kstep; const char* b3 = b2 + kstep;
            if (last && has_next) S.a_ready(nxt);
            if constexpr (SP2) {
            PG8_LDB(B0, 0, 0); PG8_LDB(B1, 0, 1); PG8_SCHED; PG8_LDA(At, 0, 0); PG8_STAGE(PG8_SA(1, 1), a1 + hstep, voffA);
            PG8_WAIT_V(8); PG8_WAIT_L(0); PG8_BAR; PG8_MMA(0, 0, At, B0); PG8_MMA(0, 1, At, B1); PG8_BAR; PG8_SCHED;
            PG8_LDA(At, 0, 1); PG8_STAGE(PG8_SB(0, 0), b2, voffB); PG8_STAGE(PG8_SB(0, 1), b2 + hstep, voffB); PG8_STAGE(PG8_SA(0, 0), a2, voffA);
            PG8_WAIT_V(8); PG8_WAIT_L(0); PG8_BAR; PG8_MMA(1, 0, At, B0); PG8_MMA(1, 1, At, B1); PG8_BAR; PG8_SCHED;
            PG8_LDB(B0, 1, 0); PG8_LDB(B1, 1, 1); PG8_SCHED; PG8_LDA(At, 1, 0); PG8_STAGE(PG8_SA(0, 1), a2 + hstep, voffA);
            PG8_WAIT_V(8); PG8_WAIT_L(0); PG8_BAR; PG8_MMA(0, 0, At, B0); PG8_MMA(0, 1, At, B1); PG8_BAR; PG8_SCHED;
            PG8_LDA(At, 1, 1); PG8_STAGE(PG8_SB(1, 0), b3, voffB); PG8_STAGE(PG8_SB(1, 1), b3 + hstep, voffB); PG8_STAGE(PG8_SA(1, 0), a3, voffA);
            PG8_WAIT_V(8); PG8_WAIT_L(0); PG8_BAR; PG8_MMA(1, 0, At, B0); PG8_MMA(1, 1, At, B1); PG8_BAR; PG8_SCHED;
            } else {
            PG8_LDB(B0, 0, 0); PG8_SCHED; PG8_LDA(At, 0, 0); PG8_STAGE(PG8_SA(1, 1), a1 + hstep, voffA);
            PG8_WAIT_L(8); PG8_BAR; PG8_WAIT_L(0); PG8_MMA(0, 0, At, B0); PG8_BAR; PG8_SCHED;
            PG8_LDB(B1, 0, 1); PG8_STAGE(PG8_SB(0, 0), b2, voffB);
            PG8_BAR; PG8_WAIT_L(0); PG8_MMA(0, 1, At, B1); PG8_BAR;
            PG8_LDA(At, 0, 1); PG8_STAGE(PG8_SA(0, 0), a2, voffA);
            PG8_BAR; PG8_WAIT_L(0); PG8_MMA(1, 0, At, B0); PG8_BAR; PG8_SCHED;
            PG8_STAGE(PG8_SB(0, 1), b2 + hstep, voffB);
            PG8_WAIT_V(6); PG8_BAR; PG8_MMA(1, 1, At, B1); PG8_BAR;
            PG8_LDB(B0, 1, 0); PG8_SCHED; PG8_LDA(At, 1, 0); PG8_STAGE(PG8_SA(0, 1), a2 + hstep, voffA);
            PG8_WAIT_L(8); PG8_BAR; PG8_WAIT_L(0); PG8_MMA(0, 0, At, B0); PG8_BAR; PG8_SCHED;
            PG8_LDB(B1, 1, 1); PG8_STAGE(PG8_SB(1, 0), b3, voffB);
            PG8_BAR; PG8_WAIT_L(0); PG8_MMA(0, 1, At, B1); PG8_BAR;
            PG8_LDA(At, 1, 1); PG8_STAGE(PG8_SA(1, 0), a3, voffA);
            PG8_BAR; PG8_WAIT_L(0); PG8_MMA(1, 0, At, B0); PG8_BAR; PG8_SCHED;
            PG8_STAGE(PG8_SB(1, 1), b3 + hstep, voffB);
            PG8_WAIT_V(6); PG8_BAR; PG8_MMA(1, 1, At, B1); PG8_BAR;
            }
        }
        if constexpr (ALIGN_EPI) { if (wr == 0) PG8_BAR; }
        if constexpr (!Epi::AFTER_DRAIN) { E(acc, cur, wr, wc, fr, fq); S.done(cur); }
        if (!has_next) break;
#pragma unroll
        for (int a = 0; a < 2; ++a)
#pragma unroll
            for (int b = 0; b < 2; ++b)
#pragma unroll
                for (int m = 0; m < 4; ++m)
#pragma unroll
                    for (int n = 0; n < 2; ++n) acc[a][b][m][n] = (f32x4){0.f, 0.f, 0.f, 0.f};
        cur = nxt; cA = nA; cB = nB; ++ui;
        if constexpr (ALIGN_EPI) { if (wr == 1) PG8_BAR; }
    }
    PG8_WAIT_V(0);
    if constexpr (!ALIGN_EPI) { if (wr == 0) PG8_BAR; }
    PG8_BAR;
    if constexpr (Epi::AFTER_DRAIN) { E.fused(acc, cur, wr, wc, fr, fq, lds, wid, lane); S.done(cur); }
#undef PG8_SA
#undef PG8_SB
#undef PG8_STAGE
#undef PG8_LDA
#undef PG8_LDB
#undef PG8_MMA
#undef PG8_WAIT_V
#undef PG8_WAIT_L
#undef PG8_BAR
#undef PG8_SCHED
}
template <class Epi, class Sched, bool ALIGN_EPI = false, bool SP2 = false>
__device__ __forceinline__ void gemm_phase_i8(PG8_LAS unsigned char* lds, const Gemm g, const Sched& S, const Epi& E) {
    const int tid = threadIdx.x, wid = __builtin_amdgcn_readfirstlane(tid >> 6), lane = tid & 63, wr = wid >> 2, wc = wid & 3, fr = lane & 15, fq = lane >> 4;
    const int K = g.K, nt = K / BK;
    unsigned voffA[2], voffB[2];
#pragma unroll
    for (int i = 0; i < 2; ++i) { int R, C; stage_rc(tid * 16 + i * 8192, R, C); const int Rb = Epi::PERM ? ((R & ~31) + perm32(R & 31)) : R;
        voffA[i] = (unsigned)(R * K + C) * 2u; voffB[i] = (unsigned)(Rb * K + C) * 2u; }
    const size_t kstep = (size_t)(BK * 2);
    const size_t hstep = (size_t)HALF * K * 2;
    const size_t tstep = 2 * hstep;
    const unsigned ldsw = (unsigned)wid * 1024u;
    const int aoff = lds_byte(wr * 64 + fr, fq * 8), boff = lds_byte(wc * 32 + fr, fq * 8);
#define PG8_SA(b, h) (((b) * 2 + (h)) * HTB)
#define PG8_SB(b, h) ((4 + (b) * 2 + (h)) * HTB)
#define PG8_STAGE(bufoff, gbase, voff) do { _Pragma("unroll") for (int _i = 0; _i < 2; ++_i) \
        __builtin_amdgcn_global_load_lds((const unsigned*)((const char*)(gbase) + (voff)[_i]), (PG8_LAS unsigned*)(lds + (bufoff) + ldsw + _i * 8192), 16, 0, 0); } while (0)
#define PG8_LDA(dst, b, h) do { _Pragma("unroll") for (int m = 0; m < 4; ++m) _Pragma("unroll") for (int k = 0; k < 2; ++k) dst[m][k] = *(const PG8_LAS bf16x8*)(lds + PG8_SA(b, h) + aoff + m * 2048 + k * 1024); } while (0)
#define PG8_LDB(dst, b, h) do { _Pragma("unroll") for (int n = 0; n < 2; ++n) _Pragma("unroll") for (int k = 0; k < 2; ++k) dst[n][k] = *(const PG8_LAS bf16x8*)(lds + PG8_SB(b, h) + boff + n * 2048 + k * 1024); } while (0)
#define PG8_MMA(ai, bj, At, Bt) do { __builtin_amdgcn_s_setprio(1); _Pragma("unroll") for (int m = 0; m < 4; ++m) _Pragma("unroll") for (int n = 0; n < 2; ++n) _Pragma("unroll") for (int k = 0; k < 2; ++k) \
        acc[ai][bj][m][n] = __builtin_amdgcn_mfma_i32_16x16x64_i8(__builtin_bit_cast(i32x4, Bt[n][k]), __builtin_bit_cast(i32x4, At[m][k]), acc[ai][bj][m][n], 0, 0, 0); __builtin_amdgcn_s_setprio(0); } while (0)
#define PG8_WAIT_V(n) asm volatile("s_waitcnt vmcnt(" #n ")" ::: "memory")
#define PG8_WAIT_L(n) asm volatile("s_waitcnt lgkmcnt(" #n ")" ::: "memory")
#define PG8_BAR __builtin_amdgcn_s_barrier()
#define PG8_SCHED __builtin_amdgcn_sched_barrier(0)
    Unit cur, nxt; int ui = 0;
    if (!S.next(0, cur)) return;
    i32x4 acc[2][2][4][2];
#pragma unroll
    for (int a = 0; a < 2; ++a)
#pragma unroll
        for (int b = 0; b < 2; ++b)
#pragma unroll
            for (int m = 0; m < 4; ++m)
#pragma unroll
                for (int n = 0; n < 2; ++n) acc[a][b][m][n] = (i32x4){0, 0, 0, 0};
    bf16x8 At[4][2], B0[2][2], B1[2][2];
    const char* cA = (const char*)g.A + (size_t)cur.pm * tstep; const char* cB = (const char*)g.Bt + (size_t)cur.pn * tstep;
    S.a_ready(cur);
    if constexpr (SP2) {
        PG8_STAGE(PG8_SB(0, 0), cB, voffB); PG8_STAGE(PG8_SB(0, 1), cB + hstep, voffB); PG8_STAGE(PG8_SA(0, 0), cA, voffA); PG8_STAGE(PG8_SA(0, 1), cA + hstep, voffA);
        if (wr == 1) PG8_BAR;
        PG8_WAIT_V(2); PG8_BAR;
        PG8_STAGE(PG8_SB(1, 0), cB + kstep, voffB); PG8_STAGE(PG8_SA(1, 0), cA + kstep, voffA); PG8_STAGE(PG8_SB(1, 1), cB + hstep + kstep, voffB);
        PG8_WAIT_V(6); PG8_BAR;
    } else {
        PG8_STAGE(PG8_SB(0, 0), cB, voffB); PG8_STAGE(PG8_SA(0, 0), cA, voffA); PG8_STAGE(PG8_SB(0, 1), cB + hstep, voffB); PG8_STAGE(PG8_SA(0, 1), cA + hstep, voffA);
        if (wr == 1) PG8_BAR;
        PG8_WAIT_V(4); PG8_BAR;
        PG8_STAGE(PG8_SB(1, 0), cB + kstep, voffB); PG8_STAGE(PG8_SA(1, 0), cA + kstep, voffA); PG8_STAGE(PG8_SB(1, 1), cB + hstep + kstep, voffB);
        PG8_WAIT_V(6); PG8_BAR;
    }
    for (;;) {
        const bool has_next = S.next(ui + 1, nxt);
        const char* nA = has_next ? (const char*)g.A + (size_t)nxt.pm * tstep : cA; const char* nB = has_next ? (const char*)g.Bt + (size_t)nxt.pn * tstep : cB;
        for (int t = 0; t < nt; t += 2) {
            const bool last = (t == nt - 2);
            const char* a1 = cA + (size_t)(t + 1) * kstep;
            const char* a2 = last ? nA : cA + (size_t)(t + 2) * kstep; const char* b2 = last ? nB : cB + (size_t)(t + 2) * kstep;
            const char* a3 = a2 + kstep; const char* b3 = b2 + kstep;
            if (last && has_next) S.a_ready(nxt);
            if constexpr (SP2) {
            PG8_LDB(B0, 0, 0); PG8_LDB(B1, 0, 1); PG8_SCHED; PG8_LDA(At, 0, 0); PG8_STAGE(PG8_SA(1, 1), a1 + hstep, voffA);
            PG8_WAIT_V(8); PG8_WAIT_L(0); PG8_BAR; PG8_MMA(0, 0, At, B0); PG8_MMA(0, 1, At, B1); PG8_BAR; PG8_SCHED;
            PG8_LDA(At, 0, 1); PG8_STAGE(PG8_SB(0, 0), b2, voffB); PG8_STAGE(PG8_SB(0, 1), b2 + hstep, voffB); PG8_STAGE(PG8_SA(0, 0), a2, voffA);
            PG8_WAIT_V(8); PG8_WAIT_L(0); PG8_BAR; PG8_MMA(1, 0, At, B0); PG8_MMA(1, 1, At, B1); PG8_BAR; PG8_SCHED;
            PG8_LDB(B0, 1, 0); PG8_LDB(B1, 1, 1); PG8_SCHED; PG8_LDA(At, 1, 0); PG8_STAGE(PG8_SA(0, 1), a2 + hstep, voffA);
            PG8_WAIT_V(8); PG8_WAIT_L(0); PG8_BAR; PG8_MMA(0, 0, At, B0); PG8_MMA(0, 1, At, B1); PG8_BAR; PG8_SCHED;
            PG8_LDA(At, 1, 1); PG8_STAGE(PG8_SB(1, 0), b3, voffB); PG8_STAGE(PG8_SB(1, 1), b3 + hstep, voffB); PG8_STAGE(PG8_SA(1, 0), a3, voffA);
            PG8_WAIT_V(8); PG8_WAIT_L(0); PG8_BAR; PG8_MMA(1, 0, At, B0); PG8_MMA(1, 1, At, B1); PG8_BAR; PG8_SCHED;
            } else {
            PG8_LDB(B0, 0, 0); PG8_SCHED; PG8_LDA(At, 0, 0); PG8_STAGE(PG8_SA(1, 1), a1 + hstep, voffA);
            PG8_WAIT_L(8); PG8_BAR; PG8_WAIT_L(0); PG8_MMA(0, 0, At, B0); PG8_BAR; PG8_SCHED;
            PG8_LDB(B1, 0, 1); PG8_STAGE(PG8_SB(0, 0), b2, voffB);
            PG8_BAR; PG8_WAIT_L(0); PG8_MMA(0, 1, At, B1); PG8_BAR;
            PG8_LDA(At, 0, 1); PG8_STAGE(PG8_SA(0, 0), a2, voffA);
            PG8_BAR; PG8_WAIT_L(0); PG8_MMA(1, 0, At, B0); PG8_BAR; PG8_SCHED;
            PG8_STAGE(PG8_SB(0, 1), b2 + hstep, voffB);
            PG8_WAIT_V(6); PG8_BAR; PG8_MMA(1, 1, At, B1); PG8_BAR;
            PG8_LDB(B0, 1, 0); PG8_SCHED; PG8_LDA(At, 1, 0); PG8_STAGE(PG8_SA(0, 1), a2 + hstep, voffA);
            PG8_WAIT_L(8); PG8_BAR; PG8_WAIT_L(0); PG8_MMA(0, 0, At, B0); PG8_BAR; PG8_SCHED;
            PG8_LDB(B1, 1, 1); PG8_STAGE(PG8_SB(1, 0), b3, voffB);
            PG8_BAR; PG8_WAIT_L(0); PG8_MMA(0, 1, At, B1); PG8_BAR;
            PG8_LDA(At, 1, 1); PG8_STAGE(PG8_SA(1, 0), a3, voffA);
            PG8_BAR; PG8_WAIT_L(0); PG8_MMA(1, 0, At, B0); PG8_BAR; PG8_SCHED;
            PG8_STAGE(PG8_SB(1, 1), b3 + hstep, voffB);
            PG8_WAIT_V(6); PG8_BAR; PG8_MMA(1, 1, At, B1); PG8_BAR;
            }
        }
        if constexpr (ALIGN_EPI) { if (wr == 0) PG8_BAR; }
        if constexpr (!Epi::AFTER_DRAIN) { E(acc, cur, wr, wc, fr, fq); S.done(cur); }
        if (!has_next) break;
#pragma unroll
        for (int a = 0; a < 2; ++a)
#pragma unroll
            for (int b = 0; b < 2; ++b)
#pragma unroll
                for (int m = 0; m < 4; ++m)
#pragma unroll
                    for (int n = 0; n < 2; ++n) acc[a][b][m][n] = (i32x4){0, 0, 0, 0};
        cur = nxt; cA = nA; cB = nB; ++ui;
        if constexpr (ALIGN_EPI) { if (wr == 1) PG8_BAR; }
    }
    PG8_WAIT_V(0);
    if constexpr (!ALIGN_EPI) { if (wr == 0) PG8_BAR; }
    PG8_BAR;
    if constexpr (Epi::AFTER_DRAIN) { E.fused(acc, cur, wr, wc, fr, fq, lds, wid, lane); S.done(cur); }
#undef PG8_SA
#undef PG8_SB
#undef PG8_STAGE
#undef PG8_LDA
#undef PG8_LDB
#undef PG8_MMA
#undef PG8_WAIT_V
#undef PG8_WAIT_L
#undef PG8_BAR
#undef PG8_SCHED
}
}

#define LAS __attribute__((address_space(3)))
typedef unsigned short bf16;
typedef float f32x2 __attribute__((ext_vector_type(2)));
typedef float f32x4 __attribute__((ext_vector_type(4)));
typedef unsigned u32x2 __attribute__((ext_vector_type(2)));
typedef unsigned u32x4 __attribute__((ext_vector_type(4)));

constexpr int PDIM = 1536;
constexpr int NTOK = 32768, DM = 1024, DIN = 2560, SEQ = 8192, NBATCH = 4, NMETA = 16;
constexpr int NHEAD = 8, NKEYS = 128, TOPK = 16, NSEL = NHEAD * TOPK;
constexpr float EPS = 1e-6f;
constexpr float U_SCALE = 64.f, V_SCALE = 16.f;
constexpr float U4_CLIP = 2.6f;
constexpr int NWAVES = 8, NTHREADS = 512;
constexpr int MKC = 32;
constexpr int LDS_BYTES = 147456;

constexpr size_t MiB = 1u << 20;
constexpr size_t WS_CTL = 0, WS_WIN_T = 1 * MiB, WS_WOUT_T = 6 * MiB, WS_WQ_T = 8 * MiB, WS_KEYS = 12 * MiB, WS_METAPART = 160 * MiB  ,
                 WS_METARSTD = 14 * MiB + 512 * 1024, WS_METAPROJ = 14 * MiB + 576 * 1024, WS_RSTD1 = 15 * MiB, WS_SSQ = 16 * MiB, WS_U8 = 32 * MiB, WS_V8 = 48 * MiB,
                 WS_IDX = 64 * MiB, WS_GATE = 80 * MiB, WS_H0B = 96 * MiB, WS_H2B = 96 * MiB, WS_Y = 160 * MiB, WS_PROJ = 224 * MiB,
                 WS_Q = 224 * MiB, WS_ESCALE = 18 * MiB, WS_SUMQ = 19 * MiB, WS_SX = 20 * MiB, WS_SW = 21 * MiB, WS_SY = 22 * MiB, WS_SWO = 23 * MiB, WS_WMX = 24 * MiB, WS_AMX = 26 * MiB, WS_RF = 28 * MiB, WS_SWQ = 29 * MiB, WS_H0I8 = 384 * MiB, WS_AW = 160 * MiB  , WS_END = 416 * MiB;

struct Params {
    const float* x; const float* meta; const float* g_mix; const float* w_in; const float* sc_w; const float* cf_w; const float* cf_b;
    const float* ln_g; const float* ln_b; const float* g_sc; const float* g_cf; const float* w_out; const float* g_ffn; const float* w_q;
    const float* keys; const float* pu; const float* pv; const float* g_fin;
    float* out; unsigned char* ws;
    int ph_lo, ph_hi, coop, pad;
};

__device__ __forceinline__ unsigned f2bf(float f) { unsigned u = __builtin_bit_cast(unsigned, f); return (u + 0x7fffu + ((u >> 16) & 1u)) >> 16; }
__device__ __forceinline__ unsigned pk2(float lo, float hi) { return f2bf(lo) | (f2bf(hi) << 16); }
__device__ __forceinline__ float bf2f(unsigned b) { return __builtin_bit_cast(float, b << 16); }
__device__ __forceinline__ float bflo(unsigned w) { return __builtin_bit_cast(float, w << 16); }
__device__ __forceinline__ float bfhi(unsigned w) { return __builtin_bit_cast(float, w & 0xffff0000u); }
__device__ __forceinline__ float wave_sum(float v) {
#pragma unroll
    for (int o = 1; o < 64; o <<= 1) v += __shfl_xor(v, o);
    return v;
}
template <int CTRL> __device__ __forceinline__ float dpp_f(float v) { return __builtin_bit_cast(float, __builtin_amdgcn_update_dpp(0, __builtin_bit_cast(int, v), CTRL, 0xf, 0xf, true)); }
__device__ __forceinline__ float wave_sum_fast(float v) {
    v += dpp_f<0xB1>(v); v += dpp_f<0x4E>(v); v += dpp_f<0x141>(v); v += dpp_f<0x140>(v);
    { auto r = __builtin_amdgcn_permlane16_swap(__float_as_uint(v), __float_as_uint(v), false, false); v = __uint_as_float(r[0]) + __uint_as_float(r[1]); }
    { auto r = __builtin_amdgcn_permlane32_swap(__float_as_uint(v), __float_as_uint(v), false, false); v = __uint_as_float(r[0]) + __uint_as_float(r[1]); }
    return v;
}
__device__ __forceinline__ float wave_max_fast(float vf) {
    unsigned v = __float_as_uint(vf);
#define WMX_DPP(ctrl) (unsigned)__builtin_amdgcn_update_dpp(0, (int)v, ctrl, 0xf, 0xf, true)
    v = max(v, WMX_DPP(0xB1)); v = max(v, WMX_DPP(0x4E)); v = max(v, WMX_DPP(0x141)); v = max(v, WMX_DPP(0x140));
#undef WMX_DPP
    { auto r = __builtin_amdgcn_permlane16_swap(v, v, false, false); const unsigned r0 = r[0], r1 = r[1]; v = max(r0, r1); }
    { auto r = __builtin_amdgcn_permlane32_swap(v, v, false, false); const unsigned r0 = r[0], r1 = r[1]; v = max(r0, r1); }
    return __uint_as_float(v);
}
__device__ __forceinline__ float sigmoid_f(float x) { return __builtin_amdgcn_rcpf(1.f + __expf(-x)); }
__device__ __forceinline__ float gelu_tanh_f(float x) {
    const float t = 0.7978845608028654f * (x + 0.044715f * x * x * x);
    const float e = __expf(2.f * t);
    const float th = 1.f - 2.f * __builtin_amdgcn_rcpf(e + 1.f);
    return 0.5f * x * (1.f + th);
}

__device__ __forceinline__ unsigned cvt_pk_bf16(float lo, float hi) { unsigned r; asm volatile("v_cvt_pk_bf16_f32 %0, %1, %2" : "=v"(r) : "v"(lo), "v"(hi)); return r; }

template <int MODE> struct EpiRowScale {
    static constexpr bool PERM = true, AFTER_DRAIN = false;
    bf16* O; int ldc; const float* rs;
    __device__ __forceinline__ void operator()(const pg8::f32x4 (&acc)[2][2][4][2], const pg8::Unit& u, int wr, int wc, int fr, int fq) const {
        const int row0 = u.pm * 256 + wr * 64 + fr, col0 = u.pn * 256 + wc * 32 + 8 * fq;
#pragma unroll
        for (int ai = 0; ai < 2; ++ai)
#pragma unroll
            for (int m = 0; m < 4; ++m) {
                const int row = row0 + ai * 128 + m * 16;
                float s;
                if (MODE == 0) s = rs[row];
                else { const f32x4* p = (const f32x4*)(rs + (size_t)row * 16); const f32x4 a = p[0], b = p[1], c = p[2], d = p[3];
                       const float t = ((a.x + a.y) + (a.z + a.w)) + ((b.x + b.y) + (b.z + b.w)) + ((c.x + c.y) + (c.z + c.w)) + ((d.x + d.y) + (d.z + d.w));
                       s = rsqrtf(t * (1.f / 1024.f) + EPS); }
                bf16* rowp = O + (size_t)row * ldc + col0;
#pragma unroll
                for (int bj = 0; bj < 2; ++bj) { const pg8::f32x4 v0 = acc[ai][bj][m][0] * s, v1 = acc[ai][bj][m][1] * s;
                    u32x4 w; w.x = cvt_pk_bf16(v0[0], v0[1]); w.y = cvt_pk_bf16(v0[2], v0[3]); w.z = cvt_pk_bf16(v1[0], v1[1]); w.w = cvt_pk_bf16(v1[2], v1[3]);
                    *(u32x4*)(rowp + bj * 128) = w; }
            }
    }
};
struct EpiProj {
    static constexpr bool PERM = true, AFTER_DRAIN = false;
    bf16* O; const float* rs;
    __device__ __forceinline__ void operator()(const pg8::f32x4 (&acc)[2][2][4][2], const pg8::Unit& u, int wr, int wc, int fr, int fq) const {
        const int row0 = u.pm * 256 + wr * 64 + fr, cin = wc * 32 + 8 * fq, pn = u.pn;
#pragma unroll
        for (int ai = 0; ai < 2; ++ai)
#pragma unroll
            for (int m = 0; m < 4; ++m) {
                const int row = row0 + ai * 128 + m * 16; const float sc = rs[row];
                float a[8], b[8];
#pragma unroll
                for (int i = 0; i < 4; ++i) { a[i] = acc[ai][0][m][0][i] * sc; a[4 + i] = acc[ai][0][m][1][i] * sc; b[i] = acc[ai][1][m][0][i] * sc; b[4 + i] = acc[ai][1][m][1][i] * sc; }
                bf16* rowp = O + (size_t)row * PDIM;
                if (pn >= 4 && pn < 6) {
                    u32x4 w0, w1; w0.x = cvt_pk_bf16(a[0], a[1]); w0.y = cvt_pk_bf16(a[2], a[3]); w0.z = cvt_pk_bf16(a[4], a[5]); w0.w = cvt_pk_bf16(a[6], a[7]);
                    w1.x = cvt_pk_bf16(b[0], b[1]); w1.y = cvt_pk_bf16(b[2], b[3]); w1.z = cvt_pk_bf16(b[4], b[5]); w1.w = cvt_pk_bf16(b[6], b[7]);
                    *(u32x4*)(rowp + 512 + 256 * (pn - 4) + cin) = w0; *(u32x4*)(rowp + 512 + 256 * (pn - 4) + 128 + cin) = w1;
                } else {
                    float o[8];
                    if (pn < 4) {
#pragma unroll
                        for (int i = 0; i < 8; ++i) o[i] = a[i] * b[i];
                    } else {
#pragma unroll
                        for (int i = 0; i < 8; ++i) o[i] = a[i] * sigmoid_f(b[i]);
                    }
                    u32x4 w; w.x = cvt_pk_bf16(o[0], o[1]); w.y = cvt_pk_bf16(o[2], o[3]); w.z = cvt_pk_bf16(o[4], o[5]); w.w = cvt_pk_bf16(o[6], o[7]);
                    *(u32x4*)(rowp + (pn < 4 ? 128 * pn : 1024 + 128 * (pn - 6)) + cin) = w;
                }
            }
    }
};
struct EpiProjI8 {
    static constexpr bool PERM = true, AFTER_DRAIN = false;
    bf16* O; const float* rs; const float* sw;
    __device__ __forceinline__ void operator()(const pg8::i32x4 (&acc)[2][2][4][2], const pg8::Unit& u, int wr, int wc, int fr, int fq) const {
        const int row0 = u.pm * 256 + wr * 64 + fr, cin = wc * 32 + 8 * fq, pn = u.pn;
        float swa[8], swb[8];
        { const f32x4 a0 = *(const f32x4*)(sw + 256 * pn + cin), a1 = *(const f32x4*)(sw + 256 * pn + cin + 4), b0 = *(const f32x4*)(sw + 256 * pn + 128 + cin), b1 = *(const f32x4*)(sw + 256 * pn + 128 + cin + 4);
          swa[0] = a0.x; swa[1] = a0.y; swa[2] = a0.z; swa[3] = a0.w; swa[4] = a1.x; swa[5] = a1.y; swa[6] = a1.z; swa[7] = a1.w;
          swb[0] = b0.x; swb[1] = b0.y; swb[2] = b0.z; swb[3] = b0.w; swb[4] = b1.x; swb[5] = b1.y; swb[6] = b1.z; swb[7] = b1.w; }
#pragma unroll
        for (int ai = 0; ai < 2; ++ai)
#pragma unroll
            for (int m = 0; m < 4; ++m) {
                const int row = row0 + ai * 128 + m * 16; const float sc = rs[row];
                float a[8], b[8];
#pragma unroll
                for (int i = 0; i < 4; ++i) { a[i] = (float)acc[ai][0][m][0][i] * (sc * swa[i]); a[4 + i] = (float)acc[ai][0][m][1][i] * (sc * swa[4 + i]);
                    b[i] = (float)acc[ai][1][m][0][i] * (sc * swb[i]); b[4 + i] = (float)acc[ai][1][m][1][i] * (sc * swb[4 + i]); }
                bf16* rowp = O + (size_t)row * PDIM;
                if (pn >= 4 && pn < 6) {
                    u32x4 w0, w1; w0.x = cvt_pk_bf16(a[0], a[1]); w0.y = cvt_pk_bf16(a[2], a[3]); w0.z = cvt_pk_bf16(a[4], a[5]); w0.w = cvt_pk_bf16(a[6], a[7]);
                    w1.x = cvt_pk_bf16(b[0], b[1]); w1.y = cvt_pk_bf16(b[2], b[3]); w1.z = cvt_pk_bf16(b[4], b[5]); w1.w = cvt_pk_bf16(b[6], b[7]);
                    *(u32x4*)(rowp + 512 + 256 * (pn - 4) + cin) = w0; *(u32x4*)(rowp + 512 + 256 * (pn - 4) + 128 + cin) = w1;
                } else {
                    float o[8];
                    if (pn < 4) {
#pragma unroll
                        for (int i = 0; i < 8; ++i) o[i] = a[i] * b[i];
                    } else {
#pragma unroll
                        for (int i = 0; i < 8; ++i) o[i] = a[i] * sigmoid_f(b[i]);
                    }
                    u32x4 w; w.x = cvt_pk_bf16(o[0], o[1]); w.y = cvt_pk_bf16(o[2], o[3]); w.z = cvt_pk_bf16(o[4], o[5]); w.w = cvt_pk_bf16(o[6], o[7]);
                    *(u32x4*)(rowp + (pn < 4 ? 128 * pn : 1024 + 128 * (pn - 6)) + cin) = w;
                }
            }
    }
};
__host__ __device__ __forceinline__ int win_src_col(int n) {
    const int t = n >> 8, j = n & 255;
    if (t < 4) return (j < 128) ? 128 * t + j : 1024 + 128 * t + (j - 128);
    if (t < 6) return 512 + 256 * (t - 4) + j;
    return (j < 128) ? 1536 + 128 * (t - 6) + j : 2048 + 128 * (t - 6) + (j - 128);
}
struct EpiResidual {
    static constexpr bool PERM = true, AFTER_DRAIN = false;
    bf16* O; const signed char* XB; const float* SX; float* ssq;
    __device__ __forceinline__ void operator()(const pg8::f32x4 (&acc)[2][2][4][2], const pg8::Unit& u, int wr, int wc, int fr, int fq) const {
        const int row0 = u.pm * 256 + wr * 64 + fr, col0 = u.pn * 256 + wc * 32 + 8 * fq;
#pragma unroll
        for (int ai = 0; ai < 2; ++ai)
#pragma unroll
            for (int m = 0; m < 4; ++m) {
                const int row = row0 + ai * 128 + m * 16;
                const signed char* xr = XB + (size_t)row * DM + col0; bf16* rowp = O + (size_t)row * DM + col0;
                float q = 0.f;
                u32x2 xw[2]; const float sxr = SX[row];
#pragma unroll
                for (int bj = 0; bj < 2; ++bj) xw[bj] = *(const u32x2*)(xr + bj * 128);
#pragma unroll
                for (int bj = 0; bj < 2; ++bj) {
                    const f32x4 x0 = (f32x4){(float)(signed char)(xw[bj].x), (float)(signed char)(xw[bj].x >> 8), (float)(signed char)(xw[bj].x >> 16), (float)((int)xw[bj].x >> 24)} * sxr,
                                x1 = (f32x4){(float)(signed char)(xw[bj].y), (float)(signed char)(xw[bj].y >> 8), (float)(signed char)(xw[bj].y >> 16), (float)((int)xw[bj].y >> 24)} * sxr;
                    const pg8::f32x4 v0 = acc[ai][bj][m][0] + x0, v1 = acc[ai][bj][m][1] + x1;
                    q += (v0[0] * v0[0] + v0[1] * v0[1]) + (v0[2] * v0[2] + v0[3] * v0[3]) + (v1[0] * v1[0] + v1[1] * v1[1]) + (v1[2] * v1[2] + v1[3] * v1[3]);
                    u32x4 w; w.x = cvt_pk_bf16(v0[0], v0[1]); w.y = cvt_pk_bf16(v0[2], v0[3]); w.z = cvt_pk_bf16(v1[0], v1[1]); w.w = cvt_pk_bf16(v1[2], v1[3]);
                    *(u32x4*)(rowp + bj * 128) = w; }
                q += __shfl_xor(q, 16); q += __shfl_xor(q, 32);
                if (fq == 0) ssq[(size_t)row * 16 + u.pn * 4 + wc] = q;
            }
    }
};

struct EpiResidualI8 {
    static constexpr bool PERM = true, AFTER_DRAIN = false;
    bf16* O; const signed char* XB; const float* SX; const float* SY; const float* SWO; float* ssq; float* amx;
    __device__ __forceinline__ void operator()(const pg8::i32x4 (&acc)[2][2][4][2], const pg8::Unit& u, int wr, int wc, int fr, int fq) const {
        const int row0 = u.pm * 256 + wr * 64 + fr, col0 = u.pn * 256 + wc * 32 + 8 * fq;
        f32x4 sw[2][2];
#pragma unroll
        for (int bj = 0; bj < 2; ++bj) { sw[bj][0] = *(const f32x4*)(SWO + col0 + bj * 128); sw[bj][1] = *(const f32x4*)(SWO + col0 + bj * 128 + 4); }
#pragma unroll
        for (int ai = 0; ai < 2; ++ai)
#pragma unroll
            for (int m = 0; m < 4; ++m) {
                const int row = row0 + ai * 128 + m * 16;
                const signed char* xr = XB + (size_t)row * DM + col0; bf16* rowp = O + (size_t)row * DM + col0;
                float q = 0.f, mxa = 0.f;
                u32x2 xw[2]; const float sxr = SX[row], syr = SY[row];
#pragma unroll
                for (int bj = 0; bj < 2; ++bj) xw[bj] = *(const u32x2*)(xr + bj * 128);
#pragma unroll
                for (int bj = 0; bj < 2; ++bj) {
                    const f32x4 x0 = (f32x4){(float)(signed char)(xw[bj].x), (float)(signed char)(xw[bj].x >> 8), (float)(signed char)(xw[bj].x >> 16), (float)((int)xw[bj].x >> 24)} * sxr,
                                x1 = (f32x4){(float)(signed char)(xw[bj].y), (float)(signed char)(xw[bj].y >> 8), (float)(signed char)(xw[bj].y >> 16), (float)((int)xw[bj].y >> 24)} * sxr;
                    const pg8::i32x4 a0 = acc[ai][bj][m][0], a1 = acc[ai][bj][m][1];
                    const f32x4 v0 = (f32x4){(float)a0[0], (float)a0[1], (float)a0[2], (float)a0[3]} * (sw[bj][0] * syr) + x0, v1 = (f32x4){(float)a1[0], (float)a1[1], (float)a1[2], (float)a1[3]} * (sw[bj][1] * syr) + x1;
                    q += (v0[0] * v0[0] + v0[1] * v0[1]) + (v0[2] * v0[2] + v0[3] * v0[3]) + (v1[0] * v1[0] + v1[1] * v1[1]) + (v1[2] * v1[2] + v1[3] * v1[3]);
                    mxa = fmaxf(mxa, fmaxf(fmaxf(fmaxf(fabsf(v0[0]), fabsf(v0[1])), fmaxf(fabsf(v0[2]), fabsf(v0[3]))), fmaxf(fmaxf(fabsf(v1[0]), fabsf(v1[1])), fmaxf(fabsf(v1[2]), fabsf(v1[3])))));
                    u32x4 w; w.x = cvt_pk_bf16(v0[0], v0[1]); w.y = cvt_pk_bf16(v0[2], v0[3]); w.z = cvt_pk_bf16(v1[0], v1[1]); w.w = cvt_pk_bf16(v1[2], v1[3]);
                    *(u32x4*)(rowp + bj * 128) = w; }
                q += __shfl_xor(q, 16); q += __shfl_xor(q, 32);
                mxa = fmaxf(mxa, __shfl_xor(mxa, 16)); mxa = fmaxf(mxa, __shfl_xor(mxa, 32));
                if (fq == 0) { ssq[(size_t)row * 16 + u.pn * 4 + wc] = q; amx[(size_t)row * 16 + u.pn * 4 + wc] = mxa; }
            }
    }
};
template <bool MAPIN> __device__ __forceinline__ void p0_transpose_item(const float* W, int K, int N, bf16* WT, LAS float* scr, int item, int lane,
                                                  const float* g_lo, const float* g_hi, int split) {
    const int nblk = N / 32, kb = item / nblk, nb = item % nblk, k0 = 64 * kb, n0 = 32 * nb;
#pragma unroll 8
    for (int i = 0; i < 32; ++i) { const int kk = 2 * i + (lane >> 5); const int k = k0 + kk;
        const float g = (k < split) ? g_lo[k] : g_hi[k - split];
        scr[kk * 33 + (lane & 31)] = W[(size_t)k * N + (MAPIN ? win_src_col(n0) : n0) + (lane & 31)] * g; }
    asm volatile("s_waitcnt lgkmcnt(0)" ::: "memory");
    const int c = lane & 7;
#pragma unroll
    for (int j = 0; j < 4; ++j) { const int n = (lane >> 3) + 8 * j; const LAS float* s = scr + (8 * c) * 33 + n;
        u32x4 o; o.x = pk2(s[0 * 33], s[1 * 33]); o.y = pk2(s[2 * 33], s[3 * 33]); o.z = pk2(s[4 * 33], s[5 * 33]); o.w = pk2(s[6 * 33], s[7 * 33]);
        *(u32x4*)(WT + (size_t)(n0 + n) * K + k0 + 8 * c) = o; }
    asm volatile("s_waitcnt lgkmcnt(0)" ::: "memory");
}

constexpr int CW_COLMAX = 5120;
__device__ __forceinline__ void p0_colmax_item(const float* W, int N, unsigned* colmax, int item, int lane, const float* g) {
    const int nblk = N / 32, kb = item / nblk, nb = item % nblk, k0 = 64 * kb, n0 = 32 * nb;
    float mx = 0.f;
#pragma unroll
    for (int i = 0; i < 32; ++i) { const int k = k0 + 2 * i + (lane >> 5); mx = fmaxf(mx, fabsf(W[(size_t)k * N + n0 + (lane & 31)] * g[k])); }
    mx = fmaxf(mx, __shfl_xor(mx, 32));
    if (lane < 32) atomicMax(colmax + n0 + lane, __float_as_uint(mx));
}
__device__ __forceinline__ void p1_quant_item(const float* W, int K, int N, signed char* WT8, float* swout, const unsigned* colmax, LAS float* scr, int item, int lane, const float* g) {
    const int nblk = N / 32, kb = item / nblk, nb = item % nblk, k0 = 64 * kb, n0 = 32 * nb, s0 = win_src_col(n0);
    const float cm = fmaxf(__uint_as_float(__hip_atomic_load((unsigned*)colmax + s0 + (lane & 31), __ATOMIC_RELAXED, __HIP_MEMORY_SCOPE_AGENT)), 1e-30f), inv = 127.f / cm;
    if (kb == 0 && lane < 32) swout[n0 + lane] = cm * (1.f / 127.f);
#pragma unroll
    for (int i = 0; i < 32; ++i) { const int kk = 2 * i + (lane >> 5); const int k = k0 + kk;
        scr[kk * 33 + (lane & 31)] = W[(size_t)k * N + s0 + (lane & 31)] * g[k] * inv; }
    asm volatile("s_waitcnt lgkmcnt(0)" ::: "memory");
    const int c = lane & 7;
#pragma unroll
    for (int j = 0; j < 4; ++j) { const int n = (lane >> 3) + 8 * j; const LAS float* sp = scr + (8 * c) * 33 + n;
        unsigned w0 = 0u, w1 = 0u;
#pragma unroll
        for (int i = 0; i < 4; ++i) { w0 |= ((unsigned)(int)rintf(sp[i * 33]) & 255u) << (8 * i); w1 |= ((unsigned)(int)rintf(sp[(4 + i) * 33]) & 255u) << (8 * i); }
        u32x2 o; o.x = w0; o.y = w1;
        *(u32x2*)(WT8 + (size_t)(n0 + n) * K + k0 + 8 * c) = o; }
    asm volatile("s_waitcnt lgkmcnt(0)" ::: "memory");
}
constexpr int CW_WCNT = 10752;
constexpr size_t WS_METARAW = 65536;
constexpr int CW_COLMAX3 = 8704;
constexpr int CW_COLMAX2 = 7680;
__device__ __forceinline__ void p0_colmax_item2(const float* W, int N, unsigned* colmax, int item, int lane, const float* g_lo, const float* g_hi, int split) {
    const int nblk = N / 32, kb = item / nblk, nb = item % nblk, k0 = 64 * kb, n0 = 32 * nb;
    float mx = 0.f;
#pragma unroll
    for (int i = 0; i < 32; ++i) { const int k = k0 + 2 * i + (lane >> 5); const float g = (k < split) ? g_lo[k] : g_hi[k - split]; mx = fmaxf(mx, fabsf(W[(size_t)k * N + n0 + (lane & 31)] * g)); }
    mx = fmaxf(mx, __shfl_xor(mx, 32));
    if (lane < 32) atomicMax(colmax + n0 + lane, __float_as_uint(mx));
}
__device__ __forceinline__ void p1_quant_item2(const float* W, int K, int N, signed char* WT8, float* swout, const unsigned* colmax, LAS float* scr, int item, int lane, const float* g_lo, const float* g_hi, int split) {
    const int nblk = N / 32, kb = item / nblk, nb = item % nblk, k0 = 64 * kb, n0 = 32 * nb;
    const float cm = fmaxf(__uint_as_float(__hip_atomic_load((unsigned*)colmax + n0 + (lane & 31), __ATOMIC_RELAXED, __HIP_MEMORY_SCOPE_AGENT)), 1e-30f), inv = 127.f / cm;
    if (kb == 0 && lane < 32) swout[n0 + lane] = cm * (1.f / 127.f);
#pragma unroll
    for (int i = 0; i < 32; ++i) { const int kk = 2 * i + (lane >> 5); const int k = k0 + kk; const float g = (k < split) ? g_lo[k] : g_hi[k - split];
        scr[kk * 33 + (lane & 31)] = W[(size_t)k * N + n0 + (lane & 31)] * g * inv; }
    asm volatile("s_waitcnt lgkmcnt(0)" ::: "memory");
    const int c = lane & 7;
#pragma unroll
    for (int j = 0; j < 4; ++j) { const int n = (lane >> 3) + 8 * j; const LAS float* sp = scr + (8 * c) * 33 + n;
        unsigned w0 = 0u, w1 = 0u;
#pragma unroll
        for (int i = 0; i < 4; ++i) { w0 |= ((unsigned)(int)rintf(sp[i * 33]) & 255u) << (8 * i); w1 |= ((unsigned)(int)rintf(sp[(4 + i) * 33]) & 255u) << (8 * i); }
        u32x2 o; o.x = w0; o.y = w1;
        *(u32x2*)(WT8 + (size_t)(n0 + n) * K + k0 + 8 * c) = o; }
    asm volatile("s_waitcnt lgkmcnt(0)" ::: "memory");
}
__device__ __forceinline__ float q4(float x, float inv_s) {
    const float a = fabsf(x) * inv_s; float r;
    if (a < 2.f) r = rintf(a * 2.f) * 0.5f; else if (a < 4.f) r = rintf(a); else r = fminf(6.f, rintf(a * 0.5f) * 2.f);
    return copysignf(r, x);
}
__device__ __forceinline__ void phase_prep(const Params& P, LAS unsigned char* lds) {
    const int tid = threadIdx.x, lane = tid & 63, wave = __builtin_amdgcn_readfirstlane(tid >> 6);
    const int gw = blockIdx.x * NWAVES + wave, NGW = gridDim.x * NWAVES;
    unsigned char* ws = P.ws;
    LAS float* scr = (LAS float*)(lds + wave * 16384);
    constexpr int I_IN = (DM / 64) * (DIN / 32), I_OUT = (DM / 64) * (DM / 32), I_Q = (DM / 64) * (2048 / 32);
    for (int it = gw; it < I_IN + I_OUT + I_Q; it += NGW) {
        int r = it;
        int grp;
        if (r < I_IN) { p0_colmax_item(P.w_in, DIN, (unsigned*)(ws + WS_CTL) + CW_COLMAX, r, lane, P.g_mix); grp = r % (DIN / 32); }
        else if (r < I_IN + I_OUT) { r -= I_IN; p0_colmax_item2(P.w_out, DM, (unsigned*)(ws + WS_CTL) + CW_COLMAX2, r, lane, P.g_sc, P.g_cf, 512); grp = 80 + r % (DM / 32); }
        else { r -= I_IN + I_OUT; p0_colmax_item2(P.w_q, 2048, (unsigned*)(ws + WS_CTL) + CW_COLMAX3, r, lane, P.g_ffn, P.g_ffn, DM); grp = 112 + r % (2048 / 32); }
        asm volatile("s_waitcnt vmcnt(0)" ::: "memory");
        if (lane == 0) (void)__hip_atomic_fetch_add((unsigned*)(ws + WS_CTL) + CW_WCNT + grp, 1u, __ATOMIC_RELAXED, __HIP_MEMORY_SCOPE_AGENT);
    }
    {
        unsigned* H0I8 = (unsigned*)(ws + WS_H0I8); float* RS1 = (float*)(ws + WS_RSTD1); float* SXp = (float*)(ws + WS_SX);
        for (int t0 = gw * 4; t0 < NTOK; t0 += NGW * 4) {
            f32x4 v[4][4];
#pragma unroll
            for (int q = 0; q < 4; ++q) { const f32x4* xr = (const f32x4*)(P.x + (size_t)(t0 + q) * DM) + lane;
#pragma unroll
                for (int j = 0; j < 4; ++j) v[q][j] = xr[64 * j]; }
#pragma unroll
            for (int q = 0; q < 4; ++q) { float sq = 0.f, mx = 0.f;
#pragma unroll
                for (int j = 0; j < 4; ++j) { sq += (v[q][j].x * v[q][j].x + v[q][j].y * v[q][j].y) + (v[q][j].z * v[q][j].z + v[q][j].w * v[q][j].w);
                    mx = fmaxf(mx, fmaxf(fmaxf(fabsf(v[q][j].x), fabsf(v[q][j].y)), fmaxf(fabsf(v[q][j].z), fabsf(v[q][j].w)))); }
                sq = wave_sum_fast(sq); mx = fmaxf(wave_max_fast(mx), 1e-30f);
                const float sx = mx * (1.f / 127.f), inv = 127.f / mx;
                if (lane == 0) { RS1[t0 + q] = sx * rsqrtf(sq * (1.f / DM) + EPS); SXp[t0 + q] = sx; }
                unsigned* o = H0I8 + (size_t)(t0 + q) * (DM / 4) + lane;
#pragma unroll
                for (int j = 0; j < 4; ++j) { const int a = (int)rintf(v[q][j].x * inv), b = (int)rintf(v[q][j].y * inv), c = (int)rintf(v[q][j].z * inv), d = (int)rintf(v[q][j].w * inv);
                    o[64 * j] = ((unsigned)a & 255u) | (((unsigned)b & 255u) << 8) | (((unsigned)c & 255u) << 16) | ((unsigned)d << 24); } }
        }
    }
    {
        bf16* KB = (bf16*)(ws + WS_KEYS);
        const int gt = blockIdx.x * NTHREADS + tid, NGT = gridDim.x * NTHREADS;
        for (int i = gt; i < 8 * 2 * 128 * 128 / 4; i += NGT) { const f32x4 v = ((const f32x4*)P.keys)[i]; u32x2 w; w.x = pk2(v.x, v.y); w.y = pk2(v.z, v.w); ((u32x2*)KB)[i] = w; }
    }
    {
        float* MP = (float*)(ws + WS_CTL + WS_METARAW); float* MR = (float*)(ws + WS_METARSTD);
        for (int r = gw; r < NMETA; r += NGW) {
            float s = 0.f;
            for (int k = lane; k < DM; k += 64) { const float v = P.meta[r * DM + k]; s += v * v; }
            s = wave_sum(s);
            if (lane == 0) MR[r] = rsqrtf(s * (1.f / DM) + EPS);
        }
        for (int it = gw; it < MKC * 40; it += NGW) {
            const int kc = it / 40, nb = it % 40, n = nb * 64 + lane;
            float acc[NMETA];
#pragma unroll
            for (int r = 0; r < NMETA; ++r) acc[r] = 0.f;
            for (int k = kc * (DM / MKC); k < (kc + 1) * (DM / MKC); ++k) {
                const float w = P.w_in[(size_t)k * DIN + n] * P.g_mix[k];
#pragma unroll
                for (int r = 0; r < NMETA; ++r) acc[r] += P.meta[r * DM + k] * w;
            }
#pragma unroll
            for (int r = 0; r < NMETA; ++r) (void)__hip_atomic_fetch_add(MP + (size_t)r * DIN + n, acc[r], __ATOMIC_RELAXED, __HIP_MEMORY_SCOPE_AGENT);
        }
    }
    {
        constexpr int NI1 = (DM / 64) * (DIN / 32), NI2 = (DM / 64) * (DM / 32), NI3 = (DM / 64) * (2048 / 32);
        unsigned* cnt = (unsigned*)(ws + WS_CTL) + CW_WCNT;
        for (int it = gw; it < NI1 + NI2 + NI3; it += NGW) {
            int grp;
            if (it < NI1) grp = win_src_col(32 * (it % (DIN / 32))) / 32; else if (it < NI1 + NI2) grp = 80 + (it - NI1) % (DM / 32); else grp = 112 + (it - NI1 - NI2) % (2048 / 32);
            { unsigned sp = 0; while (__hip_atomic_load(cnt + grp, __ATOMIC_RELAXED, __HIP_MEMORY_SCOPE_AGENT) < 16u) { __builtin_amdgcn_s_sleep(2); if (++sp > (1u << 20)) break; } }
            if (it < NI1) p1_quant_item(P.w_in, DM, DIN, (signed char*)(ws + WS_WIN_T), (float*)(ws + WS_SW), (const unsigned*)(ws + WS_CTL) + CW_COLMAX, scr, it, lane, P.g_mix);
            else if (it < NI1 + NI2) p1_quant_item2(P.w_out, DM, DM, (signed char*)(ws + WS_WOUT_T), (float*)(ws + WS_SWO), (const unsigned*)(ws + WS_CTL) + CW_COLMAX2, scr, it - NI1, lane, P.g_sc, P.g_cf, 512);
            else p1_quant_item2(P.w_q, DM, 2048, (signed char*)(ws + WS_WQ_T), (float*)(ws + WS_SWQ), (const unsigned*)(ws + WS_CTL) + CW_COLMAX3, scr, it - NI1 - NI2, lane, P.g_ffn, P.g_ffn, DM);
        }
    }
}

__device__ __forceinline__ float metaval(const float* RAW, const float* MR, int p, int c) {
    const float r = MR[p]; const float* rp = RAW + (size_t)p * DIN;
    if (c < 512) return (rp[c] * r) * (rp[1024 + c] * r);
    if (c < 1024) return rp[c] * r;
    return (rp[1536 + (c - 1024)] * r) * sigmoid_f(rp[2048 + (c - 1024)] * r);
}
__device__ __forceinline__ float meta_val(const float* MJ, const float*, int p, int col) { return MJ[p * PDIM + col]; }
__device__ __forceinline__ float proj_at(const bf16* PROJ, const float* MP, const float* MR, int b, int pos, int col) {
    if (pos < 0) return 0.f;
    if (pos < NMETA) return meta_val(MP, MR, pos, col);
    return bf2f(PROJ[(size_t)(b * SEQ + pos - NMETA) * PDIM + col]);
}
struct TabRow { f32x4 v[4]; };
__device__ __forceinline__ void tab_load(const Params& P, int e, int lane, TabRow& r) {
    const bool isv = e >= 16384; const int ee = isv ? e - 16384 : e;
    const f32x4* src = (const f32x4*)((isv ? P.pv : P.pu) + (size_t)ee * DM);
#pragma unroll
    for (int j = 0; j < 4; ++j) r.v[j] = isv ? src[4 * lane + j] : src[64 * j + lane];
}
__device__ __forceinline__ void tab_finish(const Params& P, int e, int lane, TabRow& r) {
    unsigned char* ws = P.ws; float* ESC = (float*)(ws + WS_ESCALE);
    const bool isv = e >= 16384; const int ee = isv ? e - 16384 : e;
    float mx = 0.f;
#pragma unroll
    for (int j = 0; j < 4; ++j) { if (!isv) r.v[j] = r.v[j] * ((const f32x4*)P.g_ffn)[64 * j + lane];
        mx = fmaxf(mx, fmaxf(fmaxf(fabsf(r.v[j].x), fabsf(r.v[j].y)), fmaxf(fabsf(r.v[j].z), fabsf(r.v[j].w)))); }
    mx = wave_max_fast(mx);
    if (!isv) {
        float sq2 = 0.f;
#pragma unroll
        for (int j = 0; j < 4; ++j) sq2 += (r.v[j].x * r.v[j].x + r.v[j].y * r.v[j].y) + (r.v[j].z * r.v[j].z + r.v[j].w * r.v[j].w);
        const float rms = sqrtf(wave_sum_fast(sq2) * (1.f / DM));
        const float su = fmaxf(fminf(mx, U4_CLIP * rms), 1e-30f) * (1.f / 7.f), inv = 1.f / su;
        unsigned wq[2] = {0u, 0u}; int csum = 0;
#pragma unroll
        for (int j = 0; j < 4; ++j) { const float e4[4] = {r.v[j].x, r.v[j].y, r.v[j].z, r.v[j].w};
#pragma unroll
            for (int i = 0; i < 4; ++i) { int c = (int)rintf(fminf(fmaxf(e4[i] * inv, -7.f), 7.f)); csum += c;
                wq[j >> 1] |= ((unsigned)c & 15u) << (16 * (j & 1) + 4 * i); } }
        const float cs = wave_sum_fast((float)csum);
        if (lane == 0) { ESC[e] = su; ((float*)(ws + WS_SUMQ))[e] = cs; }
        u32x2 o; o.x = wq[0]; o.y = wq[1];
        *(u32x2*)(ws + WS_U8 + (size_t)ee * 512 + 8 * lane) = o;
        return;
    }
    const float sc = fmaxf(mx, 1e-30f) * (1.f / 6.f), inv = 1.f / sc;
    if (lane == 0) ESC[e] = sc;
    unsigned w0 = 0u, w1 = 0u;
    w0 = __builtin_amdgcn_cvt_scalef32_pk_fp4_f32(w0, r.v[0].x * inv, r.v[0].y * inv, 1.0f, 0); w0 = __builtin_amdgcn_cvt_scalef32_pk_fp4_f32(w0, r.v[0].z * inv, r.v[0].w * inv, 1.0f, 1);
    w0 = __builtin_amdgcn_cvt_scalef32_pk_fp4_f32(w0, r.v[1].x * inv, r.v[1].y * inv, 1.0f, 2); w0 = __builtin_amdgcn_cvt_scalef32_pk_fp4_f32(w0, r.v[1].z * inv, r.v[1].w * inv, 1.0f, 3);
    w1 = __builtin_amdgcn_cvt_scalef32_pk_fp4_f32(w1, r.v[2].x * inv, r.v[2].y * inv, 1.0f, 0); w1 = __builtin_amdgcn_cvt_scalef32_pk_fp4_f32(w1, r.v[2].z * inv, r.v[2].w * inv, 1.0f, 1);
    w1 = __builtin_amdgcn_cvt_scalef32_pk_fp4_f32(w1, r.v[3].x * inv, r.v[3].y * inv, 1.0f, 2); w1 = __builtin_amdgcn_cvt_scalef32_pk_fp4_f32(w1, r.v[3].z * inv, r.v[3].w * inv, 1.0f, 3);
    u32x2 o; o.x = w0; o.y = w1;
    *(u32x2*)(ws + WS_V8 + (size_t)ee * 512 + 8 * lane) = o;
}
__device__ __forceinline__ void proj8_at(const bf16* PROJ, const float* MP, const float* MR, int b, int pos, int col, float (&v)[8]) {
    if (pos < 0) {
#pragma unroll
        for (int i = 0; i < 8; ++i) v[i] = 0.f;
    } else if (pos < NMETA) {
#pragma unroll
        for (int i = 0; i < 8; ++i) v[i] = metaval(MP, MR, pos, col + i);
    } else {
        const u32x4 w = *(const u32x4*)(PROJ + (size_t)(b * SEQ + pos - NMETA) * PDIM + col);
        v[0] = bflo(w.x); v[1] = bfhi(w.x); v[2] = bflo(w.y); v[3] = bfhi(w.y); v[4] = bflo(w.z); v[5] = bfhi(w.z); v[6] = bflo(w.w); v[7] = bfhi(w.w);
    }
}

template <int R> __device__ __forceinline__ void conv_rows(const LAS unsigned char* ubase, const f32x2 (&wcf)[31], f32x2 (&acc)[32]) {
    if constexpr (R < 62) {
        const unsigned uw = *(const LAS unsigned*)(ubase + R * 1024);
        const f32x2 x = (f32x2){bflo(uw), bfhi(uw)};
        constexpr int lo = R > 30 ? R - 30 : 0, hi = R < 31 ? R : 31;
#pragma unroll
        for (int ii = lo; ii <= hi; ++ii) acc[ii] += wcf[R - ii] * x;
        conv_rows<R + 1>(ubase, wcf, acc);
    }
}
__device__ __forceinline__ void phase_conv(const Params& P, LAS unsigned char* lds) {
    const int tid = threadIdx.x, lane = tid & 63, wave = __builtin_amdgcn_readfirstlane(tid >> 6);
    unsigned char* ws = P.ws;
    const bf16* PROJ = (const bf16*)(ws + WS_PROJ); const float* MP = (const float*)(ws + WS_CTL + WS_METARAW); const float* MR = (const float*)(ws + WS_METARSTD);
    bf16* Y = (bf16*)(ws + WS_Y);
    constexpr int TT = 64, NTILE = NTOK / TT, UROWS = TT + 30;
    const int cgp = wave & 3, th = wave >> 2, ch2 = cgp * 128 + 2 * lane;
    f32x2 wcf[31];
#pragma unroll
    for (int j = 0; j < 31; ++j) wcf[j] = *(const f32x2*)(P.cf_w + j * 512 + ch2);
    const f32x2 bcf = *(const f32x2*)(P.cf_b + ch2);
    for (int tile = blockIdx.x; tile < NTILE; tile += gridDim.x) {
        const int b = tile / (SEQ / TT), s0 = (tile % (SEQ / TT)) * TT;
        if (s0 >= 30) {
            const bf16* pr = PROJ + ((size_t)b * SEQ + s0 - 30) * PDIM + 1024 + 8 * lane;
            u32x4 rw[(UROWS + 7) / 8];
#pragma unroll
            for (int p = 0; p < (UROWS + 7) / 8; ++p) { const int r = p * 8 + wave; rw[p] = *(const u32x4*)(pr + (size_t)(r < UROWS ? r : UROWS - 1) * PDIM); }
#pragma unroll
            for (int p = 0; p < (UROWS + 7) / 8; ++p) { const int r = p * 8 + wave; if (r < UROWS) *(LAS u32x4*)(lds + r * 1024 + lane * 16) = rw[p]; }
        } else {
#pragma unroll 4
        for (int p = 0; p < (UROWS + 7) / 8; ++p) {
            const int r = p * 8 + wave;
            if (r < UROWS) {
                const int pos = NMETA + s0 - 30 + r;
                float uu[8];
                proj8_at(PROJ, MP, MR, b, pos, 1024 + 8 * lane, uu);
                u32x4 w; w.x = pk2(uu[0], uu[1]); w.y = pk2(uu[2], uu[3]); w.z = pk2(uu[4], uu[5]); w.w = pk2(uu[6], uu[7]);
                *(LAS u32x4*)(lds + r * 1024 + lane * 16) = w;
            }
        }
        }
        __syncthreads();
        f32x2 acc[32];
#pragma unroll
        for (int ii = 0; ii < 32; ++ii) acc[ii] = bcf;
        conv_rows<0>(lds + (32 * th) * 1024 + ch2 * 2, wcf, acc);
        u32x4 rcx[8], rbg[8];
        { const bf16* pr = PROJ + ((size_t)b * SEQ + s0 + 8 * wave) * PDIM + 8 * lane;
#pragma unroll
          for (int q = 0; q < 8; ++q) { rcx[q] = *(const u32x4*)(pr + (size_t)q * PDIM); rbg[q] = *(const u32x4*)(pr + (size_t)q * PDIM + 512); } }
        __syncthreads();
#pragma unroll
        for (int ii = 0; ii < 32; ++ii) *(LAS f32x2*)(lds + (32 * th + ii) * 2048 + ch2 * 4) = acc[ii];
        __syncthreads();
        {
            float lng[8], lnb[8];
            { const f32x4 a = *(const f32x4*)(P.ln_g + 8 * lane), c = *(const f32x4*)(P.ln_g + 8 * lane + 4), d = *(const f32x4*)(P.ln_b + 8 * lane), e = *(const f32x4*)(P.ln_b + 8 * lane + 4);
              lng[0] = a.x; lng[1] = a.y; lng[2] = a.z; lng[3] = a.w; lng[4] = c.x; lng[5] = c.y; lng[6] = c.z; lng[7] = c.w;
              lnb[0] = d.x; lnb[1] = d.y; lnb[2] = d.z; lnb[3] = d.w; lnb[4] = e.x; lnb[5] = e.y; lnb[6] = e.z; lnb[7] = e.w; }
            float wsc[3][8];
#pragma unroll
            for (int j = 0; j < 3; ++j) { const f32x4 a = *(const f32x4*)(P.sc_w + j * 512 + 8 * lane), c = *(const f32x4*)(P.sc_w + j * 512 + 8 * lane + 4);
                wsc[j][0] = a.x; wsc[j][1] = a.y; wsc[j][2] = a.z; wsc[j][3] = a.w; wsc[j][4] = c.x; wsc[j][5] = c.y; wsc[j][6] = c.z; wsc[j][7] = c.w; }
            float cxa[8], cxb[8];
            { const int pos = NMETA + s0 + 8 * wave - 2;
              proj8_at(PROJ, MP, MR, b, pos, 8 * lane, cxa); proj8_at(PROJ, MP, MR, b, pos + 1, 8 * lane, cxb); }
#pragma unroll
            for (int q = 0; q < 8; ++q) {
                const int ii = 8 * wave + q, s = s0 + ii; const size_t t = (size_t)b * SEQ + s;
                float o[8];
                { const f32x4 a = *(const LAS f32x4*)(lds + ii * 2048 + lane * 32), c = *(const LAS f32x4*)(lds + ii * 2048 + lane * 32 + 16);
                  o[0] = a.x; o[1] = a.y; o[2] = a.z; o[3] = a.w; o[4] = c.x; o[5] = c.y; o[6] = c.z; o[7] = c.w; }
                float s1 = 0.f;
#pragma unroll
                for (int i = 0; i < 8; ++i) s1 += o[i];
                const float mean = wave_sum_fast(s1) * (1.f / 512.f);
                float s2 = 0.f;
#pragma unroll
                for (int i = 0; i < 8; ++i) { o[i] -= mean; s2 += o[i] * o[i]; }
                const float rs = __builtin_amdgcn_rsqf(wave_sum_fast(s2) * (1.f / 512.f) + EPS);
                float s3 = 0.f;
#pragma unroll
                for (int i = 0; i < 8; ++i) { float y = o[i] * rs * lng[i] + lnb[i]; y = y * sigmoid_f(y); o[i] = y; s3 += y * y; }
                const float r2 = __builtin_amdgcn_rsqf(wave_sum_fast(s3) * (1.f / 512.f) + EPS);
                float bgv[8], cxc[8], accs[8];
                { const u32x4 w = rcx[q], z = rbg[q];
                  cxc[0] = bflo(w.x); cxc[1] = bfhi(w.x); cxc[2] = bflo(w.y); cxc[3] = bfhi(w.y); cxc[4] = bflo(w.z); cxc[5] = bfhi(w.z); cxc[6] = bflo(w.w); cxc[7] = bfhi(w.w);
                  bgv[0] = bflo(z.x); bgv[1] = bfhi(z.x); bgv[2] = bflo(z.y); bgv[3] = bfhi(z.y); bgv[4] = bflo(z.z); bgv[5] = bfhi(z.z); bgv[6] = bflo(z.w); bgv[7] = bfhi(z.w); }
                float s4 = 0.f;
#pragma unroll
                for (int i = 0; i < 8; ++i) { accs[i] = bgv[i] * (wsc[0][i] * cxa[i] + wsc[1][i] * cxb[i] + wsc[2][i] * cxc[i]); s4 += accs[i] * accs[i]; cxa[i] = cxb[i]; cxb[i] = cxc[i]; }
                const float r4 = __builtin_amdgcn_rsqf(wave_sum_fast(s4) * (1.f / 512.f) + EPS);
                float ym = 0.f;
#pragma unroll
                for (int i = 0; i < 8; ++i) { o[i] *= r2; accs[i] *= r4; ym = fmaxf(ym, fmaxf(fabsf(o[i]), fabsf(accs[i]))); }
                ym = fmaxf(wave_max_fast(ym), 1e-30f);
                const float yinv = 127.f * __builtin_amdgcn_rcpf(ym);
                if (lane == 0) ((float*)(ws + WS_SY))[t] = ym * (1.f / 127.f);
                u32x2 wz, wv;
                { unsigned fa[8], fo[8];
#pragma unroll
                  for (int i = 0; i < 8; ++i) { fa[i] = __float_as_uint(fmaf(accs[i], yinv, 12582912.f)); fo[i] = __float_as_uint(fmaf(o[i], yinv, 12582912.f)); }
                  wz.x = __builtin_amdgcn_perm(fa[1], fa[0], 0x0c0c0400u) | __builtin_amdgcn_perm(fa[3], fa[2], 0x04000c0cu);
                  wz.y = __builtin_amdgcn_perm(fa[5], fa[4], 0x0c0c0400u) | __builtin_amdgcn_perm(fa[7], fa[6], 0x04000c0cu);
                  wv.x = __builtin_amdgcn_perm(fo[1], fo[0], 0x0c0c0400u) | __builtin_amdgcn_perm(fo[3], fo[2], 0x04000c0cu);
                  wv.y = __builtin_amdgcn_perm(fo[5], fo[4], 0x0c0c0400u) | __builtin_amdgcn_perm(fo[7], fo[6], 0x04000c0cu); }
                *(u32x2*)(ws + WS_Y + t * DM + 8 * lane) = wz;
                *(u32x2*)(ws + WS_Y + t * DM + 512 + 8 * lane) = wv;
            }
        }
        __syncthreads();
    }
}

__device__ __forceinline__ int ord_i(float s) { int k = __builtin_bit_cast(int, s); k ^= (k >> 31) & 0x7fffffff; return k; }
__device__ __forceinline__ float unord_f(int k) { k ^= (k >> 31) & 0x7fffffff; return __builtin_bit_cast(float, k); }
#define TOP_INSERT(L, x_) do { int _x = (x_); _Pragma("unroll") for (int _i = 0; _i < 16; ++_i) { const int _hi = max(L[_i], _x); _x = min(L[_i], _x); L[_i] = _hi; } } while (0)

typedef short bf16x8 __attribute__((ext_vector_type(8)));
typedef float f32x16 __attribute__((ext_vector_type(16)));
template <bool DESC> __device__ __forceinline__ void ce_i(int& a, int& b) { const int hi = max(a, b), lo = min(a, b); if (DESC) { a = hi; b = lo; } else { a = lo; b = hi; } }
__device__ __forceinline__ void bitonic_sort16(int (&a)[16]) {
#pragma unroll
    for (int k = 2; k <= 16; k <<= 1)
#pragma unroll
        for (int j = k >> 1; j > 0; j >>= 1)
#pragma unroll
            for (int i = 0; i < 16; ++i) { const int l = i ^ j; if (l > i) { if ((i & k) == 0) ce_i<true>(a[i], a[l]); else ce_i<false>(a[i], a[l]); } }
}
__device__ __forceinline__ void bitonic_merge16(int (&a)[16]) {
#pragma unroll
    for (int j = 8; j > 0; j >>= 1)
#pragma unroll
        for (int i = 0; i < 16; ++i) { const int l = i ^ j; if (l > i) ce_i<true>(a[i], a[l]); }
}
__device__ __forceinline__ void merge_top16(int (&a)[16], const int (&b)[16]) {
#pragma unroll
    for (int i = 0; i < 16; ++i) a[i] = max(a[i], b[15 - i]);
    bitonic_merge16(a);
}
__device__ __forceinline__ int lut16(const unsigned (&T)[4], int i) {
    const unsigned sel = (unsigned)(i & 7) | 0x0c0c0c00u;
    const unsigned lo = __builtin_amdgcn_perm(T[1], T[0], sel), hi = __builtin_amdgcn_perm(T[3], T[2], sel);
    return (int)((i & 8) ? hi : lo);
}
constexpr int KROW = 272;
constexpr float SCORE_BIAS = 8.0f;

__device__ __forceinline__ void route_load_q(bf16x8 (&qf)[8], const bf16* qrow, int hb) {
#pragma unroll
    for (int ks = 0; ks < 8; ++ks) qf[ks] = *(const bf16x8*)(qrow + 64 * hb + 8 * ks);
}
__device__ __forceinline__ void route_half(const LAS unsigned char* kl, const bf16x8 (&qf)[8], int nl, int hb, int (&L)[16]) {
    f32x16 acc[4];
#pragma unroll
    for (int nt = 0; nt < 4; ++nt)
#pragma unroll
        for (int r = 0; r < 16; ++r) acc[nt][r] = SCORE_BIAS;
#pragma unroll
    for (int ks = 0; ks < 8; ++ks)
#pragma unroll
        for (int nt = 0; nt < 4; ++nt) {
            const bf16x8 a = *(const LAS bf16x8*)(kl + (32 * nt + nl) * KROW + (64 * hb + 8 * ks) * 2);
            acc[nt] = __builtin_amdgcn_mfma_f32_32x32x16_bf16(a, qf[ks], acc[nt], 0, 0, 0);
        }
    const int hb4 = 4 * hb;
    int T[4][16];
#pragma unroll
    for (int nt = 0; nt < 4; ++nt)
#pragma unroll
        for (int r = 0; r < 16; ++r) { const int n0 = 32 * nt + (r & 3) + 8 * (r >> 2); const float sc = acc[nt][r];
            T[nt][r] = (__float_as_int(sc) & ~127) | ((127 - n0) - hb4); }
    bitonic_sort16(T[0]); bitonic_sort16(T[1]); bitonic_sort16(T[2]); bitonic_sort16(T[3]);
    merge_top16(T[0], T[1]); merge_top16(T[2], T[3]); merge_top16(T[0], T[2]);
#pragma unroll
    for (int i = 0; i < 16; ++i) { const unsigned v = (unsigned)T[0][15 - i]; auto r = __builtin_amdgcn_permlane32_swap(v, v, false, false);
        const unsigned r0 = r[0], r1 = r[1]; const int partner = (int)(hb ? r0 : r1); L[i] = max(T[0][i], partner); }
    bitonic_merge16(L);
}

__device__ __forceinline__ void phase_route(const Params& P, LAS unsigned char* lds) {
    const int tid = threadIdx.x, lane = tid & 63, wave = __builtin_amdgcn_readfirstlane(tid >> 6);
    const int nl = lane & 31, hb = lane >> 5;
    unsigned char* ws = P.ws;
    const bf16* KEYS = (const bf16*)(ws + WS_KEYS); const bf16* Q = (const bf16*)(ws + WS_Q);
    int* IDX = (int*)(ws + WS_IDX); float* GATE = (float*)(ws + WS_GATE);
    int last_h = -1;
    pg8::StaticOrder S; S.init(NTOK, 2048, (int)gridDim.x, (int)blockIdx.x);
    pg8::Unit ucur, unxt;
    bool have = S.next(0, ucur);
    bf16x8 qfA[8], qfB[8];
    if (have) route_load_q(qfA, Q + ((size_t)ucur.pm * 256 + wave * 32 + nl) * 2048 + ucur.pn * 256, hb);
    for (int ui = 0; have; ++ui) {
        const int h = ucur.pn, tb = ucur.pm;
        const bool have_next = S.next(ui + 1, unxt);
        if (h != last_h) {
            __syncthreads();
            for (int c = tid; c < 4096; c += NTHREADS) { const u32x4 v = ((const u32x4*)(KEYS + (size_t)h * 32768))[c];
                *(LAS u32x4*)(lds + (c >> 4) * KROW + (c & 15) * 16) = v; }
            __syncthreads();
            last_h = h;
        }
        const size_t t = (size_t)tb * 256 + wave * 32 + nl;
        int L1[16], L2[16];
        route_load_q(qfB, Q + t * 2048 + h * 256 + 128, hb);
        route_half(lds, qfA, nl, hb, L1);
        if (have_next) route_load_q(qfA, Q + ((size_t)unxt.pm * 256 + wave * 32 + nl) * 2048 + unxt.pn * 256, hb);
        route_half(lds + 128 * KROW, qfB, nl, hb, L2);
        float v1[16], v2[16];
#pragma unroll
        for (int i = 0; i < 16; ++i) { v1[i] = __int_as_float(L1[i] & ~127); v2[i] = __int_as_float(L2[i] & ~127); }
#define CAND(i, j) ((__float_as_int(v1[i] + v2[j]) & ~255) | (255 - (16 * (i) + (j))))
        int A[16], B[16], C[16];
#pragma unroll
        for (int j = 0; j < 16; ++j) A[j] = CAND(0, j);
#pragma unroll
        for (int j = 0; j < 8; ++j) { B[j] = CAND(1, j); B[8 + j] = CAND(15 - j, 0); }
        bitonic_merge16(B);
        C[0] = CAND(2, 0); C[1] = CAND(2, 1); C[2] = CAND(2, 2); C[3] = CAND(2, 3); C[4] = CAND(2, 4);
        C[5] = CAND(3, 0); C[6] = CAND(3, 1); C[7] = CAND(3, 2); C[8] = CAND(3, 3);
        C[9] = CAND(4, 0); C[10] = CAND(4, 1); C[11] = CAND(4, 2);
        C[12] = CAND(5, 0); C[13] = CAND(5, 1); C[14] = CAND(6, 0); C[15] = CAND(6, 1);
        bitonic_sort16(C);
        { const int d0 = CAND(7, 0), d1 = CAND(7, 1); C[14] = max(C[14], d1); C[15] = max(C[15], d0); bitonic_merge16(C); }
#undef CAND
        merge_top16(A, B); merge_top16(A, C);
        unsigned T1[4], T2[4];
#pragma unroll
        for (int q = 0; q < 4; ++q) {
            T1[q] = (unsigned)(127 - (L1[4 * q] & 127)) | ((unsigned)(127 - (L1[4 * q + 1] & 127)) << 8) | ((unsigned)(127 - (L1[4 * q + 2] & 127)) << 16) | ((unsigned)(127 - (L1[4 * q + 3] & 127)) << 24);
            T2[q] = (unsigned)(127 - (L2[4 * q] & 127)) | ((unsigned)(127 - (L2[4 * q + 1] & 127)) << 8) | ((unsigned)(127 - (L2[4 * q + 2] & 127)) << 16) | ((unsigned)(127 - (L2[4 * q + 3] & 127)) << 24); }
        float val[16]; int ex[16];
#pragma unroll
        for (int k = 0; k < 16; ++k) { const int pos = 255 - (A[k] & 255); val[k] = __int_as_float(A[k] & ~255);
            ex[k] = lut16(T1, pos >> 4) * NKEYS + lut16(T2, pos & 15); }
        float sum = 0.f; const float vmax = val[0];
#pragma unroll
        for (int k = 0; k < 16; ++k) { val[k] = __expf(val[k] - vmax); sum += val[k]; }
        const float inv = __builtin_amdgcn_rcpf(sum);
        if (hb == 0) {
            int* ip = IDX + t * NSEL + h * TOPK; float* gp = GATE + t * NSEL + h * TOPK;
#pragma unroll
            for (int k4 = 0; k4 < 4; ++k4) {
                *(int4*)(ip + 4 * k4) = make_int4(ex[4 * k4], ex[4 * k4 + 1], ex[4 * k4 + 2], ex[4 * k4 + 3]);
                *(f32x4*)(gp + 4 * k4) = (f32x4){val[4 * k4] * inv, val[4 * k4 + 1] * inv, val[4 * k4 + 2] * inv, val[4 * k4 + 3] * inv};
            }
        }
        ucur = unxt; have = have_next;
    }
}

#define FP4X2(w, sel) __builtin_amdgcn_cvt_scalef32_pk_f32_fp4((w), 1.0f, (sel))
__device__ __forceinline__ float dot16_fp4(const u32x2 r, const f32x4 (&xs)[4]) {
    float p = 0.f;
    { const f32x2 a = FP4X2(r.x, 0), b = FP4X2(r.x, 1), c = FP4X2(r.x, 2), d = FP4X2(r.x, 3);
      p += (a.x * xs[0].x + a.y * xs[0].y) + (b.x * xs[0].z + b.y * xs[0].w); p += (c.x * xs[1].x + c.y * xs[1].y) + (d.x * xs[1].z + d.y * xs[1].w); }
    { const f32x2 a = FP4X2(r.y, 0), b = FP4X2(r.y, 1), c = FP4X2(r.y, 2), d = FP4X2(r.y, 3);
      p += (a.x * xs[2].x + a.y * xs[2].y) + (b.x * xs[2].z + b.y * xs[2].w); p += (c.x * xs[3].x + c.y * xs[3].y) + (d.x * xs[3].z + d.y * xs[3].w); }
    return p;
}
__device__ __forceinline__ void axpy16_fp4(const u32x2 r, float w, f32x4 (&o)[4]) {
    { const f32x2 a = FP4X2(r.x, 0), b = FP4X2(r.x, 1), c = FP4X2(r.x, 2), d = FP4X2(r.x, 3);
      o[0].x += w * a.x; o[0].y += w * a.y; o[0].z += w * b.x; o[0].w += w * b.y; o[1].x += w * c.x; o[1].y += w * c.y; o[1].z += w * d.x; o[1].w += w * d.y; }
    { const f32x2 a = FP4X2(r.y, 0), b = FP4X2(r.y, 1), c = FP4X2(r.y, 2), d = FP4X2(r.y, 3);
      o[2].x += w * a.x; o[2].y += w * a.y; o[2].z += w * b.x; o[2].w += w * b.y; o[3].x += w * c.x; o[3].y += w * c.y; o[3].z += w * d.x; o[3].w += w * d.y; }
}
__device__ __forceinline__ float swap32_add(float a, float b) { auto r = __builtin_amdgcn_permlane32_swap(__float_as_uint(a), __float_as_uint(b), false, false); return __uint_as_float(r[0]) + __uint_as_float(r[1]); }
__device__ __forceinline__ float swap16_add(float a, float b) { auto r = __builtin_amdgcn_permlane16_swap(__float_as_uint(a), __float_as_uint(b), false, false); return __uint_as_float(r[0]) + __uint_as_float(r[1]); }
__device__ __forceinline__ float row_sum16(float v) { v += dpp_f<0xB1>(v); v += dpp_f<0x4E>(v); v += dpp_f<0x141>(v); v += dpp_f<0x140>(v); return v; }
__device__ __forceinline__ float row_max16(float v) { v = fmaxf(v, dpp_f<0xB1>(v)); v = fmaxf(v, dpp_f<0x4E>(v)); v = fmaxf(v, dpp_f<0x141>(v)); v = fmaxf(v, dpp_f<0x140>(v)); return v; }
constexpr int GB = 32;
typedef __attribute__((address_space(8))) void* rsrc_t;
__device__ __forceinline__ void g_issue(u32x2 (&buf)[GB], __amdgpu_buffer_rsrc_t rs, int idxr, int lb, int voff) {
#pragma unroll
    for (int j = 0; j < GB; ++j) { const int e = __builtin_amdgcn_readlane(idxr, lb + j); buf[j] = __builtin_amdgcn_raw_buffer_load_b64(rs, voff, e * 512, 0); }
}
__device__ __forceinline__ float dot16_fp4p(const u32x2 r, const f32x2 (&xp)[8]) {
    f32x2 a = FP4X2(r.x, 0) * xp[0];
    a += FP4X2(r.x, 1) * xp[1]; a += FP4X2(r.x, 2) * xp[2]; a += FP4X2(r.x, 3) * xp[3];
    a += FP4X2(r.y, 0) * xp[4]; a += FP4X2(r.y, 1) * xp[5]; a += FP4X2(r.y, 2) * xp[6]; a += FP4X2(r.y, 3) * xp[7];
    return a.x + a.y;
}
__device__ __forceinline__ void axpy16_fp4p(const u32x2 r, float w, f32x2 (&o)[8]) {
    const f32x2 ww = (f32x2){w, w};
    o[0] += FP4X2(r.x, 0) * ww; o[1] += FP4X2(r.x, 1) * ww; o[2] += FP4X2(r.x, 2) * ww; o[3] += FP4X2(r.x, 3) * ww;
    o[4] += FP4X2(r.y, 0) * ww; o[5] += FP4X2(r.y, 1) * ww; o[6] += FP4X2(r.y, 2) * ww; o[7] += FP4X2(r.y, 3) * ww;
}
template <int H> __device__ __forceinline__ void g_compute_u(const u32x2 (&buf)[GB], int q, int i16, const f32x2 (&xp)[8], float& zlo, float& zhi) {
    float p[16];
#pragma unroll
    for (int j = 0; j < 16; ++j) p[j] = dot16_fp4p(buf[16 * H + j], xp);
    float s1[8], s2[4];
#pragma unroll
    for (int m = 0; m < 8; ++m) s1[m] = swap32_add(p[2 * m], p[2 * m + 1]);
#pragma unroll
    for (int n = 0; n < 4; ++n) s2[n] = swap16_add(s1[2 * n], s1[2 * n + 1]);
#pragma unroll
    for (int r = 0; r < 4; ++r) { const float z = row_sum16(s2[r]); const bool mine = i16 == ((4 * q + r) & 15);
        zlo = (mine && q < 4) ? z : zlo; zhi = (mine && q >= 4) ? z : zhi; }
}
template <int H> __device__ __forceinline__ void g_compute_v(const u32x2 (&buf)[GB], int q, float alo, float ahi, f32x2 (&o)[8]) {
    const int areg = __builtin_bit_cast(int, (q < 4) ? alo : ahi), sb = 4 * (q & 3);
#pragma unroll
    for (int j = 0; j < 16; ++j) { const int src = 32 * (j & 1) + 16 * ((j >> 1) & 1) + (j >> 2) + sb;
        const float w = __builtin_bit_cast(float, __builtin_amdgcn_readlane(areg, src));
        axpy16_fp4p(buf[16 * H + j], w, o); }
}
__device__ __forceinline__ void q_issue(u32x2 (&buf)[16], __amdgpu_buffer_rsrc_t rs, int ixr  , int lb, int voff) {
#pragma unroll
    for (int j = 0; j < 16; ++j) { const int e9 = __builtin_amdgcn_readlane(ixr, lb + j); buf[j] = __builtin_amdgcn_raw_buffer_load_b64(rs, voff, e9, 0); }
}
__device__ __forceinline__ void q_compute_u(const u32x2 (&buf)[16], int q, int i16, const f32x2 (&xp)[8], float& zlo, float& zhi) {
    float p[16];
#pragma unroll
    for (int j = 0; j < 16; ++j) p[j] = dot16_fp4p(buf[j], xp);
    float s1[8], s2[4];
#pragma unroll
    for (int m = 0; m < 8; ++m) s1[m] = swap32_add(p[2 * m], p[2 * m + 1]);
#pragma unroll
    for (int n = 0; n < 4; ++n) s2[n] = swap16_add(s1[2 * n], s1[2 * n + 1]);
#pragma unroll
    for (int r = 0; r < 4; ++r) { const float z = row_sum16(s2[r]); const bool mine = i16 == ((4 * q + r) & 15);
        zlo = (mine && q < 4) ? z : zlo; zhi = (mine && q >= 4) ? z : zhi; }
}
typedef _Float16 h16x2 __attribute__((ext_vector_type(2)));
#define FP4H2(w, sel) __builtin_amdgcn_cvt_scalef32_pk_f16_fp4((w), 1.0f, (sel))
__device__ __forceinline__ void axpy16_fp4h(const u32x2 r, const h16x2 ww, h16x2 (&o)[8]) {
    o[0] += FP4H2(r.x, 0) * ww; o[1] += FP4H2(r.x, 1) * ww; o[2] += FP4H2(r.x, 2) * ww; o[3] += FP4H2(r.x, 3) * ww;
    o[4] += FP4H2(r.y, 0) * ww; o[5] += FP4H2(r.y, 1) * ww; o[6] += FP4H2(r.y, 2) * ww; o[7] += FP4H2(r.y, 3) * ww;
}
__device__ __forceinline__ void q_compute_vh(const u32x2 (&buf)[16], int q, int alo, int ahi, h16x2 (&o)[8]) {
    const int areg = (q < 4) ? alo : ahi, sb = 4 * (q & 3);
#pragma unroll
    for (int j = 0; j < 16; ++j) { const int src = 32 * (j & 1) + 16 * ((j >> 1) & 1) + (j >> 2) + sb;
        const h16x2 w = __builtin_bit_cast(h16x2, __builtin_amdgcn_readlane(areg, src));
        axpy16_fp4h(buf[j], w, o); }
}
__device__ __forceinline__ void q_compute_v(const u32x2 (&buf)[16], int q, float alo, float ahi, f32x2 (&o)[8]) {
    const int areg = __builtin_bit_cast(int, (q < 4) ? alo : ahi), sb = 4 * (q & 3);
#pragma unroll
    for (int j = 0; j < 16; ++j) { const int src = 32 * (j & 1) + 16 * ((j >> 1) & 1) + (j >> 2) + sb;
        const float w = __builtin_bit_cast(float, __builtin_amdgcn_readlane(areg, src));
        axpy16_fp4p(buf[j], w, o); }
}
__device__ __forceinline__ int swap32_addi(int a, int b) { auto r = __builtin_amdgcn_permlane32_swap((unsigned)a, (unsigned)b, false, false); const unsigned r0 = r[0], r1 = r[1]; return (int)(r0 + r1); }
__device__ __forceinline__ int swap16_addi(int a, int b) { auto r = __builtin_amdgcn_permlane16_swap((unsigned)a, (unsigned)b, false, false); const unsigned r0 = r[0], r1 = r[1]; return (int)(r0 + r1); }
template <int CTRL> __device__ __forceinline__ int dpp_i(int v) { return __builtin_amdgcn_update_dpp(0, v, CTRL, 0xf, 0xf, true); }
__device__ __forceinline__ int row_sum16i(int v) { v += dpp_i<0xB1>(v); v += dpp_i<0x4E>(v); v += dpp_i<0x141>(v); v += dpp_i<0x140>(v); return v; }
__device__ __forceinline__ void q_compute_ui(const u32x2 (&buf)[16], int q, int i16, int xh0, int xh1, int xl0, int xl1, int& zlo, int& zhi) {
    int p[16];
#pragma unroll
    for (int j = 0; j < 16; ++j) { const int d1 = __builtin_amdgcn_sdot8((int)buf[j].x, xh0, __builtin_amdgcn_sdot8((int)buf[j].y, xh1, 0, false), false);
        const int d2 = __builtin_amdgcn_sdot8((int)buf[j].x, xl0, __builtin_amdgcn_sdot8((int)buf[j].y, xl1, 0, false), false);
        p[j] = (d1 << 4) + d2; }
    int s1[8], s2[4];
#pragma unroll
    for (int m = 0; m < 8; ++m) s1[m] = swap32_addi(p[2 * m], p[2 * m + 1]);
#pragma unroll
    for (int n = 0; n < 4; ++n) s2[n] = swap16_addi(s1[2 * n], s1[2 * n + 1]);
#pragma unroll
    for (int r = 0; r < 4; ++r) { const int z = row_sum16i(s2[r]); const bool mine = i16 == ((4 * q + r) & 15);
        zlo = (mine && q < 4) ? z : zlo; zhi = (mine && q >= 4) ? z : zhi; }
}
__device__ __forceinline__ void phase_gather_u(const Params& P) {
    const int tid = threadIdx.x, lane = tid & 63, wave = __builtin_amdgcn_readfirstlane(tid >> 6);
    const int gw = blockIdx.x * NWAVES + wave, NGW = gridDim.x * NWAVES;
    unsigned char* ws = P.ws;
    const int* IDX = (const int*)(ws + WS_IDX); const float* GATE = (const float*)(ws + WS_GATE); const float* ESC = (const float*)(ws + WS_ESCALE); float* AW = (float*)(ws + WS_AW);
    const __amdgpu_buffer_rsrc_t rsU = __builtin_amdgcn_make_buffer_rsrc((void*)(ws + WS_U8), 0, 16384 * 512, 0x00020000);
    const unsigned char* H2I = ws + WS_H0I8; const float* RF = (const float*)(ws + WS_RF);
    const int hh = lane >> 5, rr = (lane >> 4) & 1, i16 = lane & 15, gsel = 4 * i16 + 2 * rr + hh;
    const int voff = 8 * lane;
    const unsigned ul = (unsigned)lane;
    int t = gw;
    if (t < NTOK) {
        int idx0, idx1; unsigned hraw[4]; float sqv;
        { const int* ip = IDX + (size_t)t * NSEL; idx0 = ip[ul]; idx1 = ip[64u + ul];
          const unsigned* hp = (const unsigned*)(H2I + (size_t)t * DM);
#pragma unroll
          for (int j = 0; j < 4; ++j) hraw[j] = hp[64u * j + ul];
          sqv = RF[t]; }
        u32x2 R0[16], R1[16], R2[16], R3[16];
        { const int ix0 = idx0 << 9; q_issue(R0, rsU, ix0, 0, voff); q_issue(R1, rsU, ix0, 16, voff); q_issue(R2, rsU, ix0, 32, voff); }
        for (;;) {
            const int tn = t + NGW; const bool has_next = tn < NTOK; const int tl = has_next ? tn : t;
            int idx0n, idx1n; unsigned hrawn[4]; float sqn, g0, g1;
            { const int* ip = IDX + (size_t)tl * NSEL; idx0n = ip[ul]; idx1n = ip[64u + ul];
              const unsigned* hp = (const unsigned*)(H2I + (size_t)tl * DM);
#pragma unroll
              for (int j = 0; j < 4; ++j) hrawn[j] = hp[64u * j + ul];
              sqn = RF[tl];
              const float* gp = GATE + (size_t)t * NSEL; g0 = gp[ul]; g1 = gp[64u + ul]; }
            const float su0 = ESC[idx0], su1 = ESC[idx1], sv0 = ESC[16384 + idx0], sv1 = ESC[16384 + idx1];
            const float cq0 = ((const float*)(ws + WS_SUMQ))[idx0], cq1 = ((const float*)(ws + WS_SUMQ))[idx1];
            unsigned xh[2] = {0u, 0u}, xl[2] = {0u, 0u};
#pragma unroll
            for (int j = 0; j < 4; ++j) {
                const unsigned lo4 = hraw[j] & 0x0f0f0f0fu, hi4 = (hraw[j] >> 4) & 0x0f0f0f0fu;
                const unsigned tl4 = (lo4 | (lo4 >> 4)) & 0x00ff00ffu, th4 = (hi4 | (hi4 >> 4)) & 0x00ff00ffu;
                const unsigned pl = ((tl4 | (tl4 >> 8)) & 0xffffu) ^ 0x8888u, ph = (th4 | (th4 >> 8)) & 0xffffu;
                xl[j >> 1] |= pl << (16 * (j & 1)); xh[j >> 1] |= ph << (16 * (j & 1)); }
            int zlo = 0, zhi = 0;
            const int ix0 = idx0 << 9, ix1 = idx1 << 9;
#pragma unroll 1
            for (int qq = 0; qq < 8; qq += 4) {
                const int ixn = qq ? (idx0n << 9) : ix1;
                q_issue(R3, rsU, qq ? ix1 : ix0, 48, voff);
                q_compute_ui(R0, qq, i16, (int)xh[0], (int)xh[1], (int)xl[0], (int)xl[1], zlo, zhi);
                q_issue(R0, rsU, ixn, 0, voff);
                q_compute_ui(R1, qq + 1, i16, (int)xh[0], (int)xh[1], (int)xl[0], (int)xl[1], zlo, zhi);
                q_issue(R1, rsU, ixn, 16, voff);
                q_compute_ui(R2, qq + 2, i16, (int)xh[0], (int)xh[1], (int)xl[0], (int)xl[1], zlo, zhi);
                q_issue(R2, rsU, ixn, 32, voff);
                q_compute_ui(R3, qq + 3, i16, (int)xh[0], (int)xh[1], (int)xl[0], (int)xl[1], zlo, zhi);
            }
            const float glo = __shfl(g0, gsel), ghi = __shfl(g1, gsel), sulo = __shfl(su0, gsel), suhi = __shfl(su1, gsel), svlo = __shfl(sv0, gsel), svhi = __shfl(sv1, gsel);
            const float cqlo = __shfl(cq0, gsel), cqhi = __shfl(cq1, gsel);
            const float zfl = ((float)zlo + 8.f * cqlo) * (sulo * sqv), zfh = ((float)zhi + 8.f * cqhi) * (suhi * sqv);
            const float wl = gelu_tanh_f(zfl) * glo * svlo, wh = gelu_tanh_f(zfh) * ghi * svhi;
            const float wmx = fmaxf(wave_max_fast(fmaxf(fabsf(wl), fabsf(wh))), 1e-30f), wsc = 256.f * __builtin_amdgcn_rcpf(wmx);
            { const float a = wl * wsc, c = wh * wsc;
              const int ah = __builtin_amdgcn_cvt_pk_fp8_f32(a, a, 0, false) & 255, ch = __builtin_amdgcn_cvt_pk_fp8_f32(c, c, 0, false) & 255;
              const float ar = a - __builtin_amdgcn_cvt_f32_fp8(ah, 0), cr = c - __builtin_amdgcn_cvt_f32_fp8(ch, 0);
              const int al = __builtin_amdgcn_cvt_pk_fp8_f32(ar, ar, 0, false) & 255, cl = __builtin_amdgcn_cvt_pk_fp8_f32(cr, cr, 0, false) & 255;
              unsigned char* ap = (unsigned char*)AW + (size_t)t * 256;
              ap[gsel] = (unsigned char)ah; ap[64 + gsel] = (unsigned char)ch; ap[128 + gsel] = (unsigned char)al; ap[192 + gsel] = (unsigned char)cl;
              if (lane == 0) ((float*)(ws + WS_WMX))[t] = wmx * (1.f / 256.f); }
            if (!has_next) break;
            t = tn; idx0 = idx0n; idx1 = idx1n; sqv = sqn;
#pragma unroll
            for (int j = 0; j < 4; ++j) hraw[j] = hrawn[j];
        }
    }
}
__device__ __forceinline__ void phase_gather_v(const Params& P) {
    const int tid = threadIdx.x, lane = tid & 63, wave = __builtin_amdgcn_readfirstlane(tid >> 6);
    const int gw = blockIdx.x * NWAVES + wave, NGW = gridDim.x * NWAVES;
    unsigned char* ws = P.ws;
    const int* IDX = (const int*)(ws + WS_IDX); const float* AW = (const float*)(ws + WS_AW);
    const __amdgpu_buffer_rsrc_t rsV = __builtin_amdgcn_make_buffer_rsrc((void*)(ws + WS_V8), 0, 16384 * 512, 0x00020000);
    const bf16* H2B = (const bf16*)(ws + WS_H2B);
    const int voff = 8 * lane;
    const unsigned ul = (unsigned)lane;
    int t = gw;
    if (t < NTOK) {
        int idx0, idx1; u32x2 hraw[4]; float alo, ahi;
        { const int* ip = IDX + (size_t)t * NSEL; idx0 = ip[ul]; idx1 = ip[64u + ul];
          const u32x2* hp = (const u32x2*)(H2B + (size_t)t * DM);
#pragma unroll
          for (int j = 0; j < 4; ++j) hraw[j] = hp[64u * j + ul];
          const float* ap = AW + (size_t)t * NSEL; alo = ap[ul]; ahi = ap[64u + ul]; }
        u32x2 R0[16], R1[16], R2[16], R3[16];
        { const int ix0 = idx0 << 9; q_issue(R0, rsV, ix0, 0, voff); q_issue(R1, rsV, ix0, 16, voff); q_issue(R2, rsV, ix0, 32, voff); }
        for (;;) {
            const int tn = t + NGW; const bool has_next = tn < NTOK; const int tl = has_next ? tn : t;
            int idx0n, idx1n; u32x2 hrawn[4]; float alon, ahin;
            { const int* ip = IDX + (size_t)tl * NSEL; idx0n = ip[ul]; idx1n = ip[64u + ul];
              const u32x2* hp = (const u32x2*)(H2B + (size_t)tl * DM);
#pragma unroll
              for (int j = 0; j < 4; ++j) hrawn[j] = hp[64u * j + ul];
              const float* ap = AW + (size_t)tl * NSEL; alon = ap[ul]; ahin = ap[64u + ul]; }
            const float wmx = fmaxf(wave_max_fast(fmaxf(fabsf(alo), fabsf(ahi))), 1e-30f), winv = 1.f / wmx;
            int alh, ahh;
            { const h16x2 a = (h16x2){(_Float16)(alo * winv), (_Float16)(alo * winv)}, b = (h16x2){(_Float16)(ahi * winv), (_Float16)(ahi * winv)};
              alh = __builtin_bit_cast(int, a); ahh = __builtin_bit_cast(int, b); }
            h16x2 oh[8];
#pragma unroll
            for (int j = 0; j < 8; ++j) oh[j] = (h16x2){(_Float16)0.f, (_Float16)0.f};
            const int ix0 = idx0 << 9, ix1 = idx1 << 9;
#pragma unroll 1
            for (int qq = 0; qq < 8; qq += 4) {
                const int ixn = qq ? (idx0n << 9) : ix1;
                q_issue(R3, rsV, qq ? ix1 : ix0, 48, voff);
                q_compute_vh(R0, qq, alh, ahh, oh);
                q_issue(R0, rsV, ixn, 0, voff);
                q_compute_vh(R1, qq + 1, alh, ahh, oh);
                q_issue(R1, rsV, ixn, 16, voff);
                q_compute_vh(R2, qq + 2, alh, ahh, oh);
                q_issue(R2, rsV, ixn, 32, voff);
                q_compute_vh(R3, qq + 3, alh, ahh, oh);
            }
            f32x2 o[8];
#pragma unroll
            for (int j = 0; j < 8; ++j) o[j] = (f32x2){(float)oh[j].x * wmx, (float)oh[j].y * wmx};
            float ss = 0.f;
#pragma unroll
            for (int j = 0; j < 4; ++j) { o[2 * j] += (f32x2){bflo(hraw[j].x), bfhi(hraw[j].x)}; o[2 * j + 1] += (f32x2){bflo(hraw[j].y), bfhi(hraw[j].y)}; }
#pragma unroll
            for (int j = 0; j < 8; ++j) ss += o[j].x * o[j].x + o[j].y * o[j].y;
            ss = wave_sum_fast(ss);
            const float r3 = rsqrtf(ss * (1.f / DM) + EPS);
            f32x4* op = (f32x4*)(P.out + (size_t)t * DM);
            const f32x4* gfp = (const f32x4*)P.g_fin;
#pragma unroll
            for (int j = 0; j < 4; ++j) { const f32x4 gv = gfp[64u * j + ul]; op[64u * j + ul] = (f32x4){o[2 * j].x * r3 * gv.x, o[2 * j].y * r3 * gv.y, o[2 * j + 1].x * r3 * gv.z, o[2 * j + 1].y * r3 * gv.w}; }
            if (!has_next) break;
            t = tn; idx0 = idx0n; idx1 = idx1n; alo = alon; ahi = ahin;
#pragma unroll
            for (int j = 0; j < 4; ++j) hraw[j] = hrawn[j];
        }
    }
}


__device__ __forceinline__ void phase_gather_u2(const Params& P, LAS unsigned char* lds) {
    const int tid = threadIdx.x, lane = tid & 63, wave = __builtin_amdgcn_readfirstlane(tid >> 6);
    const int gw = blockIdx.x * NWAVES + wave, NGW = gridDim.x * NWAVES;
    unsigned char* ws = P.ws;
    const int* IDX = (const int*)(ws + WS_IDX); const float* GATE = (const float*)(ws + WS_GATE); const float* ESC = (const float*)(ws + WS_ESCALE); const float* SQ = (const float*)(ws + WS_SUMQ);
    unsigned char* AW8 = ws + WS_AW;
    const __amdgpu_buffer_rsrc_t rsU = __builtin_amdgcn_make_buffer_rsrc((void*)(ws + WS_U8), 0, 16384 * 512, 0x00020000);
    const unsigned char* H2I = ws + WS_H0I8; const float* RF = (const float*)(ws + WS_RF);
    const int hh = lane >> 5, rr = (lane >> 4) & 1, i16 = lane & 15, gsel = 4 * i16 + 2 * rr + hh;
    const int voff = 8 * lane;
    const unsigned ul = (unsigned)lane;
    LAS int* ZL = (LAS int*)(lds + wave * 6144);
    LAS int* MAP = (LAS int*)(lds + wave * 6144 + 4096);
    const int NK = (NTOK - gw + NGW - 1) / NGW;
    if (NK <= 0) return;
    const int NS = 2 * NK;
    auto permute = [&](int i0, int i1, LAS int* mp) __attribute__((always_inline)) {
        const bool l0 = (i0 >> 13) == 0, l1 = (i1 >> 13) == 0;
        const unsigned long long m0 = __ballot(l0), m1 = __ballot(l1);
        const int n0 = __popcll(m0), n1 = __popcll(m1), nlo = n0 + n1;
        const int p0 = (int)__builtin_amdgcn_mbcnt_hi((unsigned)(m0 >> 32), __builtin_amdgcn_mbcnt_lo((unsigned)m0, 0u));
        const int p1 = (int)__builtin_amdgcn_mbcnt_hi((unsigned)(m1 >> 32), __builtin_amdgcn_mbcnt_lo((unsigned)m1, 0u));
        const int pos0 = l0 ? p0 : nlo + (lane - p0), pos1 = l1 ? n0 + p1 : nlo + (64 - n0) + (lane - p1);
        mp[pos0] = i0 | (lane << 16); mp[pos1] = i1 | ((64 + lane) << 16);
    };
    int idxa0, idxa1;
    unsigned hraw[4]; float rfv;
    { const int* ip = IDX + (size_t)gw * NSEL; const int i0 = ip[ul], i1 = ip[64u + ul];
      permute(i0, i1, MAP);
      const unsigned* hp = (const unsigned*)(H2I + (size_t)gw * DM);
#pragma unroll
      for (int j = 0; j < 4; ++j) hraw[j] = hp[64u * j + ul];
      rfv = RF[gw];
      const int t1 = gw + ((1 % NK) * NGW);
      const int* ip1 = IDX + (size_t)t1 * NSEL; idxa0 = ip1[ul]; idxa1 = ip1[64u + ul]; }
    int pcur = MAP[lane] & 0xffff;
    pcur = MAP[lane] & 0xffff;
    u32x2 R0[16], R1[16], R2[16], R3[16];
    { const int ix = pcur << 9; q_issue(R0, rsU, ix, 0, voff); q_issue(R1, rsU, ix, 16, voff); q_issue(R2, rsU, ix, 32, voff); }
#pragma unroll 1
    for (int n = 0; n < NS; ++n) {
        const int pass = (n >= NK) ? 1 : 0, k = n - pass * NK, t = gw + k * NGW;
        const int n1 = (n + 1 < NS) ? n + 1 : n, pass1 = (n1 >= NK) ? 1 : 0, k1 = n1 - pass1 * NK, tn = gw + k1 * NGW;
        const int n2 = (n + 2 < NS) ? n + 2 : n1, k2 = n2 - ((n2 >= NK) ? NK : 0), tnn = gw + k2 * NGW;
        LAS int* mcur = MAP + 128 * (n & 1); LAS int* mnxt = MAP + 128 * ((n + 1) & 1);
        permute(idxa0, idxa1, mnxt);
        unsigned hrawn[4]; float rfn; int idxb0, idxb1;
        { const int* ip = IDX + (size_t)tnn * NSEL; idxb0 = ip[ul]; idxb1 = ip[64u + ul];
          const unsigned* hp = (const unsigned*)(H2I + (size_t)tn * DM);
#pragma unroll
          for (int j = 0; j < 4; ++j) hrawn[j] = hp[64u * j + ul];
          rfn = RF[tn]; }
        float suA = 0.f, suB = 0.f, cqA = 0.f, cqB = 0.f, svA = 0.f, svB = 0.f, gA = 0.f, gB = 0.f; int oA = 0, oB = 0;
        if (pass) { const int mA = mcur[gsel], mB = mcur[64 + gsel]; const int eA = mA & 0xffff, eB = mB & 0xffff; oA = mA >> 16; oB = mB >> 16;
            suA = ESC[eA]; suB = ESC[eB]; svA = ESC[16384 + eA]; svB = ESC[16384 + eB]; cqA = SQ[eA]; cqB = SQ[eB];
            gA = GATE[(size_t)t * NSEL + oA]; gB = GATE[(size_t)t * NSEL + oB]; }
        const int pnext = mnxt[64 * pass1 + lane] & 0xffff;
        unsigned xh[2] = {0u, 0u}, xl[2] = {0u, 0u};
#pragma unroll
        for (int j = 0; j < 4; ++j) {
            const unsigned lo4 = hraw[j] & 0x0f0f0f0fu, hi4 = (hraw[j] >> 4) & 0x0f0f0f0fu;
            const unsigned tl4 = (lo4 | (lo4 >> 4)) & 0x00ff00ffu, th4 = (hi4 | (hi4 >> 4)) & 0x00ff00ffu;
            const unsigned pl = ((tl4 | (tl4 >> 8)) & 0xffffu) ^ 0x8888u, ph = (th4 | (th4 >> 8)) & 0xffffu;
            xl[j >> 1] |= pl << (16 * (j & 1)); xh[j >> 1] |= ph << (16 * (j & 1)); }
        int z = 0, zdummy = 0;
        { const int ix = pcur << 9, ixn = pnext << 9;
          q_issue(R3, rsU, ix, 48, voff);
          q_compute_ui(R0, 0, i16, (int)xh[0], (int)xh[1], (int)xl[0], (int)xl[1], z, zdummy);
          q_issue(R0, rsU, ixn, 0, voff);
          q_compute_ui(R1, 1, i16, (int)xh[0], (int)xh[1], (int)xl[0], (int)xl[1], z, zdummy);
          q_issue(R1, rsU, ixn, 16, voff);
          q_compute_ui(R2, 2, i16, (int)xh[0], (int)xh[1], (int)xl[0], (int)xl[1], z, zdummy);
          q_issue(R2, rsU, ixn, 32, voff);
          q_compute_ui(R3, 3, i16, (int)xh[0], (int)xh[1], (int)xl[0], (int)xl[1], z, zdummy); }
        if (!pass) ZL[64 * k + lane] = z;
        else {
            const int zA = ZL[64 * k + lane];
            const float zfA = ((float)zA + 8.f * cqA) * (suA * rfv), zfB = ((float)z + 8.f * cqB) * (suB * rfv);
            const float wA = gelu_tanh_f(zfA) * gA * svA, wB = gelu_tanh_f(zfB) * gB * svB;
            const float wmx = fmaxf(wave_max_fast(fmaxf(fabsf(wA), fabsf(wB))), 1e-30f), wsc = 256.f * __builtin_amdgcn_rcpf(wmx);
            const float a = wA * wsc, c = wB * wsc;
            const int ah = __builtin_amdgcn_cvt_pk_fp8_f32(a, a, 0, false) & 255, ch = __builtin_amdgcn_cvt_pk_fp8_f32(c, c, 0, false) & 255;
            const float ar = a - __builtin_amdgcn_cvt_f32_fp8(ah, 0), cr = c - __builtin_amdgcn_cvt_f32_fp8(ch, 0);
            const int al = __builtin_amdgcn_cvt_pk_fp8_f32(ar, ar, 0, false) & 255, cl = __builtin_amdgcn_cvt_pk_fp8_f32(cr, cr, 0, false) & 255;
            unsigned char* ap = AW8 + (size_t)t * 256;
            ap[oA] = (unsigned char)ah; ap[oB] = (unsigned char)ch; ap[128 + oA] = (unsigned char)al; ap[128 + oB] = (unsigned char)cl;
            if (lane == 0) ((float*)(ws + WS_WMX))[t] = wmx * (1.f / 256.f);
        }
        pcur = pnext; idxa0 = idxb0; idxa1 = idxb1; rfv = rfn;
#pragma unroll
        for (int j = 0; j < 4; ++j) hraw[j] = hrawn[j];
    }
}

typedef int i32x2v __attribute__((ext_vector_type(2)));
typedef int i32x8v __attribute__((ext_vector_type(8)));
#define VM_X 9
#define VM_WAIT(n) asm volatile("s_waitcnt vmcnt(" #n ")" ::: "memory")
__device__ __forceinline__ void phase_gather_v_mfma(const Params& P, LAS unsigned char* lds) {
    const int tid = threadIdx.x, lane = tid & 63, wave = __builtin_amdgcn_readfirstlane(tid >> 6);
    unsigned char* ws = P.ws;
    const int* IDX = (const int*)(ws + WS_IDX);
    const unsigned char* V8 = ws + WS_V8; const unsigned char* AW8 = ws + WS_AW; const float* WMX = (const float*)(ws + WS_WMX);
    const unsigned short* H2S = (const unsigned short*)(ws + WS_H2B);
    const int TPB = NTOK / (int)gridDim.x, t0 = blockIdx.x * TPB, NST = TPB * 4;
    const int r0 = 16 * wave + (lane >> 3), r1 = r0 + 8;
    const unsigned c0 = 16u * (unsigned)((lane & 7) ^ ((r0 >> 1) & 7)), c1 = 16u * (unsigned)((lane & 7) ^ ((r1 >> 1) & 7));
    const int i16 = lane & 15, kb = lane >> 4;
    const int ra = 32 * kb + i16, rb = ra + 16;
    const unsigned offa = (unsigned)(ra * 128 + 16 * (wave ^ ((ra >> 1) & 7))), offb = (unsigned)(rb * 128 + 16 * (wave ^ ((rb >> 1) & 7)));
    const unsigned aoffb = (unsigned)(((i16 & 1) ? 128 : 0) + 16 * kb);
    const bool arow = (i16 & 3) < 2;
    const int colb = 256 * kb + 32 * wave + i16;
    LAS float* SS = (LAS float*)(lds + 131072 + 1024);
    LAS float* OUTB = (LAS float*)(lds + 131072 + 2048);
    const f32x4 gfv = *(const f32x4*)(P.g_fin + 256 * (wave & 3) + 4 * lane);
    const unsigned lbase = (unsigned)(unsigned long long)lds;
    struct VTok { u32x4 a, b; float w; unsigned h0, h1; };
    VTok C0, C1;
    int ia1, ib1, ia2, ib2, ia3, ib3;
#define VM_ISSUE(g, e0, e1) do { LAS unsigned char* _d = lds + (((g) & 7) * 16384) + wave * 2048; const unsigned _cb = 128u * (unsigned)((g) & 3); \
        __builtin_amdgcn_global_load_lds((const unsigned*)(V8 + (size_t)(e0) * 512 + _cb + c0), (LAS unsigned*)(_d), 16, 0, 0); \
        __builtin_amdgcn_global_load_lds((const unsigned*)(V8 + (size_t)(e1) * 512 + _cb + c1), (LAS unsigned*)(_d + 1024), 16, 0, 0); } while (0)
    {
        const int ia0 = IDX[(size_t)t0 * NSEL + r0], ib0 = IDX[(size_t)t0 * NSEL + r1];
        ia1 = IDX[(size_t)(t0 + 1) * NSEL + r0]; ib1 = IDX[(size_t)(t0 + 1) * NSEL + r1];
        ia2 = IDX[(size_t)(t0 + 2) * NSEL + r0]; ib2 = IDX[(size_t)(t0 + 2) * NSEL + r1];
        ia3 = IDX[(size_t)(t0 + 3) * NSEL + r0]; ib3 = IDX[(size_t)(t0 + 3) * NSEL + r1];
        const unsigned char* ap = AW8 + (size_t)t0 * 256 + aoffb;
        C0.a = *(const u32x4*)ap; C0.b = *(const u32x4*)(ap + 64); C0.w = WMX[t0]; C0.h0 = H2S[(size_t)t0 * DM + colb]; C0.h1 = H2S[(size_t)t0 * DM + colb + 16];
        C1.a = *(const u32x4*)(ap + 256); C1.b = *(const u32x4*)(ap + 256 + 64); C1.w = WMX[t0 + 1]; C1.h0 = H2S[(size_t)(t0 + 1) * DM + colb]; C1.h1 = H2S[(size_t)(t0 + 1) * DM + colb + 16];
        asm volatile("s_waitcnt vmcnt(0)" ::: "memory");
        VM_ISSUE(0, ia0, ib0); VM_ISSUE(1, ia0, ib0); VM_ISSUE(2, ia0, ib0); VM_ISSUE(3, ia0, ib0);
        VM_ISSUE(4, ia1, ib1); VM_ISSUE(5, ia1, ib1); VM_ISSUE(6, ia1, ib1);
    }
    float pv0 = 0.f, pv1 = 0.f;
    VTok N0, N1; int na4, nb4, na5, nb5;
    auto token = [&](const int i, const bool even, const VTok& C, const int e1a, const int e1b, const int e2a, const int e2b) __attribute__((always_inline)) {
        const int t = t0 + i;
        const u32x4 z = (u32x4){0u, 0u, 0u, 0u}; const u32x4 Alo = arow ? C.a : z, Ahi = arow ? C.b : z;
        const i32x8v A = (i32x8v){(int)Alo.x, (int)Alo.y, (int)Alo.z, (int)Alo.w, (int)Ahi.x, (int)Ahi.y, (int)Ahi.z, (int)Ahi.w};
        f32x4 acc[4][2];
#pragma unroll
        for (int cc = 0; cc < 4; ++cc) {
            const int g = 4 * i + cc;
            if (even && cc == 0) { VM_WAIT(12); } else { VM_WAIT(26); }
            asm volatile("s_waitcnt lgkmcnt(0)" ::: "memory");
            __builtin_amdgcn_s_barrier();
            __builtin_amdgcn_sched_barrier(0);
            const unsigned sa = lbase + (unsigned)((g & 7) * 16384) + offa, sbb = lbase + (unsigned)((g & 7) * 16384) + offb;
            i32x2v b00, b01, b10, b11;
            asm volatile("ds_read_b64_tr_b4 %0, %4\n\tds_read_b64_tr_b4 %1, %5\n\tds_read_b64_tr_b4 %2, %4 offset:8\n\tds_read_b64_tr_b4 %3, %5 offset:8"
                         : "=&v"(b00), "=&v"(b01), "=&v"(b10), "=&v"(b11) : "v"(sa), "v"(sbb) : "memory");
            { const int gn = g + 7;
              if (cc == 0) VM_ISSUE(gn, e1a, e1b); else VM_ISSUE(gn, e2a, e2b); }
            __builtin_amdgcn_sched_barrier(0);
            if (cc == 0) {
                if (even) {
                    const int tA = t0 + ((i + 2 < TPB) ? i + 2 : TPB - 2), tI = t0 + ((i + 4 < TPB) ? i + 4 : TPB - 2);
                    const unsigned char* ap = AW8 + (size_t)tA * 256 + aoffb; const float* wp = WMX + tA; const int* ipa = IDX + (size_t)tI * NSEL + r0; const unsigned short* hp = H2S + (size_t)tA * DM + colb;
                    asm volatile("global_load_dwordx4 %0, %14, off\n\tglobal_load_dwordx4 %1, %14, off offset:64\n\tglobal_load_dwordx4 %2, %14, off offset:256\n\tglobal_load_dwordx4 %3, %14, off offset:320\n\t"
                                 "global_load_dword %4, %15, off\n\tglobal_load_dword %5, %15, off offset:4\n\t"
                                 "global_load_ushort %6, %17, off\n\tglobal_load_ushort %7, %17, off offset:32\n\tglobal_load_ushort %8, %17, off offset:2048\n\tglobal_load_ushort %9, %17, off offset:2080\n\t"
                                 "global_load_dword %10, %16, off\n\tglobal_load_dword %11, %16, off offset:32\n\tglobal_load_dword %12, %16, off offset:512\n\tglobal_load_dword %13, %16, off offset:544"
                                 : "=&v"(N0.a), "=&v"(N0.b), "=&v"(N1.a), "=&v"(N1.b), "=&v"(N0.w), "=&v"(N1.w), "=&v"(N0.h0), "=&v"(N0.h1), "=&v"(N1.h0), "=&v"(N1.h1), "=&v"(na4), "=&v"(nb4), "=&v"(na5), "=&v"(nb5)
                                 : "v"(ap), "v"(wp), "v"(ipa), "v"(hp) : "memory");
                }
                { const f32x4 s0 = *(const LAS f32x4*)(SS + 8 * ((i + 1) & 1)), s1 = *(const LAS f32x4*)(SS + 8 * ((i + 1) & 1) + 4);
                  const float ss = ((s0.x + s0.y) + (s0.z + s0.w)) + ((s1.x + s1.y) + (s1.z + s1.w));
                  const float r3 = __builtin_amdgcn_rsqf(ss * (1.f / DM) + EPS);
                  if (i > 0 && (wave >> 2) == ((i + 1) & 1)) {
                      const f32x4 v = *(const LAS f32x4*)(OUTB + 1024 * ((i + 1) & 1) + 256 * (wave & 3) + 4 * lane);
                      *(f32x4*)(P.out + (size_t)(t - 1) * DM + 256 * (wave & 3) + 4 * lane) = (f32x4){v.x * r3 * gfv.x, v.y * r3 * gfv.y, v.z * r3 * gfv.z, v.w * r3 * gfv.w}; } }
                __builtin_amdgcn_sched_barrier(0);
            }
            asm volatile("s_waitcnt lgkmcnt(0)" : "+v"(b00), "+v"(b01), "+v"(b10), "+v"(b11) :: "memory");
            const i32x8v B0 = (i32x8v){b00.x, b00.y, b01.x, b01.y, 0, 0, 0, 0}, B1 = (i32x8v){b10.x, b10.y, b11.x, b11.y, 0, 0, 0, 0};
            const f32x4 z4 = (f32x4){0.f, 0.f, 0.f, 0.f};
            acc[cc][0] = __builtin_amdgcn_mfma_scale_f32_16x16x128_f8f6f4(A, B0, z4, 0  , 4  , 0, 0x7f7f7f7f, 0, 0x7f7f7f7f);
            acc[cc][1] = __builtin_amdgcn_mfma_scale_f32_16x16x128_f8f6f4(A, B1, z4, 0, 4, 0, 0x7f7f7f7f, 0, 0x7f7f7f7f);
        }
#pragma unroll
        for (int c = 0; c < 4; ++c) asm volatile("" :: "v"(acc[c][0]), "v"(acc[c][1]));
        float s0 = acc[0][0].x + acc[0][0].y, s1 = acc[0][1].x + acc[0][1].y;
        { const float a0 = acc[1][0].x + acc[1][0].y, a1 = acc[1][1].x + acc[1][1].y, b0 = acc[2][0].x + acc[2][0].y, b1 = acc[2][1].x + acc[2][1].y, d0 = acc[3][0].x + acc[3][0].y, d1 = acc[3][1].x + acc[3][1].y;
          s0 = (kb == 1) ? a0 : s0; s1 = (kb == 1) ? a1 : s1; s0 = (kb == 2) ? b0 : s0; s1 = (kb == 2) ? b1 : s1; s0 = (kb == 3) ? d0 : s0; s1 = (kb == 3) ? d1 : s1; }
        pv0 = s0 * C.w + __uint_as_float(C.h0 << 16); pv1 = s1 * C.w + __uint_as_float(C.h1 << 16);
        OUTB[1024 * (i & 1) + colb] = pv0; OUTB[1024 * (i & 1) + colb + 16] = pv1;
        const float sq = wave_sum_fast(pv0 * pv0 + pv1 * pv1);
        if (lane == 0) SS[8 * (i & 1) + wave] = sq;
    };
#pragma unroll 1
    for (int i = 0; i < TPB; i += 2) {
        token(i, true, C0, ia1, ib1, ia2, ib2);
        token(i + 1, false, C1, ia2, ib2, ia3, ib3);
        asm volatile("s_waitcnt vmcnt(14)" : "+v"(N0.a), "+v"(N0.b), "+v"(N1.a), "+v"(N1.b), "+v"(N0.w), "+v"(N1.w), "+v"(N0.h0), "+v"(N0.h1), "+v"(N1.h0), "+v"(N1.h1), "+v"(na4), "+v"(nb4), "+v"(na5), "+v"(nb5) :: "memory");
        C0 = N0; C1 = N1; ia1 = ia3; ib1 = ib3; ia2 = na4; ib2 = nb4; ia3 = na5; ib3 = nb5;
    }
    asm volatile("s_waitcnt vmcnt(0)" ::: "memory");
    __builtin_amdgcn_s_barrier();
    { const int i = TPB; const f32x4 s0 = *(const LAS f32x4*)(SS + 8 * ((i + 1) & 1)), s1 = *(const LAS f32x4*)(SS + 8 * ((i + 1) & 1) + 4);
      const float ss = ((s0.x + s0.y) + (s0.z + s0.w)) + ((s1.x + s1.y) + (s1.z + s1.w));
      const float r3 = rsqrtf(ss * (1.f / DM) + EPS);
      if ((wave >> 2) == ((i + 1) & 1)) {
          const f32x4 v = *(const LAS f32x4*)(OUTB + 1024 * ((i + 1) & 1) + 256 * (wave & 3) + 4 * lane);
          *(f32x4*)(P.out + (size_t)(t0 + TPB - 1) * DM + 256 * (wave & 3) + 4 * lane) = (f32x4){v.x * r3 * gfv.x, v.y * r3 * gfv.y, v.z * r3 * gfv.z, v.w * r3 * gfv.w}; } }
#undef VM_ISSUE
}

__device__ __forceinline__ void phase_quant_h2(const Params& P) {
    const int tid = threadIdx.x, lane = tid & 63, wave = __builtin_amdgcn_readfirstlane(tid >> 6);
    const int gw = blockIdx.x * NWAVES + wave, NGW = gridDim.x * NWAVES;
    unsigned char* ws = P.ws;
    const float* SSQ = (const float*)(ws + WS_SSQ); const float* AMX = (const float*)(ws + WS_AMX); float* RF = (float*)(ws + WS_RF);
    TabRow tb0, tb1, tb2;
    if (gw < NTOK) tab_load(P, gw, lane, tb0);
    if (gw + NGW < NTOK) tab_load(P, gw + NGW, lane, tb1);
    int it3 = 0;
    for (int row = gw; row < NTOK; row += NGW, it3 = (it3 == 2) ? 0 : it3 + 1) {
        { const int e2 = row + 2 * NGW;
          if (e2 < NTOK) { if (it3 == 0) tab_load(P, e2, lane, tb2); else if (it3 == 1) tab_load(P, e2, lane, tb0); else tab_load(P, e2, lane, tb1); } }
        const u32x4* hp = (const u32x4*)(ws + WS_H2B + (size_t)row * DM * 2) + 2 * lane;
        const u32x4 a = hp[0], b = hp[1];
        const float am = fmaxf(row_max16(AMX[(size_t)row * 16 + (lane & 15)]), 1e-30f) * 1.0078125f;
        const float rstd2 = __builtin_amdgcn_rsqf(row_sum16(SSQ[(size_t)row * 16 + (lane & 15)]) * (1.f / DM) + EPS);
        const float inv = 127.f * __builtin_amdgcn_rcpf(am);
        const unsigned w[8] = {a.x, a.y, a.z, a.w, b.x, b.y, b.z, b.w};
        unsigned o[4];
#pragma unroll
        for (int j = 0; j < 4; ++j) {
            const int q0 = (int)rintf(__uint_as_float(w[2 * j] << 16) * inv), q1 = (int)rintf(__uint_as_float(w[2 * j] & 0xffff0000u) * inv);
            const int q2 = (int)rintf(__uint_as_float(w[2 * j + 1] << 16) * inv), q3 = (int)rintf(__uint_as_float(w[2 * j + 1] & 0xffff0000u) * inv);
            o[j] = ((unsigned)q0 & 255u) | (((unsigned)q1 & 255u) << 8) | (((unsigned)q2 & 255u) << 16) | ((unsigned)q3 << 24); }
        u32x4 ov; ov.x = o[0]; ov.y = o[1]; ov.z = o[2]; ov.w = o[3];
        *((u32x4*)(ws + WS_H0I8 + (size_t)row * DM) + lane) = ov;
        if (lane == 0) RF[row] = am * (1.f / 127.f) * rstd2;
        if (it3 == 0) tab_finish(P, row, lane, tb0); else if (it3 == 1) tab_finish(P, row, lane, tb1); else tab_finish(P, row, lane, tb2);
    }
}
struct EpiQI8 {
    static constexpr bool PERM = true, AFTER_DRAIN = false;
    bf16* O; int ldc; const float* rf; const float* sw;
    __device__ __forceinline__ void operator()(const pg8::i32x4 (&acc)[2][2][4][2], const pg8::Unit& u, int wr, int wc, int fr, int fq) const {
        const int row0 = u.pm * 256 + wr * 64 + fr, col0 = u.pn * 256 + wc * 32 + 8 * fq;
        f32x4 swv[2][2];
#pragma unroll
        for (int bj = 0; bj < 2; ++bj) { swv[bj][0] = *(const f32x4*)(sw + col0 + bj * 128); swv[bj][1] = *(const f32x4*)(sw + col0 + bj * 128 + 4); }
#pragma unroll
        for (int ai = 0; ai < 2; ++ai)
#pragma unroll
            for (int m = 0; m < 4; ++m) {
                const int row = row0 + ai * 128 + m * 16;
                const float s = rf[row];
                bf16* rowp = O + (size_t)row * ldc + col0;
#pragma unroll
                for (int bj = 0; bj < 2; ++bj) { const pg8::i32x4 a0 = acc[ai][bj][m][0], a1 = acc[ai][bj][m][1];
                    const f32x4 v0 = (f32x4){(float)a0[0], (float)a0[1], (float)a0[2], (float)a0[3]} * (swv[bj][0] * s), v1 = (f32x4){(float)a1[0], (float)a1[1], (float)a1[2], (float)a1[3]} * (swv[bj][1] * s);
                    u32x4 w; w.x = cvt_pk_bf16(v0[0], v0[1]); w.y = cvt_pk_bf16(v0[2], v0[3]); w.z = cvt_pk_bf16(v1[0], v1[1]); w.w = cvt_pk_bf16(v1[2], v1[3]);
                    *(u32x4*)(rowp + bj * 128) = w; }
            }
    }
};
#define XB_TMO      128
#define XB_XCNT(j)  (256  + 64 * (j))
#define XB_XSUB(j)  (1280 + 64 * (j))
#define XB_XGEN(j)  (2304 + 64 * (j))
#define XB_TOP      3328
#define XB_TOPGEN   3392
#define XCD_BAR_WORDS 3456
#define XB_SPIN_CAP (1u << 18)

__device__ __forceinline__ unsigned xb_ld(unsigned* p)              { return __hip_atomic_load(p, __ATOMIC_RELAXED, __HIP_MEMORY_SCOPE_AGENT); }
__device__ __forceinline__ unsigned xb_add(unsigned* p, unsigned v) { return __hip_atomic_fetch_add(p, v, __ATOMIC_RELAXED, __HIP_MEMORY_SCOPE_AGENT); }
__device__ __forceinline__ unsigned xb_xcc_id() { return (unsigned)__builtin_amdgcn_s_getreg((3 << 11) | 20) & 0xFu; }
#define XB_SPIN(cond, bar) do { unsigned _sp = 0; while (cond) { __builtin_amdgcn_s_sleep(1); \
    if ((++_sp & 255u) == 0u) { if (xb_ld(&(bar)[XB_TMO])) break; if (_sp > XB_SPIN_CAP) { atomicAdd(&(bar)[XB_TMO], 1u); break; } } } } while (0)

struct XcdBarrier {
    unsigned* bar; unsigned x;
    volatile LAS unsigned* st;
};

__device__ __forceinline__ XcdBarrier xcd_barrier_post(unsigned* bar, volatile LAS unsigned* st) {
    XcdBarrier b; b.bar = bar; b.x = xb_xcc_id(); b.st = st;
    if (threadIdx.x == 0) (void)xb_add(&bar[XB_XCNT(b.x)], 1u);
    return b;
}
__device__ __forceinline__ void xcd_barrier_complete(unsigned* bar, unsigned x, unsigned& nloc, unsigned& nx) {
    const unsigned G = gridDim.x * gridDim.y * gridDim.z;
    unsigned sum, cnt, mine, sp = 0u;
    for (;;) {
        sum = 0u; cnt = 0u; mine = 0u;
#pragma unroll
        for (unsigned j = 0; j < 16; ++j) { const unsigned c = xb_ld(&bar[XB_XCNT(j)]); sum += c; cnt += (c > 0u) ? 1u : 0u; mine = (j == x) ? c : mine; }
        if (sum == G) break;
        __builtin_amdgcn_s_sleep(1);
        if ((++sp & 255u) == 0u) { if (xb_ld(&bar[XB_TMO])) break; if (sp > XB_SPIN_CAP) { atomicAdd(&bar[XB_TMO], 1u); break; } }
    }
    nloc = mine > 0u ? mine : 1u; nx = cnt > 0u ? cnt : 1u;
}

__device__ __forceinline__ void xcd_barrier(const XcdBarrier& b) {
    asm volatile("s_waitcnt vmcnt(0)" ::: "memory");
    __syncthreads();
    if (threadIdx.x == 0) {
        unsigned* bar = b.bar;
        __builtin_amdgcn_s_waitcnt(0);
        unsigned nloc = b.st[0], nx = b.st[1];
        if (nloc == 0u) { xcd_barrier_complete(bar, b.x, nloc, nx); b.st[0] = nloc; b.st[1] = nx; }
        const unsigned old = xb_add(&bar[XB_XSUB(b.x)], 1u);
        const unsigned gen = old / nloc;
        if (old + 1u == (gen + 1u) * nloc) {
            __builtin_amdgcn_fence(__ATOMIC_RELEASE, "agent");
            asm volatile("s_waitcnt vmcnt(0)" ::: "memory");
            const unsigned og = xb_add(&bar[XB_TOP], 1u);
            const unsigned tg = og / nx;
            if (og + 1u == (tg + 1u) * nx) xb_add(&bar[XB_TOPGEN], 1u);
            else XB_SPIN(xb_ld(&bar[XB_TOPGEN]) == tg, bar);
            __builtin_amdgcn_fence(__ATOMIC_ACQUIRE, "agent");
            xb_add(&bar[XB_XGEN(b.x)], 1u);
            asm volatile("s_waitcnt vmcnt(0)" ::: "memory");
        } else {
            XB_SPIN(xb_ld(&bar[XB_XGEN(b.x)]) == gen, bar);
            __builtin_amdgcn_fence(__ATOMIC_ACQUIRE, "agent");
            asm volatile("s_waitcnt vmcnt(0)" ::: "memory");
        }
    }
    __syncthreads();
}


#ifndef MK_MULTI
#define MK_MULTI 0
#endif
constexpr int NPHASE = 10;
#ifndef REP5
#define REP5 1
#endif
#ifndef REP6
#define REP6 1
#endif
__global__ void __launch_bounds__(NTHREADS, 2) mk_fwd(Params P) {
    extern __shared__ __attribute__((aligned(16))) unsigned char lds_raw[];
    LAS unsigned char* lds = (LAS unsigned char*)lds_raw;
    cg::grid_group grid = cg::this_grid();
    unsigned char* ws = P.ws;
    const int lo = P.ph_lo, hi = P.ph_hi;
    volatile LAS unsigned* bst = (volatile LAS unsigned*)(lds + 131072 + 64);
    if (threadIdx.x < 2) bst[threadIdx.x] = 0u;
    __syncthreads();
    XcdBarrier xbar = xcd_barrier_post((unsigned*)(ws + WS_CTL), bst);
#define IN(k) (lo <= (k) && (k) < hi)
#define SEAM(k) do { if (IN(k) && IN((k) + 1)) { xcd_barrier(xbar); } } while (0)
    if (IN(0)) phase_prep(P, lds);
    if (IN(0) && IN(1)) { }
    SEAM(1);
    if (IN(2)) {
        pg8::Gemm g{(const bf16*)(ws + WS_H0I8), (const bf16*)(ws + WS_WIN_T), NTOK, DIN, DM / 2}; pg8::StaticOrder S; S.init(NTOK, DIN, (int)gridDim.x, (int)blockIdx.x);
        EpiProjI8 E{(bf16*)(ws + WS_PROJ), (const float*)(ws + WS_RSTD1), (const float*)(ws + WS_SW)};
        pg8::gemm_phase_i8<EpiProjI8, pg8::StaticOrder, true, true>(lds, g, S, E);
    }
    SEAM(2);
    if (IN(3)) phase_conv(P, lds);
    SEAM(3);
    if (IN(4)) {
        pg8::Gemm g{(const bf16*)(ws + WS_Y), (const bf16*)(ws + WS_WOUT_T), NTOK, DM, DM / 2}; pg8::StaticOrder S; S.init(NTOK, DM, (int)gridDim.x, (int)blockIdx.x);
        EpiResidualI8 E{(bf16*)(ws + WS_H2B), (const signed char*)(ws + WS_H0I8), (const float*)(ws + WS_SX), (const float*)(ws + WS_SY), (const float*)(ws + WS_SWO), (float*)(ws + WS_SSQ), (float*)(ws + WS_AMX)};
        pg8::gemm_phase_i8<EpiResidualI8, pg8::StaticOrder, true, true>(lds, g, S, E);
    }
    SEAM(4);
    if (IN(5)) phase_quant_h2(P);
    SEAM(5);
    if (IN(6)) {
        pg8::Gemm g{(const bf16*)(ws + WS_H0I8), (const bf16*)(ws + WS_WQ_T), NTOK, 2048, DM / 2}; pg8::StaticOrder S; S.init(NTOK, 2048, (int)gridDim.x, (int)blockIdx.x);
        EpiQI8 E{(bf16*)(ws + WS_Q), 2048, (const float*)(ws + WS_RF), (const float*)(ws + WS_SWQ)};
        pg8::gemm_phase_i8<EpiQI8, pg8::StaticOrder, true, true>(lds, g, S, E);
    }
    if (IN(6) && IN(7)) { asm volatile("s_waitcnt vmcnt(0)" ::: "memory"); __syncthreads(); }
    if (IN(7)) phase_route(P, lds);
    SEAM(7);
    if (IN(8)) { if (NTOK / ((int)gridDim.x * NWAVES) <= 16) phase_gather_u2(P, lds); else phase_gather_u(P); }
    SEAM(8);
    if (IN(9)) phase_gather_v_mfma(P, lds);
#undef IN
#undef SEAM
}

extern "C" void kernel_launch(void* const* d_in, const int* in_sizes, int n_in, void* d_out, int out_size, void* d_ws, size_t ws_size, hipStream_t stream) {
    static int grid = 0;
    if (grid == 0) {
        if (n_in != 18 || in_sizes[0] != NTOK * DM || out_size != NTOK * DM || ws_size < WS_END) {
            fprintf(stderr, "kernel_launch: unexpected shapes (n_in %d in0 %d out %d ws %zu)\n", n_in, n_in > 0 ? in_sizes[0] : -1, out_size, ws_size); grid = -1; return; }
        int dev = 0, cus = 0, per_cu = 0;
        (void)hipGetDevice(&dev); (void)hipDeviceGetAttribute(&cus, hipDeviceAttributeMultiprocessorCount, dev);
        if (hipFuncSetAttribute((const void*)mk_fwd, hipFuncAttributeMaxDynamicSharedMemorySize, LDS_BYTES) != hipSuccess) { fprintf(stderr, "kernel_launch: hipFuncSetAttribute failed\n"); grid = -1; return; }
        if (hipOccupancyMaxActiveBlocksPerMultiprocessor(&per_cu, (const void*)mk_fwd, NTHREADS, LDS_BYTES) != hipSuccess || per_cu < 1) { fprintf(stderr, "kernel_launch: occupancy query failed (%d)\n", per_cu); (void)hipGetLastError(); per_cu = 1; }
        if (per_cu > 1) per_cu = 1;
        grid = cus * per_cu;
        if (grid <= 0) grid = 256;
    }
    if (grid < 0) return;
    Params p{};
    p.x = (const float*)d_in[0]; p.meta = (const float*)d_in[1]; p.g_mix = (const float*)d_in[2]; p.w_in = (const float*)d_in[3]; p.sc_w = (const float*)d_in[4];
    p.cf_w = (const float*)d_in[5]; p.cf_b = (const float*)d_in[6]; p.ln_g = (const float*)d_in[7]; p.ln_b = (const float*)d_in[8]; p.g_sc = (const float*)d_in[9];
    p.g_cf = (const float*)d_in[10]; p.w_out = (const float*)d_in[11]; p.g_ffn = (const float*)d_in[12]; p.w_q = (const float*)d_in[13]; p.keys = (const float*)d_in[14];
    p.pu = (const float*)d_in[15]; p.pv = (const float*)d_in[16]; p.g_fin = (const float*)d_in[17];
    p.out = (float*)d_out; p.ws = (unsigned char*)d_ws;
    (void)hipMemsetAsync((char*)d_ws + WS_CTL, 0, 65536 + 16 * 2560 * 4, stream);
#if MK_MULTI
    for (int ph = 0; ph < NPHASE; ++ph) { p.ph_lo = ph; p.ph_hi = ph + 1; p.coop = 0; p.pad = 0;
        hipLaunchKernelGGL(mk_fwd, dim3(grid), dim3(NTHREADS), LDS_BYTES, stream, p); }
#else
    p.ph_lo = 0; p.ph_hi = NPHASE; p.coop = 1; p.pad = 0;
    void* args[] = {&p};
    hipError_t e = hipLaunchCooperativeKernel((const void*)mk_fwd, dim3(grid), dim3(NTHREADS), args, LDS_BYTES, stream);
    if (e != hipSuccess) fprintf(stderr, "cooperative launch failed: %s (grid %d)\n", hipGetErrorString(e), grid);
#endif
}
```
